# Optimizing an MI355X kernel written in HIP

```python
import math
import jax
import jax.numpy as jnp
from jax import lax
import numpy as np

D_MODEL = 1024
BATCH = 8
SEQ = 2048
DEPTH = 1

MIX_WIDTH = D_MODEL
HGRN_WIDTH = MIX_WIDTH // 2
HGRN_HEADS = 4
HGRN_HEAD_V = HGRN_WIDTH // HGRN_HEADS
HGRN_HEAD_K = 128
HGRN_KEY = HGRN_HEADS * HGRN_HEAD_K
CONV_CH = MIX_WIDTH - HGRN_WIDTH
CONV_LEN = 31
CHUNK = 64
SUB_CHUNK = 16
N_EXPERTS = 32
TOP_K = 4
D_FF = D_MODEL
SWIGLU_LIMIT = 7.0
SWIGLU_ALPHA = 1.702
MOE_BLOCK = 256
EPS = 1e-5
IN_COLS = 3 * HGRN_KEY + 2 * HGRN_WIDTH + 2 * CONV_CH

kernel_name = "hybrid_hgrn2_conformer_moe_encoder"


def _rmsnorm(x, w):
    xf = x.astype(jnp.float32)
    y = xf * lax.rsqrt(jnp.mean(xf * xf, axis=-1, keepdims=True) + EPS)
    return (y * w).astype(x.dtype)


def _chunk_recurrence(q, k, v, logf):
    bn, nh, t_len, dk = q.shape
    dv = v.shape[-1]
    n_ch = t_len // CHUNK
    ns = CHUNK // SUB_CHUNK
    q, k, logf = [a.reshape(bn, nh, n_ch, CHUNK, dk) for a in (q, k, logf)]
    v = v.reshape(bn, nh, n_ch, CHUNK, dv)
    b = jnp.cumsum(logf, axis=3)
    b_end = b[:, :, :, -1:, :]
    k_to_end = k * jnp.exp(b_end - b)
    u = jnp.einsum('bhncd,bhnce->bhnde', k_to_end, v)
    decay = jnp.exp(b_end[:, :, :, 0, :])

    def step(state, inp):
        dec_n, u_n = inp
        return dec_n[..., None] * state + u_n, state

    s0 = jnp.zeros((bn, nh, dk, dv), jnp.float32)
    _, s_prev = lax.scan(step, s0, (jnp.moveaxis(decay, 2, 0), jnp.moveaxis(u, 2, 0)))
    o_inter = jnp.einsum('bhncd,nbhde->bhnce', q * jnp.exp(b), s_prev)
    bs = b.reshape(bn, nh, n_ch, ns, SUB_CHUNK, dk)
    qs = q.reshape(bn, nh, n_ch, ns, SUB_CHUNK, dk)
    ks = k.reshape(bn, nh, n_ch, ns, SUB_CHUNK, dk)
    e_sub = bs[:, :, :, :, -1, :]
    k_sub = ks * jnp.exp(e_sub[:, :, :, :, None, :] - bs)
    q_rel = q[:, :, :, :, None, :] * jnp.exp(
        jnp.minimum(b[:, :, :, :, None, :] - e_sub[:, :, :, None, :, :], 0.0))
    a_off = jnp.einsum('bhntjd,bhnjsd->bhntjs', q_rel, k_sub).reshape(bn, nh, n_ch, CHUNK, CHUNK)
    tri = jnp.tril(jnp.ones((SUB_CHUNK, SUB_CHUNK), bool))
    diff = bs[..., :, None, :] - bs[..., None, :, :]
    dec = jnp.exp(jnp.where(tri[:, :, None], diff, -jnp.inf))
    a_diag = jnp.einsum('bhnitd,bhnisd,bhnitsd->bhnits', qs, ks, dec)
    a_diag_full = jnp.einsum('bhnits,ij->bhnitjs', a_diag,
                             jnp.eye(ns, dtype=a_diag.dtype)).reshape(bn, nh, n_ch, CHUNK, CHUNK)
    sub_id = jnp.arange(CHUNK) // SUB_CHUNK
    off_mask = sub_id[:, None] > sub_id[None, :]
    a = jnp.where(off_mask, a_off, 0.0) + a_diag_full
    o_intra = jnp.einsum('bhnts,bhnse->bhnte', a, v)
    return (o_inter + o_intra).reshape(bn, nh, t_len, dv)


def _hgrn2_mixer(qz, fz_f, fz_b, iv, gz, lb_f, lb_b, norm_w):
    bn, t_len, _ = qz.shape

    def heads(a, d):
        return a.reshape(bn, t_len, HGRN_HEADS, d).transpose(0, 2, 1, 3).astype(jnp.float32)

    q = jax.nn.silu(heads(qz, HGRN_HEAD_K))
    v = heads(iv, HGRN_HEAD_V)

    def gate(fz, lb):
        lb = lb.astype(jnp.float32).reshape(HGRN_HEADS, 1, HGRN_HEAD_K)
        f = lb + (1.0 - lb) * jax.nn.sigmoid(heads(fz, HGRN_HEAD_K))
        return jnp.log(f), 1.0 - f

    logf_f, k_f = gate(fz_f, lb_f)
    logf_b, k_b = gate(fz_b, lb_b)
    o_f = _chunk_recurrence(q, k_f, v, logf_f)
    flip = lambda a: jnp.flip(a, axis=2)
    o_b = flip(_chunk_recurrence(flip(q), flip(k_b), flip(v), flip(logf_b)))
    o = o_f + o_b
    o = o * lax.rsqrt(jnp.mean(o * o, axis=-1, keepdims=True) + EPS)
    o = o.transpose(0, 2, 1, 3).reshape(bn, t_len, HGRN_WIDTH) * norm_w
    return (o * jax.nn.silu(gz.astype(jnp.float32))).astype(qz.dtype)


def _conformer_conv(cv, cg, dw_w, dw_b, ln_w, ln_b):
    u = cv * jax.nn.sigmoid(cg)
    pad = (CONV_LEN - 1) // 2
    u = lax.conv_general_dilated(
        u, dw_w.reshape(CONV_LEN, 1, CONV_CH).astype(u.dtype), window_strides=(1,),
        padding=[(pad, pad)], dimension_numbers=('NWC', 'WIO', 'NWC'),
        feature_group_count=CONV_CH) + dw_b
    uf = u.astype(jnp.float32)
    mu = jnp.mean(uf, axis=-1, keepdims=True)
    var = jnp.mean(jnp.square(uf - mu), axis=-1, keepdims=True)
    uf = (uf - mu) * lax.rsqrt(var + EPS) * ln_w + ln_b
    return jax.nn.silu(uf).astype(cv.dtype)


def _moe(xf, router_w, router_b, w1, b1, w2, b2):
    t_tok, d = xf.shape
    tk = t_tok * TOP_K
    logits = (xf @ router_w + router_b).astype(jnp.float32)
    top_val, top_idx = lax.top_k(logits, TOP_K)
    gates = jax.nn.softmax(top_val, axis=-1)
    flat_e = top_idx.reshape(-1).astype(jnp.int32)
    flat_tok = jnp.repeat(jnp.arange(t_tok, dtype=jnp.int32), TOP_K)
    order = jnp.argsort(flat_e)
    sorted_e = flat_e[order]
    counts = jnp.bincount(flat_e, length=N_EXPERTS)
    padded = ((counts + MOE_BLOCK - 1) // MOE_BLOCK) * MOE_BLOCK
    pad_end = jnp.cumsum(padded)
    pad_start = pad_end - padded
    grp_start = jnp.cumsum(counts) - counts
    rank = jnp.arange(tk, dtype=jnp.int32) - grp_start[sorted_e]
    dest = pad_start[sorted_e] + rank
    n_blocks = -(-tk // MOE_BLOCK) + N_EXPERTS
    rows = n_blocks * MOE_BLOCK
    src_tok = jnp.zeros((rows,), jnp.int32).at[dest].set(flat_tok[order])
    row_gate = jnp.zeros((rows,), jnp.float32).at[dest].set(gates.reshape(-1)[order])
    block_start = jnp.arange(n_blocks, dtype=pad_end.dtype) * MOE_BLOCK
    block_expert = jnp.minimum(jnp.searchsorted(pad_end, block_start, side='right'),
                               N_EXPERTS - 1).astype(jnp.int32)
    xs = xf[src_tok].reshape(n_blocks, MOE_BLOCK, d)

    def expert_block(args):
        xb, e = args
        hdn = xb @ w1[e] + b1[e]
        h_glu = jnp.minimum(hdn[:, :D_FF], SWIGLU_LIMIT)
        h_lin = jnp.clip(hdn[:, D_FF:], -SWIGLU_LIMIT, SWIGLU_LIMIT)
        act = h_glu * jax.nn.sigmoid(SWIGLU_ALPHA * h_glu) * (h_lin + 1.0)
        return act @ w2[e] + b2[e]

    ys = lax.map(expert_block, (xs, block_expert)).reshape(rows, d)
    ys = (ys.astype(jnp.float32) * row_gate[:, None]).astype(xf.dtype)
    return jnp.zeros((t_tok, d), xf.dtype).at[src_tok].add(ys)


def setup_inputs(seed: int = 0) -> dict:
    key = jax.random.key(seed)
    ks = jax.random.split(key, 20)
    nrm = lambda k, s: jax.random.normal(k, s, jnp.float32)
    return {
        "x": nrm(ks[0], (BATCH, SEQ, D_MODEL)),
        "norm1_w": 1.0 + 0.02 * nrm(ks[1], (DEPTH, D_MODEL)),
        "w_in": nrm(ks[2], (DEPTH, D_MODEL, IN_COLS)) * D_MODEL ** -0.5,
        "lb_logits": 0.1 * nrm(ks[3], (2, DEPTH + 1, HGRN_KEY)),
        "hgrn_norm_w": 1.0 + 0.02 * nrm(ks[4], (DEPTH, HGRN_WIDTH)),
        "dw_w": nrm(ks[5], (DEPTH, CONV_LEN, CONV_CH)) * CONV_LEN ** -0.5,
        "dw_b": 0.01 * nrm(ks[6], (DEPTH, CONV_CH)),
        "conv_ln_w": 1.0 + 0.02 * nrm(ks[7], (DEPTH, CONV_CH)),
        "conv_ln_b": 0.01 * nrm(ks[8], (DEPTH, CONV_CH)),
        "w_out": nrm(ks[9], (DEPTH, MIX_WIDTH, D_MODEL)) * MIX_WIDTH ** -0.5,
        "norm2_w": 1.0 + 0.02 * nrm(ks[10], (DEPTH, D_MODEL)),
        "router_w": nrm(ks[11], (DEPTH, D_MODEL, N_EXPERTS)) * D_MODEL ** -0.5,
        "router_b": 0.01 * nrm(ks[12], (DEPTH, N_EXPERTS)),
        "w1": nrm(ks[13], (DEPTH, N_EXPERTS, D_MODEL, 2 * D_FF)) * D_MODEL ** -0.5,
        "b1": 0.01 * nrm(ks[14], (DEPTH, N_EXPERTS, 2 * D_FF)),
        "w2": nrm(ks[15], (DEPTH, N_EXPERTS, D_FF, D_MODEL)) * D_FF ** -0.5,
        "b2": 0.01 * nrm(ks[16], (DEPTH, N_EXPERTS, D_MODEL)),
        "final_norm_w": 1.0 + 0.02 * nrm(ks[17], (D_MODEL,)),
    }


def reference(x, norm1_w, w_in, lb_logits, hgrn_norm_w, dw_w, dw_b, conv_ln_w, conv_ln_b,
              w_out, norm2_w, router_w, router_b, w1, b1, w2, b2, final_norm_w):
    bn, t_len, d = x.shape
    lb_table = jnp.cumsum(jax.nn.softmax(lb_logits.astype(jnp.float32), axis=1), axis=1)
    splits = list(np.cumsum([HGRN_KEY, HGRN_KEY, HGRN_KEY, HGRN_WIDTH, HGRN_WIDTH, CONV_CH]))
    h = x
    for l in range(DEPTH):
        n = _rmsnorm(h, norm1_w[l])
        proj = n @ w_in[l]
        qz, fz_f, fz_b, iv, gz, cv, cg = jnp.split(proj, splits, axis=-1)
        a_out = _hgrn2_mixer(qz, fz_f, fz_b, iv, gz, lb_table[0, l], lb_table[1, l], hgrn_norm_w[l])
        b_out = _conformer_conv(cv, cg, dw_w[l], dw_b[l], conv_ln_w[l], conv_ln_b[l])
        h = h + jnp.concatenate([a_out, b_out], axis=-1) @ w_out[l]
        n2 = _rmsnorm(h, norm2_w[l])
        h = h + _moe(n2.reshape(bn * t_len, d), router_w[l], router_b[l],
                     w1[l], b1[l], w2[l], b2[l]).reshape(bn, t_len, d)
    return _rmsnorm(h, final_norm_w)
```

```cpp
#include <hip/hip_runtime.h>
#include <cstdio>
#include <cstdint>
namespace pg8 {
#define PG8_LAS __attribute__((address_space(3)))
typedef unsigned short bf16_t;
typedef short bf16x8 __attribute__((ext_vector_type(8)));
typedef float f32x4 __attribute__((ext_vector_type(4)));
typedef unsigned u32x4 __attribute__((ext_vector_type(4)));
constexpr int BM = 256, BK = 64, HALF = 128, HTB = HALF * BK * 2  , STAGE_BYTES = 8 * HTB, NXCD = 8, WGM = 8;

__host__ __device__ __forceinline__ int lds_byte(int r, int c) { const int st = (r >> 4) * 2 + (c >> 5), rr = r & 15, cc = c & 31, ob = rr * 64 + cc * 2; return st * 1024 + (ob ^ (((ob >> 9) & 1) << 5)); }
__host__ __device__ __forceinline__ void stage_rc(int b, int& R, int& C) { const int st = b / 1024, sb = b % 1024, swz = sb ^ (((sb >> 9) & 1) << 5); R = (st >> 1) * 16 + swz / 64; C = (st & 1) * 32 + (swz % 64) / 2; }
__host__ __device__ __forceinline__ int perm32(int rho) { const int n = rho >> 4, i = rho & 15; return 8 * (i >> 2) + 4 * n + (i & 3); }

struct Unit { int pm, pn; };
struct Gemm { const bf16_t* A; const bf16_t* Bt; int M, N, K; };

struct StaticOrder {
    int nM, nN, nwg, G, c;
    __host__ __device__ void init(int M, int N, int G_, int c_) { nM = M / BM; nN = N / BM; nwg = nM * nN; G = G_; c = c_; }
    __host__ __device__ bool next(int i, Unit& u) const {
        const long L = (long)i * G + c; if (L >= nwg) return false;
        int wgid = (int)L; { const int q = nwg / NXCD, r = nwg % NXCD, xcd = wgid % NXCD, off = wgid / NXCD; wgid = (xcd < r ? xcd * (q + 1) : r * (q + 1) + (xcd - r) * q) + off; }
        const int nig = WGM * nN, gid = wgid / nig, fm = gid * WGM, gsz = (nM - fm) < WGM ? (nM - fm) : WGM;
        u.pm = fm + ((wgid % nig) % gsz); u.pn = (wgid % nig) / gsz; return true;
    }
    __device__ __forceinline__ void a_ready(const Unit&) const {}
    __device__ __forceinline__ void done(const Unit&) const {}
};
__device__ __forceinline__ unsigned cvt_pk_bf16(float lo, float hi) { unsigned r; asm volatile("v_cvt_pk_bf16_f32 %0, %1, %2" : "=v"(r) : "v"(lo), "v"(hi)); return r; }
typedef float f32x2 __attribute__((ext_vector_type(2)));
template <class Epi, class Sched, bool ALIGN_EPI = false, bool SP2 = false>
__device__ __forceinline__ void gemm_phase(PG8_LAS unsigned char* lds, const Gemm g, const Sched& S, const Epi& E) {
    const int tid = threadIdx.x, wid = __builtin_amdgcn_readfirstlane(tid >> 6), lane = tid & 63, wr = wid >> 2, wc = wid & 3, fr = lane & 15, fq = lane >> 4;
    const int K = g.K, nt = K / BK;
    unsigned voffA[2], voffB[2];
#pragma unroll
    for (int i = 0; i < 2; ++i) { int R, C; stage_rc(tid * 16 + i * 8192, R, C); const int Rb = Epi::PERM ? ((R & ~31) + perm32(R & 31)) : R;
        voffA[i] = (unsigned)(R * K + C) * 2u; voffB[i] = (unsigned)(Rb * K + C) * 2u; }
    const size_t kstep = (size_t)(BK * 2);
    const size_t hstep = (size_t)HALF * K * 2;
    const size_t tstep = 2 * hstep;
    const unsigned ldsw = (unsigned)wid * 1024u;
    const int aoff = lds_byte(wr * 64 + fr, fq * 8), boff = lds_byte(wc * 32 + fr, fq * 8);
#define PG8_SA(b, h) (((b) * 2 + (h)) * HTB)
#define PG8_SB(b, h) ((4 + (b) * 2 + (h)) * HTB)
#define PG8_STAGE(bufoff, gbase, voff) do { _Pragma("unroll") for (int _i = 0; _i < 2; ++_i) \
        __builtin_amdgcn_global_load_lds((const unsigned*)((const char*)(gbase) + (voff)[_i]), (PG8_LAS unsigned*)(lds + (bufoff) + ldsw + _i * 8192), 16, 0, 0); } while (0)
#define PG8_LDA(dst, b, h) do { _Pragma("unroll") for (int m = 0; m < 4; ++m) _Pragma("unroll") for (int k = 0; k < 2; ++k) dst[m][k] = *(const PG8_LAS bf16x8*)(lds + PG8_SA(b, h) + aoff + m * 2048 + k * 1024); } while (0)
#define PG8_LDB(dst, b, h) do { _Pragma("unroll") for (int n = 0; n < 2; ++n) _Pragma("unroll") for (int k = 0; k < 2; ++k) dst[n][k] = *(const PG8_LAS bf16x8*)(lds + PG8_SB(b, h) + boff + n * 2048 + k * 1024); } while (0)
#define PG8_MMA(ai, bj, At, Bt) do { __builtin_amdgcn_s_setprio(1); _Pragma("unroll") for (int m = 0; m < 4; ++m) _Pragma("unroll") for (int n = 0; n < 2; ++n) _Pragma("unroll") for (int k = 0; k < 2; ++k) \
        acc[ai][bj][m][n] = __builtin_amdgcn_mfma_f32_16x16x32_bf16(Bt[n][k], At[m][k], acc[ai][bj][m][n], 0, 0, 0); __builtin_amdgcn_s_setprio(0); } while (0)
#define PG8_WAIT_V(n) asm volatile("s_waitcnt vmcnt(" #n ")" ::: "memory")
#define PG8_WAIT_L(n) asm volatile("s_waitcnt lgkmcnt(" #n ")" ::: "memory")
#define PG8_BAR __builtin_amdgcn_s_barrier()
#define PG8_SCHED __builtin_amdgcn_sched_barrier(0)
    Unit cur, nxt; int ui = 0;
    if (!S.next(0, cur)) return;
    f32x4 acc[2][2][4][2];
#pragma unroll
    for (int a = 0; a < 2; ++a)
#pragma unroll
        for (int b = 0; b < 2; ++b)
#pragma unroll
            for (int m = 0; m < 4; ++m)
#pragma unroll
                for (int n = 0; n < 2; ++n) acc[a][b][m][n] = (f32x4){0.f, 0.f, 0.f, 0.f};
    bf16x8 At[4][2], B0[2][2], B1[2][2];
    const char* cA = (const char*)g.A + (size_t)cur.pm * tstep; const char* cB = (const char*)g.Bt + (size_t)cur.pn * tstep;
    S.a_ready(cur);
    if constexpr (SP2) {
        PG8_STAGE(PG8_SB(0, 0), cB, voffB); PG8_STAGE(PG8_SB(0, 1), cB + hstep, voffB); PG8_STAGE(PG8_SA(0, 0), cA, voffA); PG8_STAGE(PG8_SA(0, 1), cA + hstep, voffA);
        if (wr == 1) PG8_BAR;
        PG8_WAIT_V(2); PG8_BAR;
        PG8_STAGE(PG8_SB(1, 0), cB + kstep, voffB); PG8_STAGE(PG8_SA(1, 0), cA + kstep, voffA); PG8_STAGE(PG8_SB(1, 1), cB + hstep + kstep, voffB);
        PG8_WAIT_V(6); PG8_BAR;
    } else {
        PG8_STAGE(PG8_SB(0, 0), cB, voffB); PG8_STAGE(PG8_SA(0, 0), cA, voffA); PG8_STAGE(PG8_SB(0, 1), cB + hstep, voffB); PG8_STAGE(PG8_SA(0, 1), cA + hstep, voffA);
        if (wr == 1) PG8_BAR;
        PG8_WAIT_V(4); PG8_BAR;
        PG8_STAGE(PG8_SB(1, 0), cB + kstep, voffB); PG8_STAGE(PG8_SA(1, 0), cA + kstep, voffA); PG8_STAGE(PG8_SB(1, 1), cB + hstep + kstep, voffB);
        PG8_WAIT_V(6); PG8_BAR;
    }
    for (;;) {
        const bool has_next = S.next(ui + 1, nxt);
        const char* nA = has_next ? (const char*)g.A + (size_t)nxt.pm * tstep : cA; const char* nB = has_next ? (const char*)g.Bt + (size_t)nxt.pn * tstep : cB;
        for (int t = 0; t < nt; t += 2) {
            const bool last = (t == nt - 2);
            const char* a1 = cA + (size_t)(t + 1) * kstep;
            const char* a2 = last ? nA : cA + (size_t)(t + 2) * kstep; const char* b2 = last ? nB : cB + (size_t)(t + 2) * kstep;
            const char* a3 = a2 + kstep; const char* b3 = b2 + kstep;
            if (last && has_next) S.a_ready(nxt);
            if constexpr (SP2) {
            PG8_LDB(B0, 0, 0); PG8_LDB(B1, 0, 1); PG8_SCHED; PG8_LDA(At, 0, 0); PG8_STAGE(PG8_SA(1, 1), a1 + hstep, voffA);
            PG8_WAIT_V(8); PG8_WAIT_L(0); PG8_BAR; PG8_MMA(0, 0, At, B0); PG8_MMA(0, 1, At, B1); PG8_BAR; PG8_SCHED;
            PG8_LDA(At, 0, 1); PG8_STAGE(PG8_SB(0, 0), b2, voffB); PG8_STAGE(PG8_SB(0, 1), b2 + hstep, voffB); PG8_STAGE(PG8_SA(0, 0), a2, voffA);
            PG8_WAIT_V(8); PG8_WAIT_L(0); PG8_BAR; PG8_MMA(1, 0, At, B0); PG8_MMA(1, 1, At, B1); PG8_BAR; PG8_SCHED;
            PG8_LDB(B0, 1, 0); PG8_LDB(B1, 1, 1); PG8_SCHED; PG8_LDA(At, 1, 0); PG8_STAGE(PG8_SA(0, 1), a2 + hstep, voffA);
            PG8_WAIT_V(8); PG8_WAIT_L(0); PG8_BAR; PG8_MMA(0, 0, At, B0); PG8_MMA(0, 1, At, B1); PG8_BAR; PG8_SCHED;
            PG8_LDA(At, 1, 1); PG8_STAGE(PG8_SB(1, 0), b3, voffB); PG8_STAGE(PG8_SB(1, 1), b3 + hstep, voffB); PG8_STAGE(PG8_SA(1, 0), a3, voffA);
            PG8_WAIT_V(8); PG8_WAIT_L(0); PG8_BAR; PG8_MMA(1, 0, At, B0); PG8_MMA(1, 1, At, B1); PG8_BAR; PG8_SCHED;
            } else {
            PG8_LDB(B0, 0, 0); PG8_SCHED; PG8_LDA(At, 0, 0); PG8_STAGE(PG8_SA(1, 1), a1 + hstep, voffA);
            PG8_WAIT_L(8); PG8_BAR; PG8_WAIT_L(0); PG8_MMA(0, 0, At, B0); PG8_BAR; PG8_SCHED;
            PG8_LDB(B1, 0, 1); PG8_STAGE(PG8_SB(0, 0), b2, voffB);
            PG8_BAR; PG8_WAIT_L(0); PG8_MMA(0, 1, At, B1); PG8_BAR;
            PG8_LDA(At, 0, 1); PG8_STAGE(PG8_SA(0, 0), a2, voffA);
            PG8_BAR; PG8_WAIT_L(0); PG8_MMA(1, 0, At, B0); PG8_BAR; PG8_SCHED;
            PG8_STAGE(PG8_SB(0, 1), b2 + hstep, voffB);
            PG8_WAIT_V(6); PG8_BAR; PG8_MMA(1, 1, At, B1); PG8_BAR;
            PG8_LDB(B0, 1, 0); PG8_SCHED; PG8_LDA(At, 1, 0); PG8_STAGE(PG8_SA(0, 1), a2 + hstep, voffA);
            PG8_WAIT_L(8); PG8_BAR; PG8_WAIT_L(0); PG8_MMA(0, 0, At, B0); PG8_BAR; PG8_SCHED;
            PG8_LDB(B1, 1, 1); PG8_STAGE(PG8_SB(1, 0), b3, voffB);
            PG8_BAR; PG8_WAIT_L(0); PG8_MMA(0, 1, At, B1); PG8_BAR;
            PG8_LDA(At, 1, 1); PG8_STAGE(PG8_SA(1, 0), a3, voffA);
            PG8_BAR; PG8_WAIT_L(0); PG8_MMA(1, 0, At, B0); PG8_BAR; PG8_SCHED;
            PG8_STAGE(PG8_SB(1, 1), b3 + hstep, voffB);
            PG8_WAIT_V(6); PG8_BAR; PG8_MMA(1, 1, At, B1); PG8_BAR;
            }
        }
        if constexpr (ALIGN_EPI) { if (wr == 0) PG8_BAR; }
        if constexpr (!Epi::AFTER_DRAIN) { E(acc, cur, wr, wc, fr, fq); S.done(cur); }
        if (!has_next) break;
#pragma unroll
        for (int a = 0; a < 2; ++a)
#pragma unroll
            for (int b = 0; b < 2; ++b)
#pragma unroll
                for (int m = 0; m < 4; ++m)
#pragma unroll
                    for (int n = 0; n < 2; ++n) acc[a][b][m][n] = (f32x4){0.f, 0.f, 0.f, 0.f};
        cur = nxt; cA = nA; cB = nB; ++ui;
        if constexpr (ALIGN_EPI) { if (wr == 1) PG8_BAR; }
    }
    PG8_WAIT_V(0);
    if constexpr (!ALIGN_EPI) { if (wr == 0) PG8_BAR; }
    PG8_BAR;
    if constexpr (Epi::AFTER_DRAIN) { E.fused(acc, cur, wr, wc, fr, fq, lds, wid, lane); S.done(cur); }
#undef PG8_SA
#undef PG8_SB
#undef PG8_STAGE
#undef PG8_LDA
#undef PG8_LDB
#undef PG8_MMA
#undef PG8_WAIT_V
#undef PG8_WAIT_L
#undef PG8_BAR
#undef PG8_SCHED
}
}

#ifndef MK_N_LAUNCHES
#define MK_N_LAUNCHES 10
#endif
constexpr int N_PHASES = 10;
constexpr int NBATCH = 8, TT = 2048, MTOK = NBATCH * TT, D = 1024;
constexpr int HK = 512, NH = 4, DK = 128, DV = 128, CCH = 512, CLEN = 31, INC = 3584;
constexpr int NE = 32, TOPK = 4, FF = 1024;
constexpr float EPS = 1e-5f, SW_LIMIT = 7.0f, SW_ALPHA = 1.702f;
constexpr int NWAVES = 8, NTHR = 512;
constexpr int MOE_ROWS = (MTOK * TOPK / 256 + NE) * 256;

constexpr size_t MiB = 1u << 20;
constexpr size_t WS_CTL = 0, CTL_ZERO_BYTES = 1 * MiB;
constexpr size_t WS_WI = 1 * MiB;
constexpr size_t WS_WO = 8 * MiB;
constexpr size_t WS_TAB = 10 * MiB;
constexpr size_t WS_W1 = 16 * MiB;
constexpr size_t WS_W2 = 144 * MiB;
constexpr size_t WS_H = 208 * MiB;
constexpr size_t WS_XN = 272 * MiB;
constexpr size_t WS_Q = 304 * MiB, WS_KF = 320 * MiB, WS_KB = 336 * MiB, WS_V = 352 * MiB, WS_G = 368 * MiB, WS_U = 384 * MiB;
constexpr size_t WS_LF = 400 * MiB, WS_LB = 432 * MiB;
constexpr size_t WS_OF = 464 * MiB, WS_OB = 496 * MiB;
constexpr size_t WS_MIX = 528 * MiB;
constexpr size_t WS_XS = 304 * MiB;
constexpr size_t WS_ACT = 448 * MiB;
constexpr size_t WS_YS = 592 * MiB;
constexpr size_t WS_END = 736 * MiB;
constexpr size_t WS_WRT = WS_TAB;
constexpr size_t WS_SLOT = WS_TAB + 256 * 1024;
constexpr size_t WS_GATE = WS_TAB + 512 * 1024;
constexpr size_t WS_ROWTOK = WS_TAB + 1 * MiB;
constexpr int CW_BAR = 4096;
constexpr int CW_CNT = 16384;

constexpr int RING_OFF = 0, RING_BYTES = 131072;
constexpr int LDSCTL_OFF = RING_BYTES;
constexpr int MISC_OFF = LDSCTL_OFF + 320;
constexpr int TAB_OFF = LDSCTL_OFF + 1024;
constexpr int SB_OFF = LDSCTL_OFF + 2048;
constexpr int LDS_BYTES = 147456;

#define GAS __attribute__((address_space(1)))
#define LAS __attribute__((address_space(3)))
typedef unsigned short bf16;
typedef unsigned v4u __attribute__((ext_vector_type(4)));
typedef unsigned v2u __attribute__((ext_vector_type(2)));
typedef float f32x4 __attribute__((ext_vector_type(4)));
typedef GAS unsigned gu32;
#define RLX_AGENT __ATOMIC_RELAXED, __HIP_MEMORY_SCOPE_AGENT
#define LDS_WAIT() asm volatile("s_waitcnt lgkmcnt(0)" ::: "memory")
#define VM_WAIT() asm volatile("s_waitcnt vmcnt(0)" ::: "memory")

__device__ __forceinline__ float bf2f(unsigned b) { return __uint_as_float(b << 16); }
__device__ __forceinline__ unsigned pk2(float lo, float hi) { return pg8::cvt_pk_bf16(lo, hi); }
__device__ __forceinline__ float sigm(float x) { return __builtin_amdgcn_rcpf(1.0f + __expf(-x)); }
__device__ __forceinline__ float wave_sum(float v) {
#pragma unroll
    for (int o = 1; o < 64; o <<= 1) v += __shfl_xor(v, o);
    return v;
}

#define XB_TMO      128
#define XB_XCNT(j)  (256  + 64 * (j))
#define XB_XSUB(j)  (1280 + 64 * (j))
#define XB_XGEN(j)  (2304 + 64 * (j))
#define XB_TOP      3328
#define XB_TOPGEN   3392
#define XCD_BAR_WORDS 3456
#define XB_SPIN_CAP (1u << 18)

__device__ __forceinline__ unsigned xb_ld(unsigned* p)              { return __hip_atomic_load(p, __ATOMIC_RELAXED, __HIP_MEMORY_SCOPE_AGENT); }
__device__ __forceinline__ unsigned xb_add(unsigned* p, unsigned v) { return __hip_atomic_fetch_add(p, v, __ATOMIC_RELAXED, __HIP_MEMORY_SCOPE_AGENT); }
__device__ __forceinline__ unsigned xb_xcc_id() { return (unsigned)__builtin_amdgcn_s_getreg((3 << 11) | 20) & 0xFu; }
#define XB_SPIN(cond, bar) do { unsigned _sp = 0; while (cond) { __builtin_amdgcn_s_sleep(1); \
    if ((++_sp & 255u) == 0u) { if (xb_ld(&(bar)[XB_TMO])) break; if (_sp > XB_SPIN_CAP) { atomicAdd(&(bar)[XB_TMO], 1u); break; } } } } while (0)

struct XcdBarrier {
    unsigned* bar; unsigned x;
    volatile LAS unsigned* st;
};
__device__ __forceinline__ XcdBarrier xcd_barrier_post(unsigned* bar, volatile LAS unsigned* st) {
    XcdBarrier b; b.bar = bar; b.x = xb_xcc_id(); b.st = st;
    if (threadIdx.x == 0) (void)xb_add(&bar[XB_XCNT(b.x)], 1u);
    return b;
}
__device__ __forceinline__ void xcd_barrier_complete(unsigned* bar, unsigned x, unsigned& nloc, unsigned& nx) {
    const unsigned G = gridDim.x * gridDim.y * gridDim.z;
    unsigned sum, cnt, mine, sp = 0u;
    for (;;) {
        sum = 0u; cnt = 0u; mine = 0u;
#pragma unroll
        for (unsigned j = 0; j < 16; ++j) { const unsigned c = xb_ld(&bar[XB_XCNT(j)]); sum += c; cnt += (c > 0u) ? 1u : 0u; mine = (j == x) ? c : mine; }
        if (sum == G) break;
        __builtin_amdgcn_s_sleep(1);
        if ((++sp & 255u) == 0u) { if (xb_ld(&bar[XB_TMO])) break; if (sp > XB_SPIN_CAP) { atomicAdd(&bar[XB_TMO], 1u); break; } }
    }
    nloc = mine > 0u ? mine : 1u; nx = cnt > 0u ? cnt : 1u;
}
__device__ __forceinline__ void xcd_barrier(const XcdBarrier& b) {
    asm volatile("s_waitcnt vmcnt(0)" ::: "memory");
    __syncthreads();
    if (threadIdx.x == 0) {
        unsigned* bar = b.bar;
        __builtin_amdgcn_s_waitcnt(0);
        unsigned nloc = b.st[0], nx = b.st[1];
        if (nloc == 0u) { xcd_barrier_complete(bar, b.x, nloc, nx); b.st[0] = nloc; b.st[1] = nx; }
        const unsigned old = xb_add(&bar[XB_XSUB(b.x)], 1u);
        const unsigned gen = old / nloc;
        if (old + 1u == (gen + 1u) * nloc) {
            __builtin_amdgcn_fence(__ATOMIC_RELEASE, "agent");
            asm volatile("s_waitcnt vmcnt(0)" ::: "memory");
            const unsigned og = xb_add(&bar[XB_TOP], 1u);
            const unsigned tg = og / nx;
            if (og + 1u == (tg + 1u) * nx) xb_add(&bar[XB_TOPGEN], 1u);
            else XB_SPIN(xb_ld(&bar[XB_TOPGEN]) == tg, bar);
            __builtin_amdgcn_fence(__ATOMIC_ACQUIRE, "agent");
            xb_add(&bar[XB_XGEN(b.x)], 1u);
            asm volatile("s_waitcnt vmcnt(0)" ::: "memory");
        } else {
            XB_SPIN(xb_ld(&bar[XB_XGEN(b.x)]) == gen, bar);
            __builtin_amdgcn_fence(__ATOMIC_ACQUIRE, "agent");
            asm volatile("s_waitcnt vmcnt(0)" ::: "memory");
        }
    }
    __syncthreads();
}

__device__ __forceinline__ void st8bf(bf16* p, const f32x4& a, const f32x4& b) {
    v4u w; w.x = pk2(a[0], a[1]); w.y = pk2(a[2], a[3]); w.z = pk2(b[0], b[1]); w.w = pk2(b[2], b[3]);
    *(v4u*)p = w;
}
struct EpiProj {
    static constexpr bool PERM = true, AFTER_DRAIN = false;
    bf16 *Q, *KF, *KB, *V, *G, *U; float *LF, *LB; const float* lbl;
    template <int TYP>
    __device__ __forceinline__ void tile(const pg8::f32x4 (&acc)[2][2][4][2], int row0, int cb) const {
#pragma unroll
        for (int bj = 0; bj < 2; ++bj) {
            const int col = cb + bj * 128;
            float lb[8];
            if (TYP == 1 || TYP == 2) {
                const float* L = lbl + (TYP - 1) * 1024 + col;
#pragma unroll
                for (int i = 0; i < 8; ++i) lb[i] = __builtin_amdgcn_rcpf(1.0f + __expf(L[512 + i] - L[i]));
            }
#pragma unroll
            for (int ai = 0; ai < 2; ++ai)
#pragma unroll
                for (int m = 0; m < 4; ++m) {
                    const size_t off = (size_t)(row0 + ai * 128 + m * 16) * 512 + col;
                    f32x4 a = acc[ai][bj][m][0], b = acc[ai][bj][m][1];
                    if (TYP == 0 || TYP == 4) {
#pragma unroll
                        for (int i = 0; i < 4; ++i) { a[i] = a[i] * sigm(a[i]); b[i] = b[i] * sigm(b[i]); }
                        st8bf((TYP == 0 ? Q : G) + off, a, b);
                    } else if (TYP == 3) {
                        st8bf(V + off, a, b);
                    } else {
                        f32x4 la, lbv, ka, kb;
#pragma unroll
                        for (int i = 0; i < 4; ++i) {
                            const float fa = lb[i] + (1.0f - lb[i]) * sigm(a[i]), fb = lb[4 + i] + (1.0f - lb[4 + i]) * sigm(b[i]);
                            la[i] = __logf(fa); lbv[i] = __logf(fb); ka[i] = 1.0f - fa; kb[i] = 1.0f - fb;
                        }
                        float* Lp = (TYP == 1 ? LF : LB) + off;
                        *(f32x4*)Lp = la; *(f32x4*)(Lp + 4) = lbv;
                        st8bf((TYP == 1 ? KF : KB) + off, ka, kb);
                    }
                }
        }
    }
    __device__ __forceinline__ void operator()(const pg8::f32x4 (&acc)[2][2][4][2], const pg8::Unit& u, int wr, int wc, int fr, int fq) const {
        const int row0 = u.pm * 256 + wr * 64 + fr, pn = u.pn;
        if (pn >= 10) {
            const int col = (pn - 10) * 128 + wc * 32 + 8 * fq;
#pragma unroll
            for (int ai = 0; ai < 2; ++ai)
#pragma unroll
                for (int m = 0; m < 4; ++m) {
                    f32x4 a = acc[ai][0][m][0], b = acc[ai][0][m][1]; const f32x4 ga = acc[ai][1][m][0], gb = acc[ai][1][m][1];
#pragma unroll
                    for (int i = 0; i < 4; ++i) { a[i] = a[i] * sigm(ga[i]); b[i] = b[i] * sigm(gb[i]); }
                    st8bf(U + (size_t)(row0 + ai * 128 + m * 16) * 512 + col, a, b);
                }
        } else {
            const int cb = (pn & 1) * 256 + wc * 32 + 8 * fq, typ = pn >> 1;
            if (typ == 0) tile<0>(acc, row0, cb);
            else if (typ == 1) tile<1>(acc, row0, cb);
            else if (typ == 2) tile<2>(acc, row0, cb);
            else if (typ == 3) tile<3>(acc, row0, cb);
            else tile<4>(acc, row0, cb);
        }
    }
};
struct EpiRes {
    static constexpr bool PERM = false, AFTER_DRAIN = false;
    const float* X; float* H;
    __device__ __forceinline__ void operator()(const pg8::f32x4 (&acc)[2][2][4][2], const pg8::Unit& u, int wr, int wc, int fr, int fq) const {
        const int row0 = u.pm * 256 + wr * 64 + fr, col0 = u.pn * 256 + wc * 32 + 4 * fq;
#pragma unroll
        for (int ai = 0; ai < 2; ++ai)
#pragma unroll
            for (int m = 0; m < 4; ++m) {
                const size_t off = (size_t)(row0 + ai * 128 + m * 16) * D + col0;
#pragma unroll
                for (int bj = 0; bj < 2; ++bj)
#pragma unroll
                    for (int n = 0; n < 2; ++n) { const f32x4 xv = *(const f32x4*)(X + off + bj * 128 + n * 16); *(f32x4*)(H + off + bj * 128 + n * 16) = xv + acc[ai][bj][m][n]; }
            }
    }
};
struct EpiSwiglu {
    static constexpr bool PERM = true, AFTER_DRAIN = false;
    bf16* ACT; const float* b1;
    __device__ __forceinline__ void operator()(const pg8::f32x4 (&acc)[2][2][4][2], const pg8::Unit& u, int wr, int wc, int fr, int fq) const {
        const int e = u.pn >> 3, pn = u.pn & 7, row0 = u.pm * 256 + wr * 64 + fr, col = pn * 128 + wc * 32 + 8 * fq;
        const float* bg = b1 + (size_t)e * 2048 + col; const float* bl = bg + 1024;
        float g[8], l[8];
#pragma unroll
        for (int i = 0; i < 8; ++i) { g[i] = bg[i]; l[i] = bl[i]; }
#pragma unroll
        for (int ai = 0; ai < 2; ++ai)
#pragma unroll
            for (int m = 0; m < 4; ++m) {
                f32x4 o[2];
#pragma unroll
                for (int n = 0; n < 2; ++n)
#pragma unroll
                    for (int i = 0; i < 4; ++i) {
                        const float hg = fminf(acc[ai][0][m][n][i] + g[4 * n + i], SW_LIMIT);
                        const float hl = fminf(fmaxf(acc[ai][1][m][n][i] + l[4 * n + i], -SW_LIMIT), SW_LIMIT);
                        o[n][i] = hg * sigm(SW_ALPHA * hg) * (hl + 1.0f);
                    }
                st8bf(ACT + (size_t)(row0 + ai * 128 + m * 16) * FF + col, o[0], o[1]);
            }
    }
};
struct EpiDown {
    static constexpr bool PERM = true, AFTER_DRAIN = false;
    bf16* YS; const float* b2;
    __device__ __forceinline__ void operator()(const pg8::f32x4 (&acc)[2][2][4][2], const pg8::Unit& u, int wr, int wc, int fr, int fq) const {
        const int e = u.pn >> 2, pn = u.pn & 3, row0 = u.pm * 256 + wr * 64 + fr, col0 = pn * 256 + wc * 32 + 8 * fq;
#pragma unroll
        for (int bj = 0; bj < 2; ++bj) {
            const float* bp = b2 + (size_t)e * D + col0 + bj * 128;
            const f32x4 b0 = *(const f32x4*)bp, b1v = *(const f32x4*)(bp + 4);
#pragma unroll
            for (int ai = 0; ai < 2; ++ai)
#pragma unroll
                for (int m = 0; m < 4; ++m)
                    st8bf(YS + (size_t)(row0 + ai * 128 + m * 16) * D + col0 + bj * 128, acc[ai][bj][m][0] + b0, acc[ai][bj][m][1] + b1v);
        }
    }
};
struct MoeOrder {
    const volatile LAS int* bs; int ntn, G, v;
    __device__ __forceinline__ bool next(int i, pg8::Unit& u) const {
        const int L = i * G + v, nb = bs[32];
        if (L >= nb * ntn) return false;
        const int mb = L / ntn, pn = L - mb * ntn;
        int e = 0;
        while (e < NE - 1 && bs[e + 1] <= mb) ++e;
        u.pm = mb; u.pn = e * ntn + pn; return true;
    }
    __device__ __forceinline__ void a_ready(const pg8::Unit&) const {}
    __device__ __forceinline__ void done(const pg8::Unit&) const {}
};

struct RmIdent { __device__ __forceinline__ int operator()(int n) const { return n; } };
struct RmWin {
    __device__ __forceinline__ int operator()(int n) const {
        if (n < 2560) return n;
        if (n < 3072) { const int j = n - 2560; return 2560 + (j >> 7) * 256 + (j & 127); }
        const int j = n - 3072; return 2560 + (j >> 7) * 256 + 128 + (j & 127);
    }
};
struct RmW1 {
    __device__ __forceinline__ int operator()(int n) const {
        if (n < 1024) return (n >> 7) * 256 + (n & 127);
        const int j = n - 1024; return (j >> 7) * 256 + 128 + (j & 127);
    }
};
template <class RM>
__device__ __forceinline__ void p0_transpose_item(const float* W, int K, int N, bf16* WT, RM rm, LAS float* scr, int item, int lane) {
    const int nblk = N / 32, kb = item / nblk, nb = item % nblk, k0 = 64 * kb, n0 = 32 * nb;
#pragma unroll 8
    for (int i = 0; i < 32; ++i) { const int kk = 2 * i + (lane >> 5); scr[kk * 33 + (lane & 31)] = W[(size_t)(k0 + kk) * N + n0 + (lane & 31)]; }
    LDS_WAIT(); asm volatile("" ::: "memory");
    const int c = lane & 7;
#pragma unroll
    for (int j = 0; j < 4; ++j) { const int n = (lane >> 3) + 8 * j; const LAS float* s = scr + (8 * c) * 33 + n;
        v4u o; o.x = pk2(s[0 * 33], s[1 * 33]); o.y = pk2(s[2 * 33], s[3 * 33]); o.z = pk2(s[4 * 33], s[5 * 33]); o.w = pk2(s[6 * 33], s[7 * 33]);
        *(GAS v4u*)(WT + (size_t)rm(n0 + n) * K + k0 + 8 * c) = o; }
    LDS_WAIT(); asm volatile("" ::: "memory");
}
__device__ __forceinline__ void rms_row_to_bf16(const float* xrow, const float* w, bf16* orow, int lane) {
    const f32x4* xr = (const f32x4*)xrow + lane; const f32x4* wr = (const f32x4*)w + lane;
    f32x4 v[4]; float s = 0.f;
#pragma unroll
    for (int j = 0; j < 4; ++j) { v[j] = xr[64 * j]; s += (v[j].x * v[j].x + v[j].y * v[j].y) + (v[j].z * v[j].z + v[j].w * v[j].w); }
    const float rstd = rsqrtf(wave_sum(s) * (1.f / D) + EPS);
    v2u* o8 = (v2u*)orow + lane;
#pragma unroll
    for (int j = 0; j < 4; ++j) { const f32x4 g = wr[64 * j]; v2u o; o.x = pk2(v[j].x * rstd * g.x, v[j].y * rstd * g.y); o.y = pk2(v[j].z * rstd * g.z, v[j].w * rstd * g.w); o8[64 * j] = o; }
}

struct Args { const float* in[18]; float* out; unsigned char* ws; int ph_lo, ph_hi; };
__global__ void __launch_bounds__(NTHR, 2) fwd_kernel(Args args) {
    extern __shared__ __attribute__((aligned(16))) unsigned char lds_raw[];
    LAS unsigned char* lds = (LAS unsigned char*)lds_raw;
    volatile LAS unsigned* MISC = (volatile LAS unsigned*)(lds + MISC_OFF);
    const int tid = threadIdx.x, lane = tid & 63, wave = __builtin_amdgcn_readfirstlane(tid >> 6);
    const int G = gridDim.x; const int bx = blockIdx.x; const int vcu = (G % 8 == 0) ? (bx % 8) * (G / 8) + bx / 8 : bx;
    const int gw = vcu * NWAVES + wave, NGW = G * NWAVES;
    unsigned char* ws = args.ws;
    unsigned* ctl = (unsigned*)(ws + WS_CTL);
    const float* x = args.in[0]; const float* norm1_w = args.in[1]; const float* w_in = args.in[2]; const float* lb_logits = args.in[3];
    const float* hgrn_norm_w = args.in[4]; const float* dw_w = args.in[5]; const float* dw_b = args.in[6]; const float* conv_ln_w = args.in[7]; const float* conv_ln_b = args.in[8];
    const float* w_out = args.in[9]; const float* norm2_w = args.in[10]; const float* router_w = args.in[11]; const float* router_b = args.in[12];
    const float* w1 = args.in[13]; const float* b1 = args.in[14]; const float* w2 = args.in[15]; const float* b2 = args.in[16]; const float* final_norm_w = args.in[17];
    float* out = args.out;
    bf16* WI = (bf16*)(ws + WS_WI); bf16* WO = (bf16*)(ws + WS_WO); bf16* W1T = (bf16*)(ws + WS_W1); bf16* W2T = (bf16*)(ws + WS_W2);
    float* H = (float*)(ws + WS_H); bf16* XN = (bf16*)(ws + WS_XN);
    bf16* Qb = (bf16*)(ws + WS_Q); bf16* KFb = (bf16*)(ws + WS_KF); bf16* KBb = (bf16*)(ws + WS_KB); bf16* Vb = (bf16*)(ws + WS_V); bf16* Gb = (bf16*)(ws + WS_G); bf16* Ub = (bf16*)(ws + WS_U);
    float* LFb = (float*)(ws + WS_LF); float* LBb = (float*)(ws + WS_LB); float* OFb = (float*)(ws + WS_OF); float* OBb = (float*)(ws + WS_OB);
    bf16* MIX = (bf16*)(ws + WS_MIX); bf16* XS = (bf16*)(ws + WS_XS); bf16* ACT = (bf16*)(ws + WS_ACT); bf16* YS = (bf16*)(ws + WS_YS);
    float* WRT = (float*)(ws + WS_WRT); int* SLOT = (int*)(ws + WS_SLOT); float* GATE = (float*)(ws + WS_GATE); int* ROWTOK = (int*)(ws + WS_ROWTOK);
    volatile LAS int* bs = (volatile LAS int*)(lds + TAB_OFF);
    volatile LAS int* cl = (volatile LAS int*)(lds + TAB_OFF + 256);
    LAS int* lcnt = (LAS int*)(lds + TAB_OFF + 512);
    volatile LAS int* gbase = (volatile LAS int*)(lds + TAB_OFF + 768);

    for (int u = tid; u < (LDS_BYTES - LDSCTL_OFF) / 4; u += NTHR) ((LAS unsigned*)(lds + LDSCTL_OFF))[u] = 0u;
    __syncthreads();
    XcdBarrier bar; bar.bar = ctl + CW_BAR; bar.x = 0; bar.st = nullptr;
    if (MK_N_LAUNCHES == 1) bar = xcd_barrier_post(ctl + CW_BAR, MISC + 8);
    const int lo = args.ph_lo, hi = args.ph_hi;
#ifndef PHASE_MASK
#define PHASE_MASK 0xffffffffu
#endif
#define IN(k) ((((PHASE_MASK) >> (k)) & 1u) && lo <= (k) && (k) < hi)
#define SEAM(k) do { if (IN(k) && IN((k) + 1)) xcd_barrier(bar); } while (0)
#define BUILD_BS() do { if (tid == 0) { int a_ = 0; for (int e_ = 0; e_ < NE; ++e_) { bs[e_] = a_; const int c_ = (int)__hip_atomic_load(ctl + CW_CNT + 64 * e_, RLX_AGENT); cl[e_] = c_; a_ += (c_ + 255) >> 8; } bs[NE] = a_; } __syncthreads(); } while (0)

    if (IN(0)) {
        LAS float* scr = (LAS float*)(lds + RING_OFF + wave * 16384);
        constexpr int I_WI = (D / 64) * (INC / 32), I_WO = (D / 64) * (D / 32), I_W1 = (D / 64) * (2 * FF / 32), I_W2 = (FF / 64) * (D / 32);
        constexpr int NITEMS = I_WI + I_WO + NE * I_W1 + NE * I_W2;
        for (int it = gw; it < NITEMS; it += NGW) {
            int r = it;
            if (r < I_WI) { p0_transpose_item(w_in, D, INC, WI, RmWin(), scr, r, lane); continue; } r -= I_WI;
            if (r < I_WO) { p0_transpose_item(w_out, D, D, WO, RmIdent(), scr, r, lane); continue; } r -= I_WO;
            if (r < NE * I_W1) { const int e = r / I_W1; p0_transpose_item(w1 + (size_t)e * D * 2 * FF, D, 2 * FF, W1T + (size_t)e * 2 * FF * D, RmW1(), scr, r - e * I_W1, lane); continue; } r -= NE * I_W1;
            { const int e = r / I_W2; p0_transpose_item(w2 + (size_t)e * FF * D, FF, D, W2T + (size_t)e * D * FF, RmIdent(), scr, r - e * I_W2, lane); }
        }
        for (int m = gw; m < MTOK; m += NGW) rms_row_to_bf16(x + (size_t)m * D, norm1_w, XN + (size_t)m * D, lane);
        for (int i = bx * NTHR + tid; i < NE * D; i += G * NTHR) { const int e = i >> 10, c = i & 1023; WRT[i] = router_w[c * NE + e]; }
    }
    SEAM(0);

    if (IN(1)) {
        pg8::Gemm g{XN, WI, MTOK, INC, D}; pg8::StaticOrder S; S.init(MTOK, INC, G, bx);
        EpiProj E{Qb, KFb, KBb, Vb, Gb, Ub, LFb, LBb, lb_logits};
        pg8::gemm_phase<EpiProj, pg8::StaticOrder, true, true>(lds + RING_OFF, g, S, E);
    }
    SEAM(1);

    if (IN(2)) {
        {
            LAS unsigned short* ut = (LAS unsigned short*)(lds + RING_OFF);
            LAS float* part = (LAS float*)(lds + RING_OFF + 98304);
            LAS float* stat = (LAS float*)(lds + RING_OFF + 98304 + 4096);
            for (int unit = vcu; unit < NBATCH * (TT / 64); unit += G) {
                const int b = unit / (TT / 64), t0 = (unit % (TT / 64)) * 64;
                for (int idx = tid; idx < 94 * 64; idx += NTHR) {
                    const int r = idx >> 6, p = idx & 63, t = t0 - 15 + r;
                    v4u val = (v4u){0u, 0u, 0u, 0u};
                    if (t >= 0 && t < TT) val = *(const v4u*)(Ub + (size_t)(b * TT + t) * CCH + p * 8);
                    *(LAS v4u*)(ut + r * 512 + p * 8) = val;
                }
                __syncthreads();
                const int c = tid;
                float w[CLEN];
#pragma unroll
                for (int j = 0; j < CLEN; ++j) w[j] = dw_w[j * CCH + c];
                const float bias = dw_b[c];
                float y[64];
#pragma unroll
                for (int tb = 0; tb < 8; ++tb) {
                    float win[38];
#pragma unroll
                    for (int i = 0; i < 38; ++i) win[i] = bf2f(ut[(tb * 8 + i) * 512 + c]);
#pragma unroll
                    for (int o = 0; o < 8; ++o) { float a = bias;
#pragma unroll
                        for (int j = 0; j < CLEN; ++j) a += w[j] * win[o + j];
                        y[tb * 8 + o] = a; }
                }
#pragma unroll 1
                for (int pass = 0; pass < 2; ++pass) {
                    float s1[64];
#pragma unroll
                    for (int i = 0; i < 64; ++i) s1[i] = pass ? y[i] * y[i] : y[i];
#pragma unroll
                    for (int s = 32; s >= 1; s >>= 1) {
                        const bool up = (lane & s) != 0;
#pragma unroll
                        for (int i = 0; i < s; ++i) { const float k1 = up ? s1[i + s] : s1[i], x1 = up ? s1[i] : s1[i + s]; s1[i] = k1 + __shfl_xor(x1, s); }
                    }
                    part[(wave * 64 + lane) * 2 + pass] = s1[0];
                }
                __syncthreads();
                if (tid < 64) { float a = 0.f, q = 0.f;
#pragma unroll
                    for (int wv = 0; wv < 8; ++wv) { a += part[(wv * 64 + tid) * 2]; q += part[(wv * 64 + tid) * 2 + 1]; }
                    const float mean = a * (1.f / CCH), var = q * (1.f / CCH) - mean * mean;
                    stat[tid * 2] = mean; stat[tid * 2 + 1] = rsqrtf(fmaxf(var, 0.f) + EPS); }
                __syncthreads();
                const float lw = conv_ln_w[c], lbias = conv_ln_b[c];
#pragma unroll
                for (int t = 0; t < 64; ++t) {
                    const float v = (y[t] - stat[t * 2]) * stat[t * 2 + 1] * lw + lbias;
                    MIX[(size_t)(b * TT + t0 + t) * D + 512 + c] = (bf16)(pk2(v * sigm(v), 0.f) & 0xffffu);
                }
                __syncthreads();
            }
        }
        {
            LAS float* qs = (LAS float*)(lds + RING_OFF); LAS float* ks = qs + 2048; LAS float* fs = ks + 2048; LAS float* vs = fs + 2048; LAS float* op = vs + 2048;
            const int e = tid & 127, dq = tid >> 7;
            for (int unit = G - 1 - bx; unit < NBATCH * NH * 2; unit += G) {
                const int dir = unit & 1, h = (unit >> 1) & 3, b = unit >> 3;
                const bf16* Kp = dir ? KBb : KFb; const float* Lp = dir ? LBb : LFb; float* Op = dir ? OBb : OFb;
                float S[32];
#pragma unroll
                for (int i = 0; i < 32; ++i) S[i] = 0.f;
                for (int blk = 0; blk < TT / 16; ++blk) {
                    const int tb = dir ? (TT - 16 - blk * 16) : blk * 16;
#pragma unroll
                    for (int i = 0; i < 4; ++i) { const int idx = tid + NTHR * i, r = idx >> 7, d = idx & 127; const size_t off = (size_t)(b * TT + tb + r) * 512 + h * 128 + d;
                        qs[idx] = bf2f(Qb[off]); ks[idx] = bf2f(Kp[off]); fs[idx] = __expf(Lp[off]); vs[idx] = bf2f(Vb[off]); }
                    __syncthreads();
                    for (int st = 0; st < 16; ++st) {
                        const int r = dir ? 15 - st : st; const float v = vs[r * 128 + e]; float o = 0.f;
#pragma unroll
                        for (int dd = 0; dd < 32; ++dd) { const int d = dq * 32 + dd; S[dd] = fs[r * 128 + d] * S[dd] + ks[r * 128 + d] * v; o += qs[r * 128 + d] * S[dd]; }
                        op[(r * 4 + dq) * 128 + e] = o;
                    }
                    __syncthreads();
#pragma unroll
                    for (int i = 0; i < 4; ++i) { const int idx = tid + NTHR * i, r = idx >> 7, ee = idx & 127;
                        Op[(size_t)(b * TT + tb + r) * 512 + h * 128 + ee] = (op[(r * 4 + 0) * 128 + ee] + op[(r * 4 + 1) * 128 + ee]) + (op[(r * 4 + 2) * 128 + ee] + op[(r * 4 + 3) * 128 + ee]); }
                }
                __syncthreads();
            }
        }
    }
    SEAM(2);

    if (IN(3)) {
        for (int m = gw; m < MTOK; m += NGW) {
            const size_t off = (size_t)m * 512 + lane * 8;
            const f32x4 a0 = *(const f32x4*)(OFb + off), a1 = *(const f32x4*)(OFb + off + 4), c0 = *(const f32x4*)(OBb + off), c1 = *(const f32x4*)(OBb + off + 4);
            const f32x4 o0 = a0 + c0, o1 = a1 + c1;
            float ss = (o0.x * o0.x + o0.y * o0.y) + (o0.z * o0.z + o0.w * o0.w) + (o1.x * o1.x + o1.y * o1.y) + (o1.z * o1.z + o1.w * o1.w);
            ss += __shfl_xor(ss, 1); ss += __shfl_xor(ss, 2); ss += __shfl_xor(ss, 4); ss += __shfl_xor(ss, 8);
            const float rstd = rsqrtf(ss * (1.f / DV) + EPS);
            const v4u gv = *(const v4u*)(Gb + off);
            const f32x4 w0 = *(const f32x4*)(hgrn_norm_w + lane * 8), w1v = *(const f32x4*)(hgrn_norm_w + lane * 8 + 4);
            f32x4 r0, r1;
            r0.x = o0.x * rstd * w0.x * bf2f(gv.x & 0xffffu); r0.y = o0.y * rstd * w0.y * bf2f(gv.x >> 16);
            r0.z = o0.z * rstd * w0.z * bf2f(gv.y & 0xffffu); r0.w = o0.w * rstd * w0.w * bf2f(gv.y >> 16);
            r1.x = o1.x * rstd * w1v.x * bf2f(gv.z & 0xffffu); r1.y = o1.y * rstd * w1v.y * bf2f(gv.z >> 16);
            r1.z = o1.z * rstd * w1v.z * bf2f(gv.w & 0xffffu); r1.w = o1.w * rstd * w1v.w * bf2f(gv.w >> 16);
            st8bf(MIX + (size_t)m * D + lane * 8, r0, r1);
        }
    }
    SEAM(3);

    if (IN(4)) {
        pg8::Gemm g{MIX, WO, MTOK, D, D}; pg8::StaticOrder S; S.init(MTOK, D, G, bx);
        EpiRes E{x, H};
        pg8::gemm_phase<EpiRes, pg8::StaticOrder, true, true>(lds + RING_OFF, g, S, E);
    }
    SEAM(4);

    if (IN(5)) {
        LAS float* wl = (LAS float*)(lds + RING_OFF);
        LAS unsigned* sb = (LAS unsigned*)(lds + SB_OFF);
        for (int i = tid; i < NE * D / 4; i += NTHR) ((LAS f32x4*)wl)[i] = ((const f32x4*)WRT)[i];
        if (tid < NE) lcnt[tid] = 0;
        __syncthreads();
        int it = 0;
        for (int m = gw; m < MTOK; m += NGW, ++it) {
            const f32x4* hr = (const f32x4*)(H + (size_t)m * D) + lane; const f32x4* wr = (const f32x4*)norm2_w + lane;
            f32x4 v[4]; float s = 0.f;
#pragma unroll
            for (int j = 0; j < 4; ++j) { v[j] = hr[64 * j]; s += (v[j].x * v[j].x + v[j].y * v[j].y) + (v[j].z * v[j].z + v[j].w * v[j].w); }
            const float rstd = rsqrtf(wave_sum(s) * (1.f / D) + EPS);
            v2u* o8 = (v2u*)(XN + (size_t)m * D) + lane;
#pragma unroll
            for (int j = 0; j < 4; ++j) { const f32x4 g = wr[64 * j]; v[j] = v[j] * rstd * g; v2u o; o.x = pk2(v[j].x, v[j].y); o.y = pk2(v[j].z, v[j].w); o8[64 * j] = o; }
            float a[NE];
#pragma unroll
            for (int e = 0; e < NE; ++e) { float t = 0.f;
#pragma unroll
                for (int j = 0; j < 4; ++j) { const f32x4 wv = ((const LAS f32x4*)wl)[e * 256 + lane + 64 * j]; t += (v[j].x * wv.x + v[j].y * wv.y) + (v[j].z * wv.z + v[j].w * wv.w); }
                a[e] = t; }
#pragma unroll
            for (int s2 = 32, n = 16; n >= 1; s2 >>= 1, n >>= 1) {
                const bool up = (lane & s2) != 0;
#pragma unroll
                for (int i = 0; i < n; ++i) { const float k1 = up ? a[i + n] : a[i], x1 = up ? a[i] : a[i + n]; a[i] = k1 + __shfl_xor(x1, s2); }
            }
            float lg = a[0] + __shfl_xor(a[0], 1);
            const int myE = lane >> 1;
            lg += router_b[myE];
            float tv[TOPK]; int ti[TOPK];
#pragma unroll
            for (int k = 0; k < TOPK; ++k) {
                float mx = lg;
#pragma unroll
                for (int o = 1; o < 64; o <<= 1) mx = fmaxf(mx, __shfl_xor(mx, o));
                int cand = (lg == mx) ? myE : 99;
#pragma unroll
                for (int o = 1; o < 64; o <<= 1) cand = min(cand, __shfl_xor(cand, o));
                tv[k] = mx; ti[k] = cand;
                if (myE == cand) lg = -INFINITY;
            }
            const float e1 = __expf(tv[1] - tv[0]), e2 = __expf(tv[2] - tv[0]), e3 = __expf(tv[3] - tv[0]);
            const float inv = 1.0f / (1.0f + e1 + e2 + e3);
            if (lane < TOPK) {
                const int ek = lane == 0 ? ti[0] : lane == 1 ? ti[1] : lane == 2 ? ti[2] : ti[3];
                const float gk = (lane == 0 ? 1.0f : lane == 1 ? e1 : lane == 2 ? e2 : e3) * inv;
                const int lr = __hip_atomic_fetch_add(&lcnt[ek], 1, __ATOMIC_RELAXED, __HIP_MEMORY_SCOPE_WORKGROUP);
                sb[(wave * 64 + it) * 4 + lane] = ((unsigned)ek << 16) | (unsigned)lr;
                GATE[(size_t)m * TOPK + lane] = gk;
            }
        }
        __syncthreads();
        if (tid < NE) { const int c = lcnt[tid]; gbase[tid] = c ? (int)__hip_atomic_fetch_add(ctl + CW_CNT + 64 * tid, (unsigned)c, RLX_AGENT) : 0; }
        __syncthreads();
        it = 0;
        for (int m = gw; m < MTOK; m += NGW, ++it) {
            if (lane < TOPK) { const unsigned w = sb[(wave * 64 + it) * 4 + lane]; const int ek = (int)(w >> 16), r = gbase[ek] + (int)(w & 0xffffu);
                ROWTOK[ek * MTOK + r] = m; SLOT[(size_t)m * TOPK + lane] = ek * MTOK + r; }
        }
    }
    SEAM(5);

    if (IN(6)) {
        BUILD_BS();
        const int nrows = bs[NE] * 256;
        for (int r = gw; r < nrows; r += NGW) {
            const int mb = r >> 8; int e = 0;
            while (e < NE - 1 && bs[e + 1] <= mb) ++e;
            const int rank = r - bs[e] * 256;
            v4u a = (v4u){0u, 0u, 0u, 0u}, c = a;
            if (rank < cl[e]) { const int tok = ROWTOK[e * MTOK + rank]; const v4u* src = (const v4u*)(XN + (size_t)tok * D); a = src[lane]; c = src[lane + 64]; }
            v4u* dst = (v4u*)(XS + (size_t)r * D); dst[lane] = a; dst[lane + 64] = c;
        }
    }
    SEAM(6);

    if (IN(7)) {
        BUILD_BS();
        pg8::Gemm g{XS, W1T, MOE_ROWS, 2 * FF, D}; MoeOrder S{bs, 8, G, vcu};
        EpiSwiglu E{ACT, b1};
        pg8::gemm_phase<EpiSwiglu, MoeOrder, true, true>(lds + RING_OFF, g, S, E);
    }
    SEAM(7);

    if (IN(8)) {
        BUILD_BS();
        pg8::Gemm g{ACT, W2T, MOE_ROWS, D, FF}; MoeOrder S{bs, 4, G, vcu};
        EpiDown E{YS, b2};
        pg8::gemm_phase<EpiDown, MoeOrder, true, true>(lds + RING_OFF, g, S, E);
    }
    SEAM(8);

    if (IN(9)) {
        BUILD_BS();
        for (int m = gw; m < MTOK; m += NGW) {
            const f32x4* hr = (const f32x4*)(H + (size_t)m * D) + lane; const f32x4* wr = (const f32x4*)final_norm_w + lane;
            f32x4 v[4];
#pragma unroll
            for (int j = 0; j < 4; ++j) v[j] = hr[64 * j];
#pragma unroll
            for (int k = 0; k < TOPK; ++k) {
                const int sl = SLOT[(size_t)m * TOPK + k]; const float gk = GATE[(size_t)m * TOPK + k];
                const int e = sl >> 14, pos = bs[e] * 256 + (sl & (MTOK - 1));
                const v2u* yr = (const v2u*)(YS + (size_t)pos * D) + lane;
#pragma unroll
                for (int j = 0; j < 4; ++j) { const v2u w = yr[64 * j];
                    v[j].x += gk * bf2f(w.x & 0xffffu); v[j].y += gk * bf2f(w.x >> 16); v[j].z += gk * bf2f(w.y & 0xffffu); v[j].w += gk * bf2f(w.y >> 16); }
            }
            float s = 0.f;
#pragma unroll
            for (int j = 0; j < 4; ++j) s += (v[j].x * v[j].x + v[j].y * v[j].y) + (v[j].z * v[j].z + v[j].w * v[j].w);
            const float rstd = rsqrtf(wave_sum(s) * (1.f / D) + EPS);
            f32x4* orow = (f32x4*)(out + (size_t)m * D) + lane;
#pragma unroll
            for (int j = 0; j < 4; ++j) orow[64 * j] = v[j] * rstd * wr[64 * j];
        }
    }
#undef IN
#undef SEAM
#undef BUILD_BS
}

extern "C" void kernel_launch(void* const* d_in, const int* in_sizes, int n_in, void* d_out, int out_size, void* d_ws, size_t ws_size, hipStream_t stream) {
    static int grid = 0;
    if (grid == 0) {
        if (n_in != 18 || in_sizes[0] != MTOK * D || out_size != MTOK * D || ws_size < WS_END) { fprintf(stderr, "kernel_launch: unexpected shapes (n_in %d, in0 %d, out %d, ws %zu < %zu); nothing launched\n", n_in, n_in > 0 ? in_sizes[0] : -1, out_size, ws_size, (size_t)WS_END); grid = -1; return; }
        int dev = 0, cus = 0, per_cu = 0;
        if (hipGetDevice(&dev) != hipSuccess || hipDeviceGetAttribute(&cus, hipDeviceAttributeMultiprocessorCount, dev) != hipSuccess) { fprintf(stderr, "kernel_launch: device query failed\n"); grid = -1; return; }
        if (hipFuncSetAttribute((const void*)fwd_kernel, hipFuncAttributeMaxDynamicSharedMemorySize, LDS_BYTES) != hipSuccess) { fprintf(stderr, "kernel_launch: hipFuncSetAttribute failed\n"); grid = -1; return; }
        if (hipOccupancyMaxActiveBlocksPerMultiprocessor(&per_cu, (const void*)fwd_kernel, NTHR, LDS_BYTES) != hipSuccess || per_cu < 1)
            fprintf(stderr, "kernel_launch: note: occupancy query reports %d workgroups per CU\n", per_cu);
        (void)hipGetLastError();
        grid = cus;
    }
    if (grid < 0) return;
    if (hipMemsetAsync((char*)d_ws + WS_CTL, 0, CTL_ZERO_BYTES, stream) != hipSuccess) { fprintf(stderr, "kernel_launch: memset failed\n"); return; }
    Args a{};
    for (int i = 0; i < 18; ++i) a.in[i] = (const float*)d_in[i];
    a.out = (float*)d_out; a.ws = (unsigned char*)d_ws;
#if MK_N_LAUNCHES == 1
    a.ph_lo = 0; a.ph_hi = N_PHASES;
    hipLaunchKernelGGL(fwd_kernel, dim3(grid), dim3(NTHR), LDS_BYTES, stream, a);
#else
    for (int ph = 0; ph < N_PHASES; ++ph) { a.ph_lo = ph; a.ph_hi = ph + 1; hipLaunchKernelGGL(fwd_kernel, dim3(grid), dim3(NTHR), LDS_BYTES, stream, a); }
#endif
    const hipError_t le = hipPeekAtLastError();
    if (le != hipSuccess) fprintf(stderr, "kernel_launch: launch failed: %s\n", hipGetErrorName(le));
}
```

```cpp
#include <hip/hip_runtime.h>
#include <cstdio>
#include <cstdint>
namespace pg8 {
#define PG8_LAS __attribute__((address_space(3)))
typedef unsigned short bf16_t;
typedef short bf16x8 __attribute__((ext_vector_type(8)));
typedef float f32x4 __attribute__((ext_vector_type(4)));
typedef unsigned u32x4 __attribute__((ext_vector_type(4)));
constexpr int BM = 256, BK = 64, HALF = 128, HTB = HALF * BK * 2  , STAGE_BYTES = 8 * HTB, NXCD = 8, WGM = 8;

__host__ __device__ __forceinline__ int lds_byte(int r, int c) { const int st = (r >> 4) * 2 + (c >> 5), rr = r & 15, cc = c & 31, ob = rr * 64 + cc * 2; return st * 1024 + (ob ^ (((ob >> 9) & 1) << 5)); }
__host__ __device__ __forceinline__ void stage_rc(int b, int& R, int& C) { const int st = b / 1024, sb = b % 1024, swz = sb ^ (((sb >> 9) & 1) << 5); R = (st >> 1) * 16 + swz / 64; C = (st & 1) * 32 + (swz % 64) / 2; }
__host__ __device__ __forceinline__ int perm32(int rho) { const int n = rho >> 4, i = rho & 15; return 8 * (i >> 2) + 4 * n + (i & 3); }

struct Unit { int pm, pn; };
struct Gemm { const bf16_t* A; const bf16_t* Bt; int M, N, K; };

struct StaticOrder {
    int nM, nN, nwg, G, c;
    __host__ __device__ void init(int M, int N, int G_, int c_) { nM = M / BM; nN = N / BM; nwg = nM * nN; G = G_; c = c_; }
    __host__ __device__ bool next(int i, Unit& u) const {
        const long L = (long)i * G + c; if (L >= nwg) return false;
        int wgid = (int)L; { const int q = nwg / NXCD, r = nwg % NXCD, xcd = wgid % NXCD, off = wgid / NXCD; wgid = (xcd < r ? xcd * (q + 1) : r * (q + 1) + (xcd - r) * q) + off; }
        const int nig = WGM * nN, gid = wgid / nig, fm = gid * WGM, gsz = (nM - fm) < WGM ? (nM - fm) : WGM;
        u.pm = fm + ((wgid % nig) % gsz); u.pn = (wgid % nig) / gsz; return true;
    }
    __device__ __forceinline__ void a_ready(const Unit&) const {}
    __device__ __forceinline__ void done(const Unit&) const {}
};
__device__ __forceinline__ unsigned cvt_pk_bf16(float lo, float hi) { unsigned r; asm volatile("v_cvt_pk_bf16_f32 %0, %1, %2" : "=v"(r) : "v"(lo), "v"(hi)); return r; }
typedef float f32x2 __attribute__((ext_vector_type(2)));
template <class Epi, class Sched, bool ALIGN_EPI = false, bool SP2 = false>
__device__ __forceinline__ void gemm_phase(PG8_LAS unsigned char* lds, const Gemm g, const Sched& S, const Epi& E) {
    const int tid = threadIdx.x, wid = __builtin_amdgcn_readfirstlane(tid >> 6), lane = tid & 63, wr = wid >> 2, wc = wid & 3, fr = lane & 15, fq = lane >> 4;
    const int K = g.K, nt = K / BK;
    unsigned voffA[2], voffB[2];
#pragma unroll
    for (int i = 0; i < 2; ++i) { int R, C; stage_rc(tid * 16 + i * 8192, R, C); const int Rb = Epi::PERM ? ((R & ~31) + perm32(R & 31)) : R;
        voffA[i] = (unsigned)(R * K + C) * 2u; voffB[i] = (unsigned)(Rb * K + C) * 2u; }
    const size_t kstep = (size_t)(BK * 2);
    const size_t hstep = (size_t)HALF * K * 2;
    const size_t tstep = 2 * hstep;
    const unsigned ldsw = (unsigned)wid * 1024u;
    const int aoff = lds_byte(wr * 64 + fr, fq * 8), boff = lds_byte(wc * 32 + fr, fq * 8);
#define PG8_SA(b, h) (((b) * 2 + (h)) * HTB)
#define PG8_SB(b, h) ((4 + (b) * 2 + (h)) * HTB)
#define PG8_STAGE(bufoff, gbase, voff) do { _Pragma("unroll") for (int _i = 0; _i < 2; ++_i) \
        __builtin_amdgcn_global_load_lds((const unsigned*)((const char*)(gbase) + (voff)[_i]), (PG8_LAS unsigned*)(lds + (bufoff) + ldsw + _i * 8192), 16, 0, 0); } while (0)
#define PG8_LDA(dst, b, h) do { _Pragma("unroll") for (int m = 0; m < 4; ++m) _Pragma("unroll") for (int k = 0; k < 2; ++k) dst[m][k] = *(const PG8_LAS bf16x8*)(lds + PG8_SA(b, h) + aoff + m * 2048 + k * 1024); } while (0)
#define PG8_LDB(dst, b, h) do { _Pragma("unroll") for (int n = 0; n < 2; ++n) _Pragma("unroll") for (int k = 0; k < 2; ++k) dst[n][k] = *(const PG8_LAS bf16x8*)(lds + PG8_SB(b, h) + boff + n * 2048 + k * 1024); } while (0)
#define PG8_MMA(ai, bj, At, Bt) do { __builtin_amdgcn_s_setprio(1); _Pragma("unroll") for (int m = 0; m < 4; ++m) _Pragma("unroll") for (int n = 0; n < 2; ++n) _Pragma("unroll") for (int k = 0; k < 2; ++k) \
        acc[ai][bj][m][n] = __builtin_amdgcn_mfma_f32_16x16x32_bf16(Bt[n][k], At[m][k], acc[ai][bj][m][n], 0, 0, 0); __builtin_amdgcn_s_setprio(0); } while (0)
#define PG8_WAIT_V(n) asm volatile("s_waitcnt vmcnt(" #n ")" ::: "memory")
#define PG8_WAIT_L(n) asm volatile("s_waitcnt lgkmcnt(" #n ")" ::: "memory")
#define PG8_BAR __builtin_amdgcn_s_barrier()
#define PG8_SCHED __builtin_amdgcn_sched_barrier(0)
    Unit cur, nxt; int ui = 0;
    if (!S.next(0, cur)) return;
    f32x4 acc[2][2][4][2];
#pragma unroll
    for (int a = 0; a < 2; ++a)
#pragma unroll
        for (int b = 0; b < 2; ++b)
#pragma unroll
            for (int m = 0; m < 4; ++m)
#pragma unroll
                for (int n = 0; n < 2; ++n) acc[a][b][m][n] = (f32x4){0.f, 0.f, 0.f, 0.f};
    bf16x8 At[4][2], B0[2][2], B1[2][2];
    const char* cA = (const char*)g.A + (size_t)cur.pm * tstep; const char* cB = (const char*)g.Bt + (size_t)cur.pn * tstep;
    S.a_ready(cur);
    if constexpr (SP2) {
        PG8_STAGE(PG8_SB(0, 0), cB, voffB); PG8_STAGE(PG8_SB(0, 1), cB + hstep, voffB); PG8_STAGE(PG8_SA(0, 0), cA, voffA); PG8_STAGE(PG8_SA(0, 1), cA + hstep, voffA);
        if (wr == 1) PG8_BAR;
        PG8_WAIT_V(2); PG8_BAR;
        PG8_STAGE(PG8_SB(1, 0), cB + kstep, voffB); PG8_STAGE(PG8_SA(1, 0), cA + kstep, voffA); PG8_STAGE(PG8_SB(1, 1), cB + hstep + kstep, voffB);
        PG8_WAIT_V(6); PG8_BAR;
    } else {
        PG8_STAGE(PG8_SB(0, 0), cB, voffB); PG8_STAGE(PG8_SA(0, 0), cA, voffA); PG8_STAGE(PG8_SB(0, 1), cB + hstep, voffB); PG8_STAGE(PG8_SA(0, 1), cA + hstep, voffA);
        if (wr == 1) PG8_BAR;
        PG8_WAIT_V(4); PG8_BAR;
        PG8_STAGE(PG8_SB(1, 0), cB + kstep, voffB); PG8_STAGE(PG8_SA(1, 0), cA + kstep, voffA); PG8_STAGE(PG8_SB(1, 1), cB + hstep + kstep, voffB);
        PG8_WAIT_V(6); PG8_BAR;
    }
    for (;;) {
        const bool has_next = S.next(ui + 1, nxt);
        const char* nA = has_next ? (const char*)g.A + (size_t)nxt.pm * tstep : cA; const char* nB = has_next ? (const char*)g.Bt + (size_t)nxt.pn * tstep : cB;
        for (int t = 0; t < nt; t += 2) {
            const bool last = (t == nt - 2);
            const char* a1 = cA + (size_t)(t + 1) * kstep;
            const char* a2 = last ? nA : cA + (size_t)(t + 2) * kstep; const char* b2 = last ? nB : cB + (size_t)(t + 2) * kstep;
            const char* a3 = a2 + kstep; const char* b3 = b2 + kstep;
            if (last && has_next) S.a_ready(nxt);
            if constexpr (SP2) {
            PG8_LDB(B0, 0, 0); PG8_LDB(B1, 0, 1); PG8_SCHED; PG8_LDA(At, 0, 0); PG8_STAGE(PG8_SA(1, 1), a1 + hstep, voffA);
            PG8_WAIT_V(8); PG8_WAIT_L(0); PG8_BAR; PG8_MMA(0, 0, At, B0); PG8_MMA(0, 1, At, B1); PG8_BAR; PG8_SCHED;
            PG8_LDA(At, 0, 1); PG8_STAGE(PG8_SB(0, 0), b2, voffB); PG8_STAGE(PG8_SB(0, 1), b2 + hstep, voffB); PG8_STAGE(PG8_SA(0, 0), a2, voffA);
            PG8_WAIT_V(8); PG8_WAIT_L(0); PG8_BAR; PG8_MMA(1, 0, At, B0); PG8_MMA(1, 1, At, B1); PG8_BAR; PG8_SCHED;
            PG8_LDB(B0, 1, 0); PG8_LDB(B1, 1, 1); PG8_SCHED; PG8_LDA(At, 1, 0); PG8_STAGE(PG8_SA(0, 1), a2 + hstep, voffA);
            PG8_WAIT_V(8); PG8_WAIT_L(0); PG8_BAR; PG8_MMA(0, 0, At, B0); PG8_MMA(0, 1, At, B1); PG8_BAR; PG8_SCHED;
            PG8_LDA(At, 1, 1); PG8_STAGE(PG8_SB(1, 0), b3, voffB); PG8_STAGE(PG8_SB(1, 1), b3 + hstep, voffB); PG8_STAGE(PG8_SA(1, 0), a3, voffA);
            PG8_WAIT_V(8); PG8_WAIT_L(0); PG8_BAR; PG8_MMA(1, 0, At, B0); PG8_MMA(1, 1, At, B1); PG8_BAR; PG8_SCHED;
            } else {
            PG8_LDB(B0, 0, 0); PG8_SCHED; PG8_LDA(At, 0, 0); PG8_STAGE(PG8_SA(1, 1), a1 + hstep, voffA);
            PG8_WAIT_L(8); PG8_BAR; PG8_WAIT_L(0); PG8_MMA(0, 0, At, B0); PG8_BAR; PG8_SCHED;
            PG8_LDB(B1, 0, 1); PG8_STAGE(PG8_SB(0, 0), b2, voffB);
            PG8_BAR; PG8_WAIT_L(0); PG8_MMA(0, 1, At, B1); PG8_BAR;
            PG8_LDA(At, 0, 1); PG8_STAGE(PG8_SA(0, 0), a2, voffA);
            PG8_BAR; PG8_WAIT_L(0); PG8_MMA(1, 0, At, B0); PG8_BAR; PG8_SCHED;
            PG8_STAGE(PG8_SB(0, 1), b2 + hstep, voffB);
            PG8_WAIT_V(6); PG8_BAR; PG8_MMA(1, 1, At, B1); PG8_BAR;
            PG8_LDB(B0, 1, 0); PG8_SCHED; PG8_LDA(At, 1, 0); PG8_STAGE(PG8_SA(0, 1), a2 + hstep, voffA);
            PG8_WAIT_L(8); PG8_BAR; PG8_WAIT_L(0); PG8_MMA(0, 0, At, B0); PG8_BAR; PG8_SCHED;
            PG8_LDB(B1, 1, 1); PG8_STAGE(PG8_SB(1, 0), b3, voffB);
            PG8_BAR; PG8_WAIT_L(0); PG8_MMA(0, 1, At, B1); PG8_BAR;
            PG8_LDA(At, 1, 1); PG8_STAGE(PG8_SA(1, 0), a3, voffA);
            PG8_BAR; PG8_WAIT_L(0); PG8_MMA(1, 0, At, B0); PG8_BAR; PG8_SCHED;
            PG8_STAGE(PG8_SB(1, 1), b3 + hstep, voffB);
            PG8_WAIT_V(6); PG8_BAR; PG8_MMA(1, 1, At, B1); PG8_BAR;
            }
        }
        if constexpr (ALIGN_EPI) { if (wr == 0) PG8_BAR; }
        if constexpr (!Epi::AFTER_DRAIN) { E(acc, cur, wr, wc, fr, fq); S.done(cur); }
        if (!has_next) break;
#pragma unroll
        for (int a = 0; a < 2; ++a)
#pragma unroll
            for (int b = 0; b < 2; ++b)
#pragma unroll
                for (int m = 0; m < 4; ++m)
#pragma unroll
                    for (int n = 0; n < 2; ++n) acc[a][b][m][n] = (f32x4){0.f, 0.f, 0.f, 0.f};
        cur = nxt; cA = nA; cB = nB; ++ui;
        if constexpr (ALIGN_EPI) { if (wr == 1) PG8_BAR; }
    }
    PG8_WAIT_V(0);
    if constexpr (!ALIGN_EPI) { if (wr == 0) PG8_BAR; }
    PG8_BAR;
    if constexpr (Epi::AFTER_DRAIN) { E.fused(acc, cur, wr, wc, fr, fq, lds, wid, lane); S.done(cur); }
#undef PG8_SA
#undef PG8_SB
#undef PG8_STAGE
#undef PG8_LDA
#undef PG8_LDB
#undef PG8_MMA
#undef PG8_WAIT_V
#undef PG8_WAIT_L
#undef PG8_BAR
#undef PG8_SCHED
}
}

#ifndef MK_N_LAUNCHES
#define MK_N_LAUNCHES 1
#endif
constexpr int N_PHASES = 10;
constexpr int NBATCH = 8, TT = 2048, MTOK = NBATCH * TT, D = 1024;
constexpr int HK = 512, NH = 4, DK = 128, DV = 128, CCH = 512, CLEN = 31, INC = 3584;
constexpr int NE = 32, TOPK = 4, FF = 1024;
constexpr float EPS = 1e-5f, SW_LIMIT = 7.0f, SW_ALPHA = 1.702f;
constexpr int NWAVES = 8, NTHR = 512;
constexpr int MOE_ROWS = (MTOK * TOPK / 256 + NE) * 256;

constexpr size_t MiB = 1u << 20;
constexpr size_t WS_CTL = 0, CTL_ZERO_BYTES = 1 * MiB;
constexpr size_t WS_WI = 1 * MiB;
constexpr size_t WS_WO = 8 * MiB;
constexpr size_t WS_TAB = 10 * MiB;
constexpr size_t WS_W1 = 16 * MiB;
constexpr size_t WS_W2 = 144 * MiB;
constexpr size_t WS_H = 208 * MiB;
constexpr size_t WS_XN = 272 * MiB;
constexpr size_t WS_Q = 304 * MiB, WS_KF = 320 * MiB, WS_KB = 336 * MiB, WS_V = 352 * MiB, WS_G = 368 * MiB, WS_U = 384 * MiB;
constexpr size_t WS_LF = 400 * MiB, WS_LB = 432 * MiB;
constexpr size_t WS_OF = 464 * MiB, WS_OB = 496 * MiB;
constexpr size_t WS_MIX = 528 * MiB;
constexpr size_t WS_XS = 304 * MiB;
constexpr size_t WS_ACT = 448 * MiB;
constexpr size_t WS_YS = 592 * MiB;
constexpr size_t WS_END = 736 * MiB;
constexpr size_t WS_WRT = WS_TAB;
constexpr size_t WS_SLOT = WS_TAB + 256 * 1024;
constexpr size_t WS_GATE = WS_TAB + 512 * 1024;
constexpr size_t WS_ROWTOK = WS_TAB + 1 * MiB;
constexpr int CW_BAR = 4096;
constexpr int CW_CNT = 16384;

constexpr int RING_OFF = 0, RING_BYTES = 131072;
constexpr int LDSCTL_OFF = RING_BYTES;
constexpr int MISC_OFF = LDSCTL_OFF + 320;
constexpr int TAB_OFF = LDSCTL_OFF + 1024;
constexpr int SB_OFF = LDSCTL_OFF + 2048;
constexpr int LDS_BYTES = 147456;

#define GAS __attribute__((address_space(1)))
#define LAS __attribute__((address_space(3)))
typedef unsigned short bf16;
typedef unsigned v4u __attribute__((ext_vector_type(4)));
typedef unsigned v2u __attribute__((ext_vector_type(2)));
typedef float f32x4 __attribute__((ext_vector_type(4)));
typedef GAS unsigned gu32;
#define RLX_AGENT __ATOMIC_RELAXED, __HIP_MEMORY_SCOPE_AGENT
#define LDS_WAIT() asm volatile("s_waitcnt lgkmcnt(0)" ::: "memory")
#define VM_WAIT() asm volatile("s_waitcnt vmcnt(0)" ::: "memory")

__device__ __forceinline__ float bf2f(unsigned b) { return __uint_as_float(b << 16); }
__device__ __forceinline__ unsigned pk2(float lo, float hi) { return pg8::cvt_pk_bf16(lo, hi); }
__device__ __forceinline__ float sigm(float x) { return __builtin_amdgcn_rcpf(1.0f + __expf(-x)); }
__device__ __forceinline__ float wave_sum(float v) {
#pragma unroll
    for (int o = 1; o < 64; o <<= 1) v += __shfl_xor(v, o);
    return v;
}

#define XB_TMO      128
#define XB_XCNT(j)  (256  + 64 * (j))
#define XB_XSUB(j)  (1280 + 64 * (j))
#define XB_XGEN(j)  (2304 + 64 * (j))
#define XB_TOP      3328
#define XB_TOPGEN   3392
#define XCD_BAR_WORDS 3456
#define XB_SPIN_CAP (1u << 18)

__device__ __forceinline__ unsigned xb_ld(unsigned* p)              { return __hip_atomic_load(p, __ATOMIC_RELAXED, __HIP_MEMORY_SCOPE_AGENT); }
__device__ __forceinline__ unsigned xb_add(unsigned* p, unsigned v) { return __hip_atomic_fetch_add(p, v, __ATOMIC_RELAXED, __HIP_MEMORY_SCOPE_AGENT); }
__device__ __forceinline__ unsigned xb_xcc_id() { return (unsigned)__builtin_amdgcn_s_getreg((3 << 11) | 20) & 0xFu; }
#define XB_SPIN(cond, bar) do { unsigned _sp = 0; while (cond) { __builtin_amdgcn_s_sleep(1); \
    if ((++_sp & 255u) == 0u) { if (xb_ld(&(bar)[XB_TMO])) break; if (_sp > XB_SPIN_CAP) { atomicAdd(&(bar)[XB_TMO], 1u); break; } } } } while (0)

struct XcdBarrier {
    unsigned* bar; unsigned x;
    volatile LAS unsigned* st;
};
__device__ __forceinline__ XcdBarrier xcd_barrier_post(unsigned* bar, volatile LAS unsigned* st) {
    XcdBarrier b; b.bar = bar; b.x = xb_xcc_id(); b.st = st;
    if (threadIdx.x == 0) (void)xb_add(&bar[XB_XCNT(b.x)], 1u);
    return b;
}
__device__ __forceinline__ void xcd_barrier_complete(unsigned* bar, unsigned x, unsigned& nloc, unsigned& nx) {
    const unsigned G = gridDim.x * gridDim.y * gridDim.z;
    unsigned sum, cnt, mine, sp = 0u;
    for (;;) {
        sum = 0u; cnt = 0u; mine = 0u;
#pragma unroll
        for (unsigned j = 0; j < 16; ++j) { const unsigned c = xb_ld(&bar[XB_XCNT(j)]); sum += c; cnt += (c > 0u) ? 1u : 0u; mine = (j == x) ? c : mine; }
        if (sum == G) break;
        __builtin_amdgcn_s_sleep(1);
        if ((++sp & 255u) == 0u) { if (xb_ld(&bar[XB_TMO])) break; if (sp > XB_SPIN_CAP) { atomicAdd(&bar[XB_TMO], 1u); break; } }
    }
    nloc = mine > 0u ? mine : 1u; nx = cnt > 0u ? cnt : 1u;
}
__device__ __forceinline__ void xcd_barrier(const XcdBarrier& b) {
    asm volatile("s_waitcnt vmcnt(0)" ::: "memory");
    __syncthreads();
    if (threadIdx.x == 0) {
        unsigned* bar = b.bar;
        __builtin_amdgcn_s_waitcnt(0);
        unsigned nloc = b.st[0], nx = b.st[1];
        if (nloc == 0u) { xcd_barrier_complete(bar, b.x, nloc, nx); b.st[0] = nloc; b.st[1] = nx; }
        const unsigned old = xb_add(&bar[XB_XSUB(b.x)], 1u);
        const unsigned gen = old / nloc;
        if (old + 1u == (gen + 1u) * nloc) {
            __builtin_amdgcn_fence(__ATOMIC_RELEASE, "agent");
            asm volatile("s_waitcnt vmcnt(0)" ::: "memory");
            const unsigned og = xb_add(&bar[XB_TOP], 1u);
            const unsigned tg = og / nx;
            if (og + 1u == (tg + 1u) * nx) xb_add(&bar[XB_TOPGEN], 1u);
            else XB_SPIN(xb_ld(&bar[XB_TOPGEN]) == tg, bar);
            __builtin_amdgcn_fence(__ATOMIC_ACQUIRE, "agent");
            xb_add(&bar[XB_XGEN(b.x)], 1u);
            asm volatile("s_waitcnt vmcnt(0)" ::: "memory");
        } else {
            XB_SPIN(xb_ld(&bar[XB_XGEN(b.x)]) == gen, bar);
            __builtin_amdgcn_fence(__ATOMIC_ACQUIRE, "agent");
            asm volatile("s_waitcnt vmcnt(0)" ::: "memory");
        }
    }
    __syncthreads();
}

__device__ __forceinline__ void st8bf(bf16* p, const f32x4& a, const f32x4& b) {
    v4u w; w.x = pk2(a[0], a[1]); w.y = pk2(a[2], a[3]); w.z = pk2(b[0], b[1]); w.w = pk2(b[2], b[3]);
    *(v4u*)p = w;
}
struct EpiProj {
    static constexpr bool PERM = true, AFTER_DRAIN = false;
    bf16 *Q, *KF, *KB, *V, *G, *U; float *LF, *LB; const float* lbl;
    template <int TYP>
    __device__ __forceinline__ void tile(const pg8::f32x4 (&acc)[2][2][4][2], int row0, int cb) const {
#pragma unroll
        for (int bj = 0; bj < 2; ++bj) {
            const int col = cb + bj * 128;
            float lb[8];
            if (TYP == 1 || TYP == 2) {
                const float* L = lbl + (TYP - 1) * 1024 + col;
#pragma unroll
                for (int i = 0; i < 8; ++i) lb[i] = __builtin_amdgcn_rcpf(1.0f + __expf(L[512 + i] - L[i]));
            }
#pragma unroll
            for (int ai = 0; ai < 2; ++ai)
#pragma unroll
                for (int m = 0; m < 4; ++m) {
                    const size_t off = (size_t)(row0 + ai * 128 + m * 16) * 512 + col;
                    f32x4 a = acc[ai][bj][m][0], b = acc[ai][bj][m][1];
                    if (TYP == 0 || TYP == 4) {
#pragma unroll
                        for (int i = 0; i < 4; ++i) { a[i] = a[i] * sigm(a[i]); b[i] = b[i] * sigm(b[i]); }
                        st8bf((TYP == 0 ? Q : G) + off, a, b);
                    } else if (TYP == 3) {
                        st8bf(V + off, a, b);
                    } else {
                        f32x4 la, lbv, ka, kb;
#pragma unroll
                        for (int i = 0; i < 4; ++i) {
                            const float fa = lb[i] + (1.0f - lb[i]) * sigm(a[i]), fb = lb[4 + i] + (1.0f - lb[4 + i]) * sigm(b[i]);
                            la[i] = __logf(fa); lbv[i] = __logf(fb); ka[i] = 1.0f - fa; kb[i] = 1.0f - fb;
                        }
                        float* Lp = (TYP == 1 ? LF : LB) + off;
                        *(f32x4*)Lp = la; *(f32x4*)(Lp + 4) = lbv;
                        st8bf((TYP == 1 ? KF : KB) + off, ka, kb);
                    }
                }
        }
    }
    __device__ __forceinline__ void operator()(const pg8::f32x4 (&acc)[2][2][4][2], const pg8::Unit& u, int wr, int wc, int fr, int fq) const {
        const int row0 = u.pm * 256 + wr * 64 + fr, pn = u.pn;
        if (pn >= 10) {
            const int col = (pn - 10) * 128 + wc * 32 + 8 * fq;
#pragma unroll
            for (int ai = 0; ai < 2; ++ai)
#pragma unroll
                for (int m = 0; m < 4; ++m) {
                    f32x4 a = acc[ai][0][m][0], b = acc[ai][0][m][1]; const f32x4 ga = acc[ai][1][m][0], gb = acc[ai][1][m][1];
#pragma unroll
                    for (int i = 0; i < 4; ++i) { a[i] = a[i] * sigm(ga[i]); b[i] = b[i] * sigm(gb[i]); }
                    st8bf(U + (size_t)(row0 + ai * 128 + m * 16) * 512 + col, a, b);
                }
        } else {
            const int cb = (pn & 1) * 256 + wc * 32 + 8 * fq, typ = pn >> 1;
            if (typ == 0) tile<0>(acc, row0, cb);
            else if (typ == 1) tile<1>(acc, row0, cb);
            else if (typ == 2) tile<2>(acc, row0, cb);
            else if (typ == 3) tile<3>(acc, row0, cb);
            else tile<4>(acc, row0, cb);
        }
    }
};
struct EpiRes {
    static constexpr bool PERM = false, AFTER_DRAIN = false;
    const float* X; float* H;
    __device__ __forceinline__ void operator()(const pg8::f32x4 (&acc)[2][2][4][2], const pg8::Unit& u, int wr, int wc, int fr, int fq) const {
        const int row0 = u.pm * 256 + wr * 64 + fr, col0 = u.pn * 256 + wc * 32 + 4 * fq;
#pragma unroll
        for (int ai = 0; ai < 2; ++ai)
#pragma unroll
            for (int m = 0; m < 4; ++m) {
                const size_t off = (size_t)(row0 + ai * 128 + m * 16) * D + col0;
#pragma unroll
                for (int bj = 0; bj < 2; ++bj)
#pragma unroll
                    for (int n = 0; n < 2; ++n) { const f32x4 xv = *(const f32x4*)(X + off + bj * 128 + n * 16); *(f32x4*)(H + off + bj * 128 + n * 16) = xv + acc[ai][bj][m][n]; }
            }
    }
};
struct EpiSwiglu {
    static constexpr bool PERM = true, AFTER_DRAIN = false;
    bf16* ACT; const float* b1;
    __device__ __forceinline__ void operator()(const pg8::f32x4 (&acc)[2][2][4][2], const pg8::Unit& u, int wr, int wc, int fr, int fq) const {
        const int e = u.pn >> 3, pn = u.pn & 7, row0 = u.pm * 256 + wr * 64 + fr, col = pn * 128 + wc * 32 + 8 * fq;
        const float* bg = b1 + (size_t)e * 2048 + col; const float* bl = bg + 1024;
        float g[8], l[8];
#pragma unroll
        for (int i = 0; i < 8; ++i) { g[i] = bg[i]; l[i] = bl[i]; }
#pragma unroll
        for (int ai = 0; ai < 2; ++ai)
#pragma unroll
            for (int m = 0; m < 4; ++m) {
                f32x4 o[2];
#pragma unroll
                for (int n = 0; n < 2; ++n)
#pragma unroll
                    for (int i = 0; i < 4; ++i) {
                        const float hg = fminf(acc[ai][0][m][n][i] + g[4 * n + i], SW_LIMIT);
                        const float hl = fminf(fmaxf(acc[ai][1][m][n][i] + l[4 * n + i], -SW_LIMIT), SW_LIMIT);
                        o[n][i] = hg * sigm(SW_ALPHA * hg) * (hl + 1.0f);
                    }
                st8bf(ACT + (size_t)(row0 + ai * 128 + m * 16) * FF + col, o[0], o[1]);
            }
    }
};
struct EpiDown {
    static constexpr bool PERM = true, AFTER_DRAIN = false;
    bf16* YS; const float* b2;
    __device__ __forceinline__ void operator()(const pg8::f32x4 (&acc)[2][2][4][2], const pg8::Unit& u, int wr, int wc, int fr, int fq) const {
        const int e = u.pn >> 2, pn = u.pn & 3, row0 = u.pm * 256 + wr * 64 + fr, col0 = pn * 256 + wc * 32 + 8 * fq;
#pragma unroll
        for (int bj = 0; bj < 2; ++bj) {
            const float* bp = b2 + (size_t)e * D + col0 + bj * 128;
            const f32x4 b0 = *(const f32x4*)bp, b1v = *(const f32x4*)(bp + 4);
#pragma unroll
            for (int ai = 0; ai < 2; ++ai)
#pragma unroll
                for (int m = 0; m < 4; ++m)
                    st8bf(YS + (size_t)(row0 + ai * 128 + m * 16) * D + col0 + bj * 128, acc[ai][bj][m][0] + b0, acc[ai][bj][m][1] + b1v);
        }
    }
};
struct MoeOrder {
    const volatile LAS int* bs; int ntn, G, v;
    __device__ __forceinline__ bool next(int i, pg8::Unit& u) const {
        const int L = i * G + v, nb = bs[32];
        if (L >= nb * ntn) return false;
        const int mb = L / ntn, pn = L - mb * ntn;
        int e = 0;
        while (e < NE - 1 && bs[e + 1] <= mb) ++e;
        u.pm = mb; u.pn = e * ntn + pn; return true;
    }
    __device__ __forceinline__ void a_ready(const pg8::Unit&) const {}
    __device__ __forceinline__ void done(const pg8::Unit&) const {}
};

struct RmIdent { __device__ __forceinline__ int operator()(int n) const { return n; } };
struct RmWin {
    __device__ __forceinline__ int operator()(int n) const {
        if (n < 2560) return n;
        if (n < 3072) { const int j = n - 2560; return 2560 + (j >> 7) * 256 + (j & 127); }
        const int j = n - 3072; return 2560 + (j >> 7) * 256 + 128 + (j & 127);
    }
};
struct RmW1 {
    __device__ __forceinline__ int operator()(int n) const {
        if (n < 1024) return (n >> 7) * 256 + (n & 127);
        const int j = n - 1024; return (j >> 7) * 256 + 128 + (j & 127);
    }
};
template <class RM>
__device__ __forceinline__ void p0_transpose_item(const float* W, int K, int N, bf16* WT, RM rm, LAS float* scr, int item, int lane) {
    const int nblk = N / 32, kb = item / nblk, nb = item % nblk, k0 = 64 * kb, n0 = 32 * nb;
#pragma unroll 8
    for (int i = 0; i < 32; ++i) { const int kk = 2 * i + (lane >> 5); scr[kk * 33 + (lane & 31)] = W[(size_t)(k0 + kk) * N + n0 + (lane & 31)]; }
    LDS_WAIT(); asm volatile("" ::: "memory");
    const int c = lane & 7;
#pragma unroll
    for (int j = 0; j < 4; ++j) { const int n = (lane >> 3) + 8 * j; const LAS float* s = scr + (8 * c) * 33 + n;
        v4u o; o.x = pk2(s[0 * 33], s[1 * 33]); o.y = pk2(s[2 * 33], s[3 * 33]); o.z = pk2(s[4 * 33], s[5 * 33]); o.w = pk2(s[6 * 33], s[7 * 33]);
        *(GAS v4u*)(WT + (size_t)rm(n0 + n) * K + k0 + 8 * c) = o; }
    LDS_WAIT(); asm volatile("" ::: "memory");
}
__device__ __forceinline__ void rms_row_to_bf16(const float* xrow, const float* w, bf16* orow, int lane) {
    const f32x4* xr = (const f32x4*)xrow + lane; const f32x4* wr = (const f32x4*)w + lane;
    f32x4 v[4]; float s = 0.f;
#pragma unroll
    for (int j = 0; j < 4; ++j) { v[j] = xr[64 * j]; s += (v[j].x * v[j].x + v[j].y * v[j].y) + (v[j].z * v[j].z + v[j].w * v[j].w); }
    const float rstd = rsqrtf(wave_sum(s) * (1.f / D) + EPS);
    v2u* o8 = (v2u*)orow + lane;
#pragma unroll
    for (int j = 0; j < 4; ++j) { const f32x4 g = wr[64 * j]; v2u o; o.x = pk2(v[j].x * rstd * g.x, v[j].y * rstd * g.y); o.y = pk2(v[j].z * rstd * g.z, v[j].w * rstd * g.w); o8[64 * j] = o; }
}

struct Args { const float* in[18]; float* out; unsigned char* ws; int ph_lo, ph_hi; };
__global__ void __launch_bounds__(NTHR, 2) fwd_kernel(Args args) {
    extern __shared__ __attribute__((aligned(16))) unsigned char lds_raw[];
    LAS unsigned char* lds = (LAS unsigned char*)lds_raw;
    volatile LAS unsigned* MISC = (volatile LAS unsigned*)(lds + MISC_OFF);
    const int tid = threadIdx.x, lane = tid & 63, wave = __builtin_amdgcn_readfirstlane(tid >> 6);
    const int G = gridDim.x; const int bx = blockIdx.x; const int vcu = (G % 8 == 0) ? (bx % 8) * (G / 8) + bx / 8 : bx;
    const int gw = vcu * NWAVES + wave, NGW = G * NWAVES;
    unsigned char* ws = args.ws;
    unsigned* ctl = (unsigned*)(ws + WS_CTL);
    const float* x = args.in[0]; const float* norm1_w = args.in[1]; const float* w_in = args.in[2]; const float* lb_logits = args.in[3];
    const float* hgrn_norm_w = args.in[4]; const float* dw_w = args.in[5]; const float* dw_b = args.in[6]; const float* conv_ln_w = args.in[7]; const float* conv_ln_b = args.in[8];
    const float* w_out = args.in[9]; const float* norm2_w = args.in[10]; const float* router_w = args.in[11]; const float* router_b = args.in[12];
    const float* w1 = args.in[13]; const float* b1 = args.in[14]; const float* w2 = args.in[15]; const float* b2 = args.in[16]; const float* final_norm_w = args.in[17];
    float* out = args.out;
    bf16* WI = (bf16*)(ws + WS_WI); bf16* WO = (bf16*)(ws + WS_WO); bf16* W1T = (bf16*)(ws + WS_W1); bf16* W2T = (bf16*)(ws + WS_W2);
    float* H = (float*)(ws + WS_H); bf16* XN = (bf16*)(ws + WS_XN);
    bf16* Qb = (bf16*)(ws + WS_Q); bf16* KFb = (bf16*)(ws + WS_KF); bf16* KBb = (bf16*)(ws + WS_KB); bf16* Vb = (bf16*)(ws + WS_V); bf16* Gb = (bf16*)(ws + WS_G); bf16* Ub = (bf16*)(ws + WS_U);
    float* LFb = (float*)(ws + WS_LF); float* LBb = (float*)(ws + WS_LB); float* OFb = (float*)(ws + WS_OF); float* OBb = (float*)(ws + WS_OB);
    bf16* MIX = (bf16*)(ws + WS_MIX); bf16* XS = (bf16*)(ws + WS_XS); bf16* ACT = (bf16*)(ws + WS_ACT); bf16* YS = (bf16*)(ws + WS_YS);
    float* WRT = (float*)(ws + WS_WRT); int* SLOT = (int*)(ws + WS_SLOT); float* GATE = (float*)(ws + WS_GATE); int* ROWTOK = (int*)(ws + WS_ROWTOK);
    volatile LAS int* bs = (volatile LAS int*)(lds + TAB_OFF);
    volatile LAS int* cl = (volatile LAS int*)(lds + TAB_OFF + 256);
    LAS int* lcnt = (LAS int*)(lds + TAB_OFF + 512);
    volatile LAS int* gbase = (volatile LAS int*)(lds + TAB_OFF + 768);

    for (int u = tid; u < (LDS_BYTES - LDSCTL_OFF) / 4; u += NTHR) ((LAS unsigned*)(lds + LDSCTL_OFF))[u] = 0u;
    __syncthreads();
    XcdBarrier bar; bar.bar = ctl + CW_BAR; bar.x = 0; bar.st = nullptr;
    if (MK_N_LAUNCHES == 1) bar = xcd_barrier_post(ctl + CW_BAR, MISC + 8);
    const int lo = args.ph_lo, hi = args.ph_hi;
#ifndef PHASE_MASK
#define PHASE_MASK 0xffffffffu
#endif
#define IN(k) ((((PHASE_MASK) >> (k)) & 1u) && lo <= (k) && (k) < hi)
#define SEAM(k) do { if (IN(k) && IN((k) + 1)) xcd_barrier(bar); } while (0)
#define BUILD_BS() do { if (tid == 0) { int a_ = 0; for (int e_ = 0; e_ < NE; ++e_) { bs[e_] = a_; const int c_ = (int)__hip_atomic_load(ctl + CW_CNT + 64 * e_, RLX_AGENT); cl[e_] = c_; a_ += (c_ + 255) >> 8; } bs[NE] = a_; } __syncthreads(); } while (0)

    if (IN(0)) {
        LAS float* scr = (LAS float*)(lds + RING_OFF + wave * 16384);
        constexpr int I_WI = (D / 64) * (INC / 32), I_WO = (D / 64) * (D / 32), I_W1 = (D / 64) * (2 * FF / 32), I_W2 = (FF / 64) * (D / 32);
        constexpr int NITEMS = I_WI + I_WO + NE * I_W1 + NE * I_W2;
        for (int it = gw; it < NITEMS; it += NGW) {
            int r = it;
            if (r < I_WI) { p0_transpose_item(w_in, D, INC, WI, RmWin(), scr, r, lane); continue; } r -= I_WI;
            if (r < I_WO) { p0_transpose_item(w_out, D, D, WO, RmIdent(), scr, r, lane); continue; } r -= I_WO;
            if (r < NE * I_W1) { const int e = r / I_W1; p0_transpose_item(w1 + (size_t)e * D * 2 * FF, D, 2 * FF, W1T + (size_t)e * 2 * FF * D, RmW1(), scr, r - e * I_W1, lane); continue; } r -= NE * I_W1;
            { const int e = r / I_W2; p0_transpose_item(w2 + (size_t)e * FF * D, FF, D, W2T + (size_t)e * D * FF, RmIdent(), scr, r - e * I_W2, lane); }
        }
        for (int m = gw; m < MTOK; m += NGW) rms_row_to_bf16(x + (size_t)m * D, norm1_w, XN + (size_t)m * D, lane);
        for (int i = bx * NTHR + tid; i < NE * D; i += G * NTHR) { const int e = i >> 10, c = i & 1023; WRT[i] = router_w[c * NE + e]; }
    }
    SEAM(0);

    if (IN(1)) {
        pg8::Gemm g{XN, WI, MTOK, INC, D}; pg8::StaticOrder S; S.init(MTOK, INC, G, bx);
        EpiProj E{Qb, KFb, KBb, Vb, Gb, Ub, LFb, LBb, lb_logits};
        pg8::gemm_phase<EpiProj, pg8::StaticOrder, true, true>(lds + RING_OFF, g, S, E);
    }
    SEAM(1);

    if (IN(2)) {
        {
            LAS unsigned short* ut = (LAS unsigned short*)(lds + RING_OFF);
            LAS float* part = (LAS float*)(lds + RING_OFF + 98304);
            LAS float* stat = (LAS float*)(lds + RING_OFF + 98304 + 4096);
            for (int unit = vcu; unit < NBATCH * (TT / 64); unit += G) {
                const int b = unit / (TT / 64), t0 = (unit % (TT / 64)) * 64;
                for (int idx = tid; idx < 94 * 64; idx += NTHR) {
                    const int r = idx >> 6, p = idx & 63, t = t0 - 15 + r;
                    v4u val = (v4u){0u, 0u, 0u, 0u};
                    if (t >= 0 && t < TT) val = *(const v4u*)(Ub + (size_t)(b * TT + t) * CCH + p * 8);
                    *(LAS v4u*)(ut + r * 512 + p * 8) = val;
                }
                __syncthreads();
                const int c = tid;
                float w[CLEN];
#pragma unroll
                for (int j = 0; j < CLEN; ++j) w[j] = dw_w[j * CCH + c];
                const float bias = dw_b[c];
                float y[64];
#pragma unroll
                for (int tb = 0; tb < 8; ++tb) {
                    float win[38];
#pragma unroll
                    for (int i = 0; i < 38; ++i) win[i] = bf2f(ut[(tb * 8 + i) * 512 + c]);
#pragma unroll
                    for (int o = 0; o < 8; ++o) { float a = bias;
#pragma unroll
                        for (int j = 0; j < CLEN; ++j) a += w[j] * win[o + j];
                        y[tb * 8 + o] = a; }
                }
#pragma unroll 1
                for (int pass = 0; pass < 2; ++pass) {
                    float s1[64];
#pragma unroll
                    for (int i = 0; i < 64; ++i) s1[i] = pass ? y[i] * y[i] : y[i];
#pragma unroll
                    for (int s = 32; s >= 1; s >>= 1) {
                        const bool up = (lane & s) != 0;
#pragma unroll
                        for (int i = 0; i < s; ++i) { const float k1 = up ? s1[i + s] : s1[i], x1 = up ? s1[i] : s1[i + s]; s1[i] = k1 + __shfl_xor(x1, s); }
                    }
                    part[(wave * 64 + lane) * 2 + pass] = s1[0];
                }
                __syncthreads();
                if (tid < 64) { float a = 0.f, q = 0.f;
#pragma unroll
                    for (int wv = 0; wv < 8; ++wv) { a += part[(wv * 64 + tid) * 2]; q += part[(wv * 64 + tid) * 2 + 1]; }
                    const float mean = a * (1.f / CCH), var = q * (1.f / CCH) - mean * mean;
                    stat[tid * 2] = mean; stat[tid * 2 + 1] = rsqrtf(fmaxf(var, 0.f) + EPS); }
                __syncthreads();
                const float lw = conv_ln_w[c], lbias = conv_ln_b[c];
#pragma unroll
                for (int t = 0; t < 64; ++t) {
                    const float v = (y[t] - stat[t * 2]) * stat[t * 2 + 1] * lw + lbias;
                    MIX[(size_t)(b * TT + t0 + t) * D + 512 + c] = (bf16)(pk2(v * sigm(v), 0.f) & 0xffffu);
                }
                __syncthreads();
            }
        }
        {
            LAS float* qs = (LAS float*)(lds + RING_OFF); LAS float* ks = qs + 2048; LAS float* fs = ks + 2048; LAS float* vs = fs + 2048; LAS float* op = vs + 2048;
            const int e = tid & 127, dq = tid >> 7;
            for (int unit = G - 1 - bx; unit < NBATCH * NH * 2; unit += G) {
                const int dir = unit & 1, h = (unit >> 1) & 3, b = unit >> 3;
                const bf16* Kp = dir ? KBb : KFb; const float* Lp = dir ? LBb : LFb; float* Op = dir ? OBb : OFb;
                float S[32];
#pragma unroll
                for (int i = 0; i < 32; ++i) S[i] = 0.f;
                for (int blk = 0; blk < TT / 16; ++blk) {
                    const int tb = dir ? (TT - 16 - blk * 16) : blk * 16;
#pragma unroll
                    for (int i = 0; i < 4; ++i) { const int idx = tid + NTHR * i, r = idx >> 7, d = idx & 127; const size_t off = (size_t)(b * TT + tb + r) * 512 + h * 128 + d;
                        qs[idx] = bf2f(Qb[off]); ks[idx] = bf2f(Kp[off]); fs[idx] = __expf(Lp[off]); vs[idx] = bf2f(Vb[off]); }
                    __syncthreads();
                    for (int st = 0; st < 16; ++st) {
                        const int r = dir ? 15 - st : st; const float v = vs[r * 128 + e]; float o = 0.f;
#pragma unroll
                        for (int dd = 0; dd < 32; ++dd) { const int d = dq * 32 + dd; S[dd] = fs[r * 128 + d] * S[dd] + ks[r * 128 + d] * v; o += qs[r * 128 + d] * S[dd]; }
                        op[(r * 4 + dq) * 128 + e] = o;
                    }
                    __syncthreads();
#pragma unroll
                    for (int i = 0; i < 4; ++i) { const int idx = tid + NTHR * i, r = idx >> 7, ee = idx & 127;
                        Op[(size_t)(b * TT + tb + r) * 512 + h * 128 + ee] = (op[(r * 4 + 0) * 128 + ee] + op[(r * 4 + 1) * 128 + ee]) + (op[(r * 4 + 2) * 128 + ee] + op[(r * 4 + 3) * 128 + ee]); }
                }
                __syncthreads();
            }
        }
    }
    SEAM(2);

    if (IN(3)) {
        for (int m = gw; m < MTOK; m += NGW) {
            const size_t off = (size_t)m * 512 + lane * 8;
            const f32x4 a0 = *(const f32x4*)(OFb + off), a1 = *(const f32x4*)(OFb + off + 4), c0 = *(const f32x4*)(OBb + off), c1 = *(const f32x4*)(OBb + off + 4);
            const f32x4 o0 = a0 + c0, o1 = a1 + c1;
            float ss = (o0.x * o0.x + o0.y * o0.y) + (o0.z * o0.z + o0.w * o0.w) + (o1.x * o1.x + o1.y * o1.y) + (o1.z * o1.z + o1.w * o1.w);
            ss += __shfl_xor(ss, 1); ss += __shfl_xor(ss, 2); ss += __shfl_xor(ss, 4); ss += __shfl_xor(ss, 8);
            const float rstd = rsqrtf(ss * (1.f / DV) + EPS);
            const v4u gv = *(const v4u*)(Gb + off);
            const f32x4 w0 = *(const f32x4*)(hgrn_norm_w + lane * 8), w1v = *(const f32x4*)(hgrn_norm_w + lane * 8 + 4);
            f32x4 r0, r1;
            r0.x = o0.x * rstd * w0.x * bf2f(gv.x & 0xffffu); r0.y = o0.y * rstd * w0.y * bf2f(gv.x >> 16);
            r0.z = o0.z * rstd * w0.z * bf2f(gv.y & 0xffffu); r0.w = o0.w * rstd * w0.w * bf2f(gv.y >> 16);
            r1.x = o1.x * rstd * w1v.x * bf2f(gv.z & 0xffffu); r1.y = o1.y * rstd * w1v.y * bf2f(gv.z >> 16);
            r1.z = o1.z * rstd * w1v.z * bf2f(gv.w & 0xffffu); r1.w = o1.w * rstd * w1v.w * bf2f(gv.w >> 16);
            st8bf(MIX + (size_t)m * D + lane * 8, r0, r1);
        }
    }
    SEAM(3);

    if (IN(4)) {
        pg8::Gemm g{MIX, WO, MTOK, D, D}; pg8::StaticOrder S; S.init(MTOK, D, G, bx);
        EpiRes E{x, H};
        pg8::gemm_phase<EpiRes, pg8::StaticOrder, true, true>(lds + RING_OFF, g, S, E);
    }
    SEAM(4);

    if (IN(5)) {
        LAS float* wl = (LAS float*)(lds + RING_OFF);
        LAS unsigned* sb = (LAS unsigned*)(lds + SB_OFF);
        for (int i = tid; i < NE * D / 4; i += NTHR) ((LAS f32x4*)wl)[i] = ((const f32x4*)WRT)[i];
        if (tid < NE) lcnt[tid] = 0;
        __syncthreads();
        int it = 0;
        for (int m = gw; m < MTOK; m += NGW, ++it) {
            const f32x4* hr = (const f32x4*)(H + (size_t)m * D) + lane; const f32x4* wr = (const f32x4*)norm2_w + lane;
            f32x4 v[4]; float s = 0.f;
#pragma unroll
            for (int j = 0; j < 4; ++j) { v[j] = hr[64 * j]; s += (v[j].x * v[j].x + v[j].y * v[j].y) + (v[j].z * v[j].z + v[j].w * v[j].w); }
            const float rstd = rsqrtf(wave_sum(s) * (1.f / D) + EPS);
            v2u* o8 = (v2u*)(XN + (size_t)m * D) + lane;
#pragma unroll
            for (int j = 0; j < 4; ++j) { const f32x4 g = wr[64 * j]; v[j] = v[j] * rstd * g; v2u o; o.x = pk2(v[j].x, v[j].y); o.y = pk2(v[j].z, v[j].w); o8[64 * j] = o; }
            float a[NE];
#pragma unroll
            for (int e = 0; e < NE; ++e) { float t = 0.f;
#pragma unroll
                for (int j = 0; j < 4; ++j) { const f32x4 wv = ((const LAS f32x4*)wl)[e * 256 + lane + 64 * j]; t += (v[j].x * wv.x + v[j].y * wv.y) + (v[j].z * wv.z + v[j].w * wv.w); }
                a[e] = t; }
#pragma unroll
            for (int s2 = 32, n = 16; n >= 1; s2 >>= 1, n >>= 1) {
                const bool up = (lane & s2) != 0;
#pragma unroll
                for (int i = 0; i < n; ++i) { const float k1 = up ? a[i + n] : a[i], x1 = up ? a[i] : a[i + n]; a[i] = k1 + __shfl_xor(x1, s2); }
            }
            float lg = a[0] + __shfl_xor(a[0], 1);
            const int myE = lane >> 1;
            lg += router_b[myE];
            float tv[TOPK]; int ti[TOPK];
#pragma unroll
            for (int k = 0; k < TOPK; ++k) {
                float mx = lg;
#pragma unroll
                for (int o = 1; o < 64; o <<= 1) mx = fmaxf(mx, __shfl_xor(mx, o));
                int cand = (lg == mx) ? myE : 99;
#pragma unroll
                for (int o = 1; o < 64; o <<= 1) cand = min(cand, __shfl_xor(cand, o));
                tv[k] = mx; ti[k] = cand;
                if (myE == cand) lg = -INFINITY;
            }
            const float e1 = __expf(tv[1] - tv[0]), e2 = __expf(tv[2] - tv[0]), e3 = __expf(tv[3] - tv[0]);
            const float inv = 1.0f / (1.0f + e1 + e2 + e3);
            if (lane < TOPK) {
                const int ek = lane == 0 ? ti[0] : lane == 1 ? ti[1] : lane == 2 ? ti[2] : ti[3];
                const float gk = (lane == 0 ? 1.0f : lane == 1 ? e1 : lane == 2 ? e2 : e3) * inv;
                const int lr = __hip_atomic_fetch_add(&lcnt[ek], 1, __ATOMIC_RELAXED, __HIP_MEMORY_SCOPE_WORKGROUP);
                sb[(wave * 64 + it) * 4 + lane] = ((unsigned)ek << 16) | (unsigned)lr;
                GATE[(size_t)m * TOPK + lane] = gk;
            }
        }
        __syncthreads();
        if (tid < NE) { const int c = lcnt[tid]; gbase[tid] = c ? (int)__hip_atomic_fetch_add(ctl + CW_CNT + 64 * tid, (unsigned)c, RLX_AGENT) : 0; }
        __syncthreads();
        it = 0;
        for (int m = gw; m < MTOK; m += NGW, ++it) {
            if (lane < TOPK) { const unsigned w = sb[(wave * 64 + it) * 4 + lane]; const int ek = (int)(w >> 16), r = gbase[ek] + (int)(w & 0xffffu);
                ROWTOK[ek * MTOK + r] = m; SLOT[(size_t)m * TOPK + lane] = ek * MTOK + r; }
        }
    }
    SEAM(5);

    if (IN(6)) {
        BUILD_BS();
        const int nrows = bs[NE] * 256;
        for (int r = gw; r < nrows; r += NGW) {
            const int mb = r >> 8; int e = 0;
            while (e < NE - 1 && bs[e + 1] <= mb) ++e;
            const int rank = r - bs[e] * 256;
            v4u a = (v4u){0u, 0u, 0u, 0u}, c = a;
            if (rank < cl[e]) { const int tok = ROWTOK[e * MTOK + rank]; const v4u* src = (const v4u*)(XN + (size_t)tok * D); a = src[lane]; c = src[lane + 64]; }
            v4u* dst = (v4u*)(XS + (size_t)r * D); dst[lane] = a; dst[lane + 64] = c;
        }
    }
    SEAM(6);

    if (IN(7)) {
        BUILD_BS();
        pg8::Gemm g{XS, W1T, MOE_ROWS, 2 * FF, D}; MoeOrder S{bs, 8, G, vcu};
        EpiSwiglu E{ACT, b1};
        pg8::gemm_phase<EpiSwiglu, MoeOrder, true, true>(lds + RING_OFF, g, S, E);
    }
    SEAM(7);

    if (IN(8)) {
        BUILD_BS();
        pg8::Gemm g{ACT, W2T, MOE_ROWS, D, FF}; MoeOrder S{bs, 4, G, vcu};
        EpiDown E{YS, b2};
        pg8::gemm_phase<EpiDown, MoeOrder, true, true>(lds + RING_OFF, g, S, E);
    }
    SEAM(8);

    if (IN(9)) {
        BUILD_BS();
        for (int m = gw; m < MTOK; m += NGW) {
            const f32x4* hr = (const f32x4*)(H + (size_t)m * D) + lane; const f32x4* wr = (const f32x4*)final_norm_w + lane;
            f32x4 v[4];
#pragma unroll
            for (int j = 0; j < 4; ++j) v[j] = hr[64 * j];
#pragma unroll
            for (int k = 0; k < TOPK; ++k) {
                const int sl = SLOT[(size_t)m * TOPK + k]; const float gk = GATE[(size_t)m * TOPK + k];
                const int e = sl >> 14, pos = bs[e] * 256 + (sl & (MTOK - 1));
                const v2u* yr = (const v2u*)(YS + (size_t)pos * D) + lane;
#pragma unroll
                for (int j = 0; j < 4; ++j) { const v2u w = yr[64 * j];
                    v[j].x += gk * bf2f(w.x & 0xffffu); v[j].y += gk * bf2f(w.x >> 16); v[j].z += gk * bf2f(w.y & 0xffffu); v[j].w += gk * bf2f(w.y >> 16); }
            }
            float s = 0.f;
#pragma unroll
            for (int j = 0; j < 4; ++j) s += (v[j].x * v[j].x + v[j].y * v[j].y) + (v[j].z * v[j].z + v[j].w * v[j].w);
            const float rstd = rsqrtf(wave_sum(s) * (1.f / D) + EPS);
            f32x4* orow = (f32x4*)(out + (size_t)m * D) + lane;
#pragma unroll
            for (int j = 0; j < 4; ++j) orow[64 * j] = v[j] * rstd * wr[64 * j];
        }
    }
#undef IN
#undef SEAM
#undef BUILD_BS
}

extern "C" void kernel_launch(void* const* d_in, const int* in_sizes, int n_in, void* d_out, int out_size, void* d_ws, size_t ws_size, hipStream_t stream) {
    static int grid = 0;
    if (grid == 0) {
        if (n_in != 18 || in_sizes[0] != MTOK * D || out_size != MTOK * D || ws_size < WS_END) { fprintf(stderr, "kernel_launch: unexpected shapes (n_in %d, in0 %d, out %d, ws %zu < %zu); nothing launched\n", n_in, n_in > 0 ? in_sizes[0] : -1, out_size, ws_size, (size_t)WS_END); grid = -1; return; }
        int dev = 0, cus = 0, per_cu = 0;
        if (hipGetDevice(&dev) != hipSuccess || hipDeviceGetAttribute(&cus, hipDeviceAttributeMultiprocessorCount, dev) != hipSuccess) { fprintf(stderr, "kernel_launch: device query failed\n"); grid = -1; return; }
        if (hipFuncSetAttribute((const void*)fwd_kernel, hipFuncAttributeMaxDynamicSharedMemorySize, LDS_BYTES) != hipSuccess) { fprintf(stderr, "kernel_launch: hipFuncSetAttribute failed\n"); grid = -1; return; }
        if (hipOccupancyMaxActiveBlocksPerMultiprocessor(&per_cu, (const void*)fwd_kernel, NTHR, LDS_BYTES) != hipSuccess || per_cu < 1)
            fprintf(stderr, "kernel_launch: note: occupancy query reports %d workgroups per CU\n", per_cu);
        (void)hipGetLastError();
        grid = cus;
    }
    if (grid < 0) return;
    if (hipMemsetAsync((char*)d_ws + WS_CTL, 0, CTL_ZERO_BYTES, stream) != hipSuccess) { fprintf(stderr, "kernel_launch: memset failed\n"); return; }
    Args a{};
    for (int i = 0; i < 18; ++i) a.in[i] = (const float*)d_in[i];
    a.out = (float*)d_out; a.ws = (unsigned char*)d_ws;
#if MK_N_LAUNCHES == 1
    a.ph_lo = 0; a.ph_hi = N_PHASES;
    hipLaunchKernelGGL(fwd_kernel, dim3(grid), dim3(NTHR), LDS_BYTES, stream, a);
#else
    for (int ph = 0; ph < N_PHASES; ++ph) { a.ph_lo = ph; a.ph_hi = ph + 1; hipLaunchKernelGGL(fwd_kernel, dim3(grid), dim3(NTHR), LDS_BYTES, stream, a); }
#endif
    const hipError_t le = hipPeekAtLastError();
    if (le != hipSuccess) fprintf(stderr, "kernel_launch: launch failed: %s\n", hipGetErrorName(le));
}
```

```cpp
#include <hip/hip_runtime.h>
#include <cstdio>
#include <cstdint>
namespace pg8 {
#define PG8_LAS __attribute__((address_space(3)))
typedef unsigned short bf16_t;
typedef short bf16x8 __attribute__((ext_vector_type(8)));
typedef float f32x4 __attribute__((ext_vector_type(4)));
typedef unsigned u32x4 __attribute__((ext_vector_type(4)));
constexpr int BM = 256, BK = 64, HALF = 128, HTB = HALF * BK * 2  , STAGE_BYTES = 8 * HTB, NXCD = 8, WGM = 8;

__host__ __device__ __forceinline__ int lds_byte(int r, int c) { const int st = (r >> 4) * 2 + (c >> 5), rr = r & 15, cc = c & 31, ob = rr * 64 + cc * 2; return st * 1024 + (ob ^ (((ob >> 9) & 1) << 5)); }
__host__ __device__ __forceinline__ void stage_rc(int b, int& R, int& C) { const int st = b / 1024, sb = b % 1024, swz = sb ^ (((sb >> 9) & 1) << 5); R = (st >> 1) * 16 + swz / 64; C = (st & 1) * 32 + (swz % 64) / 2; }
__host__ __device__ __forceinline__ int perm32(int rho) { const int n = rho >> 4, i = rho & 15; return 8 * (i >> 2) + 4 * n + (i & 3); }

struct Unit { int pm, pn; };
struct Gemm { const bf16_t* A; const bf16_t* Bt; int M, N, K; };

struct StaticOrder {
    int nM, nN, nwg, G, c;
    __host__ __device__ void init(int M, int N, int G_, int c_) { nM = M / BM; nN = N / BM; nwg = nM * nN; G = G_; c = c_; }
    __host__ __device__ bool next(int i, Unit& u) const {
        const long L = (long)i * G + c; if (L >= nwg) return false;
        int wgid = (int)L; { const int q = nwg / NXCD, r = nwg % NXCD, xcd = wgid % NXCD, off = wgid / NXCD; wgid = (xcd < r ? xcd * (q + 1) : r * (q + 1) + (xcd - r) * q) + off; }
        const int nig = WGM * nN, gid = wgid / nig, fm = gid * WGM, gsz = (nM - fm) < WGM ? (nM - fm) : WGM;
        u.pm = fm + ((wgid % nig) % gsz); u.pn = (wgid % nig) / gsz; return true;
    }
    __device__ __forceinline__ void a_ready(const Unit&) const {}
    __device__ __forceinline__ void done(const Unit&) const {}
};
__device__ __forceinline__ unsigned cvt_pk_bf16(float lo, float hi) { unsigned r; asm volatile("v_cvt_pk_bf16_f32 %0, %1, %2" : "=v"(r) : "v"(lo), "v"(hi)); return r; }
typedef float f32x2 __attribute__((ext_vector_type(2)));
template <class Epi, class Sched, bool ALIGN_EPI = false, bool SP2 = false>
__device__ __forceinline__ void gemm_phase(PG8_LAS unsigned char* lds, const Gemm g, const Sched& S, const Epi& E) {
    const int tid = threadIdx.x, wid = __builtin_amdgcn_readfirstlane(tid >> 6), lane = tid & 63, wr = wid >> 2, wc = wid & 3, fr = lane & 15, fq = lane >> 4;
    const int K = g.K, nt = K / BK;
    unsigned voffA[2], voffB[2];
#pragma unroll
    for (int i = 0; i < 2; ++i) { int R, C; stage_rc(tid * 16 + i * 8192, R, C); const int Rb = Epi::PERM ? ((R & ~31) + perm32(R & 31)) : R;
        voffA[i] = (unsigned)(R * K + C) * 2u; voffB[i] = (unsigned)(Rb * K + C) * 2u; }
    const size_t kstep = (size_t)(BK * 2);
    const size_t hstep = (size_t)HALF * K * 2;
    const size_t tstep = 2 * hstep;
    const unsigned ldsw = (unsigned)wid * 1024u;
    const int aoff = lds_byte(wr * 64 + fr, fq * 8), boff = lds_byte(wc * 32 + fr, fq * 8);
#define PG8_SA(b, h) (((b) * 2 + (h)) * HTB)
#define PG8_SB(b, h) ((4 + (b) * 2 + (h)) * HTB)
#define PG8_STAGE(bufoff, gbase, voff) do { _Pragma("unroll") for (int _i = 0; _i < 2; ++_i) \
        __builtin_amdgcn_global_load_lds((const unsigned*)((const char*)(gbase) + (voff)[_i]), (PG8_LAS unsigned*)(lds + (bufoff) + ldsw + _i * 8192), 16, 0, 0); } while (0)
#define PG8_LDA(dst, b, h) do { _Pragma("unroll") for (int m = 0; m < 4; ++m) _Pragma("unroll") for (int k = 0; k < 2; ++k) dst[m][k] = *(const PG8_LAS bf16x8*)(lds + PG8_SA(b, h) + aoff + m * 2048 + k * 1024); } while (0)
#define PG8_LDB(dst, b, h) do { _Pragma("unroll") for (int n = 0; n < 2; ++n) _Pragma("unroll") for (int k = 0; k < 2; ++k) dst[n][k] = *(const PG8_LAS bf16x8*)(lds + PG8_SB(b, h) + boff + n * 2048 + k * 1024); } while (0)
#define PG8_MMA(ai, bj, At, Bt) do { __builtin_amdgcn_s_setprio(1); _Pragma("unroll") for (int m = 0; m < 4; ++m) _Pragma("unroll") for (int n = 0; n < 2; ++n) _Pragma("unroll") for (int k = 0; k < 2; ++k) \
        acc[ai][bj][m][n] = __builtin_amdgcn_mfma_f32_16x16x32_bf16(Bt[n][k], At[m][k], acc[ai][bj][m][n], 0, 0, 0); __builtin_amdgcn_s_setprio(0); } while (0)
#define PG8_WAIT_V(n) asm volatile("s_waitcnt vmcnt(" #n ")" ::: "memory")
#define PG8_WAIT_L(n) asm volatile("s_waitcnt lgkmcnt(" #n ")" ::: "memory")
#define PG8_BAR __builtin_amdgcn_s_barrier()
#define PG8_SCHED __builtin_amdgcn_sched_barrier(0)
    Unit cur, nxt; int ui = 0;
    if (!S.next(0, cur)) return;
    f32x4 acc[2][2][4][2];
#pragma unroll
    for (int a = 0; a < 2; ++a)
#pragma unroll
        for (int b = 0; b < 2; ++b)
#pragma unroll
            for (int m = 0; m < 4; ++m)
#pragma unroll
                for (int n = 0; n < 2; ++n) acc[a][b][m][n] = (f32x4){0.f, 0.f, 0.f, 0.f};
    bf16x8 At[4][2], B0[2][2], B1[2][2];
    const char* cA = (const char*)g.A + (size_t)cur.pm * tstep; const char* cB = (const char*)g.Bt + (size_t)cur.pn * tstep;
    S.a_ready(cur);
    if constexpr (SP2) {
        PG8_STAGE(PG8_SB(0, 0), cB, voffB); PG8_STAGE(PG8_SB(0, 1), cB + hstep, voffB); PG8_STAGE(PG8_SA(0, 0), cA, voffA); PG8_STAGE(PG8_SA(0, 1), cA + hstep, voffA);
        if (wr == 1) PG8_BAR;
        PG8_WAIT_V(2); PG8_BAR;
        PG8_STAGE(PG8_SB(1, 0), cB + kstep, voffB); PG8_STAGE(PG8_SA(1, 0), cA + kstep, voffA); PG8_STAGE(PG8_SB(1, 1), cB + hstep + kstep, voffB);
        PG8_WAIT_V(6); PG8_BAR;
    } else {
        PG8_STAGE(PG8_SB(0, 0), cB, voffB); PG8_STAGE(PG8_SA(0, 0), cA, voffA); PG8_STAGE(PG8_SB(0, 1), cB + hstep, voffB); PG8_STAGE(PG8_SA(0, 1), cA + hstep, voffA);
        if (wr == 1) PG8_BAR;
        PG8_WAIT_V(4); PG8_BAR;
        PG8_STAGE(PG8_SB(1, 0), cB + kstep, voffB); PG8_STAGE(PG8_SA(1, 0), cA + kstep, voffA); PG8_STAGE(PG8_SB(1, 1), cB + hstep + kstep, voffB);
        PG8_WAIT_V(6); PG8_BAR;
    }
    for (;;) {
        const bool has_next = S.next(ui + 1, nxt);
        const char* nA = has_next ? (const char*)g.A + (size_t)nxt.pm * tstep : cA; const char* nB = has_next ? (const char*)g.Bt + (size_t)nxt.pn * tstep : cB;
        for (int t = 0; t < nt; t += 2) {
            const bool last = (t == nt - 2);
            const char* a1 = cA + (size_t)(t + 1) * kstep;
            const char* a2 = last ? nA : cA + (size_t)(t + 2) * kstep; const char* b2 = last ? nB : cB + (size_t)(t + 2) * kstep;
            const char* a3 = a2 + kstep; const char* b3 = b2 + kstep;
            if (last && has_next) S.a_ready(nxt);
            if constexpr (SP2) {
            PG8_LDB(B0, 0, 0); PG8_LDB(B1, 0, 1); PG8_SCHED; PG8_LDA(At, 0, 0); PG8_STAGE(PG8_SA(1, 1), a1 + hstep, voffA);
            PG8_WAIT_V(8); PG8_WAIT_L(0); PG8_BAR; PG8_MMA(0, 0, At, B0); PG8_MMA(0, 1, At, B1); PG8_BAR; PG8_SCHED;
            PG8_LDA(At, 0, 1); PG8_STAGE(PG8_SB(0, 0), b2, voffB); PG8_STAGE(PG8_SB(0, 1), b2 + hstep, voffB); PG8_STAGE(PG8_SA(0, 0), a2, voffA);
            PG8_WAIT_V(8); PG8_WAIT_L(0); PG8_BAR; PG8_MMA(1, 0, At, B0); PG8_MMA(1, 1, At, B1); PG8_BAR; PG8_SCHED;
            PG8_LDB(B0, 1, 0); PG8_LDB(B1, 1, 1); PG8_SCHED; PG8_LDA(At, 1, 0); PG8_STAGE(PG8_SA(0, 1), a2 + hstep, voffA);
            PG8_WAIT_V(8); PG8_WAIT_L(0); PG8_BAR; PG8_MMA(0, 0, At, B0); PG8_MMA(0, 1, At, B1); PG8_BAR; PG8_SCHED;
            PG8_LDA(At, 1, 1); PG8_STAGE(PG8_SB(1, 0), b3, voffB); PG8_STAGE(PG8_SB(1, 1), b3 + hstep, voffB); PG8_STAGE(PG8_SA(1, 0), a3, voffA);
            PG8_WAIT_V(8); PG8_WAIT_L(0); PG8_BAR; PG8_MMA(1, 0, At, B0); PG8_MMA(1, 1, At, B1); PG8_BAR; PG8_SCHED;
            } else {
            PG8_LDB(B0, 0, 0); PG8_SCHED; PG8_LDA(At, 0, 0); PG8_STAGE(PG8_SA(1, 1), a1 + hstep, voffA);
            PG8_WAIT_L(8); PG8_BAR; PG8_WAIT_L(0); PG8_MMA(0, 0, At, B0); PG8_BAR; PG8_SCHED;
            PG8_LDB(B1, 0, 1); PG8_STAGE(PG8_SB(0, 0), b2, voffB);
            PG8_BAR; PG8_WAIT_L(0); PG8_MMA(0, 1, At, B1); PG8_BAR;
            PG8_LDA(At, 0, 1); PG8_STAGE(PG8_SA(0, 0), a2, voffA);
            PG8_BAR; PG8_WAIT_L(0); PG8_MMA(1, 0, At, B0); PG8_BAR; PG8_SCHED;
            PG8_STAGE(PG8_SB(0, 1), b2 + hstep, voffB);
            PG8_WAIT_V(6); PG8_BAR; PG8_MMA(1, 1, At, B1); PG8_BAR;
            PG8_LDB(B0, 1, 0); PG8_SCHED; PG8_LDA(At, 1, 0); PG8_STAGE(PG8_SA(0, 1), a2 + hstep, voffA);
            PG8_WAIT_L(8); PG8_BAR; PG8_WAIT_L(0); PG8_MMA(0, 0, At, B0); PG8_BAR; PG8_SCHED;
            PG8_LDB(B1, 1, 1); PG8_STAGE(PG8_SB(1, 0), b3, voffB);
            PG8_BAR; PG8_WAIT_L(0); PG8_MMA(0, 1, At, B1); PG8_BAR;
            PG8_LDA(At, 1, 1); PG8_STAGE(PG8_SA(1, 0), a3, voffA);
            PG8_BAR; PG8_WAIT_L(0); PG8_MMA(1, 0, At, B0); PG8_BAR; PG8_SCHED;
            PG8_STAGE(PG8_SB(1, 1), b3 + hstep, voffB);
            PG8_WAIT_V(6); PG8_BAR; PG8_MMA(1, 1, At, B1); PG8_BAR;
            }
        }
        if constexpr (ALIGN_EPI) { if (wr == 0) PG8_BAR; }
        if constexpr (!Epi::AFTER_DRAIN) { E(acc, cur, wr, wc, fr, fq); S.done(cur); }
        if (!has_next) break;
#pragma unroll
        for (int a = 0; a < 2; ++a)
#pragma unroll
            for (int b = 0; b < 2; ++b)
#pragma unroll
                for (int m = 0; m < 4; ++m)
#pragma unroll
                    for (int n = 0; n < 2; ++n) acc[a][b][m][n] = (f32x4){0.f, 0.f, 0.f, 0.f};
        cur = nxt; cA = nA; cB = nB; ++ui;
        if constexpr (ALIGN_EPI) { if (wr == 1) PG8_BAR; }
    }
    PG8_WAIT_V(0);
    if constexpr (!ALIGN_EPI) { if (wr == 0) PG8_BAR; }
    PG8_BAR;
    if constexpr (Epi::AFTER_DRAIN) { E.fused(acc, cur, wr, wc, fr, fq, lds, wid, lane); S.done(cur); }
#undef PG8_SA
#undef PG8_SB
#undef PG8_STAGE
#undef PG8_LDA
#undef PG8_LDB
#undef PG8_MMA
#undef PG8_WAIT_V
#undef PG8_WAIT_L
#undef PG8_BAR
#undef PG8_SCHED
}
}

#ifndef MK_N_LAUNCHES
#define MK_N_LAUNCHES 1
#endif
constexpr int N_PHASES = 10;
constexpr int NBATCH = 8, TT = 2048, MTOK = NBATCH * TT, D = 1024;
constexpr int HK = 512, NH = 4, DK = 128, DV = 128, CCH = 512, CLEN = 31, INC = 3584;
constexpr int NE = 32, TOPK = 4, FF = 1024;
constexpr float EPS = 1e-5f, SW_LIMIT = 7.0f, SW_ALPHA = 1.702f;
constexpr int NWAVES = 8, NTHR = 512;
constexpr int MOE_ROWS = (MTOK * TOPK / 256 + NE) * 256;

constexpr size_t MiB = 1u << 20;
constexpr size_t WS_CTL = 0, CTL_ZERO_BYTES = 1 * MiB;
constexpr size_t WS_WI = 1 * MiB;
constexpr size_t WS_WO = 8 * MiB;
constexpr size_t WS_TAB = 10 * MiB;
constexpr size_t WS_W1 = 16 * MiB;
constexpr size_t WS_W2 = 144 * MiB;
constexpr size_t WS_H = 208 * MiB;
constexpr size_t WS_XN = 272 * MiB;
constexpr size_t WS_Q = 304 * MiB, WS_KF = 320 * MiB, WS_KB = 336 * MiB, WS_V = 352 * MiB, WS_G = 368 * MiB, WS_U = 384 * MiB;
constexpr size_t WS_LF = 400 * MiB, WS_LB = 432 * MiB;
constexpr size_t WS_OF = 464 * MiB, WS_OB = 496 * MiB;
constexpr size_t WS_MIX = 528 * MiB;
constexpr size_t WS_XS = 304 * MiB;
constexpr size_t WS_ACT = 448 * MiB;
constexpr size_t WS_YS = 592 * MiB;
constexpr size_t WS_END = 736 * MiB;
constexpr size_t WS_WRT = WS_TAB;
constexpr size_t WS_SLOT = WS_TAB + 256 * 1024;
constexpr size_t WS_GATE = WS_TAB + 512 * 1024;
constexpr size_t WS_ROWTOK = WS_TAB + 1 * MiB;
constexpr int CW_BAR = 4096;
constexpr int CW_CNT = 16384;

constexpr int RING_OFF = 0, RING_BYTES = 131072;
constexpr int LDSCTL_OFF = RING_BYTES;
constexpr int MISC_OFF = LDSCTL_OFF + 320;
constexpr int TAB_OFF = LDSCTL_OFF + 1024;
constexpr int SB_OFF = LDSCTL_OFF + 2048;
constexpr int LDS_BYTES = 147456;

#define GAS __attribute__((address_space(1)))
#define LAS __attribute__((address_space(3)))
typedef unsigned short bf16;
typedef unsigned v4u __attribute__((ext_vector_type(4)));
typedef unsigned v2u __attribute__((ext_vector_type(2)));
typedef float f32x4 __attribute__((ext_vector_type(4)));
typedef GAS unsigned gu32;
#define RLX_AGENT __ATOMIC_RELAXED, __HIP_MEMORY_SCOPE_AGENT
#define LDS_WAIT() asm volatile("s_waitcnt lgkmcnt(0)" ::: "memory")
#define VM_WAIT() asm volatile("s_waitcnt vmcnt(0)" ::: "memory")

__device__ __forceinline__ float bf2f(unsigned b) { return __uint_as_float(b << 16); }
__device__ __forceinline__ unsigned pk2(float lo, float hi) { return pg8::cvt_pk_bf16(lo, hi); }
__device__ __forceinline__ float sigm(float x) { return __builtin_amdgcn_rcpf(1.0f + __expf(-x)); }
__device__ __forceinline__ float wave_sum(float v) {
#pragma unroll
    for (int o = 1; o < 64; o <<= 1) v += __shfl_xor(v, o);
    return v;
}

#define XB_TMO      128
#define XB_XCNT(j)  (256  + 64 * (j))
#define XB_XSUB(j)  (1280 + 64 * (j))
#define XB_XGEN(j)  (2304 + 64 * (j))
#define XB_TOP      3328
#define XB_TOPGEN   3392
#define XCD_BAR_WORDS 3456
#define XB_SPIN_CAP (1u << 18)

__device__ __forceinline__ unsigned xb_ld(unsigned* p)              { return __hip_atomic_load(p, __ATOMIC_RELAXED, __HIP_MEMORY_SCOPE_AGENT); }
__device__ __forceinline__ unsigned xb_add(unsigned* p, unsigned v) { return __hip_atomic_fetch_add(p, v, __ATOMIC_RELAXED, __HIP_MEMORY_SCOPE_AGENT); }
__device__ __forceinline__ unsigned xb_xcc_id() { return (unsigned)__builtin_amdgcn_s_getreg((3 << 11) | 20) & 0xFu; }
#define XB_SPIN(cond, bar) do { unsigned _sp = 0; while (cond) { __builtin_amdgcn_s_sleep(1); \
    if ((++_sp & 255u) == 0u) { if (xb_ld(&(bar)[XB_TMO])) break; if (_sp > XB_SPIN_CAP) { atomicAdd(&(bar)[XB_TMO], 1u); break; } } } } while (0)

struct XcdBarrier {
    unsigned* bar; unsigned x;
    volatile LAS unsigned* st;
};
__device__ __forceinline__ XcdBarrier xcd_barrier_post(unsigned* bar, volatile LAS unsigned* st) {
    XcdBarrier b; b.bar = bar; b.x = xb_xcc_id(); b.st = st;
    if (threadIdx.x == 0) (void)xb_add(&bar[XB_XCNT(b.x)], 1u);
    return b;
}
__device__ __forceinline__ void xcd_barrier_complete(unsigned* bar, unsigned x, unsigned& nloc, unsigned& nx) {
    const unsigned G = gridDim.x * gridDim.y * gridDim.z;
    unsigned sum, cnt, mine, sp = 0u;
    for (;;) {
        sum = 0u; cnt = 0u; mine = 0u;
#pragma unroll
        for (unsigned j = 0; j < 16; ++j) { const unsigned c = xb_ld(&bar[XB_XCNT(j)]); sum += c; cnt += (c > 0u) ? 1u : 0u; mine = (j == x) ? c : mine; }
        if (sum == G) break;
        __builtin_amdgcn_s_sleep(1);
        if ((++sp & 255u) == 0u) { if (xb_ld(&bar[XB_TMO])) break; if (sp > XB_SPIN_CAP) { atomicAdd(&bar[XB_TMO], 1u); break; } }
    }
    nloc = mine > 0u ? mine : 1u; nx = cnt > 0u ? cnt : 1u;
}
__device__ __forceinline__ void xcd_barrier(const XcdBarrier& b) {
    asm volatile("s_waitcnt vmcnt(0)" ::: "memory");
    __syncthreads();
    if (threadIdx.x == 0) {
        unsigned* bar = b.bar;
        __builtin_amdgcn_s_waitcnt(0);
        unsigned nloc = b.st[0], nx = b.st[1];
        if (nloc == 0u) { xcd_barrier_complete(bar, b.x, nloc, nx); b.st[0] = nloc; b.st[1] = nx; }
        const unsigned old = xb_add(&bar[XB_XSUB(b.x)], 1u);
        const unsigned gen = old / nloc;
        if (old + 1u == (gen + 1u) * nloc) {
            __builtin_amdgcn_fence(__ATOMIC_RELEASE, "agent");
            asm volatile("s_waitcnt vmcnt(0)" ::: "memory");
            const unsigned og = xb_add(&bar[XB_TOP], 1u);
            const unsigned tg = og / nx;
            if (og + 1u == (tg + 1u) * nx) xb_add(&bar[XB_TOPGEN], 1u);
            else XB_SPIN(xb_ld(&bar[XB_TOPGEN]) == tg, bar);
            __builtin_amdgcn_fence(__ATOMIC_ACQUIRE, "agent");
            xb_add(&bar[XB_XGEN(b.x)], 1u);
            asm volatile("s_waitcnt vmcnt(0)" ::: "memory");
        } else {
            XB_SPIN(xb_ld(&bar[XB_XGEN(b.x)]) == gen, bar);
            __builtin_amdgcn_fence(__ATOMIC_ACQUIRE, "agent");
            asm volatile("s_waitcnt vmcnt(0)" ::: "memory");
        }
    }
    __syncthreads();
}

__device__ __forceinline__ void st8bf(bf16* p, const f32x4& a, const f32x4& b) {
    v4u w; w.x = pk2(a[0], a[1]); w.y = pk2(a[2], a[3]); w.z = pk2(b[0], b[1]); w.w = pk2(b[2], b[3]);
    *(v4u*)p = w;
}
struct EpiProj {
    static constexpr bool PERM = true, AFTER_DRAIN = false;
    bf16 *Q, *KF, *KB, *V, *G, *U; float *LF, *LB; const float* lbl;
    template <int TYP>
    __device__ __forceinline__ void tile(const pg8::f32x4 (&acc)[2][2][4][2], int row0, int cb) const {
#pragma unroll
        for (int bj = 0; bj < 2; ++bj) {
            const int col = cb + bj * 128;
            float lb[8];
            if (TYP == 1 || TYP == 2) {
                const float* L = lbl + (TYP - 1) * 1024 + col;
#pragma unroll
                for (int i = 0; i < 8; ++i) lb[i] = __builtin_amdgcn_rcpf(1.0f + __expf(L[512 + i] - L[i]));
            }
#pragma unroll
            for (int ai = 0; ai < 2; ++ai)
#pragma unroll
                for (int m = 0; m < 4; ++m) {
                    const size_t off = (size_t)(row0 + ai * 128 + m * 16) * 512 + col;
                    f32x4 a = acc[ai][bj][m][0], b = acc[ai][bj][m][1];
                    if (TYP == 0 || TYP == 4) {
#pragma unroll
                        for (int i = 0; i < 4; ++i) { a[i] = a[i] * sigm(a[i]); b[i] = b[i] * sigm(b[i]); }
                        st8bf((TYP == 0 ? Q : G) + off, a, b);
                    } else if (TYP == 3) {
                        st8bf(V + off, a, b);
                    } else {
                        f32x4 la, lbv, ka, kb;
#pragma unroll
                        for (int i = 0; i < 4; ++i) {
                            const float fa = lb[i] + (1.0f - lb[i]) * sigm(a[i]), fb = lb[4 + i] + (1.0f - lb[4 + i]) * sigm(b[i]);
                            la[i] = __logf(fa); lbv[i] = __logf(fb); ka[i] = 1.0f - fa; kb[i] = 1.0f - fb;
                        }
                        float* Lp = (TYP == 1 ? LF : LB) + off;
                        *(f32x4*)Lp = la; *(f32x4*)(Lp + 4) = lbv;
                        st8bf((TYP == 1 ? KF : KB) + off, ka, kb);
                    }
                }
        }
    }
    __device__ __forceinline__ void operator()(const pg8::f32x4 (&acc)[2][2][4][2], const pg8::Unit& u, int wr, int wc, int fr, int fq) const {
        const int row0 = u.pm * 256 + wr * 64 + fr, pn = u.pn;
        if (pn >= 10) {
            const int col = (pn - 10) * 128 + wc * 32 + 8 * fq;
#pragma unroll
            for (int ai = 0; ai < 2; ++ai)
#pragma unroll
                for (int m = 0; m < 4; ++m) {
                    f32x4 a = acc[ai][0][m][0], b = acc[ai][0][m][1]; const f32x4 ga = acc[ai][1][m][0], gb = acc[ai][1][m][1];
#pragma unroll
                    for (int i = 0; i < 4; ++i) { a[i] = a[i] * sigm(ga[i]); b[i] = b[i] * sigm(gb[i]); }
                    st8bf(U + (size_t)(row0 + ai * 128 + m * 16) * 512 + col, a, b);
                }
        } else {
            const int cb = (pn & 1) * 256 + wc * 32 + 8 * fq, typ = pn >> 1;
            if (typ == 0) tile<0>(acc, row0, cb);
            else if (typ == 1) tile<1>(acc, row0, cb);
            else if (typ == 2) tile<2>(acc, row0, cb);
            else if (typ == 3) tile<3>(acc, row0, cb);
            else tile<4>(acc, row0, cb);
        }
    }
};
struct EpiRes {
    static constexpr bool PERM = false, AFTER_DRAIN = false;
    const float* X; float* H;
    __device__ __forceinline__ void operator()(const pg8::f32x4 (&acc)[2][2][4][2], const pg8::Unit& u, int wr, int wc, int fr, int fq) const {
        const int row0 = u.pm * 256 + wr * 64 + fr, col0 = u.pn * 256 + wc * 32 + 4 * fq;
#pragma unroll
        for (int ai = 0; ai < 2; ++ai)
#pragma unroll
            for (int m = 0; m < 4; ++m) {
                const size_t off = (size_t)(row0 + ai * 128 + m * 16) * D + col0;
#pragma unroll
                for (int bj = 0; bj < 2; ++bj)
#pragma unroll
                    for (int n = 0; n < 2; ++n) { const f32x4 xv = *(const f32x4*)(X + off + bj * 128 + n * 16); *(f32x4*)(H + off + bj * 128 + n * 16) = xv + acc[ai][bj][m][n]; }
            }
    }
};
struct EpiSwiglu {
    static constexpr bool PERM = true, AFTER_DRAIN = false;
    bf16* ACT; const float* b1;
    __device__ __forceinline__ void operator()(const pg8::f32x4 (&acc)[2][2][4][2], const pg8::Unit& u, int wr, int wc, int fr, int fq) const {
        const int e = u.pn >> 3, pn = u.pn & 7, row0 = u.pm * 256 + wr * 64 + fr, col = pn * 128 + wc * 32 + 8 * fq;
        const float* bg = b1 + (size_t)e * 2048 + col; const float* bl = bg + 1024;
        float g[8], l[8];
#pragma unroll
        for (int i = 0; i < 8; ++i) { g[i] = bg[i]; l[i] = bl[i]; }
#pragma unroll
        for (int ai = 0; ai < 2; ++ai)
#pragma unroll
            for (int m = 0; m < 4; ++m) {
                f32x4 o[2];
#pragma unroll
                for (int n = 0; n < 2; ++n)
#pragma unroll
                    for (int i = 0; i < 4; ++i) {
                        const float hg = fminf(acc[ai][0][m][n][i] + g[4 * n + i], SW_LIMIT);
                        const float hl = fminf(fmaxf(acc[ai][1][m][n][i] + l[4 * n + i], -SW_LIMIT), SW_LIMIT);
                        o[n][i] = hg * sigm(SW_ALPHA * hg) * (hl + 1.0f);
                    }
                st8bf(ACT + (size_t)(row0 + ai * 128 + m * 16) * FF + col, o[0], o[1]);
            }
    }
};
struct EpiDown {
    static constexpr bool PERM = true, AFTER_DRAIN = false;
    bf16* YS; const float* b2;
    __device__ __forceinline__ void operator()(const pg8::f32x4 (&acc)[2][2][4][2], const pg8::Unit& u, int wr, int wc, int fr, int fq) const {
        const int e = u.pn >> 2, pn = u.pn & 3, row0 = u.pm * 256 + wr * 64 + fr, col0 = pn * 256 + wc * 32 + 8 * fq;
#pragma unroll
        for (int bj = 0; bj < 2; ++bj) {
            const float* bp = b2 + (size_t)e * D + col0 + bj * 128;
            const f32x4 b0 = *(const f32x4*)bp, b1v = *(const f32x4*)(bp + 4);
#pragma unroll
            for (int ai = 0; ai < 2; ++ai)
#pragma unroll
                for (int m = 0; m < 4; ++m)
                    st8bf(YS + (size_t)(row0 + ai * 128 + m * 16) * D + col0 + bj * 128, acc[ai][bj][m][0] + b0, acc[ai][bj][m][1] + b1v);
        }
    }
};
struct MoeOrder {
    const volatile LAS int* bs; int ntn, G, v;
    __device__ __forceinline__ bool next(int i, pg8::Unit& u) const {
        const int L = i * G + v, nb = bs[32];
        if (L >= nb * ntn) return false;
        const int mb = L / ntn, pn = L - mb * ntn;
        int e = 0;
        while (e < NE - 1 && bs[e + 1] <= mb) ++e;
        u.pm = mb; u.pn = e * ntn + pn; return true;
    }
    __device__ __forceinline__ void a_ready(const pg8::Unit&) const {}
    __device__ __forceinline__ void done(const pg8::Unit&) const {}
};

struct RmIdent { __device__ __forceinline__ int operator()(int n) const { return n; } };
struct RmWin {
    __device__ __forceinline__ int operator()(int n) const {
        if (n < 2560) return n;
        if (n < 3072) { const int j = n - 2560; return 2560 + (j >> 7) * 256 + (j & 127); }
        const int j = n - 3072; return 2560 + (j >> 7) * 256 + 128 + (j & 127);
    }
};
struct RmW1 {
    __device__ __forceinline__ int operator()(int n) const {
        if (n < 1024) return (n >> 7) * 256 + (n & 127);
        const int j = n - 1024; return (j >> 7) * 256 + 128 + (j & 127);
    }
};
template <class RM>
__device__ __forceinline__ void p0_transpose_item(const float* W, int K, int N, bf16* WT, RM rm, LAS float* scr, int item, int lane) {
    const int nblk = N / 32, kb = item / nblk, nb = item % nblk, k0 = 64 * kb, n0 = 32 * nb;
#pragma unroll 8
    for (int i = 0; i < 32; ++i) { const int kk = 2 * i + (lane >> 5); scr[kk * 33 + (lane & 31)] = W[(size_t)(k0 + kk) * N + n0 + (lane & 31)]; }
    LDS_WAIT(); asm volatile("" ::: "memory");
    const int c = lane & 7;
#pragma unroll
    for (int j = 0; j < 4; ++j) { const int n = (lane >> 3) + 8 * j; const LAS float* s = scr + (8 * c) * 33 + n;
        v4u o; o.x = pk2(s[0 * 33], s[1 * 33]); o.y = pk2(s[2 * 33], s[3 * 33]); o.z = pk2(s[4 * 33], s[5 * 33]); o.w = pk2(s[6 * 33], s[7 * 33]);
        *(GAS v4u*)(WT + (size_t)rm(n0 + n) * K + k0 + 8 * c) = o; }
    LDS_WAIT(); asm volatile("" ::: "memory");
}
__device__ __forceinline__ void rms_row_to_bf16(const float* xrow, const float* w, bf16* orow, int lane) {
    const f32x4* xr = (const f32x4*)xrow + lane; const f32x4* wr = (const f32x4*)w + lane;
    f32x4 v[4]; float s = 0.f;
#pragma unroll
    for (int j = 0; j < 4; ++j) { v[j] = xr[64 * j]; s += (v[j].x * v[j].x + v[j].y * v[j].y) + (v[j].z * v[j].z + v[j].w * v[j].w); }
    const float rstd = rsqrtf(wave_sum(s) * (1.f / D) + EPS);
    v2u* o8 = (v2u*)orow + lane;
#pragma unroll
    for (int j = 0; j < 4; ++j) { const f32x4 g = wr[64 * j]; v2u o; o.x = pk2(v[j].x * rstd * g.x, v[j].y * rstd * g.y); o.y = pk2(v[j].z * rstd * g.z, v[j].w * rstd * g.w); o8[64 * j] = o; }
}


__device__ __forceinline__ pg8::bf16x8 lds_frag(const LAS unsigned char* p) { return *(const LAS pg8::bf16x8*)p; }
__device__ __forceinline__ void hgrn_unit(LAS unsigned char* lds, int unit, const bf16* Qb, const bf16* KFb, const bf16* KBb, const bf16* Vb, const float* LFb, const float* LBb,
                                          float* OFb, float* OBb, int tid, int lane, int wave) {
    constexpr int BF_OFF = 0, AM_OFF = 0, QI_OFF = 33792, KK_OFF = 51200, KET_OFF = 68608, VT_OFF = 87040, ST_OFF = 96256, SEG_OFF = 113664, DEC_OFF = 115712;
    constexpr int RS_D = 272, RS_S = 144, RS_BF = 528;
    const int vh = unit & 1, dir = (unit >> 1) & 1, h = (unit >> 2) & 3, b = unit >> 4;
    const bf16* Kp = dir ? KBb : KFb; const float* Lp = dir ? LBb : LFb; float* Op = dir ? OBb : OFb;
    const int lr = lane & 15, lq = lane >> 4;
    const int dA = tid & 127, seg = tid >> 7;
    const int tauB = tid >> 3, dg = tid & 7;
    for (int i = tid; i < 64 * RS_D / 16; i += NTHR) *(LAS v4u*)(lds + ST_OFF + i * 16) = (v4u){0u, 0u, 0u, 0u};
    f32x4 S[4];
#pragma unroll
    for (int i = 0; i < 4; ++i) S[i] = (f32x4){0.f, 0.f, 0.f, 0.f};
    float lf[16]; unsigned kA[16]; v4u qB[2], kB[2], vB;
#define HG_LOAD(n_) do { const int tbn_ = b * TT + (dir ? (TT / 64 - 1 - (n_)) * 64 : (n_) * 64); \
        _Pragma("unroll") for (int i = 0; i < 16; ++i) { const int tau_ = 16 * seg + i; const size_t off_ = (size_t)(dir ? tbn_ + 63 - tau_ : tbn_ + tau_) * 512 + h * 128 + dA; lf[i] = Lp[off_]; kA[i] = Kp[off_]; } \
        const size_t offB_ = (size_t)(dir ? tbn_ + 63 - tauB : tbn_ + tauB) * 512 + h * 128; \
        qB[0] = *(const v4u*)(Qb + offB_ + 16 * dg); qB[1] = *(const v4u*)(Qb + offB_ + 16 * dg + 8); kB[0] = *(const v4u*)(Kp + offB_ + 16 * dg); kB[1] = *(const v4u*)(Kp + offB_ + 16 * dg + 8); \
        vB = *(const v4u*)(Vb + offB_ + vh * 64 + 8 * dg); } while (0)
    HG_LOAD(0);
#pragma unroll 1
    for (int n = 0; n < TT / 64; ++n) {
        const int tb = b * TT + (dir ? (TT / 64 - 1 - n) * 64 : n * 64);
        float bl[16]; { float c = 0.f;
#pragma unroll
            for (int i = 0; i < 16; ++i) { c += lf[i]; bl[i] = c; }
            *(LAS float*)(lds + SEG_OFF + (seg * 128 + dA) * 4) = c; }
        __syncthreads();
        {
            const float p0 = *(LAS float*)(lds + SEG_OFF + (0 * 128 + dA) * 4), p1 = *(LAS float*)(lds + SEG_OFF + (1 * 128 + dA) * 4),
                        p2 = *(LAS float*)(lds + SEG_OFF + (2 * 128 + dA) * 4), p3 = *(LAS float*)(lds + SEG_OFF + (3 * 128 + dA) * 4);
            const float pre = (seg > 0 ? p0 : 0.f) + (seg > 1 ? p1 : 0.f) + (seg > 2 ? p2 : 0.f), bend = (p0 + p1) + (p2 + p3);
            float ke[16];
#pragma unroll
            for (int i = 0; i < 16; ++i) { const float bb = pre + bl[i]; *(LAS float*)(lds + BF_OFF + (16 * seg + i) * RS_BF + dA * 4) = bb; ke[i] = bf2f(kA[i]) * __expf(bend - bb); }
            v4u w0, w1;
            w0.x = pk2(ke[0], ke[1]); w0.y = pk2(ke[2], ke[3]); w0.z = pk2(ke[4], ke[5]); w0.w = pk2(ke[6], ke[7]);
            w1.x = pk2(ke[8], ke[9]); w1.y = pk2(ke[10], ke[11]); w1.z = pk2(ke[12], ke[13]); w1.w = pk2(ke[14], ke[15]);
            *(LAS v4u*)(lds + KET_OFF + dA * RS_S + seg * 32) = w0; *(LAS v4u*)(lds + KET_OFF + dA * RS_S + seg * 32 + 16) = w1;
            if (seg == 0) *(LAS float*)(lds + DEC_OFF + dA * 4) = __expf(bend);
        }
        __syncthreads();
        {
            const unsigned qw[8] = {qB[0].x, qB[0].y, qB[0].z, qB[0].w, qB[1].x, qB[1].y, qB[1].z, qB[1].w};
            const unsigned kw[8] = {kB[0].x, kB[0].y, kB[0].z, kB[0].w, kB[1].x, kB[1].y, kB[1].z, kB[1].w};
            unsigned qo[8], ko[8];
#pragma unroll
            for (int i = 0; i < 4; ++i) {
                const f32x4 bb = *(const LAS f32x4*)(lds + BF_OFF + tauB * RS_BF + dg * 64 + i * 16);
#pragma unroll
                for (int j = 0; j < 2; ++j) {
                    const float e0 = __expf(bb[2 * j]), e1 = __expf(bb[2 * j + 1]);
                    const unsigned qq = qw[2 * i + j], kk = kw[2 * i + j];
                    qo[2 * i + j] = pk2(bf2f(qq & 0xffffu) * e0, bf2f(qq >> 16) * e1);
                    ko[2 * i + j] = pk2(bf2f(kk & 0xffffu) * __builtin_amdgcn_rcpf(e0), bf2f(kk >> 16) * __builtin_amdgcn_rcpf(e1));
                }
            }
            *(LAS v4u*)(lds + QI_OFF + tauB * RS_D + dg * 32) = (v4u){qo[0], qo[1], qo[2], qo[3]}; *(LAS v4u*)(lds + QI_OFF + tauB * RS_D + dg * 32 + 16) = (v4u){qo[4], qo[5], qo[6], qo[7]};
            *(LAS v4u*)(lds + KK_OFF + tauB * RS_D + dg * 32) = (v4u){ko[0], ko[1], ko[2], ko[3]}; *(LAS v4u*)(lds + KK_OFF + tauB * RS_D + dg * 32 + 16) = (v4u){ko[4], ko[5], ko[6], ko[7]};
            const unsigned vw[4] = {vB.x, vB.y, vB.z, vB.w};
#pragma unroll
            for (int c = 0; c < 4; ++c) {
                *(LAS unsigned short*)(lds + VT_OFF + (8 * dg + 2 * c) * RS_S + tauB * 2) = (unsigned short)(vw[c] & 0xffffu);
                *(LAS unsigned short*)(lds + VT_OFF + (8 * dg + 2 * c + 1) * RS_S + tauB * 2) = (unsigned short)(vw[c] >> 16);
            }
        }
        __syncthreads();
        if (n + 1 < TT / 64) HG_LOAD(n + 1);
        const int ei = wave & 3, tp = wave >> 2;
        {
            const int ti = wave & 3;
#pragma unroll
            for (int sii = 0; sii < 2; ++sii) {
                const int si = tp * 2 + sii;
                v2u w = (v2u){0u, 0u};
                if (si <= ti) {
                    f32x4 a = (f32x4){0.f, 0.f, 0.f, 0.f};
#pragma unroll
                    for (int kk = 0; kk < 4; ++kk)
                        a = __builtin_amdgcn_mfma_f32_16x16x32_bf16(lds_frag(lds + KK_OFF + (16 * si + lr) * RS_D + kk * 64 + lq * 16), lds_frag(lds + QI_OFF + (16 * ti + lr) * RS_D + kk * 64 + lq * 16), a, 0, 0, 0);
                    const int s0 = 16 * si + 4 * lq, t = 16 * ti + lr;
                    w.x = pk2(s0 + 0 <= t ? a[0] : 0.f, s0 + 1 <= t ? a[1] : 0.f); w.y = pk2(s0 + 2 <= t ? a[2] : 0.f, s0 + 3 <= t ? a[3] : 0.f);
                }
                *(LAS v2u*)(lds + AM_OFF + (16 * ti + lr) * RS_S + (16 * si + 4 * lq) * 2) = w;
            }
        }
        f32x4 o[2];
#pragma unroll
        for (int tt = 0; tt < 2; ++tt) {
            o[tt] = (f32x4){0.f, 0.f, 0.f, 0.f};
#pragma unroll
            for (int kk = 0; kk < 4; ++kk)
                o[tt] = __builtin_amdgcn_mfma_f32_16x16x32_bf16(lds_frag(lds + ST_OFF + (16 * ei + lr) * RS_D + kk * 64 + lq * 16), lds_frag(lds + QI_OFF + (16 * (2 * tp + tt) + lr) * RS_D + kk * 64 + lq * 16), o[tt], 0, 0, 0);
        }
        {
            const f32x4 dv = *(const LAS f32x4*)(lds + DEC_OFF + (16 * wave + 4 * lq) * 4);
#pragma unroll
            for (int e4 = 0; e4 < 4; ++e4) S[e4] = S[e4] * dv;
#pragma unroll
            for (int kk = 0; kk < 2; ++kk) {
                const pg8::bf16x8 af = lds_frag(lds + KET_OFF + (16 * wave + lr) * RS_S + kk * 64 + lq * 16);
#pragma unroll
                for (int e4 = 0; e4 < 4; ++e4) S[e4] = __builtin_amdgcn_mfma_f32_16x16x32_bf16(af, lds_frag(lds + VT_OFF + (16 * e4 + lr) * RS_S + kk * 64 + lq * 16), S[e4], 0, 0, 0);
            }
        }
        __syncthreads();
#pragma unroll
        for (int tt = 0; tt < 2; ++tt) {
#pragma unroll
            for (int kk = 0; kk < 2; ++kk)
                o[tt] = __builtin_amdgcn_mfma_f32_16x16x32_bf16(lds_frag(lds + VT_OFF + (16 * ei + lr) * RS_S + kk * 64 + lq * 16), lds_frag(lds + AM_OFF + (16 * (2 * tp + tt) + lr) * RS_S + kk * 64 + lq * 16), o[tt], 0, 0, 0);
            const int t = 16 * (2 * tp + tt) + lr;
            *(f32x4*)(Op + (size_t)(dir ? tb + 63 - t : tb + t) * 512 + h * 128 + vh * 64 + 16 * ei + 4 * lq) = o[tt];
        }
#pragma unroll
        for (int e4 = 0; e4 < 4; ++e4) { v2u w; w.x = pk2(S[e4][0], S[e4][1]); w.y = pk2(S[e4][2], S[e4][3]); *(LAS v2u*)(lds + ST_OFF + (16 * e4 + lr) * RS_D + (16 * wave + 4 * lq) * 2) = w; }
    }
#undef HG_LOAD
    __syncthreads();
}

struct Args { const float* in[18]; float* out; unsigned char* ws; int ph_lo, ph_hi; };
__global__ void __launch_bounds__(NTHR, 2) fwd_kernel(Args args) {
    extern __shared__ __attribute__((aligned(16))) unsigned char lds_raw[];
    LAS unsigned char* lds = (LAS unsigned char*)lds_raw;
    volatile LAS unsigned* MISC = (volatile LAS unsigned*)(lds + MISC_OFF);
    const int tid = threadIdx.x, lane = tid & 63, wave = __builtin_amdgcn_readfirstlane(tid >> 6);
    const int G = gridDim.x; const int bx = blockIdx.x; const int vcu = (G % 8 == 0) ? (bx % 8) * (G / 8) + bx / 8 : bx;
    const int gw = vcu * NWAVES + wave, NGW = G * NWAVES;
    unsigned char* ws = args.ws;
    unsigned* ctl = (unsigned*)(ws + WS_CTL);
    const float* x = args.in[0]; const float* norm1_w = args.in[1]; const float* w_in = args.in[2]; const float* lb_logits = args.in[3];
    const float* hgrn_norm_w = args.in[4]; const float* dw_w = args.in[5]; const float* dw_b = args.in[6]; const float* conv_ln_w = args.in[7]; const float* conv_ln_b = args.in[8];
    const float* w_out = args.in[9]; const float* norm2_w = args.in[10]; const float* router_w = args.in[11]; const float* router_b = args.in[12];
    const float* w1 = args.in[13]; const float* b1 = args.in[14]; const float* w2 = args.in[15]; const float* b2 = args.in[16]; const float* final_norm_w = args.in[17];
    float* out = args.out;
    bf16* WI = (bf16*)(ws + WS_WI); bf16* WO = (bf16*)(ws + WS_WO); bf16* W1T = (bf16*)(ws + WS_W1); bf16* W2T = (bf16*)(ws + WS_W2);
    float* H = (float*)(ws + WS_H); bf16* XN = (bf16*)(ws + WS_XN);
    bf16* Qb = (bf16*)(ws + WS_Q); bf16* KFb = (bf16*)(ws + WS_KF); bf16* KBb = (bf16*)(ws + WS_KB); bf16* Vb = (bf16*)(ws + WS_V); bf16* Gb = (bf16*)(ws + WS_G); bf16* Ub = (bf16*)(ws + WS_U);
    float* LFb = (float*)(ws + WS_LF); float* LBb = (float*)(ws + WS_LB); float* OFb = (float*)(ws + WS_OF); float* OBb = (float*)(ws + WS_OB);
    bf16* MIX = (bf16*)(ws + WS_MIX); bf16* XS = (bf16*)(ws + WS_XS); bf16* ACT = (bf16*)(ws + WS_ACT); bf16* YS = (bf16*)(ws + WS_YS);
    float* WRT = (float*)(ws + WS_WRT); int* SLOT = (int*)(ws + WS_SLOT); float* GATE = (float*)(ws + WS_GATE); int* ROWTOK = (int*)(ws + WS_ROWTOK);
    volatile LAS int* bs = (volatile LAS int*)(lds + TAB_OFF);
    volatile LAS int* cl = (volatile LAS int*)(lds + TAB_OFF + 256);
    LAS int* lcnt = (LAS int*)(lds + TAB_OFF + 512);
    volatile LAS int* gbase = (volatile LAS int*)(lds + TAB_OFF + 768);

    for (int u = tid; u < (LDS_BYTES - LDSCTL_OFF) / 4; u += NTHR) ((LAS unsigned*)(lds + LDSCTL_OFF))[u] = 0u;
    __syncthreads();
    XcdBarrier bar; bar.bar = ctl + CW_BAR; bar.x = 0; bar.st = nullptr;
    if (MK_N_LAUNCHES == 1) bar = xcd_barrier_post(ctl + CW_BAR, MISC + 8);
    const int lo = args.ph_lo, hi = args.ph_hi;
#ifndef PHASE_MASK
#define PHASE_MASK 0xffffffffu
#endif
#define IN(k) ((((PHASE_MASK) >> (k)) & 1u) && lo <= (k) && (k) < hi)
#define SEAM(k) do { if (IN(k) && IN((k) + 1)) xcd_barrier(bar); } while (0)
#define BUILD_BS() do { if (tid == 0) { int a_ = 0; for (int e_ = 0; e_ < NE; ++e_) { bs[e_] = a_; const int c_ = (int)__hip_atomic_load(ctl + CW_CNT + 64 * e_, RLX_AGENT); cl[e_] = c_; a_ += (c_ + 255) >> 8; } bs[NE] = a_; } __syncthreads(); } while (0)

    if (IN(0)) {
        LAS float* scr = (LAS float*)(lds + RING_OFF + wave * 16384);
        constexpr int I_WI = (D / 64) * (INC / 32), I_WO = (D / 64) * (D / 32), I_W1 = (D / 64) * (2 * FF / 32), I_W2 = (FF / 64) * (D / 32);
        constexpr int NITEMS = I_WI + I_WO + NE * I_W1 + NE * I_W2;
        for (int it = gw; it < NITEMS; it += NGW) {
            int r = it;
            if (r < I_WI) { p0_transpose_item(w_in, D, INC, WI, RmWin(), scr, r, lane); continue; } r -= I_WI;
            if (r < I_WO) { p0_transpose_item(w_out, D, D, WO, RmIdent(), scr, r, lane); continue; } r -= I_WO;
            if (r < NE * I_W1) { const int e = r / I_W1; p0_transpose_item(w1 + (size_t)e * D * 2 * FF, D, 2 * FF, W1T + (size_t)e * 2 * FF * D, RmW1(), scr, r - e * I_W1, lane); continue; } r -= NE * I_W1;
            { const int e = r / I_W2; p0_transpose_item(w2 + (size_t)e * FF * D, FF, D, W2T + (size_t)e * D * FF, RmIdent(), scr, r - e * I_W2, lane); }
        }
        for (int m = gw; m < MTOK; m += NGW) rms_row_to_bf16(x + (size_t)m * D, norm1_w, XN + (size_t)m * D, lane);
        for (int i = bx * NTHR + tid; i < NE * D; i += G * NTHR) { const int e = i >> 10, c = i & 1023; WRT[i] = router_w[c * NE + e]; }
    }
    SEAM(0);

    if (IN(1)) {
        pg8::Gemm g{XN, WI, MTOK, INC, D}; pg8::StaticOrder S; S.init(MTOK, INC, G, bx);
        EpiProj E{Qb, KFb, KBb, Vb, Gb, Ub, LFb, LBb, lb_logits};
        pg8::gemm_phase<EpiProj, pg8::StaticOrder, true, true>(lds + RING_OFF, g, S, E);
    }
    SEAM(1);

    if (IN(2)) {
        const bool split = (G == 256);
#if defined(HGRN_NAIVE)
        const bool hsel = true; const int hidx = 0, hstride = 1; const bool csel = true; const int cidx = vcu, cstride = G;
#else
        const bool hsel = split ? (((bx >> 3) & 1) != 0) : true; const int hidx = split ? (bx >> 4) * 8 + (bx & 7) : bx, hstride = split ? 128 : G;
        const bool csel = split ? !hsel : true; const int cidx = split ? (bx >> 4) * 8 + (bx & 7) : bx, cstride = split ? 128 : G;
#endif
        (void)hidx; (void)hstride;
        if (csel) {
            LAS unsigned short* ut = (LAS unsigned short*)(lds + RING_OFF);
            LAS float* part = (LAS float*)(lds + RING_OFF + 98304);
            LAS float* stat = (LAS float*)(lds + RING_OFF + 98304 + 4096);
            for (int unit = cidx; unit < NBATCH * (TT / 64); unit += cstride) {
                const int b = unit / (TT / 64), t0 = (unit % (TT / 64)) * 64;
                for (int idx = tid; idx < 94 * 64; idx += NTHR) {
                    const int r = idx >> 6, p = idx & 63, t = t0 - 15 + r;
                    v4u val = (v4u){0u, 0u, 0u, 0u};
                    if (t >= 0 && t < TT) val = *(const v4u*)(Ub + (size_t)(b * TT + t) * CCH + p * 8);
                    *(LAS v4u*)(ut + r * 512 + p * 8) = val;
                }
                __syncthreads();
                const int c = tid;
                float w[CLEN];
#pragma unroll
                for (int j = 0; j < CLEN; ++j) w[j] = dw_w[j * CCH + c];
                const float bias = dw_b[c];
                float y[64];
#pragma unroll
                for (int tb = 0; tb < 8; ++tb) {
                    float win[38];
#pragma unroll
                    for (int i = 0; i < 38; ++i) win[i] = bf2f(ut[(tb * 8 + i) * 512 + c]);
#pragma unroll
                    for (int o = 0; o < 8; ++o) { float a = bias;
#pragma unroll
                        for (int j = 0; j < CLEN; ++j) a += w[j] * win[o + j];
                        y[tb * 8 + o] = a; }
                }
#pragma unroll 1
                for (int pass = 0; pass < 2; ++pass) {
                    float s1[64];
#pragma unroll
                    for (int i = 0; i < 64; ++i) s1[i] = pass ? y[i] * y[i] : y[i];
#pragma unroll
                    for (int s = 32; s >= 1; s >>= 1) {
                        const bool up = (lane & s) != 0;
#pragma unroll
                        for (int i = 0; i < s; ++i) { const float k1 = up ? s1[i + s] : s1[i], x1 = up ? s1[i] : s1[i + s]; s1[i] = k1 + __shfl_xor(x1, s); }
                    }
                    part[(wave * 64 + lane) * 2 + pass] = s1[0];
                }
                __syncthreads();
                if (tid < 64) { float a = 0.f, q = 0.f;
#pragma unroll
                    for (int wv = 0; wv < 8; ++wv) { a += part[(wv * 64 + tid) * 2]; q += part[(wv * 64 + tid) * 2 + 1]; }
                    const float mean = a * (1.f / CCH), var = q * (1.f / CCH) - mean * mean;
                    stat[tid * 2] = mean; stat[tid * 2 + 1] = rsqrtf(fmaxf(var, 0.f) + EPS); }
                __syncthreads();
                const float lw = conv_ln_w[c], lbias = conv_ln_b[c];
#pragma unroll
                for (int t = 0; t < 64; ++t) {
                    const float v = (y[t] - stat[t * 2]) * stat[t * 2 + 1] * lw + lbias;
                    MIX[(size_t)(b * TT + t0 + t) * D + 512 + c] = (bf16)(pk2(v * sigm(v), 0.f) & 0xffffu);
                }
                __syncthreads();
            }
        }
#if defined(HGRN_NAIVE)
        {
            LAS float* qs = (LAS float*)(lds + RING_OFF); LAS float* ks = qs + 2048; LAS float* fs = ks + 2048; LAS float* vs = fs + 2048; LAS float* op = vs + 2048;
            const int e = tid & 127, dq = tid >> 7;
            for (int unit = G - 1 - bx; unit < NBATCH * NH * 2; unit += G) {
                const int dir = unit & 1, h = (unit >> 1) & 3, b = unit >> 3;
                const bf16* Kp = dir ? KBb : KFb; const float* Lp = dir ? LBb : LFb; float* Op = dir ? OBb : OFb;
                float S[32];
#pragma unroll
                for (int i = 0; i < 32; ++i) S[i] = 0.f;
                for (int blk = 0; blk < TT / 16; ++blk) {
                    const int tb = dir ? (TT - 16 - blk * 16) : blk * 16;
#pragma unroll
                    for (int i = 0; i < 4; ++i) { const int idx = tid + NTHR * i, r = idx >> 7, d = idx & 127; const size_t off = (size_t)(b * TT + tb + r) * 512 + h * 128 + d;
                        qs[idx] = bf2f(Qb[off]); ks[idx] = bf2f(Kp[off]); fs[idx] = __expf(Lp[off]); vs[idx] = bf2f(Vb[off]); }
                    __syncthreads();
                    for (int st = 0; st < 16; ++st) {
                        const int r = dir ? 15 - st : st; const float v = vs[r * 128 + e]; float o = 0.f;
#pragma unroll
                        for (int dd = 0; dd < 32; ++dd) { const int d = dq * 32 + dd; S[dd] = fs[r * 128 + d] * S[dd] + ks[r * 128 + d] * v; o += qs[r * 128 + d] * S[dd]; }
                        op[(r * 4 + dq) * 128 + e] = o;
                    }
                    __syncthreads();
#pragma unroll
                    for (int i = 0; i < 4; ++i) { const int idx = tid + NTHR * i, r = idx >> 7, ee = idx & 127;
                        Op[(size_t)(b * TT + tb + r) * 512 + h * 128 + ee] = (op[(r * 4 + 0) * 128 + ee] + op[(r * 4 + 1) * 128 + ee]) + (op[(r * 4 + 2) * 128 + ee] + op[(r * 4 + 3) * 128 + ee]); }
                }
                __syncthreads();
            }
        }
#else
        if (hsel) for (int unit = hidx; unit < NBATCH * NH * 4; unit += hstride) hgrn_unit(lds + RING_OFF, unit, Qb, KFb, KBb, Vb, LFb, LBb, OFb, OBb, tid, lane, wave);
#endif
    }
    SEAM(2);

    if (IN(3)) {
        for (int m = gw; m < MTOK; m += NGW) {
            const size_t off = (size_t)m * 512 + lane * 8;
            const f32x4 a0 = *(const f32x4*)(OFb + off), a1 = *(const f32x4*)(OFb + off + 4), c0 = *(const f32x4*)(OBb + off), c1 = *(const f32x4*)(OBb + off + 4);
            const f32x4 o0 = a0 + c0, o1 = a1 + c1;
            float ss = (o0.x * o0.x + o0.y * o0.y) + (o0.z * o0.z + o0.w * o0.w) + (o1.x * o1.x + o1.y * o1.y) + (o1.z * o1.z + o1.w * o1.w);
            ss += __shfl_xor(ss, 1); ss += __shfl_xor(ss, 2); ss += __shfl_xor(ss, 4); ss += __shfl_xor(ss, 8);
            const float rstd = rsqrtf(ss * (1.f / DV) + EPS);
            const v4u gv = *(const v4u*)(Gb + off);
            const f32x4 w0 = *(const f32x4*)(hgrn_norm_w + lane * 8), w1v = *(const f32x4*)(hgrn_norm_w + lane * 8 + 4);
            f32x4 r0, r1;
            r0.x = o0.x * rstd * w0.x * bf2f(gv.x & 0xffffu); r0.y = o0.y * rstd * w0.y * bf2f(gv.x >> 16);
            r0.z = o0.z * rstd * w0.z * bf2f(gv.y & 0xffffu); r0.w = o0.w * rstd * w0.w * bf2f(gv.y >> 16);
            r1.x = o1.x * rstd * w1v.x * bf2f(gv.z & 0xffffu); r1.y = o1.y * rstd * w1v.y * bf2f(gv.z >> 16);
            r1.z = o1.z * rstd * w1v.z * bf2f(gv.w & 0xffffu); r1.w = o1.w * rstd * w1v.w * bf2f(gv.w >> 16);
            st8bf(MIX + (size_t)m * D + lane * 8, r0, r1);
        }
    }
    SEAM(3);

    if (IN(4)) {
        pg8::Gemm g{MIX, WO, MTOK, D, D}; pg8::StaticOrder S; S.init(MTOK, D, G, bx);
        EpiRes E{x, H};
        pg8::gemm_phase<EpiRes, pg8::StaticOrder, true, true>(lds + RING_OFF, g, S, E);
    }
    SEAM(4);

    if (IN(5)) {
        LAS float* wl = (LAS float*)(lds + RING_OFF);
        LAS unsigned* sb = (LAS unsigned*)(lds + SB_OFF);
        for (int i = tid; i < NE * D / 4; i += NTHR) ((LAS f32x4*)wl)[i] = ((const f32x4*)WRT)[i];
        if (tid < NE) lcnt[tid] = 0;
        __syncthreads();
        int it = 0;
        for (int m = gw; m < MTOK; m += NGW, ++it) {
            const f32x4* hr = (const f32x4*)(H + (size_t)m * D) + lane; const f32x4* wr = (const f32x4*)norm2_w + lane;
            f32x4 v[4]; float s = 0.f;
#pragma unroll
            for (int j = 0; j < 4; ++j) { v[j] = hr[64 * j]; s += (v[j].x * v[j].x + v[j].y * v[j].y) + (v[j].z * v[j].z + v[j].w * v[j].w); }
            const float rstd = rsqrtf(wave_sum(s) * (1.f / D) + EPS);
            v2u* o8 = (v2u*)(XN + (size_t)m * D) + lane;
#pragma unroll
            for (int j = 0; j < 4; ++j) { const f32x4 g = wr[64 * j]; v[j] = v[j] * rstd * g; v2u o; o.x = pk2(v[j].x, v[j].y); o.y = pk2(v[j].z, v[j].w); o8[64 * j] = o; }
            float a[NE];
#pragma unroll
            for (int e = 0; e < NE; ++e) { float t = 0.f;
#pragma unroll
                for (int j = 0; j < 4; ++j) { const f32x4 wv = ((const LAS f32x4*)wl)[e * 256 + lane + 64 * j]; t += (v[j].x * wv.x + v[j].y * wv.y) + (v[j].z * wv.z + v[j].w * wv.w); }
                a[e] = t; }
#pragma unroll
            for (int s2 = 32, n = 16; n >= 1; s2 >>= 1, n >>= 1) {
                const bool up = (lane & s2) != 0;
#pragma unroll
                for (int i = 0; i < n; ++i) { const float k1 = up ? a[i + n] : a[i], x1 = up ? a[i] : a[i + n]; a[i] = k1 + __shfl_xor(x1, s2); }
            }
            float lg = a[0] + __shfl_xor(a[0], 1);
            const int myE = lane >> 1;
            lg += router_b[myE];
            float tv[TOPK]; int ti[TOPK];
#pragma unroll
            for (int k = 0; k < TOPK; ++k) {
                float mx = lg;
#pragma unroll
                for (int o = 1; o < 64; o <<= 1) mx = fmaxf(mx, __shfl_xor(mx, o));
                int cand = (lg == mx) ? myE : 99;
#pragma unroll
                for (int o = 1; o < 64; o <<= 1) cand = min(cand, __shfl_xor(cand, o));
                tv[k] = mx; ti[k] = cand;
                if (myE == cand) lg = -INFINITY;
            }
            const float e1 = __expf(tv[1] - tv[0]), e2 = __expf(tv[2] - tv[0]), e3 = __expf(tv[3] - tv[0]);
            const float inv = 1.0f / (1.0f + e1 + e2 + e3);
            if (lane < TOPK) {
                const int ek = lane == 0 ? ti[0] : lane == 1 ? ti[1] : lane == 2 ? ti[2] : ti[3];
                const float gk = (lane == 0 ? 1.0f : lane == 1 ? e1 : lane == 2 ? e2 : e3) * inv;
                const int lr = __hip_atomic_fetch_add(&lcnt[ek], 1, __ATOMIC_RELAXED, __HIP_MEMORY_SCOPE_WORKGROUP);
                sb[(wave * 64 + it) * 4 + lane] = ((unsigned)ek << 16) | (unsigned)lr;
                GATE[(size_t)m * TOPK + lane] = gk;
            }
        }
        __syncthreads();
        if (tid < NE) { const int c = lcnt[tid]; gbase[tid] = c ? (int)__hip_atomic_fetch_add(ctl + CW_CNT + 64 * tid, (unsigned)c, RLX_AGENT) : 0; }
        __syncthreads();
        it = 0;
        for (int m = gw; m < MTOK; m += NGW, ++it) {
            if (lane < TOPK) { const unsigned w = sb[(wave * 64 + it) * 4 + lane]; const int ek = (int)(w >> 16), r = gbase[ek] + (int)(w & 0xffffu);
                ROWTOK[ek * MTOK + r] = m; SLOT[(size_t)m * TOPK + lane] = ek * MTOK + r; }
        }
    }
    SEAM(5);

    if (IN(6)) {
        BUILD_BS();
        const int nrows = bs[NE] * 256;
        for (int r = gw; r < nrows; r += NGW) {
            const int mb = r >> 8; int e = 0;
            while (e < NE - 1 && bs[e + 1] <= mb) ++e;
            const int rank = r - bs[e] * 256;
            v4u a = (v4u){0u, 0u, 0u, 0u}, c = a;
            if (rank < cl[e]) { const int tok = ROWTOK[e * MTOK + rank]; const v4u* src = (const v4u*)(XN + (size_t)tok * D); a = src[lane]; c = src[lane + 64]; }
            v4u* dst = (v4u*)(XS + (size_t)r * D); dst[lane] = a; dst[lane + 64] = c;
        }
    }
    SEAM(6);

    if (IN(7)) {
        BUILD_BS();
        pg8::Gemm g{XS, W1T, MOE_ROWS, 2 * FF, D}; MoeOrder S{bs, 8, G, vcu};
        EpiSwiglu E{ACT, b1};
        pg8::gemm_phase<EpiSwiglu, MoeOrder, true, true>(lds + RING_OFF, g, S, E);
    }
    SEAM(7);

    if (IN(8)) {
        BUILD_BS();
        pg8::Gemm g{ACT, W2T, MOE_ROWS, D, FF}; MoeOrder S{bs, 4, G, vcu};
        EpiDown E{YS, b2};
        pg8::gemm_phase<EpiDown, MoeOrder, true, true>(lds + RING_OFF, g, S, E);
    }
    SEAM(8);

    if (IN(9)) {
        BUILD_BS();
        for (int m = gw; m < MTOK; m += NGW) {
            const f32x4* hr = (const f32x4*)(H + (size_t)m * D) + lane; const f32x4* wr = (const f32x4*)final_norm_w + lane;
            f32x4 v[4];
#pragma unroll
            for (int j = 0; j < 4; ++j) v[j] = hr[64 * j];
#pragma unroll
            for (int k = 0; k < TOPK; ++k) {
                const int sl = SLOT[(size_t)m * TOPK + k]; const float gk = GATE[(size_t)m * TOPK + k];
                const int e = sl >> 14, pos = bs[e] * 256 + (sl & (MTOK - 1));
                const v2u* yr = (const v2u*)(YS + (size_t)pos * D) + lane;
#pragma unroll
                for (int j = 0; j < 4; ++j) { const v2u w = yr[64 * j];
                    v[j].x += gk * bf2f(w.x & 0xffffu); v[j].y += gk * bf2f(w.x >> 16); v[j].z += gk * bf2f(w.y & 0xffffu); v[j].w += gk * bf2f(w.y >> 16); }
            }
            float s = 0.f;
#pragma unroll
            for (int j = 0; j < 4; ++j) s += (v[j].x * v[j].x + v[j].y * v[j].y) + (v[j].z * v[j].z + v[j].w * v[j].w);
            const float rstd = rsqrtf(wave_sum(s) * (1.f / D) + EPS);
            f32x4* orow = (f32x4*)(out + (size_t)m * D) + lane;
#pragma unroll
            for (int j = 0; j < 4; ++j) orow[64 * j] = v[j] * rstd * wr[64 * j];
        }
    }
#undef IN
#undef SEAM
#undef BUILD_BS
}

extern "C" void kernel_launch(void* const* d_in, const int* in_sizes, int n_in, void* d_out, int out_size, void* d_ws, size_t ws_size, hipStream_t stream) {
    static int grid = 0;
    if (grid == 0) {
        if (n_in != 18 || in_sizes[0] != MTOK * D || out_size != MTOK * D || ws_size < WS_END) { fprintf(stderr, "kernel_launch: unexpected shapes (n_in %d, in0 %d, out %d, ws %zu < %zu); nothing launched\n", n_in, n_in > 0 ? in_sizes[0] : -1, out_size, ws_size, (size_t)WS_END); grid = -1; return; }
        int dev = 0, cus = 0, per_cu = 0;
        if (hipGetDevice(&dev) != hipSuccess || hipDeviceGetAttribute(&cus, hipDeviceAttributeMultiprocessorCount, dev) != hipSuccess) { fprintf(stderr, "kernel_launch: device query failed\n"); grid = -1; return; }
        if (hipFuncSetAttribute((const void*)fwd_kernel, hipFuncAttributeMaxDynamicSharedMemorySize, LDS_BYTES) != hipSuccess) { fprintf(stderr, "kernel_launch: hipFuncSetAttribute failed\n"); grid = -1; return; }
        if (hipOccupancyMaxActiveBlocksPerMultiprocessor(&per_cu, (const void*)fwd_kernel, NTHR, LDS_BYTES) != hipSuccess || per_cu < 1)
            fprintf(stderr, "kernel_launch: note: occupancy query reports %d workgroups per CU\n", per_cu);
        (void)hipGetLastError();
        grid = cus;
    }
    if (grid < 0) return;
    if (hipMemsetAsync((char*)d_ws + WS_CTL, 0, CTL_ZERO_BYTES, stream) != hipSuccess) { fprintf(stderr, "kernel_launch: memset failed\n"); return; }
    Args a{};
    for (int i = 0; i < 18; ++i) a.in[i] = (const float*)d_in[i];
    a.out = (float*)d_out; a.ws = (unsigned char*)d_ws;
#if MK_N_LAUNCHES == 1
    a.ph_lo = 0; a.ph_hi = N_PHASES;
    hipLaunchKernelGGL(fwd_kernel, dim3(grid), dim3(NTHR), LDS_BYTES, stream, a);
#else
    for (int ph = 0; ph < N_PHASES; ++ph) { a.ph_lo = ph; a.ph_hi = ph + 1; hipLaunchKernelGGL(fwd_kernel, dim3(grid), dim3(NTHR), LDS_BYTES, stream, a); }
#endif
    const hipError_t le = hipPeekAtLastError();
    if (le != hipSuccess) fprintf(stderr, "kernel_launch: launch failed: %s\n", hipGetErrorName(le));
}
```

```cpp
#include <hip/hip_runtime.h>
#include <cstdio>
#include <cstdint>
namespace pg8 {
#define PG8_LAS __attribute__((address_space(3)))
typedef unsigned short bf16_t;
typedef short bf16x8 __attribute__((ext_vector_type(8)));
typedef float f32x4 __attribute__((ext_vector_type(4)));
typedef unsigned u32x4 __attribute__((ext_vector_type(4)));
constexpr int BM = 256, BK = 64, HALF = 128, HTB = HALF * BK * 2  , STAGE_BYTES = 8 * HTB, NXCD = 8, WGM = 8;

__host__ __device__ __forceinline__ int lds_byte(int r, int c) { const int st = (r >> 4) * 2 + (c >> 5), rr = r & 15, cc = c & 31, ob = rr * 64 + cc * 2; return st * 1024 + (ob ^ (((ob >> 9) & 1) << 5)); }
__host__ __device__ __forceinline__ void stage_rc(int b, int& R, int& C) { const int st = b / 1024, sb = b % 1024, swz = sb ^ (((sb >> 9) & 1) << 5); R = (st >> 1) * 16 + swz / 64; C = (st & 1) * 32 + (swz % 64) / 2; }
__host__ __device__ __forceinline__ int perm32(int rho) { const int n = rho >> 4, i = rho & 15; return 8 * (i >> 2) + 4 * n + (i & 3); }

struct Unit { int pm, pn; };
struct Gemm { const bf16_t* A; const bf16_t* Bt; int M, N, K; };

struct StaticOrder {
    int nM, nN, nwg, G, c;
    __host__ __device__ void init(int M, int N, int G_, int c_) { nM = M / BM; nN = N / BM; nwg = nM * nN; G = G_; c = c_; }
    __host__ __device__ bool next(int i, Unit& u) const {
        const long L = (long)i * G + c; if (L >= nwg) return false;
        int wgid = (int)L; { const int q = nwg / NXCD, r = nwg % NXCD, xcd = wgid % NXCD, off = wgid / NXCD; wgid = (xcd < r ? xcd * (q + 1) : r * (q + 1) + (xcd - r) * q) + off; }
        const int nig = WGM * nN, gid = wgid / nig, fm = gid * WGM, gsz = (nM - fm) < WGM ? (nM - fm) : WGM;
        u.pm = fm + ((wgid % nig) % gsz); u.pn = (wgid % nig) / gsz; return true;
    }
    __device__ __forceinline__ void a_ready(const Unit&) const {}
    __device__ __forceinline__ void done(const Unit&) const {}
};
__device__ __forceinline__ unsigned cvt_pk_bf16(float lo, float hi) { unsigned r; asm volatile("v_cvt_pk_bf16_f32 %0, %1, %2" : "=v"(r) : "v"(lo), "v"(hi)); return r; }
typedef float f32x2 __attribute__((ext_vector_type(2)));
template <class Epi, class Sched, bool ALIGN_EPI = false, bool SP2 = false>
__device__ __forceinline__ void gemm_phase(PG8_LAS unsigned char* lds, const Gemm g, const Sched& S, const Epi& E) {
    const int tid = threadIdx.x, wid = __builtin_amdgcn_readfirstlane(tid >> 6), lane = tid & 63, wr = wid >> 2, wc = wid & 3, fr = lane & 15, fq = lane >> 4;
    const int K = g.K, nt = K / BK;
    unsigned voffA[2], voffB[2];
#pragma unroll
    for (int i = 0; i < 2; ++i) { int R, C; stage_rc(tid * 16 + i * 8192, R, C); const int Rb = Epi::PERM ? ((R & ~31) + perm32(R & 31)) : R;
        voffA[i] = (unsigned)(R * K + C) * 2u; voffB[i] = (unsigned)(Rb * K + C) * 2u; }
    const size_t kstep = (size_t)(BK * 2);
    const size_t hstep = (size_t)HALF * K * 2;
    const size_t tstep = 2 * hstep;
    const unsigned ldsw = (unsigned)wid * 1024u;
    const int aoff = lds_byte(wr * 64 + fr, fq * 8), boff = lds_byte(wc * 32 + fr, fq * 8);
#define PG8_SA(b, h) (((b) * 2 + (h)) * HTB)
#define PG8_SB(b, h) ((4 + (b) * 2 + (h)) * HTB)
#define PG8_STAGE(bufoff, gbase, voff) do { _Pragma("unroll") for (int _i = 0; _i < 2; ++_i) \
        __builtin_amdgcn_global_load_lds((const unsigned*)((const char*)(gbase) + (voff)[_i]), (PG8_LAS unsigned*)(lds + (bufoff) + ldsw + _i * 8192), 16, 0, 0); } while (0)
#define PG8_LDA(dst, b, h) do { _Pragma("unroll") for (int m = 0; m < 4; ++m) _Pragma("unroll") for (int k = 0; k < 2; ++k) dst[m][k] = *(const PG8_LAS bf16x8*)(lds + PG8_SA(b, h) + aoff + m * 2048 + k * 1024); } while (0)
#define PG8_LDB(dst, b, h) do { _Pragma("unroll") for (int n = 0; n < 2; ++n) _Pragma("unroll") for (int k = 0; k < 2; ++k) dst[n][k] = *(const PG8_LAS bf16x8*)(lds + PG8_SB(b, h) + boff + n * 2048 + k * 1024); } while (0)
#define PG8_MMA(ai, bj, At, Bt) do { __builtin_amdgcn_s_setprio(1); _Pragma("unroll") for (int m = 0; m < 4; ++m) _Pragma("unroll") for (int n = 0; n < 2; ++n) _Pragma("unroll") for (int k = 0; k < 2; ++k) \
        acc[ai][bj][m][n] = __builtin_amdgcn_mfma_f32_16x16x32_bf16(Bt[n][k], At[m][k], acc[ai][bj][m][n], 0, 0, 0); __builtin_amdgcn_s_setprio(0); } while (0)
#define PG8_WAIT_V(n) asm volatile("s_waitcnt vmcnt(" #n ")" ::: "memory")
#define PG8_WAIT_L(n) asm volatile("s_waitcnt lgkmcnt(" #n ")" ::: "memory")
#define PG8_BAR __builtin_amdgcn_s_barrier()
#define PG8_SCHED __builtin_amdgcn_sched_barrier(0)
    Unit cur, nxt; int ui = 0;
    if (!S.next(0, cur)) return;
    f32x4 acc[2][2][4][2];
#pragma unroll
    for (int a = 0; a < 2; ++a)
#pragma unroll
        for (int b = 0; b < 2; ++b)
#pragma unroll
            for (int m = 0; m < 4; ++m)
#pragma unroll
                for (int n = 0; n < 2; ++n) acc[a][b][m][n] = (f32x4){0.f, 0.f, 0.f, 0.f};
    bf16x8 At[4][2], B0[2][2], B1[2][2];
    const char* cA = (const char*)g.A + (size_t)cur.pm * tstep; const char* cB = (const char*)g.Bt + (size_t)cur.pn * tstep;
    S.a_ready(cur);
    if constexpr (SP2) {
        PG8_STAGE(PG8_SB(0, 0), cB, voffB); PG8_STAGE(PG8_SB(0, 1), cB + hstep, voffB); PG8_STAGE(PG8_SA(0, 0), cA, voffA); PG8_STAGE(PG8_SA(0, 1), cA + hstep, voffA);
        if (wr == 1) PG8_BAR;
        PG8_WAIT_V(2); PG8_BAR;
        PG8_STAGE(PG8_SB(1, 0), cB + kstep, voffB); PG8_STAGE(PG8_SA(1, 0), cA + kstep, voffA); PG8_STAGE(PG8_SB(1, 1), cB + hstep + kstep, voffB);
        PG8_WAIT_V(6); PG8_BAR;
    } else {
        PG8_STAGE(PG8_SB(0, 0), cB, voffB); PG8_STAGE(PG8_SA(0, 0), cA, voffA); PG8_STAGE(PG8_SB(0, 1), cB + hstep, voffB); PG8_STAGE(PG8_SA(0, 1), cA + hstep, voffA);
        if (wr == 1) PG8_BAR;
        PG8_WAIT_V(4); PG8_BAR;
        PG8_STAGE(PG8_SB(1, 0), cB + kstep, voffB); PG8_STAGE(PG8_SA(1, 0), cA + kstep, voffA); PG8_STAGE(PG8_SB(1, 1), cB + hstep + kstep, voffB);
        PG8_WAIT_V(6); PG8_BAR;
    }
    for (;;) {
        const bool has_next = S.next(ui + 1, nxt);
        const char* nA = has_next ? (const char*)g.A + (size_t)nxt.pm * tstep : cA; const char* nB = has_next ? (const char*)g.Bt + (size_t)nxt.pn * tstep : cB;
        for (int t = 0; t < nt; t += 2) {
            const bool last = (t == nt - 2);
            const char* a1 = cA + (size_t)(t + 1) * kstep;
            const char* a2 = last ? nA : cA + (size_t)(t + 2) * kstep; const char* b2 = last ? nB : cB + (size_t)(t + 2) * kstep;
            const char* a3 = a2 + kstep; const char* b3 = b2 + kstep;
            if (last && has_next) S.a_ready(nxt);
            if constexpr (SP2) {
            PG8_LDB(B0, 0, 0); PG8_LDB(B1, 0, 1); PG8_SCHED; PG8_LDA(At, 0, 0); PG8_STAGE(PG8_SA(1, 1), a1 + hstep, voffA);
            PG8_WAIT_V(8); PG8_WAIT_L(0); PG8_BAR; PG8_MMA(0, 0, At, B0); PG8_MMA(0, 1, At, B1); PG8_BAR; PG8_SCHED;
            PG8_LDA(At, 0, 1); PG8_STAGE(PG8_SB(0, 0), b2, voffB); PG8_STAGE(PG8_SB(0, 1), b2 + hstep, voffB); PG8_STAGE(PG8_SA(0, 0), a2, voffA);
            PG8_WAIT_V(8); PG8_WAIT_L(0); PG8_BAR; PG8_MMA(1, 0, At, B0); PG8_MMA(1, 1, At, B1); PG8_BAR; PG8_SCHED;
            PG8_LDB(B0, 1, 0); PG8_LDB(B1, 1, 1); PG8_SCHED; PG8_LDA(At, 1, 0); PG8_STAGE(PG8_SA(0, 1), a2 + hstep, voffA);
            PG8_WAIT_V(8); PG8_WAIT_L(0); PG8_BAR; PG8_MMA(0, 0, At, B0); PG8_MMA(0, 1, At, B1); PG8_BAR; PG8_SCHED;
            PG8_LDA(At, 1, 1); PG8_STAGE(PG8_SB(1, 0), b3, voffB); PG8_STAGE(PG8_SB(1, 1), b3 + hstep, voffB); PG8_STAGE(PG8_SA(1, 0), a3, voffA);
            PG8_WAIT_V(8); PG8_WAIT_L(0); PG8_BAR; PG8_MMA(1, 0, At, B0); PG8_MMA(1, 1, At, B1); PG8_BAR; PG8_SCHED;
            } else {
            PG8_LDB(B0, 0, 0); PG8_SCHED; PG8_LDA(At, 0, 0); PG8_STAGE(PG8_SA(1, 1), a1 + hstep, voffA);
            PG8_WAIT_L(8); PG8_BAR; PG8_WAIT_L(0); PG8_MMA(0, 0, At, B0); PG8_BAR; PG8_SCHED;
            PG8_LDB(B1, 0, 1); PG8_STAGE(PG8_SB(0, 0), b2, voffB);
            PG8_BAR; PG8_WAIT_L(0); PG8_MMA(0, 1, At, B1); PG8_BAR;
            PG8_LDA(At, 0, 1); PG8_STAGE(PG8_SA(0, 0), a2, voffA);
            PG8_BAR; PG8_WAIT_L(0); PG8_MMA(1, 0, At, B0); PG8_BAR; PG8_SCHED;
            PG8_STAGE(PG8_SB(0, 1), b2 + hstep, voffB);
            PG8_WAIT_V(6); PG8_BAR; PG8_MMA(1, 1, At, B1); PG8_BAR;
            PG8_LDB(B0, 1, 0); PG8_SCHED; PG8_LDA(At, 1, 0); PG8_STAGE(PG8_SA(0, 1), a2 + hstep, voffA);
            PG8_WAIT_L(8); PG8_BAR; PG8_WAIT_L(0); PG8_MMA(0, 0, At, B0); PG8_BAR; PG8_SCHED;
            PG8_LDB(B1, 1, 1); PG8_STAGE(PG8_SB(1, 0), b3, voffB);
            PG8_BAR; PG8_WAIT_L(0); PG8_MMA(0, 1, At, B1); PG8_BAR;
            PG8_LDA(At, 1, 1); PG8_STAGE(PG8_SA(1, 0), a3, voffA);
            PG8_BAR; PG8_WAIT_L(0); PG8_MMA(1, 0, At, B0); PG8_BAR; PG8_SCHED;
            PG8_STAGE(PG8_SB(1, 1), b3 + hstep, voffB);
            PG8_WAIT_V(6); PG8_BAR; PG8_MMA(1, 1, At, B1); PG8_BAR;
            }
        }
        if constexpr (ALIGN_EPI) { if (wr == 0) PG8_BAR; }
        if constexpr (!Epi::AFTER_DRAIN) { E(acc, cur, wr, wc, fr, fq); S.done(cur); }
        if (!has_next) break;
#pragma unroll
        for (int a = 0; a < 2; ++a)
#pragma unroll
            for (int b = 0; b < 2; ++b)
#pragma unroll
                for (int m = 0; m < 4; ++m)
#pragma unroll
                    for (int n = 0; n < 2; ++n) acc[a][b][m][n] = (f32x4){0.f, 0.f, 0.f, 0.f};
        cur = nxt; cA = nA; cB = nB; ++ui;
        if constexpr (ALIGN_EPI) { if (wr == 1) PG8_BAR; }
    }
    PG8_WAIT_V(0);
    if constexpr (!ALIGN_EPI) { if (wr == 0) PG8_BAR; }
    PG8_BAR;
    if constexpr (Epi::AFTER_DRAIN) { E.fused(acc, cur, wr, wc, fr, fq, lds, wid, lane); S.done(cur); }
#undef PG8_SA
#undef PG8_SB
#undef PG8_STAGE
#undef PG8_LDA
#undef PG8_LDB
#undef PG8_MMA
#undef PG8_WAIT_V
#undef PG8_WAIT_L
#undef PG8_BAR
#undef PG8_SCHED
}
}

#ifndef MK_N_LAUNCHES
#define MK_N_LAUNCHES 1
#endif
constexpr int N_PHASES = 10;
constexpr int NBATCH = 8, TT = 2048, MTOK = NBATCH * TT, D = 1024;
constexpr int HK = 512, NH = 4, DK = 128, DV = 128, CCH = 512, CLEN = 31, INC = 3584;
constexpr int NE = 32, TOPK = 4, FF = 1024;
constexpr float EPS = 1e-5f, SW_LIMIT = 7.0f, SW_ALPHA = 1.702f;
constexpr int NWAVES = 8, NTHR = 512;
constexpr int MOE_ROWS = (MTOK * TOPK / 256 + NE) * 256;

constexpr size_t MiB = 1u << 20;
constexpr size_t WS_CTL = 0, CTL_ZERO_BYTES = 1 * MiB;
constexpr size_t WS_WI = 1 * MiB;
constexpr size_t WS_WO = 8 * MiB;
constexpr size_t WS_TAB = 10 * MiB;
constexpr size_t WS_W1 = 16 * MiB;
constexpr size_t WS_W2 = 144 * MiB;
constexpr size_t WS_H = 208 * MiB;
constexpr size_t WS_XN = 272 * MiB;
constexpr size_t WS_Q = 304 * MiB, WS_KF = 320 * MiB, WS_KB = 336 * MiB, WS_V = 352 * MiB, WS_G = 368 * MiB, WS_U = 384 * MiB;
constexpr size_t WS_LF = 400 * MiB, WS_LB = 432 * MiB;
constexpr size_t WS_OF = 464 * MiB, WS_OB = 496 * MiB;
constexpr size_t WS_MIX = 528 * MiB;
constexpr size_t WS_XS = 304 * MiB;
constexpr size_t WS_ACT = 448 * MiB;
constexpr size_t WS_YS = 592 * MiB;
constexpr size_t WS_END = 736 * MiB;
constexpr size_t WS_WRT = WS_TAB;
constexpr size_t WS_SLOT = WS_TAB + 256 * 1024;
constexpr size_t WS_GATE = WS_TAB + 512 * 1024;
constexpr size_t WS_ROWTOK = WS_TAB + 1 * MiB;
constexpr int CW_BAR = 4096;
constexpr int CW_CNT = 16384;

constexpr int RING_OFF = 0, RING_BYTES = 131072;
constexpr int LDSCTL_OFF = RING_BYTES;
constexpr int MISC_OFF = LDSCTL_OFF + 320;
constexpr int TAB_OFF = LDSCTL_OFF + 1024;
constexpr int SB_OFF = LDSCTL_OFF + 2048;
constexpr int LDS_BYTES = 147456;

#define GAS __attribute__((address_space(1)))
#define LAS __attribute__((address_space(3)))
typedef unsigned short bf16;
typedef unsigned v4u __attribute__((ext_vector_type(4)));
typedef unsigned v2u __attribute__((ext_vector_type(2)));
typedef float f32x4 __attribute__((ext_vector_type(4)));
typedef GAS unsigned gu32;
#define RLX_AGENT __ATOMIC_RELAXED, __HIP_MEMORY_SCOPE_AGENT
#define LDS_WAIT() asm volatile("s_waitcnt lgkmcnt(0)" ::: "memory")
#define VM_WAIT() asm volatile("s_waitcnt vmcnt(0)" ::: "memory")

__device__ __forceinline__ float bf2f(unsigned b) { return __uint_as_float(b << 16); }
__device__ __forceinline__ unsigned pk2(float lo, float hi) { return pg8::cvt_pk_bf16(lo, hi); }
__device__ __forceinline__ float sigm(float x) { return __builtin_amdgcn_rcpf(1.0f + __expf(-x)); }
__device__ __forceinline__ float wave_sum(float v) {
#pragma unroll
    for (int o = 1; o < 64; o <<= 1) v += __shfl_xor(v, o);
    return v;
}

#define XB_TMO      128
#define XB_XCNT(j)  (256  + 64 * (j))
#define XB_XSUB(j)  (1280 + 64 * (j))
#define XB_XGEN(j)  (2304 + 64 * (j))
#define XB_TOP      3328
#define XB_TOPGEN   3392
#define XCD_BAR_WORDS 3456
#define XB_SPIN_CAP (1u << 18)

__device__ __forceinline__ unsigned xb_ld(unsigned* p)              { return __hip_atomic_load(p, __ATOMIC_RELAXED, __HIP_MEMORY_SCOPE_AGENT); }
__device__ __forceinline__ unsigned xb_add(unsigned* p, unsigned v) { return __hip_atomic_fetch_add(p, v, __ATOMIC_RELAXED, __HIP_MEMORY_SCOPE_AGENT); }
__device__ __forceinline__ unsigned xb_xcc_id() { return (unsigned)__builtin_amdgcn_s_getreg((3 << 11) | 20) & 0xFu; }
#define XB_SPIN(cond, bar) do { unsigned _sp = 0; while (cond) { __builtin_amdgcn_s_sleep(1); \
    if ((++_sp & 255u) == 0u) { if (xb_ld(&(bar)[XB_TMO])) break; if (_sp > XB_SPIN_CAP) { atomicAdd(&(bar)[XB_TMO], 1u); break; } } } } while (0)

struct XcdBarrier {
    unsigned* bar; unsigned x;
    volatile LAS unsigned* st;
};
__device__ __forceinline__ XcdBarrier xcd_barrier_post(unsigned* bar, volatile LAS unsigned* st) {
    XcdBarrier b; b.bar = bar; b.x = xb_xcc_id(); b.st = st;
    if (threadIdx.x == 0) (void)xb_add(&bar[XB_XCNT(b.x)], 1u);
    return b;
}
__device__ __forceinline__ void xcd_barrier_complete(unsigned* bar, unsigned x, unsigned& nloc, unsigned& nx) {
    const unsigned G = gridDim.x * gridDim.y * gridDim.z;
    unsigned sum, cnt, mine, sp = 0u;
    for (;;) {
        sum = 0u; cnt = 0u; mine = 0u;
#pragma unroll
        for (unsigned j = 0; j < 16; ++j) { const unsigned c = xb_ld(&bar[XB_XCNT(j)]); sum += c; cnt += (c > 0u) ? 1u : 0u; mine = (j == x) ? c : mine; }
        if (sum == G) break;
        __builtin_amdgcn_s_sleep(1);
        if ((++sp & 255u) == 0u) { if (xb_ld(&bar[XB_TMO])) break; if (sp > XB_SPIN_CAP) { atomicAdd(&bar[XB_TMO], 1u); break; } }
    }
    nloc = mine > 0u ? mine : 1u; nx = cnt > 0u ? cnt : 1u;
}
__device__ __forceinline__ void xcd_barrier(const XcdBarrier& b) {
    asm volatile("s_waitcnt vmcnt(0)" ::: "memory");
    __syncthreads();
    if (threadIdx.x == 0) {
        unsigned* bar = b.bar;
        __builtin_amdgcn_s_waitcnt(0);
        unsigned nloc = b.st[0], nx = b.st[1];
        if (nloc == 0u) { xcd_barrier_complete(bar, b.x, nloc, nx); b.st[0] = nloc; b.st[1] = nx; }
        const unsigned old = xb_add(&bar[XB_XSUB(b.x)], 1u);
        const unsigned gen = old / nloc;
        if (old + 1u == (gen + 1u) * nloc) {
            __builtin_amdgcn_fence(__ATOMIC_RELEASE, "agent");
            asm volatile("s_waitcnt vmcnt(0)" ::: "memory");
            const unsigned og = xb_add(&bar[XB_TOP], 1u);
            const unsigned tg = og / nx;
            if (og + 1u == (tg + 1u) * nx) xb_add(&bar[XB_TOPGEN], 1u);
            else XB_SPIN(xb_ld(&bar[XB_TOPGEN]) == tg, bar);
            __builtin_amdgcn_fence(__ATOMIC_ACQUIRE, "agent");
            xb_add(&bar[XB_XGEN(b.x)], 1u);
            asm volatile("s_waitcnt vmcnt(0)" ::: "memory");
        } else {
            XB_SPIN(xb_ld(&bar[XB_XGEN(b.x)]) == gen, bar);
            __builtin_amdgcn_fence(__ATOMIC_ACQUIRE, "agent");
            asm volatile("s_waitcnt vmcnt(0)" ::: "memory");
        }
    }
    __syncthreads();
}

__device__ __forceinline__ void st8bf(bf16* p, const f32x4& a, const f32x4& b) {
    v4u w; w.x = pk2(a[0], a[1]); w.y = pk2(a[2], a[3]); w.z = pk2(b[0], b[1]); w.w = pk2(b[2], b[3]);
    *(v4u*)p = w;
}
struct EpiProj {
    static constexpr bool PERM = true, AFTER_DRAIN = false;
    bf16 *Q, *KF, *KB, *V, *G, *U; float *LF, *LB; const float* lbl;
    template <int TYP>
    __device__ __forceinline__ void tile(const pg8::f32x4 (&acc)[2][2][4][2], int row0, int cb) const {
#pragma unroll
        for (int bj = 0; bj < 2; ++bj) {
            const int col = cb + bj * 128;
            float lb[8];
            if (TYP == 1 || TYP == 2) {
                const float* L = lbl + (TYP - 1) * 1024 + col;
#pragma unroll
                for (int i = 0; i < 8; ++i) lb[i] = __builtin_amdgcn_rcpf(1.0f + __expf(L[512 + i] - L[i]));
            }
#pragma unroll
            for (int ai = 0; ai < 2; ++ai)
#pragma unroll
                for (int m = 0; m < 4; ++m) {
                    const size_t off = (size_t)(row0 + ai * 128 + m * 16) * 512 + col;
                    f32x4 a = acc[ai][bj][m][0], b = acc[ai][bj][m][1];
                    if (TYP == 0 || TYP == 4) {
#pragma unroll
                        for (int i = 0; i < 4; ++i) { a[i] = a[i] * sigm(a[i]); b[i] = b[i] * sigm(b[i]); }
                        st8bf((TYP == 0 ? Q : G) + off, a, b);
                    } else if (TYP == 3) {
                        st8bf(V + off, a, b);
                    } else {
                        f32x4 la, lbv, ka, kb;
#pragma unroll
                        for (int i = 0; i < 4; ++i) {
                            const float fa = lb[i] + (1.0f - lb[i]) * sigm(a[i]), fb = lb[4 + i] + (1.0f - lb[4 + i]) * sigm(b[i]);
                            la[i] = __logf(fa); lbv[i] = __logf(fb); ka[i] = 1.0f - fa; kb[i] = 1.0f - fb;
                        }
                        float* Lp = (TYP == 1 ? LF : LB) + off;
                        *(f32x4*)Lp = la; *(f32x4*)(Lp + 4) = lbv;
                        st8bf((TYP == 1 ? KF : KB) + off, ka, kb);
                    }
                }
        }
    }
    __device__ __forceinline__ void operator()(const pg8::f32x4 (&acc)[2][2][4][2], const pg8::Unit& u, int wr, int wc, int fr, int fq) const {
        const int row0 = u.pm * 256 + wr * 64 + fr, pn = u.pn;
        if (pn >= 10) {
            const int col = (pn - 10) * 128 + wc * 32 + 8 * fq;
#pragma unroll
            for (int ai = 0; ai < 2; ++ai)
#pragma unroll
                for (int m = 0; m < 4; ++m) {
                    f32x4 a = acc[ai][0][m][0], b = acc[ai][0][m][1]; const f32x4 ga = acc[ai][1][m][0], gb = acc[ai][1][m][1];
#pragma unroll
                    for (int i = 0; i < 4; ++i) { a[i] = a[i] * sigm(ga[i]); b[i] = b[i] * sigm(gb[i]); }
                    st8bf(U + (size_t)(row0 + ai * 128 + m * 16) * 512 + col, a, b);
                }
        } else {
            const int cb = (pn & 1) * 256 + wc * 32 + 8 * fq, typ = pn >> 1;
            if (typ == 0) tile<0>(acc, row0, cb);
            else if (typ == 1) tile<1>(acc, row0, cb);
            else if (typ == 2) tile<2>(acc, row0, cb);
            else if (typ == 3) tile<3>(acc, row0, cb);
            else tile<4>(acc, row0, cb);
        }
    }
};
struct EpiRes {
    static constexpr bool PERM = false, AFTER_DRAIN = false;
    const float* X; float* H;
    __device__ __forceinline__ void operator()(const pg8::f32x4 (&acc)[2][2][4][2], const pg8::Unit& u, int wr, int wc, int fr, int fq) const {
        const int row0 = u.pm * 256 + wr * 64 + fr, col0 = u.pn * 256 + wc * 32 + 4 * fq;
#pragma unroll
        for (int ai = 0; ai < 2; ++ai)
#pragma unroll
            for (int m = 0; m < 4; ++m) {
                const size_t off = (size_t)(row0 + ai * 128 + m * 16) * D + col0;
#pragma unroll
                for (int bj = 0; bj < 2; ++bj)
#pragma unroll
                    for (int n = 0; n < 2; ++n) { const f32x4 xv = *(const f32x4*)(X + off + bj * 128 + n * 16); *(f32x4*)(H + off + bj * 128 + n * 16) = xv + acc[ai][bj][m][n]; }
            }
    }
};
struct EpiSwiglu {
    static constexpr bool PERM = true, AFTER_DRAIN = false;
    bf16* ACT; const float* b1;
    __device__ __forceinline__ void operator()(const pg8::f32x4 (&acc)[2][2][4][2], const pg8::Unit& u, int wr, int wc, int fr, int fq) const {
        const int e = u.pn >> 3, pn = u.pn & 7, row0 = u.pm * 256 + wr * 64 + fr, col = pn * 128 + wc * 32 + 8 * fq;
        const float* bg = b1 + (size_t)e * 2048 + col; const float* bl = bg + 1024;
        float g[8], l[8];
#pragma unroll
        for (int i = 0; i < 8; ++i) { g[i] = bg[i]; l[i] = bl[i]; }
#pragma unroll
        for (int ai = 0; ai < 2; ++ai)
#pragma unroll
            for (int m = 0; m < 4; ++m) {
                f32x4 o[2];
#pragma unroll
                for (int n = 0; n < 2; ++n)
#pragma unroll
                    for (int i = 0; i < 4; ++i) {
                        const float hg = fminf(acc[ai][0][m][n][i] + g[4 * n + i], SW_LIMIT);
                        const float hl = fminf(fmaxf(acc[ai][1][m][n][i] + l[4 * n + i], -SW_LIMIT), SW_LIMIT);
                        o[n][i] = hg * sigm(SW_ALPHA * hg) * (hl + 1.0f);
                    }
                st8bf(ACT + (size_t)(row0 + ai * 128 + m * 16) * FF + col, o[0], o[1]);
            }
    }
};
struct EpiDown {
    static constexpr bool PERM = true, AFTER_DRAIN = false;
    bf16* YS; const float* b2;
    __device__ __forceinline__ void operator()(const pg8::f32x4 (&acc)[2][2][4][2], const pg8::Unit& u, int wr, int wc, int fr, int fq) const {
        const int e = u.pn >> 2, pn = u.pn & 3, row0 = u.pm * 256 + wr * 64 + fr, col0 = pn * 256 + wc * 32 + 8 * fq;
#pragma unroll
        for (int bj = 0; bj < 2; ++bj) {
            const float* bp = b2 + (size_t)e * D + col0 + bj * 128;
            const f32x4 b0 = *(const f32x4*)bp, b1v = *(const f32x4*)(bp + 4);
#pragma unroll
            for (int ai = 0; ai < 2; ++ai)
#pragma unroll
                for (int m = 0; m < 4; ++m)
                    st8bf(YS + (size_t)(row0 + ai * 128 + m * 16) * D + col0 + bj * 128, acc[ai][bj][m][0] + b0, acc[ai][bj][m][1] + b1v);
        }
    }
};
struct MoeOrder {
    const volatile LAS int* bs; int ntn, G, v;
    __device__ __forceinline__ bool next(int i, pg8::Unit& u) const {
        const int L = i * G + v, nb = bs[32];
        if (L >= nb * ntn) return false;
        const int mb = L / ntn, pn = L - mb * ntn;
        int e = 0;
        while (e < NE - 1 && bs[e + 1] <= mb) ++e;
        u.pm = mb; u.pn = e * ntn + pn; return true;
    }
    __device__ __forceinline__ void a_ready(const pg8::Unit&) const {}
    __device__ __forceinline__ void done(const pg8::Unit&) const {}
};

struct RmIdent { __device__ __forceinline__ int operator()(int n) const { return n; } };
struct RmWin {
    __device__ __forceinline__ int operator()(int n) const {
        if (n < 2560) return n;
        if (n < 3072) { const int j = n - 2560; return 2560 + (j >> 7) * 256 + (j & 127); }
        const int j = n - 3072; return 2560 + (j >> 7) * 256 + 128 + (j & 127);
    }
};
struct RmW1 {
    __device__ __forceinline__ int operator()(int n) const {
        if (n < 1024) return (n >> 7) * 256 + (n & 127);
        const int j = n - 1024; return (j >> 7) * 256 + 128 + (j & 127);
    }
};
template <class RM>
__device__ __forceinline__ void p0_transpose_item(const float* W, int K, int N, bf16* WT, RM rm, LAS float* scr, int item, int lane) {
    const int nblk = N / 32, kb = item / nblk, nb = item % nblk, k0 = 64 * kb, n0 = 32 * nb;
#pragma unroll 8
    for (int i = 0; i < 32; ++i) { const int kk = 2 * i + (lane >> 5); scr[kk * 33 + (lane & 31)] = W[(size_t)(k0 + kk) * N + n0 + (lane & 31)]; }
    LDS_WAIT(); asm volatile("" ::: "memory");
    const int c = lane & 7;
#pragma unroll
    for (int j = 0; j < 4; ++j) { const int n = (lane >> 3) + 8 * j; const LAS float* s = scr + (8 * c) * 33 + n;
        v4u o; o.x = pk2(s[0 * 33], s[1 * 33]); o.y = pk2(s[2 * 33], s[3 * 33]); o.z = pk2(s[4 * 33], s[5 * 33]); o.w = pk2(s[6 * 33], s[7 * 33]);
        *(GAS v4u*)(WT + (size_t)rm(n0 + n) * K + k0 + 8 * c) = o; }
    LDS_WAIT(); asm volatile("" ::: "memory");
}
__device__ __forceinline__ void rms_row_to_bf16(const float* xrow, const float* w, bf16* orow, int lane) {
    const f32x4* xr = (const f32x4*)xrow + lane; const f32x4* wr = (const f32x4*)w + lane;
    f32x4 v[4]; float s = 0.f;
#pragma unroll
    for (int j = 0; j < 4; ++j) { v[j] = xr[64 * j]; s += (v[j].x * v[j].x + v[j].y * v[j].y) + (v[j].z * v[j].z + v[j].w * v[j].w); }
    const float rstd = rsqrtf(wave_sum(s) * (1.f / D) + EPS);
    v2u* o8 = (v2u*)orow + lane;
#pragma unroll
    for (int j = 0; j < 4; ++j) { const f32x4 g = wr[64 * j]; v2u o; o.x = pk2(v[j].x * rstd * g.x, v[j].y * rstd * g.y); o.y = pk2(v[j].z * rstd * g.z, v[j].w * rstd * g.w); o8[64 * j] = o; }
}


__device__ __forceinline__ pg8::bf16x8 lds_frag(const LAS unsigned char* p) { return *(const LAS pg8::bf16x8*)p; }
__device__ __forceinline__ void hgrn_unit(LAS unsigned char* lds, int unit, const bf16* Qb, const bf16* KFb, const bf16* KBb, const bf16* Vb, const float* LFb, const float* LBb,
                                          float* OFb, float* OBb, int tid, int lane, int wave) {
    constexpr int BF_OFF = 0, AM_OFF = 0, QI_OFF = 33792, KK_OFF = 51200, KET_OFF = 68608, VT_OFF = 87040, ST_OFF = 96256, SEG_OFF = 113664, DEC_OFF = 115712;
    constexpr int RS_D = 272, RS_S = 144, RS_BF = 528;
    const int vh = unit & 1, dir = (unit >> 1) & 1, h = (unit >> 2) & 3, b = unit >> 4;
    const bf16* Kp = dir ? KBb : KFb; const float* Lp = dir ? LBb : LFb; float* Op = dir ? OBb : OFb;
    const int lr = lane & 15, lq = lane >> 4;
    const int dA = tid & 127, seg = tid >> 7;
    const int tauB = tid >> 3, dg = tid & 7;
    for (int i = tid; i < 64 * RS_D / 16; i += NTHR) *(LAS v4u*)(lds + ST_OFF + i * 16) = (v4u){0u, 0u, 0u, 0u};
    f32x4 S[4];
#pragma unroll
    for (int i = 0; i < 4; ++i) S[i] = (f32x4){0.f, 0.f, 0.f, 0.f};
    float lf[16]; unsigned kA[16]; v4u qB[2], kB[2], vB;
#define HG_LOAD(n_) do { const int tbn_ = b * TT + (dir ? (TT / 64 - 1 - (n_)) * 64 : (n_) * 64); \
        _Pragma("unroll") for (int i = 0; i < 16; ++i) { const int tau_ = 16 * seg + i; const size_t off_ = (size_t)(dir ? tbn_ + 63 - tau_ : tbn_ + tau_) * 512 + h * 128 + dA; lf[i] = Lp[off_]; kA[i] = Kp[off_]; } \
        const size_t offB_ = (size_t)(dir ? tbn_ + 63 - tauB : tbn_ + tauB) * 512 + h * 128; \
        qB[0] = *(const v4u*)(Qb + offB_ + 16 * dg); qB[1] = *(const v4u*)(Qb + offB_ + 16 * dg + 8); kB[0] = *(const v4u*)(Kp + offB_ + 16 * dg); kB[1] = *(const v4u*)(Kp + offB_ + 16 * dg + 8); \
        vB = *(const v4u*)(Vb + offB_ + vh * 64 + 8 * dg); } while (0)
    HG_LOAD(0);
#pragma unroll 1
    for (int n = 0; n < TT / 64; ++n) {
        const int tb = b * TT + (dir ? (TT / 64 - 1 - n) * 64 : n * 64);
        float bl[16]; { float c = 0.f;
#pragma unroll
            for (int i = 0; i < 16; ++i) { c += lf[i]; bl[i] = c; }
            *(LAS float*)(lds + SEG_OFF + (seg * 128 + dA) * 4) = c; }
        __syncthreads();
        {
            const float p0 = *(LAS float*)(lds + SEG_OFF + (0 * 128 + dA) * 4), p1 = *(LAS float*)(lds + SEG_OFF + (1 * 128 + dA) * 4),
                        p2 = *(LAS float*)(lds + SEG_OFF + (2 * 128 + dA) * 4), p3 = *(LAS float*)(lds + SEG_OFF + (3 * 128 + dA) * 4);
            const float pre = (seg > 0 ? p0 : 0.f) + (seg > 1 ? p1 : 0.f) + (seg > 2 ? p2 : 0.f), bend = (p0 + p1) + (p2 + p3);
            float ke[16];
#pragma unroll
            for (int i = 0; i < 16; ++i) { const float bb = pre + bl[i]; *(LAS float*)(lds + BF_OFF + (16 * seg + i) * RS_BF + dA * 4) = bb; ke[i] = bf2f(kA[i]) * __expf(bend - bb); }
            v4u w0, w1;
            w0.x = pk2(ke[0], ke[1]); w0.y = pk2(ke[2], ke[3]); w0.z = pk2(ke[4], ke[5]); w0.w = pk2(ke[6], ke[7]);
            w1.x = pk2(ke[8], ke[9]); w1.y = pk2(ke[10], ke[11]); w1.z = pk2(ke[12], ke[13]); w1.w = pk2(ke[14], ke[15]);
            *(LAS v4u*)(lds + KET_OFF + dA * RS_S + seg * 32) = w0; *(LAS v4u*)(lds + KET_OFF + dA * RS_S + seg * 32 + 16) = w1;
            if (seg == 0) *(LAS float*)(lds + DEC_OFF + dA * 4) = __expf(bend);
        }
        __syncthreads();
        {
            const unsigned qw[8] = {qB[0].x, qB[0].y, qB[0].z, qB[0].w, qB[1].x, qB[1].y, qB[1].z, qB[1].w};
            const unsigned kw[8] = {kB[0].x, kB[0].y, kB[0].z, kB[0].w, kB[1].x, kB[1].y, kB[1].z, kB[1].w};
            unsigned qo[8], ko[8];
#pragma unroll
            for (int i = 0; i < 4; ++i) {
                const f32x4 bb = *(const LAS f32x4*)(lds + BF_OFF + tauB * RS_BF + dg * 64 + i * 16);
#pragma unroll
                for (int j = 0; j < 2; ++j) {
                    const float e0 = __expf(bb[2 * j]), e1 = __expf(bb[2 * j + 1]);
                    const unsigned qq = qw[2 * i + j], kk = kw[2 * i + j];
                    qo[2 * i + j] = pk2(bf2f(qq & 0xffffu) * e0, bf2f(qq >> 16) * e1);
                    ko[2 * i + j] = pk2(bf2f(kk & 0xffffu) * __builtin_amdgcn_rcpf(e0), bf2f(kk >> 16) * __builtin_amdgcn_rcpf(e1));
                }
            }
            *(LAS v4u*)(lds + QI_OFF + tauB * RS_D + dg * 32) = (v4u){qo[0], qo[1], qo[2], qo[3]}; *(LAS v4u*)(lds + QI_OFF + tauB * RS_D + dg * 32 + 16) = (v4u){qo[4], qo[5], qo[6], qo[7]};
            *(LAS v4u*)(lds + KK_OFF + tauB * RS_D + dg * 32) = (v4u){ko[0], ko[1], ko[2], ko[3]}; *(LAS v4u*)(lds + KK_OFF + tauB * RS_D + dg * 32 + 16) = (v4u){ko[4], ko[5], ko[6], ko[7]};
            const unsigned vw[4] = {vB.x, vB.y, vB.z, vB.w};
#pragma unroll
            for (int c = 0; c < 4; ++c) {
                *(LAS unsigned short*)(lds + VT_OFF + (8 * dg + 2 * c) * RS_S + tauB * 2) = (unsigned short)(vw[c] & 0xffffu);
                *(LAS unsigned short*)(lds + VT_OFF + (8 * dg + 2 * c + 1) * RS_S + tauB * 2) = (unsigned short)(vw[c] >> 16);
            }
        }
        __syncthreads();
        if (n + 1 < TT / 64) HG_LOAD(n + 1);
        const int ei = wave & 3, tp = wave >> 2;
        {
            const int ti = wave & 3;
#pragma unroll
            for (int sii = 0; sii < 2; ++sii) {
                const int si = tp * 2 + sii;
                v2u w = (v2u){0u, 0u};
                if (si <= ti) {
                    f32x4 a = (f32x4){0.f, 0.f, 0.f, 0.f};
#pragma unroll
                    for (int kk = 0; kk < 4; ++kk)
                        a = __builtin_amdgcn_mfma_f32_16x16x32_bf16(lds_frag(lds + KK_OFF + (16 * si + lr) * RS_D + kk * 64 + lq * 16), lds_frag(lds + QI_OFF + (16 * ti + lr) * RS_D + kk * 64 + lq * 16), a, 0, 0, 0);
                    const int s0 = 16 * si + 4 * lq, t = 16 * ti + lr;
                    w.x = pk2(s0 + 0 <= t ? a[0] : 0.f, s0 + 1 <= t ? a[1] : 0.f); w.y = pk2(s0 + 2 <= t ? a[2] : 0.f, s0 + 3 <= t ? a[3] : 0.f);
                }
                *(LAS v2u*)(lds + AM_OFF + (16 * ti + lr) * RS_S + (16 * si + 4 * lq) * 2) = w;
            }
        }
        f32x4 o[2];
#pragma unroll
        for (int tt = 0; tt < 2; ++tt) {
            o[tt] = (f32x4){0.f, 0.f, 0.f, 0.f};
#pragma unroll
            for (int kk = 0; kk < 4; ++kk)
                o[tt] = __builtin_amdgcn_mfma_f32_16x16x32_bf16(lds_frag(lds + ST_OFF + (16 * ei + lr) * RS_D + kk * 64 + lq * 16), lds_frag(lds + QI_OFF + (16 * (2 * tp + tt) + lr) * RS_D + kk * 64 + lq * 16), o[tt], 0, 0, 0);
        }
        {
            const f32x4 dv = *(const LAS f32x4*)(lds + DEC_OFF + (16 * wave + 4 * lq) * 4);
#pragma unroll
            for (int e4 = 0; e4 < 4; ++e4) S[e4] = S[e4] * dv;
#pragma unroll
            for (int kk = 0; kk < 2; ++kk) {
                const pg8::bf16x8 af = lds_frag(lds + KET_OFF + (16 * wave + lr) * RS_S + kk * 64 + lq * 16);
#pragma unroll
                for (int e4 = 0; e4 < 4; ++e4) S[e4] = __builtin_amdgcn_mfma_f32_16x16x32_bf16(af, lds_frag(lds + VT_OFF + (16 * e4 + lr) * RS_S + kk * 64 + lq * 16), S[e4], 0, 0, 0);
            }
        }
        __syncthreads();
#pragma unroll
        for (int tt = 0; tt < 2; ++tt) {
#pragma unroll
            for (int kk = 0; kk < 2; ++kk)
                o[tt] = __builtin_amdgcn_mfma_f32_16x16x32_bf16(lds_frag(lds + VT_OFF + (16 * ei + lr) * RS_S + kk * 64 + lq * 16), lds_frag(lds + AM_OFF + (16 * (2 * tp + tt) + lr) * RS_S + kk * 64 + lq * 16), o[tt], 0, 0, 0);
            const int t = 16 * (2 * tp + tt) + lr;
            *(f32x4*)(Op + (size_t)(dir ? tb + 63 - t : tb + t) * 512 + h * 128 + vh * 64 + 16 * ei + 4 * lq) = o[tt];
        }
#pragma unroll
        for (int e4 = 0; e4 < 4; ++e4) { v2u w; w.x = pk2(S[e4][0], S[e4][1]); w.y = pk2(S[e4][2], S[e4][3]); *(LAS v2u*)(lds + ST_OFF + (16 * e4 + lr) * RS_D + (16 * wave + 4 * lq) * 2) = w; }
    }
#undef HG_LOAD
    __syncthreads();
}

struct Args { const float* in[18]; float* out; unsigned char* ws; int ph_lo, ph_hi; };
__global__ void __launch_bounds__(NTHR, 2) fwd_kernel(Args args) {
    extern __shared__ __attribute__((aligned(16))) unsigned char lds_raw[];
    LAS unsigned char* lds = (LAS unsigned char*)lds_raw;
    volatile LAS unsigned* MISC = (volatile LAS unsigned*)(lds + MISC_OFF);
    const int tid = threadIdx.x, lane = tid & 63, wave = __builtin_amdgcn_readfirstlane(tid >> 6);
    const int G = gridDim.x; const int bx = blockIdx.x; const int vcu = (G % 8 == 0) ? (bx % 8) * (G / 8) + bx / 8 : bx;
    const int gw = vcu * NWAVES + wave, NGW = G * NWAVES;
    unsigned char* ws = args.ws;
    unsigned* ctl = (unsigned*)(ws + WS_CTL);
    const float* x = args.in[0]; const float* norm1_w = args.in[1]; const float* w_in = args.in[2]; const float* lb_logits = args.in[3];
    const float* hgrn_norm_w = args.in[4]; const float* dw_w = args.in[5]; const float* dw_b = args.in[6]; const float* conv_ln_w = args.in[7]; const float* conv_ln_b = args.in[8];
    const float* w_out = args.in[9]; const float* norm2_w = args.in[10]; const float* router_w = args.in[11]; const float* router_b = args.in[12];
    const float* w1 = args.in[13]; const float* b1 = args.in[14]; const float* w2 = args.in[15]; const float* b2 = args.in[16]; const float* final_norm_w = args.in[17];
    float* out = args.out;
    bf16* WI = (bf16*)(ws + WS_WI); bf16* WO = (bf16*)(ws + WS_WO); bf16* W1T = (bf16*)(ws + WS_W1); bf16* W2T = (bf16*)(ws + WS_W2);
    float* H = (float*)(ws + WS_H); bf16* XN = (bf16*)(ws + WS_XN);
    bf16* Qb = (bf16*)(ws + WS_Q); bf16* KFb = (bf16*)(ws + WS_KF); bf16* KBb = (bf16*)(ws + WS_KB); bf16* Vb = (bf16*)(ws + WS_V); bf16* Gb = (bf16*)(ws + WS_G); bf16* Ub = (bf16*)(ws + WS_U);
    float* LFb = (float*)(ws + WS_LF); float* LBb = (float*)(ws + WS_LB); float* OFb = (float*)(ws + WS_OF); float* OBb = (float*)(ws + WS_OB);
    bf16* MIX = (bf16*)(ws + WS_MIX); bf16* XS = (bf16*)(ws + WS_XS); bf16* ACT = (bf16*)(ws + WS_ACT); bf16* YS = (bf16*)(ws + WS_YS);
    float* WRT = (float*)(ws + WS_WRT); int* SLOT = (int*)(ws + WS_SLOT); float* GATE = (float*)(ws + WS_GATE); int* ROWTOK = (int*)(ws + WS_ROWTOK);
    volatile LAS int* bs = (volatile LAS int*)(lds + TAB_OFF);
    volatile LAS int* cl = (volatile LAS int*)(lds + TAB_OFF + 256);
    LAS int* lcnt = (LAS int*)(lds + TAB_OFF + 512);
    volatile LAS int* gbase = (volatile LAS int*)(lds + TAB_OFF + 768);

    for (int u = tid; u < (LDS_BYTES - LDSCTL_OFF) / 4; u += NTHR) ((LAS unsigned*)(lds + LDSCTL_OFF))[u] = 0u;
    __syncthreads();
    XcdBarrier bar; bar.bar = ctl + CW_BAR; bar.x = 0; bar.st = nullptr;
    if (MK_N_LAUNCHES == 1) bar = xcd_barrier_post(ctl + CW_BAR, MISC + 8);
    const int lo = args.ph_lo, hi = args.ph_hi;
#ifndef PHASE_MASK
#define PHASE_MASK 0xffffffffu
#endif
#define IN(k) ((((PHASE_MASK) >> (k)) & 1u) && lo <= (k) && (k) < hi)
#ifndef PROBE_DUP
#define PROBE_DUP -1
#endif
#define REP(k) for (int rep_ = 0; rep_ < ((PROBE_DUP) == (k) ? 2 : 1); ++rep_)
#define SEAM(k) do { if (IN(k) && IN((k) + 1)) xcd_barrier(bar); } while (0)
#define BUILD_BS() do { if (tid == 0) { int a_ = 0; for (int e_ = 0; e_ < NE; ++e_) { bs[e_] = a_; const int c_ = (int)__hip_atomic_load(ctl + CW_CNT + 64 * e_, RLX_AGENT); cl[e_] = c_; a_ += (c_ + 255) >> 8; } bs[NE] = a_; } __syncthreads(); } while (0)

    if (IN(0)) REP(0) {
        LAS float* scr = (LAS float*)(lds + RING_OFF + wave * 16384);
        constexpr int I_WI = (D / 64) * (INC / 32), I_WO = (D / 64) * (D / 32), I_W1 = (D / 64) * (2 * FF / 32), I_W2 = (FF / 64) * (D / 32);
        #if defined(HGRN_NAIVE)
        constexpr int NITEMS = I_WI + I_WO + NE * I_W1 + NE * I_W2;
#else
        constexpr int NITEMS = I_WI + I_WO + NE * I_W1;
#endif
        for (int it = gw; it < NITEMS; it += NGW) {
            int r = it;
            if (r < I_WI) { p0_transpose_item(w_in, D, INC, WI, RmWin(), scr, r, lane); continue; } r -= I_WI;
            if (r < I_WO) { p0_transpose_item(w_out, D, D, WO, RmIdent(), scr, r, lane); continue; } r -= I_WO;
            if (r < NE * I_W1) { const int e = r / I_W1; p0_transpose_item(w1 + (size_t)e * D * 2 * FF, D, 2 * FF, W1T + (size_t)e * 2 * FF * D, RmW1(), scr, r - e * I_W1, lane); continue; } r -= NE * I_W1;
#if defined(HGRN_NAIVE)
            { const int e = r / I_W2; p0_transpose_item(w2 + (size_t)e * FF * D, FF, D, W2T + (size_t)e * D * FF, RmIdent(), scr, r - e * I_W2, lane); }
#endif
        }
        for (int m = gw; m < MTOK; m += NGW) rms_row_to_bf16(x + (size_t)m * D, norm1_w, XN + (size_t)m * D, lane);
        for (int i = bx * NTHR + tid; i < NE * D; i += G * NTHR) { const int e = i >> 10, c = i & 1023; WRT[i] = router_w[c * NE + e]; }
    }
    SEAM(0);

    if (IN(1)) REP(1) {
        pg8::Gemm g{XN, WI, MTOK, INC, D}; pg8::StaticOrder S; S.init(MTOK, INC, G, bx);
        EpiProj E{Qb, KFb, KBb, Vb, Gb, Ub, LFb, LBb, lb_logits};
        pg8::gemm_phase<EpiProj, pg8::StaticOrder, true, true>(lds + RING_OFF, g, S, E);
    }
    SEAM(1);

    if (IN(2)) REP(2) {
        const bool split = (G == 256);
#if defined(HGRN_NAIVE)
        const bool hsel = true; const int hidx = 0, hstride = 1; const bool csel = true; const int cidx = vcu, cstride = G;
#else
        const bool hsel = split ? (((bx >> 3) & 1) != 0) : true; const int hidx = split ? (bx >> 4) * 8 + (bx & 7) : bx, hstride = split ? 128 : G;
        const bool csel = split ? !hsel : true; const int cidx = split ? (bx >> 4) * 8 + (bx & 7) : bx, cstride = split ? 128 : G;
#endif
        (void)hidx; (void)hstride;
        if (csel) for (int crep_ = 0; crep_ < ((PROBE_DUP) == 21 ? 2 : 1); ++crep_) {
            LAS unsigned short* ut = (LAS unsigned short*)(lds + RING_OFF);
            LAS float* part = (LAS float*)(lds + RING_OFF + 98304);
            LAS float* stat = (LAS float*)(lds + RING_OFF + 98304 + 4096);
            for (int unit = cidx; unit < NBATCH * (TT / 64); unit += cstride) {
                const int b = unit / (TT / 64), t0 = (unit % (TT / 64)) * 64;
                for (int idx = tid; idx < 94 * 64; idx += NTHR) {
                    const int r = idx >> 6, p = idx & 63, t = t0 - 15 + r;
                    v4u val = (v4u){0u, 0u, 0u, 0u};
                    if (t >= 0 && t < TT) val = *(const v4u*)(Ub + (size_t)(b * TT + t) * CCH + p * 8);
                    *(LAS v4u*)(ut + r * 512 + p * 8) = val;
                }
                __syncthreads();
                const int c = tid;
                float w[CLEN];
#pragma unroll
                for (int j = 0; j < CLEN; ++j) w[j] = dw_w[j * CCH + c];
                const float bias = dw_b[c];
                float y[64];
#pragma unroll
                for (int tb = 0; tb < 8; ++tb) {
                    float win[38];
#pragma unroll
                    for (int i = 0; i < 38; ++i) win[i] = bf2f(ut[(tb * 8 + i) * 512 + c]);
#pragma unroll
                    for (int o = 0; o < 8; ++o) { float a = bias;
#pragma unroll
                        for (int j = 0; j < CLEN; ++j) a += w[j] * win[o + j];
                        y[tb * 8 + o] = a; }
                }
#pragma unroll 1
                for (int pass = 0; pass < 2; ++pass) {
                    float s1[64];
#pragma unroll
                    for (int i = 0; i < 64; ++i) s1[i] = pass ? y[i] * y[i] : y[i];
#pragma unroll
                    for (int s = 32; s >= 1; s >>= 1) {
                        const bool up = (lane & s) != 0;
#pragma unroll
                        for (int i = 0; i < s; ++i) { const float k1 = up ? s1[i + s] : s1[i], x1 = up ? s1[i] : s1[i + s]; s1[i] = k1 + __shfl_xor(x1, s); }
                    }
                    part[(wave * 64 + lane) * 2 + pass] = s1[0];
                }
                __syncthreads();
                if (tid < 64) { float a = 0.f, q = 0.f;
#pragma unroll
                    for (int wv = 0; wv < 8; ++wv) { a += part[(wv * 64 + tid) * 2]; q += part[(wv * 64 + tid) * 2 + 1]; }
                    const float mean = a * (1.f / CCH), var = q * (1.f / CCH) - mean * mean;
                    stat[tid * 2] = mean; stat[tid * 2 + 1] = rsqrtf(fmaxf(var, 0.f) + EPS); }
                __syncthreads();
                const float lw = conv_ln_w[c], lbias = conv_ln_b[c];
#pragma unroll
                for (int t = 0; t < 64; ++t) {
                    const float v = (y[t] - stat[t * 2]) * stat[t * 2 + 1] * lw + lbias;
                    MIX[(size_t)(b * TT + t0 + t) * D + 512 + c] = (bf16)(pk2(v * sigm(v), 0.f) & 0xffffu);
                }
                __syncthreads();
            }
#if !defined(HGRN_NAIVE)
            {
                LAS float* scr = (LAS float*)(lds + RING_OFF + wave * 16384);
                constexpr int I_W2 = (FF / 64) * (D / 32);
                for (int it = cidx * NWAVES + wave; it < NE * I_W2; it += cstride * NWAVES) { const int e = it / I_W2;
                    p0_transpose_item(w2 + (size_t)e * FF * D, FF, D, W2T + (size_t)e * D * FF, RmIdent(), scr, it - e * I_W2, lane); }
            }
#endif
        }
#if defined(HGRN_NAIVE)
        {
            LAS float* qs = (LAS float*)(lds + RING_OFF); LAS float* ks = qs + 2048; LAS float* fs = ks + 2048; LAS float* vs = fs + 2048; LAS float* op = vs + 2048;
            const int e = tid & 127, dq = tid >> 7;
            for (int unit = G - 1 - bx; unit < NBATCH * NH * 2; unit += G) {
                const int dir = unit & 1, h = (unit >> 1) & 3, b = unit >> 3;
                const bf16* Kp = dir ? KBb : KFb; const float* Lp = dir ? LBb : LFb; float* Op = dir ? OBb : OFb;
                float S[32];
#pragma unroll
                for (int i = 0; i < 32; ++i) S[i] = 0.f;
                for (int blk = 0; blk < TT / 16; ++blk) {
                    const int tb = dir ? (TT - 16 - blk * 16) : blk * 16;
#pragma unroll
                    for (int i = 0; i < 4; ++i) { const int idx = tid + NTHR * i, r = idx >> 7, d = idx & 127; const size_t off = (size_t)(b * TT + tb + r) * 512 + h * 128 + d;
                        qs[idx] = bf2f(Qb[off]); ks[idx] = bf2f(Kp[off]); fs[idx] = __expf(Lp[off]); vs[idx] = bf2f(Vb[off]); }
                    __syncthreads();
                    for (int st = 0; st < 16; ++st) {
                        const int r = dir ? 15 - st : st; const float v = vs[r * 128 + e]; float o = 0.f;
#pragma unroll
                        for (int dd = 0; dd < 32; ++dd) { const int d = dq * 32 + dd; S[dd] = fs[r * 128 + d] * S[dd] + ks[r * 128 + d] * v; o += qs[r * 128 + d] * S[dd]; }
                        op[(r * 4 + dq) * 128 + e] = o;
                    }
                    __syncthreads();
#pragma unroll
                    for (int i = 0; i < 4; ++i) { const int idx = tid + NTHR * i, r = idx >> 7, ee = idx & 127;
                        Op[(size_t)(b * TT + tb + r) * 512 + h * 128 + ee] = (op[(r * 4 + 0) * 128 + ee] + op[(r * 4 + 1) * 128 + ee]) + (op[(r * 4 + 2) * 128 + ee] + op[(r * 4 + 3) * 128 + ee]); }
                }
                __syncthreads();
            }
        }
#else
        if (hsel) for (int hrep_ = 0; hrep_ < ((PROBE_DUP) == 20 ? 2 : 1); ++hrep_) for (int unit = hidx; unit < NBATCH * NH * 4; unit += hstride) hgrn_unit(lds + RING_OFF, unit, Qb, KFb, KBb, Vb, LFb, LBb, OFb, OBb, tid, lane, wave);
#endif
    }
    SEAM(2);

    if (IN(3)) REP(3) {
        for (int m = gw; m < MTOK; m += NGW) {
            const size_t off = (size_t)m * 512 + lane * 8;
            const f32x4 a0 = *(const f32x4*)(OFb + off), a1 = *(const f32x4*)(OFb + off + 4), c0 = *(const f32x4*)(OBb + off), c1 = *(const f32x4*)(OBb + off + 4);
            const f32x4 o0 = a0 + c0, o1 = a1 + c1;
            float ss = (o0.x * o0.x + o0.y * o0.y) + (o0.z * o0.z + o0.w * o0.w) + (o1.x * o1.x + o1.y * o1.y) + (o1.z * o1.z + o1.w * o1.w);
            ss += __shfl_xor(ss, 1); ss += __shfl_xor(ss, 2); ss += __shfl_xor(ss, 4); ss += __shfl_xor(ss, 8);
            const float rstd = rsqrtf(ss * (1.f / DV) + EPS);
            const v4u gv = *(const v4u*)(Gb + off);
            const f32x4 w0 = *(const f32x4*)(hgrn_norm_w + lane * 8), w1v = *(const f32x4*)(hgrn_norm_w + lane * 8 + 4);
            f32x4 r0, r1;
            r0.x = o0.x * rstd * w0.x * bf2f(gv.x & 0xffffu); r0.y = o0.y * rstd * w0.y * bf2f(gv.x >> 16);
            r0.z = o0.z * rstd * w0.z * bf2f(gv.y & 0xffffu); r0.w = o0.w * rstd * w0.w * bf2f(gv.y >> 16);
            r1.x = o1.x * rstd * w1v.x * bf2f(gv.z & 0xffffu); r1.y = o1.y * rstd * w1v.y * bf2f(gv.z >> 16);
            r1.z = o1.z * rstd * w1v.z * bf2f(gv.w & 0xffffu); r1.w = o1.w * rstd * w1v.w * bf2f(gv.w >> 16);
            st8bf(MIX + (size_t)m * D + lane * 8, r0, r1);
        }
    }
    SEAM(3);

    if (IN(4)) REP(4) {
        pg8::Gemm g{MIX, WO, MTOK, D, D}; pg8::StaticOrder S; S.init(MTOK, D, G, bx);
        EpiRes E{x, H};
        pg8::gemm_phase<EpiRes, pg8::StaticOrder, true, true>(lds + RING_OFF, g, S, E);
    }
    SEAM(4);

    if (IN(5)) REP(5) {
        LAS float* wl = (LAS float*)(lds + RING_OFF);
        LAS unsigned* sb = (LAS unsigned*)(lds + SB_OFF);
        for (int i = tid; i < NE * D / 4; i += NTHR) ((LAS f32x4*)wl)[i] = ((const f32x4*)WRT)[i];
        if (tid < NE) lcnt[tid] = 0;
        __syncthreads();
        int it = 0;
        for (int m = gw; m < MTOK; m += NGW, ++it) {
            const f32x4* hr = (const f32x4*)(H + (size_t)m * D) + lane; const f32x4* wr = (const f32x4*)norm2_w + lane;
            f32x4 v[4]; float s = 0.f;
#pragma unroll
            for (int j = 0; j < 4; ++j) { v[j] = hr[64 * j]; s += (v[j].x * v[j].x + v[j].y * v[j].y) + (v[j].z * v[j].z + v[j].w * v[j].w); }
            const float rstd = rsqrtf(wave_sum(s) * (1.f / D) + EPS);
            v2u* o8 = (v2u*)(XN + (size_t)m * D) + lane;
#pragma unroll
            for (int j = 0; j < 4; ++j) { const f32x4 g = wr[64 * j]; v[j] = v[j] * rstd * g; v2u o; o.x = pk2(v[j].x, v[j].y); o.y = pk2(v[j].z, v[j].w); o8[64 * j] = o; }
            float a[NE];
#pragma unroll
            for (int e = 0; e < NE; ++e) { float t = 0.f;
#pragma unroll
                for (int j = 0; j < 4; ++j) { const f32x4 wv = ((const LAS f32x4*)wl)[e * 256 + lane + 64 * j]; t += (v[j].x * wv.x + v[j].y * wv.y) + (v[j].z * wv.z + v[j].w * wv.w); }
                a[e] = t; }
#pragma unroll
            for (int s2 = 32, n = 16; n >= 1; s2 >>= 1, n >>= 1) {
                const bool up = (lane & s2) != 0;
#pragma unroll
                for (int i = 0; i < n; ++i) { const float k1 = up ? a[i + n] : a[i], x1 = up ? a[i] : a[i + n]; a[i] = k1 + __shfl_xor(x1, s2); }
            }
            float lg = a[0] + __shfl_xor(a[0], 1);
            const int myE = lane >> 1;
            lg += router_b[myE];
            float tv[TOPK]; int ti[TOPK];
#pragma unroll
            for (int k = 0; k < TOPK; ++k) {
                float mx = lg;
#pragma unroll
                for (int o = 1; o < 64; o <<= 1) mx = fmaxf(mx, __shfl_xor(mx, o));
                int cand = (lg == mx) ? myE : 99;
#pragma unroll
                for (int o = 1; o < 64; o <<= 1) cand = min(cand, __shfl_xor(cand, o));
                tv[k] = mx; ti[k] = cand;
                if (myE == cand) lg = -INFINITY;
            }
            const float e1 = __expf(tv[1] - tv[0]), e2 = __expf(tv[2] - tv[0]), e3 = __expf(tv[3] - tv[0]);
            const float inv = 1.0f / (1.0f + e1 + e2 + e3);
            if (lane < TOPK) {
                const int ek = lane == 0 ? ti[0] : lane == 1 ? ti[1] : lane == 2 ? ti[2] : ti[3];
                const float gk = (lane == 0 ? 1.0f : lane == 1 ? e1 : lane == 2 ? e2 : e3) * inv;
                const int lr = __hip_atomic_fetch_add(&lcnt[ek], 1, __ATOMIC_RELAXED, __HIP_MEMORY_SCOPE_WORKGROUP);
                sb[(wave * 64 + it) * 4 + lane] = ((unsigned)ek << 16) | (unsigned)lr;
                GATE[(size_t)m * TOPK + lane] = gk;
            }
        }
        __syncthreads();
        if (tid < NE) { const int c = lcnt[tid]; gbase[tid] = c ? (int)__hip_atomic_fetch_add(ctl + CW_CNT + ((PROBE_DUP) == 5 && rep_ == 0 ? 4096 : 0) + 64 * tid, (unsigned)c, RLX_AGENT) : 0; }
        __syncthreads();
        it = 0;
        for (int m = gw; m < MTOK; m += NGW, ++it) {
            if (lane < TOPK) { const unsigned w = sb[(wave * 64 + it) * 4 + lane]; const int ek = (int)(w >> 16), r = gbase[ek] + (int)(w & 0xffffu);
                ROWTOK[ek * MTOK + r] = m; SLOT[(size_t)m * TOPK + lane] = ek * MTOK + r; }
        }
    }
    SEAM(5);

    if (IN(6)) REP(6) {
        BUILD_BS();
        const int nrows = bs[NE] * 256;
        for (int r = gw; r < nrows; r += NGW) {
            const int mb = r >> 8; int e = 0;
            while (e < NE - 1 && bs[e + 1] <= mb) ++e;
            const int rank = r - bs[e] * 256;
            v4u a = (v4u){0u, 0u, 0u, 0u}, c = a;
            if (rank < cl[e]) { const int tok = ROWTOK[e * MTOK + rank]; const v4u* src = (const v4u*)(XN + (size_t)tok * D); a = src[lane]; c = src[lane + 64]; }
            v4u* dst = (v4u*)(XS + (size_t)r * D); dst[lane] = a; dst[lane + 64] = c;
        }
    }
    SEAM(6);

    if (IN(7)) REP(7) {
        BUILD_BS();
        pg8::Gemm g{XS, W1T, MOE_ROWS, 2 * FF, D}; MoeOrder S{bs, 8, G, vcu};
        EpiSwiglu E{ACT, b1};
        pg8::gemm_phase<EpiSwiglu, MoeOrder, true, true>(lds + RING_OFF, g, S, E);
    }
    SEAM(7);

    if (IN(8)) REP(8) {
        BUILD_BS();
        pg8::Gemm g{ACT, W2T, MOE_ROWS, D, FF}; MoeOrder S{bs, 4, G, vcu};
        EpiDown E{YS, b2};
        pg8::gemm_phase<EpiDown, MoeOrder, true, true>(lds + RING_OFF, g, S, E);
    }
    SEAM(8);

    if (IN(9)) REP(9) {
        BUILD_BS();
        for (int m = gw; m < MTOK; m += NGW) {
            const f32x4* hr = (const f32x4*)(H + (size_t)m * D) + lane; const f32x4* wr = (const f32x4*)final_norm_w + lane;
            f32x4 v[4];
#pragma unroll
            for (int j = 0; j < 4; ++j) v[j] = hr[64 * j];
#pragma unroll
            for (int k = 0; k < TOPK; ++k) {
                const int sl = SLOT[(size_t)m * TOPK + k]; const float gk = GATE[(size_t)m * TOPK + k];
                const int e = sl >> 14, pos = bs[e] * 256 + (sl & (MTOK - 1));
                const v2u* yr = (const v2u*)(YS + (size_t)pos * D) + lane;
#pragma unroll
                for (int j = 0; j < 4; ++j) { const v2u w = yr[64 * j];
                    v[j].x += gk * bf2f(w.x & 0xffffu); v[j].y += gk * bf2f(w.x >> 16); v[j].z += gk * bf2f(w.y & 0xffffu); v[j].w += gk * bf2f(w.y >> 16); }
            }
            float s = 0.f;
#pragma unroll
            for (int j = 0; j < 4; ++j) s += (v[j].x * v[j].x + v[j].y * v[j].y) + (v[j].z * v[j].z + v[j].w * v[j].w);
            const float rstd = rsqrtf(wave_sum(s) * (1.f / D) + EPS);
            f32x4* orow = (f32x4*)(out + (size_t)m * D) + lane;
#pragma unroll
            for (int j = 0; j < 4; ++j) orow[64 * j] = v[j] * rstd * wr[64 * j];
        }
    }
#undef IN
#undef SEAM
#undef BUILD_BS
}

extern "C" void kernel_launch(void* const* d_in, const int* in_sizes, int n_in, void* d_out, int out_size, void* d_ws, size_t ws_size, hipStream_t stream) {
    static int grid = 0;
    if (grid == 0) {
        if (n_in != 18 || in_sizes[0] != MTOK * D || out_size != MTOK * D || ws_size < WS_END) { fprintf(stderr, "kernel_launch: unexpected shapes (n_in %d, in0 %d, out %d, ws %zu < %zu); nothing launched\n", n_in, n_in > 0 ? in_sizes[0] : -1, out_size, ws_size, (size_t)WS_END); grid = -1; return; }
        int dev = 0, cus = 0, per_cu = 0;
        if (hipGetDevice(&dev) != hipSuccess || hipDeviceGetAttribute(&cus, hipDeviceAttributeMultiprocessorCount, dev) != hipSuccess) { fprintf(stderr, "kernel_launch: device query failed\n"); grid = -1; return; }
        if (hipFuncSetAttribute((const void*)fwd_kernel, hipFuncAttributeMaxDynamicSharedMemorySize, LDS_BYTES) != hipSuccess) { fprintf(stderr, "kernel_launch: hipFuncSetAttribute failed\n"); grid = -1; return; }
        if (hipOccupancyMaxActiveBlocksPerMultiprocessor(&per_cu, (const void*)fwd_kernel, NTHR, LDS_BYTES) != hipSuccess || per_cu < 1)
            fprintf(stderr, "kernel_launch: note: occupancy query reports %d workgroups per CU\n", per_cu);
        (void)hipGetLastError();
        grid = cus;
    }
    if (grid < 0) return;
    if (hipMemsetAsync((char*)d_ws + WS_CTL, 0, CTL_ZERO_BYTES, stream) != hipSuccess) { fprintf(stderr, "kernel_launch: memset failed\n"); return; }
    Args a{};
    for (int i = 0; i < 18; ++i) a.in[i] = (const float*)d_in[i];
    a.out = (float*)d_out; a.ws = (unsigned char*)d_ws;
#if MK_N_LAUNCHES == 1
    a.ph_lo = 0; a.ph_hi = N_PHASES;
    hipLaunchKernelGGL(fwd_kernel, dim3(grid), dim3(NTHR), LDS_BYTES, stream, a);
#else
    for (int ph = 0; ph < N_PHASES; ++ph) { a.ph_lo = ph; a.ph_hi = ph + 1; hipLaunchKernelGGL(fwd_kernel, dim3(grid), dim3(NTHR), LDS_BYTES, stream, a); }
#endif
    const hipError_t le = hipPeekAtLastError();
    if (le != hipSuccess) fprintf(stderr, "kernel_launch: launch failed: %s\n", hipGetErrorName(le));
}
```

```cpp
#include <hip/hip_runtime.h>
#include <cstdio>
#include <cstdint>
namespace pg8 {
#define PG8_LAS __attribute__((address_space(3)))
typedef unsigned short bf16_t;
typedef short bf16x8 __attribute__((ext_vector_type(8)));
typedef float f32x4 __attribute__((ext_vector_type(4)));
typedef unsigned u32x4 __attribute__((ext_vector_type(4)));
constexpr int BM = 256, BK = 64, HALF = 128, HTB = HALF * BK * 2  , STAGE_BYTES = 8 * HTB, NXCD = 8, WGM = 8;

__host__ __device__ __forceinline__ int lds_byte(int r, int c) { const int st = (r >> 4) * 2 + (c >> 5), rr = r & 15, cc = c & 31, ob = rr * 64 + cc * 2; return st * 1024 + (ob ^ (((ob >> 9) & 1) << 5)); }
__host__ __device__ __forceinline__ void stage_rc(int b, int& R, int& C) { const int st = b / 1024, sb = b % 1024, swz = sb ^ (((sb >> 9) & 1) << 5); R = (st >> 1) * 16 + swz / 64; C = (st & 1) * 32 + (swz % 64) / 2; }
__host__ __device__ __forceinline__ int perm32(int rho) { const int n = rho >> 4, i = rho & 15; return 8 * (i >> 2) + 4 * n + (i & 3); }

struct Unit { int pm, pn; };
struct Gemm { const bf16_t* A; const bf16_t* Bt; int M, N, K; };

struct StaticOrder {
    int nM, nN, nwg, G, c;
    __host__ __device__ void init(int M, int N, int G_, int c_) { nM = M / BM; nN = N / BM; nwg = nM * nN; G = G_; c = c_; }
    __host__ __device__ bool next(int i, Unit& u) const {
        const long L = (long)i * G + c; if (L >= nwg) return false;
        int wgid = (int)L; { const int q = nwg / NXCD, r = nwg % NXCD, xcd = wgid % NXCD, off = wgid / NXCD; wgid = (xcd < r ? xcd * (q + 1) : r * (q + 1) + (xcd - r) * q) + off; }
        const int nig = WGM * nN, gid = wgid / nig, fm = gid * WGM, gsz = (nM - fm) < WGM ? (nM - fm) : WGM;
        u.pm = fm + ((wgid % nig) % gsz); u.pn = (wgid % nig) / gsz; return true;
    }
    __device__ __forceinline__ void a_ready(const Unit&) const {}
    __device__ __forceinline__ void done(const Unit&) const {}
};
__device__ __forceinline__ unsigned cvt_pk_bf16(float lo, float hi) { unsigned r; asm volatile("v_cvt_pk_bf16_f32 %0, %1, %2" : "=v"(r) : "v"(lo), "v"(hi)); return r; }
typedef float f32x2 __attribute__((ext_vector_type(2)));
template <class Epi, class Sched, bool ALIGN_EPI = false, bool SP2 = false, bool FP8 = false>
__device__ __forceinline__ void gemm_phase(PG8_LAS unsigned char* lds, const Gemm g, const Sched& S, const Epi& E) {
    typedef int v4i_t __attribute__((ext_vector_type(4)));
    const int tid = threadIdx.x, wid = __builtin_amdgcn_readfirstlane(tid >> 6), lane = tid & 63, wr = wid >> 2, wc = wid & 3, fr = lane & 15, fq = lane >> 4;
    const int K = g.K, nt = K / BK;
    unsigned voffA[2], voffB[2];
#pragma unroll
    for (int i = 0; i < 2; ++i) { int R, C; stage_rc(tid * 16 + i * 8192, R, C); const int Rb = Epi::PERM ? ((R & ~31) + perm32(R & 31)) : R;
        voffA[i] = (unsigned)(R * K + C) * 2u; voffB[i] = (unsigned)(Rb * K + C) * 2u; }
    const size_t kstep = (size_t)(BK * 2);
    const size_t hstep = (size_t)HALF * K * 2;
    const size_t tstep = 2 * hstep;
    const unsigned ldsw = (unsigned)wid * 1024u;
    const int aoff = lds_byte(wr * 64 + fr, fq * 8), boff = lds_byte(wc * 32 + fr, fq * 8);
#define PG8_SA(b, h) (((b) * 2 + (h)) * HTB)
#define PG8_SB(b, h) ((4 + (b) * 2 + (h)) * HTB)
#define PG8_STAGE(bufoff, gbase, voff) do { _Pragma("unroll") for (int _i = 0; _i < 2; ++_i) \
        __builtin_amdgcn_global_load_lds((const unsigned*)((const char*)(gbase) + (voff)[_i]), (PG8_LAS unsigned*)(lds + (bufoff) + ldsw + _i * 8192), 16, 0, 0); } while (0)
#define PG8_LDA(dst, b, h) do { _Pragma("unroll") for (int m = 0; m < 4; ++m) _Pragma("unroll") for (int k = 0; k < 2; ++k) dst[m][k] = *(const PG8_LAS bf16x8*)(lds + PG8_SA(b, h) + aoff + m * 2048 + k * 1024); } while (0)
#define PG8_LDB(dst, b, h) do { _Pragma("unroll") for (int n = 0; n < 2; ++n) _Pragma("unroll") for (int k = 0; k < 2; ++k) dst[n][k] = *(const PG8_LAS bf16x8*)(lds + PG8_SB(b, h) + boff + n * 2048 + k * 1024); } while (0)
#define PG8_MMA(ai, bj, At, Bt) do { __builtin_amdgcn_s_setprio(1); _Pragma("unroll") for (int m = 0; m < 4; ++m) _Pragma("unroll") for (int n = 0; n < 2; ++n) { \
        if constexpr (FP8) { asm volatile("v_mfma_f32_16x16x128_f8f6f4 %0, %1, %2, %0" : "+v"(acc[ai][bj][m][n]) : "v"(__builtin_shufflevector((v4i_t)Bt[n][0], (v4i_t)Bt[n][1], 0, 1, 2, 3, 4, 5, 6, 7)), "v"(__builtin_shufflevector((v4i_t)At[m][0], (v4i_t)At[m][1], 0, 1, 2, 3, 4, 5, 6, 7))); } \
        else { _Pragma("unroll") for (int k = 0; k < 2; ++k) acc[ai][bj][m][n] = __builtin_amdgcn_mfma_f32_16x16x32_bf16(Bt[n][k], At[m][k], acc[ai][bj][m][n], 0, 0, 0); } } __builtin_amdgcn_s_setprio(0); } while (0)
#define PG8_WAIT_V(n) asm volatile("s_waitcnt vmcnt(" #n ")" ::: "memory")
#define PG8_WAIT_L(n) asm volatile("s_waitcnt lgkmcnt(" #n ")" ::: "memory")
#define PG8_BAR __builtin_amdgcn_s_barrier()
#define PG8_SCHED __builtin_amdgcn_sched_barrier(0)
    Unit cur, nxt; int ui = 0;
    if (!S.next(0, cur)) return;
    f32x4 acc[2][2][4][2];
#pragma unroll
    for (int a = 0; a < 2; ++a)
#pragma unroll
        for (int b = 0; b < 2; ++b)
#pragma unroll
            for (int m = 0; m < 4; ++m)
#pragma unroll
                for (int n = 0; n < 2; ++n) acc[a][b][m][n] = (f32x4){0.f, 0.f, 0.f, 0.f};
    bf16x8 At[4][2], B0[2][2], B1[2][2];
    const char* cA = (const char*)g.A + (size_t)cur.pm * tstep; const char* cB = (const char*)g.Bt + (size_t)cur.pn * tstep;
    S.a_ready(cur);
    if constexpr (SP2) {
        PG8_STAGE(PG8_SB(0, 0), cB, voffB); PG8_STAGE(PG8_SB(0, 1), cB + hstep, voffB); PG8_STAGE(PG8_SA(0, 0), cA, voffA); PG8_STAGE(PG8_SA(0, 1), cA + hstep, voffA);
        if (wr == 1) PG8_BAR;
        PG8_WAIT_V(2); PG8_BAR;
        PG8_STAGE(PG8_SB(1, 0), cB + kstep, voffB); PG8_STAGE(PG8_SA(1, 0), cA + kstep, voffA); PG8_STAGE(PG8_SB(1, 1), cB + hstep + kstep, voffB);
        PG8_WAIT_V(6); PG8_BAR;
    } else {
        PG8_STAGE(PG8_SB(0, 0), cB, voffB); PG8_STAGE(PG8_SA(0, 0), cA, voffA); PG8_STAGE(PG8_SB(0, 1), cB + hstep, voffB); PG8_STAGE(PG8_SA(0, 1), cA + hstep, voffA);
        if (wr == 1) PG8_BAR;
        PG8_WAIT_V(4); PG8_BAR;
        PG8_STAGE(PG8_SB(1, 0), cB + kstep, voffB); PG8_STAGE(PG8_SA(1, 0), cA + kstep, voffA); PG8_STAGE(PG8_SB(1, 1), cB + hstep + kstep, voffB);
        PG8_WAIT_V(6); PG8_BAR;
    }
    for (;;) {
        const bool has_next = S.next(ui + 1, nxt);
        const char* nA = has_next ? (const char*)g.A + (size_t)nxt.pm * tstep : cA; const char* nB = has_next ? (const char*)g.Bt + (size_t)nxt.pn * tstep : cB;
        for (int t = 0; t < nt; t += 2) {
            const bool last = (t == nt - 2);
            const char* a1 = cA + (size_t)(t + 1) * kstep;
            const char* a2 = last ? nA : cA + (size_t)(t + 2) * kstep; const char* b2 = last ? nB : cB + (size_t)(t + 2) * kstep;
            const char* a3 = a2 + kstep; const char* b3 = b2 + kstep;
            if (last && has_next) S.a_ready(nxt);
            if constexpr (SP2) {
            PG8_LDB(B0, 0, 0); PG8_LDB(B1, 0, 1); PG8_SCHED; PG8_LDA(At, 0, 0); PG8_STAGE(PG8_SA(1, 1), a1 + hstep, voffA);
            PG8_WAIT_V(8); PG8_WAIT_L(0); PG8_BAR; PG8_MMA(0, 0, At, B0); PG8_MMA(0, 1, At, B1); PG8_BAR; PG8_SCHED;
            PG8_LDA(At, 0, 1); PG8_STAGE(PG8_SB(0, 0), b2, voffB); PG8_STAGE(PG8_SB(0, 1), b2 + hstep, voffB); PG8_STAGE(PG8_SA(0, 0), a2, voffA);
            PG8_WAIT_V(8); PG8_WAIT_L(0); PG8_BAR; PG8_MMA(1, 0, At, B0); PG8_MMA(1, 1, At, B1); PG8_BAR; PG8_SCHED;
            PG8_LDB(B0, 1, 0); PG8_LDB(B1, 1, 1); PG8_SCHED; PG8_LDA(At, 1, 0); PG8_STAGE(PG8_SA(0, 1), a2 + hstep, voffA);
            PG8_WAIT_V(8); PG8_WAIT_L(0); PG8_BAR; PG8_MMA(0, 0, At, B0); PG8_MMA(0, 1, At, B1); PG8_BAR; PG8_SCHED;
            PG8_LDA(At, 1, 1); PG8_STAGE(PG8_SB(1, 0), b3, voffB); PG8_STAGE(PG8_SB(1, 1), b3 + hstep, voffB); PG8_STAGE(PG8_SA(1, 0), a3, voffA);
            PG8_WAIT_V(8); PG8_WAIT_L(0); PG8_BAR; PG8_MMA(1, 0, At, B0); PG8_MMA(1, 1, At, B1); PG8_BAR; PG8_SCHED;
            } else {
            PG8_LDB(B0, 0, 0); PG8_SCHED; PG8_LDA(At, 0, 0); PG8_STAGE(PG8_SA(1, 1), a1 + hstep, voffA);
            PG8_WAIT_L(8); PG8_BAR; PG8_WAIT_L(0); PG8_MMA(0, 0, At, B0); PG8_BAR; PG8_SCHED;
            PG8_LDB(B1, 0, 1); PG8_STAGE(PG8_SB(0, 0), b2, voffB);
            PG8_BAR; PG8_WAIT_L(0); PG8_MMA(0, 1, At, B1); PG8_BAR;
            PG8_LDA(At, 0, 1); PG8_STAGE(PG8_SA(0, 0), a2, voffA);
            PG8_BAR; PG8_WAIT_L(0); PG8_MMA(1, 0, At, B0); PG8_BAR; PG8_SCHED;
            PG8_STAGE(PG8_SB(0, 1), b2 + hstep, voffB);
            PG8_WAIT_V(6); PG8_BAR; PG8_MMA(1, 1, At, B1); PG8_BAR;
            PG8_LDB(B0, 1, 0); PG8_SCHED; PG8_LDA(At, 1, 0); PG8_STAGE(PG8_SA(0, 1), a2 + hstep, voffA);
            PG8_WAIT_L(8); PG8_BAR; PG8_WAIT_L(0); PG8_MMA(0, 0, At, B0); PG8_BAR; PG8_SCHED;
            PG8_LDB(B1, 1, 1); PG8_STAGE(PG8_SB(1, 0), b3, voffB);
            PG8_BAR; PG8_WAIT_L(0); PG8_MMA(0, 1, At, B1); PG8_BAR;
            PG8_LDA(At, 1, 1); PG8_STAGE(PG8_SA(1, 0), a3, voffA);
            PG8_BAR; PG8_WAIT_L(0); PG8_MMA(1, 0, At, B0); PG8_BAR; PG8_SCHED;
            PG8_STAGE(PG8_SB(1, 1), b3 + hstep, voffB);
            PG8_WAIT_V(6); PG8_BAR; PG8_MMA(1, 1, At, B1); PG8_BAR;
            }
        }
        if constexpr (FP8) asm volatile("s_nop 15\n\ts_nop 15" ::: "memory");
        if constexpr (ALIGN_EPI) { if (wr == 0) PG8_BAR; }
        if constexpr (!Epi::AFTER_DRAIN) { E(acc, cur, wr, wc, fr, fq); S.done(cur); }
        if (!has_next) break;
#pragma unroll
        for (int a = 0; a < 2; ++a)
#pragma unroll
            for (int b = 0; b < 2; ++b)
#pragma unroll
                for (int m = 0; m < 4; ++m)
#pragma unroll
                    for (int n = 0; n < 2; ++n) acc[a][b][m][n] = (f32x4){0.f, 0.f, 0.f, 0.f};
        cur = nxt; cA = nA; cB = nB; ++ui;
        if constexpr (ALIGN_EPI) { if (wr == 1) PG8_BAR; }
    }
    PG8_WAIT_V(0);
    if constexpr (!ALIGN_EPI) { if (wr == 0) PG8_BAR; }
    PG8_BAR;
    if constexpr (Epi::AFTER_DRAIN) { E.fused(acc, cur, wr, wc, fr, fq, lds, wid, lane); S.done(cur); }
#undef PG8_SA
#undef PG8_SB
#undef PG8_STAGE
#undef PG8_LDA
#undef PG8_LDB
#undef PG8_MMA
#undef PG8_WAIT_V
#undef PG8_WAIT_L
#undef PG8_BAR
#undef PG8_SCHED
}
}

#ifndef MK_N_LAUNCHES
#define MK_N_LAUNCHES 1
#endif
constexpr int N_PHASES = 10;
constexpr int NBATCH = 8, TT = 2048, MTOK = NBATCH * TT, D = 1024;
constexpr int HK = 512, NH = 4, DK = 128, DV = 128, CCH = 512, CLEN = 31, INC = 3584;
constexpr int NE = 32, TOPK = 4, FF = 1024;
constexpr float EPS = 1e-5f, SW_LIMIT = 7.0f, SW_ALPHA = 1.702f;
constexpr int NWAVES = 8, NTHR = 512;
constexpr int MOE_ROWS = (MTOK * TOPK / 256 + NE) * 256;

constexpr size_t MiB = 1u << 20;
constexpr size_t WS_CTL = 0, CTL_ZERO_BYTES = 1 * MiB;
constexpr size_t WS_WI = 1 * MiB;
constexpr size_t WS_WO = 8 * MiB;
constexpr size_t WS_TAB = 10 * MiB;
constexpr size_t WS_W1 = 16 * MiB;
constexpr size_t WS_W2 = 144 * MiB;
constexpr size_t WS_H = 208 * MiB;
constexpr size_t WS_XN = 272 * MiB;
constexpr size_t WS_Q = 304 * MiB, WS_KF = 320 * MiB, WS_KB = 336 * MiB, WS_V = 352 * MiB, WS_G = 368 * MiB, WS_U = 384 * MiB;
constexpr size_t WS_LF = 400 * MiB, WS_LB = 432 * MiB;
constexpr size_t WS_OF = 464 * MiB, WS_OB = 496 * MiB;
constexpr size_t WS_MIX = 528 * MiB;
constexpr size_t WS_XS = 304 * MiB;
constexpr size_t WS_ACT = 448 * MiB;
constexpr size_t WS_YS = 592 * MiB;
constexpr size_t WS_END = 736 * MiB;
constexpr size_t WS_WRT = WS_TAB;
constexpr size_t WS_SLOT = WS_TAB + 256 * 1024;
constexpr size_t WS_GATE = WS_TAB + 512 * 1024;
constexpr size_t WS_ROWTOK = WS_TAB + 1 * MiB;
constexpr int CW_BAR = 4096;
constexpr int CW_CNT = 16384;

constexpr int RING_OFF = 0, RING_BYTES = 131072;
constexpr int LDSCTL_OFF = RING_BYTES;
constexpr int MISC_OFF = LDSCTL_OFF + 320;
constexpr int TAB_OFF = LDSCTL_OFF + 1024;
constexpr int SB_OFF = LDSCTL_OFF + 2048;
constexpr int LDS_BYTES = 147456;

#define GAS __attribute__((address_space(1)))
#define LAS __attribute__((address_space(3)))
typedef unsigned short bf16;
typedef unsigned v4u __attribute__((ext_vector_type(4)));
typedef unsigned v2u __attribute__((ext_vector_type(2)));
typedef float f32x4 __attribute__((ext_vector_type(4)));
typedef GAS unsigned gu32;
#define RLX_AGENT __ATOMIC_RELAXED, __HIP_MEMORY_SCOPE_AGENT
#define LDS_WAIT() asm volatile("s_waitcnt lgkmcnt(0)" ::: "memory")
#define VM_WAIT() asm volatile("s_waitcnt vmcnt(0)" ::: "memory")

__device__ __forceinline__ float bf2f(unsigned b) { return __uint_as_float(b << 16); }
__device__ __forceinline__ unsigned pk2(float lo, float hi) { return pg8::cvt_pk_bf16(lo, hi); }
__device__ __forceinline__ float sigm(float x) { return __builtin_amdgcn_rcpf(1.0f + __expf(-x)); }
__device__ __forceinline__ float wave_sum(float v) {
#pragma unroll
    for (int o = 1; o < 64; o <<= 1) v += __shfl_xor(v, o);
    return v;
}

constexpr float SC_W = 512.f, SC_N2 = 16.f, SC_ACT = 8.f;
__device__ __forceinline__ unsigned pk4_fp8(float a, float b, float c, float d) {
    a = fminf(fmaxf(a, -448.f), 448.f); b = fminf(fmaxf(b, -448.f), 448.f); c = fminf(fmaxf(c, -448.f), 448.f); d = fminf(fmaxf(d, -448.f), 448.f);
    int w = 0; w = __builtin_amdgcn_cvt_pk_fp8_f32(a, b, w, false); w = __builtin_amdgcn_cvt_pk_fp8_f32(c, d, w, true); return (unsigned)w;
}

#define XB_TMO      128
#define XB_XCNT(j)  (256  + 64 * (j))
#define XB_XSUB(j)  (1280 + 64 * (j))
#define XB_XGEN(j)  (2304 + 64 * (j))
#define XB_TOP      3328
#define XB_TOPGEN   3392
#define XCD_BAR_WORDS 3456
#define XB_SPIN_CAP (1u << 18)

__device__ __forceinline__ unsigned xb_ld(unsigned* p)              { return __hip_atomic_load(p, __ATOMIC_RELAXED, __HIP_MEMORY_SCOPE_AGENT); }
__device__ __forceinline__ unsigned xb_add(unsigned* p, unsigned v) { return __hip_atomic_fetch_add(p, v, __ATOMIC_RELAXED, __HIP_MEMORY_SCOPE_AGENT); }
__device__ __forceinline__ unsigned xb_xcc_id() { return (unsigned)__builtin_amdgcn_s_getreg((3 << 11) | 20) & 0xFu; }
#define XB_SPIN(cond, bar) do { unsigned _sp = 0; while (cond) { __builtin_amdgcn_s_sleep(1); \
    if ((++_sp & 255u) == 0u) { if (xb_ld(&(bar)[XB_TMO])) break; if (_sp > XB_SPIN_CAP) { atomicAdd(&(bar)[XB_TMO], 1u); break; } } } } while (0)

struct XcdBarrier {
    unsigned* bar; unsigned x;
    volatile LAS unsigned* st;
};
__device__ __forceinline__ XcdBarrier xcd_barrier_post(unsigned* bar, volatile LAS unsigned* st) {
    XcdBarrier b; b.bar = bar; b.x = xb_xcc_id(); b.st = st;
    if (threadIdx.x == 0) (void)xb_add(&bar[XB_XCNT(b.x)], 1u);
    return b;
}
__device__ __forceinline__ void xcd_barrier_complete(unsigned* bar, unsigned x, unsigned& nloc, unsigned& nx) {
    const unsigned G = gridDim.x * gridDim.y * gridDim.z;
    unsigned sum, cnt, mine, sp = 0u;
    for (;;) {
        sum = 0u; cnt = 0u; mine = 0u;
#pragma unroll
        for (unsigned j = 0; j < 16; ++j) { const unsigned c = xb_ld(&bar[XB_XCNT(j)]); sum += c; cnt += (c > 0u) ? 1u : 0u; mine = (j == x) ? c : mine; }
        if (sum == G) break;
        __builtin_amdgcn_s_sleep(1);
        if ((++sp & 255u) == 0u) { if (xb_ld(&bar[XB_TMO])) break; if (sp > XB_SPIN_CAP) { atomicAdd(&bar[XB_TMO], 1u); break; } }
    }
    nloc = mine > 0u ? mine : 1u; nx = cnt > 0u ? cnt : 1u;
}
__device__ __forceinline__ void xcd_barrier(const XcdBarrier& b) {
    asm volatile("s_waitcnt vmcnt(0)" ::: "memory");
    __syncthreads();
    if (threadIdx.x == 0) {
        unsigned* bar = b.bar;
        __builtin_amdgcn_s_waitcnt(0);
        unsigned nloc = b.st[0], nx = b.st[1];
        if (nloc == 0u) { xcd_barrier_complete(bar, b.x, nloc, nx); b.st[0] = nloc; b.st[1] = nx; }
        const unsigned old = xb_add(&bar[XB_XSUB(b.x)], 1u);
        const unsigned gen = old / nloc;
        if (old + 1u == (gen + 1u) * nloc) {
            __builtin_amdgcn_fence(__ATOMIC_RELEASE, "agent");
            asm volatile("s_waitcnt vmcnt(0)" ::: "memory");
            const unsigned og = xb_add(&bar[XB_TOP], 1u);
            const unsigned tg = og / nx;
            if (og + 1u == (tg + 1u) * nx) xb_add(&bar[XB_TOPGEN], 1u);
            else XB_SPIN(xb_ld(&bar[XB_TOPGEN]) == tg, bar);
            __builtin_amdgcn_fence(__ATOMIC_ACQUIRE, "agent");
            xb_add(&bar[XB_XGEN(b.x)], 1u);
            asm volatile("s_waitcnt vmcnt(0)" ::: "memory");
        } else {
            XB_SPIN(xb_ld(&bar[XB_XGEN(b.x)]) == gen, bar);
            __builtin_amdgcn_fence(__ATOMIC_ACQUIRE, "agent");
            asm volatile("s_waitcnt vmcnt(0)" ::: "memory");
        }
    }
    __syncthreads();
}

__device__ __forceinline__ void st8bf(bf16* p, const f32x4& a, const f32x4& b) {
    v4u w; w.x = pk2(a[0], a[1]); w.y = pk2(a[2], a[3]); w.z = pk2(b[0], b[1]); w.w = pk2(b[2], b[3]);
    *(v4u*)p = w;
}
struct EpiProj {
    static constexpr bool PERM = true, AFTER_DRAIN = false;
    bf16 *Q, *KF, *KB, *V, *G, *U; float *LF, *LB; const float* lbl;
    template <int TYP>
    __device__ __forceinline__ void tile(const pg8::f32x4 (&acc)[2][2][4][2], int row0, int cb) const {
#pragma unroll
        for (int bj = 0; bj < 2; ++bj) {
            const int col = cb + bj * 128;
            float lb[8];
            if (TYP == 1 || TYP == 2) {
                const float* L = lbl + (TYP - 1) * 1024 + col;
#pragma unroll
                for (int i = 0; i < 8; ++i) lb[i] = __builtin_amdgcn_rcpf(1.0f + __expf(L[512 + i] - L[i]));
            }
#pragma unroll
            for (int ai = 0; ai < 2; ++ai)
#pragma unroll
                for (int m = 0; m < 4; ++m) {
                    const size_t off = (size_t)(row0 + ai * 128 + m * 16) * 512 + col;
                    f32x4 a = acc[ai][bj][m][0], b = acc[ai][bj][m][1];
                    if (TYP == 0 || TYP == 4) {
#pragma unroll
                        for (int i = 0; i < 4; ++i) { a[i] = a[i] * sigm(a[i]); b[i] = b[i] * sigm(b[i]); }
                        st8bf((TYP == 0 ? Q : G) + off, a, b);
                    } else if (TYP == 3) {
                        st8bf(V + off, a, b);
                    } else {
                        f32x4 la, lbv, ka, kb;
#pragma unroll
                        for (int i = 0; i < 4; ++i) {
                            const float fa = lb[i] + (1.0f - lb[i]) * sigm(a[i]), fb = lb[4 + i] + (1.0f - lb[4 + i]) * sigm(b[i]);
                            la[i] = __logf(fa); lbv[i] = __logf(fb); ka[i] = 1.0f - fa; kb[i] = 1.0f - fb;
                        }
                        float* Lp = (TYP == 1 ? LF : LB) + off;
                        *(f32x4*)Lp = la; *(f32x4*)(Lp + 4) = lbv;
                        st8bf((TYP == 1 ? KF : KB) + off, ka, kb);
                    }
                }
        }
    }
    __device__ __forceinline__ void operator()(const pg8::f32x4 (&acc)[2][2][4][2], const pg8::Unit& u, int wr, int wc, int fr, int fq) const {
        const int row0 = u.pm * 256 + wr * 64 + fr, pn = u.pn;
        if (pn >= 10) {
            const int col = (pn - 10) * 128 + wc * 32 + 8 * fq;
#pragma unroll
            for (int ai = 0; ai < 2; ++ai)
#pragma unroll
                for (int m = 0; m < 4; ++m) {
                    f32x4 a = acc[ai][0][m][0], b = acc[ai][0][m][1]; const f32x4 ga = acc[ai][1][m][0], gb = acc[ai][1][m][1];
#pragma unroll
                    for (int i = 0; i < 4; ++i) { a[i] = a[i] * sigm(ga[i]); b[i] = b[i] * sigm(gb[i]); }
                    st8bf(U + (size_t)(row0 + ai * 128 + m * 16) * 512 + col, a, b);
                }
        } else {
            const int cb = (pn & 1) * 256 + wc * 32 + 8 * fq, typ = pn >> 1;
            if (typ == 0) tile<0>(acc, row0, cb);
            else if (typ == 1) tile<1>(acc, row0, cb);
            else if (typ == 2) tile<2>(acc, row0, cb);
            else if (typ == 3) tile<3>(acc, row0, cb);
            else tile<4>(acc, row0, cb);
        }
    }
};
struct EpiRes {
    static constexpr bool PERM = false, AFTER_DRAIN = false;
    const float* X; float* H;
    __device__ __forceinline__ void operator()(const pg8::f32x4 (&acc)[2][2][4][2], const pg8::Unit& u, int wr, int wc, int fr, int fq) const {
        const int row0 = u.pm * 256 + wr * 64 + fr, col0 = u.pn * 256 + wc * 32 + 4 * fq;
#pragma unroll
        for (int ai = 0; ai < 2; ++ai)
#pragma unroll
            for (int m = 0; m < 4; ++m) {
                const size_t off = (size_t)(row0 + ai * 128 + m * 16) * D + col0;
#pragma unroll
                for (int bj = 0; bj < 2; ++bj)
#pragma unroll
                    for (int n = 0; n < 2; ++n) { const f32x4 xv = *(const f32x4*)(X + off + bj * 128 + n * 16); *(f32x4*)(H + off + bj * 128 + n * 16) = xv + acc[ai][bj][m][n]; }
            }
    }
};
struct EpiSwiglu {
    static constexpr bool PERM = true, AFTER_DRAIN = false;
    unsigned char* ACT; const float* b1;
    __device__ __forceinline__ void operator()(const pg8::f32x4 (&acc)[2][2][4][2], const pg8::Unit& u, int wr, int wc, int fr, int fq) const {
        const int e = u.pn >> 3, pn = u.pn & 7, row0 = u.pm * 256 + wr * 64 + fr, col = pn * 128 + wc * 32 + 8 * fq;
        const float* bg = b1 + (size_t)e * 2048 + col; const float* bl = bg + 1024;
        float g[8], l[8];
#pragma unroll
        for (int i = 0; i < 8; ++i) { g[i] = bg[i]; l[i] = bl[i]; }
#pragma unroll
        for (int ai = 0; ai < 2; ++ai)
#pragma unroll
            for (int m = 0; m < 4; ++m) {
                f32x4 o[2];
#pragma unroll
                for (int n = 0; n < 2; ++n)
#pragma unroll
                    for (int i = 0; i < 4; ++i) {
                        const float hg = fminf(acc[ai][0][m][n][i] * (1.0f / (SC_N2 * SC_W)) + g[4 * n + i], SW_LIMIT);
                        const float hl = fminf(fmaxf(acc[ai][1][m][n][i] * (1.0f / (SC_N2 * SC_W)) + l[4 * n + i], -SW_LIMIT), SW_LIMIT);
                        o[n][i] = hg * sigm(SW_ALPHA * hg) * (hl + 1.0f) * SC_ACT;
                    }
                v2u w; w.x = pk4_fp8(o[0][0], o[0][1], o[0][2], o[0][3]); w.y = pk4_fp8(o[1][0], o[1][1], o[1][2], o[1][3]);
                *(v2u*)(ACT + (size_t)(row0 + ai * 128 + m * 16) * FF + col) = w;
            }
    }
};
struct EpiDown {
    static constexpr bool PERM = true, AFTER_DRAIN = false;
    bf16* YS; const float* b2;
    __device__ __forceinline__ void operator()(const pg8::f32x4 (&acc)[2][2][4][2], const pg8::Unit& u, int wr, int wc, int fr, int fq) const {
        const int e = u.pn >> 2, pn = u.pn & 3, row0 = u.pm * 256 + wr * 64 + fr, col0 = pn * 256 + wc * 32 + 8 * fq;
#pragma unroll
        for (int bj = 0; bj < 2; ++bj) {
            const float* bp = b2 + (size_t)e * D + col0 + bj * 128;
            const f32x4 b0 = *(const f32x4*)bp, b1v = *(const f32x4*)(bp + 4);
#pragma unroll
            for (int ai = 0; ai < 2; ++ai)
#pragma unroll
                for (int m = 0; m < 4; ++m)
                    st8bf(YS + (size_t)(row0 + ai * 128 + m * 16) * D + col0 + bj * 128, acc[ai][bj][m][0] * (1.0f / (SC_ACT * SC_W)) + b0, acc[ai][bj][m][1] * (1.0f / (SC_ACT * SC_W)) + b1v);
        }
    }
};
struct MoeOrder {
    const volatile LAS int* bs; int ntn, G, v;
    __device__ __forceinline__ bool next(int i, pg8::Unit& u) const {
        const int L = i * G + v, nb = bs[32];
        if (L >= nb * ntn) return false;
        const int mb = L / ntn, pn = L - mb * ntn;
        int e = 0;
        while (e < NE - 1 && bs[e + 1] <= mb) ++e;
        u.pm = mb; u.pn = e * ntn + pn; return true;
    }
    __device__ __forceinline__ void a_ready(const pg8::Unit&) const {}
    __device__ __forceinline__ void done(const pg8::Unit&) const {}
};

struct RmIdent { __device__ __forceinline__ int operator()(int n) const { return n; } };
struct RmWin {
    __device__ __forceinline__ int operator()(int n) const {
        if (n < 2560) return n;
        if (n < 3072) { const int j = n - 2560; return 2560 + (j >> 7) * 256 + (j & 127); }
        const int j = n - 3072; return 2560 + (j >> 7) * 256 + 128 + (j & 127);
    }
};
struct RmW1 {
    __device__ __forceinline__ int operator()(int n) const {
        if (n < 1024) return (n >> 7) * 256 + (n & 127);
        const int j = n - 1024; return (j >> 7) * 256 + 128 + (j & 127);
    }
};
template <class RM>
__device__ __forceinline__ void p0_transpose_item(const float* W, int K, int N, bf16* WT, RM rm, LAS float* scr, int item, int lane) {
    const int nblk = N / 32, kb = item / nblk, nb = item % nblk, k0 = 64 * kb, n0 = 32 * nb;
#pragma unroll 8
    for (int i = 0; i < 32; ++i) { const int kk = 2 * i + (lane >> 5); scr[kk * 33 + (lane & 31)] = W[(size_t)(k0 + kk) * N + n0 + (lane & 31)]; }
    LDS_WAIT(); asm volatile("" ::: "memory");
    const int c = lane & 7;
#pragma unroll
    for (int j = 0; j < 4; ++j) { const int n = (lane >> 3) + 8 * j; const LAS float* s = scr + (8 * c) * 33 + n;
        v4u o; o.x = pk2(s[0 * 33], s[1 * 33]); o.y = pk2(s[2 * 33], s[3 * 33]); o.z = pk2(s[4 * 33], s[5 * 33]); o.w = pk2(s[6 * 33], s[7 * 33]);
        *(GAS v4u*)(WT + (size_t)rm(n0 + n) * K + k0 + 8 * c) = o; }
    LDS_WAIT(); asm volatile("" ::: "memory");
}

template <class RM>
__device__ __forceinline__ void p0_transpose_item_fp8(const float* W, int K, int N, unsigned char* WT, RM rm, LAS float* scr, int item, int lane) {
    const int nblk = N / 32, kb = item / nblk, nb = item % nblk, k0 = 64 * kb, n0 = 32 * nb;
#pragma unroll 8
    for (int i = 0; i < 32; ++i) { const int kk = 2 * i + (lane >> 5); scr[kk * 33 + (lane & 31)] = W[(size_t)(k0 + kk) * N + n0 + (lane & 31)]; }
    LDS_WAIT(); asm volatile("" ::: "memory");
    const int n = lane >> 1, kc = lane & 1; const LAS float* s = scr + (32 * kc) * 33 + n;
    unsigned w[8];
#pragma unroll
    for (int j = 0; j < 8; ++j) w[j] = pk4_fp8(s[(4 * j) * 33] * SC_W, s[(4 * j + 1) * 33] * SC_W, s[(4 * j + 2) * 33] * SC_W, s[(4 * j + 3) * 33] * SC_W);
    GAS v4u* dst = (GAS v4u*)(WT + (size_t)rm(n0 + n) * K + k0 + 32 * kc);
    dst[0] = (v4u){w[0], w[1], w[2], w[3]}; dst[1] = (v4u){w[4], w[5], w[6], w[7]};
    LDS_WAIT(); asm volatile("" ::: "memory");
}
__device__ __forceinline__ void rms_row_to_bf16(const float* xrow, const float* w, bf16* orow, int lane) {
    const f32x4* xr = (const f32x4*)xrow + lane; const f32x4* wr = (const f32x4*)w + lane;
    f32x4 v[4]; float s = 0.f;
#pragma unroll
    for (int j = 0; j < 4; ++j) { v[j] = xr[64 * j]; s += (v[j].x * v[j].x + v[j].y * v[j].y) + (v[j].z * v[j].z + v[j].w * v[j].w); }
    const float rstd = rsqrtf(wave_sum(s) * (1.f / D) + EPS);
    v2u* o8 = (v2u*)orow + lane;
#pragma unroll
    for (int j = 0; j < 4; ++j) { const f32x4 g = wr[64 * j]; v2u o; o.x = pk2(v[j].x * rstd * g.x, v[j].y * rstd * g.y); o.y = pk2(v[j].z * rstd * g.z, v[j].w * rstd * g.w); o8[64 * j] = o; }
}


__device__ __forceinline__ pg8::bf16x8 lds_frag(const LAS unsigned char* p) { return *(const LAS pg8::bf16x8*)p; }
__device__ __forceinline__ void hgrn_unit(LAS unsigned char* lds, int unit, const bf16* Qb, const bf16* KFb, const bf16* KBb, const bf16* Vb, const float* LFb, const float* LBb,
                                          float* OFb, float* OBb, int tid, int lane, int wave) {
    constexpr int BF_OFF = 0, AM_OFF = 0, QI_OFF = 33792, KK_OFF = 51200, KET_OFF = 68608, VT_OFF = 87040, ST_OFF = 96256, SEG_OFF = 113664, DEC_OFF = 115712;
    constexpr int RS_D = 272, RS_S = 144, RS_BF = 528;
    const int vh = unit & 1, dir = (unit >> 1) & 1, h = (unit >> 2) & 3, b = unit >> 4;
    const bf16* Kp = dir ? KBb : KFb; const float* Lp = dir ? LBb : LFb; float* Op = dir ? OBb : OFb;
    const int lr = lane & 15, lq = lane >> 4;
    const int dA = tid & 127, seg = tid >> 7;
    const int tauB = tid >> 3, dg = tid & 7;
    for (int i = tid; i < 64 * RS_D / 16; i += NTHR) *(LAS v4u*)(lds + ST_OFF + i * 16) = (v4u){0u, 0u, 0u, 0u};
    f32x4 S[4];
#pragma unroll
    for (int i = 0; i < 4; ++i) S[i] = (f32x4){0.f, 0.f, 0.f, 0.f};
    float lf[16]; unsigned kA[16]; v4u qB[2], kB[2], vB;
#define HG_LOAD(n_) do { const int tbn_ = b * TT + (dir ? (TT / 64 - 1 - (n_)) * 64 : (n_) * 64); \
        _Pragma("unroll") for (int i = 0; i < 16; ++i) { const int tau_ = 16 * seg + i; const size_t off_ = (size_t)(dir ? tbn_ + 63 - tau_ : tbn_ + tau_) * 512 + h * 128 + dA; lf[i] = Lp[off_]; kA[i] = Kp[off_]; } \
        const size_t offB_ = (size_t)(dir ? tbn_ + 63 - tauB : tbn_ + tauB) * 512 + h * 128; \
        qB[0] = *(const v4u*)(Qb + offB_ + 16 * dg); qB[1] = *(const v4u*)(Qb + offB_ + 16 * dg + 8); kB[0] = *(const v4u*)(Kp + offB_ + 16 * dg); kB[1] = *(const v4u*)(Kp + offB_ + 16 * dg + 8); \
        vB = *(const v4u*)(Vb + offB_ + vh * 64 + 8 * dg); } while (0)
    HG_LOAD(0);
#pragma unroll 1
    for (int n = 0; n < TT / 64; ++n) {
        const int tb = b * TT + (dir ? (TT / 64 - 1 - n) * 64 : n * 64);
        float bl[16]; { float c = 0.f;
#pragma unroll
            for (int i = 0; i < 16; ++i) { c += lf[i]; bl[i] = c; }
            *(LAS float*)(lds + SEG_OFF + (seg * 128 + dA) * 4) = c; }
        __syncthreads();
        {
            const float p0 = *(LAS float*)(lds + SEG_OFF + (0 * 128 + dA) * 4), p1 = *(LAS float*)(lds + SEG_OFF + (1 * 128 + dA) * 4),
                        p2 = *(LAS float*)(lds + SEG_OFF + (2 * 128 + dA) * 4), p3 = *(LAS float*)(lds + SEG_OFF + (3 * 128 + dA) * 4);
            const float pre = (seg > 0 ? p0 : 0.f) + (seg > 1 ? p1 : 0.f) + (seg > 2 ? p2 : 0.f), bend = (p0 + p1) + (p2 + p3);
            float ke[16];
#pragma unroll
            for (int i = 0; i < 16; ++i) { const float bb = pre + bl[i]; *(LAS float*)(lds + BF_OFF + (16 * seg + i) * RS_BF + dA * 4) = bb; ke[i] = bf2f(kA[i]) * __expf(bend - bb); }
            v4u w0, w1;
            w0.x = pk2(ke[0], ke[1]); w0.y = pk2(ke[2], ke[3]); w0.z = pk2(ke[4], ke[5]); w0.w = pk2(ke[6], ke[7]);
            w1.x = pk2(ke[8], ke[9]); w1.y = pk2(ke[10], ke[11]); w1.z = pk2(ke[12], ke[13]); w1.w = pk2(ke[14], ke[15]);
            *(LAS v4u*)(lds + KET_OFF + dA * RS_S + seg * 32) = w0; *(LAS v4u*)(lds + KET_OFF + dA * RS_S + seg * 32 + 16) = w1;
            if (seg == 0) *(LAS float*)(lds + DEC_OFF + dA * 4) = __expf(bend);
        }
        __syncthreads();
        {
            const unsigned qw[8] = {qB[0].x, qB[0].y, qB[0].z, qB[0].w, qB[1].x, qB[1].y, qB[1].z, qB[1].w};
            const unsigned kw[8] = {kB[0].x, kB[0].y, kB[0].z, kB[0].w, kB[1].x, kB[1].y, kB[1].z, kB[1].w};
            unsigned qo[8], ko[8];
#pragma unroll
            for (int i = 0; i < 4; ++i) {
                const f32x4 bb = *(const LAS f32x4*)(lds + BF_OFF + tauB * RS_BF + dg * 64 + i * 16);
#pragma unroll
                for (int j = 0; j < 2; ++j) {
                    const float e0 = __expf(bb[2 * j]), e1 = __expf(bb[2 * j + 1]);
                    const unsigned qq = qw[2 * i + j], kk = kw[2 * i + j];
                    qo[2 * i + j] = pk2(bf2f(qq & 0xffffu) * e0, bf2f(qq >> 16) * e1);
                    ko[2 * i + j] = pk2(bf2f(kk & 0xffffu) * __builtin_amdgcn_rcpf(e0), bf2f(kk >> 16) * __builtin_amdgcn_rcpf(e1));
                }
            }
            *(LAS v4u*)(lds + QI_OFF + tauB * RS_D + dg * 32) = (v4u){qo[0], qo[1], qo[2], qo[3]}; *(LAS v4u*)(lds + QI_OFF + tauB * RS_D + dg * 32 + 16) = (v4u){qo[4], qo[5], qo[6], qo[7]};
            *(LAS v4u*)(lds + KK_OFF + tauB * RS_D + dg * 32) = (v4u){ko[0], ko[1], ko[2], ko[3]}; *(LAS v4u*)(lds + KK_OFF + tauB * RS_D + dg * 32 + 16) = (v4u){ko[4], ko[5], ko[6], ko[7]};
            const unsigned vw[4] = {vB.x, vB.y, vB.z, vB.w};
#pragma unroll
            for (int c = 0; c < 4; ++c) {
                *(LAS unsigned short*)(lds + VT_OFF + (8 * dg + 2 * c) * RS_S + tauB * 2) = (unsigned short)(vw[c] & 0xffffu);
                *(LAS unsigned short*)(lds + VT_OFF + (8 * dg + 2 * c + 1) * RS_S + tauB * 2) = (unsigned short)(vw[c] >> 16);
            }
        }
        __syncthreads();
        if (n + 1 < TT / 64) HG_LOAD(n + 1);
        const int ei = wave & 3, tp = wave >> 2;
        {
            const int ti = wave & 3;
#pragma unroll
            for (int sii = 0; sii < 2; ++sii) {
                const int si = tp * 2 + sii;
                v2u w = (v2u){0u, 0u};
                if (si <= ti) {
                    f32x4 a = (f32x4){0.f, 0.f, 0.f, 0.f};
#pragma unroll
                    for (int kk = 0; kk < 4; ++kk)
                        a = __builtin_amdgcn_mfma_f32_16x16x32_bf16(lds_frag(lds + KK_OFF + (16 * si + lr) * RS_D + kk * 64 + lq * 16), lds_frag(lds + QI_OFF + (16 * ti + lr) * RS_D + kk * 64 + lq * 16), a, 0, 0, 0);
                    const int s0 = 16 * si + 4 * lq, t = 16 * ti + lr;
                    w.x = pk2(s0 + 0 <= t ? a[0] : 0.f, s0 + 1 <= t ? a[1] : 0.f); w.y = pk2(s0 + 2 <= t ? a[2] : 0.f, s0 + 3 <= t ? a[3] : 0.f);
                }
                *(LAS v2u*)(lds + AM_OFF + (16 * ti + lr) * RS_S + (16 * si + 4 * lq) * 2) = w;
            }
        }
        f32x4 o[2];
#pragma unroll
        for (int tt = 0; tt < 2; ++tt) {
            o[tt] = (f32x4){0.f, 0.f, 0.f, 0.f};
#pragma unroll
            for (int kk = 0; kk < 4; ++kk)
                o[tt] = __builtin_amdgcn_mfma_f32_16x16x32_bf16(lds_frag(lds + ST_OFF + (16 * ei + lr) * RS_D + kk * 64 + lq * 16), lds_frag(lds + QI_OFF + (16 * (2 * tp + tt) + lr) * RS_D + kk * 64 + lq * 16), o[tt], 0, 0, 0);
        }
        {
            const f32x4 dv = *(const LAS f32x4*)(lds + DEC_OFF + (16 * wave + 4 * lq) * 4);
#pragma unroll
            for (int e4 = 0; e4 < 4; ++e4) S[e4] = S[e4] * dv;
#pragma unroll
            for (int kk = 0; kk < 2; ++kk) {
                const pg8::bf16x8 af = lds_frag(lds + KET_OFF + (16 * wave + lr) * RS_S + kk * 64 + lq * 16);
#pragma unroll
                for (int e4 = 0; e4 < 4; ++e4) S[e4] = __builtin_amdgcn_mfma_f32_16x16x32_bf16(af, lds_frag(lds + VT_OFF + (16 * e4 + lr) * RS_S + kk * 64 + lq * 16), S[e4], 0, 0, 0);
            }
        }
        __syncthreads();
#pragma unroll
        for (int tt = 0; tt < 2; ++tt) {
#pragma unroll
            for (int kk = 0; kk < 2; ++kk)
                o[tt] = __builtin_amdgcn_mfma_f32_16x16x32_bf16(lds_frag(lds + VT_OFF + (16 * ei + lr) * RS_S + kk * 64 + lq * 16), lds_frag(lds + AM_OFF + (16 * (2 * tp + tt) + lr) * RS_S + kk * 64 + lq * 16), o[tt], 0, 0, 0);
            const int t = 16 * (2 * tp + tt) + lr;
            *(f32x4*)(Op + (size_t)(dir ? tb + 63 - t : tb + t) * 512 + h * 128 + vh * 64 + 16 * ei + 4 * lq) = o[tt];
        }
#pragma unroll
        for (int e4 = 0; e4 < 4; ++e4) { v2u w; w.x = pk2(S[e4][0], S[e4][1]); w.y = pk2(S[e4][2], S[e4][3]); *(LAS v2u*)(lds + ST_OFF + (16 * e4 + lr) * RS_D + (16 * wave + 4 * lq) * 2) = w; }
    }
#undef HG_LOAD
    __syncthreads();
}

struct Args { const float* in[18]; float* out; unsigned char* ws; int ph_lo, ph_hi; };
__global__ void __launch_bounds__(NTHR, 2) fwd_kernel(Args args) {
    extern __shared__ __attribute__((aligned(16))) unsigned char lds_raw[];
    LAS unsigned char* lds = (LAS unsigned char*)lds_raw;
    volatile LAS unsigned* MISC = (volatile LAS unsigned*)(lds + MISC_OFF);
    const int tid = threadIdx.x, lane = tid & 63, wave = __builtin_amdgcn_readfirstlane(tid >> 6);
    const int G = gridDim.x; const int bx = blockIdx.x; const int vcu = (G % 8 == 0) ? (bx % 8) * (G / 8) + bx / 8 : bx;
    const int gw = vcu * NWAVES + wave, NGW = G * NWAVES;
    unsigned char* ws = args.ws;
    unsigned* ctl = (unsigned*)(ws + WS_CTL);
    const float* x = args.in[0]; const float* norm1_w = args.in[1]; const float* w_in = args.in[2]; const float* lb_logits = args.in[3];
    const float* hgrn_norm_w = args.in[4]; const float* dw_w = args.in[5]; const float* dw_b = args.in[6]; const float* conv_ln_w = args.in[7]; const float* conv_ln_b = args.in[8];
    const float* w_out = args.in[9]; const float* norm2_w = args.in[10]; const float* router_w = args.in[11]; const float* router_b = args.in[12];
    const float* w1 = args.in[13]; const float* b1 = args.in[14]; const float* w2 = args.in[15]; const float* b2 = args.in[16]; const float* final_norm_w = args.in[17];
    float* out = args.out;
    bf16* WI = (bf16*)(ws + WS_WI); bf16* WO = (bf16*)(ws + WS_WO); unsigned char* W1T = ws + WS_W1; unsigned char* W2T = ws + WS_W2;
    float* H = (float*)(ws + WS_H); bf16* XN = (bf16*)(ws + WS_XN);
    bf16* Qb = (bf16*)(ws + WS_Q); bf16* KFb = (bf16*)(ws + WS_KF); bf16* KBb = (bf16*)(ws + WS_KB); bf16* Vb = (bf16*)(ws + WS_V); bf16* Gb = (bf16*)(ws + WS_G); bf16* Ub = (bf16*)(ws + WS_U);
    float* LFb = (float*)(ws + WS_LF); float* LBb = (float*)(ws + WS_LB); float* OFb = (float*)(ws + WS_OF); float* OBb = (float*)(ws + WS_OB);
    bf16* MIX = (bf16*)(ws + WS_MIX); unsigned char* XS = ws + WS_XS; unsigned char* ACT = ws + WS_ACT; unsigned char* N2 = ws + WS_XN; bf16* YS = (bf16*)(ws + WS_YS);
    float* WRT = (float*)(ws + WS_WRT); int* SLOT = (int*)(ws + WS_SLOT); float* GATE = (float*)(ws + WS_GATE); int* ROWTOK = (int*)(ws + WS_ROWTOK);
    volatile LAS int* bs = (volatile LAS int*)(lds + TAB_OFF);
    volatile LAS int* cl = (volatile LAS int*)(lds + TAB_OFF + 256);
    LAS int* lcnt = (LAS int*)(lds + TAB_OFF + 512);
    volatile LAS int* gbase = (volatile LAS int*)(lds + TAB_OFF + 768);

    for (int u = tid; u < (LDS_BYTES - LDSCTL_OFF) / 4; u += NTHR) ((LAS unsigned*)(lds + LDSCTL_OFF))[u] = 0u;
    __syncthreads();
    XcdBarrier bar; bar.bar = ctl + CW_BAR; bar.x = 0; bar.st = nullptr;
    if (MK_N_LAUNCHES == 1) bar = xcd_barrier_post(ctl + CW_BAR, MISC + 8);
    const int lo = args.ph_lo, hi = args.ph_hi;
#ifndef PHASE_MASK
#define PHASE_MASK 0xffffffffu
#endif
#define IN(k) ((((PHASE_MASK) >> (k)) & 1u) && lo <= (k) && (k) < hi)
#ifndef PROBE_DUP
#define PROBE_DUP -1
#endif
#define REP(k) for (int rep_ = 0; rep_ < ((PROBE_DUP) == (k) ? 2 : 1); ++rep_)
#define SEAM(k) do { if (IN(k) && IN((k) + 1)) xcd_barrier(bar); } while (0)
#define BUILD_BS() do { if (tid == 0) { int a_ = 0; for (int e_ = 0; e_ < NE; ++e_) { bs[e_] = a_; const int c_ = (int)__hip_atomic_load(ctl + CW_CNT + 64 * e_, RLX_AGENT); cl[e_] = c_; a_ += (c_ + 255) >> 8; } bs[NE] = a_; } __syncthreads(); } while (0)

    if (IN(0)) REP(0) {
        LAS float* scr = (LAS float*)(lds + RING_OFF + wave * 16384);
        constexpr int I_WI = (D / 64) * (INC / 32), I_WO = (D / 64) * (D / 32), I_W1 = (D / 64) * (2 * FF / 32), I_W2 = (FF / 64) * (D / 32);
        #if defined(HGRN_NAIVE)
        constexpr int NITEMS = I_WI + I_WO + NE * I_W1 + NE * I_W2;
#else
        constexpr int NITEMS = I_WI + I_WO + NE * I_W1;
#endif
        for (int it = gw; it < NITEMS; it += NGW) {
            int r = it;
            if (r < I_WI) { p0_transpose_item(w_in, D, INC, WI, RmWin(), scr, r, lane); continue; } r -= I_WI;
            if (r < I_WO) { p0_transpose_item(w_out, D, D, WO, RmIdent(), scr, r, lane); continue; } r -= I_WO;
            if (r < NE * I_W1) { const int e = r / I_W1; p0_transpose_item_fp8(w1 + (size_t)e * D * 2 * FF, D, 2 * FF, W1T + (size_t)e * 2 * FF * D, RmW1(), scr, r - e * I_W1, lane); continue; } r -= NE * I_W1;
#if defined(HGRN_NAIVE)
            { const int e = r / I_W2; p0_transpose_item_fp8(w2 + (size_t)e * FF * D, FF, D, W2T + (size_t)e * D * FF, RmIdent(), scr, r - e * I_W2, lane); }
#endif
        }
        for (int m = gw; m < MTOK; m += NGW) rms_row_to_bf16(x + (size_t)m * D, norm1_w, XN + (size_t)m * D, lane);
        for (int i = bx * NTHR + tid; i < NE * D; i += G * NTHR) { const int e = i >> 10, c = i & 1023; WRT[i] = router_w[c * NE + e]; }
    }
    SEAM(0);

    if (IN(1)) REP(1) {
        pg8::Gemm g{XN, WI, MTOK, INC, D}; pg8::StaticOrder S; S.init(MTOK, INC, G, bx);
        EpiProj E{Qb, KFb, KBb, Vb, Gb, Ub, LFb, LBb, lb_logits};
        pg8::gemm_phase<EpiProj, pg8::StaticOrder, true, true>(lds + RING_OFF, g, S, E);
    }
    SEAM(1);

    if (IN(2)) REP(2) {
        const bool split = (G == 256);
#if defined(HGRN_NAIVE)
        const bool hsel = true; const int hidx = 0, hstride = 1; const bool csel = true; const int cidx = vcu, cstride = G;
#else
        const bool hsel = split ? (((bx >> 3) & 1) != 0) : true; const int hidx = split ? (bx >> 4) * 8 + (bx & 7) : bx, hstride = split ? 128 : G;
        const bool csel = split ? !hsel : true; const int cidx = split ? (bx >> 4) * 8 + (bx & 7) : bx, cstride = split ? 128 : G;
#endif
        (void)hidx; (void)hstride;
        if (csel) for (int crep_ = 0; crep_ < ((PROBE_DUP) == 21 ? 2 : 1); ++crep_) {
            LAS unsigned short* ut = (LAS unsigned short*)(lds + RING_OFF);
            LAS float* part = (LAS float*)(lds + RING_OFF + 98304);
            LAS float* stat = (LAS float*)(lds + RING_OFF + 98304 + 4096);
            for (int unit = cidx; unit < NBATCH * (TT / 64); unit += cstride) {
                const int b = unit / (TT / 64), t0 = (unit % (TT / 64)) * 64;
                for (int idx = tid; idx < 94 * 64; idx += NTHR) {
                    const int r = idx >> 6, p = idx & 63, t = t0 - 15 + r;
                    v4u val = (v4u){0u, 0u, 0u, 0u};
                    if (t >= 0 && t < TT) val = *(const v4u*)(Ub + (size_t)(b * TT + t) * CCH + p * 8);
                    *(LAS v4u*)(ut + r * 512 + p * 8) = val;
                }
                __syncthreads();
                const int c = tid;
                float w[CLEN];
#pragma unroll
                for (int j = 0; j < CLEN; ++j) w[j] = dw_w[j * CCH + c];
                const float bias = dw_b[c];
                float y[64];
#pragma unroll
                for (int tb = 0; tb < 8; ++tb) {
                    float win[38];
#pragma unroll
                    for (int i = 0; i < 38; ++i) win[i] = bf2f(ut[(tb * 8 + i) * 512 + c]);
#pragma unroll
                    for (int o = 0; o < 8; ++o) { float a = bias;
#pragma unroll
                        for (int j = 0; j < CLEN; ++j) a += w[j] * win[o + j];
                        y[tb * 8 + o] = a; }
                }
#pragma unroll 1
                for (int pass = 0; pass < 2; ++pass) {
                    float s1[64];
#pragma unroll
                    for (int i = 0; i < 64; ++i) s1[i] = pass ? y[i] * y[i] : y[i];
#pragma unroll
                    for (int s = 32; s >= 1; s >>= 1) {
                        const bool up = (lane & s) != 0;
#pragma unroll
                        for (int i = 0; i < s; ++i) { const float k1 = up ? s1[i + s] : s1[i], x1 = up ? s1[i] : s1[i + s]; s1[i] = k1 + __shfl_xor(x1, s); }
                    }
                    part[(wave * 64 + lane) * 2 + pass] = s1[0];
                }
                __syncthreads();
                if (tid < 64) { float a = 0.f, q = 0.f;
#pragma unroll
                    for (int wv = 0; wv < 8; ++wv) { a += part[(wv * 64 + tid) * 2]; q += part[(wv * 64 + tid) * 2 + 1]; }
                    const float mean = a * (1.f / CCH), var = q * (1.f / CCH) - mean * mean;
                    stat[tid * 2] = mean; stat[tid * 2 + 1] = rsqrtf(fmaxf(var, 0.f) + EPS); }
                __syncthreads();
                const float lw = conv_ln_w[c], lbias = conv_ln_b[c];
#pragma unroll
                for (int t = 0; t < 64; ++t) {
                    const float v = (y[t] - stat[t * 2]) * stat[t * 2 + 1] * lw + lbias;
                    MIX[(size_t)(b * TT + t0 + t) * D + 512 + c] = (bf16)(pk2(v * sigm(v), 0.f) & 0xffffu);
                }
                __syncthreads();
            }
#if !defined(HGRN_NAIVE)
            {
                LAS float* scr = (LAS float*)(lds + RING_OFF + wave * 16384);
                constexpr int I_W2 = (FF / 64) * (D / 32);
                for (int it = cidx * NWAVES + wave; it < NE * I_W2; it += cstride * NWAVES) { const int e = it / I_W2;
                    p0_transpose_item_fp8(w2 + (size_t)e * FF * D, FF, D, W2T + (size_t)e * D * FF, RmIdent(), scr, it - e * I_W2, lane); }
            }
#endif
        }
#if defined(HGRN_NAIVE)
        {
            LAS float* qs = (LAS float*)(lds + RING_OFF); LAS float* ks = qs + 2048; LAS float* fs = ks + 2048; LAS float* vs = fs + 2048; LAS float* op = vs + 2048;
            const int e = tid & 127, dq = tid >> 7;
            for (int unit = G - 1 - bx; unit < NBATCH * NH * 2; unit += G) {
                const int dir = unit & 1, h = (unit >> 1) & 3, b = unit >> 3;
                const bf16* Kp = dir ? KBb : KFb; const float* Lp = dir ? LBb : LFb; float* Op = dir ? OBb : OFb;
                float S[32];
#pragma unroll
                for (int i = 0; i < 32; ++i) S[i] = 0.f;
                for (int blk = 0; blk < TT / 16; ++blk) {
                    const int tb = dir ? (TT - 16 - blk * 16) : blk * 16;
#pragma unroll
                    for (int i = 0; i < 4; ++i) { const int idx = tid + NTHR * i, r = idx >> 7, d = idx & 127; const size_t off = (size_t)(b * TT + tb + r) * 512 + h * 128 + d;
                        qs[idx] = bf2f(Qb[off]); ks[idx] = bf2f(Kp[off]); fs[idx] = __expf(Lp[off]); vs[idx] = bf2f(Vb[off]); }
                    __syncthreads();
                    for (int st = 0; st < 16; ++st) {
                        const int r = dir ? 15 - st : st; const float v = vs[r * 128 + e]; float o = 0.f;
#pragma unroll
                        for (int dd = 0; dd < 32; ++dd) { const int d = dq * 32 + dd; S[dd] = fs[r * 128 + d] * S[dd] + ks[r * 128 + d] * v; o += qs[r * 128 + d] * S[dd]; }
                        op[(r * 4 + dq) * 128 + e] = o;
                    }
                    __syncthreads();
#pragma unroll
                    for (int i = 0; i < 4; ++i) { const int idx = tid + NTHR * i, r = idx >> 7, ee = idx & 127;
                        Op[(size_t)(b * TT + tb + r) * 512 + h * 128 + ee] = (op[(r * 4 + 0) * 128 + ee] + op[(r * 4 + 1) * 128 + ee]) + (op[(r * 4 + 2) * 128 + ee] + op[(r * 4 + 3) * 128 + ee]); }
                }
                __syncthreads();
            }
        }
#else
        if (hsel) for (int hrep_ = 0; hrep_ < ((PROBE_DUP) == 20 ? 2 : 1); ++hrep_) for (int unit = hidx; unit < NBATCH * NH * 4; unit += hstride) hgrn_unit(lds + RING_OFF, unit, Qb, KFb, KBb, Vb, LFb, LBb, OFb, OBb, tid, lane, wave);
#endif
    }
    SEAM(2);

    if (IN(3)) REP(3) {
        for (int m = gw; m < MTOK; m += NGW) {
            const size_t off = (size_t)m * 512 + lane * 8;
            const f32x4 a0 = *(const f32x4*)(OFb + off), a1 = *(const f32x4*)(OFb + off + 4), c0 = *(const f32x4*)(OBb + off), c1 = *(const f32x4*)(OBb + off + 4);
            const f32x4 o0 = a0 + c0, o1 = a1 + c1;
            float ss = (o0.x * o0.x + o0.y * o0.y) + (o0.z * o0.z + o0.w * o0.w) + (o1.x * o1.x + o1.y * o1.y) + (o1.z * o1.z + o1.w * o1.w);
            ss += __shfl_xor(ss, 1); ss += __shfl_xor(ss, 2); ss += __shfl_xor(ss, 4); ss += __shfl_xor(ss, 8);
            const float rstd = rsqrtf(ss * (1.f / DV) + EPS);
            const v4u gv = *(const v4u*)(Gb + off);
            const f32x4 w0 = *(const f32x4*)(hgrn_norm_w + lane * 8), w1v = *(const f32x4*)(hgrn_norm_w + lane * 8 + 4);
            f32x4 r0, r1;
            r0.x = o0.x * rstd * w0.x * bf2f(gv.x & 0xffffu); r0.y = o0.y * rstd * w0.y * bf2f(gv.x >> 16);
            r0.z = o0.z * rstd * w0.z * bf2f(gv.y & 0xffffu); r0.w = o0.w * rstd * w0.w * bf2f(gv.y >> 16);
            r1.x = o1.x * rstd * w1v.x * bf2f(gv.z & 0xffffu); r1.y = o1.y * rstd * w1v.y * bf2f(gv.z >> 16);
            r1.z = o1.z * rstd * w1v.z * bf2f(gv.w & 0xffffu); r1.w = o1.w * rstd * w1v.w * bf2f(gv.w >> 16);
            st8bf(MIX + (size_t)m * D + lane * 8, r0, r1);
        }
    }
    SEAM(3);

    if (IN(4)) REP(4) {
        pg8::Gemm g{MIX, WO, MTOK, D, D}; pg8::StaticOrder S; S.init(MTOK, D, G, bx);
        EpiRes E{x, H};
        pg8::gemm_phase<EpiRes, pg8::StaticOrder, true, true>(lds + RING_OFF, g, S, E);
    }
    SEAM(4);

    if (IN(5)) REP(5) {
        LAS float* wl = (LAS float*)(lds + RING_OFF);
        LAS unsigned* sb = (LAS unsigned*)(lds + SB_OFF);
        for (int i = tid; i < NE * D / 4; i += NTHR) ((LAS f32x4*)wl)[i] = ((const f32x4*)WRT)[i];
        if (tid < NE) lcnt[tid] = 0;
        __syncthreads();
        int it = 0;
        for (int m = gw; m < MTOK; m += NGW, ++it) {
            const f32x4* hr = (const f32x4*)(H + (size_t)m * D) + lane; const f32x4* wr = (const f32x4*)norm2_w + lane;
            f32x4 v[4]; float s = 0.f;
#pragma unroll
            for (int j = 0; j < 4; ++j) { v[j] = hr[64 * j]; s += (v[j].x * v[j].x + v[j].y * v[j].y) + (v[j].z * v[j].z + v[j].w * v[j].w); }
            const float rstd = rsqrtf(wave_sum(s) * (1.f / D) + EPS);
            unsigned* o4 = (unsigned*)(N2 + (size_t)m * D) + lane;
#pragma unroll
            for (int j = 0; j < 4; ++j) { const f32x4 g = wr[64 * j]; v[j] = v[j] * rstd * g; o4[64 * j] = pk4_fp8(v[j].x * SC_N2, v[j].y * SC_N2, v[j].z * SC_N2, v[j].w * SC_N2); }
            float a[NE];
#pragma unroll
            for (int e = 0; e < NE; ++e) { float t = 0.f;
#pragma unroll
                for (int j = 0; j < 4; ++j) { const f32x4 wv = ((const LAS f32x4*)wl)[e * 256 + lane + 64 * j]; t += (v[j].x * wv.x + v[j].y * wv.y) + (v[j].z * wv.z + v[j].w * wv.w); }
                a[e] = t; }
#pragma unroll
            for (int s2 = 32, n = 16; n >= 1; s2 >>= 1, n >>= 1) {
                const bool up = (lane & s2) != 0;
#pragma unroll
                for (int i = 0; i < n; ++i) { const float k1 = up ? a[i + n] : a[i], x1 = up ? a[i] : a[i + n]; a[i] = k1 + __shfl_xor(x1, s2); }
            }
            float lg = a[0] + __shfl_xor(a[0], 1);
            const int myE = lane >> 1;
            lg += router_b[myE];
            float tv[TOPK]; int ti[TOPK];
#pragma unroll
            for (int k = 0; k < TOPK; ++k) {
                float mx = lg;
#pragma unroll
                for (int o = 1; o < 64; o <<= 1) mx = fmaxf(mx, __shfl_xor(mx, o));
                int cand = (lg == mx) ? myE : 99;
#pragma unroll
                for (int o = 1; o < 64; o <<= 1) cand = min(cand, __shfl_xor(cand, o));
                tv[k] = mx; ti[k] = cand;
                if (myE == cand) lg = -INFINITY;
            }
            const float e1 = __expf(tv[1] - tv[0]), e2 = __expf(tv[2] - tv[0]), e3 = __expf(tv[3] - tv[0]);
            const float inv = 1.0f / (1.0f + e1 + e2 + e3);
            if (lane < TOPK) {
                const int ek = lane == 0 ? ti[0] : lane == 1 ? ti[1] : lane == 2 ? ti[2] : ti[3];
                const float gk = (lane == 0 ? 1.0f : lane == 1 ? e1 : lane == 2 ? e2 : e3) * inv;
                const int lr = __hip_atomic_fetch_add(&lcnt[ek], 1, __ATOMIC_RELAXED, __HIP_MEMORY_SCOPE_WORKGROUP);
                sb[(wave * 64 + it) * 4 + lane] = ((unsigned)ek << 16) | (unsigned)lr;
                GATE[(size_t)m * TOPK + lane] = gk;
            }
        }
        __syncthreads();
        if (tid < NE) { const int c = lcnt[tid]; gbase[tid] = c ? (int)__hip_atomic_fetch_add(ctl + CW_CNT + ((PROBE_DUP) == 5 && rep_ == 0 ? 4096 : 0) + 64 * tid, (unsigned)c, RLX_AGENT) : 0; }
        __syncthreads();
        it = 0;
        for (int m = gw; m < MTOK; m += NGW, ++it) {
            if (lane < TOPK) { const unsigned w = sb[(wave * 64 + it) * 4 + lane]; const int ek = (int)(w >> 16), r = gbase[ek] + (int)(w & 0xffffu);
                ROWTOK[ek * MTOK + r] = m; SLOT[(size_t)m * TOPK + lane] = ek * MTOK + r; }
        }
    }
    SEAM(5);

    if (IN(6)) REP(6) {
        BUILD_BS();
        const int nrows = bs[NE] * 256;
        for (int r = gw; r < nrows; r += NGW) {
            const int mb = r >> 8; int e = 0;
            while (e < NE - 1 && bs[e + 1] <= mb) ++e;
            const int rank = r - bs[e] * 256;
            v4u a = (v4u){0u, 0u, 0u, 0u};
            if (rank < cl[e]) { const int tok = ROWTOK[e * MTOK + rank]; a = ((const v4u*)(N2 + (size_t)tok * D))[lane]; }
            ((v4u*)(XS + (size_t)r * D))[lane] = a;
        }
    }
    SEAM(6);

    if (IN(7)) REP(7) {
        BUILD_BS();
        pg8::Gemm g{(const bf16*)XS, (const bf16*)W1T, MOE_ROWS, 2 * FF, D / 2}; MoeOrder S{bs, 8, G, vcu};
        EpiSwiglu E{ACT, b1};
        pg8::gemm_phase<EpiSwiglu, MoeOrder, true, true, true>(lds + RING_OFF, g, S, E);
    }
    SEAM(7);

    if (IN(8)) REP(8) {
        BUILD_BS();
        pg8::Gemm g{(const bf16*)ACT, (const bf16*)W2T, MOE_ROWS, D, FF / 2}; MoeOrder S{bs, 4, G, vcu};
        EpiDown E{YS, b2};
        pg8::gemm_phase<EpiDown, MoeOrder, true, true, true>(lds + RING_OFF, g, S, E);
    }
    SEAM(8);

    if (IN(9)) REP(9) {
        BUILD_BS();
        for (int m = gw; m < MTOK; m += NGW) {
            const f32x4* hr = (const f32x4*)(H + (size_t)m * D) + lane; const f32x4* wr = (const f32x4*)final_norm_w + lane;
            f32x4 v[4];
#pragma unroll
            for (int j = 0; j < 4; ++j) v[j] = hr[64 * j];
#pragma unroll
            for (int k = 0; k < TOPK; ++k) {
                const int sl = SLOT[(size_t)m * TOPK + k]; const float gk = GATE[(size_t)m * TOPK + k];
                const int e = sl >> 14, pos = bs[e] * 256 + (sl & (MTOK - 1));
                const v2u* yr = (const v2u*)(YS + (size_t)pos * D) + lane;
#pragma unroll
                for (int j = 0; j < 4; ++j) { const v2u w = yr[64 * j];
                    v[j].x += gk * bf2f(w.x & 0xffffu); v[j].y += gk * bf2f(w.x >> 16); v[j].z += gk * bf2f(w.y & 0xffffu); v[j].w += gk * bf2f(w.y >> 16); }
            }
            float s = 0.f;
#pragma unroll
            for (int j = 0; j < 4; ++j) s += (v[j].x * v[j].x + v[j].y * v[j].y) + (v[j].z * v[j].z + v[j].w * v[j].w);
            const float rstd = rsqrtf(wave_sum(s) * (1.f / D) + EPS);
            f32x4* orow = (f32x4*)(out + (size_t)m * D) + lane;
#pragma unroll
            for (int j = 0; j < 4; ++j) orow[64 * j] = v[j] * rstd * wr[64 * j];
        }
    }
#undef IN
#undef SEAM
#undef BUILD_BS
}

extern "C" void kernel_launch(void* const* d_in, const int* in_sizes, int n_in, void* d_out, int out_size, void* d_ws, size_t ws_size, hipStream_t stream) {
    static int grid = 0;
    if (grid == 0) {
        if (n_in != 18 || in_sizes[0] != MTOK * D || out_size != MTOK * D || ws_size < WS_END) { fprintf(stderr, "kernel_launch: unexpected shapes (n_in %d, in0 %d, out %d, ws %zu < %zu); nothing launched\n", n_in, n_in > 0 ? in_sizes[0] : -1, out_size, ws_size, (size_t)WS_END); grid = -1; return; }
        int dev = 0, cus = 0, per_cu = 0;
        if (hipGetDevice(&dev) != hipSuccess || hipDeviceGetAttribute(&cus, hipDeviceAttributeMultiprocessorCount, dev) != hipSuccess) { fprintf(stderr, "kernel_launch: device query failed\n"); grid = -1; return; }
        if (hipFuncSetAttribute((const void*)fwd_kernel, hipFuncAttributeMaxDynamicSharedMemorySize, LDS_BYTES) != hipSuccess) { fprintf(stderr, "kernel_launch: hipFuncSetAttribute failed\n"); grid = -1; return; }
        if (hipOccupancyMaxActiveBlocksPerMultiprocessor(&per_cu, (const void*)fwd_kernel, NTHR, LDS_BYTES) != hipSuccess || per_cu < 1)
            fprintf(stderr, "kernel_launch: note: occupancy query reports %d workgroups per CU\n", per_cu);
        (void)hipGetLastError();
        grid = cus;
    }
    if (grid < 0) return;
    if (hipMemsetAsync((char*)d_ws + WS_CTL, 0, CTL_ZERO_BYTES, stream) != hipSuccess) { fprintf(stderr, "kernel_launch: memset failed\n"); return; }
    Args a{};
    for (int i = 0; i < 18; ++i) a.in[i] = (const float*)d_in[i];
    a.out = (float*)d_out; a.ws = (unsigned char*)d_ws;
#if MK_N_LAUNCHES == 1
    a.ph_lo = 0; a.ph_hi = N_PHASES;
    hipLaunchKernelGGL(fwd_kernel, dim3(grid), dim3(NTHR), LDS_BYTES, stream, a);
#else
    for (int ph = 0; ph < N_PHASES; ++ph) { a.ph_lo = ph; a.ph_hi = ph + 1; hipLaunchKernelGGL(fwd_kernel, dim3(grid), dim3(NTHR), LDS_BYTES, stream, a); }
#endif
    const hipError_t le = hipPeekAtLastError();
    if (le != hipSuccess) fprintf(stderr, "kernel_launch: launch failed: %s\n", hipGetErrorName(le));
}
```

```cpp
#include <hip/hip_runtime.h>
#include <cstdio>
#include <cstdint>
namespace pg8 {
#define PG8_LAS __attribute__((address_space(3)))
typedef unsigned short bf16_t;
typedef short bf16x8 __attribute__((ext_vector_type(8)));
typedef float f32x4 __attribute__((ext_vector_type(4)));
typedef unsigned u32x4 __attribute__((ext_vector_type(4)));
constexpr int BM = 256, BK = 64, HALF = 128, HTB = HALF * BK * 2  , STAGE_BYTES = 8 * HTB, NXCD = 8, WGM = 8;

__host__ __device__ __forceinline__ int lds_byte(int r, int c) { const int st = (r >> 4) * 2 + (c >> 5), rr = r & 15, cc = c & 31, ob = rr * 64 + cc * 2; return st * 1024 + (ob ^ (((ob >> 9) & 1) << 5)); }
__host__ __device__ __forceinline__ void stage_rc(int b, int& R, int& C) { const int st = b / 1024, sb = b % 1024, swz = sb ^ (((sb >> 9) & 1) << 5); R = (st >> 1) * 16 + swz / 64; C = (st & 1) * 32 + (swz % 64) / 2; }
__host__ __device__ __forceinline__ int perm32(int rho) { const int n = rho >> 4, i = rho & 15; return 8 * (i >> 2) + 4 * n + (i & 3); }

struct Unit { int pm, pn; };
struct Gemm { const bf16_t* A; const bf16_t* Bt; int M, N, K; };

struct StaticOrder {
    int nM, nN, nwg, G, c;
    __host__ __device__ void init(int M, int N, int G_, int c_) { nM = M / BM; nN = N / BM; nwg = nM * nN; G = G_; c = c_; }
    __host__ __device__ bool next(int i, Unit& u) const {
        const long L = (long)i * G + c; if (L >= nwg) return false;
        int wgid = (int)L; { const int q = nwg / NXCD, r = nwg % NXCD, xcd = wgid % NXCD, off = wgid / NXCD; wgid = (xcd < r ? xcd * (q + 1) : r * (q + 1) + (xcd - r) * q) + off; }
        const int nig = WGM * nN, gid = wgid / nig, fm = gid * WGM, gsz = (nM - fm) < WGM ? (nM - fm) : WGM;
        u.pm = fm + ((wgid % nig) % gsz); u.pn = (wgid % nig) / gsz; return true;
    }
    __device__ __forceinline__ void a_ready(const Unit&) const {}
    __device__ __forceinline__ void done(const Unit&) const {}
};
__device__ __forceinline__ unsigned cvt_pk_bf16(float lo, float hi) { unsigned r; asm volatile("v_cvt_pk_bf16_f32 %0, %1, %2" : "=v"(r) : "v"(lo), "v"(hi)); return r; }
typedef float f32x2 __attribute__((ext_vector_type(2)));
template <class Epi, class Sched, bool ALIGN_EPI = false, bool SP2 = false, bool FP8 = false>
__device__ __forceinline__ void gemm_phase(PG8_LAS unsigned char* lds, const Gemm g, const Sched& S, const Epi& E) {
    typedef int v4i_t __attribute__((ext_vector_type(4)));
    const int tid = threadIdx.x, wid = __builtin_amdgcn_readfirstlane(tid >> 6), lane = tid & 63, wr = wid >> 2, wc = wid & 3, fr = lane & 15, fq = lane >> 4;
    const int K = g.K, nt = K / BK;
    unsigned voffA[2], voffB[2];
#pragma unroll
    for (int i = 0; i < 2; ++i) { int R, C; stage_rc(tid * 16 + i * 8192, R, C); const int Rb = Epi::PERM ? ((R & ~31) + perm32(R & 31)) : R;
        voffA[i] = (unsigned)(R * K + C) * 2u; voffB[i] = (unsigned)(Rb * K + C) * 2u; }
    const size_t kstep = (size_t)(BK * 2);
    const size_t hstep = (size_t)HALF * K * 2;
    const size_t tstep = 2 * hstep;
    const unsigned ldsw = (unsigned)wid * 1024u;
    const int aoff = lds_byte(wr * 64 + fr, fq * 8), boff = lds_byte(wc * 32 + fr, fq * 8);
#define PG8_SA(b, h) (((b) * 2 + (h)) * HTB)
#define PG8_SB(b, h) ((4 + (b) * 2 + (h)) * HTB)
#define PG8_STAGE(bufoff, gbase, voff) do { _Pragma("unroll") for (int _i = 0; _i < 2; ++_i) \
        __builtin_amdgcn_global_load_lds((const unsigned*)((const char*)(gbase) + (voff)[_i]), (PG8_LAS unsigned*)(lds + (bufoff) + ldsw + _i * 8192), 16, 0, 0); } while (0)
#define PG8_LDA(dst, b, h) do { _Pragma("unroll") for (int m = 0; m < 4; ++m) _Pragma("unroll") for (int k = 0; k < 2; ++k) dst[m][k] = *(const PG8_LAS bf16x8*)(lds + PG8_SA(b, h) + aoff + m * 2048 + k * 1024); } while (0)
#define PG8_LDB(dst, b, h) do { _Pragma("unroll") for (int n = 0; n < 2; ++n) _Pragma("unroll") for (int k = 0; k < 2; ++k) dst[n][k] = *(const PG8_LAS bf16x8*)(lds + PG8_SB(b, h) + boff + n * 2048 + k * 1024); } while (0)
#define PG8_MMA(ai, bj, At, Bt) do { __builtin_amdgcn_s_setprio(1); _Pragma("unroll") for (int m = 0; m < 4; ++m) _Pragma("unroll") for (int n = 0; n < 2; ++n) { \
        if constexpr (FP8) { asm volatile("v_mfma_f32_16x16x128_f8f6f4 %0, %1, %2, %0" : "+v"(acc[ai][bj][m][n]) : "v"(__builtin_shufflevector((v4i_t)Bt[n][0], (v4i_t)Bt[n][1], 0, 1, 2, 3, 4, 5, 6, 7)), "v"(__builtin_shufflevector((v4i_t)At[m][0], (v4i_t)At[m][1], 0, 1, 2, 3, 4, 5, 6, 7))); } \
        else { _Pragma("unroll") for (int k = 0; k < 2; ++k) acc[ai][bj][m][n] = __builtin_amdgcn_mfma_f32_16x16x32_bf16(Bt[n][k], At[m][k], acc[ai][bj][m][n], 0, 0, 0); } } __builtin_amdgcn_s_setprio(0); } while (0)
#define PG8_WAIT_V(n) asm volatile("s_waitcnt vmcnt(" #n ")" ::: "memory")
#define PG8_WAIT_L(n) asm volatile("s_waitcnt lgkmcnt(" #n ")" ::: "memory")
#define PG8_BAR __builtin_amdgcn_s_barrier()
#define PG8_SCHED __builtin_amdgcn_sched_barrier(0)
    Unit cur, nxt; int ui = 0;
    if (!S.next(0, cur)) return;
    f32x4 acc[2][2][4][2];
#pragma unroll
    for (int a = 0; a < 2; ++a)
#pragma unroll
        for (int b = 0; b < 2; ++b)
#pragma unroll
            for (int m = 0; m < 4; ++m)
#pragma unroll
                for (int n = 0; n < 2; ++n) acc[a][b][m][n] = (f32x4){0.f, 0.f, 0.f, 0.f};
    bf16x8 At[4][2], B0[2][2], B1[2][2];
    const char* cA = (const char*)g.A + (size_t)cur.pm * tstep; const char* cB = (const char*)g.Bt + (size_t)cur.pn * tstep;
    S.a_ready(cur);
    if constexpr (SP2) {
        PG8_STAGE(PG8_SB(0, 0), cB, voffB); PG8_STAGE(PG8_SB(0, 1), cB + hstep, voffB); PG8_STAGE(PG8_SA(0, 0), cA, voffA); PG8_STAGE(PG8_SA(0, 1), cA + hstep, voffA);
        if (wr == 1) PG8_BAR;
        PG8_WAIT_V(2); PG8_BAR;
        PG8_STAGE(PG8_SB(1, 0), cB + kstep, voffB); PG8_STAGE(PG8_SA(1, 0), cA + kstep, voffA); PG8_STAGE(PG8_SB(1, 1), cB + hstep + kstep, voffB);
        PG8_WAIT_V(6); PG8_BAR;
    } else {
        PG8_STAGE(PG8_SB(0, 0), cB, voffB); PG8_STAGE(PG8_SA(0, 0), cA, voffA); PG8_STAGE(PG8_SB(0, 1), cB + hstep, voffB); PG8_STAGE(PG8_SA(0, 1), cA + hstep, voffA);
        if (wr == 1) PG8_BAR;
        PG8_WAIT_V(4); PG8_BAR;
        PG8_STAGE(PG8_SB(1, 0), cB + kstep, voffB); PG8_STAGE(PG8_SA(1, 0), cA + kstep, voffA); PG8_STAGE(PG8_SB(1, 1), cB + hstep + kstep, voffB);
        PG8_WAIT_V(6); PG8_BAR;
    }
    for (;;) {
        const bool has_next = S.next(ui + 1, nxt);
        const char* nA = has_next ? (const char*)g.A + (size_t)nxt.pm * tstep : cA; const char* nB = has_next ? (const char*)g.Bt + (size_t)nxt.pn * tstep : cB;
        for (int t = 0; t < nt; t += 2) {
            const bool last = (t == nt - 2);
            const char* a1 = cA + (size_t)(t + 1) * kstep;
            const char* a2 = last ? nA : cA + (size_t)(t + 2) * kstep; const char* b2 = last ? nB : cB + (size_t)(t + 2) * kstep;
            const char* a3 = a2 + kstep; const char* b3 = b2 + kstep;
            if (last && has_next) S.a_ready(nxt);
            if constexpr (SP2) {
            PG8_LDB(B0, 0, 0); PG8_LDB(B1, 0, 1); PG8_SCHED; PG8_LDA(At, 0, 0); PG8_STAGE(PG8_SA(1, 1), a1 + hstep, voffA);
            PG8_WAIT_V(8); PG8_WAIT_L(0); PG8_BAR; PG8_MMA(0, 0, At, B0); PG8_MMA(0, 1, At, B1); PG8_BAR; PG8_SCHED;
            PG8_LDA(At, 0, 1); PG8_STAGE(PG8_SB(0, 0), b2, voffB); PG8_STAGE(PG8_SB(0, 1), b2 + hstep, voffB); PG8_STAGE(PG8_SA(0, 0), a2, voffA);
            PG8_WAIT_V(8); PG8_WAIT_L(0); PG8_BAR; PG8_MMA(1, 0, At, B0); PG8_MMA(1, 1, At, B1); PG8_BAR; PG8_SCHED;
            PG8_LDB(B0, 1, 0); PG8_LDB(B1, 1, 1); PG8_SCHED; PG8_LDA(At, 1, 0); PG8_STAGE(PG8_SA(0, 1), a2 + hstep, voffA);
            PG8_WAIT_V(8); PG8_WAIT_L(0); PG8_BAR; PG8_MMA(0, 0, At, B0); PG8_MMA(0, 1, At, B1); PG8_BAR; PG8_SCHED;
            PG8_LDA(At, 1, 1); PG8_STAGE(PG8_SB(1, 0), b3, voffB); PG8_STAGE(PG8_SB(1, 1), b3 + hstep, voffB); PG8_STAGE(PG8_SA(1, 0), a3, voffA);
            PG8_WAIT_V(8); PG8_WAIT_L(0); PG8_BAR; PG8_MMA(1, 0, At, B0); PG8_MMA(1, 1, At, B1); PG8_BAR; PG8_SCHED;
            } else {
            PG8_LDB(B0, 0, 0); PG8_SCHED; PG8_LDA(At, 0, 0); PG8_STAGE(PG8_SA(1, 1), a1 + hstep, voffA);
            PG8_WAIT_L(8); PG8_BAR; PG8_WAIT_L(0); PG8_MMA(0, 0, At, B0); PG8_BAR; PG8_SCHED;
            PG8_LDB(B1, 0, 1); PG8_STAGE(PG8_SB(0, 0), b2, voffB);
            PG8_BAR; PG8_WAIT_L(0); PG8_MMA(0, 1, At, B1); PG8_BAR;
            PG8_LDA(At, 0, 1); PG8_STAGE(PG8_SA(0, 0), a2, voffA);
            PG8_BAR; PG8_WAIT_L(0); PG8_MMA(1, 0, At, B0); PG8_BAR; PG8_SCHED;
            PG8_STAGE(PG8_SB(0, 1), b2 + hstep, voffB);
            PG8_WAIT_V(6); PG8_BAR; PG8_MMA(1, 1, At, B1); PG8_BAR;
            PG8_LDB(B0, 1, 0); PG8_SCHED; PG8_LDA(At, 1, 0); PG8_STAGE(PG8_SA(0, 1), a2 + hstep, voffA);
            PG8_WAIT_L(8); PG8_BAR; PG8_WAIT_L(0); PG8_MMA(0, 0, At, B0); PG8_BAR; PG8_SCHED;
            PG8_LDB(B1, 1, 1); PG8_STAGE(PG8_SB(1, 0), b3, voffB);
            PG8_BAR; PG8_WAIT_L(0); PG8_MMA(0, 1, At, B1); PG8_BAR;
            PG8_LDA(At, 1, 1); PG8_STAGE(PG8_SA(1, 0), a3, voffA);
            PG8_BAR; PG8_WAIT_L(0); PG8_MMA(1, 0, At, B0); PG8_BAR; PG8_SCHED;
            PG8_STAGE(PG8_SB(1, 1), b3 + hstep, voffB);
            PG8_WAIT_V(6); PG8_BAR; PG8_MMA(1, 1, At, B1); PG8_BAR;
            }
        }
        if constexpr (FP8) asm volatile("s_nop 15\n\ts_nop 15" ::: "memory");
        if constexpr (ALIGN_EPI) { if (wr == 0) PG8_BAR; }
        if constexpr (!Epi::AFTER_DRAIN) { E(acc, cur, wr, wc, fr, fq); S.done(cur); }
        if (!has_next) break;
#pragma unroll
        for (int a = 0; a < 2; ++a)
#pragma unroll
            for (int b = 0; b < 2; ++b)
#pragma unroll
                for (int m = 0; m < 4; ++m)
#pragma unroll
                    for (int n = 0; n < 2; ++n) acc[a][b][m][n] = (f32x4){0.f, 0.f, 0.f, 0.f};
        cur = nxt; cA = nA; cB = nB; ++ui;
        if constexpr (ALIGN_EPI) { if (wr == 1) PG8_BAR; }
    }
    PG8_WAIT_V(0);
    if constexpr (!ALIGN_EPI) { if (wr == 0) PG8_BAR; }
    PG8_BAR;
    if constexpr (Epi::AFTER_DRAIN) { E.fused(acc, cur, wr, wc, fr, fq, lds, wid, lane); S.done(cur); }
#undef PG8_SA
#undef PG8_SB
#undef PG8_STAGE
#undef PG8_LDA
#undef PG8_LDB
#undef PG8_MMA
#undef PG8_WAIT_V
#undef PG8_WAIT_L
#undef PG8_BAR
#undef PG8_SCHED
}
}

#ifndef MK_N_LAUNCHES
#define MK_N_LAUNCHES 1
#endif
constexpr int N_PHASES = 10;
constexpr int NBATCH = 8, TT = 2048, MTOK = NBATCH * TT, D = 1024;
constexpr int HK = 512, NH = 4, DK = 128, DV = 128, CCH = 512, CLEN = 31, INC = 3584;
constexpr int NE = 32, TOPK = 4, FF = 1024;
constexpr float EPS = 1e-5f, SW_LIMIT = 7.0f, SW_ALPHA = 1.702f;
constexpr int NWAVES = 8, NTHR = 512;
constexpr int MOE_ROWS = (MTOK * TOPK / 256 + NE) * 256;

constexpr size_t MiB = 1u << 20;
constexpr size_t WS_CTL = 0, CTL_ZERO_BYTES = 1 * MiB;
constexpr size_t WS_WI = 1 * MiB;
constexpr size_t WS_WO = 8 * MiB;
constexpr size_t WS_TAB = 10 * MiB;
constexpr size_t WS_W1 = 16 * MiB;
constexpr size_t WS_W2 = 144 * MiB;
constexpr size_t WS_H = 208 * MiB;
constexpr size_t WS_XN = 272 * MiB;
constexpr size_t WS_Q = 304 * MiB, WS_KF = 320 * MiB, WS_KB = 336 * MiB, WS_V = 352 * MiB, WS_G = 368 * MiB, WS_U = 384 * MiB;
constexpr size_t WS_LF = 400 * MiB, WS_LB = 432 * MiB;
constexpr size_t WS_OF = 464 * MiB, WS_OB = 496 * MiB;
constexpr size_t WS_MIX = 528 * MiB;
constexpr size_t WS_XS = 304 * MiB;
constexpr size_t WS_ACT = 448 * MiB;
constexpr size_t WS_YS = 592 * MiB;
constexpr size_t WS_END = 736 * MiB;
constexpr size_t WS_WRT = WS_TAB;
constexpr size_t WS_SLOT = WS_TAB + 256 * 1024;
constexpr size_t WS_GATE = WS_TAB + 512 * 1024;
constexpr size_t WS_ROWTOK = WS_TAB + 1 * MiB;
constexpr int CW_BAR = 4096;
constexpr int CW_CNT = 16384;

constexpr int RING_OFF = 0, RING_BYTES = 131072;
constexpr int LDSCTL_OFF = RING_BYTES;
constexpr int MISC_OFF = LDSCTL_OFF + 320;
constexpr int TAB_OFF = LDSCTL_OFF + 1024;
constexpr int SB_OFF = LDSCTL_OFF + 2048;
constexpr int LDS_BYTES = 147456;

#define GAS __attribute__((address_space(1)))
#define LAS __attribute__((address_space(3)))
typedef unsigned short bf16;
typedef unsigned v4u __attribute__((ext_vector_type(4)));
typedef unsigned v2u __attribute__((ext_vector_type(2)));
typedef float f32x4 __attribute__((ext_vector_type(4)));
typedef GAS unsigned gu32;
#define RLX_AGENT __ATOMIC_RELAXED, __HIP_MEMORY_SCOPE_AGENT
#define LDS_WAIT() asm volatile("s_waitcnt lgkmcnt(0)" ::: "memory")
#define VM_WAIT() asm volatile("s_waitcnt vmcnt(0)" ::: "memory")

__device__ __forceinline__ float bf2f(unsigned b) { return __uint_as_float(b << 16); }
__device__ __forceinline__ unsigned pk2(float lo, float hi) { return pg8::cvt_pk_bf16(lo, hi); }
__device__ __forceinline__ float sigm(float x) { return __builtin_amdgcn_rcpf(1.0f + __expf(-x)); }
__device__ __forceinline__ float wave_sum(float v) {
#pragma unroll
    for (int o = 1; o < 64; o <<= 1) v += __shfl_xor(v, o);
    return v;
}

constexpr float SC_W = 512.f, SC_N2 = 16.f, SC_ACT = 8.f;
__device__ __forceinline__ unsigned pk4_fp8(float a, float b, float c, float d) {
    a = fminf(fmaxf(a, -448.f), 448.f); b = fminf(fmaxf(b, -448.f), 448.f); c = fminf(fmaxf(c, -448.f), 448.f); d = fminf(fmaxf(d, -448.f), 448.f);
    int w = 0; w = __builtin_amdgcn_cvt_pk_fp8_f32(a, b, w, false); w = __builtin_amdgcn_cvt_pk_fp8_f32(c, d, w, true); return (unsigned)w;
}

#define XB_TMO      128
#define XB_XCNT(j)  (256  + 64 * (j))
#define XB_XSUB(j)  (1280 + 64 * (j))
#define XB_XGEN(j)  (2304 + 64 * (j))
#define XB_TOP      3328
#define XB_TOPGEN   3392
#define XCD_BAR_WORDS 3456
#define XB_SPIN_CAP (1u << 18)

__device__ __forceinline__ unsigned xb_ld(unsigned* p)              { return __hip_atomic_load(p, __ATOMIC_RELAXED, __HIP_MEMORY_SCOPE_AGENT); }
__device__ __forceinline__ unsigned xb_add(unsigned* p, unsigned v) { return __hip_atomic_fetch_add(p, v, __ATOMIC_RELAXED, __HIP_MEMORY_SCOPE_AGENT); }
__device__ __forceinline__ unsigned xb_xcc_id() { return (unsigned)__builtin_amdgcn_s_getreg((3 << 11) | 20) & 0xFu; }
#define XB_SPIN(cond, bar) do { unsigned _sp = 0; while (cond) { __builtin_amdgcn_s_sleep(1); \
    if ((++_sp & 255u) == 0u) { if (xb_ld(&(bar)[XB_TMO])) break; if (_sp > XB_SPIN_CAP) { atomicAdd(&(bar)[XB_TMO], 1u); break; } } } } while (0)

struct XcdBarrier {
    unsigned* bar; unsigned x;
    volatile LAS unsigned* st;
};
__device__ __forceinline__ XcdBarrier xcd_barrier_post(unsigned* bar, volatile LAS unsigned* st) {
    XcdBarrier b; b.bar = bar; b.x = xb_xcc_id(); b.st = st;
    if (threadIdx.x == 0) (void)xb_add(&bar[XB_XCNT(b.x)], 1u);
    return b;
}
__device__ __forceinline__ void xcd_barrier_complete(unsigned* bar, unsigned x, unsigned& nloc, unsigned& nx) {
    const unsigned G = gridDim.x * gridDim.y * gridDim.z;
    unsigned sum, cnt, mine, sp = 0u;
    for (;;) {
        sum = 0u; cnt = 0u; mine = 0u;
#pragma unroll
        for (unsigned j = 0; j < 16; ++j) { const unsigned c = xb_ld(&bar[XB_XCNT(j)]); sum += c; cnt += (c > 0u) ? 1u : 0u; mine = (j == x) ? c : mine; }
        if (sum == G) break;
        __builtin_amdgcn_s_sleep(1);
        if ((++sp & 255u) == 0u) { if (xb_ld(&bar[XB_TMO])) break; if (sp > XB_SPIN_CAP) { atomicAdd(&bar[XB_TMO], 1u); break; } }
    }
    nloc = mine > 0u ? mine : 1u; nx = cnt > 0u ? cnt : 1u;
}
__device__ __forceinline__ void xcd_barrier(const XcdBarrier& b) {
    asm volatile("s_waitcnt vmcnt(0)" ::: "memory");
    __syncthreads();
    if (threadIdx.x == 0) {
        unsigned* bar = b.bar;
        __builtin_amdgcn_s_waitcnt(0);
        unsigned nloc = b.st[0], nx = b.st[1];
        if (nloc == 0u) { xcd_barrier_complete(bar, b.x, nloc, nx); b.st[0] = nloc; b.st[1] = nx; }
        const unsigned old = xb_add(&bar[XB_XSUB(b.x)], 1u);
        const unsigned gen = old / nloc;
        if (old + 1u == (gen + 1u) * nloc) {
            __builtin_amdgcn_fence(__ATOMIC_RELEASE, "agent");
            asm volatile("s_waitcnt vmcnt(0)" ::: "memory");
            const unsigned og = xb_add(&bar[XB_TOP], 1u);
            const unsigned tg = og / nx;
            if (og + 1u == (tg + 1u) * nx) xb_add(&bar[XB_TOPGEN], 1u);
            else XB_SPIN(xb_ld(&bar[XB_TOPGEN]) == tg, bar);
            __builtin_amdgcn_fence(__ATOMIC_ACQUIRE, "agent");
            xb_add(&bar[XB_XGEN(b.x)], 1u);
            asm volatile("s_waitcnt vmcnt(0)" ::: "memory");
        } else {
            XB_SPIN(xb_ld(&bar[XB_XGEN(b.x)]) == gen, bar);
            __builtin_amdgcn_fence(__ATOMIC_ACQUIRE, "agent");
            asm volatile("s_waitcnt vmcnt(0)" ::: "memory");
        }
    }
    __syncthreads();
}

__device__ __forceinline__ void st8bf(bf16* p, const f32x4& a, const f32x4& b) {
    v4u w; w.x = pk2(a[0], a[1]); w.y = pk2(a[2], a[3]); w.z = pk2(b[0], b[1]); w.w = pk2(b[2], b[3]);
    *(v4u*)p = w;
}
struct EpiProj {
    static constexpr bool PERM = true, AFTER_DRAIN = false;
    bf16 *Q, *KF, *KB, *V, *G, *U; float *LF, *LB; const float* lbl;
    template <int TYP>
    __device__ __forceinline__ void tile(const pg8::f32x4 (&acc)[2][2][4][2], int row0, int cb) const {
#pragma unroll
        for (int bj = 0; bj < 2; ++bj) {
            const int col = cb + bj * 128;
            float lb[8];
            if (TYP == 1 || TYP == 2) {
                const float* L = lbl + (TYP - 1) * 1024 + col;
#pragma unroll
                for (int i = 0; i < 8; ++i) lb[i] = __builtin_amdgcn_rcpf(1.0f + __expf(L[512 + i] - L[i]));
            }
#pragma unroll
            for (int ai = 0; ai < 2; ++ai)
#pragma unroll
                for (int m = 0; m < 4; ++m) {
                    const size_t off = (size_t)(row0 + ai * 128 + m * 16) * 512 + col;
                    f32x4 a = acc[ai][bj][m][0], b = acc[ai][bj][m][1];
                    if (TYP == 0 || TYP == 4) {
#pragma unroll
                        for (int i = 0; i < 4; ++i) { a[i] = a[i] * sigm(a[i]); b[i] = b[i] * sigm(b[i]); }
                        st8bf((TYP == 0 ? Q : G) + off, a, b);
                    } else if (TYP == 3) {
                        st8bf(V + off, a, b);
                    } else {
                        f32x4 la, lbv, ka, kb;
#pragma unroll
                        for (int i = 0; i < 4; ++i) {
                            const float fa = lb[i] + (1.0f - lb[i]) * sigm(a[i]), fb = lb[4 + i] + (1.0f - lb[4 + i]) * sigm(b[i]);
                            la[i] = __logf(fa); lbv[i] = __logf(fb); ka[i] = 1.0f - fa; kb[i] = 1.0f - fb;
                        }
                        float* Lp = (TYP == 1 ? LF : LB) + off;
                        *(f32x4*)Lp = la; *(f32x4*)(Lp + 4) = lbv;
                        st8bf((TYP == 1 ? KF : KB) + off, ka, kb);
                    }
                }
        }
    }
    __device__ __forceinline__ void operator()(const pg8::f32x4 (&acc)[2][2][4][2], const pg8::Unit& u, int wr, int wc, int fr, int fq) const {
        const int row0 = u.pm * 256 + wr * 64 + fr, pn = u.pn;
        if (pn >= 10) {
            const int col = (pn - 10) * 128 + wc * 32 + 8 * fq;
#pragma unroll
            for (int ai = 0; ai < 2; ++ai)
#pragma unroll
                for (int m = 0; m < 4; ++m) {
                    f32x4 a = acc[ai][0][m][0], b = acc[ai][0][m][1]; const f32x4 ga = acc[ai][1][m][0], gb = acc[ai][1][m][1];
#pragma unroll
                    for (int i = 0; i < 4; ++i) { a[i] = a[i] * sigm(ga[i]); b[i] = b[i] * sigm(gb[i]); }
                    st8bf(U + (size_t)(row0 + ai * 128 + m * 16) * 512 + col, a, b);
                }
        } else {
            const int cb = (pn & 1) * 256 + wc * 32 + 8 * fq, typ = pn >> 1;
            if (typ == 0) tile<0>(acc, row0, cb);
            else if (typ == 1) tile<1>(acc, row0, cb);
            else if (typ == 2) tile<2>(acc, row0, cb);
            else if (typ == 3) tile<3>(acc, row0, cb);
            else tile<4>(acc, row0, cb);
        }
    }
};
struct EpiRes {
    static constexpr bool PERM = false, AFTER_DRAIN = false;
    const float* X; float* H;
    __device__ __forceinline__ void operator()(const pg8::f32x4 (&acc)[2][2][4][2], const pg8::Unit& u, int wr, int wc, int fr, int fq) const {
        const int row0 = u.pm * 256 + wr * 64 + fr, col0 = u.pn * 256 + wc * 32 + 4 * fq;
#pragma unroll
        for (int ai = 0; ai < 2; ++ai)
#pragma unroll
            for (int m = 0; m < 4; ++m) {
                const size_t off = (size_t)(row0 + ai * 128 + m * 16) * D + col0;
#pragma unroll
                for (int bj = 0; bj < 2; ++bj)
#pragma unroll
                    for (int n = 0; n < 2; ++n) { const f32x4 xv = *(const f32x4*)(X + off + bj * 128 + n * 16); *(f32x4*)(H + off + bj * 128 + n * 16) = xv + acc[ai][bj][m][n]; }
            }
    }
};
struct EpiSwiglu {
    static constexpr bool PERM = true, AFTER_DRAIN = false;
    unsigned char* ACT; const float* b1;
    __device__ __forceinline__ void operator()(const pg8::f32x4 (&acc)[2][2][4][2], const pg8::Unit& u, int wr, int wc, int fr, int fq) const {
        const int e = u.pn >> 3, pn = u.pn & 7, row0 = u.pm * 256 + wr * 64 + fr, col = pn * 128 + wc * 32 + 8 * fq;
        const float* bg = b1 + (size_t)e * 2048 + col; const float* bl = bg + 1024;
        float g[8], l[8];
#pragma unroll
        for (int i = 0; i < 8; ++i) { g[i] = bg[i]; l[i] = bl[i]; }
#pragma unroll
        for (int ai = 0; ai < 2; ++ai)
#pragma unroll
            for (int m = 0; m < 4; ++m) {
                f32x4 o[2];
#pragma unroll
                for (int n = 0; n < 2; ++n)
#pragma unroll
                    for (int i = 0; i < 4; ++i) {
                        const float hg = fminf(acc[ai][0][m][n][i] * (1.0f / (SC_N2 * SC_W)) + g[4 * n + i], SW_LIMIT);
                        const float hl = fminf(fmaxf(acc[ai][1][m][n][i] * (1.0f / (SC_N2 * SC_W)) + l[4 * n + i], -SW_LIMIT), SW_LIMIT);
                        o[n][i] = hg * sigm(SW_ALPHA * hg) * (hl + 1.0f) * SC_ACT;
                    }
                v2u w; w.x = pk4_fp8(o[0][0], o[0][1], o[0][2], o[0][3]); w.y = pk4_fp8(o[1][0], o[1][1], o[1][2], o[1][3]);
                *(v2u*)(ACT + (size_t)(row0 + ai * 128 + m * 16) * FF + col) = w;
            }
    }
};
struct EpiDown {
    static constexpr bool PERM = true, AFTER_DRAIN = false;
    bf16* YS; const float* b2;
    __device__ __forceinline__ void operator()(const pg8::f32x4 (&acc)[2][2][4][2], const pg8::Unit& u, int wr, int wc, int fr, int fq) const {
        const int e = u.pn >> 2, pn = u.pn & 3, row0 = u.pm * 256 + wr * 64 + fr, col0 = pn * 256 + wc * 32 + 8 * fq;
#pragma unroll
        for (int bj = 0; bj < 2; ++bj) {
            const float* bp = b2 + (size_t)e * D + col0 + bj * 128;
            const f32x4 b0 = *(const f32x4*)bp, b1v = *(const f32x4*)(bp + 4);
#pragma unroll
            for (int ai = 0; ai < 2; ++ai)
#pragma unroll
                for (int m = 0; m < 4; ++m)
                    st8bf(YS + (size_t)(row0 + ai * 128 + m * 16) * D + col0 + bj * 128, acc[ai][bj][m][0] * (1.0f / (SC_ACT * SC_W)) + b0, acc[ai][bj][m][1] * (1.0f / (SC_ACT * SC_W)) + b1v);
        }
    }
};
struct MoeOrder {
    const volatile LAS int* bs; int ntn, G, v;
    __device__ __forceinline__ bool next(int i, pg8::Unit& u) const {
        const int L = i * G + v, nb = bs[32];
        if (L >= nb * ntn) return false;
        const int mb = L / ntn, pn = L - mb * ntn;
        int e = 0;
        while (e < NE - 1 && bs[e + 1] <= mb) ++e;
        u.pm = mb; u.pn = e * ntn + pn; return true;
    }
    __device__ __forceinline__ void a_ready(const pg8::Unit&) const {}
    __device__ __forceinline__ void done(const pg8::Unit&) const {}
};

#ifndef PROBE_DUP
#define PROBE_DUP -1
#endif
struct OrderRep : pg8::StaticOrder {
    int reps;
    __device__ __forceinline__ bool next(int i, pg8::Unit& u) const {
        const int per = (nwg + G - 1) / G, r = i / per;
        if (r >= reps) return false;
        return pg8::StaticOrder::next(i - r * per, u) ? true : ((r + 1 < reps) ? pg8::StaticOrder::next(0, u) : false);
    }
};
struct RmIdent { __device__ __forceinline__ int operator()(int n) const { return n; } };
struct RmWin {
    __device__ __forceinline__ int operator()(int n) const {
        if (n < 2560) return n;
        if (n < 3072) { const int j = n - 2560; return 2560 + (j >> 7) * 256 + (j & 127); }
        const int j = n - 3072; return 2560 + (j >> 7) * 256 + 128 + (j & 127);
    }
};
struct RmW1 {
    __device__ __forceinline__ int operator()(int n) const {
        if (n < 1024) return (n >> 7) * 256 + (n & 127);
        const int j = n - 1024; return (j >> 7) * 256 + 128 + (j & 127);
    }
};
template <bool FP8OUT, class RM>
__device__ __forceinline__ void p0_item(const float* W, int K, int N, void* WTv, RM rm, LAS float* scr, int item, int lane) {
    const int nblk = N / 32, kb = item / nblk, nb = item % nblk, k0 = 64 * kb, n0 = 32 * nb;
    const int r8 = lane >> 3, c4 = lane & 7;
    f32x4 v[8];
#pragma unroll
    for (int i = 0; i < 8; ++i) v[i] = *(const f32x4*)(W + (size_t)(k0 + 8 * i + r8) * N + n0 + 4 * c4);
#pragma unroll
    for (int i = 0; i < 8; ++i) *(LAS f32x4*)(scr + (8 * i + r8) * 36 + 4 * c4) = v[i];
    LDS_WAIT(); asm volatile("" ::: "memory");
    const int n = lane & 31, kh = lane >> 5; const LAS float* s = scr + (32 * kh) * 36 + n;
    if constexpr (FP8OUT) {
        unsigned w[8];
#pragma unroll
        for (int j = 0; j < 8; ++j) w[j] = pk4_fp8(s[(4 * j) * 36] * SC_W, s[(4 * j + 1) * 36] * SC_W, s[(4 * j + 2) * 36] * SC_W, s[(4 * j + 3) * 36] * SC_W);
        GAS v4u* dst = (GAS v4u*)((unsigned char*)WTv + (size_t)rm(n0 + n) * K + k0 + 32 * kh);
        dst[0] = (v4u){w[0], w[1], w[2], w[3]}; dst[1] = (v4u){w[4], w[5], w[6], w[7]};
    } else {
        unsigned w[16];
#pragma unroll
        for (int j = 0; j < 16; ++j) w[j] = pk2(s[(2 * j) * 36], s[(2 * j + 1) * 36]);
        GAS v4u* dst = (GAS v4u*)((bf16*)WTv + (size_t)rm(n0 + n) * K + k0 + 32 * kh);
#pragma unroll
        for (int q = 0; q < 4; ++q) dst[q] = (v4u){w[4 * q], w[4 * q + 1], w[4 * q + 2], w[4 * q + 3]};
    }
    LDS_WAIT(); asm volatile("" ::: "memory");
}
__device__ __forceinline__ void rms_row_to_bf16(const float* xrow, const float* w, bf16* orow, int lane) {
    const f32x4* xr = (const f32x4*)xrow + lane; const f32x4* wr = (const f32x4*)w + lane;
    f32x4 v[4]; float s = 0.f;
#pragma unroll
    for (int j = 0; j < 4; ++j) { v[j] = xr[64 * j]; s += (v[j].x * v[j].x + v[j].y * v[j].y) + (v[j].z * v[j].z + v[j].w * v[j].w); }
    const float rstd = rsqrtf(wave_sum(s) * (1.f / D) + EPS);
    v2u* o8 = (v2u*)orow + lane;
#pragma unroll
    for (int j = 0; j < 4; ++j) { const f32x4 g = wr[64 * j]; v2u o; o.x = pk2(v[j].x * rstd * g.x, v[j].y * rstd * g.y); o.y = pk2(v[j].z * rstd * g.z, v[j].w * rstd * g.w); o8[64 * j] = o; }
}


__device__ __forceinline__ pg8::bf16x8 lds_frag(const LAS unsigned char* p) { return *(const LAS pg8::bf16x8*)p; }
__device__ __forceinline__ pg8::bf16x8 mk_frag(v2u a, v2u b) { const v4u w = (v4u){a.x, a.y, b.x, b.y}; return (pg8::bf16x8)w; }
struct HgCtx {
    LAS unsigned char* lds; const bf16 *Qb, *Kp, *Vb; const float* Lp; float* Op;
    int b, h, dir, vh, lane, wave, lr, lq, dA, seg, tauB, dg;
    unsigned offA[16], offB, offV, ke_tr, v_tr;
};
constexpr int HG_BF = 0, HG_AM = 0, HG_QI = 33792, HG_KK = 51200, HG_KE = 68608, HG_V = 86016, HG_ST = 95232, HG_SEG = 112640, HG_DEC = 114688;
constexpr int HG_RSD = 272, HG_RSS = 144, HG_RSBF = 528;
__device__ __forceinline__ void hgrn_load(const HgCtx& c, int n, float (&lf)[16], v4u (&qB)[2], v4u (&kB)[2], v4u& vB) {
    const size_t cb = (size_t)__builtin_amdgcn_readfirstlane(c.b * TT + (c.dir ? (TT / 64 - 1 - n) * 64 : n * 64)) * 512 + c.h * 128;
    const float* Lc = c.Lp + cb; const bf16* Qc = c.Qb + cb; const bf16* Kc = c.Kp + cb; const bf16* Vc = c.Vb + cb;
#pragma unroll
    for (int i = 0; i < 16; ++i) lf[i] = Lc[c.offA[i]];
    qB[0] = *(const v4u*)(Qc + c.offB); qB[1] = *(const v4u*)(Qc + c.offB + 8); kB[0] = *(const v4u*)(Kc + c.offB); kB[1] = *(const v4u*)(Kc + c.offB + 8);
    vB = *(const v4u*)(Vc + c.offV);
}
__device__ __forceinline__ void hgrn_chunk(const HgCtx& c, int n, float (&lf)[16], v4u (&qB)[2], v4u (&kB)[2], v4u& vB, f32x4 (&S)[4]) {
    LAS unsigned char* lds = c.lds;
    const int dir = c.dir, lr = c.lr, lq = c.lq, wave = c.wave, dA = c.dA, seg = c.seg, tauB = c.tauB, dg = c.dg;
    const int tb = c.b * TT + (dir ? (TT / 64 - 1 - n) * 64 : n * 64);
    float bl[16]; { float cs = 0.f;
#pragma unroll
        for (int i = 0; i < 16; ++i) { cs += lf[i]; bl[i] = cs; }
        *(LAS float*)(lds + HG_SEG + (seg * 128 + dA) * 4) = cs; }
    __syncthreads();
    {
        const float p0 = *(LAS float*)(lds + HG_SEG + (0 * 128 + dA) * 4), p1 = *(LAS float*)(lds + HG_SEG + (1 * 128 + dA) * 4),
                    p2 = *(LAS float*)(lds + HG_SEG + (2 * 128 + dA) * 4), p3 = *(LAS float*)(lds + HG_SEG + (3 * 128 + dA) * 4);
        const float pre = (seg > 0 ? p0 : 0.f) + (seg > 1 ? p1 : 0.f) + (seg > 2 ? p2 : 0.f);
#pragma unroll
        for (int i = 0; i < 16; ++i) *(LAS float*)(lds + HG_BF + (16 * seg + i) * HG_RSBF + dA * 4) = pre + bl[i];
        if (seg == 0) *(LAS float*)(lds + HG_DEC + dA * 4) = __expf((p0 + p1) + (p2 + p3));
    }
    __syncthreads();
    {
        const unsigned qw[8] = {qB[0].x, qB[0].y, qB[0].z, qB[0].w, qB[1].x, qB[1].y, qB[1].z, qB[1].w};
        const unsigned kw[8] = {kB[0].x, kB[0].y, kB[0].z, kB[0].w, kB[1].x, kB[1].y, kB[1].z, kB[1].w};
        unsigned qo[8], ko[8], eo[8];
#pragma unroll
        for (int i = 0; i < 4; ++i) {
            const f32x4 bb = *(const LAS f32x4*)(lds + HG_BF + tauB * HG_RSBF + dg * 64 + i * 16);
            const f32x4 dc = *(const LAS f32x4*)(lds + HG_DEC + dg * 64 + i * 16);
#pragma unroll
            for (int j = 0; j < 2; ++j) {
                const float e0 = __expf(bb[2 * j]), e1 = __expf(bb[2 * j + 1]);
                const unsigned qq = qw[2 * i + j], kk = kw[2 * i + j];
                const float k0 = bf2f(kk & 0xffffu) * __builtin_amdgcn_rcpf(e0), k1 = bf2f(kk >> 16) * __builtin_amdgcn_rcpf(e1);
                qo[2 * i + j] = pk2(bf2f(qq & 0xffffu) * e0, bf2f(qq >> 16) * e1);
                ko[2 * i + j] = pk2(k0, k1);
                eo[2 * i + j] = pk2(k0 * dc[2 * j], k1 * dc[2 * j + 1]);
            }
        }
        *(LAS v4u*)(lds + HG_QI + tauB * HG_RSD + dg * 32) = (v4u){qo[0], qo[1], qo[2], qo[3]}; *(LAS v4u*)(lds + HG_QI + tauB * HG_RSD + dg * 32 + 16) = (v4u){qo[4], qo[5], qo[6], qo[7]};
        *(LAS v4u*)(lds + HG_KK + tauB * HG_RSD + dg * 32) = (v4u){ko[0], ko[1], ko[2], ko[3]}; *(LAS v4u*)(lds + HG_KK + tauB * HG_RSD + dg * 32 + 16) = (v4u){ko[4], ko[5], ko[6], ko[7]};
        *(LAS v4u*)(lds + HG_KE + tauB * HG_RSD + dg * 32) = (v4u){eo[0], eo[1], eo[2], eo[3]}; *(LAS v4u*)(lds + HG_KE + tauB * HG_RSD + dg * 32 + 16) = (v4u){eo[4], eo[5], eo[6], eo[7]};
        *(LAS v4u*)(lds + HG_V + tauB * HG_RSS + dg * 16) = vB;
    }
    __syncthreads();
    if (n + 2 < TT / 64) hgrn_load(c, n + 2, lf, qB, kB, vB);
    const int ei = wave & 3, tp = wave >> 2;
    v2u ket[2][2], vt[4][2][2];
    asm volatile("ds_read_b64_tr_b16 %0, %4\n\tds_read_b64_tr_b16 %1, %4 offset:1088\n\tds_read_b64_tr_b16 %2, %4 offset:8704\n\tds_read_b64_tr_b16 %3, %4 offset:9792"
                 : "=&v"(ket[0][0]), "=&v"(ket[0][1]), "=&v"(ket[1][0]), "=&v"(ket[1][1]) : "v"(c.ke_tr) : "memory");
#define HG_VTR(e4, o0, o1, o2, o3) asm volatile("ds_read_b64_tr_b16 %0, %4 offset:" #o0 "\n\tds_read_b64_tr_b16 %1, %4 offset:" #o1 "\n\tds_read_b64_tr_b16 %2, %4 offset:" #o2 "\n\tds_read_b64_tr_b16 %3, %4 offset:" #o3 \
                 : "=&v"(vt[e4][0][0]), "=&v"(vt[e4][0][1]), "=&v"(vt[e4][1][0]), "=&v"(vt[e4][1][1]) : "v"(c.v_tr) : "memory")
    HG_VTR(0, 0, 576, 4608, 5184); HG_VTR(1, 32, 608, 4640, 5216); HG_VTR(2, 64, 640, 4672, 5248); HG_VTR(3, 96, 672, 4704, 5280);
#undef HG_VTR
    {
        const int ti = wave & 3;
#pragma unroll
        for (int sii = 0; sii < 2; ++sii) {
            const int si = tp * 2 + sii;
            v2u w = (v2u){0u, 0u};
            if (si <= ti) {
                f32x4 a = (f32x4){0.f, 0.f, 0.f, 0.f};
#pragma unroll
                for (int kk = 0; kk < 4; ++kk)
                    a = __builtin_amdgcn_mfma_f32_16x16x32_bf16(lds_frag(lds + HG_KK + (16 * si + lr) * HG_RSD + kk * 64 + lq * 16), lds_frag(lds + HG_QI + (16 * ti + lr) * HG_RSD + kk * 64 + lq * 16), a, 0, 0, 0);
                const int s0 = 16 * si + 4 * lq, t = 16 * ti + lr;
                w.x = pk2(s0 + 0 <= t ? a[0] : 0.f, s0 + 1 <= t ? a[1] : 0.f); w.y = pk2(s0 + 2 <= t ? a[2] : 0.f, s0 + 3 <= t ? a[3] : 0.f);
            }
            *(LAS v2u*)(lds + HG_AM + (16 * ti + lr) * HG_RSS + (16 * si + 4 * lq) * 2) = w;
        }
    }
    f32x4 o[2];
#pragma unroll
    for (int tt = 0; tt < 2; ++tt) {
        o[tt] = (f32x4){0.f, 0.f, 0.f, 0.f};
#pragma unroll
        for (int kk = 0; kk < 4; ++kk)
            o[tt] = __builtin_amdgcn_mfma_f32_16x16x32_bf16(lds_frag(lds + HG_ST + (16 * ei + lr) * HG_RSD + kk * 64 + lq * 16), lds_frag(lds + HG_QI + (16 * (2 * tp + tt) + lr) * HG_RSD + kk * 64 + lq * 16), o[tt], 0, 0, 0);
    }
    asm volatile("s_waitcnt lgkmcnt(0)"
                 : "+v"(ket[0][0]), "+v"(ket[0][1]), "+v"(ket[1][0]), "+v"(ket[1][1]),
                   "+v"(vt[0][0][0]), "+v"(vt[0][0][1]), "+v"(vt[0][1][0]), "+v"(vt[0][1][1]), "+v"(vt[1][0][0]), "+v"(vt[1][0][1]), "+v"(vt[1][1][0]), "+v"(vt[1][1][1]),
                   "+v"(vt[2][0][0]), "+v"(vt[2][0][1]), "+v"(vt[2][1][0]), "+v"(vt[2][1][1]), "+v"(vt[3][0][0]), "+v"(vt[3][0][1]), "+v"(vt[3][1][0]), "+v"(vt[3][1][1]) :: "memory");
    {
        const f32x4 dv = *(const LAS f32x4*)(lds + HG_DEC + (16 * wave + 4 * lq) * 4);
#pragma unroll
        for (int e4 = 0; e4 < 4; ++e4) S[e4] = S[e4] * dv;
#pragma unroll
        for (int kk = 0; kk < 2; ++kk) {
            const pg8::bf16x8 af = mk_frag(ket[kk][0], ket[kk][1]);
#pragma unroll
            for (int e4 = 0; e4 < 4; ++e4) S[e4] = __builtin_amdgcn_mfma_f32_16x16x32_bf16(af, mk_frag(vt[e4][kk][0], vt[e4][kk][1]), S[e4], 0, 0, 0);
        }
    }
    const pg8::bf16x8 vf0 = ei == 0 ? mk_frag(vt[0][0][0], vt[0][0][1]) : ei == 1 ? mk_frag(vt[1][0][0], vt[1][0][1]) : ei == 2 ? mk_frag(vt[2][0][0], vt[2][0][1]) : mk_frag(vt[3][0][0], vt[3][0][1]);
    const pg8::bf16x8 vf1 = ei == 0 ? mk_frag(vt[0][1][0], vt[0][1][1]) : ei == 1 ? mk_frag(vt[1][1][0], vt[1][1][1]) : ei == 2 ? mk_frag(vt[2][1][0], vt[2][1][1]) : mk_frag(vt[3][1][0], vt[3][1][1]);
    __syncthreads();
#pragma unroll
    for (int tt = 0; tt < 2; ++tt) {
        o[tt] = __builtin_amdgcn_mfma_f32_16x16x32_bf16(vf0, lds_frag(lds + HG_AM + (16 * (2 * tp + tt) + lr) * HG_RSS + 0 * 64 + lq * 16), o[tt], 0, 0, 0);
        o[tt] = __builtin_amdgcn_mfma_f32_16x16x32_bf16(vf1, lds_frag(lds + HG_AM + (16 * (2 * tp + tt) + lr) * HG_RSS + 1 * 64 + lq * 16), o[tt], 0, 0, 0);
        const int t = 16 * (2 * tp + tt) + lr;
        *(f32x4*)(c.Op + (size_t)(dir ? tb + 63 - t : tb + t) * 512 + c.h * 128 + c.vh * 64 + 16 * ei + 4 * lq) = o[tt];
    }
#pragma unroll
    for (int e4 = 0; e4 < 4; ++e4) { v2u w; w.x = pk2(S[e4][0], S[e4][1]); w.y = pk2(S[e4][2], S[e4][3]); *(LAS v2u*)(lds + HG_ST + (16 * e4 + lr) * HG_RSD + (16 * wave + 4 * lq) * 2) = w; }
}
__device__ __forceinline__ void hgrn_unit(LAS unsigned char* lds, int unit, const bf16* Qb, const bf16* KFb, const bf16* KBb, const bf16* Vb, const float* LFb, const float* LBb,
                                          float* OFb, float* OBb, int tid, int lane, int wave) {
    HgCtx c;
    c.lds = lds; c.vh = unit & 1; c.dir = (unit >> 1) & 1; c.h = (unit >> 2) & 3; c.b = unit >> 4;
    c.Qb = Qb; c.Vb = Vb; c.Kp = c.dir ? KBb : KFb; c.Lp = c.dir ? LBb : LFb; c.Op = c.dir ? OBb : OFb;
    c.lane = lane; c.wave = wave; c.lr = lane & 15; c.lq = lane >> 4;
    c.dA = tid & 127; c.seg = tid >> 7;
    c.tauB = tid >> 3; c.dg = tid & 7;
    for (int i = tid; i < 64 * HG_RSD / 16; i += NTHR) *(LAS v4u*)(lds + HG_ST + i * 16) = (v4u){0u, 0u, 0u, 0u};
    f32x4 S[4];
#pragma unroll
    for (int i = 0; i < 4; ++i) S[i] = (f32x4){0.f, 0.f, 0.f, 0.f};
#pragma unroll
    for (int i = 0; i < 16; ++i) { const int tau = 16 * c.seg + i; c.offA[i] = (unsigned)((c.dir ? 63 - tau : tau) * 512 + c.dA); }
    c.offB = (unsigned)((c.dir ? 63 - c.tauB : c.tauB) * 512 + 16 * c.dg); c.offV = (unsigned)((c.dir ? 63 - c.tauB : c.tauB) * 512 + c.vh * 64 + 8 * c.dg);
    const unsigned trrow = (unsigned)(8 * c.lq + ((lane & 15) >> 2)), trcol = (unsigned)(4 * (lane & 3));
    c.ke_tr = (unsigned)(size_t)(lds + HG_KE) + trrow * HG_RSD + (16 * wave + trcol) * 2;
    c.v_tr = (unsigned)(size_t)(lds + HG_V) + trrow * HG_RSS + trcol * 2;
    float lf0[16], lf1[16]; v4u qB0[2], kB0[2], vB0, qB1[2], kB1[2], vB1;
    hgrn_load(c, 0, lf0, qB0, kB0, vB0); hgrn_load(c, 1, lf1, qB1, kB1, vB1);
#pragma unroll 1
    for (int n = 0; n < TT / 64; n += 2) { hgrn_chunk(c, n, lf0, qB0, kB0, vB0, S); hgrn_chunk(c, n + 1, lf1, qB1, kB1, vB1, S); }
    __syncthreads();
}

__device__ __forceinline__ void router_finish(float (&a)[NE], int m, int lane, const float* router_b, LAS int* lcnt, LAS unsigned* sbw, float* GATE) {
#define RF_STEP(s2, n) { const bool up = (lane & (s2)) != 0; _Pragma("unroll") for (int i = 0; i < (n); ++i) { const float k1 = up ? a[i + (n)] : a[i], x1 = up ? a[i] : a[i + (n)]; a[i] = k1 + __shfl_xor(x1, (s2)); } }
    RF_STEP(32, 16) RF_STEP(16, 8) RF_STEP(8, 4) RF_STEP(4, 2) RF_STEP(2, 1)
#undef RF_STEP
    float lg = a[0] + __shfl_xor(a[0], 1);
    const int myE = lane >> 1;
    lg += router_b[myE];
    float tv[TOPK]; int ti[TOPK];
#pragma unroll
    for (int k = 0; k < TOPK; ++k) {
        float mx = lg;
#pragma unroll
        for (int o = 1; o < 64; o <<= 1) mx = fmaxf(mx, __shfl_xor(mx, o));
        int cand = (lg == mx) ? myE : 99;
#pragma unroll
        for (int o = 1; o < 64; o <<= 1) cand = min(cand, __shfl_xor(cand, o));
        tv[k] = mx; ti[k] = cand;
        if (myE == cand) lg = -INFINITY;
    }
    const float e1 = __expf(tv[1] - tv[0]), e2 = __expf(tv[2] - tv[0]), e3 = __expf(tv[3] - tv[0]);
    const float inv = 1.0f / (1.0f + e1 + e2 + e3);
    if (lane < TOPK && m < MTOK) {
        const int ek = lane == 0 ? ti[0] : lane == 1 ? ti[1] : lane == 2 ? ti[2] : ti[3];
        const float gk = (lane == 0 ? 1.0f : lane == 1 ? e1 : lane == 2 ? e2 : e3) * inv;
        const int lr = __hip_atomic_fetch_add(&lcnt[ek], 1, __ATOMIC_RELAXED, __HIP_MEMORY_SCOPE_WORKGROUP);
        sbw[lane] = ((unsigned)ek << 16) | (unsigned)lr;
        GATE[(size_t)m * TOPK + lane] = gk;
    }
}
struct Args { const float* in[18]; float* out; unsigned char* ws; int ph_lo, ph_hi; };
__global__ void __launch_bounds__(NTHR, 2) fwd_kernel(Args args) {
    extern __shared__ __attribute__((aligned(16))) unsigned char lds_raw[];
    LAS unsigned char* lds = (LAS unsigned char*)lds_raw;
    volatile LAS unsigned* MISC = (volatile LAS unsigned*)(lds + MISC_OFF);
    const int tid = threadIdx.x, lane = tid & 63, wave = __builtin_amdgcn_readfirstlane(tid >> 6);
    const int G = gridDim.x; const int bx = blockIdx.x; const int vcu = (G % 8 == 0) ? (bx % 8) * (G / 8) + bx / 8 : bx;
    const int gw = vcu * NWAVES + wave, NGW = G * NWAVES;
    unsigned char* ws = args.ws;
    unsigned* ctl = (unsigned*)(ws + WS_CTL);
    const float* x = args.in[0]; const float* norm1_w = args.in[1]; const float* w_in = args.in[2]; const float* lb_logits = args.in[3];
    const float* hgrn_norm_w = args.in[4]; const float* dw_w = args.in[5]; const float* dw_b = args.in[6]; const float* conv_ln_w = args.in[7]; const float* conv_ln_b = args.in[8];
    const float* w_out = args.in[9]; const float* norm2_w = args.in[10]; const float* router_w = args.in[11]; const float* router_b = args.in[12];
    const float* w1 = args.in[13]; const float* b1 = args.in[14]; const float* w2 = args.in[15]; const float* b2 = args.in[16]; const float* final_norm_w = args.in[17];
    float* out = args.out;
    bf16* WI = (bf16*)(ws + WS_WI); bf16* WO = (bf16*)(ws + WS_WO); unsigned char* W1T = ws + WS_W1; unsigned char* W2T = ws + WS_W2;
    float* H = (float*)(ws + WS_H); bf16* XN = (bf16*)(ws + WS_XN);
    bf16* Qb = (bf16*)(ws + WS_Q); bf16* KFb = (bf16*)(ws + WS_KF); bf16* KBb = (bf16*)(ws + WS_KB); bf16* Vb = (bf16*)(ws + WS_V); bf16* Gb = (bf16*)(ws + WS_G); bf16* Ub = (bf16*)(ws + WS_U);
    float* LFb = (float*)(ws + WS_LF); float* LBb = (float*)(ws + WS_LB); float* OFb = (float*)(ws + WS_OF); float* OBb = (float*)(ws + WS_OB);
    bf16* MIX = (bf16*)(ws + WS_MIX); unsigned char* XS = ws + WS_XS; unsigned char* ACT = ws + WS_ACT; unsigned char* N2 = ws + WS_XN; bf16* YS = (bf16*)(ws + WS_YS);
    float* WRT = (float*)(ws + WS_WRT); int* SLOT = (int*)(ws + WS_SLOT); float* GATE = (float*)(ws + WS_GATE); int* ROWTOK = (int*)(ws + WS_ROWTOK);
    volatile LAS int* bs = (volatile LAS int*)(lds + TAB_OFF);
    volatile LAS int* cl = (volatile LAS int*)(lds + TAB_OFF + 256);
    LAS int* lcnt = (LAS int*)(lds + TAB_OFF + 512);
    volatile LAS int* gbase = (volatile LAS int*)(lds + TAB_OFF + 768);

    for (int u = tid; u < (LDS_BYTES - LDSCTL_OFF) / 4; u += NTHR) ((LAS unsigned*)(lds + LDSCTL_OFF))[u] = 0u;
    __syncthreads();
    XcdBarrier bar; bar.bar = ctl + CW_BAR; bar.x = 0; bar.st = nullptr;
    if (MK_N_LAUNCHES == 1) bar = xcd_barrier_post(ctl + CW_BAR, MISC + 8);
    const int lo = args.ph_lo, hi = args.ph_hi;
#ifndef PHASE_MASK
#define PHASE_MASK 0xffffffffu
#endif
#define IN(k) ((((PHASE_MASK) >> (k)) & 1u) && lo <= (k) && (k) < hi)
#ifndef PROBE_DUP
#define PROBE_DUP -1
#endif
#define REP(k) _Pragma("unroll 1") for (int rep_ = 0; rep_ < ((PROBE_DUP) == (k) ? 2 + (args.ph_hi >> 20) : 1); ++rep_)
#define SEAM(k) do { if (IN(k) && IN((k) + 1)) { xcd_barrier(bar); if ((PROBE_DUP) == 99) { xcd_barrier(bar); xcd_barrier(bar); } } } while (0)
#define BUILD_BS() do { if (tid == 0) { int a_ = 0; for (int e_ = 0; e_ < NE; ++e_) { bs[e_] = a_; const int c_ = (int)__hip_atomic_load(ctl + CW_CNT + 64 * e_, RLX_AGENT); cl[e_] = c_; a_ += (c_ + 255) >> 8; } bs[NE] = a_; } __syncthreads(); } while (0)

    if (IN(0)) REP(0) {
        LAS float* scr = (LAS float*)(lds + RING_OFF + wave * 16384);
        constexpr int I_WI = (D / 64) * (INC / 32), I_WO = (D / 64) * (D / 32), I_W1 = (D / 64) * (2 * FF / 32), I_W2 = (FF / 64) * (D / 32);
        #if defined(HGRN_NAIVE) || defined(W2_IN_P0)
        constexpr int NITEMS = I_WI + I_WO + NE * I_W1 + NE * I_W2;
#else
        constexpr int NITEMS = I_WI + I_WO + NE * I_W1;
#endif
        for (int it = gw; it < NITEMS; it += NGW) {
            int r = it;
            if (r < I_WI) { p0_item<false>(w_in, D, INC, WI, RmWin(), scr, r, lane); continue; } r -= I_WI;
            if (r < I_WO) { p0_item<false>(w_out, D, D, WO, RmIdent(), scr, r, lane); continue; } r -= I_WO;
            if (r < NE * I_W1) { const int e = r / I_W1; p0_item<true>(w1 + (size_t)e * D * 2 * FF, D, 2 * FF, W1T + (size_t)e * 2 * FF * D, RmW1(), scr, r - e * I_W1, lane); continue; } r -= NE * I_W1;
#if defined(HGRN_NAIVE) || defined(W2_IN_P0)
            { const int e = r / I_W2; p0_item<true>(w2 + (size_t)e * FF * D, FF, D, W2T + (size_t)e * D * FF, RmIdent(), scr, r - e * I_W2, lane); }
#endif
        }
        for (int m = gw; m < MTOK; m += NGW) rms_row_to_bf16(x + (size_t)m * D, norm1_w, XN + (size_t)m * D, lane);
        for (int i = bx * NTHR + tid; i < 16 * D; i += G * NTHR) {
            const int r = i >> 4, e16 = i & 15, k = 256 * (r & 3) + (r >> 2); const float gk = norm2_w[k];
            WRT[2 * i] = gk * router_w[k * NE + e16]; WRT[2 * i + 1] = gk * router_w[k * NE + 16 + e16]; }
    }
    SEAM(0);

    if (IN(1)) REP(1) {
        pg8::Gemm g{XN, WI, MTOK, INC, D}; OrderRep S; S.init(MTOK, INC, G, bx); S.reps = ((PROBE_DUP) == 11) ? 2 : 1;
        EpiProj E{Qb, KFb, KBb, Vb, Gb, Ub, LFb, LBb, lb_logits};
        pg8::gemm_phase<EpiProj, OrderRep, true, true>(lds + RING_OFF, g, S, E);
    }
    SEAM(1);

    if (IN(2)) REP(2) {
        const bool split = (G == 256);
#if defined(HGRN_NAIVE)
        const bool hsel = true; const int hidx = 0, hstride = 1; const bool csel = true; const int cidx = vcu, cstride = G;
#else
        const bool hsel = split ? (((bx >> 3) & 1) != 0) : true; const int hidx = split ? (bx >> 4) * 8 + (bx & 7) : bx, hstride = split ? 128 : G;
        const bool csel = split ? !hsel : true; const int cidx = split ? (bx >> 4) * 8 + (bx & 7) : bx, cstride = split ? 128 : G;
#endif
        (void)hidx; (void)hstride;
        if (csel) for (int crep_ = 0; crep_ < ((PROBE_DUP) == 21 ? 2 : 1); ++crep_) {
            LAS unsigned short* ut = (LAS unsigned short*)(lds + RING_OFF);
            LAS float* part = (LAS float*)(lds + RING_OFF + 98304);
            LAS float* stat = (LAS float*)(lds + RING_OFF + 98304 + 4096);
            for (int unit = cidx; unit < NBATCH * (TT / 64); unit += cstride) {
                const int b = unit / (TT / 64), t0 = (unit % (TT / 64)) * 64;
                for (int idx = tid; idx < 94 * 64; idx += NTHR) {
                    const int r = idx >> 6, p = idx & 63, t = t0 - 15 + r;
                    v4u val = (v4u){0u, 0u, 0u, 0u};
                    if (t >= 0 && t < TT) val = *(const v4u*)(Ub + (size_t)(b * TT + t) * CCH + p * 8);
                    *(LAS v4u*)(ut + r * 512 + p * 8) = val;
                }
                __syncthreads();
                const int c = tid;
                float w[CLEN];
#pragma unroll
                for (int j = 0; j < CLEN; ++j) w[j] = dw_w[j * CCH + c];
                const float bias = dw_b[c];
                float y[64];
#pragma unroll
                for (int tb = 0; tb < 8; ++tb) {
                    float win[38];
#pragma unroll
                    for (int i = 0; i < 38; ++i) win[i] = bf2f(ut[(tb * 8 + i) * 512 + c]);
#pragma unroll
                    for (int o = 0; o < 8; ++o) { float a = bias;
#pragma unroll
                        for (int j = 0; j < CLEN; ++j) a += w[j] * win[o + j];
                        y[tb * 8 + o] = a; }
                }
#pragma unroll 1
                for (int pass = 0; pass < 2; ++pass) {
                    float s1[64];
#pragma unroll
                    for (int i = 0; i < 64; ++i) s1[i] = pass ? y[i] * y[i] : y[i];
#pragma unroll
                    for (int s = 32; s >= 1; s >>= 1) {
                        const bool up = (lane & s) != 0;
#pragma unroll
                        for (int i = 0; i < s; ++i) { const float k1 = up ? s1[i + s] : s1[i], x1 = up ? s1[i] : s1[i + s]; s1[i] = k1 + __shfl_xor(x1, s); }
                    }
                    part[(wave * 64 + lane) * 2 + pass] = s1[0];
                }
                __syncthreads();
                if (tid < 64) { float a = 0.f, q = 0.f;
#pragma unroll
                    for (int wv = 0; wv < 8; ++wv) { a += part[(wv * 64 + tid) * 2]; q += part[(wv * 64 + tid) * 2 + 1]; }
                    const float mean = a * (1.f / CCH), var = q * (1.f / CCH) - mean * mean;
                    stat[tid * 2] = mean; stat[tid * 2 + 1] = rsqrtf(fmaxf(var, 0.f) + EPS); }
                __syncthreads();
                const float lw = conv_ln_w[c], lbias = conv_ln_b[c];
#pragma unroll
                for (int t = 0; t < 64; ++t) {
                    const float v = (y[t] - stat[t * 2]) * stat[t * 2 + 1] * lw + lbias;
                    MIX[(size_t)(b * TT + t0 + t) * D + 512 + c] = (bf16)(pk2(v * sigm(v), 0.f) & 0xffffu);
                }
                __syncthreads();
            }
#if !defined(HGRN_NAIVE) && !defined(W2_IN_P0)
            {
                LAS float* scr = (LAS float*)(lds + RING_OFF + wave * 16384);
                constexpr int I_W2 = (FF / 64) * (D / 32);
                for (int it = cidx * NWAVES + wave; it < NE * I_W2; it += cstride * NWAVES) { const int e = it / I_W2;
                    p0_item<true>(w2 + (size_t)e * FF * D, FF, D, W2T + (size_t)e * D * FF, RmIdent(), scr, it - e * I_W2, lane); }
            }
#endif
        }
#if defined(HGRN_NAIVE)
        {
            LAS float* qs = (LAS float*)(lds + RING_OFF); LAS float* ks = qs + 2048; LAS float* fs = ks + 2048; LAS float* vs = fs + 2048; LAS float* op = vs + 2048;
            const int e = tid & 127, dq = tid >> 7;
            for (int unit = G - 1 - bx; unit < NBATCH * NH * 2; unit += G) {
                const int dir = unit & 1, h = (unit >> 1) & 3, b = unit >> 3;
                const bf16* Kp = dir ? KBb : KFb; const float* Lp = dir ? LBb : LFb; float* Op = dir ? OBb : OFb;
                float S[32];
#pragma unroll
                for (int i = 0; i < 32; ++i) S[i] = 0.f;
                for (int blk = 0; blk < TT / 16; ++blk) {
                    const int tb = dir ? (TT - 16 - blk * 16) : blk * 16;
#pragma unroll
                    for (int i = 0; i < 4; ++i) { const int idx = tid + NTHR * i, r = idx >> 7, d = idx & 127; const size_t off = (size_t)(b * TT + tb + r) * 512 + h * 128 + d;
                        qs[idx] = bf2f(Qb[off]); ks[idx] = bf2f(Kp[off]); fs[idx] = __expf(Lp[off]); vs[idx] = bf2f(Vb[off]); }
                    __syncthreads();
                    for (int st = 0; st < 16; ++st) {
                        const int r = dir ? 15 - st : st; const float v = vs[r * 128 + e]; float o = 0.f;
#pragma unroll
                        for (int dd = 0; dd < 32; ++dd) { const int d = dq * 32 + dd; S[dd] = fs[r * 128 + d] * S[dd] + ks[r * 128 + d] * v; o += qs[r * 128 + d] * S[dd]; }
                        op[(r * 4 + dq) * 128 + e] = o;
                    }
                    __syncthreads();
#pragma unroll
                    for (int i = 0; i < 4; ++i) { const int idx = tid + NTHR * i, r = idx >> 7, ee = idx & 127;
                        Op[(size_t)(b * TT + tb + r) * 512 + h * 128 + ee] = (op[(r * 4 + 0) * 128 + ee] + op[(r * 4 + 1) * 128 + ee]) + (op[(r * 4 + 2) * 128 + ee] + op[(r * 4 + 3) * 128 + ee]); }
                }
                __syncthreads();
            }
        }
#else
        if (hsel) for (int hrep_ = 0; hrep_ < ((PROBE_DUP) == 20 ? 2 : 1); ++hrep_) for (int unit = hidx; unit < NBATCH * NH * 4; unit += hstride) hgrn_unit(lds + RING_OFF, unit, Qb, KFb, KBb, Vb, LFb, LBb, OFb, OBb, tid, lane, wave);
#endif
    }
    SEAM(2);

    if (IN(3)) REP(3) {
        for (int m = gw; m < MTOK; m += NGW) {
            const size_t off = (size_t)m * 512 + lane * 8;
            const f32x4 a0 = *(const f32x4*)(OFb + off), a1 = *(const f32x4*)(OFb + off + 4), c0 = *(const f32x4*)(OBb + off), c1 = *(const f32x4*)(OBb + off + 4);
            const f32x4 o0 = a0 + c0, o1 = a1 + c1;
            float ss = (o0.x * o0.x + o0.y * o0.y) + (o0.z * o0.z + o0.w * o0.w) + (o1.x * o1.x + o1.y * o1.y) + (o1.z * o1.z + o1.w * o1.w);
            ss += __shfl_xor(ss, 1); ss += __shfl_xor(ss, 2); ss += __shfl_xor(ss, 4); ss += __shfl_xor(ss, 8);
            const float rstd = rsqrtf(ss * (1.f / DV) + EPS);
            const v4u gv = *(const v4u*)(Gb + off);
            const f32x4 w0 = *(const f32x4*)(hgrn_norm_w + lane * 8), w1v = *(const f32x4*)(hgrn_norm_w + lane * 8 + 4);
            f32x4 r0, r1;
            r0.x = o0.x * rstd * w0.x * bf2f(gv.x & 0xffffu); r0.y = o0.y * rstd * w0.y * bf2f(gv.x >> 16);
            r0.z = o0.z * rstd * w0.z * bf2f(gv.y & 0xffffu); r0.w = o0.w * rstd * w0.w * bf2f(gv.y >> 16);
            r1.x = o1.x * rstd * w1v.x * bf2f(gv.z & 0xffffu); r1.y = o1.y * rstd * w1v.y * bf2f(gv.z >> 16);
            r1.z = o1.z * rstd * w1v.z * bf2f(gv.w & 0xffffu); r1.w = o1.w * rstd * w1v.w * bf2f(gv.w >> 16);
            st8bf(MIX + (size_t)m * D + lane * 8, r0, r1);
        }
    }
    SEAM(3);

    if (IN(4)) REP(4) {
        pg8::Gemm g{MIX, WO, MTOK, D, D}; pg8::StaticOrder S; S.init(MTOK, D, G, bx);
        EpiRes E{x, H};
        pg8::gemm_phase<EpiRes, pg8::StaticOrder, true, true>(lds + RING_OFF, g, S, E);
    }
    SEAM(4);

    if (IN(5)) REP(5) {
        typedef float f32x2 __attribute__((ext_vector_type(2)));
        LAS float* wl = (LAS float*)(lds + RING_OFF);
        LAS unsigned* sb = (LAS unsigned*)(lds + SB_OFF);
        for (int i = tid; i < NE * D / 4; i += NTHR) ((LAS f32x4*)wl)[i] = ((const f32x4*)WRT)[i];
        if (tid < NE) lcnt[tid] = 0;
        __syncthreads();
        for (int tg = vcu; tg < MTOK / 64; tg += G) {
            const int tok0 = tg * 64 + 16 * (wave & 3);
            if (wave < 4) {
                const int j = lane & 15, q = lane >> 4;
                const f32x4* hrow = (const f32x4*)(H + (size_t)(tok0 + j) * D + 256 * q);
                const LAS f32x2* tab = (const LAS f32x2*)wl + q * 16 + j;
                f32x4 acc0 = (f32x4){0.f, 0.f, 0.f, 0.f}, acc1 = acc0; float ss = 0.f;
                f32x4 hv = hrow[0];
#pragma unroll 2
                for (int s4 = 0; s4 < 64; ++s4) {
                    const f32x4 hc = hv;
                    if (s4 + 1 < 64) hv = hrow[s4 + 1];
                    f32x2 w[4];
#pragma unroll
                    for (int u = 0; u < 4; ++u) w[u] = tab[(4 * s4 + u) * 64];
                    ss += (hc.x * hc.x + hc.y * hc.y) + (hc.z * hc.z + hc.w * hc.w);
#pragma unroll
                    for (int u = 0; u < 4; ++u) { acc0 = __builtin_amdgcn_mfma_f32_16x16x4f32(w[u].x, hc[u], acc0, 0, 0, 0); acc1 = __builtin_amdgcn_mfma_f32_16x16x4f32(w[u].y, hc[u], acc1, 0, 0, 0); }
                }
                ss += __shfl_xor(ss, 16); ss += __shfl_xor(ss, 32);
                const float rstd = rsqrtf(ss * (1.f / D) + EPS);
                float lg[8];
#pragma unroll
                for (int r = 0; r < 4; ++r) { lg[r] = acc0[r] * rstd + router_b[4 * q + r]; lg[4 + r] = acc1[r] * rstd + router_b[16 + 4 * q + r]; }
                float tv[TOPK]; int ti[TOPK];
#pragma unroll
                for (int k = 0; k < TOPK; ++k) {
                    float bv = lg[0]; int bi = 4 * q;
#pragma unroll
                    for (int r = 1; r < 8; ++r) { const int id = (r < 4) ? 4 * q + r : 16 + 4 * q + (r - 4); if (lg[r] > bv) { bv = lg[r]; bi = id; } }
#pragma unroll
                    for (int o = 16; o < 64; o <<= 1) { const float ov = __shfl_xor(bv, o); const int oi = __shfl_xor(bi, o); if (ov > bv || (ov == bv && oi < bi)) { bv = ov; bi = oi; } }
                    tv[k] = bv; ti[k] = bi;
#pragma unroll
                    for (int r = 0; r < 8; ++r) { const int id = (r < 4) ? 4 * q + r : 16 + 4 * q + (r - 4); if (id == bi) lg[r] = -INFINITY; }
                }
                const float e1 = __expf(tv[1] - tv[0]), e2 = __expf(tv[2] - tv[0]), e3 = __expf(tv[3] - tv[0]);
                const float inv = 1.0f / (1.0f + e1 + e2 + e3);
                {
                    const int ek = q == 0 ? ti[0] : q == 1 ? ti[1] : q == 2 ? ti[2] : ti[3];
                    const float gk = (q == 0 ? 1.0f : q == 1 ? e1 : q == 2 ? e2 : e3) * inv;
                    const int lr = __hip_atomic_fetch_add(&lcnt[ek], 1, __ATOMIC_RELAXED, __HIP_MEMORY_SCOPE_WORKGROUP);
                    sb[(16 * wave + j) * 4 + q] = ((unsigned)ek << 16) | (unsigned)lr;
                    GATE[(size_t)(tok0 + j) * TOPK + q] = gk;
                }
            } else {
                for (int i = 0; i < 16; ++i) {
                    const int m = tok0 + i;
                    const f32x4* hr = (const f32x4*)(H + (size_t)m * D) + lane; const f32x4* wr = (const f32x4*)norm2_w + lane;
                    f32x4 v[4]; float s2 = 0.f;
#pragma unroll
                    for (int jj = 0; jj < 4; ++jj) { v[jj] = hr[64 * jj]; s2 += (v[jj].x * v[jj].x + v[jj].y * v[jj].y) + (v[jj].z * v[jj].z + v[jj].w * v[jj].w); }
                    const float rstd = rsqrtf(wave_sum(s2) * (1.f / D) + EPS) * SC_N2;
                    unsigned* o4 = (unsigned*)(N2 + (size_t)m * D) + lane;
#pragma unroll
                    for (int jj = 0; jj < 4; ++jj) { const f32x4 g = wr[64 * jj]; o4[64 * jj] = pk4_fp8(v[jj].x * rstd * g.x, v[jj].y * rstd * g.y, v[jj].z * rstd * g.z, v[jj].w * rstd * g.w); }
                }
            }
            __syncthreads();
            if (tid < NE) { const int c = lcnt[tid]; gbase[tid] = c ? (int)__hip_atomic_fetch_add(ctl + CW_CNT + ((PROBE_DUP) == 5 && rep_ == 0 ? 4096 : 0) + 64 * tid, (unsigned)c, RLX_AGENT) : 0; }
            __syncthreads();
            if (tid < 256) { const unsigned w = sb[tid]; const int ek = (int)(w >> 16), r = gbase[ek] + (int)(w & 0xffffu), m = tg * 64 + (tid >> 2);
                ROWTOK[ek * MTOK + r] = m; SLOT[(size_t)m * TOPK + (tid & 3)] = ek * MTOK + r; }
            if (tid < NE) lcnt[tid] = 0;
            __syncthreads();
        }
    }
    SEAM(5);

    if (IN(6)) REP(6) {
        BUILD_BS();
        const int nrows = bs[NE] * 256;
        for (int r = gw; r < nrows; r += NGW) {
            const int mb = r >> 8; int e = 0;
            while (e < NE - 1 && bs[e + 1] <= mb) ++e;
            const int rank = r - bs[e] * 256;
            v4u a = (v4u){0u, 0u, 0u, 0u};
            if (rank < cl[e]) { const int tok = ROWTOK[e * MTOK + rank]; a = ((const v4u*)(N2 + (size_t)tok * D))[lane]; }
            ((v4u*)(XS + (size_t)r * D))[lane] = a;
        }
    }
    SEAM(6);

    if (IN(7)) REP(7) {
        BUILD_BS();
        pg8::Gemm g{(const bf16*)XS, (const bf16*)W1T, MOE_ROWS, 2 * FF, D / 2}; MoeOrder S{bs, 8, G, vcu};
        EpiSwiglu E{ACT, b1};
        pg8::gemm_phase<EpiSwiglu, MoeOrder, true, true, true>(lds + RING_OFF, g, S, E);
    }
    SEAM(7);

    if (IN(8)) REP(8) {
        BUILD_BS();
        pg8::Gemm g{(const bf16*)ACT, (const bf16*)W2T, MOE_ROWS, D, FF / 2}; MoeOrder S{bs, 4, G, vcu};
        EpiDown E{YS, b2};
        pg8::gemm_phase<EpiDown, MoeOrder, true, true, true>(lds + RING_OFF, g, S, E);
    }
    SEAM(8);

    if (IN(9)) REP(9) {
        BUILD_BS();
        for (int m = gw; m < MTOK; m += NGW) {
            const f32x4* hr = (const f32x4*)(H + (size_t)m * D) + lane; const f32x4* wr = (const f32x4*)final_norm_w + lane;
            f32x4 v[4];
#pragma unroll
            for (int j = 0; j < 4; ++j) v[j] = hr[64 * j];
#pragma unroll
            for (int k = 0; k < TOPK; ++k) {
                const int sl = SLOT[(size_t)m * TOPK + k]; const float gk = GATE[(size_t)m * TOPK + k];
                const int e = sl >> 14, pos = bs[e] * 256 + (sl & (MTOK - 1));
                const v2u* yr = (const v2u*)(YS + (size_t)pos * D) + lane;
#pragma unroll
                for (int j = 0; j < 4; ++j) { const v2u w = yr[64 * j];
                    v[j].x += gk * bf2f(w.x & 0xffffu); v[j].y += gk * bf2f(w.x >> 16); v[j].z += gk * bf2f(w.y & 0xffffu); v[j].w += gk * bf2f(w.y >> 16); }
            }
            float s = 0.f;
#pragma unroll
            for (int j = 0; j < 4; ++j) s += (v[j].x * v[j].x + v[j].y * v[j].y) + (v[j].z * v[j].z + v[j].w * v[j].w);
            const float rstd = rsqrtf(wave_sum(s) * (1.f / D) + EPS);
            f32x4* orow = (f32x4*)(out + (size_t)m * D) + lane;
#pragma unroll
            for (int j = 0; j < 4; ++j) orow[64 * j] = v[j] * rstd * wr[64 * j];
        }
    }
#undef IN
#undef SEAM
#undef BUILD_BS
}

extern "C" void kernel_launch(void* const* d_in, const int* in_sizes, int n_in, void* d_out, int out_size, void* d_ws, size_t ws_size, hipStream_t stream) {
    static int grid = 0;
    if (grid == 0) {
        if (n_in != 18 || in_sizes[0] != MTOK * D || out_size != MTOK * D || ws_size < WS_END) { fprintf(stderr, "kernel_launch: unexpected shapes (n_in %d, in0 %d, out %d, ws %zu < %zu); nothing launched\n", n_in, n_in > 0 ? in_sizes[0] : -1, out_size, ws_size, (size_t)WS_END); grid = -1; return; }
        int dev = 0, cus = 0, per_cu = 0;
        if (hipGetDevice(&dev) != hipSuccess || hipDeviceGetAttribute(&cus, hipDeviceAttributeMultiprocessorCount, dev) != hipSuccess) { fprintf(stderr, "kernel_launch: device query failed\n"); grid = -1; return; }
        if (hipFuncSetAttribute((const void*)fwd_kernel, hipFuncAttributeMaxDynamicSharedMemorySize, LDS_BYTES) != hipSuccess) { fprintf(stderr, "kernel_launch: hipFuncSetAttribute failed\n"); grid = -1; return; }
        if (hipOccupancyMaxActiveBlocksPerMultiprocessor(&per_cu, (const void*)fwd_kernel, NTHR, LDS_BYTES) != hipSuccess || per_cu < 1)
            fprintf(stderr, "kernel_launch: note: occupancy query reports %d workgroups per CU\n", per_cu);
        (void)hipGetLastError();
        grid = cus;
    }
    if (grid < 0) return;
    if (hipMemsetAsync((char*)d_ws + WS_CTL, 0, CTL_ZERO_BYTES, stream) != hipSuccess) { fprintf(stderr, "kernel_launch: memset failed\n"); return; }
    Args a{};
    for (int i = 0; i < 18; ++i) a.in[i] = (const float*)d_in[i];
    a.out = (float*)d_out; a.ws = (unsigned char*)d_ws;
#if MK_N_LAUNCHES == 1
    a.ph_lo = 0; a.ph_hi = N_PHASES;
    hipLaunchKernelGGL(fwd_kernel, dim3(grid), dim3(NTHR), LDS_BYTES, stream, a);
#else
    for (int ph = 0; ph < N_PHASES; ++ph) { a.ph_lo = ph; a.ph_hi = ph + 1; hipLaunchKernelGGL(fwd_kernel, dim3(grid), dim3(NTHR), LDS_BYTES, stream, a); }
#endif
    const hipError_t le = hipPeekAtLastError();
    if (le != hipSuccess) fprintf(stderr, "kernel_launch: launch failed: %s\n", hipGetErrorName(le));
}
```

```cpp
#include <hip/hip_runtime.h>
#include <cstdio>
#include <cstdint>
namespace pg8 {
#define PG8_LAS __attribute__((address_space(3)))
typedef unsigned short bf16_t;
typedef short bf16x8 __attribute__((ext_vector_type(8)));
typedef float f32x4 __attribute__((ext_vector_type(4)));
typedef unsigned u32x4 __attribute__((ext_vector_type(4)));
constexpr int BM = 256, BK = 64, HALF = 128, HTB = HALF * BK * 2  , STAGE_BYTES = 8 * HTB, NXCD = 8, WGM = 8;

__host__ __device__ __forceinline__ int lds_byte(int r, int c) { const int st = (r >> 4) * 2 + (c >> 5), rr = r & 15, cc = c & 31, ob = rr * 64 + cc * 2; return st * 1024 + (ob ^ (((ob >> 9) & 1) << 5)); }
__host__ __device__ __forceinline__ void stage_rc(int b, int& R, int& C) { const int st = b / 1024, sb = b % 1024, swz = sb ^ (((sb >> 9) & 1) << 5); R = (st >> 1) * 16 + swz / 64; C = (st & 1) * 32 + (swz % 64) / 2; }
__host__ __device__ __forceinline__ int perm32(int rho) { const int n = rho >> 4, i = rho & 15; return 8 * (i >> 2) + 4 * n + (i & 3); }

struct Unit { int pm, pn; };
struct Gemm { const bf16_t* A; const bf16_t* Bt; int M, N, K; };

struct StaticOrder {
    int nM, nN, nwg, G, c;
    __host__ __device__ void init(int M, int N, int G_, int c_) { nM = M / BM; nN = N / BM; nwg = nM * nN; G = G_; c = c_; }
    __host__ __device__ bool next(int i, Unit& u) const {
        const long L = (long)i * G + c; if (L >= nwg) return false;
        int wgid = (int)L; { const int q = nwg / NXCD, r = nwg % NXCD, xcd = wgid % NXCD, off = wgid / NXCD; wgid = (xcd < r ? xcd * (q + 1) : r * (q + 1) + (xcd - r) * q) + off; }
        const int nig = WGM * nN, gid = wgid / nig, fm = gid * WGM, gsz = (nM - fm) < WGM ? (nM - fm) : WGM;
        u.pm = fm + ((wgid % nig) % gsz); u.pn = (wgid % nig) / gsz; return true;
    }
    __device__ __forceinline__ void a_ready(const Unit&) const {}
    __device__ __forceinline__ void done(const Unit&) const {}
};
__device__ __forceinline__ unsigned cvt_pk_bf16(float lo, float hi) { unsigned r; asm volatile("v_cvt_pk_bf16_f32 %0, %1, %2" : "=v"(r) : "v"(lo), "v"(hi)); return r; }
typedef float f32x2 __attribute__((ext_vector_type(2)));
template <class Epi, class Sched, bool ALIGN_EPI = false, bool SP2 = false, bool FP8 = false, bool GATHER = false>
__device__ __forceinline__ void gemm_phase(PG8_LAS unsigned char* lds, const Gemm g, const Sched& S, const Epi& E) {
    typedef int v4i_t __attribute__((ext_vector_type(4)));
    const int tid = threadIdx.x, wid = __builtin_amdgcn_readfirstlane(tid >> 6), lane = tid & 63, wr = wid >> 2, wc = wid & 3, fr = lane & 15, fq = lane >> 4;
    const int K = g.K, nt = K / BK;
    unsigned voffA[2], voffB[2];
#pragma unroll
    for (int i = 0; i < 2; ++i) { int R, C; stage_rc(tid * 16 + i * 8192, R, C); const int Rb = Epi::PERM ? ((R & ~31) + perm32(R & 31)) : R;
        voffA[i] = (unsigned)(R * K + C) * 2u; voffB[i] = (unsigned)(Rb * K + C) * 2u; }
    int rowA[2]; unsigned colA[2];
#pragma unroll
    for (int i = 0; i < 2; ++i) { int R, C; stage_rc(tid * 16 + i * 8192, R, C); rowA[i] = R; colA[i] = (unsigned)C * 2u; }
    const size_t kstep = (size_t)(BK * 2);
    const size_t hstep = (size_t)HALF * K * 2;
    const size_t tstep = 2 * hstep;
    const unsigned ldsw = (unsigned)wid * 1024u;
    const int aoff = lds_byte(wr * 64 + fr, fq * 8), boff = lds_byte(wc * 32 + fr, fq * 8);
#define PG8_SA(b, h) (((b) * 2 + (h)) * HTB)
#define PG8_SB(b, h) ((4 + (b) * 2 + (h)) * HTB)
#define PG8_STAGE(bufoff, gbase, voff) do { _Pragma("unroll") for (int _i = 0; _i < 2; ++_i) \
        __builtin_amdgcn_global_load_lds((const unsigned*)((const char*)(gbase) + (voff)[_i]), (PG8_LAS unsigned*)(lds + (bufoff) + ldsw + _i * 8192), 16, 0, 0); } while (0)
#define PG8_STAGE2(bufoff, gbase, o0, o1) do { \
        __builtin_amdgcn_global_load_lds((const unsigned*)((const char*)(gbase) + (o0)), (PG8_LAS unsigned*)(lds + (bufoff) + ldsw), 16, 0, 0); \
        __builtin_amdgcn_global_load_lds((const unsigned*)((const char*)(gbase) + (o1)), (PG8_LAS unsigned*)(lds + (bufoff) + ldsw + 8192), 16, 0, 0); } while (0)
#define PG8_LDA(dst, b, h) do { _Pragma("unroll") for (int m = 0; m < 4; ++m) _Pragma("unroll") for (int k = 0; k < 2; ++k) dst[m][k] = *(const PG8_LAS bf16x8*)(lds + PG8_SA(b, h) + aoff + m * 2048 + k * 1024); } while (0)
#define PG8_LDB(dst, b, h) do { _Pragma("unroll") for (int n = 0; n < 2; ++n) _Pragma("unroll") for (int k = 0; k < 2; ++k) dst[n][k] = *(const PG8_LAS bf16x8*)(lds + PG8_SB(b, h) + boff + n * 2048 + k * 1024); } while (0)
#define PG8_MMA(ai, bj, At, Bt) do { __builtin_amdgcn_s_setprio(1); _Pragma("unroll") for (int m = 0; m < 4; ++m) _Pragma("unroll") for (int n = 0; n < 2; ++n) { \
        if constexpr (FP8) { asm volatile("v_mfma_f32_16x16x128_f8f6f4 %0, %1, %2, %0" : "+v"(acc[ai][bj][m][n]) : "v"(__builtin_shufflevector((v4i_t)Bt[n][0], (v4i_t)Bt[n][1], 0, 1, 2, 3, 4, 5, 6, 7)), "v"(__builtin_shufflevector((v4i_t)At[m][0], (v4i_t)At[m][1], 0, 1, 2, 3, 4, 5, 6, 7))); } \
        else { _Pragma("unroll") for (int k = 0; k < 2; ++k) acc[ai][bj][m][n] = __builtin_amdgcn_mfma_f32_16x16x32_bf16(Bt[n][k], At[m][k], acc[ai][bj][m][n], 0, 0, 0); } } __builtin_amdgcn_s_setprio(0); } while (0)
#define PG8_WAIT_V(n) asm volatile("s_waitcnt vmcnt(" #n ")" ::: "memory")
#define PG8_WAIT_L(n) asm volatile("s_waitcnt lgkmcnt(" #n ")" ::: "memory")
#define PG8_BAR __builtin_amdgcn_s_barrier()
#define PG8_SCHED __builtin_amdgcn_sched_barrier(0)
    Unit cur, nxt; int ui = 0;
    if (!S.next(0, cur)) return;
    f32x4 acc[2][2][4][2];
#pragma unroll
    for (int a = 0; a < 2; ++a)
#pragma unroll
        for (int b = 0; b < 2; ++b)
#pragma unroll
            for (int m = 0; m < 4; ++m)
#pragma unroll
                for (int n = 0; n < 2; ++n) acc[a][b][m][n] = (f32x4){0.f, 0.f, 0.f, 0.f};
    bf16x8 At[4][2], B0[2][2], B1[2][2];
    const char* cA = (const char*)g.A + (size_t)cur.pm * tstep; const char* cB = (const char*)g.Bt + (size_t)cur.pn * tstep;
    unsigned oA[2][2], nOA[2][2]; int tk[2][2] = {{0, 0}, {0, 0}};
    if constexpr (GATHER) {
        cA = (const char*)g.A;
        const int* lst = S.a_list(cur); const int nv = S.a_valid(cur);
#pragma unroll
        for (int h = 0; h < 2; ++h)
#pragma unroll
            for (int i = 0; i < 2; ++i) { const int r = min(h * HALF + rowA[i], nv - 1); oA[h][i] = (unsigned)lst[r] * (unsigned)(K * 2) + colA[i]; }
    } else {
#pragma unroll
        for (int h = 0; h < 2; ++h)
#pragma unroll
            for (int i = 0; i < 2; ++i) oA[h][i] = voffA[i] + (unsigned)(h * hstep);
    }
#pragma unroll
    for (int h = 0; h < 2; ++h)
#pragma unroll
        for (int i = 0; i < 2; ++i) nOA[h][i] = oA[h][i];
#define PG8_OSEL(h, i) (GATHER ? (last ? nOA[h][i] : oA[h][i]) : oA[h][i])
    S.a_ready(cur);
    if constexpr (SP2) {
        PG8_STAGE(PG8_SB(0, 0), cB, voffB); PG8_STAGE(PG8_SB(0, 1), cB + hstep, voffB); PG8_STAGE2(PG8_SA(0, 0), cA, oA[0][0], oA[0][1]); PG8_STAGE2(PG8_SA(0, 1), cA, oA[1][0], oA[1][1]);
        if (wr == 1) PG8_BAR;
        PG8_WAIT_V(2); PG8_BAR;
        PG8_STAGE(PG8_SB(1, 0), cB + kstep, voffB); PG8_STAGE2(PG8_SA(1, 0), cA + kstep, oA[0][0], oA[0][1]); PG8_STAGE(PG8_SB(1, 1), cB + hstep + kstep, voffB);
        PG8_WAIT_V(6); PG8_BAR;
    } else {
        PG8_STAGE(PG8_SB(0, 0), cB, voffB); PG8_STAGE(PG8_SA(0, 0), cA, voffA); PG8_STAGE(PG8_SB(0, 1), cB + hstep, voffB); PG8_STAGE(PG8_SA(0, 1), cA + hstep, voffA);
        if (wr == 1) PG8_BAR;
        PG8_WAIT_V(4); PG8_BAR;
        PG8_STAGE(PG8_SB(1, 0), cB + kstep, voffB); PG8_STAGE(PG8_SA(1, 0), cA + kstep, voffA); PG8_STAGE(PG8_SB(1, 1), cB + hstep + kstep, voffB);
        PG8_WAIT_V(6); PG8_BAR;
    }
    for (;;) {
        const bool has_next = S.next(ui + 1, nxt);
        const char* nA = GATHER ? cA : (has_next ? (const char*)g.A + (size_t)nxt.pm * tstep : cA); const char* nB = has_next ? (const char*)g.Bt + (size_t)nxt.pn * tstep : cB;
        if constexpr (GATHER) { if (has_next) { const int* lst = S.a_list(nxt); const int nv = S.a_valid(nxt);
#pragma unroll
            for (int h = 0; h < 2; ++h)
#pragma unroll
                for (int i = 0; i < 2; ++i) { const int* pp = lst + min(h * HALF + rowA[i], nv - 1); asm volatile("global_load_dword %0, %1, off" : "=v"(tk[h][i]) : "v"(pp) : "memory"); } } }
        for (int t = 0; t < nt; t += 2) {
            const bool last = (t == nt - 2);
            const char* a1 = cA + (size_t)(t + 1) * kstep;
            const char* a2 = last ? nA : cA + (size_t)(t + 2) * kstep; const char* b2 = last ? nB : cB + (size_t)(t + 2) * kstep;
            const char* a3 = a2 + kstep; const char* b3 = b2 + kstep;
            if (last && has_next) S.a_ready(nxt);
            if constexpr (GATHER) { if (last && has_next) { asm volatile("" : "+v"(tk[0][0]), "+v"(tk[0][1]), "+v"(tk[1][0]), "+v"(tk[1][1]));
#pragma unroll
                for (int h = 0; h < 2; ++h)
#pragma unroll
                    for (int i = 0; i < 2; ++i) nOA[h][i] = (unsigned)tk[h][i] * (unsigned)(K * 2) + colA[i]; } }
            if constexpr (SP2) {
            PG8_LDB(B0, 0, 0); PG8_LDB(B1, 0, 1); PG8_SCHED; PG8_LDA(At, 0, 0); PG8_STAGE2(PG8_SA(1, 1), a1, oA[1][0], oA[1][1]);
            PG8_WAIT_V(8); PG8_WAIT_L(0); PG8_BAR; PG8_MMA(0, 0, At, B0); PG8_MMA(0, 1, At, B1); PG8_BAR; PG8_SCHED;
            PG8_LDA(At, 0, 1); PG8_STAGE(PG8_SB(0, 0), b2, voffB); PG8_STAGE(PG8_SB(0, 1), b2 + hstep, voffB); PG8_STAGE2(PG8_SA(0, 0), a2, PG8_OSEL(0, 0), PG8_OSEL(0, 1));
            PG8_WAIT_V(8); PG8_WAIT_L(0); PG8_BAR; PG8_MMA(1, 0, At, B0); PG8_MMA(1, 1, At, B1); PG8_BAR; PG8_SCHED;
            PG8_LDB(B0, 1, 0); PG8_LDB(B1, 1, 1); PG8_SCHED; PG8_LDA(At, 1, 0); PG8_STAGE2(PG8_SA(0, 1), a2, PG8_OSEL(1, 0), PG8_OSEL(1, 1));
            PG8_WAIT_V(8); PG8_WAIT_L(0); PG8_BAR; PG8_MMA(0, 0, At, B0); PG8_MMA(0, 1, At, B1); PG8_BAR; PG8_SCHED;
            PG8_LDA(At, 1, 1); PG8_STAGE(PG8_SB(1, 0), b3, voffB); PG8_STAGE(PG8_SB(1, 1), b3 + hstep, voffB); PG8_STAGE2(PG8_SA(1, 0), a3, PG8_OSEL(0, 0), PG8_OSEL(0, 1));
            PG8_WAIT_V(8); PG8_WAIT_L(0); PG8_BAR; PG8_MMA(1, 0, At, B0); PG8_MMA(1, 1, At, B1); PG8_BAR; PG8_SCHED;
            } else {
            PG8_LDB(B0, 0, 0); PG8_SCHED; PG8_LDA(At, 0, 0); PG8_STAGE(PG8_SA(1, 1), a1 + hstep, voffA);
            PG8_WAIT_L(8); PG8_BAR; PG8_WAIT_L(0); PG8_MMA(0, 0, At, B0); PG8_BAR; PG8_SCHED;
            PG8_LDB(B1, 0, 1); PG8_STAGE(PG8_SB(0, 0), b2, voffB);
            PG8_BAR; PG8_WAIT_L(0); PG8_MMA(0, 1, At, B1); PG8_BAR;
            PG8_LDA(At, 0, 1); PG8_STAGE(PG8_SA(0, 0), a2, voffA);
            PG8_BAR; PG8_WAIT_L(0); PG8_MMA(1, 0, At, B0); PG8_BAR; PG8_SCHED;
            PG8_STAGE(PG8_SB(0, 1), b2 + hstep, voffB);
            PG8_WAIT_V(6); PG8_BAR; PG8_MMA(1, 1, At, B1); PG8_BAR;
            PG8_LDB(B0, 1, 0); PG8_SCHED; PG8_LDA(At, 1, 0); PG8_STAGE(PG8_SA(0, 1), a2 + hstep, voffA);
            PG8_WAIT_L(8); PG8_BAR; PG8_WAIT_L(0); PG8_MMA(0, 0, At, B0); PG8_BAR; PG8_SCHED;
            PG8_LDB(B1, 1, 1); PG8_STAGE(PG8_SB(1, 0), b3, voffB);
            PG8_BAR; PG8_WAIT_L(0); PG8_MMA(0, 1, At, B1); PG8_BAR;
            PG8_LDA(At, 1, 1); PG8_STAGE(PG8_SA(1, 0), a3, voffA);
            PG8_BAR; PG8_WAIT_L(0); PG8_MMA(1, 0, At, B0); PG8_BAR; PG8_SCHED;
            PG8_STAGE(PG8_SB(1, 1), b3 + hstep, voffB);
            PG8_WAIT_V(6); PG8_BAR; PG8_MMA(1, 1, At, B1); PG8_BAR;
            }
        }
        if constexpr (FP8) asm volatile("s_nop 15\n\ts_nop 15" ::: "memory");
        if constexpr (ALIGN_EPI) { if (wr == 0) PG8_BAR; }
        if constexpr (!Epi::AFTER_DRAIN) { E(acc, cur, wr, wc, fr, fq); S.done(cur); }
        if (!has_next) break;
#pragma unroll
        for (int a = 0; a < 2; ++a)
#pragma unroll
            for (int b = 0; b < 2; ++b)
#pragma unroll
                for (int m = 0; m < 4; ++m)
#pragma unroll
                    for (int n = 0; n < 2; ++n) acc[a][b][m][n] = (f32x4){0.f, 0.f, 0.f, 0.f};
        cur = nxt; cA = nA; cB = nB; ++ui;
        if constexpr (GATHER) {
#pragma unroll
            for (int h = 0; h < 2; ++h)
#pragma unroll
                for (int i = 0; i < 2; ++i) oA[h][i] = nOA[h][i];
        }
        if constexpr (ALIGN_EPI) { if (wr == 1) PG8_BAR; }
    }
    PG8_WAIT_V(0);
    if constexpr (!ALIGN_EPI) { if (wr == 0) PG8_BAR; }
    PG8_BAR;
    if constexpr (Epi::AFTER_DRAIN) { E.fused(acc, cur, wr, wc, fr, fq, lds, wid, lane); S.done(cur); }
#undef PG8_SA
#undef PG8_OSEL
#undef PG8_STAGE2
#undef PG8_SB
#undef PG8_STAGE
#undef PG8_LDA
#undef PG8_LDB
#undef PG8_MMA
#undef PG8_WAIT_V
#undef PG8_WAIT_L
#undef PG8_BAR
#undef PG8_SCHED
}
}

#ifndef MK_N_LAUNCHES
#define MK_N_LAUNCHES 1
#endif
constexpr int N_PHASES = 10;
constexpr int NBATCH = 8, TT = 2048, MTOK = NBATCH * TT, D = 1024;
constexpr int HK = 512, NH = 4, DK = 128, DV = 128, CCH = 512, CLEN = 31, INC = 3584;
constexpr int NE = 32, TOPK = 4, FF = 1024;
constexpr float EPS = 1e-5f, SW_LIMIT = 7.0f, SW_ALPHA = 1.702f;
constexpr int NWAVES = 8, NTHR = 512;
constexpr int MOE_ROWS = (MTOK * TOPK / 256 + NE) * 256;

constexpr size_t MiB = 1u << 20;
constexpr size_t WS_CTL = 0, CTL_ZERO_BYTES = 1 * MiB;
constexpr size_t WS_WI = 1 * MiB;
constexpr size_t WS_WO = 8 * MiB;
constexpr size_t WS_TAB = 10 * MiB;
constexpr size_t WS_W1 = 16 * MiB;
constexpr size_t WS_W2 = 144 * MiB;
constexpr size_t WS_H = 208 * MiB;
constexpr size_t WS_XN = 272 * MiB;
constexpr size_t WS_Q = 304 * MiB, WS_KF = 320 * MiB, WS_KB = 336 * MiB, WS_V = 352 * MiB, WS_G = 368 * MiB, WS_U = 384 * MiB;
constexpr size_t WS_LF = 400 * MiB, WS_LB = 432 * MiB;
constexpr size_t WS_OF = 464 * MiB, WS_OB = 496 * MiB;
constexpr size_t WS_MIX = 528 * MiB;
constexpr size_t WS_XS = 304 * MiB;
constexpr size_t WS_ACT = 448 * MiB;
constexpr size_t WS_YS = 592 * MiB;
constexpr size_t WS_END = 736 * MiB;
constexpr size_t WS_WRT = WS_TAB;
constexpr size_t WS_SLOT = WS_TAB + 256 * 1024;
constexpr size_t WS_GATE = WS_TAB + 512 * 1024;
constexpr size_t WS_ROWTOK = WS_TAB + 1 * MiB;
constexpr int CW_BAR = 4096;
constexpr int CW_CNT = 16384;

constexpr int RING_OFF = 0, RING_BYTES = 131072;
constexpr int LDSCTL_OFF = RING_BYTES;
constexpr int MISC_OFF = LDSCTL_OFF + 320;
constexpr int TAB_OFF = LDSCTL_OFF + 1024;
constexpr int SB_OFF = LDSCTL_OFF + 2048;
constexpr int LDS_BYTES = 147456;

#define GAS __attribute__((address_space(1)))
#define LAS __attribute__((address_space(3)))
typedef unsigned short bf16;
typedef unsigned v4u __attribute__((ext_vector_type(4)));
typedef unsigned v2u __attribute__((ext_vector_type(2)));
typedef float f32x4 __attribute__((ext_vector_type(4)));
typedef GAS unsigned gu32;
#define RLX_AGENT __ATOMIC_RELAXED, __HIP_MEMORY_SCOPE_AGENT
#define LDS_WAIT() asm volatile("s_waitcnt lgkmcnt(0)" ::: "memory")
#define VM_WAIT() asm volatile("s_waitcnt vmcnt(0)" ::: "memory")

__device__ __forceinline__ float bf2f(unsigned b) { return __uint_as_float(b << 16); }
__device__ __forceinline__ unsigned pk2(float lo, float hi) { return pg8::cvt_pk_bf16(lo, hi); }
__device__ __forceinline__ float sigm(float x) { return __builtin_amdgcn_rcpf(1.0f + __expf(-x)); }
__device__ __forceinline__ float wave_sum(float v) {
#pragma unroll
    for (int o = 1; o < 64; o <<= 1) v += __shfl_xor(v, o);
    return v;
}

constexpr float SC_W = 512.f, SC_N2 = 16.f, SC_ACT = 8.f;
__device__ __forceinline__ unsigned pk4_fp8(float a, float b, float c, float d) {
    a = fminf(fmaxf(a, -448.f), 448.f); b = fminf(fmaxf(b, -448.f), 448.f); c = fminf(fmaxf(c, -448.f), 448.f); d = fminf(fmaxf(d, -448.f), 448.f);
    int w = 0; w = __builtin_amdgcn_cvt_pk_fp8_f32(a, b, w, false); w = __builtin_amdgcn_cvt_pk_fp8_f32(c, d, w, true); return (unsigned)w;
}

#define XB_TMO      128
#define XB_XCNT(j)  (256  + 64 * (j))
#define XB_XSUB(j)  (1280 + 64 * (j))
#define XB_XGEN(j)  (2304 + 64 * (j))
#define XB_TOP      3328
#define XB_TOPGEN   3392
#define XCD_BAR_WORDS 3456
#define XB_SPIN_CAP (1u << 18)

__device__ __forceinline__ unsigned xb_ld(unsigned* p)              { return __hip_atomic_load(p, __ATOMIC_RELAXED, __HIP_MEMORY_SCOPE_AGENT); }
__device__ __forceinline__ unsigned xb_add(unsigned* p, unsigned v) { return __hip_atomic_fetch_add(p, v, __ATOMIC_RELAXED, __HIP_MEMORY_SCOPE_AGENT); }
__device__ __forceinline__ unsigned xb_xcc_id() { return (unsigned)__builtin_amdgcn_s_getreg((3 << 11) | 20) & 0xFu; }
#define XB_SPIN(cond, bar) do { unsigned _sp = 0; while (cond) { __builtin_amdgcn_s_sleep(1); \
    if ((++_sp & 255u) == 0u) { if (xb_ld(&(bar)[XB_TMO])) break; if (_sp > XB_SPIN_CAP) { atomicAdd(&(bar)[XB_TMO], 1u); break; } } } } while (0)

struct XcdBarrier {
    unsigned* bar; unsigned x;
    volatile LAS unsigned* st;
};
__device__ __forceinline__ XcdBarrier xcd_barrier_post(unsigned* bar, volatile LAS unsigned* st) {
    XcdBarrier b; b.bar = bar; b.x = xb_xcc_id(); b.st = st;
    if (threadIdx.x == 0) (void)xb_add(&bar[XB_XCNT(b.x)], 1u);
    return b;
}
__device__ __forceinline__ void xcd_barrier_complete(unsigned* bar, unsigned x, unsigned& nloc, unsigned& nx) {
    const unsigned G = gridDim.x * gridDim.y * gridDim.z;
    unsigned sum, cnt, mine, sp = 0u;
    for (;;) {
        sum = 0u; cnt = 0u; mine = 0u;
#pragma unroll
        for (unsigned j = 0; j < 16; ++j) { const unsigned c = xb_ld(&bar[XB_XCNT(j)]); sum += c; cnt += (c > 0u) ? 1u : 0u; mine = (j == x) ? c : mine; }
        if (sum == G) break;
        __builtin_amdgcn_s_sleep(1);
        if ((++sp & 255u) == 0u) { if (xb_ld(&bar[XB_TMO])) break; if (sp > XB_SPIN_CAP) { atomicAdd(&bar[XB_TMO], 1u); break; } }
    }
    nloc = mine > 0u ? mine : 1u; nx = cnt > 0u ? cnt : 1u;
}
__device__ __forceinline__ void xcd_barrier(const XcdBarrier& b) {
    asm volatile("s_waitcnt vmcnt(0)" ::: "memory");
    __syncthreads();
    if (threadIdx.x == 0) {
        unsigned* bar = b.bar;
        __builtin_amdgcn_s_waitcnt(0);
        unsigned nloc = b.st[0], nx = b.st[1];
        if (nloc == 0u) { xcd_barrier_complete(bar, b.x, nloc, nx); b.st[0] = nloc; b.st[1] = nx; }
        const unsigned old = xb_add(&bar[XB_XSUB(b.x)], 1u);
        const unsigned gen = old / nloc;
        if (old + 1u == (gen + 1u) * nloc) {
            __builtin_amdgcn_fence(__ATOMIC_RELEASE, "agent");
            asm volatile("s_waitcnt vmcnt(0)" ::: "memory");
            const unsigned og = xb_add(&bar[XB_TOP], 1u);
            const unsigned tg = og / nx;
            if (og + 1u == (tg + 1u) * nx) xb_add(&bar[XB_TOPGEN], 1u);
            else XB_SPIN(xb_ld(&bar[XB_TOPGEN]) == tg, bar);
            __builtin_amdgcn_fence(__ATOMIC_ACQUIRE, "agent");
            xb_add(&bar[XB_XGEN(b.x)], 1u);
            asm volatile("s_waitcnt vmcnt(0)" ::: "memory");
        } else {
            XB_SPIN(xb_ld(&bar[XB_XGEN(b.x)]) == gen, bar);
            __builtin_amdgcn_fence(__ATOMIC_ACQUIRE, "agent");
            asm volatile("s_waitcnt vmcnt(0)" ::: "memory");
        }
    }
    __syncthreads();
}

__device__ __forceinline__ void st8bf(bf16* p, const f32x4& a, const f32x4& b) {
    v4u w; w.x = pk2(a[0], a[1]); w.y = pk2(a[2], a[3]); w.z = pk2(b[0], b[1]); w.w = pk2(b[2], b[3]);
    *(v4u*)p = w;
}
struct EpiProj {
    static constexpr bool PERM = true, AFTER_DRAIN = false;
    bf16 *Q, *KF, *KB, *V, *G, *U; float *LF, *LB; const float* lbl;
    template <int TYP>
    __device__ __forceinline__ void tile(const pg8::f32x4 (&acc)[2][2][4][2], int row0, int cb) const {
#pragma unroll
        for (int bj = 0; bj < 2; ++bj) {
            const int col = cb + bj * 128;
            float lb[8];
            if (TYP == 1 || TYP == 2) {
                const float* L = lbl + (TYP - 1) * 1024 + col;
#pragma unroll
                for (int i = 0; i < 8; ++i) lb[i] = __builtin_amdgcn_rcpf(1.0f + __expf(L[512 + i] - L[i]));
            }
#pragma unroll
            for (int ai = 0; ai < 2; ++ai)
#pragma unroll
                for (int m = 0; m < 4; ++m) {
                    const size_t off = (size_t)(row0 + ai * 128 + m * 16) * 512 + col;
                    f32x4 a = acc[ai][bj][m][0], b = acc[ai][bj][m][1];
                    if (TYP == 0 || TYP == 4) {
#pragma unroll
                        for (int i = 0; i < 4; ++i) { a[i] = a[i] * sigm(a[i]); b[i] = b[i] * sigm(b[i]); }
                        st8bf((TYP == 0 ? Q : G) + off, a, b);
                    } else if (TYP == 3) {
                        st8bf(V + off, a, b);
                    } else {
                        f32x4 la, lbv, ka, kb;
#pragma unroll
                        for (int i = 0; i < 4; ++i) {
                            const float fa = lb[i] + (1.0f - lb[i]) * sigm(a[i]), fb = lb[4 + i] + (1.0f - lb[4 + i]) * sigm(b[i]);
                            la[i] = __logf(fa); lbv[i] = __logf(fb); ka[i] = 1.0f - fa; kb[i] = 1.0f - fb;
                        }
                        float* Lp = (TYP == 1 ? LF : LB) + off;
                        *(f32x4*)Lp = la; *(f32x4*)(Lp + 4) = lbv;
                        st8bf((TYP == 1 ? KF : KB) + off, ka, kb);
                    }
                }
        }
    }
    __device__ __forceinline__ void operator()(const pg8::f32x4 (&acc)[2][2][4][2], const pg8::Unit& u, int wr, int wc, int fr, int fq) const {
        const int row0 = u.pm * 256 + wr * 64 + fr, pn = u.pn;
        if (pn >= 10) {
            const int col = (pn - 10) * 128 + wc * 32 + 8 * fq;
#pragma unroll
            for (int ai = 0; ai < 2; ++ai)
#pragma unroll
                for (int m = 0; m < 4; ++m) {
                    f32x4 a = acc[ai][0][m][0], b = acc[ai][0][m][1]; const f32x4 ga = acc[ai][1][m][0], gb = acc[ai][1][m][1];
#pragma unroll
                    for (int i = 0; i < 4; ++i) { a[i] = a[i] * sigm(ga[i]); b[i] = b[i] * sigm(gb[i]); }
                    st8bf(U + (size_t)(row0 + ai * 128 + m * 16) * 512 + col, a, b);
                }
        } else {
            const int cb = (pn & 1) * 256 + wc * 32 + 8 * fq, typ = pn >> 1;
            if (typ == 0) tile<0>(acc, row0, cb);
            else if (typ == 1) tile<1>(acc, row0, cb);
            else if (typ == 2) tile<2>(acc, row0, cb);
            else if (typ == 3) tile<3>(acc, row0, cb);
            else tile<4>(acc, row0, cb);
        }
    }
};
struct EpiRes {
    static constexpr bool PERM = false, AFTER_DRAIN = false;
    const float* X; float* H;
    __device__ __forceinline__ void operator()(const pg8::f32x4 (&acc)[2][2][4][2], const pg8::Unit& u, int wr, int wc, int fr, int fq) const {
        const int row0 = u.pm * 256 + wr * 64 + fr, col0 = u.pn * 256 + wc * 32 + 4 * fq;
#pragma unroll
        for (int ai = 0; ai < 2; ++ai)
#pragma unroll
            for (int m = 0; m < 4; ++m) {
                const size_t off = (size_t)(row0 + ai * 128 + m * 16) * D + col0;
#pragma unroll
                for (int bj = 0; bj < 2; ++bj)
#pragma unroll
                    for (int n = 0; n < 2; ++n) { const f32x4 xv = *(const f32x4*)(X + off + bj * 128 + n * 16); *(f32x4*)(H + off + bj * 128 + n * 16) = xv + acc[ai][bj][m][n]; }
            }
    }
};
struct EpiSwiglu {
    static constexpr bool PERM = true, AFTER_DRAIN = false;
    unsigned char* ACT; const float* b1;
    __device__ __forceinline__ void operator()(const pg8::f32x4 (&acc)[2][2][4][2], const pg8::Unit& u, int wr, int wc, int fr, int fq) const {
        const int e = u.pn >> 3, pn = u.pn & 7, row0 = u.pm * 256 + wr * 64 + fr, col = pn * 128 + wc * 32 + 8 * fq;
        const float* bg = b1 + (size_t)e * 2048 + col; const float* bl = bg + 1024;
        float g[8], l[8];
#pragma unroll
        for (int i = 0; i < 8; ++i) { g[i] = bg[i]; l[i] = bl[i]; }
#pragma unroll
        for (int ai = 0; ai < 2; ++ai)
#pragma unroll
            for (int m = 0; m < 4; ++m) {
                f32x4 o[2];
#pragma unroll
                for (int n = 0; n < 2; ++n)
#pragma unroll
                    for (int i = 0; i < 4; ++i) {
                        const float hg = fminf(acc[ai][0][m][n][i] * (1.0f / (SC_N2 * SC_W)) + g[4 * n + i], SW_LIMIT);
                        const float hl = fminf(fmaxf(acc[ai][1][m][n][i] * (1.0f / (SC_N2 * SC_W)) + l[4 * n + i], -SW_LIMIT), SW_LIMIT);
                        o[n][i] = hg * sigm(SW_ALPHA * hg) * (hl + 1.0f) * SC_ACT;
                    }
                v2u w; w.x = pk4_fp8(o[0][0], o[0][1], o[0][2], o[0][3]); w.y = pk4_fp8(o[1][0], o[1][1], o[1][2], o[1][3]);
                *(v2u*)(ACT + (size_t)(row0 + ai * 128 + m * 16) * FF + col) = w;
            }
    }
};
struct EpiDown {
    static constexpr bool PERM = true, AFTER_DRAIN = false;
    bf16* YS; const float* b2;
    __device__ __forceinline__ void operator()(const pg8::f32x4 (&acc)[2][2][4][2], const pg8::Unit& u, int wr, int wc, int fr, int fq) const {
        const int e = u.pn >> 2, pn = u.pn & 3, row0 = u.pm * 256 + wr * 64 + fr, col0 = pn * 256 + wc * 32 + 8 * fq;
#pragma unroll
        for (int bj = 0; bj < 2; ++bj) {
            const float* bp = b2 + (size_t)e * D + col0 + bj * 128;
            const f32x4 b0 = *(const f32x4*)bp, b1v = *(const f32x4*)(bp + 4);
#pragma unroll
            for (int ai = 0; ai < 2; ++ai)
#pragma unroll
                for (int m = 0; m < 4; ++m)
                    st8bf(YS + (size_t)(row0 + ai * 128 + m * 16) * D + col0 + bj * 128, acc[ai][bj][m][0] * (1.0f / (SC_ACT * SC_W)) + b0, acc[ai][bj][m][1] * (1.0f / (SC_ACT * SC_W)) + b1v);
        }
    }
};
struct MoeOrder {
    const volatile LAS int* bs; int ntn, G, v; const volatile LAS int* cl; const int* rowtok;
    __device__ __forceinline__ const int* a_list(const pg8::Unit& u) const { const int e = u.pn / ntn; return rowtok + e * MTOK + (u.pm - bs[e]) * 256; }
    __device__ __forceinline__ int a_valid(const pg8::Unit& u) const { const int e = u.pn / ntn; return min(256, cl[e] - (u.pm - bs[e]) * 256); }
    __device__ __forceinline__ bool next(int i, pg8::Unit& u) const {
        const int L = i * G + v, nb = bs[32];
        if (L >= nb * ntn) return false;
        const int mb = L / ntn, pn = L - mb * ntn;
        const int ln = (int)(threadIdx.x & 63);
        const int e = __popcll(__ballot(ln < NE - 1 && bs[ln + 1] <= mb));
        u.pm = mb; u.pn = e * ntn + pn; return true;
    }
    __device__ __forceinline__ void a_ready(const pg8::Unit&) const {}
    __device__ __forceinline__ void done(const pg8::Unit&) const {}
};

#ifndef PROBE_DUP
#define PROBE_DUP -1
#endif
struct OrderRep : pg8::StaticOrder {
    int reps;
    __device__ __forceinline__ bool next(int i, pg8::Unit& u) const {
        const int per = (nwg + G - 1) / G, r = i / per;
        if (r >= reps) return false;
        return pg8::StaticOrder::next(i - r * per, u) ? true : ((r + 1 < reps) ? pg8::StaticOrder::next(0, u) : false);
    }
};
struct RmIdent { __device__ __forceinline__ int operator()(int n) const { return n; } };
struct RmWin {
    __device__ __forceinline__ int operator()(int n) const {
        if (n < 2560) return n;
        if (n < 3072) { const int j = n - 2560; return 2560 + (j >> 7) * 256 + (j & 127); }
        const int j = n - 3072; return 2560 + (j >> 7) * 256 + 128 + (j & 127);
    }
};
struct RmW1 {
    __device__ __forceinline__ int operator()(int n) const {
        if (n < 1024) return (n >> 7) * 256 + (n & 127);
        const int j = n - 1024; return (j >> 7) * 256 + 128 + (j & 127);
    }
};
template <bool FP8OUT, class RM>
__device__ __forceinline__ void p0_item(const float* W, int K, int N, void* WTv, RM rm, LAS float* scr, int item, int lane) {
    const int nblk = N / 32, kb = item / nblk, nb = item % nblk, k0 = 64 * kb, n0 = 32 * nb;
    const int r8 = lane >> 3, c4 = lane & 7;
    f32x4 v[8];
#pragma unroll
    for (int i = 0; i < 8; ++i) v[i] = *(const f32x4*)(W + (size_t)(k0 + 8 * i + r8) * N + n0 + 4 * c4);
#pragma unroll
    for (int i = 0; i < 8; ++i) *(LAS f32x4*)(scr + (8 * i + r8) * 36 + 4 * c4) = v[i];
    LDS_WAIT(); asm volatile("" ::: "memory");
    const int n = lane & 31, kh = lane >> 5; const LAS float* s = scr + (32 * kh) * 36 + n;
    if constexpr (FP8OUT) {
        unsigned w[8];
#pragma unroll
        for (int j = 0; j < 8; ++j) w[j] = pk4_fp8(s[(4 * j) * 36] * SC_W, s[(4 * j + 1) * 36] * SC_W, s[(4 * j + 2) * 36] * SC_W, s[(4 * j + 3) * 36] * SC_W);
        GAS v4u* dst = (GAS v4u*)((unsigned char*)WTv + (size_t)rm(n0 + n) * K + k0 + 32 * kh);
        dst[0] = (v4u){w[0], w[1], w[2], w[3]}; dst[1] = (v4u){w[4], w[5], w[6], w[7]};
    } else {
        unsigned w[16];
#pragma unroll
        for (int j = 0; j < 16; ++j) w[j] = pk2(s[(2 * j) * 36], s[(2 * j + 1) * 36]);
        GAS v4u* dst = (GAS v4u*)((bf16*)WTv + (size_t)rm(n0 + n) * K + k0 + 32 * kh);
#pragma unroll
        for (int q = 0; q < 4; ++q) dst[q] = (v4u){w[4 * q], w[4 * q + 1], w[4 * q + 2], w[4 * q + 3]};
    }
    LDS_WAIT(); asm volatile("" ::: "memory");
}
__device__ __forceinline__ void rms_row_to_bf16(const float* xrow, const float* w, bf16* orow, int lane) {
    const f32x4* xr = (const f32x4*)xrow + lane; const f32x4* wr = (const f32x4*)w + lane;
    f32x4 v[4]; float s = 0.f;
#pragma unroll
    for (int j = 0; j < 4; ++j) { v[j] = xr[64 * j]; s += (v[j].x * v[j].x + v[j].y * v[j].y) + (v[j].z * v[j].z + v[j].w * v[j].w); }
    const float rstd = rsqrtf(wave_sum(s) * (1.f / D) + EPS);
    v2u* o8 = (v2u*)orow + lane;
#pragma unroll
    for (int j = 0; j < 4; ++j) { const f32x4 g = wr[64 * j]; v2u o; o.x = pk2(v[j].x * rstd * g.x, v[j].y * rstd * g.y); o.y = pk2(v[j].z * rstd * g.z, v[j].w * rstd * g.w); o8[64 * j] = o; }
}


__device__ __forceinline__ pg8::bf16x8 lds_frag(const LAS unsigned char* p) { return *(const LAS pg8::bf16x8*)p; }
__device__ __forceinline__ pg8::bf16x8 mk_frag(v2u a, v2u b) { const v4u w = (v4u){a.x, a.y, b.x, b.y}; return (pg8::bf16x8)w; }
struct HgCtx {
    LAS unsigned char* lds; const bf16 *Qb, *Kp, *Vb; const float* Lp; float* Op;
    int b, h, dir, vh, lane, wave, lr, lq, dA, seg, tauB, dg;
    unsigned offA[16], offB, offV, ke_tr, v_tr;
};
constexpr int HG_BF = 0, HG_AM = 0, HG_QI = 33792, HG_KK = 51200, HG_KE = 68608, HG_V = 86016, HG_ST = 95232, HG_SEG = 112640, HG_DEC = 114688;
constexpr int HG_RSD = 272, HG_RSS = 144, HG_RSBF = 528;
__device__ __forceinline__ void hgrn_load(const HgCtx& c, int n, float (&lf)[16], v4u (&qB)[2], v4u (&kB)[2], v4u& vB) {
    const size_t cb = (size_t)__builtin_amdgcn_readfirstlane(c.b * TT + (c.dir ? (TT / 64 - 1 - n) * 64 : n * 64)) * 512 + c.h * 128;
    const float* Lc = c.Lp + cb; const bf16* Qc = c.Qb + cb; const bf16* Kc = c.Kp + cb; const bf16* Vc = c.Vb + cb;
#pragma unroll
    for (int i = 0; i < 16; ++i) lf[i] = Lc[c.offA[i]];
    qB[0] = *(const v4u*)(Qc + c.offB); qB[1] = *(const v4u*)(Qc + c.offB + 8); kB[0] = *(const v4u*)(Kc + c.offB); kB[1] = *(const v4u*)(Kc + c.offB + 8);
    vB = *(const v4u*)(Vc + c.offV);
}
__device__ __forceinline__ void hgrn_chunk(const HgCtx& c, int n, float (&lf)[16], v4u (&qB)[2], v4u (&kB)[2], v4u& vB, f32x4 (&S)[4]) {
    LAS unsigned char* lds = c.lds;
    const int dir = c.dir, lr = c.lr, lq = c.lq, wave = c.wave, dA = c.dA, seg = c.seg, tauB = c.tauB, dg = c.dg;
    const int tb = c.b * TT + (dir ? (TT / 64 - 1 - n) * 64 : n * 64);
    float bl[16]; { float cs = 0.f;
#pragma unroll
        for (int i = 0; i < 16; ++i) { cs += lf[i]; bl[i] = cs; }
        *(LAS float*)(lds + HG_SEG + (seg * 128 + dA) * 4) = cs; }
    __syncthreads();
    {
        const float p0 = *(LAS float*)(lds + HG_SEG + (0 * 128 + dA) * 4), p1 = *(LAS float*)(lds + HG_SEG + (1 * 128 + dA) * 4),
                    p2 = *(LAS float*)(lds + HG_SEG + (2 * 128 + dA) * 4), p3 = *(LAS float*)(lds + HG_SEG + (3 * 128 + dA) * 4);
        const float pre = (seg > 0 ? p0 : 0.f) + (seg > 1 ? p1 : 0.f) + (seg > 2 ? p2 : 0.f);
#pragma unroll
        for (int i = 0; i < 16; ++i) *(LAS float*)(lds + HG_BF + (16 * seg + i) * HG_RSBF + dA * 4) = pre + bl[i];
        if (seg == 0) *(LAS float*)(lds + HG_DEC + dA * 4) = __expf((p0 + p1) + (p2 + p3));
    }
    __syncthreads();
    {
        const unsigned qw[8] = {qB[0].x, qB[0].y, qB[0].z, qB[0].w, qB[1].x, qB[1].y, qB[1].z, qB[1].w};
        const unsigned kw[8] = {kB[0].x, kB[0].y, kB[0].z, kB[0].w, kB[1].x, kB[1].y, kB[1].z, kB[1].w};
        unsigned qo[8], ko[8], eo[8];
#pragma unroll
        for (int i = 0; i < 4; ++i) {
            const f32x4 bb = *(const LAS f32x4*)(lds + HG_BF + tauB * HG_RSBF + dg * 64 + i * 16);
            const f32x4 dc = *(const LAS f32x4*)(lds + HG_DEC + dg * 64 + i * 16);
#pragma unroll
            for (int j = 0; j < 2; ++j) {
                const float e0 = __expf(bb[2 * j]), e1 = __expf(bb[2 * j + 1]);
                const unsigned qq = qw[2 * i + j], kk = kw[2 * i + j];
                const float k0 = bf2f(kk & 0xffffu) * __builtin_amdgcn_rcpf(e0), k1 = bf2f(kk >> 16) * __builtin_amdgcn_rcpf(e1);
                qo[2 * i + j] = pk2(bf2f(qq & 0xffffu) * e0, bf2f(qq >> 16) * e1);
                ko[2 * i + j] = pk2(k0, k1);
                eo[2 * i + j] = pk2(k0 * dc[2 * j], k1 * dc[2 * j + 1]);
            }
        }
        *(LAS v4u*)(lds + HG_QI + tauB * HG_RSD + dg * 32) = (v4u){qo[0], qo[1], qo[2], qo[3]}; *(LAS v4u*)(lds + HG_QI + tauB * HG_RSD + dg * 32 + 16) = (v4u){qo[4], qo[5], qo[6], qo[7]};
        *(LAS v4u*)(lds + HG_KK + tauB * HG_RSD + dg * 32) = (v4u){ko[0], ko[1], ko[2], ko[3]}; *(LAS v4u*)(lds + HG_KK + tauB * HG_RSD + dg * 32 + 16) = (v4u){ko[4], ko[5], ko[6], ko[7]};
        *(LAS v4u*)(lds + HG_KE + tauB * HG_RSD + dg * 32) = (v4u){eo[0], eo[1], eo[2], eo[3]}; *(LAS v4u*)(lds + HG_KE + tauB * HG_RSD + dg * 32 + 16) = (v4u){eo[4], eo[5], eo[6], eo[7]};
        *(LAS v4u*)(lds + HG_V + tauB * HG_RSS + dg * 16) = vB;
    }
    __syncthreads();
    if (n + 2 < TT / 64) hgrn_load(c, n + 2, lf, qB, kB, vB);
    const int ei = wave & 3, tp = wave >> 2;
    v2u ket[2][2], vt[4][2][2];
    asm volatile("ds_read_b64_tr_b16 %0, %4\n\tds_read_b64_tr_b16 %1, %4 offset:1088\n\tds_read_b64_tr_b16 %2, %4 offset:8704\n\tds_read_b64_tr_b16 %3, %4 offset:9792"
                 : "=&v"(ket[0][0]), "=&v"(ket[0][1]), "=&v"(ket[1][0]), "=&v"(ket[1][1]) : "v"(c.ke_tr) : "memory");
#define HG_VTR(e4, o0, o1, o2, o3) asm volatile("ds_read_b64_tr_b16 %0, %4 offset:" #o0 "\n\tds_read_b64_tr_b16 %1, %4 offset:" #o1 "\n\tds_read_b64_tr_b16 %2, %4 offset:" #o2 "\n\tds_read_b64_tr_b16 %3, %4 offset:" #o3 \
                 : "=&v"(vt[e4][0][0]), "=&v"(vt[e4][0][1]), "=&v"(vt[e4][1][0]), "=&v"(vt[e4][1][1]) : "v"(c.v_tr) : "memory")
    HG_VTR(0, 0, 576, 4608, 5184); HG_VTR(1, 32, 608, 4640, 5216); HG_VTR(2, 64, 640, 4672, 5248); HG_VTR(3, 96, 672, 4704, 5280);
#undef HG_VTR
    {
        const int ti = wave & 3;
#pragma unroll
        for (int sii = 0; sii < 2; ++sii) {
            const int si = tp * 2 + sii;
            v2u w = (v2u){0u, 0u};
            if (si <= ti) {
                f32x4 a = (f32x4){0.f, 0.f, 0.f, 0.f};
#pragma unroll
                for (int kk = 0; kk < 4; ++kk)
                    a = __builtin_amdgcn_mfma_f32_16x16x32_bf16(lds_frag(lds + HG_KK + (16 * si + lr) * HG_RSD + kk * 64 + lq * 16), lds_frag(lds + HG_QI + (16 * ti + lr) * HG_RSD + kk * 64 + lq * 16), a, 0, 0, 0);
                const int s0 = 16 * si + 4 * lq, t = 16 * ti + lr;
                w.x = pk2(s0 + 0 <= t ? a[0] : 0.f, s0 + 1 <= t ? a[1] : 0.f); w.y = pk2(s0 + 2 <= t ? a[2] : 0.f, s0 + 3 <= t ? a[3] : 0.f);
            }
            *(LAS v2u*)(lds + HG_AM + (16 * ti + lr) * HG_RSS + (16 * si + 4 * lq) * 2) = w;
        }
    }
    f32x4 o[2];
#pragma unroll
    for (int tt = 0; tt < 2; ++tt) {
        o[tt] = (f32x4){0.f, 0.f, 0.f, 0.f};
#pragma unroll
        for (int kk = 0; kk < 4; ++kk)
            o[tt] = __builtin_amdgcn_mfma_f32_16x16x32_bf16(lds_frag(lds + HG_ST + (16 * ei + lr) * HG_RSD + kk * 64 + lq * 16), lds_frag(lds + HG_QI + (16 * (2 * tp + tt) + lr) * HG_RSD + kk * 64 + lq * 16), o[tt], 0, 0, 0);
    }
    asm volatile("s_waitcnt lgkmcnt(0)"
                 : "+v"(ket[0][0]), "+v"(ket[0][1]), "+v"(ket[1][0]), "+v"(ket[1][1]),
                   "+v"(vt[0][0][0]), "+v"(vt[0][0][1]), "+v"(vt[0][1][0]), "+v"(vt[0][1][1]), "+v"(vt[1][0][0]), "+v"(vt[1][0][1]), "+v"(vt[1][1][0]), "+v"(vt[1][1][1]),
                   "+v"(vt[2][0][0]), "+v"(vt[2][0][1]), "+v"(vt[2][1][0]), "+v"(vt[2][1][1]), "+v"(vt[3][0][0]), "+v"(vt[3][0][1]), "+v"(vt[3][1][0]), "+v"(vt[3][1][1]) :: "memory");
    {
        const f32x4 dv = *(const LAS f32x4*)(lds + HG_DEC + (16 * wave + 4 * lq) * 4);
#pragma unroll
        for (int e4 = 0; e4 < 4; ++e4) S[e4] = S[e4] * dv;
#pragma unroll
        for (int kk = 0; kk < 2; ++kk) {
            const pg8::bf16x8 af = mk_frag(ket[kk][0], ket[kk][1]);
#pragma unroll
            for (int e4 = 0; e4 < 4; ++e4) S[e4] = __builtin_amdgcn_mfma_f32_16x16x32_bf16(af, mk_frag(vt[e4][kk][0], vt[e4][kk][1]), S[e4], 0, 0, 0);
        }
    }
    const pg8::bf16x8 vf0 = ei == 0 ? mk_frag(vt[0][0][0], vt[0][0][1]) : ei == 1 ? mk_frag(vt[1][0][0], vt[1][0][1]) : ei == 2 ? mk_frag(vt[2][0][0], vt[2][0][1]) : mk_frag(vt[3][0][0], vt[3][0][1]);
    const pg8::bf16x8 vf1 = ei == 0 ? mk_frag(vt[0][1][0], vt[0][1][1]) : ei == 1 ? mk_frag(vt[1][1][0], vt[1][1][1]) : ei == 2 ? mk_frag(vt[2][1][0], vt[2][1][1]) : mk_frag(vt[3][1][0], vt[3][1][1]);
    __syncthreads();
#pragma unroll
    for (int tt = 0; tt < 2; ++tt) {
        o[tt] = __builtin_amdgcn_mfma_f32_16x16x32_bf16(vf0, lds_frag(lds + HG_AM + (16 * (2 * tp + tt) + lr) * HG_RSS + 0 * 64 + lq * 16), o[tt], 0, 0, 0);
        o[tt] = __builtin_amdgcn_mfma_f32_16x16x32_bf16(vf1, lds_frag(lds + HG_AM + (16 * (2 * tp + tt) + lr) * HG_RSS + 1 * 64 + lq * 16), o[tt], 0, 0, 0);
        const int t = 16 * (2 * tp + tt) + lr;
        *(f32x4*)(c.Op + (size_t)(dir ? tb + 63 - t : tb + t) * 512 + c.h * 128 + c.vh * 64 + 16 * ei + 4 * lq) = o[tt];
    }
#pragma unroll
    for (int e4 = 0; e4 < 4; ++e4) { v2u w; w.x = pk2(S[e4][0], S[e4][1]); w.y = pk2(S[e4][2], S[e4][3]); *(LAS v2u*)(lds + HG_ST + (16 * e4 + lr) * HG_RSD + (16 * wave + 4 * lq) * 2) = w; }
}
__device__ __forceinline__ void hgrn_unit(LAS unsigned char* lds, int unit, const bf16* Qb, const bf16* KFb, const bf16* KBb, const bf16* Vb, const float* LFb, const float* LBb,
                                          float* OFb, float* OBb, int tid, int lane, int wave) {
    HgCtx c;
    c.lds = lds; c.vh = unit & 1; c.dir = (unit >> 1) & 1; c.h = (unit >> 2) & 3; c.b = unit >> 4;
    c.Qb = Qb; c.Vb = Vb; c.Kp = c.dir ? KBb : KFb; c.Lp = c.dir ? LBb : LFb; c.Op = c.dir ? OBb : OFb;
    c.lane = lane; c.wave = wave; c.lr = lane & 15; c.lq = lane >> 4;
    c.dA = tid & 127; c.seg = tid >> 7;
    c.tauB = tid >> 3; c.dg = tid & 7;
    for (int i = tid; i < 64 * HG_RSD / 16; i += NTHR) *(LAS v4u*)(lds + HG_ST + i * 16) = (v4u){0u, 0u, 0u, 0u};
    f32x4 S[4];
#pragma unroll
    for (int i = 0; i < 4; ++i) S[i] = (f32x4){0.f, 0.f, 0.f, 0.f};
#pragma unroll
    for (int i = 0; i < 16; ++i) { const int tau = 16 * c.seg + i; c.offA[i] = (unsigned)((c.dir ? 63 - tau : tau) * 512 + c.dA); }
    c.offB = (unsigned)((c.dir ? 63 - c.tauB : c.tauB) * 512 + 16 * c.dg); c.offV = (unsigned)((c.dir ? 63 - c.tauB : c.tauB) * 512 + c.vh * 64 + 8 * c.dg);
    const unsigned trrow = (unsigned)(8 * c.lq + ((lane & 15) >> 2)), trcol = (unsigned)(4 * (lane & 3));
    c.ke_tr = (unsigned)(size_t)(lds + HG_KE) + trrow * HG_RSD + (16 * wave + trcol) * 2;
    c.v_tr = (unsigned)(size_t)(lds + HG_V) + trrow * HG_RSS + trcol * 2;
    float lf0[16], lf1[16]; v4u qB0[2], kB0[2], vB0, qB1[2], kB1[2], vB1;
    hgrn_load(c, 0, lf0, qB0, kB0, vB0); hgrn_load(c, 1, lf1, qB1, kB1, vB1);
#pragma unroll 1
    for (int n = 0; n < TT / 64; n += 2) { hgrn_chunk(c, n, lf0, qB0, kB0, vB0, S); hgrn_chunk(c, n + 1, lf1, qB1, kB1, vB1, S); }
    __syncthreads();
}

__device__ __forceinline__ void router_finish(float (&a)[NE], int m, int lane, const float* router_b, LAS int* lcnt, LAS unsigned* sbw, float* GATE) {
#define RF_STEP(s2, n) { const bool up = (lane & (s2)) != 0; _Pragma("unroll") for (int i = 0; i < (n); ++i) { const float k1 = up ? a[i + (n)] : a[i], x1 = up ? a[i] : a[i + (n)]; a[i] = k1 + __shfl_xor(x1, (s2)); } }
    RF_STEP(32, 16) RF_STEP(16, 8) RF_STEP(8, 4) RF_STEP(4, 2) RF_STEP(2, 1)
#undef RF_STEP
    float lg = a[0] + __shfl_xor(a[0], 1);
    const int myE = lane >> 1;
    lg += router_b[myE];
    float tv[TOPK]; int ti[TOPK];
#pragma unroll
    for (int k = 0; k < TOPK; ++k) {
        float mx = lg;
#pragma unroll
        for (int o = 1; o < 64; o <<= 1) mx = fmaxf(mx, __shfl_xor(mx, o));
        int cand = (lg == mx) ? myE : 99;
#pragma unroll
        for (int o = 1; o < 64; o <<= 1) cand = min(cand, __shfl_xor(cand, o));
        tv[k] = mx; ti[k] = cand;
        if (myE == cand) lg = -INFINITY;
    }
    const float e1 = __expf(tv[1] - tv[0]), e2 = __expf(tv[2] - tv[0]), e3 = __expf(tv[3] - tv[0]);
    const float inv = 1.0f / (1.0f + e1 + e2 + e3);
    if (lane < TOPK && m < MTOK) {
        const int ek = lane == 0 ? ti[0] : lane == 1 ? ti[1] : lane == 2 ? ti[2] : ti[3];
        const float gk = (lane == 0 ? 1.0f : lane == 1 ? e1 : lane == 2 ? e2 : e3) * inv;
        const int lr = __hip_atomic_fetch_add(&lcnt[ek], 1, __ATOMIC_RELAXED, __HIP_MEMORY_SCOPE_WORKGROUP);
        sbw[lane] = ((unsigned)ek << 16) | (unsigned)lr;
        GATE[(size_t)m * TOPK + lane] = gk;
    }
}
struct Args { const float* in[18]; float* out; unsigned char* ws; int ph_lo, ph_hi; };
__global__ void __launch_bounds__(NTHR, 2) fwd_kernel(Args args) {
    extern __shared__ __attribute__((aligned(16))) unsigned char lds_raw[];
    LAS unsigned char* lds = (LAS unsigned char*)lds_raw;
    volatile LAS unsigned* MISC = (volatile LAS unsigned*)(lds + MISC_OFF);
    const int tid = threadIdx.x, lane = tid & 63, wave = __builtin_amdgcn_readfirstlane(tid >> 6);
    const int G = gridDim.x; const int bx = blockIdx.x; const int vcu = (G % 8 == 0) ? (bx % 8) * (G / 8) + bx / 8 : bx;
    const int gw = vcu * NWAVES + wave, NGW = G * NWAVES;
    unsigned char* ws = args.ws;
    unsigned* ctl = (unsigned*)(ws + WS_CTL);
    const float* x = args.in[0]; const float* norm1_w = args.in[1]; const float* w_in = args.in[2]; const float* lb_logits = args.in[3];
    const float* hgrn_norm_w = args.in[4]; const float* dw_w = args.in[5]; const float* dw_b = args.in[6]; const float* conv_ln_w = args.in[7]; const float* conv_ln_b = args.in[8];
    const float* w_out = args.in[9]; const float* norm2_w = args.in[10]; const float* router_w = args.in[11]; const float* router_b = args.in[12];
    const float* w1 = args.in[13]; const float* b1 = args.in[14]; const float* w2 = args.in[15]; const float* b2 = args.in[16]; const float* final_norm_w = args.in[17];
    float* out = args.out;
    bf16* WI = (bf16*)(ws + WS_WI); bf16* WO = (bf16*)(ws + WS_WO); unsigned char* W1T = ws + WS_W1; unsigned char* W2T = ws + WS_W2;
    float* H = (float*)(ws + WS_H); bf16* XN = (bf16*)(ws + WS_XN);
    bf16* Qb = (bf16*)(ws + WS_Q); bf16* KFb = (bf16*)(ws + WS_KF); bf16* KBb = (bf16*)(ws + WS_KB); bf16* Vb = (bf16*)(ws + WS_V); bf16* Gb = (bf16*)(ws + WS_G); bf16* Ub = (bf16*)(ws + WS_U);
    float* LFb = (float*)(ws + WS_LF); float* LBb = (float*)(ws + WS_LB); float* OFb = (float*)(ws + WS_OF); float* OBb = (float*)(ws + WS_OB);
    bf16* MIX = (bf16*)(ws + WS_MIX); unsigned char* XS = ws + WS_XS; unsigned char* ACT = ws + WS_ACT; unsigned char* N2 = ws + WS_XN; bf16* YS = (bf16*)(ws + WS_YS);
    float* WRT = (float*)(ws + WS_WRT); int* SLOT = (int*)(ws + WS_SLOT); float* GATE = (float*)(ws + WS_GATE); int* ROWTOK = (int*)(ws + WS_ROWTOK);
    volatile LAS int* bs = (volatile LAS int*)(lds + TAB_OFF);
    volatile LAS int* cl = (volatile LAS int*)(lds + TAB_OFF + 256);
    LAS int* lcnt = (LAS int*)(lds + TAB_OFF + 512);
    volatile LAS int* gbase = (volatile LAS int*)(lds + TAB_OFF + 768);

    for (int u = tid; u < (LDS_BYTES - LDSCTL_OFF) / 4; u += NTHR) ((LAS unsigned*)(lds + LDSCTL_OFF))[u] = 0u;
    __syncthreads();
    XcdBarrier bar; bar.bar = ctl + CW_BAR; bar.x = 0; bar.st = nullptr;
    if (MK_N_LAUNCHES == 1) bar = xcd_barrier_post(ctl + CW_BAR, MISC + 8);
    const int lo = args.ph_lo, hi = args.ph_hi;
#ifndef PHASE_MASK
#define PHASE_MASK 0xffffffffu
#endif
#define IN(k) ((((PHASE_MASK) >> (k)) & 1u) && lo <= (k) && (k) < hi)
#ifndef PROBE_DUP
#define PROBE_DUP -1
#endif
#define REP(k) _Pragma("unroll 1") for (int rep_ = 0; rep_ < ((PROBE_DUP) == (k) ? 2 + (args.ph_hi >> 20) : 1); ++rep_)
#define SEAM(k) do { if (IN(k) && IN((k) + 1)) { xcd_barrier(bar); if ((PROBE_DUP) == 99) { xcd_barrier(bar); xcd_barrier(bar); } } } while (0)
#define BUILD_BS() do { if (tid < 64) { const int c_ = tid < NE ? (int)__hip_atomic_load(ctl + CW_CNT + 64 * (tid & (NE - 1)), RLX_AGENT) : 0; int x_ = (c_ + 255) >> 8; \
        _Pragma("unroll") for (int o_ = 1; o_ < NE; o_ <<= 1) { const int y_ = __shfl_up(x_, o_); if (lane >= o_) x_ += y_; }     \
        if (tid < NE) { cl[tid] = c_; bs[tid + 1] = x_; } if (tid == 0) bs[0] = 0; } __syncthreads(); } while (0)

    if (IN(0)) REP(0) {
        LAS float* scr = (LAS float*)(lds + RING_OFF + wave * 16384);
        constexpr int I_WI = (D / 64) * (INC / 32), I_WO = (D / 64) * (D / 32), I_W1 = (D / 64) * (2 * FF / 32), I_W2 = (FF / 64) * (D / 32);
        #if defined(HGRN_NAIVE) || defined(W2_IN_P0)
        constexpr int NITEMS = I_WI + I_WO + NE * I_W1 + NE * I_W2;
#else
        constexpr int NITEMS = I_WI + I_WO + NE * I_W1;
#endif
        for (int it = gw; it < NITEMS; it += NGW) {
            int r = it;
            if (r < I_WI) { p0_item<false>(w_in, D, INC, WI, RmWin(), scr, r, lane); continue; } r -= I_WI;
            if (r < I_WO) { p0_item<false>(w_out, D, D, WO, RmIdent(), scr, r, lane); continue; } r -= I_WO;
            if (r < NE * I_W1) { const int e = r / I_W1; p0_item<true>(w1 + (size_t)e * D * 2 * FF, D, 2 * FF, W1T + (size_t)e * 2 * FF * D, RmW1(), scr, r - e * I_W1, lane); continue; } r -= NE * I_W1;
#if defined(HGRN_NAIVE) || defined(W2_IN_P0)
            { const int e = r / I_W2; p0_item<true>(w2 + (size_t)e * FF * D, FF, D, W2T + (size_t)e * D * FF, RmIdent(), scr, r - e * I_W2, lane); }
#endif
        }
        for (int m = gw; m < MTOK; m += NGW) rms_row_to_bf16(x + (size_t)m * D, norm1_w, XN + (size_t)m * D, lane);
        for (int i = bx * NTHR + tid; i < 16 * D; i += G * NTHR) {
            const int r = i >> 4, e16 = i & 15, k = 256 * (r & 3) + (r >> 2); const float gk = norm2_w[k];
            WRT[2 * i] = gk * router_w[k * NE + e16]; WRT[2 * i + 1] = gk * router_w[k * NE + 16 + e16]; }
    }
    SEAM(0);

    if (IN(1)) REP(1) {
        pg8::Gemm g{XN, WI, MTOK, INC, D}; OrderRep S; S.init(MTOK, INC, G, bx); S.reps = ((PROBE_DUP) == 11) ? 2 : 1;
        EpiProj E{Qb, KFb, KBb, Vb, Gb, Ub, LFb, LBb, lb_logits};
        pg8::gemm_phase<EpiProj, OrderRep, true, true>(lds + RING_OFF, g, S, E);
    }
    SEAM(1);

    if (IN(2)) REP(2) {
        const bool split = (G == 256);
#if defined(HGRN_NAIVE)
        const bool hsel = true; const int hidx = 0, hstride = 1; const bool csel = true; const int cidx = vcu, cstride = G;
#else
        const bool hsel = split ? (((bx >> 3) & 1) != 0) : true; const int hidx = split ? (bx >> 4) * 8 + (bx & 7) : bx, hstride = split ? 128 : G;
        const bool csel = split ? !hsel : true; const int cidx = split ? (bx >> 4) * 8 + (bx & 7) : bx, cstride = split ? 128 : G;
#endif
        (void)hidx; (void)hstride;
        if (csel) for (int crep_ = 0; crep_ < ((PROBE_DUP) == 21 ? 2 : 1); ++crep_) {
            LAS unsigned short* ut = (LAS unsigned short*)(lds + RING_OFF);
            LAS float* part = (LAS float*)(lds + RING_OFF + 98304);
            LAS float* stat = (LAS float*)(lds + RING_OFF + 98304 + 4096);
            for (int unit = cidx; unit < NBATCH * (TT / 64); unit += cstride) {
                const int b = unit / (TT / 64), t0 = (unit % (TT / 64)) * 64;
                for (int idx = tid; idx < 94 * 64; idx += NTHR) {
                    const int r = idx >> 6, p = idx & 63, t = t0 - 15 + r;
                    v4u val = (v4u){0u, 0u, 0u, 0u};
                    if (t >= 0 && t < TT) val = *(const v4u*)(Ub + (size_t)(b * TT + t) * CCH + p * 8);
                    *(LAS v4u*)(ut + r * 512 + p * 8) = val;
                }
                __syncthreads();
                const int c = tid;
                float w[CLEN];
#pragma unroll
                for (int j = 0; j < CLEN; ++j) w[j] = dw_w[j * CCH + c];
                const float bias = dw_b[c];
                float y[64];
#pragma unroll
                for (int tb = 0; tb < 8; ++tb) {
                    float win[38];
#pragma unroll
                    for (int i = 0; i < 38; ++i) win[i] = bf2f(ut[(tb * 8 + i) * 512 + c]);
#pragma unroll
                    for (int o = 0; o < 8; ++o) { float a = bias;
#pragma unroll
                        for (int j = 0; j < CLEN; ++j) a += w[j] * win[o + j];
                        y[tb * 8 + o] = a; }
                }
#pragma unroll 1
                for (int pass = 0; pass < 2; ++pass) {
                    float s1[64];
#pragma unroll
                    for (int i = 0; i < 64; ++i) s1[i] = pass ? y[i] * y[i] : y[i];
#pragma unroll
                    for (int s = 32; s >= 1; s >>= 1) {
                        const bool up = (lane & s) != 0;
#pragma unroll
                        for (int i = 0; i < s; ++i) { const float k1 = up ? s1[i + s] : s1[i], x1 = up ? s1[i] : s1[i + s]; s1[i] = k1 + __shfl_xor(x1, s); }
                    }
                    part[(wave * 64 + lane) * 2 + pass] = s1[0];
                }
                __syncthreads();
                if (tid < 64) { float a = 0.f, q = 0.f;
#pragma unroll
                    for (int wv = 0; wv < 8; ++wv) { a += part[(wv * 64 + tid) * 2]; q += part[(wv * 64 + tid) * 2 + 1]; }
                    const float mean = a * (1.f / CCH), var = q * (1.f / CCH) - mean * mean;
                    stat[tid * 2] = mean; stat[tid * 2 + 1] = rsqrtf(fmaxf(var, 0.f) + EPS); }
                __syncthreads();
                const float lw = conv_ln_w[c], lbias = conv_ln_b[c];
#pragma unroll
                for (int t = 0; t < 64; ++t) {
                    const float v = (y[t] - stat[t * 2]) * stat[t * 2 + 1] * lw + lbias;
                    MIX[(size_t)(b * TT + t0 + t) * D + 512 + c] = (bf16)(pk2(v * sigm(v), 0.f) & 0xffffu);
                }
                __syncthreads();
            }
#if !defined(HGRN_NAIVE) && !defined(W2_IN_P0)
            {
                LAS float* scr = (LAS float*)(lds + RING_OFF + wave * 16384);
                constexpr int I_W2 = (FF / 64) * (D / 32);
                for (int it = cidx * NWAVES + wave; it < NE * I_W2; it += cstride * NWAVES) { const int e = it / I_W2;
                    p0_item<true>(w2 + (size_t)e * FF * D, FF, D, W2T + (size_t)e * D * FF, RmIdent(), scr, it - e * I_W2, lane); }
            }
#endif
        }
#if defined(HGRN_NAIVE)
        {
            LAS float* qs = (LAS float*)(lds + RING_OFF); LAS float* ks = qs + 2048; LAS float* fs = ks + 2048; LAS float* vs = fs + 2048; LAS float* op = vs + 2048;
            const int e = tid & 127, dq = tid >> 7;
            for (int unit = G - 1 - bx; unit < NBATCH * NH * 2; unit += G) {
                const int dir = unit & 1, h = (unit >> 1) & 3, b = unit >> 3;
                const bf16* Kp = dir ? KBb : KFb; const float* Lp = dir ? LBb : LFb; float* Op = dir ? OBb : OFb;
                float S[32];
#pragma unroll
                for (int i = 0; i < 32; ++i) S[i] = 0.f;
                for (int blk = 0; blk < TT / 16; ++blk) {
                    const int tb = dir ? (TT - 16 - blk * 16) : blk * 16;
#pragma unroll
                    for (int i = 0; i < 4; ++i) { const int idx = tid + NTHR * i, r = idx >> 7, d = idx & 127; const size_t off = (size_t)(b * TT + tb + r) * 512 + h * 128 + d;
                        qs[idx] = bf2f(Qb[off]); ks[idx] = bf2f(Kp[off]); fs[idx] = __expf(Lp[off]); vs[idx] = bf2f(Vb[off]); }
                    __syncthreads();
                    for (int st = 0; st < 16; ++st) {
                        const int r = dir ? 15 - st : st; const float v = vs[r * 128 + e]; float o = 0.f;
#pragma unroll
                        for (int dd = 0; dd < 32; ++dd) { const int d = dq * 32 + dd; S[dd] = fs[r * 128 + d] * S[dd] + ks[r * 128 + d] * v; o += qs[r * 128 + d] * S[dd]; }
                        op[(r * 4 + dq) * 128 + e] = o;
                    }
                    __syncthreads();
#pragma unroll
                    for (int i = 0; i < 4; ++i) { const int idx = tid + NTHR * i, r = idx >> 7, ee = idx & 127;
                        Op[(size_t)(b * TT + tb + r) * 512 + h * 128 + ee] = (op[(r * 4 + 0) * 128 + ee] + op[(r * 4 + 1) * 128 + ee]) + (op[(r * 4 + 2) * 128 + ee] + op[(r * 4 + 3) * 128 + ee]); }
                }
                __syncthreads();
            }
        }
#else
        if (hsel) for (int hrep_ = 0; hrep_ < ((PROBE_DUP) == 20 ? 2 : 1); ++hrep_) for (int unit = hidx; unit < NBATCH * NH * 4; unit += hstride) hgrn_unit(lds + RING_OFF, unit, Qb, KFb, KBb, Vb, LFb, LBb, OFb, OBb, tid, lane, wave);
#endif
    }
    SEAM(2);

    if (IN(3)) REP(3) {
        for (int m = gw; m < MTOK; m += NGW) {
            const size_t off = (size_t)m * 512 + lane * 8;
            const f32x4 a0 = *(const f32x4*)(OFb + off), a1 = *(const f32x4*)(OFb + off + 4), c0 = *(const f32x4*)(OBb + off), c1 = *(const f32x4*)(OBb + off + 4);
            const f32x4 o0 = a0 + c0, o1 = a1 + c1;
            float ss = (o0.x * o0.x + o0.y * o0.y) + (o0.z * o0.z + o0.w * o0.w) + (o1.x * o1.x + o1.y * o1.y) + (o1.z * o1.z + o1.w * o1.w);
            ss += __shfl_xor(ss, 1); ss += __shfl_xor(ss, 2); ss += __shfl_xor(ss, 4); ss += __shfl_xor(ss, 8);
            const float rstd = rsqrtf(ss * (1.f / DV) + EPS);
            const v4u gv = *(const v4u*)(Gb + off);
            const f32x4 w0 = *(const f32x4*)(hgrn_norm_w + lane * 8), w1v = *(const f32x4*)(hgrn_norm_w + lane * 8 + 4);
            f32x4 r0, r1;
            r0.x = o0.x * rstd * w0.x * bf2f(gv.x & 0xffffu); r0.y = o0.y * rstd * w0.y * bf2f(gv.x >> 16);
            r0.z = o0.z * rstd * w0.z * bf2f(gv.y & 0xffffu); r0.w = o0.w * rstd * w0.w * bf2f(gv.y >> 16);
            r1.x = o1.x * rstd * w1v.x * bf2f(gv.z & 0xffffu); r1.y = o1.y * rstd * w1v.y * bf2f(gv.z >> 16);
            r1.z = o1.z * rstd * w1v.z * bf2f(gv.w & 0xffffu); r1.w = o1.w * rstd * w1v.w * bf2f(gv.w >> 16);
            st8bf(MIX + (size_t)m * D + lane * 8, r0, r1);
        }
    }
    SEAM(3);

    if (IN(4)) REP(4) {
        pg8::Gemm g{MIX, WO, MTOK, D, D}; pg8::StaticOrder S; S.init(MTOK, D, G, bx);
        EpiRes E{x, H};
        pg8::gemm_phase<EpiRes, pg8::StaticOrder, true, true>(lds + RING_OFF, g, S, E);
    }
    SEAM(4);

    if (IN(5)) REP(5) {
        typedef float f32x2 __attribute__((ext_vector_type(2)));
        LAS float* wl = (LAS float*)(lds + RING_OFF);
        LAS unsigned* sb = (LAS unsigned*)(lds + SB_OFF);
        for (int i = tid; i < NE * D / 4; i += NTHR) ((LAS f32x4*)wl)[i] = ((const f32x4*)WRT)[i];
        if (tid < NE) lcnt[tid] = 0;
        __syncthreads();
        for (int tg = vcu; tg < MTOK / 64; tg += G) {
            const int tok0 = tg * 64 + 16 * (wave & 3);
            if (wave < 4) {
                const int j = lane & 15, q = lane >> 4;
                const f32x4* hrow = (const f32x4*)(H + (size_t)(tok0 + j) * D + 256 * q);
                const LAS f32x2* tab = (const LAS f32x2*)wl + q * 16 + j;
                f32x4 acc0 = (f32x4){0.f, 0.f, 0.f, 0.f}, acc1 = acc0; float ss = 0.f;
                f32x4 hv = hrow[0];
#pragma unroll 2
                for (int s4 = 0; s4 < 64; ++s4) {
                    const f32x4 hc = hv;
                    if (s4 + 1 < 64) hv = hrow[s4 + 1];
                    f32x2 w[4];
#pragma unroll
                    for (int u = 0; u < 4; ++u) w[u] = tab[(4 * s4 + u) * 64];
                    ss += (hc.x * hc.x + hc.y * hc.y) + (hc.z * hc.z + hc.w * hc.w);
#pragma unroll
                    for (int u = 0; u < 4; ++u) { acc0 = __builtin_amdgcn_mfma_f32_16x16x4f32(w[u].x, hc[u], acc0, 0, 0, 0); acc1 = __builtin_amdgcn_mfma_f32_16x16x4f32(w[u].y, hc[u], acc1, 0, 0, 0); }
                }
                ss += __shfl_xor(ss, 16); ss += __shfl_xor(ss, 32);
                const float rstd = rsqrtf(ss * (1.f / D) + EPS);
                float lg[8];
#pragma unroll
                for (int r = 0; r < 4; ++r) { lg[r] = acc0[r] * rstd + router_b[4 * q + r]; lg[4 + r] = acc1[r] * rstd + router_b[16 + 4 * q + r]; }
                float tv[TOPK]; int ti[TOPK];
#pragma unroll
                for (int k = 0; k < TOPK; ++k) {
                    float bv = lg[0]; int bi = 4 * q;
#pragma unroll
                    for (int r = 1; r < 8; ++r) { const int id = (r < 4) ? 4 * q + r : 16 + 4 * q + (r - 4); if (lg[r] > bv) { bv = lg[r]; bi = id; } }
#pragma unroll
                    for (int o = 16; o < 64; o <<= 1) { const float ov = __shfl_xor(bv, o); const int oi = __shfl_xor(bi, o); if (ov > bv || (ov == bv && oi < bi)) { bv = ov; bi = oi; } }
                    tv[k] = bv; ti[k] = bi;
#pragma unroll
                    for (int r = 0; r < 8; ++r) { const int id = (r < 4) ? 4 * q + r : 16 + 4 * q + (r - 4); if (id == bi) lg[r] = -INFINITY; }
                }
                const float e1 = __expf(tv[1] - tv[0]), e2 = __expf(tv[2] - tv[0]), e3 = __expf(tv[3] - tv[0]);
                const float inv = 1.0f / (1.0f + e1 + e2 + e3);
                {
                    const int ek = q == 0 ? ti[0] : q == 1 ? ti[1] : q == 2 ? ti[2] : ti[3];
                    const float gk = (q == 0 ? 1.0f : q == 1 ? e1 : q == 2 ? e2 : e3) * inv;
                    const int lr = __hip_atomic_fetch_add(&lcnt[ek], 1, __ATOMIC_RELAXED, __HIP_MEMORY_SCOPE_WORKGROUP);
                    sb[(16 * wave + j) * 4 + q] = ((unsigned)ek << 16) | (unsigned)lr;
                    GATE[(size_t)(tok0 + j) * TOPK + q] = gk;
                }
            } else {
                for (int i = 0; i < 16; ++i) {
                    const int m = tok0 + i;
                    const f32x4* hr = (const f32x4*)(H + (size_t)m * D) + lane; const f32x4* wr = (const f32x4*)norm2_w + lane;
                    f32x4 v[4]; float s2 = 0.f;
#pragma unroll
                    for (int jj = 0; jj < 4; ++jj) { v[jj] = hr[64 * jj]; s2 += (v[jj].x * v[jj].x + v[jj].y * v[jj].y) + (v[jj].z * v[jj].z + v[jj].w * v[jj].w); }
                    const float rstd = rsqrtf(wave_sum(s2) * (1.f / D) + EPS) * SC_N2;
                    unsigned* o4 = (unsigned*)(N2 + (size_t)m * D) + lane;
#pragma unroll
                    for (int jj = 0; jj < 4; ++jj) { const f32x4 g = wr[64 * jj]; o4[64 * jj] = pk4_fp8(v[jj].x * rstd * g.x, v[jj].y * rstd * g.y, v[jj].z * rstd * g.z, v[jj].w * rstd * g.w); }
                }
            }
            __syncthreads();
            if (tid < NE) { const int c = lcnt[tid]; gbase[tid] = c ? (int)__hip_atomic_fetch_add(ctl + CW_CNT + ((PROBE_DUP) == 5 && rep_ == 0 ? 4096 : 0) + 64 * tid, (unsigned)c, RLX_AGENT) : 0; }
            __syncthreads();
            if (tid < 256) { const unsigned w = sb[tid]; const int ek = (int)(w >> 16), r = gbase[ek] + (int)(w & 0xffffu), m = tg * 64 + (tid >> 2);
                ROWTOK[ek * MTOK + r] = m; SLOT[(size_t)m * TOPK + (tid & 3)] = ek * MTOK + r; }
            if (tid < NE) lcnt[tid] = 0;
            __syncthreads();
        }
    }
    SEAM(5);


    if (IN(7)) REP(7) {
        BUILD_BS();
        pg8::Gemm g{(const bf16*)N2, (const bf16*)W1T, MTOK, 2 * FF, D / 2}; MoeOrder S{bs, 8, G, vcu, cl, ROWTOK};
        EpiSwiglu E{ACT, b1};
        pg8::gemm_phase<EpiSwiglu, MoeOrder, true, true, true, true>(lds + RING_OFF, g, S, E);
    }
    SEAM(7);

    if (IN(8)) REP(8) {
        BUILD_BS();
        pg8::Gemm g{(const bf16*)ACT, (const bf16*)W2T, MOE_ROWS, D, FF / 2}; MoeOrder S{bs, 4, G, vcu, cl, ROWTOK};
        EpiDown E{YS, b2};
        pg8::gemm_phase<EpiDown, MoeOrder, true, true, true>(lds + RING_OFF, g, S, E);
    }
    SEAM(8);

    if (IN(9)) REP(9) {
        BUILD_BS();
        for (int m = gw; m < MTOK; m += NGW) {
            const f32x4* hr = (const f32x4*)(H + (size_t)m * D) + lane; const f32x4* wr = (const f32x4*)final_norm_w + lane;
            f32x4 v[4];
#pragma unroll
            for (int j = 0; j < 4; ++j) v[j] = hr[64 * j];
#pragma unroll
            for (int k = 0; k < TOPK; ++k) {
                const int sl = SLOT[(size_t)m * TOPK + k]; const float gk = GATE[(size_t)m * TOPK + k];
                const int e = sl >> 14, pos = bs[e] * 256 + (sl & (MTOK - 1));
                const v2u* yr = (const v2u*)(YS + (size_t)pos * D) + lane;
#pragma unroll
                for (int j = 0; j < 4; ++j) { const v2u w = yr[64 * j];
                    v[j].x += gk * bf2f(w.x & 0xffffu); v[j].y += gk * bf2f(w.x >> 16); v[j].z += gk * bf2f(w.y & 0xffffu); v[j].w += gk * bf2f(w.y >> 16); }
            }
            float s = 0.f;
#pragma unroll
            for (int j = 0; j < 4; ++j) s += (v[j].x * v[j].x + v[j].y * v[j].y) + (v[j].z * v[j].z + v[j].w * v[j].w);
            const float rstd = rsqrtf(wave_sum(s) * (1.f / D) + EPS);
            f32x4* orow = (f32x4*)(out + (size_t)m * D) + lane;
#pragma unroll
            for (int j = 0; j < 4; ++j) orow[64 * j] = v[j] * rstd * wr[64 * j];
        }
    }
#undef IN
#undef SEAM
#undef BUILD_BS
}

extern "C" void kernel_launch(void* const* d_in, const int* in_sizes, int n_in, void* d_out, int out_size, void* d_ws, size_t ws_size, hipStream_t stream) {
    static int grid = 0;
    if (grid == 0) {
        if (n_in != 18 || in_sizes[0] != MTOK * D || out_size != MTOK * D || ws_size < WS_END) { fprintf(stderr, "kernel_launch: unexpected shapes (n_in %d, in0 %d, out %d, ws %zu < %zu); nothing launched\n", n_in, n_in > 0 ? in_sizes[0] : -1, out_size, ws_size, (size_t)WS_END); grid = -1; return; }
        int dev = 0, cus = 0, per_cu = 0;
        if (hipGetDevice(&dev) != hipSuccess || hipDeviceGetAttribute(&cus, hipDeviceAttributeMultiprocessorCount, dev) != hipSuccess) { fprintf(stderr, "kernel_launch: device query failed\n"); grid = -1; return; }
        if (hipFuncSetAttribute((const void*)fwd_kernel, hipFuncAttributeMaxDynamicSharedMemorySize, LDS_BYTES) != hipSuccess) { fprintf(stderr, "kernel_launch: hipFuncSetAttribute failed\n"); grid = -1; return; }
        if (hipOccupancyMaxActiveBlocksPerMultiprocessor(&per_cu, (const void*)fwd_kernel, NTHR, LDS_BYTES) != hipSuccess || per_cu < 1)
            fprintf(stderr, "kernel_launch: note: occupancy query reports %d workgroups per CU\n", per_cu);
        (void)hipGetLastError();
        grid = cus;
    }
    if (grid < 0) return;
    if (hipMemsetAsync((char*)d_ws + WS_CTL, 0, CTL_ZERO_BYTES, stream) != hipSuccess) { fprintf(stderr, "kernel_launch: memset failed\n"); return; }
    Args a{};
    for (int i = 0; i < 18; ++i) a.in[i] = (const float*)d_in[i];
    a.out = (float*)d_out; a.ws = (unsigned char*)d_ws;
#if MK_N_LAUNCHES == 1
    a.ph_lo = 0; a.ph_hi = N_PHASES;
    hipLaunchKernelGGL(fwd_kernel, dim3(grid), dim3(NTHR), LDS_BYTES, stream, a);
#else
    for (int ph = 0; ph < N_PHASES; ++ph) { a.ph_lo = ph; a.ph_hi = ph + 1; hipLaunchKernelGGL(fwd_kernel, dim3(grid), dim3(NTHR), LDS_BYTES, stream, a); }
#endif
    const hipError_t le = hipPeekAtLastError();
    if (le != hipSuccess) fprintf(stderr, "kernel_launch: launch failed: %s\n", hipGetErrorName(le));
}
```

```cpp
#include <hip/hip_runtime.h>
#include <cstdio>
#include <cstdint>
namespace pg8 {
#define PG8_LAS __attribute__((address_space(3)))
typedef unsigned short bf16_t;
typedef short bf16x8 __attribute__((ext_vector_type(8)));
typedef float f32x4 __attribute__((ext_vector_type(4)));
typedef unsigned u32x4 __attribute__((ext_vector_type(4)));
constexpr int BM = 256, BK = 64, HALF = 128, HTB = HALF * BK * 2  , STAGE_BYTES = 8 * HTB, NXCD = 8, WGM = 8;

__host__ __device__ __forceinline__ int lds_byte(int r, int c) { const int st = (r >> 4) * 2 + (c >> 5), rr = r & 15, cc = c & 31, ob = rr * 64 + cc * 2; return st * 1024 + (ob ^ (((ob >> 9) & 1) << 5)); }
__host__ __device__ __forceinline__ void stage_rc(int b, int& R, int& C) { const int st = b / 1024, sb = b % 1024, swz = sb ^ (((sb >> 9) & 1) << 5); R = (st >> 1) * 16 + swz / 64; C = (st & 1) * 32 + (swz % 64) / 2; }
__host__ __device__ __forceinline__ int perm32(int rho) { const int n = rho >> 4, i = rho & 15; return 8 * (i >> 2) + 4 * n + (i & 3); }

struct Unit { int pm, pn; };
struct Gemm { const bf16_t* A; const bf16_t* Bt; int M, N, K; };

struct StaticOrder {
    int nM, nN, nwg, G, c;
    __host__ __device__ void init(int M, int N, int G_, int c_) { nM = M / BM; nN = N / BM; nwg = nM * nN; G = G_; c = c_; }
    __host__ __device__ bool next(int i, Unit& u) const {
        const long L = (long)i * G + c; if (L >= nwg) return false;
        int wgid = (int)L; { const int q = nwg / NXCD, r = nwg % NXCD, xcd = wgid % NXCD, off = wgid / NXCD; wgid = (xcd < r ? xcd * (q + 1) : r * (q + 1) + (xcd - r) * q) + off; }
        const int nig = WGM * nN, gid = wgid / nig, fm = gid * WGM, gsz = (nM - fm) < WGM ? (nM - fm) : WGM;
        u.pm = fm + ((wgid % nig) % gsz); u.pn = (wgid % nig) / gsz; return true;
    }
    __device__ __forceinline__ void a_ready(const Unit&) const {}
    __device__ __forceinline__ void done(const Unit&) const {}
};
__device__ __forceinline__ unsigned cvt_pk_bf16(float lo, float hi) { unsigned r; asm volatile("v_cvt_pk_bf16_f32 %0, %1, %2" : "=v"(r) : "v"(lo), "v"(hi)); return r; }
typedef float f32x2 __attribute__((ext_vector_type(2)));
template <class Epi, class Sched, bool ALIGN_EPI = false, bool SP2 = false, bool FP8 = false, bool GATHER = false>
__device__ __forceinline__ void gemm_phase(PG8_LAS unsigned char* lds, const Gemm g, const Sched& S, const Epi& E) {
    typedef int v4i_t __attribute__((ext_vector_type(4)));
    const int tid = threadIdx.x, wid = __builtin_amdgcn_readfirstlane(tid >> 6), lane = tid & 63, wr = wid >> 2, wc = wid & 3, fr = lane & 15, fq = lane >> 4;
    const int K = g.K, nt = K / BK;
    unsigned voffA[2], voffB[2];
#pragma unroll
    for (int i = 0; i < 2; ++i) { int R, C; stage_rc(tid * 16 + i * 8192, R, C); const int Rb = Epi::PERM ? ((R & ~31) + perm32(R & 31)) : R;
        voffA[i] = (unsigned)(R * K + C) * 2u; voffB[i] = (unsigned)(Rb * K + C) * 2u; }
    int rowA[2]; unsigned colA[2];
#pragma unroll
    for (int i = 0; i < 2; ++i) { int R, C; stage_rc(tid * 16 + i * 8192, R, C); rowA[i] = R; colA[i] = (unsigned)C * 2u; }
    const size_t kstep = (size_t)(BK * 2);
    const size_t hstep = (size_t)HALF * K * 2;
    const size_t tstep = 2 * hstep;
    const unsigned ldsw = (unsigned)wid * 1024u;
    const int aoff = lds_byte(wr * 64 + fr, fq * 8), boff = lds_byte(wc * 32 + fr, fq * 8);
#define PG8_SA(b, h) (((b) * 2 + (h)) * HTB)
#define PG8_SB(b, h) ((4 + (b) * 2 + (h)) * HTB)
#define PG8_STAGE(bufoff, gbase, voff) do { _Pragma("unroll") for (int _i = 0; _i < 2; ++_i) \
        __builtin_amdgcn_global_load_lds((const unsigned*)((const char*)(gbase) + (voff)[_i]), (PG8_LAS unsigned*)(lds + (bufoff) + ldsw + _i * 8192), 16, 0, 0); } while (0)
#define PG8_STAGE2(bufoff, gbase, o0, o1) do { \
        __builtin_amdgcn_global_load_lds((const unsigned*)((const char*)(gbase) + (o0)), (PG8_LAS unsigned*)(lds + (bufoff) + ldsw), 16, 0, 0); \
        __builtin_amdgcn_global_load_lds((const unsigned*)((const char*)(gbase) + (o1)), (PG8_LAS unsigned*)(lds + (bufoff) + ldsw + 8192), 16, 0, 0); } while (0)
#define PG8_LDA(dst, b, h) do { _Pragma("unroll") for (int m = 0; m < 4; ++m) _Pragma("unroll") for (int k = 0; k < 2; ++k) dst[m][k] = *(const PG8_LAS bf16x8*)(lds + PG8_SA(b, h) + aoff + m * 2048 + k * 1024); } while (0)
#define PG8_LDB(dst, b, h) do { _Pragma("unroll") for (int n = 0; n < 2; ++n) _Pragma("unroll") for (int k = 0; k < 2; ++k) dst[n][k] = *(const PG8_LAS bf16x8*)(lds + PG8_SB(b, h) + boff + n * 2048 + k * 1024); } while (0)
#define PG8_MMA(ai, bj, At, Bt) do { __builtin_amdgcn_s_setprio(1); _Pragma("unroll") for (int m = 0; m < 4; ++m) _Pragma("unroll") for (int n = 0; n < 2; ++n) { \
        if constexpr (FP8) { asm volatile("v_mfma_f32_16x16x128_f8f6f4 %0, %1, %2, %0" : "+v"(acc[ai][bj][m][n]) : "v"(__builtin_shufflevector((v4i_t)Bt[n][0], (v4i_t)Bt[n][1], 0, 1, 2, 3, 4, 5, 6, 7)), "v"(__builtin_shufflevector((v4i_t)At[m][0], (v4i_t)At[m][1], 0, 1, 2, 3, 4, 5, 6, 7))); } \
        else { _Pragma("unroll") for (int k = 0; k < 2; ++k) acc[ai][bj][m][n] = __builtin_amdgcn_mfma_f32_16x16x32_bf16(Bt[n][k], At[m][k], acc[ai][bj][m][n], 0, 0, 0); } } __builtin_amdgcn_s_setprio(0); } while (0)
#define PG8_WAIT_V(n) asm volatile("s_waitcnt vmcnt(" #n ")" ::: "memory")
#define PG8_WAIT_L(n) asm volatile("s_waitcnt lgkmcnt(" #n ")" ::: "memory")
#define PG8_BAR __builtin_amdgcn_s_barrier()
#define PG8_SCHED __builtin_amdgcn_sched_barrier(0)
    Unit cur, nxt; int ui = 0;
    if (!S.next(0, cur)) return;
    f32x4 acc[2][2][4][2];
#pragma unroll
    for (int a = 0; a < 2; ++a)
#pragma unroll
        for (int b = 0; b < 2; ++b)
#pragma unroll
            for (int m = 0; m < 4; ++m)
#pragma unroll
                for (int n = 0; n < 2; ++n) acc[a][b][m][n] = (f32x4){0.f, 0.f, 0.f, 0.f};
    bf16x8 At[4][2], B0[2][2], B1[2][2];
    const char* cA = (const char*)g.A + (size_t)cur.pm * tstep; const char* cB = (const char*)g.Bt + (size_t)cur.pn * tstep;
    unsigned oA[2][2], nOA[2][2]; int tk[2][2] = {{0, 0}, {0, 0}};
    if constexpr (GATHER) {
        cA = (const char*)g.A;
        const int* lst = S.a_list(cur); const int nv = S.a_valid(cur);
#pragma unroll
        for (int h = 0; h < 2; ++h)
#pragma unroll
            for (int i = 0; i < 2; ++i) { const int r = min(h * HALF + rowA[i], nv - 1); oA[h][i] = (unsigned)lst[r] * (unsigned)(K * 2) + colA[i]; }
    } else {
#pragma unroll
        for (int h = 0; h < 2; ++h)
#pragma unroll
            for (int i = 0; i < 2; ++i) oA[h][i] = voffA[i] + (unsigned)(h * hstep);
    }
#pragma unroll
    for (int h = 0; h < 2; ++h)
#pragma unroll
        for (int i = 0; i < 2; ++i) nOA[h][i] = oA[h][i];
#define PG8_OSEL(h, i) (GATHER ? (last ? nOA[h][i] : oA[h][i]) : oA[h][i])
    S.a_ready(cur);
    if constexpr (SP2) {
        PG8_STAGE(PG8_SB(0, 0), cB, voffB); PG8_STAGE(PG8_SB(0, 1), cB + hstep, voffB); PG8_STAGE2(PG8_SA(0, 0), cA, oA[0][0], oA[0][1]); PG8_STAGE2(PG8_SA(0, 1), cA, oA[1][0], oA[1][1]);
        if (wr == 1) PG8_BAR;
        PG8_WAIT_V(2); PG8_BAR;
        PG8_STAGE(PG8_SB(1, 0), cB + kstep, voffB); PG8_STAGE2(PG8_SA(1, 0), cA + kstep, oA[0][0], oA[0][1]); PG8_STAGE(PG8_SB(1, 1), cB + hstep + kstep, voffB);
        PG8_WAIT_V(6); PG8_BAR;
    } else {
        PG8_STAGE(PG8_SB(0, 0), cB, voffB); PG8_STAGE(PG8_SA(0, 0), cA, voffA); PG8_STAGE(PG8_SB(0, 1), cB + hstep, voffB); PG8_STAGE(PG8_SA(0, 1), cA + hstep, voffA);
        if (wr == 1) PG8_BAR;
        PG8_WAIT_V(4); PG8_BAR;
        PG8_STAGE(PG8_SB(1, 0), cB + kstep, voffB); PG8_STAGE(PG8_SA(1, 0), cA + kstep, voffA); PG8_STAGE(PG8_SB(1, 1), cB + hstep + kstep, voffB);
        PG8_WAIT_V(6); PG8_BAR;
    }
    for (;;) {
        const bool has_next = S.next(ui + 1, nxt);
        const char* nA = GATHER ? cA : (has_next ? (const char*)g.A + (size_t)nxt.pm * tstep : cA); const char* nB = has_next ? (const char*)g.Bt + (size_t)nxt.pn * tstep : cB;
        if constexpr (GATHER) { if (has_next) { const int* lst = S.a_list(nxt); const int nv = S.a_valid(nxt);
#pragma unroll
            for (int h = 0; h < 2; ++h)
#pragma unroll
                for (int i = 0; i < 2; ++i) { const int* pp = lst + min(h * HALF + rowA[i], nv - 1); asm volatile("global_load_dword %0, %1, off" : "=v"(tk[h][i]) : "v"(pp) : "memory"); } } }
        for (int t = 0; t < nt; t += 2) {
            const bool last = (t == nt - 2);
            const char* a1 = cA + (size_t)(t + 1) * kstep;
            const char* a2 = last ? nA : cA + (size_t)(t + 2) * kstep; const char* b2 = last ? nB : cB + (size_t)(t + 2) * kstep;
            const char* a3 = a2 + kstep; const char* b3 = b2 + kstep;
            if (last && has_next) S.a_ready(nxt);
            if constexpr (GATHER) { if (last && has_next) { asm volatile("" : "+v"(tk[0][0]), "+v"(tk[0][1]), "+v"(tk[1][0]), "+v"(tk[1][1]));
#pragma unroll
                for (int h = 0; h < 2; ++h)
#pragma unroll
                    for (int i = 0; i < 2; ++i) nOA[h][i] = (unsigned)tk[h][i] * (unsigned)(K * 2) + colA[i]; } }
            if constexpr (SP2) {
            PG8_LDB(B0, 0, 0); PG8_LDB(B1, 0, 1); PG8_SCHED; PG8_LDA(At, 0, 0); PG8_STAGE2(PG8_SA(1, 1), a1, oA[1][0], oA[1][1]);
            PG8_WAIT_V(8); PG8_WAIT_L(0); PG8_BAR; PG8_MMA(0, 0, At, B0); PG8_MMA(0, 1, At, B1); PG8_BAR; PG8_SCHED;
            PG8_LDA(At, 0, 1); PG8_STAGE(PG8_SB(0, 0), b2, voffB); PG8_STAGE(PG8_SB(0, 1), b2 + hstep, voffB); PG8_STAGE2(PG8_SA(0, 0), a2, PG8_OSEL(0, 0), PG8_OSEL(0, 1));
            PG8_WAIT_V(8); PG8_WAIT_L(0); PG8_BAR; PG8_MMA(1, 0, At, B0); PG8_MMA(1, 1, At, B1); PG8_BAR; PG8_SCHED;
            PG8_LDB(B0, 1, 0); PG8_LDB(B1, 1, 1); PG8_SCHED; PG8_LDA(At, 1, 0); PG8_STAGE2(PG8_SA(0, 1), a2, PG8_OSEL(1, 0), PG8_OSEL(1, 1));
            PG8_WAIT_V(8); PG8_WAIT_L(0); PG8_BAR; PG8_MMA(0, 0, At, B0); PG8_MMA(0, 1, At, B1); PG8_BAR; PG8_SCHED;
            PG8_LDA(At, 1, 1); PG8_STAGE(PG8_SB(1, 0), b3, voffB); PG8_STAGE(PG8_SB(1, 1), b3 + hstep, voffB); PG8_STAGE2(PG8_SA(1, 0), a3, PG8_OSEL(0, 0), PG8_OSEL(0, 1));
            PG8_WAIT_V(8); PG8_WAIT_L(0); PG8_BAR; PG8_MMA(1, 0, At, B0); PG8_MMA(1, 1, At, B1); PG8_BAR; PG8_SCHED;
            } else {
            PG8_LDB(B0, 0, 0); PG8_SCHED; PG8_LDA(At, 0, 0); PG8_STAGE(PG8_SA(1, 1), a1 + hstep, voffA);
            PG8_WAIT_L(8); PG8_BAR; PG8_WAIT_L(0); PG8_MMA(0, 0, At, B0); PG8_BAR; PG8_SCHED;
            PG8_LDB(B1, 0, 1); PG8_STAGE(PG8_SB(0, 0), b2, voffB);
            PG8_BAR; PG8_WAIT_L(0); PG8_MMA(0, 1, At, B1); PG8_BAR;
            PG8_LDA(At, 0, 1); PG8_STAGE(PG8_SA(0, 0), a2, voffA);
            PG8_BAR; PG8_WAIT_L(0); PG8_MMA(1, 0, At, B0); PG8_BAR; PG8_SCHED;
            PG8_STAGE(PG8_SB(0, 1), b2 + hstep, voffB);
            PG8_WAIT_V(6); PG8_BAR; PG8_MMA(1, 1, At, B1); PG8_BAR;
            PG8_LDB(B0, 1, 0); PG8_SCHED; PG8_LDA(At, 1, 0); PG8_STAGE(PG8_SA(0, 1), a2 + hstep, voffA);
            PG8_WAIT_L(8); PG8_BAR; PG8_WAIT_L(0); PG8_MMA(0, 0, At, B0); PG8_BAR; PG8_SCHED;
            PG8_LDB(B1, 1, 1); PG8_STAGE(PG8_SB(1, 0), b3, voffB);
            PG8_BAR; PG8_WAIT_L(0); PG8_MMA(0, 1, At, B1); PG8_BAR;
            PG8_LDA(At, 1, 1); PG8_STAGE(PG8_SA(1, 0), a3, voffA);
            PG8_BAR; PG8_WAIT_L(0); PG8_MMA(1, 0, At, B0); PG8_BAR; PG8_SCHED;
            PG8_STAGE(PG8_SB(1, 1), b3 + hstep, voffB);
            PG8_WAIT_V(6); PG8_BAR; PG8_MMA(1, 1, At, B1); PG8_BAR;
            }
        }
        if constexpr (FP8) asm volatile("s_nop 15\n\ts_nop 15" ::: "memory");
        if constexpr (ALIGN_EPI) { if (wr == 0) PG8_BAR; }
        if constexpr (!Epi::AFTER_DRAIN) { E(acc, cur, wr, wc, fr, fq); S.done(cur); }
        if (!has_next) break;
#pragma unroll
        for (int a = 0; a < 2; ++a)
#pragma unroll
            for (int b = 0; b < 2; ++b)
#pragma unroll
                for (int m = 0; m < 4; ++m)
#pragma unroll
                    for (int n = 0; n < 2; ++n) acc[a][b][m][n] = (f32x4){0.f, 0.f, 0.f, 0.f};
        cur = nxt; cA = nA; cB = nB; ++ui;
        if constexpr (GATHER) {
#pragma unroll
            for (int h = 0; h < 2; ++h)
#pragma unroll
                for (int i = 0; i < 2; ++i) oA[h][i] = nOA[h][i];
        }
        if constexpr (ALIGN_EPI) { if (wr == 1) PG8_BAR; }
    }
    PG8_WAIT_V(0);
    if constexpr (!ALIGN_EPI) { if (wr == 0) PG8_BAR; }
    PG8_BAR;
    if constexpr (Epi::AFTER_DRAIN) { E.fused(acc, cur, wr, wc, fr, fq, lds, wid, lane); S.done(cur); }
#undef PG8_SA
#undef PG8_OSEL
#undef PG8_STAGE2
#undef PG8_SB
#undef PG8_STAGE
#undef PG8_LDA
#undef PG8_LDB
#undef PG8_MMA
#undef PG8_WAIT_V
#undef PG8_WAIT_L
#undef PG8_BAR
#undef PG8_SCHED
}
}

#ifndef MK_N_LAUNCHES
#define MK_N_LAUNCHES 1
#endif
constexpr int N_PHASES = 10;
constexpr int NBATCH = 8, TT = 2048, MTOK = NBATCH * TT, D = 1024;
constexpr int HK = 512, NH = 4, DK = 128, DV = 128, CCH = 512, CLEN = 31, INC = 3584;
constexpr int NE = 32, TOPK = 4, FF = 1024;
constexpr float EPS = 1e-5f, SW_LIMIT = 7.0f, SW_ALPHA = 1.702f;
constexpr int NWAVES = 8, NTHR = 512;
constexpr int W1_ITEMS = 32 * 16 * 64, W1_P1 = 6144, W1_P2 = 3072, W1_P0 = W1_ITEMS - W1_P1 - W1_P2;
constexpr int MOE_ROWS = (MTOK * TOPK / 256 + NE) * 256;

constexpr size_t MiB = 1u << 20;
constexpr size_t WS_CTL = 0, CTL_ZERO_BYTES = 1 * MiB;
constexpr size_t WS_WI = 1 * MiB;
constexpr size_t WS_WO = 8 * MiB;
constexpr size_t WS_TAB = 10 * MiB;
constexpr size_t WS_W1 = 16 * MiB;
constexpr size_t WS_W2 = 144 * MiB;
constexpr size_t WS_H = 208 * MiB;
constexpr size_t WS_XN = 272 * MiB;
constexpr size_t WS_Q = 304 * MiB, WS_KF = 320 * MiB, WS_KB = 336 * MiB, WS_V = 352 * MiB, WS_G = 368 * MiB, WS_U = 384 * MiB;
constexpr size_t WS_LF = 400 * MiB, WS_LB = 432 * MiB;
constexpr size_t WS_OF = 464 * MiB, WS_OB = 496 * MiB;
constexpr size_t WS_MIX = 528 * MiB;
constexpr size_t WS_XS = 304 * MiB;
constexpr size_t WS_ACT = 448 * MiB;
constexpr size_t WS_YS = 592 * MiB;
constexpr size_t WS_END = 736 * MiB;
constexpr size_t WS_WRT = WS_TAB;
constexpr size_t WS_SLOT = WS_TAB + 256 * 1024;
constexpr size_t WS_GATE = WS_TAB + 512 * 1024;
constexpr size_t WS_ROWTOK = WS_TAB + 1 * MiB;
constexpr int CW_BAR = 4096;
constexpr int CW_CNT = 16384;

constexpr int RING_OFF = 0, RING_BYTES = 131072;
constexpr int LDSCTL_OFF = RING_BYTES;
constexpr int MISC_OFF = LDSCTL_OFF + 320;
constexpr int TAB_OFF = LDSCTL_OFF + 1024;
constexpr int SB_OFF = LDSCTL_OFF + 2048;
constexpr int LDS_BYTES = 147456;

#define GAS __attribute__((address_space(1)))
#define LAS __attribute__((address_space(3)))
typedef unsigned short bf16;
typedef unsigned v4u __attribute__((ext_vector_type(4)));
typedef unsigned v2u __attribute__((ext_vector_type(2)));
typedef float f32x4 __attribute__((ext_vector_type(4)));
typedef GAS unsigned gu32;
#define RLX_AGENT __ATOMIC_RELAXED, __HIP_MEMORY_SCOPE_AGENT
#define LDS_WAIT() asm volatile("s_waitcnt lgkmcnt(0)" ::: "memory")
#define VM_WAIT() asm volatile("s_waitcnt vmcnt(0)" ::: "memory")

__device__ __forceinline__ float bf2f(unsigned b) { return __uint_as_float(b << 16); }
__device__ __forceinline__ unsigned pk2(float lo, float hi) { return pg8::cvt_pk_bf16(lo, hi); }
__device__ __forceinline__ float sigm(float x) { return __builtin_amdgcn_rcpf(1.0f + __expf(-x)); }
__device__ __forceinline__ float wave_sum(float v) {
#pragma unroll
    for (int o = 1; o < 64; o <<= 1) v += __shfl_xor(v, o);
    return v;
}

constexpr float SC_W = 512.f, SC_N2 = 16.f, SC_ACT = 8.f;
__device__ __forceinline__ unsigned pk4_fp8(float a, float b, float c, float d) {
    a = fminf(fmaxf(a, -448.f), 448.f); b = fminf(fmaxf(b, -448.f), 448.f); c = fminf(fmaxf(c, -448.f), 448.f); d = fminf(fmaxf(d, -448.f), 448.f);
    int w = 0; w = __builtin_amdgcn_cvt_pk_fp8_f32(a, b, w, false); w = __builtin_amdgcn_cvt_pk_fp8_f32(c, d, w, true); return (unsigned)w;
}

#define XB_TMO      128
#define XB_XCNT(j)  (256  + 64 * (j))
#define XB_XSUB(j)  (1280 + 64 * (j))
#define XB_XGEN(j)  (2304 + 64 * (j))
#define XB_TOP      3328
#define XB_TOPGEN   3392
#define XCD_BAR_WORDS 3456
#define XB_SPIN_CAP (1u << 18)

__device__ __forceinline__ unsigned xb_ld(unsigned* p)              { return __hip_atomic_load(p, __ATOMIC_RELAXED, __HIP_MEMORY_SCOPE_AGENT); }
__device__ __forceinline__ unsigned xb_add(unsigned* p, unsigned v) { return __hip_atomic_fetch_add(p, v, __ATOMIC_RELAXED, __HIP_MEMORY_SCOPE_AGENT); }
__device__ __forceinline__ unsigned xb_xcc_id() { return (unsigned)__builtin_amdgcn_s_getreg((3 << 11) | 20) & 0xFu; }
#define XB_SPIN(cond, bar) do { unsigned _sp = 0; while (cond) { __builtin_amdgcn_s_sleep(1); \
    if ((++_sp & 255u) == 0u) { if (xb_ld(&(bar)[XB_TMO])) break; if (_sp > XB_SPIN_CAP) { atomicAdd(&(bar)[XB_TMO], 1u); break; } } } } while (0)

struct XcdBarrier {
    unsigned* bar; unsigned x;
    volatile LAS unsigned* st;
};
__device__ __forceinline__ XcdBarrier xcd_barrier_post(unsigned* bar, volatile LAS unsigned* st) {
    XcdBarrier b; b.bar = bar; b.x = xb_xcc_id(); b.st = st;
    if (threadIdx.x == 0) (void)xb_add(&bar[XB_XCNT(b.x)], 1u);
    return b;
}
__device__ __forceinline__ void xcd_barrier_complete(unsigned* bar, unsigned x, unsigned& nloc, unsigned& nx) {
    const unsigned G = gridDim.x * gridDim.y * gridDim.z;
    unsigned sum, cnt, mine, sp = 0u;
    for (;;) {
        sum = 0u; cnt = 0u; mine = 0u;
#pragma unroll
        for (unsigned j = 0; j < 16; ++j) { const unsigned c = xb_ld(&bar[XB_XCNT(j)]); sum += c; cnt += (c > 0u) ? 1u : 0u; mine = (j == x) ? c : mine; }
        if (sum == G) break;
        __builtin_amdgcn_s_sleep(1);
        if ((++sp & 255u) == 0u) { if (xb_ld(&bar[XB_TMO])) break; if (sp > XB_SPIN_CAP) { atomicAdd(&bar[XB_TMO], 1u); break; } }
    }
    nloc = mine > 0u ? mine : 1u; nx = cnt > 0u ? cnt : 1u;
}
__device__ __forceinline__ void xcd_barrier(const XcdBarrier& b) {
    asm volatile("s_waitcnt vmcnt(0)" ::: "memory");
    __syncthreads();
    if (threadIdx.x == 0) {
        unsigned* bar = b.bar;
        __builtin_amdgcn_s_waitcnt(0);
        unsigned nloc = b.st[0], nx = b.st[1];
        if (nloc == 0u) { xcd_barrier_complete(bar, b.x, nloc, nx); b.st[0] = nloc; b.st[1] = nx; }
        const unsigned old = xb_add(&bar[XB_XSUB(b.x)], 1u);
        const unsigned gen = old / nloc;
        if (old + 1u == (gen + 1u) * nloc) {
            __builtin_amdgcn_fence(__ATOMIC_RELEASE, "agent");
            asm volatile("s_waitcnt vmcnt(0)" ::: "memory");
            const unsigned og = xb_add(&bar[XB_TOP], 1u);
            const unsigned tg = og / nx;
            if (og + 1u == (tg + 1u) * nx) xb_add(&bar[XB_TOPGEN], 1u);
            else XB_SPIN(xb_ld(&bar[XB_TOPGEN]) == tg, bar);
            __builtin_amdgcn_fence(__ATOMIC_ACQUIRE, "agent");
            xb_add(&bar[XB_XGEN(b.x)], 1u);
            asm volatile("s_waitcnt vmcnt(0)" ::: "memory");
        } else {
            XB_SPIN(xb_ld(&bar[XB_XGEN(b.x)]) == gen, bar);
            __builtin_amdgcn_fence(__ATOMIC_ACQUIRE, "agent");
            asm volatile("s_waitcnt vmcnt(0)" ::: "memory");
        }
    }
    __syncthreads();
}

#ifndef WT_STORES
#define WT_STORES 0
#endif
__device__ __forceinline__ void st16(void* p, v4u w) {
#if WT_STORES
    asm volatile("global_store_dwordx4 %0, %1, off sc0 sc1\n\ts_nop 1" :: "v"(p), "v"(w) : "memory");
#else
    *(v4u*)p = w;
#endif
}
__device__ __forceinline__ void st8(void* p, v2u w) {
#if WT_STORES
    asm volatile("global_store_dwordx2 %0, %1, off sc0 sc1\n\ts_nop 1" :: "v"(p), "v"(w) : "memory");
#else
    *(v2u*)p = w;
#endif
}
__device__ __forceinline__ void st8bf(bf16* p, const f32x4& a, const f32x4& b) {
    v4u w; w.x = pk2(a[0], a[1]); w.y = pk2(a[2], a[3]); w.z = pk2(b[0], b[1]); w.w = pk2(b[2], b[3]);
    st16(p, w);
}
struct EpiProj {
    static constexpr bool PERM = true, AFTER_DRAIN = false;
    bf16 *Q, *KF, *KB, *V, *G, *U; float *LF, *LB; const float* lbl;
    template <int TYP>
    __device__ __forceinline__ void tile(const pg8::f32x4 (&acc)[2][2][4][2], int row0, int cb) const {
#pragma unroll
        for (int bj = 0; bj < 2; ++bj) {
            const int col = cb + bj * 128;
            float lb[8];
            if (TYP == 1 || TYP == 2) {
                const float* L = lbl + (TYP - 1) * 1024 + col;
#pragma unroll
                for (int i = 0; i < 8; ++i) lb[i] = __builtin_amdgcn_rcpf(1.0f + __expf(L[512 + i] - L[i]));
            }
#pragma unroll
            for (int ai = 0; ai < 2; ++ai)
#pragma unroll
                for (int m = 0; m < 4; ++m) {
                    const size_t off = (size_t)(row0 + ai * 128 + m * 16) * 512 + col;
                    f32x4 a = acc[ai][bj][m][0], b = acc[ai][bj][m][1];
                    if (TYP == 0 || TYP == 4) {
#pragma unroll
                        for (int i = 0; i < 4; ++i) { a[i] = a[i] * sigm(a[i]); b[i] = b[i] * sigm(b[i]); }
                        st8bf((TYP == 0 ? Q : G) + off, a, b);
                    } else if (TYP == 3) {
                        st8bf(V + off, a, b);
                    } else {
                        f32x4 la, lbv, ka, kb;
#pragma unroll
                        for (int i = 0; i < 4; ++i) {
                            const float fa = lb[i] + (1.0f - lb[i]) * sigm(a[i]), fb = lb[4 + i] + (1.0f - lb[4 + i]) * sigm(b[i]);
                            la[i] = __logf(fa); lbv[i] = __logf(fb); ka[i] = 1.0f - fa; kb[i] = 1.0f - fb;
                        }
                        float* Lp = (TYP == 1 ? LF : LB) + off;
                        st16(Lp, (v4u)la); st16(Lp + 4, (v4u)lbv);
                        st8bf((TYP == 1 ? KF : KB) + off, ka, kb);
                    }
                }
        }
    }
    __device__ __forceinline__ void operator()(const pg8::f32x4 (&acc)[2][2][4][2], const pg8::Unit& u, int wr, int wc, int fr, int fq) const {
        const int row0 = u.pm * 256 + wr * 64 + fr, pn = u.pn;
        if (pn >= 10) {
            const int col = (pn - 10) * 128 + wc * 32 + 8 * fq;
#pragma unroll
            for (int ai = 0; ai < 2; ++ai)
#pragma unroll
                for (int m = 0; m < 4; ++m) {
                    f32x4 a = acc[ai][0][m][0], b = acc[ai][0][m][1]; const f32x4 ga = acc[ai][1][m][0], gb = acc[ai][1][m][1];
#pragma unroll
                    for (int i = 0; i < 4; ++i) { a[i] = a[i] * sigm(ga[i]); b[i] = b[i] * sigm(gb[i]); }
                    st8bf(U + (size_t)(row0 + ai * 128 + m * 16) * 512 + col, a, b);
                }
        } else {
            const int cb = (pn & 1) * 256 + wc * 32 + 8 * fq, typ = pn >> 1;
            if (typ == 0) tile<0>(acc, row0, cb);
            else if (typ == 1) tile<1>(acc, row0, cb);
            else if (typ == 2) tile<2>(acc, row0, cb);
            else if (typ == 3) tile<3>(acc, row0, cb);
            else tile<4>(acc, row0, cb);
        }
    }
};
struct EpiRes {
    static constexpr bool PERM = false, AFTER_DRAIN = false;
    const float* X; float* H;
    __device__ __forceinline__ void operator()(const pg8::f32x4 (&acc)[2][2][4][2], const pg8::Unit& u, int wr, int wc, int fr, int fq) const {
        const int row0 = u.pm * 256 + wr * 64 + fr, col0 = u.pn * 256 + wc * 32 + 4 * fq;
#pragma unroll
        for (int ai = 0; ai < 2; ++ai)
#pragma unroll
            for (int m = 0; m < 4; ++m) {
                const size_t off = (size_t)(row0 + ai * 128 + m * 16) * D + col0;
#pragma unroll
                for (int bj = 0; bj < 2; ++bj)
#pragma unroll
                    for (int n = 0; n < 2; ++n) { const f32x4 xv = *(const f32x4*)(X + off + bj * 128 + n * 16); st16(H + off + bj * 128 + n * 16, (v4u)(xv + acc[ai][bj][m][n])); }
            }
    }
};
struct EpiSwiglu {
    static constexpr bool PERM = true, AFTER_DRAIN = false;
    unsigned char* ACT; const float* b1;
    __device__ __forceinline__ void operator()(const pg8::f32x4 (&acc)[2][2][4][2], const pg8::Unit& u, int wr, int wc, int fr, int fq) const {
        const int e = u.pn >> 3, pn = u.pn & 7, row0 = u.pm * 256 + wr * 64 + fr, col = pn * 128 + wc * 32 + 8 * fq;
        const float* bg = b1 + (size_t)e * 2048 + col; const float* bl = bg + 1024;
        float g[8], l[8];
#pragma unroll
        for (int i = 0; i < 8; ++i) { g[i] = bg[i]; l[i] = bl[i]; }
#pragma unroll
        for (int ai = 0; ai < 2; ++ai)
#pragma unroll
            for (int m = 0; m < 4; ++m) {
                f32x4 o[2];
#pragma unroll
                for (int n = 0; n < 2; ++n)
#pragma unroll
                    for (int i = 0; i < 4; ++i) {
                        const float hg = fminf(acc[ai][0][m][n][i] * (1.0f / (SC_N2 * SC_W)) + g[4 * n + i], SW_LIMIT);
                        const float hl = fminf(fmaxf(acc[ai][1][m][n][i] * (1.0f / (SC_N2 * SC_W)) + l[4 * n + i], -SW_LIMIT), SW_LIMIT);
                        o[n][i] = hg * sigm(SW_ALPHA * hg) * (hl + 1.0f) * SC_ACT;
                    }
                v2u w; w.x = pk4_fp8(o[0][0], o[0][1], o[0][2], o[0][3]); w.y = pk4_fp8(o[1][0], o[1][1], o[1][2], o[1][3]);
                st8(ACT + (size_t)(row0 + ai * 128 + m * 16) * FF + col, w);
            }
    }
};
struct EpiDown {
    static constexpr bool PERM = true, AFTER_DRAIN = false;
    bf16* YS; const float* b2;
    __device__ __forceinline__ void operator()(const pg8::f32x4 (&acc)[2][2][4][2], const pg8::Unit& u, int wr, int wc, int fr, int fq) const {
        const int e = u.pn >> 2, pn = u.pn & 3, row0 = u.pm * 256 + wr * 64 + fr, col0 = pn * 256 + wc * 32 + 8 * fq;
#pragma unroll
        for (int bj = 0; bj < 2; ++bj) {
            const float* bp = b2 + (size_t)e * D + col0 + bj * 128;
            const f32x4 b0 = *(const f32x4*)bp, b1v = *(const f32x4*)(bp + 4);
#pragma unroll
            for (int ai = 0; ai < 2; ++ai)
#pragma unroll
                for (int m = 0; m < 4; ++m)
                    st8bf(YS + (size_t)(row0 + ai * 128 + m * 16) * D + col0 + bj * 128, acc[ai][bj][m][0] * (1.0f / (SC_ACT * SC_W)) + b0, acc[ai][bj][m][1] * (1.0f / (SC_ACT * SC_W)) + b1v);
        }
    }
};
struct MoeOrder {
    const volatile LAS int* bs; int ntn, G, v; const volatile LAS int* cl; const int* rowtok;
    __device__ __forceinline__ const int* a_list(const pg8::Unit& u) const { const int e = u.pn / ntn; return rowtok + e * MTOK + (u.pm - bs[e]) * 256; }
    __device__ __forceinline__ int a_valid(const pg8::Unit& u) const { const int e = u.pn / ntn; return min(256, cl[e] - (u.pm - bs[e]) * 256); }
    __device__ __forceinline__ bool next(int i, pg8::Unit& u) const {
        const int L = i * G + v, nb = bs[32];
        if (L >= nb * ntn) return false;
        const int mb = L / ntn, pn = L - mb * ntn;
        const int ln = (int)(threadIdx.x & 63);
        const int e = __popcll(__ballot(ln < NE - 1 && bs[ln + 1] <= mb));
        u.pm = mb; u.pn = e * ntn + pn; return true;
    }
    __device__ __forceinline__ void a_ready(const pg8::Unit&) const {}
    __device__ __forceinline__ void done(const pg8::Unit&) const {}
};

#ifndef PROBE_DUP
#define PROBE_DUP -1
#endif
struct OrderRep : pg8::StaticOrder {
    int reps;
    __device__ __forceinline__ bool next(int i, pg8::Unit& u) const {
        const int per = (nwg + G - 1) / G, r = i / per;
        if (r >= reps) return false;
        return pg8::StaticOrder::next(i - r * per, u) ? true : ((r + 1 < reps) ? pg8::StaticOrder::next(0, u) : false);
    }
};
struct RmIdent { __device__ __forceinline__ int operator()(int n) const { return n; } };
struct RmWin {
    __device__ __forceinline__ int operator()(int n) const {
        if (n < 2560) return n;
        if (n < 3072) { const int j = n - 2560; return 2560 + (j >> 7) * 256 + (j & 127); }
        const int j = n - 3072; return 2560 + (j >> 7) * 256 + 128 + (j & 127);
    }
};
struct RmW1 {
    __device__ __forceinline__ int operator()(int n) const {
        if (n < 1024) return (n >> 7) * 256 + (n & 127);
        const int j = n - 1024; return (j >> 7) * 256 + 128 + (j & 127);
    }
};
template <bool FP8OUT, class RM>
__device__ __forceinline__ void p0_item(const float* W, int K, int N, void* WTv, RM rm, LAS float* scr, int item, int lane) {
    const int nblk = N / 32, kb = item / nblk, nb = item % nblk, k0 = 64 * kb, n0 = 32 * nb;
    const int r8 = lane >> 3, c4 = lane & 7;
    f32x4 v[8];
#pragma unroll
    for (int i = 0; i < 8; ++i) v[i] = *(const f32x4*)(W + (size_t)(k0 + 8 * i + r8) * N + n0 + 4 * c4);
#pragma unroll
    for (int i = 0; i < 8; ++i) *(LAS f32x4*)(scr + (8 * i + r8) * 36 + 4 * c4) = v[i];
    LDS_WAIT(); asm volatile("" ::: "memory");
    const int n = lane & 31, kh = lane >> 5; const LAS float* s = scr + (32 * kh) * 36 + n;
    if constexpr (FP8OUT) {
        unsigned w[8];
#pragma unroll
        for (int j = 0; j < 8; ++j) w[j] = pk4_fp8(s[(4 * j) * 36] * SC_W, s[(4 * j + 1) * 36] * SC_W, s[(4 * j + 2) * 36] * SC_W, s[(4 * j + 3) * 36] * SC_W);
        GAS v4u* dst = (GAS v4u*)((unsigned char*)WTv + (size_t)rm(n0 + n) * K + k0 + 32 * kh);
        dst[0] = (v4u){w[0], w[1], w[2], w[3]}; dst[1] = (v4u){w[4], w[5], w[6], w[7]};
    } else {
        unsigned w[16];
#pragma unroll
        for (int j = 0; j < 16; ++j) w[j] = pk2(s[(2 * j) * 36], s[(2 * j + 1) * 36]);
        GAS v4u* dst = (GAS v4u*)((bf16*)WTv + (size_t)rm(n0 + n) * K + k0 + 32 * kh);
#pragma unroll
        for (int q = 0; q < 4; ++q) dst[q] = (v4u){w[4 * q], w[4 * q + 1], w[4 * q + 2], w[4 * q + 3]};
    }
    LDS_WAIT(); asm volatile("" ::: "memory");
}
__device__ __forceinline__ void rms_row_to_bf16(const float* xrow, const float* w, bf16* orow, int lane) {
    const f32x4* xr = (const f32x4*)xrow + lane; const f32x4* wr = (const f32x4*)w + lane;
    f32x4 v[4]; float s = 0.f;
#pragma unroll
    for (int j = 0; j < 4; ++j) { v[j] = xr[64 * j]; s += (v[j].x * v[j].x + v[j].y * v[j].y) + (v[j].z * v[j].z + v[j].w * v[j].w); }
    const float rstd = rsqrtf(wave_sum(s) * (1.f / D) + EPS);
    v2u* o8 = (v2u*)orow + lane;
#pragma unroll
    for (int j = 0; j < 4; ++j) { const f32x4 g = wr[64 * j]; v2u o; o.x = pk2(v[j].x * rstd * g.x, v[j].y * rstd * g.y); o.y = pk2(v[j].z * rstd * g.z, v[j].w * rstd * g.w); o8[64 * j] = o; }
}


__device__ __forceinline__ pg8::bf16x8 lds_frag(const LAS unsigned char* p) { return *(const LAS pg8::bf16x8*)p; }
__device__ __forceinline__ pg8::bf16x8 mk_frag(v2u a, v2u b) { const v4u w = (v4u){a.x, a.y, b.x, b.y}; return (pg8::bf16x8)w; }
struct HgCtx {
    LAS unsigned char* lds; const bf16 *Qb, *Kp, *Vb; const float* Lp; float* Op;
    int b, h, dir, vh, lane, wave, lr, lq, dA, seg, tauB, dg;
    unsigned offA[16], offB, offV, ke_tr, v_tr;
};
constexpr int HG_BF = 0, HG_AM = 0, HG_QI = 33792, HG_KK = 51200, HG_KE = 68608, HG_V = 86016, HG_ST = 95232, HG_SEG = 112640, HG_DEC = 114688;
constexpr int HG_RSD = 272, HG_RSS = 144, HG_RSBF = 528;
__device__ __forceinline__ void hgrn_load(const HgCtx& c, int n, float (&lf)[16], v4u (&qB)[2], v4u (&kB)[2], v4u& vB) {
    const size_t cb = (size_t)__builtin_amdgcn_readfirstlane(c.b * TT + (c.dir ? (TT / 64 - 1 - n) * 64 : n * 64)) * 512 + c.h * 128;
    const float* Lc = c.Lp + cb; const bf16* Qc = c.Qb + cb; const bf16* Kc = c.Kp + cb; const bf16* Vc = c.Vb + cb;
#pragma unroll
    for (int i = 0; i < 16; ++i) lf[i] = Lc[c.offA[i]];
    qB[0] = *(const v4u*)(Qc + c.offB); qB[1] = *(const v4u*)(Qc + c.offB + 8); kB[0] = *(const v4u*)(Kc + c.offB); kB[1] = *(const v4u*)(Kc + c.offB + 8);
    vB = *(const v4u*)(Vc + c.offV);
}
__device__ __forceinline__ void hgrn_chunk(const HgCtx& c, int n, float (&lf)[16], v4u (&qB)[2], v4u (&kB)[2], v4u& vB, f32x4 (&S)[4]) {
    LAS unsigned char* lds = c.lds;
    const int dir = c.dir, lr = c.lr, lq = c.lq, wave = c.wave, dA = c.dA, seg = c.seg, tauB = c.tauB, dg = c.dg;
    const int tb = c.b * TT + (dir ? (TT / 64 - 1 - n) * 64 : n * 64);
    float bl[16]; { float cs = 0.f;
#pragma unroll
        for (int i = 0; i < 16; ++i) { cs += lf[i]; bl[i] = cs; }
        *(LAS float*)(lds + HG_SEG + (seg * 128 + dA) * 4) = cs; }
    __syncthreads();
    {
        const float p0 = *(LAS float*)(lds + HG_SEG + (0 * 128 + dA) * 4), p1 = *(LAS float*)(lds + HG_SEG + (1 * 128 + dA) * 4),
                    p2 = *(LAS float*)(lds + HG_SEG + (2 * 128 + dA) * 4), p3 = *(LAS float*)(lds + HG_SEG + (3 * 128 + dA) * 4);
        const float pre = (seg > 0 ? p0 : 0.f) + (seg > 1 ? p1 : 0.f) + (seg > 2 ? p2 : 0.f);
#pragma unroll
        for (int i = 0; i < 16; ++i) *(LAS float*)(lds + HG_BF + (16 * seg + i) * HG_RSBF + dA * 4) = pre + bl[i];
        if (seg == 0) *(LAS float*)(lds + HG_DEC + dA * 4) = __expf((p0 + p1) + (p2 + p3));
    }
    __syncthreads();
    {
        const unsigned qw[8] = {qB[0].x, qB[0].y, qB[0].z, qB[0].w, qB[1].x, qB[1].y, qB[1].z, qB[1].w};
        const unsigned kw[8] = {kB[0].x, kB[0].y, kB[0].z, kB[0].w, kB[1].x, kB[1].y, kB[1].z, kB[1].w};
        unsigned qo[8], ko[8], eo[8];
#pragma unroll
        for (int i = 0; i < 4; ++i) {
            const f32x4 bb = *(const LAS f32x4*)(lds + HG_BF + tauB * HG_RSBF + dg * 64 + i * 16);
            const f32x4 dc = *(const LAS f32x4*)(lds + HG_DEC + dg * 64 + i * 16);
#pragma unroll
            for (int j = 0; j < 2; ++j) {
                const float e0 = __expf(bb[2 * j]), e1 = __expf(bb[2 * j + 1]);
                const unsigned qq = qw[2 * i + j], kk = kw[2 * i + j];
                const float k0 = bf2f(kk & 0xffffu) * __builtin_amdgcn_rcpf(e0), k1 = bf2f(kk >> 16) * __builtin_amdgcn_rcpf(e1);
                qo[2 * i + j] = pk2(bf2f(qq & 0xffffu) * e0, bf2f(qq >> 16) * e1);
                ko[2 * i + j] = pk2(k0, k1);
                eo[2 * i + j] = pk2(k0 * dc[2 * j], k1 * dc[2 * j + 1]);
            }
        }
        *(LAS v4u*)(lds + HG_QI + tauB * HG_RSD + dg * 32) = (v4u){qo[0], qo[1], qo[2], qo[3]}; *(LAS v4u*)(lds + HG_QI + tauB * HG_RSD + dg * 32 + 16) = (v4u){qo[4], qo[5], qo[6], qo[7]};
        *(LAS v4u*)(lds + HG_KK + tauB * HG_RSD + dg * 32) = (v4u){ko[0], ko[1], ko[2], ko[3]}; *(LAS v4u*)(lds + HG_KK + tauB * HG_RSD + dg * 32 + 16) = (v4u){ko[4], ko[5], ko[6], ko[7]};
        *(LAS v4u*)(lds + HG_KE + tauB * HG_RSD + dg * 32) = (v4u){eo[0], eo[1], eo[2], eo[3]}; *(LAS v4u*)(lds + HG_KE + tauB * HG_RSD + dg * 32 + 16) = (v4u){eo[4], eo[5], eo[6], eo[7]};
        *(LAS v4u*)(lds + HG_V + tauB * HG_RSS + dg * 16) = vB;
    }
    __syncthreads();
    if (n + 2 < TT / 64) hgrn_load(c, n + 2, lf, qB, kB, vB);
    const int ei = wave & 3, tp = wave >> 2;
    v2u ket[2][2], vt[4][2][2];
    asm volatile("ds_read_b64_tr_b16 %0, %4\n\tds_read_b64_tr_b16 %1, %4 offset:1088\n\tds_read_b64_tr_b16 %2, %4 offset:8704\n\tds_read_b64_tr_b16 %3, %4 offset:9792"
                 : "=&v"(ket[0][0]), "=&v"(ket[0][1]), "=&v"(ket[1][0]), "=&v"(ket[1][1]) : "v"(c.ke_tr) : "memory");
#define HG_VTR(e4, o0, o1, o2, o3) asm volatile("ds_read_b64_tr_b16 %0, %4 offset:" #o0 "\n\tds_read_b64_tr_b16 %1, %4 offset:" #o1 "\n\tds_read_b64_tr_b16 %2, %4 offset:" #o2 "\n\tds_read_b64_tr_b16 %3, %4 offset:" #o3 \
                 : "=&v"(vt[e4][0][0]), "=&v"(vt[e4][0][1]), "=&v"(vt[e4][1][0]), "=&v"(vt[e4][1][1]) : "v"(c.v_tr) : "memory")
    HG_VTR(0, 0, 576, 4608, 5184); HG_VTR(1, 32, 608, 4640, 5216); HG_VTR(2, 64, 640, 4672, 5248); HG_VTR(3, 96, 672, 4704, 5280);
#undef HG_VTR
    {
        const int ti = wave & 3;
#pragma unroll
        for (int sii = 0; sii < 2; ++sii) {
            const int si = tp * 2 + sii;
            v2u w = (v2u){0u, 0u};
            if (si <= ti) {
                f32x4 a = (f32x4){0.f, 0.f, 0.f, 0.f};
#pragma unroll
                for (int kk = 0; kk < 4; ++kk)
                    a = __builtin_amdgcn_mfma_f32_16x16x32_bf16(lds_frag(lds + HG_KK + (16 * si + lr) * HG_RSD + kk * 64 + lq * 16), lds_frag(lds + HG_QI + (16 * ti + lr) * HG_RSD + kk * 64 + lq * 16), a, 0, 0, 0);
                const int s0 = 16 * si + 4 * lq, t = 16 * ti + lr;
                w.x = pk2(s0 + 0 <= t ? a[0] : 0.f, s0 + 1 <= t ? a[1] : 0.f); w.y = pk2(s0 + 2 <= t ? a[2] : 0.f, s0 + 3 <= t ? a[3] : 0.f);
            }
            *(LAS v2u*)(lds + HG_AM + (16 * ti + lr) * HG_RSS + (16 * si + 4 * lq) * 2) = w;
        }
    }
    f32x4 o[2];
#pragma unroll
    for (int tt = 0; tt < 2; ++tt) {
        o[tt] = (f32x4){0.f, 0.f, 0.f, 0.f};
#pragma unroll
        for (int kk = 0; kk < 4; ++kk)
            o[tt] = __builtin_amdgcn_mfma_f32_16x16x32_bf16(lds_frag(lds + HG_ST + (16 * ei + lr) * HG_RSD + kk * 64 + lq * 16), lds_frag(lds + HG_QI + (16 * (2 * tp + tt) + lr) * HG_RSD + kk * 64 + lq * 16), o[tt], 0, 0, 0);
    }
    asm volatile("s_waitcnt lgkmcnt(0)"
                 : "+v"(ket[0][0]), "+v"(ket[0][1]), "+v"(ket[1][0]), "+v"(ket[1][1]),
                   "+v"(vt[0][0][0]), "+v"(vt[0][0][1]), "+v"(vt[0][1][0]), "+v"(vt[0][1][1]), "+v"(vt[1][0][0]), "+v"(vt[1][0][1]), "+v"(vt[1][1][0]), "+v"(vt[1][1][1]),
                   "+v"(vt[2][0][0]), "+v"(vt[2][0][1]), "+v"(vt[2][1][0]), "+v"(vt[2][1][1]), "+v"(vt[3][0][0]), "+v"(vt[3][0][1]), "+v"(vt[3][1][0]), "+v"(vt[3][1][1]) :: "memory");
    {
        const f32x4 dv = *(const LAS f32x4*)(lds + HG_DEC + (16 * wave + 4 * lq) * 4);
#pragma unroll
        for (int e4 = 0; e4 < 4; ++e4) S[e4] = S[e4] * dv;
#pragma unroll
        for (int kk = 0; kk < 2; ++kk) {
            const pg8::bf16x8 af = mk_frag(ket[kk][0], ket[kk][1]);
#pragma unroll
            for (int e4 = 0; e4 < 4; ++e4) S[e4] = __builtin_amdgcn_mfma_f32_16x16x32_bf16(af, mk_frag(vt[e4][kk][0], vt[e4][kk][1]), S[e4], 0, 0, 0);
        }
    }
    const pg8::bf16x8 vf0 = ei == 0 ? mk_frag(vt[0][0][0], vt[0][0][1]) : ei == 1 ? mk_frag(vt[1][0][0], vt[1][0][1]) : ei == 2 ? mk_frag(vt[2][0][0], vt[2][0][1]) : mk_frag(vt[3][0][0], vt[3][0][1]);
    const pg8::bf16x8 vf1 = ei == 0 ? mk_frag(vt[0][1][0], vt[0][1][1]) : ei == 1 ? mk_frag(vt[1][1][0], vt[1][1][1]) : ei == 2 ? mk_frag(vt[2][1][0], vt[2][1][1]) : mk_frag(vt[3][1][0], vt[3][1][1]);
    __syncthreads();
#pragma unroll
    for (int tt = 0; tt < 2; ++tt) {
        o[tt] = __builtin_amdgcn_mfma_f32_16x16x32_bf16(vf0, lds_frag(lds + HG_AM + (16 * (2 * tp + tt) + lr) * HG_RSS + 0 * 64 + lq * 16), o[tt], 0, 0, 0);
        o[tt] = __builtin_amdgcn_mfma_f32_16x16x32_bf16(vf1, lds_frag(lds + HG_AM + (16 * (2 * tp + tt) + lr) * HG_RSS + 1 * 64 + lq * 16), o[tt], 0, 0, 0);
        const int t = 16 * (2 * tp + tt) + lr;
        *(f32x4*)(c.Op + (size_t)(dir ? tb + 63 - t : tb + t) * 512 + c.h * 128 + c.vh * 64 + 16 * ei + 4 * lq) = o[tt];
    }
#pragma unroll
    for (int e4 = 0; e4 < 4; ++e4) { v2u w; w.x = pk2(S[e4][0], S[e4][1]); w.y = pk2(S[e4][2], S[e4][3]); *(LAS v2u*)(lds + HG_ST + (16 * e4 + lr) * HG_RSD + (16 * wave + 4 * lq) * 2) = w; }
}
__device__ __forceinline__ void hgrn_unit(LAS unsigned char* lds, int unit, const bf16* Qb, const bf16* KFb, const bf16* KBb, const bf16* Vb, const float* LFb, const float* LBb,
                                          float* OFb, float* OBb, int tid, int lane, int wave) {
    HgCtx c;
    c.lds = lds; c.vh = unit & 1; c.dir = (unit >> 1) & 1; c.h = (unit >> 2) & 3; c.b = unit >> 4;
    c.Qb = Qb; c.Vb = Vb; c.Kp = c.dir ? KBb : KFb; c.Lp = c.dir ? LBb : LFb; c.Op = c.dir ? OBb : OFb;
    c.lane = lane; c.wave = wave; c.lr = lane & 15; c.lq = lane >> 4;
    c.dA = tid & 127; c.seg = tid >> 7;
    c.tauB = tid >> 3; c.dg = tid & 7;
    for (int i = tid; i < 64 * HG_RSD / 16; i += NTHR) *(LAS v4u*)(lds + HG_ST + i * 16) = (v4u){0u, 0u, 0u, 0u};
    f32x4 S[4];
#pragma unroll
    for (int i = 0; i < 4; ++i) S[i] = (f32x4){0.f, 0.f, 0.f, 0.f};
#pragma unroll
    for (int i = 0; i < 16; ++i) { const int tau = 16 * c.seg + i; c.offA[i] = (unsigned)((c.dir ? 63 - tau : tau) * 512 + c.dA); }
    c.offB = (unsigned)((c.dir ? 63 - c.tauB : c.tauB) * 512 + 16 * c.dg); c.offV = (unsigned)((c.dir ? 63 - c.tauB : c.tauB) * 512 + c.vh * 64 + 8 * c.dg);
    const unsigned trrow = (unsigned)(8 * c.lq + ((lane & 15) >> 2)), trcol = (unsigned)(4 * (lane & 3));
    c.ke_tr = (unsigned)(size_t)(lds + HG_KE) + trrow * HG_RSD + (16 * wave + trcol) * 2;
    c.v_tr = (unsigned)(size_t)(lds + HG_V) + trrow * HG_RSS + trcol * 2;
    float lf0[16], lf1[16]; v4u qB0[2], kB0[2], vB0, qB1[2], kB1[2], vB1;
    hgrn_load(c, 0, lf0, qB0, kB0, vB0); hgrn_load(c, 1, lf1, qB1, kB1, vB1);
#pragma unroll 1
    for (int n = 0; n < TT / 64; n += 2) { hgrn_chunk(c, n, lf0, qB0, kB0, vB0, S); hgrn_chunk(c, n + 1, lf1, qB1, kB1, vB1, S); }
    __syncthreads();
}

__device__ __forceinline__ void router_finish(float (&a)[NE], int m, int lane, const float* router_b, LAS int* lcnt, LAS unsigned* sbw, float* GATE) {
#define RF_STEP(s2, n) { const bool up = (lane & (s2)) != 0; _Pragma("unroll") for (int i = 0; i < (n); ++i) { const float k1 = up ? a[i + (n)] : a[i], x1 = up ? a[i] : a[i + (n)]; a[i] = k1 + __shfl_xor(x1, (s2)); } }
    RF_STEP(32, 16) RF_STEP(16, 8) RF_STEP(8, 4) RF_STEP(4, 2) RF_STEP(2, 1)
#undef RF_STEP
    float lg = a[0] + __shfl_xor(a[0], 1);
    const int myE = lane >> 1;
    lg += router_b[myE];
    float tv[TOPK]; int ti[TOPK];
#pragma unroll
    for (int k = 0; k < TOPK; ++k) {
        float mx = lg;
#pragma unroll
        for (int o = 1; o < 64; o <<= 1) mx = fmaxf(mx, __shfl_xor(mx, o));
        int cand = (lg == mx) ? myE : 99;
#pragma unroll
        for (int o = 1; o < 64; o <<= 1) cand = min(cand, __shfl_xor(cand, o));
        tv[k] = mx; ti[k] = cand;
        if (myE == cand) lg = -INFINITY;
    }
    const float e1 = __expf(tv[1] - tv[0]), e2 = __expf(tv[2] - tv[0]), e3 = __expf(tv[3] - tv[0]);
    const float inv = 1.0f / (1.0f + e1 + e2 + e3);
    if (lane < TOPK && m < MTOK) {
        const int ek = lane == 0 ? ti[0] : lane == 1 ? ti[1] : lane == 2 ? ti[2] : ti[3];
        const float gk = (lane == 0 ? 1.0f : lane == 1 ? e1 : lane == 2 ? e2 : e3) * inv;
        const int lr = __hip_atomic_fetch_add(&lcnt[ek], 1, __ATOMIC_RELAXED, __HIP_MEMORY_SCOPE_WORKGROUP);
        sbw[lane] = ((unsigned)ek << 16) | (unsigned)lr;
        GATE[(size_t)m * TOPK + lane] = gk;
    }
}
#define W1_ITEM(r_) do { const int r__ = (r_); const int e__ = r__ >> 10; p0_item<true>(w1 + (size_t)e__ * D * 2 * FF, D, 2 * FF, W1T + (size_t)e__ * 2 * FF * D, RmW1(), scr, r__ & 1023, lane); } while (0)

struct Args { const float* in[18]; float* out; unsigned char* ws; int ph_lo, ph_hi; };
__global__ void __launch_bounds__(NTHR, 2) fwd_kernel(Args args) {
    extern __shared__ __attribute__((aligned(16))) unsigned char lds_raw[];
    LAS unsigned char* lds = (LAS unsigned char*)lds_raw;
    volatile LAS unsigned* MISC = (volatile LAS unsigned*)(lds + MISC_OFF);
    const int tid = threadIdx.x, lane = tid & 63, wave = __builtin_amdgcn_readfirstlane(tid >> 6);
    const int G = gridDim.x; const int bx = blockIdx.x; const int vcu = (G % 8 == 0) ? (bx % 8) * (G / 8) + bx / 8 : bx;
    const int gw = vcu * NWAVES + wave, NGW = G * NWAVES;
    unsigned char* ws = args.ws;
    unsigned* ctl = (unsigned*)(ws + WS_CTL);
    const float* x = args.in[0]; const float* norm1_w = args.in[1]; const float* w_in = args.in[2]; const float* lb_logits = args.in[3];
    const float* hgrn_norm_w = args.in[4]; const float* dw_w = args.in[5]; const float* dw_b = args.in[6]; const float* conv_ln_w = args.in[7]; const float* conv_ln_b = args.in[8];
    const float* w_out = args.in[9]; const float* norm2_w = args.in[10]; const float* router_w = args.in[11]; const float* router_b = args.in[12];
    const float* w1 = args.in[13]; const float* b1 = args.in[14]; const float* w2 = args.in[15]; const float* b2 = args.in[16]; const float* final_norm_w = args.in[17];
    float* out = args.out;
    bf16* WI = (bf16*)(ws + WS_WI); bf16* WO = (bf16*)(ws + WS_WO); unsigned char* W1T = ws + WS_W1; unsigned char* W2T = ws + WS_W2;
    float* H = (float*)(ws + WS_H); bf16* XN = (bf16*)(ws + WS_XN);
    bf16* Qb = (bf16*)(ws + WS_Q); bf16* KFb = (bf16*)(ws + WS_KF); bf16* KBb = (bf16*)(ws + WS_KB); bf16* Vb = (bf16*)(ws + WS_V); bf16* Gb = (bf16*)(ws + WS_G); bf16* Ub = (bf16*)(ws + WS_U);
    float* LFb = (float*)(ws + WS_LF); float* LBb = (float*)(ws + WS_LB); float* OFb = (float*)(ws + WS_OF); float* OBb = (float*)(ws + WS_OB);
    bf16* MIX = (bf16*)(ws + WS_MIX); unsigned char* XS = ws + WS_XS; unsigned char* ACT = ws + WS_ACT; unsigned char* N2 = ws + WS_XN; bf16* YS = (bf16*)(ws + WS_YS);
    float* WRT = (float*)(ws + WS_WRT); int* SLOT = (int*)(ws + WS_SLOT); float* GATE = (float*)(ws + WS_GATE); int* ROWTOK = (int*)(ws + WS_ROWTOK);
    volatile LAS int* bs = (volatile LAS int*)(lds + TAB_OFF);
    volatile LAS int* cl = (volatile LAS int*)(lds + TAB_OFF + 256);
    LAS int* lcnt = (LAS int*)(lds + TAB_OFF + 512);
    volatile LAS int* gbase = (volatile LAS int*)(lds + TAB_OFF + 768);

    for (int u = tid; u < (LDS_BYTES - LDSCTL_OFF) / 4; u += NTHR) ((LAS unsigned*)(lds + LDSCTL_OFF))[u] = 0u;
    __syncthreads();
    XcdBarrier bar; bar.bar = ctl + CW_BAR; bar.x = 0; bar.st = nullptr;
    if (MK_N_LAUNCHES == 1) bar = xcd_barrier_post(ctl + CW_BAR, MISC + 8);
    const int lo = args.ph_lo, hi = args.ph_hi;
#ifndef PHASE_MASK
#define PHASE_MASK 0xffffffffu
#endif
#define IN(k) ((((PHASE_MASK) >> (k)) & 1u) && lo <= (k) && (k) < hi)
#ifndef PROBE_DUP
#define PROBE_DUP -1
#endif
#define REP(k) _Pragma("unroll 1") for (int rep_ = 0; rep_ < ((PROBE_DUP) == (k) ? 2 + (args.ph_hi >> 20) : 1); ++rep_)
#define SEAM(k) do { if (IN(k) && IN((k) + 1)) { xcd_barrier(bar); if ((PROBE_DUP) == 99) { xcd_barrier(bar); xcd_barrier(bar); } } } while (0)
#define BUILD_BS() do { if (tid < 64) { const int c_ = tid < NE ? (int)__hip_atomic_load(ctl + CW_CNT + 64 * (tid & (NE - 1)), RLX_AGENT) : 0; int x_ = (c_ + 255) >> 8; \
        _Pragma("unroll") for (int o_ = 1; o_ < NE; o_ <<= 1) { const int y_ = __shfl_up(x_, o_); if (lane >= o_) x_ += y_; }     \
        if (tid < NE) { cl[tid] = c_; bs[tid + 1] = x_; } if (tid == 0) bs[0] = 0; } __syncthreads(); } while (0)

    if (IN(0)) REP(0) {
        LAS float* scr = (LAS float*)(lds + RING_OFF + wave * 16384);
        constexpr int I_WI = (D / 64) * (INC / 32), I_WO = (D / 64) * (D / 32), I_W1 = (D / 64) * (2 * FF / 32), I_W2 = (FF / 64) * (D / 32);
        #if defined(HGRN_NAIVE) || defined(W2_IN_P0)
        constexpr int NITEMS = I_WI + I_WO + NE * I_W1 + NE * I_W2;
#else
        constexpr int NITEMS = I_WI + I_WO + W1_P0;
#endif
        for (int it = gw; it < NITEMS; it += NGW) {
            int r = it;
            if (r < I_WI) { p0_item<false>(w_in, D, INC, WI, RmWin(), scr, r, lane); continue; } r -= I_WI;
            if (r < I_WO) { p0_item<false>(w_out, D, D, WO, RmIdent(), scr, r, lane); continue; } r -= I_WO;
            if (r < NE * I_W1) { W1_ITEM(r); continue; } r -= NE * I_W1;
#if defined(HGRN_NAIVE) || defined(W2_IN_P0)
            { const int e = r / I_W2; p0_item<true>(w2 + (size_t)e * FF * D, FF, D, W2T + (size_t)e * D * FF, RmIdent(), scr, r - e * I_W2, lane); }
#endif
        }
        for (int m = gw; m < MTOK; m += NGW) rms_row_to_bf16(x + (size_t)m * D, norm1_w, XN + (size_t)m * D, lane);
        for (int i = bx * NTHR + tid; i < 16 * D; i += G * NTHR) {
            const int r = i >> 4, e16 = i & 15, k = 256 * (r & 3) + (r >> 2); const float gk = norm2_w[k];
            WRT[2 * i] = gk * router_w[k * NE + e16]; WRT[2 * i + 1] = gk * router_w[k * NE + 16 + e16]; }
    }
    SEAM(0);

    if (IN(1)) REP(1) {
        pg8::Gemm g{XN, WI, MTOK, INC, D}; OrderRep S; S.init(MTOK, INC, G, bx); S.reps = ((PROBE_DUP) == 11) ? 2 : 1;
        EpiProj E{Qb, KFb, KBb, Vb, Gb, Ub, LFb, LBb, lb_logits};
        pg8::gemm_phase<EpiProj, OrderRep, true, true>(lds + RING_OFF, g, S, E);
#if !defined(HGRN_NAIVE) && !defined(W2_IN_P0)
        if (G == 256 && bx >= 128) {
            LAS float* scr = (LAS float*)(lds + RING_OFF + wave * 16384);
            for (int it = (bx - 128) * NWAVES + wave; it < W1_P1; it += 128 * NWAVES) W1_ITEM(W1_P0 + it);
        } else if (G != 256) {
            LAS float* scr = (LAS float*)(lds + RING_OFF + wave * 16384);
            for (int it = gw; it < W1_P1; it += NGW) W1_ITEM(W1_P0 + it);
        }
#endif
    }
    SEAM(1);

    if (IN(2)) REP(2) {
        const bool split = (G == 256);
#if defined(HGRN_NAIVE)
        const bool hsel = true; const int hidx = 0, hstride = 1; const bool csel = true; const int cidx = vcu, cstride = G;
#else
        const bool hsel = split ? (((bx >> 3) & 1) != 0) : true; const int hidx = split ? (bx >> 4) * 8 + (bx & 7) : bx, hstride = split ? 128 : G;
        const bool csel = split ? !hsel : true; const int cidx = split ? (bx >> 4) * 8 + (bx & 7) : bx, cstride = split ? 128 : G;
#endif
        (void)hidx; (void)hstride;
        if (csel) for (int crep_ = 0; crep_ < ((PROBE_DUP) == 21 ? 2 : 1); ++crep_) {
            LAS unsigned short* ut = (LAS unsigned short*)(lds + RING_OFF);
            LAS float* part = (LAS float*)(lds + RING_OFF + 98304);
            LAS float* stat = (LAS float*)(lds + RING_OFF + 98304 + 4096);
            for (int unit = cidx; unit < NBATCH * (TT / 64); unit += cstride) {
                const int b = unit / (TT / 64), t0 = (unit % (TT / 64)) * 64;
                for (int idx = tid; idx < 94 * 64; idx += NTHR) {
                    const int r = idx >> 6, p = idx & 63, t = t0 - 15 + r;
                    v4u val = (v4u){0u, 0u, 0u, 0u};
                    if (t >= 0 && t < TT) val = *(const v4u*)(Ub + (size_t)(b * TT + t) * CCH + p * 8);
                    *(LAS v4u*)(ut + r * 512 + p * 8) = val;
                }
                __syncthreads();
                const int c = tid;
                float w[CLEN];
#pragma unroll
                for (int j = 0; j < CLEN; ++j) w[j] = dw_w[j * CCH + c];
                const float bias = dw_b[c];
                float y[64];
#pragma unroll
                for (int tb = 0; tb < 8; ++tb) {
                    float win[38];
#pragma unroll
                    for (int i = 0; i < 38; ++i) win[i] = bf2f(ut[(tb * 8 + i) * 512 + c]);
#pragma unroll
                    for (int o = 0; o < 8; ++o) { float a = bias;
#pragma unroll
                        for (int j = 0; j < CLEN; ++j) a += w[j] * win[o + j];
                        y[tb * 8 + o] = a; }
                }
#pragma unroll 1
                for (int pass = 0; pass < 2; ++pass) {
                    float s1[64];
#pragma unroll
                    for (int i = 0; i < 64; ++i) s1[i] = pass ? y[i] * y[i] : y[i];
#pragma unroll
                    for (int s = 32; s >= 1; s >>= 1) {
                        const bool up = (lane & s) != 0;
#pragma unroll
                        for (int i = 0; i < s; ++i) { const float k1 = up ? s1[i + s] : s1[i], x1 = up ? s1[i] : s1[i + s]; s1[i] = k1 + __shfl_xor(x1, s); }
                    }
                    part[(wave * 64 + lane) * 2 + pass] = s1[0];
                }
                __syncthreads();
                if (tid < 64) { float a = 0.f, q = 0.f;
#pragma unroll
                    for (int wv = 0; wv < 8; ++wv) { a += part[(wv * 64 + tid) * 2]; q += part[(wv * 64 + tid) * 2 + 1]; }
                    const float mean = a * (1.f / CCH), var = q * (1.f / CCH) - mean * mean;
                    stat[tid * 2] = mean; stat[tid * 2 + 1] = rsqrtf(fmaxf(var, 0.f) + EPS); }
                __syncthreads();
                const float lw = conv_ln_w[c], lbias = conv_ln_b[c];
#pragma unroll
                for (int t = 0; t < 64; ++t) {
                    const float v = (y[t] - stat[t * 2]) * stat[t * 2 + 1] * lw + lbias;
                    MIX[(size_t)(b * TT + t0 + t) * D + 512 + c] = (bf16)(pk2(v * sigm(v), 0.f) & 0xffffu);
                }
                __syncthreads();
            }
#if !defined(HGRN_NAIVE) && !defined(W2_IN_P0)
            {
                LAS float* scr = (LAS float*)(lds + RING_OFF + wave * 16384);
                constexpr int I_W2 = (FF / 64) * (D / 32);
                for (int it = cidx * NWAVES + wave; it < NE * I_W2; it += cstride * NWAVES) { const int e = it / I_W2;
                    p0_item<true>(w2 + (size_t)e * FF * D, FF, D, W2T + (size_t)e * D * FF, RmIdent(), scr, it - e * I_W2, lane); }
                for (int it = cidx * NWAVES + wave; it < W1_P2; it += cstride * NWAVES) W1_ITEM(W1_P0 + W1_P1 + it);
            }
#endif
        }
#if defined(HGRN_NAIVE)
        {
            LAS float* qs = (LAS float*)(lds + RING_OFF); LAS float* ks = qs + 2048; LAS float* fs = ks + 2048; LAS float* vs = fs + 2048; LAS float* op = vs + 2048;
            const int e = tid & 127, dq = tid >> 7;
            for (int unit = G - 1 - bx; unit < NBATCH * NH * 2; unit += G) {
                const int dir = unit & 1, h = (unit >> 1) & 3, b = unit >> 3;
                const bf16* Kp = dir ? KBb : KFb; const float* Lp = dir ? LBb : LFb; float* Op = dir ? OBb : OFb;
                float S[32];
#pragma unroll
                for (int i = 0; i < 32; ++i) S[i] = 0.f;
                for (int blk = 0; blk < TT / 16; ++blk) {
                    const int tb = dir ? (TT - 16 - blk * 16) : blk * 16;
#pragma unroll
                    for (int i = 0; i < 4; ++i) { const int idx = tid + NTHR * i, r = idx >> 7, d = idx & 127; const size_t off = (size_t)(b * TT + tb + r) * 512 + h * 128 + d;
                        qs[idx] = bf2f(Qb[off]); ks[idx] = bf2f(Kp[off]); fs[idx] = __expf(Lp[off]); vs[idx] = bf2f(Vb[off]); }
                    __syncthreads();
                    for (int st = 0; st < 16; ++st) {
                        const int r = dir ? 15 - st : st; const float v = vs[r * 128 + e]; float o = 0.f;
#pragma unroll
                        for (int dd = 0; dd < 32; ++dd) { const int d = dq * 32 + dd; S[dd] = fs[r * 128 + d] * S[dd] + ks[r * 128 + d] * v; o += qs[r * 128 + d] * S[dd]; }
                        op[(r * 4 + dq) * 128 + e] = o;
                    }
                    __syncthreads();
#pragma unroll
                    for (int i = 0; i < 4; ++i) { const int idx = tid + NTHR * i, r = idx >> 7, ee = idx & 127;
                        Op[(size_t)(b * TT + tb + r) * 512 + h * 128 + ee] = (op[(r * 4 + 0) * 128 + ee] + op[(r * 4 + 1) * 128 + ee]) + (op[(r * 4 + 2) * 128 + ee] + op[(r * 4 + 3) * 128 + ee]); }
                }
                __syncthreads();
            }
        }
#else
        if (hsel) for (int hrep_ = 0; hrep_ < ((PROBE_DUP) == 20 ? 2 : 1); ++hrep_) for (int unit = hidx; unit < NBATCH * NH * 4; unit += hstride) hgrn_unit(lds + RING_OFF, unit, Qb, KFb, KBb, Vb, LFb, LBb, OFb, OBb, tid, lane, wave);
#endif
    }
    SEAM(2);

    if (IN(3)) REP(3) {
        for (int m = gw; m < MTOK; m += NGW) {
            const size_t off = (size_t)m * 512 + lane * 8;
            const f32x4 a0 = *(const f32x4*)(OFb + off), a1 = *(const f32x4*)(OFb + off + 4), c0 = *(const f32x4*)(OBb + off), c1 = *(const f32x4*)(OBb + off + 4);
            const f32x4 o0 = a0 + c0, o1 = a1 + c1;
            float ss = (o0.x * o0.x + o0.y * o0.y) + (o0.z * o0.z + o0.w * o0.w) + (o1.x * o1.x + o1.y * o1.y) + (o1.z * o1.z + o1.w * o1.w);
            ss += __shfl_xor(ss, 1); ss += __shfl_xor(ss, 2); ss += __shfl_xor(ss, 4); ss += __shfl_xor(ss, 8);
            const float rstd = rsqrtf(ss * (1.f / DV) + EPS);
            const v4u gv = *(const v4u*)(Gb + off);
            const f32x4 w0 = *(const f32x4*)(hgrn_norm_w + lane * 8), w1v = *(const f32x4*)(hgrn_norm_w + lane * 8 + 4);
            f32x4 r0, r1;
            r0.x = o0.x * rstd * w0.x * bf2f(gv.x & 0xffffu); r0.y = o0.y * rstd * w0.y * bf2f(gv.x >> 16);
            r0.z = o0.z * rstd * w0.z * bf2f(gv.y & 0xffffu); r0.w = o0.w * rstd * w0.w * bf2f(gv.y >> 16);
            r1.x = o1.x * rstd * w1v.x * bf2f(gv.z & 0xffffu); r1.y = o1.y * rstd * w1v.y * bf2f(gv.z >> 16);
            r1.z = o1.z * rstd * w1v.z * bf2f(gv.w & 0xffffu); r1.w = o1.w * rstd * w1v.w * bf2f(gv.w >> 16);
            st8bf(MIX + (size_t)m * D + lane * 8, r0, r1);
        }
    }
    SEAM(3);

    if (IN(4)) REP(4) {
        pg8::Gemm g{MIX, WO, MTOK, D, D}; pg8::StaticOrder S; S.init(MTOK, D, G, bx);
        EpiRes E{x, H};
        pg8::gemm_phase<EpiRes, pg8::StaticOrder, true, true>(lds + RING_OFF, g, S, E);
    }
    SEAM(4);

    if (IN(5)) REP(5) {
        typedef float f32x2 __attribute__((ext_vector_type(2)));
        LAS float* wl = (LAS float*)(lds + RING_OFF);
        LAS unsigned* sb = (LAS unsigned*)(lds + SB_OFF);
        { f32x4 tv_[NE * D / 4 / NTHR];
#pragma unroll
            for (int i = 0; i < NE * D / 4 / NTHR; ++i) tv_[i] = ((const f32x4*)WRT)[tid + NTHR * i];
#pragma unroll
            for (int i = 0; i < NE * D / 4 / NTHR; ++i) ((LAS f32x4*)wl)[tid + NTHR * i] = tv_[i]; }
        if (tid < NE) lcnt[tid] = 0;
        __syncthreads();
        for (int tg = vcu; tg < MTOK / 64; tg += G) {
            const int tok0 = tg * 64 + 16 * (wave & 3);
            if (wave < 4) {
                const int j = lane & 15, q = lane >> 4;
                const f32x4* hrow = (const f32x4*)(H + (size_t)(tok0 + j) * D + 256 * q);
                const LAS f32x2* tab = (const LAS f32x2*)wl + q * 16 + j;
                f32x4 acc0 = (f32x4){0.f, 0.f, 0.f, 0.f}, acc1 = acc0; float ss = 0.f;
                f32x4 hv = hrow[0];
#pragma unroll 2
                for (int s4 = 0; s4 < 64; ++s4) {
                    const f32x4 hc = hv;
                    if (s4 + 1 < 64) hv = hrow[s4 + 1];
                    f32x2 w[4];
#pragma unroll
                    for (int u = 0; u < 4; ++u) w[u] = tab[(4 * s4 + u) * 64];
                    ss += (hc.x * hc.x + hc.y * hc.y) + (hc.z * hc.z + hc.w * hc.w);
#pragma unroll
                    for (int u = 0; u < 4; ++u) { acc0 = __builtin_amdgcn_mfma_f32_16x16x4f32(w[u].x, hc[u], acc0, 0, 0, 0); acc1 = __builtin_amdgcn_mfma_f32_16x16x4f32(w[u].y, hc[u], acc1, 0, 0, 0); }
                }
                ss += __shfl_xor(ss, 16); ss += __shfl_xor(ss, 32);
                const float rstd = rsqrtf(ss * (1.f / D) + EPS);
                float lg[8];
#pragma unroll
                for (int r = 0; r < 4; ++r) { lg[r] = acc0[r] * rstd + router_b[4 * q + r]; lg[4 + r] = acc1[r] * rstd + router_b[16 + 4 * q + r]; }
                float tv[TOPK]; int ti[TOPK];
#pragma unroll
                for (int k = 0; k < TOPK; ++k) {
                    float bv = lg[0]; int bi = 4 * q;
#pragma unroll
                    for (int r = 1; r < 8; ++r) { const int id = (r < 4) ? 4 * q + r : 16 + 4 * q + (r - 4); if (lg[r] > bv) { bv = lg[r]; bi = id; } }
#pragma unroll
                    for (int o = 16; o < 64; o <<= 1) { const float ov = __shfl_xor(bv, o); const int oi = __shfl_xor(bi, o); if (ov > bv || (ov == bv && oi < bi)) { bv = ov; bi = oi; } }
                    tv[k] = bv; ti[k] = bi;
#pragma unroll
                    for (int r = 0; r < 8; ++r) { const int id = (r < 4) ? 4 * q + r : 16 + 4 * q + (r - 4); if (id == bi) lg[r] = -INFINITY; }
                }
                const float e1 = __expf(tv[1] - tv[0]), e2 = __expf(tv[2] - tv[0]), e3 = __expf(tv[3] - tv[0]);
                const float inv = 1.0f / (1.0f + e1 + e2 + e3);
                {
                    const int ek = q == 0 ? ti[0] : q == 1 ? ti[1] : q == 2 ? ti[2] : ti[3];
                    const float gk = (q == 0 ? 1.0f : q == 1 ? e1 : q == 2 ? e2 : e3) * inv;
                    const int lr = __hip_atomic_fetch_add(&lcnt[ek], 1, __ATOMIC_RELAXED, __HIP_MEMORY_SCOPE_WORKGROUP);
                    sb[(16 * wave + j) * 4 + q] = ((unsigned)ek << 16) | (unsigned)lr;
                    GATE[(size_t)(tok0 + j) * TOPK + q] = gk;
                }
            } else {
                for (int i = 0; i < 16; ++i) {
                    const int m = tok0 + i;
                    const f32x4* hr = (const f32x4*)(H + (size_t)m * D) + lane; const f32x4* wr = (const f32x4*)norm2_w + lane;
                    f32x4 v[4]; float s2 = 0.f;
#pragma unroll
                    for (int jj = 0; jj < 4; ++jj) { v[jj] = hr[64 * jj]; s2 += (v[jj].x * v[jj].x + v[jj].y * v[jj].y) + (v[jj].z * v[jj].z + v[jj].w * v[jj].w); }
                    const float rstd = rsqrtf(wave_sum(s2) * (1.f / D) + EPS) * SC_N2;
                    unsigned* o4 = (unsigned*)(N2 + (size_t)m * D) + lane;
#pragma unroll
                    for (int jj = 0; jj < 4; ++jj) { const f32x4 g = wr[64 * jj]; o4[64 * jj] = pk4_fp8(v[jj].x * rstd * g.x, v[jj].y * rstd * g.y, v[jj].z * rstd * g.z, v[jj].w * rstd * g.w); }
                }
            }
            __syncthreads();
            if (tid < NE) { const int c = lcnt[tid]; gbase[tid] = c ? (int)__hip_atomic_fetch_add(ctl + CW_CNT + ((PROBE_DUP) == 5 && rep_ == 0 ? 4096 : 0) + 64 * tid, (unsigned)c, RLX_AGENT) : 0; }
            __syncthreads();
            if (tid < 256) { const unsigned w = sb[tid]; const int ek = (int)(w >> 16), r = gbase[ek] + (int)(w & 0xffffu), m = tg * 64 + (tid >> 2);
                ROWTOK[ek * MTOK + r] = m; SLOT[(size_t)m * TOPK + (tid & 3)] = ek * MTOK + r; }
            if (tid < NE) lcnt[tid] = 0;
            __syncthreads();
        }
    }
    SEAM(5);


    if (IN(7)) REP(7) {
        BUILD_BS();
        pg8::Gemm g{(const bf16*)N2, (const bf16*)W1T, MTOK, 2 * FF, D / 2}; MoeOrder S{bs, 8, G, vcu, cl, ROWTOK};
        EpiSwiglu E{ACT, b1};
        pg8::gemm_phase<EpiSwiglu, MoeOrder, true, true, true, true>(lds + RING_OFF, g, S, E);
    }
    SEAM(7);

    if (IN(8)) REP(8) {
        BUILD_BS();
        pg8::Gemm g{(const bf16*)ACT, (const bf16*)W2T, MOE_ROWS, D, FF / 2}; MoeOrder S{bs, 4, G, vcu, cl, ROWTOK};
        EpiDown E{YS, b2};
        pg8::gemm_phase<EpiDown, MoeOrder, true, true, true>(lds + RING_OFF, g, S, E);
    }
    SEAM(8);

    if (IN(9)) REP(9) {
        BUILD_BS();
        for (int base = gw; base < MTOK; base += 16 * NGW) {
            const int mi = base + NGW * (lane >> 2); int posl = 0; float gl = 0.f;
            if (mi < MTOK) { const int sl = SLOT[(size_t)mi * TOPK + (lane & 3)]; gl = GATE[(size_t)mi * TOPK + (lane & 3)]; posl = bs[sl >> 14] * 256 + (sl & (MTOK - 1)); }
#pragma unroll 2
            for (int i = 0; i < 16; ++i) {
                const int m = base + NGW * i; if (m >= MTOK) break;
                const f32x4* hr = (const f32x4*)(H + (size_t)m * D) + lane; const f32x4* wr = (const f32x4*)final_norm_w + lane;
                int pos[TOPK]; float gk[TOPK];
#pragma unroll
                for (int k = 0; k < TOPK; ++k) { pos[k] = __shfl(posl, 4 * i + k); gk[k] = __shfl(gl, 4 * i + k); }
                f32x4 v[4]; v2u yw[TOPK][4];
#pragma unroll
                for (int j = 0; j < 4; ++j) v[j] = hr[64 * j];
#pragma unroll
                for (int k = 0; k < TOPK; ++k) { const v2u* yr = (const v2u*)(YS + (size_t)pos[k] * D) + lane;
#pragma unroll
                    for (int j = 0; j < 4; ++j) yw[k][j] = yr[64 * j]; }
#pragma unroll
                for (int k = 0; k < TOPK; ++k)
#pragma unroll
                    for (int j = 0; j < 4; ++j) { const v2u w = yw[k][j];
                        v[j].x += gk[k] * bf2f(w.x & 0xffffu); v[j].y += gk[k] * bf2f(w.x >> 16); v[j].z += gk[k] * bf2f(w.y & 0xffffu); v[j].w += gk[k] * bf2f(w.y >> 16); }
                float s = 0.f;
#pragma unroll
                for (int j = 0; j < 4; ++j) s += (v[j].x * v[j].x + v[j].y * v[j].y) + (v[j].z * v[j].z + v[j].w * v[j].w);
                const float rstd = rsqrtf(wave_sum(s) * (1.f / D) + EPS);
                f32x4* orow = (f32x4*)(out + (size_t)m * D) + lane;
#pragma unroll
                for (int j = 0; j < 4; ++j) orow[64 * j] = v[j] * rstd * wr[64 * j];
            }
        }
    }
#undef IN
#undef SEAM
#undef BUILD_BS
}

extern "C" void kernel_launch(void* const* d_in, const int* in_sizes, int n_in, void* d_out, int out_size, void* d_ws, size_t ws_size, hipStream_t stream) {
    static int grid = 0;
    if (grid == 0) {
        if (n_in != 18 || in_sizes[0] != MTOK * D || out_size != MTOK * D || ws_size < WS_END) { fprintf(stderr, "kernel_launch: unexpected shapes (n_in %d, in0 %d, out %d, ws %zu < %zu); nothing launched\n", n_in, n_in > 0 ? in_sizes[0] : -1, out_size, ws_size, (size_t)WS_END); grid = -1; return; }
        int dev = 0, cus = 0, per_cu = 0;
        if (hipGetDevice(&dev) != hipSuccess || hipDeviceGetAttribute(&cus, hipDeviceAttributeMultiprocessorCount, dev) != hipSuccess) { fprintf(stderr, "kernel_launch: device query failed\n"); grid = -1; return; }
        if (hipFuncSetAttribute((const void*)fwd_kernel, hipFuncAttributeMaxDynamicSharedMemorySize, LDS_BYTES) != hipSuccess) { fprintf(stderr, "kernel_launch: hipFuncSetAttribute failed\n"); grid = -1; return; }
        if (hipOccupancyMaxActiveBlocksPerMultiprocessor(&per_cu, (const void*)fwd_kernel, NTHR, LDS_BYTES) != hipSuccess || per_cu < 1)
            fprintf(stderr, "kernel_launch: note: occupancy query reports %d workgroups per CU\n", per_cu);
        (void)hipGetLastError();
        grid = cus;
    }
    if (grid < 0) return;
    if (hipMemsetAsync((char*)d_ws + WS_CTL, 0, CTL_ZERO_BYTES, stream) != hipSuccess) { fprintf(stderr, "kernel_launch: memset failed\n"); return; }
    Args a{};
    for (int i = 0; i < 18; ++i) a.in[i] = (const float*)d_in[i];
    a.out = (float*)d_out; a.ws = (unsigned char*)d_ws;
#if MK_N_LAUNCHES == 1
    a.ph_lo = 0; a.ph_hi = N_PHASES;
    hipLaunchKernelGGL(fwd_kernel, dim3(grid), dim3(NTHR), LDS_BYTES, stream, a);
#else
    for (int ph = 0; ph < N_PHASES; ++ph) { a.ph_lo = ph; a.ph_hi = ph + 1; hipLaunchKernelGGL(fwd_kernel, dim3(grid), dim3(NTHR), LDS_BYTES, stream, a); }
#endif
    const hipError_t le = hipPeekAtLastError();
    if (le != hipSuccess) fprintf(stderr, "kernel_launch: launch failed: %s\n", hipGetErrorName(le));
}
```

```cpp
#define HGRN_V2 1
#include <hip/hip_runtime.h>
#include <cstdio>
#include <cstdint>
namespace pg8 {
#define PG8_LAS __attribute__((address_space(3)))
typedef unsigned short bf16_t;
typedef short bf16x8 __attribute__((ext_vector_type(8)));
typedef float f32x4 __attribute__((ext_vector_type(4)));
typedef unsigned u32x4 __attribute__((ext_vector_type(4)));
constexpr int BM = 256, BK = 64, HALF = 128, HTB = HALF * BK * 2  , STAGE_BYTES = 8 * HTB, NXCD = 8, WGM = 8;

__host__ __device__ __forceinline__ int lds_byte(int r, int c) { const int st = (r >> 4) * 2 + (c >> 5), rr = r & 15, cc = c & 31, ob = rr * 64 + cc * 2; return st * 1024 + (ob ^ (((ob >> 9) & 1) << 5)); }
__host__ __device__ __forceinline__ void stage_rc(int b, int& R, int& C) { const int st = b / 1024, sb = b % 1024, swz = sb ^ (((sb >> 9) & 1) << 5); R = (st >> 1) * 16 + swz / 64; C = (st & 1) * 32 + (swz % 64) / 2; }
__host__ __device__ __forceinline__ int perm32(int rho) { const int n = rho >> 4, i = rho & 15; return 8 * (i >> 2) + 4 * n + (i & 3); }

struct Unit { int pm, pn; };
struct Gemm { const bf16_t* A; const bf16_t* Bt; int M, N, K; };

struct StaticOrder {
    int nM, nN, nwg, G, c;
    __host__ __device__ void init(int M, int N, int G_, int c_) { nM = M / BM; nN = N / BM; nwg = nM * nN; G = G_; c = c_; }
    __host__ __device__ bool next(int i, Unit& u) const {
        const long L = (long)i * G + c; if (L >= nwg) return false;
        int wgid = (int)L; { const int q = nwg / NXCD, r = nwg % NXCD, xcd = wgid % NXCD, off = wgid / NXCD; wgid = (xcd < r ? xcd * (q + 1) : r * (q + 1) + (xcd - r) * q) + off; }
        const int nig = WGM * nN, gid = wgid / nig, fm = gid * WGM, gsz = (nM - fm) < WGM ? (nM - fm) : WGM;
        u.pm = fm + ((wgid % nig) % gsz); u.pn = (wgid % nig) / gsz; return true;
    }
    __device__ __forceinline__ void a_ready(const Unit&) const {}
    __device__ __forceinline__ void done(const Unit&) const {}
};
__device__ __forceinline__ unsigned cvt_pk_bf16(float lo, float hi) { unsigned r; asm volatile("v_cvt_pk_bf16_f32 %0, %1, %2" : "=v"(r) : "v"(lo), "v"(hi)); return r; }
typedef float f32x2 __attribute__((ext_vector_type(2)));
template <class Epi, class Sched, bool ALIGN_EPI = false, bool SP2 = false, bool FP8 = false, bool GATHER = false>
__device__ __forceinline__ void gemm_phase(PG8_LAS unsigned char* lds, const Gemm g, const Sched& S, const Epi& E) {
    typedef int v4i_t __attribute__((ext_vector_type(4)));
    const int tid = threadIdx.x, wid = __builtin_amdgcn_readfirstlane(tid >> 6), lane = tid & 63, wr = wid >> 2, wc = wid & 3, fr = lane & 15, fq = lane >> 4;
    const int K = g.K, nt = K / BK;
    unsigned voffA[2], voffB[2];
#pragma unroll
    for (int i = 0; i < 2; ++i) { int R, C; stage_rc(tid * 16 + i * 8192, R, C); const int Rb = Epi::PERM ? ((R & ~31) + perm32(R & 31)) : R;
        voffA[i] = (unsigned)(R * K + C) * 2u; voffB[i] = (unsigned)(Rb * K + C) * 2u; }
    int rowA[2]; unsigned colA[2];
#pragma unroll
    for (int i = 0; i < 2; ++i) { int R, C; stage_rc(tid * 16 + i * 8192, R, C); rowA[i] = R; colA[i] = (unsigned)C * 2u; }
    const size_t kstep = (size_t)(BK * 2);
    const size_t hstep = (size_t)HALF * K * 2;
    const size_t tstep = 2 * hstep;
    const unsigned ldsw = (unsigned)wid * 1024u;
    const int aoff = lds_byte(wr * 64 + fr, fq * 8), boff = lds_byte(wc * 32 + fr, fq * 8);
#define PG8_SA(b, h) (((b) * 2 + (h)) * HTB)
#define PG8_SB(b, h) ((4 + (b) * 2 + (h)) * HTB)
#define PG8_STAGE(bufoff, gbase, voff) do { _Pragma("unroll") for (int _i = 0; _i < 2; ++_i) \
        __builtin_amdgcn_global_load_lds((const unsigned*)((const char*)(gbase) + (voff)[_i]), (PG8_LAS unsigned*)(lds + (bufoff) + ldsw + _i * 8192), 16, 0, 0); } while (0)
#define PG8_STAGE2(bufoff, gbase, o0, o1) do { \
        __builtin_amdgcn_global_load_lds((const unsigned*)((const char*)(gbase) + (o0)), (PG8_LAS unsigned*)(lds + (bufoff) + ldsw), 16, 0, 0); \
        __builtin_amdgcn_global_load_lds((const unsigned*)((const char*)(gbase) + (o1)), (PG8_LAS unsigned*)(lds + (bufoff) + ldsw + 8192), 16, 0, 0); } while (0)
#define PG8_LDA(dst, b, h) do { _Pragma("unroll") for (int m = 0; m < 4; ++m) _Pragma("unroll") for (int k = 0; k < 2; ++k) dst[m][k] = *(const PG8_LAS bf16x8*)(lds + PG8_SA(b, h) + aoff + m * 2048 + k * 1024); } while (0)
#define PG8_LDB(dst, b, h) do { _Pragma("unroll") for (int n = 0; n < 2; ++n) _Pragma("unroll") for (int k = 0; k < 2; ++k) dst[n][k] = *(const PG8_LAS bf16x8*)(lds + PG8_SB(b, h) + boff + n * 2048 + k * 1024); } while (0)
#define PG8_MMA(ai, bj, At, Bt) do { __builtin_amdgcn_s_setprio(1); _Pragma("unroll") for (int m = 0; m < 4; ++m) _Pragma("unroll") for (int n = 0; n < 2; ++n) { \
        if constexpr (FP8) { asm volatile("v_mfma_f32_16x16x128_f8f6f4 %0, %1, %2, %0" : "+v"(acc[ai][bj][m][n]) : "v"(__builtin_shufflevector((v4i_t)Bt[n][0], (v4i_t)Bt[n][1], 0, 1, 2, 3, 4, 5, 6, 7)), "v"(__builtin_shufflevector((v4i_t)At[m][0], (v4i_t)At[m][1], 0, 1, 2, 3, 4, 5, 6, 7))); } \
        else { _Pragma("unroll") for (int k = 0; k < 2; ++k) acc[ai][bj][m][n] = __builtin_amdgcn_mfma_f32_16x16x32_bf16(Bt[n][k], At[m][k], acc[ai][bj][m][n], 0, 0, 0); } } __builtin_amdgcn_s_setprio(0); } while (0)
#define PG8_WAIT_V(n) asm volatile("s_waitcnt vmcnt(" #n ")" ::: "memory")
#define PG8_WAIT_L(n) asm volatile("s_waitcnt lgkmcnt(" #n ")" ::: "memory")
#define PG8_BAR __builtin_amdgcn_s_barrier()
#define PG8_SCHED __builtin_amdgcn_sched_barrier(0)
    Unit cur, nxt; int ui = 0;
    if (!S.next(0, cur)) return;
    f32x4 acc[2][2][4][2];
#pragma unroll
    for (int a = 0; a < 2; ++a)
#pragma unroll
        for (int b = 0; b < 2; ++b)
#pragma unroll
            for (int m = 0; m < 4; ++m)
#pragma unroll
                for (int n = 0; n < 2; ++n) acc[a][b][m][n] = (f32x4){0.f, 0.f, 0.f, 0.f};
    bf16x8 At[4][2], B0[2][2], B1[2][2];
    const char* cA = (const char*)g.A + (size_t)cur.pm * tstep; const char* cB = (const char*)g.Bt + (size_t)cur.pn * tstep;
    unsigned oA[2][2], nOA[2][2]; int tk[2][2] = {{0, 0}, {0, 0}};
    if constexpr (GATHER) {
        cA = (const char*)g.A;
        const int* lst = S.a_list(cur); const int nv = S.a_valid(cur);
#pragma unroll
        for (int h = 0; h < 2; ++h)
#pragma unroll
            for (int i = 0; i < 2; ++i) { const int r = min(h * HALF + rowA[i], nv - 1); oA[h][i] = (unsigned)lst[r] * (unsigned)(K * 2) + colA[i]; }
    } else {
#pragma unroll
        for (int h = 0; h < 2; ++h)
#pragma unroll
            for (int i = 0; i < 2; ++i) oA[h][i] = voffA[i] + (unsigned)(h * hstep);
    }
#pragma unroll
    for (int h = 0; h < 2; ++h)
#pragma unroll
        for (int i = 0; i < 2; ++i) nOA[h][i] = oA[h][i];
#define PG8_OSEL(h, i) (GATHER ? (last ? nOA[h][i] : oA[h][i]) : oA[h][i])
    S.a_ready(cur);
    if constexpr (SP2) {
        PG8_STAGE(PG8_SB(0, 0), cB, voffB); PG8_STAGE(PG8_SB(0, 1), cB + hstep, voffB); PG8_STAGE2(PG8_SA(0, 0), cA, oA[0][0], oA[0][1]); PG8_STAGE2(PG8_SA(0, 1), cA, oA[1][0], oA[1][1]);
        if (wr == 1) PG8_BAR;
        PG8_WAIT_V(2); PG8_BAR;
        PG8_STAGE(PG8_SB(1, 0), cB + kstep, voffB); PG8_STAGE2(PG8_SA(1, 0), cA + kstep, oA[0][0], oA[0][1]); PG8_STAGE(PG8_SB(1, 1), cB + hstep + kstep, voffB);
        PG8_WAIT_V(6); PG8_BAR;
    } else {
        PG8_STAGE(PG8_SB(0, 0), cB, voffB); PG8_STAGE(PG8_SA(0, 0), cA, voffA); PG8_STAGE(PG8_SB(0, 1), cB + hstep, voffB); PG8_STAGE(PG8_SA(0, 1), cA + hstep, voffA);
        if (wr == 1) PG8_BAR;
        PG8_WAIT_V(4); PG8_BAR;
        PG8_STAGE(PG8_SB(1, 0), cB + kstep, voffB); PG8_STAGE(PG8_SA(1, 0), cA + kstep, voffA); PG8_STAGE(PG8_SB(1, 1), cB + hstep + kstep, voffB);
        PG8_WAIT_V(6); PG8_BAR;
    }
    for (;;) {
        const bool has_next = S.next(ui + 1, nxt);
        const char* nA = GATHER ? cA : (has_next ? (const char*)g.A + (size_t)nxt.pm * tstep : cA); const char* nB = has_next ? (const char*)g.Bt + (size_t)nxt.pn * tstep : cB;
        if constexpr (GATHER) { if (has_next) { const int* lst = S.a_list(nxt); const int nv = S.a_valid(nxt);
#pragma unroll
            for (int h = 0; h < 2; ++h)
#pragma unroll
                for (int i = 0; i < 2; ++i) { const int* pp = lst + min(h * HALF + rowA[i], nv - 1); asm volatile("global_load_dword %0, %1, off" : "=v"(tk[h][i]) : "v"(pp) : "memory"); } } }
        for (int t = 0; t < nt; t += 2) {
            const bool last = (t == nt - 2);
            const char* a1 = cA + (size_t)(t + 1) * kstep;
            const char* a2 = last ? nA : cA + (size_t)(t + 2) * kstep; const char* b2 = last ? nB : cB + (size_t)(t + 2) * kstep;
            const char* a3 = a2 + kstep; const char* b3 = b2 + kstep;
            if (last && has_next) S.a_ready(nxt);
            if constexpr (GATHER) { if (last && has_next) { asm volatile("" : "+v"(tk[0][0]), "+v"(tk[0][1]), "+v"(tk[1][0]), "+v"(tk[1][1]));
#pragma unroll
                for (int h = 0; h < 2; ++h)
#pragma unroll
                    for (int i = 0; i < 2; ++i) nOA[h][i] = (unsigned)tk[h][i] * (unsigned)(K * 2) + colA[i]; } }
            if constexpr (SP2) {
            PG8_LDB(B0, 0, 0); PG8_LDB(B1, 0, 1); PG8_SCHED; PG8_LDA(At, 0, 0); PG8_STAGE2(PG8_SA(1, 1), a1, oA[1][0], oA[1][1]);
            PG8_WAIT_V(8); PG8_WAIT_L(0); PG8_BAR; PG8_MMA(0, 0, At, B0); PG8_MMA(0, 1, At, B1); PG8_BAR; PG8_SCHED;
            PG8_LDA(At, 0, 1); PG8_STAGE(PG8_SB(0, 0), b2, voffB); PG8_STAGE(PG8_SB(0, 1), b2 + hstep, voffB); PG8_STAGE2(PG8_SA(0, 0), a2, PG8_OSEL(0, 0), PG8_OSEL(0, 1));
            PG8_WAIT_V(8); PG8_WAIT_L(0); PG8_BAR; PG8_MMA(1, 0, At, B0); PG8_MMA(1, 1, At, B1); PG8_BAR; PG8_SCHED;
            PG8_LDB(B0, 1, 0); PG8_LDB(B1, 1, 1); PG8_SCHED; PG8_LDA(At, 1, 0); PG8_STAGE2(PG8_SA(0, 1), a2, PG8_OSEL(1, 0), PG8_OSEL(1, 1));
            PG8_WAIT_V(8); PG8_WAIT_L(0); PG8_BAR; PG8_MMA(0, 0, At, B0); PG8_MMA(0, 1, At, B1); PG8_BAR; PG8_SCHED;
            PG8_LDA(At, 1, 1); PG8_STAGE(PG8_SB(1, 0), b3, voffB); PG8_STAGE(PG8_SB(1, 1), b3 + hstep, voffB); PG8_STAGE2(PG8_SA(1, 0), a3, PG8_OSEL(0, 0), PG8_OSEL(0, 1));
            PG8_WAIT_V(8); PG8_WAIT_L(0); PG8_BAR; PG8_MMA(1, 0, At, B0); PG8_MMA(1, 1, At, B1); PG8_BAR; PG8_SCHED;
            } else {
            PG8_LDB(B0, 0, 0); PG8_SCHED; PG8_LDA(At, 0, 0); PG8_STAGE(PG8_SA(1, 1), a1 + hstep, voffA);
            PG8_WAIT_L(8); PG8_BAR; PG8_WAIT_L(0); PG8_MMA(0, 0, At, B0); PG8_BAR; PG8_SCHED;
            PG8_LDB(B1, 0, 1); PG8_STAGE(PG8_SB(0, 0), b2, voffB);
            PG8_BAR; PG8_WAIT_L(0); PG8_MMA(0, 1, At, B1); PG8_BAR;
            PG8_LDA(At, 0, 1); PG8_STAGE(PG8_SA(0, 0), a2, voffA);
            PG8_BAR; PG8_WAIT_L(0); PG8_MMA(1, 0, At, B0); PG8_BAR; PG8_SCHED;
            PG8_STAGE(PG8_SB(0, 1), b2 + hstep, voffB);
            PG8_WAIT_V(6); PG8_BAR; PG8_MMA(1, 1, At, B1); PG8_BAR;
            PG8_LDB(B0, 1, 0); PG8_SCHED; PG8_LDA(At, 1, 0); PG8_STAGE(PG8_SA(0, 1), a2 + hstep, voffA);
            PG8_WAIT_L(8); PG8_BAR; PG8_WAIT_L(0); PG8_MMA(0, 0, At, B0); PG8_BAR; PG8_SCHED;
            PG8_LDB(B1, 1, 1); PG8_STAGE(PG8_SB(1, 0), b3, voffB);
            PG8_BAR; PG8_WAIT_L(0); PG8_MMA(0, 1, At, B1); PG8_BAR;
            PG8_LDA(At, 1, 1); PG8_STAGE(PG8_SA(1, 0), a3, voffA);
            PG8_BAR; PG8_WAIT_L(0); PG8_MMA(1, 0, At, B0); PG8_BAR; PG8_SCHED;
            PG8_STAGE(PG8_SB(1, 1), b3 + hstep, voffB);
            PG8_WAIT_V(6); PG8_BAR; PG8_MMA(1, 1, At, B1); PG8_BAR;
            }
        }
        if constexpr (FP8) asm volatile("s_nop 15\n\ts_nop 15" ::: "memory");
        if constexpr (ALIGN_EPI) { if (wr == 0) PG8_BAR; }
        if constexpr (!Epi::AFTER_DRAIN) { E(acc, cur, wr, wc, fr, fq); S.done(cur); }
        if (!has_next) break;
#pragma unroll
        for (int a = 0; a < 2; ++a)
#pragma unroll
            for (int b = 0; b < 2; ++b)
#pragma unroll
                for (int m = 0; m < 4; ++m)
#pragma unroll
                    for (int n = 0; n < 2; ++n) acc[a][b][m][n] = (f32x4){0.f, 0.f, 0.f, 0.f};
        cur = nxt; cA = nA; cB = nB; ++ui;
        if constexpr (GATHER) {
#pragma unroll
            for (int h = 0; h < 2; ++h)
#pragma unroll
                for (int i = 0; i < 2; ++i) oA[h][i] = nOA[h][i];
        }
        if constexpr (ALIGN_EPI) { if (wr == 1) PG8_BAR; }
    }
    PG8_WAIT_V(0);
    if constexpr (!ALIGN_EPI) { if (wr == 0) PG8_BAR; }
    PG8_BAR;
    if constexpr (Epi::AFTER_DRAIN) { E.fused(acc, cur, wr, wc, fr, fq, lds, wid, lane); S.done(cur); }
#undef PG8_SA
#undef PG8_OSEL
#undef PG8_STAGE2
#undef PG8_SB
#undef PG8_STAGE
#undef PG8_LDA
#undef PG8_LDB
#undef PG8_MMA
#undef PG8_WAIT_V
#undef PG8_WAIT_L
#undef PG8_BAR
#undef PG8_SCHED
}
}

#ifndef MK_N_LAUNCHES
#define MK_N_LAUNCHES 1
#endif
constexpr int N_PHASES = 10;
constexpr int NBATCH = 8, TT = 2048, MTOK = NBATCH * TT, D = 1024;
constexpr int HK = 512, NH = 4, DK = 128, DV = 128, CCH = 512, CLEN = 31, INC = 3584;
constexpr int NE = 32, TOPK = 4, FF = 1024;
constexpr float EPS = 1e-5f, SW_LIMIT = 7.0f, SW_ALPHA = 1.702f;
constexpr int NWAVES = 8, NTHR = 512;
constexpr int W1_ITEMS = 32 * 16 * 64, W1_P1 = 6144, W1_P2 = 20480, W1_P0 = W1_ITEMS - W1_P1 - W1_P2;
constexpr int MOE_ROWS = (MTOK * TOPK / 256 + NE) * 256;

constexpr size_t MiB = 1u << 20;
constexpr size_t WS_CTL = 0, CTL_ZERO_BYTES = 1 * MiB;
constexpr size_t WS_WI = 1 * MiB;
constexpr size_t WS_WO = 8 * MiB;
constexpr size_t WS_TAB = 10 * MiB;
constexpr size_t WS_W1 = 16 * MiB;
constexpr size_t WS_W2 = 144 * MiB;
constexpr size_t WS_H = 208 * MiB;
constexpr size_t WS_XN = 272 * MiB;
constexpr size_t WS_Q = 304 * MiB, WS_KF = 320 * MiB, WS_KB = 336 * MiB, WS_V = 352 * MiB, WS_G = 368 * MiB, WS_U = 384 * MiB;
constexpr size_t WS_LF = 400 * MiB, WS_LB = 432 * MiB;
constexpr size_t WS_OF = 464 * MiB, WS_OB = 496 * MiB;
constexpr size_t WS_MIX = 528 * MiB;
constexpr size_t WS_XS = 304 * MiB;
constexpr size_t WS_ACT = 448 * MiB;
constexpr size_t WS_YS = 592 * MiB;
constexpr size_t WS_END = 736 * MiB;
constexpr size_t WS_WRT = WS_TAB;
constexpr size_t WS_SLOT = WS_TAB + 256 * 1024;
constexpr size_t WS_GATE = WS_TAB + 512 * 1024;
constexpr size_t WS_ROWTOK = WS_TAB + 1 * MiB;
constexpr int CW_BAR = 4096;
constexpr int CW_CNT = 16384;

constexpr int RING_OFF = 0, RING_BYTES = 131072;
constexpr int LDSCTL_OFF = 152576;
constexpr int MISC_OFF = LDSCTL_OFF + 320;
constexpr int TAB_OFF = LDSCTL_OFF + 1024;
constexpr int SB_OFF = LDSCTL_OFF + 2048;
constexpr int LDS_BYTES = 163840;

#define GAS __attribute__((address_space(1)))
#define LAS __attribute__((address_space(3)))
typedef unsigned short bf16;
typedef unsigned v4u __attribute__((ext_vector_type(4)));
typedef unsigned v2u __attribute__((ext_vector_type(2)));
typedef float f32x4 __attribute__((ext_vector_type(4)));
typedef GAS unsigned gu32;
#define RLX_AGENT __ATOMIC_RELAXED, __HIP_MEMORY_SCOPE_AGENT
#define LDS_WAIT() asm volatile("s_waitcnt lgkmcnt(0)" ::: "memory")
#define VM_WAIT() asm volatile("s_waitcnt vmcnt(0)" ::: "memory")

__device__ __forceinline__ float bf2f(unsigned b) { return __uint_as_float(b << 16); }
__device__ __forceinline__ unsigned pk2(float lo, float hi) { return pg8::cvt_pk_bf16(lo, hi); }
__device__ __forceinline__ float sigm(float x) { return __builtin_amdgcn_rcpf(1.0f + __expf(-x)); }
__device__ __forceinline__ float wave_sum(float v) {
#pragma unroll
    for (int o = 1; o < 64; o <<= 1) v += __shfl_xor(v, o);
    return v;
}

constexpr float SC_W = 512.f, SC_N2 = 16.f, SC_ACT = 8.f;
__device__ __forceinline__ unsigned pk4_fp8(float a, float b, float c, float d) {
    a = fminf(fmaxf(a, -448.f), 448.f); b = fminf(fmaxf(b, -448.f), 448.f); c = fminf(fmaxf(c, -448.f), 448.f); d = fminf(fmaxf(d, -448.f), 448.f);
    int w = 0; w = __builtin_amdgcn_cvt_pk_fp8_f32(a, b, w, false); w = __builtin_amdgcn_cvt_pk_fp8_f32(c, d, w, true); return (unsigned)w;
}

#define XB_TMO      128
#define XB_XCNT(j)  (256  + 64 * (j))
#define XB_XSUB(j)  (1280 + 64 * (j))
#define XB_XGEN(j)  (2304 + 64 * (j))
#define XB_TOP      3328
#define XB_TOPGEN   3392
#define XCD_BAR_WORDS 3456
#define XB_SPIN_CAP (1u << 18)

__device__ __forceinline__ unsigned xb_ld(unsigned* p)              { return __hip_atomic_load(p, __ATOMIC_RELAXED, __HIP_MEMORY_SCOPE_AGENT); }
__device__ __forceinline__ unsigned xb_add(unsigned* p, unsigned v) { return __hip_atomic_fetch_add(p, v, __ATOMIC_RELAXED, __HIP_MEMORY_SCOPE_AGENT); }
__device__ __forceinline__ unsigned xb_xcc_id() { return (unsigned)__builtin_amdgcn_s_getreg((3 << 11) | 20) & 0xFu; }
#define XB_SPIN(cond, bar) do { unsigned _sp = 0; while (cond) { __builtin_amdgcn_s_sleep(1); \
    if ((++_sp & 255u) == 0u) { if (xb_ld(&(bar)[XB_TMO])) break; if (_sp > XB_SPIN_CAP) { atomicAdd(&(bar)[XB_TMO], 1u); break; } } } } while (0)

struct XcdBarrier {
    unsigned* bar; unsigned x;
    volatile LAS unsigned* st;
};
__device__ __forceinline__ XcdBarrier xcd_barrier_post(unsigned* bar, volatile LAS unsigned* st) {
    XcdBarrier b; b.bar = bar; b.x = xb_xcc_id(); b.st = st;
    if (threadIdx.x == 0) (void)xb_add(&bar[XB_XCNT(b.x)], 1u);
    return b;
}
__device__ __forceinline__ void xcd_barrier_complete(unsigned* bar, unsigned x, unsigned& nloc, unsigned& nx) {
    const unsigned G = gridDim.x * gridDim.y * gridDim.z;
    unsigned sum, cnt, mine, sp = 0u;
    for (;;) {
        sum = 0u; cnt = 0u; mine = 0u;
#pragma unroll
        for (unsigned j = 0; j < 16; ++j) { const unsigned c = xb_ld(&bar[XB_XCNT(j)]); sum += c; cnt += (c > 0u) ? 1u : 0u; mine = (j == x) ? c : mine; }
        if (sum == G) break;
        __builtin_amdgcn_s_sleep(1);
        if ((++sp & 255u) == 0u) { if (xb_ld(&bar[XB_TMO])) break; if (sp > XB_SPIN_CAP) { atomicAdd(&bar[XB_TMO], 1u); break; } }
    }
    nloc = mine > 0u ? mine : 1u; nx = cnt > 0u ? cnt : 1u;
}
__device__ __forceinline__ void xcd_barrier(const XcdBarrier& b) {
    asm volatile("s_waitcnt vmcnt(0)" ::: "memory");
    __syncthreads();
    if (threadIdx.x == 0) {
        unsigned* bar = b.bar;
        __builtin_amdgcn_s_waitcnt(0);
        unsigned nloc = b.st[0], nx = b.st[1];
        if (nloc == 0u) { xcd_barrier_complete(bar, b.x, nloc, nx); b.st[0] = nloc; b.st[1] = nx; }
        const unsigned old = xb_add(&bar[XB_XSUB(b.x)], 1u);
        const unsigned gen = old / nloc;
        if (old + 1u == (gen + 1u) * nloc) {
            __builtin_amdgcn_fence(__ATOMIC_RELEASE, "agent");
            asm volatile("s_waitcnt vmcnt(0)" ::: "memory");
            const unsigned og = xb_add(&bar[XB_TOP], 1u);
            const unsigned tg = og / nx;
            if (og + 1u == (tg + 1u) * nx) xb_add(&bar[XB_TOPGEN], 1u);
            else XB_SPIN(xb_ld(&bar[XB_TOPGEN]) == tg, bar);
            __builtin_amdgcn_fence(__ATOMIC_ACQUIRE, "agent");
            xb_add(&bar[XB_XGEN(b.x)], 1u);
            asm volatile("s_waitcnt vmcnt(0)" ::: "memory");
        } else {
            XB_SPIN(xb_ld(&bar[XB_XGEN(b.x)]) == gen, bar);
            __builtin_amdgcn_fence(__ATOMIC_ACQUIRE, "agent");
            asm volatile("s_waitcnt vmcnt(0)" ::: "memory");
        }
    }
    __syncthreads();
}

#ifndef WT_STORES
#define WT_STORES 0
#endif
__device__ __forceinline__ void st16(void* p, v4u w) {
#if WT_STORES
    asm volatile("global_store_dwordx4 %0, %1, off sc0 sc1\n\ts_nop 1" :: "v"(p), "v"(w) : "memory");
#else
    *(v4u*)p = w;
#endif
}
__device__ __forceinline__ void st8(void* p, v2u w) {
#if WT_STORES
    asm volatile("global_store_dwordx2 %0, %1, off sc0 sc1\n\ts_nop 1" :: "v"(p), "v"(w) : "memory");
#else
    *(v2u*)p = w;
#endif
}
__device__ __forceinline__ void st8bf(bf16* p, const f32x4& a, const f32x4& b) {
    v4u w; w.x = pk2(a[0], a[1]); w.y = pk2(a[2], a[3]); w.z = pk2(b[0], b[1]); w.w = pk2(b[2], b[3]);
    st16(p, w);
}
struct EpiProj {
    static constexpr bool PERM = true, AFTER_DRAIN = false;
    bf16 *Q, *KF, *KB, *V, *G, *U; float *LF, *LB; const float* lbl;
    template <int TYP>
    __device__ __forceinline__ void tile(const pg8::f32x4 (&acc)[2][2][4][2], int row0, int cb) const {
#pragma unroll
        for (int bj = 0; bj < 2; ++bj) {
            const int col = cb + bj * 128;
            float lb[8];
            if (TYP == 1 || TYP == 2) {
                const float* L = lbl + (TYP - 1) * 1024 + col;
#pragma unroll
                for (int i = 0; i < 8; ++i) lb[i] = __builtin_amdgcn_rcpf(1.0f + __expf(L[512 + i] - L[i]));
            }
#pragma unroll
            for (int ai = 0; ai < 2; ++ai)
#pragma unroll
                for (int m = 0; m < 4; ++m) {
                    const size_t off = (size_t)(row0 + ai * 128 + m * 16) * 512 + col;
                    f32x4 a = acc[ai][bj][m][0], b = acc[ai][bj][m][1];
                    if (TYP == 0 || TYP == 4) {
#pragma unroll
                        for (int i = 0; i < 4; ++i) { a[i] = a[i] * sigm(a[i]); b[i] = b[i] * sigm(b[i]); }
                        st8bf((TYP == 0 ? Q : G) + off, a, b);
                    } else if (TYP == 3) {
                        st8bf(V + off, a, b);
                    } else {
                        f32x4 la, lbv, ka, kb;
#pragma unroll
                        for (int i = 0; i < 4; ++i) {
                            const float fa = lb[i] + (1.0f - lb[i]) * sigm(a[i]), fb = lb[4 + i] + (1.0f - lb[4 + i]) * sigm(b[i]);
                            la[i] = __logf(fa); lbv[i] = __logf(fb); ka[i] = 1.0f - fa; kb[i] = 1.0f - fb;
                        }
                        float* Lp = (TYP == 1 ? LF : LB) + off;
                        st16(Lp, (v4u)la); st16(Lp + 4, (v4u)lbv);
                        st8bf((TYP == 1 ? KF : KB) + off, ka, kb);
                    }
                }
        }
    }
    __device__ __forceinline__ void operator()(const pg8::f32x4 (&acc)[2][2][4][2], const pg8::Unit& u, int wr, int wc, int fr, int fq) const {
        const int row0 = u.pm * 256 + wr * 64 + fr, pn = u.pn;
        if (pn >= 10) {
            const int col = (pn - 10) * 128 + wc * 32 + 8 * fq;
#pragma unroll
            for (int ai = 0; ai < 2; ++ai)
#pragma unroll
                for (int m = 0; m < 4; ++m) {
                    f32x4 a = acc[ai][0][m][0], b = acc[ai][0][m][1]; const f32x4 ga = acc[ai][1][m][0], gb = acc[ai][1][m][1];
#pragma unroll
                    for (int i = 0; i < 4; ++i) { a[i] = a[i] * sigm(ga[i]); b[i] = b[i] * sigm(gb[i]); }
                    st8bf(U + (size_t)(row0 + ai * 128 + m * 16) * 512 + col, a, b);
                }
        } else {
            const int cb = (pn & 1) * 256 + wc * 32 + 8 * fq, typ = pn >> 1;
            if (typ == 0) tile<0>(acc, row0, cb);
            else if (typ == 1) tile<1>(acc, row0, cb);
            else if (typ == 2) tile<2>(acc, row0, cb);
            else if (typ == 3) tile<3>(acc, row0, cb);
            else tile<4>(acc, row0, cb);
        }
    }
};
struct EpiRes {
    static constexpr bool PERM = false, AFTER_DRAIN = false;
    const float* X; float* H;
    __device__ __forceinline__ void operator()(const pg8::f32x4 (&acc)[2][2][4][2], const pg8::Unit& u, int wr, int wc, int fr, int fq) const {
        const int row0 = u.pm * 256 + wr * 64 + fr, col0 = u.pn * 256 + wc * 32 + 4 * fq;
#pragma unroll
        for (int ai = 0; ai < 2; ++ai)
#pragma unroll
            for (int m = 0; m < 4; ++m) {
                const size_t off = (size_t)(row0 + ai * 128 + m * 16) * D + col0;
#pragma unroll
                for (int bj = 0; bj < 2; ++bj)
#pragma unroll
                    for (int n = 0; n < 2; ++n) { const f32x4 xv = *(const f32x4*)(X + off + bj * 128 + n * 16); st16(H + off + bj * 128 + n * 16, (v4u)(xv + acc[ai][bj][m][n])); }
            }
    }
};
struct EpiSwiglu {
    static constexpr bool PERM = true, AFTER_DRAIN = false;
    unsigned char* ACT; const float* b1;
    __device__ __forceinline__ void operator()(const pg8::f32x4 (&acc)[2][2][4][2], const pg8::Unit& u, int wr, int wc, int fr, int fq) const {
        const int e = u.pn >> 3, pn = u.pn & 7, row0 = u.pm * 256 + wr * 64 + fr, col = pn * 128 + wc * 32 + 8 * fq;
        const float* bg = b1 + (size_t)e * 2048 + col; const float* bl = bg + 1024;
        float g[8], l[8];
#pragma unroll
        for (int i = 0; i < 8; ++i) { g[i] = bg[i]; l[i] = bl[i]; }
#pragma unroll
        for (int ai = 0; ai < 2; ++ai)
#pragma unroll
            for (int m = 0; m < 4; ++m) {
                f32x4 o[2];
#pragma unroll
                for (int n = 0; n < 2; ++n)
#pragma unroll
                    for (int i = 0; i < 4; ++i) {
                        const float hg = fminf(acc[ai][0][m][n][i] * (1.0f / (SC_N2 * SC_W)) + g[4 * n + i], SW_LIMIT);
                        const float hl = fminf(fmaxf(acc[ai][1][m][n][i] * (1.0f / (SC_N2 * SC_W)) + l[4 * n + i], -SW_LIMIT), SW_LIMIT);
                        o[n][i] = hg * sigm(SW_ALPHA * hg) * (hl + 1.0f) * SC_ACT;
                    }
                v2u w; w.x = pk4_fp8(o[0][0], o[0][1], o[0][2], o[0][3]); w.y = pk4_fp8(o[1][0], o[1][1], o[1][2], o[1][3]);
                st8(ACT + (size_t)(row0 + ai * 128 + m * 16) * FF + col, w);
            }
    }
};
struct EpiDown {
    static constexpr bool PERM = true, AFTER_DRAIN = false;
    bf16* YS; const float* b2;
    __device__ __forceinline__ void operator()(const pg8::f32x4 (&acc)[2][2][4][2], const pg8::Unit& u, int wr, int wc, int fr, int fq) const {
        const int e = u.pn >> 2, pn = u.pn & 3, row0 = u.pm * 256 + wr * 64 + fr, col0 = pn * 256 + wc * 32 + 8 * fq;
#pragma unroll
        for (int bj = 0; bj < 2; ++bj) {
            const float* bp = b2 + (size_t)e * D + col0 + bj * 128;
            const f32x4 b0 = *(const f32x4*)bp, b1v = *(const f32x4*)(bp + 4);
#pragma unroll
            for (int ai = 0; ai < 2; ++ai)
#pragma unroll
                for (int m = 0; m < 4; ++m)
                    st8bf(YS + (size_t)(row0 + ai * 128 + m * 16) * D + col0 + bj * 128, acc[ai][bj][m][0] * (1.0f / (SC_ACT * SC_W)) + b0, acc[ai][bj][m][1] * (1.0f / (SC_ACT * SC_W)) + b1v);
        }
    }
};
struct MoeOrder {
    const volatile LAS int* bs; int ntn, G, v; const volatile LAS int* cl; const int* rowtok;
    __device__ __forceinline__ const int* a_list(const pg8::Unit& u) const { const int e = u.pn / ntn; return rowtok + e * MTOK + (u.pm - bs[e]) * 256; }
    __device__ __forceinline__ int a_valid(const pg8::Unit& u) const { const int e = u.pn / ntn; return min(256, cl[e] - (u.pm - bs[e]) * 256); }
    __device__ __forceinline__ bool next(int i, pg8::Unit& u) const {
        const int L = i * G + v, nb = bs[32];
        if (L >= nb * ntn) return false;
        const int mb = L / ntn, pn = L - mb * ntn;
        const int ln = (int)(threadIdx.x & 63);
        const int e = __popcll(__ballot(ln < NE - 1 && bs[ln + 1] <= mb));
        u.pm = mb; u.pn = e * ntn + pn; return true;
    }
    __device__ __forceinline__ void a_ready(const pg8::Unit&) const {}
    __device__ __forceinline__ void done(const pg8::Unit&) const {}
};

#ifndef PROBE_DUP
#define PROBE_DUP -1
#endif
struct OrderRep : pg8::StaticOrder {
    int reps;
    __device__ __forceinline__ bool next(int i, pg8::Unit& u) const {
        const int per = (nwg + G - 1) / G, r = i / per;
        if (r >= reps) return false;
        return pg8::StaticOrder::next(i - r * per, u) ? true : ((r + 1 < reps) ? pg8::StaticOrder::next(0, u) : false);
    }
};
struct RmIdent { __device__ __forceinline__ int operator()(int n) const { return n; } };
struct RmWin {
    __device__ __forceinline__ int operator()(int n) const {
        if (n < 2560) return n;
        if (n < 3072) { const int j = n - 2560; return 2560 + (j >> 7) * 256 + (j & 127); }
        const int j = n - 3072; return 2560 + (j >> 7) * 256 + 128 + (j & 127);
    }
};
struct RmW1 {
    __device__ __forceinline__ int operator()(int n) const {
        if (n < 1024) return (n >> 7) * 256 + (n & 127);
        const int j = n - 1024; return (j >> 7) * 256 + 128 + (j & 127);
    }
};
__device__ __forceinline__ void p0_load(const float* W, int N, int item, int lane, f32x4 (&v)[8]) {
    const int nblk = N / 32, kb = item / nblk, nb = item % nblk, k0 = 64 * kb, n0 = 32 * nb;
    const int r8 = lane >> 3, c4 = lane & 7;
#pragma unroll
    for (int i = 0; i < 8; ++i) v[i] = *(const f32x4*)(W + (size_t)(k0 + 8 * i + r8) * N + n0 + 4 * c4);
}
template <bool FP8OUT, class RM>
__device__ __forceinline__ void p0_finish(const f32x4 (&v)[8], int K, int N, void* WTv, RM rm, LAS float* scr, int item, int lane) {
    const int nblk = N / 32, kb = item / nblk, nb = item % nblk, k0 = 64 * kb, n0 = 32 * nb;
    const int r8 = lane >> 3, c4 = lane & 7;
#pragma unroll
    for (int i = 0; i < 8; ++i) *(LAS f32x4*)(scr + (8 * i + r8) * 36 + 4 * c4) = v[i];
    LDS_WAIT(); asm volatile("" ::: "memory");
    const int n = lane & 31, kh = lane >> 5; const LAS float* s = scr + (32 * kh) * 36 + n;
    if constexpr (FP8OUT) {
        unsigned w[8];
#pragma unroll
        for (int j = 0; j < 8; ++j) w[j] = pk4_fp8(s[(4 * j) * 36] * SC_W, s[(4 * j + 1) * 36] * SC_W, s[(4 * j + 2) * 36] * SC_W, s[(4 * j + 3) * 36] * SC_W);
        GAS v4u* dst = (GAS v4u*)((unsigned char*)WTv + (size_t)rm(n0 + n) * K + k0 + 32 * kh);
        dst[0] = (v4u){w[0], w[1], w[2], w[3]}; dst[1] = (v4u){w[4], w[5], w[6], w[7]};
    } else {
        unsigned w[16];
#pragma unroll
        for (int j = 0; j < 16; ++j) w[j] = pk2(s[(2 * j) * 36], s[(2 * j + 1) * 36]);
        GAS v4u* dst = (GAS v4u*)((bf16*)WTv + (size_t)rm(n0 + n) * K + k0 + 32 * kh);
#pragma unroll
        for (int q = 0; q < 4; ++q) dst[q] = (v4u){w[4 * q], w[4 * q + 1], w[4 * q + 2], w[4 * q + 3]};
    }
    LDS_WAIT(); asm volatile("" ::: "memory");
}
template <bool FP8OUT, class RM>
__device__ __forceinline__ void p0_item(const float* W, int K, int N, void* WTv, RM rm, LAS float* scr, int item, int lane) {
    f32x4 v[8]; p0_load(W, N, item, lane, v); p0_finish<FP8OUT>(v, K, N, WTv, rm, scr, item, lane);
}
template <class RM>
__device__ __forceinline__ void convert_range_fp8(const float* W, int K, int N, unsigned char* WT, RM rm, int ipe_log2, int first, int stride, int count, int base, LAS float* scr, int lane) {
    const size_t esz = (size_t)K * N; const int mask = (1 << ipe_log2) - 1;
    f32x4 va[8], vb[8];
    int it = first;
    if (it < count) p0_load(W + (size_t)((base + it) >> ipe_log2) * esz, N, (base + it) & mask, lane, va);
    while (it < count) {
        const int i1 = it + stride, i2 = it + 2 * stride;
        if (i1 < count) p0_load(W + (size_t)((base + i1) >> ipe_log2) * esz, N, (base + i1) & mask, lane, vb);
        p0_finish<true>(va, K, N, WT + (size_t)((base + it) >> ipe_log2) * esz, rm, scr, (base + it) & mask, lane);
        if (i1 >= count) break;
        if (i2 < count) p0_load(W + (size_t)((base + i2) >> ipe_log2) * esz, N, (base + i2) & mask, lane, va);
        p0_finish<true>(vb, K, N, WT + (size_t)((base + i1) >> ipe_log2) * esz, rm, scr, (base + i1) & mask, lane);
        it = i2;
    }
}
__device__ __forceinline__ void rms_row_to_bf16(const float* xrow, const float* w, bf16* orow, int lane) {
    const f32x4* xr = (const f32x4*)xrow + lane; const f32x4* wr = (const f32x4*)w + lane;
    f32x4 v[4]; float s = 0.f;
#pragma unroll
    for (int j = 0; j < 4; ++j) { v[j] = xr[64 * j]; s += (v[j].x * v[j].x + v[j].y * v[j].y) + (v[j].z * v[j].z + v[j].w * v[j].w); }
    const float rstd = rsqrtf(wave_sum(s) * (1.f / D) + EPS);
    v2u* o8 = (v2u*)orow + lane;
#pragma unroll
    for (int j = 0; j < 4; ++j) { const f32x4 g = wr[64 * j]; v2u o; o.x = pk2(v[j].x * rstd * g.x, v[j].y * rstd * g.y); o.y = pk2(v[j].z * rstd * g.z, v[j].w * rstd * g.w); o8[64 * j] = o; }
}


__device__ __forceinline__ pg8::bf16x8 lds_frag(const LAS unsigned char* p) { return *(const LAS pg8::bf16x8*)p; }
__device__ __forceinline__ pg8::bf16x8 mk_frag(v2u a, v2u b) { const v4u w = (v4u){a.x, a.y, b.x, b.y}; return (pg8::bf16x8)w; }
struct HgCtx {
    LAS unsigned char* lds; const bf16 *Qb, *Kp, *Vb; const float* Lp; float* Op;
    int b, h, dir, vh, lane, wave, lr, lq, dA, seg, tauB, dg;
    unsigned offA[16], offB, offV, ke_tr, v_tr;
};
constexpr int HG_BF = 0, HG_AM = 0, HG_QI = 33792, HG_KK = 51200, HG_KE = 68608, HG_V = 86016, HG_ST = 95232, HG_SEG = 112640, HG_DEC = 114688;
constexpr int HG_RSD = 272, HG_RSS = 144, HG_RSBF = 528;
__device__ __forceinline__ void hgrn_load(const HgCtx& c, int n, float (&lf)[16], v4u (&qB)[2], v4u (&kB)[2], v4u& vB) {
    const size_t cb = (size_t)__builtin_amdgcn_readfirstlane(c.b * TT + (c.dir ? (TT / 64 - 1 - n) * 64 : n * 64)) * 512 + c.h * 128;
    const float* Lc = c.Lp + cb; const bf16* Qc = c.Qb + cb; const bf16* Kc = c.Kp + cb; const bf16* Vc = c.Vb + cb;
#pragma unroll
    for (int i = 0; i < 16; ++i) lf[i] = Lc[c.offA[i]];
    qB[0] = *(const v4u*)(Qc + c.offB); qB[1] = *(const v4u*)(Qc + c.offB + 8); kB[0] = *(const v4u*)(Kc + c.offB); kB[1] = *(const v4u*)(Kc + c.offB + 8);
    vB = *(const v4u*)(Vc + c.offV);
}
__device__ __forceinline__ void hgrn_chunk(const HgCtx& c, int n, float (&lf)[16], v4u (&qB)[2], v4u (&kB)[2], v4u& vB, f32x4 (&S)[4]) {
    LAS unsigned char* lds = c.lds;
    const int dir = c.dir, lr = c.lr, lq = c.lq, wave = c.wave, dA = c.dA, seg = c.seg, tauB = c.tauB, dg = c.dg;
    const int tb = c.b * TT + (dir ? (TT / 64 - 1 - n) * 64 : n * 64);
    float bl[16]; { float cs = 0.f;
#pragma unroll
        for (int i = 0; i < 16; ++i) { cs += lf[i]; bl[i] = cs; }
        *(LAS float*)(lds + HG_SEG + (seg * 128 + dA) * 4) = cs; }
    __syncthreads();
    {
        const float p0 = *(LAS float*)(lds + HG_SEG + (0 * 128 + dA) * 4), p1 = *(LAS float*)(lds + HG_SEG + (1 * 128 + dA) * 4),
                    p2 = *(LAS float*)(lds + HG_SEG + (2 * 128 + dA) * 4), p3 = *(LAS float*)(lds + HG_SEG + (3 * 128 + dA) * 4);
        const float pre = (seg > 0 ? p0 : 0.f) + (seg > 1 ? p1 : 0.f) + (seg > 2 ? p2 : 0.f);
#pragma unroll
        for (int i = 0; i < 16; ++i) *(LAS float*)(lds + HG_BF + (16 * seg + i) * HG_RSBF + dA * 4) = pre + bl[i];
        if (seg == 0) *(LAS float*)(lds + HG_DEC + dA * 4) = __expf((p0 + p1) + (p2 + p3));
    }
    __syncthreads();
    {
        const unsigned qw[8] = {qB[0].x, qB[0].y, qB[0].z, qB[0].w, qB[1].x, qB[1].y, qB[1].z, qB[1].w};
        const unsigned kw[8] = {kB[0].x, kB[0].y, kB[0].z, kB[0].w, kB[1].x, kB[1].y, kB[1].z, kB[1].w};
        unsigned qo[8], ko[8], eo[8];
#pragma unroll
        for (int i = 0; i < 4; ++i) {
            const f32x4 bb = *(const LAS f32x4*)(lds + HG_BF + tauB * HG_RSBF + dg * 64 + i * 16);
            const f32x4 dc = *(const LAS f32x4*)(lds + HG_DEC + dg * 64 + i * 16);
#pragma unroll
            for (int j = 0; j < 2; ++j) {
                const float e0 = __expf(bb[2 * j]), e1 = __expf(bb[2 * j + 1]);
                const unsigned qq = qw[2 * i + j], kk = kw[2 * i + j];
                const float k0 = bf2f(kk & 0xffffu) * __builtin_amdgcn_rcpf(e0), k1 = bf2f(kk >> 16) * __builtin_amdgcn_rcpf(e1);
                qo[2 * i + j] = pk2(bf2f(qq & 0xffffu) * e0, bf2f(qq >> 16) * e1);
                ko[2 * i + j] = pk2(k0, k1);
                eo[2 * i + j] = pk2(k0 * dc[2 * j], k1 * dc[2 * j + 1]);
            }
        }
        *(LAS v4u*)(lds + HG_QI + tauB * HG_RSD + dg * 32) = (v4u){qo[0], qo[1], qo[2], qo[3]}; *(LAS v4u*)(lds + HG_QI + tauB * HG_RSD + dg * 32 + 16) = (v4u){qo[4], qo[5], qo[6], qo[7]};
        *(LAS v4u*)(lds + HG_KK + tauB * HG_RSD + dg * 32) = (v4u){ko[0], ko[1], ko[2], ko[3]}; *(LAS v4u*)(lds + HG_KK + tauB * HG_RSD + dg * 32 + 16) = (v4u){ko[4], ko[5], ko[6], ko[7]};
        *(LAS v4u*)(lds + HG_KE + tauB * HG_RSD + dg * 32) = (v4u){eo[0], eo[1], eo[2], eo[3]}; *(LAS v4u*)(lds + HG_KE + tauB * HG_RSD + dg * 32 + 16) = (v4u){eo[4], eo[5], eo[6], eo[7]};
        *(LAS v4u*)(lds + HG_V + tauB * HG_RSS + dg * 16) = vB;
    }
    __syncthreads();
    if (n + 2 < TT / 64) hgrn_load(c, n + 2, lf, qB, kB, vB);
    const int ei = wave & 3, tp = wave >> 2;
    v2u ket[2][2], vt[4][2][2];
    asm volatile("ds_read_b64_tr_b16 %0, %4\n\tds_read_b64_tr_b16 %1, %4 offset:1088\n\tds_read_b64_tr_b16 %2, %4 offset:8704\n\tds_read_b64_tr_b16 %3, %4 offset:9792"
                 : "=&v"(ket[0][0]), "=&v"(ket[0][1]), "=&v"(ket[1][0]), "=&v"(ket[1][1]) : "v"(c.ke_tr) : "memory");
#define HG_VTR(e4, o0, o1, o2, o3) asm volatile("ds_read_b64_tr_b16 %0, %4 offset:" #o0 "\n\tds_read_b64_tr_b16 %1, %4 offset:" #o1 "\n\tds_read_b64_tr_b16 %2, %4 offset:" #o2 "\n\tds_read_b64_tr_b16 %3, %4 offset:" #o3 \
                 : "=&v"(vt[e4][0][0]), "=&v"(vt[e4][0][1]), "=&v"(vt[e4][1][0]), "=&v"(vt[e4][1][1]) : "v"(c.v_tr) : "memory")
    HG_VTR(0, 0, 576, 4608, 5184); HG_VTR(1, 32, 608, 4640, 5216); HG_VTR(2, 64, 640, 4672, 5248); HG_VTR(3, 96, 672, 4704, 5280);
#undef HG_VTR
    {
        const int ti = wave & 3;
#pragma unroll
        for (int sii = 0; sii < 2; ++sii) {
            const int si = tp * 2 + sii;
            v2u w = (v2u){0u, 0u};
            if (si <= ti) {
                f32x4 a = (f32x4){0.f, 0.f, 0.f, 0.f};
#pragma unroll
                for (int kk = 0; kk < 4; ++kk)
                    a = __builtin_amdgcn_mfma_f32_16x16x32_bf16(lds_frag(lds + HG_KK + (16 * si + lr) * HG_RSD + kk * 64 + lq * 16), lds_frag(lds + HG_QI + (16 * ti + lr) * HG_RSD + kk * 64 + lq * 16), a, 0, 0, 0);
                const int s0 = 16 * si + 4 * lq, t = 16 * ti + lr;
                w.x = pk2(s0 + 0 <= t ? a[0] : 0.f, s0 + 1 <= t ? a[1] : 0.f); w.y = pk2(s0 + 2 <= t ? a[2] : 0.f, s0 + 3 <= t ? a[3] : 0.f);
            }
            *(LAS v2u*)(lds + HG_AM + (16 * ti + lr) * HG_RSS + (16 * si + 4 * lq) * 2) = w;
        }
    }
    f32x4 o[2];
#pragma unroll
    for (int tt = 0; tt < 2; ++tt) {
        o[tt] = (f32x4){0.f, 0.f, 0.f, 0.f};
#pragma unroll
        for (int kk = 0; kk < 4; ++kk)
            o[tt] = __builtin_amdgcn_mfma_f32_16x16x32_bf16(lds_frag(lds + HG_ST + (16 * ei + lr) * HG_RSD + kk * 64 + lq * 16), lds_frag(lds + HG_QI + (16 * (2 * tp + tt) + lr) * HG_RSD + kk * 64 + lq * 16), o[tt], 0, 0, 0);
    }
    asm volatile("s_waitcnt lgkmcnt(0)"
                 : "+v"(ket[0][0]), "+v"(ket[0][1]), "+v"(ket[1][0]), "+v"(ket[1][1]),
                   "+v"(vt[0][0][0]), "+v"(vt[0][0][1]), "+v"(vt[0][1][0]), "+v"(vt[0][1][1]), "+v"(vt[1][0][0]), "+v"(vt[1][0][1]), "+v"(vt[1][1][0]), "+v"(vt[1][1][1]),
                   "+v"(vt[2][0][0]), "+v"(vt[2][0][1]), "+v"(vt[2][1][0]), "+v"(vt[2][1][1]), "+v"(vt[3][0][0]), "+v"(vt[3][0][1]), "+v"(vt[3][1][0]), "+v"(vt[3][1][1]) :: "memory");
    {
        const f32x4 dv = *(const LAS f32x4*)(lds + HG_DEC + (16 * wave + 4 * lq) * 4);
#pragma unroll
        for (int e4 = 0; e4 < 4; ++e4) S[e4] = S[e4] * dv;
#pragma unroll
        for (int kk = 0; kk < 2; ++kk) {
            const pg8::bf16x8 af = mk_frag(ket[kk][0], ket[kk][1]);
#pragma unroll
            for (int e4 = 0; e4 < 4; ++e4) S[e4] = __builtin_amdgcn_mfma_f32_16x16x32_bf16(af, mk_frag(vt[e4][kk][0], vt[e4][kk][1]), S[e4], 0, 0, 0);
        }
    }
    const pg8::bf16x8 vf0 = ei == 0 ? mk_frag(vt[0][0][0], vt[0][0][1]) : ei == 1 ? mk_frag(vt[1][0][0], vt[1][0][1]) : ei == 2 ? mk_frag(vt[2][0][0], vt[2][0][1]) : mk_frag(vt[3][0][0], vt[3][0][1]);
    const pg8::bf16x8 vf1 = ei == 0 ? mk_frag(vt[0][1][0], vt[0][1][1]) : ei == 1 ? mk_frag(vt[1][1][0], vt[1][1][1]) : ei == 2 ? mk_frag(vt[2][1][0], vt[2][1][1]) : mk_frag(vt[3][1][0], vt[3][1][1]);
    __syncthreads();
#pragma unroll
    for (int tt = 0; tt < 2; ++tt) {
        o[tt] = __builtin_amdgcn_mfma_f32_16x16x32_bf16(vf0, lds_frag(lds + HG_AM + (16 * (2 * tp + tt) + lr) * HG_RSS + 0 * 64 + lq * 16), o[tt], 0, 0, 0);
        o[tt] = __builtin_amdgcn_mfma_f32_16x16x32_bf16(vf1, lds_frag(lds + HG_AM + (16 * (2 * tp + tt) + lr) * HG_RSS + 1 * 64 + lq * 16), o[tt], 0, 0, 0);
        const int t = 16 * (2 * tp + tt) + lr;
        *(f32x4*)(c.Op + (size_t)(dir ? tb + 63 - t : tb + t) * 512 + c.h * 128 + c.vh * 64 + 16 * ei + 4 * lq) = o[tt];
    }
#pragma unroll
    for (int e4 = 0; e4 < 4; ++e4) { v2u w; w.x = pk2(S[e4][0], S[e4][1]); w.y = pk2(S[e4][2], S[e4][3]); *(LAS v2u*)(lds + HG_ST + (16 * e4 + lr) * HG_RSD + (16 * wave + 4 * lq) * 2) = w; }
}
__device__ __forceinline__ void hgrn_unit(LAS unsigned char* lds, int unit, const bf16* Qb, const bf16* KFb, const bf16* KBb, const bf16* Vb, const float* LFb, const float* LBb,
                                          float* OFb, float* OBb, int tid, int lane, int wave) {
    HgCtx c;
    c.lds = lds; c.vh = unit & 1; c.dir = (unit >> 1) & 1; c.h = (unit >> 2) & 3; c.b = unit >> 4;
    c.Qb = Qb; c.Vb = Vb; c.Kp = c.dir ? KBb : KFb; c.Lp = c.dir ? LBb : LFb; c.Op = c.dir ? OBb : OFb;
    c.lane = lane; c.wave = wave; c.lr = lane & 15; c.lq = lane >> 4;
    c.dA = tid & 127; c.seg = tid >> 7;
    c.tauB = tid >> 3; c.dg = tid & 7;
    for (int i = tid; i < 64 * HG_RSD / 16; i += NTHR) *(LAS v4u*)(lds + HG_ST + i * 16) = (v4u){0u, 0u, 0u, 0u};
    f32x4 S[4];
#pragma unroll
    for (int i = 0; i < 4; ++i) S[i] = (f32x4){0.f, 0.f, 0.f, 0.f};
#pragma unroll
    for (int i = 0; i < 16; ++i) { const int tau = 16 * c.seg + i; c.offA[i] = (unsigned)((c.dir ? 63 - tau : tau) * 512 + c.dA); }
    c.offB = (unsigned)((c.dir ? 63 - c.tauB : c.tauB) * 512 + 16 * c.dg); c.offV = (unsigned)((c.dir ? 63 - c.tauB : c.tauB) * 512 + c.vh * 64 + 8 * c.dg);
    const unsigned trrow = (unsigned)(8 * c.lq + ((lane & 15) >> 2)), trcol = (unsigned)(4 * (lane & 3));
    c.ke_tr = (unsigned)(size_t)(lds + HG_KE) + trrow * HG_RSD + (16 * wave + trcol) * 2;
    c.v_tr = (unsigned)(size_t)(lds + HG_V) + trrow * HG_RSS + trcol * 2;
    float lf0[16], lf1[16]; v4u qB0[2], kB0[2], vB0, qB1[2], kB1[2], vB1;
    hgrn_load(c, 0, lf0, qB0, kB0, vB0); hgrn_load(c, 1, lf1, qB1, kB1, vB1);
#pragma unroll 1
    for (int n = 0; n < TT / 64; n += 2) { hgrn_chunk(c, n, lf0, qB0, kB0, vB0, S); hgrn_chunk(c, n + 1, lf1, qB1, kB1, vB1, S); }
    __syncthreads();
}

__device__ __forceinline__ void router_finish(float (&a)[NE], int m, int lane, const float* router_b, LAS int* lcnt, LAS unsigned* sbw, float* GATE) {
#define RF_STEP(s2, n) { const bool up = (lane & (s2)) != 0; _Pragma("unroll") for (int i = 0; i < (n); ++i) { const float k1 = up ? a[i + (n)] : a[i], x1 = up ? a[i] : a[i + (n)]; a[i] = k1 + __shfl_xor(x1, (s2)); } }
    RF_STEP(32, 16) RF_STEP(16, 8) RF_STEP(8, 4) RF_STEP(4, 2) RF_STEP(2, 1)
#undef RF_STEP
    float lg = a[0] + __shfl_xor(a[0], 1);
    const int myE = lane >> 1;
    lg += router_b[myE];
    float tv[TOPK]; int ti[TOPK];
#pragma unroll
    for (int k = 0; k < TOPK; ++k) {
        float mx = lg;
#pragma unroll
        for (int o = 1; o < 64; o <<= 1) mx = fmaxf(mx, __shfl_xor(mx, o));
        int cand = (lg == mx) ? myE : 99;
#pragma unroll
        for (int o = 1; o < 64; o <<= 1) cand = min(cand, __shfl_xor(cand, o));
        tv[k] = mx; ti[k] = cand;
        if (myE == cand) lg = -INFINITY;
    }
    const float e1 = __expf(tv[1] - tv[0]), e2 = __expf(tv[2] - tv[0]), e3 = __expf(tv[3] - tv[0]);
    const float inv = 1.0f / (1.0f + e1 + e2 + e3);
    if (lane < TOPK && m < MTOK) {
        const int ek = lane == 0 ? ti[0] : lane == 1 ? ti[1] : lane == 2 ? ti[2] : ti[3];
        const float gk = (lane == 0 ? 1.0f : lane == 1 ? e1 : lane == 2 ? e2 : e3) * inv;
        const int lr = __hip_atomic_fetch_add(&lcnt[ek], 1, __ATOMIC_RELAXED, __HIP_MEMORY_SCOPE_WORKGROUP);
        sbw[lane] = ((unsigned)ek << 16) | (unsigned)lr;
        GATE[(size_t)m * TOPK + lane] = gk;
    }
}

#ifndef PROBE_DELAY
#define PROBE_DELAY 0
#endif
__device__ __forceinline__ void probe_delay(int us100) { const unsigned long long t0 = __builtin_amdgcn_s_memrealtime(); while (__builtin_amdgcn_s_memrealtime() - t0 < (unsigned long long)us100) __builtin_amdgcn_s_sleep(2); }
constexpr int H3_QI = 0, H3_KK = 34816, H3_V = 69632, H3_DEC = 88064, H3_ST = 89088, H3_AM = 106496, H3_LH = 115712, H3_LL = 133120, H3_END = 150528;
constexpr int H3_BUFD = 17408, H3_BUFV = 9216, H3_BUFDEC = 512;
static_assert(H3_END <= LDSCTL_OFF, "recurrence LDS image below the control words");
struct Hg3 {
    LAS unsigned char* lds; const bf16 *Qb, *Kp, *Vb; const float* Lp; float* Op;
    int b, h, dir, vh, lane, lr, lq;
};
__device__ __forceinline__ size_t hg3_row(const Hg3& c, int n, int t) {
    const int tb = c.b * TT + (c.dir ? (TT / 64 - 1 - n) * 64 : n * 64);
    return (size_t)(c.dir ? tb + 63 - t : tb + t) * 512 + c.h * 128;
}
struct Hg3LV { f32x4 lf[8]; v4u v[2]; };
struct Hg3QK { v2u q[2][4], k[2][4]; };
__device__ __forceinline__ void gld16(f32x4& d, const void* p) { asm volatile("global_load_dwordx4 %0, %1, off" : "=v"(d) : "v"(p) : "memory"); }
__device__ __forceinline__ void gld16u(v4u& d, const void* p) { asm volatile("global_load_dwordx4 %0, %1, off" : "=v"(d) : "v"(p) : "memory"); }
__device__ __forceinline__ void gld8(v2u& d, const void* p) { asm volatile("global_load_dwordx2 %0, %1, off" : "=v"(d) : "v"(p) : "memory"); }
__device__ __forceinline__ void hg3_load_lv(const Hg3& c, int n, int pt, Hg3LV& in) {
    const size_t r = hg3_row(c, n, pt >> 2);
#pragma unroll
    for (int i = 0; i < 8; ++i) gld16(in.lf[i], c.Lp + r + 32 * (pt & 3) + 4 * i);
    gld16u(in.v[0], c.Vb + r + c.vh * 64 + 16 * (pt & 3)); gld16u(in.v[1], c.Vb + r + c.vh * 64 + 16 * (pt & 3) + 8);
}
__device__ __forceinline__ void hg3_load_qk(const Hg3& c, int n, int pw, Hg3QK& in) {
#pragma unroll
    for (int ti = 0; ti < 4; ++ti) { const size_t r = hg3_row(c, n, 16 * ti + c.lr);
#pragma unroll
        for (int dt = 0; dt < 2; ++dt) { const int d0 = 16 * (2 * pw + dt) + 4 * c.lq; gld8(in.q[dt][ti], c.Qb + r + d0); gld8(in.k[dt][ti], c.Kp + r + d0); } }
}
#define H3_USE_LV(x) asm volatile("" : "+v"((x).lf[0]), "+v"((x).lf[1]), "+v"((x).lf[2]), "+v"((x).lf[3]), "+v"((x).lf[4]), "+v"((x).lf[5]), "+v"((x).lf[6]), "+v"((x).lf[7]), "+v"((x).v[0]), "+v"((x).v[1]))
#define H3_USE_QK(x) asm volatile("" : "+v"((x).q[0][0]), "+v"((x).q[0][1]), "+v"((x).q[0][2]), "+v"((x).q[0][3]), "+v"((x).q[1][0]), "+v"((x).q[1][1]), "+v"((x).q[1][2]), "+v"((x).q[1][3]), \
                                           "+v"((x).k[0][0]), "+v"((x).k[0][1]), "+v"((x).k[0][2]), "+v"((x).k[0][3]), "+v"((x).k[1][0]), "+v"((x).k[1][1]), "+v"((x).k[1][2]), "+v"((x).k[1][3]))
__device__ __forceinline__ unsigned hg3_hi_lo(float x, float y, unsigned& lo) {
    const unsigned hi = pk2(x, y);
    lo = pk2(x - bf2f(hi & 0xffffu), y - bf2f(hi >> 16));
    return hi;
}
__device__ __forceinline__ void hg3_prep_a(const Hg3& c, int buf, int pt, const Hg3LV& in) {
    const int t = pt >> 2, dq = pt & 3;
#pragma unroll
    for (int i = 0; i < 8; ++i) { unsigned l0, l1; const unsigned h0 = hg3_hi_lo(in.lf[i].x, in.lf[i].y, l0), h1 = hg3_hi_lo(in.lf[i].z, in.lf[i].w, l1);
        *(LAS v2u*)(c.lds + H3_LH + t * 272 + (32 * dq + 4 * i) * 2) = (v2u){h0, h1}; *(LAS v2u*)(c.lds + H3_LL + t * 272 + (32 * dq + 4 * i) * 2) = (v2u){l0, l1}; }
    *(LAS v4u*)(c.lds + H3_V + buf * H3_BUFV + t * 144 + dq * 32) = in.v[0]; *(LAS v4u*)(c.lds + H3_V + buf * H3_BUFV + t * 144 + dq * 32 + 16) = in.v[1];
}
__device__ __forceinline__ void hg3_prep_b(const Hg3& c, int buf, int pw, const Hg3QK& in, const pg8::bf16x8 (&U)[4]) {
    LAS unsigned char* lds = c.lds; const int lr = c.lr, lq = c.lq, lane = c.lane;
    const unsigned trrow = (unsigned)(8 * lq + ((lane & 15) >> 2)), trcol = (unsigned)(4 * (lane & 3));
    const pg8::bf16x8 ones = (pg8::bf16x8)(v4u){0x3F803F80u, 0x3F803F80u, 0x3F803F80u, 0x3F803F80u};
#pragma unroll
    for (int dt = 0; dt < 2; ++dt) {
        const int dtile = 2 * pw + dt;
        v2u fh[2][2], fl[2][2];
        const unsigned ah = (unsigned)(size_t)(lds + H3_LH) + trrow * 272 + (16 * dtile + trcol) * 2, al = ah + (H3_LL - H3_LH);
        asm volatile("ds_read_b64_tr_b16 %0, %8\n\tds_read_b64_tr_b16 %1, %8 offset:1088\n\tds_read_b64_tr_b16 %2, %8 offset:8704\n\tds_read_b64_tr_b16 %3, %8 offset:9792\n\t"
                     "ds_read_b64_tr_b16 %4, %9\n\tds_read_b64_tr_b16 %5, %9 offset:1088\n\tds_read_b64_tr_b16 %6, %9 offset:8704\n\tds_read_b64_tr_b16 %7, %9 offset:9792\n\ts_waitcnt lgkmcnt(0)"
                     : "=&v"(fh[0][0]), "=&v"(fh[0][1]), "=&v"(fh[1][0]), "=&v"(fh[1][1]), "=&v"(fl[0][0]), "=&v"(fl[0][1]), "=&v"(fl[1][0]), "=&v"(fl[1][1]) : "v"(ah), "v"(al) : "memory");
        const pg8::bf16x8 H0 = mk_frag(fh[0][0], fh[0][1]), H1 = mk_frag(fh[1][0], fh[1][1]), L0 = mk_frag(fl[0][0], fl[0][1]), L1 = mk_frag(fl[1][0], fl[1][1]);
        f32x4 bt[4];
        const f32x4 z = (f32x4){0.f, 0.f, 0.f, 0.f};
        bt[0] = __builtin_amdgcn_mfma_f32_16x16x32_bf16(L0, U[0], z, 0, 0, 0);    bt[0] = __builtin_amdgcn_mfma_f32_16x16x32_bf16(H0, U[0], bt[0], 0, 0, 0);
        bt[1] = __builtin_amdgcn_mfma_f32_16x16x32_bf16(L0, U[1], z, 0, 0, 0);    bt[1] = __builtin_amdgcn_mfma_f32_16x16x32_bf16(H0, U[1], bt[1], 0, 0, 0);
        bt[2] = __builtin_amdgcn_mfma_f32_16x16x32_bf16(L0, ones, z, 0, 0, 0);    bt[2] = __builtin_amdgcn_mfma_f32_16x16x32_bf16(L1, U[2], bt[2], 0, 0, 0);
        bt[2] = __builtin_amdgcn_mfma_f32_16x16x32_bf16(H0, ones, bt[2], 0, 0, 0); bt[2] = __builtin_amdgcn_mfma_f32_16x16x32_bf16(H1, U[2], bt[2], 0, 0, 0);
        bt[3] = __builtin_amdgcn_mfma_f32_16x16x32_bf16(L0, ones, z, 0, 0, 0);    bt[3] = __builtin_amdgcn_mfma_f32_16x16x32_bf16(L1, U[3], bt[3], 0, 0, 0);
        bt[3] = __builtin_amdgcn_mfma_f32_16x16x32_bf16(H0, ones, bt[3], 0, 0, 0); bt[3] = __builtin_amdgcn_mfma_f32_16x16x32_bf16(H1, U[3], bt[3], 0, 0, 0);
        f32x4 de;
#pragma unroll
        for (int r = 0; r < 4; ++r) de[r] = __expf(__shfl(bt[3][r], 16 * lq + 15));
        if (lr == 0) *(LAS f32x4*)(lds + H3_DEC + buf * H3_BUFDEC + (16 * dtile + 4 * lq) * 4) = de;
#pragma unroll
        for (int ti = 0; ti < 4; ++ti) {
            const v2u qq = in.q[dt][ti], kk = in.k[dt][ti];
            const float e0 = __expf(bt[ti][0]), e1 = __expf(bt[ti][1]), e2 = __expf(bt[ti][2]), e3 = __expf(bt[ti][3]);
            v2u qo, ko;
            qo.x = pk2(bf2f(qq.x & 0xffffu) * e0, bf2f(qq.x >> 16) * e1); qo.y = pk2(bf2f(qq.y & 0xffffu) * e2, bf2f(qq.y >> 16) * e3);
            ko.x = pk2(bf2f(kk.x & 0xffffu) * __builtin_amdgcn_rcpf(e0), bf2f(kk.x >> 16) * __builtin_amdgcn_rcpf(e1));
            ko.y = pk2(bf2f(kk.y & 0xffffu) * __builtin_amdgcn_rcpf(e2), bf2f(kk.y >> 16) * __builtin_amdgcn_rcpf(e3));
            const int off = (16 * ti + lr) * 272 + (16 * dtile + 4 * lq) * 2;
            *(LAS v2u*)(lds + H3_QI + buf * H3_BUFD + off) = qo; *(LAS v2u*)(lds + H3_KK + buf * H3_BUFD + off) = ko;
        }
    }
}
__device__ __forceinline__ void hg3_stage1(const Hg3& c, int buf, int mw, f32x4 (&S)[2][4], f32x4 (&o)[2][2], v2u (&vt)[4][2][2]) {
    LAS unsigned char* lds = c.lds; const int lr = c.lr, lq = c.lq, lane = c.lane;
    const LAS unsigned char* QI = lds + H3_QI + buf * H3_BUFD; const LAS unsigned char* KK = lds + H3_KK + buf * H3_BUFD;
    const unsigned trrow = (unsigned)(8 * lq + ((lane & 15) >> 2)), trcol = (unsigned)(4 * (lane & 3));
    const unsigned kk_tr = (unsigned)(size_t)KK + trrow * 272 + (32 * mw + trcol) * 2;
    const unsigned v_tr = (unsigned)(size_t)(lds + H3_V + buf * H3_BUFV) + trrow * 144 + trcol * 2;
    const int tp = mw >> 1, ep = mw & 1;
    pg8::bf16x8 qf[2][4], sf[2][4], kf[3][4];
#pragma unroll
    for (int bq = 0; bq < 2; ++bq)
#pragma unroll
        for (int kk = 0; kk < 4; ++kk) { qf[bq][kk] = lds_frag(QI + (16 * (2 * tp + bq) + lr) * 272 + kk * 64 + lq * 16); sf[bq][kk] = lds_frag(lds + H3_ST + (16 * (2 * ep + bq) + lr) * 272 + kk * 64 + lq * 16); }
#pragma unroll
    for (int a = 0; a < 2; ++a)
#pragma unroll
        for (int bq = 0; bq < 2; ++bq) o[a][bq] = (f32x4){0.f, 0.f, 0.f, 0.f};
#pragma unroll
    for (int kk = 0; kk < 4; ++kk) {
        o[0][0] = __builtin_amdgcn_mfma_f32_16x16x32_bf16(sf[0][kk], qf[0][kk], o[0][0], 0, 0, 0); o[0][1] = __builtin_amdgcn_mfma_f32_16x16x32_bf16(sf[0][kk], qf[1][kk], o[0][1], 0, 0, 0);
        o[1][0] = __builtin_amdgcn_mfma_f32_16x16x32_bf16(sf[1][kk], qf[0][kk], o[1][0], 0, 0, 0); o[1][1] = __builtin_amdgcn_mfma_f32_16x16x32_bf16(sf[1][kk], qf[1][kk], o[1][1], 0, 0, 0);
    }
    __builtin_amdgcn_sched_barrier(0);
    const int ks0 = mw == 3 ? 1 : 0;
    if (mw != 1) {
#pragma unroll
        for (int x = 0; x < 3; ++x)
#pragma unroll
            for (int kk = 0; kk < 4; ++kk) kf[x][kk] = lds_frag(KK + (16 * (ks0 + x) + lr) * 272 + kk * 64 + lq * 16);
    }
    v2u kt[2][2][2];
    {
        f32x4 at[4];
#pragma unroll
        for (int i = 0; i < 4; ++i) at[i] = (f32x4){0.f, 0.f, 0.f, 0.f};
        if (mw != 1) {
#pragma unroll
            for (int kk = 0; kk < 4; ++kk) {
                at[0] = __builtin_amdgcn_mfma_f32_16x16x32_bf16(kf[0][kk], mw == 3 ? qf[1][kk] : qf[0][kk], at[0], 0, 0, 0);
                at[1] = __builtin_amdgcn_mfma_f32_16x16x32_bf16(mw == 0 ? kf[0][kk] : kf[1][kk], mw == 2 ? qf[0][kk] : qf[1][kk], at[1], 0, 0, 0);
                at[2] = __builtin_amdgcn_mfma_f32_16x16x32_bf16(mw == 0 ? kf[1][kk] : kf[2][kk], mw == 2 ? qf[0][kk] : qf[1][kk], at[2], 0, 0, 0);
                if (mw == 2) at[3] = __builtin_amdgcn_mfma_f32_16x16x32_bf16(kf[0][kk], qf[1][kk], at[3], 0, 0, 0);
            }
        }
    asm volatile("ds_read_b64_tr_b16 %0, %8\n\tds_read_b64_tr_b16 %1, %8 offset:1088\n\tds_read_b64_tr_b16 %2, %8 offset:8704\n\tds_read_b64_tr_b16 %3, %8 offset:9792\n\t"
                 "ds_read_b64_tr_b16 %4, %8 offset:32\n\tds_read_b64_tr_b16 %5, %8 offset:1120\n\tds_read_b64_tr_b16 %6, %8 offset:8736\n\tds_read_b64_tr_b16 %7, %8 offset:9824"
                 : "=&v"(kt[0][0][0]), "=&v"(kt[0][0][1]), "=&v"(kt[0][1][0]), "=&v"(kt[0][1][1]), "=&v"(kt[1][0][0]), "=&v"(kt[1][0][1]), "=&v"(kt[1][1][0]), "=&v"(kt[1][1][1]) : "v"(kk_tr) : "memory");
#define H3_VTR(e4, o0, o1, o2, o3) asm volatile("ds_read_b64_tr_b16 %0, %4 offset:" #o0 "\n\tds_read_b64_tr_b16 %1, %4 offset:" #o1 "\n\tds_read_b64_tr_b16 %2, %4 offset:" #o2 "\n\tds_read_b64_tr_b16 %3, %4 offset:" #o3 \
                 : "=&v"(vt[e4][0][0]), "=&v"(vt[e4][0][1]), "=&v"(vt[e4][1][0]), "=&v"(vt[e4][1][1]) : "v"(v_tr) : "memory")
    H3_VTR(0, 0, 576, 4608, 5184); H3_VTR(1, 32, 608, 4640, 5216); H3_VTR(2, 64, 640, 4672, 5248); H3_VTR(3, 96, 672, 4704, 5280);
#undef H3_VTR
#pragma unroll
        for (int i = 0; i < 4; ++i) {
            int si, ti; bool have = true, zero = false;
            if (mw == 0) { si = i == 2 ? 1 : 0; ti = i == 0 ? 0 : 1; have = i < 3; }
            else if (mw == 1) { si = 1; ti = 0; have = i == 0; zero = true; }
            else if (mw == 2) { si = i == 3 ? 0 : i; ti = i == 3 ? 3 : 2; }
            else { si = i == 3 ? 3 : i + 1; ti = i == 3 ? 2 : 3; zero = i == 3; }
            if (have) {
                const int s0 = 16 * si + 4 * lq, t = 16 * ti + lr; v2u w = (v2u){0u, 0u};
                if (!zero) { w.x = pk2(s0 + 0 <= t ? at[i][0] : 0.f, s0 + 1 <= t ? at[i][1] : 0.f); w.y = pk2(s0 + 2 <= t ? at[i][2] : 0.f, s0 + 3 <= t ? at[i][3] : 0.f); }
                *(LAS v2u*)(lds + H3_AM + (16 * ti + lr) * 144 + (16 * si + 4 * lq) * 2) = w;
            }
        }
    }
    asm volatile("s_waitcnt lgkmcnt(0)"
                 : "+v"(kt[0][0][0]), "+v"(kt[0][0][1]), "+v"(kt[0][1][0]), "+v"(kt[0][1][1]), "+v"(kt[1][0][0]), "+v"(kt[1][0][1]), "+v"(kt[1][1][0]), "+v"(kt[1][1][1]),
                   "+v"(vt[0][0][0]), "+v"(vt[0][0][1]), "+v"(vt[0][1][0]), "+v"(vt[0][1][1]), "+v"(vt[1][0][0]), "+v"(vt[1][0][1]), "+v"(vt[1][1][0]), "+v"(vt[1][1][1]),
                   "+v"(vt[2][0][0]), "+v"(vt[2][0][1]), "+v"(vt[2][1][0]), "+v"(vt[2][1][1]), "+v"(vt[3][0][0]), "+v"(vt[3][0][1]), "+v"(vt[3][1][0]), "+v"(vt[3][1][1]) :: "memory");
#pragma unroll
    for (int dt = 0; dt < 2; ++dt) {
#pragma unroll
        for (int kk = 0; kk < 2; ++kk) {
            const pg8::bf16x8 af = mk_frag(kt[dt][kk][0], kt[dt][kk][1]);
#pragma unroll
            for (int e4 = 0; e4 < 4; ++e4) S[dt][e4] = __builtin_amdgcn_mfma_f32_16x16x32_bf16(af, mk_frag(vt[e4][kk][0], vt[e4][kk][1]), S[dt][e4], 0, 0, 0);
        }
        const f32x4 dv = *(const LAS f32x4*)(lds + H3_DEC + buf * H3_BUFDEC + (16 * (2 * mw + dt) + 4 * lq) * 4);
#pragma unroll
        for (int e4 = 0; e4 < 4; ++e4) S[dt][e4] = S[dt][e4] * dv;
    }
}
__device__ __forceinline__ void hg3_stage2(const Hg3& c, int n, int mw, const f32x4 (&S)[2][4], f32x4 (&o)[2][2], const v2u (&vt)[4][2][2]) {
    LAS unsigned char* lds = c.lds; const int lr = c.lr, lq = c.lq;
#pragma unroll
    for (int bq = 0; bq < 2; ++bq) {
        const int ti = 2 * (mw >> 1) + bq;
        const pg8::bf16x8 a0 = lds_frag(lds + H3_AM + (16 * ti + lr) * 144 + 0 * 64 + lq * 16);
#pragma unroll
        for (int a = 0; a < 2; ++a) { const int e4 = 2 * (mw & 1) + a;
            const pg8::bf16x8 vf = e4 == 0 ? mk_frag(vt[0][0][0], vt[0][0][1]) : e4 == 1 ? mk_frag(vt[1][0][0], vt[1][0][1]) : e4 == 2 ? mk_frag(vt[2][0][0], vt[2][0][1]) : mk_frag(vt[3][0][0], vt[3][0][1]);
            o[a][bq] = __builtin_amdgcn_mfma_f32_16x16x32_bf16(vf, a0, o[a][bq], 0, 0, 0); }
        if (mw >> 1) {
            const pg8::bf16x8 a1 = lds_frag(lds + H3_AM + (16 * ti + lr) * 144 + 1 * 64 + lq * 16);
#pragma unroll
            for (int a = 0; a < 2; ++a) { const int e4 = 2 * (mw & 1) + a;
                const pg8::bf16x8 vf = e4 == 0 ? mk_frag(vt[0][1][0], vt[0][1][1]) : e4 == 1 ? mk_frag(vt[1][1][0], vt[1][1][1]) : e4 == 2 ? mk_frag(vt[2][1][0], vt[2][1][1]) : mk_frag(vt[3][1][0], vt[3][1][1]);
                o[a][bq] = __builtin_amdgcn_mfma_f32_16x16x32_bf16(vf, a1, o[a][bq], 0, 0, 0); }
        }
#pragma unroll
        for (int a = 0; a < 2; ++a)
            *(f32x4*)(c.Op + hg3_row(c, n, 16 * ti + lr) + c.vh * 64 + 16 * (2 * (mw & 1) + a) + 4 * lq) = o[a][bq];
    }
#pragma unroll
    for (int dt = 0; dt < 2; ++dt)
#pragma unroll
        for (int e4 = 0; e4 < 4; ++e4) { v2u w; w.x = pk2(S[dt][e4][0], S[dt][e4][1]); w.y = pk2(S[dt][e4][2], S[dt][e4][3]);
            *(LAS v2u*)(lds + H3_ST + (16 * e4 + lr) * 272 + (16 * (2 * mw + dt) + 4 * lq) * 2) = w; }
}
__device__ __forceinline__ void hgrn3_unit(LAS unsigned char* lds, int unit, const bf16* Qb, const bf16* KFb, const bf16* KBb, const bf16* Vb, const float* LFb, const float* LBb,
                                           float* OFb, float* OBb, int tid, int lane, int wave) {
    Hg3 c;
    c.lds = lds; c.vh = unit & 1; c.dir = (unit >> 1) & 1; c.h = (unit >> 2) & 3; c.b = unit >> 4;
    c.Qb = Qb; c.Vb = Vb; c.Kp = c.dir ? KBb : KFb; c.Lp = c.dir ? LBb : LFb; c.Op = c.dir ? OBb : OFb;
    c.lane = lane; c.lr = lane & 15; c.lq = lane >> 4;
    constexpr int NCH = TT / 64;
    for (int i = tid; i < 64 * 272 / 16; i += NTHR) *(LAS v4u*)(lds + H3_ST + i * 16) = (v4u){0u, 0u, 0u, 0u};
    if (wave < 4) {
        const int pt = tid, pw = wave;
        pg8::bf16x8 U[4];
#pragma unroll
        for (int u = 0; u < 4; ++u) { const int kk = u >> 1, ti = u; unsigned wv[4];
#pragma unroll
            for (int j2 = 0; j2 < 4; ++j2) { const int s = 32 * kk + 8 * c.lq + 2 * j2, t = 16 * ti + c.lr; wv[j2] = (s <= t ? 0x3F80u : 0u) | (s + 1 <= t ? 0x3F800000u : 0u); }
            U[u] = (pg8::bf16x8)(v4u){wv[0], wv[1], wv[2], wv[3]}; }
        Hg3LV lv0, lv1; Hg3QK qk;
        hg3_load_lv(c, 0, pt, lv0); hg3_load_qk(c, 0, pw, qk); hg3_load_lv(c, 1, pt, lv1);
        asm volatile("s_waitcnt vmcnt(0)" ::: "memory"); H3_USE_LV(lv0); H3_USE_QK(qk); H3_USE_LV(lv1);
        hg3_prep_a(c, 0, pt, lv0);
        __syncthreads();
#define H3_TRIP(j_, LVN, LVC) do { \
            if ((j_) < NCH) { asm volatile("s_waitcnt vmcnt(10)" ::: "memory"); H3_USE_QK(qk); hg3_prep_b(c, (j_) & 1, pw, qk, U); \
                if ((j_) + 1 < NCH) hg3_load_qk(c, (j_) + 1, pw, qk); else hg3_load_qk(c, (j_), pw, qk);     \
                if ((j_) + 2 < NCH) hg3_load_lv(c, (j_) + 2, pt, LVC); else hg3_load_lv(c, (j_), pt, LVC); } \
            if (PROBE_DELAY == 2) probe_delay(100); \
            __syncthreads();                                                                    \
            if ((j_) + 1 < NCH) { asm volatile("s_waitcnt vmcnt(26)" ::: "memory"); H3_USE_LV(LVN); hg3_prep_a(c, ((j_) + 1) & 1, pt, LVN); } \
            __syncthreads();                                                                    \
        } while (0)
#pragma unroll 1
        for (int j = 0; j <= NCH; j += 2) { H3_TRIP(j, lv1, lv0); H3_TRIP(j + 1, lv0, lv1); }
#undef H3_TRIP
        asm volatile("s_waitcnt vmcnt(0)" ::: "memory");
    } else {
        const int mw = wave - 4;
        f32x4 S[2][4], o[2][2]; v2u vt[4][2][2];
#pragma unroll
        for (int a = 0; a < 2; ++a)
#pragma unroll
            for (int e4 = 0; e4 < 4; ++e4) S[a][e4] = (f32x4){0.f, 0.f, 0.f, 0.f};
        __syncthreads();
#pragma unroll 1
        for (int j = 0; j <= NCH + 1; ++j) {
            if (j > 0 && j <= NCH) hg3_stage1(c, (j - 1) & 1, mw, S, o, vt);
            if (PROBE_DELAY == 1) probe_delay(100);
            __syncthreads();
            if (j > 0 && j <= NCH) hg3_stage2(c, j - 1, mw, S, o, vt);
            __syncthreads();
        }
    }
    __syncthreads();
}


struct Hg4LV { f32x4 lf[4]; v4u v; };
struct Hg4QK { v2u q[4], k[4]; };
__device__ __forceinline__ void hg4_load_lv(const Hg3& c, int n, int tid, Hg4LV& in) {
    const size_t r = hg3_row(c, n, tid >> 3);
#pragma unroll
    for (int i = 0; i < 4; ++i) gld16(in.lf[i], c.Lp + r + 16 * (tid & 7) + 4 * i);
    gld16u(in.v, c.Vb + r + c.vh * 64 + 8 * (tid & 7));
}
__device__ __forceinline__ void hg4_load_qk(const Hg3& c, int n, int w, Hg4QK& in) {
#pragma unroll
    for (int ti = 0; ti < 4; ++ti) { const size_t r = hg3_row(c, n, 16 * ti + c.lr) + 16 * w + 4 * c.lq; gld8(in.q[ti], c.Qb + r); gld8(in.k[ti], c.Kp + r); }
}
#define H4_USE_LV(x) asm volatile("" : "+v"((x).lf[0]), "+v"((x).lf[1]), "+v"((x).lf[2]), "+v"((x).lf[3]), "+v"((x).v))
#define H4_USE_QK(x) asm volatile("" : "+v"((x).q[0]), "+v"((x).q[1]), "+v"((x).q[2]), "+v"((x).q[3]), "+v"((x).k[0]), "+v"((x).k[1]), "+v"((x).k[2]), "+v"((x).k[3]))
__device__ __forceinline__ void hg4_prep_a(const Hg3& c, int buf, int tid, const Hg4LV& in) {
    const int t = tid >> 3, dq = tid & 7;
#pragma unroll
    for (int i = 0; i < 4; ++i) { unsigned l0, l1; const unsigned h0 = hg3_hi_lo(in.lf[i].x, in.lf[i].y, l0), h1 = hg3_hi_lo(in.lf[i].z, in.lf[i].w, l1);
        *(LAS v2u*)(c.lds + H3_LH + t * 272 + (16 * dq + 4 * i) * 2) = (v2u){h0, h1}; *(LAS v2u*)(c.lds + H3_LL + t * 272 + (16 * dq + 4 * i) * 2) = (v2u){l0, l1}; }
    *(LAS v4u*)(c.lds + H3_V + buf * H3_BUFV + t * 144 + dq * 16) = in.v;
}
__device__ __forceinline__ void hg4_prep_b(const Hg3& c, int buf, int w, const Hg4QK& in, const pg8::bf16x8 (&U)[4]) {
    LAS unsigned char* lds = c.lds; const int lr = c.lr, lq = c.lq, lane = c.lane;
    const unsigned trrow = (unsigned)(8 * lq + ((lane & 15) >> 2)), trcol = (unsigned)(4 * (lane & 3));
    const pg8::bf16x8 ones = (pg8::bf16x8)(v4u){0x3F803F80u, 0x3F803F80u, 0x3F803F80u, 0x3F803F80u};
    v2u fh[2][2], fl[2][2];
    const unsigned ah = (unsigned)(size_t)(lds + H3_LH) + trrow * 272 + (16 * w + trcol) * 2, al = ah + (H3_LL - H3_LH);
    asm volatile("ds_read_b64_tr_b16 %0, %8\n\tds_read_b64_tr_b16 %1, %8 offset:1088\n\tds_read_b64_tr_b16 %2, %8 offset:8704\n\tds_read_b64_tr_b16 %3, %8 offset:9792\n\t"
                 "ds_read_b64_tr_b16 %4, %9\n\tds_read_b64_tr_b16 %5, %9 offset:1088\n\tds_read_b64_tr_b16 %6, %9 offset:8704\n\tds_read_b64_tr_b16 %7, %9 offset:9792\n\ts_waitcnt lgkmcnt(0)"
                 : "=&v"(fh[0][0]), "=&v"(fh[0][1]), "=&v"(fh[1][0]), "=&v"(fh[1][1]), "=&v"(fl[0][0]), "=&v"(fl[0][1]), "=&v"(fl[1][0]), "=&v"(fl[1][1]) : "v"(ah), "v"(al) : "memory");
    const pg8::bf16x8 H0 = mk_frag(fh[0][0], fh[0][1]), H1 = mk_frag(fh[1][0], fh[1][1]), L0 = mk_frag(fl[0][0], fl[0][1]), L1 = mk_frag(fl[1][0], fl[1][1]);
    f32x4 bt[4];
    const f32x4 z = (f32x4){0.f, 0.f, 0.f, 0.f};
    bt[0] = __builtin_amdgcn_mfma_f32_16x16x32_bf16(L0, U[0], z, 0, 0, 0);    bt[0] = __builtin_amdgcn_mfma_f32_16x16x32_bf16(H0, U[0], bt[0], 0, 0, 0);
    bt[1] = __builtin_amdgcn_mfma_f32_16x16x32_bf16(L0, U[1], z, 0, 0, 0);    bt[1] = __builtin_amdgcn_mfma_f32_16x16x32_bf16(H0, U[1], bt[1], 0, 0, 0);
    bt[2] = __builtin_amdgcn_mfma_f32_16x16x32_bf16(L0, ones, z, 0, 0, 0);    bt[2] = __builtin_amdgcn_mfma_f32_16x16x32_bf16(L1, U[2], bt[2], 0, 0, 0);
    bt[2] = __builtin_amdgcn_mfma_f32_16x16x32_bf16(H0, ones, bt[2], 0, 0, 0); bt[2] = __builtin_amdgcn_mfma_f32_16x16x32_bf16(H1, U[2], bt[2], 0, 0, 0);
    bt[3] = __builtin_amdgcn_mfma_f32_16x16x32_bf16(L0, ones, z, 0, 0, 0);    bt[3] = __builtin_amdgcn_mfma_f32_16x16x32_bf16(L1, U[3], bt[3], 0, 0, 0);
    bt[3] = __builtin_amdgcn_mfma_f32_16x16x32_bf16(H0, ones, bt[3], 0, 0, 0); bt[3] = __builtin_amdgcn_mfma_f32_16x16x32_bf16(H1, U[3], bt[3], 0, 0, 0);
    f32x4 de;
#pragma unroll
    for (int r = 0; r < 4; ++r) de[r] = __expf(__shfl(bt[3][r], 16 * lq + 15));
    if (lr == 0) *(LAS f32x4*)(lds + H3_DEC + buf * H3_BUFDEC + (16 * w + 4 * lq) * 4) = de;
#pragma unroll
    for (int ti = 0; ti < 4; ++ti) {
        const v2u qq = in.q[ti], kk = in.k[ti];
        const float e0 = __expf(bt[ti][0]), e1 = __expf(bt[ti][1]), e2 = __expf(bt[ti][2]), e3 = __expf(bt[ti][3]);
        v2u qo, ko;
        qo.x = pk2(bf2f(qq.x & 0xffffu) * e0, bf2f(qq.x >> 16) * e1); qo.y = pk2(bf2f(qq.y & 0xffffu) * e2, bf2f(qq.y >> 16) * e3);
        ko.x = pk2(bf2f(kk.x & 0xffffu) * __builtin_amdgcn_rcpf(e0), bf2f(kk.x >> 16) * __builtin_amdgcn_rcpf(e1));
        ko.y = pk2(bf2f(kk.y & 0xffffu) * __builtin_amdgcn_rcpf(e2), bf2f(kk.y >> 16) * __builtin_amdgcn_rcpf(e3));
        const int off = (16 * ti + lr) * 272 + (16 * w + 4 * lq) * 2;
        *(LAS v2u*)(lds + H3_QI + buf * H3_BUFD + off) = qo; *(LAS v2u*)(lds + H3_KK + buf * H3_BUFD + off) = ko;
    }
}
__device__ __forceinline__ void hg4_stage1(const Hg3& c, int buf, int w, f32x4 (&S)[4], f32x4 (&o)[2], v2u (&vt)[4][2][2]) {
    LAS unsigned char* lds = c.lds; const int lr = c.lr, lq = c.lq, lane = c.lane;
    const LAS unsigned char* QI = lds + H3_QI + buf * H3_BUFD; const LAS unsigned char* KK = lds + H3_KK + buf * H3_BUFD;
    const unsigned trrow = (unsigned)(8 * lq + ((lane & 15) >> 2)), trcol = (unsigned)(4 * (lane & 3));
    const unsigned kk_tr = (unsigned)(size_t)KK + trrow * 272 + (16 * w + trcol) * 2;
    const unsigned v_tr = (unsigned)(size_t)(lds + H3_V + buf * H3_BUFV) + trrow * 144 + trcol * 2;
    v2u kt[2][2];
    asm volatile("ds_read_b64_tr_b16 %0, %4\n\tds_read_b64_tr_b16 %1, %4 offset:1088\n\tds_read_b64_tr_b16 %2, %4 offset:8704\n\tds_read_b64_tr_b16 %3, %4 offset:9792"
                 : "=&v"(kt[0][0]), "=&v"(kt[0][1]), "=&v"(kt[1][0]), "=&v"(kt[1][1]) : "v"(kk_tr) : "memory");
#define H4_VTR(e4, o0, o1, o2, o3) asm volatile("ds_read_b64_tr_b16 %0, %4 offset:" #o0 "\n\tds_read_b64_tr_b16 %1, %4 offset:" #o1 "\n\tds_read_b64_tr_b16 %2, %4 offset:" #o2 "\n\tds_read_b64_tr_b16 %3, %4 offset:" #o3 \
                 : "=&v"(vt[e4][0][0]), "=&v"(vt[e4][0][1]), "=&v"(vt[e4][1][0]), "=&v"(vt[e4][1][1]) : "v"(v_tr) : "memory")
    H4_VTR(0, 0, 576, 4608, 5184); H4_VTR(1, 32, 608, 4640, 5216); H4_VTR(2, 64, 640, 4672, 5248); H4_VTR(3, 96, 672, 4704, 5280);
#undef H4_VTR
    const int ei = w & 3, tp = w >> 2;
    {
        const int ti = w & 3;
#pragma unroll
        for (int sii = 0; sii < 2; ++sii) {
            const int si = tp * 2 + sii;
            v2u wv = (v2u){0u, 0u};
            if (si <= ti) {
                f32x4 a = (f32x4){0.f, 0.f, 0.f, 0.f};
#pragma unroll
                for (int kk = 0; kk < 4; ++kk)
                    a = __builtin_amdgcn_mfma_f32_16x16x32_bf16(lds_frag(KK + (16 * si + lr) * 272 + kk * 64 + lq * 16), lds_frag(QI + (16 * ti + lr) * 272 + kk * 64 + lq * 16), a, 0, 0, 0);
                const int s0 = 16 * si + 4 * lq, t = 16 * ti + lr;
                wv.x = pk2(s0 + 0 <= t ? a[0] : 0.f, s0 + 1 <= t ? a[1] : 0.f); wv.y = pk2(s0 + 2 <= t ? a[2] : 0.f, s0 + 3 <= t ? a[3] : 0.f);
            }
            *(LAS v2u*)(lds + H3_AM + (16 * ti + lr) * 144 + (16 * si + 4 * lq) * 2) = wv;
        }
    }
#pragma unroll
    for (int tt = 0; tt < 2; ++tt) o[tt] = (f32x4){0.f, 0.f, 0.f, 0.f};
#pragma unroll
    for (int kk = 0; kk < 4; ++kk) {
        const pg8::bf16x8 sfr = lds_frag(lds + H3_ST + (16 * ei + lr) * 272 + kk * 64 + lq * 16);
#pragma unroll
        for (int tt = 0; tt < 2; ++tt) o[tt] = __builtin_amdgcn_mfma_f32_16x16x32_bf16(sfr, lds_frag(QI + (16 * (2 * tp + tt) + lr) * 272 + kk * 64 + lq * 16), o[tt], 0, 0, 0);
    }
    asm volatile("s_waitcnt lgkmcnt(0)"
                 : "+v"(kt[0][0]), "+v"(kt[0][1]), "+v"(kt[1][0]), "+v"(kt[1][1]),
                   "+v"(vt[0][0][0]), "+v"(vt[0][0][1]), "+v"(vt[0][1][0]), "+v"(vt[0][1][1]), "+v"(vt[1][0][0]), "+v"(vt[1][0][1]), "+v"(vt[1][1][0]), "+v"(vt[1][1][1]),
                   "+v"(vt[2][0][0]), "+v"(vt[2][0][1]), "+v"(vt[2][1][0]), "+v"(vt[2][1][1]), "+v"(vt[3][0][0]), "+v"(vt[3][0][1]), "+v"(vt[3][1][0]), "+v"(vt[3][1][1]) :: "memory");
#pragma unroll
    for (int kk = 0; kk < 2; ++kk) {
        const pg8::bf16x8 af = mk_frag(kt[kk][0], kt[kk][1]);
#pragma unroll
        for (int e4 = 0; e4 < 4; ++e4) S[e4] = __builtin_amdgcn_mfma_f32_16x16x32_bf16(af, mk_frag(vt[e4][kk][0], vt[e4][kk][1]), S[e4], 0, 0, 0);
    }
    const f32x4 dv = *(const LAS f32x4*)(lds + H3_DEC + buf * H3_BUFDEC + (16 * w + 4 * lq) * 4);
#pragma unroll
    for (int e4 = 0; e4 < 4; ++e4) S[e4] = S[e4] * dv;
}
__device__ __forceinline__ void hg4_stage2(const Hg3& c, int n, int w, const f32x4 (&S)[4], f32x4 (&o)[2], const v2u (&vt)[4][2][2]) {
    LAS unsigned char* lds = c.lds; const int lr = c.lr, lq = c.lq;
    const int ei = w & 3, tp = w >> 2;
    const pg8::bf16x8 vf0 = ei == 0 ? mk_frag(vt[0][0][0], vt[0][0][1]) : ei == 1 ? mk_frag(vt[1][0][0], vt[1][0][1]) : ei == 2 ? mk_frag(vt[2][0][0], vt[2][0][1]) : mk_frag(vt[3][0][0], vt[3][0][1]);
    const pg8::bf16x8 vf1 = ei == 0 ? mk_frag(vt[0][1][0], vt[0][1][1]) : ei == 1 ? mk_frag(vt[1][1][0], vt[1][1][1]) : ei == 2 ? mk_frag(vt[2][1][0], vt[2][1][1]) : mk_frag(vt[3][1][0], vt[3][1][1]);
#pragma unroll
    for (int tt = 0; tt < 2; ++tt) {
        const int ti = 2 * tp + tt;
        o[tt] = __builtin_amdgcn_mfma_f32_16x16x32_bf16(vf0, lds_frag(lds + H3_AM + (16 * ti + lr) * 144 + 0 * 64 + lq * 16), o[tt], 0, 0, 0);
        o[tt] = __builtin_amdgcn_mfma_f32_16x16x32_bf16(vf1, lds_frag(lds + H3_AM + (16 * ti + lr) * 144 + 1 * 64 + lq * 16), o[tt], 0, 0, 0);
        *(f32x4*)(c.Op + hg3_row(c, n, 16 * ti + lr) + c.vh * 64 + 16 * ei + 4 * lq) = o[tt];
    }
#pragma unroll
    for (int e4 = 0; e4 < 4; ++e4) { v2u wv; wv.x = pk2(S[e4][0], S[e4][1]); wv.y = pk2(S[e4][2], S[e4][3]); *(LAS v2u*)(lds + H3_ST + (16 * e4 + lr) * 272 + (16 * w + 4 * lq) * 2) = wv; }
}
__device__ __forceinline__ void hgrn4_unit(LAS unsigned char* lds, int unit, const bf16* Qb, const bf16* KFb, const bf16* KBb, const bf16* Vb, const float* LFb, const float* LBb,
                                           float* OFb, float* OBb, int tid, int lane, int wave) {
    Hg3 c;
    c.lds = lds; c.vh = unit & 1; c.dir = (unit >> 1) & 1; c.h = (unit >> 2) & 3; c.b = unit >> 4;
    c.Qb = Qb; c.Vb = Vb; c.Kp = c.dir ? KBb : KFb; c.Lp = c.dir ? LBb : LFb; c.Op = c.dir ? OBb : OFb;
    c.lane = lane; c.lr = lane & 15; c.lq = lane >> 4;
    constexpr int NCH = TT / 64;
    const int w = wave;
    for (int i = tid; i < 64 * 272 / 16; i += NTHR) *(LAS v4u*)(lds + H3_ST + i * 16) = (v4u){0u, 0u, 0u, 0u};
    pg8::bf16x8 U[4];
#pragma unroll
    for (int u = 0; u < 4; ++u) { const int kk = u >> 1, ti = u; unsigned wv[4];
#pragma unroll
        for (int j2 = 0; j2 < 4; ++j2) { const int sN = 32 * kk + 8 * c.lq + 2 * j2, t = 16 * ti + c.lr; wv[j2] = (sN <= t ? 0x3F80u : 0u) | (sN + 1 <= t ? 0x3F800000u : 0u); }
        U[u] = (pg8::bf16x8)(v4u){wv[0], wv[1], wv[2], wv[3]}; }
    f32x4 S[4], o[2]; v2u vt[4][2][2];
#pragma unroll
    for (int e4 = 0; e4 < 4; ++e4) S[e4] = (f32x4){0.f, 0.f, 0.f, 0.f};
    Hg4LV lv0, lv1; Hg4QK qk;
    hg4_load_lv(c, 0, tid, lv0); hg4_load_qk(c, 0, w, qk); hg4_load_lv(c, 1, tid, lv1);
    asm volatile("s_waitcnt vmcnt(0)" ::: "memory"); H4_USE_LV(lv0); H4_USE_QK(qk); H4_USE_LV(lv1);
    hg4_prep_a(c, 0, tid, lv0);
    __syncthreads();
#define H4_TRIP(j_, LVN, LVC) do { \
        if ((j_) < NCH) { asm volatile("s_waitcnt vmcnt(5)" ::: "memory"); H4_USE_QK(qk); hg4_prep_b(c, (j_) & 1, w, qk, U); \
            hg4_load_qk(c, (j_) + 1 < NCH ? (j_) + 1 : (j_), w, qk); hg4_load_lv(c, (j_) + 2 < NCH ? (j_) + 2 : (j_), tid, LVC); }     \
        if ((j_) > 0 && (j_) <= NCH) hg4_stage1(c, ((j_) - 1) & 1, w, S, o, vt); \
        if (PROBE_DELAY == 5) probe_delay(100); \
        __syncthreads();                                                                        \
        if ((j_) + 1 < NCH) { asm volatile("s_waitcnt vmcnt(13)" ::: "memory"); H4_USE_LV(LVN); hg4_prep_a(c, ((j_) + 1) & 1, tid, LVN); } \
        if ((j_) > 0 && (j_) <= NCH) hg4_stage2(c, (j_) - 1, w, S, o, vt); \
        __syncthreads();                                                                        \
    } while (0)
#pragma unroll 1
    for (int j = 0; j <= NCH; j += 2) { H4_TRIP(j, lv1, lv0); H4_TRIP(j + 1, lv0, lv1); }
#undef H4_TRIP
    asm volatile("s_waitcnt vmcnt(0)" ::: "memory");
    __syncthreads();
}

#if defined(HGRN_V2)
#define HGRN_FN hgrn_unit
#elif defined(HGRN_V3)
#define HGRN_FN hgrn3_unit
#else
#define HGRN_FN hgrn4_unit
#endif
#define W1_ITEM(r_) do { const int r__ = (r_); const int e__ = r__ >> 10; p0_item<true>(w1 + (size_t)e__ * D * 2 * FF, D, 2 * FF, W1T + (size_t)e__ * 2 * FF * D, RmW1(), scr, r__ & 1023, lane); } while (0)

struct Args { const float* in[18]; float* out; unsigned char* ws; int ph_lo, ph_hi; };
__global__ void __launch_bounds__(NTHR, 2) fwd_kernel(Args args) {
    extern __shared__ __attribute__((aligned(16))) unsigned char lds_raw[];
    LAS unsigned char* lds = (LAS unsigned char*)lds_raw;
    volatile LAS unsigned* MISC = (volatile LAS unsigned*)(lds + MISC_OFF);
    const int tid = threadIdx.x, lane = tid & 63, wave = __builtin_amdgcn_readfirstlane(tid >> 6);
    const int G = gridDim.x; const int bx = blockIdx.x; const int vcu = (G % 8 == 0) ? (bx % 8) * (G / 8) + bx / 8 : bx;
    const int gw = vcu * NWAVES + wave, NGW = G * NWAVES;
    unsigned char* ws = args.ws;
    unsigned* ctl = (unsigned*)(ws + WS_CTL);
    const float* x = args.in[0]; const float* norm1_w = args.in[1]; const float* w_in = args.in[2]; const float* lb_logits = args.in[3];
    const float* hgrn_norm_w = args.in[4]; const float* dw_w = args.in[5]; const float* dw_b = args.in[6]; const float* conv_ln_w = args.in[7]; const float* conv_ln_b = args.in[8];
    const float* w_out = args.in[9]; const float* norm2_w = args.in[10]; const float* router_w = args.in[11]; const float* router_b = args.in[12];
    const float* w1 = args.in[13]; const float* b1 = args.in[14]; const float* w2 = args.in[15]; const float* b2 = args.in[16]; const float* final_norm_w = args.in[17];
    float* out = args.out;
    bf16* WI = (bf16*)(ws + WS_WI); bf16* WO = (bf16*)(ws + WS_WO); unsigned char* W1T = ws + WS_W1; unsigned char* W2T = ws + WS_W2;
    float* H = (float*)(ws + WS_H); bf16* XN = (bf16*)(ws + WS_XN);
    bf16* Qb = (bf16*)(ws + WS_Q); bf16* KFb = (bf16*)(ws + WS_KF); bf16* KBb = (bf16*)(ws + WS_KB); bf16* Vb = (bf16*)(ws + WS_V); bf16* Gb = (bf16*)(ws + WS_G); bf16* Ub = (bf16*)(ws + WS_U);
    float* LFb = (float*)(ws + WS_LF); float* LBb = (float*)(ws + WS_LB); float* OFb = (float*)(ws + WS_OF); float* OBb = (float*)(ws + WS_OB);
    bf16* MIX = (bf16*)(ws + WS_MIX); unsigned char* XS = ws + WS_XS; unsigned char* ACT = ws + WS_ACT; unsigned char* N2 = ws + WS_XN; bf16* YS = (bf16*)(ws + WS_YS);
    float* WRT = (float*)(ws + WS_WRT); int* SLOT = (int*)(ws + WS_SLOT); float* GATE = (float*)(ws + WS_GATE); int* ROWTOK = (int*)(ws + WS_ROWTOK);
    volatile LAS int* bs = (volatile LAS int*)(lds + TAB_OFF);
    volatile LAS int* cl = (volatile LAS int*)(lds + TAB_OFF + 256);
    LAS int* lcnt = (LAS int*)(lds + TAB_OFF + 512);
    volatile LAS int* gbase = (volatile LAS int*)(lds + TAB_OFF + 768);

    for (int u = tid; u < (LDS_BYTES - LDSCTL_OFF) / 4; u += NTHR) ((LAS unsigned*)(lds + LDSCTL_OFF))[u] = 0u;
    __syncthreads();
    XcdBarrier bar; bar.bar = ctl + CW_BAR; bar.x = 0; bar.st = nullptr;
    if (MK_N_LAUNCHES == 1) bar = xcd_barrier_post(ctl + CW_BAR, MISC + 8);
    const int lo = args.ph_lo, hi = args.ph_hi;
#ifndef PHASE_MASK
#define PHASE_MASK 0xffffffffu
#endif
#define IN(k) ((((PHASE_MASK) >> (k)) & 1u) && lo <= (k) && (k) < hi)
#ifndef PROBE_DUP
#define PROBE_DUP -1
#endif
#define REP(k) _Pragma("unroll 1") for (int rep_ = 0; rep_ < ((PROBE_DUP) == (k) ? 2 + (args.ph_hi >> 20) : 1); ++rep_)
#define SEAM(k) do { if (IN(k) && IN((k) + 1)) { xcd_barrier(bar); if ((PROBE_DUP) == 99) { xcd_barrier(bar); xcd_barrier(bar); } } } while (0)
#define BUILD_BS() do { int t_; asm volatile("v_mov_b32 %0, %1" : "=v"(t_) : "v"(tid));     \
        if (t_ < 64) { const int c_ = t_ < NE ? (int)__hip_atomic_load(ctl + CW_CNT + 64 * (t_ & (NE - 1)), RLX_AGENT) : 0; int x_ = (c_ + 255) >> 8; \
        _Pragma("unroll") for (int o_ = 1; o_ < NE; o_ <<= 1) { const int y_ = __shfl_up(x_, o_); if ((t_ & 63) >= o_) x_ += y_; }     \
        if (t_ < NE) { cl[t_] = c_; bs[t_ + 1] = x_; } if (t_ == 0) bs[0] = 0; } __syncthreads(); } while (0)

    if (IN(0)) REP(0) {
        LAS float* scr = (LAS float*)(lds + RING_OFF + wave * 16384);
        constexpr int I_WI = (D / 64) * (INC / 32), I_WO = (D / 64) * (D / 32), I_W1 = (D / 64) * (2 * FF / 32), I_W2 = (FF / 64) * (D / 32);
        #if defined(HGRN_NAIVE) || defined(W2_IN_P0)
        constexpr int NITEMS = I_WI + I_WO + NE * I_W1 + NE * I_W2;
#else
        constexpr int NITEMS = I_WI + I_WO + W1_P0;
#endif
        for (int it = gw; it < NITEMS; it += NGW) {
            int r = it;
            if (r < I_WI) { p0_item<false>(w_in, D, INC, WI, RmWin(), scr, r, lane); continue; } r -= I_WI;
            if (r < I_WO) { p0_item<false>(w_out, D, D, WO, RmIdent(), scr, r, lane); continue; } r -= I_WO;
            if (r < NE * I_W1) { W1_ITEM(r); continue; } r -= NE * I_W1;
#if defined(HGRN_NAIVE) || defined(W2_IN_P0)
            { const int e = r / I_W2; p0_item<true>(w2 + (size_t)e * FF * D, FF, D, W2T + (size_t)e * D * FF, RmIdent(), scr, r - e * I_W2, lane); }
#endif
        }
        for (int m = gw; m < MTOK; m += NGW) rms_row_to_bf16(x + (size_t)m * D, norm1_w, XN + (size_t)m * D, lane);
        for (int i = bx * NTHR + tid; i < 16 * D; i += G * NTHR) {
            const int r = i >> 4, e16 = i & 15, k = 256 * (r & 3) + (r >> 2); const float gk = norm2_w[k];
            WRT[2 * i] = gk * router_w[k * NE + e16]; WRT[2 * i + 1] = gk * router_w[k * NE + 16 + e16]; }
    }
    SEAM(0);

    if (IN(1)) REP(1) {
        pg8::Gemm g{XN, WI, MTOK, INC, D}; OrderRep S; S.init(MTOK, INC, G, bx); S.reps = ((PROBE_DUP) == 11) ? 2 : 1;
        EpiProj E{Qb, KFb, KBb, Vb, Gb, Ub, LFb, LBb, lb_logits};
        pg8::gemm_phase<EpiProj, OrderRep, true, true>(lds + RING_OFF, g, S, E);
#if !defined(HGRN_NAIVE) && !defined(W2_IN_P0)
        {
            LAS float* scr = (LAS float*)(lds + RING_OFF + wave * 16384);
            if (G == 256) { if (bx >= 128) convert_range_fp8(w1, D, 2 * FF, W1T, RmW1(), 10, (bx - 128) * NWAVES + wave, 128 * NWAVES, W1_P1, W1_P0, scr, lane); }
            else convert_range_fp8(w1, D, 2 * FF, W1T, RmW1(), 10, gw, NGW, W1_P1, W1_P0, scr, lane);
        }
#endif
    }
    SEAM(1);

    if (IN(2)) REP(2) {
        const bool split = (G == 256);
#if defined(HGRN_NAIVE)
        const bool hsel = true; const int hidx = 0, hstride = 1; const bool csel = true; const int cidx = vcu, cstride = G;
#else
        const bool hsel = split ? (((bx >> 3) & 1) != 0) : true; const int hidx = split ? (bx >> 4) * 8 + (bx & 7) : bx, hstride = split ? 128 : G;
        const bool csel = split ? !hsel : true; const int cidx = split ? (bx >> 4) * 8 + (bx & 7) : bx, cstride = split ? 128 : G;
#endif
        (void)hidx; (void)hstride;
        if (csel && PROBE_DELAY == 3) probe_delay(3000); if (csel && PROBE_DELAY == 4) probe_delay(20000);
        if (csel) for (int crep_ = 0; crep_ < ((PROBE_DUP) == 21 ? 2 : 1); ++crep_) {
            LAS unsigned short* ut = (LAS unsigned short*)(lds + RING_OFF);
            LAS float* part = (LAS float*)(lds + RING_OFF + 98304);
            LAS float* stat = (LAS float*)(lds + RING_OFF + 98304 + 4096);
            for (int unit = cidx; unit < NBATCH * (TT / 64); unit += cstride) {
                const int b = unit / (TT / 64), t0 = (unit % (TT / 64)) * 64;
                for (int idx = tid; idx < 94 * 64; idx += NTHR) {
                    const int r = idx >> 6, p = idx & 63, t = t0 - 15 + r;
                    v4u val = (v4u){0u, 0u, 0u, 0u};
                    if (t >= 0 && t < TT) val = *(const v4u*)(Ub + (size_t)(b * TT + t) * CCH + p * 8);
                    *(LAS v4u*)(ut + r * 512 + p * 8) = val;
                }
                __syncthreads();
                const int c = tid;
                float w[CLEN];
#pragma unroll
                for (int j = 0; j < CLEN; ++j) w[j] = dw_w[j * CCH + c];
                const float bias = dw_b[c];
                float y[64];
#pragma unroll
                for (int tb = 0; tb < 8; ++tb) {
                    float win[38];
#pragma unroll
                    for (int i = 0; i < 38; ++i) win[i] = bf2f(ut[(tb * 8 + i) * 512 + c]);
#pragma unroll
                    for (int o = 0; o < 8; ++o) { float a = bias;
#pragma unroll
                        for (int j = 0; j < CLEN; ++j) a += w[j] * win[o + j];
                        y[tb * 8 + o] = a; }
                }
#pragma unroll 1
                for (int pass = 0; pass < 2; ++pass) {
                    float s1[64];
#pragma unroll
                    for (int i = 0; i < 64; ++i) s1[i] = pass ? y[i] * y[i] : y[i];
#pragma unroll
                    for (int s = 32; s >= 1; s >>= 1) {
                        const bool up = (lane & s) != 0;
#pragma unroll
                        for (int i = 0; i < s; ++i) { const float k1 = up ? s1[i + s] : s1[i], x1 = up ? s1[i] : s1[i + s]; s1[i] = k1 + __shfl_xor(x1, s); }
                    }
                    part[(wave * 64 + lane) * 2 + pass] = s1[0];
                }
                __syncthreads();
                if (tid < 64) { float a = 0.f, q = 0.f;
#pragma unroll
                    for (int wv = 0; wv < 8; ++wv) { a += part[(wv * 64 + tid) * 2]; q += part[(wv * 64 + tid) * 2 + 1]; }
                    const float mean = a * (1.f / CCH), var = q * (1.f / CCH) - mean * mean;
                    stat[tid * 2] = mean; stat[tid * 2 + 1] = rsqrtf(fmaxf(var, 0.f) + EPS); }
                __syncthreads();
                const float lw = conv_ln_w[c], lbias = conv_ln_b[c];
#pragma unroll
                for (int t = 0; t < 64; ++t) {
                    const float v = (y[t] - stat[t * 2]) * stat[t * 2 + 1] * lw + lbias;
                    MIX[(size_t)(b * TT + t0 + t) * D + 512 + c] = (bf16)(pk2(v * sigm(v), 0.f) & 0xffffu);
                }
                __syncthreads();
            }
#if !defined(HGRN_NAIVE) && !defined(W2_IN_P0)
            {
                LAS float* scr = (LAS float*)(lds + RING_OFF + wave * 16384);
                constexpr int I_W2 = (FF / 64) * (D / 32);
                convert_range_fp8(w2, FF, D, W2T, RmIdent(), 9, cidx * NWAVES + wave, cstride * NWAVES, NE * I_W2, 0, scr, lane);
                convert_range_fp8(w1, D, 2 * FF, W1T, RmW1(), 10, cidx * NWAVES + wave, cstride * NWAVES, W1_P2, W1_P0 + W1_P1, scr, lane);
            }
#endif
        }
#if defined(HGRN_NAIVE)
        {
            LAS float* qs = (LAS float*)(lds + RING_OFF); LAS float* ks = qs + 2048; LAS float* fs = ks + 2048; LAS float* vs = fs + 2048; LAS float* op = vs + 2048;
            const int e = tid & 127, dq = tid >> 7;
            for (int unit = G - 1 - bx; unit < NBATCH * NH * 2; unit += G) {
                const int dir = unit & 1, h = (unit >> 1) & 3, b = unit >> 3;
                const bf16* Kp = dir ? KBb : KFb; const float* Lp = dir ? LBb : LFb; float* Op = dir ? OBb : OFb;
                float S[32];
#pragma unroll
                for (int i = 0; i < 32; ++i) S[i] = 0.f;
                for (int blk = 0; blk < TT / 16; ++blk) {
                    const int tb = dir ? (TT - 16 - blk * 16) : blk * 16;
#pragma unroll
                    for (int i = 0; i < 4; ++i) { const int idx = tid + NTHR * i, r = idx >> 7, d = idx & 127; const size_t off = (size_t)(b * TT + tb + r) * 512 + h * 128 + d;
                        qs[idx] = bf2f(Qb[off]); ks[idx] = bf2f(Kp[off]); fs[idx] = __expf(Lp[off]); vs[idx] = bf2f(Vb[off]); }
                    __syncthreads();
                    for (int st = 0; st < 16; ++st) {
                        const int r = dir ? 15 - st : st; const float v = vs[r * 128 + e]; float o = 0.f;
#pragma unroll
                        for (int dd = 0; dd < 32; ++dd) { const int d = dq * 32 + dd; S[dd] = fs[r * 128 + d] * S[dd] + ks[r * 128 + d] * v; o += qs[r * 128 + d] * S[dd]; }
                        op[(r * 4 + dq) * 128 + e] = o;
                    }
                    __syncthreads();
#pragma unroll
                    for (int i = 0; i < 4; ++i) { const int idx = tid + NTHR * i, r = idx >> 7, ee = idx & 127;
                        Op[(size_t)(b * TT + tb + r) * 512 + h * 128 + ee] = (op[(r * 4 + 0) * 128 + ee] + op[(r * 4 + 1) * 128 + ee]) + (op[(r * 4 + 2) * 128 + ee] + op[(r * 4 + 3) * 128 + ee]); }
                }
                __syncthreads();
            }
        }
#else
        if (hsel) for (int unit = hidx; unit < NBATCH * NH * 4 * ((PROBE_DUP) == 20 ? 2 : 1); unit += hstride) HGRN_FN(lds + RING_OFF, unit & (NBATCH * NH * 4 - 1), Qb, KFb, KBb, Vb, LFb, LBb, OFb, OBb, tid, lane, wave);
#endif
    }
    SEAM(2);

    if (IN(3)) REP(3) {
        for (int m = gw; m < MTOK; m += NGW) {
            const size_t off = (size_t)m * 512 + lane * 8;
            const f32x4 a0 = *(const f32x4*)(OFb + off), a1 = *(const f32x4*)(OFb + off + 4), c0 = *(const f32x4*)(OBb + off), c1 = *(const f32x4*)(OBb + off + 4);
            const f32x4 o0 = a0 + c0, o1 = a1 + c1;
            float ss = (o0.x * o0.x + o0.y * o0.y) + (o0.z * o0.z + o0.w * o0.w) + (o1.x * o1.x + o1.y * o1.y) + (o1.z * o1.z + o1.w * o1.w);
            ss += __shfl_xor(ss, 1); ss += __shfl_xor(ss, 2); ss += __shfl_xor(ss, 4); ss += __shfl_xor(ss, 8);
            const float rstd = rsqrtf(ss * (1.f / DV) + EPS);
            const v4u gv = *(const v4u*)(Gb + off);
            const f32x4 w0 = *(const f32x4*)(hgrn_norm_w + lane * 8), w1v = *(const f32x4*)(hgrn_norm_w + lane * 8 + 4);
            f32x4 r0, r1;
            r0.x = o0.x * rstd * w0.x * bf2f(gv.x & 0xffffu); r0.y = o0.y * rstd * w0.y * bf2f(gv.x >> 16);
            r0.z = o0.z * rstd * w0.z * bf2f(gv.y & 0xffffu); r0.w = o0.w * rstd * w0.w * bf2f(gv.y >> 16);
            r1.x = o1.x * rstd * w1v.x * bf2f(gv.z & 0xffffu); r1.y = o1.y * rstd * w1v.y * bf2f(gv.z >> 16);
            r1.z = o1.z * rstd * w1v.z * bf2f(gv.w & 0xffffu); r1.w = o1.w * rstd * w1v.w * bf2f(gv.w >> 16);
            st8bf(MIX + (size_t)m * D + lane * 8, r0, r1);
        }
    }
    SEAM(3);

    if (IN(4)) REP(4) {
        pg8::Gemm g{MIX, WO, MTOK, D, D}; pg8::StaticOrder S; S.init(MTOK, D, G, bx);
        EpiRes E{x, H};
        pg8::gemm_phase<EpiRes, pg8::StaticOrder, true, true>(lds + RING_OFF, g, S, E);
    }
    SEAM(4);

    if (IN(5)) REP(5) {
        typedef float f32x2 __attribute__((ext_vector_type(2)));
        LAS float* wl = (LAS float*)(lds + RING_OFF);
        LAS unsigned* sb = (LAS unsigned*)(lds + SB_OFF);
        { f32x4 tv_[NE * D / 4 / NTHR];
#pragma unroll
            for (int i = 0; i < NE * D / 4 / NTHR; ++i) tv_[i] = ((const f32x4*)WRT)[tid + NTHR * i];
#pragma unroll
            for (int i = 0; i < NE * D / 4 / NTHR; ++i) ((LAS f32x4*)wl)[tid + NTHR * i] = tv_[i]; }
        if (tid < NE) lcnt[tid] = 0;
        __syncthreads();
        for (int tg = vcu; tg < MTOK / 64; tg += G) {
            const int tok0 = tg * 64 + 16 * (wave & 3);
            if (wave < 4) {
                const int j = lane & 15, q = lane >> 4;
                const f32x4* hrow = (const f32x4*)(H + (size_t)(tok0 + j) * D + 256 * q);
                const LAS f32x2* tab = (const LAS f32x2*)wl + q * 16 + j;
                f32x4 acc0 = (f32x4){0.f, 0.f, 0.f, 0.f}, acc1 = acc0; float ss = 0.f;
                f32x4 hv = hrow[0];
#pragma unroll 2
                for (int s4 = 0; s4 < 64; ++s4) {
                    const f32x4 hc = hv;
                    if (s4 + 1 < 64) hv = hrow[s4 + 1];
                    f32x2 w[4];
#pragma unroll
                    for (int u = 0; u < 4; ++u) w[u] = tab[(4 * s4 + u) * 64];
                    ss += (hc.x * hc.x + hc.y * hc.y) + (hc.z * hc.z + hc.w * hc.w);
#pragma unroll
                    for (int u = 0; u < 4; ++u) { acc0 = __builtin_amdgcn_mfma_f32_16x16x4f32(w[u].x, hc[u], acc0, 0, 0, 0); acc1 = __builtin_amdgcn_mfma_f32_16x16x4f32(w[u].y, hc[u], acc1, 0, 0, 0); }
                }
                ss += __shfl_xor(ss, 16); ss += __shfl_xor(ss, 32);
                const float rstd = rsqrtf(ss * (1.f / D) + EPS);
                float lg[8];
#pragma unroll
                for (int r = 0; r < 4; ++r) { lg[r] = acc0[r] * rstd + router_b[4 * q + r]; lg[4 + r] = acc1[r] * rstd + router_b[16 + 4 * q + r]; }
                float tv[TOPK]; int ti[TOPK];
#pragma unroll
                for (int k = 0; k < TOPK; ++k) {
                    float bv = lg[0]; int bi = 4 * q;
#pragma unroll
                    for (int r = 1; r < 8; ++r) { const int id = (r < 4) ? 4 * q + r : 16 + 4 * q + (r - 4); if (lg[r] > bv) { bv = lg[r]; bi = id; } }
#pragma unroll
                    for (int o = 16; o < 64; o <<= 1) { const float ov = __shfl_xor(bv, o); const int oi = __shfl_xor(bi, o); if (ov > bv || (ov == bv && oi < bi)) { bv = ov; bi = oi; } }
                    tv[k] = bv; ti[k] = bi;
#pragma unroll
                    for (int r = 0; r < 8; ++r) { const int id = (r < 4) ? 4 * q + r : 16 + 4 * q + (r - 4); if (id == bi) lg[r] = -INFINITY; }
                }
                const float e1 = __expf(tv[1] - tv[0]), e2 = __expf(tv[2] - tv[0]), e3 = __expf(tv[3] - tv[0]);
                const float inv = 1.0f / (1.0f + e1 + e2 + e3);
                {
                    const int ek = q == 0 ? ti[0] : q == 1 ? ti[1] : q == 2 ? ti[2] : ti[3];
                    const float gk = (q == 0 ? 1.0f : q == 1 ? e1 : q == 2 ? e2 : e3) * inv;
                    const int lr = __hip_atomic_fetch_add(&lcnt[ek], 1, __ATOMIC_RELAXED, __HIP_MEMORY_SCOPE_WORKGROUP);
                    sb[(16 * wave + j) * 4 + q] = ((unsigned)ek << 16) | (unsigned)lr;
                    GATE[(size_t)(tok0 + j) * TOPK + q] = gk;
                }
            } else {
                for (int i = 0; i < 16; ++i) {
                    const int m = tok0 + i;
                    const f32x4* hr = (const f32x4*)(H + (size_t)m * D) + lane; const f32x4* wr = (const f32x4*)norm2_w + lane;
                    f32x4 v[4]; float s2 = 0.f;
#pragma unroll
                    for (int jj = 0; jj < 4; ++jj) { v[jj] = hr[64 * jj]; s2 += (v[jj].x * v[jj].x + v[jj].y * v[jj].y) + (v[jj].z * v[jj].z + v[jj].w * v[jj].w); }
                    const float rstd = rsqrtf(wave_sum(s2) * (1.f / D) + EPS) * SC_N2;
                    unsigned* o4 = (unsigned*)(N2 + (size_t)m * D) + lane;
#pragma unroll
                    for (int jj = 0; jj < 4; ++jj) { const f32x4 g = wr[64 * jj]; o4[64 * jj] = pk4_fp8(v[jj].x * rstd * g.x, v[jj].y * rstd * g.y, v[jj].z * rstd * g.z, v[jj].w * rstd * g.w); }
                }
            }
            __syncthreads();
            if (tid < NE) { const int c = lcnt[tid]; gbase[tid] = c ? (int)__hip_atomic_fetch_add(ctl + CW_CNT + ((PROBE_DUP) == 5 && rep_ == 0 ? 4096 : 0) + 64 * tid, (unsigned)c, RLX_AGENT) : 0; }
            __syncthreads();
            if (tid < 256) { const unsigned w = sb[tid]; const int ek = (int)(w >> 16), r = gbase[ek] + (int)(w & 0xffffu), m = tg * 64 + (tid >> 2);
                ROWTOK[ek * MTOK + r] = m; SLOT[(size_t)m * TOPK + (tid & 3)] = ek * MTOK + r; }
            if (tid < NE) lcnt[tid] = 0;
            __syncthreads();
        }
    }
    SEAM(5);


    if (IN(7)) REP(7) {
        BUILD_BS();
        pg8::Gemm g{(const bf16*)N2, (const bf16*)W1T, MTOK, 2 * FF, D / 2}; MoeOrder S{bs, 8, G, vcu, cl, ROWTOK};
        EpiSwiglu E{ACT, b1};
        pg8::gemm_phase<EpiSwiglu, MoeOrder, true, true, true, true>(lds + RING_OFF, g, S, E);
    }
    SEAM(7);

    if (IN(8)) REP(8) {
        BUILD_BS();
        pg8::Gemm g{(const bf16*)ACT, (const bf16*)W2T, MOE_ROWS, D, FF / 2}; MoeOrder S{bs, 4, G, vcu, cl, ROWTOK};
        EpiDown E{YS, b2};
        pg8::gemm_phase<EpiDown, MoeOrder, true, true, true>(lds + RING_OFF, g, S, E);
    }
    SEAM(8);

    if (IN(9)) REP(9) {
        BUILD_BS();
        for (int base = gw; base < MTOK; base += 16 * NGW) {
            const int mi = base + NGW * (lane >> 2); int posl = 0; float gl = 0.f;
            if (mi < MTOK) { const int sl = SLOT[(size_t)mi * TOPK + (lane & 3)]; gl = GATE[(size_t)mi * TOPK + (lane & 3)]; posl = bs[sl >> 14] * 256 + (sl & (MTOK - 1)); }
#pragma unroll 2
            for (int i = 0; i < 16; ++i) {
                const int m = base + NGW * i; if (m >= MTOK) break;
                const f32x4* hr = (const f32x4*)(H + (size_t)m * D) + lane; const f32x4* wr = (const f32x4*)final_norm_w + lane;
                int pos[TOPK]; float gk[TOPK];
#pragma unroll
                for (int k = 0; k < TOPK; ++k) { pos[k] = __shfl(posl, 4 * i + k); gk[k] = __shfl(gl, 4 * i + k); }
                f32x4 v[4]; v2u yw[TOPK][4];
#pragma unroll
                for (int j = 0; j < 4; ++j) v[j] = hr[64 * j];
#pragma unroll
                for (int k = 0; k < TOPK; ++k) { const v2u* yr = (const v2u*)(YS + (size_t)pos[k] * D) + lane;
#pragma unroll
                    for (int j = 0; j < 4; ++j) yw[k][j] = yr[64 * j]; }
#pragma unroll
                for (int k = 0; k < TOPK; ++k)
#pragma unroll
                    for (int j = 0; j < 4; ++j) { const v2u w = yw[k][j];
                        v[j].x += gk[k] * bf2f(w.x & 0xffffu); v[j].y += gk[k] * bf2f(w.x >> 16); v[j].z += gk[k] * bf2f(w.y & 0xffffu); v[j].w += gk[k] * bf2f(w.y >> 16); }
                float s = 0.f;
#pragma unroll
                for (int j = 0; j < 4; ++j) s += (v[j].x * v[j].x + v[j].y * v[j].y) + (v[j].z * v[j].z + v[j].w * v[j].w);
                const float rstd = rsqrtf(wave_sum(s) * (1.f / D) + EPS);
                f32x4* orow = (f32x4*)(out + (size_t)m * D) + lane;
#pragma unroll
                for (int j = 0; j < 4; ++j) orow[64 * j] = v[j] * rstd * wr[64 * j];
            }
        }
    }
#undef IN
#undef SEAM
#undef BUILD_BS
}

extern "C" void kernel_launch(void* const* d_in, const int* in_sizes, int n_in, void* d_out, int out_size, void* d_ws, size_t ws_size, hipStream_t stream) {
    static int grid = 0;
    if (grid == 0) {
        if (n_in != 18 || in_sizes[0] != MTOK * D || out_size != MTOK * D || ws_size < WS_END) { fprintf(stderr, "kernel_launch: unexpected shapes (n_in %d, in0 %d, out %d, ws %zu < %zu); nothing launched\n", n_in, n_in > 0 ? in_sizes[0] : -1, out_size, ws_size, (size_t)WS_END); grid = -1; return; }
        int dev = 0, cus = 0, per_cu = 0;
        if (hipGetDevice(&dev) != hipSuccess || hipDeviceGetAttribute(&cus, hipDeviceAttributeMultiprocessorCount, dev) != hipSuccess) { fprintf(stderr, "kernel_launch: device query failed\n"); grid = -1; return; }
        if (hipFuncSetAttribute((const void*)fwd_kernel, hipFuncAttributeMaxDynamicSharedMemorySize, LDS_BYTES) != hipSuccess) { fprintf(stderr, "kernel_launch: hipFuncSetAttribute failed\n"); grid = -1; return; }
        if (hipOccupancyMaxActiveBlocksPerMultiprocessor(&per_cu, (const void*)fwd_kernel, NTHR, LDS_BYTES) != hipSuccess || per_cu < 1)
            fprintf(stderr, "kernel_launch: note: occupancy query reports %d workgroups per CU\n", per_cu);
        (void)hipGetLastError();
        grid = cus;
    }
    if (grid < 0) return;
    if (hipMemsetAsync((char*)d_ws + WS_CTL, 0, CTL_ZERO_BYTES, stream) != hipSuccess) { fprintf(stderr, "kernel_launch: memset failed\n"); return; }
    Args a{};
    for (int i = 0; i < 18; ++i) a.in[i] = (const float*)d_in[i];
    a.out = (float*)d_out; a.ws = (unsigned char*)d_ws;
#if MK_N_LAUNCHES == 1
    a.ph_lo = 0; a.ph_hi = N_PHASES;
    hipLaunchKernelGGL(fwd_kernel, dim3(grid), dim3(NTHR), LDS_BYTES, stream, a);
#else
    for (int ph = 0; ph < N_PHASES; ++ph) { a.ph_lo = ph; a.ph_hi = ph + 1; hipLaunchKernelGGL(fwd_kernel, dim3(grid), dim3(NTHR), LDS_BYTES, stream, a); }
#endif
    const hipError_t le = hipPeekAtLastError();
    if (le != hipSuccess) fprintf(stderr, "kernel_launch: launch failed: %s\n", hipGetErrorName(le));
}
```

```cpp
#define HGRN_V2 1
#include <hip/hip_runtime.h>
#include <cstdio>
#include <cstdint>
namespace pg8 {
#define PG8_LAS __attribute__((address_space(3)))
typedef unsigned short bf16_t;
typedef short bf16x8 __attribute__((ext_vector_type(8)));
typedef float f32x4 __attribute__((ext_vector_type(4)));
typedef unsigned u32x4 __attribute__((ext_vector_type(4)));
constexpr int BM = 256, BK = 64, HALF = 128, HTB = HALF * BK * 2  , STAGE_BYTES = 8 * HTB, NXCD = 8, WGM = 8;

__host__ __device__ __forceinline__ int lds_byte(int r, int c) { const int st = (r >> 4) * 2 + (c >> 5), rr = r & 15, cc = c & 31, ob = rr * 64 + cc * 2; return st * 1024 + (ob ^ (((ob >> 9) & 1) << 5)); }
__host__ __device__ __forceinline__ void stage_rc(int b, int& R, int& C) { const int st = b / 1024, sb = b % 1024, swz = sb ^ (((sb >> 9) & 1) << 5); R = (st >> 1) * 16 + swz / 64; C = (st & 1) * 32 + (swz % 64) / 2; }
__host__ __device__ __forceinline__ int perm32(int rho) { const int n = rho >> 4, i = rho & 15; return 8 * (i >> 2) + 4 * n + (i & 3); }

struct Unit { int pm, pn; };
struct Gemm { const bf16_t* A; const bf16_t* Bt; int M, N, K; };

struct StaticOrder {
    int nM, nN, nwg, G, c;
    __host__ __device__ void init(int M, int N, int G_, int c_) { nM = M / BM; nN = N / BM; nwg = nM * nN; G = G_; c = c_; }
    __host__ __device__ bool next(int i, Unit& u) const {
        const long L = (long)i * G + c; if (L >= nwg) return false;
        int wgid = (int)L; { const int q = nwg / NXCD, r = nwg % NXCD, xcd = wgid % NXCD, off = wgid / NXCD; wgid = (xcd < r ? xcd * (q + 1) : r * (q + 1) + (xcd - r) * q) + off; }
        const int nig = WGM * nN, gid = wgid / nig, fm = gid * WGM, gsz = (nM - fm) < WGM ? (nM - fm) : WGM;
        u.pm = fm + ((wgid % nig) % gsz); u.pn = (wgid % nig) / gsz; return true;
    }
    __device__ __forceinline__ void a_ready(const Unit&) const {}
    __device__ __forceinline__ void done(const Unit&) const {}
    __device__ __forceinline__ int done_defer(const Unit&) const { return -1; }
    __device__ __forceinline__ void done_signal(int) const {}
};
__device__ __forceinline__ unsigned cvt_pk_bf16(float lo, float hi) { unsigned r; asm volatile("v_cvt_pk_bf16_f32 %0, %1, %2" : "=v"(r) : "v"(lo), "v"(hi)); return r; }
typedef float f32x2 __attribute__((ext_vector_type(2)));
template <class Epi, class Sched, bool ALIGN_EPI = false, bool SP2 = false, bool FP8 = false, bool GATHER = false>
__device__ __forceinline__ void gemm_phase(PG8_LAS unsigned char* lds, const Gemm g, const Sched& S, const Epi& E) {
    typedef int v4i_t __attribute__((ext_vector_type(4)));
    const int tid = threadIdx.x, wid = __builtin_amdgcn_readfirstlane(tid >> 6), lane = tid & 63, wr = wid >> 2, wc = wid & 3, fr = lane & 15, fq = lane >> 4;
    const int K = g.K, nt = K / BK;
    unsigned voffA[2], voffB[2];
#pragma unroll
    for (int i = 0; i < 2; ++i) { int R, C; stage_rc(tid * 16 + i * 8192, R, C); const int Rb = Epi::PERM ? ((R & ~31) + perm32(R & 31)) : R;
        voffA[i] = (unsigned)(R * K + C) * 2u; voffB[i] = (unsigned)(Rb * K + C) * 2u; }
    int rowA[2]; unsigned colA[2];
#pragma unroll
    for (int i = 0; i < 2; ++i) { int R, C; stage_rc(tid * 16 + i * 8192, R, C); rowA[i] = R; colA[i] = (unsigned)C * 2u; }
    const size_t kstep = (size_t)(BK * 2);
    const size_t hstep = (size_t)HALF * K * 2;
    const size_t tstep = 2 * hstep;
    const unsigned ldsw = (unsigned)wid * 1024u;
    const int aoff = lds_byte(wr * 64 + fr, fq * 8), boff = lds_byte(wc * 32 + fr, fq * 8);
#define PG8_SA(b, h) (((b) * 2 + (h)) * HTB)
#define PG8_SB(b, h) ((4 + (b) * 2 + (h)) * HTB)
#define PG8_STAGE(bufoff, gbase, voff) do { _Pragma("unroll") for (int _i = 0; _i < 2; ++_i) \
        __builtin_amdgcn_global_load_lds((const unsigned*)((const char*)(gbase) + (voff)[_i]), (PG8_LAS unsigned*)(lds + (bufoff) + ldsw + _i * 8192), 16, 0, 0); } while (0)
#define PG8_STAGE2(bufoff, gbase, o0, o1) do { \
        __builtin_amdgcn_global_load_lds((const unsigned*)((const char*)(gbase) + (o0)), (PG8_LAS unsigned*)(lds + (bufoff) + ldsw), 16, 0, 0); \
        __builtin_amdgcn_global_load_lds((const unsigned*)((const char*)(gbase) + (o1)), (PG8_LAS unsigned*)(lds + (bufoff) + ldsw + 8192), 16, 0, 0); } while (0)
#define PG8_LDA(dst, b, h) do { _Pragma("unroll") for (int m = 0; m < 4; ++m) _Pragma("unroll") for (int k = 0; k < 2; ++k) dst[m][k] = *(const PG8_LAS bf16x8*)(lds + PG8_SA(b, h) + aoff + m * 2048 + k * 1024); } while (0)
#define PG8_LDB(dst, b, h) do { _Pragma("unroll") for (int n = 0; n < 2; ++n) _Pragma("unroll") for (int k = 0; k < 2; ++k) dst[n][k] = *(const PG8_LAS bf16x8*)(lds + PG8_SB(b, h) + boff + n * 2048 + k * 1024); } while (0)
#define PG8_MMA(ai, bj, At, Bt) do { __builtin_amdgcn_s_setprio(1); _Pragma("unroll") for (int m = 0; m < 4; ++m) _Pragma("unroll") for (int n = 0; n < 2; ++n) { \
        if constexpr (FP8) { asm volatile("v_mfma_f32_16x16x128_f8f6f4 %0, %1, %2, %0" : "+v"(acc[ai][bj][m][n]) : "v"(__builtin_shufflevector((v4i_t)Bt[n][0], (v4i_t)Bt[n][1], 0, 1, 2, 3, 4, 5, 6, 7)), "v"(__builtin_shufflevector((v4i_t)At[m][0], (v4i_t)At[m][1], 0, 1, 2, 3, 4, 5, 6, 7))); } \
        else { _Pragma("unroll") for (int k = 0; k < 2; ++k) acc[ai][bj][m][n] = __builtin_amdgcn_mfma_f32_16x16x32_bf16(Bt[n][k], At[m][k], acc[ai][bj][m][n], 0, 0, 0); } } __builtin_amdgcn_s_setprio(0); } while (0)
#define PG8_WAIT_V(n) asm volatile("s_waitcnt vmcnt(" #n ")" ::: "memory")
#define PG8_WAIT_L(n) asm volatile("s_waitcnt lgkmcnt(" #n ")" ::: "memory")
#define PG8_BAR __builtin_amdgcn_s_barrier()
#define PG8_SCHED __builtin_amdgcn_sched_barrier(0)
    Unit cur, nxt; int ui = 0; int pend = -1;
    if (!S.next(0, cur)) return;
    f32x4 acc[2][2][4][2];
#pragma unroll
    for (int a = 0; a < 2; ++a)
#pragma unroll
        for (int b = 0; b < 2; ++b)
#pragma unroll
            for (int m = 0; m < 4; ++m)
#pragma unroll
                for (int n = 0; n < 2; ++n) acc[a][b][m][n] = (f32x4){0.f, 0.f, 0.f, 0.f};
    bf16x8 At[4][2], B0[2][2], B1[2][2];
    const char* cA = (const char*)g.A + (size_t)cur.pm * tstep; const char* cB = (const char*)g.Bt + (size_t)cur.pn * tstep;
    unsigned oA[2][2], nOA[2][2]; int tk[2][2] = {{0, 0}, {0, 0}};
    if constexpr (GATHER) {
        cA = (const char*)g.A;
        const int nv = S.a_valid(cur); const unsigned ab = S.a_base(cur);
        if (S.a_is_list(cur)) { const int* lst = S.a_list(cur);
#pragma unroll
            for (int h = 0; h < 2; ++h)
#pragma unroll
                for (int i = 0; i < 2; ++i) { const int r = min(h * HALF + rowA[i], nv - 1); oA[h][i] = ab + (unsigned)lst[r] * (unsigned)(K * 2) + colA[i]; }
        } else { const int r0 = S.a_row0(cur);
#pragma unroll
            for (int h = 0; h < 2; ++h)
#pragma unroll
                for (int i = 0; i < 2; ++i) { const int r = min(h * HALF + rowA[i], nv - 1); oA[h][i] = ab + (unsigned)(r0 + r) * (unsigned)(K * 2) + colA[i]; }
        }
    } else {
#pragma unroll
        for (int h = 0; h < 2; ++h)
#pragma unroll
            for (int i = 0; i < 2; ++i) oA[h][i] = voffA[i] + (unsigned)(h * hstep);
    }
#pragma unroll
    for (int h = 0; h < 2; ++h)
#pragma unroll
        for (int i = 0; i < 2; ++i) nOA[h][i] = oA[h][i];
#define PG8_OSEL(h, i) (GATHER ? (last ? nOA[h][i] : oA[h][i]) : oA[h][i])
    S.a_ready(cur);
    if constexpr (SP2) {
        PG8_STAGE(PG8_SB(0, 0), cB, voffB); PG8_STAGE(PG8_SB(0, 1), cB + hstep, voffB); PG8_STAGE2(PG8_SA(0, 0), cA, oA[0][0], oA[0][1]); PG8_STAGE2(PG8_SA(0, 1), cA, oA[1][0], oA[1][1]);
        if (wr == 1) PG8_BAR;
        PG8_WAIT_V(2); PG8_BAR;
        PG8_STAGE(PG8_SB(1, 0), cB + kstep, voffB); PG8_STAGE2(PG8_SA(1, 0), cA + kstep, oA[0][0], oA[0][1]); PG8_STAGE(PG8_SB(1, 1), cB + hstep + kstep, voffB);
        PG8_WAIT_V(6); PG8_BAR;
    } else {
        PG8_STAGE(PG8_SB(0, 0), cB, voffB); PG8_STAGE(PG8_SA(0, 0), cA, voffA); PG8_STAGE(PG8_SB(0, 1), cB + hstep, voffB); PG8_STAGE(PG8_SA(0, 1), cA + hstep, voffA);
        if (wr == 1) PG8_BAR;
        PG8_WAIT_V(4); PG8_BAR;
        PG8_STAGE(PG8_SB(1, 0), cB + kstep, voffB); PG8_STAGE(PG8_SA(1, 0), cA + kstep, voffA); PG8_STAGE(PG8_SB(1, 1), cB + hstep + kstep, voffB);
        PG8_WAIT_V(6); PG8_BAR;
    }
    for (;;) {
        const bool has_next = S.next(ui + 1, nxt);
        const char* nA = GATHER ? cA : (has_next ? (const char*)g.A + (size_t)nxt.pm * tstep : cA); const char* nB = has_next ? (const char*)g.Bt + (size_t)nxt.pn * tstep : cB;
        if constexpr (GATHER) { if (has_next) { const int nv = S.a_valid(nxt);
            if (S.a_is_list(nxt)) { const int* lst = S.a_list(nxt);
#pragma unroll
                for (int h = 0; h < 2; ++h)
#pragma unroll
                    for (int i = 0; i < 2; ++i) { const int* pp = lst + min(h * HALF + rowA[i], nv - 1); asm volatile("global_load_dword %0, %1, off" : "=v"(tk[h][i]) : "v"(pp) : "memory"); }
            } else { const int r0 = S.a_row0(nxt);
#pragma unroll
                for (int h = 0; h < 2; ++h)
#pragma unroll
                    for (int i = 0; i < 2; ++i) tk[h][i] = r0 + min(h * HALF + rowA[i], nv - 1);
            } } }
        for (int t = 0; t < nt; t += 2) {
            const bool last = (t == nt - 2);
            const char* a1 = cA + (size_t)(t + 1) * kstep;
            const char* a2 = last ? nA : cA + (size_t)(t + 2) * kstep; const char* b2 = last ? nB : cB + (size_t)(t + 2) * kstep;
            const char* a3 = a2 + kstep; const char* b3 = b2 + kstep;
            if (last && has_next) S.a_ready(nxt);
            if constexpr (GATHER) { if (last && has_next) { asm volatile("" : "+v"(tk[0][0]), "+v"(tk[0][1]), "+v"(tk[1][0]), "+v"(tk[1][1]));
#pragma unroll
                for (int h = 0; h < 2; ++h)
#pragma unroll
                    for (int i = 0; i < 2; ++i) nOA[h][i] = S.a_base(nxt) + (unsigned)tk[h][i] * (unsigned)(K * 2) + colA[i]; } }
            if constexpr (SP2) {
            PG8_LDB(B0, 0, 0); PG8_LDB(B1, 0, 1); PG8_SCHED; PG8_LDA(At, 0, 0); PG8_STAGE2(PG8_SA(1, 1), a1, oA[1][0], oA[1][1]);
            PG8_WAIT_V(8); PG8_WAIT_L(0); PG8_BAR; PG8_MMA(0, 0, At, B0); PG8_MMA(0, 1, At, B1); PG8_BAR; PG8_SCHED;
            PG8_LDA(At, 0, 1); PG8_STAGE(PG8_SB(0, 0), b2, voffB); PG8_STAGE(PG8_SB(0, 1), b2 + hstep, voffB); PG8_STAGE2(PG8_SA(0, 0), a2, PG8_OSEL(0, 0), PG8_OSEL(0, 1));
            PG8_WAIT_V(8); if (pend >= 0) { S.done_signal(pend); pend = -1; }
            PG8_WAIT_L(0); PG8_BAR; PG8_MMA(1, 0, At, B0); PG8_MMA(1, 1, At, B1); PG8_BAR; PG8_SCHED;
            PG8_LDB(B0, 1, 0); PG8_LDB(B1, 1, 1); PG8_SCHED; PG8_LDA(At, 1, 0); PG8_STAGE2(PG8_SA(0, 1), a2, PG8_OSEL(1, 0), PG8_OSEL(1, 1));
            PG8_WAIT_V(8); PG8_WAIT_L(0); PG8_BAR; PG8_MMA(0, 0, At, B0); PG8_MMA(0, 1, At, B1); PG8_BAR; PG8_SCHED;
            PG8_LDA(At, 1, 1); PG8_STAGE(PG8_SB(1, 0), b3, voffB); PG8_STAGE(PG8_SB(1, 1), b3 + hstep, voffB); PG8_STAGE2(PG8_SA(1, 0), a3, PG8_OSEL(0, 0), PG8_OSEL(0, 1));
            PG8_WAIT_V(8); PG8_WAIT_L(0); PG8_BAR; PG8_MMA(1, 0, At, B0); PG8_MMA(1, 1, At, B1); PG8_BAR; PG8_SCHED;
            } else {
            PG8_LDB(B0, 0, 0); PG8_SCHED; PG8_LDA(At, 0, 0); PG8_STAGE(PG8_SA(1, 1), a1 + hstep, voffA);
            PG8_WAIT_L(8); PG8_BAR; PG8_WAIT_L(0); PG8_MMA(0, 0, At, B0); PG8_BAR; PG8_SCHED;
            PG8_LDB(B1, 0, 1); PG8_STAGE(PG8_SB(0, 0), b2, voffB);
            PG8_BAR; PG8_WAIT_L(0); PG8_MMA(0, 1, At, B1); PG8_BAR;
            PG8_LDA(At, 0, 1); PG8_STAGE(PG8_SA(0, 0), a2, voffA);
            PG8_BAR; PG8_WAIT_L(0); PG8_MMA(1, 0, At, B0); PG8_BAR; PG8_SCHED;
            PG8_STAGE(PG8_SB(0, 1), b2 + hstep, voffB);
            PG8_WAIT_V(6); PG8_BAR; PG8_MMA(1, 1, At, B1); PG8_BAR;
            PG8_LDB(B0, 1, 0); PG8_SCHED; PG8_LDA(At, 1, 0); PG8_STAGE(PG8_SA(0, 1), a2 + hstep, voffA);
            PG8_WAIT_L(8); PG8_BAR; PG8_WAIT_L(0); PG8_MMA(0, 0, At, B0); PG8_BAR; PG8_SCHED;
            PG8_LDB(B1, 1, 1); PG8_STAGE(PG8_SB(1, 0), b3, voffB);
            PG8_BAR; PG8_WAIT_L(0); PG8_MMA(0, 1, At, B1); PG8_BAR;
            PG8_LDA(At, 1, 1); PG8_STAGE(PG8_SA(1, 0), a3, voffA);
            PG8_BAR; PG8_WAIT_L(0); PG8_MMA(1, 0, At, B0); PG8_BAR; PG8_SCHED;
            PG8_STAGE(PG8_SB(1, 1), b3 + hstep, voffB);
            PG8_WAIT_V(6); PG8_BAR; PG8_MMA(1, 1, At, B1); PG8_BAR;
            }
        }
        if constexpr (FP8) asm volatile("s_nop 15\n\ts_nop 15" ::: "memory");
        if constexpr (ALIGN_EPI) { if (wr == 0) PG8_BAR; }
        if constexpr (!Epi::AFTER_DRAIN) { E(acc, cur, wr, wc, fr, fq); S.done(cur); pend = S.done_defer(cur); }
        if (!has_next) break;
#pragma unroll
        for (int a = 0; a < 2; ++a)
#pragma unroll
            for (int b = 0; b < 2; ++b)
#pragma unroll
                for (int m = 0; m < 4; ++m)
#pragma unroll
                    for (int n = 0; n < 2; ++n) acc[a][b][m][n] = (f32x4){0.f, 0.f, 0.f, 0.f};
        cur = nxt; cA = nA; cB = nB; ++ui;
        if constexpr (GATHER) {
#pragma unroll
            for (int h = 0; h < 2; ++h)
#pragma unroll
                for (int i = 0; i < 2; ++i) oA[h][i] = nOA[h][i];
        }
        if constexpr (ALIGN_EPI) { if (wr == 1) PG8_BAR; }
    }
    PG8_WAIT_V(0);
    if (pend >= 0) { S.done_signal(pend); pend = -1; }
    if constexpr (!ALIGN_EPI) { if (wr == 0) PG8_BAR; }
    PG8_BAR;
    if constexpr (Epi::AFTER_DRAIN) { E.fused(acc, cur, wr, wc, fr, fq, lds, wid, lane); S.done(cur); }
#undef PG8_SA
#undef PG8_OSEL
#undef PG8_STAGE2
#undef PG8_SB
#undef PG8_STAGE
#undef PG8_LDA
#undef PG8_LDB
#undef PG8_MMA
#undef PG8_WAIT_V
#undef PG8_WAIT_L
#undef PG8_BAR
#undef PG8_SCHED
}
}

#ifndef MK_N_LAUNCHES
#define MK_N_LAUNCHES 1
#endif
#ifndef PROBE_DUP
#define PROBE_DUP -1
#endif
constexpr int N_PHASES = 10;
constexpr int NBATCH = 8, TT = 2048, MTOK = NBATCH * TT, D = 1024;
constexpr int HK = 512, NH = 4, DK = 128, DV = 128, CCH = 512, CLEN = 31, INC = 3584;
constexpr int NE = 32, TOPK = 4, FF = 1024;
constexpr float EPS = 1e-5f, SW_LIMIT = 7.0f, SW_ALPHA = 1.702f;
constexpr int NWAVES = 8, NTHR = 512;
constexpr int W1_ITEMS = 32 * 16 * 64, W1_P1 = 6144, W1_P2 = 20480, W1_P0 = W1_ITEMS - W1_P1 - W1_P2;
constexpr int W2_ITEMS = 32 * 16 * 32, W2_P7 = 4096, W2_P2 = W2_ITEMS - W2_P7;
constexpr int MOE_ROWS = (MTOK * TOPK / 256 + NE) * 256;

constexpr size_t MiB = 1u << 20;
constexpr size_t WS_CTL = 0, CTL_ZERO_BYTES = 1 * MiB;
constexpr size_t WS_WI = 1 * MiB;
constexpr size_t WS_WO = 8 * MiB;
constexpr size_t WS_TAB = 10 * MiB;
constexpr size_t WS_W1 = 16 * MiB;
constexpr size_t WS_W2 = 144 * MiB;
constexpr size_t WS_H = 208 * MiB;
constexpr size_t WS_XN = 272 * MiB;
constexpr size_t WS_Q = 304 * MiB, WS_KF = 320 * MiB, WS_KB = 336 * MiB, WS_V = 352 * MiB, WS_G = 368 * MiB, WS_U = 384 * MiB;
constexpr size_t WS_LF = 400 * MiB, WS_LB = 432 * MiB;
constexpr size_t WS_OF = 464 * MiB, WS_OB = 496 * MiB;
constexpr size_t WS_MIX = 528 * MiB;
constexpr size_t WS_XS = 304 * MiB;
constexpr size_t WS_ACT = 448 * MiB;
constexpr size_t WS_YS = 592 * MiB;
constexpr size_t WS_END = 736 * MiB;
constexpr size_t WS_WRT = WS_TAB;
constexpr size_t WS_SLOT = WS_TAB + 256 * 1024;
constexpr size_t WS_GATE = WS_TAB + 512 * 1024;
constexpr size_t WS_ROWTOK = WS_TAB + 1 * MiB;
constexpr int CW_BAR = 4096;
constexpr int CW_CNT = 16384;

constexpr int RING_OFF = 0, RING_BYTES = 131072;
constexpr int LDSCTL_OFF = 152576;
constexpr int MISC_OFF = LDSCTL_OFF + 320;
constexpr int TAB_OFF = LDSCTL_OFF + 1024;
constexpr int SB_OFF = LDSCTL_OFF + 2048;
constexpr int LDS_BYTES = 163840;

#define GAS __attribute__((address_space(1)))
#define LAS __attribute__((address_space(3)))
typedef unsigned short bf16;
typedef unsigned v4u __attribute__((ext_vector_type(4)));
typedef unsigned v2u __attribute__((ext_vector_type(2)));
typedef float f32x4 __attribute__((ext_vector_type(4)));
typedef GAS unsigned gu32;
#define RLX_AGENT __ATOMIC_RELAXED, __HIP_MEMORY_SCOPE_AGENT
#define LDS_WAIT() asm volatile("s_waitcnt lgkmcnt(0)" ::: "memory")
#define VM_WAIT() asm volatile("s_waitcnt vmcnt(0)" ::: "memory")

__device__ __forceinline__ float bf2f(unsigned b) { return __uint_as_float(b << 16); }
__device__ __forceinline__ unsigned pk2(float lo, float hi) { return pg8::cvt_pk_bf16(lo, hi); }
__device__ __forceinline__ float sigm(float x) { return __builtin_amdgcn_rcpf(1.0f + __expf(-x)); }
__device__ __forceinline__ float wave_sum(float v) {
#pragma unroll
    for (int o = 1; o < 64; o <<= 1) v += __shfl_xor(v, o);
    return v;
}

constexpr float SC_W = 512.f, SC_N2 = 16.f, SC_ACT = 8.f;
__device__ __forceinline__ unsigned pk4_fp8(float a, float b, float c, float d) {
    a = fminf(fmaxf(a, -448.f), 448.f); b = fminf(fmaxf(b, -448.f), 448.f); c = fminf(fmaxf(c, -448.f), 448.f); d = fminf(fmaxf(d, -448.f), 448.f);
    int w = 0; w = __builtin_amdgcn_cvt_pk_fp8_f32(a, b, w, false); w = __builtin_amdgcn_cvt_pk_fp8_f32(c, d, w, true); return (unsigned)w;
}

#define XB_TMO      128
#define XB_XCNT(j)  (256  + 64 * (j))
#define XB_XSUB(j)  (1280 + 64 * (j))
#define XB_XGEN(j)  (2304 + 64 * (j))
#define XB_TOP      3328
#define XB_TOPGEN   3392
#define XCD_BAR_WORDS 3456
#define XB_SPIN_CAP (1u << 18)

__device__ __forceinline__ unsigned xb_ld(unsigned* p)              { return __hip_atomic_load(p, __ATOMIC_RELAXED, __HIP_MEMORY_SCOPE_AGENT); }
__device__ __forceinline__ unsigned xb_add(unsigned* p, unsigned v) { return __hip_atomic_fetch_add(p, v, __ATOMIC_RELAXED, __HIP_MEMORY_SCOPE_AGENT); }
__device__ __forceinline__ unsigned xb_xcc_id() { return (unsigned)__builtin_amdgcn_s_getreg((3 << 11) | 20) & 0xFu; }
#define XB_SPIN(cond, bar) do { unsigned _sp = 0; while (cond) { __builtin_amdgcn_s_sleep(1); \
    if ((++_sp & 255u) == 0u) { if (xb_ld(&(bar)[XB_TMO])) break; if (_sp > XB_SPIN_CAP) { atomicAdd(&(bar)[XB_TMO], 1u); break; } } } } while (0)

struct XcdBarrier {
    unsigned* bar; unsigned x;
    volatile LAS unsigned* st;
};
__device__ __forceinline__ XcdBarrier xcd_barrier_post(unsigned* bar, volatile LAS unsigned* st) {
    XcdBarrier b; b.bar = bar; b.x = xb_xcc_id(); b.st = st;
    if (threadIdx.x == 0) (void)xb_add(&bar[XB_XCNT(b.x)], 1u);
    return b;
}
__device__ __forceinline__ void xcd_barrier_complete(unsigned* bar, unsigned x, unsigned& nloc, unsigned& nx) {
    const unsigned G = gridDim.x * gridDim.y * gridDim.z;
    unsigned sum, cnt, mine, sp = 0u;
    for (;;) {
        sum = 0u; cnt = 0u; mine = 0u;
#pragma unroll
        for (unsigned j = 0; j < 16; ++j) { const unsigned c = xb_ld(&bar[XB_XCNT(j)]); sum += c; cnt += (c > 0u) ? 1u : 0u; mine = (j == x) ? c : mine; }
        if (sum == G) break;
        __builtin_amdgcn_s_sleep(1);
        if ((++sp & 255u) == 0u) { if (xb_ld(&bar[XB_TMO])) break; if (sp > XB_SPIN_CAP) { atomicAdd(&bar[XB_TMO], 1u); break; } }
    }
    nloc = mine > 0u ? mine : 1u; nx = cnt > 0u ? cnt : 1u;
}
__device__ __forceinline__ void xcd_barrier(const XcdBarrier& b) {
    asm volatile("s_waitcnt vmcnt(0)" ::: "memory");
    __syncthreads();
    if (threadIdx.x == 0) {
        unsigned* bar = b.bar;
        __builtin_amdgcn_s_waitcnt(0);
        unsigned nloc = b.st[0], nx = b.st[1];
        if (nloc == 0u) { xcd_barrier_complete(bar, b.x, nloc, nx); b.st[0] = nloc; b.st[1] = nx; }
        const unsigned old = xb_add(&bar[XB_XSUB(b.x)], 1u);
        const unsigned gen = old / nloc;
        if (old + 1u == (gen + 1u) * nloc) {
            __builtin_amdgcn_fence(__ATOMIC_RELEASE, "agent");
            asm volatile("s_waitcnt vmcnt(0)" ::: "memory");
            const unsigned og = xb_add(&bar[XB_TOP], 1u);
            const unsigned tg = og / nx;
            if (og + 1u == (tg + 1u) * nx) xb_add(&bar[XB_TOPGEN], 1u);
            else XB_SPIN(xb_ld(&bar[XB_TOPGEN]) == tg, bar);
            __builtin_amdgcn_fence(__ATOMIC_ACQUIRE, "agent");
            xb_add(&bar[XB_XGEN(b.x)], 1u);
            asm volatile("s_waitcnt vmcnt(0)" ::: "memory");
        } else {
            XB_SPIN(xb_ld(&bar[XB_XGEN(b.x)]) == gen, bar);
            __builtin_amdgcn_fence(__ATOMIC_ACQUIRE, "agent");
            asm volatile("s_waitcnt vmcnt(0)" ::: "memory");
        }
    }
    __syncthreads();
}

#ifndef WT_STORES
#define WT_STORES 0
#endif
__device__ __forceinline__ void st16(void* p, v4u w) {
#if WT_STORES
    asm volatile("global_store_dwordx4 %0, %1, off sc0 sc1\n\ts_nop 1" :: "v"(p), "v"(w) : "memory");
#else
    *(v4u*)p = w;
#endif
}
__device__ __forceinline__ void st8(void* p, v2u w) {
#if WT_STORES
    asm volatile("global_store_dwordx2 %0, %1, off sc0 sc1\n\ts_nop 1" :: "v"(p), "v"(w) : "memory");
#else
    *(v2u*)p = w;
#endif
}
__device__ __forceinline__ void st8bf(bf16* p, const f32x4& a, const f32x4& b) {
    v4u w; w.x = pk2(a[0], a[1]); w.y = pk2(a[2], a[3]); w.z = pk2(b[0], b[1]); w.w = pk2(b[2], b[3]);
    st16(p, w);
}
struct EpiProj {
    static constexpr bool PERM = true, AFTER_DRAIN = false;
    bf16 *Q, *KF, *KB, *V, *G, *U; float *LF, *LB; const float* lbl;
    template <int TYP>
    __device__ __forceinline__ void tile(const pg8::f32x4 (&acc)[2][2][4][2], int row0, int cb) const {
#pragma unroll
        for (int bj = 0; bj < 2; ++bj) {
            const int col = cb + bj * 128;
            float lb[8];
            if (TYP == 1 || TYP == 2) {
                const float* L = lbl + (TYP - 1) * 1024 + col;
#pragma unroll
                for (int i = 0; i < 8; ++i) lb[i] = __builtin_amdgcn_rcpf(1.0f + __expf(L[512 + i] - L[i]));
            }
#pragma unroll
            for (int ai = 0; ai < 2; ++ai)
#pragma unroll
                for (int m = 0; m < 4; ++m) {
                    const size_t off = (size_t)(row0 + ai * 128 + m * 16) * 512 + col;
                    f32x4 a = acc[ai][bj][m][0], b = acc[ai][bj][m][1];
                    if (TYP == 0 || TYP == 4) {
#pragma unroll
                        for (int i = 0; i < 4; ++i) { a[i] = a[i] * sigm(a[i]); b[i] = b[i] * sigm(b[i]); }
                        st8bf((TYP == 0 ? Q : G) + off, a, b);
                    } else if (TYP == 3) {
                        st8bf(V + off, a, b);
                    } else {
                        f32x4 la, lbv, ka, kb;
#pragma unroll
                        for (int i = 0; i < 4; ++i) {
                            const float fa = lb[i] + (1.0f - lb[i]) * sigm(a[i]), fb = lb[4 + i] + (1.0f - lb[4 + i]) * sigm(b[i]);
                            la[i] = __logf(fa); lbv[i] = __logf(fb); ka[i] = 1.0f - fa; kb[i] = 1.0f - fb;
                        }
                        float* Lp = (TYP == 1 ? LF : LB) + off;
                        st16(Lp, (v4u)la); st16(Lp + 4, (v4u)lbv);
                        st8bf((TYP == 1 ? KF : KB) + off, ka, kb);
                    }
                }
        }
    }
    __device__ __forceinline__ void operator()(const pg8::f32x4 (&acc)[2][2][4][2], const pg8::Unit& u, int wr, int wc, int fr, int fq) const {
        const int row0 = u.pm * 256 + wr * 64 + fr, pn = u.pn;
        if (pn >= 10) {
            const int col = (pn - 10) * 128 + wc * 32 + 8 * fq;
#pragma unroll
            for (int ai = 0; ai < 2; ++ai)
#pragma unroll
                for (int m = 0; m < 4; ++m) {
                    f32x4 a = acc[ai][0][m][0], b = acc[ai][0][m][1]; const f32x4 ga = acc[ai][1][m][0], gb = acc[ai][1][m][1];
#pragma unroll
                    for (int i = 0; i < 4; ++i) { a[i] = a[i] * sigm(ga[i]); b[i] = b[i] * sigm(gb[i]); }
                    st8bf(U + (size_t)(row0 + ai * 128 + m * 16) * 512 + col, a, b);
                }
        } else {
            const int cb = (pn & 1) * 256 + wc * 32 + 8 * fq, typ = pn >> 1;
            if (typ == 0) tile<0>(acc, row0, cb);
            else if (typ == 1) tile<1>(acc, row0, cb);
            else if (typ == 2) tile<2>(acc, row0, cb);
            else if (typ == 3) tile<3>(acc, row0, cb);
            else tile<4>(acc, row0, cb);
        }
    }
};
struct EpiRes {
    static constexpr bool PERM = false, AFTER_DRAIN = false;
    const float* X; float* H;
    __device__ __forceinline__ void operator()(const pg8::f32x4 (&acc)[2][2][4][2], const pg8::Unit& u, int wr, int wc, int fr, int fq) const {
        const int row0 = u.pm * 256 + wr * 64 + fr, col0 = u.pn * 256 + wc * 32 + 4 * fq;
#pragma unroll
        for (int ai = 0; ai < 2; ++ai)
#pragma unroll
            for (int m = 0; m < 4; ++m) {
                const size_t off = (size_t)(row0 + ai * 128 + m * 16) * D + col0;
#pragma unroll
                for (int bj = 0; bj < 2; ++bj)
#pragma unroll
                    for (int n = 0; n < 2; ++n) { const f32x4 xv = *(const f32x4*)(X + off + bj * 128 + n * 16); st16(H + off + bj * 128 + n * 16, (v4u)(xv + acc[ai][bj][m][n])); }
            }
    }
};
struct EpiSwiglu {
    static constexpr bool PERM = true, AFTER_DRAIN = false;
    unsigned char* ACT; const float* b1;
    __device__ __forceinline__ void operator()(const pg8::f32x4 (&acc)[2][2][4][2], const pg8::Unit& u, int wr, int wc, int fr, int fq) const {
        const int e = u.pn >> 3, pn = u.pn & 7, row0 = u.pm * 256 + wr * 64 + fr, col = pn * 128 + wc * 32 + 8 * fq;
        const float* bg = b1 + (size_t)e * 2048 + col; const float* bl = bg + 1024;
        float g[8], l[8];
#pragma unroll
        for (int i = 0; i < 8; ++i) { g[i] = bg[i]; l[i] = bl[i]; }
#pragma unroll
        for (int ai = 0; ai < 2; ++ai)
#pragma unroll
            for (int m = 0; m < 4; ++m) {
                f32x4 o[2];
#pragma unroll
                for (int n = 0; n < 2; ++n)
#pragma unroll
                    for (int i = 0; i < 4; ++i) {
                        const float hg = fminf(acc[ai][0][m][n][i] * (1.0f / (SC_N2 * SC_W)) + g[4 * n + i], SW_LIMIT);
                        const float hl = fminf(fmaxf(acc[ai][1][m][n][i] * (1.0f / (SC_N2 * SC_W)) + l[4 * n + i], -SW_LIMIT), SW_LIMIT);
                        o[n][i] = hg * sigm(SW_ALPHA * hg) * (hl + 1.0f) * SC_ACT;
                    }
                v2u w; w.x = pk4_fp8(o[0][0], o[0][1], o[0][2], o[0][3]); w.y = pk4_fp8(o[1][0], o[1][1], o[1][2], o[1][3]);
#if defined(MOE_MERGED)
                asm volatile("global_store_dwordx2 %0, %1, off sc0 sc1\n\ts_nop 1" :: "v"(ACT + (size_t)(row0 + ai * 128 + m * 16) * FF + col), "v"(w) : "memory");
#else
                st8(ACT + (size_t)(row0 + ai * 128 + m * 16) * FF + col, w);
#endif
            }
    }
};
struct EpiDown {
    static constexpr bool PERM = true, AFTER_DRAIN = false;
    bf16* YS; const float* b2;
    __device__ __forceinline__ void operator()(const pg8::f32x4 (&acc)[2][2][4][2], const pg8::Unit& u, int wr, int wc, int fr, int fq) const {
        const int e = u.pn >> 2, pn = u.pn & 3, row0 = u.pm * 256 + wr * 64 + fr, col0 = pn * 256 + wc * 32 + 8 * fq;
#pragma unroll
        for (int bj = 0; bj < 2; ++bj) {
            const float* bp = b2 + (size_t)e * D + col0 + bj * 128;
            const f32x4 b0 = *(const f32x4*)bp, b1v = *(const f32x4*)(bp + 4);
#pragma unroll
            for (int ai = 0; ai < 2; ++ai)
#pragma unroll
                for (int m = 0; m < 4; ++m)
                    st8bf(YS + (size_t)(row0 + ai * 128 + m * 16) * D + col0 + bj * 128, acc[ai][bj][m][0] * (1.0f / (SC_ACT * SC_W)) + b0, acc[ai][bj][m][1] * (1.0f / (SC_ACT * SC_W)) + b1v);
        }
    }
};
struct MoeOrder {
    const volatile LAS int* bs; int ntn, G, v; const volatile LAS int* cl; const int* rowtok;
    __device__ __forceinline__ const int* a_list(const pg8::Unit& u) const { const int e = u.pn / ntn; return rowtok + e * MTOK + (u.pm - bs[e]) * 256; }
    __device__ __forceinline__ int a_valid(const pg8::Unit& u) const { const int e = u.pn / ntn; return min(256, cl[e] - (u.pm - bs[e]) * 256); }
    __device__ __forceinline__ bool next(int i, pg8::Unit& u) const {
        int L = i * G + v; const int nb = bs[32];
        if (L >= nb * ntn * (((PROBE_DUP) == 17 && ntn == 8) || ((PROBE_DUP) == 18 && ntn == 4) ? 2 : 1)) return false;
        if (L >= nb * ntn) L -= nb * ntn;
        const int mb = L / ntn, pn = L - mb * ntn;
        const int ln = (int)(threadIdx.x & 63);
        const int e = __popcll(__ballot(ln < NE - 1 && bs[ln + 1] <= mb));
        u.pm = mb; u.pn = e * ntn + pn; return true;
    }
    __device__ __forceinline__ bool a_is_list(const pg8::Unit&) const { return true; }
    __device__ __forceinline__ unsigned a_base(const pg8::Unit&) const { return 0u; }
    __device__ __forceinline__ int a_row0(const pg8::Unit&) const { return 0; }
    __device__ __forceinline__ void a_ready(const pg8::Unit&) const {}
    __device__ __forceinline__ void done(const pg8::Unit&) const {}
    __device__ __forceinline__ int done_defer(const pg8::Unit&) const { return -1; }
    __device__ __forceinline__ void done_signal(int) const {}
};
constexpr int CW_BLK = 32768;
struct MoeOrder2 {
    const volatile LAS int* bs; int G, v; const volatile LAS int* cl; const int* rowtok; unsigned* ctl;
    __device__ __forceinline__ bool is_down(const pg8::Unit& u) const { return u.pn >= 512; }
    __device__ __forceinline__ int expert(const pg8::Unit& u) const { return is_down(u) ? (u.pn - 512) >> 2 : u.pn >> 3; }
    __device__ __forceinline__ bool a_is_list(const pg8::Unit& u) const { return !is_down(u); }
    __device__ __forceinline__ unsigned a_base(const pg8::Unit& u) const { return is_down(u) ? (unsigned)WS_ACT : (unsigned)WS_XN; }
    __device__ __forceinline__ int a_row0(const pg8::Unit& u) const { return u.pm * 256; }
    __device__ __forceinline__ const int* a_list(const pg8::Unit& u) const { const int e = expert(u); return rowtok + e * MTOK + (u.pm - bs[e]) * 256; }
    __device__ __forceinline__ int a_valid(const pg8::Unit& u) const { const int e = expert(u); return min(256, cl[e] - (u.pm - bs[e]) * 256); }
    __device__ __forceinline__ bool next(int i, pg8::Unit& u) const {
        const int L = i * G + v, nb = bs[32];
        if (L >= nb * 12) return false;
        const bool dn = L >= nb * 8; const int L2 = dn ? L - nb * 8 : L, ntn = dn ? 4 : 8;
        const int mb = L2 / ntn, pn = L2 - mb * ntn;
        const int ln = (int)(threadIdx.x & 63);
        const int e = __popcll(__ballot(ln < NE - 1 && bs[ln + 1] <= mb));
        u.pm = mb; u.pn = (dn ? 512 : 0) + e * ntn + pn; return true;
    }
    __device__ __forceinline__ void a_ready(const pg8::Unit& u) const {
        if (!is_down(u)) return;
        if (threadIdx.x < 64) {
            const unsigned long long t0 = __builtin_amdgcn_s_memrealtime(); unsigned polls = 0;
            while ((unsigned)__builtin_amdgcn_readfirstlane(__hip_atomic_load(ctl + CW_BLK + 64 * u.pm, __ATOMIC_RELAXED, __HIP_MEMORY_SCOPE_AGENT)) < 64u) {
                if ((++polls & 255u) == 0u && __builtin_amdgcn_readfirstlane(__hip_atomic_load(ctl + 1, __ATOMIC_RELAXED, __HIP_MEMORY_SCOPE_AGENT)) != 0u) break;
                if (__builtin_amdgcn_s_memrealtime() - t0 > 2000000ull) { if (threadIdx.x == 0) __hip_atomic_store(ctl + 1, 1u, __ATOMIC_RELAXED, __HIP_MEMORY_SCOPE_AGENT); break; }
                __builtin_amdgcn_s_sleep(2); }
            __builtin_amdgcn_fence(__ATOMIC_ACQUIRE, "agent");
            asm volatile("s_waitcnt vmcnt(0)" ::: "memory");
        }
        asm volatile("" ::: "memory"); __builtin_amdgcn_s_barrier(); asm volatile("" ::: "memory");
    }
    __device__ __forceinline__ void done(const pg8::Unit&) const {}
    __device__ __forceinline__ int done_defer(const pg8::Unit& u) const { return is_down(u) ? -1 : u.pm; }
    __device__ __forceinline__ void done_signal(int mb) const { if ((threadIdx.x & 63) == 0) __hip_atomic_fetch_add(ctl + CW_BLK + 64 * mb, 1u, __ATOMIC_RELAXED, __HIP_MEMORY_SCOPE_AGENT); }
};
struct EpiMoe {
    static constexpr bool PERM = true, AFTER_DRAIN = false;
    EpiSwiglu up; EpiDown down;
    __device__ __forceinline__ void operator()(const pg8::f32x4 (&acc)[2][2][4][2], const pg8::Unit& u, int wr, int wc, int fr, int fq) const {
        if (u.pn >= 512) { pg8::Unit d; d.pm = u.pm; d.pn = u.pn - 512; down(acc, d, wr, wc, fr, fq); } else up(acc, u, wr, wc, fr, fq);
    }
};

#ifndef PROBE_DUP
#define PROBE_DUP -1
#endif
struct OrderRep : pg8::StaticOrder {
    int reps;
    __device__ __forceinline__ bool next(int i, pg8::Unit& u) const {
        const int per = (nwg + G - 1) / G, r = i / per;
        if (r >= reps) return false;
        return pg8::StaticOrder::next(i - r * per, u) ? true : ((r + 1 < reps) ? pg8::StaticOrder::next(0, u) : false);
    }
};
struct RmIdent { __device__ __forceinline__ int operator()(int n) const { return n; } };
struct RmWin {
    __device__ __forceinline__ int operator()(int n) const {
        if (n < 2560) return n;
        if (n < 3072) { const int j = n - 2560; return 2560 + (j >> 7) * 256 + (j & 127); }
        const int j = n - 3072; return 2560 + (j >> 7) * 256 + 128 + (j & 127);
    }
};
struct RmW1 {
    __device__ __forceinline__ int operator()(int n) const {
        if (n < 1024) return (n >> 7) * 256 + (n & 127);
        const int j = n - 1024; return (j >> 7) * 256 + 128 + (j & 127);
    }
};
__device__ __forceinline__ void p0_load(const float* W, int N, int item, int lane, f32x4 (&v)[8]) {
    const int nblk = N / 32, kb = item / nblk, nb = item % nblk, k0 = 64 * kb, n0 = 32 * nb;
    const int r8 = lane >> 3, c4 = lane & 7;
#pragma unroll
    for (int i = 0; i < 8; ++i) v[i] = *(const f32x4*)(W + (size_t)(k0 + 8 * i + r8) * N + n0 + 4 * c4);
}
template <bool FP8OUT, class RM>
__device__ __forceinline__ void p0_finish(const f32x4 (&v)[8], int K, int N, void* WTv, RM rm, LAS float* scr, int item, int lane) {
    const int nblk = N / 32, kb = item / nblk, nb = item % nblk, k0 = 64 * kb, n0 = 32 * nb;
    const int r8 = lane >> 3, c4 = lane & 7;
#pragma unroll
    for (int i = 0; i < 8; ++i) *(LAS f32x4*)(scr + (8 * i + r8) * 36 + 4 * c4) = v[i];
    LDS_WAIT(); asm volatile("" ::: "memory");
    const int n = lane & 31, kh = lane >> 5; const LAS float* s = scr + (32 * kh) * 36 + n;
    if constexpr (FP8OUT) {
        unsigned w[8];
#pragma unroll
        for (int j = 0; j < 8; ++j) w[j] = pk4_fp8(s[(4 * j) * 36] * SC_W, s[(4 * j + 1) * 36] * SC_W, s[(4 * j + 2) * 36] * SC_W, s[(4 * j + 3) * 36] * SC_W);
        GAS v4u* dst = (GAS v4u*)((unsigned char*)WTv + (size_t)rm(n0 + n) * K + k0 + 32 * kh);
        dst[0] = (v4u){w[0], w[1], w[2], w[3]}; dst[1] = (v4u){w[4], w[5], w[6], w[7]};
    } else {
        unsigned w[16];
#pragma unroll
        for (int j = 0; j < 16; ++j) w[j] = pk2(s[(2 * j) * 36], s[(2 * j + 1) * 36]);
        GAS v4u* dst = (GAS v4u*)((bf16*)WTv + (size_t)rm(n0 + n) * K + k0 + 32 * kh);
#pragma unroll
        for (int q = 0; q < 4; ++q) dst[q] = (v4u){w[4 * q], w[4 * q + 1], w[4 * q + 2], w[4 * q + 3]};
    }
    LDS_WAIT(); asm volatile("" ::: "memory");
}
template <bool FP8OUT, class RM>
__device__ __forceinline__ void p0_item(const float* W, int K, int N, void* WTv, RM rm, LAS float* scr, int item, int lane) {
    f32x4 v[8]; p0_load(W, N, item, lane, v); p0_finish<FP8OUT>(v, K, N, WTv, rm, scr, item, lane);
}
template <class RM>
__device__ __forceinline__ void convert_range_fp8(const float* W, int K, int N, unsigned char* WT, RM rm, int ipe_log2, int first, int stride, int count, int base, LAS float* scr, int lane) {
    const size_t esz = (size_t)K * N; const int mask = (1 << ipe_log2) - 1;
    f32x4 va[8], vb[8];
    int it = first;
    if (it < count) p0_load(W + (size_t)((base + it) >> ipe_log2) * esz, N, (base + it) & mask, lane, va);
    while (it < count) {
        const int i1 = it + stride, i2 = it + 2 * stride;
        if (i1 < count) p0_load(W + (size_t)((base + i1) >> ipe_log2) * esz, N, (base + i1) & mask, lane, vb);
        p0_finish<true>(va, K, N, WT + (size_t)((base + it) >> ipe_log2) * esz, rm, scr, (base + it) & mask, lane);
        if (i1 >= count) break;
        if (i2 < count) p0_load(W + (size_t)((base + i2) >> ipe_log2) * esz, N, (base + i2) & mask, lane, va);
        p0_finish<true>(vb, K, N, WT + (size_t)((base + i1) >> ipe_log2) * esz, rm, scr, (base + i1) & mask, lane);
        it = i2;
    }
}
__device__ __forceinline__ void rms_row_to_bf16(const float* xrow, const float* w, bf16* orow, int lane) {
    const f32x4* xr = (const f32x4*)xrow + lane; const f32x4* wr = (const f32x4*)w + lane;
    f32x4 v[4]; float s = 0.f;
#pragma unroll
    for (int j = 0; j < 4; ++j) { v[j] = xr[64 * j]; s += (v[j].x * v[j].x + v[j].y * v[j].y) + (v[j].z * v[j].z + v[j].w * v[j].w); }
    const float rstd = rsqrtf(wave_sum(s) * (1.f / D) + EPS);
    v2u* o8 = (v2u*)orow + lane;
#pragma unroll
    for (int j = 0; j < 4; ++j) { const f32x4 g = wr[64 * j]; v2u o; o.x = pk2(v[j].x * rstd * g.x, v[j].y * rstd * g.y); o.y = pk2(v[j].z * rstd * g.z, v[j].w * rstd * g.w); o8[64 * j] = o; }
}


__device__ __forceinline__ pg8::bf16x8 lds_frag(const LAS unsigned char* p) { return *(const LAS pg8::bf16x8*)p; }
__device__ __forceinline__ pg8::bf16x8 mk_frag(v2u a, v2u b) { const v4u w = (v4u){a.x, a.y, b.x, b.y}; return (pg8::bf16x8)w; }
struct HgCtx {
    LAS unsigned char* lds; const bf16 *Qb, *Kp, *Vb; const float* Lp; float* Op;
    int b, h, dir, vh, lane, wave, lr, lq, dA, seg, tauB, dg;
    unsigned offA[16], offB, offV, ke_tr, v_tr;
};
constexpr int HG_BF = 0, HG_AM = 0, HG_QI = 33792, HG_KK = 51200, HG_KE = 68608, HG_V = 86016, HG_ST = 95232, HG_SEG = 112640, HG_DEC = 114688;
constexpr int HG_RSD = 272, HG_RSS = 144, HG_RSBF = 528;
__device__ __forceinline__ void hgrn_load(const HgCtx& c, int n, float (&lf)[16], v4u (&qB)[2], v4u (&kB)[2], v4u& vB) {
    const size_t cb = (size_t)__builtin_amdgcn_readfirstlane(c.b * TT + (c.dir ? (TT / 64 - 1 - n) * 64 : n * 64)) * 512 + c.h * 128;
    const float* Lc = c.Lp + cb; const bf16* Qc = c.Qb + cb; const bf16* Kc = c.Kp + cb; const bf16* Vc = c.Vb + cb;
#pragma unroll
    for (int i = 0; i < 16; ++i) lf[i] = Lc[c.offA[i]];
    qB[0] = *(const v4u*)(Qc + c.offB); qB[1] = *(const v4u*)(Qc + c.offB + 8); kB[0] = *(const v4u*)(Kc + c.offB); kB[1] = *(const v4u*)(Kc + c.offB + 8);
    vB = *(const v4u*)(Vc + c.offV);
}
__device__ __forceinline__ void hgrn_chunk(const HgCtx& c, int n, float (&lf)[16], v4u (&qB)[2], v4u (&kB)[2], v4u& vB, f32x4 (&S)[4]) {
    LAS unsigned char* lds = c.lds;
    const int dir = c.dir, lr = c.lr, lq = c.lq, wave = c.wave, dA = c.dA, seg = c.seg, tauB = c.tauB, dg = c.dg;
    const int tb = c.b * TT + (dir ? (TT / 64 - 1 - n) * 64 : n * 64);
    float bl[16]; { float cs = 0.f;
#pragma unroll
        for (int i = 0; i < 16; ++i) { cs += lf[i]; bl[i] = cs; }
        *(LAS float*)(lds + HG_SEG + (seg * 128 + dA) * 4) = cs; }
    __syncthreads();
    {
        const float p0 = *(LAS float*)(lds + HG_SEG + (0 * 128 + dA) * 4), p1 = *(LAS float*)(lds + HG_SEG + (1 * 128 + dA) * 4),
                    p2 = *(LAS float*)(lds + HG_SEG + (2 * 128 + dA) * 4), p3 = *(LAS float*)(lds + HG_SEG + (3 * 128 + dA) * 4);
        const float pre = (seg > 0 ? p0 : 0.f) + (seg > 1 ? p1 : 0.f) + (seg > 2 ? p2 : 0.f);
#pragma unroll
        for (int i = 0; i < 16; ++i) *(LAS float*)(lds + HG_BF + (16 * seg + i) * HG_RSBF + dA * 4) = pre + bl[i];
        if (seg == 0) *(LAS float*)(lds + HG_DEC + dA * 4) = __expf((p0 + p1) + (p2 + p3));
    }
    __syncthreads();
    {
        const unsigned qw[8] = {qB[0].x, qB[0].y, qB[0].z, qB[0].w, qB[1].x, qB[1].y, qB[1].z, qB[1].w};
        const unsigned kw[8] = {kB[0].x, kB[0].y, kB[0].z, kB[0].w, kB[1].x, kB[1].y, kB[1].z, kB[1].w};
        unsigned qo[8], ko[8], eo[8];
#pragma unroll
        for (int i = 0; i < 4; ++i) {
            const f32x4 bb = *(const LAS f32x4*)(lds + HG_BF + tauB * HG_RSBF + dg * 64 + i * 16);
            const f32x4 dc = *(const LAS f32x4*)(lds + HG_DEC + dg * 64 + i * 16);
#pragma unroll
            for (int j = 0; j < 2; ++j) {
                const float e0 = __expf(bb[2 * j]), e1 = __expf(bb[2 * j + 1]);
                const unsigned qq = qw[2 * i + j], kk = kw[2 * i + j];
                const float k0 = bf2f(kk & 0xffffu) * __builtin_amdgcn_rcpf(e0), k1 = bf2f(kk >> 16) * __builtin_amdgcn_rcpf(e1);
                qo[2 * i + j] = pk2(bf2f(qq & 0xffffu) * e0, bf2f(qq >> 16) * e1);
                ko[2 * i + j] = pk2(k0, k1);
                eo[2 * i + j] = pk2(k0 * dc[2 * j], k1 * dc[2 * j + 1]);
            }
        }
        *(LAS v4u*)(lds + HG_QI + tauB * HG_RSD + dg * 32) = (v4u){qo[0], qo[1], qo[2], qo[3]}; *(LAS v4u*)(lds + HG_QI + tauB * HG_RSD + dg * 32 + 16) = (v4u){qo[4], qo[5], qo[6], qo[7]};
        *(LAS v4u*)(lds + HG_KK + tauB * HG_RSD + dg * 32) = (v4u){ko[0], ko[1], ko[2], ko[3]}; *(LAS v4u*)(lds + HG_KK + tauB * HG_RSD + dg * 32 + 16) = (v4u){ko[4], ko[5], ko[6], ko[7]};
        *(LAS v4u*)(lds + HG_KE + tauB * HG_RSD + dg * 32) = (v4u){eo[0], eo[1], eo[2], eo[3]}; *(LAS v4u*)(lds + HG_KE + tauB * HG_RSD + dg * 32 + 16) = (v4u){eo[4], eo[5], eo[6], eo[7]};
        *(LAS v4u*)(lds + HG_V + tauB * HG_RSS + dg * 16) = vB;
    }
    __syncthreads();
    if (n + 2 < TT / 64) hgrn_load(c, n + 2, lf, qB, kB, vB);
    const int ei = wave & 3, tp = wave >> 2;
    v2u ket[2][2], vt[4][2][2];
    asm volatile("ds_read_b64_tr_b16 %0, %4\n\tds_read_b64_tr_b16 %1, %4 offset:1088\n\tds_read_b64_tr_b16 %2, %4 offset:8704\n\tds_read_b64_tr_b16 %3, %4 offset:9792"
                 : "=&v"(ket[0][0]), "=&v"(ket[0][1]), "=&v"(ket[1][0]), "=&v"(ket[1][1]) : "v"(c.ke_tr) : "memory");
#define HG_VTR(e4, o0, o1, o2, o3) asm volatile("ds_read_b64_tr_b16 %0, %4 offset:" #o0 "\n\tds_read_b64_tr_b16 %1, %4 offset:" #o1 "\n\tds_read_b64_tr_b16 %2, %4 offset:" #o2 "\n\tds_read_b64_tr_b16 %3, %4 offset:" #o3 \
                 : "=&v"(vt[e4][0][0]), "=&v"(vt[e4][0][1]), "=&v"(vt[e4][1][0]), "=&v"(vt[e4][1][1]) : "v"(c.v_tr) : "memory")
    HG_VTR(0, 0, 576, 4608, 5184); HG_VTR(1, 32, 608, 4640, 5216); HG_VTR(2, 64, 640, 4672, 5248); HG_VTR(3, 96, 672, 4704, 5280);
#undef HG_VTR
    {
        const int ti = wave & 3;
#pragma unroll
        for (int sii = 0; sii < 2; ++sii) {
            const int si = tp * 2 + sii;
            v2u w = (v2u){0u, 0u};
            if (si <= ti) {
                f32x4 a = (f32x4){0.f, 0.f, 0.f, 0.f};
#pragma unroll
                for (int kk = 0; kk < 4; ++kk)
                    a = __builtin_amdgcn_mfma_f32_16x16x32_bf16(lds_frag(lds + HG_KK + (16 * si + lr) * HG_RSD + kk * 64 + lq * 16), lds_frag(lds + HG_QI + (16 * ti + lr) * HG_RSD + kk * 64 + lq * 16), a, 0, 0, 0);
                const int s0 = 16 * si + 4 * lq, t = 16 * ti + lr;
                w.x = pk2(s0 + 0 <= t ? a[0] : 0.f, s0 + 1 <= t ? a[1] : 0.f); w.y = pk2(s0 + 2 <= t ? a[2] : 0.f, s0 + 3 <= t ? a[3] : 0.f);
            }
            *(LAS v2u*)(lds + HG_AM + (16 * ti + lr) * HG_RSS + (16 * si + 4 * lq) * 2) = w;
        }
    }
    f32x4 o[2];
#pragma unroll
    for (int tt = 0; tt < 2; ++tt) {
        o[tt] = (f32x4){0.f, 0.f, 0.f, 0.f};
#pragma unroll
        for (int kk = 0; kk < 4; ++kk)
            o[tt] = __builtin_amdgcn_mfma_f32_16x16x32_bf16(lds_frag(lds + HG_ST + (16 * ei + lr) * HG_RSD + kk * 64 + lq * 16), lds_frag(lds + HG_QI + (16 * (2 * tp + tt) + lr) * HG_RSD + kk * 64 + lq * 16), o[tt], 0, 0, 0);
    }
    asm volatile("s_waitcnt lgkmcnt(0)"
                 : "+v"(ket[0][0]), "+v"(ket[0][1]), "+v"(ket[1][0]), "+v"(ket[1][1]),
                   "+v"(vt[0][0][0]), "+v"(vt[0][0][1]), "+v"(vt[0][1][0]), "+v"(vt[0][1][1]), "+v"(vt[1][0][0]), "+v"(vt[1][0][1]), "+v"(vt[1][1][0]), "+v"(vt[1][1][1]),
                   "+v"(vt[2][0][0]), "+v"(vt[2][0][1]), "+v"(vt[2][1][0]), "+v"(vt[2][1][1]), "+v"(vt[3][0][0]), "+v"(vt[3][0][1]), "+v"(vt[3][1][0]), "+v"(vt[3][1][1]) :: "memory");
    {
        const f32x4 dv = *(const LAS f32x4*)(lds + HG_DEC + (16 * wave + 4 * lq) * 4);
#pragma unroll
        for (int e4 = 0; e4 < 4; ++e4) S[e4] = S[e4] * dv;
#pragma unroll
        for (int kk = 0; kk < 2; ++kk) {
            const pg8::bf16x8 af = mk_frag(ket[kk][0], ket[kk][1]);
#pragma unroll
            for (int e4 = 0; e4 < 4; ++e4) S[e4] = __builtin_amdgcn_mfma_f32_16x16x32_bf16(af, mk_frag(vt[e4][kk][0], vt[e4][kk][1]), S[e4], 0, 0, 0);
        }
    }
    const pg8::bf16x8 vf0 = ei == 0 ? mk_frag(vt[0][0][0], vt[0][0][1]) : ei == 1 ? mk_frag(vt[1][0][0], vt[1][0][1]) : ei == 2 ? mk_frag(vt[2][0][0], vt[2][0][1]) : mk_frag(vt[3][0][0], vt[3][0][1]);
    const pg8::bf16x8 vf1 = ei == 0 ? mk_frag(vt[0][1][0], vt[0][1][1]) : ei == 1 ? mk_frag(vt[1][1][0], vt[1][1][1]) : ei == 2 ? mk_frag(vt[2][1][0], vt[2][1][1]) : mk_frag(vt[3][1][0], vt[3][1][1]);
    __syncthreads();
#pragma unroll
    for (int tt = 0; tt < 2; ++tt) {
        o[tt] = __builtin_amdgcn_mfma_f32_16x16x32_bf16(vf0, lds_frag(lds + HG_AM + (16 * (2 * tp + tt) + lr) * HG_RSS + 0 * 64 + lq * 16), o[tt], 0, 0, 0);
        o[tt] = __builtin_amdgcn_mfma_f32_16x16x32_bf16(vf1, lds_frag(lds + HG_AM + (16 * (2 * tp + tt) + lr) * HG_RSS + 1 * 64 + lq * 16), o[tt], 0, 0, 0);
        const int t = 16 * (2 * tp + tt) + lr;
        *(f32x4*)(c.Op + (size_t)(dir ? tb + 63 - t : tb + t) * 512 + c.h * 128 + c.vh * 64 + 16 * ei + 4 * lq) = o[tt];
    }
#pragma unroll
    for (int e4 = 0; e4 < 4; ++e4) { v2u w; w.x = pk2(S[e4][0], S[e4][1]); w.y = pk2(S[e4][2], S[e4][3]); *(LAS v2u*)(lds + HG_ST + (16 * e4 + lr) * HG_RSD + (16 * wave + 4 * lq) * 2) = w; }
}
__device__ __forceinline__ void hgrn_unit(LAS unsigned char* lds, int unit, const bf16* Qb, const bf16* KFb, const bf16* KBb, const bf16* Vb, const float* LFb, const float* LBb,
                                          float* OFb, float* OBb, int tid, int lane, int wave) {
    HgCtx c;
    c.lds = lds; c.vh = unit & 1; c.dir = (unit >> 1) & 1; c.h = (unit >> 2) & 3; c.b = unit >> 4;
    c.Qb = Qb; c.Vb = Vb; c.Kp = c.dir ? KBb : KFb; c.Lp = c.dir ? LBb : LFb; c.Op = c.dir ? OBb : OFb;
    c.lane = lane; c.wave = wave; c.lr = lane & 15; c.lq = lane >> 4;
    c.dA = tid & 127; c.seg = tid >> 7;
    c.tauB = tid >> 3; c.dg = tid & 7;
    for (int i = tid; i < 64 * HG_RSD / 16; i += NTHR) *(LAS v4u*)(lds + HG_ST + i * 16) = (v4u){0u, 0u, 0u, 0u};
    f32x4 S[4];
#pragma unroll
    for (int i = 0; i < 4; ++i) S[i] = (f32x4){0.f, 0.f, 0.f, 0.f};
#pragma unroll
    for (int i = 0; i < 16; ++i) { const int tau = 16 * c.seg + i; c.offA[i] = (unsigned)((c.dir ? 63 - tau : tau) * 512 + c.dA); }
    c.offB = (unsigned)((c.dir ? 63 - c.tauB : c.tauB) * 512 + 16 * c.dg); c.offV = (unsigned)((c.dir ? 63 - c.tauB : c.tauB) * 512 + c.vh * 64 + 8 * c.dg);
    const unsigned trrow = (unsigned)(8 * c.lq + ((lane & 15) >> 2)), trcol = (unsigned)(4 * (lane & 3));
    c.ke_tr = (unsigned)(size_t)(lds + HG_KE) + trrow * HG_RSD + (16 * wave + trcol) * 2;
    c.v_tr = (unsigned)(size_t)(lds + HG_V) + trrow * HG_RSS + trcol * 2;
    float lf0[16], lf1[16]; v4u qB0[2], kB0[2], vB0, qB1[2], kB1[2], vB1;
    hgrn_load(c, 0, lf0, qB0, kB0, vB0); hgrn_load(c, 1, lf1, qB1, kB1, vB1);
#pragma unroll 1
    for (int n = 0; n < TT / 64; n += 2) { hgrn_chunk(c, n, lf0, qB0, kB0, vB0, S); hgrn_chunk(c, n + 1, lf1, qB1, kB1, vB1, S); }
    __syncthreads();
}

__device__ __forceinline__ void router_finish(float (&a)[NE], int m, int lane, const float* router_b, LAS int* lcnt, LAS unsigned* sbw, float* GATE) {
#define RF_STEP(s2, n) { const bool up = (lane & (s2)) != 0; _Pragma("unroll") for (int i = 0; i < (n); ++i) { const float k1 = up ? a[i + (n)] : a[i], x1 = up ? a[i] : a[i + (n)]; a[i] = k1 + __shfl_xor(x1, (s2)); } }
    RF_STEP(32, 16) RF_STEP(16, 8) RF_STEP(8, 4) RF_STEP(4, 2) RF_STEP(2, 1)
#undef RF_STEP
    float lg = a[0] + __shfl_xor(a[0], 1);
    const int myE = lane >> 1;
    lg += router_b[myE];
    float tv[TOPK]; int ti[TOPK];
#pragma unroll
    for (int k = 0; k < TOPK; ++k) {
        float mx = lg;
#pragma unroll
        for (int o = 1; o < 64; o <<= 1) mx = fmaxf(mx, __shfl_xor(mx, o));
        int cand = (lg == mx) ? myE : 99;
#pragma unroll
        for (int o = 1; o < 64; o <<= 1) cand = min(cand, __shfl_xor(cand, o));
        tv[k] = mx; ti[k] = cand;
        if (myE == cand) lg = -INFINITY;
    }
    const float e1 = __expf(tv[1] - tv[0]), e2 = __expf(tv[2] - tv[0]), e3 = __expf(tv[3] - tv[0]);
    const float inv = 1.0f / (1.0f + e1 + e2 + e3);
    if (lane < TOPK && m < MTOK) {
        const int ek = lane == 0 ? ti[0] : lane == 1 ? ti[1] : lane == 2 ? ti[2] : ti[3];
        const float gk = (lane == 0 ? 1.0f : lane == 1 ? e1 : lane == 2 ? e2 : e3) * inv;
        const int lr = __hip_atomic_fetch_add(&lcnt[ek], 1, __ATOMIC_RELAXED, __HIP_MEMORY_SCOPE_WORKGROUP);
        sbw[lane] = ((unsigned)ek << 16) | (unsigned)lr;
        GATE[(size_t)m * TOPK + lane] = gk;
    }
}

#ifndef PROBE_DELAY
#define PROBE_DELAY 0
#endif
__device__ __forceinline__ void probe_delay(int us100) { const unsigned long long t0 = __builtin_amdgcn_s_memrealtime(); while (__builtin_amdgcn_s_memrealtime() - t0 < (unsigned long long)us100) __builtin_amdgcn_s_sleep(2); }
constexpr int H3_QI = 0, H3_KK = 34816, H3_V = 69632, H3_DEC = 88064, H3_ST = 89088, H3_AM = 106496, H3_LH = 115712, H3_LL = 133120, H3_END = 150528;
constexpr int H3_BUFD = 17408, H3_BUFV = 9216, H3_BUFDEC = 512;
static_assert(H3_END <= LDSCTL_OFF, "recurrence LDS image below the control words");
struct Hg3 {
    LAS unsigned char* lds; const bf16 *Qb, *Kp, *Vb; const float* Lp; float* Op;
    int b, h, dir, vh, lane, lr, lq;
};
__device__ __forceinline__ size_t hg3_row(const Hg3& c, int n, int t) {
    const int tb = c.b * TT + (c.dir ? (TT / 64 - 1 - n) * 64 : n * 64);
    return (size_t)(c.dir ? tb + 63 - t : tb + t) * 512 + c.h * 128;
}
struct Hg3LV { f32x4 lf[8]; v4u v[2]; };
struct Hg3QK { v2u q[2][4], k[2][4]; };
__device__ __forceinline__ void gld16(f32x4& d, const void* p) { asm volatile("global_load_dwordx4 %0, %1, off" : "=v"(d) : "v"(p) : "memory"); }
__device__ __forceinline__ void gld16u(v4u& d, const void* p) { asm volatile("global_load_dwordx4 %0, %1, off" : "=v"(d) : "v"(p) : "memory"); }
__device__ __forceinline__ void gld8(v2u& d, const void* p) { asm volatile("global_load_dwordx2 %0, %1, off" : "=v"(d) : "v"(p) : "memory"); }
__device__ __forceinline__ void hg3_load_lv(const Hg3& c, int n, int pt, Hg3LV& in) {
    const size_t r = hg3_row(c, n, pt >> 2);
#pragma unroll
    for (int i = 0; i < 8; ++i) gld16(in.lf[i], c.Lp + r + 32 * (pt & 3) + 4 * i);
    gld16u(in.v[0], c.Vb + r + c.vh * 64 + 16 * (pt & 3)); gld16u(in.v[1], c.Vb + r + c.vh * 64 + 16 * (pt & 3) + 8);
}
__device__ __forceinline__ void hg3_load_qk(const Hg3& c, int n, int pw, Hg3QK& in) {
#pragma unroll
    for (int ti = 0; ti < 4; ++ti) { const size_t r = hg3_row(c, n, 16 * ti + c.lr);
#pragma unroll
        for (int dt = 0; dt < 2; ++dt) { const int d0 = 16 * (2 * pw + dt) + 4 * c.lq; gld8(in.q[dt][ti], c.Qb + r + d0); gld8(in.k[dt][ti], c.Kp + r + d0); } }
}
#define H3_USE_LV(x) asm volatile("" : "+v"((x).lf[0]), "+v"((x).lf[1]), "+v"((x).lf[2]), "+v"((x).lf[3]), "+v"((x).lf[4]), "+v"((x).lf[5]), "+v"((x).lf[6]), "+v"((x).lf[7]), "+v"((x).v[0]), "+v"((x).v[1]))
#define H3_USE_QK(x) asm volatile("" : "+v"((x).q[0][0]), "+v"((x).q[0][1]), "+v"((x).q[0][2]), "+v"((x).q[0][3]), "+v"((x).q[1][0]), "+v"((x).q[1][1]), "+v"((x).q[1][2]), "+v"((x).q[1][3]), \
                                           "+v"((x).k[0][0]), "+v"((x).k[0][1]), "+v"((x).k[0][2]), "+v"((x).k[0][3]), "+v"((x).k[1][0]), "+v"((x).k[1][1]), "+v"((x).k[1][2]), "+v"((x).k[1][3]))
__device__ __forceinline__ unsigned hg3_hi_lo(float x, float y, unsigned& lo) {
    const unsigned hi = pk2(x, y);
    lo = pk2(x - bf2f(hi & 0xffffu), y - bf2f(hi >> 16));
    return hi;
}
__device__ __forceinline__ void hg3_prep_a(const Hg3& c, int buf, int pt, const Hg3LV& in) {
    const int t = pt >> 2, dq = pt & 3;
#pragma unroll
    for (int i = 0; i < 8; ++i) { unsigned l0, l1; const unsigned h0 = hg3_hi_lo(in.lf[i].x, in.lf[i].y, l0), h1 = hg3_hi_lo(in.lf[i].z, in.lf[i].w, l1);
        *(LAS v2u*)(c.lds + H3_LH + t * 272 + (32 * dq + 4 * i) * 2) = (v2u){h0, h1}; *(LAS v2u*)(c.lds + H3_LL + t * 272 + (32 * dq + 4 * i) * 2) = (v2u){l0, l1}; }
    *(LAS v4u*)(c.lds + H3_V + buf * H3_BUFV + t * 144 + dq * 32) = in.v[0]; *(LAS v4u*)(c.lds + H3_V + buf * H3_BUFV + t * 144 + dq * 32 + 16) = in.v[1];
}
__device__ __forceinline__ void hg3_prep_b(const Hg3& c, int buf, int pw, const Hg3QK& in, const pg8::bf16x8 (&U)[4]) {
    LAS unsigned char* lds = c.lds; const int lr = c.lr, lq = c.lq, lane = c.lane;
    const unsigned trrow = (unsigned)(8 * lq + ((lane & 15) >> 2)), trcol = (unsigned)(4 * (lane & 3));
    const pg8::bf16x8 ones = (pg8::bf16x8)(v4u){0x3F803F80u, 0x3F803F80u, 0x3F803F80u, 0x3F803F80u};
#pragma unroll
    for (int dt = 0; dt < 2; ++dt) {
        const int dtile = 2 * pw + dt;
        v2u fh[2][2], fl[2][2];
        const unsigned ah = (unsigned)(size_t)(lds + H3_LH) + trrow * 272 + (16 * dtile + trcol) * 2, al = ah + (H3_LL - H3_LH);
        asm volatile("ds_read_b64_tr_b16 %0, %8\n\tds_read_b64_tr_b16 %1, %8 offset:1088\n\tds_read_b64_tr_b16 %2, %8 offset:8704\n\tds_read_b64_tr_b16 %3, %8 offset:9792\n\t"
                     "ds_read_b64_tr_b16 %4, %9\n\tds_read_b64_tr_b16 %5, %9 offset:1088\n\tds_read_b64_tr_b16 %6, %9 offset:8704\n\tds_read_b64_tr_b16 %7, %9 offset:9792\n\ts_waitcnt lgkmcnt(0)"
                     : "=&v"(fh[0][0]), "=&v"(fh[0][1]), "=&v"(fh[1][0]), "=&v"(fh[1][1]), "=&v"(fl[0][0]), "=&v"(fl[0][1]), "=&v"(fl[1][0]), "=&v"(fl[1][1]) : "v"(ah), "v"(al) : "memory");
        const pg8::bf16x8 H0 = mk_frag(fh[0][0], fh[0][1]), H1 = mk_frag(fh[1][0], fh[1][1]), L0 = mk_frag(fl[0][0], fl[0][1]), L1 = mk_frag(fl[1][0], fl[1][1]);
        f32x4 bt[4];
        const f32x4 z = (f32x4){0.f, 0.f, 0.f, 0.f};
        bt[0] = __builtin_amdgcn_mfma_f32_16x16x32_bf16(L0, U[0], z, 0, 0, 0);    bt[0] = __builtin_amdgcn_mfma_f32_16x16x32_bf16(H0, U[0], bt[0], 0, 0, 0);
        bt[1] = __builtin_amdgcn_mfma_f32_16x16x32_bf16(L0, U[1], z, 0, 0, 0);    bt[1] = __builtin_amdgcn_mfma_f32_16x16x32_bf16(H0, U[1], bt[1], 0, 0, 0);
        bt[2] = __builtin_amdgcn_mfma_f32_16x16x32_bf16(L0, ones, z, 0, 0, 0);    bt[2] = __builtin_amdgcn_mfma_f32_16x16x32_bf16(L1, U[2], bt[2], 0, 0, 0);
        bt[2] = __builtin_amdgcn_mfma_f32_16x16x32_bf16(H0, ones, bt[2], 0, 0, 0); bt[2] = __builtin_amdgcn_mfma_f32_16x16x32_bf16(H1, U[2], bt[2], 0, 0, 0);
        bt[3] = __builtin_amdgcn_mfma_f32_16x16x32_bf16(L0, ones, z, 0, 0, 0);    bt[3] = __builtin_amdgcn_mfma_f32_16x16x32_bf16(L1, U[3], bt[3], 0, 0, 0);
        bt[3] = __builtin_amdgcn_mfma_f32_16x16x32_bf16(H0, ones, bt[3], 0, 0, 0); bt[3] = __builtin_amdgcn_mfma_f32_16x16x32_bf16(H1, U[3], bt[3], 0, 0, 0);
        f32x4 de;
#pragma unroll
        for (int r = 0; r < 4; ++r) de[r] = __expf(__shfl(bt[3][r], 16 * lq + 15));
        if (lr == 0) *(LAS f32x4*)(lds + H3_DEC + buf * H3_BUFDEC + (16 * dtile + 4 * lq) * 4) = de;
#pragma unroll
        for (int ti = 0; ti < 4; ++ti) {
            const v2u qq = in.q[dt][ti], kk = in.k[dt][ti];
            const float e0 = __expf(bt[ti][0]), e1 = __expf(bt[ti][1]), e2 = __expf(bt[ti][2]), e3 = __expf(bt[ti][3]);
            v2u qo, ko;
            qo.x = pk2(bf2f(qq.x & 0xffffu) * e0, bf2f(qq.x >> 16) * e1); qo.y = pk2(bf2f(qq.y & 0xffffu) * e2, bf2f(qq.y >> 16) * e3);
            ko.x = pk2(bf2f(kk.x & 0xffffu) * __builtin_amdgcn_rcpf(e0), bf2f(kk.x >> 16) * __builtin_amdgcn_rcpf(e1));
            ko.y = pk2(bf2f(kk.y & 0xffffu) * __builtin_amdgcn_rcpf(e2), bf2f(kk.y >> 16) * __builtin_amdgcn_rcpf(e3));
            const int off = (16 * ti + lr) * 272 + (16 * dtile + 4 * lq) * 2;
            *(LAS v2u*)(lds + H3_QI + buf * H3_BUFD + off) = qo; *(LAS v2u*)(lds + H3_KK + buf * H3_BUFD + off) = ko;
        }
    }
}
__device__ __forceinline__ void hg3_stage1(const Hg3& c, int buf, int mw, f32x4 (&S)[2][4], f32x4 (&o)[2][2], v2u (&vt)[4][2][2]) {
    LAS unsigned char* lds = c.lds; const int lr = c.lr, lq = c.lq, lane = c.lane;
    const LAS unsigned char* QI = lds + H3_QI + buf * H3_BUFD; const LAS unsigned char* KK = lds + H3_KK + buf * H3_BUFD;
    const unsigned trrow = (unsigned)(8 * lq + ((lane & 15) >> 2)), trcol = (unsigned)(4 * (lane & 3));
    const unsigned kk_tr = (unsigned)(size_t)KK + trrow * 272 + (32 * mw + trcol) * 2;
    const unsigned v_tr = (unsigned)(size_t)(lds + H3_V + buf * H3_BUFV) + trrow * 144 + trcol * 2;
    const int tp = mw >> 1, ep = mw & 1;
    pg8::bf16x8 qf[2][4], sf[2][4], kf[3][4];
#pragma unroll
    for (int bq = 0; bq < 2; ++bq)
#pragma unroll
        for (int kk = 0; kk < 4; ++kk) { qf[bq][kk] = lds_frag(QI + (16 * (2 * tp + bq) + lr) * 272 + kk * 64 + lq * 16); sf[bq][kk] = lds_frag(lds + H3_ST + (16 * (2 * ep + bq) + lr) * 272 + kk * 64 + lq * 16); }
#pragma unroll
    for (int a = 0; a < 2; ++a)
#pragma unroll
        for (int bq = 0; bq < 2; ++bq) o[a][bq] = (f32x4){0.f, 0.f, 0.f, 0.f};
#pragma unroll
    for (int kk = 0; kk < 4; ++kk) {
        o[0][0] = __builtin_amdgcn_mfma_f32_16x16x32_bf16(sf[0][kk], qf[0][kk], o[0][0], 0, 0, 0); o[0][1] = __builtin_amdgcn_mfma_f32_16x16x32_bf16(sf[0][kk], qf[1][kk], o[0][1], 0, 0, 0);
        o[1][0] = __builtin_amdgcn_mfma_f32_16x16x32_bf16(sf[1][kk], qf[0][kk], o[1][0], 0, 0, 0); o[1][1] = __builtin_amdgcn_mfma_f32_16x16x32_bf16(sf[1][kk], qf[1][kk], o[1][1], 0, 0, 0);
    }
    __builtin_amdgcn_sched_barrier(0);
    const int ks0 = mw == 3 ? 1 : 0;
    if (mw != 1) {
#pragma unroll
        for (int x = 0; x < 3; ++x)
#pragma unroll
            for (int kk = 0; kk < 4; ++kk) kf[x][kk] = lds_frag(KK + (16 * (ks0 + x) + lr) * 272 + kk * 64 + lq * 16);
    }
    v2u kt[2][2][2];
    {
        f32x4 at[4];
#pragma unroll
        for (int i = 0; i < 4; ++i) at[i] = (f32x4){0.f, 0.f, 0.f, 0.f};
        if (mw != 1) {
#pragma unroll
            for (int kk = 0; kk < 4; ++kk) {
                at[0] = __builtin_amdgcn_mfma_f32_16x16x32_bf16(kf[0][kk], mw == 3 ? qf[1][kk] : qf[0][kk], at[0], 0, 0, 0);
                at[1] = __builtin_amdgcn_mfma_f32_16x16x32_bf16(mw == 0 ? kf[0][kk] : kf[1][kk], mw == 2 ? qf[0][kk] : qf[1][kk], at[1], 0, 0, 0);
                at[2] = __builtin_amdgcn_mfma_f32_16x16x32_bf16(mw == 0 ? kf[1][kk] : kf[2][kk], mw == 2 ? qf[0][kk] : qf[1][kk], at[2], 0, 0, 0);
                if (mw == 2) at[3] = __builtin_amdgcn_mfma_f32_16x16x32_bf16(kf[0][kk], qf[1][kk], at[3], 0, 0, 0);
            }
        }
    asm volatile("ds_read_b64_tr_b16 %0, %8\n\tds_read_b64_tr_b16 %1, %8 offset:1088\n\tds_read_b64_tr_b16 %2, %8 offset:8704\n\tds_read_b64_tr_b16 %3, %8 offset:9792\n\t"
                 "ds_read_b64_tr_b16 %4, %8 offset:32\n\tds_read_b64_tr_b16 %5, %8 offset:1120\n\tds_read_b64_tr_b16 %6, %8 offset:8736\n\tds_read_b64_tr_b16 %7, %8 offset:9824"
                 : "=&v"(kt[0][0][0]), "=&v"(kt[0][0][1]), "=&v"(kt[0][1][0]), "=&v"(kt[0][1][1]), "=&v"(kt[1][0][0]), "=&v"(kt[1][0][1]), "=&v"(kt[1][1][0]), "=&v"(kt[1][1][1]) : "v"(kk_tr) : "memory");
#define H3_VTR(e4, o0, o1, o2, o3) asm volatile("ds_read_b64_tr_b16 %0, %4 offset:" #o0 "\n\tds_read_b64_tr_b16 %1, %4 offset:" #o1 "\n\tds_read_b64_tr_b16 %2, %4 offset:" #o2 "\n\tds_read_b64_tr_b16 %3, %4 offset:" #o3 \
                 : "=&v"(vt[e4][0][0]), "=&v"(vt[e4][0][1]), "=&v"(vt[e4][1][0]), "=&v"(vt[e4][1][1]) : "v"(v_tr) : "memory")
    H3_VTR(0, 0, 576, 4608, 5184); H3_VTR(1, 32, 608, 4640, 5216); H3_VTR(2, 64, 640, 4672, 5248); H3_VTR(3, 96, 672, 4704, 5280);
#undef H3_VTR
#pragma unroll
        for (int i = 0; i < 4; ++i) {
            int si, ti; bool have = true, zero = false;
            if (mw == 0) { si = i == 2 ? 1 : 0; ti = i == 0 ? 0 : 1; have = i < 3; }
            else if (mw == 1) { si = 1; ti = 0; have = i == 0; zero = true; }
            else if (mw == 2) { si = i == 3 ? 0 : i; ti = i == 3 ? 3 : 2; }
            else { si = i == 3 ? 3 : i + 1; ti = i == 3 ? 2 : 3; zero = i == 3; }
            if (have) {
                const int s0 = 16 * si + 4 * lq, t = 16 * ti + lr; v2u w = (v2u){0u, 0u};
                if (!zero) { w.x = pk2(s0 + 0 <= t ? at[i][0] : 0.f, s0 + 1 <= t ? at[i][1] : 0.f); w.y = pk2(s0 + 2 <= t ? at[i][2] : 0.f, s0 + 3 <= t ? at[i][3] : 0.f); }
                *(LAS v2u*)(lds + H3_AM + (16 * ti + lr) * 144 + (16 * si + 4 * lq) * 2) = w;
            }
        }
    }
    asm volatile("s_waitcnt lgkmcnt(0)"
                 : "+v"(kt[0][0][0]), "+v"(kt[0][0][1]), "+v"(kt[0][1][0]), "+v"(kt[0][1][1]), "+v"(kt[1][0][0]), "+v"(kt[1][0][1]), "+v"(kt[1][1][0]), "+v"(kt[1][1][1]),
                   "+v"(vt[0][0][0]), "+v"(vt[0][0][1]), "+v"(vt[0][1][0]), "+v"(vt[0][1][1]), "+v"(vt[1][0][0]), "+v"(vt[1][0][1]), "+v"(vt[1][1][0]), "+v"(vt[1][1][1]),
                   "+v"(vt[2][0][0]), "+v"(vt[2][0][1]), "+v"(vt[2][1][0]), "+v"(vt[2][1][1]), "+v"(vt[3][0][0]), "+v"(vt[3][0][1]), "+v"(vt[3][1][0]), "+v"(vt[3][1][1]) :: "memory");
#pragma unroll
    for (int dt = 0; dt < 2; ++dt) {
#pragma unroll
        for (int kk = 0; kk < 2; ++kk) {
            const pg8::bf16x8 af = mk_frag(kt[dt][kk][0], kt[dt][kk][1]);
#pragma unroll
            for (int e4 = 0; e4 < 4; ++e4) S[dt][e4] = __builtin_amdgcn_mfma_f32_16x16x32_bf16(af, mk_frag(vt[e4][kk][0], vt[e4][kk][1]), S[dt][e4], 0, 0, 0);
        }
        const f32x4 dv = *(const LAS f32x4*)(lds + H3_DEC + buf * H3_BUFDEC + (16 * (2 * mw + dt) + 4 * lq) * 4);
#pragma unroll
        for (int e4 = 0; e4 < 4; ++e4) S[dt][e4] = S[dt][e4] * dv;
    }
}
__device__ __forceinline__ void hg3_stage2(const Hg3& c, int n, int mw, const f32x4 (&S)[2][4], f32x4 (&o)[2][2], const v2u (&vt)[4][2][2]) {
    LAS unsigned char* lds = c.lds; const int lr = c.lr, lq = c.lq;
#pragma unroll
    for (int bq = 0; bq < 2; ++bq) {
        const int ti = 2 * (mw >> 1) + bq;
        const pg8::bf16x8 a0 = lds_frag(lds + H3_AM + (16 * ti + lr) * 144 + 0 * 64 + lq * 16);
#pragma unroll
        for (int a = 0; a < 2; ++a) { const int e4 = 2 * (mw & 1) + a;
            const pg8::bf16x8 vf = e4 == 0 ? mk_frag(vt[0][0][0], vt[0][0][1]) : e4 == 1 ? mk_frag(vt[1][0][0], vt[1][0][1]) : e4 == 2 ? mk_frag(vt[2][0][0], vt[2][0][1]) : mk_frag(vt[3][0][0], vt[3][0][1]);
            o[a][bq] = __builtin_amdgcn_mfma_f32_16x16x32_bf16(vf, a0, o[a][bq], 0, 0, 0); }
        if (mw >> 1) {
            const pg8::bf16x8 a1 = lds_frag(lds + H3_AM + (16 * ti + lr) * 144 + 1 * 64 + lq * 16);
#pragma unroll
            for (int a = 0; a < 2; ++a) { const int e4 = 2 * (mw & 1) + a;
                const pg8::bf16x8 vf = e4 == 0 ? mk_frag(vt[0][1][0], vt[0][1][1]) : e4 == 1 ? mk_frag(vt[1][1][0], vt[1][1][1]) : e4 == 2 ? mk_frag(vt[2][1][0], vt[2][1][1]) : mk_frag(vt[3][1][0], vt[3][1][1]);
                o[a][bq] = __builtin_amdgcn_mfma_f32_16x16x32_bf16(vf, a1, o[a][bq], 0, 0, 0); }
        }
#pragma unroll
        for (int a = 0; a < 2; ++a)
            *(f32x4*)(c.Op + hg3_row(c, n, 16 * ti + lr) + c.vh * 64 + 16 * (2 * (mw & 1) + a) + 4 * lq) = o[a][bq];
    }
#pragma unroll
    for (int dt = 0; dt < 2; ++dt)
#pragma unroll
        for (int e4 = 0; e4 < 4; ++e4) { v2u w; w.x = pk2(S[dt][e4][0], S[dt][e4][1]); w.y = pk2(S[dt][e4][2], S[dt][e4][3]);
            *(LAS v2u*)(lds + H3_ST + (16 * e4 + lr) * 272 + (16 * (2 * mw + dt) + 4 * lq) * 2) = w; }
}
__device__ __forceinline__ void hgrn3_unit(LAS unsigned char* lds, int unit, const bf16* Qb, const bf16* KFb, const bf16* KBb, const bf16* Vb, const float* LFb, const float* LBb,
                                           float* OFb, float* OBb, int tid, int lane, int wave) {
    Hg3 c;
    c.lds = lds; c.vh = unit & 1; c.dir = (unit >> 1) & 1; c.h = (unit >> 2) & 3; c.b = unit >> 4;
    c.Qb = Qb; c.Vb = Vb; c.Kp = c.dir ? KBb : KFb; c.Lp = c.dir ? LBb : LFb; c.Op = c.dir ? OBb : OFb;
    c.lane = lane; c.lr = lane & 15; c.lq = lane >> 4;
    constexpr int NCH = TT / 64;
    for (int i = tid; i < 64 * 272 / 16; i += NTHR) *(LAS v4u*)(lds + H3_ST + i * 16) = (v4u){0u, 0u, 0u, 0u};
    if (wave < 4) {
        const int pt = tid, pw = wave;
        pg8::bf16x8 U[4];
#pragma unroll
        for (int u = 0; u < 4; ++u) { const int kk = u >> 1, ti = u; unsigned wv[4];
#pragma unroll
            for (int j2 = 0; j2 < 4; ++j2) { const int s = 32 * kk + 8 * c.lq + 2 * j2, t = 16 * ti + c.lr; wv[j2] = (s <= t ? 0x3F80u : 0u) | (s + 1 <= t ? 0x3F800000u : 0u); }
            U[u] = (pg8::bf16x8)(v4u){wv[0], wv[1], wv[2], wv[3]}; }
        Hg3LV lv0, lv1; Hg3QK qk;
        hg3_load_lv(c, 0, pt, lv0); hg3_load_qk(c, 0, pw, qk); hg3_load_lv(c, 1, pt, lv1);
        asm volatile("s_waitcnt vmcnt(0)" ::: "memory"); H3_USE_LV(lv0); H3_USE_QK(qk); H3_USE_LV(lv1);
        hg3_prep_a(c, 0, pt, lv0);
        __syncthreads();
#define H3_TRIP(j_, LVN, LVC) do { \
            if ((j_) < NCH) { asm volatile("s_waitcnt vmcnt(10)" ::: "memory"); H3_USE_QK(qk); hg3_prep_b(c, (j_) & 1, pw, qk, U); \
                if ((j_) + 1 < NCH) hg3_load_qk(c, (j_) + 1, pw, qk); else hg3_load_qk(c, (j_), pw, qk);     \
                if ((j_) + 2 < NCH) hg3_load_lv(c, (j_) + 2, pt, LVC); else hg3_load_lv(c, (j_), pt, LVC); } \
            if (PROBE_DELAY == 2) probe_delay(100); \
            __syncthreads();                                                                    \
            if ((j_) + 1 < NCH) { asm volatile("s_waitcnt vmcnt(26)" ::: "memory"); H3_USE_LV(LVN); hg3_prep_a(c, ((j_) + 1) & 1, pt, LVN); } \
            __syncthreads();                                                                    \
        } while (0)
#pragma unroll 1
        for (int j = 0; j <= NCH; j += 2) { H3_TRIP(j, lv1, lv0); H3_TRIP(j + 1, lv0, lv1); }
#undef H3_TRIP
        asm volatile("s_waitcnt vmcnt(0)" ::: "memory");
    } else {
        const int mw = wave - 4;
        f32x4 S[2][4], o[2][2]; v2u vt[4][2][2];
#pragma unroll
        for (int a = 0; a < 2; ++a)
#pragma unroll
            for (int e4 = 0; e4 < 4; ++e4) S[a][e4] = (f32x4){0.f, 0.f, 0.f, 0.f};
        __syncthreads();
#pragma unroll 1
        for (int j = 0; j <= NCH + 1; ++j) {
            if (j > 0 && j <= NCH) hg3_stage1(c, (j - 1) & 1, mw, S, o, vt);
            if (PROBE_DELAY == 1) probe_delay(100);
            __syncthreads();
            if (j > 0 && j <= NCH) hg3_stage2(c, j - 1, mw, S, o, vt);
            __syncthreads();
        }
    }
    __syncthreads();
}


struct Hg4LV { f32x4 lf[4]; v4u v; };
struct Hg4QK { v2u q[4], k[4]; };
__device__ __forceinline__ void hg4_load_lv(const Hg3& c, int n, int tid, Hg4LV& in) {
    const size_t r = hg3_row(c, n, tid >> 3);
#pragma unroll
    for (int i = 0; i < 4; ++i) gld16(in.lf[i], c.Lp + r + 16 * (tid & 7) + 4 * i);
    gld16u(in.v, c.Vb + r + c.vh * 64 + 8 * (tid & 7));
}
__device__ __forceinline__ void hg4_load_qk(const Hg3& c, int n, int w, Hg4QK& in) {
#pragma unroll
    for (int ti = 0; ti < 4; ++ti) { const size_t r = hg3_row(c, n, 16 * ti + c.lr) + 16 * w + 4 * c.lq; gld8(in.q[ti], c.Qb + r); gld8(in.k[ti], c.Kp + r); }
}
#define H4_USE_LV(x) asm volatile("" : "+v"((x).lf[0]), "+v"((x).lf[1]), "+v"((x).lf[2]), "+v"((x).lf[3]), "+v"((x).v))
#define H4_USE_QK(x) asm volatile("" : "+v"((x).q[0]), "+v"((x).q[1]), "+v"((x).q[2]), "+v"((x).q[3]), "+v"((x).k[0]), "+v"((x).k[1]), "+v"((x).k[2]), "+v"((x).k[3]))
__device__ __forceinline__ void hg4_prep_a(const Hg3& c, int buf, int tid, const Hg4LV& in) {
    const int t = tid >> 3, dq = tid & 7;
#pragma unroll
    for (int i = 0; i < 4; ++i) { unsigned l0, l1; const unsigned h0 = hg3_hi_lo(in.lf[i].x, in.lf[i].y, l0), h1 = hg3_hi_lo(in.lf[i].z, in.lf[i].w, l1);
        *(LAS v2u*)(c.lds + H3_LH + t * 272 + (16 * dq + 4 * i) * 2) = (v2u){h0, h1}; *(LAS v2u*)(c.lds + H3_LL + t * 272 + (16 * dq + 4 * i) * 2) = (v2u){l0, l1}; }
    *(LAS v4u*)(c.lds + H3_V + buf * H3_BUFV + t * 144 + dq * 16) = in.v;
}
__device__ __forceinline__ void hg4_prep_b(const Hg3& c, int buf, int w, const Hg4QK& in, const pg8::bf16x8 (&U)[4]) {
    LAS unsigned char* lds = c.lds; const int lr = c.lr, lq = c.lq, lane = c.lane;
    const unsigned trrow = (unsigned)(8 * lq + ((lane & 15) >> 2)), trcol = (unsigned)(4 * (lane & 3));
    const pg8::bf16x8 ones = (pg8::bf16x8)(v4u){0x3F803F80u, 0x3F803F80u, 0x3F803F80u, 0x3F803F80u};
    v2u fh[2][2], fl[2][2];
    const unsigned ah = (unsigned)(size_t)(lds + H3_LH) + trrow * 272 + (16 * w + trcol) * 2, al = ah + (H3_LL - H3_LH);
    asm volatile("ds_read_b64_tr_b16 %0, %8\n\tds_read_b64_tr_b16 %1, %8 offset:1088\n\tds_read_b64_tr_b16 %2, %8 offset:8704\n\tds_read_b64_tr_b16 %3, %8 offset:9792\n\t"
                 "ds_read_b64_tr_b16 %4, %9\n\tds_read_b64_tr_b16 %5, %9 offset:1088\n\tds_read_b64_tr_b16 %6, %9 offset:8704\n\tds_read_b64_tr_b16 %7, %9 offset:9792\n\ts_waitcnt lgkmcnt(0)"
                 : "=&v"(fh[0][0]), "=&v"(fh[0][1]), "=&v"(fh[1][0]), "=&v"(fh[1][1]), "=&v"(fl[0][0]), "=&v"(fl[0][1]), "=&v"(fl[1][0]), "=&v"(fl[1][1]) : "v"(ah), "v"(al) : "memory");
    const pg8::bf16x8 H0 = mk_frag(fh[0][0], fh[0][1]), H1 = mk_frag(fh[1][0], fh[1][1]), L0 = mk_frag(fl[0][0], fl[0][1]), L1 = mk_frag(fl[1][0], fl[1][1]);
    f32x4 bt[4];
    const f32x4 z = (f32x4){0.f, 0.f, 0.f, 0.f};
    bt[0] = __builtin_amdgcn_mfma_f32_16x16x32_bf16(L0, U[0], z, 0, 0, 0);    bt[0] = __builtin_amdgcn_mfma_f32_16x16x32_bf16(H0, U[0], bt[0], 0, 0, 0);
    bt[1] = __builtin_amdgcn_mfma_f32_16x16x32_bf16(L0, U[1], z, 0, 0, 0);    bt[1] = __builtin_amdgcn_mfma_f32_16x16x32_bf16(H0, U[1], bt[1], 0, 0, 0);
    bt[2] = __builtin_amdgcn_mfma_f32_16x16x32_bf16(L0, ones, z, 0, 0, 0);    bt[2] = __builtin_amdgcn_mfma_f32_16x16x32_bf16(L1, U[2], bt[2], 0, 0, 0);
    bt[2] = __builtin_amdgcn_mfma_f32_16x16x32_bf16(H0, ones, bt[2], 0, 0, 0); bt[2] = __builtin_amdgcn_mfma_f32_16x16x32_bf16(H1, U[2], bt[2], 0, 0, 0);
    bt[3] = __builtin_amdgcn_mfma_f32_16x16x32_bf16(L0, ones, z, 0, 0, 0);    bt[3] = __builtin_amdgcn_mfma_f32_16x16x32_bf16(L1, U[3], bt[3], 0, 0, 0);
    bt[3] = __builtin_amdgcn_mfma_f32_16x16x32_bf16(H0, ones, bt[3], 0, 0, 0); bt[3] = __builtin_amdgcn_mfma_f32_16x16x32_bf16(H1, U[3], bt[3], 0, 0, 0);
    f32x4 de;
#pragma unroll
    for (int r = 0; r < 4; ++r) de[r] = __expf(__shfl(bt[3][r], 16 * lq + 15));
    if (lr == 0) *(LAS f32x4*)(lds + H3_DEC + buf * H3_BUFDEC + (16 * w + 4 * lq) * 4) = de;
#pragma unroll
    for (int ti = 0; ti < 4; ++ti) {
        const v2u qq = in.q[ti], kk = in.k[ti];
        const float e0 = __expf(bt[ti][0]), e1 = __expf(bt[ti][1]), e2 = __expf(bt[ti][2]), e3 = __expf(bt[ti][3]);
        v2u qo, ko;
        qo.x = pk2(bf2f(qq.x & 0xffffu) * e0, bf2f(qq.x >> 16) * e1); qo.y = pk2(bf2f(qq.y & 0xffffu) * e2, bf2f(qq.y >> 16) * e3);
        ko.x = pk2(bf2f(kk.x & 0xffffu) * __builtin_amdgcn_rcpf(e0), bf2f(kk.x >> 16) * __builtin_amdgcn_rcpf(e1));
        ko.y = pk2(bf2f(kk.y & 0xffffu) * __builtin_amdgcn_rcpf(e2), bf2f(kk.y >> 16) * __builtin_amdgcn_rcpf(e3));
        const int off = (16 * ti + lr) * 272 + (16 * w + 4 * lq) * 2;
        *(LAS v2u*)(lds + H3_QI + buf * H3_BUFD + off) = qo; *(LAS v2u*)(lds + H3_KK + buf * H3_BUFD + off) = ko;
    }
}
__device__ __forceinline__ void hg4_stage1(const Hg3& c, int buf, int w, f32x4 (&S)[4], f32x4 (&o)[2], v2u (&vt)[4][2][2]) {
    LAS unsigned char* lds = c.lds; const int lr = c.lr, lq = c.lq, lane = c.lane;
    const LAS unsigned char* QI = lds + H3_QI + buf * H3_BUFD; const LAS unsigned char* KK = lds + H3_KK + buf * H3_BUFD;
    const unsigned trrow = (unsigned)(8 * lq + ((lane & 15) >> 2)), trcol = (unsigned)(4 * (lane & 3));
    const unsigned kk_tr = (unsigned)(size_t)KK + trrow * 272 + (16 * w + trcol) * 2;
    const unsigned v_tr = (unsigned)(size_t)(lds + H3_V + buf * H3_BUFV) + trrow * 144 + trcol * 2;
    v2u kt[2][2];
    asm volatile("ds_read_b64_tr_b16 %0, %4\n\tds_read_b64_tr_b16 %1, %4 offset:1088\n\tds_read_b64_tr_b16 %2, %4 offset:8704\n\tds_read_b64_tr_b16 %3, %4 offset:9792"
                 : "=&v"(kt[0][0]), "=&v"(kt[0][1]), "=&v"(kt[1][0]), "=&v"(kt[1][1]) : "v"(kk_tr) : "memory");
#define H4_VTR(e4, o0, o1, o2, o3) asm volatile("ds_read_b64_tr_b16 %0, %4 offset:" #o0 "\n\tds_read_b64_tr_b16 %1, %4 offset:" #o1 "\n\tds_read_b64_tr_b16 %2, %4 offset:" #o2 "\n\tds_read_b64_tr_b16 %3, %4 offset:" #o3 \
                 : "=&v"(vt[e4][0][0]), "=&v"(vt[e4][0][1]), "=&v"(vt[e4][1][0]), "=&v"(vt[e4][1][1]) : "v"(v_tr) : "memory")
    H4_VTR(0, 0, 576, 4608, 5184); H4_VTR(1, 32, 608, 4640, 5216); H4_VTR(2, 64, 640, 4672, 5248); H4_VTR(3, 96, 672, 4704, 5280);
#undef H4_VTR
    const int ei = w & 3, tp = w >> 2;
    {
        const int ti = w & 3;
#pragma unroll
        for (int sii = 0; sii < 2; ++sii) {
            const int si = tp * 2 + sii;
            v2u wv = (v2u){0u, 0u};
            if (si <= ti) {
                f32x4 a = (f32x4){0.f, 0.f, 0.f, 0.f};
#pragma unroll
                for (int kk = 0; kk < 4; ++kk)
                    a = __builtin_amdgcn_mfma_f32_16x16x32_bf16(lds_frag(KK + (16 * si + lr) * 272 + kk * 64 + lq * 16), lds_frag(QI + (16 * ti + lr) * 272 + kk * 64 + lq * 16), a, 0, 0, 0);
                const int s0 = 16 * si + 4 * lq, t = 16 * ti + lr;
                wv.x = pk2(s0 + 0 <= t ? a[0] : 0.f, s0 + 1 <= t ? a[1] : 0.f); wv.y = pk2(s0 + 2 <= t ? a[2] : 0.f, s0 + 3 <= t ? a[3] : 0.f);
            }
            *(LAS v2u*)(lds + H3_AM + (16 * ti + lr) * 144 + (16 * si + 4 * lq) * 2) = wv;
        }
    }
#pragma unroll
    for (int tt = 0; tt < 2; ++tt) o[tt] = (f32x4){0.f, 0.f, 0.f, 0.f};
#pragma unroll
    for (int kk = 0; kk < 4; ++kk) {
        const pg8::bf16x8 sfr = lds_frag(lds + H3_ST + (16 * ei + lr) * 272 + kk * 64 + lq * 16);
#pragma unroll
        for (int tt = 0; tt < 2; ++tt) o[tt] = __builtin_amdgcn_mfma_f32_16x16x32_bf16(sfr, lds_frag(QI + (16 * (2 * tp + tt) + lr) * 272 + kk * 64 + lq * 16), o[tt], 0, 0, 0);
    }
    asm volatile("s_waitcnt lgkmcnt(0)"
                 : "+v"(kt[0][0]), "+v"(kt[0][1]), "+v"(kt[1][0]), "+v"(kt[1][1]),
                   "+v"(vt[0][0][0]), "+v"(vt[0][0][1]), "+v"(vt[0][1][0]), "+v"(vt[0][1][1]), "+v"(vt[1][0][0]), "+v"(vt[1][0][1]), "+v"(vt[1][1][0]), "+v"(vt[1][1][1]),
                   "+v"(vt[2][0][0]), "+v"(vt[2][0][1]), "+v"(vt[2][1][0]), "+v"(vt[2][1][1]), "+v"(vt[3][0][0]), "+v"(vt[3][0][1]), "+v"(vt[3][1][0]), "+v"(vt[3][1][1]) :: "memory");
#pragma unroll
    for (int kk = 0; kk < 2; ++kk) {
        const pg8::bf16x8 af = mk_frag(kt[kk][0], kt[kk][1]);
#pragma unroll
        for (int e4 = 0; e4 < 4; ++e4) S[e4] = __builtin_amdgcn_mfma_f32_16x16x32_bf16(af, mk_frag(vt[e4][kk][0], vt[e4][kk][1]), S[e4], 0, 0, 0);
    }
    const f32x4 dv = *(const LAS f32x4*)(lds + H3_DEC + buf * H3_BUFDEC + (16 * w + 4 * lq) * 4);
#pragma unroll
    for (int e4 = 0; e4 < 4; ++e4) S[e4] = S[e4] * dv;
}
__device__ __forceinline__ void hg4_stage2(const Hg3& c, int n, int w, const f32x4 (&S)[4], f32x4 (&o)[2], const v2u (&vt)[4][2][2]) {
    LAS unsigned char* lds = c.lds; const int lr = c.lr, lq = c.lq;
    const int ei = w & 3, tp = w >> 2;
    const pg8::bf16x8 vf0 = ei == 0 ? mk_frag(vt[0][0][0], vt[0][0][1]) : ei == 1 ? mk_frag(vt[1][0][0], vt[1][0][1]) : ei == 2 ? mk_frag(vt[2][0][0], vt[2][0][1]) : mk_frag(vt[3][0][0], vt[3][0][1]);
    const pg8::bf16x8 vf1 = ei == 0 ? mk_frag(vt[0][1][0], vt[0][1][1]) : ei == 1 ? mk_frag(vt[1][1][0], vt[1][1][1]) : ei == 2 ? mk_frag(vt[2][1][0], vt[2][1][1]) : mk_frag(vt[3][1][0], vt[3][1][1]);
#pragma unroll
    for (int tt = 0; tt < 2; ++tt) {
        const int ti = 2 * tp + tt;
        o[tt] = __builtin_amdgcn_mfma_f32_16x16x32_bf16(vf0, lds_frag(lds + H3_AM + (16 * ti + lr) * 144 + 0 * 64 + lq * 16), o[tt], 0, 0, 0);
        o[tt] = __builtin_amdgcn_mfma_f32_16x16x32_bf16(vf1, lds_frag(lds + H3_AM + (16 * ti + lr) * 144 + 1 * 64 + lq * 16), o[tt], 0, 0, 0);
        *(f32x4*)(c.Op + hg3_row(c, n, 16 * ti + lr) + c.vh * 64 + 16 * ei + 4 * lq) = o[tt];
    }
#pragma unroll
    for (int e4 = 0; e4 < 4; ++e4) { v2u wv; wv.x = pk2(S[e4][0], S[e4][1]); wv.y = pk2(S[e4][2], S[e4][3]); *(LAS v2u*)(lds + H3_ST + (16 * e4 + lr) * 272 + (16 * w + 4 * lq) * 2) = wv; }
}
__device__ __forceinline__ void hgrn4_unit(LAS unsigned char* lds, int unit, const bf16* Qb, const bf16* KFb, const bf16* KBb, const bf16* Vb, const float* LFb, const float* LBb,
                                           float* OFb, float* OBb, int tid, int lane, int wave) {
    Hg3 c;
    c.lds = lds; c.vh = unit & 1; c.dir = (unit >> 1) & 1; c.h = (unit >> 2) & 3; c.b = unit >> 4;
    c.Qb = Qb; c.Vb = Vb; c.Kp = c.dir ? KBb : KFb; c.Lp = c.dir ? LBb : LFb; c.Op = c.dir ? OBb : OFb;
    c.lane = lane; c.lr = lane & 15; c.lq = lane >> 4;
    constexpr int NCH = TT / 64;
    const int w = wave;
    for (int i = tid; i < 64 * 272 / 16; i += NTHR) *(LAS v4u*)(lds + H3_ST + i * 16) = (v4u){0u, 0u, 0u, 0u};
    pg8::bf16x8 U[4];
#pragma unroll
    for (int u = 0; u < 4; ++u) { const int kk = u >> 1, ti = u; unsigned wv[4];
#pragma unroll
        for (int j2 = 0; j2 < 4; ++j2) { const int sN = 32 * kk + 8 * c.lq + 2 * j2, t = 16 * ti + c.lr; wv[j2] = (sN <= t ? 0x3F80u : 0u) | (sN + 1 <= t ? 0x3F800000u : 0u); }
        U[u] = (pg8::bf16x8)(v4u){wv[0], wv[1], wv[2], wv[3]}; }
    f32x4 S[4], o[2]; v2u vt[4][2][2];
#pragma unroll
    for (int e4 = 0; e4 < 4; ++e4) S[e4] = (f32x4){0.f, 0.f, 0.f, 0.f};
    Hg4LV lv0, lv1; Hg4QK qk;
    hg4_load_lv(c, 0, tid, lv0); hg4_load_qk(c, 0, w, qk); hg4_load_lv(c, 1, tid, lv1);
    asm volatile("s_waitcnt vmcnt(0)" ::: "memory"); H4_USE_LV(lv0); H4_USE_QK(qk); H4_USE_LV(lv1);
    hg4_prep_a(c, 0, tid, lv0);
    __syncthreads();
#define H4_TRIP(j_, LVN, LVC) do { \
        if ((j_) < NCH) { asm volatile("s_waitcnt vmcnt(5)" ::: "memory"); H4_USE_QK(qk); hg4_prep_b(c, (j_) & 1, w, qk, U); \
            hg4_load_qk(c, (j_) + 1 < NCH ? (j_) + 1 : (j_), w, qk); hg4_load_lv(c, (j_) + 2 < NCH ? (j_) + 2 : (j_), tid, LVC); }     \
        if ((j_) > 0 && (j_) <= NCH) hg4_stage1(c, ((j_) - 1) & 1, w, S, o, vt); \
        if (PROBE_DELAY == 5) probe_delay(100); \
        __syncthreads();                                                                        \
        if ((j_) + 1 < NCH) { asm volatile("s_waitcnt vmcnt(13)" ::: "memory"); H4_USE_LV(LVN); hg4_prep_a(c, ((j_) + 1) & 1, tid, LVN); } \
        if ((j_) > 0 && (j_) <= NCH) hg4_stage2(c, (j_) - 1, w, S, o, vt); \
        __syncthreads();                                                                        \
    } while (0)
#pragma unroll 1
    for (int j = 0; j <= NCH; j += 2) { H4_TRIP(j, lv1, lv0); H4_TRIP(j + 1, lv0, lv1); }
#undef H4_TRIP
    asm volatile("s_waitcnt vmcnt(0)" ::: "memory");
    __syncthreads();
}

#if defined(HGRN_V2)
#define HGRN_FN hgrn_unit
#elif defined(HGRN_V3)
#define HGRN_FN hgrn3_unit
#else
#define HGRN_FN hgrn4_unit
#endif
#define W1_ITEM(r_) do { const int r__ = (r_); const int e__ = r__ >> 10; p0_item<true>(w1 + (size_t)e__ * D * 2 * FF, D, 2 * FF, W1T + (size_t)e__ * 2 * FF * D, RmW1(), scr, r__ & 1023, lane); } while (0)

struct Args { const float* in[18]; float* out; unsigned char* ws; int ph_lo, ph_hi; };
__global__ void __launch_bounds__(NTHR, 2) fwd_kernel(Args args) {
    extern __shared__ __attribute__((aligned(16))) unsigned char lds_raw[];
    LAS unsigned char* lds = (LAS unsigned char*)lds_raw;
    volatile LAS unsigned* MISC = (volatile LAS unsigned*)(lds + MISC_OFF);
    const int tid = threadIdx.x, lane = tid & 63, wave = __builtin_amdgcn_readfirstlane(tid >> 6);
    const int G = gridDim.x; const int bx = blockIdx.x; const int vcu = (G % 8 == 0) ? (bx % 8) * (G / 8) + bx / 8 : bx;
    const int gw = vcu * NWAVES + wave, NGW = G * NWAVES;
    unsigned char* ws = args.ws;
    unsigned* ctl = (unsigned*)(ws + WS_CTL);
    const float* x = args.in[0]; const float* norm1_w = args.in[1]; const float* w_in = args.in[2]; const float* lb_logits = args.in[3];
    const float* hgrn_norm_w = args.in[4]; const float* dw_w = args.in[5]; const float* dw_b = args.in[6]; const float* conv_ln_w = args.in[7]; const float* conv_ln_b = args.in[8];
    const float* w_out = args.in[9]; const float* norm2_w = args.in[10]; const float* router_w = args.in[11]; const float* router_b = args.in[12];
    const float* w1 = args.in[13]; const float* b1 = args.in[14]; const float* w2 = args.in[15]; const float* b2 = args.in[16]; const float* final_norm_w = args.in[17];
    float* out = args.out;
    bf16* WI = (bf16*)(ws + WS_WI); bf16* WO = (bf16*)(ws + WS_WO); unsigned char* W1T = ws + WS_W1; unsigned char* W2T = ws + WS_W2;
    float* H = (float*)(ws + WS_H); bf16* XN = (bf16*)(ws + WS_XN);
    bf16* Qb = (bf16*)(ws + WS_Q); bf16* KFb = (bf16*)(ws + WS_KF); bf16* KBb = (bf16*)(ws + WS_KB); bf16* Vb = (bf16*)(ws + WS_V); bf16* Gb = (bf16*)(ws + WS_G); bf16* Ub = (bf16*)(ws + WS_U);
    float* LFb = (float*)(ws + WS_LF); float* LBb = (float*)(ws + WS_LB); float* OFb = (float*)(ws + WS_OF); float* OBb = (float*)(ws + WS_OB);
    bf16* MIX = (bf16*)(ws + WS_MIX); unsigned char* XS = ws + WS_XS; unsigned char* ACT = ws + WS_ACT; unsigned char* N2 = ws + WS_XN; bf16* YS = (bf16*)(ws + WS_YS);
    float* WRT = (float*)(ws + WS_WRT); int* SLOT = (int*)(ws + WS_SLOT); float* GATE = (float*)(ws + WS_GATE); int* ROWTOK = (int*)(ws + WS_ROWTOK);
    volatile LAS int* bs = (volatile LAS int*)(lds + TAB_OFF);
    volatile LAS int* cl = (volatile LAS int*)(lds + TAB_OFF + 256);
    LAS int* lcnt = (LAS int*)(lds + TAB_OFF + 512);
    volatile LAS int* gbase = (volatile LAS int*)(lds + TAB_OFF + 768);

    for (int u = tid; u < (LDS_BYTES - LDSCTL_OFF) / 4; u += NTHR) ((LAS unsigned*)(lds + LDSCTL_OFF))[u] = 0u;
    __syncthreads();
    XcdBarrier bar; bar.bar = ctl + CW_BAR; bar.x = 0; bar.st = nullptr;
    if (MK_N_LAUNCHES == 1) bar = xcd_barrier_post(ctl + CW_BAR, MISC + 8);
#ifndef PROBE_STAMP
#define PROBE_STAMP -1
#endif
    unsigned long long tS[N_PHASES + 1];
#define STAMP(k) do { if ((PROBE_STAMP) >= 0) tS[k] = __builtin_amdgcn_s_memrealtime(); } while (0)
    const int lo = args.ph_lo, hi = args.ph_hi;
#ifndef PHASE_MASK
#define PHASE_MASK 0xffffffffu
#endif
#define IN(k) ((((PHASE_MASK) >> (k)) & 1u) && lo <= (k) && (k) < hi)
#ifndef PROBE_DUP
#define PROBE_DUP -1
#endif
#define REP(k) _Pragma("unroll 1") for (int rep_ = 0; rep_ < ((PROBE_DUP) == (k) ? 2 + (args.ph_hi >> 20) : 1); ++rep_)
#define SEAM(k) do { if (IN(k) && IN((k) + 1)) { xcd_barrier(bar); if ((PROBE_DUP) == 99) { xcd_barrier(bar); xcd_barrier(bar); } } } while (0)
#define BUILD_BS() do { int t_; asm volatile("v_mov_b32 %0, %1" : "=v"(t_) : "v"(tid));     \
        if (t_ < 64) { const int c_ = t_ < NE ? (int)__hip_atomic_load(ctl + CW_CNT + 64 * (t_ & (NE - 1)), RLX_AGENT) : 0; int x_ = (c_ + 255) >> 8; \
        _Pragma("unroll") for (int o_ = 1; o_ < NE; o_ <<= 1) { const int y_ = __shfl_up(x_, o_); if ((t_ & 63) >= o_) x_ += y_; }     \
        if (t_ < NE) { cl[t_] = c_; bs[t_ + 1] = x_; } if (t_ == 0) bs[0] = 0; } __syncthreads(); } while (0)

    STAMP(0);
    if (IN(0)) REP(0) {
        LAS float* scr = (LAS float*)(lds + RING_OFF + wave * 16384);
        constexpr int I_WI = (D / 64) * (INC / 32), I_WO = (D / 64) * (D / 32), I_W1 = (D / 64) * (2 * FF / 32), I_W2 = (FF / 64) * (D / 32);
        #if defined(HGRN_NAIVE) || defined(W2_IN_P0)
        constexpr int NITEMS = I_WI + I_WO + NE * I_W1 + NE * I_W2;
#else
        constexpr int NITEMS = I_WI + I_WO + W1_P0;
#endif
#if defined(HGRN_NAIVE) || defined(W2_IN_P0)
        for (int it = gw; it < NITEMS; it += NGW) {
            int r = it;
            if (r < I_WI) { p0_item<false>(w_in, D, INC, WI, RmWin(), scr, r, lane); continue; } r -= I_WI;
            if (r < I_WO) { p0_item<false>(w_out, D, D, WO, RmIdent(), scr, r, lane); continue; } r -= I_WO;
            if (r < NE * I_W1) { W1_ITEM(r); continue; } r -= NE * I_W1;
            { const int e = r / I_W2; p0_item<true>(w2 + (size_t)e * FF * D, FF, D, W2T + (size_t)e * D * FF, RmIdent(), scr, r - e * I_W2, lane); }
        }
#else
        (void)NITEMS; (void)I_W2;
        for (int it = gw; it < I_WI + I_WO; it += NGW) { if (it < I_WI) p0_item<false>(w_in, D, INC, WI, RmWin(), scr, it, lane); else p0_item<false>(w_out, D, D, WO, RmIdent(), scr, it - I_WI, lane); }
        convert_range_fp8(w1, D, 2 * FF, W1T, RmW1(), 10, gw, NGW, W1_P0, 0, scr, lane);
#endif
        {
            const f32x4* wr = (const f32x4*)norm1_w + lane; f32x4 gw4[4];
#pragma unroll
            for (int j = 0; j < 4; ++j) gw4[j] = wr[64 * j];
#pragma unroll 1
            for (int m0 = gw; m0 < MTOK; m0 += 4 * NGW) {
                f32x4 v[4][4];
#pragma unroll
                for (int q4 = 0; q4 < 4; ++q4) { const int m = min(m0 + q4 * NGW, MTOK - 1); const f32x4* xr = (const f32x4*)(x + (size_t)m * D) + lane;
#pragma unroll
                    for (int j = 0; j < 4; ++j) v[q4][j] = xr[64 * j]; }
#pragma unroll
                for (int q4 = 0; q4 < 4; ++q4) { const int m = m0 + q4 * NGW; float sq = 0.f;
#pragma unroll
                    for (int j = 0; j < 4; ++j) sq += (v[q4][j].x * v[q4][j].x + v[q4][j].y * v[q4][j].y) + (v[q4][j].z * v[q4][j].z + v[q4][j].w * v[q4][j].w);
                    const float rstd = rsqrtf(wave_sum(sq) * (1.f / D) + EPS);
                    if (m < MTOK) { v2u* o8 = (v2u*)(XN + (size_t)m * D) + lane;
#pragma unroll
                        for (int j = 0; j < 4; ++j) { v2u o; o.x = pk2(v[q4][j].x * rstd * gw4[j].x, v[q4][j].y * rstd * gw4[j].y); o.y = pk2(v[q4][j].z * rstd * gw4[j].z, v[q4][j].w * rstd * gw4[j].w); o8[64 * j] = o; } }
                }
            }
        }
        for (int i = bx * NTHR + tid; i < 16 * D; i += G * NTHR) {
            const int r = i >> 4, e16 = i & 15, k = 256 * (r & 3) + (r >> 2); const float gk = norm2_w[k];
            WRT[2 * i] = gk * router_w[k * NE + e16]; WRT[2 * i + 1] = gk * router_w[k * NE + 16 + e16]; }
    }
    if ((PROBE_STAMP) == 600 + 0) tS[6] = __builtin_amdgcn_s_memrealtime();
    SEAM(0);

    STAMP(1);
    if (IN(1)) REP(1) {
        pg8::Gemm g{XN, WI, MTOK, INC, D}; OrderRep S; S.init(MTOK, INC, G, bx); S.reps = ((PROBE_DUP) == 11) ? 2 : 1;
        EpiProj E{Qb, KFb, KBb, Vb, Gb, Ub, LFb, LBb, lb_logits};
        pg8::gemm_phase<EpiProj, OrderRep, true, true>(lds + RING_OFF, g, S, E);
#if !defined(HGRN_NAIVE) && !defined(W2_IN_P0)
        {
            LAS float* scr = (LAS float*)(lds + RING_OFF + wave * 16384);
            if (G == 256) { if (bx >= 128) convert_range_fp8(w1, D, 2 * FF, W1T, RmW1(), 10, (bx - 128) * NWAVES + wave, 128 * NWAVES, W1_P1, W1_P0, scr, lane); }
            else convert_range_fp8(w1, D, 2 * FF, W1T, RmW1(), 10, gw, NGW, W1_P1, W1_P0, scr, lane);
        }
#endif
    }
    if ((PROBE_STAMP) == 600 + 1) tS[6] = __builtin_amdgcn_s_memrealtime();
    SEAM(1);

    STAMP(2);
    if (IN(2)) REP(2) {
        const bool split = (G == 256);
#if defined(HGRN_NAIVE)
        const bool hsel = true; const int hidx = 0, hstride = 1; const bool csel = true; const int cidx = vcu, cstride = G;
#else
        const bool hsel = split ? (((bx >> 3) & 1) != 0) : true; const int hidx = split ? (bx >> 4) * 8 + (bx & 7) : bx, hstride = split ? 128 : G;
        const bool csel = split ? !hsel : true; const int cidx = split ? (bx >> 4) * 8 + (bx & 7) : bx, cstride = split ? 128 : G;
#endif
        (void)hidx; (void)hstride;
        if (csel && PROBE_DELAY == 3) probe_delay(3000); if (csel && PROBE_DELAY == 4) probe_delay(20000);
        if (csel) for (int crep_ = 0; crep_ < ((PROBE_DUP) == 21 ? 2 : 1); ++crep_) {
            LAS unsigned short* ut = (LAS unsigned short*)(lds + RING_OFF);
            LAS float* part = (LAS float*)(lds + RING_OFF + 98304);
            LAS float* stat = (LAS float*)(lds + RING_OFF + 98304 + 4096);
            for (int unit = cidx; unit < NBATCH * (TT / 64); unit += cstride) {
                const int b = unit / (TT / 64), t0 = (unit % (TT / 64)) * 64;
                {
                    v4u val[12];
#pragma unroll
                    for (int i = 0; i < 12; ++i) { const int idx = tid + NTHR * i, r = idx >> 6, p = idx & 63, t = t0 - 15 + r;
                        val[i] = (v4u){0u, 0u, 0u, 0u};
                        if (idx < 94 * 64 && t >= 0 && t < TT) val[i] = *(const v4u*)(Ub + (size_t)(b * TT + t) * CCH + p * 8); }
#pragma unroll
                    for (int i = 0; i < 12; ++i) { const int idx = tid + NTHR * i, r = idx >> 6, p = idx & 63;
                        if (idx < 94 * 64) *(LAS v4u*)(ut + r * 512 + p * 8) = val[i]; }
                }
                __syncthreads();
                const int c = tid;
                float w[CLEN];
#pragma unroll
                for (int j = 0; j < CLEN; ++j) w[j] = dw_w[j * CCH + c];
                const float bias = dw_b[c];
                float y[64];
#pragma unroll
                for (int tb = 0; tb < 8; ++tb) {
                    float win[38];
#pragma unroll
                    for (int i = 0; i < 38; ++i) win[i] = bf2f(ut[(tb * 8 + i) * 512 + c]);
#pragma unroll
                    for (int o = 0; o < 8; ++o) { float a = bias;
#pragma unroll
                        for (int j = 0; j < CLEN; ++j) a += w[j] * win[o + j];
                        y[tb * 8 + o] = a; }
                }
#pragma unroll 1
                for (int pass = 0; pass < 2; ++pass) {
                    float s1[64];
#pragma unroll
                    for (int i = 0; i < 64; ++i) s1[i] = pass ? y[i] * y[i] : y[i];
#pragma unroll
                    for (int s = 32; s >= 1; s >>= 1) {
                        const bool up = (lane & s) != 0;
#pragma unroll
                        for (int i = 0; i < s; ++i) { const float k1 = up ? s1[i + s] : s1[i], x1 = up ? s1[i] : s1[i + s]; s1[i] = k1 + __shfl_xor(x1, s); }
                    }
                    part[(wave * 64 + lane) * 2 + pass] = s1[0];
                }
                __syncthreads();
                if (tid < 64) { float a = 0.f, q = 0.f;
#pragma unroll
                    for (int wv = 0; wv < 8; ++wv) { a += part[(wv * 64 + tid) * 2]; q += part[(wv * 64 + tid) * 2 + 1]; }
                    const float mean = a * (1.f / CCH), var = q * (1.f / CCH) - mean * mean;
                    stat[tid * 2] = mean; stat[tid * 2 + 1] = rsqrtf(fmaxf(var, 0.f) + EPS); }
                __syncthreads();
                const float lw = conv_ln_w[c], lbias = conv_ln_b[c];
#pragma unroll
                for (int t = 0; t < 64; ++t) {
                    const float v = (y[t] - stat[t * 2]) * stat[t * 2 + 1] * lw + lbias;
                    MIX[(size_t)(b * TT + t0 + t) * D + 512 + c] = (bf16)(pk2(v * sigm(v), 0.f) & 0xffffu);
                }
                __syncthreads();
            }
            if ((PROBE_STAMP) == 650) tS[6] = __builtin_amdgcn_s_memrealtime();
#if !defined(HGRN_NAIVE) && !defined(W2_IN_P0)
            {
                LAS float* scr = (LAS float*)(lds + RING_OFF + wave * 16384);
                constexpr int I_W2 = (FF / 64) * (D / 32);
                convert_range_fp8(w2, FF, D, W2T, RmIdent(), 9, cidx * NWAVES + wave, cstride * NWAVES, W2_P2, 0, scr, lane);
                convert_range_fp8(w1, D, 2 * FF, W1T, RmW1(), 10, cidx * NWAVES + wave, cstride * NWAVES, W1_P2, W1_P0 + W1_P1, scr, lane);
            }
#endif
        }
#if defined(HGRN_NAIVE)
        {
            LAS float* qs = (LAS float*)(lds + RING_OFF); LAS float* ks = qs + 2048; LAS float* fs = ks + 2048; LAS float* vs = fs + 2048; LAS float* op = vs + 2048;
            const int e = tid & 127, dq = tid >> 7;
            for (int unit = G - 1 - bx; unit < NBATCH * NH * 2; unit += G) {
                const int dir = unit & 1, h = (unit >> 1) & 3, b = unit >> 3;
                const bf16* Kp = dir ? KBb : KFb; const float* Lp = dir ? LBb : LFb; float* Op = dir ? OBb : OFb;
                float S[32];
#pragma unroll
                for (int i = 0; i < 32; ++i) S[i] = 0.f;
                for (int blk = 0; blk < TT / 16; ++blk) {
                    const int tb = dir ? (TT - 16 - blk * 16) : blk * 16;
#pragma unroll
                    for (int i = 0; i < 4; ++i) { const int idx = tid + NTHR * i, r = idx >> 7, d = idx & 127; const size_t off = (size_t)(b * TT + tb + r) * 512 + h * 128 + d;
                        qs[idx] = bf2f(Qb[off]); ks[idx] = bf2f(Kp[off]); fs[idx] = __expf(Lp[off]); vs[idx] = bf2f(Vb[off]); }
                    __syncthreads();
                    for (int st = 0; st < 16; ++st) {
                        const int r = dir ? 15 - st : st; const float v = vs[r * 128 + e]; float o = 0.f;
#pragma unroll
                        for (int dd = 0; dd < 32; ++dd) { const int d = dq * 32 + dd; S[dd] = fs[r * 128 + d] * S[dd] + ks[r * 128 + d] * v; o += qs[r * 128 + d] * S[dd]; }
                        op[(r * 4 + dq) * 128 + e] = o;
                    }
                    __syncthreads();
#pragma unroll
                    for (int i = 0; i < 4; ++i) { const int idx = tid + NTHR * i, r = idx >> 7, ee = idx & 127;
                        Op[(size_t)(b * TT + tb + r) * 512 + h * 128 + ee] = (op[(r * 4 + 0) * 128 + ee] + op[(r * 4 + 1) * 128 + ee]) + (op[(r * 4 + 2) * 128 + ee] + op[(r * 4 + 3) * 128 + ee]); }
                }
                __syncthreads();
            }
        }
#else
        if (hsel) for (int unit = hidx; unit < NBATCH * NH * 4 * ((PROBE_DUP) == 20 ? 2 : 1); unit += hstride) HGRN_FN(lds + RING_OFF, unit & (NBATCH * NH * 4 - 1), Qb, KFb, KBb, Vb, LFb, LBb, OFb, OBb, tid, lane, wave);
#endif
    }
    if ((PROBE_STAMP) == 600 + 2) tS[6] = __builtin_amdgcn_s_memrealtime();
    SEAM(2);

    STAMP(3);
    if (IN(3)) REP(3) {
        for (int m = gw; m < MTOK; m += NGW) {
            const size_t off = (size_t)m * 512 + lane * 8;
            const f32x4 a0 = *(const f32x4*)(OFb + off), a1 = *(const f32x4*)(OFb + off + 4), c0 = *(const f32x4*)(OBb + off), c1 = *(const f32x4*)(OBb + off + 4);
            const f32x4 o0 = a0 + c0, o1 = a1 + c1;
            float ss = (o0.x * o0.x + o0.y * o0.y) + (o0.z * o0.z + o0.w * o0.w) + (o1.x * o1.x + o1.y * o1.y) + (o1.z * o1.z + o1.w * o1.w);
            ss += __shfl_xor(ss, 1); ss += __shfl_xor(ss, 2); ss += __shfl_xor(ss, 4); ss += __shfl_xor(ss, 8);
            const float rstd = rsqrtf(ss * (1.f / DV) + EPS);
            const v4u gv = *(const v4u*)(Gb + off);
            const f32x4 w0 = *(const f32x4*)(hgrn_norm_w + lane * 8), w1v = *(const f32x4*)(hgrn_norm_w + lane * 8 + 4);
            f32x4 r0, r1;
            r0.x = o0.x * rstd * w0.x * bf2f(gv.x & 0xffffu); r0.y = o0.y * rstd * w0.y * bf2f(gv.x >> 16);
            r0.z = o0.z * rstd * w0.z * bf2f(gv.y & 0xffffu); r0.w = o0.w * rstd * w0.w * bf2f(gv.y >> 16);
            r1.x = o1.x * rstd * w1v.x * bf2f(gv.z & 0xffffu); r1.y = o1.y * rstd * w1v.y * bf2f(gv.z >> 16);
            r1.z = o1.z * rstd * w1v.z * bf2f(gv.w & 0xffffu); r1.w = o1.w * rstd * w1v.w * bf2f(gv.w >> 16);
            st8bf(MIX + (size_t)m * D + lane * 8, r0, r1);
        }
    }
    if ((PROBE_STAMP) == 600 + 3) tS[6] = __builtin_amdgcn_s_memrealtime();
    SEAM(3);

    STAMP(4);
    if (IN(4)) REP(4) {
        pg8::Gemm g{MIX, WO, MTOK, D, D}; pg8::StaticOrder S; S.init(MTOK, D, G, bx);
        EpiRes E{x, H};
        pg8::gemm_phase<EpiRes, pg8::StaticOrder, true, true>(lds + RING_OFF, g, S, E);
    }
    if ((PROBE_STAMP) == 600 + 4) tS[6] = __builtin_amdgcn_s_memrealtime();
    SEAM(4);

    STAMP(5);
    if (IN(5)) REP(5) {
        typedef float f32x2 __attribute__((ext_vector_type(2)));
        LAS float* wl = (LAS float*)(lds + RING_OFF);
        LAS unsigned* sb = (LAS unsigned*)(lds + SB_OFF);
        { f32x4 tv_[NE * D / 4 / NTHR];
#pragma unroll
            for (int i = 0; i < NE * D / 4 / NTHR; ++i) tv_[i] = ((const f32x4*)WRT)[tid + NTHR * i];
#pragma unroll
            for (int i = 0; i < NE * D / 4 / NTHR; ++i) ((LAS f32x4*)wl)[tid + NTHR * i] = tv_[i]; }
        if (tid < NE) lcnt[tid] = 0;
        __syncthreads();
        for (int tg = vcu; tg < MTOK / 64; tg += G) {
            const int tok0 = tg * 64 + 16 * (wave & 3);
            if (wave < 4) {
                const int j = lane & 15, q = lane >> 4;
                const f32x4* hrow = (const f32x4*)(H + (size_t)(tok0 + j) * D + 256 * q);
                const LAS f32x2* tab = (const LAS f32x2*)wl + q * 16 + j;
                f32x4 acc0 = (f32x4){0.f, 0.f, 0.f, 0.f}, acc1 = acc0; float ss = 0.f;
                f32x4 hb[8], hn[8];
#pragma unroll
                for (int i = 0; i < 8; ++i) hb[i] = hrow[i];
#pragma unroll 1
                for (int blk = 0; blk < 8; ++blk) {
                    if (blk + 1 < 8) {
#pragma unroll
                        for (int i = 0; i < 8; ++i) hn[i] = hrow[(blk + 1) * 8 + i];
                    }
#pragma unroll
                    for (int i = 0; i < 8; ++i) {
                        const f32x4 hc = hb[i]; const int s4 = blk * 8 + i;
                        f32x2 w[4];
#pragma unroll
                        for (int u = 0; u < 4; ++u) w[u] = tab[(4 * s4 + u) * 64];
                        ss += (hc.x * hc.x + hc.y * hc.y) + (hc.z * hc.z + hc.w * hc.w);
#pragma unroll
                        for (int u = 0; u < 4; ++u) { acc0 = __builtin_amdgcn_mfma_f32_16x16x4f32(w[u].x, hc[u], acc0, 0, 0, 0); acc1 = __builtin_amdgcn_mfma_f32_16x16x4f32(w[u].y, hc[u], acc1, 0, 0, 0); }
                    }
#pragma unroll
                    for (int i = 0; i < 8; ++i) hb[i] = hn[i];
                }
                ss += __shfl_xor(ss, 16); ss += __shfl_xor(ss, 32);
                const float rstd = rsqrtf(ss * (1.f / D) + EPS);
                float lg[8];
#pragma unroll
                for (int r = 0; r < 4; ++r) { lg[r] = acc0[r] * rstd + router_b[4 * q + r]; lg[4 + r] = acc1[r] * rstd + router_b[16 + 4 * q + r]; }
                float tv[TOPK]; int ti[TOPK];
#pragma unroll
                for (int k = 0; k < TOPK; ++k) {
                    float bv = lg[0]; int bi = 4 * q;
#pragma unroll
                    for (int r = 1; r < 8; ++r) { const int id = (r < 4) ? 4 * q + r : 16 + 4 * q + (r - 4); if (lg[r] > bv) { bv = lg[r]; bi = id; } }
#pragma unroll
                    for (int o = 16; o < 64; o <<= 1) { const float ov = __shfl_xor(bv, o); const int oi = __shfl_xor(bi, o); if (ov > bv || (ov == bv && oi < bi)) { bv = ov; bi = oi; } }
                    tv[k] = bv; ti[k] = bi;
#pragma unroll
                    for (int r = 0; r < 8; ++r) { const int id = (r < 4) ? 4 * q + r : 16 + 4 * q + (r - 4); if (id == bi) lg[r] = -INFINITY; }
                }
                const float e1 = __expf(tv[1] - tv[0]), e2 = __expf(tv[2] - tv[0]), e3 = __expf(tv[3] - tv[0]);
                const float inv = 1.0f / (1.0f + e1 + e2 + e3);
                {
                    const int ek = q == 0 ? ti[0] : q == 1 ? ti[1] : q == 2 ? ti[2] : ti[3];
                    const float gk = (q == 0 ? 1.0f : q == 1 ? e1 : q == 2 ? e2 : e3) * inv;
                    const int lr = __hip_atomic_fetch_add(&lcnt[ek], 1, __ATOMIC_RELAXED, __HIP_MEMORY_SCOPE_WORKGROUP);
                    sb[(16 * wave + j) * 4 + q] = ((unsigned)ek << 16) | (unsigned)lr;
                    GATE[(size_t)(tok0 + j) * TOPK + q] = gk;
                }
            } else {
                const f32x4* wr = (const f32x4*)norm2_w + lane;
                f32x4 gw4[4];
#pragma unroll
                for (int jj = 0; jj < 4; ++jj) gw4[jj] = wr[64 * jj];
#pragma unroll 1
                for (int i = 0; i < 16; i += 4) {
                    f32x4 v[4][4];
#pragma unroll
                    for (int q4 = 0; q4 < 4; ++q4) { const f32x4* hr = (const f32x4*)(H + (size_t)(tok0 + i + q4) * D) + lane;
#pragma unroll
                        for (int jj = 0; jj < 4; ++jj) v[q4][jj] = hr[64 * jj]; }
#pragma unroll
                    for (int q4 = 0; q4 < 4; ++q4) {
                        float s2 = 0.f;
#pragma unroll
                        for (int jj = 0; jj < 4; ++jj) s2 += (v[q4][jj].x * v[q4][jj].x + v[q4][jj].y * v[q4][jj].y) + (v[q4][jj].z * v[q4][jj].z + v[q4][jj].w * v[q4][jj].w);
                        const float rstd = rsqrtf(wave_sum(s2) * (1.f / D) + EPS) * SC_N2;
                        unsigned* o4 = (unsigned*)(N2 + (size_t)(tok0 + i + q4) * D) + lane;
#pragma unroll
                        for (int jj = 0; jj < 4; ++jj) o4[64 * jj] = pk4_fp8(v[q4][jj].x * rstd * gw4[jj].x, v[q4][jj].y * rstd * gw4[jj].y, v[q4][jj].z * rstd * gw4[jj].z, v[q4][jj].w * rstd * gw4[jj].w);
                    }
                }
            }
            __syncthreads();
            if (tid < NE) { const int c = lcnt[tid]; gbase[tid] = c ? (int)__hip_atomic_fetch_add(ctl + CW_CNT + ((PROBE_DUP) == 5 && rep_ == 0 ? 4096 : 0) + 64 * tid, (unsigned)c, RLX_AGENT) : 0; }
            __syncthreads();
            if (tid < 256) { const unsigned w = sb[tid]; const int ek = (int)(w >> 16), r = gbase[ek] + (int)(w & 0xffffu), m = tg * 64 + (tid >> 2);
                ROWTOK[ek * MTOK + r] = m; SLOT[(size_t)m * TOPK + (tid & 3)] = ek * MTOK + r; }
            if (tid < NE) lcnt[tid] = 0;
            __syncthreads();
        }
    }
    if ((PROBE_STAMP) == 600 + 5) tS[6] = __builtin_amdgcn_s_memrealtime();
    SEAM(5);


    if ((PROBE_STAMP) < 600 || (PROBE_STAMP) > 699) STAMP(6);
    STAMP(7);
#if defined(MOE_MERGED)
    if (IN(7)) REP(7) {
        BUILD_BS();
        pg8::Gemm g{(const bf16*)ws, (const bf16*)W1T, MTOK, 2 * FF, D / 2}; MoeOrder2 S{bs, G, vcu, cl, ROWTOK, ctl};
        EpiMoe E{EpiSwiglu{ACT, b1}, EpiDown{YS, b2}};
        pg8::gemm_phase<EpiMoe, MoeOrder2, true, true, true, true>(lds + RING_OFF, g, S, E);
    }
    if ((PROBE_STAMP) == 600 + 8) tS[6] = __builtin_amdgcn_s_memrealtime();
    SEAM(8);
#else
    if (IN(7)) REP(7) {
        BUILD_BS();
        pg8::Gemm g{(const bf16*)N2, (const bf16*)W1T, MTOK, 2 * FF, D / 2}; MoeOrder S{bs, 8, G, vcu, cl, ROWTOK};
        EpiSwiglu E{ACT, b1};
        pg8::gemm_phase<EpiSwiglu, MoeOrder, true, true, true, true>(lds + RING_OFF, g, S, E);
#if !defined(HGRN_NAIVE) && !defined(W2_IN_P0)
        {
            LAS float* scr = (LAS float*)(lds + RING_OFF + wave * 16384);
            const int r7 = (bs[NE] * 8) % G, nsl = G - r7;
            if (vcu >= r7) convert_range_fp8(w2, FF, D, W2T, RmIdent(), 9, (vcu - r7) * NWAVES + wave, nsl * NWAVES, W2_P7, W2_P2, scr, lane);
        }
#endif
    }
    if ((PROBE_STAMP) == 600 + 7) tS[6] = __builtin_amdgcn_s_memrealtime();
    SEAM(7);

    STAMP(8);
    if (IN(8)) REP(8) {
        BUILD_BS();
        pg8::Gemm g{(const bf16*)ACT, (const bf16*)W2T, MOE_ROWS, D, FF / 2}; MoeOrder S{bs, 4, G, vcu, cl, ROWTOK};
        EpiDown E{YS, b2};
        pg8::gemm_phase<EpiDown, MoeOrder, true, true, true>(lds + RING_OFF, g, S, E);
    }
    SEAM(8);
#endif

    STAMP(9);
    if (IN(9)) REP(9) {
        BUILD_BS();
        for (int base = gw; base < MTOK; base += 16 * NGW) {
            const int mi = base + NGW * (lane >> 2); int posl = 0; float gl = 0.f;
            if (mi < MTOK) { const int sl = SLOT[(size_t)mi * TOPK + (lane & 3)]; gl = GATE[(size_t)mi * TOPK + (lane & 3)]; posl = bs[sl >> 14] * 256 + (sl & (MTOK - 1)); }
#pragma unroll 2
            for (int i = 0; i < 16; ++i) {
                const int m = base + NGW * i; if (m >= MTOK) break;
                const f32x4* hr = (const f32x4*)(H + (size_t)m * D) + lane; const f32x4* wr = (const f32x4*)final_norm_w + lane;
                int pos[TOPK]; float gk[TOPK];
#pragma unroll
                for (int k = 0; k < TOPK; ++k) { pos[k] = __shfl(posl, 4 * i + k); gk[k] = __shfl(gl, 4 * i + k); }
                f32x4 v[4]; v2u yw[TOPK][4];
#pragma unroll
                for (int j = 0; j < 4; ++j) v[j] = hr[64 * j];
#pragma unroll
                for (int k = 0; k < TOPK; ++k) { const v2u* yr = (const v2u*)(YS + (size_t)pos[k] * D) + lane;
#pragma unroll
                    for (int j = 0; j < 4; ++j) yw[k][j] = yr[64 * j]; }
#pragma unroll
                for (int k = 0; k < TOPK; ++k)
#pragma unroll
                    for (int j = 0; j < 4; ++j) { const v2u w = yw[k][j];
                        v[j].x += gk[k] * bf2f(w.x & 0xffffu); v[j].y += gk[k] * bf2f(w.x >> 16); v[j].z += gk[k] * bf2f(w.y & 0xffffu); v[j].w += gk[k] * bf2f(w.y >> 16); }
                float s = 0.f;
#pragma unroll
                for (int j = 0; j < 4; ++j) s += (v[j].x * v[j].x + v[j].y * v[j].y) + (v[j].z * v[j].z + v[j].w * v[j].w);
                const float rstd = rsqrtf(wave_sum(s) * (1.f / D) + EPS);
                f32x4* orow = (f32x4*)(out + (size_t)m * D) + lane;
#pragma unroll
                for (int j = 0; j < 4; ++j) orow[64 * j] = v[j] * rstd * wr[64 * j];
            }
        }
    }
    STAMP(N_PHASES);
#ifndef PROBE_WG
#define PROBE_WG 0
#endif
    if ((PROBE_STAMP) >= 0 && bx == (PROBE_WG)) {
        const int k0 = (PROBE_STAMP) == 650 ? 2 : (PROBE_STAMP) % 100, k1 = ((PROBE_STAMP) >= 100) ? (PROBE_STAMP) / 100 : k0 + 1;
        const unsigned long long d = 2ull * (tS[k1 > N_PHASES ? N_PHASES : k1] - tS[k0]), t0 = __builtin_amdgcn_s_memrealtime();
        while (__builtin_amdgcn_s_memrealtime() - t0 < d) __builtin_amdgcn_s_sleep(8);
    }
#undef IN
#undef SEAM
#undef BUILD_BS
}

extern "C" void kernel_launch(void* const* d_in, const int* in_sizes, int n_in, void* d_out, int out_size, void* d_ws, size_t ws_size, hipStream_t stream) {
    static int grid = 0;
    if (grid == 0) {
        if (n_in != 18 || in_sizes[0] != MTOK * D || out_size != MTOK * D || ws_size < WS_END) { fprintf(stderr, "kernel_launch: unexpected shapes (n_in %d, in0 %d, out %d, ws %zu < %zu); nothing launched\n", n_in, n_in > 0 ? in_sizes[0] : -1, out_size, ws_size, (size_t)WS_END); grid = -1; return; }
        int dev = 0, cus = 0, per_cu = 0;
        if (hipGetDevice(&dev) != hipSuccess || hipDeviceGetAttribute(&cus, hipDeviceAttributeMultiprocessorCount, dev) != hipSuccess) { fprintf(stderr, "kernel_launch: device query failed\n"); grid = -1; return; }
        if (hipFuncSetAttribute((const void*)fwd_kernel, hipFuncAttributeMaxDynamicSharedMemorySize, LDS_BYTES) != hipSuccess) { fprintf(stderr, "kernel_launch: hipFuncSetAttribute failed\n"); grid = -1; return; }
        if (hipOccupancyMaxActiveBlocksPerMultiprocessor(&per_cu, (const void*)fwd_kernel, NTHR, LDS_BYTES) != hipSuccess || per_cu < 1)
            fprintf(stderr, "kernel_launch: note: occupancy query reports %d workgroups per CU\n", per_cu);
        (void)hipGetLastError();
        grid = cus;
    }
    if (grid < 0) return;
    if (hipMemsetAsync((char*)d_ws + WS_CTL, 0, CTL_ZERO_BYTES, stream) != hipSuccess) { fprintf(stderr, "kernel_launch: memset failed\n"); return; }
    Args a{};
    for (int i = 0; i < 18; ++i) a.in[i] = (const float*)d_in[i];
    a.out = (float*)d_out; a.ws = (unsigned char*)d_ws;
#if MK_N_LAUNCHES == 1
    a.ph_lo = 0; a.ph_hi = N_PHASES;
    hipLaunchKernelGGL(fwd_kernel, dim3(grid), dim3(NTHR), LDS_BYTES, stream, a);
#else
    for (int ph = 0; ph < N_PHASES; ++ph) { a.ph_lo = ph; a.ph_hi = ph + 1; hipLaunchKernelGGL(fwd_kernel, dim3(grid), dim3(NTHR), LDS_BYTES, stream, a); }
#endif
    const hipError_t le = hipPeekAtLastError();
    if (le != hipSuccess) fprintf(stderr, "kernel_launch: launch failed: %s\n", hipGetErrorName(le));
}
```

```cpp
#define HGRN_V2 1
#include <hip/hip_runtime.h>
#include <cstdio>
#include <cstdint>
namespace pg8 {
#define PG8_LAS __attribute__((address_space(3)))
typedef unsigned short bf16_t;
typedef short bf16x8 __attribute__((ext_vector_type(8)));
typedef float f32x4 __attribute__((ext_vector_type(4)));
typedef unsigned u32x4 __attribute__((ext_vector_type(4)));
constexpr int BM = 256, BK = 64, HALF = 128, HTB = HALF * BK * 2  , STAGE_BYTES = 8 * HTB, NXCD = 8, WGM = 8;

__host__ __device__ __forceinline__ int lds_byte(int r, int c) { const int st = (r >> 4) * 2 + (c >> 5), rr = r & 15, cc = c & 31, ob = rr * 64 + cc * 2; return st * 1024 + (ob ^ (((ob >> 9) & 1) << 5)); }
__host__ __device__ __forceinline__ void stage_rc(int b, int& R, int& C) { const int st = b / 1024, sb = b % 1024, swz = sb ^ (((sb >> 9) & 1) << 5); R = (st >> 1) * 16 + swz / 64; C = (st & 1) * 32 + (swz % 64) / 2; }
__host__ __device__ __forceinline__ int perm32(int rho) { const int n = rho >> 4, i = rho & 15; return 8 * (i >> 2) + 4 * n + (i & 3); }

struct Unit { int pm, pn; };
struct Gemm { const bf16_t* A; const bf16_t* Bt; int M, N, K; };

struct StaticOrder {
    int nM, nN, nwg, G, c;
    __host__ __device__ void init(int M, int N, int G_, int c_) { nM = M / BM; nN = N / BM; nwg = nM * nN; G = G_; c = c_; }
    __host__ __device__ bool next(int i, Unit& u) const {
        const long L = (long)i * G + c; if (L >= nwg) return false;
        int wgid = (int)L; { const int q = nwg / NXCD, r = nwg % NXCD, xcd = wgid % NXCD, off = wgid / NXCD; wgid = (xcd < r ? xcd * (q + 1) : r * (q + 1) + (xcd - r) * q) + off; }
        const int nig = WGM * nN, gid = wgid / nig, fm = gid * WGM, gsz = (nM - fm) < WGM ? (nM - fm) : WGM;
        u.pm = fm + ((wgid % nig) % gsz); u.pn = (wgid % nig) / gsz; return true;
    }
    __device__ __forceinline__ void a_ready(const Unit&) const {}
    __device__ __forceinline__ void done(const Unit&) const {}
    __device__ __forceinline__ int done_defer(const Unit&) const { return -1; }
    __device__ __forceinline__ void done_signal(int) const {}
};
__device__ __forceinline__ unsigned cvt_pk_bf16(float lo, float hi) { unsigned r; asm volatile("v_cvt_pk_bf16_f32 %0, %1, %2" : "=v"(r) : "v"(lo), "v"(hi)); return r; }
typedef float f32x2 __attribute__((ext_vector_type(2)));
template <class Epi, class Sched, bool ALIGN_EPI = false, bool SP2 = false, bool FP8 = false, bool GATHER = false>
__device__ __forceinline__ void gemm_phase(PG8_LAS unsigned char* lds, const Gemm g, const Sched& S, const Epi& E) {
    typedef int v4i_t __attribute__((ext_vector_type(4)));
    const int tid = threadIdx.x, wid = __builtin_amdgcn_readfirstlane(tid >> 6), lane = tid & 63, wr = wid >> 2, wc = wid & 3, fr = lane & 15, fq = lane >> 4;
    const int K = g.K, nt = K / BK;
    unsigned voffA[2], voffB[2];
#pragma unroll
    for (int i = 0; i < 2; ++i) { int R, C; stage_rc(tid * 16 + i * 8192, R, C); const int Rb = Epi::PERM ? ((R & ~31) + perm32(R & 31)) : R;
        voffA[i] = (unsigned)(R * K + C) * 2u; voffB[i] = (unsigned)(Rb * K + C) * 2u; }
    int rowA[2]; unsigned colA[2];
#pragma unroll
    for (int i = 0; i < 2; ++i) { int R, C; stage_rc(tid * 16 + i * 8192, R, C); rowA[i] = R; colA[i] = (unsigned)C * 2u; }
    const size_t kstep = (size_t)(BK * 2);
    const size_t hstep = (size_t)HALF * K * 2;
    const size_t tstep = 2 * hstep;
    const unsigned ldsw = (unsigned)wid * 1024u;
    const int aoff = lds_byte(wr * 64 + fr, fq * 8), boff = lds_byte(wc * 32 + fr, fq * 8);
#define PG8_SA(b, h) (((b) * 2 + (h)) * HTB)
#define PG8_SB(b, h) ((4 + (b) * 2 + (h)) * HTB)
#define PG8_STAGE(bufoff, gbase, voff) do { _Pragma("unroll") for (int _i = 0; _i < 2; ++_i) \
        __builtin_amdgcn_global_load_lds((const unsigned*)((const char*)(gbase) + (voff)[_i]), (PG8_LAS unsigned*)(lds + (bufoff) + ldsw + _i * 8192), 16, 0, 0); } while (0)
#define PG8_STAGE2(bufoff, gbase, o0, o1) do { \
        __builtin_amdgcn_global_load_lds((const unsigned*)((const char*)(gbase) + (o0)), (PG8_LAS unsigned*)(lds + (bufoff) + ldsw), 16, 0, 0); \
        __builtin_amdgcn_global_load_lds((const unsigned*)((const char*)(gbase) + (o1)), (PG8_LAS unsigned*)(lds + (bufoff) + ldsw + 8192), 16, 0, 0); } while (0)
#define PG8_LDA(dst, b, h) do { _Pragma("unroll") for (int m = 0; m < 4; ++m) _Pragma("unroll") for (int k = 0; k < 2; ++k) dst[m][k] = *(const PG8_LAS bf16x8*)(lds + PG8_SA(b, h) + aoff + m * 2048 + k * 1024); } while (0)
#define PG8_LDB(dst, b, h) do { _Pragma("unroll") for (int n = 0; n < 2; ++n) _Pragma("unroll") for (int k = 0; k < 2; ++k) dst[n][k] = *(const PG8_LAS bf16x8*)(lds + PG8_SB(b, h) + boff + n * 2048 + k * 1024); } while (0)
#define PG8_MMA(ai, bj, At, Bt) do { __builtin_amdgcn_s_setprio(1); _Pragma("unroll") for (int m = 0; m < 4; ++m) _Pragma("unroll") for (int n = 0; n < 2; ++n) { \
        if constexpr (FP8) { asm volatile("v_mfma_f32_16x16x128_f8f6f4 %0, %1, %2, %0" : "+v"(acc[ai][bj][m][n]) : "v"(__builtin_shufflevector((v4i_t)Bt[n][0], (v4i_t)Bt[n][1], 0, 1, 2, 3, 4, 5, 6, 7)), "v"(__builtin_shufflevector((v4i_t)At[m][0], (v4i_t)At[m][1], 0, 1, 2, 3, 4, 5, 6, 7))); } \
        else { _Pragma("unroll") for (int k = 0; k < 2; ++k) acc[ai][bj][m][n] = __builtin_amdgcn_mfma_f32_16x16x32_bf16(Bt[n][k], At[m][k], acc[ai][bj][m][n], 0, 0, 0); } } __builtin_amdgcn_s_setprio(0); } while (0)
#define PG8_WAIT_V(n) asm volatile("s_waitcnt vmcnt(" #n ")" ::: "memory")
#define PG8_WAIT_L(n) asm volatile("s_waitcnt lgkmcnt(" #n ")" ::: "memory")
#define PG8_BAR __builtin_amdgcn_s_barrier()
#define PG8_SCHED __builtin_amdgcn_sched_barrier(0)
    Unit cur, nxt; int ui = 0; int pend = -1;
    if (!S.next(0, cur)) return;
    f32x4 acc[2][2][4][2];
#pragma unroll
    for (int a = 0; a < 2; ++a)
#pragma unroll
        for (int b = 0; b < 2; ++b)
#pragma unroll
            for (int m = 0; m < 4; ++m)
#pragma unroll
                for (int n = 0; n < 2; ++n) acc[a][b][m][n] = (f32x4){0.f, 0.f, 0.f, 0.f};
    bf16x8 At[4][2], B0[2][2], B1[2][2];
    const char* cA = (const char*)g.A + (size_t)cur.pm * tstep; const char* cB = (const char*)g.Bt + (size_t)cur.pn * tstep;
    unsigned oA[2][2], nOA[2][2]; int tk[2][2] = {{0, 0}, {0, 0}};
    if constexpr (GATHER) {
        cA = (const char*)g.A;
        const int nv = S.a_valid(cur); const unsigned ab = S.a_base(cur);
        if (S.a_is_list(cur)) { const int* lst = S.a_list(cur);
#pragma unroll
            for (int h = 0; h < 2; ++h)
#pragma unroll
                for (int i = 0; i < 2; ++i) { const int r = min(h * HALF + rowA[i], nv - 1); oA[h][i] = ab + (unsigned)lst[r] * (unsigned)(K * 2) + colA[i]; }
        } else { const int r0 = S.a_row0(cur);
#pragma unroll
            for (int h = 0; h < 2; ++h)
#pragma unroll
                for (int i = 0; i < 2; ++i) { const int r = min(h * HALF + rowA[i], nv - 1); oA[h][i] = ab + (unsigned)(r0 + r) * (unsigned)(K * 2) + colA[i]; }
        }
    } else {
#pragma unroll
        for (int h = 0; h < 2; ++h)
#pragma unroll
            for (int i = 0; i < 2; ++i) oA[h][i] = voffA[i] + (unsigned)(h * hstep);
    }
#pragma unroll
    for (int h = 0; h < 2; ++h)
#pragma unroll
        for (int i = 0; i < 2; ++i) nOA[h][i] = oA[h][i];
#define PG8_OSEL(h, i) (GATHER ? (last ? nOA[h][i] : oA[h][i]) : oA[h][i])
    S.a_ready(cur);
    if constexpr (SP2) {
        PG8_STAGE(PG8_SB(0, 0), cB, voffB); PG8_STAGE(PG8_SB(0, 1), cB + hstep, voffB); PG8_STAGE2(PG8_SA(0, 0), cA, oA[0][0], oA[0][1]); PG8_STAGE2(PG8_SA(0, 1), cA, oA[1][0], oA[1][1]);
        if (wr == 1) PG8_BAR;
        PG8_WAIT_V(2); PG8_BAR;
        PG8_STAGE(PG8_SB(1, 0), cB + kstep, voffB); PG8_STAGE2(PG8_SA(1, 0), cA + kstep, oA[0][0], oA[0][1]); PG8_STAGE(PG8_SB(1, 1), cB + hstep + kstep, voffB);
        PG8_WAIT_V(6); PG8_BAR;
    } else {
        PG8_STAGE(PG8_SB(0, 0), cB, voffB); PG8_STAGE(PG8_SA(0, 0), cA, voffA); PG8_STAGE(PG8_SB(0, 1), cB + hstep, voffB); PG8_STAGE(PG8_SA(0, 1), cA + hstep, voffA);
        if (wr == 1) PG8_BAR;
        PG8_WAIT_V(4); PG8_BAR;
        PG8_STAGE(PG8_SB(1, 0), cB + kstep, voffB); PG8_STAGE(PG8_SA(1, 0), cA + kstep, voffA); PG8_STAGE(PG8_SB(1, 1), cB + hstep + kstep, voffB);
        PG8_WAIT_V(6); PG8_BAR;
    }
    for (;;) {
        const bool has_next = S.next(ui + 1, nxt);
        const char* nA = GATHER ? cA : (has_next ? (const char*)g.A + (size_t)nxt.pm * tstep : cA); const char* nB = has_next ? (const char*)g.Bt + (size_t)nxt.pn * tstep : cB;
        if constexpr (GATHER) { if (has_next) { const int nv = S.a_valid(nxt);
            if (S.a_is_list(nxt)) { const int* lst = S.a_list(nxt);
#pragma unroll
                for (int h = 0; h < 2; ++h)
#pragma unroll
                    for (int i = 0; i < 2; ++i) { const int* pp = lst + min(h * HALF + rowA[i], nv - 1); asm volatile("global_load_dword %0, %1, off" : "=v"(tk[h][i]) : "v"(pp) : "memory"); }
            } else { const int r0 = S.a_row0(nxt);
#pragma unroll
                for (int h = 0; h < 2; ++h)
#pragma unroll
                    for (int i = 0; i < 2; ++i) tk[h][i] = r0 + min(h * HALF + rowA[i], nv - 1);
            } } }
        for (int t = 0; t < nt; t += 2) {
            const bool last = (t == nt - 2);
            const char* a1 = cA + (size_t)(t + 1) * kstep;
            const char* a2 = last ? nA : cA + (size_t)(t + 2) * kstep; const char* b2 = last ? nB : cB + (size_t)(t + 2) * kstep;
            const char* a3 = a2 + kstep; const char* b3 = b2 + kstep;
            if (last && has_next) S.a_ready(nxt);
            if constexpr (GATHER) { if (last && has_next) { asm volatile("" : "+v"(tk[0][0]), "+v"(tk[0][1]), "+v"(tk[1][0]), "+v"(tk[1][1]));
#pragma unroll
                for (int h = 0; h < 2; ++h)
#pragma unroll
                    for (int i = 0; i < 2; ++i) nOA[h][i] = S.a_base(nxt) + (unsigned)tk[h][i] * (unsigned)(K * 2) + colA[i]; } }
            if constexpr (SP2) {
            PG8_LDB(B0, 0, 0); PG8_LDB(B1, 0, 1); PG8_SCHED; PG8_LDA(At, 0, 0); PG8_STAGE2(PG8_SA(1, 1), a1, oA[1][0], oA[1][1]);
            PG8_WAIT_V(8); PG8_WAIT_L(0); PG8_BAR; PG8_MMA(0, 0, At, B0); PG8_MMA(0, 1, At, B1); PG8_BAR; PG8_SCHED;
            PG8_LDA(At, 0, 1); PG8_STAGE(PG8_SB(0, 0), b2, voffB); PG8_STAGE(PG8_SB(0, 1), b2 + hstep, voffB); PG8_STAGE2(PG8_SA(0, 0), a2, PG8_OSEL(0, 0), PG8_OSEL(0, 1));
            PG8_WAIT_V(8); if (pend >= 0) { S.done_signal(pend); pend = -1; }
            PG8_WAIT_L(0); PG8_BAR; PG8_MMA(1, 0, At, B0); PG8_MMA(1, 1, At, B1); PG8_BAR; PG8_SCHED;
            PG8_LDB(B0, 1, 0); PG8_LDB(B1, 1, 1); PG8_SCHED; PG8_LDA(At, 1, 0); PG8_STAGE2(PG8_SA(0, 1), a2, PG8_OSEL(1, 0), PG8_OSEL(1, 1));
            PG8_WAIT_V(8); PG8_WAIT_L(0); PG8_BAR; PG8_MMA(0, 0, At, B0); PG8_MMA(0, 1, At, B1); PG8_BAR; PG8_SCHED;
            PG8_LDA(At, 1, 1); PG8_STAGE(PG8_SB(1, 0), b3, voffB); PG8_STAGE(PG8_SB(1, 1), b3 + hstep, voffB); PG8_STAGE2(PG8_SA(1, 0), a3, PG8_OSEL(0, 0), PG8_OSEL(0, 1));
            PG8_WAIT_V(8); PG8_WAIT_L(0); PG8_BAR; PG8_MMA(1, 0, At, B0); PG8_MMA(1, 1, At, B1); PG8_BAR; PG8_SCHED;
            } else {
            PG8_LDB(B0, 0, 0); PG8_SCHED; PG8_LDA(At, 0, 0); PG8_STAGE(PG8_SA(1, 1), a1 + hstep, voffA);
            PG8_WAIT_L(8); PG8_BAR; PG8_WAIT_L(0); PG8_MMA(0, 0, At, B0); PG8_BAR; PG8_SCHED;
            PG8_LDB(B1, 0, 1); PG8_STAGE(PG8_SB(0, 0), b2, voffB);
            PG8_BAR; PG8_WAIT_L(0); PG8_MMA(0, 1, At, B1); PG8_BAR;
            PG8_LDA(At, 0, 1); PG8_STAGE(PG8_SA(0, 0), a2, voffA);
            PG8_BAR; PG8_WAIT_L(0); PG8_MMA(1, 0, At, B0); PG8_BAR; PG8_SCHED;
            PG8_STAGE(PG8_SB(0, 1), b2 + hstep, voffB);
            PG8_WAIT_V(6); PG8_BAR; PG8_MMA(1, 1, At, B1); PG8_BAR;
            PG8_LDB(B0, 1, 0); PG8_SCHED; PG8_LDA(At, 1, 0); PG8_STAGE(PG8_SA(0, 1), a2 + hstep, voffA);
            PG8_WAIT_L(8); PG8_BAR; PG8_WAIT_L(0); PG8_MMA(0, 0, At, B0); PG8_BAR; PG8_SCHED;
            PG8_LDB(B1, 1, 1); PG8_STAGE(PG8_SB(1, 0), b3, voffB);
            PG8_BAR; PG8_WAIT_L(0); PG8_MMA(0, 1, At, B1); PG8_BAR;
            PG8_LDA(At, 1, 1); PG8_STAGE(PG8_SA(1, 0), a3, voffA);
            PG8_BAR; PG8_WAIT_L(0); PG8_MMA(1, 0, At, B0); PG8_BAR; PG8_SCHED;
            PG8_STAGE(PG8_SB(1, 1), b3 + hstep, voffB);
            PG8_WAIT_V(6); PG8_BAR; PG8_MMA(1, 1, At, B1); PG8_BAR;
            }
        }
        if constexpr (FP8) asm volatile("s_nop 15\n\ts_nop 15" ::: "memory");
        if constexpr (ALIGN_EPI) { if (wr == 0) PG8_BAR; }
        if constexpr (!Epi::AFTER_DRAIN) { E(acc, cur, wr, wc, fr, fq); S.done(cur); pend = S.done_defer(cur); }
        if (!has_next) break;
#pragma unroll
        for (int a = 0; a < 2; ++a)
#pragma unroll
            for (int b = 0; b < 2; ++b)
#pragma unroll
                for (int m = 0; m < 4; ++m)
#pragma unroll
                    for (int n = 0; n < 2; ++n) acc[a][b][m][n] = (f32x4){0.f, 0.f, 0.f, 0.f};
        cur = nxt; cA = nA; cB = nB; ++ui;
        if constexpr (GATHER) {
#pragma unroll
            for (int h = 0; h < 2; ++h)
#pragma unroll
                for (int i = 0; i < 2; ++i) oA[h][i] = nOA[h][i];
        }
        if constexpr (ALIGN_EPI) { if (wr == 1) PG8_BAR; }
    }
    PG8_WAIT_V(0);
    if (pend >= 0) { S.done_signal(pend); pend = -1; }
    if constexpr (!ALIGN_EPI) { if (wr == 0) PG8_BAR; }
    PG8_BAR;
    if constexpr (Epi::AFTER_DRAIN) { E.fused(acc, cur, wr, wc, fr, fq, lds, wid, lane); S.done(cur); }
#undef PG8_SA
#undef PG8_OSEL
#undef PG8_STAGE2
#undef PG8_SB
#undef PG8_STAGE
#undef PG8_LDA
#undef PG8_LDB
#undef PG8_MMA
#undef PG8_WAIT_V
#undef PG8_WAIT_L
#undef PG8_BAR
#undef PG8_SCHED
}
}

#ifndef MK_N_LAUNCHES
#define MK_N_LAUNCHES 1
#endif
#ifndef PROBE_DUP
#define PROBE_DUP -1
#endif
#ifndef PROBE_STAMP
#define PROBE_STAMP -1
#endif
constexpr int N_PHASES = 10;
constexpr int NBATCH = 8, TT = 2048, MTOK = NBATCH * TT, D = 1024;
constexpr int HK = 512, NH = 4, DK = 128, DV = 128, CCH = 512, CLEN = 31, INC = 3584;
constexpr int NE = 32, TOPK = 4, FF = 1024;
constexpr float EPS = 1e-5f, SW_LIMIT = 7.0f, SW_ALPHA = 1.702f;
constexpr int NWAVES = 8, NTHR = 512;
constexpr int W1_ITEMS = 32 * 16 * 64, W1_P1 = 6144, W1_P2 = 20480, W1_P0 = W1_ITEMS - W1_P1 - W1_P2;
constexpr int W2_ITEMS = 32 * 16 * 32, W2_P7 = 4096, W2_P2 = W2_ITEMS - W2_P7;
constexpr int MOE_ROWS = (MTOK * TOPK / 256 + NE) * 256;

constexpr size_t MiB = 1u << 20;
constexpr size_t WS_CTL = 0, CTL_ZERO_BYTES = 1 * MiB;
constexpr size_t WS_WI = 1 * MiB;
constexpr size_t WS_WO = 8 * MiB;
constexpr size_t WS_TAB = 10 * MiB;
constexpr size_t WS_W1 = 16 * MiB;
constexpr size_t WS_W2 = 144 * MiB;
constexpr size_t WS_H = 208 * MiB;
constexpr size_t WS_XN = 272 * MiB;
constexpr size_t WS_Q = 304 * MiB, WS_KF = 320 * MiB, WS_KB = 336 * MiB, WS_V = 352 * MiB, WS_G = 368 * MiB, WS_U = 384 * MiB;
constexpr size_t WS_LF = 400 * MiB, WS_LB = 432 * MiB;
constexpr size_t WS_OF = 464 * MiB, WS_OB = 496 * MiB;
constexpr size_t WS_MIX = 528 * MiB;
constexpr size_t WS_XS = 304 * MiB;
constexpr size_t WS_ACT = 448 * MiB;
constexpr size_t WS_YS = 592 * MiB;
constexpr size_t WS_END = 736 * MiB;
constexpr size_t WS_WRT = WS_TAB;
constexpr size_t WS_SLOT = WS_TAB + 256 * 1024;
constexpr size_t WS_GATE = WS_TAB + 512 * 1024;
constexpr size_t WS_ROWTOK = WS_TAB + 1 * MiB;
constexpr int CW_BAR = 4096;
constexpr int CW_CNT = 16384;

constexpr int RING_OFF = 0, RING_BYTES = 131072;
constexpr int LDSCTL_OFF = 152576;
constexpr int MISC_OFF = LDSCTL_OFF + 320;
constexpr int TAB_OFF = LDSCTL_OFF + 1024;
constexpr int SB_OFF = LDSCTL_OFF + 2048;
constexpr int LDS_BYTES = 163840;

#define GAS __attribute__((address_space(1)))
#define LAS __attribute__((address_space(3)))
typedef unsigned short bf16;
typedef unsigned v4u __attribute__((ext_vector_type(4)));
typedef unsigned v2u __attribute__((ext_vector_type(2)));
typedef float f32x4 __attribute__((ext_vector_type(4)));
typedef GAS unsigned gu32;
#define RLX_AGENT __ATOMIC_RELAXED, __HIP_MEMORY_SCOPE_AGENT
#define LDS_WAIT() asm volatile("s_waitcnt lgkmcnt(0)" ::: "memory")
#define VM_WAIT() asm volatile("s_waitcnt vmcnt(0)" ::: "memory")

__device__ __forceinline__ float bf2f(unsigned b) { return __uint_as_float(b << 16); }
__device__ __forceinline__ unsigned pk2(float lo, float hi) { return pg8::cvt_pk_bf16(lo, hi); }
__device__ __forceinline__ float sigm(float x) { return __builtin_amdgcn_rcpf(1.0f + __expf(-x)); }
__device__ __forceinline__ float wave_sum(float v) {
#pragma unroll
    for (int o = 1; o < 64; o <<= 1) v += __shfl_xor(v, o);
    return v;
}

constexpr float SC_W = 512.f, SC_N2 = 16.f, SC_ACT = 8.f;
__device__ __forceinline__ unsigned pk4_fp8(float a, float b, float c, float d) {
    a = fminf(fmaxf(a, -448.f), 448.f); b = fminf(fmaxf(b, -448.f), 448.f); c = fminf(fmaxf(c, -448.f), 448.f); d = fminf(fmaxf(d, -448.f), 448.f);
    int w = 0; w = __builtin_amdgcn_cvt_pk_fp8_f32(a, b, w, false); w = __builtin_amdgcn_cvt_pk_fp8_f32(c, d, w, true); return (unsigned)w;
}

#define XB_TMO      128
#define XB_XCNT(j)  (256  + 64 * (j))
#define XB_XSUB(j)  (1280 + 64 * (j))
#define XB_XGEN(j)  (2304 + 64 * (j))
#define XB_TOP      3328
#define XB_TOPGEN   3392
#define XCD_BAR_WORDS 3456
#define XB_SPIN_CAP (1u << 18)

__device__ __forceinline__ unsigned xb_ld(unsigned* p)              { return __hip_atomic_load(p, __ATOMIC_RELAXED, __HIP_MEMORY_SCOPE_AGENT); }
__device__ __forceinline__ unsigned xb_add(unsigned* p, unsigned v) { return __hip_atomic_fetch_add(p, v, __ATOMIC_RELAXED, __HIP_MEMORY_SCOPE_AGENT); }
__device__ __forceinline__ unsigned xb_xcc_id() { return (unsigned)__builtin_amdgcn_s_getreg((3 << 11) | 20) & 0xFu; }
#define XB_SPIN(cond, bar) do { unsigned _sp = 0; while (cond) { __builtin_amdgcn_s_sleep(1); \
    if ((++_sp & 255u) == 0u) { if (xb_ld(&(bar)[XB_TMO])) break; if (_sp > XB_SPIN_CAP) { atomicAdd(&(bar)[XB_TMO], 1u); break; } } } } while (0)

struct XcdBarrier {
    unsigned* bar; unsigned x;
    volatile LAS unsigned* st;
};
__device__ __forceinline__ XcdBarrier xcd_barrier_post(unsigned* bar, volatile LAS unsigned* st) {
    XcdBarrier b; b.bar = bar; b.x = xb_xcc_id(); b.st = st;
    if (threadIdx.x == 0) (void)xb_add(&bar[XB_XCNT(b.x)], 1u);
    return b;
}
__device__ __forceinline__ void xcd_barrier_complete(unsigned* bar, unsigned x, unsigned& nloc, unsigned& nx) {
    const unsigned G = gridDim.x * gridDim.y * gridDim.z;
    unsigned sum, cnt, mine, sp = 0u;
    for (;;) {
        sum = 0u; cnt = 0u; mine = 0u;
#pragma unroll
        for (unsigned j = 0; j < 16; ++j) { const unsigned c = xb_ld(&bar[XB_XCNT(j)]); sum += c; cnt += (c > 0u) ? 1u : 0u; mine = (j == x) ? c : mine; }
        if (sum == G) break;
        __builtin_amdgcn_s_sleep(1);
        if ((++sp & 255u) == 0u) { if (xb_ld(&bar[XB_TMO])) break; if (sp > XB_SPIN_CAP) { atomicAdd(&bar[XB_TMO], 1u); break; } }
    }
    nloc = mine > 0u ? mine : 1u; nx = cnt > 0u ? cnt : 1u;
}
__device__ __forceinline__ void xcd_barrier(const XcdBarrier& b) {
    asm volatile("s_waitcnt vmcnt(0)" ::: "memory");
    __syncthreads();
    if (threadIdx.x == 0) {
        unsigned* bar = b.bar;
        __builtin_amdgcn_s_waitcnt(0);
        unsigned nloc = b.st[0], nx = b.st[1];
        if (nloc == 0u) { xcd_barrier_complete(bar, b.x, nloc, nx); b.st[0] = nloc; b.st[1] = nx; }
        const unsigned old = xb_add(&bar[XB_XSUB(b.x)], 1u);
        const unsigned gen = old / nloc;
        if (old + 1u == (gen + 1u) * nloc) {
            __builtin_amdgcn_fence(__ATOMIC_RELEASE, "agent");
            asm volatile("s_waitcnt vmcnt(0)" ::: "memory");
            const unsigned og = xb_add(&bar[XB_TOP], 1u);
            const unsigned tg = og / nx;
            if (og + 1u == (tg + 1u) * nx) xb_add(&bar[XB_TOPGEN], 1u);
            else XB_SPIN(xb_ld(&bar[XB_TOPGEN]) == tg, bar);
            __builtin_amdgcn_fence(__ATOMIC_ACQUIRE, "agent");
            xb_add(&bar[XB_XGEN(b.x)], 1u);
            asm volatile("s_waitcnt vmcnt(0)" ::: "memory");
        } else {
            XB_SPIN(xb_ld(&bar[XB_XGEN(b.x)]) == gen, bar);
            __builtin_amdgcn_fence(__ATOMIC_ACQUIRE, "agent");
            asm volatile("s_waitcnt vmcnt(0)" ::: "memory");
        }
    }
    __syncthreads();
}

#ifndef WT_STORES
#define WT_STORES 0
#endif
__device__ __forceinline__ void st16(void* p, v4u w) {
#if WT_STORES
    asm volatile("global_store_dwordx4 %0, %1, off sc0 sc1\n\ts_nop 1" :: "v"(p), "v"(w) : "memory");
#else
    *(v4u*)p = w;
#endif
}
__device__ __forceinline__ void st8(void* p, v2u w) {
#if WT_STORES
    asm volatile("global_store_dwordx2 %0, %1, off sc0 sc1\n\ts_nop 1" :: "v"(p), "v"(w) : "memory");
#else
    *(v2u*)p = w;
#endif
}
__device__ __forceinline__ void st8bf(bf16* p, const f32x4& a, const f32x4& b) {
    v4u w; w.x = pk2(a[0], a[1]); w.y = pk2(a[2], a[3]); w.z = pk2(b[0], b[1]); w.w = pk2(b[2], b[3]);
    st16(p, w);
}
struct EpiProj {
    static constexpr bool PERM = true, AFTER_DRAIN = false;
    bf16 *Q, *KF, *KB, *V, *G, *U; float *LF, *LB; const float* lbl;
    template <int TYP>
    __device__ __forceinline__ void tile(const pg8::f32x4 (&acc)[2][2][4][2], int row0, int cb) const {
#pragma unroll
        for (int bj = 0; bj < 2; ++bj) {
            const int col = cb + bj * 128;
            float lb[8];
            if (TYP == 1 || TYP == 2) {
                const float* L = lbl + (TYP - 1) * 1024 + col;
#pragma unroll
                for (int i = 0; i < 8; ++i) lb[i] = __builtin_amdgcn_rcpf(1.0f + __expf(L[512 + i] - L[i]));
            }
#pragma unroll
            for (int ai = 0; ai < 2; ++ai)
#pragma unroll
                for (int m = 0; m < 4; ++m) {
                    const size_t off = (size_t)(row0 + ai * 128 + m * 16) * 512 + col;
                    f32x4 a = acc[ai][bj][m][0], b = acc[ai][bj][m][1];
                    if (TYP == 0 || TYP == 4) {
#pragma unroll
                        for (int i = 0; i < 4; ++i) { a[i] = a[i] * sigm(a[i]); b[i] = b[i] * sigm(b[i]); }
                        st8bf((TYP == 0 ? Q : G) + off, a, b);
                    } else if (TYP == 3) {
                        st8bf(V + off, a, b);
                    } else {
                        f32x4 la, lbv, ka, kb;
#pragma unroll
                        for (int i = 0; i < 4; ++i) {
                            const float fa = lb[i] + (1.0f - lb[i]) * sigm(a[i]), fb = lb[4 + i] + (1.0f - lb[4 + i]) * sigm(b[i]);
                            la[i] = __logf(fa); lbv[i] = __logf(fb); ka[i] = 1.0f - fa; kb[i] = 1.0f - fb;
                        }
                        float* Lp = (TYP == 1 ? LF : LB) + off;
                        st16(Lp, (v4u)la); st16(Lp + 4, (v4u)lbv);
                        st8bf((TYP == 1 ? KF : KB) + off, ka, kb);
                    }
                }
        }
    }
    __device__ __forceinline__ void operator()(const pg8::f32x4 (&acc)[2][2][4][2], const pg8::Unit& u, int wr, int wc, int fr, int fq) const {
        const int row0 = u.pm * 256 + wr * 64 + fr, pn = u.pn;
        if (pn >= 10) {
            const int col = (pn - 10) * 128 + wc * 32 + 8 * fq;
#pragma unroll
            for (int ai = 0; ai < 2; ++ai)
#pragma unroll
                for (int m = 0; m < 4; ++m) {
                    f32x4 a = acc[ai][0][m][0], b = acc[ai][0][m][1]; const f32x4 ga = acc[ai][1][m][0], gb = acc[ai][1][m][1];
#pragma unroll
                    for (int i = 0; i < 4; ++i) { a[i] = a[i] * sigm(ga[i]); b[i] = b[i] * sigm(gb[i]); }
                    st8bf(U + (size_t)(row0 + ai * 128 + m * 16) * 512 + col, a, b);
                }
        } else {
            const int cb = (pn & 1) * 256 + wc * 32 + 8 * fq, typ = pn >> 1;
            if (typ == 0) tile<0>(acc, row0, cb);
            else if (typ == 1) tile<1>(acc, row0, cb);
            else if (typ == 2) tile<2>(acc, row0, cb);
            else if (typ == 3) tile<3>(acc, row0, cb);
            else tile<4>(acc, row0, cb);
        }
    }
};
struct EpiRes {
    static constexpr bool PERM = false, AFTER_DRAIN = false;
    const float* X; float* H;
    __device__ __forceinline__ void operator()(const pg8::f32x4 (&acc)[2][2][4][2], const pg8::Unit& u, int wr, int wc, int fr, int fq) const {
        const int row0 = u.pm * 256 + wr * 64 + fr, col0 = u.pn * 256 + wc * 32 + 4 * fq;
#pragma unroll
        for (int ai = 0; ai < 2; ++ai)
#pragma unroll
            for (int m = 0; m < 4; ++m) {
                const size_t off = (size_t)(row0 + ai * 128 + m * 16) * D + col0;
#pragma unroll
                for (int bj = 0; bj < 2; ++bj)
#pragma unroll
                    for (int n = 0; n < 2; ++n) { const f32x4 xv = *(const f32x4*)(X + off + bj * 128 + n * 16); st16(H + off + bj * 128 + n * 16, (v4u)(xv + acc[ai][bj][m][n])); }
            }
    }
};
struct EpiSwiglu {
    static constexpr bool PERM = true, AFTER_DRAIN = false;
    unsigned char* ACT; const float* b1;
    __device__ __forceinline__ void operator()(const pg8::f32x4 (&acc)[2][2][4][2], const pg8::Unit& u, int wr, int wc, int fr, int fq) const {
        const int e = u.pn >> 3, pn = u.pn & 7, row0 = u.pm * 256 + wr * 64 + fr, col = pn * 128 + wc * 32 + 8 * fq;
        const float* bg = b1 + (size_t)e * 2048 + col; const float* bl = bg + 1024;
        float g[8], l[8];
#pragma unroll
        for (int i = 0; i < 8; ++i) { g[i] = bg[i]; l[i] = bl[i]; }
#pragma unroll
        for (int ai = 0; ai < 2; ++ai)
#pragma unroll
            for (int m = 0; m < 4; ++m) {
                f32x4 o[2];
#pragma unroll
                for (int n = 0; n < 2; ++n)
#pragma unroll
                    for (int i = 0; i < 4; ++i) {
                        const float hg = fminf(acc[ai][0][m][n][i] * (1.0f / (SC_N2 * SC_W)) + g[4 * n + i], SW_LIMIT);
                        const float hl = fminf(fmaxf(acc[ai][1][m][n][i] * (1.0f / (SC_N2 * SC_W)) + l[4 * n + i], -SW_LIMIT), SW_LIMIT);
                        o[n][i] = hg * sigm(SW_ALPHA * hg) * (hl + 1.0f) * SC_ACT;
                    }
                v2u w; w.x = pk4_fp8(o[0][0], o[0][1], o[0][2], o[0][3]); w.y = pk4_fp8(o[1][0], o[1][1], o[1][2], o[1][3]);
#if defined(MOE_MERGED)
                asm volatile("global_store_dwordx2 %0, %1, off sc0 sc1\n\ts_nop 1" :: "v"(ACT + (size_t)(row0 + ai * 128 + m * 16) * FF + col), "v"(w) : "memory");
#else
                st8(ACT + (size_t)(row0 + ai * 128 + m * 16) * FF + col, w);
#endif
            }
    }
};
struct EpiDown {
    static constexpr bool PERM = true, AFTER_DRAIN = false;
    bf16* YS; const float* b2;
    __device__ __forceinline__ void operator()(const pg8::f32x4 (&acc)[2][2][4][2], const pg8::Unit& u, int wr, int wc, int fr, int fq) const {
        const int e = u.pn >> 2, pn = u.pn & 3, row0 = u.pm * 256 + wr * 64 + fr, col0 = pn * 256 + wc * 32 + 8 * fq;
#pragma unroll
        for (int bj = 0; bj < 2; ++bj) {
            const float* bp = b2 + (size_t)e * D + col0 + bj * 128;
            const f32x4 b0 = *(const f32x4*)bp, b1v = *(const f32x4*)(bp + 4);
#pragma unroll
            for (int ai = 0; ai < 2; ++ai)
#pragma unroll
                for (int m = 0; m < 4; ++m)
                    st8bf(YS + (size_t)(row0 + ai * 128 + m * 16) * D + col0 + bj * 128, acc[ai][bj][m][0] * (1.0f / (SC_ACT * SC_W)) + b0, acc[ai][bj][m][1] * (1.0f / (SC_ACT * SC_W)) + b1v);
        }
    }
};
struct MoeOrder {
    const volatile LAS int* bs; int ntn, G, v; const volatile LAS int* cl; const int* rowtok;
    __device__ __forceinline__ const int* a_list(const pg8::Unit& u) const { const int e = u.pn / ntn; return rowtok + e * MTOK + (u.pm - bs[e]) * 256; }
    __device__ __forceinline__ int a_valid(const pg8::Unit& u) const { const int e = u.pn / ntn; return min(256, cl[e] - (u.pm - bs[e]) * 256); }
    __device__ __forceinline__ bool next(int i, pg8::Unit& u) const {
        int L = i * G + v; const int nb = bs[32];
        if (L >= nb * ntn * (((PROBE_DUP) == 17 && ntn == 8) || ((PROBE_DUP) == 18 && ntn == 4) ? 2 : 1)) return false;
        if (L >= nb * ntn) L -= nb * ntn;
        const int mb = L / ntn, pn = L - mb * ntn;
        const int ln = (int)(threadIdx.x & 63);
        const int e = __popcll(__ballot(ln < NE - 1 && bs[ln + 1] <= mb));
        u.pm = mb; u.pn = e * ntn + pn; return true;
    }
    __device__ __forceinline__ bool a_is_list(const pg8::Unit&) const { return true; }
    __device__ __forceinline__ unsigned a_base(const pg8::Unit&) const { return 0u; }
    __device__ __forceinline__ int a_row0(const pg8::Unit&) const { return 0; }
    __device__ __forceinline__ void a_ready(const pg8::Unit&) const {}
    __device__ __forceinline__ void done(const pg8::Unit&) const {}
    __device__ __forceinline__ int done_defer(const pg8::Unit&) const { return -1; }
    __device__ __forceinline__ void done_signal(int) const {}
};
constexpr int CW_BLK = 32768;
struct MoeOrder2 {
    const volatile LAS int* bs; int G, v; const volatile LAS int* cl; const int* rowtok; unsigned* ctl;
    __device__ __forceinline__ bool is_down(const pg8::Unit& u) const { return u.pn >= 512; }
    __device__ __forceinline__ int expert(const pg8::Unit& u) const { return is_down(u) ? (u.pn - 512) >> 2 : u.pn >> 3; }
    __device__ __forceinline__ bool a_is_list(const pg8::Unit& u) const { return !is_down(u); }
    __device__ __forceinline__ unsigned a_base(const pg8::Unit& u) const { return is_down(u) ? (unsigned)WS_ACT : (unsigned)WS_XN; }
    __device__ __forceinline__ int a_row0(const pg8::Unit& u) const { return u.pm * 256; }
    __device__ __forceinline__ const int* a_list(const pg8::Unit& u) const { const int e = expert(u); return rowtok + e * MTOK + (u.pm - bs[e]) * 256; }
    __device__ __forceinline__ int a_valid(const pg8::Unit& u) const { const int e = expert(u); return min(256, cl[e] - (u.pm - bs[e]) * 256); }
    __device__ __forceinline__ bool next(int i, pg8::Unit& u) const {
        const int L = i * G + v, nb = bs[32];
        if (L >= nb * 12) return false;
        const bool dn = L >= nb * 8; const int L2 = dn ? L - nb * 8 : L, ntn = dn ? 4 : 8;
        const int mb = L2 / ntn, pn = L2 - mb * ntn;
        const int ln = (int)(threadIdx.x & 63);
        const int e = __popcll(__ballot(ln < NE - 1 && bs[ln + 1] <= mb));
        u.pm = mb; u.pn = (dn ? 512 : 0) + e * ntn + pn; return true;
    }
    __device__ __forceinline__ void a_ready(const pg8::Unit& u) const {
        if (!is_down(u)) return;
        if (threadIdx.x < 64) {
            const unsigned long long t0 = __builtin_amdgcn_s_memrealtime(); unsigned polls = 0;
            while ((unsigned)__builtin_amdgcn_readfirstlane(__hip_atomic_load(ctl + CW_BLK + 64 * u.pm, __ATOMIC_RELAXED, __HIP_MEMORY_SCOPE_AGENT)) < 64u) {
                if ((++polls & 255u) == 0u && __builtin_amdgcn_readfirstlane(__hip_atomic_load(ctl + 1, __ATOMIC_RELAXED, __HIP_MEMORY_SCOPE_AGENT)) != 0u) break;
                if (__builtin_amdgcn_s_memrealtime() - t0 > 2000000ull) { if (threadIdx.x == 0) __hip_atomic_store(ctl + 1, 1u, __ATOMIC_RELAXED, __HIP_MEMORY_SCOPE_AGENT); break; }
                __builtin_amdgcn_s_sleep(2); }
            __builtin_amdgcn_fence(__ATOMIC_ACQUIRE, "agent");
            asm volatile("s_waitcnt vmcnt(0)" ::: "memory");
        }
        asm volatile("" ::: "memory"); __builtin_amdgcn_s_barrier(); asm volatile("" ::: "memory");
    }
    __device__ __forceinline__ void done(const pg8::Unit&) const {}
    __device__ __forceinline__ int done_defer(const pg8::Unit& u) const { return is_down(u) ? -1 : u.pm; }
    __device__ __forceinline__ void done_signal(int mb) const { if ((threadIdx.x & 63) == 0) __hip_atomic_fetch_add(ctl + CW_BLK + 64 * mb, 1u, __ATOMIC_RELAXED, __HIP_MEMORY_SCOPE_AGENT); }
};
struct EpiMoe {
    static constexpr bool PERM = true, AFTER_DRAIN = false;
    EpiSwiglu up; EpiDown down;
    __device__ __forceinline__ void operator()(const pg8::f32x4 (&acc)[2][2][4][2], const pg8::Unit& u, int wr, int wc, int fr, int fq) const {
        if (u.pn >= 512) { pg8::Unit d; d.pm = u.pm; d.pn = u.pn - 512; down(acc, d, wr, wc, fr, fq); } else up(acc, u, wr, wc, fr, fq);
    }
};

#ifndef PROBE_DUP
#define PROBE_DUP -1
#endif
struct OrderRep : pg8::StaticOrder {
    int reps;
    __device__ __forceinline__ bool next(int i, pg8::Unit& u) const {
        const int per = (nwg + G - 1) / G, r = i / per;
        if (r >= reps) return false;
        return pg8::StaticOrder::next(i - r * per, u) ? true : ((r + 1 < reps) ? pg8::StaticOrder::next(0, u) : false);
    }
};
struct RmIdent { __device__ __forceinline__ int operator()(int n) const { return n; } };
struct RmWin {
    __device__ __forceinline__ int operator()(int n) const {
        if (n < 2560) return n;
        if (n < 3072) { const int j = n - 2560; return 2560 + (j >> 7) * 256 + (j & 127); }
        const int j = n - 3072; return 2560 + (j >> 7) * 256 + 128 + (j & 127);
    }
};
struct RmW1 {
    __device__ __forceinline__ int operator()(int n) const {
        if (n < 1024) return (n >> 7) * 256 + (n & 127);
        const int j = n - 1024; return (j >> 7) * 256 + 128 + (j & 127);
    }
};
__device__ __forceinline__ void p0_load(const float* W, int N, int item, int lane, f32x4 (&v)[8]) {
    const int nblk = N / 32, kb = item / nblk, nb = item % nblk, k0 = 64 * kb, n0 = 32 * nb;
    const int r8 = lane >> 3, c4 = lane & 7;
#pragma unroll
    for (int i = 0; i < 8; ++i) v[i] = *(const f32x4*)(W + (size_t)(k0 + 8 * i + r8) * N + n0 + 4 * c4);
}
template <bool FP8OUT, class RM>
__device__ __forceinline__ void p0_finish(const f32x4 (&v)[8], int K, int N, void* WTv, RM rm, LAS float* scr, int item, int lane) {
    const int nblk = N / 32, kb = item / nblk, nb = item % nblk, k0 = 64 * kb, n0 = 32 * nb;
    const int r8 = lane >> 3, c4 = lane & 7;
#pragma unroll
    for (int i = 0; i < 8; ++i) *(LAS f32x4*)(scr + (8 * i + r8) * 36 + 4 * c4) = v[i];
    LDS_WAIT(); asm volatile("" ::: "memory");
    const int n = lane & 31, kh = lane >> 5; const LAS float* s = scr + (32 * kh) * 36 + n;
    if constexpr (FP8OUT) {
        unsigned w[8];
#pragma unroll
        for (int j = 0; j < 8; ++j) w[j] = pk4_fp8(s[(4 * j) * 36] * SC_W, s[(4 * j + 1) * 36] * SC_W, s[(4 * j + 2) * 36] * SC_W, s[(4 * j + 3) * 36] * SC_W);
        GAS v4u* dst = (GAS v4u*)((unsigned char*)WTv + (size_t)rm(n0 + n) * K + k0 + 32 * kh);
        dst[0] = (v4u){w[0], w[1], w[2], w[3]}; dst[1] = (v4u){w[4], w[5], w[6], w[7]};
    } else {
        unsigned w[16];
#pragma unroll
        for (int j = 0; j < 16; ++j) w[j] = pk2(s[(2 * j) * 36], s[(2 * j + 1) * 36]);
        GAS v4u* dst = (GAS v4u*)((bf16*)WTv + (size_t)rm(n0 + n) * K + k0 + 32 * kh);
#pragma unroll
        for (int q = 0; q < 4; ++q) dst[q] = (v4u){w[4 * q], w[4 * q + 1], w[4 * q + 2], w[4 * q + 3]};
    }
    LDS_WAIT(); asm volatile("" ::: "memory");
}
template <bool FP8OUT, class RM>
__device__ __forceinline__ void p0_item(const float* W, int K, int N, void* WTv, RM rm, LAS float* scr, int item, int lane) {
    f32x4 v[8]; p0_load(W, N, item, lane, v); p0_finish<FP8OUT>(v, K, N, WTv, rm, scr, item, lane);
}
template <class RM>
__device__ __forceinline__ void convert_range_fp8(const float* W, int K, int N, unsigned char* WT, RM rm, int ipe_log2, int first, int stride, int count, int base, LAS float* scr, int lane) {
    const size_t esz = (size_t)K * N; const int mask = (1 << ipe_log2) - 1;
    f32x4 va[8], vb[8];
    int it = first;
    if (it < count) p0_load(W + (size_t)((base + it) >> ipe_log2) * esz, N, (base + it) & mask, lane, va);
    while (it < count) {
        const int i1 = it + stride, i2 = it + 2 * stride;
        if (i1 < count) p0_load(W + (size_t)((base + i1) >> ipe_log2) * esz, N, (base + i1) & mask, lane, vb);
        p0_finish<true>(va, K, N, WT + (size_t)((base + it) >> ipe_log2) * esz, rm, scr, (base + it) & mask, lane);
        if (i1 >= count) break;
        if (i2 < count) p0_load(W + (size_t)((base + i2) >> ipe_log2) * esz, N, (base + i2) & mask, lane, va);
        p0_finish<true>(vb, K, N, WT + (size_t)((base + i1) >> ipe_log2) * esz, rm, scr, (base + i1) & mask, lane);
        it = i2;
    }
}
__device__ __forceinline__ void rms_row_to_bf16(const float* xrow, const float* w, bf16* orow, int lane) {
    const f32x4* xr = (const f32x4*)xrow + lane; const f32x4* wr = (const f32x4*)w + lane;
    f32x4 v[4]; float s = 0.f;
#pragma unroll
    for (int j = 0; j < 4; ++j) { v[j] = xr[64 * j]; s += (v[j].x * v[j].x + v[j].y * v[j].y) + (v[j].z * v[j].z + v[j].w * v[j].w); }
    const float rstd = rsqrtf(wave_sum(s) * (1.f / D) + EPS);
    v2u* o8 = (v2u*)orow + lane;
#pragma unroll
    for (int j = 0; j < 4; ++j) { const f32x4 g = wr[64 * j]; v2u o; o.x = pk2(v[j].x * rstd * g.x, v[j].y * rstd * g.y); o.y = pk2(v[j].z * rstd * g.z, v[j].w * rstd * g.w); o8[64 * j] = o; }
}


__device__ __forceinline__ pg8::bf16x8 lds_frag(const LAS unsigned char* p) { return *(const LAS pg8::bf16x8*)p; }
__device__ __forceinline__ pg8::bf16x8 mk_frag(v2u a, v2u b) { const v4u w = (v4u){a.x, a.y, b.x, b.y}; return (pg8::bf16x8)w; }
#ifndef PROBE_TID
#define PROBE_TID 0
#endif
#define HG_PSTAMP(lds_, n_, code_) do { if ((PROBE_STAMP) >= 660 && (PROBE_STAMP) <= 669 && (n_) == 5 && threadIdx.x == (PROBE_TID)) { \
        if ((code_) == 660) *(volatile LAS unsigned long long*)((lds_) + LDSCTL_OFF + 640) = __builtin_amdgcn_s_memrealtime(); \
        if ((code_) == (PROBE_STAMP)) *(volatile LAS unsigned long long*)((lds_) + LDSCTL_OFF + 648) = __builtin_amdgcn_s_memrealtime(); } } while (0)
struct HgCtx {
    LAS unsigned char* lds; const bf16 *Qb, *Kp, *Vb; const float* Lp; float* Op;
    int b, h, dir, vh, lane, wave, lr, lq, dA, seg, tauB, dg;
    unsigned offA[16], offB, offV, ke_tr, v_tr;
};
constexpr int HG_BF = 0, HG_AM = 0, HG_QI = 33792, HG_KK = 51200, HG_KE = 68608, HG_V = 86016, HG_ST = 95232, HG_SEG = 112640, HG_DEC = 114688;
constexpr int HG_RSD = 272, HG_RSS = 144, HG_RSBF = 528;
__device__ __forceinline__ void hgrn_load(const HgCtx& c, int n, float (&lf)[16], v4u (&qB)[2], v4u (&kB)[2], v4u& vB) {
    const size_t cb = (size_t)__builtin_amdgcn_readfirstlane(c.b * TT + (c.dir ? (TT / 64 - 1 - n) * 64 : n * 64)) * 512 + c.h * 128;
    const float* Lc = c.Lp + cb; const bf16* Qc = c.Qb + cb; const bf16* Kc = c.Kp + cb; const bf16* Vc = c.Vb + cb;
#pragma unroll
    for (int i = 0; i < 16; ++i) lf[i] = Lc[c.offA[i]];
    qB[0] = *(const v4u*)(Qc + c.offB); qB[1] = *(const v4u*)(Qc + c.offB + 8); kB[0] = *(const v4u*)(Kc + c.offB); kB[1] = *(const v4u*)(Kc + c.offB + 8);
    vB = *(const v4u*)(Vc + c.offV);
}
__device__ __forceinline__ void hgrn_chunk(const HgCtx& c, int n, float (&lf)[16], v4u (&qB)[2], v4u (&kB)[2], v4u& vB, f32x4 (&S)[4]) {
    LAS unsigned char* lds = c.lds;
    const int dir = c.dir, lr = c.lr, lq = c.lq, wave = c.wave, dA = c.dA, seg = c.seg, tauB = c.tauB, dg = c.dg;
    const int tb = c.b * TT + (dir ? (TT / 64 - 1 - n) * 64 : n * 64); HG_PSTAMP(lds, n, 660);
    float bl[16]; { float cs = 0.f;
#pragma unroll
        for (int i = 0; i < 16; ++i) { cs += lf[i]; bl[i] = cs; }
        *(LAS float*)(lds + HG_SEG + (seg * 128 + dA) * 4) = cs; }
    __syncthreads();
    HG_PSTAMP(lds, n, 661);
    {
        const float p0 = *(LAS float*)(lds + HG_SEG + (0 * 128 + dA) * 4), p1 = *(LAS float*)(lds + HG_SEG + (1 * 128 + dA) * 4),
                    p2 = *(LAS float*)(lds + HG_SEG + (2 * 128 + dA) * 4), p3 = *(LAS float*)(lds + HG_SEG + (3 * 128 + dA) * 4);
        const float pre = (seg > 0 ? p0 : 0.f) + (seg > 1 ? p1 : 0.f) + (seg > 2 ? p2 : 0.f);
#pragma unroll
        for (int i = 0; i < 16; ++i) *(LAS float*)(lds + HG_BF + (16 * seg + i) * HG_RSBF + dA * 4) = pre + bl[i];
        if (seg == 0) *(LAS float*)(lds + HG_DEC + dA * 4) = __expf((p0 + p1) + (p2 + p3));
    }
    __syncthreads();
    HG_PSTAMP(lds, n, 662);
    {
        const unsigned qw[8] = {qB[0].x, qB[0].y, qB[0].z, qB[0].w, qB[1].x, qB[1].y, qB[1].z, qB[1].w};
        const unsigned kw[8] = {kB[0].x, kB[0].y, kB[0].z, kB[0].w, kB[1].x, kB[1].y, kB[1].z, kB[1].w};
        unsigned qo[8], ko[8], eo[8];
#pragma unroll
        for (int i = 0; i < 4; ++i) {
            const f32x4 bb = *(const LAS f32x4*)(lds + HG_BF + tauB * HG_RSBF + dg * 64 + i * 16);
            const f32x4 dc = *(const LAS f32x4*)(lds + HG_DEC + dg * 64 + i * 16);
#pragma unroll
            for (int j = 0; j < 2; ++j) {
                const float e0 = __expf(bb[2 * j]), e1 = __expf(bb[2 * j + 1]);
                const unsigned qq = qw[2 * i + j], kk = kw[2 * i + j];
                const float k0 = bf2f(kk & 0xffffu) * __builtin_amdgcn_rcpf(e0), k1 = bf2f(kk >> 16) * __builtin_amdgcn_rcpf(e1);
                qo[2 * i + j] = pk2(bf2f(qq & 0xffffu) * e0, bf2f(qq >> 16) * e1);
                ko[2 * i + j] = pk2(k0, k1);
                eo[2 * i + j] = pk2(k0 * dc[2 * j], k1 * dc[2 * j + 1]);
            }
        }
        *(LAS v4u*)(lds + HG_QI + tauB * HG_RSD + dg * 32) = (v4u){qo[0], qo[1], qo[2], qo[3]}; *(LAS v4u*)(lds + HG_QI + tauB * HG_RSD + dg * 32 + 16) = (v4u){qo[4], qo[5], qo[6], qo[7]};
        *(LAS v4u*)(lds + HG_KK + tauB * HG_RSD + dg * 32) = (v4u){ko[0], ko[1], ko[2], ko[3]}; *(LAS v4u*)(lds + HG_KK + tauB * HG_RSD + dg * 32 + 16) = (v4u){ko[4], ko[5], ko[6], ko[7]};
        *(LAS v4u*)(lds + HG_KE + tauB * HG_RSD + dg * 32) = (v4u){eo[0], eo[1], eo[2], eo[3]}; *(LAS v4u*)(lds + HG_KE + tauB * HG_RSD + dg * 32 + 16) = (v4u){eo[4], eo[5], eo[6], eo[7]};
        *(LAS v4u*)(lds + HG_V + tauB * HG_RSS + dg * 16) = vB;
    }
    __syncthreads();
    HG_PSTAMP(lds, n, 663);
    if (n + 2 < TT / 64) hgrn_load(c, n + 2, lf, qB, kB, vB);
    HG_PSTAMP(lds, n, 666);
    const int ei = wave & 3, tp = wave >> 2;
    v2u ket[2][2], vt[4][2][2];
    asm volatile("ds_read_b64_tr_b16 %0, %4\n\tds_read_b64_tr_b16 %1, %4 offset:1088\n\tds_read_b64_tr_b16 %2, %4 offset:8704\n\tds_read_b64_tr_b16 %3, %4 offset:9792"
                 : "=&v"(ket[0][0]), "=&v"(ket[0][1]), "=&v"(ket[1][0]), "=&v"(ket[1][1]) : "v"(c.ke_tr) : "memory");
#define HG_VTR(e4, o0, o1, o2, o3) asm volatile("ds_read_b64_tr_b16 %0, %4 offset:" #o0 "\n\tds_read_b64_tr_b16 %1, %4 offset:" #o1 "\n\tds_read_b64_tr_b16 %2, %4 offset:" #o2 "\n\tds_read_b64_tr_b16 %3, %4 offset:" #o3 \
                 : "=&v"(vt[e4][0][0]), "=&v"(vt[e4][0][1]), "=&v"(vt[e4][1][0]), "=&v"(vt[e4][1][1]) : "v"(c.v_tr) : "memory")
    HG_VTR(0, 0, 576, 4608, 5184); HG_VTR(1, 32, 608, 4640, 5216); HG_VTR(2, 64, 640, 4672, 5248); HG_VTR(3, 96, 672, 4704, 5280);
#undef HG_VTR
    {
        const int ti = wave & 3;
#pragma unroll
        for (int sii = 0; sii < 2; ++sii) {
            const int si = tp * 2 + sii;
            v2u w = (v2u){0u, 0u};
            if (si <= ti) {
                f32x4 a = (f32x4){0.f, 0.f, 0.f, 0.f};
#pragma unroll
                for (int kk = 0; kk < 4; ++kk)
                    a = __builtin_amdgcn_mfma_f32_16x16x32_bf16(lds_frag(lds + HG_KK + (16 * si + lr) * HG_RSD + kk * 64 + lq * 16), lds_frag(lds + HG_QI + (16 * ti + lr) * HG_RSD + kk * 64 + lq * 16), a, 0, 0, 0);
                const int s0 = 16 * si + 4 * lq, t = 16 * ti + lr;
                w.x = pk2(s0 + 0 <= t ? a[0] : 0.f, s0 + 1 <= t ? a[1] : 0.f); w.y = pk2(s0 + 2 <= t ? a[2] : 0.f, s0 + 3 <= t ? a[3] : 0.f);
            }
            *(LAS v2u*)(lds + HG_AM + (16 * ti + lr) * HG_RSS + (16 * si + 4 * lq) * 2) = w;
        }
    }
    f32x4 o[2];
#pragma unroll
    for (int tt = 0; tt < 2; ++tt) {
        o[tt] = (f32x4){0.f, 0.f, 0.f, 0.f};
#pragma unroll
        for (int kk = 0; kk < 4; ++kk)
            o[tt] = __builtin_amdgcn_mfma_f32_16x16x32_bf16(lds_frag(lds + HG_ST + (16 * ei + lr) * HG_RSD + kk * 64 + lq * 16), lds_frag(lds + HG_QI + (16 * (2 * tp + tt) + lr) * HG_RSD + kk * 64 + lq * 16), o[tt], 0, 0, 0);
    }
    HG_PSTAMP(lds, n, 667);
    asm volatile("s_waitcnt lgkmcnt(0)"
                 : "+v"(ket[0][0]), "+v"(ket[0][1]), "+v"(ket[1][0]), "+v"(ket[1][1]),
                   "+v"(vt[0][0][0]), "+v"(vt[0][0][1]), "+v"(vt[0][1][0]), "+v"(vt[0][1][1]), "+v"(vt[1][0][0]), "+v"(vt[1][0][1]), "+v"(vt[1][1][0]), "+v"(vt[1][1][1]),
                   "+v"(vt[2][0][0]), "+v"(vt[2][0][1]), "+v"(vt[2][1][0]), "+v"(vt[2][1][1]), "+v"(vt[3][0][0]), "+v"(vt[3][0][1]), "+v"(vt[3][1][0]), "+v"(vt[3][1][1]) :: "memory");
    {
        const f32x4 dv = *(const LAS f32x4*)(lds + HG_DEC + (16 * wave + 4 * lq) * 4);
#pragma unroll
        for (int e4 = 0; e4 < 4; ++e4) S[e4] = S[e4] * dv;
#pragma unroll
        for (int kk = 0; kk < 2; ++kk) {
            const pg8::bf16x8 af = mk_frag(ket[kk][0], ket[kk][1]);
#pragma unroll
            for (int e4 = 0; e4 < 4; ++e4) S[e4] = __builtin_amdgcn_mfma_f32_16x16x32_bf16(af, mk_frag(vt[e4][kk][0], vt[e4][kk][1]), S[e4], 0, 0, 0);
        }
    }
    HG_PSTAMP(lds, n, 668);
    const pg8::bf16x8 vf0 = ei == 0 ? mk_frag(vt[0][0][0], vt[0][0][1]) : ei == 1 ? mk_frag(vt[1][0][0], vt[1][0][1]) : ei == 2 ? mk_frag(vt[2][0][0], vt[2][0][1]) : mk_frag(vt[3][0][0], vt[3][0][1]);
    const pg8::bf16x8 vf1 = ei == 0 ? mk_frag(vt[0][1][0], vt[0][1][1]) : ei == 1 ? mk_frag(vt[1][1][0], vt[1][1][1]) : ei == 2 ? mk_frag(vt[2][1][0], vt[2][1][1]) : mk_frag(vt[3][1][0], vt[3][1][1]);
    __syncthreads();
    HG_PSTAMP(lds, n, 664);
#pragma unroll
    for (int tt = 0; tt < 2; ++tt) {
        o[tt] = __builtin_amdgcn_mfma_f32_16x16x32_bf16(vf0, lds_frag(lds + HG_AM + (16 * (2 * tp + tt) + lr) * HG_RSS + 0 * 64 + lq * 16), o[tt], 0, 0, 0);
        o[tt] = __builtin_amdgcn_mfma_f32_16x16x32_bf16(vf1, lds_frag(lds + HG_AM + (16 * (2 * tp + tt) + lr) * HG_RSS + 1 * 64 + lq * 16), o[tt], 0, 0, 0);
        const int t = 16 * (2 * tp + tt) + lr;
        *(f32x4*)(c.Op + (size_t)(dir ? tb + 63 - t : tb + t) * 512 + c.h * 128 + c.vh * 64 + 16 * ei + 4 * lq) = o[tt];
    }
#pragma unroll
    for (int e4 = 0; e4 < 4; ++e4) { v2u w; w.x = pk2(S[e4][0], S[e4][1]); w.y = pk2(S[e4][2], S[e4][3]); *(LAS v2u*)(lds + HG_ST + (16 * e4 + lr) * HG_RSD + (16 * wave + 4 * lq) * 2) = w; }
    HG_PSTAMP(lds, n, 665);
}
__device__ __forceinline__ void hgrn_unit(LAS unsigned char* lds, int unit, const bf16* Qb, const bf16* KFb, const bf16* KBb, const bf16* Vb, const float* LFb, const float* LBb,
                                          float* OFb, float* OBb, int tid, int lane, int wave) {
    HgCtx c;
    c.lds = lds; c.vh = unit & 1; c.dir = (unit >> 1) & 1; c.h = (unit >> 2) & 3; c.b = unit >> 4;
    c.Qb = Qb; c.Vb = Vb; c.Kp = c.dir ? KBb : KFb; c.Lp = c.dir ? LBb : LFb; c.Op = c.dir ? OBb : OFb;
    c.lane = lane; c.wave = wave; c.lr = lane & 15; c.lq = lane >> 4;
    c.dA = tid & 127; c.seg = tid >> 7;
    c.tauB = tid >> 3; c.dg = tid & 7;
    for (int i = tid; i < 64 * HG_RSD / 16; i += NTHR) *(LAS v4u*)(lds + HG_ST + i * 16) = (v4u){0u, 0u, 0u, 0u};
    f32x4 S[4];
#pragma unroll
    for (int i = 0; i < 4; ++i) S[i] = (f32x4){0.f, 0.f, 0.f, 0.f};
#pragma unroll
    for (int i = 0; i < 16; ++i) { const int tau = 16 * c.seg + i; c.offA[i] = (unsigned)((c.dir ? 63 - tau : tau) * 512 + c.dA); }
    c.offB = (unsigned)((c.dir ? 63 - c.tauB : c.tauB) * 512 + 16 * c.dg); c.offV = (unsigned)((c.dir ? 63 - c.tauB : c.tauB) * 512 + c.vh * 64 + 8 * c.dg);
    const unsigned trrow = (unsigned)(8 * c.lq + ((lane & 15) >> 2)), trcol = (unsigned)(4 * (lane & 3));
    c.ke_tr = (unsigned)(size_t)(lds + HG_KE) + trrow * HG_RSD + (16 * wave + trcol) * 2;
    c.v_tr = (unsigned)(size_t)(lds + HG_V) + trrow * HG_RSS + trcol * 2;
    float lf0[16], lf1[16]; v4u qB0[2], kB0[2], vB0, qB1[2], kB1[2], vB1;
    hgrn_load(c, 0, lf0, qB0, kB0, vB0); hgrn_load(c, 1, lf1, qB1, kB1, vB1);
#pragma unroll 1
    for (int n = 0; n < TT / 64; n += 2) { hgrn_chunk(c, n, lf0, qB0, kB0, vB0, S); hgrn_chunk(c, n + 1, lf1, qB1, kB1, vB1, S); }
    __syncthreads();
}

__device__ __forceinline__ void router_finish(float (&a)[NE], int m, int lane, const float* router_b, LAS int* lcnt, LAS unsigned* sbw, float* GATE) {
#define RF_STEP(s2, n) { const bool up = (lane & (s2)) != 0; _Pragma("unroll") for (int i = 0; i < (n); ++i) { const float k1 = up ? a[i + (n)] : a[i], x1 = up ? a[i] : a[i + (n)]; a[i] = k1 + __shfl_xor(x1, (s2)); } }
    RF_STEP(32, 16) RF_STEP(16, 8) RF_STEP(8, 4) RF_STEP(4, 2) RF_STEP(2, 1)
#undef RF_STEP
    float lg = a[0] + __shfl_xor(a[0], 1);
    const int myE = lane >> 1;
    lg += router_b[myE];
    float tv[TOPK]; int ti[TOPK];
#pragma unroll
    for (int k = 0; k < TOPK; ++k) {
        float mx = lg;
#pragma unroll
        for (int o = 1; o < 64; o <<= 1) mx = fmaxf(mx, __shfl_xor(mx, o));
        int cand = (lg == mx) ? myE : 99;
#pragma unroll
        for (int o = 1; o < 64; o <<= 1) cand = min(cand, __shfl_xor(cand, o));
        tv[k] = mx; ti[k] = cand;
        if (myE == cand) lg = -INFINITY;
    }
    const float e1 = __expf(tv[1] - tv[0]), e2 = __expf(tv[2] - tv[0]), e3 = __expf(tv[3] - tv[0]);
    const float inv = 1.0f / (1.0f + e1 + e2 + e3);
    if (lane < TOPK && m < MTOK) {
        const int ek = lane == 0 ? ti[0] : lane == 1 ? ti[1] : lane == 2 ? ti[2] : ti[3];
        const float gk = (lane == 0 ? 1.0f : lane == 1 ? e1 : lane == 2 ? e2 : e3) * inv;
        const int lr = __hip_atomic_fetch_add(&lcnt[ek], 1, __ATOMIC_RELAXED, __HIP_MEMORY_SCOPE_WORKGROUP);
        sbw[lane] = ((unsigned)ek << 16) | (unsigned)lr;
        GATE[(size_t)m * TOPK + lane] = gk;
    }
}

#ifndef PROBE_DELAY
#define PROBE_DELAY 0
#endif
__device__ __forceinline__ void probe_delay(int us100) { const unsigned long long t0 = __builtin_amdgcn_s_memrealtime(); while (__builtin_amdgcn_s_memrealtime() - t0 < (unsigned long long)us100) __builtin_amdgcn_s_sleep(2); }
constexpr int H3_QI = 0, H3_KK = 34816, H3_V = 69632, H3_DEC = 88064, H3_ST = 89088, H3_AM = 106496, H3_LH = 115712, H3_LL = 133120, H3_END = 150528;
constexpr int H3_BUFD = 17408, H3_BUFV = 9216, H3_BUFDEC = 512;
static_assert(H3_END <= LDSCTL_OFF, "recurrence LDS image below the control words");
struct Hg3 {
    LAS unsigned char* lds; const bf16 *Qb, *Kp, *Vb; const float* Lp; float* Op;
    int b, h, dir, vh, lane, lr, lq;
};
__device__ __forceinline__ size_t hg3_row(const Hg3& c, int n, int t) {
    const int tb = c.b * TT + (c.dir ? (TT / 64 - 1 - n) * 64 : n * 64);
    return (size_t)(c.dir ? tb + 63 - t : tb + t) * 512 + c.h * 128;
}
struct Hg3LV { f32x4 lf[8]; v4u v[2]; };
struct Hg3QK { v2u q[2][4], k[2][4]; };
__device__ __forceinline__ void gld16(f32x4& d, const void* p) { asm volatile("global_load_dwordx4 %0, %1, off" : "=v"(d) : "v"(p) : "memory"); }
__device__ __forceinline__ void gld16u(v4u& d, const void* p) { asm volatile("global_load_dwordx4 %0, %1, off" : "=v"(d) : "v"(p) : "memory"); }
__device__ __forceinline__ void gld8(v2u& d, const void* p) { asm volatile("global_load_dwordx2 %0, %1, off" : "=v"(d) : "v"(p) : "memory"); }
__device__ __forceinline__ void hg3_load_lv(const Hg3& c, int n, int pt, Hg3LV& in) {
    const size_t r = hg3_row(c, n, pt >> 2);
#pragma unroll
    for (int i = 0; i < 8; ++i) gld16(in.lf[i], c.Lp + r + 32 * (pt & 3) + 4 * i);
    gld16u(in.v[0], c.Vb + r + c.vh * 64 + 16 * (pt & 3)); gld16u(in.v[1], c.Vb + r + c.vh * 64 + 16 * (pt & 3) + 8);
}
__device__ __forceinline__ void hg3_load_qk(const Hg3& c, int n, int pw, Hg3QK& in) {
#pragma unroll
    for (int ti = 0; ti < 4; ++ti) { const size_t r = hg3_row(c, n, 16 * ti + c.lr);
#pragma unroll
        for (int dt = 0; dt < 2; ++dt) { const int d0 = 16 * (2 * pw + dt) + 4 * c.lq; gld8(in.q[dt][ti], c.Qb + r + d0); gld8(in.k[dt][ti], c.Kp + r + d0); } }
}
#define H3_USE_LV(x) asm volatile("" : "+v"((x).lf[0]), "+v"((x).lf[1]), "+v"((x).lf[2]), "+v"((x).lf[3]), "+v"((x).lf[4]), "+v"((x).lf[5]), "+v"((x).lf[6]), "+v"((x).lf[7]), "+v"((x).v[0]), "+v"((x).v[1]))
#define H3_USE_QK(x) asm volatile("" : "+v"((x).q[0][0]), "+v"((x).q[0][1]), "+v"((x).q[0][2]), "+v"((x).q[0][3]), "+v"((x).q[1][0]), "+v"((x).q[1][1]), "+v"((x).q[1][2]), "+v"((x).q[1][3]), \
                                           "+v"((x).k[0][0]), "+v"((x).k[0][1]), "+v"((x).k[0][2]), "+v"((x).k[0][3]), "+v"((x).k[1][0]), "+v"((x).k[1][1]), "+v"((x).k[1][2]), "+v"((x).k[1][3]))
__device__ __forceinline__ unsigned hg3_hi_lo(float x, float y, unsigned& lo) {
    const unsigned hi = pk2(x, y);
    lo = pk2(x - bf2f(hi & 0xffffu), y - bf2f(hi >> 16));
    return hi;
}
__device__ __forceinline__ void hg3_prep_a(const Hg3& c, int buf, int pt, const Hg3LV& in) {
    const int t = pt >> 2, dq = pt & 3;
#pragma unroll
    for (int i = 0; i < 8; ++i) { unsigned l0, l1; const unsigned h0 = hg3_hi_lo(in.lf[i].x, in.lf[i].y, l0), h1 = hg3_hi_lo(in.lf[i].z, in.lf[i].w, l1);
        *(LAS v2u*)(c.lds + H3_LH + t * 272 + (32 * dq + 4 * i) * 2) = (v2u){h0, h1}; *(LAS v2u*)(c.lds + H3_LL + t * 272 + (32 * dq + 4 * i) * 2) = (v2u){l0, l1}; }
    *(LAS v4u*)(c.lds + H3_V + buf * H3_BUFV + t * 144 + dq * 32) = in.v[0]; *(LAS v4u*)(c.lds + H3_V + buf * H3_BUFV + t * 144 + dq * 32 + 16) = in.v[1];
}
__device__ __forceinline__ void hg3_prep_b(const Hg3& c, int buf, int pw, const Hg3QK& in, const pg8::bf16x8 (&U)[4]) {
    LAS unsigned char* lds = c.lds; const int lr = c.lr, lq = c.lq, lane = c.lane;
    const unsigned trrow = (unsigned)(8 * lq + ((lane & 15) >> 2)), trcol = (unsigned)(4 * (lane & 3));
    const pg8::bf16x8 ones = (pg8::bf16x8)(v4u){0x3F803F80u, 0x3F803F80u, 0x3F803F80u, 0x3F803F80u};
#pragma unroll
    for (int dt = 0; dt < 2; ++dt) {
        const int dtile = 2 * pw + dt;
        v2u fh[2][2], fl[2][2];
        const unsigned ah = (unsigned)(size_t)(lds + H3_LH) + trrow * 272 + (16 * dtile + trcol) * 2, al = ah + (H3_LL - H3_LH);
        asm volatile("ds_read_b64_tr_b16 %0, %8\n\tds_read_b64_tr_b16 %1, %8 offset:1088\n\tds_read_b64_tr_b16 %2, %8 offset:8704\n\tds_read_b64_tr_b16 %3, %8 offset:9792\n\t"
                     "ds_read_b64_tr_b16 %4, %9\n\tds_read_b64_tr_b16 %5, %9 offset:1088\n\tds_read_b64_tr_b16 %6, %9 offset:8704\n\tds_read_b64_tr_b16 %7, %9 offset:9792\n\ts_waitcnt lgkmcnt(0)"
                     : "=&v"(fh[0][0]), "=&v"(fh[0][1]), "=&v"(fh[1][0]), "=&v"(fh[1][1]), "=&v"(fl[0][0]), "=&v"(fl[0][1]), "=&v"(fl[1][0]), "=&v"(fl[1][1]) : "v"(ah), "v"(al) : "memory");
        const pg8::bf16x8 H0 = mk_frag(fh[0][0], fh[0][1]), H1 = mk_frag(fh[1][0], fh[1][1]), L0 = mk_frag(fl[0][0], fl[0][1]), L1 = mk_frag(fl[1][0], fl[1][1]);
        f32x4 bt[4];
        const f32x4 z = (f32x4){0.f, 0.f, 0.f, 0.f};
        bt[0] = __builtin_amdgcn_mfma_f32_16x16x32_bf16(L0, U[0], z, 0, 0, 0);    bt[0] = __builtin_amdgcn_mfma_f32_16x16x32_bf16(H0, U[0], bt[0], 0, 0, 0);
        bt[1] = __builtin_amdgcn_mfma_f32_16x16x32_bf16(L0, U[1], z, 0, 0, 0);    bt[1] = __builtin_amdgcn_mfma_f32_16x16x32_bf16(H0, U[1], bt[1], 0, 0, 0);
        bt[2] = __builtin_amdgcn_mfma_f32_16x16x32_bf16(L0, ones, z, 0, 0, 0);    bt[2] = __builtin_amdgcn_mfma_f32_16x16x32_bf16(L1, U[2], bt[2], 0, 0, 0);
        bt[2] = __builtin_amdgcn_mfma_f32_16x16x32_bf16(H0, ones, bt[2], 0, 0, 0); bt[2] = __builtin_amdgcn_mfma_f32_16x16x32_bf16(H1, U[2], bt[2], 0, 0, 0);
        bt[3] = __builtin_amdgcn_mfma_f32_16x16x32_bf16(L0, ones, z, 0, 0, 0);    bt[3] = __builtin_amdgcn_mfma_f32_16x16x32_bf16(L1, U[3], bt[3], 0, 0, 0);
        bt[3] = __builtin_amdgcn_mfma_f32_16x16x32_bf16(H0, ones, bt[3], 0, 0, 0); bt[3] = __builtin_amdgcn_mfma_f32_16x16x32_bf16(H1, U[3], bt[3], 0, 0, 0);
        f32x4 de;
#pragma unroll
        for (int r = 0; r < 4; ++r) de[r] = __expf(__shfl(bt[3][r], 16 * lq + 15));
        if (lr == 0) *(LAS f32x4*)(lds + H3_DEC + buf * H3_BUFDEC + (16 * dtile + 4 * lq) * 4) = de;
#pragma unroll
        for (int ti = 0; ti < 4; ++ti) {
            const v2u qq = in.q[dt][ti], kk = in.k[dt][ti];
            const float e0 = __expf(bt[ti][0]), e1 = __expf(bt[ti][1]), e2 = __expf(bt[ti][2]), e3 = __expf(bt[ti][3]);
            v2u qo, ko;
            qo.x = pk2(bf2f(qq.x & 0xffffu) * e0, bf2f(qq.x >> 16) * e1); qo.y = pk2(bf2f(qq.y & 0xffffu) * e2, bf2f(qq.y >> 16) * e3);
            ko.x = pk2(bf2f(kk.x & 0xffffu) * __builtin_amdgcn_rcpf(e0), bf2f(kk.x >> 16) * __builtin_amdgcn_rcpf(e1));
            ko.y = pk2(bf2f(kk.y & 0xffffu) * __builtin_amdgcn_rcpf(e2), bf2f(kk.y >> 16) * __builtin_amdgcn_rcpf(e3));
            const int off = (16 * ti + lr) * 272 + (16 * dtile + 4 * lq) * 2;
            *(LAS v2u*)(lds + H3_QI + buf * H3_BUFD + off) = qo; *(LAS v2u*)(lds + H3_KK + buf * H3_BUFD + off) = ko;
        }
    }
}
__device__ __forceinline__ void hg3_stage1(const Hg3& c, int buf, int mw, f32x4 (&S)[2][4], f32x4 (&o)[2][2], v2u (&vt)[4][2][2]) {
    LAS unsigned char* lds = c.lds; const int lr = c.lr, lq = c.lq, lane = c.lane;
    const LAS unsigned char* QI = lds + H3_QI + buf * H3_BUFD; const LAS unsigned char* KK = lds + H3_KK + buf * H3_BUFD;
    const unsigned trrow = (unsigned)(8 * lq + ((lane & 15) >> 2)), trcol = (unsigned)(4 * (lane & 3));
    const unsigned kk_tr = (unsigned)(size_t)KK + trrow * 272 + (32 * mw + trcol) * 2;
    const unsigned v_tr = (unsigned)(size_t)(lds + H3_V + buf * H3_BUFV) + trrow * 144 + trcol * 2;
    const int tp = mw >> 1, ep = mw & 1;
    pg8::bf16x8 qf[2][4], sf[2][4], kf[3][4];
#pragma unroll
    for (int bq = 0; bq < 2; ++bq)
#pragma unroll
        for (int kk = 0; kk < 4; ++kk) { qf[bq][kk] = lds_frag(QI + (16 * (2 * tp + bq) + lr) * 272 + kk * 64 + lq * 16); sf[bq][kk] = lds_frag(lds + H3_ST + (16 * (2 * ep + bq) + lr) * 272 + kk * 64 + lq * 16); }
#pragma unroll
    for (int a = 0; a < 2; ++a)
#pragma unroll
        for (int bq = 0; bq < 2; ++bq) o[a][bq] = (f32x4){0.f, 0.f, 0.f, 0.f};
#pragma unroll
    for (int kk = 0; kk < 4; ++kk) {
        o[0][0] = __builtin_amdgcn_mfma_f32_16x16x32_bf16(sf[0][kk], qf[0][kk], o[0][0], 0, 0, 0); o[0][1] = __builtin_amdgcn_mfma_f32_16x16x32_bf16(sf[0][kk], qf[1][kk], o[0][1], 0, 0, 0);
        o[1][0] = __builtin_amdgcn_mfma_f32_16x16x32_bf16(sf[1][kk], qf[0][kk], o[1][0], 0, 0, 0); o[1][1] = __builtin_amdgcn_mfma_f32_16x16x32_bf16(sf[1][kk], qf[1][kk], o[1][1], 0, 0, 0);
    }
    __builtin_amdgcn_sched_barrier(0);
    const int ks0 = mw == 3 ? 1 : 0;
    if (mw != 1) {
#pragma unroll
        for (int x = 0; x < 3; ++x)
#pragma unroll
            for (int kk = 0; kk < 4; ++kk) kf[x][kk] = lds_frag(KK + (16 * (ks0 + x) + lr) * 272 + kk * 64 + lq * 16);
    }
    v2u kt[2][2][2];
    {
        f32x4 at[4];
#pragma unroll
        for (int i = 0; i < 4; ++i) at[i] = (f32x4){0.f, 0.f, 0.f, 0.f};
        if (mw != 1) {
#pragma unroll
            for (int kk = 0; kk < 4; ++kk) {
                at[0] = __builtin_amdgcn_mfma_f32_16x16x32_bf16(kf[0][kk], mw == 3 ? qf[1][kk] : qf[0][kk], at[0], 0, 0, 0);
                at[1] = __builtin_amdgcn_mfma_f32_16x16x32_bf16(mw == 0 ? kf[0][kk] : kf[1][kk], mw == 2 ? qf[0][kk] : qf[1][kk], at[1], 0, 0, 0);
                at[2] = __builtin_amdgcn_mfma_f32_16x16x32_bf16(mw == 0 ? kf[1][kk] : kf[2][kk], mw == 2 ? qf[0][kk] : qf[1][kk], at[2], 0, 0, 0);
                if (mw == 2) at[3] = __builtin_amdgcn_mfma_f32_16x16x32_bf16(kf[0][kk], qf[1][kk], at[3], 0, 0, 0);
            }
        }
    asm volatile("ds_read_b64_tr_b16 %0, %8\n\tds_read_b64_tr_b16 %1, %8 offset:1088\n\tds_read_b64_tr_b16 %2, %8 offset:8704\n\tds_read_b64_tr_b16 %3, %8 offset:9792\n\t"
                 "ds_read_b64_tr_b16 %4, %8 offset:32\n\tds_read_b64_tr_b16 %5, %8 offset:1120\n\tds_read_b64_tr_b16 %6, %8 offset:8736\n\tds_read_b64_tr_b16 %7, %8 offset:9824"
                 : "=&v"(kt[0][0][0]), "=&v"(kt[0][0][1]), "=&v"(kt[0][1][0]), "=&v"(kt[0][1][1]), "=&v"(kt[1][0][0]), "=&v"(kt[1][0][1]), "=&v"(kt[1][1][0]), "=&v"(kt[1][1][1]) : "v"(kk_tr) : "memory");
#define H3_VTR(e4, o0, o1, o2, o3) asm volatile("ds_read_b64_tr_b16 %0, %4 offset:" #o0 "\n\tds_read_b64_tr_b16 %1, %4 offset:" #o1 "\n\tds_read_b64_tr_b16 %2, %4 offset:" #o2 "\n\tds_read_b64_tr_b16 %3, %4 offset:" #o3 \
                 : "=&v"(vt[e4][0][0]), "=&v"(vt[e4][0][1]), "=&v"(vt[e4][1][0]), "=&v"(vt[e4][1][1]) : "v"(v_tr) : "memory")
    H3_VTR(0, 0, 576, 4608, 5184); H3_VTR(1, 32, 608, 4640, 5216); H3_VTR(2, 64, 640, 4672, 5248); H3_VTR(3, 96, 672, 4704, 5280);
#undef H3_VTR
#pragma unroll
        for (int i = 0; i < 4; ++i) {
            int si, ti; bool have = true, zero = false;
            if (mw == 0) { si = i == 2 ? 1 : 0; ti = i == 0 ? 0 : 1; have = i < 3; }
            else if (mw == 1) { si = 1; ti = 0; have = i == 0; zero = true; }
            else if (mw == 2) { si = i == 3 ? 0 : i; ti = i == 3 ? 3 : 2; }
            else { si = i == 3 ? 3 : i + 1; ti = i == 3 ? 2 : 3; zero = i == 3; }
            if (have) {
                const int s0 = 16 * si + 4 * lq, t = 16 * ti + lr; v2u w = (v2u){0u, 0u};
                if (!zero) { w.x = pk2(s0 + 0 <= t ? at[i][0] : 0.f, s0 + 1 <= t ? at[i][1] : 0.f); w.y = pk2(s0 + 2 <= t ? at[i][2] : 0.f, s0 + 3 <= t ? at[i][3] : 0.f); }
                *(LAS v2u*)(lds + H3_AM + (16 * ti + lr) * 144 + (16 * si + 4 * lq) * 2) = w;
            }
        }
    }
    asm volatile("s_waitcnt lgkmcnt(0)"
                 : "+v"(kt[0][0][0]), "+v"(kt[0][0][1]), "+v"(kt[0][1][0]), "+v"(kt[0][1][1]), "+v"(kt[1][0][0]), "+v"(kt[1][0][1]), "+v"(kt[1][1][0]), "+v"(kt[1][1][1]),
                   "+v"(vt[0][0][0]), "+v"(vt[0][0][1]), "+v"(vt[0][1][0]), "+v"(vt[0][1][1]), "+v"(vt[1][0][0]), "+v"(vt[1][0][1]), "+v"(vt[1][1][0]), "+v"(vt[1][1][1]),
                   "+v"(vt[2][0][0]), "+v"(vt[2][0][1]), "+v"(vt[2][1][0]), "+v"(vt[2][1][1]), "+v"(vt[3][0][0]), "+v"(vt[3][0][1]), "+v"(vt[3][1][0]), "+v"(vt[3][1][1]) :: "memory");
#pragma unroll
    for (int dt = 0; dt < 2; ++dt) {
#pragma unroll
        for (int kk = 0; kk < 2; ++kk) {
            const pg8::bf16x8 af = mk_frag(kt[dt][kk][0], kt[dt][kk][1]);
#pragma unroll
            for (int e4 = 0; e4 < 4; ++e4) S[dt][e4] = __builtin_amdgcn_mfma_f32_16x16x32_bf16(af, mk_frag(vt[e4][kk][0], vt[e4][kk][1]), S[dt][e4], 0, 0, 0);
        }
        const f32x4 dv = *(const LAS f32x4*)(lds + H3_DEC + buf * H3_BUFDEC + (16 * (2 * mw + dt) + 4 * lq) * 4);
#pragma unroll
        for (int e4 = 0; e4 < 4; ++e4) S[dt][e4] = S[dt][e4] * dv;
    }
}
__device__ __forceinline__ void hg3_stage2(const Hg3& c, int n, int mw, const f32x4 (&S)[2][4], f32x4 (&o)[2][2], const v2u (&vt)[4][2][2]) {
    LAS unsigned char* lds = c.lds; const int lr = c.lr, lq = c.lq;
#pragma unroll
    for (int bq = 0; bq < 2; ++bq) {
        const int ti = 2 * (mw >> 1) + bq;
        const pg8::bf16x8 a0 = lds_frag(lds + H3_AM + (16 * ti + lr) * 144 + 0 * 64 + lq * 16);
#pragma unroll
        for (int a = 0; a < 2; ++a) { const int e4 = 2 * (mw & 1) + a;
            const pg8::bf16x8 vf = e4 == 0 ? mk_frag(vt[0][0][0], vt[0][0][1]) : e4 == 1 ? mk_frag(vt[1][0][0], vt[1][0][1]) : e4 == 2 ? mk_frag(vt[2][0][0], vt[2][0][1]) : mk_frag(vt[3][0][0], vt[3][0][1]);
            o[a][bq] = __builtin_amdgcn_mfma_f32_16x16x32_bf16(vf, a0, o[a][bq], 0, 0, 0); }
        if (mw >> 1) {
            const pg8::bf16x8 a1 = lds_frag(lds + H3_AM + (16 * ti + lr) * 144 + 1 * 64 + lq * 16);
#pragma unroll
            for (int a = 0; a < 2; ++a) { const int e4 = 2 * (mw & 1) + a;
                const pg8::bf16x8 vf = e4 == 0 ? mk_frag(vt[0][1][0], vt[0][1][1]) : e4 == 1 ? mk_frag(vt[1][1][0], vt[1][1][1]) : e4 == 2 ? mk_frag(vt[2][1][0], vt[2][1][1]) : mk_frag(vt[3][1][0], vt[3][1][1]);
                o[a][bq] = __builtin_amdgcn_mfma_f32_16x16x32_bf16(vf, a1, o[a][bq], 0, 0, 0); }
        }
#pragma unroll
        for (int a = 0; a < 2; ++a)
            *(f32x4*)(c.Op + hg3_row(c, n, 16 * ti + lr) + c.vh * 64 + 16 * (2 * (mw & 1) + a) + 4 * lq) = o[a][bq];
    }
#pragma unroll
    for (int dt = 0; dt < 2; ++dt)
#pragma unroll
        for (int e4 = 0; e4 < 4; ++e4) { v2u w; w.x = pk2(S[dt][e4][0], S[dt][e4][1]); w.y = pk2(S[dt][e4][2], S[dt][e4][3]);
            *(LAS v2u*)(lds + H3_ST + (16 * e4 + lr) * 272 + (16 * (2 * mw + dt) + 4 * lq) * 2) = w; }
}
__device__ __forceinline__ void hgrn3_unit(LAS unsigned char* lds, int unit, const bf16* Qb, const bf16* KFb, const bf16* KBb, const bf16* Vb, const float* LFb, const float* LBb,
                                           float* OFb, float* OBb, int tid, int lane, int wave) {
    Hg3 c;
    c.lds = lds; c.vh = unit & 1; c.dir = (unit >> 1) & 1; c.h = (unit >> 2) & 3; c.b = unit >> 4;
    c.Qb = Qb; c.Vb = Vb; c.Kp = c.dir ? KBb : KFb; c.Lp = c.dir ? LBb : LFb; c.Op = c.dir ? OBb : OFb;
    c.lane = lane; c.lr = lane & 15; c.lq = lane >> 4;
    constexpr int NCH = TT / 64;
    for (int i = tid; i < 64 * 272 / 16; i += NTHR) *(LAS v4u*)(lds + H3_ST + i * 16) = (v4u){0u, 0u, 0u, 0u};
    if (wave < 4) {
        const int pt = tid, pw = wave;
        pg8::bf16x8 U[4];
#pragma unroll
        for (int u = 0; u < 4; ++u) { const int kk = u >> 1, ti = u; unsigned wv[4];
#pragma unroll
            for (int j2 = 0; j2 < 4; ++j2) { const int s = 32 * kk + 8 * c.lq + 2 * j2, t = 16 * ti + c.lr; wv[j2] = (s <= t ? 0x3F80u : 0u) | (s + 1 <= t ? 0x3F800000u : 0u); }
            U[u] = (pg8::bf16x8)(v4u){wv[0], wv[1], wv[2], wv[3]}; }
        Hg3LV lv0, lv1; Hg3QK qk;
        hg3_load_lv(c, 0, pt, lv0); hg3_load_qk(c, 0, pw, qk); hg3_load_lv(c, 1, pt, lv1);
        asm volatile("s_waitcnt vmcnt(0)" ::: "memory"); H3_USE_LV(lv0); H3_USE_QK(qk); H3_USE_LV(lv1);
        hg3_prep_a(c, 0, pt, lv0);
        __syncthreads();
#define H3_TRIP(j_, LVN, LVC) do { \
            if ((j_) < NCH) { asm volatile("s_waitcnt vmcnt(10)" ::: "memory"); H3_USE_QK(qk); hg3_prep_b(c, (j_) & 1, pw, qk, U); \
                if ((j_) + 1 < NCH) hg3_load_qk(c, (j_) + 1, pw, qk); else hg3_load_qk(c, (j_), pw, qk);     \
                if ((j_) + 2 < NCH) hg3_load_lv(c, (j_) + 2, pt, LVC); else hg3_load_lv(c, (j_), pt, LVC); } \
            if (PROBE_DELAY == 2) probe_delay(100); \
            __syncthreads();                                                                    \
            if ((j_) + 1 < NCH) { asm volatile("s_waitcnt vmcnt(26)" ::: "memory"); H3_USE_LV(LVN); hg3_prep_a(c, ((j_) + 1) & 1, pt, LVN); } \
            __syncthreads();                                                                    \
        } while (0)
#pragma unroll 1
        for (int j = 0; j <= NCH; j += 2) { H3_TRIP(j, lv1, lv0); H3_TRIP(j + 1, lv0, lv1); }
#undef H3_TRIP
        asm volatile("s_waitcnt vmcnt(0)" ::: "memory");
    } else {
        const int mw = wave - 4;
        f32x4 S[2][4], o[2][2]; v2u vt[4][2][2];
#pragma unroll
        for (int a = 0; a < 2; ++a)
#pragma unroll
            for (int e4 = 0; e4 < 4; ++e4) S[a][e4] = (f32x4){0.f, 0.f, 0.f, 0.f};
        __syncthreads();
#pragma unroll 1
        for (int j = 0; j <= NCH + 1; ++j) {
            if (j > 0 && j <= NCH) hg3_stage1(c, (j - 1) & 1, mw, S, o, vt);
            if (PROBE_DELAY == 1) probe_delay(100);
            __syncthreads();
            if (j > 0 && j <= NCH) hg3_stage2(c, j - 1, mw, S, o, vt);
            __syncthreads();
        }
    }
    __syncthreads();
}


struct Hg4LV { f32x4 lf[4]; v4u v; };
struct Hg4QK { v2u q[4], k[4]; };
__device__ __forceinline__ void hg4_load_lv(const Hg3& c, int n, int tid, Hg4LV& in) {
    const size_t r = hg3_row(c, n, tid >> 3);
#pragma unroll
    for (int i = 0; i < 4; ++i) gld16(in.lf[i], c.Lp + r + 16 * (tid & 7) + 4 * i);
    gld16u(in.v, c.Vb + r + c.vh * 64 + 8 * (tid & 7));
}
__device__ __forceinline__ void hg4_load_qk(const Hg3& c, int n, int w, Hg4QK& in) {
#pragma unroll
    for (int ti = 0; ti < 4; ++ti) { const size_t r = hg3_row(c, n, 16 * ti + c.lr) + 16 * w + 4 * c.lq; gld8(in.q[ti], c.Qb + r); gld8(in.k[ti], c.Kp + r); }
}
#define H4_USE_LV(x) asm volatile("" : "+v"((x).lf[0]), "+v"((x).lf[1]), "+v"((x).lf[2]), "+v"((x).lf[3]), "+v"((x).v))
#define H4_USE_QK(x) asm volatile("" : "+v"((x).q[0]), "+v"((x).q[1]), "+v"((x).q[2]), "+v"((x).q[3]), "+v"((x).k[0]), "+v"((x).k[1]), "+v"((x).k[2]), "+v"((x).k[3]))
__device__ __forceinline__ void hg4_prep_a(const Hg3& c, int buf, int tid, const Hg4LV& in) {
    const int t = tid >> 3, dq = tid & 7;
#pragma unroll
    for (int i = 0; i < 4; ++i) { unsigned l0, l1; const unsigned h0 = hg3_hi_lo(in.lf[i].x, in.lf[i].y, l0), h1 = hg3_hi_lo(in.lf[i].z, in.lf[i].w, l1);
        *(LAS v2u*)(c.lds + H3_LH + t * 272 + (16 * dq + 4 * i) * 2) = (v2u){h0, h1}; *(LAS v2u*)(c.lds + H3_LL + t * 272 + (16 * dq + 4 * i) * 2) = (v2u){l0, l1}; }
    *(LAS v4u*)(c.lds + H3_V + buf * H3_BUFV + t * 144 + dq * 16) = in.v;
}
__device__ __forceinline__ void hg4_prep_b(const Hg3& c, int buf, int w, const Hg4QK& in, const pg8::bf16x8 (&U)[4]) {
    LAS unsigned char* lds = c.lds; const int lr = c.lr, lq = c.lq, lane = c.lane;
    const unsigned trrow = (unsigned)(8 * lq + ((lane & 15) >> 2)), trcol = (unsigned)(4 * (lane & 3));
    const pg8::bf16x8 ones = (pg8::bf16x8)(v4u){0x3F803F80u, 0x3F803F80u, 0x3F803F80u, 0x3F803F80u};
    v2u fh[2][2], fl[2][2];
    const unsigned ah = (unsigned)(size_t)(lds + H3_LH) + trrow * 272 + (16 * w + trcol) * 2, al = ah + (H3_LL - H3_LH);
    asm volatile("ds_read_b64_tr_b16 %0, %8\n\tds_read_b64_tr_b16 %1, %8 offset:1088\n\tds_read_b64_tr_b16 %2, %8 offset:8704\n\tds_read_b64_tr_b16 %3, %8 offset:9792\n\t"
                 "ds_read_b64_tr_b16 %4, %9\n\tds_read_b64_tr_b16 %5, %9 offset:1088\n\tds_read_b64_tr_b16 %6, %9 offset:8704\n\tds_read_b64_tr_b16 %7, %9 offset:9792\n\ts_waitcnt lgkmcnt(0)"
                 : "=&v"(fh[0][0]), "=&v"(fh[0][1]), "=&v"(fh[1][0]), "=&v"(fh[1][1]), "=&v"(fl[0][0]), "=&v"(fl[0][1]), "=&v"(fl[1][0]), "=&v"(fl[1][1]) : "v"(ah), "v"(al) : "memory");
    const pg8::bf16x8 H0 = mk_frag(fh[0][0], fh[0][1]), H1 = mk_frag(fh[1][0], fh[1][1]), L0 = mk_frag(fl[0][0], fl[0][1]), L1 = mk_frag(fl[1][0], fl[1][1]);
    f32x4 bt[4];
    const f32x4 z = (f32x4){0.f, 0.f, 0.f, 0.f};
    bt[0] = __builtin_amdgcn_mfma_f32_16x16x32_bf16(L0, U[0], z, 0, 0, 0);    bt[0] = __builtin_amdgcn_mfma_f32_16x16x32_bf16(H0, U[0], bt[0], 0, 0, 0);
    bt[1] = __builtin_amdgcn_mfma_f32_16x16x32_bf16(L0, U[1], z, 0, 0, 0);    bt[1] = __builtin_amdgcn_mfma_f32_16x16x32_bf16(H0, U[1], bt[1], 0, 0, 0);
    bt[2] = __builtin_amdgcn_mfma_f32_16x16x32_bf16(L0, ones, z, 0, 0, 0);    bt[2] = __builtin_amdgcn_mfma_f32_16x16x32_bf16(L1, U[2], bt[2], 0, 0, 0);
    bt[2] = __builtin_amdgcn_mfma_f32_16x16x32_bf16(H0, ones, bt[2], 0, 0, 0); bt[2] = __builtin_amdgcn_mfma_f32_16x16x32_bf16(H1, U[2], bt[2], 0, 0, 0);
    bt[3] = __builtin_amdgcn_mfma_f32_16x16x32_bf16(L0, ones, z, 0, 0, 0);    bt[3] = __builtin_amdgcn_mfma_f32_16x16x32_bf16(L1, U[3], bt[3], 0, 0, 0);
    bt[3] = __builtin_amdgcn_mfma_f32_16x16x32_bf16(H0, ones, bt[3], 0, 0, 0); bt[3] = __builtin_amdgcn_mfma_f32_16x16x32_bf16(H1, U[3], bt[3], 0, 0, 0);
    f32x4 de;
#pragma unroll
    for (int r = 0; r < 4; ++r) de[r] = __expf(__shfl(bt[3][r], 16 * lq + 15));
    if (lr == 0) *(LAS f32x4*)(lds + H3_DEC + buf * H3_BUFDEC + (16 * w + 4 * lq) * 4) = de;
#pragma unroll
    for (int ti = 0; ti < 4; ++ti) {
        const v2u qq = in.q[ti], kk = in.k[ti];
        const float e0 = __expf(bt[ti][0]), e1 = __expf(bt[ti][1]), e2 = __expf(bt[ti][2]), e3 = __expf(bt[ti][3]);
        v2u qo, ko;
        qo.x = pk2(bf2f(qq.x & 0xffffu) * e0, bf2f(qq.x >> 16) * e1); qo.y = pk2(bf2f(qq.y & 0xffffu) * e2, bf2f(qq.y >> 16) * e3);
        ko.x = pk2(bf2f(kk.x & 0xffffu) * __builtin_amdgcn_rcpf(e0), bf2f(kk.x >> 16) * __builtin_amdgcn_rcpf(e1));
        ko.y = pk2(bf2f(kk.y & 0xffffu) * __builtin_amdgcn_rcpf(e2), bf2f(kk.y >> 16) * __builtin_amdgcn_rcpf(e3));
        const int off = (16 * ti + lr) * 272 + (16 * w + 4 * lq) * 2;
        *(LAS v2u*)(lds + H3_QI + buf * H3_BUFD + off) = qo; *(LAS v2u*)(lds + H3_KK + buf * H3_BUFD + off) = ko;
    }
}
__device__ __forceinline__ void hg4_stage1(const Hg3& c, int buf, int w, f32x4 (&S)[4], f32x4 (&o)[2], v2u (&vt)[4][2][2]) {
    LAS unsigned char* lds = c.lds; const int lr = c.lr, lq = c.lq, lane = c.lane;
    const LAS unsigned char* QI = lds + H3_QI + buf * H3_BUFD; const LAS unsigned char* KK = lds + H3_KK + buf * H3_BUFD;
    const unsigned trrow = (unsigned)(8 * lq + ((lane & 15) >> 2)), trcol = (unsigned)(4 * (lane & 3));
    const unsigned kk_tr = (unsigned)(size_t)KK + trrow * 272 + (16 * w + trcol) * 2;
    const unsigned v_tr = (unsigned)(size_t)(lds + H3_V + buf * H3_BUFV) + trrow * 144 + trcol * 2;
    v2u kt[2][2];
    asm volatile("ds_read_b64_tr_b16 %0, %4\n\tds_read_b64_tr_b16 %1, %4 offset:1088\n\tds_read_b64_tr_b16 %2, %4 offset:8704\n\tds_read_b64_tr_b16 %3, %4 offset:9792"
                 : "=&v"(kt[0][0]), "=&v"(kt[0][1]), "=&v"(kt[1][0]), "=&v"(kt[1][1]) : "v"(kk_tr) : "memory");
#define H4_VTR(e4, o0, o1, o2, o3) asm volatile("ds_read_b64_tr_b16 %0, %4 offset:" #o0 "\n\tds_read_b64_tr_b16 %1, %4 offset:" #o1 "\n\tds_read_b64_tr_b16 %2, %4 offset:" #o2 "\n\tds_read_b64_tr_b16 %3, %4 offset:" #o3 \
                 : "=&v"(vt[e4][0][0]), "=&v"(vt[e4][0][1]), "=&v"(vt[e4][1][0]), "=&v"(vt[e4][1][1]) : "v"(v_tr) : "memory")
    H4_VTR(0, 0, 576, 4608, 5184); H4_VTR(1, 32, 608, 4640, 5216); H4_VTR(2, 64, 640, 4672, 5248); H4_VTR(3, 96, 672, 4704, 5280);
#undef H4_VTR
    const int ei = w & 3, tp = w >> 2;
    {
        const int ti = w & 3;
#pragma unroll
        for (int sii = 0; sii < 2; ++sii) {
            const int si = tp * 2 + sii;
            v2u wv = (v2u){0u, 0u};
            if (si <= ti) {
                f32x4 a = (f32x4){0.f, 0.f, 0.f, 0.f};
#pragma unroll
                for (int kk = 0; kk < 4; ++kk)
                    a = __builtin_amdgcn_mfma_f32_16x16x32_bf16(lds_frag(KK + (16 * si + lr) * 272 + kk * 64 + lq * 16), lds_frag(QI + (16 * ti + lr) * 272 + kk * 64 + lq * 16), a, 0, 0, 0);
                const int s0 = 16 * si + 4 * lq, t = 16 * ti + lr;
                wv.x = pk2(s0 + 0 <= t ? a[0] : 0.f, s0 + 1 <= t ? a[1] : 0.f); wv.y = pk2(s0 + 2 <= t ? a[2] : 0.f, s0 + 3 <= t ? a[3] : 0.f);
            }
            *(LAS v2u*)(lds + H3_AM + (16 * ti + lr) * 144 + (16 * si + 4 * lq) * 2) = wv;
        }
    }
#pragma unroll
    for (int tt = 0; tt < 2; ++tt) o[tt] = (f32x4){0.f, 0.f, 0.f, 0.f};
#pragma unroll
    for (int kk = 0; kk < 4; ++kk) {
        const pg8::bf16x8 sfr = lds_frag(lds + H3_ST + (16 * ei + lr) * 272 + kk * 64 + lq * 16);
#pragma unroll
        for (int tt = 0; tt < 2; ++tt) o[tt] = __builtin_amdgcn_mfma_f32_16x16x32_bf16(sfr, lds_frag(QI + (16 * (2 * tp + tt) + lr) * 272 + kk * 64 + lq * 16), o[tt], 0, 0, 0);
    }
    asm volatile("s_waitcnt lgkmcnt(0)"
                 : "+v"(kt[0][0]), "+v"(kt[0][1]), "+v"(kt[1][0]), "+v"(kt[1][1]),
                   "+v"(vt[0][0][0]), "+v"(vt[0][0][1]), "+v"(vt[0][1][0]), "+v"(vt[0][1][1]), "+v"(vt[1][0][0]), "+v"(vt[1][0][1]), "+v"(vt[1][1][0]), "+v"(vt[1][1][1]),
                   "+v"(vt[2][0][0]), "+v"(vt[2][0][1]), "+v"(vt[2][1][0]), "+v"(vt[2][1][1]), "+v"(vt[3][0][0]), "+v"(vt[3][0][1]), "+v"(vt[3][1][0]), "+v"(vt[3][1][1]) :: "memory");
#pragma unroll
    for (int kk = 0; kk < 2; ++kk) {
        const pg8::bf16x8 af = mk_frag(kt[kk][0], kt[kk][1]);
#pragma unroll
        for (int e4 = 0; e4 < 4; ++e4) S[e4] = __builtin_amdgcn_mfma_f32_16x16x32_bf16(af, mk_frag(vt[e4][kk][0], vt[e4][kk][1]), S[e4], 0, 0, 0);
    }
    const f32x4 dv = *(const LAS f32x4*)(lds + H3_DEC + buf * H3_BUFDEC + (16 * w + 4 * lq) * 4);
#pragma unroll
    for (int e4 = 0; e4 < 4; ++e4) S[e4] = S[e4] * dv;
}
__device__ __forceinline__ void hg4_stage2(const Hg3& c, int n, int w, const f32x4 (&S)[4], f32x4 (&o)[2], const v2u (&vt)[4][2][2]) {
    LAS unsigned char* lds = c.lds; const int lr = c.lr, lq = c.lq;
    const int ei = w & 3, tp = w >> 2;
    const pg8::bf16x8 vf0 = ei == 0 ? mk_frag(vt[0][0][0], vt[0][0][1]) : ei == 1 ? mk_frag(vt[1][0][0], vt[1][0][1]) : ei == 2 ? mk_frag(vt[2][0][0], vt[2][0][1]) : mk_frag(vt[3][0][0], vt[3][0][1]);
    const pg8::bf16x8 vf1 = ei == 0 ? mk_frag(vt[0][1][0], vt[0][1][1]) : ei == 1 ? mk_frag(vt[1][1][0], vt[1][1][1]) : ei == 2 ? mk_frag(vt[2][1][0], vt[2][1][1]) : mk_frag(vt[3][1][0], vt[3][1][1]);
#pragma unroll
    for (int tt = 0; tt < 2; ++tt) {
        const int ti = 2 * tp + tt;
        o[tt] = __builtin_amdgcn_mfma_f32_16x16x32_bf16(vf0, lds_frag(lds + H3_AM + (16 * ti + lr) * 144 + 0 * 64 + lq * 16), o[tt], 0, 0, 0);
        o[tt] = __builtin_amdgcn_mfma_f32_16x16x32_bf16(vf1, lds_frag(lds + H3_AM + (16 * ti + lr) * 144 + 1 * 64 + lq * 16), o[tt], 0, 0, 0);
        *(f32x4*)(c.Op + hg3_row(c, n, 16 * ti + lr) + c.vh * 64 + 16 * ei + 4 * lq) = o[tt];
    }
#pragma unroll
    for (int e4 = 0; e4 < 4; ++e4) { v2u wv; wv.x = pk2(S[e4][0], S[e4][1]); wv.y = pk2(S[e4][2], S[e4][3]); *(LAS v2u*)(lds + H3_ST + (16 * e4 + lr) * 272 + (16 * w + 4 * lq) * 2) = wv; }
}
__device__ __forceinline__ void hgrn4_unit(LAS unsigned char* lds, int unit, const bf16* Qb, const bf16* KFb, const bf16* KBb, const bf16* Vb, const float* LFb, const float* LBb,
                                           float* OFb, float* OBb, int tid, int lane, int wave) {
    Hg3 c;
    c.lds = lds; c.vh = unit & 1; c.dir = (unit >> 1) & 1; c.h = (unit >> 2) & 3; c.b = unit >> 4;
    c.Qb = Qb; c.Vb = Vb; c.Kp = c.dir ? KBb : KFb; c.Lp = c.dir ? LBb : LFb; c.Op = c.dir ? OBb : OFb;
    c.lane = lane; c.lr = lane & 15; c.lq = lane >> 4;
    constexpr int NCH = TT / 64;
    const int w = wave;
    for (int i = tid; i < 64 * 272 / 16; i += NTHR) *(LAS v4u*)(lds + H3_ST + i * 16) = (v4u){0u, 0u, 0u, 0u};
    pg8::bf16x8 U[4];
#pragma unroll
    for (int u = 0; u < 4; ++u) { const int kk = u >> 1, ti = u; unsigned wv[4];
#pragma unroll
        for (int j2 = 0; j2 < 4; ++j2) { const int sN = 32 * kk + 8 * c.lq + 2 * j2, t = 16 * ti + c.lr; wv[j2] = (sN <= t ? 0x3F80u : 0u) | (sN + 1 <= t ? 0x3F800000u : 0u); }
        U[u] = (pg8::bf16x8)(v4u){wv[0], wv[1], wv[2], wv[3]}; }
    f32x4 S[4], o[2]; v2u vt[4][2][2];
#pragma unroll
    for (int e4 = 0; e4 < 4; ++e4) S[e4] = (f32x4){0.f, 0.f, 0.f, 0.f};
    Hg4LV lv0, lv1; Hg4QK qk;
    hg4_load_lv(c, 0, tid, lv0); hg4_load_qk(c, 0, w, qk); hg4_load_lv(c, 1, tid, lv1);
    asm volatile("s_waitcnt vmcnt(0)" ::: "memory"); H4_USE_LV(lv0); H4_USE_QK(qk); H4_USE_LV(lv1);
    hg4_prep_a(c, 0, tid, lv0);
    __syncthreads();
#define H4_TRIP(j_, LVN, LVC) do { \
        if ((j_) < NCH) { asm volatile("s_waitcnt vmcnt(5)" ::: "memory"); H4_USE_QK(qk); hg4_prep_b(c, (j_) & 1, w, qk, U); \
            hg4_load_qk(c, (j_) + 1 < NCH ? (j_) + 1 : (j_), w, qk); hg4_load_lv(c, (j_) + 2 < NCH ? (j_) + 2 : (j_), tid, LVC); }     \
        if ((j_) > 0 && (j_) <= NCH) hg4_stage1(c, ((j_) - 1) & 1, w, S, o, vt); \
        if (PROBE_DELAY == 5) probe_delay(100); \
        __syncthreads();                                                                        \
        if ((j_) + 1 < NCH) { asm volatile("s_waitcnt vmcnt(13)" ::: "memory"); H4_USE_LV(LVN); hg4_prep_a(c, ((j_) + 1) & 1, tid, LVN); } \
        if ((j_) > 0 && (j_) <= NCH) hg4_stage2(c, (j_) - 1, w, S, o, vt); \
        __syncthreads();                                                                        \
    } while (0)
#pragma unroll 1
    for (int j = 0; j <= NCH; j += 2) { H4_TRIP(j, lv1, lv0); H4_TRIP(j + 1, lv0, lv1); }
#undef H4_TRIP
    asm volatile("s_waitcnt vmcnt(0)" ::: "memory");
    __syncthreads();
}

#if defined(HGRN_V2)
#define HGRN_FN hgrn_unit
#elif defined(HGRN_V3)
#define HGRN_FN hgrn3_unit
#else
#define HGRN_FN hgrn4_unit
#endif
#define W1_ITEM(r_) do { const int r__ = (r_); const int e__ = r__ >> 10; p0_item<true>(w1 + (size_t)e__ * D * 2 * FF, D, 2 * FF, W1T + (size_t)e__ * 2 * FF * D, RmW1(), scr, r__ & 1023, lane); } while (0)

struct Args { const float* in[18]; float* out; unsigned char* ws; int ph_lo, ph_hi; };
__global__ void __launch_bounds__(NTHR, 2) fwd_kernel(Args args) {
    extern __shared__ __attribute__((aligned(16))) unsigned char lds_raw[];
    LAS unsigned char* lds = (LAS unsigned char*)lds_raw;
    volatile LAS unsigned* MISC = (volatile LAS unsigned*)(lds + MISC_OFF);
    const int tid = threadIdx.x, lane = tid & 63, wave = __builtin_amdgcn_readfirstlane(tid >> 6);
    const int G = gridDim.x; const int bx = blockIdx.x; const int vcu = (G % 8 == 0) ? (bx % 8) * (G / 8) + bx / 8 : bx;
    const int gw = vcu * NWAVES + wave, NGW = G * NWAVES;
    unsigned char* ws = args.ws;
    unsigned* ctl = (unsigned*)(ws + WS_CTL);
    const float* x = args.in[0]; const float* norm1_w = args.in[1]; const float* w_in = args.in[2]; const float* lb_logits = args.in[3];
    const float* hgrn_norm_w = args.in[4]; const float* dw_w = args.in[5]; const float* dw_b = args.in[6]; const float* conv_ln_w = args.in[7]; const float* conv_ln_b = args.in[8];
    const float* w_out = args.in[9]; const float* norm2_w = args.in[10]; const float* router_w = args.in[11]; const float* router_b = args.in[12];
    const float* w1 = args.in[13]; const float* b1 = args.in[14]; const float* w2 = args.in[15]; const float* b2 = args.in[16]; const float* final_norm_w = args.in[17];
    float* out = args.out;
    bf16* WI = (bf16*)(ws + WS_WI); bf16* WO = (bf16*)(ws + WS_WO); unsigned char* W1T = ws + WS_W1; unsigned char* W2T = ws + WS_W2;
    float* H = (float*)(ws + WS_H); bf16* XN = (bf16*)(ws + WS_XN);
    bf16* Qb = (bf16*)(ws + WS_Q); bf16* KFb = (bf16*)(ws + WS_KF); bf16* KBb = (bf16*)(ws + WS_KB); bf16* Vb = (bf16*)(ws + WS_V); bf16* Gb = (bf16*)(ws + WS_G); bf16* Ub = (bf16*)(ws + WS_U);
    float* LFb = (float*)(ws + WS_LF); float* LBb = (float*)(ws + WS_LB); float* OFb = (float*)(ws + WS_OF); float* OBb = (float*)(ws + WS_OB);
    bf16* MIX = (bf16*)(ws + WS_MIX); unsigned char* XS = ws + WS_XS; unsigned char* ACT = ws + WS_ACT; unsigned char* N2 = ws + WS_XN; bf16* YS = (bf16*)(ws + WS_YS);
    float* WRT = (float*)(ws + WS_WRT); int* SLOT = (int*)(ws + WS_SLOT); float* GATE = (float*)(ws + WS_GATE); int* ROWTOK = (int*)(ws + WS_ROWTOK);
    volatile LAS int* bs = (volatile LAS int*)(lds + TAB_OFF);
    volatile LAS int* cl = (volatile LAS int*)(lds + TAB_OFF + 256);
    LAS int* lcnt = (LAS int*)(lds + TAB_OFF + 512);
    volatile LAS int* gbase = (volatile LAS int*)(lds + TAB_OFF + 768);

    for (int u = tid; u < (LDS_BYTES - LDSCTL_OFF) / 4; u += NTHR) ((LAS unsigned*)(lds + LDSCTL_OFF))[u] = 0u;
    __syncthreads();
    XcdBarrier bar; bar.bar = ctl + CW_BAR; bar.x = 0; bar.st = nullptr;
    if (MK_N_LAUNCHES == 1) bar = xcd_barrier_post(ctl + CW_BAR, MISC + 8);
#ifndef PROBE_STAMP
#define PROBE_STAMP -1
#endif
    unsigned long long tS[N_PHASES + 1];
#define STAMP(k) do { if ((PROBE_STAMP) >= 0) tS[k] = __builtin_amdgcn_s_memrealtime(); } while (0)
    const int lo = args.ph_lo, hi = args.ph_hi;
#ifndef PHASE_MASK
#define PHASE_MASK 0xffffffffu
#endif
#define IN(k) ((((PHASE_MASK) >> (k)) & 1u) && lo <= (k) && (k) < hi)
#ifndef PROBE_DUP
#define PROBE_DUP -1
#endif
#define REP(k) _Pragma("unroll 1") for (int rep_ = 0; rep_ < ((PROBE_DUP) == (k) ? 2 + (args.ph_hi >> 20) : 1); ++rep_)
#define SEAM(k) do { if (IN(k) && IN((k) + 1)) { xcd_barrier(bar); if ((PROBE_DUP) == 99) { xcd_barrier(bar); xcd_barrier(bar); } } } while (0)
#define BUILD_BS() do { int t_; asm volatile("v_mov_b32 %0, %1" : "=v"(t_) : "v"(tid));     \
        if (t_ < 64) { const int c_ = t_ < NE ? (int)__hip_atomic_load(ctl + CW_CNT + 64 * (t_ & (NE - 1)), RLX_AGENT) : 0; int x_ = (c_ + 255) >> 8; \
        _Pragma("unroll") for (int o_ = 1; o_ < NE; o_ <<= 1) { const int y_ = __shfl_up(x_, o_); if ((t_ & 63) >= o_) x_ += y_; }     \
        if (t_ < NE) { cl[t_] = c_; bs[t_ + 1] = x_; } if (t_ == 0) bs[0] = 0; } __syncthreads(); } while (0)

    STAMP(0);
    if (IN(0)) REP(0) {
        LAS float* scr = (LAS float*)(lds + RING_OFF + wave * 16384);
        constexpr int I_WI = (D / 64) * (INC / 32), I_WO = (D / 64) * (D / 32), I_W1 = (D / 64) * (2 * FF / 32), I_W2 = (FF / 64) * (D / 32);
        #if defined(HGRN_NAIVE) || defined(W2_IN_P0)
        constexpr int NITEMS = I_WI + I_WO + NE * I_W1 + NE * I_W2;
#else
        constexpr int NITEMS = I_WI + I_WO + W1_P0;
#endif
#if defined(HGRN_NAIVE) || defined(W2_IN_P0)
        for (int it = gw; it < NITEMS; it += NGW) {
            int r = it;
            if (r < I_WI) { p0_item<false>(w_in, D, INC, WI, RmWin(), scr, r, lane); continue; } r -= I_WI;
            if (r < I_WO) { p0_item<false>(w_out, D, D, WO, RmIdent(), scr, r, lane); continue; } r -= I_WO;
            if (r < NE * I_W1) { W1_ITEM(r); continue; } r -= NE * I_W1;
            { const int e = r / I_W2; p0_item<true>(w2 + (size_t)e * FF * D, FF, D, W2T + (size_t)e * D * FF, RmIdent(), scr, r - e * I_W2, lane); }
        }
#else
        (void)NITEMS; (void)I_W2;
        for (int it = gw; it < I_WI + I_WO; it += NGW) { if (it < I_WI) p0_item<false>(w_in, D, INC, WI, RmWin(), scr, it, lane); else p0_item<false>(w_out, D, D, WO, RmIdent(), scr, it - I_WI, lane); }
        convert_range_fp8(w1, D, 2 * FF, W1T, RmW1(), 10, gw, NGW, W1_P0, 0, scr, lane);
#endif
        {
            const f32x4* wr = (const f32x4*)norm1_w + lane; f32x4 gw4[4];
#pragma unroll
            for (int j = 0; j < 4; ++j) gw4[j] = wr[64 * j];
#pragma unroll 1
            for (int m0 = gw; m0 < MTOK; m0 += 4 * NGW) {
                f32x4 v[4][4];
#pragma unroll
                for (int q4 = 0; q4 < 4; ++q4) { const int m = min(m0 + q4 * NGW, MTOK - 1); const f32x4* xr = (const f32x4*)(x + (size_t)m * D) + lane;
#pragma unroll
                    for (int j = 0; j < 4; ++j) v[q4][j] = xr[64 * j]; }
#pragma unroll
                for (int q4 = 0; q4 < 4; ++q4) { const int m = m0 + q4 * NGW; float sq = 0.f;
#pragma unroll
                    for (int j = 0; j < 4; ++j) sq += (v[q4][j].x * v[q4][j].x + v[q4][j].y * v[q4][j].y) + (v[q4][j].z * v[q4][j].z + v[q4][j].w * v[q4][j].w);
                    const float rstd = rsqrtf(wave_sum(sq) * (1.f / D) + EPS);
                    if (m < MTOK) { v2u* o8 = (v2u*)(XN + (size_t)m * D) + lane;
#pragma unroll
                        for (int j = 0; j < 4; ++j) { v2u o; o.x = pk2(v[q4][j].x * rstd * gw4[j].x, v[q4][j].y * rstd * gw4[j].y); o.y = pk2(v[q4][j].z * rstd * gw4[j].z, v[q4][j].w * rstd * gw4[j].w); o8[64 * j] = o; } }
                }
            }
        }
        for (int i = bx * NTHR + tid; i < 16 * D; i += G * NTHR) {
            const int r = i >> 4, e16 = i & 15, k = 256 * (r & 3) + (r >> 2); const float gk = norm2_w[k];
            WRT[2 * i] = gk * router_w[k * NE + e16]; WRT[2 * i + 1] = gk * router_w[k * NE + 16 + e16]; }
    }
    if ((PROBE_STAMP) == 600 + 0) tS[6] = __builtin_amdgcn_s_memrealtime();
    SEAM(0);

    STAMP(1);
    if (IN(1)) REP(1) {
        pg8::Gemm g{XN, WI, MTOK, INC, D}; OrderRep S; S.init(MTOK, INC, G, bx); S.reps = ((PROBE_DUP) == 11) ? 2 : 1;
        EpiProj E{Qb, KFb, KBb, Vb, Gb, Ub, LFb, LBb, lb_logits};
        pg8::gemm_phase<EpiProj, OrderRep, true, true>(lds + RING_OFF, g, S, E);
#if !defined(HGRN_NAIVE) && !defined(W2_IN_P0)
        {
            LAS float* scr = (LAS float*)(lds + RING_OFF + wave * 16384);
            if (G == 256) { if (bx >= 128) convert_range_fp8(w1, D, 2 * FF, W1T, RmW1(), 10, (bx - 128) * NWAVES + wave, 128 * NWAVES, W1_P1, W1_P0, scr, lane); }
            else convert_range_fp8(w1, D, 2 * FF, W1T, RmW1(), 10, gw, NGW, W1_P1, W1_P0, scr, lane);
        }
#endif
    }
    if ((PROBE_STAMP) == 600 + 1) tS[6] = __builtin_amdgcn_s_memrealtime();
    SEAM(1);

    STAMP(2);
    if (IN(2)) REP(2) {
        const bool split = (G == 256);
#if defined(HGRN_NAIVE)
        const bool hsel = true; const int hidx = 0, hstride = 1; const bool csel = true; const int cidx = vcu, cstride = G;
#else
        const bool hsel = split ? (((bx >> 3) & 1) != 0) : true; const int hidx = split ? (bx >> 4) * 8 + (bx & 7) : bx, hstride = split ? 128 : G;
        const bool csel = split ? !hsel : true; const int cidx = split ? (bx >> 4) * 8 + (bx & 7) : bx, cstride = split ? 128 : G;
#endif
        (void)hidx; (void)hstride;
        if (csel && PROBE_DELAY == 3) probe_delay(3000); if (csel && PROBE_DELAY == 4) probe_delay(20000);
        if (csel) for (int crep_ = 0; crep_ < ((PROBE_DUP) == 21 ? 2 : 1); ++crep_) {
            LAS unsigned short* ut = (LAS unsigned short*)(lds + RING_OFF);
            LAS float* part = (LAS float*)(lds + RING_OFF + 98304);
            LAS float* stat = (LAS float*)(lds + RING_OFF + 98304 + 4096);
            for (int unit = cidx; unit < NBATCH * (TT / 64); unit += cstride) {
                const int b = unit / (TT / 64), t0 = (unit % (TT / 64)) * 64;
                {
                    v4u val[12];
#pragma unroll
                    for (int i = 0; i < 12; ++i) { const int idx = tid + NTHR * i, r = idx >> 6, p = idx & 63, t = t0 - 15 + r;
                        val[i] = (v4u){0u, 0u, 0u, 0u};
                        if (idx < 94 * 64 && t >= 0 && t < TT) val[i] = *(const v4u*)(Ub + (size_t)(b * TT + t) * CCH + p * 8); }
#pragma unroll
                    for (int i = 0; i < 12; ++i) { const int idx = tid + NTHR * i, r = idx >> 6, p = idx & 63;
                        if (idx < 94 * 64) *(LAS v4u*)(ut + r * 512 + p * 8) = val[i]; }
                }
                __syncthreads(); if ((PROBE_STAMP) == 651 && unit == cidx) tS[6] = __builtin_amdgcn_s_memrealtime();
                const int c = tid;
                float w[CLEN];
#pragma unroll
                for (int j = 0; j < CLEN; ++j) w[j] = dw_w[j * CCH + c];
                const float bias = dw_b[c];
                float y[64];
#pragma unroll
                for (int tb = 0; tb < 8; ++tb) {
                    float win[38];
#pragma unroll
                    for (int i = 0; i < 38; ++i) win[i] = bf2f(ut[(tb * 8 + i) * 512 + c]);
#pragma unroll
                    for (int o = 0; o < 8; ++o) { float a = bias;
#pragma unroll
                        for (int j = 0; j < CLEN; ++j) a += w[j] * win[o + j];
                        y[tb * 8 + o] = a; }
                }
#pragma unroll 1
                for (int pass = 0; pass < 2; ++pass) {
                    float s1[64];
#pragma unroll
                    for (int i = 0; i < 64; ++i) s1[i] = pass ? y[i] * y[i] : y[i];
#pragma unroll
                    for (int s = 32; s >= 1; s >>= 1) {
                        const bool up = (lane & s) != 0;
#pragma unroll
                        for (int i = 0; i < s; ++i) { const float k1 = up ? s1[i + s] : s1[i], x1 = up ? s1[i] : s1[i + s]; s1[i] = k1 + __shfl_xor(x1, s); }
                    }
                    part[(wave * 64 + lane) * 2 + pass] = s1[0];
                }
                __syncthreads(); if ((PROBE_STAMP) == 652 && unit == cidx) tS[6] = __builtin_amdgcn_s_memrealtime();
                if (tid < 64) { float a = 0.f, q = 0.f;
#pragma unroll
                    for (int wv = 0; wv < 8; ++wv) { a += part[(wv * 64 + tid) * 2]; q += part[(wv * 64 + tid) * 2 + 1]; }
                    const float mean = a * (1.f / CCH), var = q * (1.f / CCH) - mean * mean;
                    stat[tid * 2] = mean; stat[tid * 2 + 1] = rsqrtf(fmaxf(var, 0.f) + EPS); }
                __syncthreads();
                const float lw = conv_ln_w[c], lbias = conv_ln_b[c];
#pragma unroll
                for (int t = 0; t < 64; ++t) {
                    const float v = (y[t] - stat[t * 2]) * stat[t * 2 + 1] * lw + lbias;
                    MIX[(size_t)(b * TT + t0 + t) * D + 512 + c] = (bf16)(pk2(v * sigm(v), 0.f) & 0xffffu);
                }
                __syncthreads(); if ((PROBE_STAMP) == 653 && unit == cidx) tS[6] = __builtin_amdgcn_s_memrealtime();
            }
            if ((PROBE_STAMP) == 650) tS[6] = __builtin_amdgcn_s_memrealtime();
#if !defined(HGRN_NAIVE) && !defined(W2_IN_P0)
            {
                LAS float* scr = (LAS float*)(lds + RING_OFF + wave * 16384);
                constexpr int I_W2 = (FF / 64) * (D / 32);
                convert_range_fp8(w2, FF, D, W2T, RmIdent(), 9, cidx * NWAVES + wave, cstride * NWAVES, W2_P2, 0, scr, lane);
                convert_range_fp8(w1, D, 2 * FF, W1T, RmW1(), 10, cidx * NWAVES + wave, cstride * NWAVES, W1_P2, W1_P0 + W1_P1, scr, lane);
            }
#endif
        }
#if defined(HGRN_NAIVE)
        {
            LAS float* qs = (LAS float*)(lds + RING_OFF); LAS float* ks = qs + 2048; LAS float* fs = ks + 2048; LAS float* vs = fs + 2048; LAS float* op = vs + 2048;
            const int e = tid & 127, dq = tid >> 7;
            for (int unit = G - 1 - bx; unit < NBATCH * NH * 2; unit += G) {
                const int dir = unit & 1, h = (unit >> 1) & 3, b = unit >> 3;
                const bf16* Kp = dir ? KBb : KFb; const float* Lp = dir ? LBb : LFb; float* Op = dir ? OBb : OFb;
                float S[32];
#pragma unroll
                for (int i = 0; i < 32; ++i) S[i] = 0.f;
                for (int blk = 0; blk < TT / 16; ++blk) {
                    const int tb = dir ? (TT - 16 - blk * 16) : blk * 16;
#pragma unroll
                    for (int i = 0; i < 4; ++i) { const int idx = tid + NTHR * i, r = idx >> 7, d = idx & 127; const size_t off = (size_t)(b * TT + tb + r) * 512 + h * 128 + d;
                        qs[idx] = bf2f(Qb[off]); ks[idx] = bf2f(Kp[off]); fs[idx] = __expf(Lp[off]); vs[idx] = bf2f(Vb[off]); }
                    __syncthreads();
                    for (int st = 0; st < 16; ++st) {
                        const int r = dir ? 15 - st : st; const float v = vs[r * 128 + e]; float o = 0.f;
#pragma unroll
                        for (int dd = 0; dd < 32; ++dd) { const int d = dq * 32 + dd; S[dd] = fs[r * 128 + d] * S[dd] + ks[r * 128 + d] * v; o += qs[r * 128 + d] * S[dd]; }
                        op[(r * 4 + dq) * 128 + e] = o;
                    }
                    __syncthreads();
#pragma unroll
                    for (int i = 0; i < 4; ++i) { const int idx = tid + NTHR * i, r = idx >> 7, ee = idx & 127;
                        Op[(size_t)(b * TT + tb + r) * 512 + h * 128 + ee] = (op[(r * 4 + 0) * 128 + ee] + op[(r * 4 + 1) * 128 + ee]) + (op[(r * 4 + 2) * 128 + ee] + op[(r * 4 + 3) * 128 + ee]); }
                }
                __syncthreads();
            }
        }
#else
        if (hsel) for (int unit = hidx; unit < NBATCH * NH * 4 * ((PROBE_DUP) == 20 ? 2 : 1); unit += hstride) HGRN_FN(lds + RING_OFF, unit & (NBATCH * NH * 4 - 1), Qb, KFb, KBb, Vb, LFb, LBb, OFb, OBb, tid, lane, wave);
#endif
    }
    if ((PROBE_STAMP) == 600 + 2) tS[6] = __builtin_amdgcn_s_memrealtime();
    SEAM(2);

    STAMP(3);
    if (IN(3)) REP(3) {
        for (int m = gw; m < MTOK; m += NGW) {
            const size_t off = (size_t)m * 512 + lane * 8;
            const f32x4 a0 = *(const f32x4*)(OFb + off), a1 = *(const f32x4*)(OFb + off + 4), c0 = *(const f32x4*)(OBb + off), c1 = *(const f32x4*)(OBb + off + 4);
            const f32x4 o0 = a0 + c0, o1 = a1 + c1;
            float ss = (o0.x * o0.x + o0.y * o0.y) + (o0.z * o0.z + o0.w * o0.w) + (o1.x * o1.x + o1.y * o1.y) + (o1.z * o1.z + o1.w * o1.w);
            ss += __shfl_xor(ss, 1); ss += __shfl_xor(ss, 2); ss += __shfl_xor(ss, 4); ss += __shfl_xor(ss, 8);
            const float rstd = rsqrtf(ss * (1.f / DV) + EPS);
            const v4u gv = *(const v4u*)(Gb + off);
            const f32x4 w0 = *(const f32x4*)(hgrn_norm_w + lane * 8), w1v = *(const f32x4*)(hgrn_norm_w + lane * 8 + 4);
            f32x4 r0, r1;
            r0.x = o0.x * rstd * w0.x * bf2f(gv.x & 0xffffu); r0.y = o0.y * rstd * w0.y * bf2f(gv.x >> 16);
            r0.z = o0.z * rstd * w0.z * bf2f(gv.y & 0xffffu); r0.w = o0.w * rstd * w0.w * bf2f(gv.y >> 16);
            r1.x = o1.x * rstd * w1v.x * bf2f(gv.z & 0xffffu); r1.y = o1.y * rstd * w1v.y * bf2f(gv.z >> 16);
            r1.z = o1.z * rstd * w1v.z * bf2f(gv.w & 0xffffu); r1.w = o1.w * rstd * w1v.w * bf2f(gv.w >> 16);
            st8bf(MIX + (size_t)m * D + lane * 8, r0, r1);
        }
    }
    if ((PROBE_STAMP) == 600 + 3) tS[6] = __builtin_amdgcn_s_memrealtime();
    SEAM(3);

    STAMP(4);
    if (IN(4)) REP(4) {
        pg8::Gemm g{MIX, WO, MTOK, D, D}; pg8::StaticOrder S; S.init(MTOK, D, G, bx);
        EpiRes E{x, H};
        pg8::gemm_phase<EpiRes, pg8::StaticOrder, true, true>(lds + RING_OFF, g, S, E);
    }
    if ((PROBE_STAMP) == 600 + 4) tS[6] = __builtin_amdgcn_s_memrealtime();
    SEAM(4);

    STAMP(5);
    if (IN(5)) REP(5) {
        typedef float f32x2 __attribute__((ext_vector_type(2)));
        LAS float* wl = (LAS float*)(lds + RING_OFF);
        LAS unsigned* sb = (LAS unsigned*)(lds + SB_OFF);
        { f32x4 tv_[NE * D / 4 / NTHR];
#pragma unroll
            for (int i = 0; i < NE * D / 4 / NTHR; ++i) tv_[i] = ((const f32x4*)WRT)[tid + NTHR * i];
#pragma unroll
            for (int i = 0; i < NE * D / 4 / NTHR; ++i) ((LAS f32x4*)wl)[tid + NTHR * i] = tv_[i]; }
        if (tid < NE) lcnt[tid] = 0;
        __syncthreads();
        for (int tg = vcu; tg < MTOK / 64; tg += G) {
            const int tok0 = tg * 64 + 16 * (wave & 3);
            if (wave < 4) {
                const int j = lane & 15, q = lane >> 4;
                const f32x4* hrow = (const f32x4*)(H + (size_t)(tok0 + j) * D + 256 * q);
                const LAS f32x2* tab = (const LAS f32x2*)wl + q * 16 + j;
                f32x4 acc0 = (f32x4){0.f, 0.f, 0.f, 0.f}, acc1 = acc0; float ss = 0.f;
                f32x4 hb[8], hn[8];
#pragma unroll
                for (int i = 0; i < 8; ++i) hb[i] = hrow[i];
#pragma unroll 1
                for (int blk = 0; blk < 8; ++blk) {
                    if (blk + 1 < 8) {
#pragma unroll
                        for (int i = 0; i < 8; ++i) hn[i] = hrow[(blk + 1) * 8 + i];
                    }
#pragma unroll
                    for (int i = 0; i < 8; ++i) {
                        const f32x4 hc = hb[i]; const int s4 = blk * 8 + i;
                        f32x2 w[4];
#pragma unroll
                        for (int u = 0; u < 4; ++u) w[u] = tab[(4 * s4 + u) * 64];
                        ss += (hc.x * hc.x + hc.y * hc.y) + (hc.z * hc.z + hc.w * hc.w);
#pragma unroll
                        for (int u = 0; u < 4; ++u) { acc0 = __builtin_amdgcn_mfma_f32_16x16x4f32(w[u].x, hc[u], acc0, 0, 0, 0); acc1 = __builtin_amdgcn_mfma_f32_16x16x4f32(w[u].y, hc[u], acc1, 0, 0, 0); }
                    }
#pragma unroll
                    for (int i = 0; i < 8; ++i) hb[i] = hn[i];
                }
                ss += __shfl_xor(ss, 16); ss += __shfl_xor(ss, 32);
                const float rstd = rsqrtf(ss * (1.f / D) + EPS);
                float lg[8];
#pragma unroll
                for (int r = 0; r < 4; ++r) { lg[r] = acc0[r] * rstd + router_b[4 * q + r]; lg[4 + r] = acc1[r] * rstd + router_b[16 + 4 * q + r]; }
                float tv[TOPK]; int ti[TOPK];
#pragma unroll
                for (int k = 0; k < TOPK; ++k) {
                    float bv = lg[0]; int bi = 4 * q;
#pragma unroll
                    for (int r = 1; r < 8; ++r) { const int id = (r < 4) ? 4 * q + r : 16 + 4 * q + (r - 4); if (lg[r] > bv) { bv = lg[r]; bi = id; } }
#pragma unroll
                    for (int o = 16; o < 64; o <<= 1) { const float ov = __shfl_xor(bv, o); const int oi = __shfl_xor(bi, o); if (ov > bv || (ov == bv && oi < bi)) { bv = ov; bi = oi; } }
                    tv[k] = bv; ti[k] = bi;
#pragma unroll
                    for (int r = 0; r < 8; ++r) { const int id = (r < 4) ? 4 * q + r : 16 + 4 * q + (r - 4); if (id == bi) lg[r] = -INFINITY; }
                }
                const float e1 = __expf(tv[1] - tv[0]), e2 = __expf(tv[2] - tv[0]), e3 = __expf(tv[3] - tv[0]);
                const float inv = 1.0f / (1.0f + e1 + e2 + e3);
                {
                    const int ek = q == 0 ? ti[0] : q == 1 ? ti[1] : q == 2 ? ti[2] : ti[3];
                    const float gk = (q == 0 ? 1.0f : q == 1 ? e1 : q == 2 ? e2 : e3) * inv;
                    const int lr = __hip_atomic_fetch_add(&lcnt[ek], 1, __ATOMIC_RELAXED, __HIP_MEMORY_SCOPE_WORKGROUP);
                    sb[(16 * wave + j) * 4 + q] = ((unsigned)ek << 16) | (unsigned)lr;
                    GATE[(size_t)(tok0 + j) * TOPK + q] = gk;
                }
            } else {
                const f32x4* wr = (const f32x4*)norm2_w + lane;
                f32x4 gw4[4];
#pragma unroll
                for (int jj = 0; jj < 4; ++jj) gw4[jj] = wr[64 * jj];
#pragma unroll 1
                for (int i = 0; i < 16; i += 4) {
                    f32x4 v[4][4];
#pragma unroll
                    for (int q4 = 0; q4 < 4; ++q4) { const f32x4* hr = (const f32x4*)(H + (size_t)(tok0 + i + q4) * D) + lane;
#pragma unroll
                        for (int jj = 0; jj < 4; ++jj) v[q4][jj] = hr[64 * jj]; }
#pragma unroll
                    for (int q4 = 0; q4 < 4; ++q4) {
                        float s2 = 0.f;
#pragma unroll
                        for (int jj = 0; jj < 4; ++jj) s2 += (v[q4][jj].x * v[q4][jj].x + v[q4][jj].y * v[q4][jj].y) + (v[q4][jj].z * v[q4][jj].z + v[q4][jj].w * v[q4][jj].w);
                        const float rstd = rsqrtf(wave_sum(s2) * (1.f / D) + EPS) * SC_N2;
                        unsigned* o4 = (unsigned*)(N2 + (size_t)(tok0 + i + q4) * D) + lane;
#pragma unroll
                        for (int jj = 0; jj < 4; ++jj) o4[64 * jj] = pk4_fp8(v[q4][jj].x * rstd * gw4[jj].x, v[q4][jj].y * rstd * gw4[jj].y, v[q4][jj].z * rstd * gw4[jj].z, v[q4][jj].w * rstd * gw4[jj].w);
                    }
                }
            }
            __syncthreads();
            if (tid < NE) { const int c = lcnt[tid]; gbase[tid] = c ? (int)__hip_atomic_fetch_add(ctl + CW_CNT + ((PROBE_DUP) == 5 && rep_ == 0 ? 4096 : 0) + 64 * tid, (unsigned)c, RLX_AGENT) : 0; }
            __syncthreads();
            if (tid < 256) { const unsigned w = sb[tid]; const int ek = (int)(w >> 16), r = gbase[ek] + (int)(w & 0xffffu), m = tg * 64 + (tid >> 2);
                ROWTOK[ek * MTOK + r] = m; SLOT[(size_t)m * TOPK + (tid & 3)] = ek * MTOK + r; }
            if (tid < NE) lcnt[tid] = 0;
            __syncthreads();
        }
    }
    if ((PROBE_STAMP) == 600 + 5) tS[6] = __builtin_amdgcn_s_memrealtime();
    SEAM(5);


    if ((PROBE_STAMP) < 600 || (PROBE_STAMP) > 699) STAMP(6);
    STAMP(7);
#if defined(MOE_MERGED)
    if (IN(7)) REP(7) {
        BUILD_BS();
        pg8::Gemm g{(const bf16*)ws, (const bf16*)W1T, MTOK, 2 * FF, D / 2}; MoeOrder2 S{bs, G, vcu, cl, ROWTOK, ctl};
        EpiMoe E{EpiSwiglu{ACT, b1}, EpiDown{YS, b2}};
        pg8::gemm_phase<EpiMoe, MoeOrder2, true, true, true, true>(lds + RING_OFF, g, S, E);
    }
    if ((PROBE_STAMP) == 600 + 8) tS[6] = __builtin_amdgcn_s_memrealtime();
    SEAM(8);
#else
    if (IN(7)) REP(7) {
        BUILD_BS();
        pg8::Gemm g{(const bf16*)N2, (const bf16*)W1T, MTOK, 2 * FF, D / 2}; MoeOrder S{bs, 8, G, vcu, cl, ROWTOK};
        EpiSwiglu E{ACT, b1};
        pg8::gemm_phase<EpiSwiglu, MoeOrder, true, true, true, true>(lds + RING_OFF, g, S, E);
#if !defined(HGRN_NAIVE) && !defined(W2_IN_P0)
        {
            LAS float* scr = (LAS float*)(lds + RING_OFF + wave * 16384);
            const int r7 = (bs[NE] * 8) % G, nsl = G - r7;
            if (vcu >= r7) convert_range_fp8(w2, FF, D, W2T, RmIdent(), 9, (vcu - r7) * NWAVES + wave, nsl * NWAVES, W2_P7, W2_P2, scr, lane);
        }
#endif
    }
    if ((PROBE_STAMP) == 600 + 7) tS[6] = __builtin_amdgcn_s_memrealtime();
    SEAM(7);

    STAMP(8);
    if (IN(8)) REP(8) {
        BUILD_BS();
        pg8::Gemm g{(const bf16*)ACT, (const bf16*)W2T, MOE_ROWS, D, FF / 2}; MoeOrder S{bs, 4, G, vcu, cl, ROWTOK};
        EpiDown E{YS, b2};
        pg8::gemm_phase<EpiDown, MoeOrder, true, true, true>(lds + RING_OFF, g, S, E);
    }
    SEAM(8);
#endif

    STAMP(9);
    if (IN(9)) REP(9) {
        BUILD_BS();
        for (int base = gw; base < MTOK; base += 16 * NGW) {
            const int mi = base + NGW * (lane >> 2); int posl = 0; float gl = 0.f;
            if (mi < MTOK) { const int sl = SLOT[(size_t)mi * TOPK + (lane & 3)]; gl = GATE[(size_t)mi * TOPK + (lane & 3)]; posl = bs[sl >> 14] * 256 + (sl & (MTOK - 1)); }
#pragma unroll 2
            for (int i = 0; i < 16; ++i) {
                const int m = base + NGW * i; if (m >= MTOK) break;
                const f32x4* hr = (const f32x4*)(H + (size_t)m * D) + lane; const f32x4* wr = (const f32x4*)final_norm_w + lane;
                int pos[TOPK]; float gk[TOPK];
#pragma unroll
                for (int k = 0; k < TOPK; ++k) { pos[k] = __shfl(posl, 4 * i + k); gk[k] = __shfl(gl, 4 * i + k); }
                f32x4 v[4]; v2u yw[TOPK][4];
#pragma unroll
                for (int j = 0; j < 4; ++j) v[j] = hr[64 * j];
#pragma unroll
                for (int k = 0; k < TOPK; ++k) { const v2u* yr = (const v2u*)(YS + (size_t)pos[k] * D) + lane;
#pragma unroll
                    for (int j = 0; j < 4; ++j) yw[k][j] = yr[64 * j]; }
#pragma unroll
                for (int k = 0; k < TOPK; ++k)
#pragma unroll
                    for (int j = 0; j < 4; ++j) { const v2u w = yw[k][j];
                        v[j].x += gk[k] * bf2f(w.x & 0xffffu); v[j].y += gk[k] * bf2f(w.x >> 16); v[j].z += gk[k] * bf2f(w.y & 0xffffu); v[j].w += gk[k] * bf2f(w.y >> 16); }
                float s = 0.f;
#pragma unroll
                for (int j = 0; j < 4; ++j) s += (v[j].x * v[j].x + v[j].y * v[j].y) + (v[j].z * v[j].z + v[j].w * v[j].w);
                const float rstd = rsqrtf(wave_sum(s) * (1.f / D) + EPS);
                f32x4* orow = (f32x4*)(out + (size_t)m * D) + lane;
#pragma unroll
                for (int j = 0; j < 4; ++j) orow[64 * j] = v[j] * rstd * wr[64 * j];
            }
        }
    }
    STAMP(N_PHASES);
#ifndef PROBE_WG
#define PROBE_WG 0
#endif
    if ((PROBE_STAMP) >= 660 && (PROBE_STAMP) <= 669 && bx == (PROBE_WG)) {
        const unsigned long long a_ = *(volatile LAS unsigned long long*)(lds + LDSCTL_OFF + 640), b_ = *(volatile LAS unsigned long long*)(lds + LDSCTL_OFF + 648);
        const unsigned long long d = 64ull * (b_ - a_), t0 = __builtin_amdgcn_s_memrealtime();
        while (__builtin_amdgcn_s_memrealtime() - t0 < d) __builtin_amdgcn_s_sleep(8);
    } else
    if ((PROBE_STAMP) >= 0 && bx == (PROBE_WG)) {
        const int k0 = ((PROBE_STAMP) >= 650 && (PROBE_STAMP) <= 659) ? 2 : (PROBE_STAMP) % 100, k1 = ((PROBE_STAMP) >= 100) ? (PROBE_STAMP) / 100 : k0 + 1;
        const unsigned long long d = 2ull * (tS[k1 > N_PHASES ? N_PHASES : k1] - tS[k0]), t0 = __builtin_amdgcn_s_memrealtime();
        while (__builtin_amdgcn_s_memrealtime() - t0 < d) __builtin_amdgcn_s_sleep(8);
    }
#undef IN
#undef SEAM
#undef BUILD_BS
}

extern "C" void kernel_launch(void* const* d_in, const int* in_sizes, int n_in, void* d_out, int out_size, void* d_ws, size_t ws_size, hipStream_t stream) {
    static int grid = 0;
    if (grid == 0) {
        if (n_in != 18 || in_sizes[0] != MTOK * D || out_size != MTOK * D || ws_size < WS_END) { fprintf(stderr, "kernel_launch: unexpected shapes (n_in %d, in0 %d, out %d, ws %zu < %zu); nothing launched\n", n_in, n_in > 0 ? in_sizes[0] : -1, out_size, ws_size, (size_t)WS_END); grid = -1; return; }
        int dev = 0, cus = 0, per_cu = 0;
        if (hipGetDevice(&dev) != hipSuccess || hipDeviceGetAttribute(&cus, hipDeviceAttributeMultiprocessorCount, dev) != hipSuccess) { fprintf(stderr, "kernel_launch: device query failed\n"); grid = -1; return; }
        if (hipFuncSetAttribute((const void*)fwd_kernel, hipFuncAttributeMaxDynamicSharedMemorySize, LDS_BYTES) != hipSuccess) { fprintf(stderr, "kernel_launch: hipFuncSetAttribute failed\n"); grid = -1; return; }
        if (hipOccupancyMaxActiveBlocksPerMultiprocessor(&per_cu, (const void*)fwd_kernel, NTHR, LDS_BYTES) != hipSuccess || per_cu < 1)
            fprintf(stderr, "kernel_launch: note: occupancy query reports %d workgroups per CU\n", per_cu);
        (void)hipGetLastError();
        grid = cus;
    }
    if (grid < 0) return;
    if (hipMemsetAsync((char*)d_ws + WS_CTL, 0, CTL_ZERO_BYTES, stream) != hipSuccess) { fprintf(stderr, "kernel_launch: memset failed\n"); return; }
    Args a{};
    for (int i = 0; i < 18; ++i) a.in[i] = (const float*)d_in[i];
    a.out = (float*)d_out; a.ws = (unsigned char*)d_ws;
#if MK_N_LAUNCHES == 1
    a.ph_lo = 0; a.ph_hi = N_PHASES;
    hipLaunchKernelGGL(fwd_kernel, dim3(grid), dim3(NTHR), LDS_BYTES, stream, a);
#else
    for (int ph = 0; ph < N_PHASES; ++ph) { a.ph_lo = ph; a.ph_hi = ph + 1; hipLaunchKernelGGL(fwd_kernel, dim3(grid), dim3(NTHR), LDS_BYTES, stream, a); }
#endif
    const hipError_t le = hipPeekAtLastError();
    if (le != hipSuccess) fprintf(stderr, "kernel_launch: launch failed: %s\n", hipGetErrorName(le));
}
```

```cpp
#define HGRN_V2 1
#include <hip/hip_runtime.h>
#include <cstdio>
#include <cstdint>
namespace pg8 {
#define PG8_LAS __attribute__((address_space(3)))
typedef unsigned short bf16_t;
typedef short bf16x8 __attribute__((ext_vector_type(8)));
typedef float f32x4 __attribute__((ext_vector_type(4)));
typedef unsigned u32x4 __attribute__((ext_vector_type(4)));
constexpr int BM = 256, BK = 64, HALF = 128, HTB = HALF * BK * 2  , STAGE_BYTES = 8 * HTB, NXCD = 8, WGM = 8;

__host__ __device__ __forceinline__ int lds_byte(int r, int c) { const int st = (r >> 4) * 2 + (c >> 5), rr = r & 15, cc = c & 31, ob = rr * 64 + cc * 2; return st * 1024 + (ob ^ (((ob >> 9) & 1) << 5)); }
__host__ __device__ __forceinline__ void stage_rc(int b, int& R, int& C) { const int st = b / 1024, sb = b % 1024, swz = sb ^ (((sb >> 9) & 1) << 5); R = (st >> 1) * 16 + swz / 64; C = (st & 1) * 32 + (swz % 64) / 2; }
__host__ __device__ __forceinline__ int perm32(int rho) { const int n = rho >> 4, i = rho & 15; return 8 * (i >> 2) + 4 * n + (i & 3); }

struct Unit { int pm, pn; };
struct Gemm { const bf16_t* A; const bf16_t* Bt; int M, N, K; };

struct StaticOrder {
    int nM, nN, nwg, G, c;
    __host__ __device__ void init(int M, int N, int G_, int c_) { nM = M / BM; nN = N / BM; nwg = nM * nN; G = G_; c = c_; }
    __host__ __device__ bool next(int i, Unit& u) const {
        const long L = (long)i * G + c; if (L >= nwg) return false;
        int wgid = (int)L; { const int q = nwg / NXCD, r = nwg % NXCD, xcd = wgid % NXCD, off = wgid / NXCD; wgid = (xcd < r ? xcd * (q + 1) : r * (q + 1) + (xcd - r) * q) + off; }
        const int nig = WGM * nN, gid = wgid / nig, fm = gid * WGM, gsz = (nM - fm) < WGM ? (nM - fm) : WGM;
        u.pm = fm + ((wgid % nig) % gsz); u.pn = (wgid % nig) / gsz; return true;
    }
    __device__ __forceinline__ void a_ready(const Unit&) const {}
    __device__ __forceinline__ void done(const Unit&) const {}
    __device__ __forceinline__ int done_defer(const Unit&) const { return -1; }
    __device__ __forceinline__ void done_signal(int) const {}
};
__device__ __forceinline__ unsigned cvt_pk_bf16(float lo, float hi) { unsigned r; asm volatile("v_cvt_pk_bf16_f32 %0, %1, %2" : "=v"(r) : "v"(lo), "v"(hi)); return r; }
typedef float f32x2 __attribute__((ext_vector_type(2)));
template <class Epi, class Sched, bool ALIGN_EPI = false, bool SP2 = false, bool FP8 = false, bool GATHER = false>
__device__ __forceinline__ void gemm_phase(PG8_LAS unsigned char* lds, const Gemm g, const Sched& S, const Epi& E) {
    typedef int v4i_t __attribute__((ext_vector_type(4)));
    const int tid = threadIdx.x, wid = __builtin_amdgcn_readfirstlane(tid >> 6), lane = tid & 63, wr = wid >> 2, wc = wid & 3, fr = lane & 15, fq = lane >> 4;
    const int K = g.K, nt = K / BK;
    unsigned voffA[2], voffB[2];
#pragma unroll
    for (int i = 0; i < 2; ++i) { int R, C; stage_rc(tid * 16 + i * 8192, R, C); const int Rb = Epi::PERM ? ((R & ~31) + perm32(R & 31)) : R;
        voffA[i] = (unsigned)(R * K + C) * 2u; voffB[i] = (unsigned)(Rb * K + C) * 2u; }
    int rowA[2]; unsigned colA[2];
#pragma unroll
    for (int i = 0; i < 2; ++i) { int R, C; stage_rc(tid * 16 + i * 8192, R, C); rowA[i] = R; colA[i] = (unsigned)C * 2u; }
    const size_t kstep = (size_t)(BK * 2);
    const size_t hstep = (size_t)HALF * K * 2;
    const size_t tstep = 2 * hstep;
    const unsigned ldsw = (unsigned)wid * 1024u;
    const int aoff = lds_byte(wr * 64 + fr, fq * 8), boff = lds_byte(wc * 32 + fr, fq * 8);
#define PG8_SA(b, h) (((b) * 2 + (h)) * HTB)
#define PG8_SB(b, h) ((4 + (b) * 2 + (h)) * HTB)
#define PG8_STAGE(bufoff, gbase, voff) do { _Pragma("unroll") for (int _i = 0; _i < 2; ++_i) \
        __builtin_amdgcn_global_load_lds((const unsigned*)((const char*)(gbase) + (voff)[_i]), (PG8_LAS unsigned*)(lds + (bufoff) + ldsw + _i * 8192), 16, 0, 0); } while (0)
#define PG8_STAGE2(bufoff, gbase, o0, o1) do { \
        __builtin_amdgcn_global_load_lds((const unsigned*)((const char*)(gbase) + (o0)), (PG8_LAS unsigned*)(lds + (bufoff) + ldsw), 16, 0, 0); \
        __builtin_amdgcn_global_load_lds((const unsigned*)((const char*)(gbase) + (o1)), (PG8_LAS unsigned*)(lds + (bufoff) + ldsw + 8192), 16, 0, 0); } while (0)
#define PG8_LDA(dst, b, h) do { _Pragma("unroll") for (int m = 0; m < 4; ++m) _Pragma("unroll") for (int k = 0; k < 2; ++k) dst[m][k] = *(const PG8_LAS bf16x8*)(lds + PG8_SA(b, h) + aoff + m * 2048 + k * 1024); } while (0)
#define PG8_LDB(dst, b, h) do { _Pragma("unroll") for (int n = 0; n < 2; ++n) _Pragma("unroll") for (int k = 0; k < 2; ++k) dst[n][k] = *(const PG8_LAS bf16x8*)(lds + PG8_SB(b, h) + boff + n * 2048 + k * 1024); } while (0)
#define PG8_MMA(ai, bj, At, Bt) do { __builtin_amdgcn_s_setprio(1); _Pragma("unroll") for (int m = 0; m < 4; ++m) _Pragma("unroll") for (int n = 0; n < 2; ++n) { \
        if constexpr (FP8) { asm volatile("v_mfma_f32_16x16x128_f8f6f4 %0, %1, %2, %0" : "+v"(acc[ai][bj][m][n]) : "v"(__builtin_shufflevector((v4i_t)Bt[n][0], (v4i_t)Bt[n][1], 0, 1, 2, 3, 4, 5, 6, 7)), "v"(__builtin_shufflevector((v4i_t)At[m][0], (v4i_t)At[m][1], 0, 1, 2, 3, 4, 5, 6, 7))); } \
        else { _Pragma("unroll") for (int k = 0; k < 2; ++k) acc[ai][bj][m][n] = __builtin_amdgcn_mfma_f32_16x16x32_bf16(Bt[n][k], At[m][k], acc[ai][bj][m][n], 0, 0, 0); } } __builtin_amdgcn_s_setprio(0); } while (0)
#define PG8_WAIT_V(n) asm volatile("s_waitcnt vmcnt(" #n ")" ::: "memory")
#define PG8_WAIT_L(n) asm volatile("s_waitcnt lgkmcnt(" #n ")" ::: "memory")
#define PG8_BAR __builtin_amdgcn_s_barrier()
#define PG8_SCHED __builtin_amdgcn_sched_barrier(0)
    Unit cur, nxt; int ui = 0; int pend = -1;
    if (!S.next(0, cur)) return;
    f32x4 acc[2][2][4][2];
#pragma unroll
    for (int a = 0; a < 2; ++a)
#pragma unroll
        for (int b = 0; b < 2; ++b)
#pragma unroll
            for (int m = 0; m < 4; ++m)
#pragma unroll
                for (int n = 0; n < 2; ++n) acc[a][b][m][n] = (f32x4){0.f, 0.f, 0.f, 0.f};
    bf16x8 At[4][2], B0[2][2], B1[2][2];
    const char* cA = (const char*)g.A + (size_t)cur.pm * tstep; const char* cB = (const char*)g.Bt + (size_t)cur.pn * tstep;
    unsigned oA[2][2], nOA[2][2]; int tk[2][2] = {{0, 0}, {0, 0}};
    if constexpr (GATHER) {
        cA = (const char*)g.A;
        const int nv = S.a_valid(cur); const unsigned ab = S.a_base(cur);
        if (S.a_is_list(cur)) { const int* lst = S.a_list(cur);
#pragma unroll
            for (int h = 0; h < 2; ++h)
#pragma unroll
                for (int i = 0; i < 2; ++i) { const int r = min(h * HALF + rowA[i], nv - 1); oA[h][i] = ab + (unsigned)lst[r] * (unsigned)(K * 2) + colA[i]; }
        } else { const int r0 = S.a_row0(cur);
#pragma unroll
            for (int h = 0; h < 2; ++h)
#pragma unroll
                for (int i = 0; i < 2; ++i) { const int r = min(h * HALF + rowA[i], nv - 1); oA[h][i] = ab + (unsigned)(r0 + r) * (unsigned)(K * 2) + colA[i]; }
        }
    } else {
#pragma unroll
        for (int h = 0; h < 2; ++h)
#pragma unroll
            for (int i = 0; i < 2; ++i) oA[h][i] = voffA[i] + (unsigned)(h * hstep);
    }
#pragma unroll
    for (int h = 0; h < 2; ++h)
#pragma unroll
        for (int i = 0; i < 2; ++i) nOA[h][i] = oA[h][i];
#define PG8_OSEL(h, i) (GATHER ? (last ? nOA[h][i] : oA[h][i]) : oA[h][i])
    S.a_ready(cur);
    if constexpr (SP2) {
        PG8_STAGE(PG8_SB(0, 0), cB, voffB); PG8_STAGE(PG8_SB(0, 1), cB + hstep, voffB); PG8_STAGE2(PG8_SA(0, 0), cA, oA[0][0], oA[0][1]); PG8_STAGE2(PG8_SA(0, 1), cA, oA[1][0], oA[1][1]);
        if (wr == 1) PG8_BAR;
        PG8_WAIT_V(2); PG8_BAR;
        PG8_STAGE(PG8_SB(1, 0), cB + kstep, voffB); PG8_STAGE2(PG8_SA(1, 0), cA + kstep, oA[0][0], oA[0][1]); PG8_STAGE(PG8_SB(1, 1), cB + hstep + kstep, voffB);
        PG8_WAIT_V(6); PG8_BAR;
    } else {
        PG8_STAGE(PG8_SB(0, 0), cB, voffB); PG8_STAGE(PG8_SA(0, 0), cA, voffA); PG8_STAGE(PG8_SB(0, 1), cB + hstep, voffB); PG8_STAGE(PG8_SA(0, 1), cA + hstep, voffA);
        if (wr == 1) PG8_BAR;
        PG8_WAIT_V(4); PG8_BAR;
        PG8_STAGE(PG8_SB(1, 0), cB + kstep, voffB); PG8_STAGE(PG8_SA(1, 0), cA + kstep, voffA); PG8_STAGE(PG8_SB(1, 1), cB + hstep + kstep, voffB);
        PG8_WAIT_V(6); PG8_BAR;
    }
    for (;;) {
        const bool has_next = S.next(ui + 1, nxt);
        const char* nA = GATHER ? cA : (has_next ? (const char*)g.A + (size_t)nxt.pm * tstep : cA); const char* nB = has_next ? (const char*)g.Bt + (size_t)nxt.pn * tstep : cB;
        if constexpr (GATHER) { if (has_next) { const int nv = S.a_valid(nxt);
            if (S.a_is_list(nxt)) { const int* lst = S.a_list(nxt);
#pragma unroll
                for (int h = 0; h < 2; ++h)
#pragma unroll
                    for (int i = 0; i < 2; ++i) { const int* pp = lst + min(h * HALF + rowA[i], nv - 1); asm volatile("global_load_dword %0, %1, off" : "=v"(tk[h][i]) : "v"(pp) : "memory"); }
            } else { const int r0 = S.a_row0(nxt);
#pragma unroll
                for (int h = 0; h < 2; ++h)
#pragma unroll
                    for (int i = 0; i < 2; ++i) tk[h][i] = r0 + min(h * HALF + rowA[i], nv - 1);
            } } }
        for (int t = 0; t < nt; t += 2) {
            const bool last = (t == nt - 2);
            const char* a1 = cA + (size_t)(t + 1) * kstep;
            const char* a2 = last ? nA : cA + (size_t)(t + 2) * kstep; const char* b2 = last ? nB : cB + (size_t)(t + 2) * kstep;
            const char* a3 = a2 + kstep; const char* b3 = b2 + kstep;
            if (last && has_next) S.a_ready(nxt);
            if constexpr (GATHER) { if (last && has_next) { asm volatile("" : "+v"(tk[0][0]), "+v"(tk[0][1]), "+v"(tk[1][0]), "+v"(tk[1][1]));
#pragma unroll
                for (int h = 0; h < 2; ++h)
#pragma unroll
                    for (int i = 0; i < 2; ++i) nOA[h][i] = S.a_base(nxt) + (unsigned)tk[h][i] * (unsigned)(K * 2) + colA[i]; } }
            if constexpr (SP2) {
            PG8_LDB(B0, 0, 0); PG8_LDB(B1, 0, 1); PG8_SCHED; PG8_LDA(At, 0, 0); PG8_STAGE2(PG8_SA(1, 1), a1, oA[1][0], oA[1][1]);
            PG8_WAIT_V(8); PG8_WAIT_L(0); PG8_BAR; PG8_MMA(0, 0, At, B0); PG8_MMA(0, 1, At, B1); PG8_BAR; PG8_SCHED;
            PG8_LDA(At, 0, 1); PG8_STAGE(PG8_SB(0, 0), b2, voffB); PG8_STAGE(PG8_SB(0, 1), b2 + hstep, voffB); PG8_STAGE2(PG8_SA(0, 0), a2, PG8_OSEL(0, 0), PG8_OSEL(0, 1));
            PG8_WAIT_V(8); if (pend >= 0) { S.done_signal(pend); pend = -1; }
            PG8_WAIT_L(0); PG8_BAR; PG8_MMA(1, 0, At, B0); PG8_MMA(1, 1, At, B1); PG8_BAR; PG8_SCHED;
            PG8_LDB(B0, 1, 0); PG8_LDB(B1, 1, 1); PG8_SCHED; PG8_LDA(At, 1, 0); PG8_STAGE2(PG8_SA(0, 1), a2, PG8_OSEL(1, 0), PG8_OSEL(1, 1));
            PG8_WAIT_V(8); PG8_WAIT_L(0); PG8_BAR; PG8_MMA(0, 0, At, B0); PG8_MMA(0, 1, At, B1); PG8_BAR; PG8_SCHED;
            PG8_LDA(At, 1, 1); PG8_STAGE(PG8_SB(1, 0), b3, voffB); PG8_STAGE(PG8_SB(1, 1), b3 + hstep, voffB); PG8_STAGE2(PG8_SA(1, 0), a3, PG8_OSEL(0, 0), PG8_OSEL(0, 1));
            PG8_WAIT_V(8); PG8_WAIT_L(0); PG8_BAR; PG8_MMA(1, 0, At, B0); PG8_MMA(1, 1, At, B1); PG8_BAR; PG8_SCHED;
            } else {
            PG8_LDB(B0, 0, 0); PG8_SCHED; PG8_LDA(At, 0, 0); PG8_STAGE(PG8_SA(1, 1), a1 + hstep, voffA);
            PG8_WAIT_L(8); PG8_BAR; PG8_WAIT_L(0); PG8_MMA(0, 0, At, B0); PG8_BAR; PG8_SCHED;
            PG8_LDB(B1, 0, 1); PG8_STAGE(PG8_SB(0, 0), b2, voffB);
            PG8_BAR; PG8_WAIT_L(0); PG8_MMA(0, 1, At, B1); PG8_BAR;
            PG8_LDA(At, 0, 1); PG8_STAGE(PG8_SA(0, 0), a2, voffA);
            PG8_BAR; PG8_WAIT_L(0); PG8_MMA(1, 0, At, B0); PG8_BAR; PG8_SCHED;
            PG8_STAGE(PG8_SB(0, 1), b2 + hstep, voffB);
            PG8_WAIT_V(6); PG8_BAR; PG8_MMA(1, 1, At, B1); PG8_BAR;
            PG8_LDB(B0, 1, 0); PG8_SCHED; PG8_LDA(At, 1, 0); PG8_STAGE(PG8_SA(0, 1), a2 + hstep, voffA);
            PG8_WAIT_L(8); PG8_BAR; PG8_WAIT_L(0); PG8_MMA(0, 0, At, B0); PG8_BAR; PG8_SCHED;
            PG8_LDB(B1, 1, 1); PG8_STAGE(PG8_SB(1, 0), b3, voffB);
            PG8_BAR; PG8_WAIT_L(0); PG8_MMA(0, 1, At, B1); PG8_BAR;
            PG8_LDA(At, 1, 1); PG8_STAGE(PG8_SA(1, 0), a3, voffA);
            PG8_BAR; PG8_WAIT_L(0); PG8_MMA(1, 0, At, B0); PG8_BAR; PG8_SCHED;
            PG8_STAGE(PG8_SB(1, 1), b3 + hstep, voffB);
            PG8_WAIT_V(6); PG8_BAR; PG8_MMA(1, 1, At, B1); PG8_BAR;
            }
        }
        if constexpr (FP8) asm volatile("s_nop 15\n\ts_nop 15" ::: "memory");
        if constexpr (ALIGN_EPI) { if (wr == 0) PG8_BAR; }
        if constexpr (!Epi::AFTER_DRAIN) { E(acc, cur, wr, wc, fr, fq); S.done(cur); pend = S.done_defer(cur); }
        if (!has_next) break;
#pragma unroll
        for (int a = 0; a < 2; ++a)
#pragma unroll
            for (int b = 0; b < 2; ++b)
#pragma unroll
                for (int m = 0; m < 4; ++m)
#pragma unroll
                    for (int n = 0; n < 2; ++n) acc[a][b][m][n] = (f32x4){0.f, 0.f, 0.f, 0.f};
        cur = nxt; cA = nA; cB = nB; ++ui;
        if constexpr (GATHER) {
#pragma unroll
            for (int h = 0; h < 2; ++h)
#pragma unroll
                for (int i = 0; i < 2; ++i) oA[h][i] = nOA[h][i];
        }
        if constexpr (ALIGN_EPI) { if (wr == 1) PG8_BAR; }
    }
    PG8_WAIT_V(0);
    if (pend >= 0) { S.done_signal(pend); pend = -1; }
    if constexpr (!ALIGN_EPI) { if (wr == 0) PG8_BAR; }
    PG8_BAR;
    if constexpr (Epi::AFTER_DRAIN) { E.fused(acc, cur, wr, wc, fr, fq, lds, wid, lane); S.done(cur); }
#undef PG8_SA
#undef PG8_OSEL
#undef PG8_STAGE2
#undef PG8_SB
#undef PG8_STAGE
#undef PG8_LDA
#undef PG8_LDB
#undef PG8_MMA
#undef PG8_WAIT_V
#undef PG8_WAIT_L
#undef PG8_BAR
#undef PG8_SCHED
}
}

#ifndef MK_N_LAUNCHES
#define MK_N_LAUNCHES 1
#endif
#ifndef PROBE_DUP
#define PROBE_DUP -1
#endif
#ifndef PROBE_STAMP
#define PROBE_STAMP -1
#endif
constexpr int N_PHASES = 10;
constexpr int NBATCH = 8, TT = 2048, MTOK = NBATCH * TT, D = 1024;
constexpr int HK = 512, NH = 4, DK = 128, DV = 128, CCH = 512, CLEN = 31, INC = 3584;
constexpr int NE = 32, TOPK = 4, FF = 1024;
constexpr float EPS = 1e-5f, SW_LIMIT = 7.0f, SW_ALPHA = 1.702f;
constexpr int NWAVES = 8, NTHR = 512;
constexpr int W1_ITEMS = 32 * 16 * 64, W1_P1 = 6144, W1_P2 = 20480, W1_P0 = W1_ITEMS - W1_P1 - W1_P2;
constexpr int W2_ITEMS = 32 * 16 * 32, W2_P7 = 4096, W2_P2 = W2_ITEMS - W2_P7;
constexpr int MOE_ROWS = (MTOK * TOPK / 256 + NE) * 256;

constexpr size_t MiB = 1u << 20;
constexpr size_t WS_CTL = 0, CTL_ZERO_BYTES = 256 * 1024;
constexpr size_t WS_WI = 1 * MiB;
constexpr size_t WS_WO = 8 * MiB;
constexpr size_t WS_TAB = 10 * MiB;
constexpr size_t WS_W1 = 16 * MiB;
constexpr size_t WS_W2 = 144 * MiB;
constexpr size_t WS_H = 208 * MiB;
constexpr size_t WS_XN = 272 * MiB;
constexpr size_t WS_Q = 304 * MiB, WS_KF = 320 * MiB, WS_KB = 336 * MiB, WS_V = 352 * MiB, WS_G = 368 * MiB, WS_U = 384 * MiB;
constexpr size_t WS_LF = 400 * MiB, WS_LB = 432 * MiB;
constexpr size_t WS_OF = 464 * MiB, WS_OB = 496 * MiB;
constexpr size_t WS_MIX = 528 * MiB;
constexpr size_t WS_XS = 304 * MiB;
constexpr size_t WS_ACT = 448 * MiB;
constexpr size_t WS_YS = 592 * MiB;
constexpr size_t WS_END = 736 * MiB;
constexpr size_t WS_WRT = WS_TAB;
constexpr size_t WS_SLOT = WS_TAB + 256 * 1024;
constexpr size_t WS_GATE = WS_TAB + 512 * 1024;
constexpr size_t WS_ROWTOK = WS_TAB + 1 * MiB;
constexpr int CW_BAR = 4096;
constexpr int CW_CNT = 16384;

constexpr int RING_OFF = 0, RING_BYTES = 131072;
constexpr int LDSCTL_OFF = 152576;
constexpr int MISC_OFF = LDSCTL_OFF + 320;
constexpr int TAB_OFF = LDSCTL_OFF + 1024;
constexpr int SB_OFF = LDSCTL_OFF + 2048;
constexpr int LDS_BYTES = 163840;

#define GAS __attribute__((address_space(1)))
#define LAS __attribute__((address_space(3)))
typedef unsigned short bf16;
typedef unsigned v4u __attribute__((ext_vector_type(4)));
typedef unsigned v2u __attribute__((ext_vector_type(2)));
typedef float f32x4 __attribute__((ext_vector_type(4)));
typedef GAS unsigned gu32;
#define RLX_AGENT __ATOMIC_RELAXED, __HIP_MEMORY_SCOPE_AGENT
#define LDS_WAIT() asm volatile("s_waitcnt lgkmcnt(0)" ::: "memory")
#define VM_WAIT() asm volatile("s_waitcnt vmcnt(0)" ::: "memory")

__device__ __forceinline__ float bf2f(unsigned b) { return __uint_as_float(b << 16); }
typedef __bf16 bf16x2_t __attribute__((ext_vector_type(2)));
typedef float f32x2_t __attribute__((ext_vector_type(2)));
__device__ __forceinline__ unsigned pk2(float lo, float hi) { const bf16x2_t r = __builtin_convertvector((f32x2_t){lo, hi}, bf16x2_t); return __builtin_bit_cast(unsigned, r); }
__device__ __forceinline__ float sigm(float x) { return __builtin_amdgcn_rcpf(1.0f + __expf(-x)); }
__device__ __forceinline__ float wave_sum(float v) {
#pragma unroll
    for (int o = 1; o < 64; o <<= 1) v += __shfl_xor(v, o);
    return v;
}

constexpr float SC_W = 512.f, SC_N2 = 16.f, SC_ACT = 8.f;
__device__ __forceinline__ unsigned pk4_fp8(float a, float b, float c, float d) {
    a = fminf(fmaxf(a, -448.f), 448.f); b = fminf(fmaxf(b, -448.f), 448.f); c = fminf(fmaxf(c, -448.f), 448.f); d = fminf(fmaxf(d, -448.f), 448.f);
    int w = 0; w = __builtin_amdgcn_cvt_pk_fp8_f32(a, b, w, false); w = __builtin_amdgcn_cvt_pk_fp8_f32(c, d, w, true); return (unsigned)w;
}

#define XB_TMO      128
#define XB_XCNT(j)  (256  + 64 * (j))
#define XB_XSUB(j)  (1280 + 64 * (j))
#define XB_XGEN(j)  (2304 + 64 * (j))
#define XB_TOP      3328
#define XB_TOPGEN   3392
#define XCD_BAR_WORDS 3456
#define XB_SPIN_CAP (1u << 18)

__device__ __forceinline__ unsigned xb_ld(unsigned* p)              { return __hip_atomic_load(p, __ATOMIC_RELAXED, __HIP_MEMORY_SCOPE_AGENT); }
__device__ __forceinline__ unsigned xb_add(unsigned* p, unsigned v) { return __hip_atomic_fetch_add(p, v, __ATOMIC_RELAXED, __HIP_MEMORY_SCOPE_AGENT); }
__device__ __forceinline__ unsigned xb_xcc_id() { return (unsigned)__builtin_amdgcn_s_getreg((3 << 11) | 20) & 0xFu; }
#define XB_SPIN(cond, bar) do { unsigned _sp = 0; while (cond) { __builtin_amdgcn_s_sleep(1); \
    if ((++_sp & 255u) == 0u) { if (xb_ld(&(bar)[XB_TMO])) break; if (_sp > XB_SPIN_CAP) { atomicAdd(&(bar)[XB_TMO], 1u); break; } } } } while (0)

struct XcdBarrier {
    unsigned* bar; unsigned x;
    volatile LAS unsigned* st;
};
__device__ __forceinline__ XcdBarrier xcd_barrier_post(unsigned* bar, volatile LAS unsigned* st) {
    XcdBarrier b; b.bar = bar; b.x = xb_xcc_id(); b.st = st;
    if (threadIdx.x == 0) (void)xb_add(&bar[XB_XCNT(b.x)], 1u);
    return b;
}
__device__ __forceinline__ void xcd_barrier_complete(unsigned* bar, unsigned x, unsigned& nloc, unsigned& nx) {
    const unsigned G = gridDim.x * gridDim.y * gridDim.z;
    unsigned sum, cnt, mine, sp = 0u;
    for (;;) {
        sum = 0u; cnt = 0u; mine = 0u;
#pragma unroll
        for (unsigned j = 0; j < 16; ++j) { const unsigned c = xb_ld(&bar[XB_XCNT(j)]); sum += c; cnt += (c > 0u) ? 1u : 0u; mine = (j == x) ? c : mine; }
        if (sum == G) break;
        __builtin_amdgcn_s_sleep(1);
        if ((++sp & 255u) == 0u) { if (xb_ld(&bar[XB_TMO])) break; if (sp > XB_SPIN_CAP) { atomicAdd(&bar[XB_TMO], 1u); break; } }
    }
    nloc = mine > 0u ? mine : 1u; nx = cnt > 0u ? cnt : 1u;
}
__device__ __forceinline__ void xcd_barrier(const XcdBarrier& b) {
    asm volatile("s_waitcnt vmcnt(0)" ::: "memory");
    __syncthreads();
    if (threadIdx.x == 0) {
        unsigned* bar = b.bar;
        __builtin_amdgcn_s_waitcnt(0);
        unsigned nloc = b.st[0], nx = b.st[1];
        if (nloc == 0u) { xcd_barrier_complete(bar, b.x, nloc, nx); b.st[0] = nloc; b.st[1] = nx; }
        const unsigned old = xb_add(&bar[XB_XSUB(b.x)], 1u);
        const unsigned gen = old / nloc;
        if (old + 1u == (gen + 1u) * nloc) {
            __builtin_amdgcn_fence(__ATOMIC_RELEASE, "agent");
            asm volatile("s_waitcnt vmcnt(0)" ::: "memory");
            const unsigned og = xb_add(&bar[XB_TOP], 1u);
            const unsigned tg = og / nx;
            if (og + 1u == (tg + 1u) * nx) xb_add(&bar[XB_TOPGEN], 1u);
            else XB_SPIN(xb_ld(&bar[XB_TOPGEN]) == tg, bar);
            __builtin_amdgcn_fence(__ATOMIC_ACQUIRE, "agent");
            xb_add(&bar[XB_XGEN(b.x)], 1u);
            asm volatile("s_waitcnt vmcnt(0)" ::: "memory");
        } else {
            XB_SPIN(xb_ld(&bar[XB_XGEN(b.x)]) == gen, bar);
            __builtin_amdgcn_fence(__ATOMIC_ACQUIRE, "agent");
            asm volatile("s_waitcnt vmcnt(0)" ::: "memory");
        }
    }
    __syncthreads();
}

#ifndef WT_STORES
#define WT_STORES 0
#endif
__device__ __forceinline__ void st16(void* p, v4u w) {
#if WT_STORES
    asm volatile("global_store_dwordx4 %0, %1, off sc0 sc1\n\ts_nop 1" :: "v"(p), "v"(w) : "memory");
#else
    *(v4u*)p = w;
#endif
}
__device__ __forceinline__ void st8(void* p, v2u w) {
#if WT_STORES
    asm volatile("global_store_dwordx2 %0, %1, off sc0 sc1\n\ts_nop 1" :: "v"(p), "v"(w) : "memory");
#else
    *(v2u*)p = w;
#endif
}
__device__ __forceinline__ void st8bf(bf16* p, const f32x4& a, const f32x4& b) {
    v4u w; w.x = pk2(a[0], a[1]); w.y = pk2(a[2], a[3]); w.z = pk2(b[0], b[1]); w.w = pk2(b[2], b[3]);
    st16(p, w);
}
struct EpiProj {
    static constexpr bool PERM = true, AFTER_DRAIN = false;
    bf16 *Q, *KF, *KB, *V, *G, *U; float *LF, *LB; const float* lbl;
    template <int TYP>
    __device__ __forceinline__ void tile(const pg8::f32x4 (&acc)[2][2][4][2], int row0, int cb) const {
#pragma unroll
        for (int bj = 0; bj < 2; ++bj) {
            const int col = cb + bj * 128;
            float lb[8];
            if (TYP == 1 || TYP == 2) {
                const float* L = lbl + (TYP - 1) * 1024 + col;
#pragma unroll
                for (int i = 0; i < 8; ++i) lb[i] = __builtin_amdgcn_rcpf(1.0f + __expf(L[512 + i] - L[i]));
            }
#pragma unroll
            for (int ai = 0; ai < 2; ++ai)
#pragma unroll
                for (int m = 0; m < 4; ++m) {
                    const size_t off = (size_t)(row0 + ai * 128 + m * 16) * 512 + col;
                    f32x4 a = acc[ai][bj][m][0], b = acc[ai][bj][m][1];
                    if (TYP == 0 || TYP == 4) {
#pragma unroll
                        for (int i = 0; i < 4; ++i) { a[i] = a[i] * sigm(a[i]); b[i] = b[i] * sigm(b[i]); }
                        st8bf((TYP == 0 ? Q : G) + off, a, b);
                    } else if (TYP == 3) {
                        st8bf(V + off, a, b);
                    } else {
                        f32x4 la, lbv, ka, kb;
#pragma unroll
                        for (int i = 0; i < 4; ++i) {
                            const float fa = lb[i] + (1.0f - lb[i]) * sigm(a[i]), fb = lb[4 + i] + (1.0f - lb[4 + i]) * sigm(b[i]);
                            la[i] = __logf(fa); lbv[i] = __logf(fb); ka[i] = 1.0f - fa; kb[i] = 1.0f - fb;
                        }
                        float* Lp = (TYP == 1 ? LF : LB) + off;
                        st16(Lp, (v4u)la); st16(Lp + 4, (v4u)lbv);
                        st8bf((TYP == 1 ? KF : KB) + off, ka, kb);
                    }
                }
        }
    }
    __device__ __forceinline__ void operator()(const pg8::f32x4 (&acc)[2][2][4][2], const pg8::Unit& u, int wr, int wc, int fr, int fq) const {
        const int row0 = u.pm * 256 + wr * 64 + fr, pn = u.pn;
        if (pn >= 10) {
            const int col = (pn - 10) * 128 + wc * 32 + 8 * fq;
#pragma unroll
            for (int ai = 0; ai < 2; ++ai)
#pragma unroll
                for (int m = 0; m < 4; ++m) {
                    f32x4 a = acc[ai][0][m][0], b = acc[ai][0][m][1]; const f32x4 ga = acc[ai][1][m][0], gb = acc[ai][1][m][1];
#pragma unroll
                    for (int i = 0; i < 4; ++i) { a[i] = a[i] * sigm(ga[i]); b[i] = b[i] * sigm(gb[i]); }
                    st8bf(U + (size_t)(row0 + ai * 128 + m * 16) * 512 + col, a, b);
                }
        } else {
            const int cb = (pn & 1) * 256 + wc * 32 + 8 * fq, typ = pn >> 1;
            if (typ == 0) tile<0>(acc, row0, cb);
            else if (typ == 1) tile<1>(acc, row0, cb);
            else if (typ == 2) tile<2>(acc, row0, cb);
            else if (typ == 3) tile<3>(acc, row0, cb);
            else tile<4>(acc, row0, cb);
        }
    }
};
struct EpiRes {
    static constexpr bool PERM = false, AFTER_DRAIN = false;
    const float* X; float* H;
    __device__ __forceinline__ void operator()(const pg8::f32x4 (&acc)[2][2][4][2], const pg8::Unit& u, int wr, int wc, int fr, int fq) const {
        const int row0 = u.pm * 256 + wr * 64 + fr, col0 = u.pn * 256 + wc * 32 + 4 * fq;
#pragma unroll
        for (int ai = 0; ai < 2; ++ai)
#pragma unroll
            for (int m = 0; m < 4; ++m) {
                const size_t off = (size_t)(row0 + ai * 128 + m * 16) * D + col0;
#pragma unroll
                for (int bj = 0; bj < 2; ++bj)
#pragma unroll
                    for (int n = 0; n < 2; ++n) { const f32x4 xv = *(const f32x4*)(X + off + bj * 128 + n * 16); st16(H + off + bj * 128 + n * 16, (v4u)(xv + acc[ai][bj][m][n])); }
            }
    }
};
struct EpiSwiglu {
    static constexpr bool PERM = true, AFTER_DRAIN = false;
    unsigned char* ACT; const float* b1;
    __device__ __forceinline__ void operator()(const pg8::f32x4 (&acc)[2][2][4][2], const pg8::Unit& u, int wr, int wc, int fr, int fq) const {
        const int e = u.pn >> 3, pn = u.pn & 7, row0 = u.pm * 256 + wr * 64 + fr, col = pn * 128 + wc * 32 + 8 * fq;
        const float* bg = b1 + (size_t)e * 2048 + col; const float* bl = bg + 1024;
        float g[8], l[8];
#pragma unroll
        for (int i = 0; i < 8; ++i) { g[i] = bg[i]; l[i] = bl[i]; }
#pragma unroll
        for (int ai = 0; ai < 2; ++ai)
#pragma unroll
            for (int m = 0; m < 4; ++m) {
                f32x4 o[2];
#pragma unroll
                for (int n = 0; n < 2; ++n)
#pragma unroll
                    for (int i = 0; i < 4; ++i) {
                        const float hg = fminf(acc[ai][0][m][n][i] * (1.0f / (SC_N2 * SC_W)) + g[4 * n + i], SW_LIMIT);
                        const float hl = fminf(fmaxf(acc[ai][1][m][n][i] * (1.0f / (SC_N2 * SC_W)) + l[4 * n + i], -SW_LIMIT), SW_LIMIT);
                        o[n][i] = hg * sigm(SW_ALPHA * hg) * (hl + 1.0f) * SC_ACT;
                    }
                v2u w; w.x = pk4_fp8(o[0][0], o[0][1], o[0][2], o[0][3]); w.y = pk4_fp8(o[1][0], o[1][1], o[1][2], o[1][3]);
#if defined(MOE_MERGED)
                asm volatile("global_store_dwordx2 %0, %1, off sc0 sc1\n\ts_nop 1" :: "v"(ACT + (size_t)(row0 + ai * 128 + m * 16) * FF + col), "v"(w) : "memory");
#else
                st8(ACT + (size_t)(row0 + ai * 128 + m * 16) * FF + col, w);
#endif
            }
    }
};
struct EpiDown {
    static constexpr bool PERM = true, AFTER_DRAIN = false;
    bf16* YS; const float* b2;
    __device__ __forceinline__ void operator()(const pg8::f32x4 (&acc)[2][2][4][2], const pg8::Unit& u, int wr, int wc, int fr, int fq) const {
        const int e = u.pn >> 2, pn = u.pn & 3, row0 = u.pm * 256 + wr * 64 + fr, col0 = pn * 256 + wc * 32 + 8 * fq;
#pragma unroll
        for (int bj = 0; bj < 2; ++bj) {
            const float* bp = b2 + (size_t)e * D + col0 + bj * 128;
            const f32x4 b0 = *(const f32x4*)bp, b1v = *(const f32x4*)(bp + 4);
#pragma unroll
            for (int ai = 0; ai < 2; ++ai)
#pragma unroll
                for (int m = 0; m < 4; ++m)
                    st8bf(YS + (size_t)(row0 + ai * 128 + m * 16) * D + col0 + bj * 128, acc[ai][bj][m][0] * (1.0f / (SC_ACT * SC_W)) + b0, acc[ai][bj][m][1] * (1.0f / (SC_ACT * SC_W)) + b1v);
        }
    }
};
struct MoeOrder {
    const volatile LAS int* bs; int ntn, G, v; const volatile LAS int* cl; const int* rowtok;
    __device__ __forceinline__ const int* a_list(const pg8::Unit& u) const { const int e = u.pn / ntn; return rowtok + e * MTOK + (u.pm - bs[e]) * 256; }
    __device__ __forceinline__ int a_valid(const pg8::Unit& u) const { const int e = u.pn / ntn; return min(256, cl[e] - (u.pm - bs[e]) * 256); }
    __device__ __forceinline__ bool next(int i, pg8::Unit& u) const {
        int L = i * G + v; const int nb = bs[32];
        if (L >= nb * ntn * (((PROBE_DUP) == 17 && ntn == 8) || ((PROBE_DUP) == 18 && ntn == 4) ? 2 : 1)) return false;
        if (L >= nb * ntn) L -= nb * ntn;
        const int mb = L / ntn, pn = L - mb * ntn;
        const int ln = (int)(threadIdx.x & 63);
        const int e = __popcll(__ballot(ln < NE - 1 && bs[ln + 1] <= mb));
        u.pm = mb; u.pn = e * ntn + pn; return true;
    }
    __device__ __forceinline__ bool a_is_list(const pg8::Unit&) const { return true; }
    __device__ __forceinline__ unsigned a_base(const pg8::Unit&) const { return 0u; }
    __device__ __forceinline__ int a_row0(const pg8::Unit&) const { return 0; }
    __device__ __forceinline__ void a_ready(const pg8::Unit&) const {}
    __device__ __forceinline__ void done(const pg8::Unit&) const {}
    __device__ __forceinline__ int done_defer(const pg8::Unit&) const { return -1; }
    __device__ __forceinline__ void done_signal(int) const {}
};
constexpr int CW_BLK = 32768;
struct MoeOrder2 {
    const volatile LAS int* bs; int G, v; const volatile LAS int* cl; const int* rowtok; unsigned* ctl;
    __device__ __forceinline__ bool is_down(const pg8::Unit& u) const { return u.pn >= 512; }
    __device__ __forceinline__ int expert(const pg8::Unit& u) const { return is_down(u) ? (u.pn - 512) >> 2 : u.pn >> 3; }
    __device__ __forceinline__ bool a_is_list(const pg8::Unit& u) const { return !is_down(u); }
    __device__ __forceinline__ unsigned a_base(const pg8::Unit& u) const { return is_down(u) ? (unsigned)WS_ACT : (unsigned)WS_XN; }
    __device__ __forceinline__ int a_row0(const pg8::Unit& u) const { return u.pm * 256; }
    __device__ __forceinline__ const int* a_list(const pg8::Unit& u) const { const int e = expert(u); return rowtok + e * MTOK + (u.pm - bs[e]) * 256; }
    __device__ __forceinline__ int a_valid(const pg8::Unit& u) const { const int e = expert(u); return min(256, cl[e] - (u.pm - bs[e]) * 256); }
    __device__ __forceinline__ bool next(int i, pg8::Unit& u) const {
        const int L = i * G + v, nb = bs[32];
        if (L >= nb * 12) return false;
        const bool dn = L >= nb * 8; const int L2 = dn ? L - nb * 8 : L, ntn = dn ? 4 : 8;
        const int mb = L2 / ntn, pn = L2 - mb * ntn;
        const int ln = (int)(threadIdx.x & 63);
        const int e = __popcll(__ballot(ln < NE - 1 && bs[ln + 1] <= mb));
        u.pm = mb; u.pn = (dn ? 512 : 0) + e * ntn + pn; return true;
    }
    __device__ __forceinline__ void a_ready(const pg8::Unit& u) const {
        if (!is_down(u)) return;
        if (threadIdx.x < 64) {
            const unsigned long long t0 = __builtin_amdgcn_s_memrealtime(); unsigned polls = 0;
            while ((unsigned)__builtin_amdgcn_readfirstlane(__hip_atomic_load(ctl + CW_BLK + 64 * u.pm, __ATOMIC_RELAXED, __HIP_MEMORY_SCOPE_AGENT)) < 64u) {
                if ((++polls & 255u) == 0u && __builtin_amdgcn_readfirstlane(__hip_atomic_load(ctl + 1, __ATOMIC_RELAXED, __HIP_MEMORY_SCOPE_AGENT)) != 0u) break;
                if (__builtin_amdgcn_s_memrealtime() - t0 > 2000000ull) { if (threadIdx.x == 0) __hip_atomic_store(ctl + 1, 1u, __ATOMIC_RELAXED, __HIP_MEMORY_SCOPE_AGENT); break; }
                __builtin_amdgcn_s_sleep(2); }
            __builtin_amdgcn_fence(__ATOMIC_ACQUIRE, "agent");
            asm volatile("s_waitcnt vmcnt(0)" ::: "memory");
        }
        asm volatile("" ::: "memory"); __builtin_amdgcn_s_barrier(); asm volatile("" ::: "memory");
    }
    __device__ __forceinline__ void done(const pg8::Unit&) const {}
    __device__ __forceinline__ int done_defer(const pg8::Unit& u) const { return is_down(u) ? -1 : u.pm; }
    __device__ __forceinline__ void done_signal(int mb) const { if ((threadIdx.x & 63) == 0) __hip_atomic_fetch_add(ctl + CW_BLK + 64 * mb, 1u, __ATOMIC_RELAXED, __HIP_MEMORY_SCOPE_AGENT); }
};
struct EpiMoe {
    static constexpr bool PERM = true, AFTER_DRAIN = false;
    EpiSwiglu up; EpiDown down;
    __device__ __forceinline__ void operator()(const pg8::f32x4 (&acc)[2][2][4][2], const pg8::Unit& u, int wr, int wc, int fr, int fq) const {
        if (u.pn >= 512) { pg8::Unit d; d.pm = u.pm; d.pn = u.pn - 512; down(acc, d, wr, wc, fr, fq); } else up(acc, u, wr, wc, fr, fq);
    }
};

#ifndef PROBE_DUP
#define PROBE_DUP -1
#endif
struct OrderRep : pg8::StaticOrder {
    int reps;
    __device__ __forceinline__ bool next(int i, pg8::Unit& u) const {
        const int per = (nwg + G - 1) / G, r = i / per;
        if (r >= reps) return false;
        return pg8::StaticOrder::next(i - r * per, u) ? true : ((r + 1 < reps) ? pg8::StaticOrder::next(0, u) : false);
    }
};
struct RmIdent { __device__ __forceinline__ int operator()(int n) const { return n; } };
struct RmWin {
    __device__ __forceinline__ int operator()(int n) const {
        if (n < 2560) return n;
        if (n < 3072) { const int j = n - 2560; return 2560 + (j >> 7) * 256 + (j & 127); }
        const int j = n - 3072; return 2560 + (j >> 7) * 256 + 128 + (j & 127);
    }
};
struct RmW1 {
    __device__ __forceinline__ int operator()(int n) const {
        if (n < 1024) return (n >> 7) * 256 + (n & 127);
        const int j = n - 1024; return (j >> 7) * 256 + 128 + (j & 127);
    }
};
__device__ __forceinline__ void p0_load(const float* W, int N, int item, int lane, f32x4 (&v)[8]) {
    const int nblk = N / 32, kb = item / nblk, nb = item % nblk, k0 = 64 * kb, n0 = 32 * nb;
    const int r8 = lane >> 3, c4 = lane & 7;
#pragma unroll
    for (int i = 0; i < 8; ++i) v[i] = *(const f32x4*)(W + (size_t)(k0 + 8 * i + r8) * N + n0 + 4 * c4);
}
template <bool FP8OUT, class RM>
__device__ __forceinline__ void p0_finish(const f32x4 (&v)[8], int K, int N, void* WTv, RM rm, LAS float* scr, int item, int lane) {
    const int nblk = N / 32, kb = item / nblk, nb = item % nblk, k0 = 64 * kb, n0 = 32 * nb;
    const int r8 = lane >> 3, c4 = lane & 7;
#pragma unroll
    for (int i = 0; i < 8; ++i) *(LAS f32x4*)(scr + (8 * i + r8) * 36 + 4 * c4) = v[i];
    LDS_WAIT(); asm volatile("" ::: "memory");
    const int n = lane & 31, kh = lane >> 5; const LAS float* s = scr + (32 * kh) * 36 + n;
    if constexpr (FP8OUT) {
        unsigned w[8];
#pragma unroll
        for (int j = 0; j < 8; ++j) w[j] = pk4_fp8(s[(4 * j) * 36] * SC_W, s[(4 * j + 1) * 36] * SC_W, s[(4 * j + 2) * 36] * SC_W, s[(4 * j + 3) * 36] * SC_W);
        GAS v4u* dst = (GAS v4u*)((unsigned char*)WTv + (size_t)rm(n0 + n) * K + k0 + 32 * kh);
        dst[0] = (v4u){w[0], w[1], w[2], w[3]}; dst[1] = (v4u){w[4], w[5], w[6], w[7]};
    } else {
        unsigned w[16];
#pragma unroll
        for (int j = 0; j < 16; ++j) w[j] = pk2(s[(2 * j) * 36], s[(2 * j + 1) * 36]);
        GAS v4u* dst = (GAS v4u*)((bf16*)WTv + (size_t)rm(n0 + n) * K + k0 + 32 * kh);
#pragma unroll
        for (int q = 0; q < 4; ++q) dst[q] = (v4u){w[4 * q], w[4 * q + 1], w[4 * q + 2], w[4 * q + 3]};
    }
    LDS_WAIT(); asm volatile("" ::: "memory");
}
template <bool FP8OUT, class RM>
__device__ __forceinline__ void p0_item(const float* W, int K, int N, void* WTv, RM rm, LAS float* scr, int item, int lane) {
    f32x4 v[8]; p0_load(W, N, item, lane, v); p0_finish<FP8OUT>(v, K, N, WTv, rm, scr, item, lane);
}
template <class RM>
__device__ __forceinline__ void convert_range_fp8(const float* W, int K, int N, unsigned char* WT, RM rm, int ipe_log2, int first, int stride, int count, int base, LAS float* scr, int lane) {
    const size_t esz = (size_t)K * N; const int mask = (1 << ipe_log2) - 1;
    f32x4 va[8], vb[8];
    int it = first;
    if (it < count) p0_load(W + (size_t)((base + it) >> ipe_log2) * esz, N, (base + it) & mask, lane, va);
    while (it < count) {
        const int i1 = it + stride, i2 = it + 2 * stride;
        if (i1 < count) p0_load(W + (size_t)((base + i1) >> ipe_log2) * esz, N, (base + i1) & mask, lane, vb);
        p0_finish<true>(va, K, N, WT + (size_t)((base + it) >> ipe_log2) * esz, rm, scr, (base + it) & mask, lane);
        if (i1 >= count) break;
        if (i2 < count) p0_load(W + (size_t)((base + i2) >> ipe_log2) * esz, N, (base + i2) & mask, lane, va);
        p0_finish<true>(vb, K, N, WT + (size_t)((base + i1) >> ipe_log2) * esz, rm, scr, (base + i1) & mask, lane);
        it = i2;
    }
}
__device__ __forceinline__ void rms_row_to_bf16(const float* xrow, const float* w, bf16* orow, int lane) {
    const f32x4* xr = (const f32x4*)xrow + lane; const f32x4* wr = (const f32x4*)w + lane;
    f32x4 v[4]; float s = 0.f;
#pragma unroll
    for (int j = 0; j < 4; ++j) { v[j] = xr[64 * j]; s += (v[j].x * v[j].x + v[j].y * v[j].y) + (v[j].z * v[j].z + v[j].w * v[j].w); }
    const float rstd = rsqrtf(wave_sum(s) * (1.f / D) + EPS);
    v2u* o8 = (v2u*)orow + lane;
#pragma unroll
    for (int j = 0; j < 4; ++j) { const f32x4 g = wr[64 * j]; v2u o; o.x = pk2(v[j].x * rstd * g.x, v[j].y * rstd * g.y); o.y = pk2(v[j].z * rstd * g.z, v[j].w * rstd * g.w); o8[64 * j] = o; }
}


__device__ __forceinline__ pg8::bf16x8 lds_frag(const LAS unsigned char* p) { return *(const LAS pg8::bf16x8*)p; }
__device__ __forceinline__ pg8::bf16x8 mk_frag(v2u a, v2u b) { const v4u w = (v4u){a.x, a.y, b.x, b.y}; return (pg8::bf16x8)w; }
#ifndef PROBE_TID
#define PROBE_TID 0
#endif
#define HG_PSTAMP(lds_, n_, code_) do { if ((PROBE_STAMP) >= 660 && (PROBE_STAMP) <= 669 && (n_) == 5 && threadIdx.x == (PROBE_TID)) { \
        if ((code_) == 660) *(volatile LAS unsigned long long*)((lds_) + LDSCTL_OFF + 640) = __builtin_amdgcn_s_memrealtime(); \
        if ((code_) == (PROBE_STAMP)) *(volatile LAS unsigned long long*)((lds_) + LDSCTL_OFF + 648) = __builtin_amdgcn_s_memrealtime(); } } while (0)
struct HgCtx {
    LAS unsigned char* lds; const bf16 *Qb, *Kp, *Vb; const float* Lp; float* Op;
    int b, h, dir, vh, lane, wave, lr, lq, dA, seg, tauB, dg;
    unsigned offA[16], offB, offV, ke_tr, v_tr;
};
constexpr int HG_BF = 0, HG_AM = 0, HG_QI = 33792, HG_KK = 51200, HG_KE = 68608, HG_V = 86016, HG_ST = 95232, HG_SEG = 112640, HG_DEC = 114688;
constexpr int HG_RSD = 272, HG_RSS = 144, HG_RSBF = 528;
__device__ __forceinline__ void hgrn_load(const HgCtx& c, int n, float (&lf)[16], v4u (&qB)[2], v4u (&kB)[2], v4u& vB) {
    const size_t cb = (size_t)__builtin_amdgcn_readfirstlane(c.b * TT + (c.dir ? (TT / 64 - 1 - n) * 64 : n * 64)) * 512 + c.h * 128;
    const float* Lc = c.Lp + cb; const bf16* Qc = c.Qb + cb; const bf16* Kc = c.Kp + cb; const bf16* Vc = c.Vb + cb;
#pragma unroll
    for (int i = 0; i < 16; ++i) lf[i] = Lc[c.offA[i]];
    qB[0] = *(const v4u*)(Qc + c.offB); qB[1] = *(const v4u*)(Qc + c.offB + 8); kB[0] = *(const v4u*)(Kc + c.offB); kB[1] = *(const v4u*)(Kc + c.offB + 8);
    vB = *(const v4u*)(Vc + c.offV);
}
__device__ __forceinline__ void hgrn_chunk(const HgCtx& c, int n, float (&lf)[16], v4u (&qB)[2], v4u (&kB)[2], v4u& vB, f32x4 (&S)[4]) {
    LAS unsigned char* lds = c.lds;
    const int dir = c.dir, lr = c.lr, lq = c.lq, wave = c.wave, dA = c.dA, seg = c.seg, tauB = c.tauB, dg = c.dg;
    const int tb = c.b * TT + (dir ? (TT / 64 - 1 - n) * 64 : n * 64); HG_PSTAMP(lds, n, 660);
    float bl[16]; { float cs = 0.f;
#pragma unroll
        for (int i = 0; i < 16; ++i) { cs += lf[i]; bl[i] = cs; }
        *(LAS float*)(lds + HG_SEG + (seg * 128 + dA) * 4) = cs; }
    __syncthreads();
    HG_PSTAMP(lds, n, 661);
    {
        const float p0 = *(LAS float*)(lds + HG_SEG + (0 * 128 + dA) * 4), p1 = *(LAS float*)(lds + HG_SEG + (1 * 128 + dA) * 4),
                    p2 = *(LAS float*)(lds + HG_SEG + (2 * 128 + dA) * 4), p3 = *(LAS float*)(lds + HG_SEG + (3 * 128 + dA) * 4);
        const float pre = (seg > 0 ? p0 : 0.f) + (seg > 1 ? p1 : 0.f) + (seg > 2 ? p2 : 0.f);
#pragma unroll
        for (int i = 0; i < 16; ++i) *(LAS float*)(lds + HG_BF + (16 * seg + i) * HG_RSBF + dA * 4) = pre + bl[i];
        if (seg == 0) *(LAS float*)(lds + HG_DEC + dA * 4) = __expf((p0 + p1) + (p2 + p3));
    }
    __syncthreads();
    HG_PSTAMP(lds, n, 662);
    {
        const unsigned qw[8] = {qB[0].x, qB[0].y, qB[0].z, qB[0].w, qB[1].x, qB[1].y, qB[1].z, qB[1].w};
        const unsigned kw[8] = {kB[0].x, kB[0].y, kB[0].z, kB[0].w, kB[1].x, kB[1].y, kB[1].z, kB[1].w};
        unsigned qo[8], ko[8], eo[8];
#pragma unroll
        for (int i = 0; i < 4; ++i) {
            const f32x4 bb = *(const LAS f32x4*)(lds + HG_BF + tauB * HG_RSBF + dg * 64 + i * 16);
            const f32x4 dc = *(const LAS f32x4*)(lds + HG_DEC + dg * 64 + i * 16);
#pragma unroll
            for (int j = 0; j < 2; ++j) {
                const float e0 = __expf(bb[2 * j]), e1 = __expf(bb[2 * j + 1]);
                const unsigned qq = qw[2 * i + j], kk = kw[2 * i + j];
                const float k0 = bf2f(kk & 0xffffu) * __builtin_amdgcn_rcpf(e0), k1 = bf2f(kk >> 16) * __builtin_amdgcn_rcpf(e1);
                qo[2 * i + j] = pk2(bf2f(qq & 0xffffu) * e0, bf2f(qq >> 16) * e1);
                ko[2 * i + j] = pk2(k0, k1);
                eo[2 * i + j] = pk2(k0 * dc[2 * j], k1 * dc[2 * j + 1]);
            }
        }
        *(LAS v4u*)(lds + HG_QI + tauB * HG_RSD + dg * 32) = (v4u){qo[0], qo[1], qo[2], qo[3]}; *(LAS v4u*)(lds + HG_QI + tauB * HG_RSD + dg * 32 + 16) = (v4u){qo[4], qo[5], qo[6], qo[7]};
        *(LAS v4u*)(lds + HG_KK + tauB * HG_RSD + dg * 32) = (v4u){ko[0], ko[1], ko[2], ko[3]}; *(LAS v4u*)(lds + HG_KK + tauB * HG_RSD + dg * 32 + 16) = (v4u){ko[4], ko[5], ko[6], ko[7]};
        *(LAS v4u*)(lds + HG_KE + tauB * HG_RSD + dg * 32) = (v4u){eo[0], eo[1], eo[2], eo[3]}; *(LAS v4u*)(lds + HG_KE + tauB * HG_RSD + dg * 32 + 16) = (v4u){eo[4], eo[5], eo[6], eo[7]};
        *(LAS v4u*)(lds + HG_V + tauB * HG_RSS + dg * 16) = vB;
    }
    __syncthreads();
    HG_PSTAMP(lds, n, 663);
    if (n + 2 < TT / 64) hgrn_load(c, n + 2, lf, qB, kB, vB);
    HG_PSTAMP(lds, n, 666);
    const int ei = wave & 3, tp = wave >> 2;
    v2u ket[2][2], vt[4][2][2];
    asm volatile("ds_read_b64_tr_b16 %0, %4\n\tds_read_b64_tr_b16 %1, %4 offset:1088\n\tds_read_b64_tr_b16 %2, %4 offset:8704\n\tds_read_b64_tr_b16 %3, %4 offset:9792"
                 : "=&v"(ket[0][0]), "=&v"(ket[0][1]), "=&v"(ket[1][0]), "=&v"(ket[1][1]) : "v"(c.ke_tr) : "memory");
#define HG_VTR(e4, o0, o1, o2, o3) asm volatile("ds_read_b64_tr_b16 %0, %4 offset:" #o0 "\n\tds_read_b64_tr_b16 %1, %4 offset:" #o1 "\n\tds_read_b64_tr_b16 %2, %4 offset:" #o2 "\n\tds_read_b64_tr_b16 %3, %4 offset:" #o3 \
                 : "=&v"(vt[e4][0][0]), "=&v"(vt[e4][0][1]), "=&v"(vt[e4][1][0]), "=&v"(vt[e4][1][1]) : "v"(c.v_tr) : "memory")
    HG_VTR(0, 0, 576, 4608, 5184); HG_VTR(1, 32, 608, 4640, 5216); HG_VTR(2, 64, 640, 4672, 5248); HG_VTR(3, 96, 672, 4704, 5280);
#undef HG_VTR
    {
        const int ti = wave & 3;
#pragma unroll
        for (int sii = 0; sii < 2; ++sii) {
            const int si = tp * 2 + sii;
            v2u w = (v2u){0u, 0u};
            if (si <= ti) {
                f32x4 a = (f32x4){0.f, 0.f, 0.f, 0.f};
#pragma unroll
                for (int kk = 0; kk < 4; ++kk)
                    a = __builtin_amdgcn_mfma_f32_16x16x32_bf16(lds_frag(lds + HG_KK + (16 * si + lr) * HG_RSD + kk * 64 + lq * 16), lds_frag(lds + HG_QI + (16 * ti + lr) * HG_RSD + kk * 64 + lq * 16), a, 0, 0, 0);
                const int s0 = 16 * si + 4 * lq, t = 16 * ti + lr;
                w.x = pk2(s0 + 0 <= t ? a[0] : 0.f, s0 + 1 <= t ? a[1] : 0.f); w.y = pk2(s0 + 2 <= t ? a[2] : 0.f, s0 + 3 <= t ? a[3] : 0.f);
            }
            *(LAS v2u*)(lds + HG_AM + (16 * ti + lr) * HG_RSS + (16 * si + 4 * lq) * 2) = w;
        }
    }
    f32x4 o[2];
#pragma unroll
    for (int tt = 0; tt < 2; ++tt) {
        o[tt] = (f32x4){0.f, 0.f, 0.f, 0.f};
#pragma unroll
        for (int kk = 0; kk < 4; ++kk)
            o[tt] = __builtin_amdgcn_mfma_f32_16x16x32_bf16(lds_frag(lds + HG_ST + (16 * ei + lr) * HG_RSD + kk * 64 + lq * 16), lds_frag(lds + HG_QI + (16 * (2 * tp + tt) + lr) * HG_RSD + kk * 64 + lq * 16), o[tt], 0, 0, 0);
    }
    HG_PSTAMP(lds, n, 667);
    asm volatile("s_waitcnt lgkmcnt(0)"
                 : "+v"(ket[0][0]), "+v"(ket[0][1]), "+v"(ket[1][0]), "+v"(ket[1][1]),
                   "+v"(vt[0][0][0]), "+v"(vt[0][0][1]), "+v"(vt[0][1][0]), "+v"(vt[0][1][1]), "+v"(vt[1][0][0]), "+v"(vt[1][0][1]), "+v"(vt[1][1][0]), "+v"(vt[1][1][1]),
                   "+v"(vt[2][0][0]), "+v"(vt[2][0][1]), "+v"(vt[2][1][0]), "+v"(vt[2][1][1]), "+v"(vt[3][0][0]), "+v"(vt[3][0][1]), "+v"(vt[3][1][0]), "+v"(vt[3][1][1]) :: "memory");
    {
        const f32x4 dv = *(const LAS f32x4*)(lds + HG_DEC + (16 * wave + 4 * lq) * 4);
#pragma unroll
        for (int e4 = 0; e4 < 4; ++e4) S[e4] = S[e4] * dv;
#pragma unroll
        for (int kk = 0; kk < 2; ++kk) {
            const pg8::bf16x8 af = mk_frag(ket[kk][0], ket[kk][1]);
#pragma unroll
            for (int e4 = 0; e4 < 4; ++e4) S[e4] = __builtin_amdgcn_mfma_f32_16x16x32_bf16(af, mk_frag(vt[e4][kk][0], vt[e4][kk][1]), S[e4], 0, 0, 0);
        }
    }
    HG_PSTAMP(lds, n, 668);
    const pg8::bf16x8 vf0 = ei == 0 ? mk_frag(vt[0][0][0], vt[0][0][1]) : ei == 1 ? mk_frag(vt[1][0][0], vt[1][0][1]) : ei == 2 ? mk_frag(vt[2][0][0], vt[2][0][1]) : mk_frag(vt[3][0][0], vt[3][0][1]);
    const pg8::bf16x8 vf1 = ei == 0 ? mk_frag(vt[0][1][0], vt[0][1][1]) : ei == 1 ? mk_frag(vt[1][1][0], vt[1][1][1]) : ei == 2 ? mk_frag(vt[2][1][0], vt[2][1][1]) : mk_frag(vt[3][1][0], vt[3][1][1]);
    __syncthreads();
    HG_PSTAMP(lds, n, 664);
#pragma unroll
    for (int tt = 0; tt < 2; ++tt) {
        o[tt] = __builtin_amdgcn_mfma_f32_16x16x32_bf16(vf0, lds_frag(lds + HG_AM + (16 * (2 * tp + tt) + lr) * HG_RSS + 0 * 64 + lq * 16), o[tt], 0, 0, 0);
        o[tt] = __builtin_amdgcn_mfma_f32_16x16x32_bf16(vf1, lds_frag(lds + HG_AM + (16 * (2 * tp + tt) + lr) * HG_RSS + 1 * 64 + lq * 16), o[tt], 0, 0, 0);
        const int t = 16 * (2 * tp + tt) + lr;
        { v2u ow; ow.x = pk2(o[tt][0], o[tt][1]); ow.y = pk2(o[tt][2], o[tt][3]);
          *(v2u*)((bf16*)c.Op + (size_t)(dir ? tb + 63 - t : tb + t) * 512 + c.h * 128 + c.vh * 64 + 16 * ei + 4 * lq) = ow; }
    }
#pragma unroll
    for (int e4 = 0; e4 < 4; ++e4) { v2u w; w.x = pk2(S[e4][0], S[e4][1]); w.y = pk2(S[e4][2], S[e4][3]); *(LAS v2u*)(lds + HG_ST + (16 * e4 + lr) * HG_RSD + (16 * wave + 4 * lq) * 2) = w; }
    HG_PSTAMP(lds, n, 665);
}
__device__ __forceinline__ void hgrn_unit(LAS unsigned char* lds, int unit, const bf16* Qb, const bf16* KFb, const bf16* KBb, const bf16* Vb, const float* LFb, const float* LBb,
                                          float* OFb, float* OBb, int tid, int lane, int wave) {
    HgCtx c;
    c.lds = lds; c.vh = unit & 1; c.dir = (unit >> 1) & 1; c.h = (unit >> 2) & 3; c.b = unit >> 4;
    c.Qb = Qb; c.Vb = Vb; c.Kp = c.dir ? KBb : KFb; c.Lp = c.dir ? LBb : LFb; c.Op = c.dir ? OBb : OFb;
    c.lane = lane; c.wave = wave; c.lr = lane & 15; c.lq = lane >> 4;
    c.dA = tid & 127; c.seg = tid >> 7;
    c.tauB = tid >> 3; c.dg = tid & 7;
    for (int i = tid; i < 64 * HG_RSD / 16; i += NTHR) *(LAS v4u*)(lds + HG_ST + i * 16) = (v4u){0u, 0u, 0u, 0u};
    f32x4 S[4];
#pragma unroll
    for (int i = 0; i < 4; ++i) S[i] = (f32x4){0.f, 0.f, 0.f, 0.f};
#pragma unroll
    for (int i = 0; i < 16; ++i) { const int tau = 16 * c.seg + i; c.offA[i] = (unsigned)((c.dir ? 63 - tau : tau) * 512 + c.dA); }
    c.offB = (unsigned)((c.dir ? 63 - c.tauB : c.tauB) * 512 + 16 * c.dg); c.offV = (unsigned)((c.dir ? 63 - c.tauB : c.tauB) * 512 + c.vh * 64 + 8 * c.dg);
    const unsigned trrow = (unsigned)(8 * c.lq + ((lane & 15) >> 2)), trcol = (unsigned)(4 * (lane & 3));
    c.ke_tr = (unsigned)(size_t)(lds + HG_KE) + trrow * HG_RSD + (16 * wave + trcol) * 2;
    c.v_tr = (unsigned)(size_t)(lds + HG_V) + trrow * HG_RSS + trcol * 2;
    float lf0[16], lf1[16]; v4u qB0[2], kB0[2], vB0, qB1[2], kB1[2], vB1;
    hgrn_load(c, 0, lf0, qB0, kB0, vB0); hgrn_load(c, 1, lf1, qB1, kB1, vB1);
#pragma unroll 1
    for (int n = 0; n < TT / 64; n += 2) { hgrn_chunk(c, n, lf0, qB0, kB0, vB0, S); hgrn_chunk(c, n + 1, lf1, qB1, kB1, vB1, S); }
    __syncthreads();
}

__device__ __forceinline__ void router_finish(float (&a)[NE], int m, int lane, const float* router_b, LAS int* lcnt, LAS unsigned* sbw, float* GATE) {
#define RF_STEP(s2, n) { const bool up = (lane & (s2)) != 0; _Pragma("unroll") for (int i = 0; i < (n); ++i) { const float k1 = up ? a[i + (n)] : a[i], x1 = up ? a[i] : a[i + (n)]; a[i] = k1 + __shfl_xor(x1, (s2)); } }
    RF_STEP(32, 16) RF_STEP(16, 8) RF_STEP(8, 4) RF_STEP(4, 2) RF_STEP(2, 1)
#undef RF_STEP
    float lg = a[0] + __shfl_xor(a[0], 1);
    const int myE = lane >> 1;
    lg += router_b[myE];
    float tv[TOPK]; int ti[TOPK];
#pragma unroll
    for (int k = 0; k < TOPK; ++k) {
        float mx = lg;
#pragma unroll
        for (int o = 1; o < 64; o <<= 1) mx = fmaxf(mx, __shfl_xor(mx, o));
        int cand = (lg == mx) ? myE : 99;
#pragma unroll
        for (int o = 1; o < 64; o <<= 1) cand = min(cand, __shfl_xor(cand, o));
        tv[k] = mx; ti[k] = cand;
        if (myE == cand) lg = -INFINITY;
    }
    const float e1 = __expf(tv[1] - tv[0]), e2 = __expf(tv[2] - tv[0]), e3 = __expf(tv[3] - tv[0]);
    const float inv = 1.0f / (1.0f + e1 + e2 + e3);
    if (lane < TOPK && m < MTOK) {
        const int ek = lane == 0 ? ti[0] : lane == 1 ? ti[1] : lane == 2 ? ti[2] : ti[3];
        const float gk = (lane == 0 ? 1.0f : lane == 1 ? e1 : lane == 2 ? e2 : e3) * inv;
        const int lr = __hip_atomic_fetch_add(&lcnt[ek], 1, __ATOMIC_RELAXED, __HIP_MEMORY_SCOPE_WORKGROUP);
        sbw[lane] = ((unsigned)ek << 16) | (unsigned)lr;
        GATE[(size_t)m * TOPK + lane] = gk;
    }
}

#ifndef PROBE_DELAY
#define PROBE_DELAY 0
#endif
__device__ __forceinline__ void probe_delay(int us100) { const unsigned long long t0 = __builtin_amdgcn_s_memrealtime(); while (__builtin_amdgcn_s_memrealtime() - t0 < (unsigned long long)us100) __builtin_amdgcn_s_sleep(2); }
constexpr int H3_QI = 0, H3_KK = 34816, H3_V = 69632, H3_DEC = 88064, H3_ST = 89088, H3_AM = 106496, H3_LH = 115712, H3_LL = 133120, H3_END = 150528;
constexpr int H3_BUFD = 17408, H3_BUFV = 9216, H3_BUFDEC = 512;
static_assert(H3_END <= LDSCTL_OFF, "recurrence LDS image below the control words");
struct Hg3 {
    LAS unsigned char* lds; const bf16 *Qb, *Kp, *Vb; const float* Lp; float* Op;
    int b, h, dir, vh, lane, lr, lq;
};
__device__ __forceinline__ size_t hg3_row(const Hg3& c, int n, int t) {
    const int tb = c.b * TT + (c.dir ? (TT / 64 - 1 - n) * 64 : n * 64);
    return (size_t)(c.dir ? tb + 63 - t : tb + t) * 512 + c.h * 128;
}
struct Hg3LV { f32x4 lf[8]; v4u v[2]; };
struct Hg3QK { v2u q[2][4], k[2][4]; };
__device__ __forceinline__ void gld16(f32x4& d, const void* p) { asm volatile("global_load_dwordx4 %0, %1, off" : "=v"(d) : "v"(p) : "memory"); }
__device__ __forceinline__ void gld16u(v4u& d, const void* p) { asm volatile("global_load_dwordx4 %0, %1, off" : "=v"(d) : "v"(p) : "memory"); }
__device__ __forceinline__ void gld8(v2u& d, const void* p) { asm volatile("global_load_dwordx2 %0, %1, off" : "=v"(d) : "v"(p) : "memory"); }
__device__ __forceinline__ void hg3_load_lv(const Hg3& c, int n, int pt, Hg3LV& in) {
    const size_t r = hg3_row(c, n, pt >> 2);
#pragma unroll
    for (int i = 0; i < 8; ++i) gld16(in.lf[i], c.Lp + r + 32 * (pt & 3) + 4 * i);
    gld16u(in.v[0], c.Vb + r + c.vh * 64 + 16 * (pt & 3)); gld16u(in.v[1], c.Vb + r + c.vh * 64 + 16 * (pt & 3) + 8);
}
__device__ __forceinline__ void hg3_load_qk(const Hg3& c, int n, int pw, Hg3QK& in) {
#pragma unroll
    for (int ti = 0; ti < 4; ++ti) { const size_t r = hg3_row(c, n, 16 * ti + c.lr);
#pragma unroll
        for (int dt = 0; dt < 2; ++dt) { const int d0 = 16 * (2 * pw + dt) + 4 * c.lq; gld8(in.q[dt][ti], c.Qb + r + d0); gld8(in.k[dt][ti], c.Kp + r + d0); } }
}
#define H3_USE_LV(x) asm volatile("" : "+v"((x).lf[0]), "+v"((x).lf[1]), "+v"((x).lf[2]), "+v"((x).lf[3]), "+v"((x).lf[4]), "+v"((x).lf[5]), "+v"((x).lf[6]), "+v"((x).lf[7]), "+v"((x).v[0]), "+v"((x).v[1]))
#define H3_USE_QK(x) asm volatile("" : "+v"((x).q[0][0]), "+v"((x).q[0][1]), "+v"((x).q[0][2]), "+v"((x).q[0][3]), "+v"((x).q[1][0]), "+v"((x).q[1][1]), "+v"((x).q[1][2]), "+v"((x).q[1][3]), \
                                           "+v"((x).k[0][0]), "+v"((x).k[0][1]), "+v"((x).k[0][2]), "+v"((x).k[0][3]), "+v"((x).k[1][0]), "+v"((x).k[1][1]), "+v"((x).k[1][2]), "+v"((x).k[1][3]))
__device__ __forceinline__ unsigned hg3_hi_lo(float x, float y, unsigned& lo) {
    const unsigned hi = pk2(x, y);
    lo = pk2(x - bf2f(hi & 0xffffu), y - bf2f(hi >> 16));
    return hi;
}
__device__ __forceinline__ void hg3_prep_a(const Hg3& c, int buf, int pt, const Hg3LV& in) {
    const int t = pt >> 2, dq = pt & 3;
#pragma unroll
    for (int i = 0; i < 8; ++i) { unsigned l0, l1; const unsigned h0 = hg3_hi_lo(in.lf[i].x, in.lf[i].y, l0), h1 = hg3_hi_lo(in.lf[i].z, in.lf[i].w, l1);
        *(LAS v2u*)(c.lds + H3_LH + t * 272 + (32 * dq + 4 * i) * 2) = (v2u){h0, h1}; *(LAS v2u*)(c.lds + H3_LL + t * 272 + (32 * dq + 4 * i) * 2) = (v2u){l0, l1}; }
    *(LAS v4u*)(c.lds + H3_V + buf * H3_BUFV + t * 144 + dq * 32) = in.v[0]; *(LAS v4u*)(c.lds + H3_V + buf * H3_BUFV + t * 144 + dq * 32 + 16) = in.v[1];
}
__device__ __forceinline__ void hg3_prep_b(const Hg3& c, int buf, int pw, const Hg3QK& in, const pg8::bf16x8 (&U)[4]) {
    LAS unsigned char* lds = c.lds; const int lr = c.lr, lq = c.lq, lane = c.lane;
    const unsigned trrow = (unsigned)(8 * lq + ((lane & 15) >> 2)), trcol = (unsigned)(4 * (lane & 3));
    const pg8::bf16x8 ones = (pg8::bf16x8)(v4u){0x3F803F80u, 0x3F803F80u, 0x3F803F80u, 0x3F803F80u};
#pragma unroll
    for (int dt = 0; dt < 2; ++dt) {
        const int dtile = 2 * pw + dt;
        v2u fh[2][2], fl[2][2];
        const unsigned ah = (unsigned)(size_t)(lds + H3_LH) + trrow * 272 + (16 * dtile + trcol) * 2, al = ah + (H3_LL - H3_LH);
        asm volatile("ds_read_b64_tr_b16 %0, %8\n\tds_read_b64_tr_b16 %1, %8 offset:1088\n\tds_read_b64_tr_b16 %2, %8 offset:8704\n\tds_read_b64_tr_b16 %3, %8 offset:9792\n\t"
                     "ds_read_b64_tr_b16 %4, %9\n\tds_read_b64_tr_b16 %5, %9 offset:1088\n\tds_read_b64_tr_b16 %6, %9 offset:8704\n\tds_read_b64_tr_b16 %7, %9 offset:9792\n\ts_waitcnt lgkmcnt(0)"
                     : "=&v"(fh[0][0]), "=&v"(fh[0][1]), "=&v"(fh[1][0]), "=&v"(fh[1][1]), "=&v"(fl[0][0]), "=&v"(fl[0][1]), "=&v"(fl[1][0]), "=&v"(fl[1][1]) : "v"(ah), "v"(al) : "memory");
        const pg8::bf16x8 H0 = mk_frag(fh[0][0], fh[0][1]), H1 = mk_frag(fh[1][0], fh[1][1]), L0 = mk_frag(fl[0][0], fl[0][1]), L1 = mk_frag(fl[1][0], fl[1][1]);
        f32x4 bt[4];
        const f32x4 z = (f32x4){0.f, 0.f, 0.f, 0.f};
        bt[0] = __builtin_amdgcn_mfma_f32_16x16x32_bf16(L0, U[0], z, 0, 0, 0);    bt[0] = __builtin_amdgcn_mfma_f32_16x16x32_bf16(H0, U[0], bt[0], 0, 0, 0);
        bt[1] = __builtin_amdgcn_mfma_f32_16x16x32_bf16(L0, U[1], z, 0, 0, 0);    bt[1] = __builtin_amdgcn_mfma_f32_16x16x32_bf16(H0, U[1], bt[1], 0, 0, 0);
        bt[2] = __builtin_amdgcn_mfma_f32_16x16x32_bf16(L0, ones, z, 0, 0, 0);    bt[2] = __builtin_amdgcn_mfma_f32_16x16x32_bf16(L1, U[2], bt[2], 0, 0, 0);
        bt[2] = __builtin_amdgcn_mfma_f32_16x16x32_bf16(H0, ones, bt[2], 0, 0, 0); bt[2] = __builtin_amdgcn_mfma_f32_16x16x32_bf16(H1, U[2], bt[2], 0, 0, 0);
        bt[3] = __builtin_amdgcn_mfma_f32_16x16x32_bf16(L0, ones, z, 0, 0, 0);    bt[3] = __builtin_amdgcn_mfma_f32_16x16x32_bf16(L1, U[3], bt[3], 0, 0, 0);
        bt[3] = __builtin_amdgcn_mfma_f32_16x16x32_bf16(H0, ones, bt[3], 0, 0, 0); bt[3] = __builtin_amdgcn_mfma_f32_16x16x32_bf16(H1, U[3], bt[3], 0, 0, 0);
        f32x4 de;
#pragma unroll
        for (int r = 0; r < 4; ++r) de[r] = __expf(__shfl(bt[3][r], 16 * lq + 15));
        if (lr == 0) *(LAS f32x4*)(lds + H3_DEC + buf * H3_BUFDEC + (16 * dtile + 4 * lq) * 4) = de;
#pragma unroll
        for (int ti = 0; ti < 4; ++ti) {
            const v2u qq = in.q[dt][ti], kk = in.k[dt][ti];
            const float e0 = __expf(bt[ti][0]), e1 = __expf(bt[ti][1]), e2 = __expf(bt[ti][2]), e3 = __expf(bt[ti][3]);
            v2u qo, ko;
            qo.x = pk2(bf2f(qq.x & 0xffffu) * e0, bf2f(qq.x >> 16) * e1); qo.y = pk2(bf2f(qq.y & 0xffffu) * e2, bf2f(qq.y >> 16) * e3);
            ko.x = pk2(bf2f(kk.x & 0xffffu) * __builtin_amdgcn_rcpf(e0), bf2f(kk.x >> 16) * __builtin_amdgcn_rcpf(e1));
            ko.y = pk2(bf2f(kk.y & 0xffffu) * __builtin_amdgcn_rcpf(e2), bf2f(kk.y >> 16) * __builtin_amdgcn_rcpf(e3));
            const int off = (16 * ti + lr) * 272 + (16 * dtile + 4 * lq) * 2;
            *(LAS v2u*)(lds + H3_QI + buf * H3_BUFD + off) = qo; *(LAS v2u*)(lds + H3_KK + buf * H3_BUFD + off) = ko;
        }
    }
}
__device__ __forceinline__ void hg3_stage1(const Hg3& c, int buf, int mw, f32x4 (&S)[2][4], f32x4 (&o)[2][2], v2u (&vt)[4][2][2]) {
    LAS unsigned char* lds = c.lds; const int lr = c.lr, lq = c.lq, lane = c.lane;
    const LAS unsigned char* QI = lds + H3_QI + buf * H3_BUFD; const LAS unsigned char* KK = lds + H3_KK + buf * H3_BUFD;
    const unsigned trrow = (unsigned)(8 * lq + ((lane & 15) >> 2)), trcol = (unsigned)(4 * (lane & 3));
    const unsigned kk_tr = (unsigned)(size_t)KK + trrow * 272 + (32 * mw + trcol) * 2;
    const unsigned v_tr = (unsigned)(size_t)(lds + H3_V + buf * H3_BUFV) + trrow * 144 + trcol * 2;
    const int tp = mw >> 1, ep = mw & 1;
    pg8::bf16x8 qf[2][4], sf[2][4], kf[3][4];
#pragma unroll
    for (int bq = 0; bq < 2; ++bq)
#pragma unroll
        for (int kk = 0; kk < 4; ++kk) { qf[bq][kk] = lds_frag(QI + (16 * (2 * tp + bq) + lr) * 272 + kk * 64 + lq * 16); sf[bq][kk] = lds_frag(lds + H3_ST + (16 * (2 * ep + bq) + lr) * 272 + kk * 64 + lq * 16); }
#pragma unroll
    for (int a = 0; a < 2; ++a)
#pragma unroll
        for (int bq = 0; bq < 2; ++bq) o[a][bq] = (f32x4){0.f, 0.f, 0.f, 0.f};
#pragma unroll
    for (int kk = 0; kk < 4; ++kk) {
        o[0][0] = __builtin_amdgcn_mfma_f32_16x16x32_bf16(sf[0][kk], qf[0][kk], o[0][0], 0, 0, 0); o[0][1] = __builtin_amdgcn_mfma_f32_16x16x32_bf16(sf[0][kk], qf[1][kk], o[0][1], 0, 0, 0);
        o[1][0] = __builtin_amdgcn_mfma_f32_16x16x32_bf16(sf[1][kk], qf[0][kk], o[1][0], 0, 0, 0); o[1][1] = __builtin_amdgcn_mfma_f32_16x16x32_bf16(sf[1][kk], qf[1][kk], o[1][1], 0, 0, 0);
    }
    __builtin_amdgcn_sched_barrier(0);
    const int ks0 = mw == 3 ? 1 : 0;
    if (mw != 1) {
#pragma unroll
        for (int x = 0; x < 3; ++x)
#pragma unroll
            for (int kk = 0; kk < 4; ++kk) kf[x][kk] = lds_frag(KK + (16 * (ks0 + x) + lr) * 272 + kk * 64 + lq * 16);
    }
    v2u kt[2][2][2];
    {
        f32x4 at[4];
#pragma unroll
        for (int i = 0; i < 4; ++i) at[i] = (f32x4){0.f, 0.f, 0.f, 0.f};
        if (mw != 1) {
#pragma unroll
            for (int kk = 0; kk < 4; ++kk) {
                at[0] = __builtin_amdgcn_mfma_f32_16x16x32_bf16(kf[0][kk], mw == 3 ? qf[1][kk] : qf[0][kk], at[0], 0, 0, 0);
                at[1] = __builtin_amdgcn_mfma_f32_16x16x32_bf16(mw == 0 ? kf[0][kk] : kf[1][kk], mw == 2 ? qf[0][kk] : qf[1][kk], at[1], 0, 0, 0);
                at[2] = __builtin_amdgcn_mfma_f32_16x16x32_bf16(mw == 0 ? kf[1][kk] : kf[2][kk], mw == 2 ? qf[0][kk] : qf[1][kk], at[2], 0, 0, 0);
                if (mw == 2) at[3] = __builtin_amdgcn_mfma_f32_16x16x32_bf16(kf[0][kk], qf[1][kk], at[3], 0, 0, 0);
            }
        }
    asm volatile("ds_read_b64_tr_b16 %0, %8\n\tds_read_b64_tr_b16 %1, %8 offset:1088\n\tds_read_b64_tr_b16 %2, %8 offset:8704\n\tds_read_b64_tr_b16 %3, %8 offset:9792\n\t"
                 "ds_read_b64_tr_b16 %4, %8 offset:32\n\tds_read_b64_tr_b16 %5, %8 offset:1120\n\tds_read_b64_tr_b16 %6, %8 offset:8736\n\tds_read_b64_tr_b16 %7, %8 offset:9824"
                 : "=&v"(kt[0][0][0]), "=&v"(kt[0][0][1]), "=&v"(kt[0][1][0]), "=&v"(kt[0][1][1]), "=&v"(kt[1][0][0]), "=&v"(kt[1][0][1]), "=&v"(kt[1][1][0]), "=&v"(kt[1][1][1]) : "v"(kk_tr) : "memory");
#define H3_VTR(e4, o0, o1, o2, o3) asm volatile("ds_read_b64_tr_b16 %0, %4 offset:" #o0 "\n\tds_read_b64_tr_b16 %1, %4 offset:" #o1 "\n\tds_read_b64_tr_b16 %2, %4 offset:" #o2 "\n\tds_read_b64_tr_b16 %3, %4 offset:" #o3 \
                 : "=&v"(vt[e4][0][0]), "=&v"(vt[e4][0][1]), "=&v"(vt[e4][1][0]), "=&v"(vt[e4][1][1]) : "v"(v_tr) : "memory")
    H3_VTR(0, 0, 576, 4608, 5184); H3_VTR(1, 32, 608, 4640, 5216); H3_VTR(2, 64, 640, 4672, 5248); H3_VTR(3, 96, 672, 4704, 5280);
#undef H3_VTR
#pragma unroll
        for (int i = 0; i < 4; ++i) {
            int si, ti; bool have = true, zero = false;
            if (mw == 0) { si = i == 2 ? 1 : 0; ti = i == 0 ? 0 : 1; have = i < 3; }
            else if (mw == 1) { si = 1; ti = 0; have = i == 0; zero = true; }
            else if (mw == 2) { si = i == 3 ? 0 : i; ti = i == 3 ? 3 : 2; }
            else { si = i == 3 ? 3 : i + 1; ti = i == 3 ? 2 : 3; zero = i == 3; }
            if (have) {
                const int s0 = 16 * si + 4 * lq, t = 16 * ti + lr; v2u w = (v2u){0u, 0u};
                if (!zero) { w.x = pk2(s0 + 0 <= t ? at[i][0] : 0.f, s0 + 1 <= t ? at[i][1] : 0.f); w.y = pk2(s0 + 2 <= t ? at[i][2] : 0.f, s0 + 3 <= t ? at[i][3] : 0.f); }
                *(LAS v2u*)(lds + H3_AM + (16 * ti + lr) * 144 + (16 * si + 4 * lq) * 2) = w;
            }
        }
    }
    asm volatile("s_waitcnt lgkmcnt(0)"
                 : "+v"(kt[0][0][0]), "+v"(kt[0][0][1]), "+v"(kt[0][1][0]), "+v"(kt[0][1][1]), "+v"(kt[1][0][0]), "+v"(kt[1][0][1]), "+v"(kt[1][1][0]), "+v"(kt[1][1][1]),
                   "+v"(vt[0][0][0]), "+v"(vt[0][0][1]), "+v"(vt[0][1][0]), "+v"(vt[0][1][1]), "+v"(vt[1][0][0]), "+v"(vt[1][0][1]), "+v"(vt[1][1][0]), "+v"(vt[1][1][1]),
                   "+v"(vt[2][0][0]), "+v"(vt[2][0][1]), "+v"(vt[2][1][0]), "+v"(vt[2][1][1]), "+v"(vt[3][0][0]), "+v"(vt[3][0][1]), "+v"(vt[3][1][0]), "+v"(vt[3][1][1]) :: "memory");
#pragma unroll
    for (int dt = 0; dt < 2; ++dt) {
#pragma unroll
        for (int kk = 0; kk < 2; ++kk) {
            const pg8::bf16x8 af = mk_frag(kt[dt][kk][0], kt[dt][kk][1]);
#pragma unroll
            for (int e4 = 0; e4 < 4; ++e4) S[dt][e4] = __builtin_amdgcn_mfma_f32_16x16x32_bf16(af, mk_frag(vt[e4][kk][0], vt[e4][kk][1]), S[dt][e4], 0, 0, 0);
        }
        const f32x4 dv = *(const LAS f32x4*)(lds + H3_DEC + buf * H3_BUFDEC + (16 * (2 * mw + dt) + 4 * lq) * 4);
#pragma unroll
        for (int e4 = 0; e4 < 4; ++e4) S[dt][e4] = S[dt][e4] * dv;
    }
}
__device__ __forceinline__ void hg3_stage2(const Hg3& c, int n, int mw, const f32x4 (&S)[2][4], f32x4 (&o)[2][2], const v2u (&vt)[4][2][2]) {
    LAS unsigned char* lds = c.lds; const int lr = c.lr, lq = c.lq;
#pragma unroll
    for (int bq = 0; bq < 2; ++bq) {
        const int ti = 2 * (mw >> 1) + bq;
        const pg8::bf16x8 a0 = lds_frag(lds + H3_AM + (16 * ti + lr) * 144 + 0 * 64 + lq * 16);
#pragma unroll
        for (int a = 0; a < 2; ++a) { const int e4 = 2 * (mw & 1) + a;
            const pg8::bf16x8 vf = e4 == 0 ? mk_frag(vt[0][0][0], vt[0][0][1]) : e4 == 1 ? mk_frag(vt[1][0][0], vt[1][0][1]) : e4 == 2 ? mk_frag(vt[2][0][0], vt[2][0][1]) : mk_frag(vt[3][0][0], vt[3][0][1]);
            o[a][bq] = __builtin_amdgcn_mfma_f32_16x16x32_bf16(vf, a0, o[a][bq], 0, 0, 0); }
        if (mw >> 1) {
            const pg8::bf16x8 a1 = lds_frag(lds + H3_AM + (16 * ti + lr) * 144 + 1 * 64 + lq * 16);
#pragma unroll
            for (int a = 0; a < 2; ++a) { const int e4 = 2 * (mw & 1) + a;
                const pg8::bf16x8 vf = e4 == 0 ? mk_frag(vt[0][1][0], vt[0][1][1]) : e4 == 1 ? mk_frag(vt[1][1][0], vt[1][1][1]) : e4 == 2 ? mk_frag(vt[2][1][0], vt[2][1][1]) : mk_frag(vt[3][1][0], vt[3][1][1]);
                o[a][bq] = __builtin_amdgcn_mfma_f32_16x16x32_bf16(vf, a1, o[a][bq], 0, 0, 0); }
        }
#pragma unroll
        for (int a = 0; a < 2; ++a)
            *(f32x4*)(c.Op + hg3_row(c, n, 16 * ti + lr) + c.vh * 64 + 16 * (2 * (mw & 1) + a) + 4 * lq) = o[a][bq];
    }
#pragma unroll
    for (int dt = 0; dt < 2; ++dt)
#pragma unroll
        for (int e4 = 0; e4 < 4; ++e4) { v2u w; w.x = pk2(S[dt][e4][0], S[dt][e4][1]); w.y = pk2(S[dt][e4][2], S[dt][e4][3]);
            *(LAS v2u*)(lds + H3_ST + (16 * e4 + lr) * 272 + (16 * (2 * mw + dt) + 4 * lq) * 2) = w; }
}
__device__ __forceinline__ void hgrn3_unit(LAS unsigned char* lds, int unit, const bf16* Qb, const bf16* KFb, const bf16* KBb, const bf16* Vb, const float* LFb, const float* LBb,
                                           float* OFb, float* OBb, int tid, int lane, int wave) {
    Hg3 c;
    c.lds = lds; c.vh = unit & 1; c.dir = (unit >> 1) & 1; c.h = (unit >> 2) & 3; c.b = unit >> 4;
    c.Qb = Qb; c.Vb = Vb; c.Kp = c.dir ? KBb : KFb; c.Lp = c.dir ? LBb : LFb; c.Op = c.dir ? OBb : OFb;
    c.lane = lane; c.lr = lane & 15; c.lq = lane >> 4;
    constexpr int NCH = TT / 64;
    for (int i = tid; i < 64 * 272 / 16; i += NTHR) *(LAS v4u*)(lds + H3_ST + i * 16) = (v4u){0u, 0u, 0u, 0u};
    if (wave < 4) {
        const int pt = tid, pw = wave;
        pg8::bf16x8 U[4];
#pragma unroll
        for (int u = 0; u < 4; ++u) { const int kk = u >> 1, ti = u; unsigned wv[4];
#pragma unroll
            for (int j2 = 0; j2 < 4; ++j2) { const int s = 32 * kk + 8 * c.lq + 2 * j2, t = 16 * ti + c.lr; wv[j2] = (s <= t ? 0x3F80u : 0u) | (s + 1 <= t ? 0x3F800000u : 0u); }
            U[u] = (pg8::bf16x8)(v4u){wv[0], wv[1], wv[2], wv[3]}; }
        Hg3LV lv0, lv1; Hg3QK qk;
        hg3_load_lv(c, 0, pt, lv0); hg3_load_qk(c, 0, pw, qk); hg3_load_lv(c, 1, pt, lv1);
        asm volatile("s_waitcnt vmcnt(0)" ::: "memory"); H3_USE_LV(lv0); H3_USE_QK(qk); H3_USE_LV(lv1);
        hg3_prep_a(c, 0, pt, lv0);
        __syncthreads();
#define H3_TRIP(j_, LVN, LVC) do { \
            if ((j_) < NCH) { asm volatile("s_waitcnt vmcnt(10)" ::: "memory"); H3_USE_QK(qk); hg3_prep_b(c, (j_) & 1, pw, qk, U); \
                if ((j_) + 1 < NCH) hg3_load_qk(c, (j_) + 1, pw, qk); else hg3_load_qk(c, (j_), pw, qk);     \
                if ((j_) + 2 < NCH) hg3_load_lv(c, (j_) + 2, pt, LVC); else hg3_load_lv(c, (j_), pt, LVC); } \
            if (PROBE_DELAY == 2) probe_delay(100); \
            __syncthreads();                                                                    \
            if ((j_) + 1 < NCH) { asm volatile("s_waitcnt vmcnt(26)" ::: "memory"); H3_USE_LV(LVN); hg3_prep_a(c, ((j_) + 1) & 1, pt, LVN); } \
            __syncthreads();                                                                    \
        } while (0)
#pragma unroll 1
        for (int j = 0; j <= NCH; j += 2) { H3_TRIP(j, lv1, lv0); H3_TRIP(j + 1, lv0, lv1); }
#undef H3_TRIP
        asm volatile("s_waitcnt vmcnt(0)" ::: "memory");
    } else {
        const int mw = wave - 4;
        f32x4 S[2][4], o[2][2]; v2u vt[4][2][2];
#pragma unroll
        for (int a = 0; a < 2; ++a)
#pragma unroll
            for (int e4 = 0; e4 < 4; ++e4) S[a][e4] = (f32x4){0.f, 0.f, 0.f, 0.f};
        __syncthreads();
#pragma unroll 1
        for (int j = 0; j <= NCH + 1; ++j) {
            if (j > 0 && j <= NCH) hg3_stage1(c, (j - 1) & 1, mw, S, o, vt);
            if (PROBE_DELAY == 1) probe_delay(100);
            __syncthreads();
            if (j > 0 && j <= NCH) hg3_stage2(c, j - 1, mw, S, o, vt);
            __syncthreads();
        }
    }
    __syncthreads();
}


struct Hg4LV { f32x4 lf[4]; v4u v; };
struct Hg4QK { v2u q[4], k[4]; };
__device__ __forceinline__ void hg4_load_lv(const Hg3& c, int n, int tid, Hg4LV& in) {
    const size_t r = hg3_row(c, n, tid >> 3);
#pragma unroll
    for (int i = 0; i < 4; ++i) gld16(in.lf[i], c.Lp + r + 16 * (tid & 7) + 4 * i);
    gld16u(in.v, c.Vb + r + c.vh * 64 + 8 * (tid & 7));
}
__device__ __forceinline__ void hg4_load_qk(const Hg3& c, int n, int w, Hg4QK& in) {
#pragma unroll
    for (int ti = 0; ti < 4; ++ti) { const size_t r = hg3_row(c, n, 16 * ti + c.lr) + 16 * w + 4 * c.lq; gld8(in.q[ti], c.Qb + r); gld8(in.k[ti], c.Kp + r); }
}
#define H4_USE_LV(x) asm volatile("" : "+v"((x).lf[0]), "+v"((x).lf[1]), "+v"((x).lf[2]), "+v"((x).lf[3]), "+v"((x).v))
#define H4_USE_QK(x) asm volatile("" : "+v"((x).q[0]), "+v"((x).q[1]), "+v"((x).q[2]), "+v"((x).q[3]), "+v"((x).k[0]), "+v"((x).k[1]), "+v"((x).k[2]), "+v"((x).k[3]))
__device__ __forceinline__ void hg4_prep_a(const Hg3& c, int buf, int tid, const Hg4LV& in) {
    const int t = tid >> 3, dq = tid & 7;
#pragma unroll
    for (int i = 0; i < 4; ++i) { unsigned l0, l1; const unsigned h0 = hg3_hi_lo(in.lf[i].x, in.lf[i].y, l0), h1 = hg3_hi_lo(in.lf[i].z, in.lf[i].w, l1);
        *(LAS v2u*)(c.lds + H3_LH + t * 272 + (16 * dq + 4 * i) * 2) = (v2u){h0, h1}; *(LAS v2u*)(c.lds + H3_LL + t * 272 + (16 * dq + 4 * i) * 2) = (v2u){l0, l1}; }
    *(LAS v4u*)(c.lds + H3_V + buf * H3_BUFV + t * 144 + dq * 16) = in.v;
}
__device__ __forceinline__ void hg4_prep_b(const Hg3& c, int buf, int w, const Hg4QK& in, const pg8::bf16x8 (&U)[4]) {
    LAS unsigned char* lds = c.lds; const int lr = c.lr, lq = c.lq, lane = c.lane;
    const unsigned trrow = (unsigned)(8 * lq + ((lane & 15) >> 2)), trcol = (unsigned)(4 * (lane & 3));
    const pg8::bf16x8 ones = (pg8::bf16x8)(v4u){0x3F803F80u, 0x3F803F80u, 0x3F803F80u, 0x3F803F80u};
    v2u fh[2][2], fl[2][2];
    const unsigned ah = (unsigned)(size_t)(lds + H3_LH) + trrow * 272 + (16 * w + trcol) * 2, al = ah + (H3_LL - H3_LH);
    asm volatile("ds_read_b64_tr_b16 %0, %8\n\tds_read_b64_tr_b16 %1, %8 offset:1088\n\tds_read_b64_tr_b16 %2, %8 offset:8704\n\tds_read_b64_tr_b16 %3, %8 offset:9792\n\t"
                 "ds_read_b64_tr_b16 %4, %9\n\tds_read_b64_tr_b16 %5, %9 offset:1088\n\tds_read_b64_tr_b16 %6, %9 offset:8704\n\tds_read_b64_tr_b16 %7, %9 offset:9792\n\ts_waitcnt lgkmcnt(0)"
                 : "=&v"(fh[0][0]), "=&v"(fh[0][1]), "=&v"(fh[1][0]), "=&v"(fh[1][1]), "=&v"(fl[0][0]), "=&v"(fl[0][1]), "=&v"(fl[1][0]), "=&v"(fl[1][1]) : "v"(ah), "v"(al) : "memory");
    const pg8::bf16x8 H0 = mk_frag(fh[0][0], fh[0][1]), H1 = mk_frag(fh[1][0], fh[1][1]), L0 = mk_frag(fl[0][0], fl[0][1]), L1 = mk_frag(fl[1][0], fl[1][1]);
    f32x4 bt[4];
    const f32x4 z = (f32x4){0.f, 0.f, 0.f, 0.f};
    bt[0] = __builtin_amdgcn_mfma_f32_16x16x32_bf16(L0, U[0], z, 0, 0, 0);    bt[0] = __builtin_amdgcn_mfma_f32_16x16x32_bf16(H0, U[0], bt[0], 0, 0, 0);
    bt[1] = __builtin_amdgcn_mfma_f32_16x16x32_bf16(L0, U[1], z, 0, 0, 0);    bt[1] = __builtin_amdgcn_mfma_f32_16x16x32_bf16(H0, U[1], bt[1], 0, 0, 0);
    bt[2] = __builtin_amdgcn_mfma_f32_16x16x32_bf16(L0, ones, z, 0, 0, 0);    bt[2] = __builtin_amdgcn_mfma_f32_16x16x32_bf16(L1, U[2], bt[2], 0, 0, 0);
    bt[2] = __builtin_amdgcn_mfma_f32_16x16x32_bf16(H0, ones, bt[2], 0, 0, 0); bt[2] = __builtin_amdgcn_mfma_f32_16x16x32_bf16(H1, U[2], bt[2], 0, 0, 0);
    bt[3] = __builtin_amdgcn_mfma_f32_16x16x32_bf16(L0, ones, z, 0, 0, 0);    bt[3] = __builtin_amdgcn_mfma_f32_16x16x32_bf16(L1, U[3], bt[3], 0, 0, 0);
    bt[3] = __builtin_amdgcn_mfma_f32_16x16x32_bf16(H0, ones, bt[3], 0, 0, 0); bt[3] = __builtin_amdgcn_mfma_f32_16x16x32_bf16(H1, U[3], bt[3], 0, 0, 0);
    f32x4 de;
#pragma unroll
    for (int r = 0; r < 4; ++r) de[r] = __expf(__shfl(bt[3][r], 16 * lq + 15));
    if (lr == 0) *(LAS f32x4*)(lds + H3_DEC + buf * H3_BUFDEC + (16 * w + 4 * lq) * 4) = de;
#pragma unroll
    for (int ti = 0; ti < 4; ++ti) {
        const v2u qq = in.q[ti], kk = in.k[ti];
        const float e0 = __expf(bt[ti][0]), e1 = __expf(bt[ti][1]), e2 = __expf(bt[ti][2]), e3 = __expf(bt[ti][3]);
        v2u qo, ko;
        qo.x = pk2(bf2f(qq.x & 0xffffu) * e0, bf2f(qq.x >> 16) * e1); qo.y = pk2(bf2f(qq.y & 0xffffu) * e2, bf2f(qq.y >> 16) * e3);
        ko.x = pk2(bf2f(kk.x & 0xffffu) * __builtin_amdgcn_rcpf(e0), bf2f(kk.x >> 16) * __builtin_amdgcn_rcpf(e1));
        ko.y = pk2(bf2f(kk.y & 0xffffu) * __builtin_amdgcn_rcpf(e2), bf2f(kk.y >> 16) * __builtin_amdgcn_rcpf(e3));
        const int off = (16 * ti + lr) * 272 + (16 * w + 4 * lq) * 2;
        *(LAS v2u*)(lds + H3_QI + buf * H3_BUFD + off) = qo; *(LAS v2u*)(lds + H3_KK + buf * H3_BUFD + off) = ko;
    }
}
__device__ __forceinline__ void hg4_stage1(const Hg3& c, int buf, int w, f32x4 (&S)[4], f32x4 (&o)[2], v2u (&vt)[4][2][2]) {
    LAS unsigned char* lds = c.lds; const int lr = c.lr, lq = c.lq, lane = c.lane;
    const LAS unsigned char* QI = lds + H3_QI + buf * H3_BUFD; const LAS unsigned char* KK = lds + H3_KK + buf * H3_BUFD;
    const unsigned trrow = (unsigned)(8 * lq + ((lane & 15) >> 2)), trcol = (unsigned)(4 * (lane & 3));
    const unsigned kk_tr = (unsigned)(size_t)KK + trrow * 272 + (16 * w + trcol) * 2;
    const unsigned v_tr = (unsigned)(size_t)(lds + H3_V + buf * H3_BUFV) + trrow * 144 + trcol * 2;
    v2u kt[2][2];
    asm volatile("ds_read_b64_tr_b16 %0, %4\n\tds_read_b64_tr_b16 %1, %4 offset:1088\n\tds_read_b64_tr_b16 %2, %4 offset:8704\n\tds_read_b64_tr_b16 %3, %4 offset:9792"
                 : "=&v"(kt[0][0]), "=&v"(kt[0][1]), "=&v"(kt[1][0]), "=&v"(kt[1][1]) : "v"(kk_tr) : "memory");
#define H4_VTR(e4, o0, o1, o2, o3) asm volatile("ds_read_b64_tr_b16 %0, %4 offset:" #o0 "\n\tds_read_b64_tr_b16 %1, %4 offset:" #o1 "\n\tds_read_b64_tr_b16 %2, %4 offset:" #o2 "\n\tds_read_b64_tr_b16 %3, %4 offset:" #o3 \
                 : "=&v"(vt[e4][0][0]), "=&v"(vt[e4][0][1]), "=&v"(vt[e4][1][0]), "=&v"(vt[e4][1][1]) : "v"(v_tr) : "memory")
    H4_VTR(0, 0, 576, 4608, 5184); H4_VTR(1, 32, 608, 4640, 5216); H4_VTR(2, 64, 640, 4672, 5248); H4_VTR(3, 96, 672, 4704, 5280);
#undef H4_VTR
    const int ei = w & 3, tp = w >> 2;
    {
        const int ti = w & 3;
#pragma unroll
        for (int sii = 0; sii < 2; ++sii) {
            const int si = tp * 2 + sii;
            v2u wv = (v2u){0u, 0u};
            if (si <= ti) {
                f32x4 a = (f32x4){0.f, 0.f, 0.f, 0.f};
#pragma unroll
                for (int kk = 0; kk < 4; ++kk)
                    a = __builtin_amdgcn_mfma_f32_16x16x32_bf16(lds_frag(KK + (16 * si + lr) * 272 + kk * 64 + lq * 16), lds_frag(QI + (16 * ti + lr) * 272 + kk * 64 + lq * 16), a, 0, 0, 0);
                const int s0 = 16 * si + 4 * lq, t = 16 * ti + lr;
                wv.x = pk2(s0 + 0 <= t ? a[0] : 0.f, s0 + 1 <= t ? a[1] : 0.f); wv.y = pk2(s0 + 2 <= t ? a[2] : 0.f, s0 + 3 <= t ? a[3] : 0.f);
            }
            *(LAS v2u*)(lds + H3_AM + (16 * ti + lr) * 144 + (16 * si + 4 * lq) * 2) = wv;
        }
    }
#pragma unroll
    for (int tt = 0; tt < 2; ++tt) o[tt] = (f32x4){0.f, 0.f, 0.f, 0.f};
#pragma unroll
    for (int kk = 0; kk < 4; ++kk) {
        const pg8::bf16x8 sfr = lds_frag(lds + H3_ST + (16 * ei + lr) * 272 + kk * 64 + lq * 16);
#pragma unroll
        for (int tt = 0; tt < 2; ++tt) o[tt] = __builtin_amdgcn_mfma_f32_16x16x32_bf16(sfr, lds_frag(QI + (16 * (2 * tp + tt) + lr) * 272 + kk * 64 + lq * 16), o[tt], 0, 0, 0);
    }
    asm volatile("s_waitcnt lgkmcnt(0)"
                 : "+v"(kt[0][0]), "+v"(kt[0][1]), "+v"(kt[1][0]), "+v"(kt[1][1]),
                   "+v"(vt[0][0][0]), "+v"(vt[0][0][1]), "+v"(vt[0][1][0]), "+v"(vt[0][1][1]), "+v"(vt[1][0][0]), "+v"(vt[1][0][1]), "+v"(vt[1][1][0]), "+v"(vt[1][1][1]),
                   "+v"(vt[2][0][0]), "+v"(vt[2][0][1]), "+v"(vt[2][1][0]), "+v"(vt[2][1][1]), "+v"(vt[3][0][0]), "+v"(vt[3][0][1]), "+v"(vt[3][1][0]), "+v"(vt[3][1][1]) :: "memory");
#pragma unroll
    for (int kk = 0; kk < 2; ++kk) {
        const pg8::bf16x8 af = mk_frag(kt[kk][0], kt[kk][1]);
#pragma unroll
        for (int e4 = 0; e4 < 4; ++e4) S[e4] = __builtin_amdgcn_mfma_f32_16x16x32_bf16(af, mk_frag(vt[e4][kk][0], vt[e4][kk][1]), S[e4], 0, 0, 0);
    }
    const f32x4 dv = *(const LAS f32x4*)(lds + H3_DEC + buf * H3_BUFDEC + (16 * w + 4 * lq) * 4);
#pragma unroll
    for (int e4 = 0; e4 < 4; ++e4) S[e4] = S[e4] * dv;
}
__device__ __forceinline__ void hg4_stage2(const Hg3& c, int n, int w, const f32x4 (&S)[4], f32x4 (&o)[2], const v2u (&vt)[4][2][2]) {
    LAS unsigned char* lds = c.lds; const int lr = c.lr, lq = c.lq;
    const int ei = w & 3, tp = w >> 2;
    const pg8::bf16x8 vf0 = ei == 0 ? mk_frag(vt[0][0][0], vt[0][0][1]) : ei == 1 ? mk_frag(vt[1][0][0], vt[1][0][1]) : ei == 2 ? mk_frag(vt[2][0][0], vt[2][0][1]) : mk_frag(vt[3][0][0], vt[3][0][1]);
    const pg8::bf16x8 vf1 = ei == 0 ? mk_frag(vt[0][1][0], vt[0][1][1]) : ei == 1 ? mk_frag(vt[1][1][0], vt[1][1][1]) : ei == 2 ? mk_frag(vt[2][1][0], vt[2][1][1]) : mk_frag(vt[3][1][0], vt[3][1][1]);
#pragma unroll
    for (int tt = 0; tt < 2; ++tt) {
        const int ti = 2 * tp + tt;
        o[tt] = __builtin_amdgcn_mfma_f32_16x16x32_bf16(vf0, lds_frag(lds + H3_AM + (16 * ti + lr) * 144 + 0 * 64 + lq * 16), o[tt], 0, 0, 0);
        o[tt] = __builtin_amdgcn_mfma_f32_16x16x32_bf16(vf1, lds_frag(lds + H3_AM + (16 * ti + lr) * 144 + 1 * 64 + lq * 16), o[tt], 0, 0, 0);
        *(f32x4*)(c.Op + hg3_row(c, n, 16 * ti + lr) + c.vh * 64 + 16 * ei + 4 * lq) = o[tt];
    }
#pragma unroll
    for (int e4 = 0; e4 < 4; ++e4) { v2u wv; wv.x = pk2(S[e4][0], S[e4][1]); wv.y = pk2(S[e4][2], S[e4][3]); *(LAS v2u*)(lds + H3_ST + (16 * e4 + lr) * 272 + (16 * w + 4 * lq) * 2) = wv; }
}
__device__ __forceinline__ void hgrn4_unit(LAS unsigned char* lds, int unit, const bf16* Qb, const bf16* KFb, const bf16* KBb, const bf16* Vb, const float* LFb, const float* LBb,
                                           float* OFb, float* OBb, int tid, int lane, int wave) {
    Hg3 c;
    c.lds = lds; c.vh = unit & 1; c.dir = (unit >> 1) & 1; c.h = (unit >> 2) & 3; c.b = unit >> 4;
    c.Qb = Qb; c.Vb = Vb; c.Kp = c.dir ? KBb : KFb; c.Lp = c.dir ? LBb : LFb; c.Op = c.dir ? OBb : OFb;
    c.lane = lane; c.lr = lane & 15; c.lq = lane >> 4;
    constexpr int NCH = TT / 64;
    const int w = wave;
    for (int i = tid; i < 64 * 272 / 16; i += NTHR) *(LAS v4u*)(lds + H3_ST + i * 16) = (v4u){0u, 0u, 0u, 0u};
    pg8::bf16x8 U[4];
#pragma unroll
    for (int u = 0; u < 4; ++u) { const int kk = u >> 1, ti = u; unsigned wv[4];
#pragma unroll
        for (int j2 = 0; j2 < 4; ++j2) { const int sN = 32 * kk + 8 * c.lq + 2 * j2, t = 16 * ti + c.lr; wv[j2] = (sN <= t ? 0x3F80u : 0u) | (sN + 1 <= t ? 0x3F800000u : 0u); }
        U[u] = (pg8::bf16x8)(v4u){wv[0], wv[1], wv[2], wv[3]}; }
    f32x4 S[4], o[2]; v2u vt[4][2][2];
#pragma unroll
    for (int e4 = 0; e4 < 4; ++e4) S[e4] = (f32x4){0.f, 0.f, 0.f, 0.f};
    Hg4LV lv0, lv1; Hg4QK qk;
    hg4_load_lv(c, 0, tid, lv0); hg4_load_qk(c, 0, w, qk); hg4_load_lv(c, 1, tid, lv1);
    asm volatile("s_waitcnt vmcnt(0)" ::: "memory"); H4_USE_LV(lv0); H4_USE_QK(qk); H4_USE_LV(lv1);
    hg4_prep_a(c, 0, tid, lv0);
    __syncthreads();
#define H4_TRIP(j_, LVN, LVC) do { \
        if ((j_) < NCH) { asm volatile("s_waitcnt vmcnt(5)" ::: "memory"); H4_USE_QK(qk); hg4_prep_b(c, (j_) & 1, w, qk, U); \
            hg4_load_qk(c, (j_) + 1 < NCH ? (j_) + 1 : (j_), w, qk); hg4_load_lv(c, (j_) + 2 < NCH ? (j_) + 2 : (j_), tid, LVC); }     \
        if ((j_) > 0 && (j_) <= NCH) hg4_stage1(c, ((j_) - 1) & 1, w, S, o, vt); \
        if (PROBE_DELAY == 5) probe_delay(100); \
        __syncthreads();                                                                        \
        if ((j_) + 1 < NCH) { asm volatile("s_waitcnt vmcnt(13)" ::: "memory"); H4_USE_LV(LVN); hg4_prep_a(c, ((j_) + 1) & 1, tid, LVN); } \
        if ((j_) > 0 && (j_) <= NCH) hg4_stage2(c, (j_) - 1, w, S, o, vt); \
        __syncthreads();                                                                        \
    } while (0)
#pragma unroll 1
    for (int j = 0; j <= NCH; j += 2) { H4_TRIP(j, lv1, lv0); H4_TRIP(j + 1, lv0, lv1); }
#undef H4_TRIP
    asm volatile("s_waitcnt vmcnt(0)" ::: "memory");
    __syncthreads();
}

#if defined(HGRN_V2)
#define HGRN_FN hgrn_unit
#elif defined(HGRN_V3)
#define HGRN_FN hgrn3_unit
#else
#define HGRN_FN hgrn4_unit
#endif
#define W1_ITEM(r_) do { const int r__ = (r_); const int e__ = r__ >> 10; p0_item<true>(w1 + (size_t)e__ * D * 2 * FF, D, 2 * FF, W1T + (size_t)e__ * 2 * FF * D, RmW1(), scr, r__ & 1023, lane); } while (0)

struct Args { const float* in[18]; float* out; unsigned char* ws; int ph_lo, ph_hi; };
__global__ void __launch_bounds__(NTHR, 2) fwd_kernel(Args args) {
    extern __shared__ __attribute__((aligned(16))) unsigned char lds_raw[];
    LAS unsigned char* lds = (LAS unsigned char*)lds_raw;
    volatile LAS unsigned* MISC = (volatile LAS unsigned*)(lds + MISC_OFF);
    const int tid = threadIdx.x, lane = tid & 63, wave = __builtin_amdgcn_readfirstlane(tid >> 6);
    const int G = gridDim.x; const int bx = blockIdx.x; const int vcu = (G % 8 == 0) ? (bx % 8) * (G / 8) + bx / 8 : bx;
    const int gw = vcu * NWAVES + wave, NGW = G * NWAVES;
    unsigned char* ws = args.ws;
    unsigned* ctl = (unsigned*)(ws + WS_CTL);
    const float* x = args.in[0]; const float* norm1_w = args.in[1]; const float* w_in = args.in[2]; const float* lb_logits = args.in[3];
    const float* hgrn_norm_w = args.in[4]; const float* dw_w = args.in[5]; const float* dw_b = args.in[6]; const float* conv_ln_w = args.in[7]; const float* conv_ln_b = args.in[8];
    const float* w_out = args.in[9]; const float* norm2_w = args.in[10]; const float* router_w = args.in[11]; const float* router_b = args.in[12];
    const float* w1 = args.in[13]; const float* b1 = args.in[14]; const float* w2 = args.in[15]; const float* b2 = args.in[16]; const float* final_norm_w = args.in[17];
    float* out = args.out;
    bf16* WI = (bf16*)(ws + WS_WI); bf16* WO = (bf16*)(ws + WS_WO); unsigned char* W1T = ws + WS_W1; unsigned char* W2T = ws + WS_W2;
    float* H = (float*)(ws + WS_H); bf16* XN = (bf16*)(ws + WS_XN);
    bf16* Qb = (bf16*)(ws + WS_Q); bf16* KFb = (bf16*)(ws + WS_KF); bf16* KBb = (bf16*)(ws + WS_KB); bf16* Vb = (bf16*)(ws + WS_V); bf16* Gb = (bf16*)(ws + WS_G); bf16* Ub = (bf16*)(ws + WS_U);
    float* LFb = (float*)(ws + WS_LF); float* LBb = (float*)(ws + WS_LB); float* OFb = (float*)(ws + WS_OF); float* OBb = (float*)(ws + WS_OB);
    bf16* MIX = (bf16*)(ws + WS_MIX); unsigned char* XS = ws + WS_XS; unsigned char* ACT = ws + WS_ACT; unsigned char* N2 = ws + WS_XN; bf16* YS = (bf16*)(ws + WS_YS);
    float* WRT = (float*)(ws + WS_WRT); int* SLOT = (int*)(ws + WS_SLOT); float* GATE = (float*)(ws + WS_GATE); int* ROWTOK = (int*)(ws + WS_ROWTOK);
    volatile LAS int* bs = (volatile LAS int*)(lds + TAB_OFF);
    volatile LAS int* cl = (volatile LAS int*)(lds + TAB_OFF + 256);
    LAS int* lcnt = (LAS int*)(lds + TAB_OFF + 512);
    volatile LAS int* gbase = (volatile LAS int*)(lds + TAB_OFF + 768);

    for (int u = tid; u < (LDS_BYTES - LDSCTL_OFF) / 4; u += NTHR) ((LAS unsigned*)(lds + LDSCTL_OFF))[u] = 0u;
    __syncthreads();
    XcdBarrier bar; bar.bar = ctl + CW_BAR; bar.x = 0; bar.st = nullptr;
    if (MK_N_LAUNCHES == 1) bar = xcd_barrier_post(ctl + CW_BAR, MISC + 8);
#ifndef PROBE_STAMP
#define PROBE_STAMP -1
#endif
    unsigned long long tS[N_PHASES + 1];
#define STAMP(k) do { if ((PROBE_STAMP) >= 0) tS[k] = __builtin_amdgcn_s_memrealtime(); } while (0)
    const int lo = args.ph_lo, hi = args.ph_hi;
#ifndef PHASE_MASK
#define PHASE_MASK 0xffffffffu
#endif
#define IN(k) ((((PHASE_MASK) >> (k)) & 1u) && lo <= (k) && (k) < hi)
#ifndef PROBE_DUP
#define PROBE_DUP -1
#endif
#define REP(k) _Pragma("unroll 1") for (int rep_ = 0; rep_ < ((PROBE_DUP) == (k) ? 2 + (args.ph_hi >> 20) : 1); ++rep_)
#define SEAM(k) do { if (IN(k) && IN((k) + 1)) { xcd_barrier(bar); if ((PROBE_DUP) == 99) { xcd_barrier(bar); xcd_barrier(bar); } } } while (0)
#define BUILD_BS() do { int t_; asm volatile("v_mov_b32 %0, %1" : "=v"(t_) : "v"(tid));     \
        if (t_ < 64) { const int c_ = t_ < NE ? (int)__hip_atomic_load(ctl + CW_CNT + 64 * (t_ & (NE - 1)), RLX_AGENT) : 0; int x_ = (c_ + 255) >> 8; \
        _Pragma("unroll") for (int o_ = 1; o_ < NE; o_ <<= 1) { const int y_ = __shfl_up(x_, o_); if ((t_ & 63) >= o_) x_ += y_; }     \
        if (t_ < NE) { cl[t_] = c_; bs[t_ + 1] = x_; } if (t_ == 0) bs[0] = 0; } __syncthreads(); } while (0)

    STAMP(0);
    if (IN(0)) REP(0) {
        LAS float* scr = (LAS float*)(lds + RING_OFF + wave * 16384);
        constexpr int I_WI = (D / 64) * (INC / 32), I_WO = (D / 64) * (D / 32), I_W1 = (D / 64) * (2 * FF / 32), I_W2 = (FF / 64) * (D / 32);
        #if defined(HGRN_NAIVE) || defined(W2_IN_P0)
        constexpr int NITEMS = I_WI + I_WO + NE * I_W1 + NE * I_W2;
#else
        constexpr int NITEMS = I_WI + I_WO + W1_P0;
#endif
#if defined(HGRN_NAIVE) || defined(W2_IN_P0)
        for (int it = gw; it < NITEMS; it += NGW) {
            int r = it;
            if (r < I_WI) { p0_item<false>(w_in, D, INC, WI, RmWin(), scr, r, lane); continue; } r -= I_WI;
            if (r < I_WO) { p0_item<false>(w_out, D, D, WO, RmIdent(), scr, r, lane); continue; } r -= I_WO;
            if (r < NE * I_W1) { W1_ITEM(r); continue; } r -= NE * I_W1;
            { const int e = r / I_W2; p0_item<true>(w2 + (size_t)e * FF * D, FF, D, W2T + (size_t)e * D * FF, RmIdent(), scr, r - e * I_W2, lane); }
        }
#else
        (void)NITEMS; (void)I_W2;
        for (int it = gw; it < I_WI + I_WO; it += NGW) { if (it < I_WI) p0_item<false>(w_in, D, INC, WI, RmWin(), scr, it, lane); else p0_item<false>(w_out, D, D, WO, RmIdent(), scr, it - I_WI, lane); }
        convert_range_fp8(w1, D, 2 * FF, W1T, RmW1(), 10, gw, NGW, W1_P0, 0, scr, lane);
#endif
        {
            const f32x4* wr = (const f32x4*)norm1_w + lane; f32x4 gw4[4];
#pragma unroll
            for (int j = 0; j < 4; ++j) gw4[j] = wr[64 * j];
#pragma unroll 1
            for (int m0 = gw; m0 < MTOK; m0 += 4 * NGW) {
                f32x4 v[4][4];
#pragma unroll
                for (int q4 = 0; q4 < 4; ++q4) { const int m = min(m0 + q4 * NGW, MTOK - 1); const f32x4* xr = (const f32x4*)(x + (size_t)m * D) + lane;
#pragma unroll
                    for (int j = 0; j < 4; ++j) v[q4][j] = xr[64 * j]; }
#pragma unroll
                for (int q4 = 0; q4 < 4; ++q4) { const int m = m0 + q4 * NGW; float sq = 0.f;
#pragma unroll
                    for (int j = 0; j < 4; ++j) sq += (v[q4][j].x * v[q4][j].x + v[q4][j].y * v[q4][j].y) + (v[q4][j].z * v[q4][j].z + v[q4][j].w * v[q4][j].w);
                    const float rstd = rsqrtf(wave_sum(sq) * (1.f / D) + EPS);
                    if (m < MTOK) { v2u* o8 = (v2u*)(XN + (size_t)m * D) + lane;
#pragma unroll
                        for (int j = 0; j < 4; ++j) { v2u o; o.x = pk2(v[q4][j].x * rstd * gw4[j].x, v[q4][j].y * rstd * gw4[j].y); o.y = pk2(v[q4][j].z * rstd * gw4[j].z, v[q4][j].w * rstd * gw4[j].w); o8[64 * j] = o; } }
                }
            }
        }
        for (int i = bx * NTHR + tid; i < 16 * D; i += G * NTHR) {
            const int r = i >> 4, e16 = i & 15, k = 256 * (r & 3) + (r >> 2); const float gk = norm2_w[k];
            WRT[2 * i] = gk * router_w[k * NE + e16]; WRT[2 * i + 1] = gk * router_w[k * NE + 16 + e16]; }
    }
    if ((PROBE_STAMP) == 600 + 0) tS[6] = __builtin_amdgcn_s_memrealtime();
    SEAM(0);

    STAMP(1);
    if (IN(1)) REP(1) {
        pg8::Gemm g{XN, WI, MTOK, INC, D}; OrderRep S; S.init(MTOK, INC, G, bx); S.reps = ((PROBE_DUP) == 11) ? 2 : 1;
        EpiProj E{Qb, KFb, KBb, Vb, Gb, Ub, LFb, LBb, lb_logits};
        pg8::gemm_phase<EpiProj, OrderRep, true, true>(lds + RING_OFF, g, S, E);
#if !defined(HGRN_NAIVE) && !defined(W2_IN_P0)
        {
            LAS float* scr = (LAS float*)(lds + RING_OFF + wave * 16384);
            if (G == 256) { if (bx >= 128) convert_range_fp8(w1, D, 2 * FF, W1T, RmW1(), 10, (bx - 128) * NWAVES + wave, 128 * NWAVES, W1_P1, W1_P0, scr, lane); }
            else convert_range_fp8(w1, D, 2 * FF, W1T, RmW1(), 10, gw, NGW, W1_P1, W1_P0, scr, lane);
        }
#endif
    }
    if ((PROBE_STAMP) == 600 + 1) tS[6] = __builtin_amdgcn_s_memrealtime();
    SEAM(1);

    STAMP(2);
    if (IN(2)) REP(2) {
        const bool split = (G == 256);
#if defined(HGRN_NAIVE)
        const bool hsel = true; const int hidx = 0, hstride = 1; const bool csel = true; const int cidx = vcu, cstride = G;
#else
        const bool hsel = split ? (((bx >> 3) & 1) != 0) : true; const int hidx = split ? (bx >> 4) * 8 + (bx & 7) : bx, hstride = split ? 128 : G;
        const bool csel = split ? !hsel : true; const int cidx = split ? (bx >> 4) * 8 + (bx & 7) : bx, cstride = split ? 128 : G;
#endif
        (void)hidx; (void)hstride;
        if (csel && PROBE_DELAY == 3) probe_delay(3000); if (csel && PROBE_DELAY == 4) probe_delay(20000);
        if (csel) for (int crep_ = 0; crep_ < ((PROBE_DUP) == 21 ? 2 : 1); ++crep_) {
            LAS unsigned short* ut = (LAS unsigned short*)(lds + RING_OFF);
            LAS float* part = (LAS float*)(lds + RING_OFF + 98304);
            LAS float* stat = (LAS float*)(lds + RING_OFF + 98304 + 4096);
            for (int unit = cidx; unit < NBATCH * (TT / 64); unit += cstride) {
                const int b = unit / (TT / 64), t0 = (unit % (TT / 64)) * 64;
                {
                    v4u val[12];
#pragma unroll
                    for (int i = 0; i < 12; ++i) { const int idx = tid + NTHR * i, r = idx >> 6, p = idx & 63, t = t0 - 15 + r;
                        val[i] = (v4u){0u, 0u, 0u, 0u};
                        if (idx < 94 * 64 && t >= 0 && t < TT) val[i] = *(const v4u*)(Ub + (size_t)(b * TT + t) * CCH + p * 8); }
#pragma unroll
                    for (int i = 0; i < 12; ++i) { const int idx = tid + NTHR * i, r = idx >> 6, p = idx & 63;
                        if (idx < 94 * 64) *(LAS v4u*)(ut + r * 512 + p * 8) = val[i]; }
                }
                __syncthreads(); if ((PROBE_STAMP) == 651 && unit == cidx) tS[6] = __builtin_amdgcn_s_memrealtime();
                const int c = tid;
                float w[CLEN];
#pragma unroll
                for (int j = 0; j < CLEN; ++j) w[j] = dw_w[j * CCH + c];
                const float bias = dw_b[c];
                float y[64];
#pragma unroll
                for (int tb = 0; tb < 8; ++tb) {
                    float win[38];
#pragma unroll
                    for (int i = 0; i < 38; ++i) win[i] = bf2f(ut[(tb * 8 + i) * 512 + c]);
#pragma unroll
                    for (int o = 0; o < 8; ++o) { float a = bias;
#pragma unroll
                        for (int j = 0; j < CLEN; ++j) a += w[j] * win[o + j];
                        y[tb * 8 + o] = a; }
                }
#pragma unroll 1
                for (int pass = 0; pass < 2; ++pass) {
                    float s1[64];
#pragma unroll
                    for (int i = 0; i < 64; ++i) s1[i] = pass ? y[i] * y[i] : y[i];
#pragma unroll
                    for (int s = 32; s >= 1; s >>= 1) {
                        const bool up = (lane & s) != 0;
#pragma unroll
                        for (int i = 0; i < s; ++i) { const float k1 = up ? s1[i + s] : s1[i], x1 = up ? s1[i] : s1[i + s]; s1[i] = k1 + __shfl_xor(x1, s); }
                    }
                    part[(wave * 64 + lane) * 2 + pass] = s1[0];
                }
                __syncthreads(); if ((PROBE_STAMP) == 652 && unit == cidx) tS[6] = __builtin_amdgcn_s_memrealtime();
                if (tid < 64) { float a = 0.f, q = 0.f;
#pragma unroll
                    for (int wv = 0; wv < 8; ++wv) { a += part[(wv * 64 + tid) * 2]; q += part[(wv * 64 + tid) * 2 + 1]; }
                    const float mean = a * (1.f / CCH), var = q * (1.f / CCH) - mean * mean;
                    stat[tid * 2] = mean; stat[tid * 2 + 1] = rsqrtf(fmaxf(var, 0.f) + EPS); }
                __syncthreads();
                const float lw = conv_ln_w[c], lbias = conv_ln_b[c];
#pragma unroll
                for (int t = 0; t < 64; ++t) {
                    const float v = (y[t] - stat[t * 2]) * stat[t * 2 + 1] * lw + lbias;
                    MIX[(size_t)(b * TT + t0 + t) * D + 512 + c] = (bf16)(pk2(v * sigm(v), 0.f) & 0xffffu);
                }
                __syncthreads(); if ((PROBE_STAMP) == 653 && unit == cidx) tS[6] = __builtin_amdgcn_s_memrealtime();
            }
            if ((PROBE_STAMP) == 650) tS[6] = __builtin_amdgcn_s_memrealtime();
#if !defined(HGRN_NAIVE) && !defined(W2_IN_P0)
            {
                LAS float* scr = (LAS float*)(lds + RING_OFF + wave * 16384);
                constexpr int I_W2 = (FF / 64) * (D / 32);
                convert_range_fp8(w2, FF, D, W2T, RmIdent(), 9, cidx * NWAVES + wave, cstride * NWAVES, W2_P2, 0, scr, lane);
                convert_range_fp8(w1, D, 2 * FF, W1T, RmW1(), 10, cidx * NWAVES + wave, cstride * NWAVES, W1_P2, W1_P0 + W1_P1, scr, lane);
            }
#endif
        }
#if defined(HGRN_NAIVE)
        {
            LAS float* qs = (LAS float*)(lds + RING_OFF); LAS float* ks = qs + 2048; LAS float* fs = ks + 2048; LAS float* vs = fs + 2048; LAS float* op = vs + 2048;
            const int e = tid & 127, dq = tid >> 7;
            for (int unit = G - 1 - bx; unit < NBATCH * NH * 2; unit += G) {
                const int dir = unit & 1, h = (unit >> 1) & 3, b = unit >> 3;
                const bf16* Kp = dir ? KBb : KFb; const float* Lp = dir ? LBb : LFb; float* Op = dir ? OBb : OFb;
                float S[32];
#pragma unroll
                for (int i = 0; i < 32; ++i) S[i] = 0.f;
                for (int blk = 0; blk < TT / 16; ++blk) {
                    const int tb = dir ? (TT - 16 - blk * 16) : blk * 16;
#pragma unroll
                    for (int i = 0; i < 4; ++i) { const int idx = tid + NTHR * i, r = idx >> 7, d = idx & 127; const size_t off = (size_t)(b * TT + tb + r) * 512 + h * 128 + d;
                        qs[idx] = bf2f(Qb[off]); ks[idx] = bf2f(Kp[off]); fs[idx] = __expf(Lp[off]); vs[idx] = bf2f(Vb[off]); }
                    __syncthreads();
                    for (int st = 0; st < 16; ++st) {
                        const int r = dir ? 15 - st : st; const float v = vs[r * 128 + e]; float o = 0.f;
#pragma unroll
                        for (int dd = 0; dd < 32; ++dd) { const int d = dq * 32 + dd; S[dd] = fs[r * 128 + d] * S[dd] + ks[r * 128 + d] * v; o += qs[r * 128 + d] * S[dd]; }
                        op[(r * 4 + dq) * 128 + e] = o;
                    }
                    __syncthreads();
#pragma unroll
                    for (int i = 0; i < 4; ++i) { const int idx = tid + NTHR * i, r = idx >> 7, ee = idx & 127;
                        Op[(size_t)(b * TT + tb + r) * 512 + h * 128 + ee] = (op[(r * 4 + 0) * 128 + ee] + op[(r * 4 + 1) * 128 + ee]) + (op[(r * 4 + 2) * 128 + ee] + op[(r * 4 + 3) * 128 + ee]); }
                }
                __syncthreads();
            }
        }
#else
        if (hsel) for (int unit = hidx; unit < NBATCH * NH * 4 * ((PROBE_DUP) == 20 ? 2 : 1); unit += hstride) HGRN_FN(lds + RING_OFF, unit & (NBATCH * NH * 4 - 1), Qb, KFb, KBb, Vb, LFb, LBb, OFb, OBb, tid, lane, wave);
#endif
    }
    if ((PROBE_STAMP) == 600 + 2) tS[6] = __builtin_amdgcn_s_memrealtime();
    SEAM(2);

    STAMP(3);
    if (IN(3)) REP(3) {
        for (int m = gw; m < MTOK; m += NGW) {
            const size_t off = (size_t)m * 512 + lane * 8;
#if defined(HGRN_V2)
            const v4u ua = *(const v4u*)((const bf16*)OFb + off), uc = *(const v4u*)((const bf16*)OBb + off);
            const f32x4 a0 = (f32x4){bf2f(ua.x & 0xffffu), bf2f(ua.x >> 16), bf2f(ua.y & 0xffffu), bf2f(ua.y >> 16)}, a1 = (f32x4){bf2f(ua.z & 0xffffu), bf2f(ua.z >> 16), bf2f(ua.w & 0xffffu), bf2f(ua.w >> 16)};
            const f32x4 c0 = (f32x4){bf2f(uc.x & 0xffffu), bf2f(uc.x >> 16), bf2f(uc.y & 0xffffu), bf2f(uc.y >> 16)}, c1 = (f32x4){bf2f(uc.z & 0xffffu), bf2f(uc.z >> 16), bf2f(uc.w & 0xffffu), bf2f(uc.w >> 16)};
#else
            const f32x4 a0 = *(const f32x4*)(OFb + off), a1 = *(const f32x4*)(OFb + off + 4), c0 = *(const f32x4*)(OBb + off), c1 = *(const f32x4*)(OBb + off + 4);
#endif
            const f32x4 o0 = a0 + c0, o1 = a1 + c1;
            float ss = (o0.x * o0.x + o0.y * o0.y) + (o0.z * o0.z + o0.w * o0.w) + (o1.x * o1.x + o1.y * o1.y) + (o1.z * o1.z + o1.w * o1.w);
            ss += __shfl_xor(ss, 1); ss += __shfl_xor(ss, 2); ss += __shfl_xor(ss, 4); ss += __shfl_xor(ss, 8);
            const float rstd = rsqrtf(ss * (1.f / DV) + EPS);
            const v4u gv = *(const v4u*)(Gb + off);
            const f32x4 w0 = *(const f32x4*)(hgrn_norm_w + lane * 8), w1v = *(const f32x4*)(hgrn_norm_w + lane * 8 + 4);
            f32x4 r0, r1;
            r0.x = o0.x * rstd * w0.x * bf2f(gv.x & 0xffffu); r0.y = o0.y * rstd * w0.y * bf2f(gv.x >> 16);
            r0.z = o0.z * rstd * w0.z * bf2f(gv.y & 0xffffu); r0.w = o0.w * rstd * w0.w * bf2f(gv.y >> 16);
            r1.x = o1.x * rstd * w1v.x * bf2f(gv.z & 0xffffu); r1.y = o1.y * rstd * w1v.y * bf2f(gv.z >> 16);
            r1.z = o1.z * rstd * w1v.z * bf2f(gv.w & 0xffffu); r1.w = o1.w * rstd * w1v.w * bf2f(gv.w >> 16);
            st8bf(MIX + (size_t)m * D + lane * 8, r0, r1);
        }
    }
    if ((PROBE_STAMP) == 600 + 3) tS[6] = __builtin_amdgcn_s_memrealtime();
    SEAM(3);

    STAMP(4);
    if (IN(4)) REP(4) {
        pg8::Gemm g{MIX, WO, MTOK, D, D}; pg8::StaticOrder S; S.init(MTOK, D, G, bx);
        EpiRes E{x, H};
        pg8::gemm_phase<EpiRes, pg8::StaticOrder, true, true>(lds + RING_OFF, g, S, E);
    }
    if ((PROBE_STAMP) == 600 + 4) tS[6] = __builtin_amdgcn_s_memrealtime();
    SEAM(4);

    STAMP(5);
    if (IN(5)) REP(5) {
        typedef float f32x2 __attribute__((ext_vector_type(2)));
        LAS float* wl = (LAS float*)(lds + RING_OFF);
        LAS unsigned* sb = (LAS unsigned*)(lds + SB_OFF);
        { f32x4 tv_[NE * D / 4 / NTHR];
#pragma unroll
            for (int i = 0; i < NE * D / 4 / NTHR; ++i) tv_[i] = ((const f32x4*)WRT)[tid + NTHR * i];
#pragma unroll
            for (int i = 0; i < NE * D / 4 / NTHR; ++i) ((LAS f32x4*)wl)[tid + NTHR * i] = tv_[i]; }
        if (tid < NE) lcnt[tid] = 0;
        __syncthreads();
        for (int tg = vcu; tg < MTOK / 64; tg += G) {
            const int tok0 = tg * 64 + 16 * (wave & 3);
            if (wave < 4) {
                const int j = lane & 15, q = lane >> 4;
                const f32x4* hrow = (const f32x4*)(H + (size_t)(tok0 + j) * D + 256 * q);
                const LAS f32x2* tab = (const LAS f32x2*)wl + q * 16 + j;
                f32x4 acc0 = (f32x4){0.f, 0.f, 0.f, 0.f}, acc1 = acc0; float ss = 0.f;
                f32x4 hb[8], hn[8];
#pragma unroll
                for (int i = 0; i < 8; ++i) hb[i] = hrow[i];
#pragma unroll 1
                for (int blk = 0; blk < 8; ++blk) {
                    if (blk + 1 < 8) {
#pragma unroll
                        for (int i = 0; i < 8; ++i) hn[i] = hrow[(blk + 1) * 8 + i];
                    }
#pragma unroll
                    for (int i = 0; i < 8; ++i) {
                        const f32x4 hc = hb[i]; const int s4 = blk * 8 + i;
                        f32x2 w[4];
#pragma unroll
                        for (int u = 0; u < 4; ++u) w[u] = tab[(4 * s4 + u) * 64];
                        ss += (hc.x * hc.x + hc.y * hc.y) + (hc.z * hc.z + hc.w * hc.w);
#pragma unroll
                        for (int u = 0; u < 4; ++u) { acc0 = __builtin_amdgcn_mfma_f32_16x16x4f32(w[u].x, hc[u], acc0, 0, 0, 0); acc1 = __builtin_amdgcn_mfma_f32_16x16x4f32(w[u].y, hc[u], acc1, 0, 0, 0); }
                    }
#pragma unroll
                    for (int i = 0; i < 8; ++i) hb[i] = hn[i];
                }
                ss += __shfl_xor(ss, 16); ss += __shfl_xor(ss, 32);
                const float rstd = rsqrtf(ss * (1.f / D) + EPS);
                float lg[8];
#pragma unroll
                for (int r = 0; r < 4; ++r) { lg[r] = acc0[r] * rstd + router_b[4 * q + r]; lg[4 + r] = acc1[r] * rstd + router_b[16 + 4 * q + r]; }
                float tv[TOPK]; int ti[TOPK];
#pragma unroll
                for (int k = 0; k < TOPK; ++k) {
                    float bv = lg[0]; int bi = 4 * q;
#pragma unroll
                    for (int r = 1; r < 8; ++r) { const int id = (r < 4) ? 4 * q + r : 16 + 4 * q + (r - 4); if (lg[r] > bv) { bv = lg[r]; bi = id; } }
#pragma unroll
                    for (int o = 16; o < 64; o <<= 1) { const float ov = __shfl_xor(bv, o); const int oi = __shfl_xor(bi, o); if (ov > bv || (ov == bv && oi < bi)) { bv = ov; bi = oi; } }
                    tv[k] = bv; ti[k] = bi;
#pragma unroll
                    for (int r = 0; r < 8; ++r) { const int id = (r < 4) ? 4 * q + r : 16 + 4 * q + (r - 4); if (id == bi) lg[r] = -INFINITY; }
                }
                const float e1 = __expf(tv[1] - tv[0]), e2 = __expf(tv[2] - tv[0]), e3 = __expf(tv[3] - tv[0]);
                const float inv = 1.0f / (1.0f + e1 + e2 + e3);
                {
                    const int ek = q == 0 ? ti[0] : q == 1 ? ti[1] : q == 2 ? ti[2] : ti[3];
                    const float gk = (q == 0 ? 1.0f : q == 1 ? e1 : q == 2 ? e2 : e3) * inv;
                    const int lr = __hip_atomic_fetch_add(&lcnt[ek], 1, __ATOMIC_RELAXED, __HIP_MEMORY_SCOPE_WORKGROUP);
                    sb[(16 * wave + j) * 4 + q] = ((unsigned)ek << 16) | (unsigned)lr;
                    GATE[(size_t)(tok0 + j) * TOPK + q] = gk;
                }
            } else {
                const f32x4* wr = (const f32x4*)norm2_w + lane;
                f32x4 gw4[4];
#pragma unroll
                for (int jj = 0; jj < 4; ++jj) gw4[jj] = wr[64 * jj];
#pragma unroll 1
                for (int i = 0; i < 16; i += 4) {
                    f32x4 v[4][4];
#pragma unroll
                    for (int q4 = 0; q4 < 4; ++q4) { const f32x4* hr = (const f32x4*)(H + (size_t)(tok0 + i + q4) * D) + lane;
#pragma unroll
                        for (int jj = 0; jj < 4; ++jj) v[q4][jj] = hr[64 * jj]; }
#pragma unroll
                    for (int q4 = 0; q4 < 4; ++q4) {
                        float s2 = 0.f;
#pragma unroll
                        for (int jj = 0; jj < 4; ++jj) s2 += (v[q4][jj].x * v[q4][jj].x + v[q4][jj].y * v[q4][jj].y) + (v[q4][jj].z * v[q4][jj].z + v[q4][jj].w * v[q4][jj].w);
                        const float rstd = rsqrtf(wave_sum(s2) * (1.f / D) + EPS) * SC_N2;
                        unsigned* o4 = (unsigned*)(N2 + (size_t)(tok0 + i + q4) * D) + lane;
#pragma unroll
                        for (int jj = 0; jj < 4; ++jj) o4[64 * jj] = pk4_fp8(v[q4][jj].x * rstd * gw4[jj].x, v[q4][jj].y * rstd * gw4[jj].y, v[q4][jj].z * rstd * gw4[jj].z, v[q4][jj].w * rstd * gw4[jj].w);
                    }
                }
            }
            __syncthreads();
            if (tid < NE) { const int c = lcnt[tid]; gbase[tid] = c ? (int)__hip_atomic_fetch_add(ctl + CW_CNT + ((PROBE_DUP) == 5 && rep_ == 0 ? 4096 : 0) + 64 * tid, (unsigned)c, RLX_AGENT) : 0; }
            __syncthreads();
            if (tid < 256) { const unsigned w = sb[tid]; const int ek = (int)(w >> 16), r = gbase[ek] + (int)(w & 0xffffu), m = tg * 64 + (tid >> 2);
                ROWTOK[ek * MTOK + r] = m; SLOT[(size_t)m * TOPK + (tid & 3)] = ek * MTOK + r; }
            if (tid < NE) lcnt[tid] = 0;
            __syncthreads();
        }
    }
    if ((PROBE_STAMP) == 600 + 5) tS[6] = __builtin_amdgcn_s_memrealtime();
    SEAM(5);


    if ((PROBE_STAMP) < 600 || (PROBE_STAMP) > 699) STAMP(6);
    STAMP(7);
#if defined(MOE_MERGED)
    if (IN(7)) REP(7) {
        BUILD_BS();
        pg8::Gemm g{(const bf16*)ws, (const bf16*)W1T, MTOK, 2 * FF, D / 2}; MoeOrder2 S{bs, G, vcu, cl, ROWTOK, ctl};
        EpiMoe E{EpiSwiglu{ACT, b1}, EpiDown{YS, b2}};
        pg8::gemm_phase<EpiMoe, MoeOrder2, true, true, true, true>(lds + RING_OFF, g, S, E);
    }
    if ((PROBE_STAMP) == 600 + 8) tS[6] = __builtin_amdgcn_s_memrealtime();
    SEAM(8);
#else
    if (IN(7)) REP(7) {
        BUILD_BS();
        pg8::Gemm g{(const bf16*)N2, (const bf16*)W1T, MTOK, 2 * FF, D / 2}; MoeOrder S{bs, 8, G, vcu, cl, ROWTOK};
        EpiSwiglu E{ACT, b1};
        pg8::gemm_phase<EpiSwiglu, MoeOrder, true, true, true, true>(lds + RING_OFF, g, S, E);
#if !defined(HGRN_NAIVE) && !defined(W2_IN_P0)
        {
            LAS float* scr = (LAS float*)(lds + RING_OFF + wave * 16384);
            const int r7 = (bs[NE] * 8) % G, nsl = G - r7;
            if (vcu >= r7) convert_range_fp8(w2, FF, D, W2T, RmIdent(), 9, (vcu - r7) * NWAVES + wave, nsl * NWAVES, W2_P7, W2_P2, scr, lane);
        }
#endif
    }
    if ((PROBE_STAMP) == 600 + 7) tS[6] = __builtin_amdgcn_s_memrealtime();
    SEAM(7);

    STAMP(8);
    if (IN(8)) REP(8) {
        BUILD_BS();
        pg8::Gemm g{(const bf16*)ACT, (const bf16*)W2T, MOE_ROWS, D, FF / 2}; MoeOrder S{bs, 4, G, vcu, cl, ROWTOK};
        EpiDown E{YS, b2};
        pg8::gemm_phase<EpiDown, MoeOrder, true, true, true>(lds + RING_OFF, g, S, E);
    }
    SEAM(8);
#endif

    STAMP(9);
    if (IN(9)) REP(9) {
        BUILD_BS();
        for (int base = gw; base < MTOK; base += 16 * NGW) {
            const int mi = base + NGW * (lane >> 2); int posl = 0; float gl = 0.f;
            if (mi < MTOK) { const int sl = SLOT[(size_t)mi * TOPK + (lane & 3)]; gl = GATE[(size_t)mi * TOPK + (lane & 3)]; posl = bs[sl >> 14] * 256 + (sl & (MTOK - 1)); }
#pragma unroll 2
            for (int i = 0; i < 16; ++i) {
                const int m = base + NGW * i; if (m >= MTOK) break;
                const f32x4* hr = (const f32x4*)(H + (size_t)m * D) + lane; const f32x4* wr = (const f32x4*)final_norm_w + lane;
                int pos[TOPK]; float gk[TOPK];
#pragma unroll
                for (int k = 0; k < TOPK; ++k) { pos[k] = __shfl(posl, 4 * i + k); gk[k] = __shfl(gl, 4 * i + k); }
                f32x4 v[4]; v2u yw[TOPK][4];
#pragma unroll
                for (int j = 0; j < 4; ++j) v[j] = hr[64 * j];
#pragma unroll
                for (int k = 0; k < TOPK; ++k) { const v2u* yr = (const v2u*)(YS + (size_t)pos[k] * D) + lane;
#pragma unroll
                    for (int j = 0; j < 4; ++j) yw[k][j] = yr[64 * j]; }
#pragma unroll
                for (int k = 0; k < TOPK; ++k)
#pragma unroll
                    for (int j = 0; j < 4; ++j) { const v2u w = yw[k][j];
                        v[j].x += gk[k] * bf2f(w.x & 0xffffu); v[j].y += gk[k] * bf2f(w.x >> 16); v[j].z += gk[k] * bf2f(w.y & 0xffffu); v[j].w += gk[k] * bf2f(w.y >> 16); }
                float s = 0.f;
#pragma unroll
                for (int j = 0; j < 4; ++j) s += (v[j].x * v[j].x + v[j].y * v[j].y) + (v[j].z * v[j].z + v[j].w * v[j].w);
                const float rstd = rsqrtf(wave_sum(s) * (1.f / D) + EPS);
                f32x4* orow = (f32x4*)(out + (size_t)m * D) + lane;
#pragma unroll
                for (int j = 0; j < 4; ++j) orow[64 * j] = v[j] * rstd * wr[64 * j];
            }
        }
    }
    STAMP(N_PHASES);
#ifndef PROBE_WG
#define PROBE_WG 0
#endif
    if ((PROBE_STAMP) >= 660 && (PROBE_STAMP) <= 669 && bx == (PROBE_WG)) {
        const unsigned long long a_ = *(volatile LAS unsigned long long*)(lds + LDSCTL_OFF + 640), b_ = *(volatile LAS unsigned long long*)(lds + LDSCTL_OFF + 648);
        const unsigned long long d = 64ull * (b_ - a_), t0 = __builtin_amdgcn_s_memrealtime();
        while (__builtin_amdgcn_s_memrealtime() - t0 < d) __builtin_amdgcn_s_sleep(8);
    } else
    if ((PROBE_STAMP) >= 0 && bx == (PROBE_WG)) {
        const int k0 = ((PROBE_STAMP) >= 650 && (PROBE_STAMP) <= 659) ? 2 : (PROBE_STAMP) % 100, k1 = ((PROBE_STAMP) >= 100) ? (PROBE_STAMP) / 100 : k0 + 1;
        const unsigned long long d = 2ull * (tS[k1 > N_PHASES ? N_PHASES : k1] - tS[k0]), t0 = __builtin_amdgcn_s_memrealtime();
        while (__builtin_amdgcn_s_memrealtime() - t0 < d) __builtin_amdgcn_s_sleep(8);
    }
#undef IN
#undef SEAM
#undef BUILD_BS
}

extern "C" void kernel_launch(void* const* d_in, const int* in_sizes, int n_in, void* d_out, int out_size, void* d_ws, size_t ws_size, hipStream_t stream) {
    static int grid = 0;
    if (grid == 0) {
        if (n_in != 18 || in_sizes[0] != MTOK * D || out_size != MTOK * D || ws_size < WS_END) { fprintf(stderr, "kernel_launch: unexpected shapes (n_in %d, in0 %d, out %d, ws %zu < %zu); nothing launched\n", n_in, n_in > 0 ? in_sizes[0] : -1, out_size, ws_size, (size_t)WS_END); grid = -1; return; }
        int dev = 0, cus = 0, per_cu = 0;
        if (hipGetDevice(&dev) != hipSuccess || hipDeviceGetAttribute(&cus, hipDeviceAttributeMultiprocessorCount, dev) != hipSuccess) { fprintf(stderr, "kernel_launch: device query failed\n"); grid = -1; return; }
        if (hipFuncSetAttribute((const void*)fwd_kernel, hipFuncAttributeMaxDynamicSharedMemorySize, LDS_BYTES) != hipSuccess) { fprintf(stderr, "kernel_launch: hipFuncSetAttribute failed\n"); grid = -1; return; }
        if (hipOccupancyMaxActiveBlocksPerMultiprocessor(&per_cu, (const void*)fwd_kernel, NTHR, LDS_BYTES) != hipSuccess || per_cu < 1)
            fprintf(stderr, "kernel_launch: note: occupancy query reports %d workgroups per CU\n", per_cu);
        (void)hipGetLastError();
        grid = cus;
    }
    if (grid < 0) return;
    if (hipMemsetAsync((char*)d_ws + WS_CTL, 0, CTL_ZERO_BYTES, stream) != hipSuccess) { fprintf(stderr, "kernel_launch: memset failed\n"); return; }
    Args a{};
    for (int i = 0; i < 18; ++i) a.in[i] = (const float*)d_in[i];
    a.out = (float*)d_out; a.ws = (unsigned char*)d_ws;
#if MK_N_LAUNCHES == 1
    a.ph_lo = 0; a.ph_hi = N_PHASES;
    hipLaunchKernelGGL(fwd_kernel, dim3(grid), dim3(NTHR), LDS_BYTES, stream, a);
#else
    for (int ph = 0; ph < N_PHASES; ++ph) { a.ph_lo = ph; a.ph_hi = ph + 1; hipLaunchKernelGGL(fwd_kernel, dim3(grid), dim3(NTHR), LDS_BYTES, stream, a); }
#endif
    const hipError_t le = hipPeekAtLastError();
    if (le != hipSuccess) fprintf(stderr, "kernel_launch: launch failed: %s\n", hipGetErrorName(le));
}
```

```cpp
#define HGRN_V2 1
#include <hip/hip_runtime.h>
#include <cstdio>
#include <cstdint>
namespace pg8 {
#define PG8_LAS __attribute__((address_space(3)))
typedef unsigned short bf16_t;
typedef short bf16x8 __attribute__((ext_vector_type(8)));
typedef float f32x4 __attribute__((ext_vector_type(4)));
typedef unsigned u32x4 __attribute__((ext_vector_type(4)));
constexpr int BM = 256, BK = 64, HALF = 128, HTB = HALF * BK * 2  , STAGE_BYTES = 8 * HTB, NXCD = 8, WGM = 8;

__host__ __device__ __forceinline__ int lds_byte(int r, int c) { const int st = (r >> 4) * 2 + (c >> 5), rr = r & 15, cc = c & 31, ob = rr * 64 + cc * 2; return st * 1024 + (ob ^ (((ob >> 9) & 1) << 5)); }
__host__ __device__ __forceinline__ void stage_rc(int b, int& R, int& C) { const int st = b / 1024, sb = b % 1024, swz = sb ^ (((sb >> 9) & 1) << 5); R = (st >> 1) * 16 + swz / 64; C = (st & 1) * 32 + (swz % 64) / 2; }
__host__ __device__ __forceinline__ int perm32(int rho) { const int n = rho >> 4, i = rho & 15; return 8 * (i >> 2) + 4 * n + (i & 3); }

struct Unit { int pm, pn; };
struct Gemm { const bf16_t* A; const bf16_t* Bt; int M, N, K; };

struct StaticOrder {
    int nM, nN, nwg, G, c;
    __host__ __device__ void init(int M, int N, int G_, int c_) { nM = M / BM; nN = N / BM; nwg = nM * nN; G = G_; c = c_; }
    __host__ __device__ bool next(int i, Unit& u) const {
        const long L = (long)i * G + c; if (L >= nwg) return false;
        int wgid = (int)L; { const int q = nwg / NXCD, r = nwg % NXCD, xcd = wgid % NXCD, off = wgid / NXCD; wgid = (xcd < r ? xcd * (q + 1) : r * (q + 1) + (xcd - r) * q) + off; }
        const int nig = WGM * nN, gid = wgid / nig, fm = gid * WGM, gsz = (nM - fm) < WGM ? (nM - fm) : WGM;
        u.pm = fm + ((wgid % nig) % gsz); u.pn = (wgid % nig) / gsz; return true;
    }
    __device__ __forceinline__ void a_ready(const Unit&) const {}
    __device__ __forceinline__ void done(const Unit&) const {}
    __device__ __forceinline__ int done_defer(const Unit&) const { return -1; }
    __device__ __forceinline__ void done_signal(int) const {}
};
__device__ __forceinline__ unsigned cvt_pk_bf16(float lo, float hi) { unsigned r; asm volatile("v_cvt_pk_bf16_f32 %0, %1, %2" : "=v"(r) : "v"(lo), "v"(hi)); return r; }
typedef float f32x2 __attribute__((ext_vector_type(2)));
template <class Epi, class Sched, bool ALIGN_EPI = false, bool SP2 = false, bool FP8 = false, bool GATHER = false>
__device__ __forceinline__ void gemm_phase(PG8_LAS unsigned char* lds, const Gemm g, const Sched& S, const Epi& E) {
    typedef int v4i_t __attribute__((ext_vector_type(4)));
    const int tid = threadIdx.x, wid = __builtin_amdgcn_readfirstlane(tid >> 6), lane = tid & 63, wr = wid >> 2, wc = wid & 3, fr = lane & 15, fq = lane >> 4;
    const int K = g.K, nt = K / BK;
    unsigned voffA[2], voffB[2];
#pragma unroll
    for (int i = 0; i < 2; ++i) { int R, C; stage_rc(tid * 16 + i * 8192, R, C); const int Rb = Epi::PERM ? ((R & ~31) + perm32(R & 31)) : R;
        voffA[i] = (unsigned)(R * K + C) * 2u; voffB[i] = (unsigned)(Rb * K + C) * 2u; }
    int rowA[2]; unsigned colA[2];
#pragma unroll
    for (int i = 0; i < 2; ++i) { int R, C; stage_rc(tid * 16 + i * 8192, R, C); rowA[i] = R; colA[i] = (unsigned)C * 2u; }
    const size_t kstep = (size_t)(BK * 2);
    const size_t hstep = (size_t)HALF * K * 2;
    const size_t tstep = 2 * hstep;
    const unsigned ldsw = (unsigned)wid * 1024u;
    const int aoff = lds_byte(wr * 64 + fr, fq * 8), boff = lds_byte(wc * 32 + fr, fq * 8);
#define PG8_SA(b, h) (((b) * 2 + (h)) * HTB)
#define PG8_SB(b, h) ((4 + (b) * 2 + (h)) * HTB)
#define PG8_STAGE(bufoff, gbase, voff) do { _Pragma("unroll") for (int _i = 0; _i < 2; ++_i) \
        __builtin_amdgcn_global_load_lds((const unsigned*)((const char*)(gbase) + (voff)[_i]), (PG8_LAS unsigned*)(lds + (bufoff) + ldsw + _i * 8192), 16, 0, 0); } while (0)
#define PG8_STAGE2(bufoff, gbase, o0, o1) do { \
        __builtin_amdgcn_global_load_lds((const unsigned*)((const char*)(gbase) + (o0)), (PG8_LAS unsigned*)(lds + (bufoff) + ldsw), 16, 0, 0); \
        __builtin_amdgcn_global_load_lds((const unsigned*)((const char*)(gbase) + (o1)), (PG8_LAS unsigned*)(lds + (bufoff) + ldsw + 8192), 16, 0, 0); } while (0)
#define PG8_LDA(dst, b, h) do { _Pragma("unroll") for (int m = 0; m < 4; ++m) _Pragma("unroll") for (int k = 0; k < 2; ++k) dst[m][k] = *(const PG8_LAS bf16x8*)(lds + PG8_SA(b, h) + aoff + m * 2048 + k * 1024); } while (0)
#define PG8_LDB(dst, b, h) do { _Pragma("unroll") for (int n = 0; n < 2; ++n) _Pragma("unroll") for (int k = 0; k < 2; ++k) dst[n][k] = *(const PG8_LAS bf16x8*)(lds + PG8_SB(b, h) + boff + n * 2048 + k * 1024); } while (0)
#define PG8_MMA(ai, bj, At, Bt) do { __builtin_amdgcn_s_setprio(1); _Pragma("unroll") for (int m = 0; m < 4; ++m) _Pragma("unroll") for (int n = 0; n < 2; ++n) { \
        if constexpr (FP8) { asm volatile("v_mfma_f32_16x16x128_f8f6f4 %0, %1, %2, %0" : "+v"(acc[ai][bj][m][n]) : "v"(__builtin_shufflevector((v4i_t)Bt[n][0], (v4i_t)Bt[n][1], 0, 1, 2, 3, 4, 5, 6, 7)), "v"(__builtin_shufflevector((v4i_t)At[m][0], (v4i_t)At[m][1], 0, 1, 2, 3, 4, 5, 6, 7))); } \
        else { _Pragma("unroll") for (int k = 0; k < 2; ++k) acc[ai][bj][m][n] = __builtin_amdgcn_mfma_f32_16x16x32_bf16(Bt[n][k], At[m][k], acc[ai][bj][m][n], 0, 0, 0); } } __builtin_amdgcn_s_setprio(0); } while (0)
#define PG8_WAIT_V(n) asm volatile("s_waitcnt vmcnt(" #n ")" ::: "memory")
#define PG8_WAIT_L(n) asm volatile("s_waitcnt lgkmcnt(" #n ")" ::: "memory")
#define PG8_BAR __builtin_amdgcn_s_barrier()
#define PG8_SCHED __builtin_amdgcn_sched_barrier(0)
    Unit cur, nxt; int ui = 0; int pend = -1;
    if (!S.next(0, cur)) return;
    f32x4 acc[2][2][4][2];
#pragma unroll
    for (int a = 0; a < 2; ++a)
#pragma unroll
        for (int b = 0; b < 2; ++b)
#pragma unroll
            for (int m = 0; m < 4; ++m)
#pragma unroll
                for (int n = 0; n < 2; ++n) acc[a][b][m][n] = (f32x4){0.f, 0.f, 0.f, 0.f};
    bf16x8 At[4][2], B0[2][2], B1[2][2];
    const char* cA = (const char*)g.A + (size_t)cur.pm * tstep; const char* cB = (const char*)g.Bt + (size_t)cur.pn * tstep;
    unsigned oA[2][2], nOA[2][2]; int tk[2][2] = {{0, 0}, {0, 0}};
    if constexpr (GATHER) {
        cA = (const char*)g.A;
        const int nv = S.a_valid(cur); const unsigned ab = S.a_base(cur);
        if (S.a_is_list(cur)) { const int* lst = S.a_list(cur);
#pragma unroll
            for (int h = 0; h < 2; ++h)
#pragma unroll
                for (int i = 0; i < 2; ++i) { const int r = min(h * HALF + rowA[i], nv - 1); oA[h][i] = ab + (unsigned)lst[r] * (unsigned)(K * 2) + colA[i]; }
        } else { const int r0 = S.a_row0(cur);
#pragma unroll
            for (int h = 0; h < 2; ++h)
#pragma unroll
                for (int i = 0; i < 2; ++i) { const int r = min(h * HALF + rowA[i], nv - 1); oA[h][i] = ab + (unsigned)(r0 + r) * (unsigned)(K * 2) + colA[i]; }
        }
    } else {
#pragma unroll
        for (int h = 0; h < 2; ++h)
#pragma unroll
            for (int i = 0; i < 2; ++i) oA[h][i] = voffA[i] + (unsigned)(h * hstep);
    }
#pragma unroll
    for (int h = 0; h < 2; ++h)
#pragma unroll
        for (int i = 0; i < 2; ++i) nOA[h][i] = oA[h][i];
#define PG8_OSEL(h, i) (GATHER ? (last ? nOA[h][i] : oA[h][i]) : oA[h][i])
    S.a_ready(cur);
    if constexpr (SP2) {
        PG8_STAGE(PG8_SB(0, 0), cB, voffB); PG8_STAGE(PG8_SB(0, 1), cB + hstep, voffB); PG8_STAGE2(PG8_SA(0, 0), cA, oA[0][0], oA[0][1]); PG8_STAGE2(PG8_SA(0, 1), cA, oA[1][0], oA[1][1]);
        if (wr == 1) PG8_BAR;
        PG8_WAIT_V(2); PG8_BAR;
        PG8_STAGE(PG8_SB(1, 0), cB + kstep, voffB); PG8_STAGE2(PG8_SA(1, 0), cA + kstep, oA[0][0], oA[0][1]); PG8_STAGE(PG8_SB(1, 1), cB + hstep + kstep, voffB);
        PG8_WAIT_V(6); PG8_BAR;
    } else {
        PG8_STAGE(PG8_SB(0, 0), cB, voffB); PG8_STAGE(PG8_SA(0, 0), cA, voffA); PG8_STAGE(PG8_SB(0, 1), cB + hstep, voffB); PG8_STAGE(PG8_SA(0, 1), cA + hstep, voffA);
        if (wr == 1) PG8_BAR;
        PG8_WAIT_V(4); PG8_BAR;
        PG8_STAGE(PG8_SB(1, 0), cB + kstep, voffB); PG8_STAGE(PG8_SA(1, 0), cA + kstep, voffA); PG8_STAGE(PG8_SB(1, 1), cB + hstep + kstep, voffB);
        PG8_WAIT_V(6); PG8_BAR;
    }
    for (;;) {
        const bool has_next = S.next(ui + 1, nxt);
        const char* nA = GATHER ? cA : (has_next ? (const char*)g.A + (size_t)nxt.pm * tstep : cA); const char* nB = has_next ? (const char*)g.Bt + (size_t)nxt.pn * tstep : cB;
        if constexpr (GATHER) { if (has_next) { const int nv = S.a_valid(nxt);
            if (S.a_is_list(nxt)) { const int* lst = S.a_list(nxt);
#pragma unroll
                for (int h = 0; h < 2; ++h)
#pragma unroll
                    for (int i = 0; i < 2; ++i) { const int* pp = lst + min(h * HALF + rowA[i], nv - 1); asm volatile("global_load_dword %0, %1, off" : "=v"(tk[h][i]) : "v"(pp) : "memory"); }
            } else { const int r0 = S.a_row0(nxt);
#pragma unroll
                for (int h = 0; h < 2; ++h)
#pragma unroll
                    for (int i = 0; i < 2; ++i) tk[h][i] = r0 + min(h * HALF + rowA[i], nv - 1);
            } } }
        for (int t = 0; t < nt; t += 2) {
            const bool last = (t == nt - 2);
            const char* a1 = cA + (size_t)(t + 1) * kstep;
            const char* a2 = last ? nA : cA + (size_t)(t + 2) * kstep; const char* b2 = last ? nB : cB + (size_t)(t + 2) * kstep;
            const char* a3 = a2 + kstep; const char* b3 = b2 + kstep;
            if (last && has_next) S.a_ready(nxt);
            if constexpr (GATHER) { if (last && has_next) { asm volatile("" : "+v"(tk[0][0]), "+v"(tk[0][1]), "+v"(tk[1][0]), "+v"(tk[1][1]));
#pragma unroll
                for (int h = 0; h < 2; ++h)
#pragma unroll
                    for (int i = 0; i < 2; ++i) nOA[h][i] = S.a_base(nxt) + (unsigned)tk[h][i] * (unsigned)(K * 2) + colA[i]; } }
            if constexpr (SP2) {
            PG8_LDB(B0, 0, 0); PG8_LDB(B1, 0, 1); PG8_SCHED; PG8_LDA(At, 0, 0); PG8_STAGE2(PG8_SA(1, 1), a1, oA[1][0], oA[1][1]);
            PG8_WAIT_V(8); PG8_WAIT_L(0); PG8_BAR; PG8_MMA(0, 0, At, B0); PG8_MMA(0, 1, At, B1); PG8_BAR; PG8_SCHED;
            PG8_LDA(At, 0, 1); PG8_STAGE(PG8_SB(0, 0), b2, voffB); PG8_STAGE(PG8_SB(0, 1), b2 + hstep, voffB); PG8_STAGE2(PG8_SA(0, 0), a2, PG8_OSEL(0, 0), PG8_OSEL(0, 1));
            PG8_WAIT_V(8); if (pend >= 0) { S.done_signal(pend); pend = -1; }
            PG8_WAIT_L(0); PG8_BAR; PG8_MMA(1, 0, At, B0); PG8_MMA(1, 1, At, B1); PG8_BAR; PG8_SCHED;
            PG8_LDB(B0, 1, 0); PG8_LDB(B1, 1, 1); PG8_SCHED; PG8_LDA(At, 1, 0); PG8_STAGE2(PG8_SA(0, 1), a2, PG8_OSEL(1, 0), PG8_OSEL(1, 1));
            PG8_WAIT_V(8); PG8_WAIT_L(0); PG8_BAR; PG8_MMA(0, 0, At, B0); PG8_MMA(0, 1, At, B1); PG8_BAR; PG8_SCHED;
            PG8_LDA(At, 1, 1); PG8_STAGE(PG8_SB(1, 0), b3, voffB); PG8_STAGE(PG8_SB(1, 1), b3 + hstep, voffB); PG8_STAGE2(PG8_SA(1, 0), a3, PG8_OSEL(0, 0), PG8_OSEL(0, 1));
            PG8_WAIT_V(8); PG8_WAIT_L(0); PG8_BAR; PG8_MMA(1, 0, At, B0); PG8_MMA(1, 1, At, B1); PG8_BAR; PG8_SCHED;
            } else {
            PG8_LDB(B0, 0, 0); PG8_SCHED; PG8_LDA(At, 0, 0); PG8_STAGE(PG8_SA(1, 1), a1 + hstep, voffA);
            PG8_WAIT_L(8); PG8_BAR; PG8_WAIT_L(0); PG8_MMA(0, 0, At, B0); PG8_BAR; PG8_SCHED;
            PG8_LDB(B1, 0, 1); PG8_STAGE(PG8_SB(0, 0), b2, voffB);
            PG8_BAR; PG8_WAIT_L(0); PG8_MMA(0, 1, At, B1); PG8_BAR;
            PG8_LDA(At, 0, 1); PG8_STAGE(PG8_SA(0, 0), a2, voffA);
            PG8_BAR; PG8_WAIT_L(0); PG8_MMA(1, 0, At, B0); PG8_BAR; PG8_SCHED;
            PG8_STAGE(PG8_SB(0, 1), b2 + hstep, voffB);
            PG8_WAIT_V(6); PG8_BAR; PG8_MMA(1, 1, At, B1); PG8_BAR;
            PG8_LDB(B0, 1, 0); PG8_SCHED; PG8_LDA(At, 1, 0); PG8_STAGE(PG8_SA(0, 1), a2 + hstep, voffA);
            PG8_WAIT_L(8); PG8_BAR; PG8_WAIT_L(0); PG8_MMA(0, 0, At, B0); PG8_BAR; PG8_SCHED;
            PG8_LDB(B1, 1, 1); PG8_STAGE(PG8_SB(1, 0), b3, voffB);
            PG8_BAR; PG8_WAIT_L(0); PG8_MMA(0, 1, At, B1); PG8_BAR;
            PG8_LDA(At, 1, 1); PG8_STAGE(PG8_SA(1, 0), a3, voffA);
            PG8_BAR; PG8_WAIT_L(0); PG8_MMA(1, 0, At, B0); PG8_BAR; PG8_SCHED;
            PG8_STAGE(PG8_SB(1, 1), b3 + hstep, voffB);
            PG8_WAIT_V(6); PG8_BAR; PG8_MMA(1, 1, At, B1); PG8_BAR;
            }
        }
        if constexpr (FP8) asm volatile("s_nop 15\n\ts_nop 15" ::: "memory");
        if constexpr (ALIGN_EPI) { if (wr == 0) PG8_BAR; }
        if constexpr (!Epi::AFTER_DRAIN) { E(acc, cur, wr, wc, fr, fq); S.done(cur); pend = S.done_defer(cur); }
        if (!has_next) break;
#pragma unroll
        for (int a = 0; a < 2; ++a)
#pragma unroll
            for (int b = 0; b < 2; ++b)
#pragma unroll
                for (int m = 0; m < 4; ++m)
#pragma unroll
                    for (int n = 0; n < 2; ++n) acc[a][b][m][n] = (f32x4){0.f, 0.f, 0.f, 0.f};
        cur = nxt; cA = nA; cB = nB; ++ui;
        if constexpr (GATHER) {
#pragma unroll
            for (int h = 0; h < 2; ++h)
#pragma unroll
                for (int i = 0; i < 2; ++i) oA[h][i] = nOA[h][i];
        }
        if constexpr (ALIGN_EPI) { if (wr == 1) PG8_BAR; }
    }
    PG8_WAIT_V(0);
    if (pend >= 0) { S.done_signal(pend); pend = -1; }
    if constexpr (!ALIGN_EPI) { if (wr == 0) PG8_BAR; }
    PG8_BAR;
    if constexpr (Epi::AFTER_DRAIN) { E.fused(acc, cur, wr, wc, fr, fq, lds, wid, lane); S.done(cur); }
#undef PG8_SA
#undef PG8_OSEL
#undef PG8_STAGE2
#undef PG8_SB
#undef PG8_STAGE
#undef PG8_LDA
#undef PG8_LDB
#undef PG8_MMA
#undef PG8_WAIT_V
#undef PG8_WAIT_L
#undef PG8_BAR
#undef PG8_SCHED
}
}

#ifndef MK_N_LAUNCHES
#define MK_N_LAUNCHES 1
#endif
#ifndef PROBE_DUP
#define PROBE_DUP -1
#endif
#ifndef PROBE_STAMP
#define PROBE_STAMP -1
#endif
constexpr int N_PHASES = 10;
constexpr int NBATCH = 8, TT = 2048, MTOK = NBATCH * TT, D = 1024;
constexpr int HK = 512, NH = 4, DK = 128, DV = 128, CCH = 512, CLEN = 31, INC = 3584;
constexpr int NE = 32, TOPK = 4, FF = 1024;
constexpr float EPS = 1e-5f, SW_LIMIT = 7.0f, SW_ALPHA = 1.702f;
constexpr int NWAVES = 8, NTHR = 512;
constexpr int W1_ITEMS = 32 * 16 * 64, W1_P1 = 6144, W1_P2 = 20480, W1_P0 = W1_ITEMS - W1_P1 - W1_P2;
constexpr int W2_ITEMS = 32 * 16 * 32, W2_P7 = 4096, W2_P2 = W2_ITEMS - W2_P7;
constexpr int MOE_ROWS = (MTOK * TOPK / 256 + NE) * 256;

constexpr size_t MiB = 1u << 20;
constexpr size_t WS_CTL = 0, CTL_ZERO_BYTES = 256 * 1024;
constexpr size_t WS_WI = 1 * MiB;
constexpr size_t WS_WO = 8 * MiB;
constexpr size_t WS_TAB = 10 * MiB;
constexpr size_t WS_W1 = 16 * MiB;
constexpr size_t WS_W2 = 144 * MiB;
constexpr size_t WS_H = 208 * MiB;
constexpr size_t WS_XN = 272 * MiB;
constexpr size_t WS_Q = 304 * MiB, WS_KF = 320 * MiB, WS_KB = 336 * MiB, WS_V = 352 * MiB, WS_G = 368 * MiB, WS_U = 384 * MiB;
constexpr size_t WS_LF = 400 * MiB, WS_LB = 432 * MiB;
constexpr size_t WS_OF = 464 * MiB, WS_OB = 496 * MiB;
constexpr size_t WS_MIX = 528 * MiB;
constexpr size_t WS_XS = 304 * MiB;
constexpr size_t WS_ACT = 448 * MiB;
constexpr size_t WS_YS = 592 * MiB;
constexpr size_t WS_END = 736 * MiB;
constexpr size_t WS_WRT = WS_TAB;
constexpr size_t WS_SLOT = WS_TAB + 256 * 1024;
constexpr size_t WS_GATE = WS_TAB + 512 * 1024;
constexpr size_t WS_ROWTOK = WS_TAB + 1 * MiB;
constexpr int CW_BAR = 4096;
constexpr int CW_CNT = 16384;

constexpr int RING_OFF = 0, RING_BYTES = 131072;
constexpr int LDSCTL_OFF = 152576;
constexpr int MISC_OFF = LDSCTL_OFF + 320;
constexpr int TAB_OFF = LDSCTL_OFF + 1024;
constexpr int SB_OFF = LDSCTL_OFF + 2048;
constexpr int LDS_BYTES = 163840;

#define GAS __attribute__((address_space(1)))
#define LAS __attribute__((address_space(3)))
typedef unsigned short bf16;
typedef unsigned v4u __attribute__((ext_vector_type(4)));
typedef unsigned v2u __attribute__((ext_vector_type(2)));
typedef float f32x4 __attribute__((ext_vector_type(4)));
typedef GAS unsigned gu32;
#define RLX_AGENT __ATOMIC_RELAXED, __HIP_MEMORY_SCOPE_AGENT
#define LDS_WAIT() asm volatile("s_waitcnt lgkmcnt(0)" ::: "memory")
#define VM_WAIT() asm volatile("s_waitcnt vmcnt(0)" ::: "memory")

__device__ __forceinline__ float bf2f(unsigned b) { return __uint_as_float(b << 16); }
typedef __bf16 bf16x2_t __attribute__((ext_vector_type(2)));
typedef float f32x2_t __attribute__((ext_vector_type(2)));
__device__ __forceinline__ unsigned pk2(float lo, float hi) { const bf16x2_t r = __builtin_convertvector((f32x2_t){lo, hi}, bf16x2_t); return __builtin_bit_cast(unsigned, r); }
__device__ __forceinline__ float sigm(float x) { return __builtin_amdgcn_rcpf(1.0f + __expf(-x)); }
__device__ __forceinline__ float wave_sum(float v) {
#pragma unroll
    for (int o = 1; o < 64; o <<= 1) v += __shfl_xor(v, o);
    return v;
}

constexpr float SC_W = 512.f, SC_N2 = 16.f, SC_ACT = 8.f;
__device__ __forceinline__ unsigned pk4_fp8(float a, float b, float c, float d) {
    a = fminf(fmaxf(a, -448.f), 448.f); b = fminf(fmaxf(b, -448.f), 448.f); c = fminf(fmaxf(c, -448.f), 448.f); d = fminf(fmaxf(d, -448.f), 448.f);
    int w = 0; w = __builtin_amdgcn_cvt_pk_fp8_f32(a, b, w, false); w = __builtin_amdgcn_cvt_pk_fp8_f32(c, d, w, true); return (unsigned)w;
}

#define XB_TMO      128
#define XB_XCNT(j)  (256  + 64 * (j))
#define XB_XSUB(j)  (1280 + 64 * (j))
#define XB_XGEN(j)  (2304 + 64 * (j))
#define XB_TOP      3328
#define XB_TOPGEN   3392
#define XCD_BAR_WORDS 3456
#define XB_SPIN_CAP (1u << 18)

__device__ __forceinline__ unsigned xb_ld(unsigned* p)              { return __hip_atomic_load(p, __ATOMIC_RELAXED, __HIP_MEMORY_SCOPE_AGENT); }
__device__ __forceinline__ unsigned xb_add(unsigned* p, unsigned v) { return __hip_atomic_fetch_add(p, v, __ATOMIC_RELAXED, __HIP_MEMORY_SCOPE_AGENT); }
__device__ __forceinline__ unsigned xb_xcc_id() { return (unsigned)__builtin_amdgcn_s_getreg((3 << 11) | 20) & 0xFu; }
#define XB_SPIN(cond, bar) do { unsigned _sp = 0; while (cond) { __builtin_amdgcn_s_sleep(1); \
    if ((++_sp & 255u) == 0u) { if (xb_ld(&(bar)[XB_TMO])) break; if (_sp > XB_SPIN_CAP) { atomicAdd(&(bar)[XB_TMO], 1u); break; } } } } while (0)

struct XcdBarrier {
    unsigned* bar; unsigned x;
    volatile LAS unsigned* st;
};
__device__ __forceinline__ XcdBarrier xcd_barrier_post(unsigned* bar, volatile LAS unsigned* st) {
    XcdBarrier b; b.bar = bar; b.x = xb_xcc_id(); b.st = st;
    if (threadIdx.x == 0) (void)xb_add(&bar[XB_XCNT(b.x)], 1u);
    return b;
}
__device__ __forceinline__ void xcd_barrier_complete(unsigned* bar, unsigned x, unsigned& nloc, unsigned& nx) {
    const unsigned G = gridDim.x * gridDim.y * gridDim.z;
    unsigned sum, cnt, mine, sp = 0u;
    for (;;) {
        sum = 0u; cnt = 0u; mine = 0u;
#pragma unroll
        for (unsigned j = 0; j < 16; ++j) { const unsigned c = xb_ld(&bar[XB_XCNT(j)]); sum += c; cnt += (c > 0u) ? 1u : 0u; mine = (j == x) ? c : mine; }
        if (sum == G) break;
        __builtin_amdgcn_s_sleep(1);
        if ((++sp & 255u) == 0u) { if (xb_ld(&bar[XB_TMO])) break; if (sp > XB_SPIN_CAP) { atomicAdd(&bar[XB_TMO], 1u); break; } }
    }
    nloc = mine > 0u ? mine : 1u; nx = cnt > 0u ? cnt : 1u;
}
__device__ __forceinline__ void xcd_barrier(const XcdBarrier& b) {
    asm volatile("s_waitcnt vmcnt(0)" ::: "memory");
    __syncthreads();
    if (threadIdx.x == 0) {
        unsigned* bar = b.bar;
        __builtin_amdgcn_s_waitcnt(0);
        unsigned nloc = b.st[0], nx = b.st[1];
        if (nloc == 0u) { xcd_barrier_complete(bar, b.x, nloc, nx); b.st[0] = nloc; b.st[1] = nx; }
        const unsigned old = xb_add(&bar[XB_XSUB(b.x)], 1u);
        const unsigned gen = old / nloc;
        if (old + 1u == (gen + 1u) * nloc) {
            __builtin_amdgcn_fence(__ATOMIC_RELEASE, "agent");
            asm volatile("s_waitcnt vmcnt(0)" ::: "memory");
            const unsigned og = xb_add(&bar[XB_TOP], 1u);
            const unsigned tg = og / nx;
            if (og + 1u == (tg + 1u) * nx) xb_add(&bar[XB_TOPGEN], 1u);
            else XB_SPIN(xb_ld(&bar[XB_TOPGEN]) == tg, bar);
            __builtin_amdgcn_fence(__ATOMIC_ACQUIRE, "agent");
            xb_add(&bar[XB_XGEN(b.x)], 1u);
            asm volatile("s_waitcnt vmcnt(0)" ::: "memory");
        } else {
            XB_SPIN(xb_ld(&bar[XB_XGEN(b.x)]) == gen, bar);
            __builtin_amdgcn_fence(__ATOMIC_ACQUIRE, "agent");
            asm volatile("s_waitcnt vmcnt(0)" ::: "memory");
        }
    }
    __syncthreads();
}

#ifndef WT_STORES
#define WT_STORES 0
#endif
__device__ __forceinline__ void st16(void* p, v4u w) {
#if WT_STORES
    asm volatile("global_store_dwordx4 %0, %1, off sc0 sc1\n\ts_nop 1" :: "v"(p), "v"(w) : "memory");
#else
    *(v4u*)p = w;
#endif
}
__device__ __forceinline__ void st8(void* p, v2u w) {
#if WT_STORES
    asm volatile("global_store_dwordx2 %0, %1, off sc0 sc1\n\ts_nop 1" :: "v"(p), "v"(w) : "memory");
#else
    *(v2u*)p = w;
#endif
}
__device__ __forceinline__ void st8bf(bf16* p, const f32x4& a, const f32x4& b) {
    v4u w; w.x = pk2(a[0], a[1]); w.y = pk2(a[2], a[3]); w.z = pk2(b[0], b[1]); w.w = pk2(b[2], b[3]);
    st16(p, w);
}
struct EpiProj {
    static constexpr bool PERM = true, AFTER_DRAIN = false;
    bf16 *Q, *KF, *KB, *V, *G, *U; float *LF, *LB; const float* lbl;
    template <int TYP>
    __device__ __forceinline__ void tile(const pg8::f32x4 (&acc)[2][2][4][2], int row0, int cb) const {
#pragma unroll
        for (int bj = 0; bj < 2; ++bj) {
            const int col = cb + bj * 128;
            float lb[8];
            if (TYP == 1 || TYP == 2) {
                const float* L = lbl + (TYP - 1) * 1024 + col;
#pragma unroll
                for (int i = 0; i < 8; ++i) lb[i] = __builtin_amdgcn_rcpf(1.0f + __expf(L[512 + i] - L[i]));
            }
#pragma unroll
            for (int ai = 0; ai < 2; ++ai)
#pragma unroll
                for (int m = 0; m < 4; ++m) {
                    const size_t off = (size_t)(row0 + ai * 128 + m * 16) * 512 + col;
                    f32x4 a = acc[ai][bj][m][0], b = acc[ai][bj][m][1];
                    if (TYP == 0 || TYP == 4) {
#pragma unroll
                        for (int i = 0; i < 4; ++i) { a[i] = a[i] * sigm(a[i]); b[i] = b[i] * sigm(b[i]); }
                        st8bf((TYP == 0 ? Q : G) + off, a, b);
                    } else if (TYP == 3) {
                        st8bf(V + off, a, b);
                    } else {
                        f32x4 la, lbv, ka, kb;
#pragma unroll
                        for (int i = 0; i < 4; ++i) {
                            const float fa = lb[i] + (1.0f - lb[i]) * sigm(a[i]), fb = lb[4 + i] + (1.0f - lb[4 + i]) * sigm(b[i]);
                            la[i] = __logf(fa); lbv[i] = __logf(fb); ka[i] = 1.0f - fa; kb[i] = 1.0f - fb;
                        }
                        float* Lp = (TYP == 1 ? LF : LB) + off;
                        st16(Lp, (v4u)la); st16(Lp + 4, (v4u)lbv);
                        st8bf((TYP == 1 ? KF : KB) + off, ka, kb);
                    }
                }
        }
    }
    __device__ __forceinline__ void operator()(const pg8::f32x4 (&acc)[2][2][4][2], const pg8::Unit& u, int wr, int wc, int fr, int fq) const {
        const int row0 = u.pm * 256 + wr * 64 + fr, pn = u.pn;
        if (pn >= 10) {
            const int col = (pn - 10) * 128 + wc * 32 + 8 * fq;
#pragma unroll
            for (int ai = 0; ai < 2; ++ai)
#pragma unroll
                for (int m = 0; m < 4; ++m) {
                    f32x4 a = acc[ai][0][m][0], b = acc[ai][0][m][1]; const f32x4 ga = acc[ai][1][m][0], gb = acc[ai][1][m][1];
#pragma unroll
                    for (int i = 0; i < 4; ++i) { a[i] = a[i] * sigm(ga[i]); b[i] = b[i] * sigm(gb[i]); }
                    st8bf(U + (size_t)(row0 + ai * 128 + m * 16) * 512 + col, a, b);
                }
        } else {
            const int cb = (pn & 1) * 256 + wc * 32 + 8 * fq, typ = pn >> 1;
            if (typ == 0) tile<0>(acc, row0, cb);
            else if (typ == 1) tile<1>(acc, row0, cb);
            else if (typ == 2) tile<2>(acc, row0, cb);
            else if (typ == 3) tile<3>(acc, row0, cb);
            else tile<4>(acc, row0, cb);
        }
    }
};
struct EpiRes {
    static constexpr bool PERM = false, AFTER_DRAIN = false;
    const float* X; float* H;
    __device__ __forceinline__ void operator()(const pg8::f32x4 (&acc)[2][2][4][2], const pg8::Unit& u, int wr, int wc, int fr, int fq) const {
        const int row0 = u.pm * 256 + wr * 64 + fr, col0 = u.pn * 256 + wc * 32 + 4 * fq;
#pragma unroll
        for (int ai = 0; ai < 2; ++ai)
#pragma unroll
            for (int m = 0; m < 4; ++m) {
                const size_t off = (size_t)(row0 + ai * 128 + m * 16) * D + col0;
#pragma unroll
                for (int bj = 0; bj < 2; ++bj)
#pragma unroll
                    for (int n = 0; n < 2; ++n) { const f32x4 xv = *(const f32x4*)(X + off + bj * 128 + n * 16); st16(H + off + bj * 128 + n * 16, (v4u)(xv + acc[ai][bj][m][n])); }
            }
    }
};
struct EpiSwiglu {
    static constexpr bool PERM = true, AFTER_DRAIN = false;
    unsigned char* ACT; const float* b1;
    __device__ __forceinline__ void operator()(const pg8::f32x4 (&acc)[2][2][4][2], const pg8::Unit& u, int wr, int wc, int fr, int fq) const {
        const int e = u.pn >> 3, pn = u.pn & 7, row0 = u.pm * 256 + wr * 64 + fr, col = pn * 128 + wc * 32 + 8 * fq;
        const float* bg = b1 + (size_t)e * 2048 + col; const float* bl = bg + 1024;
        float g[8], l[8];
#pragma unroll
        for (int i = 0; i < 8; ++i) { g[i] = bg[i]; l[i] = bl[i]; }
#pragma unroll
        for (int ai = 0; ai < 2; ++ai)
#pragma unroll
            for (int m = 0; m < 4; ++m) {
                f32x4 o[2];
#pragma unroll
                for (int n = 0; n < 2; ++n)
#pragma unroll
                    for (int i = 0; i < 4; ++i) {
                        const float hg = fminf(acc[ai][0][m][n][i] * (1.0f / (SC_N2 * SC_W)) + g[4 * n + i], SW_LIMIT);
                        const float hl = fminf(fmaxf(acc[ai][1][m][n][i] * (1.0f / (SC_N2 * SC_W)) + l[4 * n + i], -SW_LIMIT), SW_LIMIT);
                        o[n][i] = hg * sigm(SW_ALPHA * hg) * (hl + 1.0f) * SC_ACT;
                    }
                v2u w; w.x = pk4_fp8(o[0][0], o[0][1], o[0][2], o[0][3]); w.y = pk4_fp8(o[1][0], o[1][1], o[1][2], o[1][3]);
#if defined(MOE_MERGED)
                asm volatile("global_store_dwordx2 %0, %1, off sc0 sc1\n\ts_nop 1" :: "v"(ACT + (size_t)(row0 + ai * 128 + m * 16) * FF + col), "v"(w) : "memory");
#else
                st8(ACT + (size_t)(row0 + ai * 128 + m * 16) * FF + col, w);
#endif
            }
    }
};
struct EpiDown {
    static constexpr bool PERM = true, AFTER_DRAIN = false;
    bf16* YS; const float* b2;
    __device__ __forceinline__ void operator()(const pg8::f32x4 (&acc)[2][2][4][2], const pg8::Unit& u, int wr, int wc, int fr, int fq) const {
        const int e = u.pn >> 2, pn = u.pn & 3, row0 = u.pm * 256 + wr * 64 + fr, col0 = pn * 256 + wc * 32 + 8 * fq;
#pragma unroll
        for (int bj = 0; bj < 2; ++bj) {
            const float* bp = b2 + (size_t)e * D + col0 + bj * 128;
            const f32x4 b0 = *(const f32x4*)bp, b1v = *(const f32x4*)(bp + 4);
#pragma unroll
            for (int ai = 0; ai < 2; ++ai)
#pragma unroll
                for (int m = 0; m < 4; ++m)
                    st8bf(YS + (size_t)(row0 + ai * 128 + m * 16) * D + col0 + bj * 128, acc[ai][bj][m][0] * (1.0f / (SC_ACT * SC_W)) + b0, acc[ai][bj][m][1] * (1.0f / (SC_ACT * SC_W)) + b1v);
        }
    }
};
struct MoeOrder {
    const volatile LAS int* bs; int ntn, G, v; const volatile LAS int* cl; const int* rowtok;
    __device__ __forceinline__ const int* a_list(const pg8::Unit& u) const { const int e = u.pn / ntn; return rowtok + e * MTOK + (u.pm - bs[e]) * 256; }
    __device__ __forceinline__ int a_valid(const pg8::Unit& u) const { const int e = u.pn / ntn; return min(256, cl[e] - (u.pm - bs[e]) * 256); }
    __device__ __forceinline__ bool next(int i, pg8::Unit& u) const {
        int L = i * G + v; const int nb = bs[32];
        if (L >= nb * ntn * (((PROBE_DUP) == 17 && ntn == 8) || ((PROBE_DUP) == 18 && ntn == 4) ? 2 : 1)) return false;
        if (L >= nb * ntn) L -= nb * ntn;
        const int mb = L / ntn, pn = L - mb * ntn;
        const int ln = (int)(threadIdx.x & 63);
        const int e = __popcll(__ballot(ln < NE - 1 && bs[ln + 1] <= mb));
        u.pm = mb; u.pn = e * ntn + pn; return true;
    }
    __device__ __forceinline__ bool a_is_list(const pg8::Unit&) const { return true; }
    __device__ __forceinline__ unsigned a_base(const pg8::Unit&) const { return 0u; }
    __device__ __forceinline__ int a_row0(const pg8::Unit&) const { return 0; }
    __device__ __forceinline__ void a_ready(const pg8::Unit&) const {}
    __device__ __forceinline__ void done(const pg8::Unit&) const {}
    __device__ __forceinline__ int done_defer(const pg8::Unit&) const { return -1; }
    __device__ __forceinline__ void done_signal(int) const {}
};
constexpr int CW_BLK = 32768;
struct MoeOrder2 {
    const volatile LAS int* bs; int G, v; const volatile LAS int* cl; const int* rowtok; unsigned* ctl;
    __device__ __forceinline__ bool is_down(const pg8::Unit& u) const { return u.pn >= 512; }
    __device__ __forceinline__ int expert(const pg8::Unit& u) const { return is_down(u) ? (u.pn - 512) >> 2 : u.pn >> 3; }
    __device__ __forceinline__ bool a_is_list(const pg8::Unit& u) const { return !is_down(u); }
    __device__ __forceinline__ unsigned a_base(const pg8::Unit& u) const { return is_down(u) ? (unsigned)WS_ACT : (unsigned)WS_XN; }
    __device__ __forceinline__ int a_row0(const pg8::Unit& u) const { return u.pm * 256; }
    __device__ __forceinline__ const int* a_list(const pg8::Unit& u) const { const int e = expert(u); return rowtok + e * MTOK + (u.pm - bs[e]) * 256; }
    __device__ __forceinline__ int a_valid(const pg8::Unit& u) const { const int e = expert(u); return min(256, cl[e] - (u.pm - bs[e]) * 256); }
    __device__ __forceinline__ bool next(int i, pg8::Unit& u) const {
        const int L = i * G + v, nb = bs[32];
        if (L >= nb * 12) return false;
        const bool dn = L >= nb * 8; const int L2 = dn ? L - nb * 8 : L, ntn = dn ? 4 : 8;
        const int mb = L2 / ntn, pn = L2 - mb * ntn;
        const int ln = (int)(threadIdx.x & 63);
        const int e = __popcll(__ballot(ln < NE - 1 && bs[ln + 1] <= mb));
        u.pm = mb; u.pn = (dn ? 512 : 0) + e * ntn + pn; return true;
    }
    __device__ __forceinline__ void a_ready(const pg8::Unit& u) const {
        if (!is_down(u)) return;
        if (threadIdx.x < 64) {
            const unsigned long long t0 = __builtin_amdgcn_s_memrealtime(); unsigned polls = 0;
            while ((unsigned)__builtin_amdgcn_readfirstlane(__hip_atomic_load(ctl + CW_BLK + 64 * u.pm, __ATOMIC_RELAXED, __HIP_MEMORY_SCOPE_AGENT)) < 64u) {
                if ((++polls & 255u) == 0u && __builtin_amdgcn_readfirstlane(__hip_atomic_load(ctl + 1, __ATOMIC_RELAXED, __HIP_MEMORY_SCOPE_AGENT)) != 0u) break;
                if (__builtin_amdgcn_s_memrealtime() - t0 > 2000000ull) { if (threadIdx.x == 0) __hip_atomic_store(ctl + 1, 1u, __ATOMIC_RELAXED, __HIP_MEMORY_SCOPE_AGENT); break; }
                __builtin_amdgcn_s_sleep(2); }
            __builtin_amdgcn_fence(__ATOMIC_ACQUIRE, "agent");
            asm volatile("s_waitcnt vmcnt(0)" ::: "memory");
        }
        asm volatile("" ::: "memory"); __builtin_amdgcn_s_barrier(); asm volatile("" ::: "memory");
    }
    __device__ __forceinline__ void done(const pg8::Unit&) const {}
    __device__ __forceinline__ int done_defer(const pg8::Unit& u) const { return is_down(u) ? -1 : u.pm; }
    __device__ __forceinline__ void done_signal(int mb) const { if ((threadIdx.x & 63) == 0) __hip_atomic_fetch_add(ctl + CW_BLK + 64 * mb, 1u, __ATOMIC_RELAXED, __HIP_MEMORY_SCOPE_AGENT); }
};
struct EpiMoe {
    static constexpr bool PERM = true, AFTER_DRAIN = false;
    EpiSwiglu up; EpiDown down;
    __device__ __forceinline__ void operator()(const pg8::f32x4 (&acc)[2][2][4][2], const pg8::Unit& u, int wr, int wc, int fr, int fq) const {
        if (u.pn >= 512) { pg8::Unit d; d.pm = u.pm; d.pn = u.pn - 512; down(acc, d, wr, wc, fr, fq); } else up(acc, u, wr, wc, fr, fq);
    }
};

#ifndef PROBE_DUP
#define PROBE_DUP -1
#endif
struct OrderRep : pg8::StaticOrder {
    int reps;
    __device__ __forceinline__ bool next(int i, pg8::Unit& u) const {
        const int per = (nwg + G - 1) / G, r = i / per;
        if (r >= reps) return false;
        return pg8::StaticOrder::next(i - r * per, u) ? true : ((r + 1 < reps) ? pg8::StaticOrder::next(0, u) : false);
    }
};
struct RmIdent { __device__ __forceinline__ int operator()(int n) const { return n; } };
struct RmWin {
    __device__ __forceinline__ int operator()(int n) const {
        if (n < 2560) return n;
        if (n < 3072) { const int j = n - 2560; return 2560 + (j >> 7) * 256 + (j & 127); }
        const int j = n - 3072; return 2560 + (j >> 7) * 256 + 128 + (j & 127);
    }
};
struct RmW1 {
    __device__ __forceinline__ int operator()(int n) const {
        if (n < 1024) return (n >> 7) * 256 + (n & 127);
        const int j = n - 1024; return (j >> 7) * 256 + 128 + (j & 127);
    }
};
__device__ __forceinline__ void p0_load(const float* W, int N, int item, int lane, f32x4 (&v)[8]) {
    const int nblk = N / 32, kb = item / nblk, nb = item % nblk, k0 = 64 * kb, n0 = 32 * nb;
    const int r8 = lane >> 3, c4 = lane & 7;
#pragma unroll
    for (int i = 0; i < 8; ++i) v[i] = *(const f32x4*)(W + (size_t)(k0 + 8 * i + r8) * N + n0 + 4 * c4);
}
template <bool FP8OUT, class RM>
__device__ __forceinline__ void p0_finish(const f32x4 (&v)[8], int K, int N, void* WTv, RM rm, LAS float* scr, int item, int lane) {
    const int nblk = N / 32, kb = item / nblk, nb = item % nblk, k0 = 64 * kb, n0 = 32 * nb;
    const int r8 = lane >> 3, c4 = lane & 7;
#pragma unroll
    for (int i = 0; i < 8; ++i) *(LAS f32x4*)(scr + (8 * i + r8) * 36 + 4 * c4) = v[i];
    LDS_WAIT(); asm volatile("" ::: "memory");
    const int n = lane & 31, kh = lane >> 5; const LAS float* s = scr + (32 * kh) * 36 + n;
    if constexpr (FP8OUT) {
        unsigned w[8];
#pragma unroll
        for (int j = 0; j < 8; ++j) w[j] = pk4_fp8(s[(4 * j) * 36] * SC_W, s[(4 * j + 1) * 36] * SC_W, s[(4 * j + 2) * 36] * SC_W, s[(4 * j + 3) * 36] * SC_W);
        GAS v4u* dst = (GAS v4u*)((unsigned char*)WTv + (size_t)rm(n0 + n) * K + k0 + 32 * kh);
        dst[0] = (v4u){w[0], w[1], w[2], w[3]}; dst[1] = (v4u){w[4], w[5], w[6], w[7]};
    } else {
        unsigned w[16];
#pragma unroll
        for (int j = 0; j < 16; ++j) w[j] = pk2(s[(2 * j) * 36], s[(2 * j + 1) * 36]);
        GAS v4u* dst = (GAS v4u*)((bf16*)WTv + (size_t)rm(n0 + n) * K + k0 + 32 * kh);
#pragma unroll
        for (int q = 0; q < 4; ++q) dst[q] = (v4u){w[4 * q], w[4 * q + 1], w[4 * q + 2], w[4 * q + 3]};
    }
    LDS_WAIT(); asm volatile("" ::: "memory");
}
template <bool FP8OUT, class RM>
__device__ __forceinline__ void p0_item(const float* W, int K, int N, void* WTv, RM rm, LAS float* scr, int item, int lane) {
    f32x4 v[8]; p0_load(W, N, item, lane, v); p0_finish<FP8OUT>(v, K, N, WTv, rm, scr, item, lane);
}
template <class RM>
__device__ __forceinline__ void convert_range_fp8(const float* W, int K, int N, unsigned char* WT, RM rm, int ipe_log2, int first, int stride, int count, int base, LAS float* scr, int lane) {
    const size_t esz = (size_t)K * N; const int mask = (1 << ipe_log2) - 1;
    f32x4 va[8], vb[8];
    int it = first;
    if (it < count) p0_load(W + (size_t)((base + it) >> ipe_log2) * esz, N, (base + it) & mask, lane, va);
    while (it < count) {
        const int i1 = it + stride, i2 = it + 2 * stride;
        if (i1 < count) p0_load(W + (size_t)((base + i1) >> ipe_log2) * esz, N, (base + i1) & mask, lane, vb);
        p0_finish<true>(va, K, N, WT + (size_t)((base + it) >> ipe_log2) * esz, rm, scr, (base + it) & mask, lane);
        if (i1 >= count) break;
        if (i2 < count) p0_load(W + (size_t)((base + i2) >> ipe_log2) * esz, N, (base + i2) & mask, lane, va);
        p0_finish<true>(vb, K, N, WT + (size_t)((base + i1) >> ipe_log2) * esz, rm, scr, (base + i1) & mask, lane);
        it = i2;
    }
}
__device__ __forceinline__ void rms_row_to_bf16(const float* xrow, const float* w, bf16* orow, int lane) {
    const f32x4* xr = (const f32x4*)xrow + lane; const f32x4* wr = (const f32x4*)w + lane;
    f32x4 v[4]; float s = 0.f;
#pragma unroll
    for (int j = 0; j < 4; ++j) { v[j] = xr[64 * j]; s += (v[j].x * v[j].x + v[j].y * v[j].y) + (v[j].z * v[j].z + v[j].w * v[j].w); }
    const float rstd = rsqrtf(wave_sum(s) * (1.f / D) + EPS);
    v2u* o8 = (v2u*)orow + lane;
#pragma unroll
    for (int j = 0; j < 4; ++j) { const f32x4 g = wr[64 * j]; v2u o; o.x = pk2(v[j].x * rstd * g.x, v[j].y * rstd * g.y); o.y = pk2(v[j].z * rstd * g.z, v[j].w * rstd * g.w); o8[64 * j] = o; }
}


__device__ __forceinline__ pg8::bf16x8 lds_frag(const LAS unsigned char* p) { return *(const LAS pg8::bf16x8*)p; }
__device__ __forceinline__ pg8::bf16x8 mk_frag(v2u a, v2u b) { const v4u w = (v4u){a.x, a.y, b.x, b.y}; return (pg8::bf16x8)w; }
#ifndef PROBE_TID
#define PROBE_TID 0
#endif
#define HG_PSTAMP(lds_, n_, code_) do { if ((PROBE_STAMP) >= 660 && (PROBE_STAMP) <= 669 && (n_) == 5 && threadIdx.x == (PROBE_TID)) { \
        if ((code_) == 660) *(volatile LAS unsigned long long*)((lds_) + LDSCTL_OFF + 640) = __builtin_amdgcn_s_memrealtime(); \
        if ((code_) == (PROBE_STAMP)) *(volatile LAS unsigned long long*)((lds_) + LDSCTL_OFF + 648) = __builtin_amdgcn_s_memrealtime(); } } while (0)
struct HgCtx {
    LAS unsigned char* lds; const bf16 *Qb, *Kp, *Vb; const float* Lp; float* Op;
    int b, h, dir, vh, lane, wave, lr, lq, dA, seg, tauB, dg;
    unsigned offA[16], offB, offV, ke_tr, v_tr;
};
constexpr int HG_BF = 0, HG_AM = 0, HG_QI = 33792, HG_KK = 51200, HG_KE = 68608, HG_V = 86016, HG_ST = 95232, HG_SEG = 112640, HG_DEC = 114688;
constexpr int HG_RSD = 272, HG_RSS = 144, HG_RSBF = 528;
__device__ __forceinline__ void hgrn_load(const HgCtx& c, int n, float (&lf)[16], v4u (&qB)[2], v4u (&kB)[2], v4u& vB) {
    const size_t cb = (size_t)__builtin_amdgcn_readfirstlane(c.b * TT + (c.dir ? (TT / 64 - 1 - n) * 64 : n * 64)) * 512 + c.h * 128;
    const float* Lc = c.Lp + cb; const bf16* Qc = c.Qb + cb; const bf16* Kc = c.Kp + cb; const bf16* Vc = c.Vb + cb;
#pragma unroll
    for (int i = 0; i < 16; ++i) lf[i] = Lc[c.offA[i]];
    qB[0] = *(const v4u*)(Qc + c.offB); qB[1] = *(const v4u*)(Qc + c.offB + 8); kB[0] = *(const v4u*)(Kc + c.offB); kB[1] = *(const v4u*)(Kc + c.offB + 8);
    vB = *(const v4u*)(Vc + c.offV);
}
__device__ __forceinline__ void hgrn_chunk(const HgCtx& c, int n, float (&lf)[16], v4u (&qB)[2], v4u (&kB)[2], v4u& vB, f32x4 (&S)[4]) {
    LAS unsigned char* lds = c.lds;
    const int dir = c.dir, lr = c.lr, lq = c.lq, wave = c.wave, dA = c.dA, seg = c.seg, tauB = c.tauB, dg = c.dg;
    const int tb = c.b * TT + (dir ? (TT / 64 - 1 - n) * 64 : n * 64); HG_PSTAMP(lds, n, 660);
    float bl[16]; { float cs = 0.f;
#pragma unroll
        for (int i = 0; i < 16; ++i) { cs += lf[i]; bl[i] = cs; }
        *(LAS float*)(lds + HG_SEG + (seg * 128 + dA) * 4) = cs; }
    __syncthreads();
    HG_PSTAMP(lds, n, 661);
    {
        const float p0 = *(LAS float*)(lds + HG_SEG + (0 * 128 + dA) * 4), p1 = *(LAS float*)(lds + HG_SEG + (1 * 128 + dA) * 4),
                    p2 = *(LAS float*)(lds + HG_SEG + (2 * 128 + dA) * 4), p3 = *(LAS float*)(lds + HG_SEG + (3 * 128 + dA) * 4);
        const float pre = (seg > 0 ? p0 : 0.f) + (seg > 1 ? p1 : 0.f) + (seg > 2 ? p2 : 0.f);
#pragma unroll
        for (int i = 0; i < 16; ++i) *(LAS float*)(lds + HG_BF + (16 * seg + i) * HG_RSBF + dA * 4) = pre + bl[i];
        if (seg == 0) *(LAS float*)(lds + HG_DEC + dA * 4) = __expf((p0 + p1) + (p2 + p3));
    }
    __syncthreads();
    HG_PSTAMP(lds, n, 662);
    {
        const unsigned qw[8] = {qB[0].x, qB[0].y, qB[0].z, qB[0].w, qB[1].x, qB[1].y, qB[1].z, qB[1].w};
        const unsigned kw[8] = {kB[0].x, kB[0].y, kB[0].z, kB[0].w, kB[1].x, kB[1].y, kB[1].z, kB[1].w};
        unsigned qo[8], ko[8], eo[8];
#pragma unroll
        for (int i = 0; i < 4; ++i) {
            const f32x4 bb = *(const LAS f32x4*)(lds + HG_BF + tauB * HG_RSBF + dg * 64 + i * 16);
            const f32x4 dc = *(const LAS f32x4*)(lds + HG_DEC + dg * 64 + i * 16);
#pragma unroll
            for (int j = 0; j < 2; ++j) {
                const float e0 = __expf(bb[2 * j]), e1 = __expf(bb[2 * j + 1]);
                const unsigned qq = qw[2 * i + j], kk = kw[2 * i + j];
                const float k0 = bf2f(kk & 0xffffu) * __builtin_amdgcn_rcpf(e0), k1 = bf2f(kk >> 16) * __builtin_amdgcn_rcpf(e1);
                qo[2 * i + j] = pk2(bf2f(qq & 0xffffu) * e0, bf2f(qq >> 16) * e1);
                ko[2 * i + j] = pk2(k0, k1);
                eo[2 * i + j] = pk2(k0 * dc[2 * j], k1 * dc[2 * j + 1]);
            }
        }
        *(LAS v4u*)(lds + HG_QI + tauB * HG_RSD + dg * 32) = (v4u){qo[0], qo[1], qo[2], qo[3]}; *(LAS v4u*)(lds + HG_QI + tauB * HG_RSD + dg * 32 + 16) = (v4u){qo[4], qo[5], qo[6], qo[7]};
        *(LAS v4u*)(lds + HG_KK + tauB * HG_RSD + dg * 32) = (v4u){ko[0], ko[1], ko[2], ko[3]}; *(LAS v4u*)(lds + HG_KK + tauB * HG_RSD + dg * 32 + 16) = (v4u){ko[4], ko[5], ko[6], ko[7]};
        *(LAS v4u*)(lds + HG_KE + tauB * HG_RSD + dg * 32) = (v4u){eo[0], eo[1], eo[2], eo[3]}; *(LAS v4u*)(lds + HG_KE + tauB * HG_RSD + dg * 32 + 16) = (v4u){eo[4], eo[5], eo[6], eo[7]};
        *(LAS v4u*)(lds + HG_V + tauB * HG_RSS + dg * 16) = vB;
    }
    __syncthreads();
    HG_PSTAMP(lds, n, 663);
    if (n + 2 < TT / 64) hgrn_load(c, n + 2, lf, qB, kB, vB);
    HG_PSTAMP(lds, n, 666);
    const int ei = wave & 3, tp = wave >> 2;
    v2u ket[2][2], vt[4][2][2];
    asm volatile("ds_read_b64_tr_b16 %0, %4\n\tds_read_b64_tr_b16 %1, %4 offset:1088\n\tds_read_b64_tr_b16 %2, %4 offset:8704\n\tds_read_b64_tr_b16 %3, %4 offset:9792"
                 : "=&v"(ket[0][0]), "=&v"(ket[0][1]), "=&v"(ket[1][0]), "=&v"(ket[1][1]) : "v"(c.ke_tr) : "memory");
#define HG_VTR(e4, o0, o1, o2, o3) asm volatile("ds_read_b64_tr_b16 %0, %4 offset:" #o0 "\n\tds_read_b64_tr_b16 %1, %4 offset:" #o1 "\n\tds_read_b64_tr_b16 %2, %4 offset:" #o2 "\n\tds_read_b64_tr_b16 %3, %4 offset:" #o3 \
                 : "=&v"(vt[e4][0][0]), "=&v"(vt[e4][0][1]), "=&v"(vt[e4][1][0]), "=&v"(vt[e4][1][1]) : "v"(c.v_tr) : "memory")
    HG_VTR(0, 0, 576, 4608, 5184); HG_VTR(1, 32, 608, 4640, 5216); HG_VTR(2, 64, 640, 4672, 5248); HG_VTR(3, 96, 672, 4704, 5280);
#undef HG_VTR
    {
        const int ti = wave & 3;
#pragma unroll
        for (int sii = 0; sii < 2; ++sii) {
            const int si = tp * 2 + sii;
            v2u w = (v2u){0u, 0u};
            if (si <= ti) {
                f32x4 a = (f32x4){0.f, 0.f, 0.f, 0.f};
#pragma unroll
                for (int kk = 0; kk < 4; ++kk)
                    a = __builtin_amdgcn_mfma_f32_16x16x32_bf16(lds_frag(lds + HG_KK + (16 * si + lr) * HG_RSD + kk * 64 + lq * 16), lds_frag(lds + HG_QI + (16 * ti + lr) * HG_RSD + kk * 64 + lq * 16), a, 0, 0, 0);
                const int s0 = 16 * si + 4 * lq, t = 16 * ti + lr;
                w.x = pk2(s0 + 0 <= t ? a[0] : 0.f, s0 + 1 <= t ? a[1] : 0.f); w.y = pk2(s0 + 2 <= t ? a[2] : 0.f, s0 + 3 <= t ? a[3] : 0.f);
            }
            *(LAS v2u*)(lds + HG_AM + (16 * ti + lr) * HG_RSS + (16 * si + 4 * lq) * 2) = w;
        }
    }
    f32x4 o[2];
#pragma unroll
    for (int tt = 0; tt < 2; ++tt) {
        o[tt] = (f32x4){0.f, 0.f, 0.f, 0.f};
#pragma unroll
        for (int kk = 0; kk < 4; ++kk)
            o[tt] = __builtin_amdgcn_mfma_f32_16x16x32_bf16(lds_frag(lds + HG_ST + (16 * ei + lr) * HG_RSD + kk * 64 + lq * 16), lds_frag(lds + HG_QI + (16 * (2 * tp + tt) + lr) * HG_RSD + kk * 64 + lq * 16), o[tt], 0, 0, 0);
    }
    HG_PSTAMP(lds, n, 667);
    asm volatile("s_waitcnt lgkmcnt(0)"
                 : "+v"(ket[0][0]), "+v"(ket[0][1]), "+v"(ket[1][0]), "+v"(ket[1][1]),
                   "+v"(vt[0][0][0]), "+v"(vt[0][0][1]), "+v"(vt[0][1][0]), "+v"(vt[0][1][1]), "+v"(vt[1][0][0]), "+v"(vt[1][0][1]), "+v"(vt[1][1][0]), "+v"(vt[1][1][1]),
                   "+v"(vt[2][0][0]), "+v"(vt[2][0][1]), "+v"(vt[2][1][0]), "+v"(vt[2][1][1]), "+v"(vt[3][0][0]), "+v"(vt[3][0][1]), "+v"(vt[3][1][0]), "+v"(vt[3][1][1]) :: "memory");
    {
        const f32x4 dv = *(const LAS f32x4*)(lds + HG_DEC + (16 * wave + 4 * lq) * 4);
#pragma unroll
        for (int e4 = 0; e4 < 4; ++e4) S[e4] = S[e4] * dv;
#pragma unroll
        for (int kk = 0; kk < 2; ++kk) {
            const pg8::bf16x8 af = mk_frag(ket[kk][0], ket[kk][1]);
#pragma unroll
            for (int e4 = 0; e4 < 4; ++e4) S[e4] = __builtin_amdgcn_mfma_f32_16x16x32_bf16(af, mk_frag(vt[e4][kk][0], vt[e4][kk][1]), S[e4], 0, 0, 0);
        }
    }
    HG_PSTAMP(lds, n, 668);
    const pg8::bf16x8 vf0 = ei == 0 ? mk_frag(vt[0][0][0], vt[0][0][1]) : ei == 1 ? mk_frag(vt[1][0][0], vt[1][0][1]) : ei == 2 ? mk_frag(vt[2][0][0], vt[2][0][1]) : mk_frag(vt[3][0][0], vt[3][0][1]);
    const pg8::bf16x8 vf1 = ei == 0 ? mk_frag(vt[0][1][0], vt[0][1][1]) : ei == 1 ? mk_frag(vt[1][1][0], vt[1][1][1]) : ei == 2 ? mk_frag(vt[2][1][0], vt[2][1][1]) : mk_frag(vt[3][1][0], vt[3][1][1]);
    __syncthreads();
    HG_PSTAMP(lds, n, 664);
#pragma unroll
    for (int tt = 0; tt < 2; ++tt) {
        o[tt] = __builtin_amdgcn_mfma_f32_16x16x32_bf16(vf0, lds_frag(lds + HG_AM + (16 * (2 * tp + tt) + lr) * HG_RSS + 0 * 64 + lq * 16), o[tt], 0, 0, 0);
        o[tt] = __builtin_amdgcn_mfma_f32_16x16x32_bf16(vf1, lds_frag(lds + HG_AM + (16 * (2 * tp + tt) + lr) * HG_RSS + 1 * 64 + lq * 16), o[tt], 0, 0, 0);
        const int t = 16 * (2 * tp + tt) + lr;
        { v2u ow; ow.x = pk2(o[tt][0], o[tt][1]); ow.y = pk2(o[tt][2], o[tt][3]);
          *(v2u*)((bf16*)c.Op + (size_t)(dir ? tb + 63 - t : tb + t) * 512 + c.h * 128 + c.vh * 64 + 16 * ei + 4 * lq) = ow; }
    }
#pragma unroll
    for (int e4 = 0; e4 < 4; ++e4) { v2u w; w.x = pk2(S[e4][0], S[e4][1]); w.y = pk2(S[e4][2], S[e4][3]); *(LAS v2u*)(lds + HG_ST + (16 * e4 + lr) * HG_RSD + (16 * wave + 4 * lq) * 2) = w; }
    HG_PSTAMP(lds, n, 665);
}
__device__ __forceinline__ void hgrn_unit(LAS unsigned char* lds, int unit, const bf16* Qb, const bf16* KFb, const bf16* KBb, const bf16* Vb, const float* LFb, const float* LBb,
                                          float* OFb, float* OBb, int tid, int lane, int wave) {
    HgCtx c;
    c.lds = lds; c.vh = unit & 1; c.dir = (unit >> 1) & 1; c.h = (unit >> 2) & 3; c.b = unit >> 4;
    c.Qb = Qb; c.Vb = Vb; c.Kp = c.dir ? KBb : KFb; c.Lp = c.dir ? LBb : LFb; c.Op = c.dir ? OBb : OFb;
    c.lane = lane; c.wave = wave; c.lr = lane & 15; c.lq = lane >> 4;
    c.dA = tid & 127; c.seg = tid >> 7;
    c.tauB = tid >> 3; c.dg = tid & 7;
    for (int i = tid; i < 64 * HG_RSD / 16; i += NTHR) *(LAS v4u*)(lds + HG_ST + i * 16) = (v4u){0u, 0u, 0u, 0u};
    f32x4 S[4];
#pragma unroll
    for (int i = 0; i < 4; ++i) S[i] = (f32x4){0.f, 0.f, 0.f, 0.f};
#pragma unroll
    for (int i = 0; i < 16; ++i) { const int tau = 16 * c.seg + i; c.offA[i] = (unsigned)((c.dir ? 63 - tau : tau) * 512 + c.dA); }
    c.offB = (unsigned)((c.dir ? 63 - c.tauB : c.tauB) * 512 + 16 * c.dg); c.offV = (unsigned)((c.dir ? 63 - c.tauB : c.tauB) * 512 + c.vh * 64 + 8 * c.dg);
    const unsigned trrow = (unsigned)(8 * c.lq + ((lane & 15) >> 2)), trcol = (unsigned)(4 * (lane & 3));
    c.ke_tr = (unsigned)(size_t)(lds + HG_KE) + trrow * HG_RSD + (16 * wave + trcol) * 2;
    c.v_tr = (unsigned)(size_t)(lds + HG_V) + trrow * HG_RSS + trcol * 2;
    float lf0[16], lf1[16]; v4u qB0[2], kB0[2], vB0, qB1[2], kB1[2], vB1;
    hgrn_load(c, 0, lf0, qB0, kB0, vB0); hgrn_load(c, 1, lf1, qB1, kB1, vB1);
#pragma unroll 1
    for (int n = 0; n < TT / 64; n += 2) { hgrn_chunk(c, n, lf0, qB0, kB0, vB0, S); hgrn_chunk(c, n + 1, lf1, qB1, kB1, vB1, S); }
    __syncthreads();
}

__device__ __forceinline__ void router_finish(float (&a)[NE], int m, int lane, const float* router_b, LAS int* lcnt, LAS unsigned* sbw, float* GATE) {
#define RF_STEP(s2, n) { const bool up = (lane & (s2)) != 0; _Pragma("unroll") for (int i = 0; i < (n); ++i) { const float k1 = up ? a[i + (n)] : a[i], x1 = up ? a[i] : a[i + (n)]; a[i] = k1 + __shfl_xor(x1, (s2)); } }
    RF_STEP(32, 16) RF_STEP(16, 8) RF_STEP(8, 4) RF_STEP(4, 2) RF_STEP(2, 1)
#undef RF_STEP
    float lg = a[0] + __shfl_xor(a[0], 1);
    const int myE = lane >> 1;
    lg += router_b[myE];
    float tv[TOPK]; int ti[TOPK];
#pragma unroll
    for (int k = 0; k < TOPK; ++k) {
        float mx = lg;
#pragma unroll
        for (int o = 1; o < 64; o <<= 1) mx = fmaxf(mx, __shfl_xor(mx, o));
        int cand = (lg == mx) ? myE : 99;
#pragma unroll
        for (int o = 1; o < 64; o <<= 1) cand = min(cand, __shfl_xor(cand, o));
        tv[k] = mx; ti[k] = cand;
        if (myE == cand) lg = -INFINITY;
    }
    const float e1 = __expf(tv[1] - tv[0]), e2 = __expf(tv[2] - tv[0]), e3 = __expf(tv[3] - tv[0]);
    const float inv = 1.0f / (1.0f + e1 + e2 + e3);
    if (lane < TOPK && m < MTOK) {
        const int ek = lane == 0 ? ti[0] : lane == 1 ? ti[1] : lane == 2 ? ti[2] : ti[3];
        const float gk = (lane == 0 ? 1.0f : lane == 1 ? e1 : lane == 2 ? e2 : e3) * inv;
        const int lr = __hip_atomic_fetch_add(&lcnt[ek], 1, __ATOMIC_RELAXED, __HIP_MEMORY_SCOPE_WORKGROUP);
        sbw[lane] = ((unsigned)ek << 16) | (unsigned)lr;
        GATE[(size_t)m * TOPK + lane] = gk;
    }
}

#ifndef PROBE_DELAY
#define PROBE_DELAY 0
#endif
__device__ __forceinline__ void probe_delay(int us100) { const unsigned long long t0 = __builtin_amdgcn_s_memrealtime(); while (__builtin_amdgcn_s_memrealtime() - t0 < (unsigned long long)us100) __builtin_amdgcn_s_sleep(2); }
constexpr int H3_QI = 0, H3_KK = 34816, H3_V = 69632, H3_DEC = 88064, H3_ST = 89088, H3_AM = 106496, H3_LH = 115712, H3_LL = 133120, H3_END = 150528;
constexpr int H3_BUFD = 17408, H3_BUFV = 9216, H3_BUFDEC = 512;
static_assert(H3_END <= LDSCTL_OFF, "recurrence LDS image below the control words");
struct Hg3 {
    LAS unsigned char* lds; const bf16 *Qb, *Kp, *Vb; const float* Lp; float* Op;
    int b, h, dir, vh, lane, lr, lq;
};
__device__ __forceinline__ size_t hg3_row(const Hg3& c, int n, int t) {
    const int tb = c.b * TT + (c.dir ? (TT / 64 - 1 - n) * 64 : n * 64);
    return (size_t)(c.dir ? tb + 63 - t : tb + t) * 512 + c.h * 128;
}
struct Hg3LV { f32x4 lf[8]; v4u v[2]; };
struct Hg3QK { v2u q[2][4], k[2][4]; };
__device__ __forceinline__ void gld16(f32x4& d, const void* p) { asm volatile("global_load_dwordx4 %0, %1, off" : "=v"(d) : "v"(p) : "memory"); }
__device__ __forceinline__ void gld16u(v4u& d, const void* p) { asm volatile("global_load_dwordx4 %0, %1, off" : "=v"(d) : "v"(p) : "memory"); }
__device__ __forceinline__ void gld8(v2u& d, const void* p) { asm volatile("global_load_dwordx2 %0, %1, off" : "=v"(d) : "v"(p) : "memory"); }
__device__ __forceinline__ void hg3_load_lv(const Hg3& c, int n, int pt, Hg3LV& in) {
    const size_t r = hg3_row(c, n, pt >> 2);
#pragma unroll
    for (int i = 0; i < 8; ++i) gld16(in.lf[i], c.Lp + r + 32 * (pt & 3) + 4 * i);
    gld16u(in.v[0], c.Vb + r + c.vh * 64 + 16 * (pt & 3)); gld16u(in.v[1], c.Vb + r + c.vh * 64 + 16 * (pt & 3) + 8);
}
__device__ __forceinline__ void hg3_load_qk(const Hg3& c, int n, int pw, Hg3QK& in) {
#pragma unroll
    for (int ti = 0; ti < 4; ++ti) { const size_t r = hg3_row(c, n, 16 * ti + c.lr);
#pragma unroll
        for (int dt = 0; dt < 2; ++dt) { const int d0 = 16 * (2 * pw + dt) + 4 * c.lq; gld8(in.q[dt][ti], c.Qb + r + d0); gld8(in.k[dt][ti], c.Kp + r + d0); } }
}
#define H3_USE_LV(x) asm volatile("" : "+v"((x).lf[0]), "+v"((x).lf[1]), "+v"((x).lf[2]), "+v"((x).lf[3]), "+v"((x).lf[4]), "+v"((x).lf[5]), "+v"((x).lf[6]), "+v"((x).lf[7]), "+v"((x).v[0]), "+v"((x).v[1]))
#define H3_USE_QK(x) asm volatile("" : "+v"((x).q[0][0]), "+v"((x).q[0][1]), "+v"((x).q[0][2]), "+v"((x).q[0][3]), "+v"((x).q[1][0]), "+v"((x).q[1][1]), "+v"((x).q[1][2]), "+v"((x).q[1][3]), \
                                           "+v"((x).k[0][0]), "+v"((x).k[0][1]), "+v"((x).k[0][2]), "+v"((x).k[0][3]), "+v"((x).k[1][0]), "+v"((x).k[1][1]), "+v"((x).k[1][2]), "+v"((x).k[1][3]))
__device__ __forceinline__ unsigned hg3_hi_lo(float x, float y, unsigned& lo) {
    const unsigned hi = pk2(x, y);
    lo = pk2(x - bf2f(hi & 0xffffu), y - bf2f(hi >> 16));
    return hi;
}
__device__ __forceinline__ void hg3_prep_a(const Hg3& c, int buf, int pt, const Hg3LV& in) {
    const int t = pt >> 2, dq = pt & 3;
#pragma unroll
    for (int i = 0; i < 8; ++i) { unsigned l0, l1; const unsigned h0 = hg3_hi_lo(in.lf[i].x, in.lf[i].y, l0), h1 = hg3_hi_lo(in.lf[i].z, in.lf[i].w, l1);
        *(LAS v2u*)(c.lds + H3_LH + t * 272 + (32 * dq + 4 * i) * 2) = (v2u){h0, h1}; *(LAS v2u*)(c.lds + H3_LL + t * 272 + (32 * dq + 4 * i) * 2) = (v2u){l0, l1}; }
    *(LAS v4u*)(c.lds + H3_V + buf * H3_BUFV + t * 144 + dq * 32) = in.v[0]; *(LAS v4u*)(c.lds + H3_V + buf * H3_BUFV + t * 144 + dq * 32 + 16) = in.v[1];
}
__device__ __forceinline__ void hg3_prep_b(const Hg3& c, int buf, int pw, const Hg3QK& in, const pg8::bf16x8 (&U)[4]) {
    LAS unsigned char* lds = c.lds; const int lr = c.lr, lq = c.lq, lane = c.lane;
    const unsigned trrow = (unsigned)(8 * lq + ((lane & 15) >> 2)), trcol = (unsigned)(4 * (lane & 3));
    const pg8::bf16x8 ones = (pg8::bf16x8)(v4u){0x3F803F80u, 0x3F803F80u, 0x3F803F80u, 0x3F803F80u};
#pragma unroll
    for (int dt = 0; dt < 2; ++dt) {
        const int dtile = 2 * pw + dt;
        v2u fh[2][2], fl[2][2];
        const unsigned ah = (unsigned)(size_t)(lds + H3_LH) + trrow * 272 + (16 * dtile + trcol) * 2, al = ah + (H3_LL - H3_LH);
        asm volatile("ds_read_b64_tr_b16 %0, %8\n\tds_read_b64_tr_b16 %1, %8 offset:1088\n\tds_read_b64_tr_b16 %2, %8 offset:8704\n\tds_read_b64_tr_b16 %3, %8 offset:9792\n\t"
                     "ds_read_b64_tr_b16 %4, %9\n\tds_read_b64_tr_b16 %5, %9 offset:1088\n\tds_read_b64_tr_b16 %6, %9 offset:8704\n\tds_read_b64_tr_b16 %7, %9 offset:9792\n\ts_waitcnt lgkmcnt(0)"
                     : "=&v"(fh[0][0]), "=&v"(fh[0][1]), "=&v"(fh[1][0]), "=&v"(fh[1][1]), "=&v"(fl[0][0]), "=&v"(fl[0][1]), "=&v"(fl[1][0]), "=&v"(fl[1][1]) : "v"(ah), "v"(al) : "memory");
        const pg8::bf16x8 H0 = mk_frag(fh[0][0], fh[0][1]), H1 = mk_frag(fh[1][0], fh[1][1]), L0 = mk_frag(fl[0][0], fl[0][1]), L1 = mk_frag(fl[1][0], fl[1][1]);
        f32x4 bt[4];
        const f32x4 z = (f32x4){0.f, 0.f, 0.f, 0.f};
        bt[0] = __builtin_amdgcn_mfma_f32_16x16x32_bf16(L0, U[0], z, 0, 0, 0);    bt[0] = __builtin_amdgcn_mfma_f32_16x16x32_bf16(H0, U[0], bt[0], 0, 0, 0);
        bt[1] = __builtin_amdgcn_mfma_f32_16x16x32_bf16(L0, U[1], z, 0, 0, 0);    bt[1] = __builtin_amdgcn_mfma_f32_16x16x32_bf16(H0, U[1], bt[1], 0, 0, 0);
        bt[2] = __builtin_amdgcn_mfma_f32_16x16x32_bf16(L0, ones, z, 0, 0, 0);    bt[2] = __builtin_amdgcn_mfma_f32_16x16x32_bf16(L1, U[2], bt[2], 0, 0, 0);
        bt[2] = __builtin_amdgcn_mfma_f32_16x16x32_bf16(H0, ones, bt[2], 0, 0, 0); bt[2] = __builtin_amdgcn_mfma_f32_16x16x32_bf16(H1, U[2], bt[2], 0, 0, 0);
        bt[3] = __builtin_amdgcn_mfma_f32_16x16x32_bf16(L0, ones, z, 0, 0, 0);    bt[3] = __builtin_amdgcn_mfma_f32_16x16x32_bf16(L1, U[3], bt[3], 0, 0, 0);
        bt[3] = __builtin_amdgcn_mfma_f32_16x16x32_bf16(H0, ones, bt[3], 0, 0, 0); bt[3] = __builtin_amdgcn_mfma_f32_16x16x32_bf16(H1, U[3], bt[3], 0, 0, 0);
        f32x4 de;
#pragma unroll
        for (int r = 0; r < 4; ++r) de[r] = __expf(__shfl(bt[3][r], 16 * lq + 15));
        if (lr == 0) *(LAS f32x4*)(lds + H3_DEC + buf * H3_BUFDEC + (16 * dtile + 4 * lq) * 4) = de;
#pragma unroll
        for (int ti = 0; ti < 4; ++ti) {
            const v2u qq = in.q[dt][ti], kk = in.k[dt][ti];
            const float e0 = __expf(bt[ti][0]), e1 = __expf(bt[ti][1]), e2 = __expf(bt[ti][2]), e3 = __expf(bt[ti][3]);
            v2u qo, ko;
            qo.x = pk2(bf2f(qq.x & 0xffffu) * e0, bf2f(qq.x >> 16) * e1); qo.y = pk2(bf2f(qq.y & 0xffffu) * e2, bf2f(qq.y >> 16) * e3);
            ko.x = pk2(bf2f(kk.x & 0xffffu) * __builtin_amdgcn_rcpf(e0), bf2f(kk.x >> 16) * __builtin_amdgcn_rcpf(e1));
            ko.y = pk2(bf2f(kk.y & 0xffffu) * __builtin_amdgcn_rcpf(e2), bf2f(kk.y >> 16) * __builtin_amdgcn_rcpf(e3));
            const int off = (16 * ti + lr) * 272 + (16 * dtile + 4 * lq) * 2;
            *(LAS v2u*)(lds + H3_QI + buf * H3_BUFD + off) = qo; *(LAS v2u*)(lds + H3_KK + buf * H3_BUFD + off) = ko;
        }
    }
}
__device__ __forceinline__ void hg3_stage1(const Hg3& c, int buf, int mw, f32x4 (&S)[2][4], f32x4 (&o)[2][2], v2u (&vt)[4][2][2]) {
    LAS unsigned char* lds = c.lds; const int lr = c.lr, lq = c.lq, lane = c.lane;
    const LAS unsigned char* QI = lds + H3_QI + buf * H3_BUFD; const LAS unsigned char* KK = lds + H3_KK + buf * H3_BUFD;
    const unsigned trrow = (unsigned)(8 * lq + ((lane & 15) >> 2)), trcol = (unsigned)(4 * (lane & 3));
    const unsigned kk_tr = (unsigned)(size_t)KK + trrow * 272 + (32 * mw + trcol) * 2;
    const unsigned v_tr = (unsigned)(size_t)(lds + H3_V + buf * H3_BUFV) + trrow * 144 + trcol * 2;
    const int tp = mw >> 1, ep = mw & 1;
    pg8::bf16x8 qf[2][4], sf[2][4], kf[3][4];
#pragma unroll
    for (int bq = 0; bq < 2; ++bq)
#pragma unroll
        for (int kk = 0; kk < 4; ++kk) { qf[bq][kk] = lds_frag(QI + (16 * (2 * tp + bq) + lr) * 272 + kk * 64 + lq * 16); sf[bq][kk] = lds_frag(lds + H3_ST + (16 * (2 * ep + bq) + lr) * 272 + kk * 64 + lq * 16); }
#pragma unroll
    for (int a = 0; a < 2; ++a)
#pragma unroll
        for (int bq = 0; bq < 2; ++bq) o[a][bq] = (f32x4){0.f, 0.f, 0.f, 0.f};
#pragma unroll
    for (int kk = 0; kk < 4; ++kk) {
        o[0][0] = __builtin_amdgcn_mfma_f32_16x16x32_bf16(sf[0][kk], qf[0][kk], o[0][0], 0, 0, 0); o[0][1] = __builtin_amdgcn_mfma_f32_16x16x32_bf16(sf[0][kk], qf[1][kk], o[0][1], 0, 0, 0);
        o[1][0] = __builtin_amdgcn_mfma_f32_16x16x32_bf16(sf[1][kk], qf[0][kk], o[1][0], 0, 0, 0); o[1][1] = __builtin_amdgcn_mfma_f32_16x16x32_bf16(sf[1][kk], qf[1][kk], o[1][1], 0, 0, 0);
    }
    __builtin_amdgcn_sched_barrier(0);
    const int ks0 = mw == 3 ? 1 : 0;
    if (mw != 1) {
#pragma unroll
        for (int x = 0; x < 3; ++x)
#pragma unroll
            for (int kk = 0; kk < 4; ++kk) kf[x][kk] = lds_frag(KK + (16 * (ks0 + x) + lr) * 272 + kk * 64 + lq * 16);
    }
    v2u kt[2][2][2];
    {
        f32x4 at[4];
#pragma unroll
        for (int i = 0; i < 4; ++i) at[i] = (f32x4){0.f, 0.f, 0.f, 0.f};
        if (mw != 1) {
#pragma unroll
            for (int kk = 0; kk < 4; ++kk) {
                at[0] = __builtin_amdgcn_mfma_f32_16x16x32_bf16(kf[0][kk], mw == 3 ? qf[1][kk] : qf[0][kk], at[0], 0, 0, 0);
                at[1] = __builtin_amdgcn_mfma_f32_16x16x32_bf16(mw == 0 ? kf[0][kk] : kf[1][kk], mw == 2 ? qf[0][kk] : qf[1][kk], at[1], 0, 0, 0);
                at[2] = __builtin_amdgcn_mfma_f32_16x16x32_bf16(mw == 0 ? kf[1][kk] : kf[2][kk], mw == 2 ? qf[0][kk] : qf[1][kk], at[2], 0, 0, 0);
                if (mw == 2) at[3] = __builtin_amdgcn_mfma_f32_16x16x32_bf16(kf[0][kk], qf[1][kk], at[3], 0, 0, 0);
            }
        }
    asm volatile("ds_read_b64_tr_b16 %0, %8\n\tds_read_b64_tr_b16 %1, %8 offset:1088\n\tds_read_b64_tr_b16 %2, %8 offset:8704\n\tds_read_b64_tr_b16 %3, %8 offset:9792\n\t"
                 "ds_read_b64_tr_b16 %4, %8 offset:32\n\tds_read_b64_tr_b16 %5, %8 offset:1120\n\tds_read_b64_tr_b16 %6, %8 offset:8736\n\tds_read_b64_tr_b16 %7, %8 offset:9824"
                 : "=&v"(kt[0][0][0]), "=&v"(kt[0][0][1]), "=&v"(kt[0][1][0]), "=&v"(kt[0][1][1]), "=&v"(kt[1][0][0]), "=&v"(kt[1][0][1]), "=&v"(kt[1][1][0]), "=&v"(kt[1][1][1]) : "v"(kk_tr) : "memory");
#define H3_VTR(e4, o0, o1, o2, o3) asm volatile("ds_read_b64_tr_b16 %0, %4 offset:" #o0 "\n\tds_read_b64_tr_b16 %1, %4 offset:" #o1 "\n\tds_read_b64_tr_b16 %2, %4 offset:" #o2 "\n\tds_read_b64_tr_b16 %3, %4 offset:" #o3 \
                 : "=&v"(vt[e4][0][0]), "=&v"(vt[e4][0][1]), "=&v"(vt[e4][1][0]), "=&v"(vt[e4][1][1]) : "v"(v_tr) : "memory")
    H3_VTR(0, 0, 576, 4608, 5184); H3_VTR(1, 32, 608, 4640, 5216); H3_VTR(2, 64, 640, 4672, 5248); H3_VTR(3, 96, 672, 4704, 5280);
#undef H3_VTR
#pragma unroll
        for (int i = 0; i < 4; ++i) {
            int si, ti; bool have = true, zero = false;
            if (mw == 0) { si = i == 2 ? 1 : 0; ti = i == 0 ? 0 : 1; have = i < 3; }
            else if (mw == 1) { si = 1; ti = 0; have = i == 0; zero = true; }
            else if (mw == 2) { si = i == 3 ? 0 : i; ti = i == 3 ? 3 : 2; }
            else { si = i == 3 ? 3 : i + 1; ti = i == 3 ? 2 : 3; zero = i == 3; }
            if (have) {
                const int s0 = 16 * si + 4 * lq, t = 16 * ti + lr; v2u w = (v2u){0u, 0u};
                if (!zero) { w.x = pk2(s0 + 0 <= t ? at[i][0] : 0.f, s0 + 1 <= t ? at[i][1] : 0.f); w.y = pk2(s0 + 2 <= t ? at[i][2] : 0.f, s0 + 3 <= t ? at[i][3] : 0.f); }
                *(LAS v2u*)(lds + H3_AM + (16 * ti + lr) * 144 + (16 * si + 4 * lq) * 2) = w;
            }
        }
    }
    asm volatile("s_waitcnt lgkmcnt(0)"
                 : "+v"(kt[0][0][0]), "+v"(kt[0][0][1]), "+v"(kt[0][1][0]), "+v"(kt[0][1][1]), "+v"(kt[1][0][0]), "+v"(kt[1][0][1]), "+v"(kt[1][1][0]), "+v"(kt[1][1][1]),
                   "+v"(vt[0][0][0]), "+v"(vt[0][0][1]), "+v"(vt[0][1][0]), "+v"(vt[0][1][1]), "+v"(vt[1][0][0]), "+v"(vt[1][0][1]), "+v"(vt[1][1][0]), "+v"(vt[1][1][1]),
                   "+v"(vt[2][0][0]), "+v"(vt[2][0][1]), "+v"(vt[2][1][0]), "+v"(vt[2][1][1]), "+v"(vt[3][0][0]), "+v"(vt[3][0][1]), "+v"(vt[3][1][0]), "+v"(vt[3][1][1]) :: "memory");
#pragma unroll
    for (int dt = 0; dt < 2; ++dt) {
#pragma unroll
        for (int kk = 0; kk < 2; ++kk) {
            const pg8::bf16x8 af = mk_frag(kt[dt][kk][0], kt[dt][kk][1]);
#pragma unroll
            for (int e4 = 0; e4 < 4; ++e4) S[dt][e4] = __builtin_amdgcn_mfma_f32_16x16x32_bf16(af, mk_frag(vt[e4][kk][0], vt[e4][kk][1]), S[dt][e4], 0, 0, 0);
        }
        const f32x4 dv = *(const LAS f32x4*)(lds + H3_DEC + buf * H3_BUFDEC + (16 * (2 * mw + dt) + 4 * lq) * 4);
#pragma unroll
        for (int e4 = 0; e4 < 4; ++e4) S[dt][e4] = S[dt][e4] * dv;
    }
}
__device__ __forceinline__ void hg3_stage2(const Hg3& c, int n, int mw, const f32x4 (&S)[2][4], f32x4 (&o)[2][2], const v2u (&vt)[4][2][2]) {
    LAS unsigned char* lds = c.lds; const int lr = c.lr, lq = c.lq;
#pragma unroll
    for (int bq = 0; bq < 2; ++bq) {
        const int ti = 2 * (mw >> 1) + bq;
        const pg8::bf16x8 a0 = lds_frag(lds + H3_AM + (16 * ti + lr) * 144 + 0 * 64 + lq * 16);
#pragma unroll
        for (int a = 0; a < 2; ++a) { const int e4 = 2 * (mw & 1) + a;
            const pg8::bf16x8 vf = e4 == 0 ? mk_frag(vt[0][0][0], vt[0][0][1]) : e4 == 1 ? mk_frag(vt[1][0][0], vt[1][0][1]) : e4 == 2 ? mk_frag(vt[2][0][0], vt[2][0][1]) : mk_frag(vt[3][0][0], vt[3][0][1]);
            o[a][bq] = __builtin_amdgcn_mfma_f32_16x16x32_bf16(vf, a0, o[a][bq], 0, 0, 0); }
        if (mw >> 1) {
            const pg8::bf16x8 a1 = lds_frag(lds + H3_AM + (16 * ti + lr) * 144 + 1 * 64 + lq * 16);
#pragma unroll
            for (int a = 0; a < 2; ++a) { const int e4 = 2 * (mw & 1) + a;
                const pg8::bf16x8 vf = e4 == 0 ? mk_frag(vt[0][1][0], vt[0][1][1]) : e4 == 1 ? mk_frag(vt[1][1][0], vt[1][1][1]) : e4 == 2 ? mk_frag(vt[2][1][0], vt[2][1][1]) : mk_frag(vt[3][1][0], vt[3][1][1]);
                o[a][bq] = __builtin_amdgcn_mfma_f32_16x16x32_bf16(vf, a1, o[a][bq], 0, 0, 0); }
        }
#pragma unroll
        for (int a = 0; a < 2; ++a)
            *(f32x4*)(c.Op + hg3_row(c, n, 16 * ti + lr) + c.vh * 64 + 16 * (2 * (mw & 1) + a) + 4 * lq) = o[a][bq];
    }
#pragma unroll
    for (int dt = 0; dt < 2; ++dt)
#pragma unroll
        for (int e4 = 0; e4 < 4; ++e4) { v2u w; w.x = pk2(S[dt][e4][0], S[dt][e4][1]); w.y = pk2(S[dt][e4][2], S[dt][e4][3]);
            *(LAS v2u*)(lds + H3_ST + (16 * e4 + lr) * 272 + (16 * (2 * mw + dt) + 4 * lq) * 2) = w; }
}
__device__ __forceinline__ void hgrn3_unit(LAS unsigned char* lds, int unit, const bf16* Qb, const bf16* KFb, const bf16* KBb, const bf16* Vb, const float* LFb, const float* LBb,
                                           float* OFb, float* OBb, int tid, int lane, int wave) {
    Hg3 c;
    c.lds = lds; c.vh = unit & 1; c.dir = (unit >> 1) & 1; c.h = (unit >> 2) & 3; c.b = unit >> 4;
    c.Qb = Qb; c.Vb = Vb; c.Kp = c.dir ? KBb : KFb; c.Lp = c.dir ? LBb : LFb; c.Op = c.dir ? OBb : OFb;
    c.lane = lane; c.lr = lane & 15; c.lq = lane >> 4;
    constexpr int NCH = TT / 64;
    for (int i = tid; i < 64 * 272 / 16; i += NTHR) *(LAS v4u*)(lds + H3_ST + i * 16) = (v4u){0u, 0u, 0u, 0u};
    if (wave < 4) {
        const int pt = tid, pw = wave;
        pg8::bf16x8 U[4];
#pragma unroll
        for (int u = 0; u < 4; ++u) { const int kk = u >> 1, ti = u; unsigned wv[4];
#pragma unroll
            for (int j2 = 0; j2 < 4; ++j2) { const int s = 32 * kk + 8 * c.lq + 2 * j2, t = 16 * ti + c.lr; wv[j2] = (s <= t ? 0x3F80u : 0u) | (s + 1 <= t ? 0x3F800000u : 0u); }
            U[u] = (pg8::bf16x8)(v4u){wv[0], wv[1], wv[2], wv[3]}; }
        Hg3LV lv0, lv1; Hg3QK qk;
        hg3_load_lv(c, 0, pt, lv0); hg3_load_qk(c, 0, pw, qk); hg3_load_lv(c, 1, pt, lv1);
        asm volatile("s_waitcnt vmcnt(0)" ::: "memory"); H3_USE_LV(lv0); H3_USE_QK(qk); H3_USE_LV(lv1);
        hg3_prep_a(c, 0, pt, lv0);
        __syncthreads();
#define H3_TRIP(j_, LVN, LVC) do { \
            if ((j_) < NCH) { asm volatile("s_waitcnt vmcnt(10)" ::: "memory"); H3_USE_QK(qk); hg3_prep_b(c, (j_) & 1, pw, qk, U); \
                if ((j_) + 1 < NCH) hg3_load_qk(c, (j_) + 1, pw, qk); else hg3_load_qk(c, (j_), pw, qk);     \
                if ((j_) + 2 < NCH) hg3_load_lv(c, (j_) + 2, pt, LVC); else hg3_load_lv(c, (j_), pt, LVC); } \
            if (PROBE_DELAY == 2) probe_delay(100); \
            __syncthreads();                                                                    \
            if ((j_) + 1 < NCH) { asm volatile("s_waitcnt vmcnt(26)" ::: "memory"); H3_USE_LV(LVN); hg3_prep_a(c, ((j_) + 1) & 1, pt, LVN); } \
            __syncthreads();                                                                    \
        } while (0)
#pragma unroll 1
        for (int j = 0; j <= NCH; j += 2) { H3_TRIP(j, lv1, lv0); H3_TRIP(j + 1, lv0, lv1); }
#undef H3_TRIP
        asm volatile("s_waitcnt vmcnt(0)" ::: "memory");
    } else {
        const int mw = wave - 4;
        f32x4 S[2][4], o[2][2]; v2u vt[4][2][2];
#pragma unroll
        for (int a = 0; a < 2; ++a)
#pragma unroll
            for (int e4 = 0; e4 < 4; ++e4) S[a][e4] = (f32x4){0.f, 0.f, 0.f, 0.f};
        __syncthreads();
#pragma unroll 1
        for (int j = 0; j <= NCH + 1; ++j) {
            if (j > 0 && j <= NCH) hg3_stage1(c, (j - 1) & 1, mw, S, o, vt);
            if (PROBE_DELAY == 1) probe_delay(100);
            __syncthreads();
            if (j > 0 && j <= NCH) hg3_stage2(c, j - 1, mw, S, o, vt);
            __syncthreads();
        }
    }
    __syncthreads();
}


struct Hg4LV { f32x4 lf[4]; v4u v; };
struct Hg4QK { v2u q[4], k[4]; };
__device__ __forceinline__ void hg4_load_lv(const Hg3& c, int n, int tid, Hg4LV& in) {
    const size_t r = hg3_row(c, n, tid >> 3);
#pragma unroll
    for (int i = 0; i < 4; ++i) gld16(in.lf[i], c.Lp + r + 16 * (tid & 7) + 4 * i);
    gld16u(in.v, c.Vb + r + c.vh * 64 + 8 * (tid & 7));
}
__device__ __forceinline__ void hg4_load_qk(const Hg3& c, int n, int w, Hg4QK& in) {
#pragma unroll
    for (int ti = 0; ti < 4; ++ti) { const size_t r = hg3_row(c, n, 16 * ti + c.lr) + 16 * w + 4 * c.lq; gld8(in.q[ti], c.Qb + r); gld8(in.k[ti], c.Kp + r); }
}
#define H4_USE_LV(x) asm volatile("" : "+v"((x).lf[0]), "+v"((x).lf[1]), "+v"((x).lf[2]), "+v"((x).lf[3]), "+v"((x).v))
#define H4_USE_QK(x) asm volatile("" : "+v"((x).q[0]), "+v"((x).q[1]), "+v"((x).q[2]), "+v"((x).q[3]), "+v"((x).k[0]), "+v"((x).k[1]), "+v"((x).k[2]), "+v"((x).k[3]))
__device__ __forceinline__ void hg4_prep_a(const Hg3& c, int buf, int tid, const Hg4LV& in) {
    const int t = tid >> 3, dq = tid & 7;
#pragma unroll
    for (int i = 0; i < 4; ++i) { unsigned l0, l1; const unsigned h0 = hg3_hi_lo(in.lf[i].x, in.lf[i].y, l0), h1 = hg3_hi_lo(in.lf[i].z, in.lf[i].w, l1);
        *(LAS v2u*)(c.lds + H3_LH + t * 272 + (16 * dq + 4 * i) * 2) = (v2u){h0, h1}; *(LAS v2u*)(c.lds + H3_LL + t * 272 + (16 * dq + 4 * i) * 2) = (v2u){l0, l1}; }
    *(LAS v4u*)(c.lds + H3_V + buf * H3_BUFV + t * 144 + dq * 16) = in.v;
}
__device__ __forceinline__ void hg4_prep_b(const Hg3& c, int buf, int w, const Hg4QK& in, const pg8::bf16x8 (&U)[4]) {
    LAS unsigned char* lds = c.lds; const int lr = c.lr, lq = c.lq, lane = c.lane;
    const unsigned trrow = (unsigned)(8 * lq + ((lane & 15) >> 2)), trcol = (unsigned)(4 * (lane & 3));
    const pg8::bf16x8 ones = (pg8::bf16x8)(v4u){0x3F803F80u, 0x3F803F80u, 0x3F803F80u, 0x3F803F80u};
    v2u fh[2][2], fl[2][2];
    const unsigned ah = (unsigned)(size_t)(lds + H3_LH) + trrow * 272 + (16 * w + trcol) * 2, al = ah + (H3_LL - H3_LH);
    asm volatile("ds_read_b64_tr_b16 %0, %8\n\tds_read_b64_tr_b16 %1, %8 offset:1088\n\tds_read_b64_tr_b16 %2, %8 offset:8704\n\tds_read_b64_tr_b16 %3, %8 offset:9792\n\t"
                 "ds_read_b64_tr_b16 %4, %9\n\tds_read_b64_tr_b16 %5, %9 offset:1088\n\tds_read_b64_tr_b16 %6, %9 offset:8704\n\tds_read_b64_tr_b16 %7, %9 offset:9792\n\ts_waitcnt lgkmcnt(0)"
                 : "=&v"(fh[0][0]), "=&v"(fh[0][1]), "=&v"(fh[1][0]), "=&v"(fh[1][1]), "=&v"(fl[0][0]), "=&v"(fl[0][1]), "=&v"(fl[1][0]), "=&v"(fl[1][1]) : "v"(ah), "v"(al) : "memory");
    const pg8::bf16x8 H0 = mk_frag(fh[0][0], fh[0][1]), H1 = mk_frag(fh[1][0], fh[1][1]), L0 = mk_frag(fl[0][0], fl[0][1]), L1 = mk_frag(fl[1][0], fl[1][1]);
    f32x4 bt[4];
    const f32x4 z = (f32x4){0.f, 0.f, 0.f, 0.f};
    bt[0] = __builtin_amdgcn_mfma_f32_16x16x32_bf16(L0, U[0], z, 0, 0, 0);    bt[0] = __builtin_amdgcn_mfma_f32_16x16x32_bf16(H0, U[0], bt[0], 0, 0, 0);
    bt[1] = __builtin_amdgcn_mfma_f32_16x16x32_bf16(L0, U[1], z, 0, 0, 0);    bt[1] = __builtin_amdgcn_mfma_f32_16x16x32_bf16(H0, U[1], bt[1], 0, 0, 0);
    bt[2] = __builtin_amdgcn_mfma_f32_16x16x32_bf16(L0, ones, z, 0, 0, 0);    bt[2] = __builtin_amdgcn_mfma_f32_16x16x32_bf16(L1, U[2], bt[2], 0, 0, 0);
    bt[2] = __builtin_amdgcn_mfma_f32_16x16x32_bf16(H0, ones, bt[2], 0, 0, 0); bt[2] = __builtin_amdgcn_mfma_f32_16x16x32_bf16(H1, U[2], bt[2], 0, 0, 0);
    bt[3] = __builtin_amdgcn_mfma_f32_16x16x32_bf16(L0, ones, z, 0, 0, 0);    bt[3] = __builtin_amdgcn_mfma_f32_16x16x32_bf16(L1, U[3], bt[3], 0, 0, 0);
    bt[3] = __builtin_amdgcn_mfma_f32_16x16x32_bf16(H0, ones, bt[3], 0, 0, 0); bt[3] = __builtin_amdgcn_mfma_f32_16x16x32_bf16(H1, U[3], bt[3], 0, 0, 0);
    f32x4 de;
#pragma unroll
    for (int r = 0; r < 4; ++r) de[r] = __expf(__shfl(bt[3][r], 16 * lq + 15));
    if (lr == 0) *(LAS f32x4*)(lds + H3_DEC + buf * H3_BUFDEC + (16 * w + 4 * lq) * 4) = de;
#pragma unroll
    for (int ti = 0; ti < 4; ++ti) {
        const v2u qq = in.q[ti], kk = in.k[ti];
        const float e0 = __expf(bt[ti][0]), e1 = __expf(bt[ti][1]), e2 = __expf(bt[ti][2]), e3 = __expf(bt[ti][3]);
        v2u qo, ko;
        qo.x = pk2(bf2f(qq.x & 0xffffu) * e0, bf2f(qq.x >> 16) * e1); qo.y = pk2(bf2f(qq.y & 0xffffu) * e2, bf2f(qq.y >> 16) * e3);
        ko.x = pk2(bf2f(kk.x & 0xffffu) * __builtin_amdgcn_rcpf(e0), bf2f(kk.x >> 16) * __builtin_amdgcn_rcpf(e1));
        ko.y = pk2(bf2f(kk.y & 0xffffu) * __builtin_amdgcn_rcpf(e2), bf2f(kk.y >> 16) * __builtin_amdgcn_rcpf(e3));
        const int off = (16 * ti + lr) * 272 + (16 * w + 4 * lq) * 2;
        *(LAS v2u*)(lds + H3_QI + buf * H3_BUFD + off) = qo; *(LAS v2u*)(lds + H3_KK + buf * H3_BUFD + off) = ko;
    }
}
__device__ __forceinline__ void hg4_stage1(const Hg3& c, int buf, int w, f32x4 (&S)[4], f32x4 (&o)[2], v2u (&vt)[4][2][2]) {
    LAS unsigned char* lds = c.lds; const int lr = c.lr, lq = c.lq, lane = c.lane;
    const LAS unsigned char* QI = lds + H3_QI + buf * H3_BUFD; const LAS unsigned char* KK = lds + H3_KK + buf * H3_BUFD;
    const unsigned trrow = (unsigned)(8 * lq + ((lane & 15) >> 2)), trcol = (unsigned)(4 * (lane & 3));
    const unsigned kk_tr = (unsigned)(size_t)KK + trrow * 272 + (16 * w + trcol) * 2;
    const unsigned v_tr = (unsigned)(size_t)(lds + H3_V + buf * H3_BUFV) + trrow * 144 + trcol * 2;
    v2u kt[2][2];
    asm volatile("ds_read_b64_tr_b16 %0, %4\n\tds_read_b64_tr_b16 %1, %4 offset:1088\n\tds_read_b64_tr_b16 %2, %4 offset:8704\n\tds_read_b64_tr_b16 %3, %4 offset:9792"
                 : "=&v"(kt[0][0]), "=&v"(kt[0][1]), "=&v"(kt[1][0]), "=&v"(kt[1][1]) : "v"(kk_tr) : "memory");
#define H4_VTR(e4, o0, o1, o2, o3) asm volatile("ds_read_b64_tr_b16 %0, %4 offset:" #o0 "\n\tds_read_b64_tr_b16 %1, %4 offset:" #o1 "\n\tds_read_b64_tr_b16 %2, %4 offset:" #o2 "\n\tds_read_b64_tr_b16 %3, %4 offset:" #o3 \
                 : "=&v"(vt[e4][0][0]), "=&v"(vt[e4][0][1]), "=&v"(vt[e4][1][0]), "=&v"(vt[e4][1][1]) : "v"(v_tr) : "memory")
    H4_VTR(0, 0, 576, 4608, 5184); H4_VTR(1, 32, 608, 4640, 5216); H4_VTR(2, 64, 640, 4672, 5248); H4_VTR(3, 96, 672, 4704, 5280);
#undef H4_VTR
    const int ei = w & 3, tp = w >> 2;
    {
        const int ti = w & 3;
#pragma unroll
        for (int sii = 0; sii < 2; ++sii) {
            const int si = tp * 2 + sii;
            v2u wv = (v2u){0u, 0u};
            if (si <= ti) {
                f32x4 a = (f32x4){0.f, 0.f, 0.f, 0.f};
#pragma unroll
                for (int kk = 0; kk < 4; ++kk)
                    a = __builtin_amdgcn_mfma_f32_16x16x32_bf16(lds_frag(KK + (16 * si + lr) * 272 + kk * 64 + lq * 16), lds_frag(QI + (16 * ti + lr) * 272 + kk * 64 + lq * 16), a, 0, 0, 0);
                const int s0 = 16 * si + 4 * lq, t = 16 * ti + lr;
                wv.x = pk2(s0 + 0 <= t ? a[0] : 0.f, s0 + 1 <= t ? a[1] : 0.f); wv.y = pk2(s0 + 2 <= t ? a[2] : 0.f, s0 + 3 <= t ? a[3] : 0.f);
            }
            *(LAS v2u*)(lds + H3_AM + (16 * ti + lr) * 144 + (16 * si + 4 * lq) * 2) = wv;
        }
    }
#pragma unroll
    for (int tt = 0; tt < 2; ++tt) o[tt] = (f32x4){0.f, 0.f, 0.f, 0.f};
#pragma unroll
    for (int kk = 0; kk < 4; ++kk) {
        const pg8::bf16x8 sfr = lds_frag(lds + H3_ST + (16 * ei + lr) * 272 + kk * 64 + lq * 16);
#pragma unroll
        for (int tt = 0; tt < 2; ++tt) o[tt] = __builtin_amdgcn_mfma_f32_16x16x32_bf16(sfr, lds_frag(QI + (16 * (2 * tp + tt) + lr) * 272 + kk * 64 + lq * 16), o[tt], 0, 0, 0);
    }
    asm volatile("s_waitcnt lgkmcnt(0)"
                 : "+v"(kt[0][0]), "+v"(kt[0][1]), "+v"(kt[1][0]), "+v"(kt[1][1]),
                   "+v"(vt[0][0][0]), "+v"(vt[0][0][1]), "+v"(vt[0][1][0]), "+v"(vt[0][1][1]), "+v"(vt[1][0][0]), "+v"(vt[1][0][1]), "+v"(vt[1][1][0]), "+v"(vt[1][1][1]),
                   "+v"(vt[2][0][0]), "+v"(vt[2][0][1]), "+v"(vt[2][1][0]), "+v"(vt[2][1][1]), "+v"(vt[3][0][0]), "+v"(vt[3][0][1]), "+v"(vt[3][1][0]), "+v"(vt[3][1][1]) :: "memory");
#pragma unroll
    for (int kk = 0; kk < 2; ++kk) {
        const pg8::bf16x8 af = mk_frag(kt[kk][0], kt[kk][1]);
#pragma unroll
        for (int e4 = 0; e4 < 4; ++e4) S[e4] = __builtin_amdgcn_mfma_f32_16x16x32_bf16(af, mk_frag(vt[e4][kk][0], vt[e4][kk][1]), S[e4], 0, 0, 0);
    }
    const f32x4 dv = *(const LAS f32x4*)(lds + H3_DEC + buf * H3_BUFDEC + (16 * w + 4 * lq) * 4);
#pragma unroll
    for (int e4 = 0; e4 < 4; ++e4) S[e4] = S[e4] * dv;
}
__device__ __forceinline__ void hg4_stage2(const Hg3& c, int n, int w, const f32x4 (&S)[4], f32x4 (&o)[2], const v2u (&vt)[4][2][2]) {
    LAS unsigned char* lds = c.lds; const int lr = c.lr, lq = c.lq;
    const int ei = w & 3, tp = w >> 2;
    const pg8::bf16x8 vf0 = ei == 0 ? mk_frag(vt[0][0][0], vt[0][0][1]) : ei == 1 ? mk_frag(vt[1][0][0], vt[1][0][1]) : ei == 2 ? mk_frag(vt[2][0][0], vt[2][0][1]) : mk_frag(vt[3][0][0], vt[3][0][1]);
    const pg8::bf16x8 vf1 = ei == 0 ? mk_frag(vt[0][1][0], vt[0][1][1]) : ei == 1 ? mk_frag(vt[1][1][0], vt[1][1][1]) : ei == 2 ? mk_frag(vt[2][1][0], vt[2][1][1]) : mk_frag(vt[3][1][0], vt[3][1][1]);
#pragma unroll
    for (int tt = 0; tt < 2; ++tt) {
        const int ti = 2 * tp + tt;
        o[tt] = __builtin_amdgcn_mfma_f32_16x16x32_bf16(vf0, lds_frag(lds + H3_AM + (16 * ti + lr) * 144 + 0 * 64 + lq * 16), o[tt], 0, 0, 0);
        o[tt] = __builtin_amdgcn_mfma_f32_16x16x32_bf16(vf1, lds_frag(lds + H3_AM + (16 * ti + lr) * 144 + 1 * 64 + lq * 16), o[tt], 0, 0, 0);
        *(f32x4*)(c.Op + hg3_row(c, n, 16 * ti + lr) + c.vh * 64 + 16 * ei + 4 * lq) = o[tt];
    }
#pragma unroll
    for (int e4 = 0; e4 < 4; ++e4) { v2u wv; wv.x = pk2(S[e4][0], S[e4][1]); wv.y = pk2(S[e4][2], S[e4][3]); *(LAS v2u*)(lds + H3_ST + (16 * e4 + lr) * 272 + (16 * w + 4 * lq) * 2) = wv; }
}
__device__ __forceinline__ void hgrn4_unit(LAS unsigned char* lds, int unit, const bf16* Qb, const bf16* KFb, const bf16* KBb, const bf16* Vb, const float* LFb, const float* LBb,
                                           float* OFb, float* OBb, int tid, int lane, int wave) {
    Hg3 c;
    c.lds = lds; c.vh = unit & 1; c.dir = (unit >> 1) & 1; c.h = (unit >> 2) & 3; c.b = unit >> 4;
    c.Qb = Qb; c.Vb = Vb; c.Kp = c.dir ? KBb : KFb; c.Lp = c.dir ? LBb : LFb; c.Op = c.dir ? OBb : OFb;
    c.lane = lane; c.lr = lane & 15; c.lq = lane >> 4;
    constexpr int NCH = TT / 64;
    const int w = wave;
    for (int i = tid; i < 64 * 272 / 16; i += NTHR) *(LAS v4u*)(lds + H3_ST + i * 16) = (v4u){0u, 0u, 0u, 0u};
    pg8::bf16x8 U[4];
#pragma unroll
    for (int u = 0; u < 4; ++u) { const int kk = u >> 1, ti = u; unsigned wv[4];
#pragma unroll
        for (int j2 = 0; j2 < 4; ++j2) { const int sN = 32 * kk + 8 * c.lq + 2 * j2, t = 16 * ti + c.lr; wv[j2] = (sN <= t ? 0x3F80u : 0u) | (sN + 1 <= t ? 0x3F800000u : 0u); }
        U[u] = (pg8::bf16x8)(v4u){wv[0], wv[1], wv[2], wv[3]}; }
    f32x4 S[4], o[2]; v2u vt[4][2][2];
#pragma unroll
    for (int e4 = 0; e4 < 4; ++e4) S[e4] = (f32x4){0.f, 0.f, 0.f, 0.f};
    Hg4LV lv0, lv1; Hg4QK qk;
    hg4_load_lv(c, 0, tid, lv0); hg4_load_qk(c, 0, w, qk); hg4_load_lv(c, 1, tid, lv1);
    asm volatile("s_waitcnt vmcnt(0)" ::: "memory"); H4_USE_LV(lv0); H4_USE_QK(qk); H4_USE_LV(lv1);
    hg4_prep_a(c, 0, tid, lv0);
    __syncthreads();
#define H4_TRIP(j_, LVN, LVC) do { \
        if ((j_) < NCH) { asm volatile("s_waitcnt vmcnt(5)" ::: "memory"); H4_USE_QK(qk); hg4_prep_b(c, (j_) & 1, w, qk, U); \
            hg4_load_qk(c, (j_) + 1 < NCH ? (j_) + 1 : (j_), w, qk); hg4_load_lv(c, (j_) + 2 < NCH ? (j_) + 2 : (j_), tid, LVC); }     \
        if ((j_) > 0 && (j_) <= NCH) hg4_stage1(c, ((j_) - 1) & 1, w, S, o, vt); \
        if (PROBE_DELAY == 5) probe_delay(100); \
        __syncthreads();                                                                        \
        if ((j_) + 1 < NCH) { asm volatile("s_waitcnt vmcnt(13)" ::: "memory"); H4_USE_LV(LVN); hg4_prep_a(c, ((j_) + 1) & 1, tid, LVN); } \
        if ((j_) > 0 && (j_) <= NCH) hg4_stage2(c, (j_) - 1, w, S, o, vt); \
        __syncthreads();                                                                        \
    } while (0)
#pragma unroll 1
    for (int j = 0; j <= NCH; j += 2) { H4_TRIP(j, lv1, lv0); H4_TRIP(j + 1, lv0, lv1); }
#undef H4_TRIP
    asm volatile("s_waitcnt vmcnt(0)" ::: "memory");
    __syncthreads();
}

#if defined(HGRN_V2)
#define HGRN_FN hgrn_unit
#elif defined(HGRN_V3)
#define HGRN_FN hgrn3_unit
#else
#define HGRN_FN hgrn4_unit
#endif
#define W1_ITEM(r_) do { const int r__ = (r_); const int e__ = r__ >> 10; p0_item<true>(w1 + (size_t)e__ * D * 2 * FF, D, 2 * FF, W1T + (size_t)e__ * 2 * FF * D, RmW1(), scr, r__ & 1023, lane); } while (0)

struct Args { const float* in[18]; float* out; unsigned char* ws; int ph_lo, ph_hi; };
__global__ void __launch_bounds__(NTHR, 2) fwd_kernel(Args args) {
    extern __shared__ __attribute__((aligned(16))) unsigned char lds_raw[];
    LAS unsigned char* lds = (LAS unsigned char*)lds_raw;
    volatile LAS unsigned* MISC = (volatile LAS unsigned*)(lds + MISC_OFF);
    const int tid = threadIdx.x, lane = tid & 63, wave = __builtin_amdgcn_readfirstlane(tid >> 6);
    const int G = gridDim.x; const int bx = blockIdx.x; const int vcu = (G % 8 == 0) ? (bx % 8) * (G / 8) + bx / 8 : bx;
    const int gw = vcu * NWAVES + wave, NGW = G * NWAVES;
    unsigned char* ws = args.ws;
    unsigned* ctl = (unsigned*)(ws + WS_CTL);
    const float* x = args.in[0]; const float* norm1_w = args.in[1]; const float* w_in = args.in[2]; const float* lb_logits = args.in[3];
    const float* hgrn_norm_w = args.in[4]; const float* dw_w = args.in[5]; const float* dw_b = args.in[6]; const float* conv_ln_w = args.in[7]; const float* conv_ln_b = args.in[8];
    const float* w_out = args.in[9]; const float* norm2_w = args.in[10]; const float* router_w = args.in[11]; const float* router_b = args.in[12];
    const float* w1 = args.in[13]; const float* b1 = args.in[14]; const float* w2 = args.in[15]; const float* b2 = args.in[16]; const float* final_norm_w = args.in[17];
    float* out = args.out;
    bf16* WI = (bf16*)(ws + WS_WI); bf16* WO = (bf16*)(ws + WS_WO); unsigned char* W1T = ws + WS_W1; unsigned char* W2T = ws + WS_W2;
    float* H = (float*)(ws + WS_H); bf16* XN = (bf16*)(ws + WS_XN);
    bf16* Qb = (bf16*)(ws + WS_Q); bf16* KFb = (bf16*)(ws + WS_KF); bf16* KBb = (bf16*)(ws + WS_KB); bf16* Vb = (bf16*)(ws + WS_V); bf16* Gb = (bf16*)(ws + WS_G); bf16* Ub = (bf16*)(ws + WS_U);
    float* LFb = (float*)(ws + WS_LF); float* LBb = (float*)(ws + WS_LB); float* OFb = (float*)(ws + WS_OF); float* OBb = (float*)(ws + WS_OB);
    bf16* MIX = (bf16*)(ws + WS_MIX); unsigned char* XS = ws + WS_XS; unsigned char* ACT = ws + WS_ACT; unsigned char* N2 = ws + WS_XN; bf16* YS = (bf16*)(ws + WS_YS);
    float* WRT = (float*)(ws + WS_WRT); int* SLOT = (int*)(ws + WS_SLOT); float* GATE = (float*)(ws + WS_GATE); int* ROWTOK = (int*)(ws + WS_ROWTOK);
    volatile LAS int* bs = (volatile LAS int*)(lds + TAB_OFF);
    volatile LAS int* cl = (volatile LAS int*)(lds + TAB_OFF + 256);
    LAS int* lcnt = (LAS int*)(lds + TAB_OFF + 512);
    volatile LAS int* gbase = (volatile LAS int*)(lds + TAB_OFF + 768);

    for (int u = tid; u < (LDS_BYTES - LDSCTL_OFF) / 4; u += NTHR) ((LAS unsigned*)(lds + LDSCTL_OFF))[u] = 0u;
    __syncthreads();
    XcdBarrier bar; bar.bar = ctl + CW_BAR; bar.x = 0; bar.st = nullptr;
    if (MK_N_LAUNCHES == 1) bar = xcd_barrier_post(ctl + CW_BAR, MISC + 8);
#ifndef PROBE_STAMP
#define PROBE_STAMP -1
#endif
    unsigned long long tS[N_PHASES + 1];
#define STAMP(k) do { if ((PROBE_STAMP) >= 0) tS[k] = __builtin_amdgcn_s_memrealtime(); } while (0)
    const int lo = args.ph_lo, hi = args.ph_hi;
#ifndef PHASE_MASK
#define PHASE_MASK 0xffffffffu
#endif
#define IN(k) ((((PHASE_MASK) >> (k)) & 1u) && lo <= (k) && (k) < hi)
#ifndef PROBE_DUP
#define PROBE_DUP -1
#endif
#define REP(k) _Pragma("unroll 1") for (int rep_ = 0; rep_ < ((PROBE_DUP) == (k) ? 2 + (args.ph_hi >> 20) : 1); ++rep_)
#define SEAM(k) do { if (IN(k) && IN((k) + 1)) { xcd_barrier(bar); if ((PROBE_DUP) == 99) { xcd_barrier(bar); xcd_barrier(bar); } } } while (0)
#define BUILD_BS() do { int t_; asm volatile("v_mov_b32 %0, %1" : "=v"(t_) : "v"(tid));     \
        if (t_ < 64) { const int c_ = t_ < NE ? (int)__hip_atomic_load(ctl + CW_CNT + 64 * (t_ & (NE - 1)), RLX_AGENT) : 0; int x_ = (c_ + 255) >> 8; \
        _Pragma("unroll") for (int o_ = 1; o_ < NE; o_ <<= 1) { const int y_ = __shfl_up(x_, o_); if ((t_ & 63) >= o_) x_ += y_; }     \
        if (t_ < NE) { cl[t_] = c_; bs[t_ + 1] = x_; } if (t_ == 0) bs[0] = 0; } __syncthreads(); } while (0)

    STAMP(0);
    if (IN(0)) REP(0) {
        LAS float* scr = (LAS float*)(lds + RING_OFF + wave * 16384);
        constexpr int I_WI = (D / 64) * (INC / 32), I_WO = (D / 64) * (D / 32), I_W1 = (D / 64) * (2 * FF / 32), I_W2 = (FF / 64) * (D / 32);
        #if defined(HGRN_NAIVE) || defined(W2_IN_P0)
        constexpr int NITEMS = I_WI + I_WO + NE * I_W1 + NE * I_W2;
#else
        constexpr int NITEMS = I_WI + I_WO + W1_P0;
#endif
        {
            const f32x4* wr = (const f32x4*)norm1_w + lane; f32x4 gw4[4];
#pragma unroll
            for (int j = 0; j < 4; ++j) gw4[j] = wr[64 * j];
#pragma unroll 1
            for (int m0 = gw; m0 < MTOK; m0 += 4 * NGW) {
                f32x4 v[4][4];
#pragma unroll
                for (int q4 = 0; q4 < 4; ++q4) { const int m = min(m0 + q4 * NGW, MTOK - 1); const f32x4* xr = (const f32x4*)(x + (size_t)m * D) + lane;
#pragma unroll
                    for (int j = 0; j < 4; ++j) v[q4][j] = xr[64 * j]; }
#pragma unroll
                for (int q4 = 0; q4 < 4; ++q4) { const int m = m0 + q4 * NGW; float sq = 0.f;
#pragma unroll
                    for (int j = 0; j < 4; ++j) sq += (v[q4][j].x * v[q4][j].x + v[q4][j].y * v[q4][j].y) + (v[q4][j].z * v[q4][j].z + v[q4][j].w * v[q4][j].w);
                    const float rstd = rsqrtf(wave_sum(sq) * (1.f / D) + EPS);
                    if (m < MTOK) { v2u* o8 = (v2u*)(XN + (size_t)m * D) + lane;
#pragma unroll
                        for (int j = 0; j < 4; ++j) { v2u o; o.x = pk2(v[q4][j].x * rstd * gw4[j].x, v[q4][j].y * rstd * gw4[j].y); o.y = pk2(v[q4][j].z * rstd * gw4[j].z, v[q4][j].w * rstd * gw4[j].w); o8[64 * j] = o; } }
                }
            }
        }
#if defined(HGRN_NAIVE) || defined(W2_IN_P0)
        for (int it = gw; it < NITEMS; it += NGW) {
            int r = it;
            if (r < I_WI) { p0_item<false>(w_in, D, INC, WI, RmWin(), scr, r, lane); continue; } r -= I_WI;
            if (r < I_WO) { p0_item<false>(w_out, D, D, WO, RmIdent(), scr, r, lane); continue; } r -= I_WO;
            if (r < NE * I_W1) { W1_ITEM(r); continue; } r -= NE * I_W1;
            { const int e = r / I_W2; p0_item<true>(w2 + (size_t)e * FF * D, FF, D, W2T + (size_t)e * D * FF, RmIdent(), scr, r - e * I_W2, lane); }
        }
#else
        (void)NITEMS; (void)I_W2;
        for (int it = gw; it < I_WI + I_WO; it += NGW) { if (it < I_WI) p0_item<false>(w_in, D, INC, WI, RmWin(), scr, it, lane); else p0_item<false>(w_out, D, D, WO, RmIdent(), scr, it - I_WI, lane); }
        convert_range_fp8(w1, D, 2 * FF, W1T, RmW1(), 10, gw, NGW, W1_P0, 0, scr, lane);
#endif
        if ((PROBE_STAMP) == 640) tS[6] = __builtin_amdgcn_s_memrealtime();
        for (int i = bx * NTHR + tid; i < 16 * D; i += G * NTHR) {
            const int r = i >> 4, e16 = i & 15, k = 256 * (r & 3) + (r >> 2); const float gk = norm2_w[k];
            WRT[2 * i] = gk * router_w[k * NE + e16]; WRT[2 * i + 1] = gk * router_w[k * NE + 16 + e16]; }
    }
    if ((PROBE_STAMP) == 600 + 0) tS[6] = __builtin_amdgcn_s_memrealtime();
    SEAM(0);

    STAMP(1);
    if (IN(1)) REP(1) {
        pg8::Gemm g{XN, WI, MTOK, INC, D}; OrderRep S; S.init(MTOK, INC, G, bx); S.reps = ((PROBE_DUP) == 11) ? 2 : 1;
        EpiProj E{Qb, KFb, KBb, Vb, Gb, Ub, LFb, LBb, lb_logits};
        pg8::gemm_phase<EpiProj, OrderRep, true, true>(lds + RING_OFF, g, S, E);
#if !defined(HGRN_NAIVE) && !defined(W2_IN_P0)
        {
            LAS float* scr = (LAS float*)(lds + RING_OFF + wave * 16384);
            if (G == 256) { if (bx >= 128) convert_range_fp8(w1, D, 2 * FF, W1T, RmW1(), 10, (bx - 128) * NWAVES + wave, 128 * NWAVES, W1_P1, W1_P0, scr, lane); }
            else convert_range_fp8(w1, D, 2 * FF, W1T, RmW1(), 10, gw, NGW, W1_P1, W1_P0, scr, lane);
        }
#endif
    }
    if ((PROBE_STAMP) == 600 + 1) tS[6] = __builtin_amdgcn_s_memrealtime();
    SEAM(1);

    STAMP(2);
    if (IN(2)) REP(2) {
        const bool split = (G == 256);
#if defined(HGRN_NAIVE)
        const bool hsel = true; const int hidx = 0, hstride = 1; const bool csel = true; const int cidx = vcu, cstride = G;
#else
        const bool hsel = split ? (((bx >> 3) & 1) != 0) : true; const int hidx = split ? (bx >> 4) * 8 + (bx & 7) : bx, hstride = split ? 128 : G;
        const bool csel = split ? !hsel : true; const int cidx = split ? (bx >> 4) * 8 + (bx & 7) : bx, cstride = split ? 128 : G;
#endif
        (void)hidx; (void)hstride;
        if (csel && PROBE_DELAY == 3) probe_delay(3000); if (csel && PROBE_DELAY == 4) probe_delay(20000);
        if (csel) for (int crep_ = 0; crep_ < ((PROBE_DUP) == 21 ? 2 : 1); ++crep_) {
            LAS unsigned short* ut = (LAS unsigned short*)(lds + RING_OFF);
            LAS float* part = (LAS float*)(lds + RING_OFF + 98304);
            LAS float* stat = (LAS float*)(lds + RING_OFF + 98304 + 4096);
            for (int unit = cidx; unit < NBATCH * (TT / 64); unit += cstride) {
                const int b = unit / (TT / 64), t0 = (unit % (TT / 64)) * 64;
                {
                    v4u val[12];
#pragma unroll
                    for (int i = 0; i < 12; ++i) { const int idx = tid + NTHR * i, r = idx >> 6, p = idx & 63, t = t0 - 15 + r;
                        val[i] = (v4u){0u, 0u, 0u, 0u};
                        if (idx < 94 * 64 && t >= 0 && t < TT) val[i] = *(const v4u*)(Ub + (size_t)(b * TT + t) * CCH + p * 8); }
#pragma unroll
                    for (int i = 0; i < 12; ++i) { const int idx = tid + NTHR * i, r = idx >> 6, p = idx & 63;
                        if (idx < 94 * 64) *(LAS v4u*)(ut + r * 512 + p * 8) = val[i]; }
                }
                __syncthreads(); if ((PROBE_STAMP) == 651 && unit == cidx) tS[6] = __builtin_amdgcn_s_memrealtime();
                const int c = tid;
                float w[CLEN];
#pragma unroll
                for (int j = 0; j < CLEN; ++j) w[j] = dw_w[j * CCH + c];
                const float bias = dw_b[c];
                float y[64];
#pragma unroll
                for (int tb = 0; tb < 8; ++tb) {
                    float win[38];
#pragma unroll
                    for (int i = 0; i < 38; ++i) win[i] = bf2f(ut[(tb * 8 + i) * 512 + c]);
#pragma unroll
                    for (int o = 0; o < 8; ++o) { float a = bias;
#pragma unroll
                        for (int j = 0; j < CLEN; ++j) a += w[j] * win[o + j];
                        y[tb * 8 + o] = a; }
                }
#pragma unroll 1
                for (int pass = 0; pass < 2; ++pass) {
                    float s1[64];
#pragma unroll
                    for (int i = 0; i < 64; ++i) s1[i] = pass ? y[i] * y[i] : y[i];
#pragma unroll
                    for (int s = 32; s >= 1; s >>= 1) {
                        const bool up = (lane & s) != 0;
#pragma unroll
                        for (int i = 0; i < s; ++i) { const float k1 = up ? s1[i + s] : s1[i], x1 = up ? s1[i] : s1[i + s]; s1[i] = k1 + __shfl_xor(x1, s); }
                    }
                    part[(wave * 64 + lane) * 2 + pass] = s1[0];
                }
                __syncthreads(); if ((PROBE_STAMP) == 652 && unit == cidx) tS[6] = __builtin_amdgcn_s_memrealtime();
                if (tid < 64) { float a = 0.f, q = 0.f;
#pragma unroll
                    for (int wv = 0; wv < 8; ++wv) { a += part[(wv * 64 + tid) * 2]; q += part[(wv * 64 + tid) * 2 + 1]; }
                    const float mean = a * (1.f / CCH), var = q * (1.f / CCH) - mean * mean;
                    stat[tid * 2] = mean; stat[tid * 2 + 1] = rsqrtf(fmaxf(var, 0.f) + EPS); }
                __syncthreads();
                const float lw = conv_ln_w[c], lbias = conv_ln_b[c];
#pragma unroll
                for (int t = 0; t < 64; ++t) {
                    const float v = (y[t] - stat[t * 2]) * stat[t * 2 + 1] * lw + lbias;
                    MIX[(size_t)(b * TT + t0 + t) * D + 512 + c] = (bf16)(pk2(v * sigm(v), 0.f) & 0xffffu);
                }
                __syncthreads(); if ((PROBE_STAMP) == 653 && unit == cidx) tS[6] = __builtin_amdgcn_s_memrealtime();
            }
            if ((PROBE_STAMP) == 650) tS[6] = __builtin_amdgcn_s_memrealtime();
#if !defined(HGRN_NAIVE) && !defined(W2_IN_P0)
            {
                LAS float* scr = (LAS float*)(lds + RING_OFF + wave * 16384);
                constexpr int I_W2 = (FF / 64) * (D / 32);
                convert_range_fp8(w2, FF, D, W2T, RmIdent(), 9, cidx * NWAVES + wave, cstride * NWAVES, W2_P2, 0, scr, lane);
                convert_range_fp8(w1, D, 2 * FF, W1T, RmW1(), 10, cidx * NWAVES + wave, cstride * NWAVES, W1_P2, W1_P0 + W1_P1, scr, lane);
            }
#endif
        }
#if defined(HGRN_NAIVE)
        {
            LAS float* qs = (LAS float*)(lds + RING_OFF); LAS float* ks = qs + 2048; LAS float* fs = ks + 2048; LAS float* vs = fs + 2048; LAS float* op = vs + 2048;
            const int e = tid & 127, dq = tid >> 7;
            for (int unit = G - 1 - bx; unit < NBATCH * NH * 2; unit += G) {
                const int dir = unit & 1, h = (unit >> 1) & 3, b = unit >> 3;
                const bf16* Kp = dir ? KBb : KFb; const float* Lp = dir ? LBb : LFb; float* Op = dir ? OBb : OFb;
                float S[32];
#pragma unroll
                for (int i = 0; i < 32; ++i) S[i] = 0.f;
                for (int blk = 0; blk < TT / 16; ++blk) {
                    const int tb = dir ? (TT - 16 - blk * 16) : blk * 16;
#pragma unroll
                    for (int i = 0; i < 4; ++i) { const int idx = tid + NTHR * i, r = idx >> 7, d = idx & 127; const size_t off = (size_t)(b * TT + tb + r) * 512 + h * 128 + d;
                        qs[idx] = bf2f(Qb[off]); ks[idx] = bf2f(Kp[off]); fs[idx] = __expf(Lp[off]); vs[idx] = bf2f(Vb[off]); }
                    __syncthreads();
                    for (int st = 0; st < 16; ++st) {
                        const int r = dir ? 15 - st : st; const float v = vs[r * 128 + e]; float o = 0.f;
#pragma unroll
                        for (int dd = 0; dd < 32; ++dd) { const int d = dq * 32 + dd; S[dd] = fs[r * 128 + d] * S[dd] + ks[r * 128 + d] * v; o += qs[r * 128 + d] * S[dd]; }
                        op[(r * 4 + dq) * 128 + e] = o;
                    }
                    __syncthreads();
#pragma unroll
                    for (int i = 0; i < 4; ++i) { const int idx = tid + NTHR * i, r = idx >> 7, ee = idx & 127;
                        Op[(size_t)(b * TT + tb + r) * 512 + h * 128 + ee] = (op[(r * 4 + 0) * 128 + ee] + op[(r * 4 + 1) * 128 + ee]) + (op[(r * 4 + 2) * 128 + ee] + op[(r * 4 + 3) * 128 + ee]); }
                }
                __syncthreads();
            }
        }
#else
        if (hsel) for (int unit = hidx; unit < NBATCH * NH * 4 * ((PROBE_DUP) == 20 ? 2 : 1); unit += hstride) HGRN_FN(lds + RING_OFF, unit & (NBATCH * NH * 4 - 1), Qb, KFb, KBb, Vb, LFb, LBb, OFb, OBb, tid, lane, wave);
#endif
    }
    if ((PROBE_STAMP) == 600 + 2) tS[6] = __builtin_amdgcn_s_memrealtime();
    SEAM(2);

    STAMP(3);
    if (IN(3)) REP(3) {
        for (int m = gw; m < MTOK; m += NGW) {
            const size_t off = (size_t)m * 512 + lane * 8;
#if defined(HGRN_V2)
            const v4u ua = *(const v4u*)((const bf16*)OFb + off), uc = *(const v4u*)((const bf16*)OBb + off);
            const f32x4 a0 = (f32x4){bf2f(ua.x & 0xffffu), bf2f(ua.x >> 16), bf2f(ua.y & 0xffffu), bf2f(ua.y >> 16)}, a1 = (f32x4){bf2f(ua.z & 0xffffu), bf2f(ua.z >> 16), bf2f(ua.w & 0xffffu), bf2f(ua.w >> 16)};
            const f32x4 c0 = (f32x4){bf2f(uc.x & 0xffffu), bf2f(uc.x >> 16), bf2f(uc.y & 0xffffu), bf2f(uc.y >> 16)}, c1 = (f32x4){bf2f(uc.z & 0xffffu), bf2f(uc.z >> 16), bf2f(uc.w & 0xffffu), bf2f(uc.w >> 16)};
#else
            const f32x4 a0 = *(const f32x4*)(OFb + off), a1 = *(const f32x4*)(OFb + off + 4), c0 = *(const f32x4*)(OBb + off), c1 = *(const f32x4*)(OBb + off + 4);
#endif
            const f32x4 o0 = a0 + c0, o1 = a1 + c1;
            float ss = (o0.x * o0.x + o0.y * o0.y) + (o0.z * o0.z + o0.w * o0.w) + (o1.x * o1.x + o1.y * o1.y) + (o1.z * o1.z + o1.w * o1.w);
            ss += __shfl_xor(ss, 1); ss += __shfl_xor(ss, 2); ss += __shfl_xor(ss, 4); ss += __shfl_xor(ss, 8);
            const float rstd = rsqrtf(ss * (1.f / DV) + EPS);
            const v4u gv = *(const v4u*)(Gb + off);
            const f32x4 w0 = *(const f32x4*)(hgrn_norm_w + lane * 8), w1v = *(const f32x4*)(hgrn_norm_w + lane * 8 + 4);
            f32x4 r0, r1;
            r0.x = o0.x * rstd * w0.x * bf2f(gv.x & 0xffffu); r0.y = o0.y * rstd * w0.y * bf2f(gv.x >> 16);
            r0.z = o0.z * rstd * w0.z * bf2f(gv.y & 0xffffu); r0.w = o0.w * rstd * w0.w * bf2f(gv.y >> 16);
            r1.x = o1.x * rstd * w1v.x * bf2f(gv.z & 0xffffu); r1.y = o1.y * rstd * w1v.y * bf2f(gv.z >> 16);
            r1.z = o1.z * rstd * w1v.z * bf2f(gv.w & 0xffffu); r1.w = o1.w * rstd * w1v.w * bf2f(gv.w >> 16);
            st8bf(MIX + (size_t)m * D + lane * 8, r0, r1);
        }
    }
    if ((PROBE_STAMP) == 600 + 3) tS[6] = __builtin_amdgcn_s_memrealtime();
    SEAM(3);

    STAMP(4);
    if (IN(4)) REP(4) {
        pg8::Gemm g{MIX, WO, MTOK, D, D}; pg8::StaticOrder S; S.init(MTOK, D, G, bx);
        EpiRes E{x, H};
        pg8::gemm_phase<EpiRes, pg8::StaticOrder, true, true>(lds + RING_OFF, g, S, E);
    }
    if ((PROBE_STAMP) == 600 + 4) tS[6] = __builtin_amdgcn_s_memrealtime();
    SEAM(4);

    STAMP(5);
    if (IN(5)) REP(5) {
        typedef float f32x2 __attribute__((ext_vector_type(2)));
        LAS float* wl = (LAS float*)(lds + RING_OFF);
        LAS unsigned* sb = (LAS unsigned*)(lds + SB_OFF);
        { f32x4 tv_[NE * D / 4 / NTHR];
#pragma unroll
            for (int i = 0; i < NE * D / 4 / NTHR; ++i) tv_[i] = ((const f32x4*)WRT)[tid + NTHR * i];
#pragma unroll
            for (int i = 0; i < NE * D / 4 / NTHR; ++i) ((LAS f32x4*)wl)[tid + NTHR * i] = tv_[i]; }
        if (tid < NE) lcnt[tid] = 0;
        __syncthreads();
        for (int tg = vcu; tg < MTOK / 64; tg += G) {
            const int tok0 = tg * 64 + 16 * (wave & 3);
            if (wave < 4) {
                const int j = lane & 15, q = lane >> 4;
                const f32x4* hrow = (const f32x4*)(H + (size_t)(tok0 + j) * D + 256 * q);
                const LAS f32x2* tab = (const LAS f32x2*)wl + q * 16 + j;
                f32x4 acc0 = (f32x4){0.f, 0.f, 0.f, 0.f}, acc1 = acc0; float ss = 0.f;
                f32x4 hb[8], hn[8];
#pragma unroll
                for (int i = 0; i < 8; ++i) hb[i] = hrow[i];
#pragma unroll 1
                for (int blk = 0; blk < 8; ++blk) {
                    if (blk + 1 < 8) {
#pragma unroll
                        for (int i = 0; i < 8; ++i) hn[i] = hrow[(blk + 1) * 8 + i];
                    }
#pragma unroll
                    for (int i = 0; i < 8; ++i) {
                        const f32x4 hc = hb[i]; const int s4 = blk * 8 + i;
                        f32x2 w[4];
#pragma unroll
                        for (int u = 0; u < 4; ++u) w[u] = tab[(4 * s4 + u) * 64];
                        ss += (hc.x * hc.x + hc.y * hc.y) + (hc.z * hc.z + hc.w * hc.w);
#pragma unroll
                        for (int u = 0; u < 4; ++u) { acc0 = __builtin_amdgcn_mfma_f32_16x16x4f32(w[u].x, hc[u], acc0, 0, 0, 0); acc1 = __builtin_amdgcn_mfma_f32_16x16x4f32(w[u].y, hc[u], acc1, 0, 0, 0); }
                    }
#pragma unroll
                    for (int i = 0; i < 8; ++i) hb[i] = hn[i];
                }
                ss += __shfl_xor(ss, 16); ss += __shfl_xor(ss, 32);
                const float rstd = rsqrtf(ss * (1.f / D) + EPS);
                float lg[8];
#pragma unroll
                for (int r = 0; r < 4; ++r) { lg[r] = acc0[r] * rstd + router_b[4 * q + r]; lg[4 + r] = acc1[r] * rstd + router_b[16 + 4 * q + r]; }
                float tv[TOPK]; int ti[TOPK];
#pragma unroll
                for (int k = 0; k < TOPK; ++k) {
                    float bv = lg[0]; int bi = 4 * q;
#pragma unroll
                    for (int r = 1; r < 8; ++r) { const int id = (r < 4) ? 4 * q + r : 16 + 4 * q + (r - 4); if (lg[r] > bv) { bv = lg[r]; bi = id; } }
#pragma unroll
                    for (int o = 16; o < 64; o <<= 1) { const float ov = __shfl_xor(bv, o); const int oi = __shfl_xor(bi, o); if (ov > bv || (ov == bv && oi < bi)) { bv = ov; bi = oi; } }
                    tv[k] = bv; ti[k] = bi;
#pragma unroll
                    for (int r = 0; r < 8; ++r) { const int id = (r < 4) ? 4 * q + r : 16 + 4 * q + (r - 4); if (id == bi) lg[r] = -INFINITY; }
                }
                const float e1 = __expf(tv[1] - tv[0]), e2 = __expf(tv[2] - tv[0]), e3 = __expf(tv[3] - tv[0]);
                const float inv = 1.0f / (1.0f + e1 + e2 + e3);
                {
                    const int ek = q == 0 ? ti[0] : q == 1 ? ti[1] : q == 2 ? ti[2] : ti[3];
                    const float gk = (q == 0 ? 1.0f : q == 1 ? e1 : q == 2 ? e2 : e3) * inv;
                    const int lr = __hip_atomic_fetch_add(&lcnt[ek], 1, __ATOMIC_RELAXED, __HIP_MEMORY_SCOPE_WORKGROUP);
                    sb[(16 * wave + j) * 4 + q] = ((unsigned)ek << 16) | (unsigned)lr;
                    GATE[(size_t)(tok0 + j) * TOPK + q] = gk;
                }
            } else {
                const f32x4* wr = (const f32x4*)norm2_w + lane;
                f32x4 gw4[4];
#pragma unroll
                for (int jj = 0; jj < 4; ++jj) gw4[jj] = wr[64 * jj];
#pragma unroll 1
                for (int i = 0; i < 16; i += 4) {
                    f32x4 v[4][4];
#pragma unroll
                    for (int q4 = 0; q4 < 4; ++q4) { const f32x4* hr = (const f32x4*)(H + (size_t)(tok0 + i + q4) * D) + lane;
#pragma unroll
                        for (int jj = 0; jj < 4; ++jj) v[q4][jj] = hr[64 * jj]; }
#pragma unroll
                    for (int q4 = 0; q4 < 4; ++q4) {
                        float s2 = 0.f;
#pragma unroll
                        for (int jj = 0; jj < 4; ++jj) s2 += (v[q4][jj].x * v[q4][jj].x + v[q4][jj].y * v[q4][jj].y) + (v[q4][jj].z * v[q4][jj].z + v[q4][jj].w * v[q4][jj].w);
                        const float rstd = rsqrtf(wave_sum(s2) * (1.f / D) + EPS) * SC_N2;
                        unsigned* o4 = (unsigned*)(N2 + (size_t)(tok0 + i + q4) * D) + lane;
#pragma unroll
                        for (int jj = 0; jj < 4; ++jj) o4[64 * jj] = pk4_fp8(v[q4][jj].x * rstd * gw4[jj].x, v[q4][jj].y * rstd * gw4[jj].y, v[q4][jj].z * rstd * gw4[jj].z, v[q4][jj].w * rstd * gw4[jj].w);
                    }
                }
            }
            __syncthreads();
            if (tid < NE) { const int c = lcnt[tid]; gbase[tid] = c ? (int)__hip_atomic_fetch_add(ctl + CW_CNT + ((PROBE_DUP) == 5 && rep_ == 0 ? 4096 : 0) + 64 * tid, (unsigned)c, RLX_AGENT) : 0; }
            __syncthreads();
            if (tid < 256) { const unsigned w = sb[tid]; const int ek = (int)(w >> 16), r = gbase[ek] + (int)(w & 0xffffu), m = tg * 64 + (tid >> 2);
                ROWTOK[ek * MTOK + r] = m; SLOT[(size_t)m * TOPK + (tid & 3)] = ek * MTOK + r; }
            if (tid < NE) lcnt[tid] = 0;
            __syncthreads();
        }
    }
    if ((PROBE_STAMP) == 600 + 5) tS[6] = __builtin_amdgcn_s_memrealtime();
    SEAM(5);


    if ((PROBE_STAMP) < 600 || (PROBE_STAMP) > 699) STAMP(6);
    STAMP(7);
#if defined(MOE_MERGED)
    if (IN(7)) REP(7) {
        BUILD_BS();
        pg8::Gemm g{(const bf16*)ws, (const bf16*)W1T, MTOK, 2 * FF, D / 2}; MoeOrder2 S{bs, G, vcu, cl, ROWTOK, ctl};
        EpiMoe E{EpiSwiglu{ACT, b1}, EpiDown{YS, b2}};
        pg8::gemm_phase<EpiMoe, MoeOrder2, true, true, true, true>(lds + RING_OFF, g, S, E);
    }
    if ((PROBE_STAMP) == 600 + 8) tS[6] = __builtin_amdgcn_s_memrealtime();
    SEAM(8);
#else
    if (IN(7)) REP(7) {
        BUILD_BS();
        pg8::Gemm g{(const bf16*)N2, (const bf16*)W1T, MTOK, 2 * FF, D / 2}; MoeOrder S{bs, 8, G, vcu, cl, ROWTOK};
        EpiSwiglu E{ACT, b1};
        pg8::gemm_phase<EpiSwiglu, MoeOrder, true, true, true, true>(lds + RING_OFF, g, S, E);
#if !defined(HGRN_NAIVE) && !defined(W2_IN_P0)
        {
            LAS float* scr = (LAS float*)(lds + RING_OFF + wave * 16384);
            const int r7 = (bs[NE] * 8) % G, nsl = G - r7;
            if (vcu >= r7) convert_range_fp8(w2, FF, D, W2T, RmIdent(), 9, (vcu - r7) * NWAVES + wave, nsl * NWAVES, W2_P7, W2_P2, scr, lane);
        }
#endif
    }
    if ((PROBE_STAMP) == 600 + 7) tS[6] = __builtin_amdgcn_s_memrealtime();
    SEAM(7);

    STAMP(8);
    if (IN(8)) REP(8) {
        BUILD_BS();
        pg8::Gemm g{(const bf16*)ACT, (const bf16*)W2T, MOE_ROWS, D, FF / 2}; MoeOrder S{bs, 4, G, vcu, cl, ROWTOK};
        EpiDown E{YS, b2};
        pg8::gemm_phase<EpiDown, MoeOrder, true, true, true>(lds + RING_OFF, g, S, E);
    }
    SEAM(8);
#endif

    STAMP(9);
    if (IN(9)) REP(9) {
        BUILD_BS();
        for (int base = gw; base < MTOK; base += 16 * NGW) {
            const int mi = base + NGW * (lane >> 2); int posl = 0; float gl = 0.f;
            if (mi < MTOK) { const int sl = SLOT[(size_t)mi * TOPK + (lane & 3)]; gl = GATE[(size_t)mi * TOPK + (lane & 3)]; posl = bs[sl >> 14] * 256 + (sl & (MTOK - 1)); }
#pragma unroll 2
            for (int i = 0; i < 16; ++i) {
                const int m = base + NGW * i; if (m >= MTOK) break;
                const f32x4* hr = (const f32x4*)(H + (size_t)m * D) + lane; const f32x4* wr = (const f32x4*)final_norm_w + lane;
                int pos[TOPK]; float gk[TOPK];
#pragma unroll
                for (int k = 0; k < TOPK; ++k) { pos[k] = __shfl(posl, 4 * i + k); gk[k] = __shfl(gl, 4 * i + k); }
                f32x4 v[4]; v2u yw[TOPK][4];
#pragma unroll
                for (int j = 0; j < 4; ++j) v[j] = hr[64 * j];
#pragma unroll
                for (int k = 0; k < TOPK; ++k) { const v2u* yr = (const v2u*)(YS + (size_t)pos[k] * D) + lane;
#pragma unroll
                    for (int j = 0; j < 4; ++j) yw[k][j] = yr[64 * j]; }
#pragma unroll
                for (int k = 0; k < TOPK; ++k)
#pragma unroll
                    for (int j = 0; j < 4; ++j) { const v2u w = yw[k][j];
                        v[j].x += gk[k] * bf2f(w.x & 0xffffu); v[j].y += gk[k] * bf2f(w.x >> 16); v[j].z += gk[k] * bf2f(w.y & 0xffffu); v[j].w += gk[k] * bf2f(w.y >> 16); }
                float s = 0.f;
#pragma unroll
                for (int j = 0; j < 4; ++j) s += (v[j].x * v[j].x + v[j].y * v[j].y) + (v[j].z * v[j].z + v[j].w * v[j].w);
                const float rstd = rsqrtf(wave_sum(s) * (1.f / D) + EPS);
                f32x4* orow = (f32x4*)(out + (size_t)m * D) + lane;
#pragma unroll
                for (int j = 0; j < 4; ++j) orow[64 * j] = v[j] * rstd * wr[64 * j];
            }
        }
    }
    STAMP(N_PHASES);
#ifndef PROBE_WG
#define PROBE_WG 0
#endif
    if ((PROBE_STAMP) >= 660 && (PROBE_STAMP) <= 669 && bx == (PROBE_WG)) {
        const unsigned long long a_ = *(volatile LAS unsigned long long*)(lds + LDSCTL_OFF + 640), b_ = *(volatile LAS unsigned long long*)(lds + LDSCTL_OFF + 648);
        const unsigned long long d = 64ull * (b_ - a_), t0 = __builtin_amdgcn_s_memrealtime();
        while (__builtin_amdgcn_s_memrealtime() - t0 < d) __builtin_amdgcn_s_sleep(8);
    } else
    if ((PROBE_STAMP) >= 0 && bx == (PROBE_WG)) {
        const int k0 = (PROBE_STAMP) == 640 ? 0 : ((PROBE_STAMP) >= 650 && (PROBE_STAMP) <= 659) ? 2 : (PROBE_STAMP) % 100, k1 = ((PROBE_STAMP) >= 100) ? (PROBE_STAMP) / 100 : k0 + 1;
        const unsigned long long d = 2ull * (tS[k1 > N_PHASES ? N_PHASES : k1] - tS[k0]), t0 = __builtin_amdgcn_s_memrealtime();
        while (__builtin_amdgcn_s_memrealtime() - t0 < d) __builtin_amdgcn_s_sleep(8);
    }
#undef IN
#undef SEAM
#undef BUILD_BS
}

extern "C" void kernel_launch(void* const* d_in, const int* in_sizes, int n_in, void* d_out, int out_size, void* d_ws, size_t ws_size, hipStream_t stream) {
    static int grid = 0;
    if (grid == 0) {
        if (n_in != 18 || in_sizes[0] != MTOK * D || out_size != MTOK * D || ws_size < WS_END) { fprintf(stderr, "kernel_launch: unexpected shapes (n_in %d, in0 %d, out %d, ws %zu < %zu); nothing launched\n", n_in, n_in > 0 ? in_sizes[0] : -1, out_size, ws_size, (size_t)WS_END); grid = -1; return; }
        int dev = 0, cus = 0, per_cu = 0;
        if (hipGetDevice(&dev) != hipSuccess || hipDeviceGetAttribute(&cus, hipDeviceAttributeMultiprocessorCount, dev) != hipSuccess) { fprintf(stderr, "kernel_launch: device query failed\n"); grid = -1; return; }
        if (hipFuncSetAttribute((const void*)fwd_kernel, hipFuncAttributeMaxDynamicSharedMemorySize, LDS_BYTES) != hipSuccess) { fprintf(stderr, "kernel_launch: hipFuncSetAttribute failed\n"); grid = -1; return; }
        if (hipOccupancyMaxActiveBlocksPerMultiprocessor(&per_cu, (const void*)fwd_kernel, NTHR, LDS_BYTES) != hipSuccess || per_cu < 1)
            fprintf(stderr, "kernel_launch: note: occupancy query reports %d workgroups per CU\n", per_cu);
        (void)hipGetLastError();
        grid = cus;
    }
    if (grid < 0) return;
    if (hipMemsetAsync((char*)d_ws + WS_CTL, 0, CTL_ZERO_BYTES, stream) != hipSuccess) { fprintf(stderr, "kernel_launch: memset failed\n"); return; }
    Args a{};
    for (int i = 0; i < 18; ++i) a.in[i] = (const float*)d_in[i];
    a.out = (float*)d_out; a.ws = (unsigned char*)d_ws;
#if MK_N_LAUNCHES == 1
    a.ph_lo = 0; a.ph_hi = N_PHASES;
    hipLaunchKernelGGL(fwd_kernel, dim3(grid), dim3(NTHR), LDS_BYTES, stream, a);
#else
    for (int ph = 0; ph < N_PHASES; ++ph) { a.ph_lo = ph; a.ph_hi = ph + 1; hipLaunchKernelGGL(fwd_kernel, dim3(grid), dim3(NTHR), LDS_BYTES, stream, a); }
#endif
    const hipError_t le = hipPeekAtLastError();
    if (le != hipSuccess) fprintf(stderr, "kernel_launch: launch failed: %s\n", hipGetErrorName(le));
}
```

```cpp
#define HGRN_V2 1
#include <hip/hip_runtime.h>
#include <cstdio>
#include <cstdint>
namespace pg8 {
#define PG8_LAS __attribute__((address_space(3)))
typedef unsigned short bf16_t;
typedef short bf16x8 __attribute__((ext_vector_type(8)));
typedef float f32x4 __attribute__((ext_vector_type(4)));
typedef unsigned u32x4 __attribute__((ext_vector_type(4)));
constexpr int BM = 256, BK = 64, HALF = 128, HTB = HALF * BK * 2  , STAGE_BYTES = 8 * HTB, NXCD = 8, WGM = 8;

__host__ __device__ __forceinline__ int lds_byte(int r, int c) { const int st = (r >> 4) * 2 + (c >> 5), rr = r & 15, cc = c & 31, ob = rr * 64 + cc * 2; return st * 1024 + (ob ^ (((ob >> 9) & 1) << 5)); }
__host__ __device__ __forceinline__ void stage_rc(int b, int& R, int& C) { const int st = b / 1024, sb = b % 1024, swz = sb ^ (((sb >> 9) & 1) << 5); R = (st >> 1) * 16 + swz / 64; C = (st & 1) * 32 + (swz % 64) / 2; }
__host__ __device__ __forceinline__ int perm32(int rho) { const int n = rho >> 4, i = rho & 15; return 8 * (i >> 2) + 4 * n + (i & 3); }

struct Unit { int pm, pn; };
struct Gemm { const bf16_t* A; const bf16_t* Bt; int M, N, K; };

struct StaticOrder {
    int nM, nN, nwg, G, c;
    __host__ __device__ void init(int M, int N, int G_, int c_) { nM = M / BM; nN = N / BM; nwg = nM * nN; G = G_; c = c_; }
    __host__ __device__ bool next(int i, Unit& u) const {
        const long L = (long)i * G + c; if (L >= nwg) return false;
        int wgid = (int)L; { const int q = nwg / NXCD, r = nwg % NXCD, xcd = wgid % NXCD, off = wgid / NXCD; wgid = (xcd < r ? xcd * (q + 1) : r * (q + 1) + (xcd - r) * q) + off; }
        const int nig = WGM * nN, gid = wgid / nig, fm = gid * WGM, gsz = (nM - fm) < WGM ? (nM - fm) : WGM;
        u.pm = fm + ((wgid % nig) % gsz); u.pn = (wgid % nig) / gsz; return true;
    }
    __device__ __forceinline__ void a_ready(const Unit&) const {}
    __device__ __forceinline__ void done(const Unit&) const {}
    __device__ __forceinline__ int done_defer(const Unit&) const { return -1; }
    __device__ __forceinline__ void done_signal(int) const {}
};
__device__ __forceinline__ unsigned cvt_pk_bf16(float lo, float hi) { unsigned r; asm volatile("v_cvt_pk_bf16_f32 %0, %1, %2" : "=v"(r) : "v"(lo), "v"(hi)); return r; }
typedef float f32x2 __attribute__((ext_vector_type(2)));
template <class Epi, class Sched, bool ALIGN_EPI = false, bool SP2 = false, bool FP8 = false, bool GATHER = false>
__device__ __forceinline__ void gemm_phase(PG8_LAS unsigned char* lds, const Gemm g, const Sched& S, const Epi& E) {
    typedef int v4i_t __attribute__((ext_vector_type(4)));
    const int tid = threadIdx.x, wid = __builtin_amdgcn_readfirstlane(tid >> 6), lane = tid & 63, wr = wid >> 2, wc = wid & 3, fr = lane & 15, fq = lane >> 4;
    const int K = g.K, nt = K / BK;
    unsigned voffA[2], voffB[2];
#pragma unroll
    for (int i = 0; i < 2; ++i) { int R, C; stage_rc(tid * 16 + i * 8192, R, C); const int Rb = Epi::PERM ? ((R & ~31) + perm32(R & 31)) : R;
        voffA[i] = (unsigned)(R * K + C) * 2u; voffB[i] = (unsigned)(Rb * K + C) * 2u; }
    int rowA[2]; unsigned colA[2];
#pragma unroll
    for (int i = 0; i < 2; ++i) { int R, C; stage_rc(tid * 16 + i * 8192, R, C); rowA[i] = R; colA[i] = (unsigned)C * 2u; }
    const size_t kstep = (size_t)(BK * 2);
    const size_t hstep = (size_t)HALF * K * 2;
    const size_t tstep = 2 * hstep;
    const unsigned ldsw = (unsigned)wid * 1024u;
    const int aoff = lds_byte(wr * 64 + fr, fq * 8), boff = lds_byte(wc * 32 + fr, fq * 8);
#define PG8_SA(b, h) (((b) * 2 + (h)) * HTB)
#define PG8_SB(b, h) ((4 + (b) * 2 + (h)) * HTB)
#define PG8_STAGE(bufoff, gbase, voff) do { _Pragma("unroll") for (int _i = 0; _i < 2; ++_i) \
        __builtin_amdgcn_global_load_lds((const unsigned*)((const char*)(gbase) + (voff)[_i]), (PG8_LAS unsigned*)(lds + (bufoff) + ldsw + _i * 8192), 16, 0, 0); } while (0)
#define PG8_STAGE2(bufoff, gbase, o0, o1) do { \
        __builtin_amdgcn_global_load_lds((const unsigned*)((const char*)(gbase) + (o0)), (PG8_LAS unsigned*)(lds + (bufoff) + ldsw), 16, 0, 0); \
        __builtin_amdgcn_global_load_lds((const unsigned*)((const char*)(gbase) + (o1)), (PG8_LAS unsigned*)(lds + (bufoff) + ldsw + 8192), 16, 0, 0); } while (0)
#define PG8_LDA(dst, b, h) do { _Pragma("unroll") for (int m = 0; m < 4; ++m) _Pragma("unroll") for (int k = 0; k < 2; ++k) dst[m][k] = *(const PG8_LAS bf16x8*)(lds + PG8_SA(b, h) + aoff + m * 2048 + k * 1024); } while (0)
#define PG8_LDB(dst, b, h) do { _Pragma("unroll") for (int n = 0; n < 2; ++n) _Pragma("unroll") for (int k = 0; k < 2; ++k) dst[n][k] = *(const PG8_LAS bf16x8*)(lds + PG8_SB(b, h) + boff + n * 2048 + k * 1024); } while (0)
#define PG8_MMA(ai, bj, At, Bt) do { __builtin_amdgcn_s_setprio(1); _Pragma("unroll") for (int m = 0; m < 4; ++m) _Pragma("unroll") for (int n = 0; n < 2; ++n) { \
        if constexpr (FP8) { asm volatile("v_mfma_f32_16x16x128_f8f6f4 %0, %1, %2, %0" : "+v"(acc[ai][bj][m][n]) : "v"(__builtin_shufflevector((v4i_t)Bt[n][0], (v4i_t)Bt[n][1], 0, 1, 2, 3, 4, 5, 6, 7)), "v"(__builtin_shufflevector((v4i_t)At[m][0], (v4i_t)At[m][1], 0, 1, 2, 3, 4, 5, 6, 7))); } \
        else { _Pragma("unroll") for (int k = 0; k < 2; ++k) acc[ai][bj][m][n] = __builtin_amdgcn_mfma_f32_16x16x32_bf16(Bt[n][k], At[m][k], acc[ai][bj][m][n], 0, 0, 0); } } __builtin_amdgcn_s_setprio(0); } while (0)
#define PG8_WAIT_V(n) asm volatile("s_waitcnt vmcnt(" #n ")" ::: "memory")
#define PG8_WAIT_L(n) asm volatile("s_waitcnt lgkmcnt(" #n ")" ::: "memory")
#define PG8_BAR __builtin_amdgcn_s_barrier()
#define PG8_SCHED __builtin_amdgcn_sched_barrier(0)
    Unit cur, nxt; int ui = 0; int pend = -1;
    if (!S.next(0, cur)) return;
    f32x4 acc[2][2][4][2];
#pragma unroll
    for (int a = 0; a < 2; ++a)
#pragma unroll
        for (int b = 0; b < 2; ++b)
#pragma unroll
            for (int m = 0; m < 4; ++m)
#pragma unroll
                for (int n = 0; n < 2; ++n) acc[a][b][m][n] = (f32x4){0.f, 0.f, 0.f, 0.f};
    bf16x8 At[4][2], B0[2][2], B1[2][2];
    const char* cA = (const char*)g.A + (size_t)cur.pm * tstep; const char* cB = (const char*)g.Bt + (size_t)cur.pn * tstep;
    unsigned oA[2][2], nOA[2][2]; int tk[2][2] = {{0, 0}, {0, 0}};
    if constexpr (GATHER) {
        cA = (const char*)g.A;
        const int nv = S.a_valid(cur); const unsigned ab = S.a_base(cur);
        if (S.a_is_list(cur)) { const int* lst = S.a_list(cur);
#pragma unroll
            for (int h = 0; h < 2; ++h)
#pragma unroll
                for (int i = 0; i < 2; ++i) { const int r = min(h * HALF + rowA[i], nv - 1); oA[h][i] = ab + (unsigned)lst[r] * (unsigned)(K * 2) + colA[i]; }
        } else { const int r0 = S.a_row0(cur);
#pragma unroll
            for (int h = 0; h < 2; ++h)
#pragma unroll
                for (int i = 0; i < 2; ++i) { const int r = min(h * HALF + rowA[i], nv - 1); oA[h][i] = ab + (unsigned)(r0 + r) * (unsigned)(K * 2) + colA[i]; }
        }
    } else {
#pragma unroll
        for (int h = 0; h < 2; ++h)
#pragma unroll
            for (int i = 0; i < 2; ++i) oA[h][i] = voffA[i] + (unsigned)(h * hstep);
    }
#pragma unroll
    for (int h = 0; h < 2; ++h)
#pragma unroll
        for (int i = 0; i < 2; ++i) nOA[h][i] = oA[h][i];
#define PG8_OSEL(h, i) (GATHER ? (last ? nOA[h][i] : oA[h][i]) : oA[h][i])
    S.a_ready(cur);
    if constexpr (SP2) {
        PG8_STAGE(PG8_SB(0, 0), cB, voffB); PG8_STAGE(PG8_SB(0, 1), cB + hstep, voffB); PG8_STAGE2(PG8_SA(0, 0), cA, oA[0][0], oA[0][1]); PG8_STAGE2(PG8_SA(0, 1), cA, oA[1][0], oA[1][1]);
        if (wr == 1) PG8_BAR;
        PG8_WAIT_V(2); PG8_BAR;
        PG8_STAGE(PG8_SB(1, 0), cB + kstep, voffB); PG8_STAGE2(PG8_SA(1, 0), cA + kstep, oA[0][0], oA[0][1]); PG8_STAGE(PG8_SB(1, 1), cB + hstep + kstep, voffB);
        PG8_WAIT_V(6); PG8_BAR;
    } else {
        PG8_STAGE(PG8_SB(0, 0), cB, voffB); PG8_STAGE(PG8_SA(0, 0), cA, voffA); PG8_STAGE(PG8_SB(0, 1), cB + hstep, voffB); PG8_STAGE(PG8_SA(0, 1), cA + hstep, voffA);
        if (wr == 1) PG8_BAR;
        PG8_WAIT_V(4); PG8_BAR;
        PG8_STAGE(PG8_SB(1, 0), cB + kstep, voffB); PG8_STAGE(PG8_SA(1, 0), cA + kstep, voffA); PG8_STAGE(PG8_SB(1, 1), cB + hstep + kstep, voffB);
        PG8_WAIT_V(6); PG8_BAR;
    }
    for (;;) {
        const bool has_next = S.next(ui + 1, nxt);
        const char* nA = GATHER ? cA : (has_next ? (const char*)g.A + (size_t)nxt.pm * tstep : cA); const char* nB = has_next ? (const char*)g.Bt + (size_t)nxt.pn * tstep : cB;
        if constexpr (GATHER) { if (has_next) { const int nv = S.a_valid(nxt);
            if (S.a_is_list(nxt)) { const int* lst = S.a_list(nxt);
#pragma unroll
                for (int h = 0; h < 2; ++h)
#pragma unroll
                    for (int i = 0; i < 2; ++i) { const int* pp = lst + min(h * HALF + rowA[i], nv - 1); asm volatile("global_load_dword %0, %1, off" : "=v"(tk[h][i]) : "v"(pp) : "memory"); }
            } else { const int r0 = S.a_row0(nxt);
#pragma unroll
                for (int h = 0; h < 2; ++h)
#pragma unroll
                    for (int i = 0; i < 2; ++i) tk[h][i] = r0 + min(h * HALF + rowA[i], nv - 1);
            } } }
        for (int t = 0; t < nt; t += 2) {
            const bool last = (t == nt - 2);
            const char* a1 = cA + (size_t)(t + 1) * kstep;
            const char* a2 = last ? nA : cA + (size_t)(t + 2) * kstep; const char* b2 = last ? nB : cB + (size_t)(t + 2) * kstep;
            const char* a3 = a2 + kstep; const char* b3 = b2 + kstep;
            if (last && has_next) S.a_ready(nxt);
            if constexpr (GATHER) { if (last && has_next) { asm volatile("" : "+v"(tk[0][0]), "+v"(tk[0][1]), "+v"(tk[1][0]), "+v"(tk[1][1]));
#pragma unroll
                for (int h = 0; h < 2; ++h)
#pragma unroll
                    for (int i = 0; i < 2; ++i) nOA[h][i] = S.a_base(nxt) + (unsigned)tk[h][i] * (unsigned)(K * 2) + colA[i]; } }
            if constexpr (SP2) {
            PG8_LDB(B0, 0, 0); PG8_LDB(B1, 0, 1); PG8_SCHED; PG8_LDA(At, 0, 0); PG8_STAGE2(PG8_SA(1, 1), a1, oA[1][0], oA[1][1]);
            PG8_WAIT_V(8); PG8_WAIT_L(0); PG8_BAR; PG8_MMA(0, 0, At, B0); PG8_MMA(0, 1, At, B1); PG8_BAR; PG8_SCHED;
            PG8_LDA(At, 0, 1); PG8_STAGE(PG8_SB(0, 0), b2, voffB); PG8_STAGE(PG8_SB(0, 1), b2 + hstep, voffB); PG8_STAGE2(PG8_SA(0, 0), a2, PG8_OSEL(0, 0), PG8_OSEL(0, 1));
            PG8_WAIT_V(8); if (pend >= 0) { S.done_signal(pend); pend = -1; }
            PG8_WAIT_L(0); PG8_BAR; PG8_MMA(1, 0, At, B0); PG8_MMA(1, 1, At, B1); PG8_BAR; PG8_SCHED;
            PG8_LDB(B0, 1, 0); PG8_LDB(B1, 1, 1); PG8_SCHED; PG8_LDA(At, 1, 0); PG8_STAGE2(PG8_SA(0, 1), a2, PG8_OSEL(1, 0), PG8_OSEL(1, 1));
            PG8_WAIT_V(8); PG8_WAIT_L(0); PG8_BAR; PG8_MMA(0, 0, At, B0); PG8_MMA(0, 1, At, B1); PG8_BAR; PG8_SCHED;
            PG8_LDA(At, 1, 1); PG8_STAGE(PG8_SB(1, 0), b3, voffB); PG8_STAGE(PG8_SB(1, 1), b3 + hstep, voffB); PG8_STAGE2(PG8_SA(1, 0), a3, PG8_OSEL(0, 0), PG8_OSEL(0, 1));
            PG8_WAIT_V(8); PG8_WAIT_L(0); PG8_BAR; PG8_MMA(1, 0, At, B0); PG8_MMA(1, 1, At, B1); PG8_BAR; PG8_SCHED;
            } else {
            PG8_LDB(B0, 0, 0); PG8_SCHED; PG8_LDA(At, 0, 0); PG8_STAGE(PG8_SA(1, 1), a1 + hstep, voffA);
            PG8_WAIT_L(8); PG8_BAR; PG8_WAIT_L(0); PG8_MMA(0, 0, At, B0); PG8_BAR; PG8_SCHED;
            PG8_LDB(B1, 0, 1); PG8_STAGE(PG8_SB(0, 0), b2, voffB);
            PG8_BAR; PG8_WAIT_L(0); PG8_MMA(0, 1, At, B1); PG8_BAR;
            PG8_LDA(At, 0, 1); PG8_STAGE(PG8_SA(0, 0), a2, voffA);
            PG8_BAR; PG8_WAIT_L(0); PG8_MMA(1, 0, At, B0); PG8_BAR; PG8_SCHED;
            PG8_STAGE(PG8_SB(0, 1), b2 + hstep, voffB);
            PG8_WAIT_V(6); PG8_BAR; PG8_MMA(1, 1, At, B1); PG8_BAR;
            PG8_LDB(B0, 1, 0); PG8_SCHED; PG8_LDA(At, 1, 0); PG8_STAGE(PG8_SA(0, 1), a2 + hstep, voffA);
            PG8_WAIT_L(8); PG8_BAR; PG8_WAIT_L(0); PG8_MMA(0, 0, At, B0); PG8_BAR; PG8_SCHED;
            PG8_LDB(B1, 1, 1); PG8_STAGE(PG8_SB(1, 0), b3, voffB);
            PG8_BAR; PG8_WAIT_L(0); PG8_MMA(0, 1, At, B1); PG8_BAR;
            PG8_LDA(At, 1, 1); PG8_STAGE(PG8_SA(1, 0), a3, voffA);
            PG8_BAR; PG8_WAIT_L(0); PG8_MMA(1, 0, At, B0); PG8_BAR; PG8_SCHED;
            PG8_STAGE(PG8_SB(1, 1), b3 + hstep, voffB);
            PG8_WAIT_V(6); PG8_BAR; PG8_MMA(1, 1, At, B1); PG8_BAR;
            }
        }
        if constexpr (FP8) asm volatile("s_nop 15\n\ts_nop 15" ::: "memory");
        if constexpr (ALIGN_EPI) { if (wr == 0) PG8_BAR; }
        if constexpr (!Epi::AFTER_DRAIN) { E(acc, cur, wr, wc, fr, fq); S.done(cur); pend = S.done_defer(cur); }
        if (!has_next) break;
#pragma unroll
        for (int a = 0; a < 2; ++a)
#pragma unroll
            for (int b = 0; b < 2; ++b)
#pragma unroll
                for (int m = 0; m < 4; ++m)
#pragma unroll
                    for (int n = 0; n < 2; ++n) acc[a][b][m][n] = (f32x4){0.f, 0.f, 0.f, 0.f};
        cur = nxt; cA = nA; cB = nB; ++ui;
        if constexpr (GATHER) {
#pragma unroll
            for (int h = 0; h < 2; ++h)
#pragma unroll
                for (int i = 0; i < 2; ++i) oA[h][i] = nOA[h][i];
        }
        if constexpr (ALIGN_EPI) { if (wr == 1) PG8_BAR; }
    }
    PG8_WAIT_V(0);
    if (pend >= 0) { S.done_signal(pend); pend = -1; }
    if constexpr (!ALIGN_EPI) { if (wr == 0) PG8_BAR; }
    PG8_BAR;
    if constexpr (Epi::AFTER_DRAIN) { E.fused(acc, cur, wr, wc, fr, fq, lds, wid, lane); S.done(cur); }
#undef PG8_SA
#undef PG8_OSEL
#undef PG8_STAGE2
#undef PG8_SB
#undef PG8_STAGE
#undef PG8_LDA
#undef PG8_LDB
#undef PG8_MMA
#undef PG8_WAIT_V
#undef PG8_WAIT_L
#undef PG8_BAR
#undef PG8_SCHED
}
}

#ifndef MK_N_LAUNCHES
#define MK_N_LAUNCHES 1
#endif
#ifndef PROBE_DUP
#define PROBE_DUP -1
#endif
#ifndef PROBE_STAMP
#define PROBE_STAMP -1
#endif
constexpr int N_PHASES = 10;
constexpr int NBATCH = 8, TT = 2048, MTOK = NBATCH * TT, D = 1024;
constexpr int HK = 512, NH = 4, DK = 128, DV = 128, CCH = 512, CLEN = 31, INC = 3584;
constexpr int NE = 32, TOPK = 4, FF = 1024;
constexpr float EPS = 1e-5f, SW_LIMIT = 7.0f, SW_ALPHA = 1.702f;
constexpr int NWAVES = 8, NTHR = 512;
constexpr int W1_ITEMS = 32 * 16 * 64, W1_P1 = 6144, W1_P2 = 20480, W1_P0 = W1_ITEMS - W1_P1 - W1_P2;
constexpr int W2_ITEMS = 32 * 16 * 32, W2_P7 = 4096, W2_P2 = W2_ITEMS - W2_P7;
constexpr int MOE_ROWS = (MTOK * TOPK / 256 + NE) * 256;

constexpr size_t MiB = 1u << 20;
constexpr size_t WS_CTL = 0, CTL_ZERO_BYTES = 256 * 1024;
constexpr size_t WS_WI = 1 * MiB;
constexpr size_t WS_WO = 8 * MiB;
constexpr size_t WS_TAB = 10 * MiB;
constexpr size_t WS_W1 = 16 * MiB;
constexpr size_t WS_W2 = 144 * MiB;
constexpr size_t WS_H = 208 * MiB;
constexpr size_t WS_XN = 272 * MiB;
constexpr size_t WS_Q = 304 * MiB, WS_KF = 320 * MiB, WS_KB = 336 * MiB, WS_V = 352 * MiB, WS_G = 368 * MiB, WS_U = 384 * MiB;
constexpr size_t WS_LF = 400 * MiB, WS_LB = 432 * MiB;
constexpr size_t WS_OF = 464 * MiB, WS_OB = 496 * MiB;
constexpr size_t WS_MIX = 528 * MiB;
constexpr size_t WS_XS = 304 * MiB;
constexpr size_t WS_ACT = 448 * MiB;
constexpr size_t WS_YS = 592 * MiB;
constexpr size_t WS_END = 736 * MiB;
constexpr size_t WS_WRT = WS_TAB;
constexpr size_t WS_SLOT = WS_TAB + 256 * 1024;
constexpr size_t WS_GATE = WS_TAB + 512 * 1024;
constexpr size_t WS_ROWTOK = WS_TAB + 1 * MiB;
constexpr int CW_BAR = 4096;
constexpr int CW_CNT = 16384;

constexpr int RING_OFF = 0, RING_BYTES = 131072;
constexpr int LDSCTL_OFF = 152576;
constexpr int MISC_OFF = LDSCTL_OFF + 320;
constexpr int TAB_OFF = LDSCTL_OFF + 1024;
constexpr int SB_OFF = LDSCTL_OFF + 2048;
constexpr int LDS_BYTES = 163840;

#define GAS __attribute__((address_space(1)))
#define LAS __attribute__((address_space(3)))
typedef unsigned short bf16;
typedef unsigned v4u __attribute__((ext_vector_type(4)));
typedef unsigned v2u __attribute__((ext_vector_type(2)));
typedef float f32x4 __attribute__((ext_vector_type(4)));
typedef GAS unsigned gu32;
#define RLX_AGENT __ATOMIC_RELAXED, __HIP_MEMORY_SCOPE_AGENT
#define LDS_WAIT() asm volatile("s_waitcnt lgkmcnt(0)" ::: "memory")
#define VM_WAIT() asm volatile("s_waitcnt vmcnt(0)" ::: "memory")

__device__ __forceinline__ float bf2f(unsigned b) { return __uint_as_float(b << 16); }
typedef __bf16 bf16x2_t __attribute__((ext_vector_type(2)));
typedef float f32x2_t __attribute__((ext_vector_type(2)));
__device__ __forceinline__ unsigned pk2(float lo, float hi) { const bf16x2_t r = __builtin_convertvector((f32x2_t){lo, hi}, bf16x2_t); return __builtin_bit_cast(unsigned, r); }
__device__ __forceinline__ float sigm(float x) { return __builtin_amdgcn_rcpf(1.0f + __expf(-x)); }
__device__ __forceinline__ float wave_sum(float v) {
#pragma unroll
    for (int o = 1; o < 64; o <<= 1) v += __shfl_xor(v, o);
    return v;
}

constexpr float SC_W = 512.f, SC_N2 = 16.f, SC_ACT = 8.f, SC_YS = 32.f;
__device__ __forceinline__ unsigned pk4_fp8(float a, float b, float c, float d) {
    a = fminf(fmaxf(a, -448.f), 448.f); b = fminf(fmaxf(b, -448.f), 448.f); c = fminf(fmaxf(c, -448.f), 448.f); d = fminf(fmaxf(d, -448.f), 448.f);
    int w = 0; w = __builtin_amdgcn_cvt_pk_fp8_f32(a, b, w, false); w = __builtin_amdgcn_cvt_pk_fp8_f32(c, d, w, true); return (unsigned)w;
}

#define XB_TMO      128
#define XB_XCNT(j)  (256  + 64 * (j))
#define XB_XSUB(j)  (1280 + 64 * (j))
#define XB_XGEN(j)  (2304 + 64 * (j))
#define XB_TOP      3328
#define XB_TOPGEN   3392
#define XCD_BAR_WORDS 3456
#define XB_SPIN_CAP (1u << 18)

__device__ __forceinline__ unsigned xb_ld(unsigned* p)              { return __hip_atomic_load(p, __ATOMIC_RELAXED, __HIP_MEMORY_SCOPE_AGENT); }
__device__ __forceinline__ unsigned xb_add(unsigned* p, unsigned v) { return __hip_atomic_fetch_add(p, v, __ATOMIC_RELAXED, __HIP_MEMORY_SCOPE_AGENT); }
__device__ __forceinline__ unsigned xb_xcc_id() { return (unsigned)__builtin_amdgcn_s_getreg((3 << 11) | 20) & 0xFu; }
#define XB_SPIN(cond, bar) do { unsigned _sp = 0; while (cond) { __builtin_amdgcn_s_sleep(1); \
    if ((++_sp & 255u) == 0u) { if (xb_ld(&(bar)[XB_TMO])) break; if (_sp > XB_SPIN_CAP) { atomicAdd(&(bar)[XB_TMO], 1u); break; } } } } while (0)

struct XcdBarrier {
    unsigned* bar; unsigned x;
    volatile LAS unsigned* st;
};
__device__ __forceinline__ XcdBarrier xcd_barrier_post(unsigned* bar, volatile LAS unsigned* st) {
    XcdBarrier b; b.bar = bar; b.x = xb_xcc_id(); b.st = st;
    if (threadIdx.x == 0) (void)xb_add(&bar[XB_XCNT(b.x)], 1u);
    return b;
}
__device__ __forceinline__ void xcd_barrier_complete(unsigned* bar, unsigned x, unsigned& nloc, unsigned& nx) {
    const unsigned G = gridDim.x * gridDim.y * gridDim.z;
    unsigned sum, cnt, mine, sp = 0u;
    for (;;) {
        sum = 0u; cnt = 0u; mine = 0u;
#pragma unroll
        for (unsigned j = 0; j < 16; ++j) { const unsigned c = xb_ld(&bar[XB_XCNT(j)]); sum += c; cnt += (c > 0u) ? 1u : 0u; mine = (j == x) ? c : mine; }
        if (sum == G) break;
        __builtin_amdgcn_s_sleep(1);
        if ((++sp & 255u) == 0u) { if (xb_ld(&bar[XB_TMO])) break; if (sp > XB_SPIN_CAP) { atomicAdd(&bar[XB_TMO], 1u); break; } }
    }
    nloc = mine > 0u ? mine : 1u; nx = cnt > 0u ? cnt : 1u;
}
__device__ __forceinline__ void xcd_barrier(const XcdBarrier& b) {
    asm volatile("s_waitcnt vmcnt(0)" ::: "memory");
    __syncthreads();
    if (threadIdx.x == 0) {
        unsigned* bar = b.bar;
        __builtin_amdgcn_s_waitcnt(0);
        unsigned nloc = b.st[0], nx = b.st[1];
        if (nloc == 0u) { xcd_barrier_complete(bar, b.x, nloc, nx); b.st[0] = nloc; b.st[1] = nx; }
        const unsigned old = xb_add(&bar[XB_XSUB(b.x)], 1u);
        const unsigned gen = old / nloc;
        if (old + 1u == (gen + 1u) * nloc) {
            __builtin_amdgcn_fence(__ATOMIC_RELEASE, "agent");
            asm volatile("s_waitcnt vmcnt(0)" ::: "memory");
            const unsigned og = xb_add(&bar[XB_TOP], 1u);
            const unsigned tg = og / nx;
            if (og + 1u == (tg + 1u) * nx) xb_add(&bar[XB_TOPGEN], 1u);
            else XB_SPIN(xb_ld(&bar[XB_TOPGEN]) == tg, bar);
            __builtin_amdgcn_fence(__ATOMIC_ACQUIRE, "agent");
            xb_add(&bar[XB_XGEN(b.x)], 1u);
            asm volatile("s_waitcnt vmcnt(0)" ::: "memory");
        } else {
            XB_SPIN(xb_ld(&bar[XB_XGEN(b.x)]) == gen, bar);
            __builtin_amdgcn_fence(__ATOMIC_ACQUIRE, "agent");
            asm volatile("s_waitcnt vmcnt(0)" ::: "memory");
        }
    }
    __syncthreads();
}

#ifndef WT_STORES
#define WT_STORES 0
#endif
__device__ __forceinline__ void st16(void* p, v4u w) {
#if WT_STORES
    asm volatile("global_store_dwordx4 %0, %1, off sc0 sc1\n\ts_nop 1" :: "v"(p), "v"(w) : "memory");
#else
    *(v4u*)p = w;
#endif
}
__device__ __forceinline__ void st8(void* p, v2u w) {
#if WT_STORES
    asm volatile("global_store_dwordx2 %0, %1, off sc0 sc1\n\ts_nop 1" :: "v"(p), "v"(w) : "memory");
#else
    *(v2u*)p = w;
#endif
}
__device__ __forceinline__ void st8bf(bf16* p, const f32x4& a, const f32x4& b) {
    v4u w; w.x = pk2(a[0], a[1]); w.y = pk2(a[2], a[3]); w.z = pk2(b[0], b[1]); w.w = pk2(b[2], b[3]);
    st16(p, w);
}
struct EpiProj {
    static constexpr bool PERM = true, AFTER_DRAIN = false;
    bf16 *Q, *KF, *KB, *V, *G, *U; float *LF, *LB; const float* lbl;
    template <int TYP>
    __device__ __forceinline__ void tile(const pg8::f32x4 (&acc)[2][2][4][2], int row0, int cb) const {
#pragma unroll
        for (int bj = 0; bj < 2; ++bj) {
            const int col = cb + bj * 128;
            float lb[8];
            if (TYP == 1 || TYP == 2) {
                const float* L = lbl + (TYP - 1) * 1024 + col;
#pragma unroll
                for (int i = 0; i < 8; ++i) lb[i] = __builtin_amdgcn_rcpf(1.0f + __expf(L[512 + i] - L[i]));
            }
#pragma unroll
            for (int ai = 0; ai < 2; ++ai)
#pragma unroll
                for (int m = 0; m < 4; ++m) {
                    const size_t off = (size_t)(row0 + ai * 128 + m * 16) * 512 + col;
                    f32x4 a = acc[ai][bj][m][0], b = acc[ai][bj][m][1];
                    if (TYP == 0 || TYP == 4) {
#pragma unroll
                        for (int i = 0; i < 4; ++i) { a[i] = a[i] * sigm(a[i]); b[i] = b[i] * sigm(b[i]); }
                        st8bf((TYP == 0 ? Q : G) + off, a, b);
                    } else if (TYP == 3) {
                        st8bf(V + off, a, b);
                    } else {
                        f32x4 la, lbv, ka, kb;
#pragma unroll
                        for (int i = 0; i < 4; ++i) {
                            const float fa = lb[i] + (1.0f - lb[i]) * sigm(a[i]), fb = lb[4 + i] + (1.0f - lb[4 + i]) * sigm(b[i]);
                            la[i] = __logf(fa); lbv[i] = __logf(fb); ka[i] = 1.0f - fa; kb[i] = 1.0f - fb;
                        }
                        float* Lp = (TYP == 1 ? LF : LB) + off;
                        st16(Lp, (v4u)la); st16(Lp + 4, (v4u)lbv);
                        st8bf((TYP == 1 ? KF : KB) + off, ka, kb);
                    }
                }
        }
    }
    __device__ __forceinline__ void operator()(const pg8::f32x4 (&acc)[2][2][4][2], const pg8::Unit& u, int wr, int wc, int fr, int fq) const {
        const int row0 = u.pm * 256 + wr * 64 + fr, pn = u.pn;
        if (pn >= 10) {
            const int col = (pn - 10) * 128 + wc * 32 + 8 * fq;
#pragma unroll
            for (int ai = 0; ai < 2; ++ai)
#pragma unroll
                for (int m = 0; m < 4; ++m) {
                    f32x4 a = acc[ai][0][m][0], b = acc[ai][0][m][1]; const f32x4 ga = acc[ai][1][m][0], gb = acc[ai][1][m][1];
#pragma unroll
                    for (int i = 0; i < 4; ++i) { a[i] = a[i] * sigm(ga[i]); b[i] = b[i] * sigm(gb[i]); }
                    st8bf(U + (size_t)(row0 + ai * 128 + m * 16) * 512 + col, a, b);
                }
        } else {
            const int cb = (pn & 1) * 256 + wc * 32 + 8 * fq, typ = pn >> 1;
            if (typ == 0) tile<0>(acc, row0, cb);
            else if (typ == 1) tile<1>(acc, row0, cb);
            else if (typ == 2) tile<2>(acc, row0, cb);
            else if (typ == 3) tile<3>(acc, row0, cb);
            else tile<4>(acc, row0, cb);
        }
    }
};
struct EpiRes {
    static constexpr bool PERM = false, AFTER_DRAIN = false;
    const float* X; float* H;
    __device__ __forceinline__ void operator()(const pg8::f32x4 (&acc)[2][2][4][2], const pg8::Unit& u, int wr, int wc, int fr, int fq) const {
        const int row0 = u.pm * 256 + wr * 64 + fr, col0 = u.pn * 256 + wc * 32 + 4 * fq;
#pragma unroll
        for (int ai = 0; ai < 2; ++ai)
#pragma unroll
            for (int m = 0; m < 4; ++m) {
                const size_t off = (size_t)(row0 + ai * 128 + m * 16) * D + col0;
#pragma unroll
                for (int bj = 0; bj < 2; ++bj)
#pragma unroll
                    for (int n = 0; n < 2; ++n) { const f32x4 xv = *(const f32x4*)(X + off + bj * 128 + n * 16); st16(H + off + bj * 128 + n * 16, (v4u)(xv + acc[ai][bj][m][n])); }
            }
    }
};
struct EpiSwiglu {
    static constexpr bool PERM = true, AFTER_DRAIN = false;
    unsigned char* ACT; const float* b1;
    __device__ __forceinline__ void operator()(const pg8::f32x4 (&acc)[2][2][4][2], const pg8::Unit& u, int wr, int wc, int fr, int fq) const {
        const int e = u.pn >> 3, pn = u.pn & 7, row0 = u.pm * 256 + wr * 64 + fr, col = pn * 128 + wc * 32 + 8 * fq;
        const float* bg = b1 + (size_t)e * 2048 + col; const float* bl = bg + 1024;
        float g[8], l[8];
#pragma unroll
        for (int i = 0; i < 8; ++i) { g[i] = bg[i]; l[i] = bl[i]; }
#pragma unroll
        for (int ai = 0; ai < 2; ++ai)
#pragma unroll
            for (int m = 0; m < 4; ++m) {
                f32x4 o[2];
#pragma unroll
                for (int n = 0; n < 2; ++n)
#pragma unroll
                    for (int i = 0; i < 4; ++i) {
                        const float hg = fminf(acc[ai][0][m][n][i] * (1.0f / (SC_N2 * SC_W)) + g[4 * n + i], SW_LIMIT);
                        const float hl = fminf(fmaxf(acc[ai][1][m][n][i] * (1.0f / (SC_N2 * SC_W)) + l[4 * n + i], -SW_LIMIT), SW_LIMIT);
                        o[n][i] = hg * sigm(SW_ALPHA * hg) * (hl + 1.0f) * SC_ACT;
                    }
                v2u w; w.x = pk4_fp8(o[0][0], o[0][1], o[0][2], o[0][3]); w.y = pk4_fp8(o[1][0], o[1][1], o[1][2], o[1][3]);
#if defined(MOE_MERGED)
                asm volatile("global_store_dwordx2 %0, %1, off sc0 sc1\n\ts_nop 1" :: "v"(ACT + (size_t)(row0 + ai * 128 + m * 16) * FF + col), "v"(w) : "memory");
#else
                st8(ACT + (size_t)(row0 + ai * 128 + m * 16) * FF + col, w);
#endif
            }
    }
};
struct EpiDown {
    static constexpr bool PERM = true, AFTER_DRAIN = false;
    unsigned char* YS; const float* b2;
    __device__ __forceinline__ void operator()(const pg8::f32x4 (&acc)[2][2][4][2], const pg8::Unit& u, int wr, int wc, int fr, int fq) const {
        const int e = u.pn >> 2, pn = u.pn & 3, row0 = u.pm * 256 + wr * 64 + fr, col0 = pn * 256 + wc * 32 + 8 * fq;
#pragma unroll
        for (int bj = 0; bj < 2; ++bj) {
            const float* bp = b2 + (size_t)e * D + col0 + bj * 128;
            const f32x4 b0 = *(const f32x4*)bp, b1v = *(const f32x4*)(bp + 4);
#pragma unroll
            for (int ai = 0; ai < 2; ++ai)
#pragma unroll
                for (int m = 0; m < 4; ++m)
                    { const f32x4 y0 = (acc[ai][bj][m][0] * (1.0f / (SC_ACT * SC_W)) + b0) * SC_YS, y1 = (acc[ai][bj][m][1] * (1.0f / (SC_ACT * SC_W)) + b1v) * SC_YS;
                      v2u w; w.x = pk4_fp8(y0[0], y0[1], y0[2], y0[3]); w.y = pk4_fp8(y1[0], y1[1], y1[2], y1[3]); st8(YS + (size_t)(row0 + ai * 128 + m * 16) * D + col0 + bj * 128, w); }
        }
    }
};
struct MoeOrder {
    const volatile LAS int* bs; int ntn, G, v; const volatile LAS int* cl; const int* rowtok;
    __device__ __forceinline__ const int* a_list(const pg8::Unit& u) const { const int e = u.pn / ntn; return rowtok + e * MTOK + (u.pm - bs[e]) * 256; }
    __device__ __forceinline__ int a_valid(const pg8::Unit& u) const { const int e = u.pn / ntn; return min(256, cl[e] - (u.pm - bs[e]) * 256); }
    __device__ __forceinline__ bool next(int i, pg8::Unit& u) const {
        int L = i * G + v; const int nb = bs[32];
        if (L >= nb * ntn * (((PROBE_DUP) == 17 && ntn == 8) || ((PROBE_DUP) == 18 && ntn == 4) ? 2 : 1)) return false;
        if (L >= nb * ntn) L -= nb * ntn;
        const int mb = L / ntn, pn = L - mb * ntn;
        const int ln = (int)(threadIdx.x & 63);
        const int e = __popcll(__ballot(ln < NE - 1 && bs[ln + 1] <= mb));
        u.pm = mb; u.pn = e * ntn + pn; return true;
    }
    __device__ __forceinline__ bool a_is_list(const pg8::Unit&) const { return true; }
    __device__ __forceinline__ unsigned a_base(const pg8::Unit&) const { return 0u; }
    __device__ __forceinline__ int a_row0(const pg8::Unit&) const { return 0; }
    __device__ __forceinline__ void a_ready(const pg8::Unit&) const {}
    __device__ __forceinline__ void done(const pg8::Unit&) const {}
    __device__ __forceinline__ int done_defer(const pg8::Unit&) const { return -1; }
    __device__ __forceinline__ void done_signal(int) const {}
};
constexpr int CW_BLK = 32768;
struct MoeOrder2 {
    const volatile LAS int* bs; int G, v; const volatile LAS int* cl; const int* rowtok; unsigned* ctl;
    __device__ __forceinline__ bool is_down(const pg8::Unit& u) const { return u.pn >= 512; }
    __device__ __forceinline__ int expert(const pg8::Unit& u) const { return is_down(u) ? (u.pn - 512) >> 2 : u.pn >> 3; }
    __device__ __forceinline__ bool a_is_list(const pg8::Unit& u) const { return !is_down(u); }
    __device__ __forceinline__ unsigned a_base(const pg8::Unit& u) const { return is_down(u) ? (unsigned)WS_ACT : (unsigned)WS_XN; }
    __device__ __forceinline__ int a_row0(const pg8::Unit& u) const { return u.pm * 256; }
    __device__ __forceinline__ const int* a_list(const pg8::Unit& u) const { const int e = expert(u); return rowtok + e * MTOK + (u.pm - bs[e]) * 256; }
    __device__ __forceinline__ int a_valid(const pg8::Unit& u) const { const int e = expert(u); return min(256, cl[e] - (u.pm - bs[e]) * 256); }
    __device__ __forceinline__ bool next(int i, pg8::Unit& u) const {
        const int L = i * G + v, nb = bs[32];
        if (L >= nb * 12) return false;
        const bool dn = L >= nb * 8; const int L2 = dn ? L - nb * 8 : L, ntn = dn ? 4 : 8;
        const int mb = L2 / ntn, pn = L2 - mb * ntn;
        const int ln = (int)(threadIdx.x & 63);
        const int e = __popcll(__ballot(ln < NE - 1 && bs[ln + 1] <= mb));
        u.pm = mb; u.pn = (dn ? 512 : 0) + e * ntn + pn; return true;
    }
    __device__ __forceinline__ void a_ready(const pg8::Unit& u) const {
        if (!is_down(u)) return;
        if (threadIdx.x < 64) {
            const unsigned long long t0 = __builtin_amdgcn_s_memrealtime(); unsigned polls = 0;
            while ((unsigned)__builtin_amdgcn_readfirstlane(__hip_atomic_load(ctl + CW_BLK + 64 * u.pm, __ATOMIC_RELAXED, __HIP_MEMORY_SCOPE_AGENT)) < 64u) {
                if ((++polls & 255u) == 0u && __builtin_amdgcn_readfirstlane(__hip_atomic_load(ctl + 1, __ATOMIC_RELAXED, __HIP_MEMORY_SCOPE_AGENT)) != 0u) break;
                if (__builtin_amdgcn_s_memrealtime() - t0 > 2000000ull) { if (threadIdx.x == 0) __hip_atomic_store(ctl + 1, 1u, __ATOMIC_RELAXED, __HIP_MEMORY_SCOPE_AGENT); break; }
                __builtin_amdgcn_s_sleep(2); }
            __builtin_amdgcn_fence(__ATOMIC_ACQUIRE, "agent");
            asm volatile("s_waitcnt vmcnt(0)" ::: "memory");
        }
        asm volatile("" ::: "memory"); __builtin_amdgcn_s_barrier(); asm volatile("" ::: "memory");
    }
    __device__ __forceinline__ void done(const pg8::Unit&) const {}
    __device__ __forceinline__ int done_defer(const pg8::Unit& u) const { return is_down(u) ? -1 : u.pm; }
    __device__ __forceinline__ void done_signal(int mb) const { if ((threadIdx.x & 63) == 0) __hip_atomic_fetch_add(ctl + CW_BLK + 64 * mb, 1u, __ATOMIC_RELAXED, __HIP_MEMORY_SCOPE_AGENT); }
};
struct EpiMoe {
    static constexpr bool PERM = true, AFTER_DRAIN = false;
    EpiSwiglu up; EpiDown down;
    __device__ __forceinline__ void operator()(const pg8::f32x4 (&acc)[2][2][4][2], const pg8::Unit& u, int wr, int wc, int fr, int fq) const {
        if (u.pn >= 512) { pg8::Unit d; d.pm = u.pm; d.pn = u.pn - 512; down(acc, d, wr, wc, fr, fq); } else up(acc, u, wr, wc, fr, fq);
    }
};

#ifndef PROBE_DUP
#define PROBE_DUP -1
#endif
struct OrderRep : pg8::StaticOrder {
    int reps;
    __device__ __forceinline__ bool next(int i, pg8::Unit& u) const {
        const int per = (nwg + G - 1) / G, r = i / per;
        if (r >= reps) return false;
        return pg8::StaticOrder::next(i - r * per, u) ? true : ((r + 1 < reps) ? pg8::StaticOrder::next(0, u) : false);
    }
};
struct RmIdent { __device__ __forceinline__ int operator()(int n) const { return n; } };
struct RmWin {
    __device__ __forceinline__ int operator()(int n) const {
        if (n < 2560) return n;
        if (n < 3072) { const int j = n - 2560; return 2560 + (j >> 7) * 256 + (j & 127); }
        const int j = n - 3072; return 2560 + (j >> 7) * 256 + 128 + (j & 127);
    }
};
struct RmW1 {
    __device__ __forceinline__ int operator()(int n) const {
        if (n < 1024) return (n >> 7) * 256 + (n & 127);
        const int j = n - 1024; return (j >> 7) * 256 + 128 + (j & 127);
    }
};
__device__ __forceinline__ void p0_load(const float* W, int N, int item, int lane, f32x4 (&v)[8]) {
    const int nblk = N / 32, kb = item / nblk, nb = item % nblk, k0 = 64 * kb, n0 = 32 * nb;
    const int r8 = lane >> 3, c4 = lane & 7;
#pragma unroll
    for (int i = 0; i < 8; ++i) v[i] = *(const f32x4*)(W + (size_t)(k0 + 8 * i + r8) * N + n0 + 4 * c4);
}
template <bool FP8OUT, class RM>
__device__ __forceinline__ void p0_finish(const f32x4 (&v)[8], int K, int N, void* WTv, RM rm, LAS float* scr, int item, int lane) {
    const int nblk = N / 32, kb = item / nblk, nb = item % nblk, k0 = 64 * kb, n0 = 32 * nb;
    const int r8 = lane >> 3, c4 = lane & 7;
#pragma unroll
    for (int i = 0; i < 8; ++i) *(LAS f32x4*)(scr + (8 * i + r8) * 36 + 4 * c4) = v[i];
    LDS_WAIT(); asm volatile("" ::: "memory");
    const int n = lane & 31, kh = lane >> 5; const LAS float* s = scr + (32 * kh) * 36 + n;
    if constexpr (FP8OUT) {
        unsigned w[8];
#pragma unroll
        for (int j = 0; j < 8; ++j) w[j] = pk4_fp8(s[(4 * j) * 36] * SC_W, s[(4 * j + 1) * 36] * SC_W, s[(4 * j + 2) * 36] * SC_W, s[(4 * j + 3) * 36] * SC_W);
        GAS v4u* dst = (GAS v4u*)((unsigned char*)WTv + (size_t)rm(n0 + n) * K + k0 + 32 * kh);
        dst[0] = (v4u){w[0], w[1], w[2], w[3]}; dst[1] = (v4u){w[4], w[5], w[6], w[7]};
    } else {
        unsigned w[16];
#pragma unroll
        for (int j = 0; j < 16; ++j) w[j] = pk2(s[(2 * j) * 36], s[(2 * j + 1) * 36]);
        GAS v4u* dst = (GAS v4u*)((bf16*)WTv + (size_t)rm(n0 + n) * K + k0 + 32 * kh);
#pragma unroll
        for (int q = 0; q < 4; ++q) dst[q] = (v4u){w[4 * q], w[4 * q + 1], w[4 * q + 2], w[4 * q + 3]};
    }
    LDS_WAIT(); asm volatile("" ::: "memory");
}
template <bool FP8OUT, class RM>
__device__ __forceinline__ void p0_item(const float* W, int K, int N, void* WTv, RM rm, LAS float* scr, int item, int lane) {
    f32x4 v[8]; p0_load(W, N, item, lane, v); p0_finish<FP8OUT>(v, K, N, WTv, rm, scr, item, lane);
}
template <class RM>
__device__ __forceinline__ void convert_range_fp8(const float* W, int K, int N, unsigned char* WT, RM rm, int ipe_log2, int first, int stride, int count, int base, LAS float* scr, int lane) {
    const size_t esz = (size_t)K * N; const int mask = (1 << ipe_log2) - 1;
    f32x4 va[8], vb[8];
    int it = first;
    if (it < count) p0_load(W + (size_t)((base + it) >> ipe_log2) * esz, N, (base + it) & mask, lane, va);
    while (it < count) {
        const int i1 = it + stride, i2 = it + 2 * stride;
        if (i1 < count) p0_load(W + (size_t)((base + i1) >> ipe_log2) * esz, N, (base + i1) & mask, lane, vb);
        p0_finish<true>(va, K, N, WT + (size_t)((base + it) >> ipe_log2) * esz, rm, scr, (base + it) & mask, lane);
        if (i1 >= count) break;
        if (i2 < count) p0_load(W + (size_t)((base + i2) >> ipe_log2) * esz, N, (base + i2) & mask, lane, va);
        p0_finish<true>(vb, K, N, WT + (size_t)((base + i1) >> ipe_log2) * esz, rm, scr, (base + i1) & mask, lane);
        it = i2;
    }
}
__device__ __forceinline__ void rms_row_to_bf16(const float* xrow, const float* w, bf16* orow, int lane) {
    const f32x4* xr = (const f32x4*)xrow + lane; const f32x4* wr = (const f32x4*)w + lane;
    f32x4 v[4]; float s = 0.f;
#pragma unroll
    for (int j = 0; j < 4; ++j) { v[j] = xr[64 * j]; s += (v[j].x * v[j].x + v[j].y * v[j].y) + (v[j].z * v[j].z + v[j].w * v[j].w); }
    const float rstd = rsqrtf(wave_sum(s) * (1.f / D) + EPS);
    v2u* o8 = (v2u*)orow + lane;
#pragma unroll
    for (int j = 0; j < 4; ++j) { const f32x4 g = wr[64 * j]; v2u o; o.x = pk2(v[j].x * rstd * g.x, v[j].y * rstd * g.y); o.y = pk2(v[j].z * rstd * g.z, v[j].w * rstd * g.w); o8[64 * j] = o; }
}


__device__ __forceinline__ pg8::bf16x8 lds_frag(const LAS unsigned char* p) { return *(const LAS pg8::bf16x8*)p; }
__device__ __forceinline__ pg8::bf16x8 mk_frag(v2u a, v2u b) { const v4u w = (v4u){a.x, a.y, b.x, b.y}; return (pg8::bf16x8)w; }
#ifndef PROBE_TID
#define PROBE_TID 0
#endif
#define HG_PSTAMP(lds_, n_, code_) do { if ((PROBE_STAMP) >= 660 && (PROBE_STAMP) <= 669 && (n_) == 5 && threadIdx.x == (PROBE_TID)) { \
        if ((code_) == 660) *(volatile LAS unsigned long long*)((lds_) + LDSCTL_OFF + 640) = __builtin_amdgcn_s_memrealtime(); \
        if ((code_) == (PROBE_STAMP)) *(volatile LAS unsigned long long*)((lds_) + LDSCTL_OFF + 648) = __builtin_amdgcn_s_memrealtime(); } } while (0)
struct HgCtx {
    LAS unsigned char* lds; const bf16 *Qb, *Kp, *Vb; const float* Lp; float* Op;
    int b, h, dir, vh, lane, wave, lr, lq, dA, seg, tauB, dg;
    unsigned offA[16], offB, offV, ke_tr, v_tr;
};
constexpr int HG_BF = 0, HG_AM = 0, HG_QI = 33792, HG_KK = 51200, HG_KE = 68608, HG_V = 86016, HG_ST = 95232, HG_SEG = 112640, HG_DEC = 114688;
constexpr int HG_RSD = 272, HG_RSS = 144, HG_RSBF = 528;
__device__ __forceinline__ void hgrn_load(const HgCtx& c, int n, float (&lf)[16], v4u (&qB)[2], v4u (&kB)[2], v4u& vB) {
    const size_t cb = (size_t)__builtin_amdgcn_readfirstlane(c.b * TT + (c.dir ? (TT / 64 - 1 - n) * 64 : n * 64)) * 512 + c.h * 128;
    const float* Lc = c.Lp + cb; const bf16* Qc = c.Qb + cb; const bf16* Kc = c.Kp + cb; const bf16* Vc = c.Vb + cb;
#pragma unroll
    for (int i = 0; i < 16; ++i) lf[i] = Lc[c.offA[i]];
    qB[0] = *(const v4u*)(Qc + c.offB); qB[1] = *(const v4u*)(Qc + c.offB + 8); kB[0] = *(const v4u*)(Kc + c.offB); kB[1] = *(const v4u*)(Kc + c.offB + 8);
    vB = *(const v4u*)(Vc + c.offV);
}
__device__ __forceinline__ void hgrn_chunk(const HgCtx& c, int n, float (&lf)[16], v4u (&qB)[2], v4u (&kB)[2], v4u& vB, f32x4 (&S)[4]) {
    LAS unsigned char* lds = c.lds;
    const int dir = c.dir, lr = c.lr, lq = c.lq, wave = c.wave, dA = c.dA, seg = c.seg, tauB = c.tauB, dg = c.dg;
    const int tb = c.b * TT + (dir ? (TT / 64 - 1 - n) * 64 : n * 64); HG_PSTAMP(lds, n, 660);
    float bl[16]; { float cs = 0.f;
#pragma unroll
        for (int i = 0; i < 16; ++i) { cs += lf[i]; bl[i] = cs; }
        *(LAS float*)(lds + HG_SEG + (seg * 128 + dA) * 4) = cs; }
    __syncthreads();
    HG_PSTAMP(lds, n, 661);
    {
        const float p0 = *(LAS float*)(lds + HG_SEG + (0 * 128 + dA) * 4), p1 = *(LAS float*)(lds + HG_SEG + (1 * 128 + dA) * 4),
                    p2 = *(LAS float*)(lds + HG_SEG + (2 * 128 + dA) * 4), p3 = *(LAS float*)(lds + HG_SEG + (3 * 128 + dA) * 4);
        const float pre = (seg > 0 ? p0 : 0.f) + (seg > 1 ? p1 : 0.f) + (seg > 2 ? p2 : 0.f);
#pragma unroll
        for (int i = 0; i < 16; ++i) *(LAS float*)(lds + HG_BF + (16 * seg + i) * HG_RSBF + dA * 4) = pre + bl[i];
        if (seg == 0) *(LAS float*)(lds + HG_DEC + dA * 4) = __expf((p0 + p1) + (p2 + p3));
    }
    __syncthreads();
    HG_PSTAMP(lds, n, 662);
    {
        const unsigned qw[8] = {qB[0].x, qB[0].y, qB[0].z, qB[0].w, qB[1].x, qB[1].y, qB[1].z, qB[1].w};
        const unsigned kw[8] = {kB[0].x, kB[0].y, kB[0].z, kB[0].w, kB[1].x, kB[1].y, kB[1].z, kB[1].w};
        unsigned qo[8], ko[8], eo[8];
#pragma unroll
        for (int i = 0; i < 4; ++i) {
            const f32x4 bb = *(const LAS f32x4*)(lds + HG_BF + tauB * HG_RSBF + dg * 64 + i * 16);
            const f32x4 dc = *(const LAS f32x4*)(lds + HG_DEC + dg * 64 + i * 16);
#pragma unroll
            for (int j = 0; j < 2; ++j) {
                const float e0 = __expf(bb[2 * j]), e1 = __expf(bb[2 * j + 1]);
                const unsigned qq = qw[2 * i + j], kk = kw[2 * i + j];
                const float k0 = bf2f(kk & 0xffffu) * __builtin_amdgcn_rcpf(e0), k1 = bf2f(kk >> 16) * __builtin_amdgcn_rcpf(e1);
                qo[2 * i + j] = pk2(bf2f(qq & 0xffffu) * e0, bf2f(qq >> 16) * e1);
                ko[2 * i + j] = pk2(k0, k1);
                eo[2 * i + j] = pk2(k0 * dc[2 * j], k1 * dc[2 * j + 1]);
            }
        }
        *(LAS v4u*)(lds + HG_QI + tauB * HG_RSD + dg * 32) = (v4u){qo[0], qo[1], qo[2], qo[3]}; *(LAS v4u*)(lds + HG_QI + tauB * HG_RSD + dg * 32 + 16) = (v4u){qo[4], qo[5], qo[6], qo[7]};
        *(LAS v4u*)(lds + HG_KK + tauB * HG_RSD + dg * 32) = (v4u){ko[0], ko[1], ko[2], ko[3]}; *(LAS v4u*)(lds + HG_KK + tauB * HG_RSD + dg * 32 + 16) = (v4u){ko[4], ko[5], ko[6], ko[7]};
        *(LAS v4u*)(lds + HG_KE + tauB * HG_RSD + dg * 32) = (v4u){eo[0], eo[1], eo[2], eo[3]}; *(LAS v4u*)(lds + HG_KE + tauB * HG_RSD + dg * 32 + 16) = (v4u){eo[4], eo[5], eo[6], eo[7]};
        *(LAS v4u*)(lds + HG_V + tauB * HG_RSS + dg * 16) = vB;
    }
    __syncthreads();
    HG_PSTAMP(lds, n, 663);
    if (n + 2 < TT / 64) hgrn_load(c, n + 2, lf, qB, kB, vB);
    HG_PSTAMP(lds, n, 666);
    const int ei = wave & 3, tp = wave >> 2;
    v2u ket[2][2], vt[4][2][2];
    asm volatile("ds_read_b64_tr_b16 %0, %4\n\tds_read_b64_tr_b16 %1, %4 offset:1088\n\tds_read_b64_tr_b16 %2, %4 offset:8704\n\tds_read_b64_tr_b16 %3, %4 offset:9792"
                 : "=&v"(ket[0][0]), "=&v"(ket[0][1]), "=&v"(ket[1][0]), "=&v"(ket[1][1]) : "v"(c.ke_tr) : "memory");
#define HG_VTR(e4, o0, o1, o2, o3) asm volatile("ds_read_b64_tr_b16 %0, %4 offset:" #o0 "\n\tds_read_b64_tr_b16 %1, %4 offset:" #o1 "\n\tds_read_b64_tr_b16 %2, %4 offset:" #o2 "\n\tds_read_b64_tr_b16 %3, %4 offset:" #o3 \
                 : "=&v"(vt[e4][0][0]), "=&v"(vt[e4][0][1]), "=&v"(vt[e4][1][0]), "=&v"(vt[e4][1][1]) : "v"(c.v_tr) : "memory")
    HG_VTR(0, 0, 576, 4608, 5184); HG_VTR(1, 32, 608, 4640, 5216); HG_VTR(2, 64, 640, 4672, 5248); HG_VTR(3, 96, 672, 4704, 5280);
#undef HG_VTR
    {
        const int ti = wave & 3;
#pragma unroll
        for (int sii = 0; sii < 2; ++sii) {
            const int si = tp * 2 + sii;
            v2u w = (v2u){0u, 0u};
            if (si <= ti) {
                f32x4 a = (f32x4){0.f, 0.f, 0.f, 0.f};
#pragma unroll
                for (int kk = 0; kk < 4; ++kk)
                    a = __builtin_amdgcn_mfma_f32_16x16x32_bf16(lds_frag(lds + HG_KK + (16 * si + lr) * HG_RSD + kk * 64 + lq * 16), lds_frag(lds + HG_QI + (16 * ti + lr) * HG_RSD + kk * 64 + lq * 16), a, 0, 0, 0);
                const int s0 = 16 * si + 4 * lq, t = 16 * ti + lr;
                w.x = pk2(s0 + 0 <= t ? a[0] : 0.f, s0 + 1 <= t ? a[1] : 0.f); w.y = pk2(s0 + 2 <= t ? a[2] : 0.f, s0 + 3 <= t ? a[3] : 0.f);
            }
            *(LAS v2u*)(lds + HG_AM + (16 * ti + lr) * HG_RSS + (16 * si + 4 * lq) * 2) = w;
        }
    }
    f32x4 o[2];
#pragma unroll
    for (int tt = 0; tt < 2; ++tt) {
        o[tt] = (f32x4){0.f, 0.f, 0.f, 0.f};
#pragma unroll
        for (int kk = 0; kk < 4; ++kk)
            o[tt] = __builtin_amdgcn_mfma_f32_16x16x32_bf16(lds_frag(lds + HG_ST + (16 * ei + lr) * HG_RSD + kk * 64 + lq * 16), lds_frag(lds + HG_QI + (16 * (2 * tp + tt) + lr) * HG_RSD + kk * 64 + lq * 16), o[tt], 0, 0, 0);
    }
    HG_PSTAMP(lds, n, 667);
    asm volatile("s_waitcnt lgkmcnt(0)"
                 : "+v"(ket[0][0]), "+v"(ket[0][1]), "+v"(ket[1][0]), "+v"(ket[1][1]),
                   "+v"(vt[0][0][0]), "+v"(vt[0][0][1]), "+v"(vt[0][1][0]), "+v"(vt[0][1][1]), "+v"(vt[1][0][0]), "+v"(vt[1][0][1]), "+v"(vt[1][1][0]), "+v"(vt[1][1][1]),
                   "+v"(vt[2][0][0]), "+v"(vt[2][0][1]), "+v"(vt[2][1][0]), "+v"(vt[2][1][1]), "+v"(vt[3][0][0]), "+v"(vt[3][0][1]), "+v"(vt[3][1][0]), "+v"(vt[3][1][1]) :: "memory");
    {
        const f32x4 dv = *(const LAS f32x4*)(lds + HG_DEC + (16 * wave + 4 * lq) * 4);
#pragma unroll
        for (int e4 = 0; e4 < 4; ++e4) S[e4] = S[e4] * dv;
#pragma unroll
        for (int kk = 0; kk < 2; ++kk) {
            const pg8::bf16x8 af = mk_frag(ket[kk][0], ket[kk][1]);
#pragma unroll
            for (int e4 = 0; e4 < 4; ++e4) S[e4] = __builtin_amdgcn_mfma_f32_16x16x32_bf16(af, mk_frag(vt[e4][kk][0], vt[e4][kk][1]), S[e4], 0, 0, 0);
        }
    }
    HG_PSTAMP(lds, n, 668);
    const pg8::bf16x8 vf0 = ei == 0 ? mk_frag(vt[0][0][0], vt[0][0][1]) : ei == 1 ? mk_frag(vt[1][0][0], vt[1][0][1]) : ei == 2 ? mk_frag(vt[2][0][0], vt[2][0][1]) : mk_frag(vt[3][0][0], vt[3][0][1]);
    const pg8::bf16x8 vf1 = ei == 0 ? mk_frag(vt[0][1][0], vt[0][1][1]) : ei == 1 ? mk_frag(vt[1][1][0], vt[1][1][1]) : ei == 2 ? mk_frag(vt[2][1][0], vt[2][1][1]) : mk_frag(vt[3][1][0], vt[3][1][1]);
    __syncthreads();
    HG_PSTAMP(lds, n, 664);
#pragma unroll
    for (int tt = 0; tt < 2; ++tt) {
        o[tt] = __builtin_amdgcn_mfma_f32_16x16x32_bf16(vf0, lds_frag(lds + HG_AM + (16 * (2 * tp + tt) + lr) * HG_RSS + 0 * 64 + lq * 16), o[tt], 0, 0, 0);
        o[tt] = __builtin_amdgcn_mfma_f32_16x16x32_bf16(vf1, lds_frag(lds + HG_AM + (16 * (2 * tp + tt) + lr) * HG_RSS + 1 * 64 + lq * 16), o[tt], 0, 0, 0);
        const int t = 16 * (2 * tp + tt) + lr;
        { v2u ow; ow.x = pk2(o[tt][0], o[tt][1]); ow.y = pk2(o[tt][2], o[tt][3]);
          *(v2u*)((bf16*)c.Op + (size_t)(dir ? tb + 63 - t : tb + t) * 512 + c.h * 128 + c.vh * 64 + 16 * ei + 4 * lq) = ow; }
    }
#pragma unroll
    for (int e4 = 0; e4 < 4; ++e4) { v2u w; w.x = pk2(S[e4][0], S[e4][1]); w.y = pk2(S[e4][2], S[e4][3]); *(LAS v2u*)(lds + HG_ST + (16 * e4 + lr) * HG_RSD + (16 * wave + 4 * lq) * 2) = w; }
    HG_PSTAMP(lds, n, 665);
}
__device__ __forceinline__ void hgrn_unit(LAS unsigned char* lds, int unit, const bf16* Qb, const bf16* KFb, const bf16* KBb, const bf16* Vb, const float* LFb, const float* LBb,
                                          float* OFb, float* OBb, int tid, int lane, int wave) {
    HgCtx c;
    c.lds = lds; c.vh = unit & 1; c.dir = (unit >> 1) & 1; c.h = (unit >> 2) & 3; c.b = unit >> 4;
    c.Qb = Qb; c.Vb = Vb; c.Kp = c.dir ? KBb : KFb; c.Lp = c.dir ? LBb : LFb; c.Op = c.dir ? OBb : OFb;
    c.lane = lane; c.wave = wave; c.lr = lane & 15; c.lq = lane >> 4;
    c.dA = tid & 127; c.seg = tid >> 7;
    c.tauB = tid >> 3; c.dg = tid & 7;
    for (int i = tid; i < 64 * HG_RSD / 16; i += NTHR) *(LAS v4u*)(lds + HG_ST + i * 16) = (v4u){0u, 0u, 0u, 0u};
    f32x4 S[4];
#pragma unroll
    for (int i = 0; i < 4; ++i) S[i] = (f32x4){0.f, 0.f, 0.f, 0.f};
#pragma unroll
    for (int i = 0; i < 16; ++i) { const int tau = 16 * c.seg + i; c.offA[i] = (unsigned)((c.dir ? 63 - tau : tau) * 512 + c.dA); }
    c.offB = (unsigned)((c.dir ? 63 - c.tauB : c.tauB) * 512 + 16 * c.dg); c.offV = (unsigned)((c.dir ? 63 - c.tauB : c.tauB) * 512 + c.vh * 64 + 8 * c.dg);
    const unsigned trrow = (unsigned)(8 * c.lq + ((lane & 15) >> 2)), trcol = (unsigned)(4 * (lane & 3));
    c.ke_tr = (unsigned)(size_t)(lds + HG_KE) + trrow * HG_RSD + (16 * wave + trcol) * 2;
    c.v_tr = (unsigned)(size_t)(lds + HG_V) + trrow * HG_RSS + trcol * 2;
    float lf0[16], lf1[16]; v4u qB0[2], kB0[2], vB0, qB1[2], kB1[2], vB1;
    hgrn_load(c, 0, lf0, qB0, kB0, vB0); hgrn_load(c, 1, lf1, qB1, kB1, vB1);
#pragma unroll 1
    for (int n = 0; n < TT / 64; n += 2) { hgrn_chunk(c, n, lf0, qB0, kB0, vB0, S); hgrn_chunk(c, n + 1, lf1, qB1, kB1, vB1, S); }
    __syncthreads();
}

__device__ __forceinline__ void router_finish(float (&a)[NE], int m, int lane, const float* router_b, LAS int* lcnt, LAS unsigned* sbw, float* GATE) {
#define RF_STEP(s2, n) { const bool up = (lane & (s2)) != 0; _Pragma("unroll") for (int i = 0; i < (n); ++i) { const float k1 = up ? a[i + (n)] : a[i], x1 = up ? a[i] : a[i + (n)]; a[i] = k1 + __shfl_xor(x1, (s2)); } }
    RF_STEP(32, 16) RF_STEP(16, 8) RF_STEP(8, 4) RF_STEP(4, 2) RF_STEP(2, 1)
#undef RF_STEP
    float lg = a[0] + __shfl_xor(a[0], 1);
    const int myE = lane >> 1;
    lg += router_b[myE];
    float tv[TOPK]; int ti[TOPK];
#pragma unroll
    for (int k = 0; k < TOPK; ++k) {
        float mx = lg;
#pragma unroll
        for (int o = 1; o < 64; o <<= 1) mx = fmaxf(mx, __shfl_xor(mx, o));
        int cand = (lg == mx) ? myE : 99;
#pragma unroll
        for (int o = 1; o < 64; o <<= 1) cand = min(cand, __shfl_xor(cand, o));
        tv[k] = mx; ti[k] = cand;
        if (myE == cand) lg = -INFINITY;
    }
    const float e1 = __expf(tv[1] - tv[0]), e2 = __expf(tv[2] - tv[0]), e3 = __expf(tv[3] - tv[0]);
    const float inv = 1.0f / (1.0f + e1 + e2 + e3);
    if (lane < TOPK && m < MTOK) {
        const int ek = lane == 0 ? ti[0] : lane == 1 ? ti[1] : lane == 2 ? ti[2] : ti[3];
        const float gk = (lane == 0 ? 1.0f : lane == 1 ? e1 : lane == 2 ? e2 : e3) * inv;
        const int lr = __hip_atomic_fetch_add(&lcnt[ek], 1, __ATOMIC_RELAXED, __HIP_MEMORY_SCOPE_WORKGROUP);
        sbw[lane] = ((unsigned)ek << 16) | (unsigned)lr;
        GATE[(size_t)m * TOPK + lane] = gk;
    }
}

#ifndef PROBE_DELAY
#define PROBE_DELAY 0
#endif
__device__ __forceinline__ void probe_delay(int us100) { const unsigned long long t0 = __builtin_amdgcn_s_memrealtime(); while (__builtin_amdgcn_s_memrealtime() - t0 < (unsigned long long)us100) __builtin_amdgcn_s_sleep(2); }
constexpr int H3_QI = 0, H3_KK = 34816, H3_V = 69632, H3_DEC = 88064, H3_ST = 89088, H3_AM = 106496, H3_LH = 115712, H3_LL = 133120, H3_END = 150528;
constexpr int H3_BUFD = 17408, H3_BUFV = 9216, H3_BUFDEC = 512;
static_assert(H3_END <= LDSCTL_OFF, "recurrence LDS image below the control words");
struct Hg3 {
    LAS unsigned char* lds; const bf16 *Qb, *Kp, *Vb; const float* Lp; float* Op;
    int b, h, dir, vh, lane, lr, lq;
};
__device__ __forceinline__ size_t hg3_row(const Hg3& c, int n, int t) {
    const int tb = c.b * TT + (c.dir ? (TT / 64 - 1 - n) * 64 : n * 64);
    return (size_t)(c.dir ? tb + 63 - t : tb + t) * 512 + c.h * 128;
}
struct Hg3LV { f32x4 lf[8]; v4u v[2]; };
struct Hg3QK { v2u q[2][4], k[2][4]; };
__device__ __forceinline__ void gld16(f32x4& d, const void* p) { asm volatile("global_load_dwordx4 %0, %1, off" : "=v"(d) : "v"(p) : "memory"); }
__device__ __forceinline__ void gld16u(v4u& d, const void* p) { asm volatile("global_load_dwordx4 %0, %1, off" : "=v"(d) : "v"(p) : "memory"); }
__device__ __forceinline__ void gld8(v2u& d, const void* p) { asm volatile("global_load_dwordx2 %0, %1, off" : "=v"(d) : "v"(p) : "memory"); }
__device__ __forceinline__ void hg3_load_lv(const Hg3& c, int n, int pt, Hg3LV& in) {
    const size_t r = hg3_row(c, n, pt >> 2);
#pragma unroll
    for (int i = 0; i < 8; ++i) gld16(in.lf[i], c.Lp + r + 32 * (pt & 3) + 4 * i);
    gld16u(in.v[0], c.Vb + r + c.vh * 64 + 16 * (pt & 3)); gld16u(in.v[1], c.Vb + r + c.vh * 64 + 16 * (pt & 3) + 8);
}
__device__ __forceinline__ void hg3_load_qk(const Hg3& c, int n, int pw, Hg3QK& in) {
#pragma unroll
    for (int ti = 0; ti < 4; ++ti) { const size_t r = hg3_row(c, n, 16 * ti + c.lr);
#pragma unroll
        for (int dt = 0; dt < 2; ++dt) { const int d0 = 16 * (2 * pw + dt) + 4 * c.lq; gld8(in.q[dt][ti], c.Qb + r + d0); gld8(in.k[dt][ti], c.Kp + r + d0); } }
}
#define H3_USE_LV(x) asm volatile("" : "+v"((x).lf[0]), "+v"((x).lf[1]), "+v"((x).lf[2]), "+v"((x).lf[3]), "+v"((x).lf[4]), "+v"((x).lf[5]), "+v"((x).lf[6]), "+v"((x).lf[7]), "+v"((x).v[0]), "+v"((x).v[1]))
#define H3_USE_QK(x) asm volatile("" : "+v"((x).q[0][0]), "+v"((x).q[0][1]), "+v"((x).q[0][2]), "+v"((x).q[0][3]), "+v"((x).q[1][0]), "+v"((x).q[1][1]), "+v"((x).q[1][2]), "+v"((x).q[1][3]), \
                                           "+v"((x).k[0][0]), "+v"((x).k[0][1]), "+v"((x).k[0][2]), "+v"((x).k[0][3]), "+v"((x).k[1][0]), "+v"((x).k[1][1]), "+v"((x).k[1][2]), "+v"((x).k[1][3]))
__device__ __forceinline__ unsigned hg3_hi_lo(float x, float y, unsigned& lo) {
    const unsigned hi = pk2(x, y);
    lo = pk2(x - bf2f(hi & 0xffffu), y - bf2f(hi >> 16));
    return hi;
}
__device__ __forceinline__ void hg3_prep_a(const Hg3& c, int buf, int pt, const Hg3LV& in) {
    const int t = pt >> 2, dq = pt & 3;
#pragma unroll
    for (int i = 0; i < 8; ++i) { unsigned l0, l1; const unsigned h0 = hg3_hi_lo(in.lf[i].x, in.lf[i].y, l0), h1 = hg3_hi_lo(in.lf[i].z, in.lf[i].w, l1);
        *(LAS v2u*)(c.lds + H3_LH + t * 272 + (32 * dq + 4 * i) * 2) = (v2u){h0, h1}; *(LAS v2u*)(c.lds + H3_LL + t * 272 + (32 * dq + 4 * i) * 2) = (v2u){l0, l1}; }
    *(LAS v4u*)(c.lds + H3_V + buf * H3_BUFV + t * 144 + dq * 32) = in.v[0]; *(LAS v4u*)(c.lds + H3_V + buf * H3_BUFV + t * 144 + dq * 32 + 16) = in.v[1];
}
__device__ __forceinline__ void hg3_prep_b(const Hg3& c, int buf, int pw, const Hg3QK& in, const pg8::bf16x8 (&U)[4]) {
    LAS unsigned char* lds = c.lds; const int lr = c.lr, lq = c.lq, lane = c.lane;
    const unsigned trrow = (unsigned)(8 * lq + ((lane & 15) >> 2)), trcol = (unsigned)(4 * (lane & 3));
    const pg8::bf16x8 ones = (pg8::bf16x8)(v4u){0x3F803F80u, 0x3F803F80u, 0x3F803F80u, 0x3F803F80u};
#pragma unroll
    for (int dt = 0; dt < 2; ++dt) {
        const int dtile = 2 * pw + dt;
        v2u fh[2][2], fl[2][2];
        const unsigned ah = (unsigned)(size_t)(lds + H3_LH) + trrow * 272 + (16 * dtile + trcol) * 2, al = ah + (H3_LL - H3_LH);
        asm volatile("ds_read_b64_tr_b16 %0, %8\n\tds_read_b64_tr_b16 %1, %8 offset:1088\n\tds_read_b64_tr_b16 %2, %8 offset:8704\n\tds_read_b64_tr_b16 %3, %8 offset:9792\n\t"
                     "ds_read_b64_tr_b16 %4, %9\n\tds_read_b64_tr_b16 %5, %9 offset:1088\n\tds_read_b64_tr_b16 %6, %9 offset:8704\n\tds_read_b64_tr_b16 %7, %9 offset:9792\n\ts_waitcnt lgkmcnt(0)"
                     : "=&v"(fh[0][0]), "=&v"(fh[0][1]), "=&v"(fh[1][0]), "=&v"(fh[1][1]), "=&v"(fl[0][0]), "=&v"(fl[0][1]), "=&v"(fl[1][0]), "=&v"(fl[1][1]) : "v"(ah), "v"(al) : "memory");
        const pg8::bf16x8 H0 = mk_frag(fh[0][0], fh[0][1]), H1 = mk_frag(fh[1][0], fh[1][1]), L0 = mk_frag(fl[0][0], fl[0][1]), L1 = mk_frag(fl[1][0], fl[1][1]);
        f32x4 bt[4];
        const f32x4 z = (f32x4){0.f, 0.f, 0.f, 0.f};
        bt[0] = __builtin_amdgcn_mfma_f32_16x16x32_bf16(L0, U[0], z, 0, 0, 0);    bt[0] = __builtin_amdgcn_mfma_f32_16x16x32_bf16(H0, U[0], bt[0], 0, 0, 0);
        bt[1] = __builtin_amdgcn_mfma_f32_16x16x32_bf16(L0, U[1], z, 0, 0, 0);    bt[1] = __builtin_amdgcn_mfma_f32_16x16x32_bf16(H0, U[1], bt[1], 0, 0, 0);
        bt[2] = __builtin_amdgcn_mfma_f32_16x16x32_bf16(L0, ones, z, 0, 0, 0);    bt[2] = __builtin_amdgcn_mfma_f32_16x16x32_bf16(L1, U[2], bt[2], 0, 0, 0);
        bt[2] = __builtin_amdgcn_mfma_f32_16x16x32_bf16(H0, ones, bt[2], 0, 0, 0); bt[2] = __builtin_amdgcn_mfma_f32_16x16x32_bf16(H1, U[2], bt[2], 0, 0, 0);
        bt[3] = __builtin_amdgcn_mfma_f32_16x16x32_bf16(L0, ones, z, 0, 0, 0);    bt[3] = __builtin_amdgcn_mfma_f32_16x16x32_bf16(L1, U[3], bt[3], 0, 0, 0);
        bt[3] = __builtin_amdgcn_mfma_f32_16x16x32_bf16(H0, ones, bt[3], 0, 0, 0); bt[3] = __builtin_amdgcn_mfma_f32_16x16x32_bf16(H1, U[3], bt[3], 0, 0, 0);
        f32x4 de;
#pragma unroll
        for (int r = 0; r < 4; ++r) de[r] = __expf(__shfl(bt[3][r], 16 * lq + 15));
        if (lr == 0) *(LAS f32x4*)(lds + H3_DEC + buf * H3_BUFDEC + (16 * dtile + 4 * lq) * 4) = de;
#pragma unroll
        for (int ti = 0; ti < 4; ++ti) {
            const v2u qq = in.q[dt][ti], kk = in.k[dt][ti];
            const float e0 = __expf(bt[ti][0]), e1 = __expf(bt[ti][1]), e2 = __expf(bt[ti][2]), e3 = __expf(bt[ti][3]);
            v2u qo, ko;
            qo.x = pk2(bf2f(qq.x & 0xffffu) * e0, bf2f(qq.x >> 16) * e1); qo.y = pk2(bf2f(qq.y & 0xffffu) * e2, bf2f(qq.y >> 16) * e3);
            ko.x = pk2(bf2f(kk.x & 0xffffu) * __builtin_amdgcn_rcpf(e0), bf2f(kk.x >> 16) * __builtin_amdgcn_rcpf(e1));
            ko.y = pk2(bf2f(kk.y & 0xffffu) * __builtin_amdgcn_rcpf(e2), bf2f(kk.y >> 16) * __builtin_amdgcn_rcpf(e3));
            const int off = (16 * ti + lr) * 272 + (16 * dtile + 4 * lq) * 2;
            *(LAS v2u*)(lds + H3_QI + buf * H3_BUFD + off) = qo; *(LAS v2u*)(lds + H3_KK + buf * H3_BUFD + off) = ko;
        }
    }
}
__device__ __forceinline__ void hg3_stage1(const Hg3& c, int buf, int mw, f32x4 (&S)[2][4], f32x4 (&o)[2][2], v2u (&vt)[4][2][2]) {
    LAS unsigned char* lds = c.lds; const int lr = c.lr, lq = c.lq, lane = c.lane;
    const LAS unsigned char* QI = lds + H3_QI + buf * H3_BUFD; const LAS unsigned char* KK = lds + H3_KK + buf * H3_BUFD;
    const unsigned trrow = (unsigned)(8 * lq + ((lane & 15) >> 2)), trcol = (unsigned)(4 * (lane & 3));
    const unsigned kk_tr = (unsigned)(size_t)KK + trrow * 272 + (32 * mw + trcol) * 2;
    const unsigned v_tr = (unsigned)(size_t)(lds + H3_V + buf * H3_BUFV) + trrow * 144 + trcol * 2;
    const int tp = mw >> 1, ep = mw & 1;
    pg8::bf16x8 qf[2][4], sf[2][4], kf[3][4];
#pragma unroll
    for (int bq = 0; bq < 2; ++bq)
#pragma unroll
        for (int kk = 0; kk < 4; ++kk) { qf[bq][kk] = lds_frag(QI + (16 * (2 * tp + bq) + lr) * 272 + kk * 64 + lq * 16); sf[bq][kk] = lds_frag(lds + H3_ST + (16 * (2 * ep + bq) + lr) * 272 + kk * 64 + lq * 16); }
#pragma unroll
    for (int a = 0; a < 2; ++a)
#pragma unroll
        for (int bq = 0; bq < 2; ++bq) o[a][bq] = (f32x4){0.f, 0.f, 0.f, 0.f};
#pragma unroll
    for (int kk = 0; kk < 4; ++kk) {
        o[0][0] = __builtin_amdgcn_mfma_f32_16x16x32_bf16(sf[0][kk], qf[0][kk], o[0][0], 0, 0, 0); o[0][1] = __builtin_amdgcn_mfma_f32_16x16x32_bf16(sf[0][kk], qf[1][kk], o[0][1], 0, 0, 0);
        o[1][0] = __builtin_amdgcn_mfma_f32_16x16x32_bf16(sf[1][kk], qf[0][kk], o[1][0], 0, 0, 0); o[1][1] = __builtin_amdgcn_mfma_f32_16x16x32_bf16(sf[1][kk], qf[1][kk], o[1][1], 0, 0, 0);
    }
    __builtin_amdgcn_sched_barrier(0);
    const int ks0 = mw == 3 ? 1 : 0;
    if (mw != 1) {
#pragma unroll
        for (int x = 0; x < 3; ++x)
#pragma unroll
            for (int kk = 0; kk < 4; ++kk) kf[x][kk] = lds_frag(KK + (16 * (ks0 + x) + lr) * 272 + kk * 64 + lq * 16);
    }
    v2u kt[2][2][2];
    {
        f32x4 at[4];
#pragma unroll
        for (int i = 0; i < 4; ++i) at[i] = (f32x4){0.f, 0.f, 0.f, 0.f};
        if (mw != 1) {
#pragma unroll
            for (int kk = 0; kk < 4; ++kk) {
                at[0] = __builtin_amdgcn_mfma_f32_16x16x32_bf16(kf[0][kk], mw == 3 ? qf[1][kk] : qf[0][kk], at[0], 0, 0, 0);
                at[1] = __builtin_amdgcn_mfma_f32_16x16x32_bf16(mw == 0 ? kf[0][kk] : kf[1][kk], mw == 2 ? qf[0][kk] : qf[1][kk], at[1], 0, 0, 0);
                at[2] = __builtin_amdgcn_mfma_f32_16x16x32_bf16(mw == 0 ? kf[1][kk] : kf[2][kk], mw == 2 ? qf[0][kk] : qf[1][kk], at[2], 0, 0, 0);
                if (mw == 2) at[3] = __builtin_amdgcn_mfma_f32_16x16x32_bf16(kf[0][kk], qf[1][kk], at[3], 0, 0, 0);
            }
        }
    asm volatile("ds_read_b64_tr_b16 %0, %8\n\tds_read_b64_tr_b16 %1, %8 offset:1088\n\tds_read_b64_tr_b16 %2, %8 offset:8704\n\tds_read_b64_tr_b16 %3, %8 offset:9792\n\t"
                 "ds_read_b64_tr_b16 %4, %8 offset:32\n\tds_read_b64_tr_b16 %5, %8 offset:1120\n\tds_read_b64_tr_b16 %6, %8 offset:8736\n\tds_read_b64_tr_b16 %7, %8 offset:9824"
                 : "=&v"(kt[0][0][0]), "=&v"(kt[0][0][1]), "=&v"(kt[0][1][0]), "=&v"(kt[0][1][1]), "=&v"(kt[1][0][0]), "=&v"(kt[1][0][1]), "=&v"(kt[1][1][0]), "=&v"(kt[1][1][1]) : "v"(kk_tr) : "memory");
#define H3_VTR(e4, o0, o1, o2, o3) asm volatile("ds_read_b64_tr_b16 %0, %4 offset:" #o0 "\n\tds_read_b64_tr_b16 %1, %4 offset:" #o1 "\n\tds_read_b64_tr_b16 %2, %4 offset:" #o2 "\n\tds_read_b64_tr_b16 %3, %4 offset:" #o3 \
                 : "=&v"(vt[e4][0][0]), "=&v"(vt[e4][0][1]), "=&v"(vt[e4][1][0]), "=&v"(vt[e4][1][1]) : "v"(v_tr) : "memory")
    H3_VTR(0, 0, 576, 4608, 5184); H3_VTR(1, 32, 608, 4640, 5216); H3_VTR(2, 64, 640, 4672, 5248); H3_VTR(3, 96, 672, 4704, 5280);
#undef H3_VTR
#pragma unroll
        for (int i = 0; i < 4; ++i) {
            int si, ti; bool have = true, zero = false;
            if (mw == 0) { si = i == 2 ? 1 : 0; ti = i == 0 ? 0 : 1; have = i < 3; }
            else if (mw == 1) { si = 1; ti = 0; have = i == 0; zero = true; }
            else if (mw == 2) { si = i == 3 ? 0 : i; ti = i == 3 ? 3 : 2; }
            else { si = i == 3 ? 3 : i + 1; ti = i == 3 ? 2 : 3; zero = i == 3; }
            if (have) {
                const int s0 = 16 * si + 4 * lq, t = 16 * ti + lr; v2u w = (v2u){0u, 0u};
                if (!zero) { w.x = pk2(s0 + 0 <= t ? at[i][0] : 0.f, s0 + 1 <= t ? at[i][1] : 0.f); w.y = pk2(s0 + 2 <= t ? at[i][2] : 0.f, s0 + 3 <= t ? at[i][3] : 0.f); }
                *(LAS v2u*)(lds + H3_AM + (16 * ti + lr) * 144 + (16 * si + 4 * lq) * 2) = w;
            }
        }
    }
    asm volatile("s_waitcnt lgkmcnt(0)"
                 : "+v"(kt[0][0][0]), "+v"(kt[0][0][1]), "+v"(kt[0][1][0]), "+v"(kt[0][1][1]), "+v"(kt[1][0][0]), "+v"(kt[1][0][1]), "+v"(kt[1][1][0]), "+v"(kt[1][1][1]),
                   "+v"(vt[0][0][0]), "+v"(vt[0][0][1]), "+v"(vt[0][1][0]), "+v"(vt[0][1][1]), "+v"(vt[1][0][0]), "+v"(vt[1][0][1]), "+v"(vt[1][1][0]), "+v"(vt[1][1][1]),
                   "+v"(vt[2][0][0]), "+v"(vt[2][0][1]), "+v"(vt[2][1][0]), "+v"(vt[2][1][1]), "+v"(vt[3][0][0]), "+v"(vt[3][0][1]), "+v"(vt[3][1][0]), "+v"(vt[3][1][1]) :: "memory");
#pragma unroll
    for (int dt = 0; dt < 2; ++dt) {
#pragma unroll
        for (int kk = 0; kk < 2; ++kk) {
            const pg8::bf16x8 af = mk_frag(kt[dt][kk][0], kt[dt][kk][1]);
#pragma unroll
            for (int e4 = 0; e4 < 4; ++e4) S[dt][e4] = __builtin_amdgcn_mfma_f32_16x16x32_bf16(af, mk_frag(vt[e4][kk][0], vt[e4][kk][1]), S[dt][e4], 0, 0, 0);
        }
        const f32x4 dv = *(const LAS f32x4*)(lds + H3_DEC + buf * H3_BUFDEC + (16 * (2 * mw + dt) + 4 * lq) * 4);
#pragma unroll
        for (int e4 = 0; e4 < 4; ++e4) S[dt][e4] = S[dt][e4] * dv;
    }
}
__device__ __forceinline__ void hg3_stage2(const Hg3& c, int n, int mw, const f32x4 (&S)[2][4], f32x4 (&o)[2][2], const v2u (&vt)[4][2][2]) {
    LAS unsigned char* lds = c.lds; const int lr = c.lr, lq = c.lq;
#pragma unroll
    for (int bq = 0; bq < 2; ++bq) {
        const int ti = 2 * (mw >> 1) + bq;
        const pg8::bf16x8 a0 = lds_frag(lds + H3_AM + (16 * ti + lr) * 144 + 0 * 64 + lq * 16);
#pragma unroll
        for (int a = 0; a < 2; ++a) { const int e4 = 2 * (mw & 1) + a;
            const pg8::bf16x8 vf = e4 == 0 ? mk_frag(vt[0][0][0], vt[0][0][1]) : e4 == 1 ? mk_frag(vt[1][0][0], vt[1][0][1]) : e4 == 2 ? mk_frag(vt[2][0][0], vt[2][0][1]) : mk_frag(vt[3][0][0], vt[3][0][1]);
            o[a][bq] = __builtin_amdgcn_mfma_f32_16x16x32_bf16(vf, a0, o[a][bq], 0, 0, 0); }
        if (mw >> 1) {
            const pg8::bf16x8 a1 = lds_frag(lds + H3_AM + (16 * ti + lr) * 144 + 1 * 64 + lq * 16);
#pragma unroll
            for (int a = 0; a < 2; ++a) { const int e4 = 2 * (mw & 1) + a;
                const pg8::bf16x8 vf = e4 == 0 ? mk_frag(vt[0][1][0], vt[0][1][1]) : e4 == 1 ? mk_frag(vt[1][1][0], vt[1][1][1]) : e4 == 2 ? mk_frag(vt[2][1][0], vt[2][1][1]) : mk_frag(vt[3][1][0], vt[3][1][1]);
                o[a][bq] = __builtin_amdgcn_mfma_f32_16x16x32_bf16(vf, a1, o[a][bq], 0, 0, 0); }
        }
#pragma unroll
        for (int a = 0; a < 2; ++a)
            *(f32x4*)(c.Op + hg3_row(c, n, 16 * ti + lr) + c.vh * 64 + 16 * (2 * (mw & 1) + a) + 4 * lq) = o[a][bq];
    }
#pragma unroll
    for (int dt = 0; dt < 2; ++dt)
#pragma unroll
        for (int e4 = 0; e4 < 4; ++e4) { v2u w; w.x = pk2(S[dt][e4][0], S[dt][e4][1]); w.y = pk2(S[dt][e4][2], S[dt][e4][3]);
            *(LAS v2u*)(lds + H3_ST + (16 * e4 + lr) * 272 + (16 * (2 * mw + dt) + 4 * lq) * 2) = w; }
}
__device__ __forceinline__ void hgrn3_unit(LAS unsigned char* lds, int unit, const bf16* Qb, const bf16* KFb, const bf16* KBb, const bf16* Vb, const float* LFb, const float* LBb,
                                           float* OFb, float* OBb, int tid, int lane, int wave) {
    Hg3 c;
    c.lds = lds; c.vh = unit & 1; c.dir = (unit >> 1) & 1; c.h = (unit >> 2) & 3; c.b = unit >> 4;
    c.Qb = Qb; c.Vb = Vb; c.Kp = c.dir ? KBb : KFb; c.Lp = c.dir ? LBb : LFb; c.Op = c.dir ? OBb : OFb;
    c.lane = lane; c.lr = lane & 15; c.lq = lane >> 4;
    constexpr int NCH = TT / 64;
    for (int i = tid; i < 64 * 272 / 16; i += NTHR) *(LAS v4u*)(lds + H3_ST + i * 16) = (v4u){0u, 0u, 0u, 0u};
    if (wave < 4) {
        const int pt = tid, pw = wave;
        pg8::bf16x8 U[4];
#pragma unroll
        for (int u = 0; u < 4; ++u) { const int kk = u >> 1, ti = u; unsigned wv[4];
#pragma unroll
            for (int j2 = 0; j2 < 4; ++j2) { const int s = 32 * kk + 8 * c.lq + 2 * j2, t = 16 * ti + c.lr; wv[j2] = (s <= t ? 0x3F80u : 0u) | (s + 1 <= t ? 0x3F800000u : 0u); }
            U[u] = (pg8::bf16x8)(v4u){wv[0], wv[1], wv[2], wv[3]}; }
        Hg3LV lv0, lv1; Hg3QK qk;
        hg3_load_lv(c, 0, pt, lv0); hg3_load_qk(c, 0, pw, qk); hg3_load_lv(c, 1, pt, lv1);
        asm volatile("s_waitcnt vmcnt(0)" ::: "memory"); H3_USE_LV(lv0); H3_USE_QK(qk); H3_USE_LV(lv1);
        hg3_prep_a(c, 0, pt, lv0);
        __syncthreads();
#define H3_TRIP(j_, LVN, LVC) do { \
            if ((j_) < NCH) { asm volatile("s_waitcnt vmcnt(10)" ::: "memory"); H3_USE_QK(qk); hg3_prep_b(c, (j_) & 1, pw, qk, U); \
                if ((j_) + 1 < NCH) hg3_load_qk(c, (j_) + 1, pw, qk); else hg3_load_qk(c, (j_), pw, qk);     \
                if ((j_) + 2 < NCH) hg3_load_lv(c, (j_) + 2, pt, LVC); else hg3_load_lv(c, (j_), pt, LVC); } \
            if (PROBE_DELAY == 2) probe_delay(100); \
            __syncthreads();                                                                    \
            if ((j_) + 1 < NCH) { asm volatile("s_waitcnt vmcnt(26)" ::: "memory"); H3_USE_LV(LVN); hg3_prep_a(c, ((j_) + 1) & 1, pt, LVN); } \
            __syncthreads();                                                                    \
        } while (0)
#pragma unroll 1
        for (int j = 0; j <= NCH; j += 2) { H3_TRIP(j, lv1, lv0); H3_TRIP(j + 1, lv0, lv1); }
#undef H3_TRIP
        asm volatile("s_waitcnt vmcnt(0)" ::: "memory");
    } else {
        const int mw = wave - 4;
        f32x4 S[2][4], o[2][2]; v2u vt[4][2][2];
#pragma unroll
        for (int a = 0; a < 2; ++a)
#pragma unroll
            for (int e4 = 0; e4 < 4; ++e4) S[a][e4] = (f32x4){0.f, 0.f, 0.f, 0.f};
        __syncthreads();
#pragma unroll 1
        for (int j = 0; j <= NCH + 1; ++j) {
            if (j > 0 && j <= NCH) hg3_stage1(c, (j - 1) & 1, mw, S, o, vt);
            if (PROBE_DELAY == 1) probe_delay(100);
            __syncthreads();
            if (j > 0 && j <= NCH) hg3_stage2(c, j - 1, mw, S, o, vt);
            __syncthreads();
        }
    }
    __syncthreads();
}


struct Hg4LV { f32x4 lf[4]; v4u v; };
struct Hg4QK { v2u q[4], k[4]; };
__device__ __forceinline__ void hg4_load_lv(const Hg3& c, int n, int tid, Hg4LV& in) {
    const size_t r = hg3_row(c, n, tid >> 3);
#pragma unroll
    for (int i = 0; i < 4; ++i) gld16(in.lf[i], c.Lp + r + 16 * (tid & 7) + 4 * i);
    gld16u(in.v, c.Vb + r + c.vh * 64 + 8 * (tid & 7));
}
__device__ __forceinline__ void hg4_load_qk(const Hg3& c, int n, int w, Hg4QK& in) {
#pragma unroll
    for (int ti = 0; ti < 4; ++ti) { const size_t r = hg3_row(c, n, 16 * ti + c.lr) + 16 * w + 4 * c.lq; gld8(in.q[ti], c.Qb + r); gld8(in.k[ti], c.Kp + r); }
}
#define H4_USE_LV(x) asm volatile("" : "+v"((x).lf[0]), "+v"((x).lf[1]), "+v"((x).lf[2]), "+v"((x).lf[3]), "+v"((x).v))
#define H4_USE_QK(x) asm volatile("" : "+v"((x).q[0]), "+v"((x).q[1]), "+v"((x).q[2]), "+v"((x).q[3]), "+v"((x).k[0]), "+v"((x).k[1]), "+v"((x).k[2]), "+v"((x).k[3]))
__device__ __forceinline__ void hg4_prep_a(const Hg3& c, int buf, int tid, const Hg4LV& in) {
    const int t = tid >> 3, dq = tid & 7;
#pragma unroll
    for (int i = 0; i < 4; ++i) { unsigned l0, l1; const unsigned h0 = hg3_hi_lo(in.lf[i].x, in.lf[i].y, l0), h1 = hg3_hi_lo(in.lf[i].z, in.lf[i].w, l1);
        *(LAS v2u*)(c.lds + H3_LH + t * 272 + (16 * dq + 4 * i) * 2) = (v2u){h0, h1}; *(LAS v2u*)(c.lds + H3_LL + t * 272 + (16 * dq + 4 * i) * 2) = (v2u){l0, l1}; }
    *(LAS v4u*)(c.lds + H3_V + buf * H3_BUFV + t * 144 + dq * 16) = in.v;
}
__device__ __forceinline__ void hg4_prep_b(const Hg3& c, int buf, int w, const Hg4QK& in, const pg8::bf16x8 (&U)[4]) {
    LAS unsigned char* lds = c.lds; const int lr = c.lr, lq = c.lq, lane = c.lane;
    const unsigned trrow = (unsigned)(8 * lq + ((lane & 15) >> 2)), trcol = (unsigned)(4 * (lane & 3));
    const pg8::bf16x8 ones = (pg8::bf16x8)(v4u){0x3F803F80u, 0x3F803F80u, 0x3F803F80u, 0x3F803F80u};
    v2u fh[2][2], fl[2][2];
    const unsigned ah = (unsigned)(size_t)(lds + H3_LH) + trrow * 272 + (16 * w + trcol) * 2, al = ah + (H3_LL - H3_LH);
    asm volatile("ds_read_b64_tr_b16 %0, %8\n\tds_read_b64_tr_b16 %1, %8 offset:1088\n\tds_read_b64_tr_b16 %2, %8 offset:8704\n\tds_read_b64_tr_b16 %3, %8 offset:9792\n\t"
                 "ds_read_b64_tr_b16 %4, %9\n\tds_read_b64_tr_b16 %5, %9 offset:1088\n\tds_read_b64_tr_b16 %6, %9 offset:8704\n\tds_read_b64_tr_b16 %7, %9 offset:9792\n\ts_waitcnt lgkmcnt(0)"
                 : "=&v"(fh[0][0]), "=&v"(fh[0][1]), "=&v"(fh[1][0]), "=&v"(fh[1][1]), "=&v"(fl[0][0]), "=&v"(fl[0][1]), "=&v"(fl[1][0]), "=&v"(fl[1][1]) : "v"(ah), "v"(al) : "memory");
    const pg8::bf16x8 H0 = mk_frag(fh[0][0], fh[0][1]), H1 = mk_frag(fh[1][0], fh[1][1]), L0 = mk_frag(fl[0][0], fl[0][1]), L1 = mk_frag(fl[1][0], fl[1][1]);
    f32x4 bt[4];
    const f32x4 z = (f32x4){0.f, 0.f, 0.f, 0.f};
    bt[0] = __builtin_amdgcn_mfma_f32_16x16x32_bf16(L0, U[0], z, 0, 0, 0);    bt[0] = __builtin_amdgcn_mfma_f32_16x16x32_bf16(H0, U[0], bt[0], 0, 0, 0);
    bt[1] = __builtin_amdgcn_mfma_f32_16x16x32_bf16(L0, U[1], z, 0, 0, 0);    bt[1] = __builtin_amdgcn_mfma_f32_16x16x32_bf16(H0, U[1], bt[1], 0, 0, 0);
    bt[2] = __builtin_amdgcn_mfma_f32_16x16x32_bf16(L0, ones, z, 0, 0, 0);    bt[2] = __builtin_amdgcn_mfma_f32_16x16x32_bf16(L1, U[2], bt[2], 0, 0, 0);
    bt[2] = __builtin_amdgcn_mfma_f32_16x16x32_bf16(H0, ones, bt[2], 0, 0, 0); bt[2] = __builtin_amdgcn_mfma_f32_16x16x32_bf16(H1, U[2], bt[2], 0, 0, 0);
    bt[3] = __builtin_amdgcn_mfma_f32_16x16x32_bf16(L0, ones, z, 0, 0, 0);    bt[3] = __builtin_amdgcn_mfma_f32_16x16x32_bf16(L1, U[3], bt[3], 0, 0, 0);
    bt[3] = __builtin_amdgcn_mfma_f32_16x16x32_bf16(H0, ones, bt[3], 0, 0, 0); bt[3] = __builtin_amdgcn_mfma_f32_16x16x32_bf16(H1, U[3], bt[3], 0, 0, 0);
    f32x4 de;
#pragma unroll
    for (int r = 0; r < 4; ++r) de[r] = __expf(__shfl(bt[3][r], 16 * lq + 15));
    if (lr == 0) *(LAS f32x4*)(lds + H3_DEC + buf * H3_BUFDEC + (16 * w + 4 * lq) * 4) = de;
#pragma unroll
    for (int ti = 0; ti < 4; ++ti) {
        const v2u qq = in.q[ti], kk = in.k[ti];
        const float e0 = __expf(bt[ti][0]), e1 = __expf(bt[ti][1]), e2 = __expf(bt[ti][2]), e3 = __expf(bt[ti][3]);
        v2u qo, ko;
        qo.x = pk2(bf2f(qq.x & 0xffffu) * e0, bf2f(qq.x >> 16) * e1); qo.y = pk2(bf2f(qq.y & 0xffffu) * e2, bf2f(qq.y >> 16) * e3);
        ko.x = pk2(bf2f(kk.x & 0xffffu) * __builtin_amdgcn_rcpf(e0), bf2f(kk.x >> 16) * __builtin_amdgcn_rcpf(e1));
        ko.y = pk2(bf2f(kk.y & 0xffffu) * __builtin_amdgcn_rcpf(e2), bf2f(kk.y >> 16) * __builtin_amdgcn_rcpf(e3));
        const int off = (16 * ti + lr) * 272 + (16 * w + 4 * lq) * 2;
        *(LAS v2u*)(lds + H3_QI + buf * H3_BUFD + off) = qo; *(LAS v2u*)(lds + H3_KK + buf * H3_BUFD + off) = ko;
    }
}
__device__ __forceinline__ void hg4_stage1(const Hg3& c, int buf, int w, f32x4 (&S)[4], f32x4 (&o)[2], v2u (&vt)[4][2][2]) {
    LAS unsigned char* lds = c.lds; const int lr = c.lr, lq = c.lq, lane = c.lane;
    const LAS unsigned char* QI = lds + H3_QI + buf * H3_BUFD; const LAS unsigned char* KK = lds + H3_KK + buf * H3_BUFD;
    const unsigned trrow = (unsigned)(8 * lq + ((lane & 15) >> 2)), trcol = (unsigned)(4 * (lane & 3));
    const unsigned kk_tr = (unsigned)(size_t)KK + trrow * 272 + (16 * w + trcol) * 2;
    const unsigned v_tr = (unsigned)(size_t)(lds + H3_V + buf * H3_BUFV) + trrow * 144 + trcol * 2;
    v2u kt[2][2];
    asm volatile("ds_read_b64_tr_b16 %0, %4\n\tds_read_b64_tr_b16 %1, %4 offset:1088\n\tds_read_b64_tr_b16 %2, %4 offset:8704\n\tds_read_b64_tr_b16 %3, %4 offset:9792"
                 : "=&v"(kt[0][0]), "=&v"(kt[0][1]), "=&v"(kt[1][0]), "=&v"(kt[1][1]) : "v"(kk_tr) : "memory");
#define H4_VTR(e4, o0, o1, o2, o3) asm volatile("ds_read_b64_tr_b16 %0, %4 offset:" #o0 "\n\tds_read_b64_tr_b16 %1, %4 offset:" #o1 "\n\tds_read_b64_tr_b16 %2, %4 offset:" #o2 "\n\tds_read_b64_tr_b16 %3, %4 offset:" #o3 \
                 : "=&v"(vt[e4][0][0]), "=&v"(vt[e4][0][1]), "=&v"(vt[e4][1][0]), "=&v"(vt[e4][1][1]) : "v"(v_tr) : "memory")
    H4_VTR(0, 0, 576, 4608, 5184); H4_VTR(1, 32, 608, 4640, 5216); H4_VTR(2, 64, 640, 4672, 5248); H4_VTR(3, 96, 672, 4704, 5280);
#undef H4_VTR
    const int ei = w & 3, tp = w >> 2;
    {
        const int ti = w & 3;
#pragma unroll
        for (int sii = 0; sii < 2; ++sii) {
            const int si = tp * 2 + sii;
            v2u wv = (v2u){0u, 0u};
            if (si <= ti) {
                f32x4 a = (f32x4){0.f, 0.f, 0.f, 0.f};
#pragma unroll
                for (int kk = 0; kk < 4; ++kk)
                    a = __builtin_amdgcn_mfma_f32_16x16x32_bf16(lds_frag(KK + (16 * si + lr) * 272 + kk * 64 + lq * 16), lds_frag(QI + (16 * ti + lr) * 272 + kk * 64 + lq * 16), a, 0, 0, 0);
                const int s0 = 16 * si + 4 * lq, t = 16 * ti + lr;
                wv.x = pk2(s0 + 0 <= t ? a[0] : 0.f, s0 + 1 <= t ? a[1] : 0.f); wv.y = pk2(s0 + 2 <= t ? a[2] : 0.f, s0 + 3 <= t ? a[3] : 0.f);
            }
            *(LAS v2u*)(lds + H3_AM + (16 * ti + lr) * 144 + (16 * si + 4 * lq) * 2) = wv;
        }
    }
#pragma unroll
    for (int tt = 0; tt < 2; ++tt) o[tt] = (f32x4){0.f, 0.f, 0.f, 0.f};
#pragma unroll
    for (int kk = 0; kk < 4; ++kk) {
        const pg8::bf16x8 sfr = lds_frag(lds + H3_ST + (16 * ei + lr) * 272 + kk * 64 + lq * 16);
#pragma unroll
        for (int tt = 0; tt < 2; ++tt) o[tt] = __builtin_amdgcn_mfma_f32_16x16x32_bf16(sfr, lds_frag(QI + (16 * (2 * tp + tt) + lr) * 272 + kk * 64 + lq * 16), o[tt], 0, 0, 0);
    }
    asm volatile("s_waitcnt lgkmcnt(0)"
                 : "+v"(kt[0][0]), "+v"(kt[0][1]), "+v"(kt[1][0]), "+v"(kt[1][1]),
                   "+v"(vt[0][0][0]), "+v"(vt[0][0][1]), "+v"(vt[0][1][0]), "+v"(vt[0][1][1]), "+v"(vt[1][0][0]), "+v"(vt[1][0][1]), "+v"(vt[1][1][0]), "+v"(vt[1][1][1]),
                   "+v"(vt[2][0][0]), "+v"(vt[2][0][1]), "+v"(vt[2][1][0]), "+v"(vt[2][1][1]), "+v"(vt[3][0][0]), "+v"(vt[3][0][1]), "+v"(vt[3][1][0]), "+v"(vt[3][1][1]) :: "memory");
#pragma unroll
    for (int kk = 0; kk < 2; ++kk) {
        const pg8::bf16x8 af = mk_frag(kt[kk][0], kt[kk][1]);
#pragma unroll
        for (int e4 = 0; e4 < 4; ++e4) S[e4] = __builtin_amdgcn_mfma_f32_16x16x32_bf16(af, mk_frag(vt[e4][kk][0], vt[e4][kk][1]), S[e4], 0, 0, 0);
    }
    const f32x4 dv = *(const LAS f32x4*)(lds + H3_DEC + buf * H3_BUFDEC + (16 * w + 4 * lq) * 4);
#pragma unroll
    for (int e4 = 0; e4 < 4; ++e4) S[e4] = S[e4] * dv;
}
__device__ __forceinline__ void hg4_stage2(const Hg3& c, int n, int w, const f32x4 (&S)[4], f32x4 (&o)[2], const v2u (&vt)[4][2][2]) {
    LAS unsigned char* lds = c.lds; const int lr = c.lr, lq = c.lq;
    const int ei = w & 3, tp = w >> 2;
    const pg8::bf16x8 vf0 = ei == 0 ? mk_frag(vt[0][0][0], vt[0][0][1]) : ei == 1 ? mk_frag(vt[1][0][0], vt[1][0][1]) : ei == 2 ? mk_frag(vt[2][0][0], vt[2][0][1]) : mk_frag(vt[3][0][0], vt[3][0][1]);
    const pg8::bf16x8 vf1 = ei == 0 ? mk_frag(vt[0][1][0], vt[0][1][1]) : ei == 1 ? mk_frag(vt[1][1][0], vt[1][1][1]) : ei == 2 ? mk_frag(vt[2][1][0], vt[2][1][1]) : mk_frag(vt[3][1][0], vt[3][1][1]);
#pragma unroll
    for (int tt = 0; tt < 2; ++tt) {
        const int ti = 2 * tp + tt;
        o[tt] = __builtin_amdgcn_mfma_f32_16x16x32_bf16(vf0, lds_frag(lds + H3_AM + (16 * ti + lr) * 144 + 0 * 64 + lq * 16), o[tt], 0, 0, 0);
        o[tt] = __builtin_amdgcn_mfma_f32_16x16x32_bf16(vf1, lds_frag(lds + H3_AM + (16 * ti + lr) * 144 + 1 * 64 + lq * 16), o[tt], 0, 0, 0);
        *(f32x4*)(c.Op + hg3_row(c, n, 16 * ti + lr) + c.vh * 64 + 16 * ei + 4 * lq) = o[tt];
    }
#pragma unroll
    for (int e4 = 0; e4 < 4; ++e4) { v2u wv; wv.x = pk2(S[e4][0], S[e4][1]); wv.y = pk2(S[e4][2], S[e4][3]); *(LAS v2u*)(lds + H3_ST + (16 * e4 + lr) * 272 + (16 * w + 4 * lq) * 2) = wv; }
}
__device__ __forceinline__ void hgrn4_unit(LAS unsigned char* lds, int unit, const bf16* Qb, const bf16* KFb, const bf16* KBb, const bf16* Vb, const float* LFb, const float* LBb,
                                           float* OFb, float* OBb, int tid, int lane, int wave) {
    Hg3 c;
    c.lds = lds; c.vh = unit & 1; c.dir = (unit >> 1) & 1; c.h = (unit >> 2) & 3; c.b = unit >> 4;
    c.Qb = Qb; c.Vb = Vb; c.Kp = c.dir ? KBb : KFb; c.Lp = c.dir ? LBb : LFb; c.Op = c.dir ? OBb : OFb;
    c.lane = lane; c.lr = lane & 15; c.lq = lane >> 4;
    constexpr int NCH = TT / 64;
    const int w = wave;
    for (int i = tid; i < 64 * 272 / 16; i += NTHR) *(LAS v4u*)(lds + H3_ST + i * 16) = (v4u){0u, 0u, 0u, 0u};
    pg8::bf16x8 U[4];
#pragma unroll
    for (int u = 0; u < 4; ++u) { const int kk = u >> 1, ti = u; unsigned wv[4];
#pragma unroll
        for (int j2 = 0; j2 < 4; ++j2) { const int sN = 32 * kk + 8 * c.lq + 2 * j2, t = 16 * ti + c.lr; wv[j2] = (sN <= t ? 0x3F80u : 0u) | (sN + 1 <= t ? 0x3F800000u : 0u); }
        U[u] = (pg8::bf16x8)(v4u){wv[0], wv[1], wv[2], wv[3]}; }
    f32x4 S[4], o[2]; v2u vt[4][2][2];
#pragma unroll
    for (int e4 = 0; e4 < 4; ++e4) S[e4] = (f32x4){0.f, 0.f, 0.f, 0.f};
    Hg4LV lv0, lv1; Hg4QK qk;
    hg4_load_lv(c, 0, tid, lv0); hg4_load_qk(c, 0, w, qk); hg4_load_lv(c, 1, tid, lv1);
    asm volatile("s_waitcnt vmcnt(0)" ::: "memory"); H4_USE_LV(lv0); H4_USE_QK(qk); H4_USE_LV(lv1);
    hg4_prep_a(c, 0, tid, lv0);
    __syncthreads();
#define H4_TRIP(j_, LVN, LVC) do { \
        if ((j_) < NCH) { asm volatile("s_waitcnt vmcnt(5)" ::: "memory"); H4_USE_QK(qk); hg4_prep_b(c, (j_) & 1, w, qk, U); \
            hg4_load_qk(c, (j_) + 1 < NCH ? (j_) + 1 : (j_), w, qk); hg4_load_lv(c, (j_) + 2 < NCH ? (j_) + 2 : (j_), tid, LVC); }     \
        if ((j_) > 0 && (j_) <= NCH) hg4_stage1(c, ((j_) - 1) & 1, w, S, o, vt); \
        if (PROBE_DELAY == 5) probe_delay(100); \
        __syncthreads();                                                                        \
        if ((j_) + 1 < NCH) { asm volatile("s_waitcnt vmcnt(13)" ::: "memory"); H4_USE_LV(LVN); hg4_prep_a(c, ((j_) + 1) & 1, tid, LVN); } \
        if ((j_) > 0 && (j_) <= NCH) hg4_stage2(c, (j_) - 1, w, S, o, vt); \
        __syncthreads();                                                                        \
    } while (0)
#pragma unroll 1
    for (int j = 0; j <= NCH; j += 2) { H4_TRIP(j, lv1, lv0); H4_TRIP(j + 1, lv0, lv1); }
#undef H4_TRIP
    asm volatile("s_waitcnt vmcnt(0)" ::: "memory");
    __syncthreads();
}

#if defined(HGRN_V2)
#define HGRN_FN hgrn_unit
#elif defined(HGRN_V3)
#define HGRN_FN hgrn3_unit
#else
#define HGRN_FN hgrn4_unit
#endif
#define W1_ITEM(r_) do { const int r__ = (r_); const int e__ = r__ >> 10; p0_item<true>(w1 + (size_t)e__ * D * 2 * FF, D, 2 * FF, W1T + (size_t)e__ * 2 * FF * D, RmW1(), scr, r__ & 1023, lane); } while (0)

struct Args { const float* in[18]; float* out; unsigned char* ws; int ph_lo, ph_hi; };
__global__ void __launch_bounds__(NTHR, 2) fwd_kernel(Args args) {
    extern __shared__ __attribute__((aligned(16))) unsigned char lds_raw[];
    LAS unsigned char* lds = (LAS unsigned char*)lds_raw;
    volatile LAS unsigned* MISC = (volatile LAS unsigned*)(lds + MISC_OFF);
    const int tid = threadIdx.x, lane = tid & 63, wave = __builtin_amdgcn_readfirstlane(tid >> 6);
    const int G = gridDim.x; const int bx = blockIdx.x; const int vcu = (G % 8 == 0) ? (bx % 8) * (G / 8) + bx / 8 : bx;
    const int gw = vcu * NWAVES + wave, NGW = G * NWAVES;
    unsigned char* ws = args.ws;
    unsigned* ctl = (unsigned*)(ws + WS_CTL);
    const float* x = args.in[0]; const float* norm1_w = args.in[1]; const float* w_in = args.in[2]; const float* lb_logits = args.in[3];
    const float* hgrn_norm_w = args.in[4]; const float* dw_w = args.in[5]; const float* dw_b = args.in[6]; const float* conv_ln_w = args.in[7]; const float* conv_ln_b = args.in[8];
    const float* w_out = args.in[9]; const float* norm2_w = args.in[10]; const float* router_w = args.in[11]; const float* router_b = args.in[12];
    const float* w1 = args.in[13]; const float* b1 = args.in[14]; const float* w2 = args.in[15]; const float* b2 = args.in[16]; const float* final_norm_w = args.in[17];
    float* out = args.out;
    bf16* WI = (bf16*)(ws + WS_WI); bf16* WO = (bf16*)(ws + WS_WO); unsigned char* W1T = ws + WS_W1; unsigned char* W2T = ws + WS_W2;
    float* H = (float*)(ws + WS_H); bf16* XN = (bf16*)(ws + WS_XN);
    bf16* Qb = (bf16*)(ws + WS_Q); bf16* KFb = (bf16*)(ws + WS_KF); bf16* KBb = (bf16*)(ws + WS_KB); bf16* Vb = (bf16*)(ws + WS_V); bf16* Gb = (bf16*)(ws + WS_G); bf16* Ub = (bf16*)(ws + WS_U);
    float* LFb = (float*)(ws + WS_LF); float* LBb = (float*)(ws + WS_LB); float* OFb = (float*)(ws + WS_OF); float* OBb = (float*)(ws + WS_OB);
    bf16* MIX = (bf16*)(ws + WS_MIX); unsigned char* XS = ws + WS_XS; unsigned char* ACT = ws + WS_ACT; unsigned char* N2 = ws + WS_XN; unsigned char* YS = ws + WS_YS;
    float* WRT = (float*)(ws + WS_WRT); int* SLOT = (int*)(ws + WS_SLOT); float* GATE = (float*)(ws + WS_GATE); int* ROWTOK = (int*)(ws + WS_ROWTOK);
    volatile LAS int* bs = (volatile LAS int*)(lds + TAB_OFF);
    volatile LAS int* cl = (volatile LAS int*)(lds + TAB_OFF + 256);
    LAS int* lcnt = (LAS int*)(lds + TAB_OFF + 512);
    volatile LAS int* gbase = (volatile LAS int*)(lds + TAB_OFF + 768);

    for (int u = tid; u < (LDS_BYTES - LDSCTL_OFF) / 4; u += NTHR) ((LAS unsigned*)(lds + LDSCTL_OFF))[u] = 0u;
    __syncthreads();
    XcdBarrier bar; bar.bar = ctl + CW_BAR; bar.x = 0; bar.st = nullptr;
    if (MK_N_LAUNCHES == 1) bar = xcd_barrier_post(ctl + CW_BAR, MISC + 8);
#ifndef PROBE_STAMP
#define PROBE_STAMP -1
#endif
    unsigned long long tS[N_PHASES + 1];
#define STAMP(k) do { if ((PROBE_STAMP) >= 0) tS[k] = __builtin_amdgcn_s_memrealtime(); } while (0)
    const int lo = args.ph_lo, hi = args.ph_hi;
#ifndef PHASE_MASK
#define PHASE_MASK 0xffffffffu
#endif
#define IN(k) ((((PHASE_MASK) >> (k)) & 1u) && lo <= (k) && (k) < hi)
#ifndef PROBE_DUP
#define PROBE_DUP -1
#endif
#define REP(k) _Pragma("unroll 1") for (int rep_ = 0; rep_ < ((PROBE_DUP) == (k) ? 2 + (args.ph_hi >> 20) : 1); ++rep_)
#define SEAM(k) do { if (IN(k) && IN((k) + 1)) { xcd_barrier(bar); if ((PROBE_DUP) == 99) { xcd_barrier(bar); xcd_barrier(bar); } } } while (0)
#define BUILD_BS() do { int t_; asm volatile("v_mov_b32 %0, %1" : "=v"(t_) : "v"(tid));     \
        if (t_ < 64) { const int c_ = t_ < NE ? (int)__hip_atomic_load(ctl + CW_CNT + 64 * (t_ & (NE - 1)), RLX_AGENT) : 0; int x_ = (c_ + 255) >> 8; \
        _Pragma("unroll") for (int o_ = 1; o_ < NE; o_ <<= 1) { const int y_ = __shfl_up(x_, o_); if ((t_ & 63) >= o_) x_ += y_; }     \
        if (t_ < NE) { cl[t_] = c_; bs[t_ + 1] = x_; } if (t_ == 0) bs[0] = 0; } __syncthreads(); } while (0)

    STAMP(0);
    if (IN(0)) REP(0) {
        LAS float* scr = (LAS float*)(lds + RING_OFF + wave * 16384);
        constexpr int I_WI = (D / 64) * (INC / 32), I_WO = (D / 64) * (D / 32), I_W1 = (D / 64) * (2 * FF / 32), I_W2 = (FF / 64) * (D / 32);
        #if defined(HGRN_NAIVE) || defined(W2_IN_P0)
        constexpr int NITEMS = I_WI + I_WO + NE * I_W1 + NE * I_W2;
#else
        constexpr int NITEMS = I_WI + I_WO + W1_P0;
#endif
        {
            const f32x4* wr = (const f32x4*)norm1_w + lane; f32x4 gw4[4];
#pragma unroll
            for (int j = 0; j < 4; ++j) gw4[j] = wr[64 * j];
#pragma unroll 1
            for (int m0 = gw; m0 < MTOK; m0 += 4 * NGW) {
                f32x4 v[4][4];
#pragma unroll
                for (int q4 = 0; q4 < 4; ++q4) { const int m = min(m0 + q4 * NGW, MTOK - 1); const f32x4* xr = (const f32x4*)(x + (size_t)m * D) + lane;
#pragma unroll
                    for (int j = 0; j < 4; ++j) v[q4][j] = xr[64 * j]; }
#pragma unroll
                for (int q4 = 0; q4 < 4; ++q4) { const int m = m0 + q4 * NGW; float sq = 0.f;
#pragma unroll
                    for (int j = 0; j < 4; ++j) sq += (v[q4][j].x * v[q4][j].x + v[q4][j].y * v[q4][j].y) + (v[q4][j].z * v[q4][j].z + v[q4][j].w * v[q4][j].w);
                    const float rstd = rsqrtf(wave_sum(sq) * (1.f / D) + EPS);
                    if (m < MTOK) { v2u* o8 = (v2u*)(XN + (size_t)m * D) + lane;
#pragma unroll
                        for (int j = 0; j < 4; ++j) { v2u o; o.x = pk2(v[q4][j].x * rstd * gw4[j].x, v[q4][j].y * rstd * gw4[j].y); o.y = pk2(v[q4][j].z * rstd * gw4[j].z, v[q4][j].w * rstd * gw4[j].w); o8[64 * j] = o; } }
                }
            }
        }
#if defined(HGRN_NAIVE) || defined(W2_IN_P0)
        for (int it = gw; it < NITEMS; it += NGW) {
            int r = it;
            if (r < I_WI) { p0_item<false>(w_in, D, INC, WI, RmWin(), scr, r, lane); continue; } r -= I_WI;
            if (r < I_WO) { p0_item<false>(w_out, D, D, WO, RmIdent(), scr, r, lane); continue; } r -= I_WO;
            if (r < NE * I_W1) { W1_ITEM(r); continue; } r -= NE * I_W1;
            { const int e = r / I_W2; p0_item<true>(w2 + (size_t)e * FF * D, FF, D, W2T + (size_t)e * D * FF, RmIdent(), scr, r - e * I_W2, lane); }
        }
#else
        (void)NITEMS; (void)I_W2;
        for (int it = gw; it < I_WI + I_WO; it += NGW) { if (it < I_WI) p0_item<false>(w_in, D, INC, WI, RmWin(), scr, it, lane); else p0_item<false>(w_out, D, D, WO, RmIdent(), scr, it - I_WI, lane); }
        convert_range_fp8(w1, D, 2 * FF, W1T, RmW1(), 10, gw, NGW, W1_P0, 0, scr, lane);
#endif
        if ((PROBE_STAMP) == 640) tS[6] = __builtin_amdgcn_s_memrealtime();
        for (int i = bx * NTHR + tid; i < 16 * D; i += G * NTHR) {
            const int r = i >> 4, e16 = i & 15, k = 256 * (r & 3) + (r >> 2); const float gk = norm2_w[k];
            WRT[2 * i] = gk * router_w[k * NE + e16]; WRT[2 * i + 1] = gk * router_w[k * NE + 16 + e16]; }
    }
    if ((PROBE_STAMP) == 600 + 0) tS[6] = __builtin_amdgcn_s_memrealtime();
    SEAM(0);

    STAMP(1);
    if (IN(1)) REP(1) {
        pg8::Gemm g{XN, WI, MTOK, INC, D}; OrderRep S; S.init(MTOK, INC, G, bx); S.reps = ((PROBE_DUP) == 11) ? 2 : 1;
        EpiProj E{Qb, KFb, KBb, Vb, Gb, Ub, LFb, LBb, lb_logits};
        pg8::gemm_phase<EpiProj, OrderRep, true, true>(lds + RING_OFF, g, S, E);
#if !defined(HGRN_NAIVE) && !defined(W2_IN_P0)
        {
            LAS float* scr = (LAS float*)(lds + RING_OFF + wave * 16384);
            if (G == 256) { if (bx >= 128) convert_range_fp8(w1, D, 2 * FF, W1T, RmW1(), 10, (bx - 128) * NWAVES + wave, 128 * NWAVES, W1_P1, W1_P0, scr, lane); }
            else convert_range_fp8(w1, D, 2 * FF, W1T, RmW1(), 10, gw, NGW, W1_P1, W1_P0, scr, lane);
        }
#endif
    }
    if ((PROBE_STAMP) == 600 + 1) tS[6] = __builtin_amdgcn_s_memrealtime();
    SEAM(1);

    STAMP(2);
    if (IN(2)) REP(2) {
        const bool split = (G == 256);
#if defined(HGRN_NAIVE)
        const bool hsel = true; const int hidx = 0, hstride = 1; const bool csel = true; const int cidx = vcu, cstride = G;
#else
        const bool hsel = split ? (((bx >> 3) & 1) != 0) : true; const int hidx = split ? (bx >> 4) * 8 + (bx & 7) : bx, hstride = split ? 128 : G;
        const bool csel = split ? !hsel : true; const int cidx = split ? (bx >> 4) * 8 + (bx & 7) : bx, cstride = split ? 128 : G;
#endif
        (void)hidx; (void)hstride;
        if (csel && PROBE_DELAY == 3) probe_delay(3000); if (csel && PROBE_DELAY == 4) probe_delay(20000);
        if (csel) for (int crep_ = 0; crep_ < ((PROBE_DUP) == 21 ? 2 : 1); ++crep_) {
            LAS unsigned short* ut = (LAS unsigned short*)(lds + RING_OFF);
            LAS float* part = (LAS float*)(lds + RING_OFF + 98304);
            LAS float* stat = (LAS float*)(lds + RING_OFF + 98304 + 4096);
            for (int unit = cidx; unit < NBATCH * (TT / 64); unit += cstride) {
                const int b = unit / (TT / 64), t0 = (unit % (TT / 64)) * 64;
                {
                    v4u val[12];
#pragma unroll
                    for (int i = 0; i < 12; ++i) { const int idx = tid + NTHR * i, r = idx >> 6, p = idx & 63, t = t0 - 15 + r;
                        val[i] = (v4u){0u, 0u, 0u, 0u};
                        if (idx < 94 * 64 && t >= 0 && t < TT) val[i] = *(const v4u*)(Ub + (size_t)(b * TT + t) * CCH + p * 8); }
#pragma unroll
                    for (int i = 0; i < 12; ++i) { const int idx = tid + NTHR * i, r = idx >> 6, p = idx & 63;
                        if (idx < 94 * 64) *(LAS v4u*)(ut + r * 512 + p * 8) = val[i]; }
                }
                __syncthreads(); if ((PROBE_STAMP) == 651 && unit == cidx) tS[6] = __builtin_amdgcn_s_memrealtime();
                const int c = tid;
                float w[CLEN];
#pragma unroll
                for (int j = 0; j < CLEN; ++j) w[j] = dw_w[j * CCH + c];
                const float bias = dw_b[c];
                float y[64];
#pragma unroll
                for (int tb = 0; tb < 8; ++tb) {
                    float win[38];
#pragma unroll
                    for (int i = 0; i < 38; ++i) win[i] = bf2f(ut[(tb * 8 + i) * 512 + c]);
#pragma unroll
                    for (int o = 0; o < 8; ++o) { float a = bias;
#pragma unroll
                        for (int j = 0; j < CLEN; ++j) a += w[j] * win[o + j];
                        y[tb * 8 + o] = a; }
                }
#pragma unroll 1
                for (int pass = 0; pass < 2; ++pass) {
                    float s1[64];
#pragma unroll
                    for (int i = 0; i < 64; ++i) s1[i] = pass ? y[i] * y[i] : y[i];
#pragma unroll
                    for (int s = 32; s >= 1; s >>= 1) {
                        const bool up = (lane & s) != 0;
#pragma unroll
                        for (int i = 0; i < s; ++i) { const float k1 = up ? s1[i + s] : s1[i], x1 = up ? s1[i] : s1[i + s]; s1[i] = k1 + __shfl_xor(x1, s); }
                    }
                    part[(wave * 64 + lane) * 2 + pass] = s1[0];
                }
                __syncthreads(); if ((PROBE_STAMP) == 652 && unit == cidx) tS[6] = __builtin_amdgcn_s_memrealtime();
                if (tid < 64) { float a = 0.f, q = 0.f;
#pragma unroll
                    for (int wv = 0; wv < 8; ++wv) { a += part[(wv * 64 + tid) * 2]; q += part[(wv * 64 + tid) * 2 + 1]; }
                    const float mean = a * (1.f / CCH), var = q * (1.f / CCH) - mean * mean;
                    stat[tid * 2] = mean; stat[tid * 2 + 1] = rsqrtf(fmaxf(var, 0.f) + EPS); }
                __syncthreads();
                const float lw = conv_ln_w[c], lbias = conv_ln_b[c];
#pragma unroll
                for (int t = 0; t < 64; ++t) {
                    const float v = (y[t] - stat[t * 2]) * stat[t * 2 + 1] * lw + lbias;
                    MIX[(size_t)(b * TT + t0 + t) * D + 512 + c] = (bf16)(pk2(v * sigm(v), 0.f) & 0xffffu);
                }
                __syncthreads(); if ((PROBE_STAMP) == 653 && unit == cidx) tS[6] = __builtin_amdgcn_s_memrealtime();
            }
            if ((PROBE_STAMP) == 650) tS[6] = __builtin_amdgcn_s_memrealtime();
#if !defined(HGRN_NAIVE) && !defined(W2_IN_P0)
            {
                LAS float* scr = (LAS float*)(lds + RING_OFF + wave * 16384);
                constexpr int I_W2 = (FF / 64) * (D / 32);
                convert_range_fp8(w2, FF, D, W2T, RmIdent(), 9, cidx * NWAVES + wave, cstride * NWAVES, W2_P2, 0, scr, lane);
                convert_range_fp8(w1, D, 2 * FF, W1T, RmW1(), 10, cidx * NWAVES + wave, cstride * NWAVES, W1_P2, W1_P0 + W1_P1, scr, lane);
            }
#endif
        }
#if defined(HGRN_NAIVE)
        {
            LAS float* qs = (LAS float*)(lds + RING_OFF); LAS float* ks = qs + 2048; LAS float* fs = ks + 2048; LAS float* vs = fs + 2048; LAS float* op = vs + 2048;
            const int e = tid & 127, dq = tid >> 7;
            for (int unit = G - 1 - bx; unit < NBATCH * NH * 2; unit += G) {
                const int dir = unit & 1, h = (unit >> 1) & 3, b = unit >> 3;
                const bf16* Kp = dir ? KBb : KFb; const float* Lp = dir ? LBb : LFb; float* Op = dir ? OBb : OFb;
                float S[32];
#pragma unroll
                for (int i = 0; i < 32; ++i) S[i] = 0.f;
                for (int blk = 0; blk < TT / 16; ++blk) {
                    const int tb = dir ? (TT - 16 - blk * 16) : blk * 16;
#pragma unroll
                    for (int i = 0; i < 4; ++i) { const int idx = tid + NTHR * i, r = idx >> 7, d = idx & 127; const size_t off = (size_t)(b * TT + tb + r) * 512 + h * 128 + d;
                        qs[idx] = bf2f(Qb[off]); ks[idx] = bf2f(Kp[off]); fs[idx] = __expf(Lp[off]); vs[idx] = bf2f(Vb[off]); }
                    __syncthreads();
                    for (int st = 0; st < 16; ++st) {
                        const int r = dir ? 15 - st : st; const float v = vs[r * 128 + e]; float o = 0.f;
#pragma unroll
                        for (int dd = 0; dd < 32; ++dd) { const int d = dq * 32 + dd; S[dd] = fs[r * 128 + d] * S[dd] + ks[r * 128 + d] * v; o += qs[r * 128 + d] * S[dd]; }
                        op[(r * 4 + dq) * 128 + e] = o;
                    }
                    __syncthreads();
#pragma unroll
                    for (int i = 0; i < 4; ++i) { const int idx = tid + NTHR * i, r = idx >> 7, ee = idx & 127;
                        Op[(size_t)(b * TT + tb + r) * 512 + h * 128 + ee] = (op[(r * 4 + 0) * 128 + ee] + op[(r * 4 + 1) * 128 + ee]) + (op[(r * 4 + 2) * 128 + ee] + op[(r * 4 + 3) * 128 + ee]); }
                }
                __syncthreads();
            }
        }
#else
        if (hsel) for (int unit = hidx; unit < NBATCH * NH * 4 * ((PROBE_DUP) == 20 ? 2 : 1); unit += hstride) HGRN_FN(lds + RING_OFF, unit & (NBATCH * NH * 4 - 1), Qb, KFb, KBb, Vb, LFb, LBb, OFb, OBb, tid, lane, wave);
#endif
    }
    if ((PROBE_STAMP) == 600 + 2) tS[6] = __builtin_amdgcn_s_memrealtime();
    SEAM(2);

    STAMP(3);
    if (IN(3)) REP(3) {
        for (int m = gw; m < MTOK; m += NGW) {
            const size_t off = (size_t)m * 512 + lane * 8;
#if defined(HGRN_V2)
            const v4u ua = *(const v4u*)((const bf16*)OFb + off), uc = *(const v4u*)((const bf16*)OBb + off);
            const f32x4 a0 = (f32x4){bf2f(ua.x & 0xffffu), bf2f(ua.x >> 16), bf2f(ua.y & 0xffffu), bf2f(ua.y >> 16)}, a1 = (f32x4){bf2f(ua.z & 0xffffu), bf2f(ua.z >> 16), bf2f(ua.w & 0xffffu), bf2f(ua.w >> 16)};
            const f32x4 c0 = (f32x4){bf2f(uc.x & 0xffffu), bf2f(uc.x >> 16), bf2f(uc.y & 0xffffu), bf2f(uc.y >> 16)}, c1 = (f32x4){bf2f(uc.z & 0xffffu), bf2f(uc.z >> 16), bf2f(uc.w & 0xffffu), bf2f(uc.w >> 16)};
#else
            const f32x4 a0 = *(const f32x4*)(OFb + off), a1 = *(const f32x4*)(OFb + off + 4), c0 = *(const f32x4*)(OBb + off), c1 = *(const f32x4*)(OBb + off + 4);
#endif
            const f32x4 o0 = a0 + c0, o1 = a1 + c1;
            float ss = (o0.x * o0.x + o0.y * o0.y) + (o0.z * o0.z + o0.w * o0.w) + (o1.x * o1.x + o1.y * o1.y) + (o1.z * o1.z + o1.w * o1.w);
            ss += __shfl_xor(ss, 1); ss += __shfl_xor(ss, 2); ss += __shfl_xor(ss, 4); ss += __shfl_xor(ss, 8);
            const float rstd = rsqrtf(ss * (1.f / DV) + EPS);
            const v4u gv = *(const v4u*)(Gb + off);
            const f32x4 w0 = *(const f32x4*)(hgrn_norm_w + lane * 8), w1v = *(const f32x4*)(hgrn_norm_w + lane * 8 + 4);
            f32x4 r0, r1;
            r0.x = o0.x * rstd * w0.x * bf2f(gv.x & 0xffffu); r0.y = o0.y * rstd * w0.y * bf2f(gv.x >> 16);
            r0.z = o0.z * rstd * w0.z * bf2f(gv.y & 0xffffu); r0.w = o0.w * rstd * w0.w * bf2f(gv.y >> 16);
            r1.x = o1.x * rstd * w1v.x * bf2f(gv.z & 0xffffu); r1.y = o1.y * rstd * w1v.y * bf2f(gv.z >> 16);
            r1.z = o1.z * rstd * w1v.z * bf2f(gv.w & 0xffffu); r1.w = o1.w * rstd * w1v.w * bf2f(gv.w >> 16);
            st8bf(MIX + (size_t)m * D + lane * 8, r0, r1);
        }
    }
    if ((PROBE_STAMP) == 600 + 3) tS[6] = __builtin_amdgcn_s_memrealtime();
    SEAM(3);

    STAMP(4);
    if (IN(4)) REP(4) {
        pg8::Gemm g{MIX, WO, MTOK, D, D}; pg8::StaticOrder S; S.init(MTOK, D, G, bx);
        EpiRes E{x, H};
        pg8::gemm_phase<EpiRes, pg8::StaticOrder, true, true>(lds + RING_OFF, g, S, E);
    }
    if ((PROBE_STAMP) == 600 + 4) tS[6] = __builtin_amdgcn_s_memrealtime();
    SEAM(4);

    STAMP(5);
    if (IN(5)) REP(5) {
        typedef float f32x2 __attribute__((ext_vector_type(2)));
        LAS float* wl = (LAS float*)(lds + RING_OFF);
        LAS unsigned* sb = (LAS unsigned*)(lds + SB_OFF);
        { f32x4 tv_[NE * D / 4 / NTHR];
#pragma unroll
            for (int i = 0; i < NE * D / 4 / NTHR; ++i) tv_[i] = ((const f32x4*)WRT)[tid + NTHR * i];
#pragma unroll
            for (int i = 0; i < NE * D / 4 / NTHR; ++i) ((LAS f32x4*)wl)[tid + NTHR * i] = tv_[i]; }
        if (tid < NE) lcnt[tid] = 0;
        __syncthreads();
        for (int tg = vcu; tg < MTOK / 64; tg += G) {
            const int tok0 = tg * 64 + 16 * (wave & 3);
            if (wave < 4) {
                const int j = lane & 15, q = lane >> 4;
                const f32x4* hrow = (const f32x4*)(H + (size_t)(tok0 + j) * D + 256 * q);
                const LAS f32x2* tab = (const LAS f32x2*)wl + q * 16 + j;
                f32x4 acc0 = (f32x4){0.f, 0.f, 0.f, 0.f}, acc1 = acc0; float ss = 0.f;
                f32x4 hb[8], hn[8];
#pragma unroll
                for (int i = 0; i < 8; ++i) hb[i] = hrow[i];
#pragma unroll 1
                for (int blk = 0; blk < 8; ++blk) {
                    if (blk + 1 < 8) {
#pragma unroll
                        for (int i = 0; i < 8; ++i) hn[i] = hrow[(blk + 1) * 8 + i];
                    }
#pragma unroll
                    for (int i = 0; i < 8; ++i) {
                        const f32x4 hc = hb[i]; const int s4 = blk * 8 + i;
                        f32x2 w[4];
#pragma unroll
                        for (int u = 0; u < 4; ++u) w[u] = tab[(4 * s4 + u) * 64];
                        ss += (hc.x * hc.x + hc.y * hc.y) + (hc.z * hc.z + hc.w * hc.w);
#pragma unroll
                        for (int u = 0; u < 4; ++u) { acc0 = __builtin_amdgcn_mfma_f32_16x16x4f32(w[u].x, hc[u], acc0, 0, 0, 0); acc1 = __builtin_amdgcn_mfma_f32_16x16x4f32(w[u].y, hc[u], acc1, 0, 0, 0); }
                    }
#pragma unroll
                    for (int i = 0; i < 8; ++i) hb[i] = hn[i];
                }
                ss += __shfl_xor(ss, 16); ss += __shfl_xor(ss, 32);
                const float rstd = rsqrtf(ss * (1.f / D) + EPS);
                float lg[8];
#pragma unroll
                for (int r = 0; r < 4; ++r) { lg[r] = acc0[r] * rstd + router_b[4 * q + r]; lg[4 + r] = acc1[r] * rstd + router_b[16 + 4 * q + r]; }
                float tv[TOPK]; int ti[TOPK];
#pragma unroll
                for (int k = 0; k < TOPK; ++k) {
                    float bv = lg[0]; int bi = 4 * q;
#pragma unroll
                    for (int r = 1; r < 8; ++r) { const int id = (r < 4) ? 4 * q + r : 16 + 4 * q + (r - 4); if (lg[r] > bv) { bv = lg[r]; bi = id; } }
#pragma unroll
                    for (int o = 16; o < 64; o <<= 1) { const float ov = __shfl_xor(bv, o); const int oi = __shfl_xor(bi, o); if (ov > bv || (ov == bv && oi < bi)) { bv = ov; bi = oi; } }
                    tv[k] = bv; ti[k] = bi;
#pragma unroll
                    for (int r = 0; r < 8; ++r) { const int id = (r < 4) ? 4 * q + r : 16 + 4 * q + (r - 4); if (id == bi) lg[r] = -INFINITY; }
                }
                const float e1 = __expf(tv[1] - tv[0]), e2 = __expf(tv[2] - tv[0]), e3 = __expf(tv[3] - tv[0]);
                const float inv = 1.0f / (1.0f + e1 + e2 + e3);
                {
                    const int ek = q == 0 ? ti[0] : q == 1 ? ti[1] : q == 2 ? ti[2] : ti[3];
                    const float gk = (q == 0 ? 1.0f : q == 1 ? e1 : q == 2 ? e2 : e3) * inv;
                    const int lr = __hip_atomic_fetch_add(&lcnt[ek], 1, __ATOMIC_RELAXED, __HIP_MEMORY_SCOPE_WORKGROUP);
                    sb[(16 * wave + j) * 4 + q] = ((unsigned)ek << 16) | (unsigned)lr;
                    GATE[(size_t)(tok0 + j) * TOPK + q] = gk;
                }
            } else {
                const f32x4* wr = (const f32x4*)norm2_w + lane;
                f32x4 gw4[4];
#pragma unroll
                for (int jj = 0; jj < 4; ++jj) gw4[jj] = wr[64 * jj];
#pragma unroll 1
                for (int i = 0; i < 16; i += 4) {
                    f32x4 v[4][4];
#pragma unroll
                    for (int q4 = 0; q4 < 4; ++q4) { const f32x4* hr = (const f32x4*)(H + (size_t)(tok0 + i + q4) * D) + lane;
#pragma unroll
                        for (int jj = 0; jj < 4; ++jj) v[q4][jj] = hr[64 * jj]; }
#pragma unroll
                    for (int q4 = 0; q4 < 4; ++q4) {
                        float s2 = 0.f;
#pragma unroll
                        for (int jj = 0; jj < 4; ++jj) s2 += (v[q4][jj].x * v[q4][jj].x + v[q4][jj].y * v[q4][jj].y) + (v[q4][jj].z * v[q4][jj].z + v[q4][jj].w * v[q4][jj].w);
                        const float rstd = rsqrtf(wave_sum(s2) * (1.f / D) + EPS) * SC_N2;
                        unsigned* o4 = (unsigned*)(N2 + (size_t)(tok0 + i + q4) * D) + lane;
#pragma unroll
                        for (int jj = 0; jj < 4; ++jj) o4[64 * jj] = pk4_fp8(v[q4][jj].x * rstd * gw4[jj].x, v[q4][jj].y * rstd * gw4[jj].y, v[q4][jj].z * rstd * gw4[jj].z, v[q4][jj].w * rstd * gw4[jj].w);
                    }
                }
            }
            __syncthreads();
            if (tid < NE) { const int c = lcnt[tid]; gbase[tid] = c ? (int)__hip_atomic_fetch_add(ctl + CW_CNT + ((PROBE_DUP) == 5 && rep_ == 0 ? 4096 : 0) + 64 * tid, (unsigned)c, RLX_AGENT) : 0; }
            __syncthreads();
            if (tid < 256) { const unsigned w = sb[tid]; const int ek = (int)(w >> 16), r = gbase[ek] + (int)(w & 0xffffu), m = tg * 64 + (tid >> 2);
                ROWTOK[ek * MTOK + r] = m; SLOT[(size_t)m * TOPK + (tid & 3)] = ek * MTOK + r; }
            if (tid < NE) lcnt[tid] = 0;
            __syncthreads();
        }
    }
    if ((PROBE_STAMP) == 600 + 5) tS[6] = __builtin_amdgcn_s_memrealtime();
    SEAM(5);


    if ((PROBE_STAMP) < 600 || (PROBE_STAMP) > 699) STAMP(6);
    STAMP(7);
#if defined(MOE_MERGED)
    if (IN(7)) REP(7) {
        BUILD_BS();
        pg8::Gemm g{(const bf16*)ws, (const bf16*)W1T, MTOK, 2 * FF, D / 2}; MoeOrder2 S{bs, G, vcu, cl, ROWTOK, ctl};
        EpiMoe E{EpiSwiglu{ACT, b1}, EpiDown{YS, b2}};
        pg8::gemm_phase<EpiMoe, MoeOrder2, true, true, true, true>(lds + RING_OFF, g, S, E);
    }
    if ((PROBE_STAMP) == 600 + 8) tS[6] = __builtin_amdgcn_s_memrealtime();
    SEAM(8);
#else
    if (IN(7)) REP(7) {
        BUILD_BS();
        pg8::Gemm g{(const bf16*)N2, (const bf16*)W1T, MTOK, 2 * FF, D / 2}; MoeOrder S{bs, 8, G, vcu, cl, ROWTOK};
        EpiSwiglu E{ACT, b1};
        pg8::gemm_phase<EpiSwiglu, MoeOrder, true, true, true, true>(lds + RING_OFF, g, S, E);
#if !defined(HGRN_NAIVE) && !defined(W2_IN_P0)
        {
            LAS float* scr = (LAS float*)(lds + RING_OFF + wave * 16384);
            const int r7 = (bs[NE] * 8) % G, nsl = G - r7;
            if (vcu >= r7) convert_range_fp8(w2, FF, D, W2T, RmIdent(), 9, (vcu - r7) * NWAVES + wave, nsl * NWAVES, W2_P7, W2_P2, scr, lane);
        }
#endif
    }
    if ((PROBE_STAMP) == 600 + 7) tS[6] = __builtin_amdgcn_s_memrealtime();
    SEAM(7);

    STAMP(8);
    if (IN(8)) REP(8) {
        BUILD_BS();
        pg8::Gemm g{(const bf16*)ACT, (const bf16*)W2T, MOE_ROWS, D, FF / 2}; MoeOrder S{bs, 4, G, vcu, cl, ROWTOK};
        EpiDown E{YS, b2};
        pg8::gemm_phase<EpiDown, MoeOrder, true, true, true>(lds + RING_OFF, g, S, E);
    }
    SEAM(8);
#endif

    STAMP(9);
    if (IN(9)) REP(9) {
        BUILD_BS();
        for (int base = gw; base < MTOK; base += 16 * NGW) {
            const int mi = base + NGW * (lane >> 2); int posl = 0; float gl = 0.f;
            if (mi < MTOK) { const int sl = SLOT[(size_t)mi * TOPK + (lane & 3)]; gl = GATE[(size_t)mi * TOPK + (lane & 3)]; posl = bs[sl >> 14] * 256 + (sl & (MTOK - 1)); }
#pragma unroll 2
            for (int i = 0; i < 16; ++i) {
                const int m = base + NGW * i; if (m >= MTOK) break;
                const f32x4* hr = (const f32x4*)(H + (size_t)m * D) + lane; const f32x4* wr = (const f32x4*)final_norm_w + lane;
                int pos[TOPK]; float gk[TOPK];
#pragma unroll
                for (int k = 0; k < TOPK; ++k) { pos[k] = __shfl(posl, 4 * i + k); gk[k] = __shfl(gl, 4 * i + k); }
                f32x4 v[4]; unsigned yw[TOPK][4];
#pragma unroll
                for (int j = 0; j < 4; ++j) v[j] = hr[64 * j];
#pragma unroll
                for (int k = 0; k < TOPK; ++k) { const unsigned* yr = (const unsigned*)(YS + (size_t)pos[k] * D) + lane;
#pragma unroll
                    for (int j = 0; j < 4; ++j) yw[k][j] = yr[64 * j]; }
#pragma unroll
                for (int k = 0; k < TOPK; ++k)
#pragma unroll
                    for (int j = 0; j < 4; ++j) { const f32x2_t lo = __builtin_amdgcn_cvt_pk_f32_fp8((int)yw[k][j], false), hi = __builtin_amdgcn_cvt_pk_f32_fp8((int)yw[k][j], true); const float g = gk[k] * (1.0f / SC_YS);
                        v[j].x += g * lo.x; v[j].y += g * lo.y; v[j].z += g * hi.x; v[j].w += g * hi.y; }
                float s = 0.f;
#pragma unroll
                for (int j = 0; j < 4; ++j) s += (v[j].x * v[j].x + v[j].y * v[j].y) + (v[j].z * v[j].z + v[j].w * v[j].w);
                const float rstd = rsqrtf(wave_sum(s) * (1.f / D) + EPS);
                f32x4* orow = (f32x4*)(out + (size_t)m * D) + lane;
#pragma unroll
                for (int j = 0; j < 4; ++j) orow[64 * j] = v[j] * rstd * wr[64 * j];
            }
        }
    }
    STAMP(N_PHASES);
#ifndef PROBE_WG
#define PROBE_WG 0
#endif
    if ((PROBE_STAMP) >= 660 && (PROBE_STAMP) <= 669 && bx == (PROBE_WG)) {
        const unsigned long long a_ = *(volatile LAS unsigned long long*)(lds + LDSCTL_OFF + 640), b_ = *(volatile LAS unsigned long long*)(lds + LDSCTL_OFF + 648);
        const unsigned long long d = 64ull * (b_ - a_), t0 = __builtin_amdgcn_s_memrealtime();
        while (__builtin_amdgcn_s_memrealtime() - t0 < d) __builtin_amdgcn_s_sleep(8);
    } else
    if ((PROBE_STAMP) >= 0 && bx == (PROBE_WG)) {
        const int k0 = (PROBE_STAMP) == 640 ? 0 : ((PROBE_STAMP) >= 650 && (PROBE_STAMP) <= 659) ? 2 : (PROBE_STAMP) % 100, k1 = ((PROBE_STAMP) >= 100) ? (PROBE_STAMP) / 100 : k0 + 1;
        const unsigned long long d = 2ull * (tS[k1 > N_PHASES ? N_PHASES : k1] - tS[k0]), t0 = __builtin_amdgcn_s_memrealtime();
        while (__builtin_amdgcn_s_memrealtime() - t0 < d) __builtin_amdgcn_s_sleep(8);
    }
#undef IN
#undef SEAM
#undef BUILD_BS
}

extern "C" void kernel_launch(void* const* d_in, const int* in_sizes, int n_in, void* d_out, int out_size, void* d_ws, size_t ws_size, hipStream_t stream) {
    static int grid = 0;
    if (grid == 0) {
        if (n_in != 18 || in_sizes[0] != MTOK * D || out_size != MTOK * D || ws_size < WS_END) { fprintf(stderr, "kernel_launch: unexpected shapes (n_in %d, in0 %d, out %d, ws %zu < %zu); nothing launched\n", n_in, n_in > 0 ? in_sizes[0] : -1, out_size, ws_size, (size_t)WS_END); grid = -1; return; }
        int dev = 0, cus = 0, per_cu = 0;
        if (hipGetDevice(&dev) != hipSuccess || hipDeviceGetAttribute(&cus, hipDeviceAttributeMultiprocessorCount, dev) != hipSuccess) { fprintf(stderr, "kernel_launch: device query failed\n"); grid = -1; return; }
        if (hipFuncSetAttribute((const void*)fwd_kernel, hipFuncAttributeMaxDynamicSharedMemorySize, LDS_BYTES) != hipSuccess) { fprintf(stderr, "kernel_launch: hipFuncSetAttribute failed\n"); grid = -1; return; }
        if (hipOccupancyMaxActiveBlocksPerMultiprocessor(&per_cu, (const void*)fwd_kernel, NTHR, LDS_BYTES) != hipSuccess || per_cu < 1)
            fprintf(stderr, "kernel_launch: note: occupancy query reports %d workgroups per CU\n", per_cu);
        (void)hipGetLastError();
        grid = cus;
    }
    if (grid < 0) return;
    if (hipMemsetAsync((char*)d_ws + WS_CTL, 0, CTL_ZERO_BYTES, stream) != hipSuccess) { fprintf(stderr, "kernel_launch: memset failed\n"); return; }
    Args a{};
    for (int i = 0; i < 18; ++i) a.in[i] = (const float*)d_in[i];
    a.out = (float*)d_out; a.ws = (unsigned char*)d_ws;
#if MK_N_LAUNCHES == 1
    a.ph_lo = 0; a.ph_hi = N_PHASES;
    hipLaunchKernelGGL(fwd_kernel, dim3(grid), dim3(NTHR), LDS_BYTES, stream, a);
#else
    for (int ph = 0; ph < N_PHASES; ++ph) { a.ph_lo = ph; a.ph_hi = ph + 1; hipLaunchKernelGGL(fwd_kernel, dim3(grid), dim3(NTHR), LDS_BYTES, stream, a); }
#endif
    const hipError_t le = hipPeekAtLastError();
    if (le != hipSuccess) fprintf(stderr, "kernel_launch: launch failed: %s\n", hipGetErrorName(le));
}
```

```cpp
#define HGRN_V2 1
#include <hip/hip_runtime.h>
#include <cstdio>
#include <cstdint>
namespace pg8 {
#define PG8_LAS __attribute__((address_space(3)))
typedef unsigned short bf16_t;
typedef short bf16x8 __attribute__((ext_vector_type(8)));
typedef float f32x4 __attribute__((ext_vector_type(4)));
typedef unsigned u32x4 __attribute__((ext_vector_type(4)));
constexpr int BM = 256, BK = 64, HALF = 128, HTB = HALF * BK * 2  , STAGE_BYTES = 8 * HTB, NXCD = 8, WGM = 8;

__host__ __device__ __forceinline__ int lds_byte(int r, int c) { const int st = (r >> 4) * 2 + (c >> 5), rr = r & 15, cc = c & 31, ob = rr * 64 + cc * 2; return st * 1024 + (ob ^ (((ob >> 9) & 1) << 5)); }
__host__ __device__ __forceinline__ void stage_rc(int b, int& R, int& C) { const int st = b / 1024, sb = b % 1024, swz = sb ^ (((sb >> 9) & 1) << 5); R = (st >> 1) * 16 + swz / 64; C = (st & 1) * 32 + (swz % 64) / 2; }
__host__ __device__ __forceinline__ int perm32(int rho) { const int n = rho >> 4, i = rho & 15; return 8 * (i >> 2) + 4 * n + (i & 3); }

struct Unit { int pm, pn; };
struct Gemm { const bf16_t* A; const bf16_t* Bt; int M, N, K; };

struct StaticOrder {
    int nM, nN, nwg, G, c;
    __host__ __device__ void init(int M, int N, int G_, int c_) { nM = M / BM; nN = N / BM; nwg = nM * nN; G = G_; c = c_; }
    __host__ __device__ bool next(int i, Unit& u) const {
        const long L = (long)i * G + c; if (L >= nwg) return false;
        int wgid = (int)L; { const int q = nwg / NXCD, r = nwg % NXCD, xcd = wgid % NXCD, off = wgid / NXCD; wgid = (xcd < r ? xcd * (q + 1) : r * (q + 1) + (xcd - r) * q) + off; }
        const int nig = WGM * nN, gid = wgid / nig, fm = gid * WGM, gsz = (nM - fm) < WGM ? (nM - fm) : WGM;
        u.pm = fm + ((wgid % nig) % gsz); u.pn = (wgid % nig) / gsz; return true;
    }
    __device__ __forceinline__ void a_ready(const Unit&) const {}
    __device__ __forceinline__ void done(const Unit&) const {}
    __device__ __forceinline__ int done_defer(const Unit&) const { return -1; }
    __device__ __forceinline__ void done_signal(int) const {}
};
__device__ __forceinline__ unsigned cvt_pk_bf16(float lo, float hi) { unsigned r; asm volatile("v_cvt_pk_bf16_f32 %0, %1, %2" : "=v"(r) : "v"(lo), "v"(hi)); return r; }
typedef float f32x2 __attribute__((ext_vector_type(2)));
template <class Epi, class Sched, bool ALIGN_EPI = false, bool SP2 = false, bool FP8 = false, bool GATHER = false>
__device__ __forceinline__ void gemm_phase(PG8_LAS unsigned char* lds, const Gemm g, const Sched& S, const Epi& E) {
    typedef int v4i_t __attribute__((ext_vector_type(4)));
    const int tid = threadIdx.x, wid = __builtin_amdgcn_readfirstlane(tid >> 6), lane = tid & 63, wr = wid >> 2, wc = wid & 3, fr = lane & 15, fq = lane >> 4;
    const int K = g.K, nt = K / BK;
    unsigned voffA[2], voffB[2];
#pragma unroll
    for (int i = 0; i < 2; ++i) { int R, C; stage_rc(tid * 16 + i * 8192, R, C); const int Rb = Epi::PERM ? ((R & ~31) + perm32(R & 31)) : R;
        voffA[i] = (unsigned)(R * K + C) * 2u; voffB[i] = (unsigned)(Rb * K + C) * 2u; }
    int rowA[2]; unsigned colA[2];
#pragma unroll
    for (int i = 0; i < 2; ++i) { int R, C; stage_rc(tid * 16 + i * 8192, R, C); rowA[i] = R; colA[i] = (unsigned)C * 2u; }
    const size_t kstep = (size_t)(BK * 2);
    const size_t hstep = (size_t)HALF * K * 2;
    const size_t tstep = 2 * hstep;
    const unsigned ldsw = (unsigned)wid * 1024u;
    const int aoff = lds_byte(wr * 64 + fr, fq * 8), boff = lds_byte(wc * 32 + fr, fq * 8);
#define PG8_SA(b, h) (((b) * 2 + (h)) * HTB)
#define PG8_SB(b, h) ((4 + (b) * 2 + (h)) * HTB)
#define PG8_STAGE(bufoff, gbase, voff) do { _Pragma("unroll") for (int _i = 0; _i < 2; ++_i) \
        __builtin_amdgcn_global_load_lds((const unsigned*)((const char*)(gbase) + (voff)[_i]), (PG8_LAS unsigned*)(lds + (bufoff) + ldsw + _i * 8192), 16, 0, 0); } while (0)
#define PG8_STAGE2(bufoff, gbase, o0, o1) do { \
        __builtin_amdgcn_global_load_lds((const unsigned*)((const char*)(gbase) + (o0)), (PG8_LAS unsigned*)(lds + (bufoff) + ldsw), 16, 0, 0); \
        __builtin_amdgcn_global_load_lds((const unsigned*)((const char*)(gbase) + (o1)), (PG8_LAS unsigned*)(lds + (bufoff) + ldsw + 8192), 16, 0, 0); } while (0)
#define PG8_LDA(dst, b, h) do { _Pragma("unroll") for (int m = 0; m < 4; ++m) _Pragma("unroll") for (int k = 0; k < 2; ++k) dst[m][k] = *(const PG8_LAS bf16x8*)(lds + PG8_SA(b, h) + aoff + m * 2048 + k * 1024); } while (0)
#define PG8_LDB(dst, b, h) do { _Pragma("unroll") for (int n = 0; n < 2; ++n) _Pragma("unroll") for (int k = 0; k < 2; ++k) dst[n][k] = *(const PG8_LAS bf16x8*)(lds + PG8_SB(b, h) + boff + n * 2048 + k * 1024); } while (0)
#define PG8_MMA(ai, bj, At, Bt) do { __builtin_amdgcn_s_setprio(1); _Pragma("unroll") for (int m = 0; m < 4; ++m) _Pragma("unroll") for (int n = 0; n < 2; ++n) { \
        if constexpr (FP8) { asm volatile("v_mfma_f32_16x16x128_f8f6f4 %0, %1, %2, %0" : "+v"(acc[ai][bj][m][n]) : "v"(__builtin_shufflevector((v4i_t)Bt[n][0], (v4i_t)Bt[n][1], 0, 1, 2, 3, 4, 5, 6, 7)), "v"(__builtin_shufflevector((v4i_t)At[m][0], (v4i_t)At[m][1], 0, 1, 2, 3, 4, 5, 6, 7))); } \
        else { _Pragma("unroll") for (int k = 0; k < 2; ++k) acc[ai][bj][m][n] = __builtin_amdgcn_mfma_f32_16x16x32_bf16(Bt[n][k], At[m][k], acc[ai][bj][m][n], 0, 0, 0); } } __builtin_amdgcn_s_setprio(0); } while (0)
#define PG8_WAIT_V(n) asm volatile("s_waitcnt vmcnt(" #n ")" ::: "memory")
#define PG8_WAIT_L(n) asm volatile("s_waitcnt lgkmcnt(" #n ")" ::: "memory")
#define PG8_BAR __builtin_amdgcn_s_barrier()
#define PG8_SCHED __builtin_amdgcn_sched_barrier(0)
    Unit cur, nxt; int ui = 0; int pend = -1;
    if (!S.next(0, cur)) return;
    f32x4 acc[2][2][4][2];
#pragma unroll
    for (int a = 0; a < 2; ++a)
#pragma unroll
        for (int b = 0; b < 2; ++b)
#pragma unroll
            for (int m = 0; m < 4; ++m)
#pragma unroll
                for (int n = 0; n < 2; ++n) acc[a][b][m][n] = (f32x4){0.f, 0.f, 0.f, 0.f};
    bf16x8 At[4][2], B0[2][2], B1[2][2];
    const char* cA = (const char*)g.A + (size_t)cur.pm * tstep; const char* cB = (const char*)g.Bt + (size_t)cur.pn * tstep;
    unsigned oA[2][2], nOA[2][2]; int tk[2][2] = {{0, 0}, {0, 0}};
    if constexpr (GATHER) {
        cA = (const char*)g.A;
        const int nv = S.a_valid(cur); const unsigned ab = S.a_base(cur);
        if (S.a_is_list(cur)) { const int* lst = S.a_list(cur);
#pragma unroll
            for (int h = 0; h < 2; ++h)
#pragma unroll
                for (int i = 0; i < 2; ++i) { const int r = min(h * HALF + rowA[i], nv - 1); oA[h][i] = ab + (unsigned)lst[r] * (unsigned)(K * 2) + colA[i]; }
        } else { const int r0 = S.a_row0(cur);
#pragma unroll
            for (int h = 0; h < 2; ++h)
#pragma unroll
                for (int i = 0; i < 2; ++i) { const int r = min(h * HALF + rowA[i], nv - 1); oA[h][i] = ab + (unsigned)(r0 + r) * (unsigned)(K * 2) + colA[i]; }
        }
    } else {
#pragma unroll
        for (int h = 0; h < 2; ++h)
#pragma unroll
            for (int i = 0; i < 2; ++i) oA[h][i] = voffA[i] + (unsigned)(h * hstep);
    }
#pragma unroll
    for (int h = 0; h < 2; ++h)
#pragma unroll
        for (int i = 0; i < 2; ++i) nOA[h][i] = oA[h][i];
#define PG8_OSEL(h, i) (GATHER ? (last ? nOA[h][i] : oA[h][i]) : oA[h][i])
    S.a_ready(cur);
    if constexpr (SP2) {
        PG8_STAGE(PG8_SB(0, 0), cB, voffB); PG8_STAGE(PG8_SB(0, 1), cB + hstep, voffB); PG8_STAGE2(PG8_SA(0, 0), cA, oA[0][0], oA[0][1]); PG8_STAGE2(PG8_SA(0, 1), cA, oA[1][0], oA[1][1]);
        if (wr == 1) PG8_BAR;
        PG8_WAIT_V(2); PG8_BAR;
        PG8_STAGE(PG8_SB(1, 0), cB + kstep, voffB); PG8_STAGE2(PG8_SA(1, 0), cA + kstep, oA[0][0], oA[0][1]); PG8_STAGE(PG8_SB(1, 1), cB + hstep + kstep, voffB);
        PG8_WAIT_V(6); PG8_BAR;
    } else {
        PG8_STAGE(PG8_SB(0, 0), cB, voffB); PG8_STAGE(PG8_SA(0, 0), cA, voffA); PG8_STAGE(PG8_SB(0, 1), cB + hstep, voffB); PG8_STAGE(PG8_SA(0, 1), cA + hstep, voffA);
        if (wr == 1) PG8_BAR;
        PG8_WAIT_V(4); PG8_BAR;
        PG8_STAGE(PG8_SB(1, 0), cB + kstep, voffB); PG8_STAGE(PG8_SA(1, 0), cA + kstep, voffA); PG8_STAGE(PG8_SB(1, 1), cB + hstep + kstep, voffB);
        PG8_WAIT_V(6); PG8_BAR;
    }
    for (;;) {
        const bool has_next = S.next(ui + 1, nxt);
        const char* nA = GATHER ? cA : (has_next ? (const char*)g.A + (size_t)nxt.pm * tstep : cA); const char* nB = has_next ? (const char*)g.Bt + (size_t)nxt.pn * tstep : cB;
        if constexpr (GATHER) { if (has_next) { const int nv = S.a_valid(nxt);
            if (S.a_is_list(nxt)) { const int* lst = S.a_list(nxt);
#pragma unroll
                for (int h = 0; h < 2; ++h)
#pragma unroll
                    for (int i = 0; i < 2; ++i) { const int* pp = lst + min(h * HALF + rowA[i], nv - 1); asm volatile("global_load_dword %0, %1, off" : "=v"(tk[h][i]) : "v"(pp) : "memory"); }
            } else { const int r0 = S.a_row0(nxt);
#pragma unroll
                for (int h = 0; h < 2; ++h)
#pragma unroll
                    for (int i = 0; i < 2; ++i) tk[h][i] = r0 + min(h * HALF + rowA[i], nv - 1);
            } } }
        for (int t = 0; t < nt; t += 2) {
            const bool last = (t == nt - 2);
            const char* a1 = cA + (size_t)(t + 1) * kstep;
            const char* a2 = last ? nA : cA + (size_t)(t + 2) * kstep; const char* b2 = last ? nB : cB + (size_t)(t + 2) * kstep;
            const char* a3 = a2 + kstep; const char* b3 = b2 + kstep;
            if (last && has_next) S.a_ready(nxt);
            if constexpr (GATHER) { if (last && has_next) { asm volatile("" : "+v"(tk[0][0]), "+v"(tk[0][1]), "+v"(tk[1][0]), "+v"(tk[1][1]));
#pragma unroll
                for (int h = 0; h < 2; ++h)
#pragma unroll
                    for (int i = 0; i < 2; ++i) nOA[h][i] = S.a_base(nxt) + (unsigned)tk[h][i] * (unsigned)(K * 2) + colA[i]; } }
            if constexpr (SP2) {
            PG8_LDB(B0, 0, 0); PG8_LDB(B1, 0, 1); PG8_SCHED; PG8_LDA(At, 0, 0); PG8_STAGE2(PG8_SA(1, 1), a1, oA[1][0], oA[1][1]);
            PG8_WAIT_V(8); PG8_WAIT_L(0); PG8_BAR; PG8_MMA(0, 0, At, B0); PG8_MMA(0, 1, At, B1); PG8_BAR; PG8_SCHED;
            PG8_LDA(At, 0, 1); PG8_STAGE(PG8_SB(0, 0), b2, voffB); PG8_STAGE(PG8_SB(0, 1), b2 + hstep, voffB); PG8_STAGE2(PG8_SA(0, 0), a2, PG8_OSEL(0, 0), PG8_OSEL(0, 1));
            PG8_WAIT_V(8); if (pend >= 0) { S.done_signal(pend); pend = -1; }
            PG8_WAIT_L(0); PG8_BAR; PG8_MMA(1, 0, At, B0); PG8_MMA(1, 1, At, B1); PG8_BAR; PG8_SCHED;
            PG8_LDB(B0, 1, 0); PG8_LDB(B1, 1, 1); PG8_SCHED; PG8_LDA(At, 1, 0); PG8_STAGE2(PG8_SA(0, 1), a2, PG8_OSEL(1, 0), PG8_OSEL(1, 1));
            PG8_WAIT_V(8); PG8_WAIT_L(0); PG8_BAR; PG8_MMA(0, 0, At, B0); PG8_MMA(0, 1, At, B1); PG8_BAR; PG8_SCHED;
            PG8_LDA(At, 1, 1); PG8_STAGE(PG8_SB(1, 0), b3, voffB); PG8_STAGE(PG8_SB(1, 1), b3 + hstep, voffB); PG8_STAGE2(PG8_SA(1, 0), a3, PG8_OSEL(0, 0), PG8_OSEL(0, 1));
            PG8_WAIT_V(8); PG8_WAIT_L(0); PG8_BAR; PG8_MMA(1, 0, At, B0); PG8_MMA(1, 1, At, B1); PG8_BAR; PG8_SCHED;
            } else {
            PG8_LDB(B0, 0, 0); PG8_SCHED; PG8_LDA(At, 0, 0); PG8_STAGE(PG8_SA(1, 1), a1 + hstep, voffA);
            PG8_WAIT_L(8); PG8_BAR; PG8_WAIT_L(0); PG8_MMA(0, 0, At, B0); PG8_BAR; PG8_SCHED;
            PG8_LDB(B1, 0, 1); PG8_STAGE(PG8_SB(0, 0), b2, voffB);
            PG8_BAR; PG8_WAIT_L(0); PG8_MMA(0, 1, At, B1); PG8_BAR;
            PG8_LDA(At, 0, 1); PG8_STAGE(PG8_SA(0, 0), a2, voffA);
            PG8_BAR; PG8_WAIT_L(0); PG8_MMA(1, 0, At, B0); PG8_BAR; PG8_SCHED;
            PG8_STAGE(PG8_SB(0, 1), b2 + hstep, voffB);
            PG8_WAIT_V(6); PG8_BAR; PG8_MMA(1, 1, At, B1); PG8_BAR;
            PG8_LDB(B0, 1, 0); PG8_SCHED; PG8_LDA(At, 1, 0); PG8_STAGE(PG8_SA(0, 1), a2 + hstep, voffA);
            PG8_WAIT_L(8); PG8_BAR; PG8_WAIT_L(0); PG8_MMA(0, 0, At, B0); PG8_BAR; PG8_SCHED;
            PG8_LDB(B1, 1, 1); PG8_STAGE(PG8_SB(1, 0), b3, voffB);
            PG8_BAR; PG8_WAIT_L(0); PG8_MMA(0, 1, At, B1); PG8_BAR;
            PG8_LDA(At, 1, 1); PG8_STAGE(PG8_SA(1, 0), a3, voffA);
            PG8_BAR; PG8_WAIT_L(0); PG8_MMA(1, 0, At, B0); PG8_BAR; PG8_SCHED;
            PG8_STAGE(PG8_SB(1, 1), b3 + hstep, voffB);
            PG8_WAIT_V(6); PG8_BAR; PG8_MMA(1, 1, At, B1); PG8_BAR;
            }
        }
        if constexpr (FP8) asm volatile("s_nop 15\n\ts_nop 15" ::: "memory");
        if constexpr (ALIGN_EPI) { if (wr == 0) PG8_BAR; }
        if constexpr (!Epi::AFTER_DRAIN) { E(acc, cur, wr, wc, fr, fq); S.done(cur); pend = S.done_defer(cur); }
        if (!has_next) break;
#pragma unroll
        for (int a = 0; a < 2; ++a)
#pragma unroll
            for (int b = 0; b < 2; ++b)
#pragma unroll
                for (int m = 0; m < 4; ++m)
#pragma unroll
                    for (int n = 0; n < 2; ++n) acc[a][b][m][n] = (f32x4){0.f, 0.f, 0.f, 0.f};
        cur = nxt; cA = nA; cB = nB; ++ui;
        if constexpr (GATHER) {
#pragma unroll
            for (int h = 0; h < 2; ++h)
#pragma unroll
                for (int i = 0; i < 2; ++i) oA[h][i] = nOA[h][i];
        }
        if constexpr (ALIGN_EPI) { if (wr == 1) PG8_BAR; }
    }
    PG8_WAIT_V(0);
    if (pend >= 0) { S.done_signal(pend); pend = -1; }
    if constexpr (!ALIGN_EPI) { if (wr == 0) PG8_BAR; }
    PG8_BAR;
    if constexpr (Epi::AFTER_DRAIN) { E.fused(acc, cur, wr, wc, fr, fq, lds, wid, lane); S.done(cur); }
#undef PG8_SA
#undef PG8_OSEL
#undef PG8_STAGE2
#undef PG8_SB
#undef PG8_STAGE
#undef PG8_LDA
#undef PG8_LDB
#undef PG8_MMA
#undef PG8_WAIT_V
#undef PG8_WAIT_L
#undef PG8_BAR
#undef PG8_SCHED
}
}

#ifndef MK_N_LAUNCHES
#define MK_N_LAUNCHES 1
#endif
#ifndef PROBE_DUP
#define PROBE_DUP -1
#endif
#ifndef PROBE_STAMP
#define PROBE_STAMP -1
#endif
constexpr int N_PHASES = 10;
constexpr int NBATCH = 8, TT = 2048, MTOK = NBATCH * TT, D = 1024;
constexpr int HK = 512, NH = 4, DK = 128, DV = 128, CCH = 512, CLEN = 31, INC = 3584;
constexpr int NE = 32, TOPK = 4, FF = 1024;
constexpr float EPS = 1e-5f, SW_LIMIT = 7.0f, SW_ALPHA = 1.702f;
constexpr int NWAVES = 8, NTHR = 512;
constexpr int W1_ITEMS = 32 * 16 * 64, W1_P1 = 6144, W1_P2 = 20480, W1_P0 = W1_ITEMS - W1_P1 - W1_P2;
constexpr int W2_ITEMS = 32 * 16 * 32, W2_P7 = 4096, W2_P2 = W2_ITEMS - W2_P7;
constexpr int MOE_ROWS = (MTOK * TOPK / 256 + NE) * 256;

constexpr size_t MiB = 1u << 20;
constexpr size_t WS_CTL = 0, CTL_ZERO_BYTES = 256 * 1024;
constexpr size_t WS_WI = 1 * MiB;
constexpr size_t WS_WO = 8 * MiB;
constexpr size_t WS_TAB = 10 * MiB;
constexpr size_t WS_W1 = 16 * MiB;
constexpr size_t WS_W2 = 144 * MiB;
constexpr size_t WS_H = 208 * MiB;
constexpr size_t WS_XN = 272 * MiB;
constexpr size_t WS_Q = 304 * MiB, WS_KF = 320 * MiB, WS_KB = 336 * MiB, WS_V = 352 * MiB, WS_G = 368 * MiB, WS_U = 384 * MiB;
constexpr size_t WS_LF = 400 * MiB, WS_LB = 432 * MiB;
constexpr size_t WS_OF = 464 * MiB, WS_OB = 496 * MiB;
constexpr size_t WS_MIX = 528 * MiB;
constexpr size_t WS_XS = 304 * MiB;
constexpr size_t WS_ACT = 448 * MiB;
constexpr size_t WS_YS = 592 * MiB;
constexpr size_t WS_END = 736 * MiB;
constexpr size_t WS_WRT = WS_TAB;
constexpr size_t WS_SLOT = WS_TAB + 256 * 1024;
constexpr size_t WS_GATE = WS_TAB + 512 * 1024;
constexpr size_t WS_ROWTOK = WS_TAB + 1 * MiB;
constexpr int CW_BAR = 4096;
constexpr int CW_CNT = 16384;

constexpr int RING_OFF = 0, RING_BYTES = 131072;
#if defined(HGRN_V2)
constexpr int LDSCTL_OFF = 135168;
#else
constexpr int LDSCTL_OFF = 152576;
#endif
constexpr int MISC_OFF = LDSCTL_OFF + 320;
constexpr int TAB_OFF = LDSCTL_OFF + 1024;
constexpr int SB_OFF = LDSCTL_OFF + 2048;
#if defined(HGRN_V2)
constexpr int LDS_BYTES = 147456;
#else
constexpr int LDS_BYTES = 163840;
#endif

#define GAS __attribute__((address_space(1)))
#define LAS __attribute__((address_space(3)))
typedef unsigned short bf16;
typedef unsigned v4u __attribute__((ext_vector_type(4)));
typedef unsigned v2u __attribute__((ext_vector_type(2)));
typedef float f32x4 __attribute__((ext_vector_type(4)));
typedef GAS unsigned gu32;
#define RLX_AGENT __ATOMIC_RELAXED, __HIP_MEMORY_SCOPE_AGENT
#define LDS_WAIT() asm volatile("s_waitcnt lgkmcnt(0)" ::: "memory")
#define VM_WAIT() asm volatile("s_waitcnt vmcnt(0)" ::: "memory")

__device__ __forceinline__ float bf2f(unsigned b) { return __uint_as_float(b << 16); }
typedef __bf16 bf16x2_t __attribute__((ext_vector_type(2)));
typedef float f32x2_t __attribute__((ext_vector_type(2)));
__device__ __forceinline__ unsigned pk2(float lo, float hi) { const bf16x2_t r = __builtin_convertvector((f32x2_t){lo, hi}, bf16x2_t); return __builtin_bit_cast(unsigned, r); }
__device__ __forceinline__ float sigm(float x) { return __builtin_amdgcn_rcpf(1.0f + __expf(-x)); }
__device__ __forceinline__ float wave_sum(float v) {
#pragma unroll
    for (int o = 1; o < 64; o <<= 1) v += __shfl_xor(v, o);
    return v;
}

constexpr float SC_W = 512.f, SC_N2 = 16.f, SC_ACT = 8.f, SC_YS = 32.f;
__device__ __forceinline__ unsigned pk4_fp8(float a, float b, float c, float d) {
    a = fminf(fmaxf(a, -448.f), 448.f); b = fminf(fmaxf(b, -448.f), 448.f); c = fminf(fmaxf(c, -448.f), 448.f); d = fminf(fmaxf(d, -448.f), 448.f);
    int w = 0; w = __builtin_amdgcn_cvt_pk_fp8_f32(a, b, w, false); w = __builtin_amdgcn_cvt_pk_fp8_f32(c, d, w, true); return (unsigned)w;
}

#define XB_TMO      128
#define XB_XCNT(j)  (256  + 64 * (j))
#define XB_XSUB(j)  (1280 + 64 * (j))
#define XB_XGEN(j)  (2304 + 64 * (j))
#define XB_TOP      3328
#define XB_TOPGEN   3392
#define XCD_BAR_WORDS 3456
#define XB_SPIN_CAP (1u << 18)

__device__ __forceinline__ unsigned xb_ld(unsigned* p)              { return __hip_atomic_load(p, __ATOMIC_RELAXED, __HIP_MEMORY_SCOPE_AGENT); }
__device__ __forceinline__ unsigned xb_add(unsigned* p, unsigned v) { return __hip_atomic_fetch_add(p, v, __ATOMIC_RELAXED, __HIP_MEMORY_SCOPE_AGENT); }
__device__ __forceinline__ unsigned xb_xcc_id() { return (unsigned)__builtin_amdgcn_s_getreg((3 << 11) | 20) & 0xFu; }
#define XB_SPIN(cond, bar) do { unsigned _sp = 0; while (cond) { __builtin_amdgcn_s_sleep(1); \
    if ((++_sp & 255u) == 0u) { if (xb_ld(&(bar)[XB_TMO])) break; if (_sp > XB_SPIN_CAP) { atomicAdd(&(bar)[XB_TMO], 1u); break; } } } } while (0)

struct XcdBarrier {
    unsigned* bar; unsigned x;
    volatile LAS unsigned* st;
};
__device__ __forceinline__ XcdBarrier xcd_barrier_post(unsigned* bar, volatile LAS unsigned* st) {
    XcdBarrier b; b.bar = bar; b.x = xb_xcc_id(); b.st = st;
    if (threadIdx.x == 0) (void)xb_add(&bar[XB_XCNT(b.x)], 1u);
    return b;
}
__device__ __forceinline__ void xcd_barrier_complete(unsigned* bar, unsigned x, unsigned& nloc, unsigned& nx) {
    const unsigned G = gridDim.x * gridDim.y * gridDim.z;
    unsigned sum, cnt, mine, sp = 0u;
    for (;;) {
        sum = 0u; cnt = 0u; mine = 0u;
#pragma unroll
        for (unsigned j = 0; j < 16; ++j) { const unsigned c = xb_ld(&bar[XB_XCNT(j)]); sum += c; cnt += (c > 0u) ? 1u : 0u; mine = (j == x) ? c : mine; }
        if (sum == G) break;
        __builtin_amdgcn_s_sleep(1);
        if ((++sp & 255u) == 0u) { if (xb_ld(&bar[XB_TMO])) break; if (sp > XB_SPIN_CAP) { atomicAdd(&bar[XB_TMO], 1u); break; } }
    }
    nloc = mine > 0u ? mine : 1u; nx = cnt > 0u ? cnt : 1u;
}
__device__ __forceinline__ void xcd_barrier(const XcdBarrier& b) {
    asm volatile("s_waitcnt vmcnt(0)" ::: "memory");
    __syncthreads();
    if (threadIdx.x == 0) {
        unsigned* bar = b.bar;
        __builtin_amdgcn_s_waitcnt(0);
        unsigned nloc = b.st[0], nx = b.st[1];
        if (nloc == 0u) { xcd_barrier_complete(bar, b.x, nloc, nx); b.st[0] = nloc; b.st[1] = nx; }
        const unsigned old = xb_add(&bar[XB_XSUB(b.x)], 1u);
        const unsigned gen = old / nloc;
        if (old + 1u == (gen + 1u) * nloc) {
            __builtin_amdgcn_fence(__ATOMIC_RELEASE, "agent");
            asm volatile("s_waitcnt vmcnt(0)" ::: "memory");
            const unsigned og = xb_add(&bar[XB_TOP], 1u);
            const unsigned tg = og / nx;
            if (og + 1u == (tg + 1u) * nx) xb_add(&bar[XB_TOPGEN], 1u);
            else XB_SPIN(xb_ld(&bar[XB_TOPGEN]) == tg, bar);
            __builtin_amdgcn_fence(__ATOMIC_ACQUIRE, "agent");
            xb_add(&bar[XB_XGEN(b.x)], 1u);
            asm volatile("s_waitcnt vmcnt(0)" ::: "memory");
        } else {
            XB_SPIN(xb_ld(&bar[XB_XGEN(b.x)]) == gen, bar);
            __builtin_amdgcn_fence(__ATOMIC_ACQUIRE, "agent");
            asm volatile("s_waitcnt vmcnt(0)" ::: "memory");
        }
    }
    __syncthreads();
}

#ifndef WT_STORES
#define WT_STORES 0
#endif
__device__ __forceinline__ void st16(void* p, v4u w) {
#if WT_STORES
    asm volatile("global_store_dwordx4 %0, %1, off sc0 sc1\n\ts_nop 1" :: "v"(p), "v"(w) : "memory");
#else
    *(v4u*)p = w;
#endif
}
__device__ __forceinline__ void st8(void* p, v2u w) {
#if WT_STORES
    asm volatile("global_store_dwordx2 %0, %1, off sc0 sc1\n\ts_nop 1" :: "v"(p), "v"(w) : "memory");
#else
    *(v2u*)p = w;
#endif
}
__device__ __forceinline__ void st8bf(bf16* p, const f32x4& a, const f32x4& b) {
    v4u w; w.x = pk2(a[0], a[1]); w.y = pk2(a[2], a[3]); w.z = pk2(b[0], b[1]); w.w = pk2(b[2], b[3]);
    st16(p, w);
}
struct EpiProj {
    static constexpr bool PERM = true, AFTER_DRAIN = false;
    bf16 *Q, *KF, *KB, *V, *G, *U; float *LF, *LB; const float* lbl;
    template <int TYP>
    __device__ __forceinline__ void tile(const pg8::f32x4 (&acc)[2][2][4][2], int row0, int cb) const {
#pragma unroll
        for (int bj = 0; bj < 2; ++bj) {
            const int col = cb + bj * 128;
            float lb[8];
            if (TYP == 1 || TYP == 2) {
                const float* L = lbl + (TYP - 1) * 1024 + col;
#pragma unroll
                for (int i = 0; i < 8; ++i) lb[i] = __builtin_amdgcn_rcpf(1.0f + __expf(L[512 + i] - L[i]));
            }
#pragma unroll
            for (int ai = 0; ai < 2; ++ai)
#pragma unroll
                for (int m = 0; m < 4; ++m) {
                    const size_t off = (size_t)(row0 + ai * 128 + m * 16) * 512 + col;
                    f32x4 a = acc[ai][bj][m][0], b = acc[ai][bj][m][1];
                    if (TYP == 0 || TYP == 4) {
#pragma unroll
                        for (int i = 0; i < 4; ++i) { a[i] = a[i] * sigm(a[i]); b[i] = b[i] * sigm(b[i]); }
                        st8bf((TYP == 0 ? Q : G) + off, a, b);
                    } else if (TYP == 3) {
                        st8bf(V + off, a, b);
                    } else {
                        f32x4 la, lbv, ka, kb;
#pragma unroll
                        for (int i = 0; i < 4; ++i) {
                            const float fa = lb[i] + (1.0f - lb[i]) * sigm(a[i]), fb = lb[4 + i] + (1.0f - lb[4 + i]) * sigm(b[i]);
                            la[i] = __logf(fa); lbv[i] = __logf(fb); ka[i] = 1.0f - fa; kb[i] = 1.0f - fb;
                        }
                        float* Lp = (TYP == 1 ? LF : LB) + off;
                        st16(Lp, (v4u)la); st16(Lp + 4, (v4u)lbv);
                        st8bf((TYP == 1 ? KF : KB) + off, ka, kb);
                    }
                }
        }
    }
    __device__ __forceinline__ void operator()(const pg8::f32x4 (&acc)[2][2][4][2], const pg8::Unit& u, int wr, int wc, int fr, int fq) const {
        const int row0 = u.pm * 256 + wr * 64 + fr, pn = u.pn;
        if (pn >= 10) {
            const int col = (pn - 10) * 128 + wc * 32 + 8 * fq;
#pragma unroll
            for (int ai = 0; ai < 2; ++ai)
#pragma unroll
                for (int m = 0; m < 4; ++m) {
                    f32x4 a = acc[ai][0][m][0], b = acc[ai][0][m][1]; const f32x4 ga = acc[ai][1][m][0], gb = acc[ai][1][m][1];
#pragma unroll
                    for (int i = 0; i < 4; ++i) { a[i] = a[i] * sigm(ga[i]); b[i] = b[i] * sigm(gb[i]); }
                    st8bf(U + (size_t)(row0 + ai * 128 + m * 16) * 512 + col, a, b);
                }
        } else {
            const int cb = (pn & 1) * 256 + wc * 32 + 8 * fq, typ = pn >> 1;
            if (typ == 0) tile<0>(acc, row0, cb);
            else if (typ == 1) tile<1>(acc, row0, cb);
            else if (typ == 2) tile<2>(acc, row0, cb);
            else if (typ == 3) tile<3>(acc, row0, cb);
            else tile<4>(acc, row0, cb);
        }
    }
};
struct EpiRes {
    static constexpr bool PERM = false, AFTER_DRAIN = false;
    const float* X; float* H;
    __device__ __forceinline__ void operator()(const pg8::f32x4 (&acc)[2][2][4][2], const pg8::Unit& u, int wr, int wc, int fr, int fq) const {
        const int row0 = u.pm * 256 + wr * 64 + fr, col0 = u.pn * 256 + wc * 32 + 4 * fq;
#pragma unroll
        for (int ai = 0; ai < 2; ++ai)
#pragma unroll
            for (int m = 0; m < 4; ++m) {
                const size_t off = (size_t)(row0 + ai * 128 + m * 16) * D + col0;
#pragma unroll
                for (int bj = 0; bj < 2; ++bj)
#pragma unroll
                    for (int n = 0; n < 2; ++n) { const f32x4 xv = *(const f32x4*)(X + off + bj * 128 + n * 16); st16(H + off + bj * 128 + n * 16, (v4u)(xv + acc[ai][bj][m][n])); }
            }
    }
};
struct EpiSwiglu {
    static constexpr bool PERM = true, AFTER_DRAIN = false;
    unsigned char* ACT; const float* b1;
    __device__ __forceinline__ void operator()(const pg8::f32x4 (&acc)[2][2][4][2], const pg8::Unit& u, int wr, int wc, int fr, int fq) const {
        const int e = u.pn >> 3, pn = u.pn & 7, row0 = u.pm * 256 + wr * 64 + fr, col = pn * 128 + wc * 32 + 8 * fq;
        const float* bg = b1 + (size_t)e * 2048 + col; const float* bl = bg + 1024;
        float g[8], l[8];
#pragma unroll
        for (int i = 0; i < 8; ++i) { g[i] = bg[i]; l[i] = bl[i]; }
#pragma unroll
        for (int ai = 0; ai < 2; ++ai)
#pragma unroll
            for (int m = 0; m < 4; ++m) {
                f32x4 o[2];
#pragma unroll
                for (int n = 0; n < 2; ++n)
#pragma unroll
                    for (int i = 0; i < 4; ++i) {
                        const float hg = fminf(acc[ai][0][m][n][i] * (1.0f / (SC_N2 * SC_W)) + g[4 * n + i], SW_LIMIT);
                        const float hl = fminf(fmaxf(acc[ai][1][m][n][i] * (1.0f / (SC_N2 * SC_W)) + l[4 * n + i], -SW_LIMIT), SW_LIMIT);
                        o[n][i] = hg * sigm(SW_ALPHA * hg) * (hl + 1.0f) * SC_ACT;
                    }
                v2u w; w.x = pk4_fp8(o[0][0], o[0][1], o[0][2], o[0][3]); w.y = pk4_fp8(o[1][0], o[1][1], o[1][2], o[1][3]);
#if defined(MOE_MERGED)
                asm volatile("global_store_dwordx2 %0, %1, off sc0 sc1\n\ts_nop 1" :: "v"(ACT + (size_t)(row0 + ai * 128 + m * 16) * FF + col), "v"(w) : "memory");
#else
                st8(ACT + (size_t)(row0 + ai * 128 + m * 16) * FF + col, w);
#endif
            }
    }
};
struct EpiDown {
    static constexpr bool PERM = true, AFTER_DRAIN = false;
    unsigned char* YS; const float* b2;
    __device__ __forceinline__ void operator()(const pg8::f32x4 (&acc)[2][2][4][2], const pg8::Unit& u, int wr, int wc, int fr, int fq) const {
        const int e = u.pn >> 2, pn = u.pn & 3, row0 = u.pm * 256 + wr * 64 + fr, col0 = pn * 256 + wc * 32 + 8 * fq;
#pragma unroll
        for (int bj = 0; bj < 2; ++bj) {
            const float* bp = b2 + (size_t)e * D + col0 + bj * 128;
            const f32x4 b0 = *(const f32x4*)bp, b1v = *(const f32x4*)(bp + 4);
#pragma unroll
            for (int ai = 0; ai < 2; ++ai)
#pragma unroll
                for (int m = 0; m < 4; ++m)
                    { const f32x4 y0 = (acc[ai][bj][m][0] * (1.0f / (SC_ACT * SC_W)) + b0) * SC_YS, y1 = (acc[ai][bj][m][1] * (1.0f / (SC_ACT * SC_W)) + b1v) * SC_YS;
                      v2u w; w.x = pk4_fp8(y0[0], y0[1], y0[2], y0[3]); w.y = pk4_fp8(y1[0], y1[1], y1[2], y1[3]); st8(YS + (size_t)(row0 + ai * 128 + m * 16) * D + col0 + bj * 128, w); }
        }
    }
};
struct MoeOrder {
    const volatile LAS int* bs; int ntn, G, v; const volatile LAS int* cl; const int* rowtok;
    __device__ __forceinline__ const int* a_list(const pg8::Unit& u) const { const int e = u.pn / ntn; return rowtok + e * MTOK + (u.pm - bs[e]) * 256; }
    __device__ __forceinline__ int a_valid(const pg8::Unit& u) const { const int e = u.pn / ntn; return min(256, cl[e] - (u.pm - bs[e]) * 256); }
    __device__ __forceinline__ bool next(int i, pg8::Unit& u) const {
        int L = i * G + v; const int nb = bs[32];
        if (L >= nb * ntn * (((PROBE_DUP) == 17 && ntn == 8) || ((PROBE_DUP) == 18 && ntn == 4) ? 2 : 1)) return false;
        if (L >= nb * ntn) L -= nb * ntn;
        const int mb = L / ntn, pn = L - mb * ntn;
        const int ln = (int)(threadIdx.x & 63);
        const int e = __popcll(__ballot(ln < NE - 1 && bs[ln + 1] <= mb));
        u.pm = mb; u.pn = e * ntn + pn; return true;
    }
    __device__ __forceinline__ bool a_is_list(const pg8::Unit&) const { return true; }
    __device__ __forceinline__ unsigned a_base(const pg8::Unit&) const { return 0u; }
    __device__ __forceinline__ int a_row0(const pg8::Unit&) const { return 0; }
    __device__ __forceinline__ void a_ready(const pg8::Unit&) const {}
    __device__ __forceinline__ void done(const pg8::Unit&) const {}
    __device__ __forceinline__ int done_defer(const pg8::Unit&) const { return -1; }
    __device__ __forceinline__ void done_signal(int) const {}
};
constexpr int CW_BLK = 32768;
struct MoeOrder2 {
    const volatile LAS int* bs; int G, v; const volatile LAS int* cl; const int* rowtok; unsigned* ctl;
    __device__ __forceinline__ bool is_down(const pg8::Unit& u) const { return u.pn >= 512; }
    __device__ __forceinline__ int expert(const pg8::Unit& u) const { return is_down(u) ? (u.pn - 512) >> 2 : u.pn >> 3; }
    __device__ __forceinline__ bool a_is_list(const pg8::Unit& u) const { return !is_down(u); }
    __device__ __forceinline__ unsigned a_base(const pg8::Unit& u) const { return is_down(u) ? (unsigned)WS_ACT : (unsigned)WS_XN; }
    __device__ __forceinline__ int a_row0(const pg8::Unit& u) const { return u.pm * 256; }
    __device__ __forceinline__ const int* a_list(const pg8::Unit& u) const { const int e = expert(u); return rowtok + e * MTOK + (u.pm - bs[e]) * 256; }
    __device__ __forceinline__ int a_valid(const pg8::Unit& u) const { const int e = expert(u); return min(256, cl[e] - (u.pm - bs[e]) * 256); }
    __device__ __forceinline__ bool next(int i, pg8::Unit& u) const {
        const int L = i * G + v, nb = bs[32];
        if (L >= nb * 12) return false;
        const bool dn = L >= nb * 8; const int L2 = dn ? L - nb * 8 : L, ntn = dn ? 4 : 8;
        const int mb = L2 / ntn, pn = L2 - mb * ntn;
        const int ln = (int)(threadIdx.x & 63);
        const int e = __popcll(__ballot(ln < NE - 1 && bs[ln + 1] <= mb));
        u.pm = mb; u.pn = (dn ? 512 : 0) + e * ntn + pn; return true;
    }
    __device__ __forceinline__ void a_ready(const pg8::Unit& u) const {
        if (!is_down(u)) return;
        if (threadIdx.x < 64) {
            const unsigned long long t0 = __builtin_amdgcn_s_memrealtime(); unsigned polls = 0;
            while ((unsigned)__builtin_amdgcn_readfirstlane(__hip_atomic_load(ctl + CW_BLK + 64 * u.pm, __ATOMIC_RELAXED, __HIP_MEMORY_SCOPE_AGENT)) < 64u) {
                if ((++polls & 255u) == 0u && __builtin_amdgcn_readfirstlane(__hip_atomic_load(ctl + 1, __ATOMIC_RELAXED, __HIP_MEMORY_SCOPE_AGENT)) != 0u) break;
                if (__builtin_amdgcn_s_memrealtime() - t0 > 2000000ull) { if (threadIdx.x == 0) __hip_atomic_store(ctl + 1, 1u, __ATOMIC_RELAXED, __HIP_MEMORY_SCOPE_AGENT); break; }
                __builtin_amdgcn_s_sleep(2); }
            __builtin_amdgcn_fence(__ATOMIC_ACQUIRE, "agent");
            asm volatile("s_waitcnt vmcnt(0)" ::: "memory");
        }
        asm volatile("" ::: "memory"); __builtin_amdgcn_s_barrier(); asm volatile("" ::: "memory");
    }
    __device__ __forceinline__ void done(const pg8::Unit&) const {}
    __device__ __forceinline__ int done_defer(const pg8::Unit& u) const { return is_down(u) ? -1 : u.pm; }
    __device__ __forceinline__ void done_signal(int mb) const { if ((threadIdx.x & 63) == 0) __hip_atomic_fetch_add(ctl + CW_BLK + 64 * mb, 1u, __ATOMIC_RELAXED, __HIP_MEMORY_SCOPE_AGENT); }
};
struct EpiMoe {
    static constexpr bool PERM = true, AFTER_DRAIN = false;
    EpiSwiglu up; EpiDown down;
    __device__ __forceinline__ void operator()(const pg8::f32x4 (&acc)[2][2][4][2], const pg8::Unit& u, int wr, int wc, int fr, int fq) const {
        if (u.pn >= 512) { pg8::Unit d; d.pm = u.pm; d.pn = u.pn - 512; down(acc, d, wr, wc, fr, fq); } else up(acc, u, wr, wc, fr, fq);
    }
};

#ifndef PROBE_DUP
#define PROBE_DUP -1
#endif
struct OrderRep : pg8::StaticOrder {
    int reps;
    __device__ __forceinline__ bool next(int i, pg8::Unit& u) const {
        const int per = (nwg + G - 1) / G, r = i / per;
        if (r >= reps) return false;
        return pg8::StaticOrder::next(i - r * per, u) ? true : ((r + 1 < reps) ? pg8::StaticOrder::next(0, u) : false);
    }
};
struct RmIdent { __device__ __forceinline__ int operator()(int n) const { return n; } };
struct RmWin {
    __device__ __forceinline__ int operator()(int n) const {
        if (n < 2560) return n;
        if (n < 3072) { const int j = n - 2560; return 2560 + (j >> 7) * 256 + (j & 127); }
        const int j = n - 3072; return 2560 + (j >> 7) * 256 + 128 + (j & 127);
    }
};
struct RmW1 {
    __device__ __forceinline__ int operator()(int n) const {
        if (n < 1024) return (n >> 7) * 256 + (n & 127);
        const int j = n - 1024; return (j >> 7) * 256 + 128 + (j & 127);
    }
};
__device__ __forceinline__ void p0_load(const float* W, int N, int item, int lane, f32x4 (&v)[8]) {
    const int nblk = N / 32, kb = item / nblk, nb = item % nblk, k0 = 64 * kb, n0 = 32 * nb;
    const int r8 = lane >> 3, c4 = lane & 7;
#pragma unroll
    for (int i = 0; i < 8; ++i) v[i] = *(const f32x4*)(W + (size_t)(k0 + 8 * i + r8) * N + n0 + 4 * c4);
}
template <bool FP8OUT, class RM>
__device__ __forceinline__ void p0_finish(const f32x4 (&v)[8], int K, int N, void* WTv, RM rm, LAS float* scr, int item, int lane) {
    const int nblk = N / 32, kb = item / nblk, nb = item % nblk, k0 = 64 * kb, n0 = 32 * nb;
    const int r8 = lane >> 3, c4 = lane & 7;
#pragma unroll
    for (int i = 0; i < 8; ++i) *(LAS f32x4*)(scr + (8 * i + r8) * 36 + 4 * c4) = v[i];
    LDS_WAIT(); asm volatile("" ::: "memory");
    const int n = lane & 31, kh = lane >> 5; const LAS float* s = scr + (32 * kh) * 36 + n;
    if constexpr (FP8OUT) {
        unsigned w[8];
#pragma unroll
        for (int j = 0; j < 8; ++j) w[j] = pk4_fp8(s[(4 * j) * 36] * SC_W, s[(4 * j + 1) * 36] * SC_W, s[(4 * j + 2) * 36] * SC_W, s[(4 * j + 3) * 36] * SC_W);
        GAS v4u* dst = (GAS v4u*)((unsigned char*)WTv + (size_t)rm(n0 + n) * K + k0 + 32 * kh);
        dst[0] = (v4u){w[0], w[1], w[2], w[3]}; dst[1] = (v4u){w[4], w[5], w[6], w[7]};
    } else {
        unsigned w[16];
#pragma unroll
        for (int j = 0; j < 16; ++j) w[j] = pk2(s[(2 * j) * 36], s[(2 * j + 1) * 36]);
        GAS v4u* dst = (GAS v4u*)((bf16*)WTv + (size_t)rm(n0 + n) * K + k0 + 32 * kh);
#pragma unroll
        for (int q = 0; q < 4; ++q) dst[q] = (v4u){w[4 * q], w[4 * q + 1], w[4 * q + 2], w[4 * q + 3]};
    }
    LDS_WAIT(); asm volatile("" ::: "memory");
}
template <bool FP8OUT, class RM>
__device__ __forceinline__ void p0_item(const float* W, int K, int N, void* WTv, RM rm, LAS float* scr, int item, int lane) {
    f32x4 v[8]; p0_load(W, N, item, lane, v); p0_finish<FP8OUT>(v, K, N, WTv, rm, scr, item, lane);
}
template <class RM>
__device__ __forceinline__ void convert_range_fp8(const float* W, int K, int N, unsigned char* WT, RM rm, int ipe_log2, int first, int stride, int count, int base, LAS float* scr, int lane) {
    const size_t esz = (size_t)K * N; const int mask = (1 << ipe_log2) - 1;
    f32x4 va[8], vb[8];
    int it = first;
    if (it < count) p0_load(W + (size_t)((base + it) >> ipe_log2) * esz, N, (base + it) & mask, lane, va);
    while (it < count) {
        const int i1 = it + stride, i2 = it + 2 * stride;
        if (i1 < count) p0_load(W + (size_t)((base + i1) >> ipe_log2) * esz, N, (base + i1) & mask, lane, vb);
        p0_finish<true>(va, K, N, WT + (size_t)((base + it) >> ipe_log2) * esz, rm, scr, (base + it) & mask, lane);
        if (i1 >= count) break;
        if (i2 < count) p0_load(W + (size_t)((base + i2) >> ipe_log2) * esz, N, (base + i2) & mask, lane, va);
        p0_finish<true>(vb, K, N, WT + (size_t)((base + i1) >> ipe_log2) * esz, rm, scr, (base + i1) & mask, lane);
        it = i2;
    }
}
__device__ __forceinline__ void rms_row_to_bf16(const float* xrow, const float* w, bf16* orow, int lane) {
    const f32x4* xr = (const f32x4*)xrow + lane; const f32x4* wr = (const f32x4*)w + lane;
    f32x4 v[4]; float s = 0.f;
#pragma unroll
    for (int j = 0; j < 4; ++j) { v[j] = xr[64 * j]; s += (v[j].x * v[j].x + v[j].y * v[j].y) + (v[j].z * v[j].z + v[j].w * v[j].w); }
    const float rstd = rsqrtf(wave_sum(s) * (1.f / D) + EPS);
    v2u* o8 = (v2u*)orow + lane;
#pragma unroll
    for (int j = 0; j < 4; ++j) { const f32x4 g = wr[64 * j]; v2u o; o.x = pk2(v[j].x * rstd * g.x, v[j].y * rstd * g.y); o.y = pk2(v[j].z * rstd * g.z, v[j].w * rstd * g.w); o8[64 * j] = o; }
}


__device__ __forceinline__ pg8::bf16x8 lds_frag(const LAS unsigned char* p) { return *(const LAS pg8::bf16x8*)p; }
__device__ __forceinline__ pg8::bf16x8 mk_frag(v2u a, v2u b) { const v4u w = (v4u){a.x, a.y, b.x, b.y}; return (pg8::bf16x8)w; }
#ifndef PROBE_TID
#define PROBE_TID 0
#endif
#define HG_PSTAMP(lds_, n_, code_) do { if ((PROBE_STAMP) >= 660 && (PROBE_STAMP) <= 669 && (n_) == 5 && threadIdx.x == (PROBE_TID)) { \
        if ((code_) == 660) *(volatile LAS unsigned long long*)((lds_) + LDSCTL_OFF + 640) = __builtin_amdgcn_s_memrealtime(); \
        if ((code_) == (PROBE_STAMP)) *(volatile LAS unsigned long long*)((lds_) + LDSCTL_OFF + 648) = __builtin_amdgcn_s_memrealtime(); } } while (0)
struct HgCtx {
    LAS unsigned char* lds; const bf16 *Qb, *Kp, *Vb; const float* Lp; float* Op;
    int b, h, dir, vh, lane, wave, lr, lq, dA, seg, tauB, dg;
    unsigned offA[16], offB, offV, ke_tr, v_tr;
};
constexpr int HG_BF = 0, HG_AM = 0, HG_QI = 33792, HG_KK = 51200, HG_KE = 68608, HG_V = 86016, HG_ST = 95232, HG_SEG = 112640, HG_DEC = 114688;
constexpr int HG_RSD = 272, HG_RSS = 144, HG_RSBF = 528;
__device__ __forceinline__ void hgrn_load(const HgCtx& c, int n, float (&lf)[16], v4u (&qB)[2], v4u (&kB)[2], v4u& vB) {
    const size_t cb = (size_t)__builtin_amdgcn_readfirstlane(c.b * TT + (c.dir ? (TT / 64 - 1 - n) * 64 : n * 64)) * 512 + c.h * 128;
    const float* Lc = c.Lp + cb; const bf16* Qc = c.Qb + cb; const bf16* Kc = c.Kp + cb; const bf16* Vc = c.Vb + cb;
#pragma unroll
    for (int i = 0; i < 16; ++i) lf[i] = Lc[c.offA[i]];
    qB[0] = *(const v4u*)(Qc + c.offB); qB[1] = *(const v4u*)(Qc + c.offB + 8); kB[0] = *(const v4u*)(Kc + c.offB); kB[1] = *(const v4u*)(Kc + c.offB + 8);
    vB = *(const v4u*)(Vc + c.offV);
}
__device__ __forceinline__ void hgrn_chunk(const HgCtx& c, int n, float (&lf)[16], v4u (&qB)[2], v4u (&kB)[2], v4u& vB, f32x4 (&S)[4]) {
    LAS unsigned char* lds = c.lds;
    const int dir = c.dir, lr = c.lr, lq = c.lq, wave = c.wave, dA = c.dA, seg = c.seg, tauB = c.tauB, dg = c.dg;
    const int tb = c.b * TT + (dir ? (TT / 64 - 1 - n) * 64 : n * 64); HG_PSTAMP(lds, n, 660);
    float bl[16]; { float cs = 0.f;
#pragma unroll
        for (int i = 0; i < 16; ++i) { cs += lf[i]; bl[i] = cs; }
        *(LAS float*)(lds + HG_SEG + (seg * 128 + dA) * 4) = cs; }
    __syncthreads();
    HG_PSTAMP(lds, n, 661);
    {
        const float p0 = *(LAS float*)(lds + HG_SEG + (0 * 128 + dA) * 4), p1 = *(LAS float*)(lds + HG_SEG + (1 * 128 + dA) * 4),
                    p2 = *(LAS float*)(lds + HG_SEG + (2 * 128 + dA) * 4), p3 = *(LAS float*)(lds + HG_SEG + (3 * 128 + dA) * 4);
        const float pre = (seg > 0 ? p0 : 0.f) + (seg > 1 ? p1 : 0.f) + (seg > 2 ? p2 : 0.f);
#pragma unroll
        for (int i = 0; i < 16; ++i) *(LAS float*)(lds + HG_BF + (16 * seg + i) * HG_RSBF + dA * 4) = pre + bl[i];
        if (seg == 0) *(LAS float*)(lds + HG_DEC + dA * 4) = __expf((p0 + p1) + (p2 + p3));
    }
    __syncthreads();
    HG_PSTAMP(lds, n, 662);
    {
        const unsigned qw[8] = {qB[0].x, qB[0].y, qB[0].z, qB[0].w, qB[1].x, qB[1].y, qB[1].z, qB[1].w};
        const unsigned kw[8] = {kB[0].x, kB[0].y, kB[0].z, kB[0].w, kB[1].x, kB[1].y, kB[1].z, kB[1].w};
        unsigned qo[8], ko[8], eo[8];
#pragma unroll
        for (int i = 0; i < 4; ++i) {
            const f32x4 bb = *(const LAS f32x4*)(lds + HG_BF + tauB * HG_RSBF + dg * 64 + i * 16);
            const f32x4 dc = *(const LAS f32x4*)(lds + HG_DEC + dg * 64 + i * 16);
#pragma unroll
            for (int j = 0; j < 2; ++j) {
                const float e0 = __expf(bb[2 * j]), e1 = __expf(bb[2 * j + 1]);
                const unsigned qq = qw[2 * i + j], kk = kw[2 * i + j];
                const float k0 = bf2f(kk & 0xffffu) * __builtin_amdgcn_rcpf(e0), k1 = bf2f(kk >> 16) * __builtin_amdgcn_rcpf(e1);
                qo[2 * i + j] = pk2(bf2f(qq & 0xffffu) * e0, bf2f(qq >> 16) * e1);
                ko[2 * i + j] = pk2(k0, k1);
                eo[2 * i + j] = pk2(k0 * dc[2 * j], k1 * dc[2 * j + 1]);
            }
        }
        *(LAS v4u*)(lds + HG_QI + tauB * HG_RSD + dg * 32) = (v4u){qo[0], qo[1], qo[2], qo[3]}; *(LAS v4u*)(lds + HG_QI + tauB * HG_RSD + dg * 32 + 16) = (v4u){qo[4], qo[5], qo[6], qo[7]};
        *(LAS v4u*)(lds + HG_KK + tauB * HG_RSD + dg * 32) = (v4u){ko[0], ko[1], ko[2], ko[3]}; *(LAS v4u*)(lds + HG_KK + tauB * HG_RSD + dg * 32 + 16) = (v4u){ko[4], ko[5], ko[6], ko[7]};
        *(LAS v4u*)(lds + HG_KE + tauB * HG_RSD + dg * 32) = (v4u){eo[0], eo[1], eo[2], eo[3]}; *(LAS v4u*)(lds + HG_KE + tauB * HG_RSD + dg * 32 + 16) = (v4u){eo[4], eo[5], eo[6], eo[7]};
        *(LAS v4u*)(lds + HG_V + tauB * HG_RSS + dg * 16) = vB;
    }
    __syncthreads();
    HG_PSTAMP(lds, n, 663);
    if (n + 2 < TT / 64) hgrn_load(c, n + 2, lf, qB, kB, vB);
    HG_PSTAMP(lds, n, 666);
    const int ei = wave & 3, tp = wave >> 2;
    v2u ket[2][2], vt[4][2][2];
    asm volatile("ds_read_b64_tr_b16 %0, %4\n\tds_read_b64_tr_b16 %1, %4 offset:1088\n\tds_read_b64_tr_b16 %2, %4 offset:8704\n\tds_read_b64_tr_b16 %3, %4 offset:9792"
                 : "=&v"(ket[0][0]), "=&v"(ket[0][1]), "=&v"(ket[1][0]), "=&v"(ket[1][1]) : "v"(c.ke_tr) : "memory");
#define HG_VTR(e4, o0, o1, o2, o3) asm volatile("ds_read_b64_tr_b16 %0, %4 offset:" #o0 "\n\tds_read_b64_tr_b16 %1, %4 offset:" #o1 "\n\tds_read_b64_tr_b16 %2, %4 offset:" #o2 "\n\tds_read_b64_tr_b16 %3, %4 offset:" #o3 \
                 : "=&v"(vt[e4][0][0]), "=&v"(vt[e4][0][1]), "=&v"(vt[e4][1][0]), "=&v"(vt[e4][1][1]) : "v"(c.v_tr) : "memory")
    HG_VTR(0, 0, 576, 4608, 5184); HG_VTR(1, 32, 608, 4640, 5216); HG_VTR(2, 64, 640, 4672, 5248); HG_VTR(3, 96, 672, 4704, 5280);
#undef HG_VTR
    {
        const int ti = wave & 3;
#pragma unroll
        for (int sii = 0; sii < 2; ++sii) {
            const int si = tp * 2 + sii;
            v2u w = (v2u){0u, 0u};
            if (si <= ti) {
                f32x4 a = (f32x4){0.f, 0.f, 0.f, 0.f};
#pragma unroll
                for (int kk = 0; kk < 4; ++kk)
                    a = __builtin_amdgcn_mfma_f32_16x16x32_bf16(lds_frag(lds + HG_KK + (16 * si + lr) * HG_RSD + kk * 64 + lq * 16), lds_frag(lds + HG_QI + (16 * ti + lr) * HG_RSD + kk * 64 + lq * 16), a, 0, 0, 0);
                const int s0 = 16 * si + 4 * lq, t = 16 * ti + lr;
                w.x = pk2(s0 + 0 <= t ? a[0] : 0.f, s0 + 1 <= t ? a[1] : 0.f); w.y = pk2(s0 + 2 <= t ? a[2] : 0.f, s0 + 3 <= t ? a[3] : 0.f);
            }
            *(LAS v2u*)(lds + HG_AM + (16 * ti + lr) * HG_RSS + (16 * si + 4 * lq) * 2) = w;
        }
    }
    f32x4 o[2];
#pragma unroll
    for (int tt = 0; tt < 2; ++tt) {
        o[tt] = (f32x4){0.f, 0.f, 0.f, 0.f};
#pragma unroll
        for (int kk = 0; kk < 4; ++kk)
            o[tt] = __builtin_amdgcn_mfma_f32_16x16x32_bf16(lds_frag(lds + HG_ST + (16 * ei + lr) * HG_RSD + kk * 64 + lq * 16), lds_frag(lds + HG_QI + (16 * (2 * tp + tt) + lr) * HG_RSD + kk * 64 + lq * 16), o[tt], 0, 0, 0);
    }
    HG_PSTAMP(lds, n, 667);
    asm volatile("s_waitcnt lgkmcnt(0)"
                 : "+v"(ket[0][0]), "+v"(ket[0][1]), "+v"(ket[1][0]), "+v"(ket[1][1]),
                   "+v"(vt[0][0][0]), "+v"(vt[0][0][1]), "+v"(vt[0][1][0]), "+v"(vt[0][1][1]), "+v"(vt[1][0][0]), "+v"(vt[1][0][1]), "+v"(vt[1][1][0]), "+v"(vt[1][1][1]),
                   "+v"(vt[2][0][0]), "+v"(vt[2][0][1]), "+v"(vt[2][1][0]), "+v"(vt[2][1][1]), "+v"(vt[3][0][0]), "+v"(vt[3][0][1]), "+v"(vt[3][1][0]), "+v"(vt[3][1][1]) :: "memory");
    {
        const f32x4 dv = *(const LAS f32x4*)(lds + HG_DEC + (16 * wave + 4 * lq) * 4);
#pragma unroll
        for (int e4 = 0; e4 < 4; ++e4) S[e4] = S[e4] * dv;
#pragma unroll
        for (int kk = 0; kk < 2; ++kk) {
            const pg8::bf16x8 af = mk_frag(ket[kk][0], ket[kk][1]);
#pragma unroll
            for (int e4 = 0; e4 < 4; ++e4) S[e4] = __builtin_amdgcn_mfma_f32_16x16x32_bf16(af, mk_frag(vt[e4][kk][0], vt[e4][kk][1]), S[e4], 0, 0, 0);
        }
    }
    HG_PSTAMP(lds, n, 668);
    const pg8::bf16x8 vf0 = ei == 0 ? mk_frag(vt[0][0][0], vt[0][0][1]) : ei == 1 ? mk_frag(vt[1][0][0], vt[1][0][1]) : ei == 2 ? mk_frag(vt[2][0][0], vt[2][0][1]) : mk_frag(vt[3][0][0], vt[3][0][1]);
    const pg8::bf16x8 vf1 = ei == 0 ? mk_frag(vt[0][1][0], vt[0][1][1]) : ei == 1 ? mk_frag(vt[1][1][0], vt[1][1][1]) : ei == 2 ? mk_frag(vt[2][1][0], vt[2][1][1]) : mk_frag(vt[3][1][0], vt[3][1][1]);
    __syncthreads();
    HG_PSTAMP(lds, n, 664);
#pragma unroll
    for (int tt = 0; tt < 2; ++tt) {
        o[tt] = __builtin_amdgcn_mfma_f32_16x16x32_bf16(vf0, lds_frag(lds + HG_AM + (16 * (2 * tp + tt) + lr) * HG_RSS + 0 * 64 + lq * 16), o[tt], 0, 0, 0);
        o[tt] = __builtin_amdgcn_mfma_f32_16x16x32_bf16(vf1, lds_frag(lds + HG_AM + (16 * (2 * tp + tt) + lr) * HG_RSS + 1 * 64 + lq * 16), o[tt], 0, 0, 0);
        const int t = 16 * (2 * tp + tt) + lr;
        { v2u ow; ow.x = pk2(o[tt][0], o[tt][1]); ow.y = pk2(o[tt][2], o[tt][3]);
          *(v2u*)((bf16*)c.Op + (size_t)(dir ? tb + 63 - t : tb + t) * 512 + c.h * 128 + c.vh * 64 + 16 * ei + 4 * lq) = ow; }
    }
#pragma unroll
    for (int e4 = 0; e4 < 4; ++e4) { v2u w; w.x = pk2(S[e4][0], S[e4][1]); w.y = pk2(S[e4][2], S[e4][3]); *(LAS v2u*)(lds + HG_ST + (16 * e4 + lr) * HG_RSD + (16 * wave + 4 * lq) * 2) = w; }
    HG_PSTAMP(lds, n, 665);
}
__device__ __forceinline__ void hgrn_unit(LAS unsigned char* lds, int unit, const bf16* Qb, const bf16* KFb, const bf16* KBb, const bf16* Vb, const float* LFb, const float* LBb,
                                          float* OFb, float* OBb, int tid, int lane, int wave) {
    HgCtx c;
    c.lds = lds; c.vh = unit & 1; c.dir = (unit >> 1) & 1; c.h = (unit >> 2) & 3; c.b = unit >> 4;
    c.Qb = Qb; c.Vb = Vb; c.Kp = c.dir ? KBb : KFb; c.Lp = c.dir ? LBb : LFb; c.Op = c.dir ? OBb : OFb;
    c.lane = lane; c.wave = wave; c.lr = lane & 15; c.lq = lane >> 4;
    c.dA = tid & 127; c.seg = tid >> 7;
    c.tauB = tid >> 3; c.dg = tid & 7;
    for (int i = tid; i < 64 * HG_RSD / 16; i += NTHR) *(LAS v4u*)(lds + HG_ST + i * 16) = (v4u){0u, 0u, 0u, 0u};
    f32x4 S[4];
#pragma unroll
    for (int i = 0; i < 4; ++i) S[i] = (f32x4){0.f, 0.f, 0.f, 0.f};
#pragma unroll
    for (int i = 0; i < 16; ++i) { const int tau = 16 * c.seg + i; c.offA[i] = (unsigned)((c.dir ? 63 - tau : tau) * 512 + c.dA); }
    c.offB = (unsigned)((c.dir ? 63 - c.tauB : c.tauB) * 512 + 16 * c.dg); c.offV = (unsigned)((c.dir ? 63 - c.tauB : c.tauB) * 512 + c.vh * 64 + 8 * c.dg);
    const unsigned trrow = (unsigned)(8 * c.lq + ((lane & 15) >> 2)), trcol = (unsigned)(4 * (lane & 3));
    c.ke_tr = (unsigned)(size_t)(lds + HG_KE) + trrow * HG_RSD + (16 * wave + trcol) * 2;
    c.v_tr = (unsigned)(size_t)(lds + HG_V) + trrow * HG_RSS + trcol * 2;
    float lf0[16], lf1[16]; v4u qB0[2], kB0[2], vB0, qB1[2], kB1[2], vB1;
    hgrn_load(c, 0, lf0, qB0, kB0, vB0); hgrn_load(c, 1, lf1, qB1, kB1, vB1);
#pragma unroll 1
    for (int n = 0; n < TT / 64; n += 2) { hgrn_chunk(c, n, lf0, qB0, kB0, vB0, S); hgrn_chunk(c, n + 1, lf1, qB1, kB1, vB1, S); }
    __syncthreads();
}

__device__ __forceinline__ void router_finish(float (&a)[NE], int m, int lane, const float* router_b, LAS int* lcnt, LAS unsigned* sbw, float* GATE) {
#define RF_STEP(s2, n) { const bool up = (lane & (s2)) != 0; _Pragma("unroll") for (int i = 0; i < (n); ++i) { const float k1 = up ? a[i + (n)] : a[i], x1 = up ? a[i] : a[i + (n)]; a[i] = k1 + __shfl_xor(x1, (s2)); } }
    RF_STEP(32, 16) RF_STEP(16, 8) RF_STEP(8, 4) RF_STEP(4, 2) RF_STEP(2, 1)
#undef RF_STEP
    float lg = a[0] + __shfl_xor(a[0], 1);
    const int myE = lane >> 1;
    lg += router_b[myE];
    float tv[TOPK]; int ti[TOPK];
#pragma unroll
    for (int k = 0; k < TOPK; ++k) {
        float mx = lg;
#pragma unroll
        for (int o = 1; o < 64; o <<= 1) mx = fmaxf(mx, __shfl_xor(mx, o));
        int cand = (lg == mx) ? myE : 99;
#pragma unroll
        for (int o = 1; o < 64; o <<= 1) cand = min(cand, __shfl_xor(cand, o));
        tv[k] = mx; ti[k] = cand;
        if (myE == cand) lg = -INFINITY;
    }
    const float e1 = __expf(tv[1] - tv[0]), e2 = __expf(tv[2] - tv[0]), e3 = __expf(tv[3] - tv[0]);
    const float inv = 1.0f / (1.0f + e1 + e2 + e3);
    if (lane < TOPK && m < MTOK) {
        const int ek = lane == 0 ? ti[0] : lane == 1 ? ti[1] : lane == 2 ? ti[2] : ti[3];
        const float gk = (lane == 0 ? 1.0f : lane == 1 ? e1 : lane == 2 ? e2 : e3) * inv;
        const int lr = __hip_atomic_fetch_add(&lcnt[ek], 1, __ATOMIC_RELAXED, __HIP_MEMORY_SCOPE_WORKGROUP);
        sbw[lane] = ((unsigned)ek << 16) | (unsigned)lr;
        GATE[(size_t)m * TOPK + lane] = gk;
    }
}

#ifndef PROBE_DELAY
#define PROBE_DELAY 0
#endif
__device__ __forceinline__ void probe_delay(int us100) { const unsigned long long t0 = __builtin_amdgcn_s_memrealtime(); while (__builtin_amdgcn_s_memrealtime() - t0 < (unsigned long long)us100) __builtin_amdgcn_s_sleep(2); }
#if !defined(HGRN_V2)
constexpr int H3_QI = 0, H3_KK = 34816, H3_V = 69632, H3_DEC = 88064, H3_ST = 89088, H3_AM = 106496, H3_LH = 115712, H3_LL = 133120, H3_END = 150528;
constexpr int H3_BUFD = 17408, H3_BUFV = 9216, H3_BUFDEC = 512;
static_assert(H3_END <= LDSCTL_OFF, "recurrence LDS image below the control words");
struct Hg3 {
    LAS unsigned char* lds; const bf16 *Qb, *Kp, *Vb; const float* Lp; float* Op;
    int b, h, dir, vh, lane, lr, lq;
};
__device__ __forceinline__ size_t hg3_row(const Hg3& c, int n, int t) {
    const int tb = c.b * TT + (c.dir ? (TT / 64 - 1 - n) * 64 : n * 64);
    return (size_t)(c.dir ? tb + 63 - t : tb + t) * 512 + c.h * 128;
}
struct Hg3LV { f32x4 lf[8]; v4u v[2]; };
struct Hg3QK { v2u q[2][4], k[2][4]; };
__device__ __forceinline__ void gld16(f32x4& d, const void* p) { asm volatile("global_load_dwordx4 %0, %1, off" : "=v"(d) : "v"(p) : "memory"); }
__device__ __forceinline__ void gld16u(v4u& d, const void* p) { asm volatile("global_load_dwordx4 %0, %1, off" : "=v"(d) : "v"(p) : "memory"); }
__device__ __forceinline__ void gld8(v2u& d, const void* p) { asm volatile("global_load_dwordx2 %0, %1, off" : "=v"(d) : "v"(p) : "memory"); }
__device__ __forceinline__ void hg3_load_lv(const Hg3& c, int n, int pt, Hg3LV& in) {
    const size_t r = hg3_row(c, n, pt >> 2);
#pragma unroll
    for (int i = 0; i < 8; ++i) gld16(in.lf[i], c.Lp + r + 32 * (pt & 3) + 4 * i);
    gld16u(in.v[0], c.Vb + r + c.vh * 64 + 16 * (pt & 3)); gld16u(in.v[1], c.Vb + r + c.vh * 64 + 16 * (pt & 3) + 8);
}
__device__ __forceinline__ void hg3_load_qk(const Hg3& c, int n, int pw, Hg3QK& in) {
#pragma unroll
    for (int ti = 0; ti < 4; ++ti) { const size_t r = hg3_row(c, n, 16 * ti + c.lr);
#pragma unroll
        for (int dt = 0; dt < 2; ++dt) { const int d0 = 16 * (2 * pw + dt) + 4 * c.lq; gld8(in.q[dt][ti], c.Qb + r + d0); gld8(in.k[dt][ti], c.Kp + r + d0); } }
}
#define H3_USE_LV(x) asm volatile("" : "+v"((x).lf[0]), "+v"((x).lf[1]), "+v"((x).lf[2]), "+v"((x).lf[3]), "+v"((x).lf[4]), "+v"((x).lf[5]), "+v"((x).lf[6]), "+v"((x).lf[7]), "+v"((x).v[0]), "+v"((x).v[1]))
#define H3_USE_QK(x) asm volatile("" : "+v"((x).q[0][0]), "+v"((x).q[0][1]), "+v"((x).q[0][2]), "+v"((x).q[0][3]), "+v"((x).q[1][0]), "+v"((x).q[1][1]), "+v"((x).q[1][2]), "+v"((x).q[1][3]), \
                                           "+v"((x).k[0][0]), "+v"((x).k[0][1]), "+v"((x).k[0][2]), "+v"((x).k[0][3]), "+v"((x).k[1][0]), "+v"((x).k[1][1]), "+v"((x).k[1][2]), "+v"((x).k[1][3]))
__device__ __forceinline__ unsigned hg3_hi_lo(float x, float y, unsigned& lo) {
    const unsigned hi = pk2(x, y);
    lo = pk2(x - bf2f(hi & 0xffffu), y - bf2f(hi >> 16));
    return hi;
}
__device__ __forceinline__ void hg3_prep_a(const Hg3& c, int buf, int pt, const Hg3LV& in) {
    const int t = pt >> 2, dq = pt & 3;
#pragma unroll
    for (int i = 0; i < 8; ++i) { unsigned l0, l1; const unsigned h0 = hg3_hi_lo(in.lf[i].x, in.lf[i].y, l0), h1 = hg3_hi_lo(in.lf[i].z, in.lf[i].w, l1);
        *(LAS v2u*)(c.lds + H3_LH + t * 272 + (32 * dq + 4 * i) * 2) = (v2u){h0, h1}; *(LAS v2u*)(c.lds + H3_LL + t * 272 + (32 * dq + 4 * i) * 2) = (v2u){l0, l1}; }
    *(LAS v4u*)(c.lds + H3_V + buf * H3_BUFV + t * 144 + dq * 32) = in.v[0]; *(LAS v4u*)(c.lds + H3_V + buf * H3_BUFV + t * 144 + dq * 32 + 16) = in.v[1];
}
__device__ __forceinline__ void hg3_prep_b(const Hg3& c, int buf, int pw, const Hg3QK& in, const pg8::bf16x8 (&U)[4]) {
    LAS unsigned char* lds = c.lds; const int lr = c.lr, lq = c.lq, lane = c.lane;
    const unsigned trrow = (unsigned)(8 * lq + ((lane & 15) >> 2)), trcol = (unsigned)(4 * (lane & 3));
    const pg8::bf16x8 ones = (pg8::bf16x8)(v4u){0x3F803F80u, 0x3F803F80u, 0x3F803F80u, 0x3F803F80u};
#pragma unroll
    for (int dt = 0; dt < 2; ++dt) {
        const int dtile = 2 * pw + dt;
        v2u fh[2][2], fl[2][2];
        const unsigned ah = (unsigned)(size_t)(lds + H3_LH) + trrow * 272 + (16 * dtile + trcol) * 2, al = ah + (H3_LL - H3_LH);
        asm volatile("ds_read_b64_tr_b16 %0, %8\n\tds_read_b64_tr_b16 %1, %8 offset:1088\n\tds_read_b64_tr_b16 %2, %8 offset:8704\n\tds_read_b64_tr_b16 %3, %8 offset:9792\n\t"
                     "ds_read_b64_tr_b16 %4, %9\n\tds_read_b64_tr_b16 %5, %9 offset:1088\n\tds_read_b64_tr_b16 %6, %9 offset:8704\n\tds_read_b64_tr_b16 %7, %9 offset:9792\n\ts_waitcnt lgkmcnt(0)"
                     : "=&v"(fh[0][0]), "=&v"(fh[0][1]), "=&v"(fh[1][0]), "=&v"(fh[1][1]), "=&v"(fl[0][0]), "=&v"(fl[0][1]), "=&v"(fl[1][0]), "=&v"(fl[1][1]) : "v"(ah), "v"(al) : "memory");
        const pg8::bf16x8 H0 = mk_frag(fh[0][0], fh[0][1]), H1 = mk_frag(fh[1][0], fh[1][1]), L0 = mk_frag(fl[0][0], fl[0][1]), L1 = mk_frag(fl[1][0], fl[1][1]);
        f32x4 bt[4];
        const f32x4 z = (f32x4){0.f, 0.f, 0.f, 0.f};
        bt[0] = __builtin_amdgcn_mfma_f32_16x16x32_bf16(L0, U[0], z, 0, 0, 0);    bt[0] = __builtin_amdgcn_mfma_f32_16x16x32_bf16(H0, U[0], bt[0], 0, 0, 0);
        bt[1] = __builtin_amdgcn_mfma_f32_16x16x32_bf16(L0, U[1], z, 0, 0, 0);    bt[1] = __builtin_amdgcn_mfma_f32_16x16x32_bf16(H0, U[1], bt[1], 0, 0, 0);
        bt[2] = __builtin_amdgcn_mfma_f32_16x16x32_bf16(L0, ones, z, 0, 0, 0);    bt[2] = __builtin_amdgcn_mfma_f32_16x16x32_bf16(L1, U[2], bt[2], 0, 0, 0);
        bt[2] = __builtin_amdgcn_mfma_f32_16x16x32_bf16(H0, ones, bt[2], 0, 0, 0); bt[2] = __builtin_amdgcn_mfma_f32_16x16x32_bf16(H1, U[2], bt[2], 0, 0, 0);
        bt[3] = __builtin_amdgcn_mfma_f32_16x16x32_bf16(L0, ones, z, 0, 0, 0);    bt[3] = __builtin_amdgcn_mfma_f32_16x16x32_bf16(L1, U[3], bt[3], 0, 0, 0);
        bt[3] = __builtin_amdgcn_mfma_f32_16x16x32_bf16(H0, ones, bt[3], 0, 0, 0); bt[3] = __builtin_amdgcn_mfma_f32_16x16x32_bf16(H1, U[3], bt[3], 0, 0, 0);
        f32x4 de;
#pragma unroll
        for (int r = 0; r < 4; ++r) de[r] = __expf(__shfl(bt[3][r], 16 * lq + 15));
        if (lr == 0) *(LAS f32x4*)(lds + H3_DEC + buf * H3_BUFDEC + (16 * dtile + 4 * lq) * 4) = de;
#pragma unroll
        for (int ti = 0; ti < 4; ++ti) {
            const v2u qq = in.q[dt][ti], kk = in.k[dt][ti];
            const float e0 = __expf(bt[ti][0]), e1 = __expf(bt[ti][1]), e2 = __expf(bt[ti][2]), e3 = __expf(bt[ti][3]);
            v2u qo, ko;
            qo.x = pk2(bf2f(qq.x & 0xffffu) * e0, bf2f(qq.x >> 16) * e1); qo.y = pk2(bf2f(qq.y & 0xffffu) * e2, bf2f(qq.y >> 16) * e3);
            ko.x = pk2(bf2f(kk.x & 0xffffu) * __builtin_amdgcn_rcpf(e0), bf2f(kk.x >> 16) * __builtin_amdgcn_rcpf(e1));
            ko.y = pk2(bf2f(kk.y & 0xffffu) * __builtin_amdgcn_rcpf(e2), bf2f(kk.y >> 16) * __builtin_amdgcn_rcpf(e3));
            const int off = (16 * ti + lr) * 272 + (16 * dtile + 4 * lq) * 2;
            *(LAS v2u*)(lds + H3_QI + buf * H3_BUFD + off) = qo; *(LAS v2u*)(lds + H3_KK + buf * H3_BUFD + off) = ko;
        }
    }
}
__device__ __forceinline__ void hg3_stage1(const Hg3& c, int buf, int mw, f32x4 (&S)[2][4], f32x4 (&o)[2][2], v2u (&vt)[4][2][2]) {
    LAS unsigned char* lds = c.lds; const int lr = c.lr, lq = c.lq, lane = c.lane;
    const LAS unsigned char* QI = lds + H3_QI + buf * H3_BUFD; const LAS unsigned char* KK = lds + H3_KK + buf * H3_BUFD;
    const unsigned trrow = (unsigned)(8 * lq + ((lane & 15) >> 2)), trcol = (unsigned)(4 * (lane & 3));
    const unsigned kk_tr = (unsigned)(size_t)KK + trrow * 272 + (32 * mw + trcol) * 2;
    const unsigned v_tr = (unsigned)(size_t)(lds + H3_V + buf * H3_BUFV) + trrow * 144 + trcol * 2;
    const int tp = mw >> 1, ep = mw & 1;
    pg8::bf16x8 qf[2][4], sf[2][4], kf[3][4];
#pragma unroll
    for (int bq = 0; bq < 2; ++bq)
#pragma unroll
        for (int kk = 0; kk < 4; ++kk) { qf[bq][kk] = lds_frag(QI + (16 * (2 * tp + bq) + lr) * 272 + kk * 64 + lq * 16); sf[bq][kk] = lds_frag(lds + H3_ST + (16 * (2 * ep + bq) + lr) * 272 + kk * 64 + lq * 16); }
#pragma unroll
    for (int a = 0; a < 2; ++a)
#pragma unroll
        for (int bq = 0; bq < 2; ++bq) o[a][bq] = (f32x4){0.f, 0.f, 0.f, 0.f};
#pragma unroll
    for (int kk = 0; kk < 4; ++kk) {
        o[0][0] = __builtin_amdgcn_mfma_f32_16x16x32_bf16(sf[0][kk], qf[0][kk], o[0][0], 0, 0, 0); o[0][1] = __builtin_amdgcn_mfma_f32_16x16x32_bf16(sf[0][kk], qf[1][kk], o[0][1], 0, 0, 0);
        o[1][0] = __builtin_amdgcn_mfma_f32_16x16x32_bf16(sf[1][kk], qf[0][kk], o[1][0], 0, 0, 0); o[1][1] = __builtin_amdgcn_mfma_f32_16x16x32_bf16(sf[1][kk], qf[1][kk], o[1][1], 0, 0, 0);
    }
    __builtin_amdgcn_sched_barrier(0);
    const int ks0 = mw == 3 ? 1 : 0;
    if (mw != 1) {
#pragma unroll
        for (int x = 0; x < 3; ++x)
#pragma unroll
            for (int kk = 0; kk < 4; ++kk) kf[x][kk] = lds_frag(KK + (16 * (ks0 + x) + lr) * 272 + kk * 64 + lq * 16);
    }
    v2u kt[2][2][2];
    {
        f32x4 at[4];
#pragma unroll
        for (int i = 0; i < 4; ++i) at[i] = (f32x4){0.f, 0.f, 0.f, 0.f};
        if (mw != 1) {
#pragma unroll
            for (int kk = 0; kk < 4; ++kk) {
                at[0] = __builtin_amdgcn_mfma_f32_16x16x32_bf16(kf[0][kk], mw == 3 ? qf[1][kk] : qf[0][kk], at[0], 0, 0, 0);
                at[1] = __builtin_amdgcn_mfma_f32_16x16x32_bf16(mw == 0 ? kf[0][kk] : kf[1][kk], mw == 2 ? qf[0][kk] : qf[1][kk], at[1], 0, 0, 0);
                at[2] = __builtin_amdgcn_mfma_f32_16x16x32_bf16(mw == 0 ? kf[1][kk] : kf[2][kk], mw == 2 ? qf[0][kk] : qf[1][kk], at[2], 0, 0, 0);
                if (mw == 2) at[3] = __builtin_amdgcn_mfma_f32_16x16x32_bf16(kf[0][kk], qf[1][kk], at[3], 0, 0, 0);
            }
        }
    asm volatile("ds_read_b64_tr_b16 %0, %8\n\tds_read_b64_tr_b16 %1, %8 offset:1088\n\tds_read_b64_tr_b16 %2, %8 offset:8704\n\tds_read_b64_tr_b16 %3, %8 offset:9792\n\t"
                 "ds_read_b64_tr_b16 %4, %8 offset:32\n\tds_read_b64_tr_b16 %5, %8 offset:1120\n\tds_read_b64_tr_b16 %6, %8 offset:8736\n\tds_read_b64_tr_b16 %7, %8 offset:9824"
                 : "=&v"(kt[0][0][0]), "=&v"(kt[0][0][1]), "=&v"(kt[0][1][0]), "=&v"(kt[0][1][1]), "=&v"(kt[1][0][0]), "=&v"(kt[1][0][1]), "=&v"(kt[1][1][0]), "=&v"(kt[1][1][1]) : "v"(kk_tr) : "memory");
#define H3_VTR(e4, o0, o1, o2, o3) asm volatile("ds_read_b64_tr_b16 %0, %4 offset:" #o0 "\n\tds_read_b64_tr_b16 %1, %4 offset:" #o1 "\n\tds_read_b64_tr_b16 %2, %4 offset:" #o2 "\n\tds_read_b64_tr_b16 %3, %4 offset:" #o3 \
                 : "=&v"(vt[e4][0][0]), "=&v"(vt[e4][0][1]), "=&v"(vt[e4][1][0]), "=&v"(vt[e4][1][1]) : "v"(v_tr) : "memory")
    H3_VTR(0, 0, 576, 4608, 5184); H3_VTR(1, 32, 608, 4640, 5216); H3_VTR(2, 64, 640, 4672, 5248); H3_VTR(3, 96, 672, 4704, 5280);
#undef H3_VTR
#pragma unroll
        for (int i = 0; i < 4; ++i) {
            int si, ti; bool have = true, zero = false;
            if (mw == 0) { si = i == 2 ? 1 : 0; ti = i == 0 ? 0 : 1; have = i < 3; }
            else if (mw == 1) { si = 1; ti = 0; have = i == 0; zero = true; }
            else if (mw == 2) { si = i == 3 ? 0 : i; ti = i == 3 ? 3 : 2; }
            else { si = i == 3 ? 3 : i + 1; ti = i == 3 ? 2 : 3; zero = i == 3; }
            if (have) {
                const int s0 = 16 * si + 4 * lq, t = 16 * ti + lr; v2u w = (v2u){0u, 0u};
                if (!zero) { w.x = pk2(s0 + 0 <= t ? at[i][0] : 0.f, s0 + 1 <= t ? at[i][1] : 0.f); w.y = pk2(s0 + 2 <= t ? at[i][2] : 0.f, s0 + 3 <= t ? at[i][3] : 0.f); }
                *(LAS v2u*)(lds + H3_AM + (16 * ti + lr) * 144 + (16 * si + 4 * lq) * 2) = w;
            }
        }
    }
    asm volatile("s_waitcnt lgkmcnt(0)"
                 : "+v"(kt[0][0][0]), "+v"(kt[0][0][1]), "+v"(kt[0][1][0]), "+v"(kt[0][1][1]), "+v"(kt[1][0][0]), "+v"(kt[1][0][1]), "+v"(kt[1][1][0]), "+v"(kt[1][1][1]),
                   "+v"(vt[0][0][0]), "+v"(vt[0][0][1]), "+v"(vt[0][1][0]), "+v"(vt[0][1][1]), "+v"(vt[1][0][0]), "+v"(vt[1][0][1]), "+v"(vt[1][1][0]), "+v"(vt[1][1][1]),
                   "+v"(vt[2][0][0]), "+v"(vt[2][0][1]), "+v"(vt[2][1][0]), "+v"(vt[2][1][1]), "+v"(vt[3][0][0]), "+v"(vt[3][0][1]), "+v"(vt[3][1][0]), "+v"(vt[3][1][1]) :: "memory");
#pragma unroll
    for (int dt = 0; dt < 2; ++dt) {
#pragma unroll
        for (int kk = 0; kk < 2; ++kk) {
            const pg8::bf16x8 af = mk_frag(kt[dt][kk][0], kt[dt][kk][1]);
#pragma unroll
            for (int e4 = 0; e4 < 4; ++e4) S[dt][e4] = __builtin_amdgcn_mfma_f32_16x16x32_bf16(af, mk_frag(vt[e4][kk][0], vt[e4][kk][1]), S[dt][e4], 0, 0, 0);
        }
        const f32x4 dv = *(const LAS f32x4*)(lds + H3_DEC + buf * H3_BUFDEC + (16 * (2 * mw + dt) + 4 * lq) * 4);
#pragma unroll
        for (int e4 = 0; e4 < 4; ++e4) S[dt][e4] = S[dt][e4] * dv;
    }
}
__device__ __forceinline__ void hg3_stage2(const Hg3& c, int n, int mw, const f32x4 (&S)[2][4], f32x4 (&o)[2][2], const v2u (&vt)[4][2][2]) {
    LAS unsigned char* lds = c.lds; const int lr = c.lr, lq = c.lq;
#pragma unroll
    for (int bq = 0; bq < 2; ++bq) {
        const int ti = 2 * (mw >> 1) + bq;
        const pg8::bf16x8 a0 = lds_frag(lds + H3_AM + (16 * ti + lr) * 144 + 0 * 64 + lq * 16);
#pragma unroll
        for (int a = 0; a < 2; ++a) { const int e4 = 2 * (mw & 1) + a;
            const pg8::bf16x8 vf = e4 == 0 ? mk_frag(vt[0][0][0], vt[0][0][1]) : e4 == 1 ? mk_frag(vt[1][0][0], vt[1][0][1]) : e4 == 2 ? mk_frag(vt[2][0][0], vt[2][0][1]) : mk_frag(vt[3][0][0], vt[3][0][1]);
            o[a][bq] = __builtin_amdgcn_mfma_f32_16x16x32_bf16(vf, a0, o[a][bq], 0, 0, 0); }
        if (mw >> 1) {
            const pg8::bf16x8 a1 = lds_frag(lds + H3_AM + (16 * ti + lr) * 144 + 1 * 64 + lq * 16);
#pragma unroll
            for (int a = 0; a < 2; ++a) { const int e4 = 2 * (mw & 1) + a;
                const pg8::bf16x8 vf = e4 == 0 ? mk_frag(vt[0][1][0], vt[0][1][1]) : e4 == 1 ? mk_frag(vt[1][1][0], vt[1][1][1]) : e4 == 2 ? mk_frag(vt[2][1][0], vt[2][1][1]) : mk_frag(vt[3][1][0], vt[3][1][1]);
                o[a][bq] = __builtin_amdgcn_mfma_f32_16x16x32_bf16(vf, a1, o[a][bq], 0, 0, 0); }
        }
#pragma unroll
        for (int a = 0; a < 2; ++a)
            *(f32x4*)(c.Op + hg3_row(c, n, 16 * ti + lr) + c.vh * 64 + 16 * (2 * (mw & 1) + a) + 4 * lq) = o[a][bq];
    }
#pragma unroll
    for (int dt = 0; dt < 2; ++dt)
#pragma unroll
        for (int e4 = 0; e4 < 4; ++e4) { v2u w; w.x = pk2(S[dt][e4][0], S[dt][e4][1]); w.y = pk2(S[dt][e4][2], S[dt][e4][3]);
            *(LAS v2u*)(lds + H3_ST + (16 * e4 + lr) * 272 + (16 * (2 * mw + dt) + 4 * lq) * 2) = w; }
}
__device__ __forceinline__ void hgrn3_unit(LAS unsigned char* lds, int unit, const bf16* Qb, const bf16* KFb, const bf16* KBb, const bf16* Vb, const float* LFb, const float* LBb,
                                           float* OFb, float* OBb, int tid, int lane, int wave) {
    Hg3 c;
    c.lds = lds; c.vh = unit & 1; c.dir = (unit >> 1) & 1; c.h = (unit >> 2) & 3; c.b = unit >> 4;
    c.Qb = Qb; c.Vb = Vb; c.Kp = c.dir ? KBb : KFb; c.Lp = c.dir ? LBb : LFb; c.Op = c.dir ? OBb : OFb;
    c.lane = lane; c.lr = lane & 15; c.lq = lane >> 4;
    constexpr int NCH = TT / 64;
    for (int i = tid; i < 64 * 272 / 16; i += NTHR) *(LAS v4u*)(lds + H3_ST + i * 16) = (v4u){0u, 0u, 0u, 0u};
    if (wave < 4) {
        const int pt = tid, pw = wave;
        pg8::bf16x8 U[4];
#pragma unroll
        for (int u = 0; u < 4; ++u) { const int kk = u >> 1, ti = u; unsigned wv[4];
#pragma unroll
            for (int j2 = 0; j2 < 4; ++j2) { const int s = 32 * kk + 8 * c.lq + 2 * j2, t = 16 * ti + c.lr; wv[j2] = (s <= t ? 0x3F80u : 0u) | (s + 1 <= t ? 0x3F800000u : 0u); }
            U[u] = (pg8::bf16x8)(v4u){wv[0], wv[1], wv[2], wv[3]}; }
        Hg3LV lv0, lv1; Hg3QK qk;
        hg3_load_lv(c, 0, pt, lv0); hg3_load_qk(c, 0, pw, qk); hg3_load_lv(c, 1, pt, lv1);
        asm volatile("s_waitcnt vmcnt(0)" ::: "memory"); H3_USE_LV(lv0); H3_USE_QK(qk); H3_USE_LV(lv1);
        hg3_prep_a(c, 0, pt, lv0);
        __syncthreads();
#define H3_TRIP(j_, LVN, LVC) do { \
            if ((j_) < NCH) { asm volatile("s_waitcnt vmcnt(10)" ::: "memory"); H3_USE_QK(qk); hg3_prep_b(c, (j_) & 1, pw, qk, U); \
                if ((j_) + 1 < NCH) hg3_load_qk(c, (j_) + 1, pw, qk); else hg3_load_qk(c, (j_), pw, qk);     \
                if ((j_) + 2 < NCH) hg3_load_lv(c, (j_) + 2, pt, LVC); else hg3_load_lv(c, (j_), pt, LVC); } \
            if (PROBE_DELAY == 2) probe_delay(100); \
            __syncthreads();                                                                    \
            if ((j_) + 1 < NCH) { asm volatile("s_waitcnt vmcnt(26)" ::: "memory"); H3_USE_LV(LVN); hg3_prep_a(c, ((j_) + 1) & 1, pt, LVN); } \
            __syncthreads();                                                                    \
        } while (0)
#pragma unroll 1
        for (int j = 0; j <= NCH; j += 2) { H3_TRIP(j, lv1, lv0); H3_TRIP(j + 1, lv0, lv1); }
#undef H3_TRIP
        asm volatile("s_waitcnt vmcnt(0)" ::: "memory");
    } else {
        const int mw = wave - 4;
        f32x4 S[2][4], o[2][2]; v2u vt[4][2][2];
#pragma unroll
        for (int a = 0; a < 2; ++a)
#pragma unroll
            for (int e4 = 0; e4 < 4; ++e4) S[a][e4] = (f32x4){0.f, 0.f, 0.f, 0.f};
        __syncthreads();
#pragma unroll 1
        for (int j = 0; j <= NCH + 1; ++j) {
            if (j > 0 && j <= NCH) hg3_stage1(c, (j - 1) & 1, mw, S, o, vt);
            if (PROBE_DELAY == 1) probe_delay(100);
            __syncthreads();
            if (j > 0 && j <= NCH) hg3_stage2(c, j - 1, mw, S, o, vt);
            __syncthreads();
        }
    }
    __syncthreads();
}


struct Hg4LV { f32x4 lf[4]; v4u v; };
struct Hg4QK { v2u q[4], k[4]; };
__device__ __forceinline__ void hg4_load_lv(const Hg3& c, int n, int tid, Hg4LV& in) {
    const size_t r = hg3_row(c, n, tid >> 3);
#pragma unroll
    for (int i = 0; i < 4; ++i) gld16(in.lf[i], c.Lp + r + 16 * (tid & 7) + 4 * i);
    gld16u(in.v, c.Vb + r + c.vh * 64 + 8 * (tid & 7));
}
__device__ __forceinline__ void hg4_load_qk(const Hg3& c, int n, int w, Hg4QK& in) {
#pragma unroll
    for (int ti = 0; ti < 4; ++ti) { const size_t r = hg3_row(c, n, 16 * ti + c.lr) + 16 * w + 4 * c.lq; gld8(in.q[ti], c.Qb + r); gld8(in.k[ti], c.Kp + r); }
}
#define H4_USE_LV(x) asm volatile("" : "+v"((x).lf[0]), "+v"((x).lf[1]), "+v"((x).lf[2]), "+v"((x).lf[3]), "+v"((x).v))
#define H4_USE_QK(x) asm volatile("" : "+v"((x).q[0]), "+v"((x).q[1]), "+v"((x).q[2]), "+v"((x).q[3]), "+v"((x).k[0]), "+v"((x).k[1]), "+v"((x).k[2]), "+v"((x).k[3]))
__device__ __forceinline__ void hg4_prep_a(const Hg3& c, int buf, int tid, const Hg4LV& in) {
    const int t = tid >> 3, dq = tid & 7;
#pragma unroll
    for (int i = 0; i < 4; ++i) { unsigned l0, l1; const unsigned h0 = hg3_hi_lo(in.lf[i].x, in.lf[i].y, l0), h1 = hg3_hi_lo(in.lf[i].z, in.lf[i].w, l1);
        *(LAS v2u*)(c.lds + H3_LH + t * 272 + (16 * dq + 4 * i) * 2) = (v2u){h0, h1}; *(LAS v2u*)(c.lds + H3_LL + t * 272 + (16 * dq + 4 * i) * 2) = (v2u){l0, l1}; }
    *(LAS v4u*)(c.lds + H3_V + buf * H3_BUFV + t * 144 + dq * 16) = in.v;
}
__device__ __forceinline__ void hg4_prep_b(const Hg3& c, int buf, int w, const Hg4QK& in, const pg8::bf16x8 (&U)[4]) {
    LAS unsigned char* lds = c.lds; const int lr = c.lr, lq = c.lq, lane = c.lane;
    const unsigned trrow = (unsigned)(8 * lq + ((lane & 15) >> 2)), trcol = (unsigned)(4 * (lane & 3));
    const pg8::bf16x8 ones = (pg8::bf16x8)(v4u){0x3F803F80u, 0x3F803F80u, 0x3F803F80u, 0x3F803F80u};
    v2u fh[2][2], fl[2][2];
    const unsigned ah = (unsigned)(size_t)(lds + H3_LH) + trrow * 272 + (16 * w + trcol) * 2, al = ah + (H3_LL - H3_LH);
    asm volatile("ds_read_b64_tr_b16 %0, %8\n\tds_read_b64_tr_b16 %1, %8 offset:1088\n\tds_read_b64_tr_b16 %2, %8 offset:8704\n\tds_read_b64_tr_b16 %3, %8 offset:9792\n\t"
                 "ds_read_b64_tr_b16 %4, %9\n\tds_read_b64_tr_b16 %5, %9 offset:1088\n\tds_read_b64_tr_b16 %6, %9 offset:8704\n\tds_read_b64_tr_b16 %7, %9 offset:9792\n\ts_waitcnt lgkmcnt(0)"
                 : "=&v"(fh[0][0]), "=&v"(fh[0][1]), "=&v"(fh[1][0]), "=&v"(fh[1][1]), "=&v"(fl[0][0]), "=&v"(fl[0][1]), "=&v"(fl[1][0]), "=&v"(fl[1][1]) : "v"(ah), "v"(al) : "memory");
    const pg8::bf16x8 H0 = mk_frag(fh[0][0], fh[0][1]), H1 = mk_frag(fh[1][0], fh[1][1]), L0 = mk_frag(fl[0][0], fl[0][1]), L1 = mk_frag(fl[1][0], fl[1][1]);
    f32x4 bt[4];
    const f32x4 z = (f32x4){0.f, 0.f, 0.f, 0.f};
    bt[0] = __builtin_amdgcn_mfma_f32_16x16x32_bf16(L0, U[0], z, 0, 0, 0);    bt[0] = __builtin_amdgcn_mfma_f32_16x16x32_bf16(H0, U[0], bt[0], 0, 0, 0);
    bt[1] = __builtin_amdgcn_mfma_f32_16x16x32_bf16(L0, U[1], z, 0, 0, 0);    bt[1] = __builtin_amdgcn_mfma_f32_16x16x32_bf16(H0, U[1], bt[1], 0, 0, 0);
    bt[2] = __builtin_amdgcn_mfma_f32_16x16x32_bf16(L0, ones, z, 0, 0, 0);    bt[2] = __builtin_amdgcn_mfma_f32_16x16x32_bf16(L1, U[2], bt[2], 0, 0, 0);
    bt[2] = __builtin_amdgcn_mfma_f32_16x16x32_bf16(H0, ones, bt[2], 0, 0, 0); bt[2] = __builtin_amdgcn_mfma_f32_16x16x32_bf16(H1, U[2], bt[2], 0, 0, 0);
    bt[3] = __builtin_amdgcn_mfma_f32_16x16x32_bf16(L0, ones, z, 0, 0, 0);    bt[3] = __builtin_amdgcn_mfma_f32_16x16x32_bf16(L1, U[3], bt[3], 0, 0, 0);
    bt[3] = __builtin_amdgcn_mfma_f32_16x16x32_bf16(H0, ones, bt[3], 0, 0, 0); bt[3] = __builtin_amdgcn_mfma_f32_16x16x32_bf16(H1, U[3], bt[3], 0, 0, 0);
    f32x4 de;
#pragma unroll
    for (int r = 0; r < 4; ++r) de[r] = __expf(__shfl(bt[3][r], 16 * lq + 15));
    if (lr == 0) *(LAS f32x4*)(lds + H3_DEC + buf * H3_BUFDEC + (16 * w + 4 * lq) * 4) = de;
#pragma unroll
    for (int ti = 0; ti < 4; ++ti) {
        const v2u qq = in.q[ti], kk = in.k[ti];
        const float e0 = __expf(bt[ti][0]), e1 = __expf(bt[ti][1]), e2 = __expf(bt[ti][2]), e3 = __expf(bt[ti][3]);
        v2u qo, ko;
        qo.x = pk2(bf2f(qq.x & 0xffffu) * e0, bf2f(qq.x >> 16) * e1); qo.y = pk2(bf2f(qq.y & 0xffffu) * e2, bf2f(qq.y >> 16) * e3);
        ko.x = pk2(bf2f(kk.x & 0xffffu) * __builtin_amdgcn_rcpf(e0), bf2f(kk.x >> 16) * __builtin_amdgcn_rcpf(e1));
        ko.y = pk2(bf2f(kk.y & 0xffffu) * __builtin_amdgcn_rcpf(e2), bf2f(kk.y >> 16) * __builtin_amdgcn_rcpf(e3));
        const int off = (16 * ti + lr) * 272 + (16 * w + 4 * lq) * 2;
        *(LAS v2u*)(lds + H3_QI + buf * H3_BUFD + off) = qo; *(LAS v2u*)(lds + H3_KK + buf * H3_BUFD + off) = ko;
    }
}
__device__ __forceinline__ void hg4_stage1(const Hg3& c, int buf, int w, f32x4 (&S)[4], f32x4 (&o)[2], v2u (&vt)[4][2][2]) {
    LAS unsigned char* lds = c.lds; const int lr = c.lr, lq = c.lq, lane = c.lane;
    const LAS unsigned char* QI = lds + H3_QI + buf * H3_BUFD; const LAS unsigned char* KK = lds + H3_KK + buf * H3_BUFD;
    const unsigned trrow = (unsigned)(8 * lq + ((lane & 15) >> 2)), trcol = (unsigned)(4 * (lane & 3));
    const unsigned kk_tr = (unsigned)(size_t)KK + trrow * 272 + (16 * w + trcol) * 2;
    const unsigned v_tr = (unsigned)(size_t)(lds + H3_V + buf * H3_BUFV) + trrow * 144 + trcol * 2;
    v2u kt[2][2];
    asm volatile("ds_read_b64_tr_b16 %0, %4\n\tds_read_b64_tr_b16 %1, %4 offset:1088\n\tds_read_b64_tr_b16 %2, %4 offset:8704\n\tds_read_b64_tr_b16 %3, %4 offset:9792"
                 : "=&v"(kt[0][0]), "=&v"(kt[0][1]), "=&v"(kt[1][0]), "=&v"(kt[1][1]) : "v"(kk_tr) : "memory");
#define H4_VTR(e4, o0, o1, o2, o3) asm volatile("ds_read_b64_tr_b16 %0, %4 offset:" #o0 "\n\tds_read_b64_tr_b16 %1, %4 offset:" #o1 "\n\tds_read_b64_tr_b16 %2, %4 offset:" #o2 "\n\tds_read_b64_tr_b16 %3, %4 offset:" #o3 \
                 : "=&v"(vt[e4][0][0]), "=&v"(vt[e4][0][1]), "=&v"(vt[e4][1][0]), "=&v"(vt[e4][1][1]) : "v"(v_tr) : "memory")
    H4_VTR(0, 0, 576, 4608, 5184); H4_VTR(1, 32, 608, 4640, 5216); H4_VTR(2, 64, 640, 4672, 5248); H4_VTR(3, 96, 672, 4704, 5280);
#undef H4_VTR
    const int ei = w & 3, tp = w >> 2;
    {
        const int ti = w & 3;
#pragma unroll
        for (int sii = 0; sii < 2; ++sii) {
            const int si = tp * 2 + sii;
            v2u wv = (v2u){0u, 0u};
            if (si <= ti) {
                f32x4 a = (f32x4){0.f, 0.f, 0.f, 0.f};
#pragma unroll
                for (int kk = 0; kk < 4; ++kk)
                    a = __builtin_amdgcn_mfma_f32_16x16x32_bf16(lds_frag(KK + (16 * si + lr) * 272 + kk * 64 + lq * 16), lds_frag(QI + (16 * ti + lr) * 272 + kk * 64 + lq * 16), a, 0, 0, 0);
                const int s0 = 16 * si + 4 * lq, t = 16 * ti + lr;
                wv.x = pk2(s0 + 0 <= t ? a[0] : 0.f, s0 + 1 <= t ? a[1] : 0.f); wv.y = pk2(s0 + 2 <= t ? a[2] : 0.f, s0 + 3 <= t ? a[3] : 0.f);
            }
            *(LAS v2u*)(lds + H3_AM + (16 * ti + lr) * 144 + (16 * si + 4 * lq) * 2) = wv;
        }
    }
#pragma unroll
    for (int tt = 0; tt < 2; ++tt) o[tt] = (f32x4){0.f, 0.f, 0.f, 0.f};
#pragma unroll
    for (int kk = 0; kk < 4; ++kk) {
        const pg8::bf16x8 sfr = lds_frag(lds + H3_ST + (16 * ei + lr) * 272 + kk * 64 + lq * 16);
#pragma unroll
        for (int tt = 0; tt < 2; ++tt) o[tt] = __builtin_amdgcn_mfma_f32_16x16x32_bf16(sfr, lds_frag(QI + (16 * (2 * tp + tt) + lr) * 272 + kk * 64 + lq * 16), o[tt], 0, 0, 0);
    }
    asm volatile("s_waitcnt lgkmcnt(0)"
                 : "+v"(kt[0][0]), "+v"(kt[0][1]), "+v"(kt[1][0]), "+v"(kt[1][1]),
                   "+v"(vt[0][0][0]), "+v"(vt[0][0][1]), "+v"(vt[0][1][0]), "+v"(vt[0][1][1]), "+v"(vt[1][0][0]), "+v"(vt[1][0][1]), "+v"(vt[1][1][0]), "+v"(vt[1][1][1]),
                   "+v"(vt[2][0][0]), "+v"(vt[2][0][1]), "+v"(vt[2][1][0]), "+v"(vt[2][1][1]), "+v"(vt[3][0][0]), "+v"(vt[3][0][1]), "+v"(vt[3][1][0]), "+v"(vt[3][1][1]) :: "memory");
#pragma unroll
    for (int kk = 0; kk < 2; ++kk) {
        const pg8::bf16x8 af = mk_frag(kt[kk][0], kt[kk][1]);
#pragma unroll
        for (int e4 = 0; e4 < 4; ++e4) S[e4] = __builtin_amdgcn_mfma_f32_16x16x32_bf16(af, mk_frag(vt[e4][kk][0], vt[e4][kk][1]), S[e4], 0, 0, 0);
    }
    const f32x4 dv = *(const LAS f32x4*)(lds + H3_DEC + buf * H3_BUFDEC + (16 * w + 4 * lq) * 4);
#pragma unroll
    for (int e4 = 0; e4 < 4; ++e4) S[e4] = S[e4] * dv;
}
__device__ __forceinline__ void hg4_stage2(const Hg3& c, int n, int w, const f32x4 (&S)[4], f32x4 (&o)[2], const v2u (&vt)[4][2][2]) {
    LAS unsigned char* lds = c.lds; const int lr = c.lr, lq = c.lq;
    const int ei = w & 3, tp = w >> 2;
    const pg8::bf16x8 vf0 = ei == 0 ? mk_frag(vt[0][0][0], vt[0][0][1]) : ei == 1 ? mk_frag(vt[1][0][0], vt[1][0][1]) : ei == 2 ? mk_frag(vt[2][0][0], vt[2][0][1]) : mk_frag(vt[3][0][0], vt[3][0][1]);
    const pg8::bf16x8 vf1 = ei == 0 ? mk_frag(vt[0][1][0], vt[0][1][1]) : ei == 1 ? mk_frag(vt[1][1][0], vt[1][1][1]) : ei == 2 ? mk_frag(vt[2][1][0], vt[2][1][1]) : mk_frag(vt[3][1][0], vt[3][1][1]);
#pragma unroll
    for (int tt = 0; tt < 2; ++tt) {
        const int ti = 2 * tp + tt;
        o[tt] = __builtin_amdgcn_mfma_f32_16x16x32_bf16(vf0, lds_frag(lds + H3_AM + (16 * ti + lr) * 144 + 0 * 64 + lq * 16), o[tt], 0, 0, 0);
        o[tt] = __builtin_amdgcn_mfma_f32_16x16x32_bf16(vf1, lds_frag(lds + H3_AM + (16 * ti + lr) * 144 + 1 * 64 + lq * 16), o[tt], 0, 0, 0);
        *(f32x4*)(c.Op + hg3_row(c, n, 16 * ti + lr) + c.vh * 64 + 16 * ei + 4 * lq) = o[tt];
    }
#pragma unroll
    for (int e4 = 0; e4 < 4; ++e4) { v2u wv; wv.x = pk2(S[e4][0], S[e4][1]); wv.y = pk2(S[e4][2], S[e4][3]); *(LAS v2u*)(lds + H3_ST + (16 * e4 + lr) * 272 + (16 * w + 4 * lq) * 2) = wv; }
}
__device__ __forceinline__ void hgrn4_unit(LAS unsigned char* lds, int unit, const bf16* Qb, const bf16* KFb, const bf16* KBb, const bf16* Vb, const float* LFb, const float* LBb,
                                           float* OFb, float* OBb, int tid, int lane, int wave) {
    Hg3 c;
    c.lds = lds; c.vh = unit & 1; c.dir = (unit >> 1) & 1; c.h = (unit >> 2) & 3; c.b = unit >> 4;
    c.Qb = Qb; c.Vb = Vb; c.Kp = c.dir ? KBb : KFb; c.Lp = c.dir ? LBb : LFb; c.Op = c.dir ? OBb : OFb;
    c.lane = lane; c.lr = lane & 15; c.lq = lane >> 4;
    constexpr int NCH = TT / 64;
    const int w = wave;
    for (int i = tid; i < 64 * 272 / 16; i += NTHR) *(LAS v4u*)(lds + H3_ST + i * 16) = (v4u){0u, 0u, 0u, 0u};
    pg8::bf16x8 U[4];
#pragma unroll
    for (int u = 0; u < 4; ++u) { const int kk = u >> 1, ti = u; unsigned wv[4];
#pragma unroll
        for (int j2 = 0; j2 < 4; ++j2) { const int sN = 32 * kk + 8 * c.lq + 2 * j2, t = 16 * ti + c.lr; wv[j2] = (sN <= t ? 0x3F80u : 0u) | (sN + 1 <= t ? 0x3F800000u : 0u); }
        U[u] = (pg8::bf16x8)(v4u){wv[0], wv[1], wv[2], wv[3]}; }
    f32x4 S[4], o[2]; v2u vt[4][2][2];
#pragma unroll
    for (int e4 = 0; e4 < 4; ++e4) S[e4] = (f32x4){0.f, 0.f, 0.f, 0.f};
    Hg4LV lv0, lv1; Hg4QK qk;
    hg4_load_lv(c, 0, tid, lv0); hg4_load_qk(c, 0, w, qk); hg4_load_lv(c, 1, tid, lv1);
    asm volatile("s_waitcnt vmcnt(0)" ::: "memory"); H4_USE_LV(lv0); H4_USE_QK(qk); H4_USE_LV(lv1);
    hg4_prep_a(c, 0, tid, lv0);
    __syncthreads();
#define H4_TRIP(j_, LVN, LVC) do { \
        if ((j_) < NCH) { asm volatile("s_waitcnt vmcnt(5)" ::: "memory"); H4_USE_QK(qk); hg4_prep_b(c, (j_) & 1, w, qk, U); \
            hg4_load_qk(c, (j_) + 1 < NCH ? (j_) + 1 : (j_), w, qk); hg4_load_lv(c, (j_) + 2 < NCH ? (j_) + 2 : (j_), tid, LVC); }     \
        if ((j_) > 0 && (j_) <= NCH) hg4_stage1(c, ((j_) - 1) & 1, w, S, o, vt); \
        if (PROBE_DELAY == 5) probe_delay(100); \
        __syncthreads();                                                                        \
        if ((j_) + 1 < NCH) { asm volatile("s_waitcnt vmcnt(13)" ::: "memory"); H4_USE_LV(LVN); hg4_prep_a(c, ((j_) + 1) & 1, tid, LVN); } \
        if ((j_) > 0 && (j_) <= NCH) hg4_stage2(c, (j_) - 1, w, S, o, vt); \
        __syncthreads();                                                                        \
    } while (0)
#pragma unroll 1
    for (int j = 0; j <= NCH; j += 2) { H4_TRIP(j, lv1, lv0); H4_TRIP(j + 1, lv0, lv1); }
#undef H4_TRIP
    asm volatile("s_waitcnt vmcnt(0)" ::: "memory");
    __syncthreads();
}

#endif
#if defined(HGRN_V2)
#define HGRN_FN hgrn_unit
#elif defined(HGRN_V3)
#define HGRN_FN hgrn3_unit
#else
#define HGRN_FN hgrn4_unit
#endif
#define W1_ITEM(r_) do { const int r__ = (r_); const int e__ = r__ >> 10; p0_item<true>(w1 + (size_t)e__ * D * 2 * FF, D, 2 * FF, W1T + (size_t)e__ * 2 * FF * D, RmW1(), scr, r__ & 1023, lane); } while (0)

struct Args { const float* in[18]; float* out; unsigned char* ws; int ph_lo, ph_hi; };
__global__ void __launch_bounds__(NTHR, 2) fwd_kernel(Args args) {
    extern __shared__ __attribute__((aligned(16))) unsigned char lds_raw[];
    LAS unsigned char* lds = (LAS unsigned char*)lds_raw;
    volatile LAS unsigned* MISC = (volatile LAS unsigned*)(lds + MISC_OFF);
    const int tid = threadIdx.x, lane = tid & 63, wave = __builtin_amdgcn_readfirstlane(tid >> 6);
    const int G = gridDim.x; const int bx = blockIdx.x; const int vcu = (G % 8 == 0) ? (bx % 8) * (G / 8) + bx / 8 : bx;
    const int gw = vcu * NWAVES + wave, NGW = G * NWAVES;
    unsigned char* ws = args.ws;
    unsigned* ctl = (unsigned*)(ws + WS_CTL);
    const float* x = args.in[0]; const float* norm1_w = args.in[1]; const float* w_in = args.in[2]; const float* lb_logits = args.in[3];
    const float* hgrn_norm_w = args.in[4]; const float* dw_w = args.in[5]; const float* dw_b = args.in[6]; const float* conv_ln_w = args.in[7]; const float* conv_ln_b = args.in[8];
    const float* w_out = args.in[9]; const float* norm2_w = args.in[10]; const float* router_w = args.in[11]; const float* router_b = args.in[12];
    const float* w1 = args.in[13]; const float* b1 = args.in[14]; const float* w2 = args.in[15]; const float* b2 = args.in[16]; const float* final_norm_w = args.in[17];
    float* out = args.out;
    bf16* WI = (bf16*)(ws + WS_WI); bf16* WO = (bf16*)(ws + WS_WO); unsigned char* W1T = ws + WS_W1; unsigned char* W2T = ws + WS_W2;
    float* H = (float*)(ws + WS_H); bf16* XN = (bf16*)(ws + WS_XN);
    bf16* Qb = (bf16*)(ws + WS_Q); bf16* KFb = (bf16*)(ws + WS_KF); bf16* KBb = (bf16*)(ws + WS_KB); bf16* Vb = (bf16*)(ws + WS_V); bf16* Gb = (bf16*)(ws + WS_G); bf16* Ub = (bf16*)(ws + WS_U);
    float* LFb = (float*)(ws + WS_LF); float* LBb = (float*)(ws + WS_LB); float* OFb = (float*)(ws + WS_OF); float* OBb = (float*)(ws + WS_OB);
    bf16* MIX = (bf16*)(ws + WS_MIX); unsigned char* XS = ws + WS_XS; unsigned char* ACT = ws + WS_ACT; unsigned char* N2 = ws + WS_XN; unsigned char* YS = ws + WS_YS;
    float* WRT = (float*)(ws + WS_WRT); int* SLOT = (int*)(ws + WS_SLOT); float* GATE = (float*)(ws + WS_GATE); int* ROWTOK = (int*)(ws + WS_ROWTOK);
    volatile LAS int* bs = (volatile LAS int*)(lds + TAB_OFF);
    volatile LAS int* cl = (volatile LAS int*)(lds + TAB_OFF + 256);
    LAS int* lcnt = (LAS int*)(lds + TAB_OFF + 512);
    volatile LAS int* gbase = (volatile LAS int*)(lds + TAB_OFF + 768);

    for (int u = tid; u < (LDS_BYTES - LDSCTL_OFF) / 4; u += NTHR) ((LAS unsigned*)(lds + LDSCTL_OFF))[u] = 0u;
    __syncthreads();
    XcdBarrier bar; bar.bar = ctl + CW_BAR; bar.x = 0; bar.st = nullptr;
    if (MK_N_LAUNCHES == 1) bar = xcd_barrier_post(ctl + CW_BAR, MISC + 8);
#ifndef PROBE_STAMP
#define PROBE_STAMP -1
#endif
    unsigned long long tS[N_PHASES + 1];
#define STAMP(k) do { if ((PROBE_STAMP) >= 0) tS[k] = __builtin_amdgcn_s_memrealtime(); } while (0)
    const int lo = args.ph_lo, hi = args.ph_hi;
#ifndef PHASE_MASK
#define PHASE_MASK 0xffffffffu
#endif
#define IN(k) ((((PHASE_MASK) >> (k)) & 1u) && lo <= (k) && (k) < hi)
#ifndef PROBE_DUP
#define PROBE_DUP -1
#endif
#define REP(k) _Pragma("unroll 1") for (int rep_ = 0; rep_ < ((PROBE_DUP) == (k) ? 2 + (args.ph_hi >> 20) : 1); ++rep_)
#define SEAM(k) do { if (IN(k) && IN((k) + 1)) { xcd_barrier(bar); if ((PROBE_DUP) == 99) { xcd_barrier(bar); xcd_barrier(bar); } } } while (0)
#define BUILD_BS() do { int t_; asm volatile("v_mov_b32 %0, %1" : "=v"(t_) : "v"(tid));     \
        if (t_ < 64) { const int c_ = t_ < NE ? (int)__hip_atomic_load(ctl + CW_CNT + 64 * (t_ & (NE - 1)), RLX_AGENT) : 0; int x_ = (c_ + 255) >> 8; \
        _Pragma("unroll") for (int o_ = 1; o_ < NE; o_ <<= 1) { const int y_ = __shfl_up(x_, o_); if ((t_ & 63) >= o_) x_ += y_; }     \
        if (t_ < NE) { cl[t_] = c_; bs[t_ + 1] = x_; } if (t_ == 0) bs[0] = 0; } __syncthreads(); } while (0)

    STAMP(0);
    if (IN(0)) REP(0) {
        LAS float* scr = (LAS float*)(lds + RING_OFF + wave * 16384);
        constexpr int I_WI = (D / 64) * (INC / 32), I_WO = (D / 64) * (D / 32), I_W1 = (D / 64) * (2 * FF / 32), I_W2 = (FF / 64) * (D / 32);
        #if defined(HGRN_NAIVE) || defined(W2_IN_P0)
        constexpr int NITEMS = I_WI + I_WO + NE * I_W1 + NE * I_W2;
#else
        constexpr int NITEMS = I_WI + I_WO + W1_P0;
#endif
        {
            const f32x4* wr = (const f32x4*)norm1_w + lane; f32x4 gw4[4];
#pragma unroll
            for (int j = 0; j < 4; ++j) gw4[j] = wr[64 * j];
#pragma unroll 1
            for (int m0 = gw; m0 < MTOK; m0 += 4 * NGW) {
                f32x4 v[4][4];
#pragma unroll
                for (int q4 = 0; q4 < 4; ++q4) { const int m = min(m0 + q4 * NGW, MTOK - 1); const f32x4* xr = (const f32x4*)(x + (size_t)m * D) + lane;
#pragma unroll
                    for (int j = 0; j < 4; ++j) v[q4][j] = xr[64 * j]; }
#pragma unroll
                for (int q4 = 0; q4 < 4; ++q4) { const int m = m0 + q4 * NGW; float sq = 0.f;
#pragma unroll
                    for (int j = 0; j < 4; ++j) sq += (v[q4][j].x * v[q4][j].x + v[q4][j].y * v[q4][j].y) + (v[q4][j].z * v[q4][j].z + v[q4][j].w * v[q4][j].w);
                    const float rstd = rsqrtf(wave_sum(sq) * (1.f / D) + EPS);
                    if (m < MTOK) { v2u* o8 = (v2u*)(XN + (size_t)m * D) + lane;
#pragma unroll
                        for (int j = 0; j < 4; ++j) { v2u o; o.x = pk2(v[q4][j].x * rstd * gw4[j].x, v[q4][j].y * rstd * gw4[j].y); o.y = pk2(v[q4][j].z * rstd * gw4[j].z, v[q4][j].w * rstd * gw4[j].w); o8[64 * j] = o; } }
                }
            }
        }
#if defined(HGRN_NAIVE) || defined(W2_IN_P0)
        for (int it = gw; it < NITEMS; it += NGW) {
            int r = it;
            if (r < I_WI) { p0_item<false>(w_in, D, INC, WI, RmWin(), scr, r, lane); continue; } r -= I_WI;
            if (r < I_WO) { p0_item<false>(w_out, D, D, WO, RmIdent(), scr, r, lane); continue; } r -= I_WO;
            if (r < NE * I_W1) { W1_ITEM(r); continue; } r -= NE * I_W1;
            { const int e = r / I_W2; p0_item<true>(w2 + (size_t)e * FF * D, FF, D, W2T + (size_t)e * D * FF, RmIdent(), scr, r - e * I_W2, lane); }
        }
#else
        (void)NITEMS; (void)I_W2;
        for (int it = gw; it < I_WI + I_WO; it += NGW) { if (it < I_WI) p0_item<false>(w_in, D, INC, WI, RmWin(), scr, it, lane); else p0_item<false>(w_out, D, D, WO, RmIdent(), scr, it - I_WI, lane); }
        convert_range_fp8(w1, D, 2 * FF, W1T, RmW1(), 10, gw, NGW, W1_P0, 0, scr, lane);
#endif
        if ((PROBE_STAMP) == 640) tS[6] = __builtin_amdgcn_s_memrealtime();
        for (int i = bx * NTHR + tid; i < 16 * D; i += G * NTHR) {
            const int r = i >> 4, e16 = i & 15, k = 256 * (r & 3) + (r >> 2); const float gk = norm2_w[k];
            WRT[2 * i] = gk * router_w[k * NE + e16]; WRT[2 * i + 1] = gk * router_w[k * NE + 16 + e16]; }
    }
    if ((PROBE_STAMP) == 600 + 0) tS[6] = __builtin_amdgcn_s_memrealtime();
    SEAM(0);

    STAMP(1);
    if (IN(1)) REP(1) {
        pg8::Gemm g{XN, WI, MTOK, INC, D}; OrderRep S; S.init(MTOK, INC, G, bx); S.reps = ((PROBE_DUP) == 11) ? 2 : 1;
        EpiProj E{Qb, KFb, KBb, Vb, Gb, Ub, LFb, LBb, lb_logits};
        pg8::gemm_phase<EpiProj, OrderRep, true, true>(lds + RING_OFF, g, S, E);
#if !defined(HGRN_NAIVE) && !defined(W2_IN_P0)
        {
            LAS float* scr = (LAS float*)(lds + RING_OFF + wave * 16384);
            if (G == 256) { if (bx >= 128) convert_range_fp8(w1, D, 2 * FF, W1T, RmW1(), 10, (bx - 128) * NWAVES + wave, 128 * NWAVES, W1_P1, W1_P0, scr, lane); }
            else convert_range_fp8(w1, D, 2 * FF, W1T, RmW1(), 10, gw, NGW, W1_P1, W1_P0, scr, lane);
        }
#endif
    }
    if ((PROBE_STAMP) == 600 + 1) tS[6] = __builtin_amdgcn_s_memrealtime();
    SEAM(1);

    STAMP(2);
    if (IN(2)) REP(2) {
        const bool split = (G == 256);
#if defined(HGRN_NAIVE)
        const bool hsel = true; const int hidx = 0, hstride = 1; const bool csel = true; const int cidx = vcu, cstride = G;
#else
        const bool hsel = split ? (((bx >> 3) & 1) != 0) : true; const int hidx = split ? (bx >> 4) * 8 + (bx & 7) : bx, hstride = split ? 128 : G;
        const bool csel = split ? !hsel : true; const int cidx = split ? (bx >> 4) * 8 + (bx & 7) : bx, cstride = split ? 128 : G;
#endif
        (void)hidx; (void)hstride;
        if (csel && PROBE_DELAY == 3) probe_delay(3000); if (csel && PROBE_DELAY == 4) probe_delay(20000);
        if (csel) for (int crep_ = 0; crep_ < ((PROBE_DUP) == 21 ? 2 : 1); ++crep_) {
            LAS unsigned short* ut = (LAS unsigned short*)(lds + RING_OFF);
            LAS float* part = (LAS float*)(lds + RING_OFF + 98304);
            LAS float* stat = (LAS float*)(lds + RING_OFF + 98304 + 4096);
            for (int unit = cidx; unit < NBATCH * (TT / 64); unit += cstride) {
                const int b = unit / (TT / 64), t0 = (unit % (TT / 64)) * 64;
                {
                    v4u val[12];
#pragma unroll
                    for (int i = 0; i < 12; ++i) { const int idx = tid + NTHR * i, r = idx >> 6, p = idx & 63, t = t0 - 15 + r;
                        val[i] = (v4u){0u, 0u, 0u, 0u};
                        if (idx < 94 * 64 && t >= 0 && t < TT) val[i] = *(const v4u*)(Ub + (size_t)(b * TT + t) * CCH + p * 8); }
#pragma unroll
                    for (int i = 0; i < 12; ++i) { const int idx = tid + NTHR * i, r = idx >> 6, p = idx & 63;
                        if (idx < 94 * 64) *(LAS v4u*)(ut + r * 512 + p * 8) = val[i]; }
                }
                __syncthreads(); if ((PROBE_STAMP) == 651 && unit == cidx) tS[6] = __builtin_amdgcn_s_memrealtime();
                const int c = tid;
                float w[CLEN];
#pragma unroll
                for (int j = 0; j < CLEN; ++j) w[j] = dw_w[j * CCH + c];
                const float bias = dw_b[c];
                float y[64];
#pragma unroll
                for (int tb = 0; tb < 8; ++tb) {
                    float win[38];
#pragma unroll
                    for (int i = 0; i < 38; ++i) win[i] = bf2f(ut[(tb * 8 + i) * 512 + c]);
#pragma unroll
                    for (int o = 0; o < 8; ++o) { float a = bias;
#pragma unroll
                        for (int j = 0; j < CLEN; ++j) a += w[j] * win[o + j];
                        y[tb * 8 + o] = a; }
                }
#pragma unroll 1
                for (int pass = 0; pass < 2; ++pass) {
                    float s1[64];
#pragma unroll
                    for (int i = 0; i < 64; ++i) s1[i] = pass ? y[i] * y[i] : y[i];
#pragma unroll
                    for (int s = 32; s >= 1; s >>= 1) {
                        const bool up = (lane & s) != 0;
#pragma unroll
                        for (int i = 0; i < s; ++i) { const float k1 = up ? s1[i + s] : s1[i], x1 = up ? s1[i] : s1[i + s]; s1[i] = k1 + __shfl_xor(x1, s); }
                    }
                    part[(wave * 64 + lane) * 2 + pass] = s1[0];
                }
                __syncthreads(); if ((PROBE_STAMP) == 652 && unit == cidx) tS[6] = __builtin_amdgcn_s_memrealtime();
                if (tid < 64) { float a = 0.f, q = 0.f;
#pragma unroll
                    for (int wv = 0; wv < 8; ++wv) { a += part[(wv * 64 + tid) * 2]; q += part[(wv * 64 + tid) * 2 + 1]; }
                    const float mean = a * (1.f / CCH), var = q * (1.f / CCH) - mean * mean;
                    stat[tid * 2] = mean; stat[tid * 2 + 1] = rsqrtf(fmaxf(var, 0.f) + EPS); }
                __syncthreads();
                const float lw = conv_ln_w[c], lbias = conv_ln_b[c];
#pragma unroll
                for (int t = 0; t < 64; ++t) {
                    const float v = (y[t] - stat[t * 2]) * stat[t * 2 + 1] * lw + lbias;
                    MIX[(size_t)(b * TT + t0 + t) * D + 512 + c] = (bf16)(pk2(v * sigm(v), 0.f) & 0xffffu);
                }
                __syncthreads(); if ((PROBE_STAMP) == 653 && unit == cidx) tS[6] = __builtin_amdgcn_s_memrealtime();
            }
            if ((PROBE_STAMP) == 650) tS[6] = __builtin_amdgcn_s_memrealtime();
#if !defined(HGRN_NAIVE) && !defined(W2_IN_P0)
            {
                LAS float* scr = (LAS float*)(lds + RING_OFF + wave * 16384);
                constexpr int I_W2 = (FF / 64) * (D / 32);
                convert_range_fp8(w2, FF, D, W2T, RmIdent(), 9, cidx * NWAVES + wave, cstride * NWAVES, W2_P2, 0, scr, lane);
                convert_range_fp8(w1, D, 2 * FF, W1T, RmW1(), 10, cidx * NWAVES + wave, cstride * NWAVES, W1_P2, W1_P0 + W1_P1, scr, lane);
            }
#endif
        }
#if defined(HGRN_NAIVE)
        {
            LAS float* qs = (LAS float*)(lds + RING_OFF); LAS float* ks = qs + 2048; LAS float* fs = ks + 2048; LAS float* vs = fs + 2048; LAS float* op = vs + 2048;
            const int e = tid & 127, dq = tid >> 7;
            for (int unit = G - 1 - bx; unit < NBATCH * NH * 2; unit += G) {
                const int dir = unit & 1, h = (unit >> 1) & 3, b = unit >> 3;
                const bf16* Kp = dir ? KBb : KFb; const float* Lp = dir ? LBb : LFb; float* Op = dir ? OBb : OFb;
                float S[32];
#pragma unroll
                for (int i = 0; i < 32; ++i) S[i] = 0.f;
                for (int blk = 0; blk < TT / 16; ++blk) {
                    const int tb = dir ? (TT - 16 - blk * 16) : blk * 16;
#pragma unroll
                    for (int i = 0; i < 4; ++i) { const int idx = tid + NTHR * i, r = idx >> 7, d = idx & 127; const size_t off = (size_t)(b * TT + tb + r) * 512 + h * 128 + d;
                        qs[idx] = bf2f(Qb[off]); ks[idx] = bf2f(Kp[off]); fs[idx] = __expf(Lp[off]); vs[idx] = bf2f(Vb[off]); }
                    __syncthreads();
                    for (int st = 0; st < 16; ++st) {
                        const int r = dir ? 15 - st : st; const float v = vs[r * 128 + e]; float o = 0.f;
#pragma unroll
                        for (int dd = 0; dd < 32; ++dd) { const int d = dq * 32 + dd; S[dd] = fs[r * 128 + d] * S[dd] + ks[r * 128 + d] * v; o += qs[r * 128 + d] * S[dd]; }
                        op[(r * 4 + dq) * 128 + e] = o;
                    }
                    __syncthreads();
#pragma unroll
                    for (int i = 0; i < 4; ++i) { const int idx = tid + NTHR * i, r = idx >> 7, ee = idx & 127;
                        Op[(size_t)(b * TT + tb + r) * 512 + h * 128 + ee] = (op[(r * 4 + 0) * 128 + ee] + op[(r * 4 + 1) * 128 + ee]) + (op[(r * 4 + 2) * 128 + ee] + op[(r * 4 + 3) * 128 + ee]); }
                }
                __syncthreads();
            }
        }
#else
        if (hsel) for (int unit = hidx; unit < NBATCH * NH * 4 * ((PROBE_DUP) == 20 ? 2 : 1); unit += hstride) HGRN_FN(lds + RING_OFF, unit & (NBATCH * NH * 4 - 1), Qb, KFb, KBb, Vb, LFb, LBb, OFb, OBb, tid, lane, wave);
#endif
    }
    if ((PROBE_STAMP) == 600 + 2) tS[6] = __builtin_amdgcn_s_memrealtime();
    SEAM(2);

    STAMP(3);
    if (IN(3)) REP(3) {
        for (int m = gw; m < MTOK; m += NGW) {
            const size_t off = (size_t)m * 512 + lane * 8;
#if defined(HGRN_V2)
            const v4u ua = *(const v4u*)((const bf16*)OFb + off), uc = *(const v4u*)((const bf16*)OBb + off);
            const f32x4 a0 = (f32x4){bf2f(ua.x & 0xffffu), bf2f(ua.x >> 16), bf2f(ua.y & 0xffffu), bf2f(ua.y >> 16)}, a1 = (f32x4){bf2f(ua.z & 0xffffu), bf2f(ua.z >> 16), bf2f(ua.w & 0xffffu), bf2f(ua.w >> 16)};
            const f32x4 c0 = (f32x4){bf2f(uc.x & 0xffffu), bf2f(uc.x >> 16), bf2f(uc.y & 0xffffu), bf2f(uc.y >> 16)}, c1 = (f32x4){bf2f(uc.z & 0xffffu), bf2f(uc.z >> 16), bf2f(uc.w & 0xffffu), bf2f(uc.w >> 16)};
#else
            const f32x4 a0 = *(const f32x4*)(OFb + off), a1 = *(const f32x4*)(OFb + off + 4), c0 = *(const f32x4*)(OBb + off), c1 = *(const f32x4*)(OBb + off + 4);
#endif
            const f32x4 o0 = a0 + c0, o1 = a1 + c1;
            float ss = (o0.x * o0.x + o0.y * o0.y) + (o0.z * o0.z + o0.w * o0.w) + (o1.x * o1.x + o1.y * o1.y) + (o1.z * o1.z + o1.w * o1.w);
            ss += __shfl_xor(ss, 1); ss += __shfl_xor(ss, 2); ss += __shfl_xor(ss, 4); ss += __shfl_xor(ss, 8);
            const float rstd = rsqrtf(ss * (1.f / DV) + EPS);
            const v4u gv = *(const v4u*)(Gb + off);
            const f32x4 w0 = *(const f32x4*)(hgrn_norm_w + lane * 8), w1v = *(const f32x4*)(hgrn_norm_w + lane * 8 + 4);
            f32x4 r0, r1;
            r0.x = o0.x * rstd * w0.x * bf2f(gv.x & 0xffffu); r0.y = o0.y * rstd * w0.y * bf2f(gv.x >> 16);
            r0.z = o0.z * rstd * w0.z * bf2f(gv.y & 0xffffu); r0.w = o0.w * rstd * w0.w * bf2f(gv.y >> 16);
            r1.x = o1.x * rstd * w1v.x * bf2f(gv.z & 0xffffu); r1.y = o1.y * rstd * w1v.y * bf2f(gv.z >> 16);
            r1.z = o1.z * rstd * w1v.z * bf2f(gv.w & 0xffffu); r1.w = o1.w * rstd * w1v.w * bf2f(gv.w >> 16);
            st8bf(MIX + (size_t)m * D + lane * 8, r0, r1);
        }
    }
    if ((PROBE_STAMP) == 600 + 3) tS[6] = __builtin_amdgcn_s_memrealtime();
    SEAM(3);

    STAMP(4);
    if (IN(4)) REP(4) {
        pg8::Gemm g{MIX, WO, MTOK, D, D}; pg8::StaticOrder S; S.init(MTOK, D, G, bx);
        EpiRes E{x, H};
        pg8::gemm_phase<EpiRes, pg8::StaticOrder, true, true>(lds + RING_OFF, g, S, E);
    }
    if ((PROBE_STAMP) == 600 + 4) tS[6] = __builtin_amdgcn_s_memrealtime();
    SEAM(4);

    STAMP(5);
    if (IN(5)) REP(5) {
        typedef float f32x2 __attribute__((ext_vector_type(2)));
        LAS float* wl = (LAS float*)(lds + RING_OFF);
        LAS unsigned* sb = (LAS unsigned*)(lds + SB_OFF);
        { f32x4 tv_[NE * D / 4 / NTHR];
#pragma unroll
            for (int i = 0; i < NE * D / 4 / NTHR; ++i) tv_[i] = ((const f32x4*)WRT)[tid + NTHR * i];
#pragma unroll
            for (int i = 0; i < NE * D / 4 / NTHR; ++i) ((LAS f32x4*)wl)[tid + NTHR * i] = tv_[i]; }
        if (tid < NE) lcnt[tid] = 0;
        __syncthreads();
        for (int tg = vcu; tg < MTOK / 64; tg += G) {
            const int tok0 = tg * 64 + 16 * (wave & 3);
            if (wave < 4) {
                const int j = lane & 15, q = lane >> 4;
                const f32x4* hrow = (const f32x4*)(H + (size_t)(tok0 + j) * D + 256 * q);
                const LAS f32x2* tab = (const LAS f32x2*)wl + q * 16 + j;
                f32x4 acc0 = (f32x4){0.f, 0.f, 0.f, 0.f}, acc1 = acc0; float ss = 0.f;
                f32x4 hb[8], hn[8];
#pragma unroll
                for (int i = 0; i < 8; ++i) hb[i] = hrow[i];
#pragma unroll 1
                for (int blk = 0; blk < 8; ++blk) {
                    if (blk + 1 < 8) {
#pragma unroll
                        for (int i = 0; i < 8; ++i) hn[i] = hrow[(blk + 1) * 8 + i];
                    }
#pragma unroll
                    for (int i = 0; i < 8; ++i) {
                        const f32x4 hc = hb[i]; const int s4 = blk * 8 + i;
                        f32x2 w[4];
#pragma unroll
                        for (int u = 0; u < 4; ++u) w[u] = tab[(4 * s4 + u) * 64];
                        ss += (hc.x * hc.x + hc.y * hc.y) + (hc.z * hc.z + hc.w * hc.w);
#pragma unroll
                        for (int u = 0; u < 4; ++u) { acc0 = __builtin_amdgcn_mfma_f32_16x16x4f32(w[u].x, hc[u], acc0, 0, 0, 0); acc1 = __builtin_amdgcn_mfma_f32_16x16x4f32(w[u].y, hc[u], acc1, 0, 0, 0); }
                    }
#pragma unroll
                    for (int i = 0; i < 8; ++i) hb[i] = hn[i];
                }
                ss += __shfl_xor(ss, 16); ss += __shfl_xor(ss, 32);
                const float rstd = rsqrtf(ss * (1.f / D) + EPS);
                float lg[8];
#pragma unroll
                for (int r = 0; r < 4; ++r) { lg[r] = acc0[r] * rstd + router_b[4 * q + r]; lg[4 + r] = acc1[r] * rstd + router_b[16 + 4 * q + r]; }
                float tv[TOPK]; int ti[TOPK];
#pragma unroll
                for (int k = 0; k < TOPK; ++k) {
                    float bv = lg[0]; int bi = 4 * q;
#pragma unroll
                    for (int r = 1; r < 8; ++r) { const int id = (r < 4) ? 4 * q + r : 16 + 4 * q + (r - 4); if (lg[r] > bv) { bv = lg[r]; bi = id; } }
#pragma unroll
                    for (int o = 16; o < 64; o <<= 1) { const float ov = __shfl_xor(bv, o); const int oi = __shfl_xor(bi, o); if (ov > bv || (ov == bv && oi < bi)) { bv = ov; bi = oi; } }
                    tv[k] = bv; ti[k] = bi;
#pragma unroll
                    for (int r = 0; r < 8; ++r) { const int id = (r < 4) ? 4 * q + r : 16 + 4 * q + (r - 4); if (id == bi) lg[r] = -INFINITY; }
                }
                const float e1 = __expf(tv[1] - tv[0]), e2 = __expf(tv[2] - tv[0]), e3 = __expf(tv[3] - tv[0]);
                const float inv = 1.0f / (1.0f + e1 + e2 + e3);
                {
                    const int ek = q == 0 ? ti[0] : q == 1 ? ti[1] : q == 2 ? ti[2] : ti[3];
                    const float gk = (q == 0 ? 1.0f : q == 1 ? e1 : q == 2 ? e2 : e3) * inv;
                    const int lr = __hip_atomic_fetch_add(&lcnt[ek], 1, __ATOMIC_RELAXED, __HIP_MEMORY_SCOPE_WORKGROUP);
                    sb[(16 * wave + j) * 4 + q] = ((unsigned)ek << 16) | (unsigned)lr;
                    GATE[(size_t)(tok0 + j) * TOPK + q] = gk;
                }
            } else {
                const f32x4* wr = (const f32x4*)norm2_w + lane;
                f32x4 gw4[4];
#pragma unroll
                for (int jj = 0; jj < 4; ++jj) gw4[jj] = wr[64 * jj];
#pragma unroll 1
                for (int i = 0; i < 16; i += 4) {
                    f32x4 v[4][4];
#pragma unroll
                    for (int q4 = 0; q4 < 4; ++q4) { const f32x4* hr = (const f32x4*)(H + (size_t)(tok0 + i + q4) * D) + lane;
#pragma unroll
                        for (int jj = 0; jj < 4; ++jj) v[q4][jj] = hr[64 * jj]; }
#pragma unroll
                    for (int q4 = 0; q4 < 4; ++q4) {
                        float s2 = 0.f;
#pragma unroll
                        for (int jj = 0; jj < 4; ++jj) s2 += (v[q4][jj].x * v[q4][jj].x + v[q4][jj].y * v[q4][jj].y) + (v[q4][jj].z * v[q4][jj].z + v[q4][jj].w * v[q4][jj].w);
                        const float rstd = rsqrtf(wave_sum(s2) * (1.f / D) + EPS) * SC_N2;
                        unsigned* o4 = (unsigned*)(N2 + (size_t)(tok0 + i + q4) * D) + lane;
#pragma unroll
                        for (int jj = 0; jj < 4; ++jj) o4[64 * jj] = pk4_fp8(v[q4][jj].x * rstd * gw4[jj].x, v[q4][jj].y * rstd * gw4[jj].y, v[q4][jj].z * rstd * gw4[jj].z, v[q4][jj].w * rstd * gw4[jj].w);
                    }
                }
            }
            __syncthreads();
            if (tid < NE) { const int c = lcnt[tid]; gbase[tid] = c ? (int)__hip_atomic_fetch_add(ctl + CW_CNT + ((PROBE_DUP) == 5 && rep_ == 0 ? 4096 : 0) + 64 * tid, (unsigned)c, RLX_AGENT) : 0; }
            __syncthreads();
            if (tid < 256) { const unsigned w = sb[tid]; const int ek = (int)(w >> 16), r = gbase[ek] + (int)(w & 0xffffu), m = tg * 64 + (tid >> 2);
                ROWTOK[ek * MTOK + r] = m; SLOT[(size_t)m * TOPK + (tid & 3)] = ek * MTOK + r; }
            if (tid < NE) lcnt[tid] = 0;
            __syncthreads();
        }
    }
    if ((PROBE_STAMP) == 600 + 5) tS[6] = __builtin_amdgcn_s_memrealtime();
    SEAM(5);


    if ((PROBE_STAMP) < 600 || (PROBE_STAMP) > 699) STAMP(6);
    STAMP(7);
#if defined(MOE_MERGED)
    if (IN(7)) REP(7) {
        BUILD_BS();
        pg8::Gemm g{(const bf16*)ws, (const bf16*)W1T, MTOK, 2 * FF, D / 2}; MoeOrder2 S{bs, G, vcu, cl, ROWTOK, ctl};
        EpiMoe E{EpiSwiglu{ACT, b1}, EpiDown{YS, b2}};
        pg8::gemm_phase<EpiMoe, MoeOrder2, true, true, true, true>(lds + RING_OFF, g, S, E);
    }
    if ((PROBE_STAMP) == 600 + 8) tS[6] = __builtin_amdgcn_s_memrealtime();
    SEAM(8);
#else
    if (IN(7)) REP(7) {
        BUILD_BS();
        pg8::Gemm g{(const bf16*)N2, (const bf16*)W1T, MTOK, 2 * FF, D / 2}; MoeOrder S{bs, 8, G, vcu, cl, ROWTOK};
        EpiSwiglu E{ACT, b1};
        pg8::gemm_phase<EpiSwiglu, MoeOrder, true, true, true, true>(lds + RING_OFF, g, S, E);
#if !defined(HGRN_NAIVE) && !defined(W2_IN_P0)
        {
            LAS float* scr = (LAS float*)(lds + RING_OFF + wave * 16384);
            const int r7 = (bs[NE] * 8) % G, nsl = G - r7;
            if (vcu >= r7) convert_range_fp8(w2, FF, D, W2T, RmIdent(), 9, (vcu - r7) * NWAVES + wave, nsl * NWAVES, W2_P7, W2_P2, scr, lane);
        }
#endif
    }
    if ((PROBE_STAMP) == 600 + 7) tS[6] = __builtin_amdgcn_s_memrealtime();
    SEAM(7);

    STAMP(8);
    if (IN(8)) REP(8) {
        BUILD_BS();
        pg8::Gemm g{(const bf16*)ACT, (const bf16*)W2T, MOE_ROWS, D, FF / 2}; MoeOrder S{bs, 4, G, vcu, cl, ROWTOK};
        EpiDown E{YS, b2};
        pg8::gemm_phase<EpiDown, MoeOrder, true, true, true>(lds + RING_OFF, g, S, E);
    }
    SEAM(8);
#endif

    STAMP(9);
    if (IN(9)) REP(9) {
        BUILD_BS();
        for (int base = gw; base < MTOK; base += 16 * NGW) {
            const int mi = base + NGW * (lane >> 2); int posl = 0; float gl = 0.f;
            if (mi < MTOK) { const int sl = SLOT[(size_t)mi * TOPK + (lane & 3)]; gl = GATE[(size_t)mi * TOPK + (lane & 3)]; posl = bs[sl >> 14] * 256 + (sl & (MTOK - 1)); }
#pragma unroll 2
            for (int i = 0; i < 16; ++i) {
                const int m = base + NGW * i; if (m >= MTOK) break;
                const f32x4* hr = (const f32x4*)(H + (size_t)m * D) + lane; const f32x4* wr = (const f32x4*)final_norm_w + lane;
                int pos[TOPK]; float gk[TOPK];
#pragma unroll
                for (int k = 0; k < TOPK; ++k) { pos[k] = __shfl(posl, 4 * i + k); gk[k] = __shfl(gl, 4 * i + k); }
                f32x4 v[4]; unsigned yw[TOPK][4];
#pragma unroll
                for (int j = 0; j < 4; ++j) v[j] = hr[64 * j];
#pragma unroll
                for (int k = 0; k < TOPK; ++k) { const unsigned* yr = (const unsigned*)(YS + (size_t)pos[k] * D) + lane;
#pragma unroll
                    for (int j = 0; j < 4; ++j) yw[k][j] = yr[64 * j]; }
#pragma unroll
                for (int k = 0; k < TOPK; ++k)
#pragma unroll
                    for (int j = 0; j < 4; ++j) { const f32x2_t lo = __builtin_amdgcn_cvt_pk_f32_fp8((int)yw[k][j], false), hi = __builtin_amdgcn_cvt_pk_f32_fp8((int)yw[k][j], true); const float g = gk[k] * (1.0f / SC_YS);
                        v[j].x += g * lo.x; v[j].y += g * lo.y; v[j].z += g * hi.x; v[j].w += g * hi.y; }
                float s = 0.f;
#pragma unroll
                for (int j = 0; j < 4; ++j) s += (v[j].x * v[j].x + v[j].y * v[j].y) + (v[j].z * v[j].z + v[j].w * v[j].w);
                const float rstd = rsqrtf(wave_sum(s) * (1.f / D) + EPS);
                f32x4* orow = (f32x4*)(out + (size_t)m * D) + lane;
#pragma unroll
                for (int j = 0; j < 4; ++j) orow[64 * j] = v[j] * rstd * wr[64 * j];
            }
        }
    }
    STAMP(N_PHASES);
#ifndef PROBE_WG
#define PROBE_WG 0
#endif
    if ((PROBE_STAMP) >= 660 && (PROBE_STAMP) <= 669 && bx == (PROBE_WG)) {
        const unsigned long long a_ = *(volatile LAS unsigned long long*)(lds + LDSCTL_OFF + 640), b_ = *(volatile LAS unsigned long long*)(lds + LDSCTL_OFF + 648);
        const unsigned long long d = 64ull * (b_ - a_), t0 = __builtin_amdgcn_s_memrealtime();
        while (__builtin_amdgcn_s_memrealtime() - t0 < d) __builtin_amdgcn_s_sleep(8);
    } else
    if ((PROBE_STAMP) >= 0 && bx == (PROBE_WG)) {
        const int k0 = (PROBE_STAMP) == 640 ? 0 : ((PROBE_STAMP) >= 650 && (PROBE_STAMP) <= 659) ? 2 : (PROBE_STAMP) % 100, k1 = ((PROBE_STAMP) >= 100) ? (PROBE_STAMP) / 100 : k0 + 1;
        const unsigned long long d = 2ull * (tS[k1 > N_PHASES ? N_PHASES : k1] - tS[k0]), t0 = __builtin_amdgcn_s_memrealtime();
        while (__builtin_amdgcn_s_memrealtime() - t0 < d) __builtin_amdgcn_s_sleep(8);
    }
#undef IN
#undef SEAM
#undef BUILD_BS
}

extern "C" void kernel_launch(void* const* d_in, const int* in_sizes, int n_in, void* d_out, int out_size, void* d_ws, size_t ws_size, hipStream_t stream) {
    static int grid = 0;
    if (grid == 0) {
        if (n_in != 18 || in_sizes[0] != MTOK * D || out_size != MTOK * D || ws_size < WS_END) { fprintf(stderr, "kernel_launch: unexpected shapes (n_in %d, in0 %d, out %d, ws %zu < %zu); nothing launched\n", n_in, n_in > 0 ? in_sizes[0] : -1, out_size, ws_size, (size_t)WS_END); grid = -1; return; }
        int dev = 0, cus = 0, per_cu = 0;
        if (hipGetDevice(&dev) != hipSuccess || hipDeviceGetAttribute(&cus, hipDeviceAttributeMultiprocessorCount, dev) != hipSuccess) { fprintf(stderr, "kernel_launch: device query failed\n"); grid = -1; return; }
        if (hipFuncSetAttribute((const void*)fwd_kernel, hipFuncAttributeMaxDynamicSharedMemorySize, LDS_BYTES) != hipSuccess) { fprintf(stderr, "kernel_launch: hipFuncSetAttribute failed\n"); grid = -1; return; }
        if (hipOccupancyMaxActiveBlocksPerMultiprocessor(&per_cu, (const void*)fwd_kernel, NTHR, LDS_BYTES) != hipSuccess || per_cu < 1)
            fprintf(stderr, "kernel_launch: note: occupancy query reports %d workgroups per CU\n", per_cu);
        (void)hipGetLastError();
        grid = cus;
    }
    if (grid < 0) return;
    if (hipMemsetAsync((char*)d_ws + WS_CTL, 0, CTL_ZERO_BYTES, stream) != hipSuccess) { fprintf(stderr, "kernel_launch: memset failed\n"); return; }
    Args a{};
    for (int i = 0; i < 18; ++i) a.in[i] = (const float*)d_in[i];
    a.out = (float*)d_out; a.ws = (unsigned char*)d_ws;
#if MK_N_LAUNCHES == 1
    a.ph_lo = 0; a.ph_hi = N_PHASES;
    hipLaunchKernelGGL(fwd_kernel, dim3(grid), dim3(NTHR), LDS_BYTES, stream, a);
#else
    for (int ph = 0; ph < N_PHASES; ++ph) { a.ph_lo = ph; a.ph_hi = ph + 1; hipLaunchKernelGGL(fwd_kernel, dim3(grid), dim3(NTHR), LDS_BYTES, stream, a); }
#endif
    const hipError_t le = hipPeekAtLastError();
    if (le != hipSuccess) fprintf(stderr, "kernel_launch: launch failed: %s\n", hipGetErrorName(le));
}
```

```cpp
#define HGRN_V2 1
#include <hip/hip_runtime.h>
#include <cstdio>
#include <cstdint>
namespace pg8 {
#define PG8_LAS __attribute__((address_space(3)))
typedef unsigned short bf16_t;
typedef short bf16x8 __attribute__((ext_vector_type(8)));
typedef float f32x4 __attribute__((ext_vector_type(4)));
typedef unsigned u32x4 __attribute__((ext_vector_type(4)));
constexpr int BM = 256, BK = 64, HALF = 128, HTB = HALF * BK * 2  , STAGE_BYTES = 8 * HTB, NXCD = 8, WGM = 8;

__host__ __device__ __forceinline__ int lds_byte(int r, int c) { const int st = (r >> 4) * 2 + (c >> 5), rr = r & 15, cc = c & 31, ob = rr * 64 + cc * 2; return st * 1024 + (ob ^ (((ob >> 9) & 1) << 5)); }
__host__ __device__ __forceinline__ void stage_rc(int b, int& R, int& C) { const int st = b / 1024, sb = b % 1024, swz = sb ^ (((sb >> 9) & 1) << 5); R = (st >> 1) * 16 + swz / 64; C = (st & 1) * 32 + (swz % 64) / 2; }
__host__ __device__ __forceinline__ int perm32(int rho) { const int n = rho >> 4, i = rho & 15; return 8 * (i >> 2) + 4 * n + (i & 3); }

struct Unit { int pm, pn; };
struct Gemm { const bf16_t* A; const bf16_t* Bt; int M, N, K; };

struct StaticOrder {
    int nM, nN, nwg, G, c;
    __host__ __device__ void init(int M, int N, int G_, int c_) { nM = M / BM; nN = N / BM; nwg = nM * nN; G = G_; c = c_; }
    __host__ __device__ bool next(int i, Unit& u) const {
        const long L = (long)i * G + c; if (L >= nwg) return false;
        int wgid = (int)L; { const int q = nwg / NXCD, r = nwg % NXCD, xcd = wgid % NXCD, off = wgid / NXCD; wgid = (xcd < r ? xcd * (q + 1) : r * (q + 1) + (xcd - r) * q) + off; }
        const int nig = WGM * nN, gid = wgid / nig, fm = gid * WGM, gsz = (nM - fm) < WGM ? (nM - fm) : WGM;
        u.pm = fm + ((wgid % nig) % gsz); u.pn = (wgid % nig) / gsz; return true;
    }
    __device__ __forceinline__ void a_ready(const Unit&) const {}
    __device__ __forceinline__ void done(const Unit&) const {}
    __device__ __forceinline__ int done_defer(const Unit&) const { return -1; }
    __device__ __forceinline__ void done_signal(int) const {}
};
__device__ __forceinline__ unsigned cvt_pk_bf16(float lo, float hi) { unsigned r; asm volatile("v_cvt_pk_bf16_f32 %0, %1, %2" : "=v"(r) : "v"(lo), "v"(hi)); return r; }
typedef float f32x2 __attribute__((ext_vector_type(2)));
template <class Epi, class Sched, bool ALIGN_EPI = false, bool SP2 = false, bool FP8 = false, bool GATHER = false>
__device__ __forceinline__ void gemm_phase(PG8_LAS unsigned char* lds, const Gemm g, const Sched& S, const Epi& E) {
    typedef int v4i_t __attribute__((ext_vector_type(4)));
    const int tid = threadIdx.x, wid = __builtin_amdgcn_readfirstlane(tid >> 6), lane = tid & 63, wr = wid >> 2, wc = wid & 3, fr = lane & 15, fq = lane >> 4;
    const int K = g.K, nt = K / BK;
    unsigned voffA[2], voffB[2];
#pragma unroll
    for (int i = 0; i < 2; ++i) { int R, C; stage_rc(tid * 16 + i * 8192, R, C); const int Rb = Epi::PERM ? ((R & ~31) + perm32(R & 31)) : R;
        voffA[i] = (unsigned)(R * K + C) * 2u; voffB[i] = (unsigned)(Rb * K + C) * 2u; }
    int rowA[2]; unsigned colA[2];
#pragma unroll
    for (int i = 0; i < 2; ++i) { int R, C; stage_rc(tid * 16 + i * 8192, R, C); rowA[i] = R; colA[i] = (unsigned)C * 2u; }
    const size_t kstep = (size_t)(BK * 2);
    const size_t hstep = (size_t)HALF * K * 2;
    const size_t tstep = 2 * hstep;
    const unsigned ldsw = (unsigned)wid * 1024u;
    const int aoff = lds_byte(wr * 64 + fr, fq * 8), boff = lds_byte(wc * 32 + fr, fq * 8);
#define PG8_SA(b, h) (((b) * 2 + (h)) * HTB)
#define PG8_SB(b, h) ((4 + (b) * 2 + (h)) * HTB)
#define PG8_STAGE(bufoff, gbase, voff) do { _Pragma("unroll") for (int _i = 0; _i < 2; ++_i) \
        __builtin_amdgcn_global_load_lds((const unsigned*)((const char*)(gbase) + (voff)[_i]), (PG8_LAS unsigned*)(lds + (bufoff) + ldsw + _i * 8192), 16, 0, 0); } while (0)
#define PG8_STAGE2(bufoff, gbase, o0, o1) do { \
        __builtin_amdgcn_global_load_lds((const unsigned*)((const char*)(gbase) + (o0)), (PG8_LAS unsigned*)(lds + (bufoff) + ldsw), 16, 0, 0); \
        __builtin_amdgcn_global_load_lds((const unsigned*)((const char*)(gbase) + (o1)), (PG8_LAS unsigned*)(lds + (bufoff) + ldsw + 8192), 16, 0, 0); } while (0)
#define PG8_LDA(dst, b, h) do { _Pragma("unroll") for (int m = 0; m < 4; ++m) _Pragma("unroll") for (int k = 0; k < 2; ++k) dst[m][k] = *(const PG8_LAS bf16x8*)(lds + PG8_SA(b, h) + aoff + m * 2048 + k * 1024); } while (0)
#define PG8_LDB(dst, b, h) do { _Pragma("unroll") for (int n = 0; n < 2; ++n) _Pragma("unroll") for (int k = 0; k < 2; ++k) dst[n][k] = *(const PG8_LAS bf16x8*)(lds + PG8_SB(b, h) + boff + n * 2048 + k * 1024); } while (0)
#define PG8_MMA(ai, bj, At, Bt) do { __builtin_amdgcn_s_setprio(1); _Pragma("unroll") for (int m = 0; m < 4; ++m) _Pragma("unroll") for (int n = 0; n < 2; ++n) { \
        if constexpr (FP8) { asm volatile("v_mfma_f32_16x16x128_f8f6f4 %0, %1, %2, %0" : "+v"(acc[ai][bj][m][n]) : "v"(__builtin_shufflevector((v4i_t)Bt[n][0], (v4i_t)Bt[n][1], 0, 1, 2, 3, 4, 5, 6, 7)), "v"(__builtin_shufflevector((v4i_t)At[m][0], (v4i_t)At[m][1], 0, 1, 2, 3, 4, 5, 6, 7))); } \
        else { _Pragma("unroll") for (int k = 0; k < 2; ++k) acc[ai][bj][m][n] = __builtin_amdgcn_mfma_f32_16x16x32_bf16(Bt[n][k], At[m][k], acc[ai][bj][m][n], 0, 0, 0); } } __builtin_amdgcn_s_setprio(0); } while (0)
#define PG8_WAIT_V(n) asm volatile("s_waitcnt vmcnt(" #n ")" ::: "memory")
#define PG8_WAIT_L(n) asm volatile("s_waitcnt lgkmcnt(" #n ")" ::: "memory")
#define PG8_BAR __builtin_amdgcn_s_barrier()
#define PG8_SCHED __builtin_amdgcn_sched_barrier(0)
    Unit cur, nxt; int ui = 0; int pend = -1;
    if (!S.next(0, cur)) return;
    f32x4 acc[2][2][4][2];
#pragma unroll
    for (int a = 0; a < 2; ++a)
#pragma unroll
        for (int b = 0; b < 2; ++b)
#pragma unroll
            for (int m = 0; m < 4; ++m)
#pragma unroll
                for (int n = 0; n < 2; ++n) acc[a][b][m][n] = (f32x4){0.f, 0.f, 0.f, 0.f};
    bf16x8 At[4][2], B0[2][2], B1[2][2];
    const char* cA = (const char*)g.A + (size_t)cur.pm * tstep; const char* cB = (const char*)g.Bt + (size_t)cur.pn * tstep;
    unsigned oA[2][2], nOA[2][2]; int tk[2][2] = {{0, 0}, {0, 0}};
    if constexpr (GATHER) {
        cA = (const char*)g.A;
        const int nv = S.a_valid(cur); const unsigned ab = S.a_base(cur);
        if (S.a_is_list(cur)) { const int* lst = S.a_list(cur);
#pragma unroll
            for (int h = 0; h < 2; ++h)
#pragma unroll
                for (int i = 0; i < 2; ++i) { const int r = min(h * HALF + rowA[i], nv - 1); oA[h][i] = ab + (unsigned)lst[r] * (unsigned)(K * 2) + colA[i]; }
        } else { const int r0 = S.a_row0(cur);
#pragma unroll
            for (int h = 0; h < 2; ++h)
#pragma unroll
                for (int i = 0; i < 2; ++i) { const int r = min(h * HALF + rowA[i], nv - 1); oA[h][i] = ab + (unsigned)(r0 + r) * (unsigned)(K * 2) + colA[i]; }
        }
    } else {
#pragma unroll
        for (int h = 0; h < 2; ++h)
#pragma unroll
            for (int i = 0; i < 2; ++i) oA[h][i] = voffA[i] + (unsigned)(h * hstep);
    }
#pragma unroll
    for (int h = 0; h < 2; ++h)
#pragma unroll
        for (int i = 0; i < 2; ++i) nOA[h][i] = oA[h][i];
#define PG8_OSEL(h, i) (GATHER ? (last ? nOA[h][i] : oA[h][i]) : oA[h][i])
    S.a_ready(cur);
    if constexpr (SP2) {
        PG8_STAGE(PG8_SB(0, 0), cB, voffB); PG8_STAGE(PG8_SB(0, 1), cB + hstep, voffB); PG8_STAGE2(PG8_SA(0, 0), cA, oA[0][0], oA[0][1]); PG8_STAGE2(PG8_SA(0, 1), cA, oA[1][0], oA[1][1]);
        if (wr == 1) PG8_BAR;
        PG8_WAIT_V(2); PG8_BAR;
        PG8_STAGE(PG8_SB(1, 0), cB + kstep, voffB); PG8_STAGE2(PG8_SA(1, 0), cA + kstep, oA[0][0], oA[0][1]); PG8_STAGE(PG8_SB(1, 1), cB + hstep + kstep, voffB);
        PG8_WAIT_V(6); PG8_BAR;
    } else {
        PG8_STAGE(PG8_SB(0, 0), cB, voffB); PG8_STAGE(PG8_SA(0, 0), cA, voffA); PG8_STAGE(PG8_SB(0, 1), cB + hstep, voffB); PG8_STAGE(PG8_SA(0, 1), cA + hstep, voffA);
        if (wr == 1) PG8_BAR;
        PG8_WAIT_V(4); PG8_BAR;
        PG8_STAGE(PG8_SB(1, 0), cB + kstep, voffB); PG8_STAGE(PG8_SA(1, 0), cA + kstep, voffA); PG8_STAGE(PG8_SB(1, 1), cB + hstep + kstep, voffB);
        PG8_WAIT_V(6); PG8_BAR;
    }
    for (;;) {
        const bool has_next = S.next(ui + 1, nxt);
        const char* nA = GATHER ? cA : (has_next ? (const char*)g.A + (size_t)nxt.pm * tstep : cA); const char* nB = has_next ? (const char*)g.Bt + (size_t)nxt.pn * tstep : cB;
        if constexpr (GATHER) { if (has_next) { const int nv = S.a_valid(nxt);
            if (S.a_is_list(nxt)) { const int* lst = S.a_list(nxt);
#pragma unroll
                for (int h = 0; h < 2; ++h)
#pragma unroll
                    for (int i = 0; i < 2; ++i) { const int* pp = lst + min(h * HALF + rowA[i], nv - 1); asm volatile("global_load_dword %0, %1, off" : "=v"(tk[h][i]) : "v"(pp) : "memory"); }
            } else { const int r0 = S.a_row0(nxt);
#pragma unroll
                for (int h = 0; h < 2; ++h)
#pragma unroll
                    for (int i = 0; i < 2; ++i) tk[h][i] = r0 + min(h * HALF + rowA[i], nv - 1);
            } } }
        for (int t = 0; t < nt; t += 2) {
            const bool last = (t == nt - 2);
            const char* a1 = cA + (size_t)(t + 1) * kstep;
            const char* a2 = last ? nA : cA + (size_t)(t + 2) * kstep; const char* b2 = last ? nB : cB + (size_t)(t + 2) * kstep;
            const char* a3 = a2 + kstep; const char* b3 = b2 + kstep;
            if (last && has_next) S.a_ready(nxt);
            if constexpr (GATHER) { if (last && has_next) { asm volatile("" : "+v"(tk[0][0]), "+v"(tk[0][1]), "+v"(tk[1][0]), "+v"(tk[1][1]));
#pragma unroll
                for (int h = 0; h < 2; ++h)
#pragma unroll
                    for (int i = 0; i < 2; ++i) nOA[h][i] = S.a_base(nxt) + (unsigned)tk[h][i] * (unsigned)(K * 2) + colA[i]; } }
            if constexpr (SP2) {
            PG8_LDB(B0, 0, 0); PG8_LDB(B1, 0, 1); PG8_SCHED; PG8_LDA(At, 0, 0); PG8_STAGE2(PG8_SA(1, 1), a1, oA[1][0], oA[1][1]);
            PG8_WAIT_V(8); PG8_WAIT_L(0); PG8_BAR; PG8_MMA(0, 0, At, B0); PG8_MMA(0, 1, At, B1); PG8_BAR; PG8_SCHED;
            PG8_LDA(At, 0, 1); PG8_STAGE(PG8_SB(0, 0), b2, voffB); PG8_STAGE(PG8_SB(0, 1), b2 + hstep, voffB); PG8_STAGE2(PG8_SA(0, 0), a2, PG8_OSEL(0, 0), PG8_OSEL(0, 1));
            PG8_WAIT_V(8); if (pend >= 0) { S.done_signal(pend); pend = -1; }
            PG8_WAIT_L(0); PG8_BAR; PG8_MMA(1, 0, At, B0); PG8_MMA(1, 1, At, B1); PG8_BAR; PG8_SCHED;
            PG8_LDB(B0, 1, 0); PG8_LDB(B1, 1, 1); PG8_SCHED; PG8_LDA(At, 1, 0); PG8_STAGE2(PG8_SA(0, 1), a2, PG8_OSEL(1, 0), PG8_OSEL(1, 1));
            PG8_WAIT_V(8); PG8_WAIT_L(0); PG8_BAR; PG8_MMA(0, 0, At, B0); PG8_MMA(0, 1, At, B1); PG8_BAR; PG8_SCHED;
            PG8_LDA(At, 1, 1); PG8_STAGE(PG8_SB(1, 0), b3, voffB); PG8_STAGE(PG8_SB(1, 1), b3 + hstep, voffB); PG8_STAGE2(PG8_SA(1, 0), a3, PG8_OSEL(0, 0), PG8_OSEL(0, 1));
            PG8_WAIT_V(8); PG8_WAIT_L(0); PG8_BAR; PG8_MMA(1, 0, At, B0); PG8_MMA(1, 1, At, B1); PG8_BAR; PG8_SCHED;
            } else {
            PG8_LDB(B0, 0, 0); PG8_SCHED; PG8_LDA(At, 0, 0); PG8_STAGE(PG8_SA(1, 1), a1 + hstep, voffA);
            PG8_WAIT_L(8); PG8_BAR; PG8_WAIT_L(0); PG8_MMA(0, 0, At, B0); PG8_BAR; PG8_SCHED;
            PG8_LDB(B1, 0, 1); PG8_STAGE(PG8_SB(0, 0), b2, voffB);
            PG8_BAR; PG8_WAIT_L(0); PG8_MMA(0, 1, At, B1); PG8_BAR;
            PG8_LDA(At, 0, 1); PG8_STAGE(PG8_SA(0, 0), a2, voffA);
            PG8_BAR; PG8_WAIT_L(0); PG8_MMA(1, 0, At, B0); PG8_BAR; PG8_SCHED;
            PG8_STAGE(PG8_SB(0, 1), b2 + hstep, voffB);
            PG8_WAIT_V(6); PG8_BAR; PG8_MMA(1, 1, At, B1); PG8_BAR;
            PG8_LDB(B0, 1, 0); PG8_SCHED; PG8_LDA(At, 1, 0); PG8_STAGE(PG8_SA(0, 1), a2 + hstep, voffA);
            PG8_WAIT_L(8); PG8_BAR; PG8_WAIT_L(0); PG8_MMA(0, 0, At, B0); PG8_BAR; PG8_SCHED;
            PG8_LDB(B1, 1, 1); PG8_STAGE(PG8_SB(1, 0), b3, voffB);
            PG8_BAR; PG8_WAIT_L(0); PG8_MMA(0, 1, At, B1); PG8_BAR;
            PG8_LDA(At, 1, 1); PG8_STAGE(PG8_SA(1, 0), a3, voffA);
            PG8_BAR; PG8_WAIT_L(0); PG8_MMA(1, 0, At, B0); PG8_BAR; PG8_SCHED;
            PG8_STAGE(PG8_SB(1, 1), b3 + hstep, voffB);
            PG8_WAIT_V(6); PG8_BAR; PG8_MMA(1, 1, At, B1); PG8_BAR;
            }
        }
        if constexpr (FP8) asm volatile("s_nop 15\n\ts_nop 15" ::: "memory");
        if constexpr (ALIGN_EPI) { if (wr == 0) PG8_BAR; }
        if constexpr (!Epi::AFTER_DRAIN) { E(acc, cur, wr, wc, fr, fq); S.done(cur); pend = S.done_defer(cur); }
        if (!has_next) break;
#pragma unroll
        for (int a = 0; a < 2; ++a)
#pragma unroll
            for (int b = 0; b < 2; ++b)
#pragma unroll
                for (int m = 0; m < 4; ++m)
#pragma unroll
                    for (int n = 0; n < 2; ++n) acc[a][b][m][n] = (f32x4){0.f, 0.f, 0.f, 0.f};
        cur = nxt; cA = nA; cB = nB; ++ui;
        if constexpr (GATHER) {
#pragma unroll
            for (int h = 0; h < 2; ++h)
#pragma unroll
                for (int i = 0; i < 2; ++i) oA[h][i] = nOA[h][i];
        }
        if constexpr (ALIGN_EPI) { if (wr == 1) PG8_BAR; }
    }
    PG8_WAIT_V(0);
    if (pend >= 0) { S.done_signal(pend); pend = -1; }
    if constexpr (!ALIGN_EPI) { if (wr == 0) PG8_BAR; }
    PG8_BAR;
    if constexpr (Epi::AFTER_DRAIN) { E.fused(acc, cur, wr, wc, fr, fq, lds, wid, lane); S.done(cur); }
#undef PG8_SA
#undef PG8_OSEL
#undef PG8_STAGE2
#undef PG8_SB
#undef PG8_STAGE
#undef PG8_LDA
#undef PG8_LDB
#undef PG8_MMA
#undef PG8_WAIT_V
#undef PG8_WAIT_L
#undef PG8_BAR
#undef PG8_SCHED
}
}

#ifndef MK_N_LAUNCHES
#define MK_N_LAUNCHES 1
#endif
#ifndef PROBE_DUP
#define PROBE_DUP -1
#endif
#ifndef PROBE_STAMP
#define PROBE_STAMP -1
#endif
constexpr int N_PHASES = 10;
constexpr int NBATCH = 8, TT = 2048, MTOK = NBATCH * TT, D = 1024;
constexpr int HK = 512, NH = 4, DK = 128, DV = 128, CCH = 512, CLEN = 31, INC = 3584;
constexpr int NE = 32, TOPK = 4, FF = 1024;
constexpr float EPS = 1e-5f, SW_LIMIT = 7.0f, SW_ALPHA = 1.702f;
constexpr int NWAVES = 8, NTHR = 512;
constexpr int W1_ITEMS = 32 * 16 * 64, W1_P1 = 6144, W1_P2 = 20480, W1_P0 = W1_ITEMS - W1_P1 - W1_P2;
constexpr int W2_ITEMS = 32 * 16 * 32, W2_P7 = 4096, W2_P2 = W2_ITEMS - W2_P7;
constexpr int MOE_ROWS = (MTOK * TOPK / 256 + NE) * 256;

constexpr size_t MiB = 1u << 20;
constexpr size_t WS_CTL = 0, CTL_ZERO_BYTES = 256 * 1024;
constexpr size_t WS_WI = 1 * MiB;
constexpr size_t WS_WO = 8 * MiB;
constexpr size_t WS_TAB = 10 * MiB;
constexpr size_t WS_W1 = 16 * MiB;
constexpr size_t WS_W2 = 144 * MiB;
constexpr size_t WS_H = 208 * MiB;
constexpr size_t WS_XN = 272 * MiB;
constexpr size_t WS_Q = 304 * MiB, WS_KF = 320 * MiB, WS_KB = 336 * MiB, WS_V = 352 * MiB, WS_G = 368 * MiB, WS_U = 384 * MiB;
constexpr size_t WS_LF = 400 * MiB, WS_LB = 432 * MiB;
constexpr size_t WS_OF = 464 * MiB, WS_OB = 496 * MiB;
constexpr size_t WS_MIX = 528 * MiB;
constexpr size_t WS_XS = 304 * MiB;
constexpr size_t WS_ACT = 448 * MiB;
constexpr size_t WS_YS = 592 * MiB;
constexpr size_t WS_END = 736 * MiB;
constexpr size_t WS_WRT = WS_TAB;
constexpr size_t WS_SLOT = WS_TAB + 256 * 1024;
constexpr size_t WS_GATE = WS_TAB + 512 * 1024;
constexpr size_t WS_ROWTOK = WS_TAB + 1 * MiB;
constexpr int CW_BAR = 4096;
constexpr int CW_CNT = 16384;

constexpr int RING_OFF = 0, RING_BYTES = 131072;
#if defined(HGRN_V2)
constexpr int LDSCTL_OFF = 135168;
#else
constexpr int LDSCTL_OFF = 152576;
#endif
constexpr int MISC_OFF = LDSCTL_OFF + 320;
constexpr int TAB_OFF = LDSCTL_OFF + 1024;
constexpr int SB_OFF = LDSCTL_OFF + 2048;
#if defined(HGRN_V2)
constexpr int LDS_BYTES = 147456;
#else
constexpr int LDS_BYTES = 163840;
#endif

#define GAS __attribute__((address_space(1)))
#define LAS __attribute__((address_space(3)))
typedef unsigned short bf16;
typedef unsigned v4u __attribute__((ext_vector_type(4)));
typedef unsigned v2u __attribute__((ext_vector_type(2)));
typedef float f32x4 __attribute__((ext_vector_type(4)));
typedef GAS unsigned gu32;
#define RLX_AGENT __ATOMIC_RELAXED, __HIP_MEMORY_SCOPE_AGENT
#define LDS_WAIT() asm volatile("s_waitcnt lgkmcnt(0)" ::: "memory")
#define VM_WAIT() asm volatile("s_waitcnt vmcnt(0)" ::: "memory")

__device__ __forceinline__ float bf2f(unsigned b) { return __uint_as_float(b << 16); }
typedef __bf16 bf16x2_t __attribute__((ext_vector_type(2)));
typedef float f32x2_t __attribute__((ext_vector_type(2)));
__device__ __forceinline__ unsigned pk2(float lo, float hi) { const bf16x2_t r = __builtin_convertvector((f32x2_t){lo, hi}, bf16x2_t); return __builtin_bit_cast(unsigned, r); }
__device__ __forceinline__ float sigm(float x) { return __builtin_amdgcn_rcpf(1.0f + __expf(-x)); }
__device__ __forceinline__ float wave_sum(float v) {
#pragma unroll
    for (int o = 1; o < 64; o <<= 1) v += __shfl_xor(v, o);
    return v;
}

constexpr float SC_W = 512.f, SC_N2 = 16.f, SC_ACT = 8.f, SC_YS = 32.f;
__device__ __forceinline__ unsigned pk4_fp8(float a, float b, float c, float d) {
    a = fminf(fmaxf(a, -448.f), 448.f); b = fminf(fmaxf(b, -448.f), 448.f); c = fminf(fmaxf(c, -448.f), 448.f); d = fminf(fmaxf(d, -448.f), 448.f);
    int w = 0; w = __builtin_amdgcn_cvt_pk_fp8_f32(a, b, w, false); w = __builtin_amdgcn_cvt_pk_fp8_f32(c, d, w, true); return (unsigned)w;
}

#define XB_TMO      128
#define XB_XCNT(j)  (256  + 64 * (j))
#define XB_XSUB(j)  (1280 + 64 * (j))
#define XB_XGEN(j)  (2304 + 64 * (j))
#define XB_TOP      3328
#define XB_TOPGEN   3392
#define XCD_BAR_WORDS 3456
#define XB_SPIN_CAP (1u << 18)

__device__ __forceinline__ unsigned xb_ld(unsigned* p)              { return __hip_atomic_load(p, __ATOMIC_RELAXED, __HIP_MEMORY_SCOPE_AGENT); }
__device__ __forceinline__ unsigned xb_add(unsigned* p, unsigned v) { return __hip_atomic_fetch_add(p, v, __ATOMIC_RELAXED, __HIP_MEMORY_SCOPE_AGENT); }
__device__ __forceinline__ unsigned xb_xcc_id() { return (unsigned)__builtin_amdgcn_s_getreg((3 << 11) | 20) & 0xFu; }
#define XB_SPIN(cond, bar) do { unsigned _sp = 0; while (cond) { __builtin_amdgcn_s_sleep(1); \
    if ((++_sp & 255u) == 0u) { if (xb_ld(&(bar)[XB_TMO])) break; if (_sp > XB_SPIN_CAP) { atomicAdd(&(bar)[XB_TMO], 1u); break; } } } } while (0)

struct XcdBarrier {
    unsigned* bar; unsigned x;
    volatile LAS unsigned* st;
};
__device__ __forceinline__ XcdBarrier xcd_barrier_post(unsigned* bar, volatile LAS unsigned* st) {
    XcdBarrier b; b.bar = bar; b.x = xb_xcc_id(); b.st = st;
    if (threadIdx.x == 0) (void)xb_add(&bar[XB_XCNT(b.x)], 1u);
    return b;
}
__device__ __forceinline__ void xcd_barrier_complete(unsigned* bar, unsigned x, unsigned& nloc, unsigned& nx) {
    const unsigned G = gridDim.x * gridDim.y * gridDim.z;
    unsigned sum, cnt, mine, sp = 0u;
    for (;;) {
        sum = 0u; cnt = 0u; mine = 0u;
#pragma unroll
        for (unsigned j = 0; j < 16; ++j) { const unsigned c = xb_ld(&bar[XB_XCNT(j)]); sum += c; cnt += (c > 0u) ? 1u : 0u; mine = (j == x) ? c : mine; }
        if (sum == G) break;
        __builtin_amdgcn_s_sleep(1);
        if ((++sp & 255u) == 0u) { if (xb_ld(&bar[XB_TMO])) break; if (sp > XB_SPIN_CAP) { atomicAdd(&bar[XB_TMO], 1u); break; } }
    }
    nloc = mine > 0u ? mine : 1u; nx = cnt > 0u ? cnt : 1u;
}
__device__ __forceinline__ void xcd_barrier(const XcdBarrier& b) {
    asm volatile("s_waitcnt vmcnt(0)" ::: "memory");
    __syncthreads();
    if (threadIdx.x == 0) {
        unsigned* bar = b.bar;
        __builtin_amdgcn_s_waitcnt(0);
        unsigned nloc = b.st[0], nx = b.st[1];
        if (nloc == 0u) { xcd_barrier_complete(bar, b.x, nloc, nx); b.st[0] = nloc; b.st[1] = nx; }
        const unsigned old = xb_add(&bar[XB_XSUB(b.x)], 1u);
        const unsigned gen = old / nloc;
        if (old + 1u == (gen + 1u) * nloc) {
            __builtin_amdgcn_fence(__ATOMIC_RELEASE, "agent");
            asm volatile("s_waitcnt vmcnt(0)" ::: "memory");
            const unsigned og = xb_add(&bar[XB_TOP], 1u);
            const unsigned tg = og / nx;
            if (og + 1u == (tg + 1u) * nx) xb_add(&bar[XB_TOPGEN], 1u);
            else XB_SPIN(xb_ld(&bar[XB_TOPGEN]) == tg, bar);
            __builtin_amdgcn_fence(__ATOMIC_ACQUIRE, "agent");
            xb_add(&bar[XB_XGEN(b.x)], 1u);
            asm volatile("s_waitcnt vmcnt(0)" ::: "memory");
        } else {
            XB_SPIN(xb_ld(&bar[XB_XGEN(b.x)]) == gen, bar);
            __builtin_amdgcn_fence(__ATOMIC_ACQUIRE, "agent");
            asm volatile("s_waitcnt vmcnt(0)" ::: "memory");
        }
    }
    __syncthreads();
}

#ifndef WT_STORES
#define WT_STORES 0
#endif
__device__ __forceinline__ void st16(void* p, v4u w) {
#if WT_STORES
    asm volatile("global_store_dwordx4 %0, %1, off sc0 sc1\n\ts_nop 1" :: "v"(p), "v"(w) : "memory");
#else
    *(v4u*)p = w;
#endif
}
__device__ __forceinline__ void st8(void* p, v2u w) {
#if WT_STORES
    asm volatile("global_store_dwordx2 %0, %1, off sc0 sc1\n\ts_nop 1" :: "v"(p), "v"(w) : "memory");
#else
    *(v2u*)p = w;
#endif
}
__device__ __forceinline__ void st8bf(bf16* p, const f32x4& a, const f32x4& b) {
    v4u w; w.x = pk2(a[0], a[1]); w.y = pk2(a[2], a[3]); w.z = pk2(b[0], b[1]); w.w = pk2(b[2], b[3]);
    st16(p, w);
}
struct EpiProj {
    static constexpr bool PERM = true, AFTER_DRAIN = false;
    bf16 *Q, *KF, *KB, *V, *G, *U; float *LF, *LB; const float* lbl;
    template <int TYP>
    __device__ __forceinline__ void tile(const pg8::f32x4 (&acc)[2][2][4][2], int row0, int cb) const {
#pragma unroll
        for (int bj = 0; bj < 2; ++bj) {
            const int col = cb + bj * 128;
            float lb[8];
            if (TYP == 1 || TYP == 2) {
                const float* L = lbl + (TYP - 1) * 1024 + col;
#pragma unroll
                for (int i = 0; i < 8; ++i) lb[i] = __builtin_amdgcn_rcpf(1.0f + __expf(L[512 + i] - L[i]));
            }
#pragma unroll
            for (int ai = 0; ai < 2; ++ai)
#pragma unroll
                for (int m = 0; m < 4; ++m) {
                    const size_t off = (size_t)(row0 + ai * 128 + m * 16) * 512 + col;
                    f32x4 a = acc[ai][bj][m][0], b = acc[ai][bj][m][1];
                    if (TYP == 0 || TYP == 4) {
#pragma unroll
                        for (int i = 0; i < 4; ++i) { a[i] = a[i] * sigm(a[i]); b[i] = b[i] * sigm(b[i]); }
                        st8bf((TYP == 0 ? Q : G) + off, a, b);
                    } else if (TYP == 3) {
                        st8bf(V + off, a, b);
                    } else {
                        f32x4 la, lbv, ka, kb;
#pragma unroll
                        for (int i = 0; i < 4; ++i) {
                            const float fa = lb[i] + (1.0f - lb[i]) * sigm(a[i]), fb = lb[4 + i] + (1.0f - lb[4 + i]) * sigm(b[i]);
                            la[i] = __logf(fa); lbv[i] = __logf(fb); ka[i] = 1.0f - fa; kb[i] = 1.0f - fb;
                        }
                        float* Lp = (TYP == 1 ? LF : LB) + off;
                        st16(Lp, (v4u)la); st16(Lp + 4, (v4u)lbv);
                        st8bf((TYP == 1 ? KF : KB) + off, ka, kb);
                    }
                }
        }
    }
    __device__ __forceinline__ void operator()(const pg8::f32x4 (&acc)[2][2][4][2], const pg8::Unit& u, int wr, int wc, int fr, int fq) const {
        const int row0 = u.pm * 256 + wr * 64 + fr, pn = u.pn;
        if (pn >= 10) {
            const int col = (pn - 10) * 128 + wc * 32 + 8 * fq;
#pragma unroll
            for (int ai = 0; ai < 2; ++ai)
#pragma unroll
                for (int m = 0; m < 4; ++m) {
                    f32x4 a = acc[ai][0][m][0], b = acc[ai][0][m][1]; const f32x4 ga = acc[ai][1][m][0], gb = acc[ai][1][m][1];
#pragma unroll
                    for (int i = 0; i < 4; ++i) { a[i] = a[i] * sigm(ga[i]); b[i] = b[i] * sigm(gb[i]); }
                    st8bf(U + (size_t)(row0 + ai * 128 + m * 16) * 512 + col, a, b);
                }
        } else {
            const int cb = (pn & 1) * 256 + wc * 32 + 8 * fq, typ = pn >> 1;
            if (typ == 0) tile<0>(acc, row0, cb);
            else if (typ == 1) tile<1>(acc, row0, cb);
            else if (typ == 2) tile<2>(acc, row0, cb);
            else if (typ == 3) tile<3>(acc, row0, cb);
            else tile<4>(acc, row0, cb);
        }
    }
};
struct EpiRes {
    static constexpr bool PERM = false, AFTER_DRAIN = false;
    const float* X; float* H;
    __device__ __forceinline__ void operator()(const pg8::f32x4 (&acc)[2][2][4][2], const pg8::Unit& u, int wr, int wc, int fr, int fq) const {
        const int row0 = u.pm * 256 + wr * 64 + fr, col0 = u.pn * 256 + wc * 32 + 4 * fq;
#pragma unroll
        for (int ai = 0; ai < 2; ++ai)
#pragma unroll
            for (int m = 0; m < 4; ++m) {
                const size_t off = (size_t)(row0 + ai * 128 + m * 16) * D + col0;
#pragma unroll
                for (int bj = 0; bj < 2; ++bj)
#pragma unroll
                    for (int n = 0; n < 2; ++n) { const f32x4 xv = *(const f32x4*)(X + off + bj * 128 + n * 16); st16(H + off + bj * 128 + n * 16, (v4u)(xv + acc[ai][bj][m][n])); }
            }
    }
};
struct EpiSwiglu {
    static constexpr bool PERM = true, AFTER_DRAIN = false;
    unsigned char* ACT; const float* b1;
    __device__ __forceinline__ void operator()(const pg8::f32x4 (&acc)[2][2][4][2], const pg8::Unit& u, int wr, int wc, int fr, int fq) const {
        const int e = u.pn >> 3, pn = u.pn & 7, row0 = u.pm * 256 + wr * 64 + fr, col = pn * 128 + wc * 32 + 8 * fq;
        const float* bg = b1 + (size_t)e * 2048 + col; const float* bl = bg + 1024;
        float g[8], l[8];
#pragma unroll
        for (int i = 0; i < 8; ++i) { g[i] = bg[i]; l[i] = bl[i]; }
#pragma unroll
        for (int ai = 0; ai < 2; ++ai)
#pragma unroll
            for (int m = 0; m < 4; ++m) {
                f32x4 o[2];
#pragma unroll
                for (int n = 0; n < 2; ++n)
#pragma unroll
                    for (int i = 0; i < 4; ++i) {
                        const float hg = fminf(acc[ai][0][m][n][i] * (1.0f / (SC_N2 * SC_W)) + g[4 * n + i], SW_LIMIT);
                        const float hl = fminf(fmaxf(acc[ai][1][m][n][i] * (1.0f / (SC_N2 * SC_W)) + l[4 * n + i], -SW_LIMIT), SW_LIMIT);
                        o[n][i] = hg * sigm(SW_ALPHA * hg) * (hl + 1.0f) * SC_ACT;
                    }
                v2u w; w.x = pk4_fp8(o[0][0], o[0][1], o[0][2], o[0][3]); w.y = pk4_fp8(o[1][0], o[1][1], o[1][2], o[1][3]);
#if defined(MOE_MERGED)
                asm volatile("global_store_dwordx2 %0, %1, off sc0 sc1\n\ts_nop 1" :: "v"(ACT + (size_t)(row0 + ai * 128 + m * 16) * FF + col), "v"(w) : "memory");
#else
                st8(ACT + (size_t)(row0 + ai * 128 + m * 16) * FF + col, w);
#endif
            }
    }
};
struct EpiDown {
    static constexpr bool PERM = true, AFTER_DRAIN = false;
    unsigned char* YS; const float* b2;
    __device__ __forceinline__ void operator()(const pg8::f32x4 (&acc)[2][2][4][2], const pg8::Unit& u, int wr, int wc, int fr, int fq) const {
        const int e = u.pn >> 2, pn = u.pn & 3, row0 = u.pm * 256 + wr * 64 + fr, col0 = pn * 256 + wc * 32 + 8 * fq;
#pragma unroll
        for (int bj = 0; bj < 2; ++bj) {
            const float* bp = b2 + (size_t)e * D + col0 + bj * 128;
            const f32x4 b0 = *(const f32x4*)bp, b1v = *(const f32x4*)(bp + 4);
#pragma unroll
            for (int ai = 0; ai < 2; ++ai)
#pragma unroll
                for (int m = 0; m < 4; ++m)
                    { const f32x4 y0 = (acc[ai][bj][m][0] * (1.0f / (SC_ACT * SC_W)) + b0) * SC_YS, y1 = (acc[ai][bj][m][1] * (1.0f / (SC_ACT * SC_W)) + b1v) * SC_YS;
                      v2u w; w.x = pk4_fp8(y0[0], y0[1], y0[2], y0[3]); w.y = pk4_fp8(y1[0], y1[1], y1[2], y1[3]); st8(YS + (size_t)(row0 + ai * 128 + m * 16) * D + col0 + bj * 128, w); }
        }
    }
};
struct MoeOrder {
    const volatile LAS int* bs; int ntn, G, v; const volatile LAS int* cl; const int* rowtok;
    __device__ __forceinline__ const int* a_list(const pg8::Unit& u) const { const int e = u.pn / ntn; return rowtok + e * MTOK + (u.pm - bs[e]) * 256; }
    __device__ __forceinline__ int a_valid(const pg8::Unit& u) const { const int e = u.pn / ntn; return min(256, cl[e] - (u.pm - bs[e]) * 256); }
    __device__ __forceinline__ bool next(int i, pg8::Unit& u) const {
        int L = i * G + v; const int nb = bs[32];
        if (L >= nb * ntn * (((PROBE_DUP) == 17 && ntn == 8) || ((PROBE_DUP) == 18 && ntn == 4) ? 2 : 1)) return false;
        if (L >= nb * ntn) L -= nb * ntn;
        const int mb = L / ntn, pn = L - mb * ntn;
        const int ln = (int)(threadIdx.x & 63);
        const int e = __popcll(__ballot(ln < NE - 1 && bs[ln + 1] <= mb));
        u.pm = mb; u.pn = e * ntn + pn; return true;
    }
    __device__ __forceinline__ bool a_is_list(const pg8::Unit&) const { return true; }
    __device__ __forceinline__ unsigned a_base(const pg8::Unit&) const { return 0u; }
    __device__ __forceinline__ int a_row0(const pg8::Unit&) const { return 0; }
    __device__ __forceinline__ void a_ready(const pg8::Unit&) const {}
    __device__ __forceinline__ void done(const pg8::Unit&) const {}
    __device__ __forceinline__ int done_defer(const pg8::Unit&) const { return -1; }
    __device__ __forceinline__ void done_signal(int) const {}
};
constexpr int CW_BLK = 32768;
struct MoeOrder2 {
    const volatile LAS int* bs; int G, v; const volatile LAS int* cl; const int* rowtok; unsigned* ctl;
    __device__ __forceinline__ bool is_down(const pg8::Unit& u) const { return u.pn >= 512; }
    __device__ __forceinline__ int expert(const pg8::Unit& u) const { return is_down(u) ? (u.pn - 512) >> 2 : u.pn >> 3; }
    __device__ __forceinline__ bool a_is_list(const pg8::Unit& u) const { return !is_down(u); }
    __device__ __forceinline__ unsigned a_base(const pg8::Unit& u) const { return is_down(u) ? (unsigned)WS_ACT : (unsigned)WS_XN; }
    __device__ __forceinline__ int a_row0(const pg8::Unit& u) const { return u.pm * 256; }
    __device__ __forceinline__ const int* a_list(const pg8::Unit& u) const { const int e = expert(u); return rowtok + e * MTOK + (u.pm - bs[e]) * 256; }
    __device__ __forceinline__ int a_valid(const pg8::Unit& u) const { const int e = expert(u); return min(256, cl[e] - (u.pm - bs[e]) * 256); }
    __device__ __forceinline__ bool next(int i, pg8::Unit& u) const {
        const int L = i * G + v, nb = bs[32];
        if (L >= nb * 12) return false;
        const bool dn = L >= nb * 8; const int L2 = dn ? L - nb * 8 : L, ntn = dn ? 4 : 8;
        const int mb = L2 / ntn, pn = L2 - mb * ntn;
        const int ln = (int)(threadIdx.x & 63);
        const int e = __popcll(__ballot(ln < NE - 1 && bs[ln + 1] <= mb));
        u.pm = mb; u.pn = (dn ? 512 : 0) + e * ntn + pn; return true;
    }
    __device__ __forceinline__ void a_ready(const pg8::Unit& u) const {
        if (!is_down(u)) return;
        if (threadIdx.x < 64) {
            const unsigned long long t0 = __builtin_amdgcn_s_memrealtime(); unsigned polls = 0;
            while ((unsigned)__builtin_amdgcn_readfirstlane(__hip_atomic_load(ctl + CW_BLK + 64 * u.pm, __ATOMIC_RELAXED, __HIP_MEMORY_SCOPE_AGENT)) < 64u) {
                if ((++polls & 255u) == 0u && __builtin_amdgcn_readfirstlane(__hip_atomic_load(ctl + 1, __ATOMIC_RELAXED, __HIP_MEMORY_SCOPE_AGENT)) != 0u) break;
                if (__builtin_amdgcn_s_memrealtime() - t0 > 2000000ull) { if (threadIdx.x == 0) __hip_atomic_store(ctl + 1, 1u, __ATOMIC_RELAXED, __HIP_MEMORY_SCOPE_AGENT); break; }
                __builtin_amdgcn_s_sleep(2); }
            __builtin_amdgcn_fence(__ATOMIC_ACQUIRE, "agent");
            asm volatile("s_waitcnt vmcnt(0)" ::: "memory");
        }
        asm volatile("" ::: "memory"); __builtin_amdgcn_s_barrier(); asm volatile("" ::: "memory");
    }
    __device__ __forceinline__ void done(const pg8::Unit&) const {}
    __device__ __forceinline__ int done_defer(const pg8::Unit& u) const { return is_down(u) ? -1 : u.pm; }
    __device__ __forceinline__ void done_signal(int mb) const { if ((threadIdx.x & 63) == 0) __hip_atomic_fetch_add(ctl + CW_BLK + 64 * mb, 1u, __ATOMIC_RELAXED, __HIP_MEMORY_SCOPE_AGENT); }
};
struct EpiMoe {
    static constexpr bool PERM = true, AFTER_DRAIN = false;
    EpiSwiglu up; EpiDown down;
    __device__ __forceinline__ void operator()(const pg8::f32x4 (&acc)[2][2][4][2], const pg8::Unit& u, int wr, int wc, int fr, int fq) const {
        if (u.pn >= 512) { pg8::Unit d; d.pm = u.pm; d.pn = u.pn - 512; down(acc, d, wr, wc, fr, fq); } else up(acc, u, wr, wc, fr, fq);
    }
};

#ifndef PROBE_DUP
#define PROBE_DUP -1
#endif
struct OrderRep : pg8::StaticOrder {
    int reps;
    __device__ __forceinline__ bool next(int i, pg8::Unit& u) const {
        const int per = (nwg + G - 1) / G, r = i / per;
        if (r >= reps) return false;
        return pg8::StaticOrder::next(i - r * per, u) ? true : ((r + 1 < reps) ? pg8::StaticOrder::next(0, u) : false);
    }
};
struct RmIdent { __device__ __forceinline__ int operator()(int n) const { return n; } };
struct RmWin {
    __device__ __forceinline__ int operator()(int n) const {
        if (n < 2560) return n;
        if (n < 3072) { const int j = n - 2560; return 2560 + (j >> 7) * 256 + (j & 127); }
        const int j = n - 3072; return 2560 + (j >> 7) * 256 + 128 + (j & 127);
    }
};
struct RmW1 {
    __device__ __forceinline__ int operator()(int n) const {
        if (n < 1024) return (n >> 7) * 256 + (n & 127);
        const int j = n - 1024; return (j >> 7) * 256 + 128 + (j & 127);
    }
};
__device__ __forceinline__ void p0_load(const float* W, int N, int item, int lane, f32x4 (&v)[8]) {
    const int nblk = N / 32, kb = item / nblk, nb = item % nblk, k0 = 64 * kb, n0 = 32 * nb;
    const int r8 = lane >> 3, c4 = lane & 7;
#pragma unroll
    for (int i = 0; i < 8; ++i) v[i] = *(const f32x4*)(W + (size_t)(k0 + 8 * i + r8) * N + n0 + 4 * c4);
}
template <bool FP8OUT, class RM>
__device__ __forceinline__ void p0_finish(const f32x4 (&v)[8], int K, int N, void* WTv, RM rm, LAS float* scr, int item, int lane) {
    const int nblk = N / 32, kb = item / nblk, nb = item % nblk, k0 = 64 * kb, n0 = 32 * nb;
    const int r8 = lane >> 3, c4 = lane & 7;
#pragma unroll
    for (int i = 0; i < 8; ++i) *(LAS f32x4*)(scr + (8 * i + r8) * 36 + 4 * c4) = v[i];
    LDS_WAIT(); asm volatile("" ::: "memory");
    const int n = lane & 31, kh = lane >> 5; const LAS float* s = scr + (32 * kh) * 36 + n;
    if constexpr (FP8OUT) {
        unsigned w[8];
#pragma unroll
        for (int j = 0; j < 8; ++j) w[j] = pk4_fp8(s[(4 * j) * 36] * SC_W, s[(4 * j + 1) * 36] * SC_W, s[(4 * j + 2) * 36] * SC_W, s[(4 * j + 3) * 36] * SC_W);
        GAS v4u* dst = (GAS v4u*)((unsigned char*)WTv + (size_t)rm(n0 + n) * K + k0 + 32 * kh);
        dst[0] = (v4u){w[0], w[1], w[2], w[3]}; dst[1] = (v4u){w[4], w[5], w[6], w[7]};
    } else {
        unsigned w[16];
#pragma unroll
        for (int j = 0; j < 16; ++j) w[j] = pk2(s[(2 * j) * 36], s[(2 * j + 1) * 36]);
        GAS v4u* dst = (GAS v4u*)((bf16*)WTv + (size_t)rm(n0 + n) * K + k0 + 32 * kh);
#pragma unroll
        for (int q = 0; q < 4; ++q) dst[q] = (v4u){w[4 * q], w[4 * q + 1], w[4 * q + 2], w[4 * q + 3]};
    }
    LDS_WAIT(); asm volatile("" ::: "memory");
}
template <bool FP8OUT, class RM>
__device__ __forceinline__ void p0_item(const float* W, int K, int N, void* WTv, RM rm, LAS float* scr, int item, int lane) {
    f32x4 v[8]; p0_load(W, N, item, lane, v); p0_finish<FP8OUT>(v, K, N, WTv, rm, scr, item, lane);
}
template <class RM>
__device__ __forceinline__ void convert_range_fp8(const float* W, int K, int N, unsigned char* WT, RM rm, int ipe_log2, int first, int stride, int count, int base, LAS float* scr, int lane) {
    const size_t esz = (size_t)K * N; const int mask = (1 << ipe_log2) - 1;
    f32x4 va[8], vb[8];
    int it = first;
    if (it < count) p0_load(W + (size_t)((base + it) >> ipe_log2) * esz, N, (base + it) & mask, lane, va);
    while (it < count) {
        const int i1 = it + stride, i2 = it + 2 * stride;
        if (i1 < count) p0_load(W + (size_t)((base + i1) >> ipe_log2) * esz, N, (base + i1) & mask, lane, vb);
        p0_finish<true>(va, K, N, WT + (size_t)((base + it) >> ipe_log2) * esz, rm, scr, (base + it) & mask, lane);
        if (i1 >= count) break;
        if (i2 < count) p0_load(W + (size_t)((base + i2) >> ipe_log2) * esz, N, (base + i2) & mask, lane, va);
        p0_finish<true>(vb, K, N, WT + (size_t)((base + i1) >> ipe_log2) * esz, rm, scr, (base + i1) & mask, lane);
        it = i2;
    }
}
#ifndef CONV_BLOCKED
#define CONV_BLOCKED 0
#endif
template <class RM>
__device__ __forceinline__ void convert_slice_fp8(const float* W, int K, int N, unsigned char* WT, RM rm, int ipe_log2, int id, int nw, int count, int base, LAS float* scr, int lane) {
#if CONV_BLOCKED
    const int per = (count + nw - 1) / nw, b0 = id * per, b1 = min(count, b0 + per);
    if (b0 < b1) convert_range_fp8(W, K, N, WT, rm, ipe_log2, 0, 1, b1 - b0, base + b0, scr, lane);
#else
    convert_range_fp8(W, K, N, WT, rm, ipe_log2, id, nw, count, base, scr, lane);
#endif
}
__device__ __forceinline__ void rms_row_to_bf16(const float* xrow, const float* w, bf16* orow, int lane) {
    const f32x4* xr = (const f32x4*)xrow + lane; const f32x4* wr = (const f32x4*)w + lane;
    f32x4 v[4]; float s = 0.f;
#pragma unroll
    for (int j = 0; j < 4; ++j) { v[j] = xr[64 * j]; s += (v[j].x * v[j].x + v[j].y * v[j].y) + (v[j].z * v[j].z + v[j].w * v[j].w); }
    const float rstd = rsqrtf(wave_sum(s) * (1.f / D) + EPS);
    v2u* o8 = (v2u*)orow + lane;
#pragma unroll
    for (int j = 0; j < 4; ++j) { const f32x4 g = wr[64 * j]; v2u o; o.x = pk2(v[j].x * rstd * g.x, v[j].y * rstd * g.y); o.y = pk2(v[j].z * rstd * g.z, v[j].w * rstd * g.w); o8[64 * j] = o; }
}


__device__ __forceinline__ pg8::bf16x8 lds_frag(const LAS unsigned char* p) { return *(const LAS pg8::bf16x8*)p; }
__device__ __forceinline__ pg8::bf16x8 mk_frag(v2u a, v2u b) { const v4u w = (v4u){a.x, a.y, b.x, b.y}; return (pg8::bf16x8)w; }
#ifndef PROBE_TID
#define PROBE_TID 0
#endif
#define HG_PSTAMP(lds_, n_, code_) do { if ((PROBE_STAMP) >= 660 && (PROBE_STAMP) <= 669 && (n_) == 5 && threadIdx.x == (PROBE_TID)) { \
        if ((code_) == 660) *(volatile LAS unsigned long long*)((lds_) + LDSCTL_OFF + 640) = __builtin_amdgcn_s_memrealtime(); \
        if ((code_) == (PROBE_STAMP)) *(volatile LAS unsigned long long*)((lds_) + LDSCTL_OFF + 648) = __builtin_amdgcn_s_memrealtime(); } } while (0)
struct HgCtx {
    LAS unsigned char* lds; const bf16 *Qb, *Kp, *Vb; const float* Lp; float* Op;
    int b, h, dir, vh, lane, wave, lr, lq, dA, seg, tauB, dg;
    unsigned offA[16], offB, offV, ke_tr, v_tr;
};
constexpr int HG_BF = 0, HG_AM = 0, HG_QI = 33792, HG_KK = 51200, HG_KE = 68608, HG_V = 86016, HG_ST = 95232, HG_SEG = 112640, HG_DEC = 114688;
constexpr int HG_RSD = 272, HG_RSS = 144, HG_RSBF = 528;
__device__ __forceinline__ void hgrn_load(const HgCtx& c, int n, float (&lf)[16], v4u (&qB)[2], v4u (&kB)[2], v4u& vB) {
    const size_t cb = (size_t)__builtin_amdgcn_readfirstlane(c.b * TT + (c.dir ? (TT / 64 - 1 - n) * 64 : n * 64)) * 512 + c.h * 128;
    const float* Lc = c.Lp + cb; const bf16* Qc = c.Qb + cb; const bf16* Kc = c.Kp + cb; const bf16* Vc = c.Vb + cb;
#pragma unroll
    for (int i = 0; i < 16; ++i) lf[i] = Lc[c.offA[i]];
    qB[0] = *(const v4u*)(Qc + c.offB); qB[1] = *(const v4u*)(Qc + c.offB + 8); kB[0] = *(const v4u*)(Kc + c.offB); kB[1] = *(const v4u*)(Kc + c.offB + 8);
    vB = *(const v4u*)(Vc + c.offV);
}
__device__ __forceinline__ void hgrn_chunk(const HgCtx& c, int n, float (&lf)[16], v4u (&qB)[2], v4u (&kB)[2], v4u& vB, f32x4 (&S)[4]) {
    LAS unsigned char* lds = c.lds;
    const int dir = c.dir, lr = c.lr, lq = c.lq, wave = c.wave, dA = c.dA, seg = c.seg, tauB = c.tauB, dg = c.dg;
    const int tb = c.b * TT + (dir ? (TT / 64 - 1 - n) * 64 : n * 64); HG_PSTAMP(lds, n, 660);
    float bl[16]; { float cs = 0.f;
#pragma unroll
        for (int i = 0; i < 16; ++i) { cs += lf[i]; bl[i] = cs; }
        *(LAS float*)(lds + HG_SEG + (seg * 128 + dA) * 4) = cs; }
    __syncthreads();
    HG_PSTAMP(lds, n, 661);
    {
        const float p0 = *(LAS float*)(lds + HG_SEG + (0 * 128 + dA) * 4), p1 = *(LAS float*)(lds + HG_SEG + (1 * 128 + dA) * 4),
                    p2 = *(LAS float*)(lds + HG_SEG + (2 * 128 + dA) * 4), p3 = *(LAS float*)(lds + HG_SEG + (3 * 128 + dA) * 4);
        const float pre = (seg > 0 ? p0 : 0.f) + (seg > 1 ? p1 : 0.f) + (seg > 2 ? p2 : 0.f);
#pragma unroll
        for (int i = 0; i < 16; ++i) *(LAS float*)(lds + HG_BF + (16 * seg + i) * HG_RSBF + dA * 4) = pre + bl[i];
        if (seg == 0) *(LAS float*)(lds + HG_DEC + dA * 4) = __expf((p0 + p1) + (p2 + p3));
    }
    __syncthreads();
    HG_PSTAMP(lds, n, 662);
    {
        const unsigned qw[8] = {qB[0].x, qB[0].y, qB[0].z, qB[0].w, qB[1].x, qB[1].y, qB[1].z, qB[1].w};
        const unsigned kw[8] = {kB[0].x, kB[0].y, kB[0].z, kB[0].w, kB[1].x, kB[1].y, kB[1].z, kB[1].w};
        unsigned qo[8], ko[8], eo[8];
#pragma unroll
        for (int i = 0; i < 4; ++i) {
            const f32x4 bb = *(const LAS f32x4*)(lds + HG_BF + tauB * HG_RSBF + dg * 64 + i * 16);
            const f32x4 dc = *(const LAS f32x4*)(lds + HG_DEC + dg * 64 + i * 16);
#pragma unroll
            for (int j = 0; j < 2; ++j) {
                const float e0 = __expf(bb[2 * j]), e1 = __expf(bb[2 * j + 1]);
                const unsigned qq = qw[2 * i + j], kk = kw[2 * i + j];
                const float k0 = bf2f(kk & 0xffffu) * __builtin_amdgcn_rcpf(e0), k1 = bf2f(kk >> 16) * __builtin_amdgcn_rcpf(e1);
                qo[2 * i + j] = pk2(bf2f(qq & 0xffffu) * e0, bf2f(qq >> 16) * e1);
                ko[2 * i + j] = pk2(k0, k1);
                eo[2 * i + j] = pk2(k0 * dc[2 * j], k1 * dc[2 * j + 1]);
            }
        }
        *(LAS v4u*)(lds + HG_QI + tauB * HG_RSD + dg * 32) = (v4u){qo[0], qo[1], qo[2], qo[3]}; *(LAS v4u*)(lds + HG_QI + tauB * HG_RSD + dg * 32 + 16) = (v4u){qo[4], qo[5], qo[6], qo[7]};
        *(LAS v4u*)(lds + HG_KK + tauB * HG_RSD + dg * 32) = (v4u){ko[0], ko[1], ko[2], ko[3]}; *(LAS v4u*)(lds + HG_KK + tauB * HG_RSD + dg * 32 + 16) = (v4u){ko[4], ko[5], ko[6], ko[7]};
        *(LAS v4u*)(lds + HG_KE + tauB * HG_RSD + dg * 32) = (v4u){eo[0], eo[1], eo[2], eo[3]}; *(LAS v4u*)(lds + HG_KE + tauB * HG_RSD + dg * 32 + 16) = (v4u){eo[4], eo[5], eo[6], eo[7]};
        *(LAS v4u*)(lds + HG_V + tauB * HG_RSS + dg * 16) = vB;
    }
    __syncthreads();
    HG_PSTAMP(lds, n, 663);
    if (n + 2 < TT / 64) hgrn_load(c, n + 2, lf, qB, kB, vB);
    HG_PSTAMP(lds, n, 666);
    const int ei = wave & 3, tp = wave >> 2;
    v2u ket[2][2], vt[4][2][2];
    asm volatile("ds_read_b64_tr_b16 %0, %4\n\tds_read_b64_tr_b16 %1, %4 offset:1088\n\tds_read_b64_tr_b16 %2, %4 offset:8704\n\tds_read_b64_tr_b16 %3, %4 offset:9792"
                 : "=&v"(ket[0][0]), "=&v"(ket[0][1]), "=&v"(ket[1][0]), "=&v"(ket[1][1]) : "v"(c.ke_tr) : "memory");
#define HG_VTR(e4, o0, o1, o2, o3) asm volatile("ds_read_b64_tr_b16 %0, %4 offset:" #o0 "\n\tds_read_b64_tr_b16 %1, %4 offset:" #o1 "\n\tds_read_b64_tr_b16 %2, %4 offset:" #o2 "\n\tds_read_b64_tr_b16 %3, %4 offset:" #o3 \
                 : "=&v"(vt[e4][0][0]), "=&v"(vt[e4][0][1]), "=&v"(vt[e4][1][0]), "=&v"(vt[e4][1][1]) : "v"(c.v_tr) : "memory")
    HG_VTR(0, 0, 576, 4608, 5184); HG_VTR(1, 32, 608, 4640, 5216); HG_VTR(2, 64, 640, 4672, 5248); HG_VTR(3, 96, 672, 4704, 5280);
#undef HG_VTR
    {
        const int ti = wave & 3;
#pragma unroll
        for (int sii = 0; sii < 2; ++sii) {
            const int si = tp * 2 + sii;
            v2u w = (v2u){0u, 0u};
            if (si <= ti) {
                f32x4 a = (f32x4){0.f, 0.f, 0.f, 0.f};
#pragma unroll
                for (int kk = 0; kk < 4; ++kk)
                    a = __builtin_amdgcn_mfma_f32_16x16x32_bf16(lds_frag(lds + HG_KK + (16 * si + lr) * HG_RSD + kk * 64 + lq * 16), lds_frag(lds + HG_QI + (16 * ti + lr) * HG_RSD + kk * 64 + lq * 16), a, 0, 0, 0);
                const int s0 = 16 * si + 4 * lq, t = 16 * ti + lr;
                w.x = pk2(s0 + 0 <= t ? a[0] : 0.f, s0 + 1 <= t ? a[1] : 0.f); w.y = pk2(s0 + 2 <= t ? a[2] : 0.f, s0 + 3 <= t ? a[3] : 0.f);
            }
            *(LAS v2u*)(lds + HG_AM + (16 * ti + lr) * HG_RSS + (16 * si + 4 * lq) * 2) = w;
        }
    }
    f32x4 o[2];
#pragma unroll
    for (int tt = 0; tt < 2; ++tt) {
        o[tt] = (f32x4){0.f, 0.f, 0.f, 0.f};
#pragma unroll
        for (int kk = 0; kk < 4; ++kk)
            o[tt] = __builtin_amdgcn_mfma_f32_16x16x32_bf16(lds_frag(lds + HG_ST + (16 * ei + lr) * HG_RSD + kk * 64 + lq * 16), lds_frag(lds + HG_QI + (16 * (2 * tp + tt) + lr) * HG_RSD + kk * 64 + lq * 16), o[tt], 0, 0, 0);
    }
    HG_PSTAMP(lds, n, 667);
    asm volatile("s_waitcnt lgkmcnt(0)"
                 : "+v"(ket[0][0]), "+v"(ket[0][1]), "+v"(ket[1][0]), "+v"(ket[1][1]),
                   "+v"(vt[0][0][0]), "+v"(vt[0][0][1]), "+v"(vt[0][1][0]), "+v"(vt[0][1][1]), "+v"(vt[1][0][0]), "+v"(vt[1][0][1]), "+v"(vt[1][1][0]), "+v"(vt[1][1][1]),
                   "+v"(vt[2][0][0]), "+v"(vt[2][0][1]), "+v"(vt[2][1][0]), "+v"(vt[2][1][1]), "+v"(vt[3][0][0]), "+v"(vt[3][0][1]), "+v"(vt[3][1][0]), "+v"(vt[3][1][1]) :: "memory");
    {
        const f32x4 dv = *(const LAS f32x4*)(lds + HG_DEC + (16 * wave + 4 * lq) * 4);
#pragma unroll
        for (int e4 = 0; e4 < 4; ++e4) S[e4] = S[e4] * dv;
#pragma unroll
        for (int kk = 0; kk < 2; ++kk) {
            const pg8::bf16x8 af = mk_frag(ket[kk][0], ket[kk][1]);
#pragma unroll
            for (int e4 = 0; e4 < 4; ++e4) S[e4] = __builtin_amdgcn_mfma_f32_16x16x32_bf16(af, mk_frag(vt[e4][kk][0], vt[e4][kk][1]), S[e4], 0, 0, 0);
        }
    }
    HG_PSTAMP(lds, n, 668);
    const pg8::bf16x8 vf0 = ei == 0 ? mk_frag(vt[0][0][0], vt[0][0][1]) : ei == 1 ? mk_frag(vt[1][0][0], vt[1][0][1]) : ei == 2 ? mk_frag(vt[2][0][0], vt[2][0][1]) : mk_frag(vt[3][0][0], vt[3][0][1]);
    const pg8::bf16x8 vf1 = ei == 0 ? mk_frag(vt[0][1][0], vt[0][1][1]) : ei == 1 ? mk_frag(vt[1][1][0], vt[1][1][1]) : ei == 2 ? mk_frag(vt[2][1][0], vt[2][1][1]) : mk_frag(vt[3][1][0], vt[3][1][1]);
    __syncthreads();
    HG_PSTAMP(lds, n, 664);
#pragma unroll
    for (int tt = 0; tt < 2; ++tt) {
        o[tt] = __builtin_amdgcn_mfma_f32_16x16x32_bf16(vf0, lds_frag(lds + HG_AM + (16 * (2 * tp + tt) + lr) * HG_RSS + 0 * 64 + lq * 16), o[tt], 0, 0, 0);
        o[tt] = __builtin_amdgcn_mfma_f32_16x16x32_bf16(vf1, lds_frag(lds + HG_AM + (16 * (2 * tp + tt) + lr) * HG_RSS + 1 * 64 + lq * 16), o[tt], 0, 0, 0);
        const int t = 16 * (2 * tp + tt) + lr;
        { v2u ow; ow.x = pk2(o[tt][0], o[tt][1]); ow.y = pk2(o[tt][2], o[tt][3]);
          *(v2u*)((bf16*)c.Op + (size_t)(dir ? tb + 63 - t : tb + t) * 512 + c.h * 128 + c.vh * 64 + 16 * ei + 4 * lq) = ow; }
    }
#pragma unroll
    for (int e4 = 0; e4 < 4; ++e4) { v2u w; w.x = pk2(S[e4][0], S[e4][1]); w.y = pk2(S[e4][2], S[e4][3]); *(LAS v2u*)(lds + HG_ST + (16 * e4 + lr) * HG_RSD + (16 * wave + 4 * lq) * 2) = w; }
    HG_PSTAMP(lds, n, 665);
}
__device__ __forceinline__ void hgrn_unit(LAS unsigned char* lds, int unit, const bf16* Qb, const bf16* KFb, const bf16* KBb, const bf16* Vb, const float* LFb, const float* LBb,
                                          float* OFb, float* OBb, int tid, int lane, int wave) {
    HgCtx c;
    c.lds = lds; c.vh = unit & 1; c.dir = (unit >> 1) & 1; c.h = (unit >> 2) & 3; c.b = unit >> 4;
    c.Qb = Qb; c.Vb = Vb; c.Kp = c.dir ? KBb : KFb; c.Lp = c.dir ? LBb : LFb; c.Op = c.dir ? OBb : OFb;
    c.lane = lane; c.wave = wave; c.lr = lane & 15; c.lq = lane >> 4;
    c.dA = tid & 127; c.seg = tid >> 7;
    c.tauB = tid >> 3; c.dg = tid & 7;
    for (int i = tid; i < 64 * HG_RSD / 16; i += NTHR) *(LAS v4u*)(lds + HG_ST + i * 16) = (v4u){0u, 0u, 0u, 0u};
    f32x4 S[4];
#pragma unroll
    for (int i = 0; i < 4; ++i) S[i] = (f32x4){0.f, 0.f, 0.f, 0.f};
#pragma unroll
    for (int i = 0; i < 16; ++i) { const int tau = 16 * c.seg + i; c.offA[i] = (unsigned)((c.dir ? 63 - tau : tau) * 512 + c.dA); }
    c.offB = (unsigned)((c.dir ? 63 - c.tauB : c.tauB) * 512 + 16 * c.dg); c.offV = (unsigned)((c.dir ? 63 - c.tauB : c.tauB) * 512 + c.vh * 64 + 8 * c.dg);
    const unsigned trrow = (unsigned)(8 * c.lq + ((lane & 15) >> 2)), trcol = (unsigned)(4 * (lane & 3));
    c.ke_tr = (unsigned)(size_t)(lds + HG_KE) + trrow * HG_RSD + (16 * wave + trcol) * 2;
    c.v_tr = (unsigned)(size_t)(lds + HG_V) + trrow * HG_RSS + trcol * 2;
    float lf0[16], lf1[16]; v4u qB0[2], kB0[2], vB0, qB1[2], kB1[2], vB1;
    hgrn_load(c, 0, lf0, qB0, kB0, vB0); hgrn_load(c, 1, lf1, qB1, kB1, vB1);
#pragma unroll 1
    for (int n = 0; n < TT / 64; n += 2) { hgrn_chunk(c, n, lf0, qB0, kB0, vB0, S); hgrn_chunk(c, n + 1, lf1, qB1, kB1, vB1, S); }
    __syncthreads();
}

__device__ __forceinline__ void router_finish(float (&a)[NE], int m, int lane, const float* router_b, LAS int* lcnt, LAS unsigned* sbw, float* GATE) {
#define RF_STEP(s2, n) { const bool up = (lane & (s2)) != 0; _Pragma("unroll") for (int i = 0; i < (n); ++i) { const float k1 = up ? a[i + (n)] : a[i], x1 = up ? a[i] : a[i + (n)]; a[i] = k1 + __shfl_xor(x1, (s2)); } }
    RF_STEP(32, 16) RF_STEP(16, 8) RF_STEP(8, 4) RF_STEP(4, 2) RF_STEP(2, 1)
#undef RF_STEP
    float lg = a[0] + __shfl_xor(a[0], 1);
    const int myE = lane >> 1;
    lg += router_b[myE];
    float tv[TOPK]; int ti[TOPK];
#pragma unroll
    for (int k = 0; k < TOPK; ++k) {
        float mx = lg;
#pragma unroll
        for (int o = 1; o < 64; o <<= 1) mx = fmaxf(mx, __shfl_xor(mx, o));
        int cand = (lg == mx) ? myE : 99;
#pragma unroll
        for (int o = 1; o < 64; o <<= 1) cand = min(cand, __shfl_xor(cand, o));
        tv[k] = mx; ti[k] = cand;
        if (myE == cand) lg = -INFINITY;
    }
    const float e1 = __expf(tv[1] - tv[0]), e2 = __expf(tv[2] - tv[0]), e3 = __expf(tv[3] - tv[0]);
    const float inv = 1.0f / (1.0f + e1 + e2 + e3);
    if (lane < TOPK && m < MTOK) {
        const int ek = lane == 0 ? ti[0] : lane == 1 ? ti[1] : lane == 2 ? ti[2] : ti[3];
        const float gk = (lane == 0 ? 1.0f : lane == 1 ? e1 : lane == 2 ? e2 : e3) * inv;
        const int lr = __hip_atomic_fetch_add(&lcnt[ek], 1, __ATOMIC_RELAXED, __HIP_MEMORY_SCOPE_WORKGROUP);
        sbw[lane] = ((unsigned)ek << 16) | (unsigned)lr;
        GATE[(size_t)m * TOPK + lane] = gk;
    }
}

#ifndef PROBE_DELAY
#define PROBE_DELAY 0
#endif
__device__ __forceinline__ void probe_delay(int us100) { const unsigned long long t0 = __builtin_amdgcn_s_memrealtime(); while (__builtin_amdgcn_s_memrealtime() - t0 < (unsigned long long)us100) __builtin_amdgcn_s_sleep(2); }
#if !defined(HGRN_V2)
constexpr int H3_QI = 0, H3_KK = 34816, H3_V = 69632, H3_DEC = 88064, H3_ST = 89088, H3_AM = 106496, H3_LH = 115712, H3_LL = 133120, H3_END = 150528;
constexpr int H3_BUFD = 17408, H3_BUFV = 9216, H3_BUFDEC = 512;
static_assert(H3_END <= LDSCTL_OFF, "recurrence LDS image below the control words");
struct Hg3 {
    LAS unsigned char* lds; const bf16 *Qb, *Kp, *Vb; const float* Lp; float* Op;
    int b, h, dir, vh, lane, lr, lq;
};
__device__ __forceinline__ size_t hg3_row(const Hg3& c, int n, int t) {
    const int tb = c.b * TT + (c.dir ? (TT / 64 - 1 - n) * 64 : n * 64);
    return (size_t)(c.dir ? tb + 63 - t : tb + t) * 512 + c.h * 128;
}
struct Hg3LV { f32x4 lf[8]; v4u v[2]; };
struct Hg3QK { v2u q[2][4], k[2][4]; };
__device__ __forceinline__ void gld16(f32x4& d, const void* p) { asm volatile("global_load_dwordx4 %0, %1, off" : "=v"(d) : "v"(p) : "memory"); }
__device__ __forceinline__ void gld16u(v4u& d, const void* p) { asm volatile("global_load_dwordx4 %0, %1, off" : "=v"(d) : "v"(p) : "memory"); }
__device__ __forceinline__ void gld8(v2u& d, const void* p) { asm volatile("global_load_dwordx2 %0, %1, off" : "=v"(d) : "v"(p) : "memory"); }
__device__ __forceinline__ void hg3_load_lv(const Hg3& c, int n, int pt, Hg3LV& in) {
    const size_t r = hg3_row(c, n, pt >> 2);
#pragma unroll
    for (int i = 0; i < 8; ++i) gld16(in.lf[i], c.Lp + r + 32 * (pt & 3) + 4 * i);
    gld16u(in.v[0], c.Vb + r + c.vh * 64 + 16 * (pt & 3)); gld16u(in.v[1], c.Vb + r + c.vh * 64 + 16 * (pt & 3) + 8);
}
__device__ __forceinline__ void hg3_load_qk(const Hg3& c, int n, int pw, Hg3QK& in) {
#pragma unroll
    for (int ti = 0; ti < 4; ++ti) { const size_t r = hg3_row(c, n, 16 * ti + c.lr);
#pragma unroll
        for (int dt = 0; dt < 2; ++dt) { const int d0 = 16 * (2 * pw + dt) + 4 * c.lq; gld8(in.q[dt][ti], c.Qb + r + d0); gld8(in.k[dt][ti], c.Kp + r + d0); } }
}
#define H3_USE_LV(x) asm volatile("" : "+v"((x).lf[0]), "+v"((x).lf[1]), "+v"((x).lf[2]), "+v"((x).lf[3]), "+v"((x).lf[4]), "+v"((x).lf[5]), "+v"((x).lf[6]), "+v"((x).lf[7]), "+v"((x).v[0]), "+v"((x).v[1]))
#define H3_USE_QK(x) asm volatile("" : "+v"((x).q[0][0]), "+v"((x).q[0][1]), "+v"((x).q[0][2]), "+v"((x).q[0][3]), "+v"((x).q[1][0]), "+v"((x).q[1][1]), "+v"((x).q[1][2]), "+v"((x).q[1][3]), \
                                           "+v"((x).k[0][0]), "+v"((x).k[0][1]), "+v"((x).k[0][2]), "+v"((x).k[0][3]), "+v"((x).k[1][0]), "+v"((x).k[1][1]), "+v"((x).k[1][2]), "+v"((x).k[1][3]))
__device__ __forceinline__ unsigned hg3_hi_lo(float x, float y, unsigned& lo) {
    const unsigned hi = pk2(x, y);
    lo = pk2(x - bf2f(hi & 0xffffu), y - bf2f(hi >> 16));
    return hi;
}
__device__ __forceinline__ void hg3_prep_a(const Hg3& c, int buf, int pt, const Hg3LV& in) {
    const int t = pt >> 2, dq = pt & 3;
#pragma unroll
    for (int i = 0; i < 8; ++i) { unsigned l0, l1; const unsigned h0 = hg3_hi_lo(in.lf[i].x, in.lf[i].y, l0), h1 = hg3_hi_lo(in.lf[i].z, in.lf[i].w, l1);
        *(LAS v2u*)(c.lds + H3_LH + t * 272 + (32 * dq + 4 * i) * 2) = (v2u){h0, h1}; *(LAS v2u*)(c.lds + H3_LL + t * 272 + (32 * dq + 4 * i) * 2) = (v2u){l0, l1}; }
    *(LAS v4u*)(c.lds + H3_V + buf * H3_BUFV + t * 144 + dq * 32) = in.v[0]; *(LAS v4u*)(c.lds + H3_V + buf * H3_BUFV + t * 144 + dq * 32 + 16) = in.v[1];
}
__device__ __forceinline__ void hg3_prep_b(const Hg3& c, int buf, int pw, const Hg3QK& in, const pg8::bf16x8 (&U)[4]) {
    LAS unsigned char* lds = c.lds; const int lr = c.lr, lq = c.lq, lane = c.lane;
    const unsigned trrow = (unsigned)(8 * lq + ((lane & 15) >> 2)), trcol = (unsigned)(4 * (lane & 3));
    const pg8::bf16x8 ones = (pg8::bf16x8)(v4u){0x3F803F80u, 0x3F803F80u, 0x3F803F80u, 0x3F803F80u};
#pragma unroll
    for (int dt = 0; dt < 2; ++dt) {
        const int dtile = 2 * pw + dt;
        v2u fh[2][2], fl[2][2];
        const unsigned ah = (unsigned)(size_t)(lds + H3_LH) + trrow * 272 + (16 * dtile + trcol) * 2, al = ah + (H3_LL - H3_LH);
        asm volatile("ds_read_b64_tr_b16 %0, %8\n\tds_read_b64_tr_b16 %1, %8 offset:1088\n\tds_read_b64_tr_b16 %2, %8 offset:8704\n\tds_read_b64_tr_b16 %3, %8 offset:9792\n\t"
                     "ds_read_b64_tr_b16 %4, %9\n\tds_read_b64_tr_b16 %5, %9 offset:1088\n\tds_read_b64_tr_b16 %6, %9 offset:8704\n\tds_read_b64_tr_b16 %7, %9 offset:9792\n\ts_waitcnt lgkmcnt(0)"
                     : "=&v"(fh[0][0]), "=&v"(fh[0][1]), "=&v"(fh[1][0]), "=&v"(fh[1][1]), "=&v"(fl[0][0]), "=&v"(fl[0][1]), "=&v"(fl[1][0]), "=&v"(fl[1][1]) : "v"(ah), "v"(al) : "memory");
        const pg8::bf16x8 H0 = mk_frag(fh[0][0], fh[0][1]), H1 = mk_frag(fh[1][0], fh[1][1]), L0 = mk_frag(fl[0][0], fl[0][1]), L1 = mk_frag(fl[1][0], fl[1][1]);
        f32x4 bt[4];
        const f32x4 z = (f32x4){0.f, 0.f, 0.f, 0.f};
        bt[0] = __builtin_amdgcn_mfma_f32_16x16x32_bf16(L0, U[0], z, 0, 0, 0);    bt[0] = __builtin_amdgcn_mfma_f32_16x16x32_bf16(H0, U[0], bt[0], 0, 0, 0);
        bt[1] = __builtin_amdgcn_mfma_f32_16x16x32_bf16(L0, U[1], z, 0, 0, 0);    bt[1] = __builtin_amdgcn_mfma_f32_16x16x32_bf16(H0, U[1], bt[1], 0, 0, 0);
        bt[2] = __builtin_amdgcn_mfma_f32_16x16x32_bf16(L0, ones, z, 0, 0, 0);    bt[2] = __builtin_amdgcn_mfma_f32_16x16x32_bf16(L1, U[2], bt[2], 0, 0, 0);
        bt[2] = __builtin_amdgcn_mfma_f32_16x16x32_bf16(H0, ones, bt[2], 0, 0, 0); bt[2] = __builtin_amdgcn_mfma_f32_16x16x32_bf16(H1, U[2], bt[2], 0, 0, 0);
        bt[3] = __builtin_amdgcn_mfma_f32_16x16x32_bf16(L0, ones, z, 0, 0, 0);    bt[3] = __builtin_amdgcn_mfma_f32_16x16x32_bf16(L1, U[3], bt[3], 0, 0, 0);
        bt[3] = __builtin_amdgcn_mfma_f32_16x16x32_bf16(H0, ones, bt[3], 0, 0, 0); bt[3] = __builtin_amdgcn_mfma_f32_16x16x32_bf16(H1, U[3], bt[3], 0, 0, 0);
        f32x4 de;
#pragma unroll
        for (int r = 0; r < 4; ++r) de[r] = __expf(__shfl(bt[3][r], 16 * lq + 15));
        if (lr == 0) *(LAS f32x4*)(lds + H3_DEC + buf * H3_BUFDEC + (16 * dtile + 4 * lq) * 4) = de;
#pragma unroll
        for (int ti = 0; ti < 4; ++ti) {
            const v2u qq = in.q[dt][ti], kk = in.k[dt][ti];
            const float e0 = __expf(bt[ti][0]), e1 = __expf(bt[ti][1]), e2 = __expf(bt[ti][2]), e3 = __expf(bt[ti][3]);
            v2u qo, ko;
            qo.x = pk2(bf2f(qq.x & 0xffffu) * e0, bf2f(qq.x >> 16) * e1); qo.y = pk2(bf2f(qq.y & 0xffffu) * e2, bf2f(qq.y >> 16) * e3);
            ko.x = pk2(bf2f(kk.x & 0xffffu) * __builtin_amdgcn_rcpf(e0), bf2f(kk.x >> 16) * __builtin_amdgcn_rcpf(e1));
            ko.y = pk2(bf2f(kk.y & 0xffffu) * __builtin_amdgcn_rcpf(e2), bf2f(kk.y >> 16) * __builtin_amdgcn_rcpf(e3));
            const int off = (16 * ti + lr) * 272 + (16 * dtile + 4 * lq) * 2;
            *(LAS v2u*)(lds + H3_QI + buf * H3_BUFD + off) = qo; *(LAS v2u*)(lds + H3_KK + buf * H3_BUFD + off) = ko;
        }
    }
}
__device__ __forceinline__ void hg3_stage1(const Hg3& c, int buf, int mw, f32x4 (&S)[2][4], f32x4 (&o)[2][2], v2u (&vt)[4][2][2]) {
    LAS unsigned char* lds = c.lds; const int lr = c.lr, lq = c.lq, lane = c.lane;
    const LAS unsigned char* QI = lds + H3_QI + buf * H3_BUFD; const LAS unsigned char* KK = lds + H3_KK + buf * H3_BUFD;
    const unsigned trrow = (unsigned)(8 * lq + ((lane & 15) >> 2)), trcol = (unsigned)(4 * (lane & 3));
    const unsigned kk_tr = (unsigned)(size_t)KK + trrow * 272 + (32 * mw + trcol) * 2;
    const unsigned v_tr = (unsigned)(size_t)(lds + H3_V + buf * H3_BUFV) + trrow * 144 + trcol * 2;
    const int tp = mw >> 1, ep = mw & 1;
    pg8::bf16x8 qf[2][4], sf[2][4], kf[3][4];
#pragma unroll
    for (int bq = 0; bq < 2; ++bq)
#pragma unroll
        for (int kk = 0; kk < 4; ++kk) { qf[bq][kk] = lds_frag(QI + (16 * (2 * tp + bq) + lr) * 272 + kk * 64 + lq * 16); sf[bq][kk] = lds_frag(lds + H3_ST + (16 * (2 * ep + bq) + lr) * 272 + kk * 64 + lq * 16); }
#pragma unroll
    for (int a = 0; a < 2; ++a)
#pragma unroll
        for (int bq = 0; bq < 2; ++bq) o[a][bq] = (f32x4){0.f, 0.f, 0.f, 0.f};
#pragma unroll
    for (int kk = 0; kk < 4; ++kk) {
        o[0][0] = __builtin_amdgcn_mfma_f32_16x16x32_bf16(sf[0][kk], qf[0][kk], o[0][0], 0, 0, 0); o[0][1] = __builtin_amdgcn_mfma_f32_16x16x32_bf16(sf[0][kk], qf[1][kk], o[0][1], 0, 0, 0);
        o[1][0] = __builtin_amdgcn_mfma_f32_16x16x32_bf16(sf[1][kk], qf[0][kk], o[1][0], 0, 0, 0); o[1][1] = __builtin_amdgcn_mfma_f32_16x16x32_bf16(sf[1][kk], qf[1][kk], o[1][1], 0, 0, 0);
    }
    __builtin_amdgcn_sched_barrier(0);
    const int ks0 = mw == 3 ? 1 : 0;
    if (mw != 1) {
#pragma unroll
        for (int x = 0; x < 3; ++x)
#pragma unroll
            for (int kk = 0; kk < 4; ++kk) kf[x][kk] = lds_frag(KK + (16 * (ks0 + x) + lr) * 272 + kk * 64 + lq * 16);
    }
    v2u kt[2][2][2];
    {
        f32x4 at[4];
#pragma unroll
        for (int i = 0; i < 4; ++i) at[i] = (f32x4){0.f, 0.f, 0.f, 0.f};
        if (mw != 1) {
#pragma unroll
            for (int kk = 0; kk < 4; ++kk) {
                at[0] = __builtin_amdgcn_mfma_f32_16x16x32_bf16(kf[0][kk], mw == 3 ? qf[1][kk] : qf[0][kk], at[0], 0, 0, 0);
                at[1] = __builtin_amdgcn_mfma_f32_16x16x32_bf16(mw == 0 ? kf[0][kk] : kf[1][kk], mw == 2 ? qf[0][kk] : qf[1][kk], at[1], 0, 0, 0);
                at[2] = __builtin_amdgcn_mfma_f32_16x16x32_bf16(mw == 0 ? kf[1][kk] : kf[2][kk], mw == 2 ? qf[0][kk] : qf[1][kk], at[2], 0, 0, 0);
                if (mw == 2) at[3] = __builtin_amdgcn_mfma_f32_16x16x32_bf16(kf[0][kk], qf[1][kk], at[3], 0, 0, 0);
            }
        }
    asm volatile("ds_read_b64_tr_b16 %0, %8\n\tds_read_b64_tr_b16 %1, %8 offset:1088\n\tds_read_b64_tr_b16 %2, %8 offset:8704\n\tds_read_b64_tr_b16 %3, %8 offset:9792\n\t"
                 "ds_read_b64_tr_b16 %4, %8 offset:32\n\tds_read_b64_tr_b16 %5, %8 offset:1120\n\tds_read_b64_tr_b16 %6, %8 offset:8736\n\tds_read_b64_tr_b16 %7, %8 offset:9824"
                 : "=&v"(kt[0][0][0]), "=&v"(kt[0][0][1]), "=&v"(kt[0][1][0]), "=&v"(kt[0][1][1]), "=&v"(kt[1][0][0]), "=&v"(kt[1][0][1]), "=&v"(kt[1][1][0]), "=&v"(kt[1][1][1]) : "v"(kk_tr) : "memory");
#define H3_VTR(e4, o0, o1, o2, o3) asm volatile("ds_read_b64_tr_b16 %0, %4 offset:" #o0 "\n\tds_read_b64_tr_b16 %1, %4 offset:" #o1 "\n\tds_read_b64_tr_b16 %2, %4 offset:" #o2 "\n\tds_read_b64_tr_b16 %3, %4 offset:" #o3 \
                 : "=&v"(vt[e4][0][0]), "=&v"(vt[e4][0][1]), "=&v"(vt[e4][1][0]), "=&v"(vt[e4][1][1]) : "v"(v_tr) : "memory")
    H3_VTR(0, 0, 576, 4608, 5184); H3_VTR(1, 32, 608, 4640, 5216); H3_VTR(2, 64, 640, 4672, 5248); H3_VTR(3, 96, 672, 4704, 5280);
#undef H3_VTR
#pragma unroll
        for (int i = 0; i < 4; ++i) {
            int si, ti; bool have = true, zero = false;
            if (mw == 0) { si = i == 2 ? 1 : 0; ti = i == 0 ? 0 : 1; have = i < 3; }
            else if (mw == 1) { si = 1; ti = 0; have = i == 0; zero = true; }
            else if (mw == 2) { si = i == 3 ? 0 : i; ti = i == 3 ? 3 : 2; }
            else { si = i == 3 ? 3 : i + 1; ti = i == 3 ? 2 : 3; zero = i == 3; }
            if (have) {
                const int s0 = 16 * si + 4 * lq, t = 16 * ti + lr; v2u w = (v2u){0u, 0u};
                if (!zero) { w.x = pk2(s0 + 0 <= t ? at[i][0] : 0.f, s0 + 1 <= t ? at[i][1] : 0.f); w.y = pk2(s0 + 2 <= t ? at[i][2] : 0.f, s0 + 3 <= t ? at[i][3] : 0.f); }
                *(LAS v2u*)(lds + H3_AM + (16 * ti + lr) * 144 + (16 * si + 4 * lq) * 2) = w;
            }
        }
    }
    asm volatile("s_waitcnt lgkmcnt(0)"
                 : "+v"(kt[0][0][0]), "+v"(kt[0][0][1]), "+v"(kt[0][1][0]), "+v"(kt[0][1][1]), "+v"(kt[1][0][0]), "+v"(kt[1][0][1]), "+v"(kt[1][1][0]), "+v"(kt[1][1][1]),
                   "+v"(vt[0][0][0]), "+v"(vt[0][0][1]), "+v"(vt[0][1][0]), "+v"(vt[0][1][1]), "+v"(vt[1][0][0]), "+v"(vt[1][0][1]), "+v"(vt[1][1][0]), "+v"(vt[1][1][1]),
                   "+v"(vt[2][0][0]), "+v"(vt[2][0][1]), "+v"(vt[2][1][0]), "+v"(vt[2][1][1]), "+v"(vt[3][0][0]), "+v"(vt[3][0][1]), "+v"(vt[3][1][0]), "+v"(vt[3][1][1]) :: "memory");
#pragma unroll
    for (int dt = 0; dt < 2; ++dt) {
#pragma unroll
        for (int kk = 0; kk < 2; ++kk) {
            const pg8::bf16x8 af = mk_frag(kt[dt][kk][0], kt[dt][kk][1]);
#pragma unroll
            for (int e4 = 0; e4 < 4; ++e4) S[dt][e4] = __builtin_amdgcn_mfma_f32_16x16x32_bf16(af, mk_frag(vt[e4][kk][0], vt[e4][kk][1]), S[dt][e4], 0, 0, 0);
        }
        const f32x4 dv = *(const LAS f32x4*)(lds + H3_DEC + buf * H3_BUFDEC + (16 * (2 * mw + dt) + 4 * lq) * 4);
#pragma unroll
        for (int e4 = 0; e4 < 4; ++e4) S[dt][e4] = S[dt][e4] * dv;
    }
}
__device__ __forceinline__ void hg3_stage2(const Hg3& c, int n, int mw, const f32x4 (&S)[2][4], f32x4 (&o)[2][2], const v2u (&vt)[4][2][2]) {
    LAS unsigned char* lds = c.lds; const int lr = c.lr, lq = c.lq;
#pragma unroll
    for (int bq = 0; bq < 2; ++bq) {
        const int ti = 2 * (mw >> 1) + bq;
        const pg8::bf16x8 a0 = lds_frag(lds + H3_AM + (16 * ti + lr) * 144 + 0 * 64 + lq * 16);
#pragma unroll
        for (int a = 0; a < 2; ++a) { const int e4 = 2 * (mw & 1) + a;
            const pg8::bf16x8 vf = e4 == 0 ? mk_frag(vt[0][0][0], vt[0][0][1]) : e4 == 1 ? mk_frag(vt[1][0][0], vt[1][0][1]) : e4 == 2 ? mk_frag(vt[2][0][0], vt[2][0][1]) : mk_frag(vt[3][0][0], vt[3][0][1]);
            o[a][bq] = __builtin_amdgcn_mfma_f32_16x16x32_bf16(vf, a0, o[a][bq], 0, 0, 0); }
        if (mw >> 1) {
            const pg8::bf16x8 a1 = lds_frag(lds + H3_AM + (16 * ti + lr) * 144 + 1 * 64 + lq * 16);
#pragma unroll
            for (int a = 0; a < 2; ++a) { const int e4 = 2 * (mw & 1) + a;
                const pg8::bf16x8 vf = e4 == 0 ? mk_frag(vt[0][1][0], vt[0][1][1]) : e4 == 1 ? mk_frag(vt[1][1][0], vt[1][1][1]) : e4 == 2 ? mk_frag(vt[2][1][0], vt[2][1][1]) : mk_frag(vt[3][1][0], vt[3][1][1]);
                o[a][bq] = __builtin_amdgcn_mfma_f32_16x16x32_bf16(vf, a1, o[a][bq], 0, 0, 0); }
        }
#pragma unroll
        for (int a = 0; a < 2; ++a)
            *(f32x4*)(c.Op + hg3_row(c, n, 16 * ti + lr) + c.vh * 64 + 16 * (2 * (mw & 1) + a) + 4 * lq) = o[a][bq];
    }
#pragma unroll
    for (int dt = 0; dt < 2; ++dt)
#pragma unroll
        for (int e4 = 0; e4 < 4; ++e4) { v2u w; w.x = pk2(S[dt][e4][0], S[dt][e4][1]); w.y = pk2(S[dt][e4][2], S[dt][e4][3]);
            *(LAS v2u*)(lds + H3_ST + (16 * e4 + lr) * 272 + (16 * (2 * mw + dt) + 4 * lq) * 2) = w; }
}
__device__ __forceinline__ void hgrn3_unit(LAS unsigned char* lds, int unit, const bf16* Qb, const bf16* KFb, const bf16* KBb, const bf16* Vb, const float* LFb, const float* LBb,
                                           float* OFb, float* OBb, int tid, int lane, int wave) {
    Hg3 c;
    c.lds = lds; c.vh = unit & 1; c.dir = (unit >> 1) & 1; c.h = (unit >> 2) & 3; c.b = unit >> 4;
    c.Qb = Qb; c.Vb = Vb; c.Kp = c.dir ? KBb : KFb; c.Lp = c.dir ? LBb : LFb; c.Op = c.dir ? OBb : OFb;
    c.lane = lane; c.lr = lane & 15; c.lq = lane >> 4;
    constexpr int NCH = TT / 64;
    for (int i = tid; i < 64 * 272 / 16; i += NTHR) *(LAS v4u*)(lds + H3_ST + i * 16) = (v4u){0u, 0u, 0u, 0u};
    if (wave < 4) {
        const int pt = tid, pw = wave;
        pg8::bf16x8 U[4];
#pragma unroll
        for (int u = 0; u < 4; ++u) { const int kk = u >> 1, ti = u; unsigned wv[4];
#pragma unroll
            for (int j2 = 0; j2 < 4; ++j2) { const int s = 32 * kk + 8 * c.lq + 2 * j2, t = 16 * ti + c.lr; wv[j2] = (s <= t ? 0x3F80u : 0u) | (s + 1 <= t ? 0x3F800000u : 0u); }
            U[u] = (pg8::bf16x8)(v4u){wv[0], wv[1], wv[2], wv[3]}; }
        Hg3LV lv0, lv1; Hg3QK qk;
        hg3_load_lv(c, 0, pt, lv0); hg3_load_qk(c, 0, pw, qk); hg3_load_lv(c, 1, pt, lv1);
        asm volatile("s_waitcnt vmcnt(0)" ::: "memory"); H3_USE_LV(lv0); H3_USE_QK(qk); H3_USE_LV(lv1);
        hg3_prep_a(c, 0, pt, lv0);
        __syncthreads();
#define H3_TRIP(j_, LVN, LVC) do { \
            if ((j_) < NCH) { asm volatile("s_waitcnt vmcnt(10)" ::: "memory"); H3_USE_QK(qk); hg3_prep_b(c, (j_) & 1, pw, qk, U); \
                if ((j_) + 1 < NCH) hg3_load_qk(c, (j_) + 1, pw, qk); else hg3_load_qk(c, (j_), pw, qk);     \
                if ((j_) + 2 < NCH) hg3_load_lv(c, (j_) + 2, pt, LVC); else hg3_load_lv(c, (j_), pt, LVC); } \
            if (PROBE_DELAY == 2) probe_delay(100); \
            __syncthreads();                                                                    \
            if ((j_) + 1 < NCH) { asm volatile("s_waitcnt vmcnt(26)" ::: "memory"); H3_USE_LV(LVN); hg3_prep_a(c, ((j_) + 1) & 1, pt, LVN); } \
            __syncthreads();                                                                    \
        } while (0)
#pragma unroll 1
        for (int j = 0; j <= NCH; j += 2) { H3_TRIP(j, lv1, lv0); H3_TRIP(j + 1, lv0, lv1); }
#undef H3_TRIP
        asm volatile("s_waitcnt vmcnt(0)" ::: "memory");
    } else {
        const int mw = wave - 4;
        f32x4 S[2][4], o[2][2]; v2u vt[4][2][2];
#pragma unroll
        for (int a = 0; a < 2; ++a)
#pragma unroll
            for (int e4 = 0; e4 < 4; ++e4) S[a][e4] = (f32x4){0.f, 0.f, 0.f, 0.f};
        __syncthreads();
#pragma unroll 1
        for (int j = 0; j <= NCH + 1; ++j) {
            if (j > 0 && j <= NCH) hg3_stage1(c, (j - 1) & 1, mw, S, o, vt);
            if (PROBE_DELAY == 1) probe_delay(100);
            __syncthreads();
            if (j > 0 && j <= NCH) hg3_stage2(c, j - 1, mw, S, o, vt);
            __syncthreads();
        }
    }
    __syncthreads();
}


struct Hg4LV { f32x4 lf[4]; v4u v; };
struct Hg4QK { v2u q[4], k[4]; };
__device__ __forceinline__ void hg4_load_lv(const Hg3& c, int n, int tid, Hg4LV& in) {
    const size_t r = hg3_row(c, n, tid >> 3);
#pragma unroll
    for (int i = 0; i < 4; ++i) gld16(in.lf[i], c.Lp + r + 16 * (tid & 7) + 4 * i);
    gld16u(in.v, c.Vb + r + c.vh * 64 + 8 * (tid & 7));
}
__device__ __forceinline__ void hg4_load_qk(const Hg3& c, int n, int w, Hg4QK& in) {
#pragma unroll
    for (int ti = 0; ti < 4; ++ti) { const size_t r = hg3_row(c, n, 16 * ti + c.lr) + 16 * w + 4 * c.lq; gld8(in.q[ti], c.Qb + r); gld8(in.k[ti], c.Kp + r); }
}
#define H4_USE_LV(x) asm volatile("" : "+v"((x).lf[0]), "+v"((x).lf[1]), "+v"((x).lf[2]), "+v"((x).lf[3]), "+v"((x).v))
#define H4_USE_QK(x) asm volatile("" : "+v"((x).q[0]), "+v"((x).q[1]), "+v"((x).q[2]), "+v"((x).q[3]), "+v"((x).k[0]), "+v"((x).k[1]), "+v"((x).k[2]), "+v"((x).k[3]))
__device__ __forceinline__ void hg4_prep_a(const Hg3& c, int buf, int tid, const Hg4LV& in) {
    const int t = tid >> 3, dq = tid & 7;
#pragma unroll
    for (int i = 0; i < 4; ++i) { unsigned l0, l1; const unsigned h0 = hg3_hi_lo(in.lf[i].x, in.lf[i].y, l0), h1 = hg3_hi_lo(in.lf[i].z, in.lf[i].w, l1);
        *(LAS v2u*)(c.lds + H3_LH + t * 272 + (16 * dq + 4 * i) * 2) = (v2u){h0, h1}; *(LAS v2u*)(c.lds + H3_LL + t * 272 + (16 * dq + 4 * i) * 2) = (v2u){l0, l1}; }
    *(LAS v4u*)(c.lds + H3_V + buf * H3_BUFV + t * 144 + dq * 16) = in.v;
}
__device__ __forceinline__ void hg4_prep_b(const Hg3& c, int buf, int w, const Hg4QK& in, const pg8::bf16x8 (&U)[4]) {
    LAS unsigned char* lds = c.lds; const int lr = c.lr, lq = c.lq, lane = c.lane;
    const unsigned trrow = (unsigned)(8 * lq + ((lane & 15) >> 2)), trcol = (unsigned)(4 * (lane & 3));
    const pg8::bf16x8 ones = (pg8::bf16x8)(v4u){0x3F803F80u, 0x3F803F80u, 0x3F803F80u, 0x3F803F80u};
    v2u fh[2][2], fl[2][2];
    const unsigned ah = (unsigned)(size_t)(lds + H3_LH) + trrow * 272 + (16 * w + trcol) * 2, al = ah + (H3_LL - H3_LH);
    asm volatile("ds_read_b64_tr_b16 %0, %8\n\tds_read_b64_tr_b16 %1, %8 offset:1088\n\tds_read_b64_tr_b16 %2, %8 offset:8704\n\tds_read_b64_tr_b16 %3, %8 offset:9792\n\t"
                 "ds_read_b64_tr_b16 %4, %9\n\tds_read_b64_tr_b16 %5, %9 offset:1088\n\tds_read_b64_tr_b16 %6, %9 offset:8704\n\tds_read_b64_tr_b16 %7, %9 offset:9792\n\ts_waitcnt lgkmcnt(0)"
                 : "=&v"(fh[0][0]), "=&v"(fh[0][1]), "=&v"(fh[1][0]), "=&v"(fh[1][1]), "=&v"(fl[0][0]), "=&v"(fl[0][1]), "=&v"(fl[1][0]), "=&v"(fl[1][1]) : "v"(ah), "v"(al) : "memory");
    const pg8::bf16x8 H0 = mk_frag(fh[0][0], fh[0][1]), H1 = mk_frag(fh[1][0], fh[1][1]), L0 = mk_frag(fl[0][0], fl[0][1]), L1 = mk_frag(fl[1][0], fl[1][1]);
    f32x4 bt[4];
    const f32x4 z = (f32x4){0.f, 0.f, 0.f, 0.f};
    bt[0] = __builtin_amdgcn_mfma_f32_16x16x32_bf16(L0, U[0], z, 0, 0, 0);    bt[0] = __builtin_amdgcn_mfma_f32_16x16x32_bf16(H0, U[0], bt[0], 0, 0, 0);
    bt[1] = __builtin_amdgcn_mfma_f32_16x16x32_bf16(L0, U[1], z, 0, 0, 0);    bt[1] = __builtin_amdgcn_mfma_f32_16x16x32_bf16(H0, U[1], bt[1], 0, 0, 0);
    bt[2] = __builtin_amdgcn_mfma_f32_16x16x32_bf16(L0, ones, z, 0, 0, 0);    bt[2] = __builtin_amdgcn_mfma_f32_16x16x32_bf16(L1, U[2], bt[2], 0, 0, 0);
    bt[2] = __builtin_amdgcn_mfma_f32_16x16x32_bf16(H0, ones, bt[2], 0, 0, 0); bt[2] = __builtin_amdgcn_mfma_f32_16x16x32_bf16(H1, U[2], bt[2], 0, 0, 0);
    bt[3] = __builtin_amdgcn_mfma_f32_16x16x32_bf16(L0, ones, z, 0, 0, 0);    bt[3] = __builtin_amdgcn_mfma_f32_16x16x32_bf16(L1, U[3], bt[3], 0, 0, 0);
    bt[3] = __builtin_amdgcn_mfma_f32_16x16x32_bf16(H0, ones, bt[3], 0, 0, 0); bt[3] = __builtin_amdgcn_mfma_f32_16x16x32_bf16(H1, U[3], bt[3], 0, 0, 0);
    f32x4 de;
#pragma unroll
    for (int r = 0; r < 4; ++r) de[r] = __expf(__shfl(bt[3][r], 16 * lq + 15));
    if (lr == 0) *(LAS f32x4*)(lds + H3_DEC + buf * H3_BUFDEC + (16 * w + 4 * lq) * 4) = de;
#pragma unroll
    for (int ti = 0; ti < 4; ++ti) {
        const v2u qq = in.q[ti], kk = in.k[ti];
        const float e0 = __expf(bt[ti][0]), e1 = __expf(bt[ti][1]), e2 = __expf(bt[ti][2]), e3 = __expf(bt[ti][3]);
        v2u qo, ko;
        qo.x = pk2(bf2f(qq.x & 0xffffu) * e0, bf2f(qq.x >> 16) * e1); qo.y = pk2(bf2f(qq.y & 0xffffu) * e2, bf2f(qq.y >> 16) * e3);
        ko.x = pk2(bf2f(kk.x & 0xffffu) * __builtin_amdgcn_rcpf(e0), bf2f(kk.x >> 16) * __builtin_amdgcn_rcpf(e1));
        ko.y = pk2(bf2f(kk.y & 0xffffu) * __builtin_amdgcn_rcpf(e2), bf2f(kk.y >> 16) * __builtin_amdgcn_rcpf(e3));
        const int off = (16 * ti + lr) * 272 + (16 * w + 4 * lq) * 2;
        *(LAS v2u*)(lds + H3_QI + buf * H3_BUFD + off) = qo; *(LAS v2u*)(lds + H3_KK + buf * H3_BUFD + off) = ko;
    }
}
__device__ __forceinline__ void hg4_stage1(const Hg3& c, int buf, int w, f32x4 (&S)[4], f32x4 (&o)[2], v2u (&vt)[4][2][2]) {
    LAS unsigned char* lds = c.lds; const int lr = c.lr, lq = c.lq, lane = c.lane;
    const LAS unsigned char* QI = lds + H3_QI + buf * H3_BUFD; const LAS unsigned char* KK = lds + H3_KK + buf * H3_BUFD;
    const unsigned trrow = (unsigned)(8 * lq + ((lane & 15) >> 2)), trcol = (unsigned)(4 * (lane & 3));
    const unsigned kk_tr = (unsigned)(size_t)KK + trrow * 272 + (16 * w + trcol) * 2;
    const unsigned v_tr = (unsigned)(size_t)(lds + H3_V + buf * H3_BUFV) + trrow * 144 + trcol * 2;
    v2u kt[2][2];
    asm volatile("ds_read_b64_tr_b16 %0, %4\n\tds_read_b64_tr_b16 %1, %4 offset:1088\n\tds_read_b64_tr_b16 %2, %4 offset:8704\n\tds_read_b64_tr_b16 %3, %4 offset:9792"
                 : "=&v"(kt[0][0]), "=&v"(kt[0][1]), "=&v"(kt[1][0]), "=&v"(kt[1][1]) : "v"(kk_tr) : "memory");
#define H4_VTR(e4, o0, o1, o2, o3) asm volatile("ds_read_b64_tr_b16 %0, %4 offset:" #o0 "\n\tds_read_b64_tr_b16 %1, %4 offset:" #o1 "\n\tds_read_b64_tr_b16 %2, %4 offset:" #o2 "\n\tds_read_b64_tr_b16 %3, %4 offset:" #o3 \
                 : "=&v"(vt[e4][0][0]), "=&v"(vt[e4][0][1]), "=&v"(vt[e4][1][0]), "=&v"(vt[e4][1][1]) : "v"(v_tr) : "memory")
    H4_VTR(0, 0, 576, 4608, 5184); H4_VTR(1, 32, 608, 4640, 5216); H4_VTR(2, 64, 640, 4672, 5248); H4_VTR(3, 96, 672, 4704, 5280);
#undef H4_VTR
    const int ei = w & 3, tp = w >> 2;
    {
        const int ti = w & 3;
#pragma unroll
        for (int sii = 0; sii < 2; ++sii) {
            const int si = tp * 2 + sii;
            v2u wv = (v2u){0u, 0u};
            if (si <= ti) {
                f32x4 a = (f32x4){0.f, 0.f, 0.f, 0.f};
#pragma unroll
                for (int kk = 0; kk < 4; ++kk)
                    a = __builtin_amdgcn_mfma_f32_16x16x32_bf16(lds_frag(KK + (16 * si + lr) * 272 + kk * 64 + lq * 16), lds_frag(QI + (16 * ti + lr) * 272 + kk * 64 + lq * 16), a, 0, 0, 0);
                const int s0 = 16 * si + 4 * lq, t = 16 * ti + lr;
                wv.x = pk2(s0 + 0 <= t ? a[0] : 0.f, s0 + 1 <= t ? a[1] : 0.f); wv.y = pk2(s0 + 2 <= t ? a[2] : 0.f, s0 + 3 <= t ? a[3] : 0.f);
            }
            *(LAS v2u*)(lds + H3_AM + (16 * ti + lr) * 144 + (16 * si + 4 * lq) * 2) = wv;
        }
    }
#pragma unroll
    for (int tt = 0; tt < 2; ++tt) o[tt] = (f32x4){0.f, 0.f, 0.f, 0.f};
#pragma unroll
    for (int kk = 0; kk < 4; ++kk) {
        const pg8::bf16x8 sfr = lds_frag(lds + H3_ST + (16 * ei + lr) * 272 + kk * 64 + lq * 16);
#pragma unroll
        for (int tt = 0; tt < 2; ++tt) o[tt] = __builtin_amdgcn_mfma_f32_16x16x32_bf16(sfr, lds_frag(QI + (16 * (2 * tp + tt) + lr) * 272 + kk * 64 + lq * 16), o[tt], 0, 0, 0);
    }
    asm volatile("s_waitcnt lgkmcnt(0)"
                 : "+v"(kt[0][0]), "+v"(kt[0][1]), "+v"(kt[1][0]), "+v"(kt[1][1]),
                   "+v"(vt[0][0][0]), "+v"(vt[0][0][1]), "+v"(vt[0][1][0]), "+v"(vt[0][1][1]), "+v"(vt[1][0][0]), "+v"(vt[1][0][1]), "+v"(vt[1][1][0]), "+v"(vt[1][1][1]),
                   "+v"(vt[2][0][0]), "+v"(vt[2][0][1]), "+v"(vt[2][1][0]), "+v"(vt[2][1][1]), "+v"(vt[3][0][0]), "+v"(vt[3][0][1]), "+v"(vt[3][1][0]), "+v"(vt[3][1][1]) :: "memory");
#pragma unroll
    for (int kk = 0; kk < 2; ++kk) {
        const pg8::bf16x8 af = mk_frag(kt[kk][0], kt[kk][1]);
#pragma unroll
        for (int e4 = 0; e4 < 4; ++e4) S[e4] = __builtin_amdgcn_mfma_f32_16x16x32_bf16(af, mk_frag(vt[e4][kk][0], vt[e4][kk][1]), S[e4], 0, 0, 0);
    }
    const f32x4 dv = *(const LAS f32x4*)(lds + H3_DEC + buf * H3_BUFDEC + (16 * w + 4 * lq) * 4);
#pragma unroll
    for (int e4 = 0; e4 < 4; ++e4) S[e4] = S[e4] * dv;
}
__device__ __forceinline__ void hg4_stage2(const Hg3& c, int n, int w, const f32x4 (&S)[4], f32x4 (&o)[2], const v2u (&vt)[4][2][2]) {
    LAS unsigned char* lds = c.lds; const int lr = c.lr, lq = c.lq;
    const int ei = w & 3, tp = w >> 2;
    const pg8::bf16x8 vf0 = ei == 0 ? mk_frag(vt[0][0][0], vt[0][0][1]) : ei == 1 ? mk_frag(vt[1][0][0], vt[1][0][1]) : ei == 2 ? mk_frag(vt[2][0][0], vt[2][0][1]) : mk_frag(vt[3][0][0], vt[3][0][1]);
    const pg8::bf16x8 vf1 = ei == 0 ? mk_frag(vt[0][1][0], vt[0][1][1]) : ei == 1 ? mk_frag(vt[1][1][0], vt[1][1][1]) : ei == 2 ? mk_frag(vt[2][1][0], vt[2][1][1]) : mk_frag(vt[3][1][0], vt[3][1][1]);
#pragma unroll
    for (int tt = 0; tt < 2; ++tt) {
        const int ti = 2 * tp + tt;
        o[tt] = __builtin_amdgcn_mfma_f32_16x16x32_bf16(vf0, lds_frag(lds + H3_AM + (16 * ti + lr) * 144 + 0 * 64 + lq * 16), o[tt], 0, 0, 0);
        o[tt] = __builtin_amdgcn_mfma_f32_16x16x32_bf16(vf1, lds_frag(lds + H3_AM + (16 * ti + lr) * 144 + 1 * 64 + lq * 16), o[tt], 0, 0, 0);
        *(f32x4*)(c.Op + hg3_row(c, n, 16 * ti + lr) + c.vh * 64 + 16 * ei + 4 * lq) = o[tt];
    }
#pragma unroll
    for (int e4 = 0; e4 < 4; ++e4) { v2u wv; wv.x = pk2(S[e4][0], S[e4][1]); wv.y = pk2(S[e4][2], S[e4][3]); *(LAS v2u*)(lds + H3_ST + (16 * e4 + lr) * 272 + (16 * w + 4 * lq) * 2) = wv; }
}
__device__ __forceinline__ void hgrn4_unit(LAS unsigned char* lds, int unit, const bf16* Qb, const bf16* KFb, const bf16* KBb, const bf16* Vb, const float* LFb, const float* LBb,
                                           float* OFb, float* OBb, int tid, int lane, int wave) {
    Hg3 c;
    c.lds = lds; c.vh = unit & 1; c.dir = (unit >> 1) & 1; c.h = (unit >> 2) & 3; c.b = unit >> 4;
    c.Qb = Qb; c.Vb = Vb; c.Kp = c.dir ? KBb : KFb; c.Lp = c.dir ? LBb : LFb; c.Op = c.dir ? OBb : OFb;
    c.lane = lane; c.lr = lane & 15; c.lq = lane >> 4;
    constexpr int NCH = TT / 64;
    const int w = wave;
    for (int i = tid; i < 64 * 272 / 16; i += NTHR) *(LAS v4u*)(lds + H3_ST + i * 16) = (v4u){0u, 0u, 0u, 0u};
    pg8::bf16x8 U[4];
#pragma unroll
    for (int u = 0; u < 4; ++u) { const int kk = u >> 1, ti = u; unsigned wv[4];
#pragma unroll
        for (int j2 = 0; j2 < 4; ++j2) { const int sN = 32 * kk + 8 * c.lq + 2 * j2, t = 16 * ti + c.lr; wv[j2] = (sN <= t ? 0x3F80u : 0u) | (sN + 1 <= t ? 0x3F800000u : 0u); }
        U[u] = (pg8::bf16x8)(v4u){wv[0], wv[1], wv[2], wv[3]}; }
    f32x4 S[4], o[2]; v2u vt[4][2][2];
#pragma unroll
    for (int e4 = 0; e4 < 4; ++e4) S[e4] = (f32x4){0.f, 0.f, 0.f, 0.f};
    Hg4LV lv0, lv1; Hg4QK qk;
    hg4_load_lv(c, 0, tid, lv0); hg4_load_qk(c, 0, w, qk); hg4_load_lv(c, 1, tid, lv1);
    asm volatile("s_waitcnt vmcnt(0)" ::: "memory"); H4_USE_LV(lv0); H4_USE_QK(qk); H4_USE_LV(lv1);
    hg4_prep_a(c, 0, tid, lv0);
    __syncthreads();
#define H4_TRIP(j_, LVN, LVC) do { \
        if ((j_) < NCH) { asm volatile("s_waitcnt vmcnt(5)" ::: "memory"); H4_USE_QK(qk); hg4_prep_b(c, (j_) & 1, w, qk, U); \
            hg4_load_qk(c, (j_) + 1 < NCH ? (j_) + 1 : (j_), w, qk); hg4_load_lv(c, (j_) + 2 < NCH ? (j_) + 2 : (j_), tid, LVC); }     \
        if ((j_) > 0 && (j_) <= NCH) hg4_stage1(c, ((j_) - 1) & 1, w, S, o, vt); \
        if (PROBE_DELAY == 5) probe_delay(100); \
        __syncthreads();                                                                        \
        if ((j_) + 1 < NCH) { asm volatile("s_waitcnt vmcnt(13)" ::: "memory"); H4_USE_LV(LVN); hg4_prep_a(c, ((j_) + 1) & 1, tid, LVN); } \
        if ((j_) > 0 && (j_) <= NCH) hg4_stage2(c, (j_) - 1, w, S, o, vt); \
        __syncthreads();                                                                        \
    } while (0)
#pragma unroll 1
    for (int j = 0; j <= NCH; j += 2) { H4_TRIP(j, lv1, lv0); H4_TRIP(j + 1, lv0, lv1); }
#undef H4_TRIP
    asm volatile("s_waitcnt vmcnt(0)" ::: "memory");
    __syncthreads();
}

#endif
#if defined(HGRN_V2)
#define HGRN_FN hgrn_unit
#elif defined(HGRN_V3)
#define HGRN_FN hgrn3_unit
#else
#define HGRN_FN hgrn4_unit
#endif
#define W1_ITEM(r_) do { const int r__ = (r_); const int e__ = r__ >> 10; p0_item<true>(w1 + (size_t)e__ * D * 2 * FF, D, 2 * FF, W1T + (size_t)e__ * 2 * FF * D, RmW1(), scr, r__ & 1023, lane); } while (0)

struct Args { const float* in[18]; float* out; unsigned char* ws; int ph_lo, ph_hi; };
__global__ void __launch_bounds__(NTHR, 2) fwd_kernel(Args args) {
    extern __shared__ __attribute__((aligned(16))) unsigned char lds_raw[];
    LAS unsigned char* lds = (LAS unsigned char*)lds_raw;
    volatile LAS unsigned* MISC = (volatile LAS unsigned*)(lds + MISC_OFF);
    const int tid = threadIdx.x, lane = tid & 63, wave = __builtin_amdgcn_readfirstlane(tid >> 6);
    const int G = gridDim.x; const int bx = blockIdx.x; const int vcu = (G % 8 == 0) ? (bx % 8) * (G / 8) + bx / 8 : bx;
    const int gw = vcu * NWAVES + wave, NGW = G * NWAVES;
    unsigned char* ws = args.ws;
    unsigned* ctl = (unsigned*)(ws + WS_CTL);
    const float* x = args.in[0]; const float* norm1_w = args.in[1]; const float* w_in = args.in[2]; const float* lb_logits = args.in[3];
    const float* hgrn_norm_w = args.in[4]; const float* dw_w = args.in[5]; const float* dw_b = args.in[6]; const float* conv_ln_w = args.in[7]; const float* conv_ln_b = args.in[8];
    const float* w_out = args.in[9]; const float* norm2_w = args.in[10]; const float* router_w = args.in[11]; const float* router_b = args.in[12];
    const float* w1 = args.in[13]; const float* b1 = args.in[14]; const float* w2 = args.in[15]; const float* b2 = args.in[16]; const float* final_norm_w = args.in[17];
    float* out = args.out;
    bf16* WI = (bf16*)(ws + WS_WI); bf16* WO = (bf16*)(ws + WS_WO); unsigned char* W1T = ws + WS_W1; unsigned char* W2T = ws + WS_W2;
    float* H = (float*)(ws + WS_H); bf16* XN = (bf16*)(ws + WS_XN);
    bf16* Qb = (bf16*)(ws + WS_Q); bf16* KFb = (bf16*)(ws + WS_KF); bf16* KBb = (bf16*)(ws + WS_KB); bf16* Vb = (bf16*)(ws + WS_V); bf16* Gb = (bf16*)(ws + WS_G); bf16* Ub = (bf16*)(ws + WS_U);
    float* LFb = (float*)(ws + WS_LF); float* LBb = (float*)(ws + WS_LB); float* OFb = (float*)(ws + WS_OF); float* OBb = (float*)(ws + WS_OB);
    bf16* MIX = (bf16*)(ws + WS_MIX); unsigned char* XS = ws + WS_XS; unsigned char* ACT = ws + WS_ACT; unsigned char* N2 = ws + WS_XN; unsigned char* YS = ws + WS_YS;
    float* WRT = (float*)(ws + WS_WRT); int* SLOT = (int*)(ws + WS_SLOT); float* GATE = (float*)(ws + WS_GATE); int* ROWTOK = (int*)(ws + WS_ROWTOK);
    volatile LAS int* bs = (volatile LAS int*)(lds + TAB_OFF);
    volatile LAS int* cl = (volatile LAS int*)(lds + TAB_OFF + 256);
    LAS int* lcnt = (LAS int*)(lds + TAB_OFF + 512);
    volatile LAS int* gbase = (volatile LAS int*)(lds + TAB_OFF + 768);

    for (int u = tid; u < (LDS_BYTES - LDSCTL_OFF) / 4; u += NTHR) ((LAS unsigned*)(lds + LDSCTL_OFF))[u] = 0u;
    __syncthreads();
    XcdBarrier bar; bar.bar = ctl + CW_BAR; bar.x = 0; bar.st = nullptr;
    if (MK_N_LAUNCHES == 1) bar = xcd_barrier_post(ctl + CW_BAR, MISC + 8);
#ifndef PROBE_STAMP
#define PROBE_STAMP -1
#endif
    unsigned long long tS[N_PHASES + 1];
#define STAMP(k) do { if ((PROBE_STAMP) >= 0) tS[k] = __builtin_amdgcn_s_memrealtime(); } while (0)
    const int lo = args.ph_lo, hi = args.ph_hi;
#ifndef PHASE_MASK
#define PHASE_MASK 0xffffffffu
#endif
#define IN(k) ((((PHASE_MASK) >> (k)) & 1u) && lo <= (k) && (k) < hi)
#ifndef PROBE_DUP
#define PROBE_DUP -1
#endif
#define REP(k) _Pragma("unroll 1") for (int rep_ = 0; rep_ < ((PROBE_DUP) == (k) ? 2 + (args.ph_hi >> 20) : 1); ++rep_)
#define SEAM(k) do { if (IN(k) && IN((k) + 1)) { xcd_barrier(bar); if ((PROBE_DUP) == 99) { xcd_barrier(bar); xcd_barrier(bar); } } } while (0)
#define BUILD_BS() do { int t_; asm volatile("v_mov_b32 %0, %1" : "=v"(t_) : "v"(tid));     \
        if (t_ < 64) { const int c_ = t_ < NE ? (int)__hip_atomic_load(ctl + CW_CNT + 64 * (t_ & (NE - 1)), RLX_AGENT) : 0; int x_ = (c_ + 255) >> 8; \
        _Pragma("unroll") for (int o_ = 1; o_ < NE; o_ <<= 1) { const int y_ = __shfl_up(x_, o_); if ((t_ & 63) >= o_) x_ += y_; }     \
        if (t_ < NE) { cl[t_] = c_; bs[t_ + 1] = x_; } if (t_ == 0) bs[0] = 0; } __syncthreads(); } while (0)

    STAMP(0);
    if (IN(0)) REP(0) {
        LAS float* scr = (LAS float*)(lds + RING_OFF + wave * 16384);
        constexpr int I_WI = (D / 64) * (INC / 32), I_WO = (D / 64) * (D / 32), I_W1 = (D / 64) * (2 * FF / 32), I_W2 = (FF / 64) * (D / 32);
        #if defined(HGRN_NAIVE) || defined(W2_IN_P0)
        constexpr int NITEMS = I_WI + I_WO + NE * I_W1 + NE * I_W2;
#else
        constexpr int NITEMS = I_WI + I_WO + W1_P0;
#endif
        {
            const f32x4* wr = (const f32x4*)norm1_w + lane; f32x4 gw4[4];
#pragma unroll
            for (int j = 0; j < 4; ++j) gw4[j] = wr[64 * j];
#pragma unroll 1
            for (int m0 = gw; m0 < MTOK; m0 += 4 * NGW) {
                f32x4 v[4][4];
#pragma unroll
                for (int q4 = 0; q4 < 4; ++q4) { const int m = min(m0 + q4 * NGW, MTOK - 1); const f32x4* xr = (const f32x4*)(x + (size_t)m * D) + lane;
#pragma unroll
                    for (int j = 0; j < 4; ++j) v[q4][j] = xr[64 * j]; }
#pragma unroll
                for (int q4 = 0; q4 < 4; ++q4) { const int m = m0 + q4 * NGW; float sq = 0.f;
#pragma unroll
                    for (int j = 0; j < 4; ++j) sq += (v[q4][j].x * v[q4][j].x + v[q4][j].y * v[q4][j].y) + (v[q4][j].z * v[q4][j].z + v[q4][j].w * v[q4][j].w);
                    const float rstd = rsqrtf(wave_sum(sq) * (1.f / D) + EPS);
                    if (m < MTOK) { v2u* o8 = (v2u*)(XN + (size_t)m * D) + lane;
#pragma unroll
                        for (int j = 0; j < 4; ++j) { v2u o; o.x = pk2(v[q4][j].x * rstd * gw4[j].x, v[q4][j].y * rstd * gw4[j].y); o.y = pk2(v[q4][j].z * rstd * gw4[j].z, v[q4][j].w * rstd * gw4[j].w); o8[64 * j] = o; } }
                }
            }
        }
#if defined(HGRN_NAIVE) || defined(W2_IN_P0)
        for (int it = gw; it < NITEMS; it += NGW) {
            int r = it;
            if (r < I_WI) { p0_item<false>(w_in, D, INC, WI, RmWin(), scr, r, lane); continue; } r -= I_WI;
            if (r < I_WO) { p0_item<false>(w_out, D, D, WO, RmIdent(), scr, r, lane); continue; } r -= I_WO;
            if (r < NE * I_W1) { W1_ITEM(r); continue; } r -= NE * I_W1;
            { const int e = r / I_W2; p0_item<true>(w2 + (size_t)e * FF * D, FF, D, W2T + (size_t)e * D * FF, RmIdent(), scr, r - e * I_W2, lane); }
        }
#else
        (void)NITEMS; (void)I_W2;
        for (int it = gw; it < I_WI + I_WO; it += NGW) { if (it < I_WI) p0_item<false>(w_in, D, INC, WI, RmWin(), scr, it, lane); else p0_item<false>(w_out, D, D, WO, RmIdent(), scr, it - I_WI, lane); }
        convert_slice_fp8(w1, D, 2 * FF, W1T, RmW1(), 10, gw, NGW, W1_P0, 0, scr, lane);
#endif
        if ((PROBE_STAMP) == 640) tS[6] = __builtin_amdgcn_s_memrealtime();
        for (int i = bx * NTHR + tid; i < 16 * D; i += G * NTHR) {
            const int r = i >> 4, e16 = i & 15, k = 256 * (r & 3) + (r >> 2); const float gk = norm2_w[k];
            WRT[2 * i] = gk * router_w[k * NE + e16]; WRT[2 * i + 1] = gk * router_w[k * NE + 16 + e16]; }
    }
    if ((PROBE_STAMP) == 600 + 0) tS[6] = __builtin_amdgcn_s_memrealtime();
    SEAM(0);

    STAMP(1);
    if (IN(1)) REP(1) {
        pg8::Gemm g{XN, WI, MTOK, INC, D}; OrderRep S; S.init(MTOK, INC, G, bx); S.reps = ((PROBE_DUP) == 11) ? 2 : 1;
        EpiProj E{Qb, KFb, KBb, Vb, Gb, Ub, LFb, LBb, lb_logits};
        pg8::gemm_phase<EpiProj, OrderRep, true, true>(lds + RING_OFF, g, S, E);
#if !defined(HGRN_NAIVE) && !defined(W2_IN_P0)
        {
            LAS float* scr = (LAS float*)(lds + RING_OFF + wave * 16384);
            if (G == 256) { if (bx >= 128) convert_slice_fp8(w1, D, 2 * FF, W1T, RmW1(), 10, (bx - 128) * NWAVES + wave, 128 * NWAVES, W1_P1, W1_P0, scr, lane); }
            else convert_slice_fp8(w1, D, 2 * FF, W1T, RmW1(), 10, gw, NGW, W1_P1, W1_P0, scr, lane);
        }
#endif
    }
    if ((PROBE_STAMP) == 600 + 1) tS[6] = __builtin_amdgcn_s_memrealtime();
    SEAM(1);

    STAMP(2);
    if (IN(2)) REP(2) {
        const bool split = (G == 256);
#if defined(HGRN_NAIVE)
        const bool hsel = true; const int hidx = 0, hstride = 1; const bool csel = true; const int cidx = vcu, cstride = G;
#else
        const bool hsel = split ? (((bx >> 3) & 1) != 0) : true; const int hidx = split ? (bx >> 4) * 8 + (bx & 7) : bx, hstride = split ? 128 : G;
        const bool csel = split ? !hsel : true; const int cidx = split ? (bx >> 4) * 8 + (bx & 7) : bx, cstride = split ? 128 : G;
#endif
        (void)hidx; (void)hstride;
        if (csel && PROBE_DELAY == 3) probe_delay(3000); if (csel && PROBE_DELAY == 4) probe_delay(20000);
        if (csel) for (int crep_ = 0; crep_ < ((PROBE_DUP) == 21 ? 2 : 1); ++crep_) {
            LAS unsigned short* ut = (LAS unsigned short*)(lds + RING_OFF);
            LAS float* part = (LAS float*)(lds + RING_OFF + 98304);
            LAS float* stat = (LAS float*)(lds + RING_OFF + 98304 + 4096);
            for (int unit = cidx; unit < NBATCH * (TT / 64); unit += cstride) {
                const int b = unit / (TT / 64), t0 = (unit % (TT / 64)) * 64;
                {
                    v4u val[12];
#pragma unroll
                    for (int i = 0; i < 12; ++i) { const int idx = tid + NTHR * i, r = idx >> 6, p = idx & 63, t = t0 - 15 + r;
                        val[i] = (v4u){0u, 0u, 0u, 0u};
                        if (idx < 94 * 64 && t >= 0 && t < TT) val[i] = *(const v4u*)(Ub + (size_t)(b * TT + t) * CCH + p * 8); }
#pragma unroll
                    for (int i = 0; i < 12; ++i) { const int idx = tid + NTHR * i, r = idx >> 6, p = idx & 63;
                        if (idx < 94 * 64) *(LAS v4u*)(ut + r * 512 + p * 8) = val[i]; }
                }
                __syncthreads(); if ((PROBE_STAMP) == 651 && unit == cidx) tS[6] = __builtin_amdgcn_s_memrealtime();
                const int c = tid;
                float w[CLEN];
#pragma unroll
                for (int j = 0; j < CLEN; ++j) w[j] = dw_w[j * CCH + c];
                const float bias = dw_b[c];
                float y[64];
#pragma unroll
                for (int tb = 0; tb < 8; ++tb) {
                    float win[38];
#pragma unroll
                    for (int i = 0; i < 38; ++i) win[i] = bf2f(ut[(tb * 8 + i) * 512 + c]);
#pragma unroll
                    for (int o = 0; o < 8; ++o) { float a = bias;
#pragma unroll
                        for (int j = 0; j < CLEN; ++j) a += w[j] * win[o + j];
                        y[tb * 8 + o] = a; }
                }
#pragma unroll 1
                for (int pass = 0; pass < 2; ++pass) {
                    float s1[64];
#pragma unroll
                    for (int i = 0; i < 64; ++i) s1[i] = pass ? y[i] * y[i] : y[i];
#pragma unroll
                    for (int s = 32; s >= 1; s >>= 1) {
                        const bool up = (lane & s) != 0;
#pragma unroll
                        for (int i = 0; i < s; ++i) { const float k1 = up ? s1[i + s] : s1[i], x1 = up ? s1[i] : s1[i + s]; s1[i] = k1 + __shfl_xor(x1, s); }
                    }
                    part[(wave * 64 + lane) * 2 + pass] = s1[0];
                }
                __syncthreads(); if ((PROBE_STAMP) == 652 && unit == cidx) tS[6] = __builtin_amdgcn_s_memrealtime();
                if (tid < 64) { float a = 0.f, q = 0.f;
#pragma unroll
                    for (int wv = 0; wv < 8; ++wv) { a += part[(wv * 64 + tid) * 2]; q += part[(wv * 64 + tid) * 2 + 1]; }
                    const float mean = a * (1.f / CCH), var = q * (1.f / CCH) - mean * mean;
                    stat[tid * 2] = mean; stat[tid * 2 + 1] = rsqrtf(fmaxf(var, 0.f) + EPS); }
                __syncthreads();
                const float lw = conv_ln_w[c], lbias = conv_ln_b[c];
#pragma unroll
                for (int t = 0; t < 64; ++t) {
                    const float v = (y[t] - stat[t * 2]) * stat[t * 2 + 1] * lw + lbias;
                    MIX[(size_t)(b * TT + t0 + t) * D + 512 + c] = (bf16)(pk2(v * sigm(v), 0.f) & 0xffffu);
                }
                __syncthreads(); if ((PROBE_STAMP) == 653 && unit == cidx) tS[6] = __builtin_amdgcn_s_memrealtime();
            }
            if ((PROBE_STAMP) == 650) tS[6] = __builtin_amdgcn_s_memrealtime();
#if !defined(HGRN_NAIVE) && !defined(W2_IN_P0)
            {
                LAS float* scr = (LAS float*)(lds + RING_OFF + wave * 16384);
                constexpr int I_W2 = (FF / 64) * (D / 32);
                convert_slice_fp8(w2, FF, D, W2T, RmIdent(), 9, cidx * NWAVES + wave, cstride * NWAVES, W2_P2, 0, scr, lane);
                convert_slice_fp8(w1, D, 2 * FF, W1T, RmW1(), 10, cidx * NWAVES + wave, cstride * NWAVES, W1_P2, W1_P0 + W1_P1, scr, lane);
            }
#endif
        }
#if defined(HGRN_NAIVE)
        {
            LAS float* qs = (LAS float*)(lds + RING_OFF); LAS float* ks = qs + 2048; LAS float* fs = ks + 2048; LAS float* vs = fs + 2048; LAS float* op = vs + 2048;
            const int e = tid & 127, dq = tid >> 7;
            for (int unit = G - 1 - bx; unit < NBATCH * NH * 2; unit += G) {
                const int dir = unit & 1, h = (unit >> 1) & 3, b = unit >> 3;
                const bf16* Kp = dir ? KBb : KFb; const float* Lp = dir ? LBb : LFb; float* Op = dir ? OBb : OFb;
                float S[32];
#pragma unroll
                for (int i = 0; i < 32; ++i) S[i] = 0.f;
                for (int blk = 0; blk < TT / 16; ++blk) {
                    const int tb = dir ? (TT - 16 - blk * 16) : blk * 16;
#pragma unroll
                    for (int i = 0; i < 4; ++i) { const int idx = tid + NTHR * i, r = idx >> 7, d = idx & 127; const size_t off = (size_t)(b * TT + tb + r) * 512 + h * 128 + d;
                        qs[idx] = bf2f(Qb[off]); ks[idx] = bf2f(Kp[off]); fs[idx] = __expf(Lp[off]); vs[idx] = bf2f(Vb[off]); }
                    __syncthreads();
                    for (int st = 0; st < 16; ++st) {
                        const int r = dir ? 15 - st : st; const float v = vs[r * 128 + e]; float o = 0.f;
#pragma unroll
                        for (int dd = 0; dd < 32; ++dd) { const int d = dq * 32 + dd; S[dd] = fs[r * 128 + d] * S[dd] + ks[r * 128 + d] * v; o += qs[r * 128 + d] * S[dd]; }
                        op[(r * 4 + dq) * 128 + e] = o;
                    }
                    __syncthreads();
#pragma unroll
                    for (int i = 0; i < 4; ++i) { const int idx = tid + NTHR * i, r = idx >> 7, ee = idx & 127;
                        Op[(size_t)(b * TT + tb + r) * 512 + h * 128 + ee] = (op[(r * 4 + 0) * 128 + ee] + op[(r * 4 + 1) * 128 + ee]) + (op[(r * 4 + 2) * 128 + ee] + op[(r * 4 + 3) * 128 + ee]); }
                }
                __syncthreads();
            }
        }
#else
        if (hsel) for (int unit = hidx; unit < NBATCH * NH * 4 * ((PROBE_DUP) == 20 ? 2 : 1); unit += hstride) HGRN_FN(lds + RING_OFF, unit & (NBATCH * NH * 4 - 1), Qb, KFb, KBb, Vb, LFb, LBb, OFb, OBb, tid, lane, wave);
#endif
    }
    if ((PROBE_STAMP) == 600 + 2) tS[6] = __builtin_amdgcn_s_memrealtime();
    SEAM(2);

    STAMP(3);
    if (IN(3)) REP(3) {
        for (int m = gw; m < MTOK; m += NGW) {
            const size_t off = (size_t)m * 512 + lane * 8;
#if defined(HGRN_V2)
            const v4u ua = *(const v4u*)((const bf16*)OFb + off), uc = *(const v4u*)((const bf16*)OBb + off);
            const f32x4 a0 = (f32x4){bf2f(ua.x & 0xffffu), bf2f(ua.x >> 16), bf2f(ua.y & 0xffffu), bf2f(ua.y >> 16)}, a1 = (f32x4){bf2f(ua.z & 0xffffu), bf2f(ua.z >> 16), bf2f(ua.w & 0xffffu), bf2f(ua.w >> 16)};
            const f32x4 c0 = (f32x4){bf2f(uc.x & 0xffffu), bf2f(uc.x >> 16), bf2f(uc.y & 0xffffu), bf2f(uc.y >> 16)}, c1 = (f32x4){bf2f(uc.z & 0xffffu), bf2f(uc.z >> 16), bf2f(uc.w & 0xffffu), bf2f(uc.w >> 16)};
#else
            const f32x4 a0 = *(const f32x4*)(OFb + off), a1 = *(const f32x4*)(OFb + off + 4), c0 = *(const f32x4*)(OBb + off), c1 = *(const f32x4*)(OBb + off + 4);
#endif
            const f32x4 o0 = a0 + c0, o1 = a1 + c1;
            float ss = (o0.x * o0.x + o0.y * o0.y) + (o0.z * o0.z + o0.w * o0.w) + (o1.x * o1.x + o1.y * o1.y) + (o1.z * o1.z + o1.w * o1.w);
            ss += __shfl_xor(ss, 1); ss += __shfl_xor(ss, 2); ss += __shfl_xor(ss, 4); ss += __shfl_xor(ss, 8);
            const float rstd = rsqrtf(ss * (1.f / DV) + EPS);
            const v4u gv = *(const v4u*)(Gb + off);
            const f32x4 w0 = *(const f32x4*)(hgrn_norm_w + lane * 8), w1v = *(const f32x4*)(hgrn_norm_w + lane * 8 + 4);
            f32x4 r0, r1;
            r0.x = o0.x * rstd * w0.x * bf2f(gv.x & 0xffffu); r0.y = o0.y * rstd * w0.y * bf2f(gv.x >> 16);
            r0.z = o0.z * rstd * w0.z * bf2f(gv.y & 0xffffu); r0.w = o0.w * rstd * w0.w * bf2f(gv.y >> 16);
            r1.x = o1.x * rstd * w1v.x * bf2f(gv.z & 0xffffu); r1.y = o1.y * rstd * w1v.y * bf2f(gv.z >> 16);
            r1.z = o1.z * rstd * w1v.z * bf2f(gv.w & 0xffffu); r1.w = o1.w * rstd * w1v.w * bf2f(gv.w >> 16);
            st8bf(MIX + (size_t)m * D + lane * 8, r0, r1);
        }
    }
    if ((PROBE_STAMP) == 600 + 3) tS[6] = __builtin_amdgcn_s_memrealtime();
    SEAM(3);

    STAMP(4);
    if (IN(4)) REP(4) {
        pg8::Gemm g{MIX, WO, MTOK, D, D}; pg8::StaticOrder S; S.init(MTOK, D, G, bx);
        EpiRes E{x, H};
        pg8::gemm_phase<EpiRes, pg8::StaticOrder, true, true>(lds + RING_OFF, g, S, E);
    }
    if ((PROBE_STAMP) == 600 + 4) tS[6] = __builtin_amdgcn_s_memrealtime();
    SEAM(4);

    STAMP(5);
    if (IN(5)) REP(5) {
        typedef float f32x2 __attribute__((ext_vector_type(2)));
        LAS float* wl = (LAS float*)(lds + RING_OFF);
        LAS unsigned* sb = (LAS unsigned*)(lds + SB_OFF);
        { f32x4 tv_[NE * D / 4 / NTHR];
#pragma unroll
            for (int i = 0; i < NE * D / 4 / NTHR; ++i) tv_[i] = ((const f32x4*)WRT)[tid + NTHR * i];
#pragma unroll
            for (int i = 0; i < NE * D / 4 / NTHR; ++i) ((LAS f32x4*)wl)[tid + NTHR * i] = tv_[i]; }
        if (tid < NE) lcnt[tid] = 0;
        __syncthreads();
        for (int tg = vcu; tg < MTOK / 64; tg += G) {
            const int tok0 = tg * 64 + 16 * (wave & 3);
            if (wave < 4) {
                const int j = lane & 15, q = lane >> 4;
                const f32x4* hrow = (const f32x4*)(H + (size_t)(tok0 + j) * D + 256 * q);
                const LAS f32x2* tab = (const LAS f32x2*)wl + q * 16 + j;
                f32x4 acc0 = (f32x4){0.f, 0.f, 0.f, 0.f}, acc1 = acc0; float ss = 0.f;
                f32x4 hb[8], hn[8];
#pragma unroll
                for (int i = 0; i < 8; ++i) hb[i] = hrow[i];
#pragma unroll 1
                for (int blk = 0; blk < 8; ++blk) {
                    if (blk + 1 < 8) {
#pragma unroll
                        for (int i = 0; i < 8; ++i) hn[i] = hrow[(blk + 1) * 8 + i];
                    }
#pragma unroll
                    for (int i = 0; i < 8; ++i) {
                        const f32x4 hc = hb[i]; const int s4 = blk * 8 + i;
                        f32x2 w[4];
#pragma unroll
                        for (int u = 0; u < 4; ++u) w[u] = tab[(4 * s4 + u) * 64];
                        ss += (hc.x * hc.x + hc.y * hc.y) + (hc.z * hc.z + hc.w * hc.w);
#pragma unroll
                        for (int u = 0; u < 4; ++u) { acc0 = __builtin_amdgcn_mfma_f32_16x16x4f32(w[u].x, hc[u], acc0, 0, 0, 0); acc1 = __builtin_amdgcn_mfma_f32_16x16x4f32(w[u].y, hc[u], acc1, 0, 0, 0); }
                    }
#pragma unroll
                    for (int i = 0; i < 8; ++i) hb[i] = hn[i];
                }
                ss += __shfl_xor(ss, 16); ss += __shfl_xor(ss, 32);
                const float rstd = rsqrtf(ss * (1.f / D) + EPS);
                float lg[8];
#pragma unroll
                for (int r = 0; r < 4; ++r) { lg[r] = acc0[r] * rstd + router_b[4 * q + r]; lg[4 + r] = acc1[r] * rstd + router_b[16 + 4 * q + r]; }
                float tv[TOPK]; int ti[TOPK];
#pragma unroll
                for (int k = 0; k < TOPK; ++k) {
                    float bv = lg[0]; int bi = 4 * q;
#pragma unroll
                    for (int r = 1; r < 8; ++r) { const int id = (r < 4) ? 4 * q + r : 16 + 4 * q + (r - 4); if (lg[r] > bv) { bv = lg[r]; bi = id; } }
#pragma unroll
                    for (int o = 16; o < 64; o <<= 1) { const float ov = __shfl_xor(bv, o); const int oi = __shfl_xor(bi, o); if (ov > bv || (ov == bv && oi < bi)) { bv = ov; bi = oi; } }
                    tv[k] = bv; ti[k] = bi;
#pragma unroll
                    for (int r = 0; r < 8; ++r) { const int id = (r < 4) ? 4 * q + r : 16 + 4 * q + (r - 4); if (id == bi) lg[r] = -INFINITY; }
                }
                const float e1 = __expf(tv[1] - tv[0]), e2 = __expf(tv[2] - tv[0]), e3 = __expf(tv[3] - tv[0]);
                const float inv = 1.0f / (1.0f + e1 + e2 + e3);
                {
                    const int ek = q == 0 ? ti[0] : q == 1 ? ti[1] : q == 2 ? ti[2] : ti[3];
                    const float gk = (q == 0 ? 1.0f : q == 1 ? e1 : q == 2 ? e2 : e3) * inv;
                    const int lr = __hip_atomic_fetch_add(&lcnt[ek], 1, __ATOMIC_RELAXED, __HIP_MEMORY_SCOPE_WORKGROUP);
                    sb[(16 * wave + j) * 4 + q] = ((unsigned)ek << 16) | (unsigned)lr;
                    GATE[(size_t)(tok0 + j) * TOPK + q] = gk;
                }
            } else {
                const f32x4* wr = (const f32x4*)norm2_w + lane;
                f32x4 gw4[4];
#pragma unroll
                for (int jj = 0; jj < 4; ++jj) gw4[jj] = wr[64 * jj];
#pragma unroll 1
                for (int i = 0; i < 16; i += 4) {
                    f32x4 v[4][4];
#pragma unroll
                    for (int q4 = 0; q4 < 4; ++q4) { const f32x4* hr = (const f32x4*)(H + (size_t)(tok0 + i + q4) * D) + lane;
#pragma unroll
                        for (int jj = 0; jj < 4; ++jj) v[q4][jj] = hr[64 * jj]; }
#pragma unroll
                    for (int q4 = 0; q4 < 4; ++q4) {
                        float s2 = 0.f;
#pragma unroll
                        for (int jj = 0; jj < 4; ++jj) s2 += (v[q4][jj].x * v[q4][jj].x + v[q4][jj].y * v[q4][jj].y) + (v[q4][jj].z * v[q4][jj].z + v[q4][jj].w * v[q4][jj].w);
                        const float rstd = rsqrtf(wave_sum(s2) * (1.f / D) + EPS) * SC_N2;
                        unsigned* o4 = (unsigned*)(N2 + (size_t)(tok0 + i + q4) * D) + lane;
#pragma unroll
                        for (int jj = 0; jj < 4; ++jj) o4[64 * jj] = pk4_fp8(v[q4][jj].x * rstd * gw4[jj].x, v[q4][jj].y * rstd * gw4[jj].y, v[q4][jj].z * rstd * gw4[jj].z, v[q4][jj].w * rstd * gw4[jj].w);
                    }
                }
            }
            __syncthreads();
            if (tid < NE) { const int c = lcnt[tid]; gbase[tid] = c ? (int)__hip_atomic_fetch_add(ctl + CW_CNT + ((PROBE_DUP) == 5 && rep_ == 0 ? 4096 : 0) + 64 * tid, (unsigned)c, RLX_AGENT) : 0; }
            __syncthreads();
            if (tid < 256) { const unsigned w = sb[tid]; const int ek = (int)(w >> 16), r = gbase[ek] + (int)(w & 0xffffu), m = tg * 64 + (tid >> 2);
                ROWTOK[ek * MTOK + r] = m; SLOT[(size_t)m * TOPK + (tid & 3)] = ek * MTOK + r; }
            if (tid < NE) lcnt[tid] = 0;
            __syncthreads();
        }
    }
    if ((PROBE_STAMP) == 600 + 5) tS[6] = __builtin_amdgcn_s_memrealtime();
    SEAM(5);


    if ((PROBE_STAMP) < 600 || (PROBE_STAMP) > 699) STAMP(6);
    STAMP(7);
#if defined(MOE_MERGED)
    if (IN(7)) REP(7) {
        BUILD_BS();
        pg8::Gemm g{(const bf16*)ws, (const bf16*)W1T, MTOK, 2 * FF, D / 2}; MoeOrder2 S{bs, G, vcu, cl, ROWTOK, ctl};
        EpiMoe E{EpiSwiglu{ACT, b1}, EpiDown{YS, b2}};
        pg8::gemm_phase<EpiMoe, MoeOrder2, true, true, true, true>(lds + RING_OFF, g, S, E);
    }
    if ((PROBE_STAMP) == 600 + 8) tS[6] = __builtin_amdgcn_s_memrealtime();
    SEAM(8);
#else
    if (IN(7)) REP(7) {
        BUILD_BS();
        pg8::Gemm g{(const bf16*)N2, (const bf16*)W1T, MTOK, 2 * FF, D / 2}; MoeOrder S{bs, 8, G, vcu, cl, ROWTOK};
        EpiSwiglu E{ACT, b1};
        pg8::gemm_phase<EpiSwiglu, MoeOrder, true, true, true, true>(lds + RING_OFF, g, S, E);
#if !defined(HGRN_NAIVE) && !defined(W2_IN_P0)
        {
            LAS float* scr = (LAS float*)(lds + RING_OFF + wave * 16384);
            const int r7 = (bs[NE] * 8) % G, nsl = G - r7;
            if (vcu >= r7) convert_slice_fp8(w2, FF, D, W2T, RmIdent(), 9, (vcu - r7) * NWAVES + wave, nsl * NWAVES, W2_P7, W2_P2, scr, lane);
        }
#endif
    }
    if ((PROBE_STAMP) == 600 + 7) tS[6] = __builtin_amdgcn_s_memrealtime();
    SEAM(7);

    STAMP(8);
    if (IN(8)) REP(8) {
        BUILD_BS();
        pg8::Gemm g{(const bf16*)ACT, (const bf16*)W2T, MOE_ROWS, D, FF / 2}; MoeOrder S{bs, 4, G, vcu, cl, ROWTOK};
        EpiDown E{YS, b2};
        pg8::gemm_phase<EpiDown, MoeOrder, true, true, true>(lds + RING_OFF, g, S, E);
    }
    SEAM(8);
#endif

    STAMP(9);
    if (IN(9)) REP(9) {
        BUILD_BS();
        for (int base = gw; base < MTOK; base += 16 * NGW) {
            const int mi = base + NGW * (lane >> 2); int posl = 0; float gl = 0.f;
            if (mi < MTOK) { const int sl = SLOT[(size_t)mi * TOPK + (lane & 3)]; gl = GATE[(size_t)mi * TOPK + (lane & 3)]; posl = bs[sl >> 14] * 256 + (sl & (MTOK - 1)); }
#pragma unroll 2
            for (int i = 0; i < 16; ++i) {
                const int m = base + NGW * i; if (m >= MTOK) break;
                const f32x4* hr = (const f32x4*)(H + (size_t)m * D) + lane; const f32x4* wr = (const f32x4*)final_norm_w + lane;
                int pos[TOPK]; float gk[TOPK];
#pragma unroll
                for (int k = 0; k < TOPK; ++k) { pos[k] = __shfl(posl, 4 * i + k); gk[k] = __shfl(gl, 4 * i + k); }
                f32x4 v[4]; unsigned yw[TOPK][4];
#pragma unroll
                for (int j = 0; j < 4; ++j) v[j] = hr[64 * j];
#pragma unroll
                for (int k = 0; k < TOPK; ++k) { const unsigned* yr = (const unsigned*)(YS + (size_t)pos[k] * D) + lane;
#pragma unroll
                    for (int j = 0; j < 4; ++j) yw[k][j] = yr[64 * j]; }
#pragma unroll
                for (int k = 0; k < TOPK; ++k)
#pragma unroll
                    for (int j = 0; j < 4; ++j) { const f32x2_t lo = __builtin_amdgcn_cvt_pk_f32_fp8((int)yw[k][j], false), hi = __builtin_amdgcn_cvt_pk_f32_fp8((int)yw[k][j], true); const float g = gk[k] * (1.0f / SC_YS);
                        v[j].x += g * lo.x; v[j].y += g * lo.y; v[j].z += g * hi.x; v[j].w += g * hi.y; }
                float s = 0.f;
#pragma unroll
                for (int j = 0; j < 4; ++j) s += (v[j].x * v[j].x + v[j].y * v[j].y) + (v[j].z * v[j].z + v[j].w * v[j].w);
                const float rstd = rsqrtf(wave_sum(s) * (1.f / D) + EPS);
                f32x4* orow = (f32x4*)(out + (size_t)m * D) + lane;
#pragma unroll
                for (int j = 0; j < 4; ++j) orow[64 * j] = v[j] * rstd * wr[64 * j];
            }
        }
    }
    STAMP(N_PHASES);
#ifndef PROBE_WG
#define PROBE_WG 0
#endif
    if ((PROBE_STAMP) >= 660 && (PROBE_STAMP) <= 669 && bx == (PROBE_WG)) {
        const unsigned long long a_ = *(volatile LAS unsigned long long*)(lds + LDSCTL_OFF + 640), b_ = *(volatile LAS unsigned long long*)(lds + LDSCTL_OFF + 648);
        const unsigned long long d = 64ull * (b_ - a_), t0 = __builtin_amdgcn_s_memrealtime();
        while (__builtin_amdgcn_s_memrealtime() - t0 < d) __builtin_amdgcn_s_sleep(8);
    } else
    if ((PROBE_STAMP) >= 0 && bx == (PROBE_WG)) {
        const int k0 = (PROBE_STAMP) == 640 ? 0 : ((PROBE_STAMP) >= 650 && (PROBE_STAMP) <= 659) ? 2 : (PROBE_STAMP) % 100, k1 = ((PROBE_STAMP) >= 100) ? (PROBE_STAMP) / 100 : k0 + 1;
        const unsigned long long d = 2ull * (tS[k1 > N_PHASES ? N_PHASES : k1] - tS[k0]), t0 = __builtin_amdgcn_s_memrealtime();
        while (__builtin_amdgcn_s_memrealtime() - t0 < d) __builtin_amdgcn_s_sleep(8);
    }
#undef IN
#undef SEAM
#undef BUILD_BS
}

extern "C" void kernel_launch(void* const* d_in, const int* in_sizes, int n_in, void* d_out, int out_size, void* d_ws, size_t ws_size, hipStream_t stream) {
    static int grid = 0;
    if (grid == 0) {
        if (n_in != 18 || in_sizes[0] != MTOK * D || out_size != MTOK * D || ws_size < WS_END) { fprintf(stderr, "kernel_launch: unexpected shapes (n_in %d, in0 %d, out %d, ws %zu < %zu); nothing launched\n", n_in, n_in > 0 ? in_sizes[0] : -1, out_size, ws_size, (size_t)WS_END); grid = -1; return; }
        int dev = 0, cus = 0, per_cu = 0;
        if (hipGetDevice(&dev) != hipSuccess || hipDeviceGetAttribute(&cus, hipDeviceAttributeMultiprocessorCount, dev) != hipSuccess) { fprintf(stderr, "kernel_launch: device query failed\n"); grid = -1; return; }
        if (hipFuncSetAttribute((const void*)fwd_kernel, hipFuncAttributeMaxDynamicSharedMemorySize, LDS_BYTES) != hipSuccess) { fprintf(stderr, "kernel_launch: hipFuncSetAttribute failed\n"); grid = -1; return; }
        if (hipOccupancyMaxActiveBlocksPerMultiprocessor(&per_cu, (const void*)fwd_kernel, NTHR, LDS_BYTES) != hipSuccess || per_cu < 1)
            fprintf(stderr, "kernel_launch: note: occupancy query reports %d workgroups per CU\n", per_cu);
        (void)hipGetLastError();
        grid = cus;
    }
    if (grid < 0) return;
    if (hipMemsetAsync((char*)d_ws + WS_CTL, 0, CTL_ZERO_BYTES, stream) != hipSuccess) { fprintf(stderr, "kernel_launch: memset failed\n"); return; }
    Args a{};
    for (int i = 0; i < 18; ++i) a.in[i] = (const float*)d_in[i];
    a.out = (float*)d_out; a.ws = (unsigned char*)d_ws;
#if MK_N_LAUNCHES == 1
    a.ph_lo = 0; a.ph_hi = N_PHASES;
    hipLaunchKernelGGL(fwd_kernel, dim3(grid), dim3(NTHR), LDS_BYTES, stream, a);
#else
    for (int ph = 0; ph < N_PHASES; ++ph) { a.ph_lo = ph; a.ph_hi = ph + 1; hipLaunchKernelGGL(fwd_kernel, dim3(grid), dim3(NTHR), LDS_BYTES, stream, a); }
#endif
    const hipError_t le = hipPeekAtLastError();
    if (le != hipSuccess) fprintf(stderr, "kernel_launch: launch failed: %s\n", hipGetErrorName(le));
}
```
